# Optimizing an MI355X kernel written in HIP

```python
import math
import jax
import jax.numpy as jnp
from jax import lax
import numpy as np

D_MODEL = 1024
BATCH = 16
SEQ = 2048
DEPTH = 2

GRID_W = 64
ROPE_THETA = 10000.0
Q_BLOCK = 128
LN_EPS = 1e-5
RMS_EPS = 1e-6
MIX_WIDTH = D_MODEL
GW = MIX_WIDTH // 4
HEAD_DIM = 64
ATT_HEADS = GW // HEAD_DIM
ATT_KV_HEADS = 2
RWKV_HEADS = GW // HEAD_DIM
RWKV_DECAY_LORA = 32
RWKV_AAA_LORA = 32
RWKV_GATE_LORA = 64
RWKV_GN_EPS = 64e-5
RWKV_DECAY_SCALE = math.exp(-0.5)
HGRN_HEADS = 4
HGRN_EXPAND = 64
HGRN_VDIM = GW // HGRN_HEADS
HGRN_CHUNK = 16
MLA_HEADS = 4
MLA_NOPE = 64
MLA_ROPE = 32
MLA_V = GW // MLA_HEADS
MLA_Q_RANK = 192
MLA_KV_RANK = 128
MEM_TOKENS = 256
MEM_HEADS = 4
MOE_GROUPS = 4
MOE_PER_GROUP = 8
MOE_EXPERTS = MOE_GROUPS * MOE_PER_GROUP
MOE_TOPK = 2
MOE_HIDDEN = 256
MOE_BLOCK = 128
DN_ALPHA = (2 * DEPTH) ** 0.25
DN_BETA = (8 * DEPTH) ** -0.25
ATT_IN = ATT_HEADS * HEAD_DIM + 2 * ATT_KV_HEADS * HEAD_DIM
RWKV_IN = 3 * GW + 2 * RWKV_DECAY_LORA + 2 * RWKV_AAA_LORA + RWKV_GATE_LORA
HGRN_IN = 3 * HGRN_HEADS * HGRN_EXPAND + 2 * HGRN_HEADS * HGRN_VDIM
MLA_IN = MLA_Q_RANK + MLA_KV_RANK + MLA_ROPE
IN_WIDTH = ATT_IN + RWKV_IN + HGRN_IN + MLA_IN

kernel_name = 'hybrid_parallel_heads_hmoe_encoder'


def split_sizes(x, sizes):
    idx, acc = [], 0
    for s in sizes[:-1]:
        acc += s
        idx.append(acc)
    return jnp.split(x, idx, axis=-1)


def layer_norm(x, g, b):
    xf = x.astype(jnp.float32)
    mu = jnp.mean(xf, -1, keepdims=True)
    var = jnp.mean(jnp.square(xf - mu), -1, keepdims=True)
    return ((xf - mu) * lax.rsqrt(var + LN_EPS) * g + b).astype(x.dtype)


def rms_norm(x, g):
    xf = x.astype(jnp.float32)
    return (xf * lax.rsqrt(jnp.mean(xf * xf, -1, keepdims=True) + RMS_EPS) * g).astype(x.dtype)


def rope_tables(pos, dim, dtype):
    inv = ROPE_THETA ** (-jnp.arange(0, dim, 2, dtype=jnp.float32) / dim)
    ang = pos[:, None] * inv[None, :]
    return jnp.cos(ang).astype(dtype), jnp.sin(ang).astype(dtype)


def apply_rope_1d(x, cos, sin):
    x1, x2 = jnp.split(x, 2, axis=-1)
    c, s = cos[:, None, :], sin[:, None, :]
    return jnp.concatenate([x1 * c - x2 * s, x1 * s + x2 * c], axis=-1)


def axial_rope(x, row_pos, col_pos):
    half = x.shape[-1] // 2
    cr, sr = rope_tables(row_pos, half, x.dtype)
    cc, sc = rope_tables(col_pos, half, x.dtype)
    return jnp.concatenate([apply_rope_1d(x[..., :half], cr, sr),
                            apply_rope_1d(x[..., half:], cc, sc)], axis=-1)


def block_attention(q, k, v, scale):
    B, S, H, dk = q.shape
    Hkv, dv = k.shape[2], v.shape[-1]
    G = H // Hkv
    nb = S // Q_BLOCK
    qb = q.reshape(B, nb, Q_BLOCK, Hkv, G, dk).transpose(1, 0, 2, 3, 4, 5)

    def attend(qblk):
        s = jnp.einsum('bqkgd,bskd->bkgqs', qblk, k, preferred_element_type=jnp.float32) * scale
        p = jax.nn.softmax(s, axis=-1).astype(v.dtype)
        return jnp.einsum('bkgqs,bskd->bqkgd', p, v)

    o = lax.map(attend, qb)
    return o.transpose(1, 0, 2, 3, 4, 5).reshape(B, S, H * dv)


def gqa_axial_mixer(z, q_norm, k_norm, row_pos, col_pos):
    B, S, _ = z.shape
    q, k, v = split_sizes(z, (ATT_HEADS * HEAD_DIM, ATT_KV_HEADS * HEAD_DIM, ATT_KV_HEADS * HEAD_DIM))
    q = q.reshape(B, S, ATT_HEADS, HEAD_DIM)
    k = k.reshape(B, S, ATT_KV_HEADS, HEAD_DIM)
    v = v.reshape(B, S, ATT_KV_HEADS, HEAD_DIM)
    q = axial_rope(rms_norm(q, q_norm), row_pos, col_pos)
    k = axial_rope(rms_norm(k, k_norm), row_pos, col_pos)
    return block_attention(q, k, v, HEAD_DIM ** -0.5)


def rwkv7_bidir(z, mu_prev, mu_next, w0, w2, a0, a2, g2, k_k, k_a, r_k, gn_g, gn_b):
    B, S, _ = z.shape
    H, N = RWKV_HEADS, HEAD_DIM
    zf = z.astype(jnp.float32)
    z_prev = jnp.pad(zf, ((0, 0), (1, 0), (0, 0)))[:, :-1]
    z_next = jnp.pad(zf, ((0, 0), (0, 1), (0, 0)))[:, 1:]
    zf = zf + mu_prev * (z_prev - zf) + mu_next * (z_next - zf)
    r, k, v, w_lo, a_lo, g_lo = split_sizes(
        zf, (GW, GW, GW, 2 * RWKV_DECAY_LORA, 2 * RWKV_AAA_LORA, RWKV_GATE_LORA))
    w_lo = w_lo.reshape(B, S, 2, RWKV_DECAY_LORA)
    a_lo = a_lo.reshape(B, S, 2, RWKV_AAA_LORA)
    w_raw = w0 + jnp.einsum('bsdr,drc->bsdc', jnp.tanh(w_lo), w2)
    decay = jnp.exp(-RWKV_DECAY_SCALE * jax.nn.sigmoid(w_raw))
    a = jax.nn.sigmoid(a0 + jnp.einsum('bsdr,drc->bsdc', a_lo, a2))
    g = jax.nn.sigmoid(g_lo) @ g2
    kk = (k * k_k).reshape(B, S, H, N)
    kk = kk / jnp.maximum(jnp.sqrt(jnp.sum(kk * kk, -1, keepdims=True)), 1e-12)
    k_dir = k[:, :, None, :] * (1.0 + (a - 1.0) * k_a)

    def heads(t):
        return t.reshape(t.shape[:-1] + (H, N))

    decay, a, k_dir, r, v = heads(decay), heads(a), heads(k_dir), heads(r), heads(v)
    a_kk = a * kk[:, :, None]

    def per_dir(t):
        return jnp.stack([t[:, :, 0], t[:, ::-1, 1]], 0).transpose(2, 0, 1, 3, 4)

    def both_dirs(t):
        return jnp.stack([t, t[:, ::-1]], 0).transpose(2, 0, 1, 3, 4)

    seq_in = (both_dirs(r), per_dir(decay), per_dir(k_dir), both_dirs(v), both_dirs(kk), per_dir(a_kk))

    def step(state, inp):
        r_t, w_t, k_t, v_t, kk_t, akk_t = inp
        sa = jnp.einsum('dbhij,dbhj->dbhi', state, kk_t)
        state = (state * w_t[..., None, :] - sa[..., None] * akk_t[..., None, :]
                 + v_t[..., None] * k_t[..., None, :])
        return state, jnp.einsum('dbhij,dbhj->dbhi', state, r_t)

    state0 = jnp.zeros((2, B, H, N, N), jnp.float32)
    _, ys = lax.scan(step, state0, seq_in)
    ys = ys.transpose(1, 2, 0, 3, 4)
    y = ys[0] + ys[1, :, ::-1]
    mu = jnp.mean(y, -1, keepdims=True)
    var = jnp.mean(jnp.square(y - mu), -1, keepdims=True)
    y = ((y - mu) * lax.rsqrt(var + RWKV_GN_EPS)).reshape(B, S, GW) * gn_g + gn_b
    bonus = jnp.sum(r[:, :, None] * k_dir * r_k, axis=(2, 4))
    out = (y + (bonus[..., None] * v).reshape(B, S, GW)) * g
    return out.astype(z.dtype)


def hgrn2_chunk(q, log_f, v):
    B, S, H, Dk = q.shape
    Dv = v.shape[-1]
    C = HGRN_CHUNK
    nc = S // C
    k = -jnp.expm1(log_f)
    q, log_f, k, v = [t.reshape(B, nc, C, H, t.shape[-1]) for t in (q, log_f, k, v)]
    G = jnp.cumsum(log_f, axis=2)
    mask = jnp.tril(jnp.ones((C, C), bool))[None, None, :, :, None, None]
    pair_decay = jnp.exp(jnp.where(mask, G[:, :, :, None] - G[:, :, None, :], -jnp.inf))
    A = jnp.einsum('bnthd,bntshd,bnshd->bnhts', q, pair_decay, k)
    intra = jnp.einsum('bnhts,bnshe->bnthe', A, v)
    G_last = G[:, :, -1]
    U = jnp.einsum('bnshd,bnshe->bnhde', k * jnp.exp(G_last[:, :, None] - G), v)
    chunk_decay = jnp.exp(G_last)

    def step(state, inp):
        dec, u = inp
        return dec[..., None] * state + u, state

    state0 = jnp.zeros((B, H, Dk, Dv), jnp.float32)
    _, S_prev = lax.scan(step, state0, (chunk_decay.transpose(1, 0, 2, 3), U.transpose(1, 0, 2, 3, 4)))
    S_prev = S_prev.transpose(1, 0, 2, 3, 4)
    inter = jnp.einsum('bnthd,bnhde->bnthe', q * jnp.exp(G), S_prev)
    return (intra + inter).reshape(B, S, H, Dv)


def hgrn2_bidir(z, lb, norm_g):
    B, S, _ = z.shape
    H, Dk, Dv = HGRN_HEADS, HGRN_EXPAND, HGRN_VDIM
    zf = z.astype(jnp.float32)
    q, f_fwd, f_bwd, i, g = split_sizes(zf, (H * Dk, H * Dk, H * Dk, H * Dv, H * Dv))
    q = jax.nn.silu(q).reshape(B, S, H, Dk)
    i = i.reshape(B, S, H, Dv)
    lb = lb.astype(jnp.float32).reshape(H, Dk)
    log_lb, log_1m_lb = jnp.log(lb), jnp.log1p(-lb)

    def log_forget(fr):
        return jnp.logaddexp(log_1m_lb + jax.nn.log_sigmoid(fr.reshape(B, S, H, Dk)), log_lb)

    o = (hgrn2_chunk(q, log_forget(f_fwd), i)
         + hgrn2_chunk(q[:, ::-1], log_forget(f_bwd)[:, ::-1], i[:, ::-1])[:, ::-1])
    o = o * lax.rsqrt(jnp.mean(o * o, -1, keepdims=True) + RMS_EPS) * norm_g.reshape(H, Dv)
    return (o.reshape(B, S, H * Dv) * jax.nn.silu(g)).astype(z.dtype)


def mla_mixer(z, q_norm, kv_norm, w_uq, w_ukv, row_pos, col_pos):
    B, S, _ = z.shape
    H = MLA_HEADS
    c_q, c_kv, k_rope = split_sizes(z, (MLA_Q_RANK, MLA_KV_RANK, MLA_ROPE))
    q = (rms_norm(c_q, q_norm) @ w_uq).reshape(B, S, H, MLA_NOPE + MLA_ROPE)
    kv = (rms_norm(c_kv, kv_norm) @ w_ukv).reshape(B, S, H, MLA_NOPE + MLA_V)
    q_nope, q_rope = q[..., :MLA_NOPE], q[..., MLA_NOPE:]
    k_nope, v = kv[..., :MLA_NOPE], kv[..., MLA_NOPE:]
    q_rope = axial_rope(q_rope, row_pos, col_pos)
    k_rope = axial_rope(k_rope[:, :, None, :], row_pos, col_pos)
    q = jnp.concatenate([q_nope, q_rope], -1)
    k = jnp.concatenate([k_nope, jnp.broadcast_to(k_rope, (B, S, H, MLA_ROPE))], -1)
    return block_attention(q, k, v, (MLA_NOPE + MLA_ROPE) ** -0.5)


def memory_cross_attention(x, mem, wq, wkv, wo):
    B, S, D = x.shape
    M = mem.shape[1]
    dh = D // MEM_HEADS
    q = (x @ wq).reshape(B, S, MEM_HEADS, dh)
    k, v = jnp.split(mem @ wkv, 2, axis=-1)
    k = k.reshape(B, M, MEM_HEADS, dh)
    v = v.reshape(B, M, MEM_HEADS, dh)
    return block_attention(q, k, v, dh ** -0.5) @ wo


def grouped_expert_ffn(xt, e_ids, gates, w1, w3, w2):
    N, D = xt.shape
    K = e_ids.shape[1]
    E = w1.shape[0]
    M = N * K
    flat_e = e_ids.reshape(-1).astype(jnp.int32)
    flat_tok = jnp.arange(M, dtype=jnp.int32) // K
    counts = jnp.zeros((E,), jnp.int32).at[flat_e].add(1)
    padded = (counts + MOE_BLOCK - 1) // MOE_BLOCK * MOE_BLOCK
    pad_end = jnp.cumsum(padded)
    pad_start = pad_end - padded
    seg_start = jnp.cumsum(counts) - counts
    order = jnp.argsort(flat_e)
    sorted_e = flat_e[order]
    dest_sorted = pad_start[sorted_e] + jnp.arange(M, dtype=jnp.int32) - seg_start[sorted_e]
    dest = jnp.zeros((M,), jnp.int32).at[order].set(dest_sorted)
    n_rows = (M + MOE_BLOCK - 1) // MOE_BLOCK * MOE_BLOCK + E * MOE_BLOCK
    n_blocks = n_rows // MOE_BLOCK
    row_tok = jnp.full((n_rows,), N, jnp.int32).at[dest].set(flat_tok)
    x_rows = jnp.concatenate([xt, jnp.zeros((1, D), xt.dtype)], 0)[row_tok]
    x_rows = x_rows.reshape(n_blocks, MOE_BLOCK, D)
    block_start = jnp.arange(n_blocks, dtype=jnp.int32) * MOE_BLOCK
    block_e = jnp.minimum(jnp.searchsorted(pad_end, block_start, side='right'), E - 1)

    def expert_block(args):
        xb, e = args
        h = jax.nn.silu(xb @ w1[e]) * (xb @ w3[e])
        return h @ w2[e]

    y_rows = lax.map(expert_block, (x_rows, block_e)).reshape(n_rows, D)
    return jnp.sum(y_rows[dest].reshape(N, K, D) * gates[..., None], axis=1)


def hierarchical_moe(x, wg_group, bg_group, wg_expert, bg_expert, w1, w3, w2):
    B, S, D = x.shape
    xt = x.reshape(B * S, D)
    N = xt.shape[0]
    g_logits = (xt @ wg_group).astype(jnp.float32) + bg_group
    g_idx = jnp.argmax(g_logits, axis=-1)
    p_group = jnp.take_along_axis(jax.nn.softmax(g_logits, -1), g_idx[:, None], axis=1)
    e_logits = ((xt @ wg_expert).astype(jnp.float32) + bg_expert).reshape(N, MOE_GROUPS, MOE_PER_GROUP)
    e_sel = jnp.take_along_axis(e_logits, g_idx[:, None, None], axis=1)[:, 0]
    top_v, top_i = lax.top_k(e_sel, MOE_TOPK)
    gates = (p_group * jax.nn.softmax(top_v, -1)).astype(x.dtype)
    e_ids = g_idx[:, None].astype(jnp.int32) * MOE_PER_GROUP + top_i.astype(jnp.int32)
    return grouped_expert_ffn(xt, e_ids, gates, w1, w3, w2).reshape(B, S, D)


def setup_inputs(seed: int = 0) -> dict:
    key = jax.random.key(seed)
    ks = iter(jax.random.split(key, 48))
    L, D = DEPTH, D_MODEL

    def nrm(shape, scale=1.0):
        return scale * jax.random.normal(next(ks), shape, jnp.float32)

    def gain(shape):
        return 1.0 + nrm(shape, 0.02)

    return {
        'x': nrm((BATCH, SEQ, D)),
        'mem': nrm((BATCH, MEM_TOKENS, D)),
        'ln_in_g': gain((D,)),
        'ln_in_b': nrm((D,), 0.02),
        'w_in': nrm((L, D, IN_WIDTH), D ** -0.5),
        'attn_q_norm': gain((L, HEAD_DIM)),
        'attn_k_norm': gain((L, HEAD_DIM)),
        'rwkv_mu_prev': 0.3 + nrm((L, RWKV_IN), 0.1),
        'rwkv_mu_next': 0.3 + nrm((L, RWKV_IN), 0.1),
        'rwkv_w0': nrm((L, 2, GW), 0.5),
        'rwkv_w2': nrm((L, 2, RWKV_DECAY_LORA, GW), RWKV_DECAY_LORA ** -0.5),
        'rwkv_a0': nrm((L, 2, GW), 0.1),
        'rwkv_a2': nrm((L, 2, RWKV_AAA_LORA, GW), RWKV_AAA_LORA ** -0.5),
        'rwkv_g2': nrm((L, RWKV_GATE_LORA, GW), RWKV_GATE_LORA ** -0.5),
        'rwkv_k_k': 0.85 + nrm((L, GW), 0.02),
        'rwkv_k_a': gain((L, GW)),
        'rwkv_r_k': nrm((L, RWKV_HEADS, HEAD_DIM), 0.1),
        'rwkv_gn_g': gain((L, GW)),
        'rwkv_gn_b': nrm((L, GW), 0.02),
        'hgrn_lb_logits': nrm((L, HGRN_HEADS * HGRN_EXPAND), 0.5),
        'hgrn_norm_g': gain((L, HGRN_HEADS * HGRN_VDIM)),
        'mla_q_norm': gain((L, MLA_Q_RANK)),
        'mla_kv_norm': gain((L, MLA_KV_RANK)),
        'mla_w_uq': nrm((L, MLA_Q_RANK, MLA_HEADS * (MLA_NOPE + MLA_ROPE)), MLA_Q_RANK ** -0.5),
        'mla_w_ukv': nrm((L, MLA_KV_RANK, MLA_HEADS * (MLA_NOPE + MLA_V)), MLA_KV_RANK ** -0.5),
        'w_out': nrm((L, MIX_WIDTH, D), DN_BETA * MIX_WIDTH ** -0.5),
        'ln1_g': gain((L, D)),
        'ln1_b': nrm((L, D), 0.02),
        'mem_wq': nrm((L, D, D), D ** -0.5),
        'mem_wkv': nrm((L, D, 2 * D), D ** -0.5),
        'mem_wo': nrm((L, D, D), DN_BETA * D ** -0.5),
        'ln2_g': gain((L, D)),
        'ln2_b': nrm((L, D), 0.02),
        'moe_wg_group': nrm((L, D, MOE_GROUPS), D ** -0.5),
        'moe_bg_group': nrm((L, MOE_GROUPS), 0.01),
        'moe_wg_expert': nrm((L, D, MOE_EXPERTS), D ** -0.5),
        'moe_bg_expert': nrm((L, MOE_EXPERTS), 0.01),
        'moe_w1': nrm((L, MOE_EXPERTS, D, MOE_HIDDEN), D ** -0.5),
        'moe_w3': nrm((L, MOE_EXPERTS, D, MOE_HIDDEN), D ** -0.5),
        'moe_w2': nrm((L, MOE_EXPERTS, MOE_HIDDEN, D), DN_BETA * MOE_HIDDEN ** -0.5),
        'ln3_g': gain((L, D)),
        'ln3_b': nrm((L, D), 0.02),
    }


def reference(x, mem, ln_in_g, ln_in_b, w_in, attn_q_norm, attn_k_norm,
              rwkv_mu_prev, rwkv_mu_next, rwkv_w0, rwkv_w2, rwkv_a0, rwkv_a2, rwkv_g2,
              rwkv_k_k, rwkv_k_a, rwkv_r_k, rwkv_gn_g, rwkv_gn_b,
              hgrn_lb_logits, hgrn_norm_g,
              mla_q_norm, mla_kv_norm, mla_w_uq, mla_w_ukv,
              w_out, ln1_g, ln1_b,
              mem_wq, mem_wkv, mem_wo, ln2_g, ln2_b,
              moe_wg_group, moe_bg_group, moe_wg_expert, moe_bg_expert,
              moe_w1, moe_w3, moe_w2, ln3_g, ln3_b):
    S = x.shape[1]
    ROWS = S // GRID_W
    row_pos = jnp.repeat(jnp.arange(ROWS, dtype=jnp.float32), GRID_W)
    col_pos = jnp.tile(jnp.arange(GRID_W, dtype=jnp.float32), ROWS)
    lb_all = jnp.cumsum(jax.nn.softmax(hgrn_lb_logits.astype(jnp.float32), axis=0), axis=0)
    lb_all = lb_all - lb_all[0]

    x = layer_norm(x, ln_in_g, ln_in_b)
    for l in range(DEPTH):
        h = x @ w_in[l]
        z_att, z_rwkv, z_hgrn, z_mla = split_sizes(h, (ATT_IN, RWKV_IN, HGRN_IN, MLA_IN))
        y_att = gqa_axial_mixer(z_att, attn_q_norm[l], attn_k_norm[l], row_pos, col_pos)
        y_rwkv = rwkv7_bidir(z_rwkv, rwkv_mu_prev[l], rwkv_mu_next[l], rwkv_w0[l], rwkv_w2[l],
                             rwkv_a0[l], rwkv_a2[l], rwkv_g2[l], rwkv_k_k[l], rwkv_k_a[l],
                             rwkv_r_k[l], rwkv_gn_g[l], rwkv_gn_b[l])
        y_hgrn = hgrn2_bidir(z_hgrn, lb_all[l], hgrn_norm_g[l])
        y_mla = mla_mixer(z_mla, mla_q_norm[l], mla_kv_norm[l], mla_w_uq[l], mla_w_ukv[l],
                          row_pos, col_pos)
        mix = jnp.concatenate([y_att, y_rwkv, y_hgrn, y_mla], axis=-1) @ w_out[l]
        x = layer_norm(DN_ALPHA * x + mix, ln1_g[l], ln1_b[l])
        x = layer_norm(DN_ALPHA * x + memory_cross_attention(x, mem, mem_wq[l], mem_wkv[l], mem_wo[l]),
                       ln2_g[l], ln2_b[l])
        x = layer_norm(DN_ALPHA * x + hierarchical_moe(x, moe_wg_group[l], moe_bg_group[l],
                                                       moe_wg_expert[l], moe_bg_expert[l],
                                                       moe_w1[l], moe_w3[l], moe_w2[l]),
                       ln3_g[l], ln3_b[l])
    return x
```

```cpp
#ifndef CPU_EMU
#include <hip/hip_runtime.h>
#else
#include "emu_shim.h"
#endif
#include <stdint.h>

#ifndef CFG_B
#define CFG_B 16
#endif
#ifndef CFG_S
#define CFG_S 2048
#endif
#ifndef N_LAUNCH_MODE
#define N_LAUNCH_MODE 0
#endif

typedef unsigned short bf16;
#define DI __device__ __forceinline__

constexpr int BATCH = CFG_B, SEQ = CFG_S, NTOK = BATCH * SEQ, DM = 1024;
constexpr int MEMT = 256, NMEM = BATCH * MEMT;
constexpr int GRIDW = 64;
constexpr int HP = 3328;
constexpr int IN_WIDTH = 3104;
constexpr int NEXP = 32, MOEH = 256;
constexpr int MOE_ROWS = 2 * NTOK + NEXP * 256;
constexpr float LN_EPS = 1e-5f, RMS_EPS = 1e-6f, GN_EPS = 64e-5f;
constexpr float DN_ALPHA = 1.41421356237309515f;
constexpr float DECAY_SCALE = 0.60653065971263342f;

constexpr size_t AL(size_t x) { return (x + 255) & ~(size_t)255; }
constexpr size_t OFF_CTL = 0;
constexpr size_t CTL_BYTES = 32768;
constexpr size_t CTL_CNT = 16384;
constexpr size_t CTL_EOFF = 16384 + 1024;
constexpr size_t OFF_XB = AL(OFF_CTL + CTL_BYTES);
constexpr size_t SZ_XB = (size_t)NTOK * DM * 2;
constexpr size_t OFF_WTS = AL(OFF_XB + SZ_XB);
constexpr size_t W_IN_T = 0;
constexpr size_t W_UQ_T = W_IN_T + (size_t)HP * 1024 * 2;
constexpr size_t W_UKV_T = W_UQ_T + 512 * 256 * 2;
constexpr size_t W_OUT_T = W_UKV_T + 512 * 256 * 2;
constexpr size_t W_Q_T = W_OUT_T + 1024 * 1024 * 2;
constexpr size_t W_KV_T = W_Q_T + 1024 * 1024 * 2;
constexpr size_t W_O_T = W_KV_T + 2048 * 1024 * 2;
constexpr size_t SZ_WTS = W_O_T + 1024 * 1024 * 2;
constexpr size_t OFF_KMEM = AL(OFF_WTS + SZ_WTS);
constexpr size_t OFF_VTMEM = AL(OFF_KMEM + (size_t)NMEM * 1024 * 2);
constexpr size_t OFF_MEMB = AL(OFF_VTMEM + (size_t)NMEM * 1024 * 2);
constexpr size_t OFF_VTATT = AL(OFF_MEMB + (size_t)NMEM * 1024 * 2);
constexpr size_t OFF_VTMLA = AL(OFF_VTATT + (size_t)BATCH * 2 * 64 * SEQ * 2);
constexpr size_t OFF_HATT = AL(OFF_VTMLA + (size_t)BATCH * 4 * 64 * SEQ * 2);
constexpr size_t OFF_HMLA = OFF_HATT + (size_t)NTOK * 512 * 2;
constexpr size_t OFF_HRWKV = OFF_HMLA + (size_t)NTOK * 512 * 2;
constexpr size_t OFF_R7 = OFF_HRWKV + (size_t)NTOK * 1024 * 2;
constexpr size_t SZ_R7 = (size_t)NTOK * 9 * 256 * 2;
constexpr size_t OFF_HHGRN = OFF_R7 + SZ_R7;
constexpr size_t WS_END = OFF_HHGRN + (size_t)NTOK * 1280 * 2;

constexpr size_t OFF_QMLA = OFF_XB;
constexpr size_t OFF_KNOPE = OFF_QMLA + (size_t)NTOK * 384 * 2;
constexpr size_t OFF_KROPE = OFF_KNOPE + (size_t)NTOK * 256 * 2;
constexpr size_t OFF_G = OFF_KROPE + (size_t)NTOK * 32 * 2;
constexpr size_t OFF_BONUS = OFF_G + (size_t)NTOK * 256 * 2;
static_assert(OFF_BONUS + (size_t)NTOK * 16 <= OFF_XB + SZ_XB, "xb alias region");
constexpr size_t OFF_YCAT = OFF_HRWKV;
constexpr size_t OFF_QMEM = OFF_HATT;
constexpr size_t OFF_OMEM = OFF_R7;
#ifdef CPU_EMU
constexpr size_t OFF_EMU_SCAN = WS_END;
constexpr size_t OFF_LISTS = AL(OFF_EMU_SCAN + (size_t)4 * NTOK * 256 * 2);
#else
constexpr size_t OFF_LISTS = OFF_HATT;
#endif
constexpr size_t OFF_TINFO = OFF_LISTS + (size_t)NEXP * NTOK * 4;
constexpr size_t OFF_HM = AL(OFF_TINFO + (size_t)NTOK * 32);
constexpr size_t OFF_YROWS = AL(OFF_HM + (size_t)MOE_ROWS * 256 * 2);
#ifdef CPU_EMU
constexpr size_t OFF_W13T = AL(OFF_YROWS + (size_t)MOE_ROWS * 1024 * 2);
#else
static_assert(OFF_YROWS + (size_t)MOE_ROWS * 1024 * 2 <= OFF_HHGRN, "moe alias region");
constexpr size_t OFF_W13T = OFF_HHGRN;
#endif
constexpr size_t OFF_W2T = OFF_W13T + (size_t)NEXP * 512 * 1024 * 2;
#ifdef CPU_EMU
constexpr size_t WS_END_EMU = OFF_W2T + (size_t)NEXP * 1024 * 256 * 2;
#else
static_assert(OFF_W2T + (size_t)NEXP * 1024 * 256 * 2 <= WS_END, "moe weights alias");
#endif

enum { R_R = 0, R_V = 1, R_KK = 2, R_W0 = 3, R_W1 = 4, R_KD0 = 5, R_KD1 = 6, R_AK0 = 7, R_AK1 = 8 };

DI float bf2f(bf16 v) { union { unsigned u; float f; } x; x.u = (unsigned)v << 16; return x.f; }
DI bf16 f2bf(float f) { union { unsigned u; float f; } x; x.f = f; unsigned u = x.u; u += 0x7fffu + ((u >> 16) & 1u); return (bf16)(u >> 16); }
DI float sigmoidf_(float x) { return 1.0f / (1.0f + expf(-x)); }
DI float siluf_(float x) { return x * sigmoidf_(x); }

#ifdef CPU_EMU
constexpr int GRP = 1;
DI float grp_sum(float v) { return v; }
DI int gthreads() { return 1; }
DI int gtid_() { return 0; }
DI int wave_item_index() { return 0; }
#else
constexpr int GRP = 64;
DI float grp_sum(float v) {
#pragma unroll
    for (int o = 32; o > 0; o >>= 1) v += __shfl_xor(v, o, 64);
    return v;
}
DI int gthreads() { return gridDim.x * blockDim.x; }
DI int gtid_() { return blockIdx.x * blockDim.x + threadIdx.x; }
DI int wave_item_index() { return (int)(((threadIdx.x >> 6) * gridDim.x + blockIdx.x) * 64 + (threadIdx.x & 63)); }
#endif
constexpr int PER64 = 64 / GRP;
constexpr int PERLN = 1024 / GRP;
DI int glane() { return (int)(threadIdx.x % GRP); }
DI int ggrp() { return gtid_() / GRP; }
DI int ngrp() { return gthreads() / GRP; }

struct Args {
    const float* in[42];
    float* out;
    unsigned char* ws;
    int ph_lo, ph_hi;
};

DI float rope_inv(int f, int nf) { return powf(10000.0f, -(float)f / (float)nf); }

#ifndef CPU_EMU
using bf16x8 = __attribute__((ext_vector_type(8))) short;
using bf16x4 = __attribute__((ext_vector_type(4))) short;
using f32x4 = __attribute__((ext_vector_type(4))) float;
using f32x16 = __attribute__((ext_vector_type(16))) float;
typedef __bf16 bf16v2 __attribute__((ext_vector_type(2)));
typedef float f32v2 __attribute__((ext_vector_type(2)));
DI unsigned pack_bf16(float lo, float hi) { f32v2 v = {lo, hi}; bf16v2 b = __builtin_convertvector(v, bf16v2); return __builtin_bit_cast(unsigned, b); }

constexpr int G_BM = 256, G_BK = 64, G_HALF = 128, G_HT = G_HALF * G_BK, G_SHM = 8 * G_HT * 2;
DI int g_lds_byte(int r, int c) { int st = (r >> 4) * 2 + (c >> 5), rr = r & 15, cc = c & 31, ob = rr * 64 + cc * 2; return st * 1024 + (ob ^ (((ob >> 9) & 1) << 5)); }
DI void g_stage_rc(int b, int& R, int& C) { int st = b / 1024, sb = b % 1024, swz = sb ^ (((sb >> 9) & 1) << 5); R = (st >> 1) * 16 + swz / 64; C = (st & 1) * 32 + (swz % 64) / 2; }

template <bool GATHER, class Epi>
DI void gemm_unit_t(bf16* shm, const bf16* __restrict__ A, int lda, const int* rowmap, int arow0,
                    const bf16* __restrict__ Bt, int ldb, int bcol0, int K, const Epi& epi) {
#define SA(b, h) (shm + ((b) * 2 + (h)) * G_HT)
#define SB(b, h) (shm + (4 + (b) * 2 + (h)) * G_HT)
#define STAGE_AX(T, P, hf, kt) do { for (int _i = 0; _i < 2; ++_i) { int _b = (T) * 16 + _i * 8192; int _r, _c; g_stage_rc(_b, _r, _c); \
        const long _row = GATHER ? (long)rowmap[(hf) * G_HALF + _r] : (long)(arow0 + (hf) * G_HALF + _r); \
        __builtin_amdgcn_global_load_lds((const unsigned*)(A + _row * lda + (long)(kt) * G_BK + _c), (unsigned*)((char*)(P) + _b), 16, 0, 0); } } while (0)
#define STAGE_BX(T, P, hf, kt) do { for (int _i = 0; _i < 2; ++_i) { int _b = (T) * 16 + _i * 8192; int _r, _c; g_stage_rc(_b, _r, _c); \
        __builtin_amdgcn_global_load_lds((const unsigned*)(Bt + (long)(bcol0 + (hf) * G_HALF + _r) * ldb + (long)(kt) * G_BK + _c), (unsigned*)((char*)(P) + _b), 16, 0, 0); } } while (0)
#define STAGE_A(P, hf, kt) STAGE_AX(t0, P, hf, kt)
#define STAGE_B(P, hf, kt) STAGE_BX(t0, P, hf, kt)
#define LDA(dst, b, h) for (int m = 0; m < 4; ++m) for (int k = 0; k < 2; ++k) \
        dst[m][k] = *reinterpret_cast<const bf16x8*>((char*)SA(b, h) + g_lds_byte(wr * 64 + m * 16 + fr, k * 32 + fq * 8))
#define LDB(dst, b, h) for (int n = 0; n < 2; ++n) for (int k = 0; k < 2; ++k) \
        dst[n][k] = *reinterpret_cast<const bf16x8*>((char*)SB(b, h) + g_lds_byte(wc * 32 + n * 16 + fr, k * 32 + fq * 8))
#define MMA(ai, bj, At, Bt_) do { __builtin_amdgcn_s_setprio(1); \
        for (int m = 0; m < 4; ++m) for (int n = 0; n < 2; ++n) for (int k = 0; k < 2; ++k) \
            acc[ai][bj][m][n] = __builtin_amdgcn_mfma_f32_16x16x32_bf16(Bt_[n][k], At[m][k], acc[ai][bj][m][n], 0, 0, 0); \
        __builtin_amdgcn_s_setprio(0); } while (0)
#define WAIT_V(n) asm volatile("s_waitcnt vmcnt(" #n ")" ::: "memory")
#define WAIT_L(n) asm volatile("s_waitcnt lgkmcnt(" #n ")" ::: "memory")
#define BAR __builtin_amdgcn_s_barrier()
#define SCHED __builtin_amdgcn_sched_barrier(0)
    int t0 = threadIdx.x; asm volatile("" : "+v"(t0));
    int wid = t0 >> 6, lane = t0 & 63, wr = wid >> 2, wc = wid & 3, fr = lane & 15, fq = lane >> 4;
    f32x4 acc[2][2][4][2] = {};
    bf16x8 At[4][2], B0[2][2], B1[2][2];
    const int nt = K / G_BK;
    STAGE_B(SB(0, 0), 0, 0); STAGE_A(SA(0, 0), 0, 0);
    STAGE_B(SB(0, 1), 1, 0); STAGE_A(SA(0, 1), 1, 0);
    if (wr == 1) BAR;
    WAIT_V(4); BAR;
    STAGE_B(SB(1, 0), 0, 1); STAGE_A(SA(1, 0), 0, 1); STAGE_B(SB(1, 1), 1, 1);
    WAIT_V(6); BAR;
    for (int t = 0; t < nt - 2; t += 2) {
        LDB(B0, 0, 0); SCHED; LDA(At, 0, 0); STAGE_A(SA(1, 1), 1, t + 1);
        WAIT_L(8); BAR; WAIT_L(0); MMA(0, 0, At, B0); BAR; SCHED;
        LDB(B1, 0, 1); STAGE_B(SB(0, 0), 0, t + 2);
        BAR; WAIT_L(0); MMA(0, 1, At, B1); BAR;
        LDA(At, 0, 1); STAGE_A(SA(0, 0), 0, t + 2);
        BAR; WAIT_L(0); MMA(1, 0, At, B0); BAR; SCHED;
        STAGE_B(SB(0, 1), 1, t + 2);
        WAIT_V(6); BAR; MMA(1, 1, At, B1); BAR;
        LDB(B0, 1, 0); SCHED; LDA(At, 1, 0); STAGE_A(SA(0, 1), 1, t + 2);
        WAIT_L(8); BAR; WAIT_L(0); MMA(0, 0, At, B0); BAR; SCHED;
        LDB(B1, 1, 1); STAGE_B(SB(1, 0), 0, t + 3);
        BAR; WAIT_L(0); MMA(0, 1, At, B1); BAR;
        LDA(At, 1, 1); STAGE_A(SA(1, 0), 0, t + 3);
        BAR; WAIT_L(0); MMA(1, 0, At, B0); BAR; SCHED;
        STAGE_B(SB(1, 1), 1, t + 3);
        WAIT_V(6); BAR; MMA(1, 1, At, B1); BAR;
    }
    int tz = t0; asm volatile("" : "+v"(tz)); wid = tz >> 6; lane = tz & 63; wr = wid >> 2; wc = wid & 3; fr = lane & 15; fq = lane >> 4;
    { LDB(B0, 0, 0); WAIT_V(0); LDA(At, 0, 0); STAGE_AX(tz, SA(1, 1), 1, nt - 1);
      BAR; WAIT_L(0); MMA(0, 0, At, B0); BAR;
      LDB(B1, 0, 1); BAR; WAIT_L(0); MMA(0, 1, At, B1); BAR;
      LDA(At, 0, 1); WAIT_V(4); BAR; WAIT_L(0); MMA(1, 0, At, B0); MMA(1, 1, At, B1); BAR; }
    { LDB(B0, 1, 0); LDA(At, 1, 0); WAIT_V(2); BAR; WAIT_L(0); MMA(0, 0, At, B0); BAR;
      LDB(B1, 1, 1); WAIT_V(0); BAR; WAIT_L(0); MMA(0, 1, At, B1); BAR;
      LDA(At, 1, 1); BAR; WAIT_L(0); MMA(1, 0, At, B0); MMA(1, 1, At, B1); BAR; }
    if (wr == 0) BAR;
#pragma unroll
    for (int ai = 0; ai < 2; ++ai)
#pragma unroll
        for (int m = 0; m < 4; ++m)
#pragma unroll
            for (int bj = 0; bj < 2; ++bj)
#pragma unroll
                for (int n = 0; n < 2; ++n) {
                    const f32x4 v = acc[ai][bj][m][n];
                    epi(ai * G_HALF + wr * 64 + m * 16 + fr, bj * G_HALF + wc * 32 + n * 16 + fq * 4, v[0], v[1], v[2], v[3]);
                }
#undef SA
#undef SB
#undef STAGE_A
#undef STAGE_B
#undef STAGE_AX
#undef STAGE_BX
#undef LDA
#undef LDB
#undef MMA
}
template <class Epi>
DI void gemm_unit(bf16* shm, const bf16* __restrict__ A, int lda, const int* rowmap, int arow0,
                  const bf16* __restrict__ Bt, int ldb, int bcol0, int K, const Epi& epi) {
    if (rowmap) gemm_unit_t<true>(shm, A, lda, rowmap, arow0, Bt, ldb, bcol0, K, epi);
    else gemm_unit_t<false>(shm, A, lda, rowmap, arow0, Bt, ldb, bcol0, K, epi);
}
#else
template <class Epi>
void gemm_unit(bf16* shm, const bf16* A, int lda, const int* rowmap, int arow0, const bf16* Bt, int ldb, int bcol0, int K, const Epi& epi, int mrows = 256) {
    for (int r = 0; r < mrows; ++r) {
        int arow = rowmap ? rowmap[r] : arow0 + r;
        for (int c = 0; c < 256; c += 4) {
            float v[4];
            for (int q = 0; q < 4; ++q) {
                double s = 0; const bf16* a = A + (long)arow * lda; const bf16* b = Bt + (long)(bcol0 + c + q) * ldb;
                for (int k = 0; k < K; ++k) s += (double)bf2f(a[k]) * bf2f(b[k]);
                v[q] = (float)s;
            }
            epi(r, c, v[0], v[1], v[2], v[3]);
        }
    }
}
#endif

DI void st_bf16x4(bf16* p, float a, float b, float c, float d) {
#ifndef CPU_EMU
    uint2 u; u.x = pack_bf16(a, b); u.y = pack_bf16(c, d); *reinterpret_cast<uint2*>(p) = u;
#else
    p[0] = f2bf(a); p[1] = f2bf(b); p[2] = f2bf(c); p[3] = f2bf(d);
#endif
}

struct Frame {
    const float* const* in;
    float* xf;
    unsigned char* ws;
    unsigned char* smem;
    int mrows_limit;
};
#define WSP(T, off) ((T*)(F.ws + (off)))

DI void ln_row_write(float* xrow, bf16* brow, const float* vals_in  , const float* g, const float* b);

template <class Fn>
DI void layer_norm_rows(const Frame& F, const float* g, const float* b, Fn pre, bool write_out_extra, float* extra) {
    float* xf = F.xf; bf16* xb = WSP(bf16, OFF_XB);
    for (int row = ggrp(); row < NTOK; row += ngrp()) {
        float v[PERLN]; float s = 0.f;
        for (int i = 0; i < PERLN; ++i) { int c = glane() + i * GRP; v[i] = pre(row, c); s += v[i]; }
        s = grp_sum(s); const float mu = s * (1.0f / 1024.0f);
        float q = 0.f;
        for (int i = 0; i < PERLN; ++i) { float d = v[i] - mu; q += d * d; }
        q = grp_sum(q); const float rs = 1.0f / sqrtf(q * (1.0f / 1024.0f) + LN_EPS);
        for (int i = 0; i < PERLN; ++i) { int c = glane() + i * GRP; float y = (v[i] - mu) * rs * g[c] + b[c];
            xf[(size_t)row * DM + c] = y; xb[(size_t)row * DM + c] = f2bf(y); if (write_out_extra) extra[(size_t)row * DM + c] = y; }
    }
}

DI void phase_pro(const Frame& F) {
    const float* x = F.in[0]; const float* mem = F.in[1];
    layer_norm_rows(F, F.in[2], F.in[3], [&](int row, int c) { return x[(size_t)row * DM + c]; }, false, nullptr);
    bf16* memb = WSP(bf16, OFF_MEMB);
    for (size_t i = gtid_(); i < (size_t)NMEM * DM; i += gthreads()) memb[i] = f2bf(mem[i]);
}

template <class Src>
DI void cvt_transpose(const Frame& F, bf16* dst, int Nn, int Kk, Src src) {
#ifdef CPU_EMU
    for (int n = 0; n < Nn; ++n) for (int k = 0; k < Kk; ++k) dst[(size_t)n * Kk + k] = f2bf(src(k, n));
#else
    float* tile = (float*)F.smem;
    const int tn = Nn / 64, tk = Kk / 64, ntile = tn * tk;
    for (int t = blockIdx.x; t < ntile; t += gridDim.x) {
        const int n0 = (t % tn) * 64, k0 = (t / tn) * 64;
        __syncthreads();
        for (int i = threadIdx.x; i < 4096; i += blockDim.x) { int k = i >> 6, n = i & 63; tile[k * 65 + n] = src(k0 + k, n0 + n); }
        __syncthreads();
        for (int i = threadIdx.x; i < 4096; i += blockDim.x) { int n = i >> 6, k = i & 63; dst[(size_t)(n0 + n) * Kk + k0 + k] = f2bf(tile[k * 65 + n]); }
    }
#endif
}

DI int win_src_col(int n) {
    if (n < 512) return n;
    if (n < 1536) { int c = n - 512; return c < 960 ? 512 + c : -1; }
    if (n < 2816) return 1472 + (n - 1536);
    int c = n - 2816;
    if (c < 192) return 2752 + c;
    if (c < 224) return 2752 + 320 + (c - 192);
    if (c < 256) return -1;
    if (c < 384) return 2752 + 192 + (c - 256);
    return -1;
}
DI int wuq_src_col(int n) {
    if (n >= 384) return -1;
    int h = n / 96, w = n % 96;
    if (w < 64) return h * 96 + w;
    int p = w - 64, m = p >> 1, which = p & 1;
    int i = (m < 8 ? m : 16 + (m - 8)) + (which ? 8 : 0);
    return h * 96 + 64 + i;
}

DI void phase_cvt(const Frame& F, int l) {
    bf16* wts = WSP(bf16, OFF_WTS);
    { const float* w = F.in[4] + (size_t)l * 1024 * IN_WIDTH;
      cvt_transpose(F, (bf16*)((char*)wts + W_IN_T), HP, 1024, [&](int k, int n) { int s = win_src_col(n); return s < 0 ? 0.f : w[(size_t)k * IN_WIDTH + s]; }); }
    { const float* w = F.in[23] + (size_t)l * 192 * 384;
      cvt_transpose(F, (bf16*)((char*)wts + W_UQ_T), 512, 256, [&](int k, int n) { int s = wuq_src_col(n); return (s < 0 || k >= 192) ? 0.f : w[(size_t)k * 384 + s]; }); }
    { const float* w = F.in[24] + (size_t)l * 128 * 512;
      cvt_transpose(F, (bf16*)((char*)wts + W_UKV_T), 512, 256, [&](int k, int n) { return k >= 128 ? 0.f : w[(size_t)k * 512 + n]; }); }
    { const float* w = F.in[25] + (size_t)l * 1024 * 1024;
      cvt_transpose(F, (bf16*)((char*)wts + W_OUT_T), 1024, 1024, [&](int k, int n) { return w[(size_t)k * 1024 + n]; }); }
    { const float* w = F.in[28] + (size_t)l * 1024 * 1024;
      cvt_transpose(F, (bf16*)((char*)wts + W_Q_T), 1024, 1024, [&](int k, int n) { return w[(size_t)k * 1024 + n]; }); }
    { const float* w = F.in[29] + (size_t)l * 1024 * 2048;
      cvt_transpose(F, (bf16*)((char*)wts + W_KV_T), 2048, 1024, [&](int k, int n) { return w[(size_t)k * 2048 + n]; }); }
    { const float* w = F.in[30] + (size_t)l * 1024 * 1024;
      cvt_transpose(F, (bf16*)((char*)wts + W_O_T), 1024, 1024, [&](int k, int n) { return w[(size_t)k * 1024 + n]; }); }
}

DI void phase_cvt_moe(const Frame& F, int l) {
    for (int e = 0; e < NEXP; ++e) {
        const float* w1 = F.in[37] + ((size_t)l * NEXP + e) * 1024 * 256;
        const float* w3 = F.in[38] + ((size_t)l * NEXP + e) * 1024 * 256;
        const float* w2 = F.in[39] + ((size_t)l * NEXP + e) * 256 * 1024;
        cvt_transpose(F, WSP(bf16, OFF_W13T) + (size_t)e * 512 * 1024, 512, 1024,
                      [&](int k, int n) { return (n & 1) ? w3[(size_t)k * 256 + (n >> 1)] : w1[(size_t)k * 256 + (n >> 1)]; });
        cvt_transpose(F, WSP(bf16, OFF_W2T) + (size_t)e * 1024 * 256, 1024, 256, [&](int k, int n) { return w2[(size_t)k * 1024 + n]; });
    }
}

struct EpiH {
    bf16* hatt; bf16* hrwkv; bf16* hhgrn; bf16* hmla; int row0, pn;
    DI void operator()(int r, int c, float a, float b, float cc, float d) const {
        const size_t row = row0 + r;
        bf16* p;
        if (pn < 2) p = hatt + row * 512 + pn * 256 + c;
        else if (pn < 6) p = hrwkv + row * 1024 + (pn - 2) * 256 + c;
        else if (pn < 11) p = hhgrn + row * 1280 + (pn - 6) * 256 + c;
        else p = hmla + row * 512 + (pn - 11) * 256 + c;
        st_bf16x4(p, a, b, cc, d);
    }
};
struct EpiKV {
    bf16* kmem; bf16* vt; int row0, pn;
    DI void operator()(int r, int c, float a, float b, float cc, float d) const {
        const int row = row0 + r, col = pn * 256 + c;
        if (col < 1024) { st_bf16x4(kmem + (size_t)row * 1024 + col, a, b, cc, d); }
        else { const int bb = row / MEMT, key = row % MEMT, hc = col - 1024;
            bf16* p = vt + ((size_t)bb * 1024 + hc) * MEMT + key;
            p[0] = f2bf(a); p[MEMT] = f2bf(b); p[2 * MEMT] = f2bf(cc); p[3 * MEMT] = f2bf(d); }
    }
};

DI void phase_gemm1(const Frame& F) {
    const bf16* xb = WSP(bf16, OFF_XB); const bf16* wts = WSP(bf16, OFF_WTS);
    const int nM = (NTOK + 255) / 256, nN = HP / 256, n1 = nM * nN;
    const int nMk = (NMEM + 255) / 256, nNk = 8, n2 = nMk * nNk;
    for (int u = blockIdx.x; u < n1 + n2; u += gridDim.x) {
        if (u < n1) {
            const int pm = u / nN, pn = u % nN;
            EpiH E{WSP(bf16, OFF_HATT), WSP(bf16, OFF_HRWKV), WSP(bf16, OFF_HHGRN), WSP(bf16, OFF_HMLA), pm * 256, pn};
#ifdef CPU_EMU
            gemm_unit((bf16*)F.smem, xb, 1024, nullptr, pm * 256, (const bf16*)((const char*)wts + W_IN_T), 1024, pn * 256, 1024, E, min(256, NTOK - pm * 256));
#else
            gemm_unit((bf16*)F.smem, xb, 1024, nullptr, pm * 256, (const bf16*)((const char*)wts + W_IN_T), 1024, pn * 256, 1024, E);
#endif
        } else {
            const int v = u - n1, pm = v / nNk, pn = v % nNk;
            EpiKV E{WSP(bf16, OFF_KMEM), WSP(bf16, OFF_VTMEM), pm * 256, pn};
            gemm_unit((bf16*)F.smem, WSP(bf16, OFF_MEMB), 1024, nullptr, pm * 256, (const bf16*)((const char*)wts + W_KV_T), 1024, pn * 256, 1024, E);
        }
    }
}

DI void phase_prep(const Frame& F, int l) {
    {
        bf16* hatt = WSP(bf16, OFF_HATT); bf16* vt = WSP(bf16, OFF_VTATT);
        const float* qn = F.in[5] + l * 64; const float* kn = F.in[6] + l * 64;
        const int nitem = NTOK * 6;
        for (int it = ggrp(); it < nitem; it += ngrp()) {
            const int n = it / 6, hh = it % 6;
            const int s = n % SEQ;
            bf16* p = hatt + (size_t)n * 512 + hh * 64;
            const float* gn = hh < 4 ? qn : kn;
            float v[PER64]; float ss = 0.f;
            for (int i = 0; i < PER64; ++i) { int j = glane() + i * GRP; v[i] = bf2f(p[j]); ss += v[i] * v[i]; }
            ss = grp_sum(ss); const float rs = 1.0f / sqrtf(ss * (1.0f / 64.0f) + RMS_EPS);
            float o[PER64];
#ifdef CPU_EMU
            float nv[64]; for (int j = 0; j < 64; ++j) nv[j] = v[j] * rs * gn[j];
#endif
            for (int i = 0; i < PER64; ++i) {
                int j = glane() + i * GRP;
                const int half = j >> 5, w = j & 31, f = w & 15, second = w >> 4;
                const float pos = half == 0 ? (float)(s / GRIDW) : (float)(s % GRIDW);
                const float ang = pos * rope_inv(2 * f, 32);
                const float cs = cosf(ang), sn = sinf(ang);
                const float mine = v[i] * rs * gn[j];
                const int jp = second ? j - 16 : j + 16;
#ifdef CPU_EMU
                const float partner = nv[jp];
#else
                const float partner = __shfl(v[0], jp, 64) * rs * gn[jp];
#endif
                o[i] = second ? (partner * sn + mine * cs) : (mine * cs - partner * sn);
            }
            for (int i = 0; i < PER64; ++i) { int j = glane() + i * GRP; p[j] = f2bf(o[i]); }
        }
        for (size_t i = gtid_(); i < (size_t)NTOK * 128; i += gthreads()) {
            const int n = (int)(i / 128), c = (int)(i % 128), b = n / SEQ, s = n % SEQ;
            vt[((size_t)b * 128 + c) * SEQ + s] = hatt[(size_t)n * 512 + 384 + c];
        }
    }
    {
        bf16* hm = WSP(bf16, OFF_HMLA); bf16* kr = WSP(bf16, OFF_KROPE);
        const float* qn = F.in[21] + l * 192; const float* kvn = F.in[22] + l * 128;
        for (int it = ggrp(); it < NTOK * 2; it += ngrp()) {
            const int n = it >> 1, which = it & 1;
            bf16* p = hm + (size_t)n * 512 + (which ? 256 : 0);
            const int len = which ? 128 : 192; const float* gn = which ? kvn : qn;
            float ss = 0.f;
            for (int j = glane(); j < len; j += GRP) { float x = bf2f(p[j]); ss += x * x; }
            ss = grp_sum(ss); const float rs = 1.0f / sqrtf(ss / (float)len + RMS_EPS);
            for (int j = glane(); j < len; j += GRP) p[j] = f2bf(bf2f(p[j]) * rs * gn[j]);
        }
        for (int i = gtid_(); i < NTOK * 16; i += gthreads()) {
            const int n = i >> 4, m = i & 15, s = n % SEQ;
            const bf16* src = hm + (size_t)n * 512 + 192;
            const int i1 = (m < 8 ? m : 16 + (m - 8)), i2 = i1 + 8;
            const float x1 = bf2f(src[i1]), x2 = bf2f(src[i2]);
            const float pos = m < 8 ? (float)(s / GRIDW) : (float)(s % GRIDW);
            const float ang = pos * rope_inv(2 * (m & 7), 16);
            const float cs = cosf(ang), sn = sinf(ang);
            kr[(size_t)n * 32 + 2 * m] = f2bf(x1 * cs - x2 * sn);
            kr[(size_t)n * 32 + 2 * m + 1] = f2bf(x1 * sn + x2 * cs);
        }
    }
    {
        const bf16* hz = WSP(bf16, OFF_HRWKV); bf16* r7 = WSP(bf16, OFF_R7); bf16* gb = WSP(bf16, OFF_G); float* bonus = WSP(float, OFF_BONUS);
        const float* mup = F.in[7] + l * 960; const float* mun = F.in[8] + l * 960;
        const float* w0 = F.in[9] + l * 512; const float* w2 = F.in[10] + (size_t)l * 2 * 32 * 256;
        const float* a0 = F.in[11] + l * 512; const float* a2 = F.in[12] + (size_t)l * 2 * 32 * 256;
        const float* g2 = F.in[13] + (size_t)l * 64 * 256;
        const float* k_k = F.in[14] + l * 256; const float* k_a = F.in[15] + l * 256; const float* r_k = F.in[16] + l * 256;
        const size_t AS = (size_t)NTOK * 256;
        for (int it = ggrp(); it < NTOK * 4; it += ngrp()) {
            const int n = it >> 2, h = it & 3, s = n % SEQ;
            const bf16* z = hz + (size_t)n * 1024;
            const bool hp = s > 0, hn = s < SEQ - 1;
            auto shifted = [&](int c) -> float {
                const float zc = bf2f(z[c]);
                const float zp = hp ? bf2f(z[c - 1024]) : 0.f, zn = hn ? bf2f(z[c + 1024]) : 0.f;
                return zc + mup[c] * (zp - zc) + mun[c] * (zn - zc);
            };
            float kkv[PER64], rr[PER64], kd0[PER64], kd1[PER64], aa0[PER64], aa1[PER64];
            float ss = 0.f, bs = 0.f;
            for (int i = 0; i < PER64; ++i) {
                const int j = glane() + i * GRP, c = h * 64 + j;
                const float r = shifted(c), k = shifted(256 + c), v = shifted(512 + c);
                float wr0 = w0[c], wr1 = w0[256 + c], ar0 = a0[c], ar1 = a0[256 + c], g = 0.f;
                for (int q = 0; q < 32; ++q) {
                    wr0 += tanhf(shifted(768 + q)) * w2[(size_t)q * 256 + c];
                    wr1 += tanhf(shifted(800 + q)) * w2[(size_t)(32 + q) * 256 + c];
                    ar0 += shifted(832 + q) * a2[(size_t)q * 256 + c];
                    ar1 += shifted(864 + q) * a2[(size_t)(32 + q) * 256 + c];
                }
                for (int q = 0; q < 64; ++q) g += sigmoidf_(shifted(896 + q)) * g2[(size_t)q * 256 + c];
                const float dec0 = expf(-DECAY_SCALE * sigmoidf_(wr0)), dec1 = expf(-DECAY_SCALE * sigmoidf_(wr1));
                const float A0 = sigmoidf_(ar0), A1 = sigmoidf_(ar1);
                const float kk = k * k_k[c];
                kkv[i] = kk; ss += kk * kk; rr[i] = r; aa0[i] = A0; aa1[i] = A1;
                kd0[i] = k * (1.0f + (A0 - 1.0f) * k_a[c]); kd1[i] = k * (1.0f + (A1 - 1.0f) * k_a[c]);
                bs += r * (kd0[i] + kd1[i]) * r_k[c];
                const size_t o = (size_t)n * 256 + c;
                r7[R_R * AS + o] = f2bf(r); r7[R_V * AS + o] = f2bf(v);
                r7[R_W0 * AS + o] = f2bf(dec0); r7[R_W1 * AS + o] = f2bf(dec1);
                r7[R_KD0 * AS + o] = f2bf(kd0[i]); r7[R_KD1 * AS + o] = f2bf(kd1[i]);
                gb[o] = f2bf(g);
            }
            ss = grp_sum(ss); bs = grp_sum(bs);
            const float inv = 1.0f / fmaxf(sqrtf(ss), 1e-12f);
            for (int i = 0; i < PER64; ++i) {
                const int j = glane() + i * GRP, c = h * 64 + j; const size_t o = (size_t)n * 256 + c;
                const float kk = kkv[i] * inv;
                r7[R_KK * AS + o] = f2bf(kk); r7[R_AK0 * AS + o] = f2bf(aa0[i] * kk); r7[R_AK1 * AS + o] = f2bf(aa1[i] * kk);
            }
            if (glane() == 0) bonus[(size_t)n * 4 + h] = bs;
        }
    }
    {
        bf16* hh = WSP(bf16, OFF_HHGRN);
        const float* lg = F.in[19];
        for (size_t i = gtid_(); i < (size_t)NTOK * 768; i += gthreads()) {
            const int n = (int)(i / 768), c = (int)(i % 768);
            bf16* p = hh + (size_t)n * 1280 + c;
            const float x = bf2f(*p);
            if (c < 256) { *p = f2bf(siluf_(x)); }
            else {
                const int d = c & 255;
                float lb = 0.f;
                if (l == 1) { const float a = lg[d], b = lg[256 + d]; const float m = fmaxf(a, b); const float ea = expf(a - m), eb = expf(b - m); lb = eb / (ea + eb); }
                *p = f2bf((1.0f - lb) * sigmoidf_(-x));
            }
        }
    }
}

struct EpiQMla {
    bf16* q; int row0, pn;
    DI void operator()(int r, int c, float a, float b, float cc, float d) const {
        const int row = row0 + r, col = pn * 256 + c;
        if (col >= 384) return;
        const int w = col % 96;
        if (w >= 64) {
            const int s = row % SEQ;
#pragma unroll
            for (int t = 0; t < 2; ++t) {
                const int m = ((w - 64) >> 1) + t;
                const float pos = m < 8 ? (float)(s / GRIDW) : (float)(s % GRIDW);
                const float ang = pos * rope_inv(2 * (m & 7), 16);
                const float cs = cosf(ang), sn = sinf(ang);
                float& x1 = t ? cc : a; float& x2 = t ? d : b;
                const float y1 = x1 * cs - x2 * sn, y2 = x1 * sn + x2 * cs; x1 = y1; x2 = y2;
            }
        }
        st_bf16x4(q + (size_t)row * 384 + col, a, b, cc, d);
    }
};
struct EpiKVMla {
    bf16* kn; bf16* vt; int row0, pn;
    DI void operator()(int r, int c, float a, float b, float cc, float d) const {
        const int row = row0 + r, col = pn * 256 + c, h = col >> 7, w = col & 127;
        if (w < 64) st_bf16x4(kn + (size_t)row * 256 + h * 64 + w, a, b, cc, d);
        else { const int bb = row / SEQ, s = row % SEQ; bf16* p = vt + ((size_t)bb * 256 + h * 64 + (w - 64)) * SEQ + s;
            p[0] = f2bf(a); p[SEQ] = f2bf(b); p[2 * SEQ] = f2bf(cc); p[3 * SEQ] = f2bf(d); }
    }
};
DI void phase_mlaup(const Frame& F) {
    const bf16* hm = WSP(bf16, OFF_HMLA); const char* wts = (const char*)WSP(bf16, OFF_WTS);
    const int nM = (NTOK + 255) / 256;
    for (int u = blockIdx.x; u < nM * 4; u += gridDim.x) {
        const int pm = u >> 2, j = u & 3;
#ifdef CPU_EMU
        const int mr = min(256, NTOK - pm * 256);
#define MR , mr
#else
#define MR
#endif
        if (j < 2) { EpiQMla E{WSP(bf16, OFF_QMLA), pm * 256, j};
            gemm_unit((bf16*)F.smem, hm, 512, nullptr, pm * 256, (const bf16*)(wts + W_UQ_T), 256, j * 256, 256, E MR); }
        else { EpiKVMla E{WSP(bf16, OFF_KNOPE), WSP(bf16, OFF_VTMLA), pm * 256, j - 2};
            gemm_unit((bf16*)F.smem, hm + 256, 512, nullptr, pm * 256, (const bf16*)(wts + W_UKV_T), 256, (j - 2) * 256, 256, E MR); }
    }
}

struct AttnDesc {
    const bf16* q; int q_stride;
    int q_hstride;
    const bf16* k; int k_stride; int k_hstride;
    const bf16* k2; int k2_stride;
    int dk_main;
    const bf16* vt;
    bf16* o; int o_stride; int o_hstride;
    int H, HKV, SQ, SK;
    float scale;
};

#ifdef CPU_EMU
template <int DK, int DV>
void attn_phase(const Frame& F, const AttnDesc& A) {
    const int G = A.H / A.HKV;
    float* sc = (float*)malloc(sizeof(float) * A.SK);
    for (int b = 0; b < BATCH; ++b) for (int h = 0; h < A.H; ++h) for (int s = 0; s < A.SQ; ++s) {
        const int kv = h / G;
        const bf16* q = A.q + (size_t)(b * A.SQ + s) * A.q_stride + h * A.q_hstride;
        float mx = -1e30f;
        for (int key = 0; key < A.SK; ++key) {
            const bf16* kp = A.k + (size_t)(b * A.SK + key) * A.k_stride + kv * A.k_hstride;
            double acc = 0;
            for (int d = 0; d < DK; ++d) {
                float kvl = d < A.dk_main ? bf2f(kp[d]) : bf2f(A.k2[(size_t)(b * A.SK + key) * A.k2_stride + d - A.dk_main]);
                acc += (double)bf2f(q[d]) * kvl;
            }
            sc[key] = (float)acc * A.scale; mx = fmaxf(mx, sc[key]);
        }
        double sum = 0; for (int key = 0; key < A.SK; ++key) { sc[key] = expf(sc[key] - mx); sum += sc[key]; }
        for (int dv = 0; dv < DV; ++dv) {
            const bf16* vp = A.vt + ((size_t)(b * A.HKV + kv) * DV + dv) * A.SK;
            double acc = 0; for (int key = 0; key < A.SK; ++key) acc += (double)bf2f(f2bf(sc[key])) * bf2f(vp[key]);
            A.o[(size_t)(b * A.SQ + s) * A.o_stride + h * A.o_hstride + dv] = f2bf((float)(acc / sum));
        }
    }
    free(sc);
}
#else
DI int crow16(int reg, int h) { return (reg & 3) + 8 * (reg >> 2) + 4 * h; }
template <int DK, int DV, int DVT>
DI void attn_phase(const Frame& F, const AttnDesc& A) {
    constexpr int KP = DK + 8;
    constexpr int VP = 64 + 8;
    constexpr int NPASS = DV / DVT;
    bf16* Ks = (bf16*)F.smem;
    bf16* Vs = Ks + 64 * KP;
    const int tid = threadIdx.x, wave = tid >> 6, lane = tid & 63, r = lane & 31, hh = lane >> 5;
    const int G = A.H / A.HKV;
    const int nqb = A.SQ / 256;
    const int nunit = BATCH * A.H * nqb * NPASS;
    const float sl2 = A.scale * 1.4426950408889634f;
    for (int u = blockIdx.x; u < nunit; u += gridDim.x) {
        int t = u; const int pass = t % NPASS; t /= NPASS; const int qb = t % nqb; t /= nqb; const int h = t % A.H; const int b = t / A.H;
        const int kv = h / G;
        const int q0 = qb * 256 + wave * 32;
        bf16x8 qf[DK / 16];
        { const bf16* qp = A.q + (size_t)(b * A.SQ + q0 + r) * A.q_stride + h * A.q_hstride + 8 * hh;
#pragma unroll
          for (int ks = 0; ks < DK / 16; ++ks) qf[ks] = *reinterpret_cast<const bf16x8*>(qp + 16 * ks); }
        f32x16 oacc[DVT / 32];
#pragma unroll
        for (int i = 0; i < DVT / 32; ++i)
#pragma unroll
            for (int j = 0; j < 16; ++j) oacc[i][j] = 0.f;
        float mrun = -INFINITY, lrun = 0.f;
        for (int kt = 0; kt < A.SK / 64; ++kt) {
            __syncthreads();
            for (int c = tid; c < 64 * (DK / 8); c += 512) {
                const int key = c / (DK / 8), d8 = (c % (DK / 8)) * 8;
                const size_t krow = (size_t)(b * A.SK + kt * 64 + key);
                uint4 v;
                if (d8 < A.dk_main) v = *reinterpret_cast<const uint4*>(A.k + krow * A.k_stride + kv * A.k_hstride + d8);
                else v = *reinterpret_cast<const uint4*>(A.k2 + krow * A.k2_stride + (d8 - A.dk_main));
                *reinterpret_cast<uint4*>(Ks + key * KP + d8) = v;
            }
            for (int c = tid; c < DVT * 8; c += 512) {
                const int dv = c >> 3, k8 = (c & 7) * 8;
                const uint4 v = *reinterpret_cast<const uint4*>(A.vt + ((size_t)(b * A.HKV + kv) * DV + pass * DVT + dv) * A.SK + kt * 64 + k8);
                *reinterpret_cast<uint4*>(Vs + dv * VP + k8) = v;
            }
            __syncthreads();
            f32x16 sacc[2];
#pragma unroll
            for (int kb = 0; kb < 2; ++kb) {
#pragma unroll
                for (int j = 0; j < 16; ++j) sacc[kb][j] = 0.f;
#pragma unroll
                for (int ks = 0; ks < DK / 16; ++ks) {
                    const bf16x8 kf = *reinterpret_cast<const bf16x8*>(Ks + (kb * 32 + r) * KP + 16 * ks + 8 * hh);
                    sacc[kb] = __builtin_amdgcn_mfma_f32_32x32x16_bf16(kf, qf[ks], sacc[kb], 0, 0, 0);
                }
            }
            float mx = -INFINITY;
#pragma unroll
            for (int kb = 0; kb < 2; ++kb)
#pragma unroll
                for (int j = 0; j < 16; ++j) mx = fmaxf(mx, sacc[kb][j]);
            mx = fmaxf(mx, __shfl_xor(mx, 32, 64));
            const float mnew = fmaxf(mrun, mx * sl2);
            const float alpha = exp2f(mrun - mnew);
            mrun = mnew;
            float psum = 0.f;
#pragma unroll
            for (int kb = 0; kb < 2; ++kb)
#pragma unroll
                for (int j = 0; j < 16; ++j) { const float p = exp2f(sacc[kb][j] * sl2 - mnew); sacc[kb][j] = p; psum += p; }
            lrun = lrun * alpha + psum;
#pragma unroll
            for (int i = 0; i < DVT / 32; ++i)
#pragma unroll
                for (int j = 0; j < 16; ++j) oacc[i][j] *= alpha;
#pragma unroll
            for (int kb = 0; kb < 2; ++kb)
#pragma unroll
                for (int s2 = 0; s2 < 2; ++s2) {
                    union { bf16x8 v; unsigned u[4]; } pf;
#pragma unroll
                    for (int j = 0; j < 4; ++j) pf.u[j] = pack_bf16(sacc[kb][8 * s2 + 2 * j], sacc[kb][8 * s2 + 2 * j + 1]);
#pragma unroll
                    for (int i = 0; i < DVT / 32; ++i) {
                        const bf16* vp = Vs + (i * 32 + r) * VP + kb * 32 + 16 * s2 + 4 * hh;
                        union { bf16x8 v; bf16x4 h2[2]; } vf;
                        vf.h2[0] = *reinterpret_cast<const bf16x4*>(vp);
                        vf.h2[1] = *reinterpret_cast<const bf16x4*>(vp + 8);
                        oacc[i] = __builtin_amdgcn_mfma_f32_32x32x16_bf16(vf.v, pf.v, oacc[i], 0, 0, 0);
                    }
                }
        }
        lrun += __shfl_xor(lrun, 32, 64);
        const float inv = 1.0f / lrun;
        bf16* op = A.o + (size_t)(b * A.SQ + q0 + r) * A.o_stride + h * A.o_hstride + pass * DVT;
#pragma unroll
        for (int i = 0; i < DVT / 32; ++i)
#pragma unroll
            for (int g = 0; g < 4; ++g)
                st_bf16x4(op + i * 32 + 8 * g + 4 * hh, oacc[i][4 * g] * inv, oacc[i][4 * g + 1] * inv, oacc[i][4 * g + 2] * inv, oacc[i][4 * g + 3] * inv);
    }
}
#endif

DI AttnDesc desc_gqa(const Frame& F) {
    AttnDesc A; A.q = WSP(bf16, OFF_HATT); A.q_stride = 512; A.q_hstride = 64;
    A.k = WSP(bf16, OFF_HATT) + 256; A.k_stride = 512; A.k_hstride = 64; A.k2 = nullptr; A.k2_stride = 0; A.dk_main = 64;
    A.vt = WSP(bf16, OFF_VTATT); A.o = WSP(bf16, OFF_YCAT); A.o_stride = 1024; A.o_hstride = 64;
    A.H = 4; A.HKV = 2; A.SQ = SEQ; A.SK = SEQ; A.scale = 0.125f; return A;
}
DI AttnDesc desc_mla(const Frame& F) {
    AttnDesc A; A.q = WSP(bf16, OFF_QMLA); A.q_stride = 384; A.q_hstride = 96;
    A.k = WSP(bf16, OFF_KNOPE); A.k_stride = 256; A.k_hstride = 64; A.k2 = WSP(bf16, OFF_KROPE); A.k2_stride = 32; A.dk_main = 64;
    A.vt = WSP(bf16, OFF_VTMLA); A.o = WSP(bf16, OFF_YCAT) + 768; A.o_stride = 1024; A.o_hstride = 64;
    A.H = 4; A.HKV = 4; A.SQ = SEQ; A.SK = SEQ; A.scale = 0.10206207261596575f; return A;
}
DI AttnDesc desc_mem(const Frame& F) {
    AttnDesc A; A.q = WSP(bf16, OFF_QMEM); A.q_stride = 1024; A.q_hstride = 256;
    A.k = WSP(bf16, OFF_KMEM); A.k_stride = 1024; A.k_hstride = 256; A.k2 = nullptr; A.k2_stride = 0; A.dk_main = 256;
    A.vt = WSP(bf16, OFF_VTMEM); A.o = WSP(bf16, OFF_OMEM); A.o_stride = 1024; A.o_hstride = 256;
    A.H = 4; A.HKV = 4; A.SQ = SEQ; A.SK = MEMT; A.scale = 0.0625f; return A;
}

DI void phase_scans(const Frame& F) {
    bf16* r7 = WSP(bf16, OFF_R7); const size_t AS = (size_t)NTOK * 256;
    bf16* hh = WSP(bf16, OFF_HHGRN);
    const int nitem = 2 * BATCH * 4 * 64 * 2;
    for (int it = wave_item_index(); it < nitem; it += gthreads()) {
        const int kind = it / (2 * BATCH * 4 * 64);
        int c = (it % (2 * BATCH * 4 * 64)) / 64; const int i = it % 64;
        const int d = c / (BATCH * 4); c %= BATCH * 4; const int b = c / 4, h = c % 4;
        float S[64];
#pragma unroll
        for (int j = 0; j < 64; ++j) S[j] = 0.f;
        if (kind == 0) {
            const bf16* pr = r7 + R_R * AS, *pv = r7 + R_V * AS, *pkk = r7 + R_KK * AS;
            bf16* pw = r7 + (d ? R_W1 : R_W0) * AS; const bf16* pkd = r7 + (d ? R_KD1 : R_KD0) * AS, *pak = r7 + (d ? R_AK1 : R_AK0) * AS;
            for (int t = 0; t < SEQ; ++t) {
                const int s = d ? SEQ - 1 - t : t;
                const size_t o = ((size_t)(b * SEQ + s)) * 256 + h * 64;
                const float v = bf2f(pv[o + i]);
                float sa = 0.f;
#pragma unroll
                for (int j = 0; j < 64; ++j) sa += S[j] * bf2f(pkk[o + j]);
                float y = 0.f;
#pragma unroll
                for (int j = 0; j < 64; ++j) {
                    S[j] = S[j] * bf2f(pw[o + j]) - sa * bf2f(pak[o + j]) + v * bf2f(pkd[o + j]);
                    y += S[j] * bf2f(pr[o + j]);
                }
#ifndef CPU_EMU
                __builtin_amdgcn_wave_barrier();
#endif
#ifdef CPU_EMU
                WSP(bf16, OFF_EMU_SCAN)[(size_t)d * AS + (size_t)(b * SEQ + s) * 256 + h * 64 + i] = f2bf(y);
#else
                pw[o + i] = f2bf(y);
#endif
            }
        } else {
            const bf16* pq = hh; bf16* pk = hh + 256 + d * 256; const bf16* pi = hh + 768;
            for (int t = 0; t < SEQ; ++t) {
                const int s = d ? SEQ - 1 - t : t;
                const size_t o = ((size_t)(b * SEQ + s)) * 1280 + h * 64;
                const float v = bf2f(pi[o + i]);
                float acc = 0.f;
#pragma unroll
                for (int j = 0; j < 64; ++j) {
                    const float k = bf2f(pk[o + j]);
                    S[j] = S[j] + k * (v - S[j]);
                    acc += S[j] * bf2f(pq[o + j]);
                }
#ifndef CPU_EMU
                __builtin_amdgcn_wave_barrier();
#endif
#ifdef CPU_EMU
                WSP(bf16, OFF_EMU_SCAN)[(size_t)(2 + d) * AS + (size_t)(b * SEQ + s) * 256 + h * 64 + i] = f2bf(acc);
#else
                pk[o + i] = f2bf(acc);
#endif
            }
        }
    }
}

DI void phase_fin(const Frame& F, int l) {
    const bf16* r7 = WSP(bf16, OFF_R7); const size_t AS = (size_t)NTOK * 256;
    const bf16* gb = WSP(bf16, OFF_G); const float* bonus = WSP(float, OFF_BONUS);
    const bf16* hh = WSP(bf16, OFF_HHGRN); bf16* ycat = WSP(bf16, OFF_YCAT);
    const float* gng = F.in[17] + l * 256; const float* gnb = F.in[18] + l * 256; const float* hng = F.in[20] + l * 256;
    for (int it = ggrp(); it < NTOK * 8; it += ngrp()) {
        const int n = it >> 3, kind = (it >> 2) & 1, h = it & 3;
        float v[PER64];
        if (kind == 0) {
            float s1 = 0.f;
            for (int i = 0; i < PER64; ++i) { const int c = h * 64 + glane() + i * GRP; const size_t o = (size_t)n * 256 + c;
#ifdef CPU_EMU
                v[i] = bf2f(WSP(bf16, OFF_EMU_SCAN)[o]) + bf2f(WSP(bf16, OFF_EMU_SCAN)[AS + o]); s1 += v[i]; }
#else
                v[i] = bf2f(r7[R_W0 * AS + o]) + bf2f(r7[R_W1 * AS + o]); s1 += v[i]; }
#endif
            s1 = grp_sum(s1); const float mu = s1 * (1.0f / 64.0f);
            float s2 = 0.f; for (int i = 0; i < PER64; ++i) { const float dd = v[i] - mu; s2 += dd * dd; }
            s2 = grp_sum(s2); const float rs = 1.0f / sqrtf(s2 * (1.0f / 64.0f) + GN_EPS);
            const float bo = bonus[(size_t)n * 4 + h];
            for (int i = 0; i < PER64; ++i) { const int c = h * 64 + glane() + i * GRP; const size_t o = (size_t)n * 256 + c;
                const float y = (v[i] - mu) * rs * gng[c] + gnb[c];
                ycat[(size_t)n * 1024 + 256 + c] = f2bf((y + bo * bf2f(r7[R_V * AS + o])) * bf2f(gb[o])); }
        } else {
            float s2 = 0.f;
            for (int i = 0; i < PER64; ++i) { const int c = h * 64 + glane() + i * GRP; const size_t o = (size_t)n * 1280 + c;
#ifdef CPU_EMU
                const size_t oe = (size_t)n * 256 + c;
                v[i] = bf2f(WSP(bf16, OFF_EMU_SCAN)[2 * AS + oe]) + bf2f(WSP(bf16, OFF_EMU_SCAN)[3 * AS + oe]); s2 += v[i] * v[i]; }
#else
                v[i] = bf2f(hh[o + 256]) + bf2f(hh[o + 512]); s2 += v[i] * v[i]; }
#endif
            s2 = grp_sum(s2); const float rs = 1.0f / sqrtf(s2 * (1.0f / 64.0f) + RMS_EPS);
            for (int i = 0; i < PER64; ++i) { const int c = h * 64 + glane() + i * GRP; const size_t o = (size_t)n * 1280 + c;
                ycat[(size_t)n * 1024 + 512 + c] = f2bf(v[i] * rs * hng[c] * siluf_(bf2f(hh[o + 1024]))); }
        }
    }
}

struct EpiResid {
    float* xf; int row0, pn;
    DI void operator()(int r, int c, float a, float b, float cc, float d) const {
        float* p = xf + (size_t)(row0 + r) * DM + pn * 256 + c;
#ifndef CPU_EMU
        float4 x = *reinterpret_cast<float4*>(p);
        x.x = DN_ALPHA * x.x + a; x.y = DN_ALPHA * x.y + b; x.z = DN_ALPHA * x.z + cc; x.w = DN_ALPHA * x.w + d;
        *reinterpret_cast<float4*>(p) = x;
#else
        p[0] = DN_ALPHA * p[0] + a; p[1] = DN_ALPHA * p[1] + b; p[2] = DN_ALPHA * p[2] + cc; p[3] = DN_ALPHA * p[3] + d;
#endif
    }
};
struct EpiBf {
    bf16* o; int ld; int row0, pn;
    DI void operator()(int r, int c, float a, float b, float cc, float d) const { st_bf16x4(o + (size_t)(row0 + r) * ld + pn * 256 + c, a, b, cc, d); }
};
template <int MODE>
DI void phase_gemm_sq(const Frame& F, const bf16* A, size_t woff, bf16* outb) {
    const bf16* W = (const bf16*)((const char*)WSP(bf16, OFF_WTS) + woff);
    const int nM = (NTOK + 255) / 256;
    for (int u = blockIdx.x; u < nM * 4; u += gridDim.x) {
        const int pm = u >> 2, pn = u & 3;
#ifdef CPU_EMU
        const int mr = min(256, NTOK - pm * 256);
#endif
        if (MODE == 0) { EpiResid E{F.xf, pm * 256, pn}; gemm_unit((bf16*)F.smem, A, 1024, nullptr, pm * 256, W, 1024, pn * 256, 1024, E MR); }
        else { EpiBf E{outb, 1024, pm * 256, pn}; gemm_unit((bf16*)F.smem, A, 1024, nullptr, pm * 256, W, 1024, pn * 256, 1024, E MR); }
    }
}

DI void phase_ln(const Frame& F, const float* g, const float* b) {
    const float* xf = F.xf;
    layer_norm_rows(F, g, b, [&](int row, int c) { return xf[(size_t)row * DM + c]; }, false, nullptr);
}

DI void phase_route(const Frame& F, int l) {
    const float* xf = F.xf;
    const float* wg = F.in[33] + (size_t)l * 1024 * 4; const float* bg = F.in[34] + l * 4;
    const float* we = F.in[35] + (size_t)l * 1024 * 32; const float* be = F.in[36] + l * 32;
    int* counts = (int*)(F.ws + CTL_CNT) + l * 32;
    int* lists = WSP(int, OFF_LISTS); float* tinfo = WSP(float, OFF_TINFO);
    for (int row = ggrp(); row < NTOK; row += ngrp()) {
        float gl[4] = {0.f, 0.f, 0.f, 0.f};
        for (int i = 0; i < PERLN; ++i) { const int c = glane() + i * GRP; const float x = xf[(size_t)row * DM + c];
#pragma unroll
            for (int q = 0; q < 4; ++q) gl[q] += x * wg[c * 4 + q]; }
#pragma unroll
        for (int q = 0; q < 4; ++q) gl[q] = grp_sum(gl[q]) + bg[q];
        int gi = 0; float gm = gl[0];
#pragma unroll
        for (int q = 1; q < 4; ++q) if (gl[q] > gm) { gm = gl[q]; gi = q; }
        float den = 0.f;
#pragma unroll
        for (int q = 0; q < 4; ++q) den += expf(gl[q] - gm);
        const float pgroup = 1.0f / den;
        float el[8] = {0.f, 0.f, 0.f, 0.f, 0.f, 0.f, 0.f, 0.f};
        for (int i = 0; i < PERLN; ++i) { const int c = glane() + i * GRP; const float x = xf[(size_t)row * DM + c];
#pragma unroll
            for (int q = 0; q < 8; ++q) el[q] += x * we[c * 32 + gi * 8 + q]; }
#pragma unroll
        for (int q = 0; q < 8; ++q) el[q] = grp_sum(el[q]) + be[gi * 8 + q];
        int i0 = 0; float v0 = el[0];
#pragma unroll
        for (int q = 1; q < 8; ++q) if (el[q] > v0) { v0 = el[q]; i0 = q; }
        int i1 = -1; float v1 = -INFINITY;
#pragma unroll
        for (int q = 0; q < 8; ++q) if (q != i0 && el[q] > v1) { v1 = el[q]; i1 = q; }
        const float e1 = expf(v1 - v0); const float g0 = pgroup / (1.0f + e1), g1 = pgroup * e1 / (1.0f + e1);
        if (glane() == 0) {
            const int ea = gi * 8 + i0, eb = gi * 8 + i1;
            const int pa = atomicAdd(&counts[ea], 1), pb = atomicAdd(&counts[eb], 1);
            lists[(size_t)ea * NTOK + pa] = row; lists[(size_t)eb * NTOK + pb] = row;
            int* ti = (int*)(tinfo + (size_t)row * 8);
            ti[0] = ea; ti[1] = pa; ti[2] = eb; ti[3] = pb; tinfo[(size_t)row * 8 + 4] = g0; tinfo[(size_t)row * 8 + 5] = g1;
        }
    }
}

struct EpiMoeUp {
    bf16* hm; int row0, pn;
    DI void operator()(int r, int c, float a, float b, float cc, float d) const {
        bf16* p = hm + (size_t)(row0 + r) * 256 + ((pn * 256 + c) >> 1);
        p[0] = f2bf(siluf_(a) * b); p[1] = f2bf(siluf_(cc) * d);
    }
};
DI void moe_tiles(const int* counts, int* toff  ) {
    __syncthreads();
    if (threadIdx.x == 0) { int acc = 0; for (int e = 0; e < NEXP; ++e) { toff[e] = acc; acc += (counts[e] + 255) >> 8; } toff[NEXP] = acc; }
    __syncthreads();
}
DI void phase_moe_up(const Frame& F, int l) {
    const int* counts = (const int*)(F.ws + CTL_CNT) + l * 32;
    int* eoff = (int*)(F.ws + CTL_EOFF) + l * 33;
    int* rowmap = (int*)(F.smem + 131072);
    int* toff = rowmap + 256;
    moe_tiles(counts, toff);
    if (blockIdx.x == 0 && threadIdx.x == 0) for (int e = 0; e <= NEXP; ++e) eoff[e] = toff[e] * 256;
    const int* lists = WSP(int, OFF_LISTS); const bf16* xb = WSP(bf16, OFF_XB);
    const int nunit = toff[NEXP] * 2;
    for (int u = blockIdx.x; u < nunit; u += gridDim.x) {
        const int tile = u >> 1, pn = u & 1;
        int e = 0; while (toff[e + 1] <= tile) ++e;
        const int t0 = (tile - toff[e]) * 256, cnt = counts[e];
        __syncthreads();
        for (int i = threadIdx.x; i < 256; i += blockDim.x) rowmap[i] = (t0 + i < cnt) ? lists[(size_t)e * NTOK + t0 + i] : 0;
        __syncthreads();
        EpiMoeUp E{WSP(bf16, OFF_HM), tile * 256, pn};
        gemm_unit((bf16*)F.smem, xb, 1024, rowmap, 0, WSP(bf16, OFF_W13T) + (size_t)e * 512 * 1024, 1024, pn * 256, 1024, E);
    }
}
DI void phase_moe_down(const Frame& F, int l) {
    const int* counts = (const int*)(F.ws + CTL_CNT) + l * 32;
    int* toff = (int*)(F.smem + 131072) + 256;
    moe_tiles(counts, toff);
    const int nunit = toff[NEXP] * 4;
    for (int u = blockIdx.x; u < nunit; u += gridDim.x) {
        const int tile = u >> 2, pn = u & 3;
        int e = 0; while (toff[e + 1] <= tile) ++e;
        EpiBf E{WSP(bf16, OFF_YROWS), 1024, tile * 256, pn};
        gemm_unit((bf16*)F.smem, WSP(bf16, OFF_HM), 256, nullptr, tile * 256, WSP(bf16, OFF_W2T) + (size_t)e * 1024 * 256, 256, pn * 256, 256, E);
    }
}
DI void phase_ln3(const Frame& F, int l) {
    const float* xf = F.xf; const bf16* yr = WSP(bf16, OFF_YROWS); const float* tinfo = WSP(float, OFF_TINFO);
    const int* eoff = (const int*)(F.ws + CTL_EOFF) + l * 33;
    layer_norm_rows(F, F.in[40] + l * 1024, F.in[41] + l * 1024, [&](int row, int c) {
        const int* ti = (const int*)(tinfo + (size_t)row * 8);
        const size_t ra = (size_t)eoff[ti[0]] + ti[1], rb = (size_t)eoff[ti[2]] + ti[3];
        return DN_ALPHA * xf[(size_t)row * DM + c] + tinfo[(size_t)row * 8 + 4] * bf2f(yr[ra * 1024 + c]) + tinfo[(size_t)row * 8 + 5] * bf2f(yr[rb * 1024 + c]);
    }, false, nullptr);
}

constexpr int NPH_LAYER = 16;
constexpr int NPH_TOTAL = 1 + 2 * NPH_LAYER;
constexpr int SMEM_BYTES = 131072 + 2048;

template <int K>
DI void run_layer_phase(const Frame& F, int l) {
    if constexpr (K == 0) phase_cvt(F, l);
    if constexpr (K == 1) phase_gemm1(F);
    if constexpr (K == 2) phase_prep(F, l);
    if constexpr (K == 3) phase_mlaup(F);
    if constexpr (K == 4) {
#ifdef CPU_EMU
        attn_phase<64, 64>(F, desc_gqa(F)); attn_phase<96, 64>(F, desc_mla(F));
#else
        attn_phase<64, 64, 64>(F, desc_gqa(F)); attn_phase<96, 64, 64>(F, desc_mla(F));
#endif
        phase_scans(F);
    }
    if constexpr (K == 5) phase_fin(F, l);
    if constexpr (K == 6) phase_gemm_sq<0>(F, WSP(bf16, OFF_YCAT), W_OUT_T, nullptr);
    if constexpr (K == 7) phase_ln(F, F.in[26] + l * 1024, F.in[27] + l * 1024);
    if constexpr (K == 8) phase_gemm_sq<1>(F, WSP(bf16, OFF_XB), W_Q_T, WSP(bf16, OFF_QMEM));
    if constexpr (K == 9) {
#ifdef CPU_EMU
        attn_phase<256, 256>(F, desc_mem(F));
#else
        attn_phase<256, 256, 128>(F, desc_mem(F));
#endif
    }
    if constexpr (K == 10) phase_gemm_sq<0>(F, WSP(bf16, OFF_OMEM), W_O_T, nullptr);
    if constexpr (K == 11) { phase_ln(F, F.in[31] + l * 1024, F.in[32] + l * 1024); phase_cvt_moe(F, l); }
    if constexpr (K == 12) phase_route(F, l);
    if constexpr (K == 13) phase_moe_up(F, l);
    if constexpr (K == 14) phase_moe_down(F, l);
    if constexpr (K == 15) phase_ln3(F, l);
}

#ifndef CPU_EMU
template <int K>
__global__ void __launch_bounds__(512, 2) k_phase(Args a, int l) {
    extern __shared__ __attribute__((aligned(16))) unsigned char lds[];
    Frame F; F.in = a.in; F.xf = a.out; F.ws = a.ws; F.smem = lds; F.mrows_limit = 256;
    if constexpr (K < 0) phase_pro(F); else run_layer_phase<K>(F, l);
}

template <int K>
static void launch_phase(const Args& a, int l, int grid, hipStream_t stream) {
    static bool attr = false;
    if (!attr) { (void)hipFuncSetAttribute((const void*)k_phase<K>, hipFuncAttributeMaxDynamicSharedMemorySize, SMEM_BYTES); attr = true; }
    hipLaunchKernelGGL(k_phase<K>, dim3(grid), dim3(512), SMEM_BYTES, stream, a, l);
}

extern "C" void kernel_launch(void* const* d_in, const int* in_sizes, int n_in, void* d_out, int out_size, void* d_ws, size_t ws_size, hipStream_t stream) {
    if (n_in != 42 || ws_size < WS_END) return;
    Args a{};
    for (int i = 0; i < 42; ++i) a.in[i] = (const float*)d_in[i];
    a.out = (float*)d_out; a.ws = (unsigned char*)d_ws; a.ph_lo = 0; a.ph_hi = NPH_TOTAL;
    (void)hipMemsetAsync(d_ws, 0, CTL_BYTES, stream);
    const int grid = 256;
    launch_phase<-1>(a, 0, grid, stream);
    for (int l = 0; l < 2; ++l) {
        launch_phase<0>(a, l, grid, stream); launch_phase<1>(a, l, grid, stream); launch_phase<2>(a, l, grid, stream); launch_phase<3>(a, l, grid, stream);
        launch_phase<4>(a, l, grid, stream); launch_phase<5>(a, l, grid, stream); launch_phase<6>(a, l, grid, stream); launch_phase<7>(a, l, grid, stream);
        launch_phase<8>(a, l, grid, stream); launch_phase<9>(a, l, grid, stream); launch_phase<10>(a, l, grid, stream); launch_phase<11>(a, l, grid, stream);
        launch_phase<12>(a, l, grid, stream); launch_phase<13>(a, l, grid, stream); launch_phase<14>(a, l, grid, stream); launch_phase<15>(a, l, grid, stream);
    }
}
#endif
```

```cpp
#ifndef CPU_EMU
#include <hip/hip_runtime.h>
#else
#include "emu_shim.h"
#endif
#include <stdint.h>

#ifndef CFG_B
#define CFG_B 16
#endif
#ifndef CFG_S
#define CFG_S 2048
#endif
#ifndef N_LAUNCH_MODE
#define N_LAUNCH_MODE 1
#endif

typedef unsigned short bf16;
#define DI __device__ __forceinline__

constexpr int BATCH = CFG_B, SEQ = CFG_S, NTOK = BATCH * SEQ, DM = 1024;
constexpr int MEMT = 256, NMEM = BATCH * MEMT;
constexpr int GRIDW = 64;
constexpr int HP = 3328;
constexpr int IN_WIDTH = 3104;
constexpr int NEXP = 32, MOEH = 256;
constexpr int MOE_ROWS = 2 * NTOK + NEXP * 256;
constexpr float LN_EPS = 1e-5f, RMS_EPS = 1e-6f, GN_EPS = 64e-5f;
constexpr float DN_ALPHA = 1.41421356237309515f;
constexpr float DECAY_SCALE = 0.60653065971263342f;

constexpr size_t AL(size_t x) { return (x + 255) & ~(size_t)255; }
constexpr size_t OFF_CTL = 0;
constexpr size_t CTL_BYTES = 32768;
constexpr size_t CTL_CNT = 16384;
constexpr size_t CTL_EOFF = 16384 + 1024;
constexpr size_t OFF_XB = AL(OFF_CTL + CTL_BYTES);
constexpr size_t SZ_XB = (size_t)NTOK * DM * 2;
constexpr size_t OFF_WTS = AL(OFF_XB + SZ_XB);
constexpr size_t W_IN_T = 0;
constexpr size_t W_UQ_T = W_IN_T + (size_t)HP * 1024 * 2;
constexpr size_t W_UKV_T = W_UQ_T + 512 * 256 * 2;
constexpr size_t W_OUT_T = W_UKV_T + 512 * 256 * 2;
constexpr size_t W_Q_T = W_OUT_T + 1024 * 1024 * 2;
constexpr size_t W_KV_T = W_Q_T + 1024 * 1024 * 2;
constexpr size_t W_O_T = W_KV_T + 2048 * 1024 * 2;
constexpr size_t SZ_WTS = W_O_T + 1024 * 1024 * 2;
constexpr size_t OFF_KMEM = AL(OFF_WTS + SZ_WTS);
constexpr size_t OFF_VTMEM = AL(OFF_KMEM + (size_t)NMEM * 1024 * 2);
constexpr size_t OFF_MEMB = AL(OFF_VTMEM + (size_t)NMEM * 1024 * 2);
constexpr size_t OFF_VTATT = AL(OFF_MEMB + (size_t)NMEM * 1024 * 2);
constexpr size_t OFF_VTMLA = AL(OFF_VTATT + (size_t)BATCH * 2 * 64 * SEQ * 2);
constexpr size_t OFF_HATT = AL(OFF_VTMLA + (size_t)BATCH * 4 * 64 * SEQ * 2);
constexpr size_t OFF_HMLA = OFF_HATT + (size_t)NTOK * 512 * 2;
constexpr size_t OFF_HRWKV = OFF_HMLA + (size_t)NTOK * 512 * 2;
constexpr size_t OFF_R7 = OFF_HRWKV + (size_t)NTOK * 1024 * 2;
constexpr size_t SZ_R7 = (size_t)NTOK * 9 * 256 * 2;
constexpr size_t OFF_HHGRN = OFF_R7 + SZ_R7;
constexpr size_t WS_END = OFF_HHGRN + (size_t)NTOK * 1280 * 2;

constexpr size_t OFF_QMLA = OFF_XB;
constexpr size_t OFF_KNOPE = OFF_QMLA + (size_t)NTOK * 384 * 2;
constexpr size_t OFF_KROPE = OFF_KNOPE + (size_t)NTOK * 256 * 2;
constexpr size_t OFF_G = OFF_KROPE + (size_t)NTOK * 32 * 2;
constexpr size_t OFF_BONUS = OFF_G + (size_t)NTOK * 256 * 2;
static_assert(OFF_BONUS + (size_t)NTOK * 16 <= OFF_XB + SZ_XB, "xb alias region");
constexpr size_t OFF_YCAT = OFF_HRWKV;
constexpr size_t OFF_QMEM = OFF_HATT;
constexpr size_t OFF_OMEM = OFF_R7;
#ifdef CPU_EMU
constexpr size_t OFF_EMU_SCAN = WS_END;
constexpr size_t OFF_LISTS = AL(OFF_EMU_SCAN + (size_t)4 * NTOK * 256 * 2);
#else
constexpr size_t OFF_LISTS = OFF_HATT;
#endif
constexpr size_t OFF_TINFO = OFF_LISTS + (size_t)NEXP * NTOK * 4;
constexpr size_t OFF_HM = AL(OFF_TINFO + (size_t)NTOK * 32);
constexpr size_t OFF_YROWS = AL(OFF_HM + (size_t)MOE_ROWS * 256 * 2);
#ifdef CPU_EMU
constexpr size_t OFF_W13T = AL(OFF_YROWS + (size_t)MOE_ROWS * 1024 * 2);
#else
static_assert(OFF_YROWS + (size_t)MOE_ROWS * 1024 * 2 <= OFF_HHGRN, "moe alias region");
constexpr size_t OFF_W13T = OFF_HHGRN;
#endif
constexpr size_t OFF_W2T = OFF_W13T + (size_t)NEXP * 512 * 1024 * 2;
#ifdef CPU_EMU
constexpr size_t WS_END_EMU = OFF_W2T + (size_t)NEXP * 1024 * 256 * 2;
#else
static_assert(OFF_W2T + (size_t)NEXP * 1024 * 256 * 2 <= WS_END, "moe weights alias");
#endif

enum { R_R = 0, R_V = 1, R_KK = 2, R_W0 = 3, R_W1 = 4, R_KD0 = 5, R_KD1 = 6, R_AK0 = 7, R_AK1 = 8 };

DI float bf2f(bf16 v) { union { unsigned u; float f; } x; x.u = (unsigned)v << 16; return x.f; }
DI bf16 f2bf(float f) { union { unsigned u; float f; } x; x.f = f; unsigned u = x.u; u += 0x7fffu + ((u >> 16) & 1u); return (bf16)(u >> 16); }
DI float sigmoidf_(float x) { return 1.0f / (1.0f + expf(-x)); }
DI float siluf_(float x) { return x * sigmoidf_(x); }

#ifdef CPU_EMU
typedef const float* const* InPtr;
#else
typedef const float* const __attribute__((address_space(4)))* InPtr;
#endif
struct Frame {
    InPtr in;
    float* xf;
    unsigned char* ws;
    unsigned char* smem;
    int tid;
    int wv;
};
#ifdef CPU_EMU
constexpr int NTH = 1;
#else
constexpr int NTH = 512;
#endif
#ifdef CPU_EMU
constexpr int GRP = 1;
DI float grp_sum(const Frame& F, float v) { return v; }
DI int gthreads() { return 1; }
DI int gtid_(const Frame& F) { return 0; }
DI int wave_item_index(const Frame& F) { return 0; }
#else
constexpr int GRP = 64;
DI float shfl_idx(const Frame& F, float v, int src_lane) { return __builtin_bit_cast(float, __builtin_amdgcn_ds_bpermute(src_lane << 2, __builtin_bit_cast(int, v))); }
DI float shfl_xor(const Frame& F, float v, int mask) { return shfl_idx(F, v, (F.tid & 63) ^ mask); }
DI float grp_sum(const Frame& F, float v) {
#pragma unroll
    for (int o = 32; o > 0; o >>= 1) v += shfl_xor(F, v, o);
    return v;
}
DI int gthreads() { return gridDim.x * NTH; }
DI int gtid_(const Frame& F) { return blockIdx.x * NTH + F.tid; }
DI int wave_item_index(const Frame& F) { return (int)(((F.tid >> 6) * gridDim.x + blockIdx.x) * 64 + (F.tid & 63)); }
#endif
constexpr int PER64 = 64 / GRP;
constexpr int PERLN = 1024 / GRP;
DI int fresh_tid(const Frame& F) {
#ifdef CPU_EMU
    return 0;
#else
    unsigned m0 = ~0u; asm volatile("" : "+s"(m0));
    int t = F.wv * 64 + (int)__builtin_amdgcn_mbcnt_hi(m0, __builtin_amdgcn_mbcnt_lo(m0, 0u)); asm volatile("" : "+v"(t)); return t;
#endif
}
DI int glane(const Frame& F) { return (int)(F.tid % GRP); }
DI int ggrp(const Frame& F) { return gtid_(F) / GRP; }
DI int ngrp() { return gthreads() / GRP; }

struct Args {
    const float* in[42];
    float* out;
    unsigned char* ws;
    int ph_lo, ph_hi;
};

DI float rope_inv(int f, int nf) { return powf(10000.0f, -(float)f / (float)nf); }

#ifndef CPU_EMU
using bf16x8 = __attribute__((ext_vector_type(8))) short;
using bf16x4 = __attribute__((ext_vector_type(4))) short;
using f32x4 = __attribute__((ext_vector_type(4))) float;
using f32x16 = __attribute__((ext_vector_type(16))) float;
typedef __bf16 bf16v2 __attribute__((ext_vector_type(2)));
typedef float f32v2 __attribute__((ext_vector_type(2)));
DI unsigned pack_bf16(float lo, float hi) { f32v2 v = {lo, hi}; bf16v2 b = __builtin_convertvector(v, bf16v2); return __builtin_bit_cast(unsigned, b); }

constexpr int G_BM = 256, G_BK = 64, G_HALF = 128, G_HT = G_HALF * G_BK, G_SHM = 8 * G_HT * 2;
DI int g_lds_byte(int r, int c) { int st = (r >> 4) * 2 + (c >> 5), rr = r & 15, cc = c & 31, ob = rr * 64 + cc * 2; return st * 1024 + (ob ^ (((ob >> 9) & 1) << 5)); }
DI void g_stage_rc(int b, int& R, int& C) { int st = b / 1024, sb = b % 1024, swz = sb ^ (((sb >> 9) & 1) << 5); R = (st >> 1) * 16 + swz / 64; C = (st & 1) * 32 + (swz % 64) / 2; }

template <bool GATHER, class Epi>
DI void gemm_unit_t(int wv_in, bf16* shm, const bf16* __restrict__ A, int lda, const int* rowmap, int arow0,
                    const bf16* __restrict__ Bt, int ldb, int bcol0, int K, const Epi& epi) {
#define SA(b, h) (shm + ((b) * 2 + (h)) * G_HT)
#define SB(b, h) (shm + (4 + (b) * 2 + (h)) * G_HT)
#define STAGE_AX(T, P, hf, kt) do { for (int _i = 0; _i < 2; ++_i) { int _b = (T) * 16 + _i * 8192; int _r, _c; g_stage_rc(_b, _r, _c); \
        const long _row = GATHER ? (long)rowmap[(hf) * G_HALF + _r] : (long)(arow0 + (hf) * G_HALF + _r); \
        __builtin_amdgcn_global_load_lds((const unsigned*)(A + _row * lda + (long)(kt) * G_BK + _c), (unsigned*)((char*)(P) + _b), 16, 0, 0); } } while (0)
#define STAGE_BX(T, P, hf, kt) do { for (int _i = 0; _i < 2; ++_i) { int _b = (T) * 16 + _i * 8192; int _r, _c; g_stage_rc(_b, _r, _c); \
        __builtin_amdgcn_global_load_lds((const unsigned*)(Bt + (long)(bcol0 + (hf) * G_HALF + _r) * ldb + (long)(kt) * G_BK + _c), (unsigned*)((char*)(P) + _b), 16, 0, 0); } } while (0)
#define STAGE_A(P, hf, kt) STAGE_AX(t0, P, hf, kt)
#define STAGE_B(P, hf, kt) STAGE_BX(t0, P, hf, kt)
#define LDA(dst, b, h) for (int m = 0; m < 4; ++m) for (int k = 0; k < 2; ++k) \
        dst[m][k] = *reinterpret_cast<const bf16x8*>((char*)SA(b, h) + g_lds_byte(wr * 64 + m * 16 + fr, k * 32 + fq * 8))
#define LDB(dst, b, h) for (int n = 0; n < 2; ++n) for (int k = 0; k < 2; ++k) \
        dst[n][k] = *reinterpret_cast<const bf16x8*>((char*)SB(b, h) + g_lds_byte(wc * 32 + n * 16 + fr, k * 32 + fq * 8))
#define MMA(ai, bj, At, Bt_) do { __builtin_amdgcn_s_setprio(1); \
        for (int m = 0; m < 4; ++m) for (int n = 0; n < 2; ++n) for (int k = 0; k < 2; ++k) \
            acc[ai][bj][m][n] = __builtin_amdgcn_mfma_f32_16x16x32_bf16(Bt_[n][k], At[m][k], acc[ai][bj][m][n], 0, 0, 0); \
        __builtin_amdgcn_s_setprio(0); } while (0)
#define WAIT_V(n) asm volatile("s_waitcnt vmcnt(" #n ")" ::: "memory")
#define WAIT_L(n) asm volatile("s_waitcnt lgkmcnt(" #n ")" ::: "memory")
#define BAR __builtin_amdgcn_s_barrier()
#define SCHED __builtin_amdgcn_sched_barrier(0)
    unsigned m0 = ~0u; asm volatile("" : "+s"(m0));
    int t0 = wv_in * 64 + (int)__builtin_amdgcn_mbcnt_hi(m0, __builtin_amdgcn_mbcnt_lo(m0, 0u)); asm volatile("" : "+v"(t0));
    int wid = t0 >> 6, lane = t0 & 63, wr = wid >> 2, wc = wid & 3, fr = lane & 15, fq = lane >> 4;
    f32x4 acc[2][2][4][2] = {};
    bf16x8 At[4][2], B0[2][2], B1[2][2];
    const int nt = K / G_BK;
    STAGE_B(SB(0, 0), 0, 0); STAGE_A(SA(0, 0), 0, 0);
    STAGE_B(SB(0, 1), 1, 0); STAGE_A(SA(0, 1), 1, 0);
    if (wr == 1) BAR;
    WAIT_V(4); BAR;
    STAGE_B(SB(1, 0), 0, 1); STAGE_A(SA(1, 0), 0, 1); STAGE_B(SB(1, 1), 1, 1);
    WAIT_V(6); BAR;
    for (int t = 0; t < nt - 2; t += 2) {
        LDB(B0, 0, 0); SCHED; LDA(At, 0, 0); STAGE_A(SA(1, 1), 1, t + 1);
        WAIT_L(8); BAR; WAIT_L(0); MMA(0, 0, At, B0); BAR; SCHED;
        LDB(B1, 0, 1); STAGE_B(SB(0, 0), 0, t + 2);
        BAR; WAIT_L(0); MMA(0, 1, At, B1); BAR;
        LDA(At, 0, 1); STAGE_A(SA(0, 0), 0, t + 2);
        BAR; WAIT_L(0); MMA(1, 0, At, B0); BAR; SCHED;
        STAGE_B(SB(0, 1), 1, t + 2);
        WAIT_V(6); BAR; MMA(1, 1, At, B1); BAR;
        LDB(B0, 1, 0); SCHED; LDA(At, 1, 0); STAGE_A(SA(0, 1), 1, t + 2);
        WAIT_L(8); BAR; WAIT_L(0); MMA(0, 0, At, B0); BAR; SCHED;
        LDB(B1, 1, 1); STAGE_B(SB(1, 0), 0, t + 3);
        BAR; WAIT_L(0); MMA(0, 1, At, B1); BAR;
        LDA(At, 1, 1); STAGE_A(SA(1, 0), 0, t + 3);
        BAR; WAIT_L(0); MMA(1, 0, At, B0); BAR; SCHED;
        STAGE_B(SB(1, 1), 1, t + 3);
        WAIT_V(6); BAR; MMA(1, 1, At, B1); BAR;
    }
    int tz = t0; asm volatile("" : "+v"(tz)); wid = tz >> 6; lane = tz & 63; wr = wid >> 2; wc = wid & 3; fr = lane & 15; fq = lane >> 4;
    { LDB(B0, 0, 0); WAIT_V(0); LDA(At, 0, 0); STAGE_AX(tz, SA(1, 1), 1, nt - 1);
      BAR; WAIT_L(0); MMA(0, 0, At, B0); BAR;
      LDB(B1, 0, 1); BAR; WAIT_L(0); MMA(0, 1, At, B1); BAR;
      LDA(At, 0, 1); WAIT_V(4); BAR; WAIT_L(0); MMA(1, 0, At, B0); MMA(1, 1, At, B1); BAR; }
    { LDB(B0, 1, 0); LDA(At, 1, 0); WAIT_V(2); BAR; WAIT_L(0); MMA(0, 0, At, B0); BAR;
      LDB(B1, 1, 1); WAIT_V(0); BAR; WAIT_L(0); MMA(0, 1, At, B1); BAR;
      LDA(At, 1, 1); BAR; WAIT_L(0); MMA(1, 0, At, B0); MMA(1, 1, At, B1); BAR; }
    if (wr == 0) BAR;
#pragma unroll
    for (int ai = 0; ai < 2; ++ai)
#pragma unroll
        for (int m = 0; m < 4; ++m)
#pragma unroll
            for (int bj = 0; bj < 2; ++bj)
#pragma unroll
                for (int n = 0; n < 2; ++n) {
                    const f32x4 v = acc[ai][bj][m][n];
                    epi(ai * G_HALF + wr * 64 + m * 16 + fr, bj * G_HALF + wc * 32 + n * 16 + fq * 4, v[0], v[1], v[2], v[3]);
                }
#undef SA
#undef SB
#undef STAGE_A
#undef STAGE_B
#undef STAGE_AX
#undef STAGE_BX
#undef LDA
#undef LDB
#undef MMA
}
template <class Epi>
DI void gemm_unit(const Frame& F, const bf16* __restrict__ A, int lda, const int* rowmap, int arow0,
                  const bf16* __restrict__ Bt, int ldb, int bcol0, int K, const Epi& epi) {
    if (rowmap) gemm_unit_t<true>(F.wv, (bf16*)F.smem, A, lda, rowmap, arow0, Bt, ldb, bcol0, K, epi);
    else gemm_unit_t<false>(F.wv, (bf16*)F.smem, A, lda, rowmap, arow0, Bt, ldb, bcol0, K, epi);
}
#else
template <class Epi>
void gemm_unit(const Frame& F, const bf16* A, int lda, const int* rowmap, int arow0, const bf16* Bt, int ldb, int bcol0, int K, const Epi& epi, int mrows = 256) {
    for (int r = 0; r < mrows; ++r) {
        int arow = rowmap ? rowmap[r] : arow0 + r;
        for (int c = 0; c < 256; c += 4) {
            float v[4];
            for (int q = 0; q < 4; ++q) {
                double s = 0; const bf16* a = A + (long)arow * lda; const bf16* b = Bt + (long)(bcol0 + c + q) * ldb;
                for (int k = 0; k < K; ++k) s += (double)bf2f(a[k]) * bf2f(b[k]);
                v[q] = (float)s;
            }
            epi(r, c, v[0], v[1], v[2], v[3]);
        }
    }
}
#endif

DI void st_bf16x4(bf16* p, float a, float b, float c, float d) {
#ifndef CPU_EMU
    uint2 u; u.x = pack_bf16(a, b); u.y = pack_bf16(c, d); *reinterpret_cast<uint2*>(p) = u;
#else
    p[0] = f2bf(a); p[1] = f2bf(b); p[2] = f2bf(c); p[3] = f2bf(d);
#endif
}

#define WSP(T, off) ((T*)(F.ws + (off)))

DI void ln_row_write(float* xrow, bf16* brow, const float* vals_in  , const float* g, const float* b);

template <class Fn>
DI void layer_norm_rows(const Frame& F, const float* g, const float* b, Fn pre, bool write_out_extra, float* extra) {
    float* xf = F.xf; bf16* xb = WSP(bf16, OFF_XB);
    for (int row = ggrp(F); row < NTOK; row += ngrp()) {
        float v[PERLN]; float s = 0.f;
        for (int i = 0; i < PERLN; ++i) { int c = glane(F) + i * GRP; v[i] = pre(row, c); s += v[i]; }
        s = grp_sum(F, s); const float mu = s * (1.0f / 1024.0f);
        float q = 0.f;
        for (int i = 0; i < PERLN; ++i) { float d = v[i] - mu; q += d * d; }
        q = grp_sum(F, q); const float rs = 1.0f / sqrtf(q * (1.0f / 1024.0f) + LN_EPS);
        for (int i = 0; i < PERLN; ++i) { int c = glane(F) + i * GRP; float y = (v[i] - mu) * rs * g[c] + b[c];
            xf[(size_t)row * DM + c] = y; xb[(size_t)row * DM + c] = f2bf(y); if (write_out_extra) extra[(size_t)row * DM + c] = y; }
    }
}

DI void phase_pro(const Frame& F) {
    const float* x = F.in[0]; const float* mem = F.in[1];
    layer_norm_rows(F, F.in[2], F.in[3], [&](int row, int c) { return x[(size_t)row * DM + c]; }, false, nullptr);
    bf16* memb = WSP(bf16, OFF_MEMB);
    for (size_t i = gtid_(F); i < (size_t)NMEM * DM; i += gthreads()) memb[i] = f2bf(mem[i]);
}

template <class Src>
DI void cvt_transpose(const Frame& F, bf16* dst, int Nn, int Kk, Src src) {
#ifdef CPU_EMU
    for (int n = 0; n < Nn; ++n) for (int k = 0; k < Kk; ++k) dst[(size_t)n * Kk + k] = f2bf(src(k, n));
#else
    float* tile = (float*)F.smem;
    const int tn = Nn / 64, tk = Kk / 64, ntile = tn * tk;
    for (int t = blockIdx.x; t < ntile; t += gridDim.x) {
        const int n0 = (t % tn) * 64, k0 = (t / tn) * 64;
        __syncthreads();
        for (int i = F.tid; i < 4096; i += NTH) { int k = i >> 6, n = i & 63; tile[k * 65 + n] = src(k0 + k, n0 + n); }
        __syncthreads();
        for (int i = F.tid; i < 4096; i += NTH) { int n = i >> 6, k = i & 63; dst[(size_t)(n0 + n) * Kk + k0 + k] = f2bf(tile[k * 65 + n]); }
    }
#endif
}

DI int win_src_col(int n) {
    if (n < 512) return n;
    if (n < 1536) { int c = n - 512; return c < 960 ? 512 + c : -1; }
    if (n < 2816) return 1472 + (n - 1536);
    int c = n - 2816;
    if (c < 192) return 2752 + c;
    if (c < 224) return 2752 + 320 + (c - 192);
    if (c < 256) return -1;
    if (c < 384) return 2752 + 192 + (c - 256);
    return -1;
}
DI int wuq_src_col(int n) {
    if (n >= 384) return -1;
    int h = n / 96, w = n % 96;
    if (w < 64) return h * 96 + w;
    int p = w - 64, m = p >> 1, which = p & 1;
    int i = (m < 8 ? m : 16 + (m - 8)) + (which ? 8 : 0);
    return h * 96 + 64 + i;
}

DI void phase_cvt(const Frame& F, int l) {
    bf16* wts = WSP(bf16, OFF_WTS);
    { const float* w = F.in[4] + (size_t)l * 1024 * IN_WIDTH;
      cvt_transpose(F, (bf16*)((char*)wts + W_IN_T), HP, 1024, [&](int k, int n) { int s = win_src_col(n); return s < 0 ? 0.f : w[(size_t)k * IN_WIDTH + s]; }); }
    { const float* w = F.in[23] + (size_t)l * 192 * 384;
      cvt_transpose(F, (bf16*)((char*)wts + W_UQ_T), 512, 256, [&](int k, int n) { int s = wuq_src_col(n); return (s < 0 || k >= 192) ? 0.f : w[(size_t)k * 384 + s]; }); }
    { const float* w = F.in[24] + (size_t)l * 128 * 512;
      cvt_transpose(F, (bf16*)((char*)wts + W_UKV_T), 512, 256, [&](int k, int n) { return k >= 128 ? 0.f : w[(size_t)k * 512 + n]; }); }
    { const float* w = F.in[25] + (size_t)l * 1024 * 1024;
      cvt_transpose(F, (bf16*)((char*)wts + W_OUT_T), 1024, 1024, [&](int k, int n) { return w[(size_t)k * 1024 + n]; }); }
    { const float* w = F.in[28] + (size_t)l * 1024 * 1024;
      cvt_transpose(F, (bf16*)((char*)wts + W_Q_T), 1024, 1024, [&](int k, int n) { return w[(size_t)k * 1024 + n]; }); }
    { const float* w = F.in[29] + (size_t)l * 1024 * 2048;
      cvt_transpose(F, (bf16*)((char*)wts + W_KV_T), 2048, 1024, [&](int k, int n) { return w[(size_t)k * 2048 + n]; }); }
    { const float* w = F.in[30] + (size_t)l * 1024 * 1024;
      cvt_transpose(F, (bf16*)((char*)wts + W_O_T), 1024, 1024, [&](int k, int n) { return w[(size_t)k * 1024 + n]; }); }
}

DI void phase_cvt_moe(const Frame& F, int l) {
    for (int e = 0; e < NEXP; ++e) {
        const float* w1 = F.in[37] + ((size_t)l * NEXP + e) * 1024 * 256;
        const float* w3 = F.in[38] + ((size_t)l * NEXP + e) * 1024 * 256;
        const float* w2 = F.in[39] + ((size_t)l * NEXP + e) * 256 * 1024;
        cvt_transpose(F, WSP(bf16, OFF_W13T) + (size_t)e * 512 * 1024, 512, 1024,
                      [&](int k, int n) { return (n & 1) ? w3[(size_t)k * 256 + (n >> 1)] : w1[(size_t)k * 256 + (n >> 1)]; });
        cvt_transpose(F, WSP(bf16, OFF_W2T) + (size_t)e * 1024 * 256, 1024, 256, [&](int k, int n) { return w2[(size_t)k * 1024 + n]; });
    }
}

struct EpiH {
    bf16* hatt; bf16* hrwkv; bf16* hhgrn; bf16* hmla; int row0, pn;
    DI void operator()(int r, int c, float a, float b, float cc, float d) const {
        const size_t row = row0 + r;
        bf16* p;
        if (pn < 2) p = hatt + row * 512 + pn * 256 + c;
        else if (pn < 6) p = hrwkv + row * 1024 + (pn - 2) * 256 + c;
        else if (pn < 11) p = hhgrn + row * 1280 + (pn - 6) * 256 + c;
        else p = hmla + row * 512 + (pn - 11) * 256 + c;
        st_bf16x4(p, a, b, cc, d);
    }
};
struct EpiKV {
    bf16* kmem; bf16* vt; int row0, pn;
    DI void operator()(int r, int c, float a, float b, float cc, float d) const {
        const int row = row0 + r, col = pn * 256 + c;
        if (col < 1024) { st_bf16x4(kmem + (size_t)row * 1024 + col, a, b, cc, d); }
        else { const int bb = row / MEMT, key = row % MEMT, hc = col - 1024;
            bf16* p = vt + ((size_t)bb * 1024 + hc) * MEMT + key;
            p[0] = f2bf(a); p[MEMT] = f2bf(b); p[2 * MEMT] = f2bf(cc); p[3 * MEMT] = f2bf(d); }
    }
};

DI void phase_gemm1(const Frame& F) {
    const bf16* xb = WSP(bf16, OFF_XB); const bf16* wts = WSP(bf16, OFF_WTS);
    const int nM = (NTOK + 255) / 256, nN = HP / 256, n1 = nM * nN;
    const int nMk = (NMEM + 255) / 256, nNk = 8, n2 = nMk * nNk;
    for (int u = blockIdx.x; u < n1 + n2; u += gridDim.x) {
        if (u < n1) {
            const int pm = u / nN, pn = u % nN;
            EpiH E{WSP(bf16, OFF_HATT), WSP(bf16, OFF_HRWKV), WSP(bf16, OFF_HHGRN), WSP(bf16, OFF_HMLA), pm * 256, pn};
#ifdef CPU_EMU
            gemm_unit(F, xb, 1024, nullptr, pm * 256, (const bf16*)((const char*)wts + W_IN_T), 1024, pn * 256, 1024, E, min(256, NTOK - pm * 256));
#else
            gemm_unit(F, xb, 1024, nullptr, pm * 256, (const bf16*)((const char*)wts + W_IN_T), 1024, pn * 256, 1024, E);
#endif
        } else {
            const int v = u - n1, pm = v / nNk, pn = v % nNk;
            EpiKV E{WSP(bf16, OFF_KMEM), WSP(bf16, OFF_VTMEM), pm * 256, pn};
            gemm_unit(F, WSP(bf16, OFF_MEMB), 1024, nullptr, pm * 256, (const bf16*)((const char*)wts + W_KV_T), 1024, pn * 256, 1024, E);
        }
    }
}

DI void phase_prep(const Frame& F, int l) {
    {
        bf16* hatt = WSP(bf16, OFF_HATT); bf16* vt = WSP(bf16, OFF_VTATT);
        const float* qn = F.in[5] + l * 64; const float* kn = F.in[6] + l * 64;
        const int nitem = NTOK * 6;
        for (int it = ggrp(F); it < nitem; it += ngrp()) {
            const int n = it / 6, hh = it % 6;
            const int s = n % SEQ;
            bf16* p = hatt + (size_t)n * 512 + hh * 64;
            const float* gn = hh < 4 ? qn : kn;
            float v[PER64]; float ss = 0.f;
            for (int i = 0; i < PER64; ++i) { int j = glane(F) + i * GRP; v[i] = bf2f(p[j]); ss += v[i] * v[i]; }
            ss = grp_sum(F, ss); const float rs = 1.0f / sqrtf(ss * (1.0f / 64.0f) + RMS_EPS);
            float o[PER64];
#ifdef CPU_EMU
            float nv[64]; for (int j = 0; j < 64; ++j) nv[j] = v[j] * rs * gn[j];
#endif
            for (int i = 0; i < PER64; ++i) {
                int j = glane(F) + i * GRP;
                const int half = j >> 5, w = j & 31, f = w & 15, second = w >> 4;
                const float pos = half == 0 ? (float)(s / GRIDW) : (float)(s % GRIDW);
                const float ang = pos * rope_inv(2 * f, 32);
                const float cs = cosf(ang), sn = sinf(ang);
                const float mine = v[i] * rs * gn[j];
                const int jp = second ? j - 16 : j + 16;
#ifdef CPU_EMU
                const float partner = nv[jp];
#else
                const float partner = shfl_idx(F, v[0], jp) * rs * gn[jp];
#endif
                o[i] = second ? (partner * sn + mine * cs) : (mine * cs - partner * sn);
            }
            for (int i = 0; i < PER64; ++i) { int j = glane(F) + i * GRP; p[j] = f2bf(o[i]); }
        }
        for (size_t i = gtid_(F); i < (size_t)NTOK * 128; i += gthreads()) {
            const int n = (int)(i / 128), c = (int)(i % 128), b = n / SEQ, s = n % SEQ;
            vt[((size_t)b * 128 + c) * SEQ + s] = hatt[(size_t)n * 512 + 384 + c];
        }
    }
    {
        bf16* hm = WSP(bf16, OFF_HMLA); bf16* kr = WSP(bf16, OFF_KROPE);
        const float* qn = F.in[21] + l * 192; const float* kvn = F.in[22] + l * 128;
        for (int it = ggrp(F); it < NTOK * 2; it += ngrp()) {
            const int n = it >> 1, which = it & 1;
            bf16* p = hm + (size_t)n * 512 + (which ? 256 : 0);
            const int len = which ? 128 : 192; const float* gn = which ? kvn : qn;
            float ss = 0.f;
            for (int j = glane(F); j < len; j += GRP) { float x = bf2f(p[j]); ss += x * x; }
            ss = grp_sum(F, ss); const float rs = 1.0f / sqrtf(ss / (float)len + RMS_EPS);
            for (int j = glane(F); j < len; j += GRP) p[j] = f2bf(bf2f(p[j]) * rs * gn[j]);
        }
        for (int i = gtid_(F); i < NTOK * 16; i += gthreads()) {
            const int n = i >> 4, m = i & 15, s = n % SEQ;
            const bf16* src = hm + (size_t)n * 512 + 192;
            const int i1 = (m < 8 ? m : 16 + (m - 8)), i2 = i1 + 8;
            const float x1 = bf2f(src[i1]), x2 = bf2f(src[i2]);
            const float pos = m < 8 ? (float)(s / GRIDW) : (float)(s % GRIDW);
            const float ang = pos * rope_inv(2 * (m & 7), 16);
            const float cs = cosf(ang), sn = sinf(ang);
            kr[(size_t)n * 32 + 2 * m] = f2bf(x1 * cs - x2 * sn);
            kr[(size_t)n * 32 + 2 * m + 1] = f2bf(x1 * sn + x2 * cs);
        }
    }
    {
        const bf16* hz = WSP(bf16, OFF_HRWKV); bf16* r7 = WSP(bf16, OFF_R7); bf16* gb = WSP(bf16, OFF_G); float* bonus = WSP(float, OFF_BONUS);
        const float* mup = F.in[7] + l * 960; const float* mun = F.in[8] + l * 960;
        const float* w0 = F.in[9] + l * 512; const float* w2 = F.in[10] + (size_t)l * 2 * 32 * 256;
        const float* a0 = F.in[11] + l * 512; const float* a2 = F.in[12] + (size_t)l * 2 * 32 * 256;
        const float* g2 = F.in[13] + (size_t)l * 64 * 256;
        const float* k_k = F.in[14] + l * 256; const float* k_a = F.in[15] + l * 256; const float* r_k = F.in[16] + l * 256;
        const size_t AS = (size_t)NTOK * 256;
        for (int it = ggrp(F); it < NTOK * 4; it += ngrp()) {
            const int n = it >> 2, h = it & 3, s = n % SEQ;
            const bf16* z = hz + (size_t)n * 1024;
            const bool hp = s > 0, hn = s < SEQ - 1;
            auto shifted = [&](int c) -> float {
                const float zc = bf2f(z[c]);
                const float zp = hp ? bf2f(z[c - 1024]) : 0.f, zn = hn ? bf2f(z[c + 1024]) : 0.f;
                return zc + mup[c] * (zp - zc) + mun[c] * (zn - zc);
            };
            float kkv[PER64], rr[PER64], kd0[PER64], kd1[PER64], aa0[PER64], aa1[PER64];
            float ss = 0.f, bs = 0.f;
            for (int i = 0; i < PER64; ++i) {
                const int j = glane(F) + i * GRP, c = h * 64 + j;
                const float r = shifted(c), k = shifted(256 + c), v = shifted(512 + c);
                float wr0 = w0[c], wr1 = w0[256 + c], ar0 = a0[c], ar1 = a0[256 + c], g = 0.f;
                for (int q = 0; q < 32; ++q) {
                    wr0 += tanhf(shifted(768 + q)) * w2[(size_t)q * 256 + c];
                    wr1 += tanhf(shifted(800 + q)) * w2[(size_t)(32 + q) * 256 + c];
                    ar0 += shifted(832 + q) * a2[(size_t)q * 256 + c];
                    ar1 += shifted(864 + q) * a2[(size_t)(32 + q) * 256 + c];
                }
                for (int q = 0; q < 64; ++q) g += sigmoidf_(shifted(896 + q)) * g2[(size_t)q * 256 + c];
                const float dec0 = expf(-DECAY_SCALE * sigmoidf_(wr0)), dec1 = expf(-DECAY_SCALE * sigmoidf_(wr1));
                const float A0 = sigmoidf_(ar0), A1 = sigmoidf_(ar1);
                const float kk = k * k_k[c];
                kkv[i] = kk; ss += kk * kk; rr[i] = r; aa0[i] = A0; aa1[i] = A1;
                kd0[i] = k * (1.0f + (A0 - 1.0f) * k_a[c]); kd1[i] = k * (1.0f + (A1 - 1.0f) * k_a[c]);
                bs += r * (kd0[i] + kd1[i]) * r_k[c];
                const size_t o = (size_t)n * 256 + c;
                r7[R_R * AS + o] = f2bf(r); r7[R_V * AS + o] = f2bf(v);
                r7[R_W0 * AS + o] = f2bf(dec0); r7[R_W1 * AS + o] = f2bf(dec1);
                r7[R_KD0 * AS + o] = f2bf(kd0[i]); r7[R_KD1 * AS + o] = f2bf(kd1[i]);
                gb[o] = f2bf(g);
            }
            ss = grp_sum(F, ss); bs = grp_sum(F, bs);
            const float inv = 1.0f / fmaxf(sqrtf(ss), 1e-12f);
            for (int i = 0; i < PER64; ++i) {
                const int j = glane(F) + i * GRP, c = h * 64 + j; const size_t o = (size_t)n * 256 + c;
                const float kk = kkv[i] * inv;
                r7[R_KK * AS + o] = f2bf(kk); r7[R_AK0 * AS + o] = f2bf(aa0[i] * kk); r7[R_AK1 * AS + o] = f2bf(aa1[i] * kk);
            }
            if (glane(F) == 0) bonus[(size_t)n * 4 + h] = bs;
        }
    }
    {
        bf16* hh = WSP(bf16, OFF_HHGRN);
        const float* lg = F.in[19];
        for (size_t i = gtid_(F); i < (size_t)NTOK * 768; i += gthreads()) {
            const int n = (int)(i / 768), c = (int)(i % 768);
            bf16* p = hh + (size_t)n * 1280 + c;
            const float x = bf2f(*p);
            if (c < 256) { *p = f2bf(siluf_(x)); }
            else {
                const int d = c & 255;
                float lb = 0.f;
                if (l == 1) { const float a = lg[d], b = lg[256 + d]; const float m = fmaxf(a, b); const float ea = expf(a - m), eb = expf(b - m); lb = eb / (ea + eb); }
                *p = f2bf((1.0f - lb) * sigmoidf_(-x));
            }
        }
    }
}

struct EpiQMla {
    bf16* q; int row0, pn;
    DI void operator()(int r, int c, float a, float b, float cc, float d) const {
        const int row = row0 + r, col = pn * 256 + c;
        if (col >= 384) return;
        const int w = col % 96;
        if (w >= 64) {
            const int s = row % SEQ;
#pragma unroll
            for (int t = 0; t < 2; ++t) {
                const int m = ((w - 64) >> 1) + t;
                const float pos = m < 8 ? (float)(s / GRIDW) : (float)(s % GRIDW);
                const float ang = pos * rope_inv(2 * (m & 7), 16);
                const float cs = cosf(ang), sn = sinf(ang);
                float& x1 = t ? cc : a; float& x2 = t ? d : b;
                const float y1 = x1 * cs - x2 * sn, y2 = x1 * sn + x2 * cs; x1 = y1; x2 = y2;
            }
        }
        st_bf16x4(q + (size_t)row * 384 + col, a, b, cc, d);
    }
};
struct EpiKVMla {
    bf16* kn; bf16* vt; int row0, pn;
    DI void operator()(int r, int c, float a, float b, float cc, float d) const {
        const int row = row0 + r, col = pn * 256 + c, h = col >> 7, w = col & 127;
        if (w < 64) st_bf16x4(kn + (size_t)row * 256 + h * 64 + w, a, b, cc, d);
        else { const int bb = row / SEQ, s = row % SEQ; bf16* p = vt + ((size_t)bb * 256 + h * 64 + (w - 64)) * SEQ + s;
            p[0] = f2bf(a); p[SEQ] = f2bf(b); p[2 * SEQ] = f2bf(cc); p[3 * SEQ] = f2bf(d); }
    }
};
DI void phase_mlaup(const Frame& F) {
    const bf16* hm = WSP(bf16, OFF_HMLA); const char* wts = (const char*)WSP(bf16, OFF_WTS);
    const int nM = (NTOK + 255) / 256;
    for (int u = blockIdx.x; u < nM * 4; u += gridDim.x) {
        const int pm = u >> 2, j = u & 3;
#ifdef CPU_EMU
        const int mr = min(256, NTOK - pm * 256);
#define MR , mr
#else
#define MR
#endif
        if (j < 2) { EpiQMla E{WSP(bf16, OFF_QMLA), pm * 256, j};
            gemm_unit(F, hm, 512, nullptr, pm * 256, (const bf16*)(wts + W_UQ_T), 256, j * 256, 256, E MR); }
        else { EpiKVMla E{WSP(bf16, OFF_KNOPE), WSP(bf16, OFF_VTMLA), pm * 256, j - 2};
            gemm_unit(F, hm + 256, 512, nullptr, pm * 256, (const bf16*)(wts + W_UKV_T), 256, (j - 2) * 256, 256, E MR); }
    }
}

struct AttnDesc {
    const bf16* q; int q_stride;
    int q_hstride;
    const bf16* k; int k_stride; int k_hstride;
    const bf16* k2; int k2_stride;
    int dk_main;
    const bf16* vt;
    bf16* o; int o_stride; int o_hstride;
    int H, HKV, SQ, SK;
    float scale;
};

#ifdef CPU_EMU
template <int DK, int DV>
void attn_phase(const Frame& F, const AttnDesc& A) {
    const int G = A.H / A.HKV;
    float* sc = (float*)malloc(sizeof(float) * A.SK);
    for (int b = 0; b < BATCH; ++b) for (int h = 0; h < A.H; ++h) for (int s = 0; s < A.SQ; ++s) {
        const int kv = h / G;
        const bf16* q = A.q + (size_t)(b * A.SQ + s) * A.q_stride + h * A.q_hstride;
        float mx = -1e30f;
        for (int key = 0; key < A.SK; ++key) {
            const bf16* kp = A.k + (size_t)(b * A.SK + key) * A.k_stride + kv * A.k_hstride;
            double acc = 0;
            for (int d = 0; d < DK; ++d) {
                float kvl = d < A.dk_main ? bf2f(kp[d]) : bf2f(A.k2[(size_t)(b * A.SK + key) * A.k2_stride + d - A.dk_main]);
                acc += (double)bf2f(q[d]) * kvl;
            }
            sc[key] = (float)acc * A.scale; mx = fmaxf(mx, sc[key]);
        }
        double sum = 0; for (int key = 0; key < A.SK; ++key) { sc[key] = expf(sc[key] - mx); sum += sc[key]; }
        for (int dv = 0; dv < DV; ++dv) {
            const bf16* vp = A.vt + ((size_t)(b * A.HKV + kv) * DV + dv) * A.SK;
            double acc = 0; for (int key = 0; key < A.SK; ++key) acc += (double)bf2f(f2bf(sc[key])) * bf2f(vp[key]);
            A.o[(size_t)(b * A.SQ + s) * A.o_stride + h * A.o_hstride + dv] = f2bf((float)(acc / sum));
        }
    }
    free(sc);
}
#else
DI int crow16(int reg, int h) { return (reg & 3) + 8 * (reg >> 2) + 4 * h; }
template <int DK, int DV, int DVT>
DI void attn_phase(const Frame& F, const AttnDesc& A) {
    constexpr int KP = DK + 8;
    constexpr int VP = 64 + 8;
    constexpr int NPASS = DV / DVT;
    bf16* Ks = (bf16*)F.smem;
    bf16* Vs = Ks + 64 * KP;
    const int tid = F.tid, wave = tid >> 6, lane = tid & 63, r = lane & 31, hh = lane >> 5;
    const int G = A.H / A.HKV;
    const int nqb = A.SQ / 256;
    const int nunit = BATCH * A.H * nqb * NPASS;
    const float sl2 = A.scale * 1.4426950408889634f;
    for (int u = blockIdx.x; u < nunit; u += gridDim.x) {
        int t = u; const int pass = t % NPASS; t /= NPASS; const int qb = t % nqb; t /= nqb; const int h = t % A.H; const int b = t / A.H;
        const int kv = h / G;
        const int q0 = qb * 256 + wave * 32;
        bf16x8 qf[DK / 16];
        { const bf16* qp = A.q + (size_t)(b * A.SQ + q0 + r) * A.q_stride + h * A.q_hstride + 8 * hh;
#pragma unroll
          for (int ks = 0; ks < DK / 16; ++ks) qf[ks] = *reinterpret_cast<const bf16x8*>(qp + 16 * ks); }
        f32x16 oacc[DVT / 32];
#pragma unroll
        for (int i = 0; i < DVT / 32; ++i)
#pragma unroll
            for (int j = 0; j < 16; ++j) oacc[i][j] = 0.f;
        float mrun = -INFINITY, lrun = 0.f;
        for (int kt = 0; kt < A.SK / 64; ++kt) {
            __syncthreads();
            for (int c = tid; c < 64 * (DK / 8); c += 512) {
                const int key = c / (DK / 8), d8 = (c % (DK / 8)) * 8;
                const size_t krow = (size_t)(b * A.SK + kt * 64 + key);
                uint4 v;
                if (d8 < A.dk_main) v = *reinterpret_cast<const uint4*>(A.k + krow * A.k_stride + kv * A.k_hstride + d8);
                else v = *reinterpret_cast<const uint4*>(A.k2 + krow * A.k2_stride + (d8 - A.dk_main));
                *reinterpret_cast<uint4*>(Ks + key * KP + d8) = v;
            }
            for (int c = tid; c < DVT * 8; c += 512) {
                const int dv = c >> 3, k8 = (c & 7) * 8;
                const uint4 v = *reinterpret_cast<const uint4*>(A.vt + ((size_t)(b * A.HKV + kv) * DV + pass * DVT + dv) * A.SK + kt * 64 + k8);
                *reinterpret_cast<uint4*>(Vs + dv * VP + k8) = v;
            }
            __syncthreads();
            f32x16 sacc[2];
#pragma unroll
            for (int kb = 0; kb < 2; ++kb) {
#pragma unroll
                for (int j = 0; j < 16; ++j) sacc[kb][j] = 0.f;
#pragma unroll
                for (int ks = 0; ks < DK / 16; ++ks) {
                    const bf16x8 kf = *reinterpret_cast<const bf16x8*>(Ks + (kb * 32 + r) * KP + 16 * ks + 8 * hh);
                    sacc[kb] = __builtin_amdgcn_mfma_f32_32x32x16_bf16(kf, qf[ks], sacc[kb], 0, 0, 0);
                }
            }
            float mx = -INFINITY;
#pragma unroll
            for (int kb = 0; kb < 2; ++kb)
#pragma unroll
                for (int j = 0; j < 16; ++j) mx = fmaxf(mx, sacc[kb][j]);
            mx = fmaxf(mx, shfl_xor(F, mx, 32));
            const float mnew = fmaxf(mrun, mx * sl2);
            const float alpha = exp2f(mrun - mnew);
            mrun = mnew;
            float psum = 0.f;
#pragma unroll
            for (int kb = 0; kb < 2; ++kb)
#pragma unroll
                for (int j = 0; j < 16; ++j) { const float p = exp2f(sacc[kb][j] * sl2 - mnew); sacc[kb][j] = p; psum += p; }
            lrun = lrun * alpha + psum;
#pragma unroll
            for (int i = 0; i < DVT / 32; ++i)
#pragma unroll
                for (int j = 0; j < 16; ++j) oacc[i][j] *= alpha;
#pragma unroll
            for (int kb = 0; kb < 2; ++kb)
#pragma unroll
                for (int s2 = 0; s2 < 2; ++s2) {
                    union { bf16x8 v; unsigned u[4]; } pf;
#pragma unroll
                    for (int j = 0; j < 4; ++j) pf.u[j] = pack_bf16(sacc[kb][8 * s2 + 2 * j], sacc[kb][8 * s2 + 2 * j + 1]);
#pragma unroll
                    for (int i = 0; i < DVT / 32; ++i) {
                        const bf16* vp = Vs + (i * 32 + r) * VP + kb * 32 + 16 * s2 + 4 * hh;
                        union { bf16x8 v; bf16x4 h2[2]; } vf;
                        vf.h2[0] = *reinterpret_cast<const bf16x4*>(vp);
                        vf.h2[1] = *reinterpret_cast<const bf16x4*>(vp + 8);
                        oacc[i] = __builtin_amdgcn_mfma_f32_32x32x16_bf16(vf.v, pf.v, oacc[i], 0, 0, 0);
                    }
                }
        }
        lrun += shfl_xor(F, lrun, 32);
        const float inv = 1.0f / lrun;
        bf16* op = A.o + (size_t)(b * A.SQ + q0 + r) * A.o_stride + h * A.o_hstride + pass * DVT;
#pragma unroll
        for (int i = 0; i < DVT / 32; ++i)
#pragma unroll
            for (int g = 0; g < 4; ++g)
                st_bf16x4(op + i * 32 + 8 * g + 4 * hh, oacc[i][4 * g] * inv, oacc[i][4 * g + 1] * inv, oacc[i][4 * g + 2] * inv, oacc[i][4 * g + 3] * inv);
    }
}
#endif

DI AttnDesc desc_gqa(const Frame& F) {
    AttnDesc A; A.q = WSP(bf16, OFF_HATT); A.q_stride = 512; A.q_hstride = 64;
    A.k = WSP(bf16, OFF_HATT) + 256; A.k_stride = 512; A.k_hstride = 64; A.k2 = nullptr; A.k2_stride = 0; A.dk_main = 64;
    A.vt = WSP(bf16, OFF_VTATT); A.o = WSP(bf16, OFF_YCAT); A.o_stride = 1024; A.o_hstride = 64;
    A.H = 4; A.HKV = 2; A.SQ = SEQ; A.SK = SEQ; A.scale = 0.125f; return A;
}
DI AttnDesc desc_mla(const Frame& F) {
    AttnDesc A; A.q = WSP(bf16, OFF_QMLA); A.q_stride = 384; A.q_hstride = 96;
    A.k = WSP(bf16, OFF_KNOPE); A.k_stride = 256; A.k_hstride = 64; A.k2 = WSP(bf16, OFF_KROPE); A.k2_stride = 32; A.dk_main = 64;
    A.vt = WSP(bf16, OFF_VTMLA); A.o = WSP(bf16, OFF_YCAT) + 768; A.o_stride = 1024; A.o_hstride = 64;
    A.H = 4; A.HKV = 4; A.SQ = SEQ; A.SK = SEQ; A.scale = 0.10206207261596575f; return A;
}
DI AttnDesc desc_mem(const Frame& F) {
    AttnDesc A; A.q = WSP(bf16, OFF_QMEM); A.q_stride = 1024; A.q_hstride = 256;
    A.k = WSP(bf16, OFF_KMEM); A.k_stride = 1024; A.k_hstride = 256; A.k2 = nullptr; A.k2_stride = 0; A.dk_main = 256;
    A.vt = WSP(bf16, OFF_VTMEM); A.o = WSP(bf16, OFF_OMEM); A.o_stride = 1024; A.o_hstride = 256;
    A.H = 4; A.HKV = 4; A.SQ = SEQ; A.SK = MEMT; A.scale = 0.0625f; return A;
}

DI void phase_scans(const Frame& F) {
    bf16* r7 = WSP(bf16, OFF_R7); const size_t AS = (size_t)NTOK * 256;
    bf16* hh = WSP(bf16, OFF_HHGRN);
    const int nitem = 2 * BATCH * 4 * 64 * 2;
    for (int it = wave_item_index(F); it < nitem; it += gthreads()) {
        const int kind = it / (2 * BATCH * 4 * 64);
        int c = (it % (2 * BATCH * 4 * 64)) / 64; const int i = it % 64;
        const int d = c / (BATCH * 4); c %= BATCH * 4; const int b = c / 4, h = c % 4;
        float S[64];
#pragma unroll
        for (int j = 0; j < 64; ++j) S[j] = 0.f;
        if (kind == 0) {
            const bf16* pr = r7 + R_R * AS, *pv = r7 + R_V * AS, *pkk = r7 + R_KK * AS;
            bf16* pw = r7 + (d ? R_W1 : R_W0) * AS; const bf16* pkd = r7 + (d ? R_KD1 : R_KD0) * AS, *pak = r7 + (d ? R_AK1 : R_AK0) * AS;
            for (int t = 0; t < SEQ; ++t) {
                const int s = d ? SEQ - 1 - t : t;
                const size_t o = ((size_t)(b * SEQ + s)) * 256 + h * 64;
                const float v = bf2f(pv[o + i]);
                float sa = 0.f;
#pragma unroll
                for (int j = 0; j < 64; ++j) sa += S[j] * bf2f(pkk[o + j]);
                float y = 0.f;
#pragma unroll
                for (int j = 0; j < 64; ++j) {
                    S[j] = S[j] * bf2f(pw[o + j]) - sa * bf2f(pak[o + j]) + v * bf2f(pkd[o + j]);
                    y += S[j] * bf2f(pr[o + j]);
                }
#ifndef CPU_EMU
                __builtin_amdgcn_wave_barrier();
#endif
#ifdef CPU_EMU
                WSP(bf16, OFF_EMU_SCAN)[(size_t)d * AS + (size_t)(b * SEQ + s) * 256 + h * 64 + i] = f2bf(y);
#else
                pw[o + i] = f2bf(y);
#endif
            }
        } else {
            const bf16* pq = hh; bf16* pk = hh + 256 + d * 256; const bf16* pi = hh + 768;
            for (int t = 0; t < SEQ; ++t) {
                const int s = d ? SEQ - 1 - t : t;
                const size_t o = ((size_t)(b * SEQ + s)) * 1280 + h * 64;
                const float v = bf2f(pi[o + i]);
                float acc = 0.f;
#pragma unroll
                for (int j = 0; j < 64; ++j) {
                    const float k = bf2f(pk[o + j]);
                    S[j] = S[j] + k * (v - S[j]);
                    acc += S[j] * bf2f(pq[o + j]);
                }
#ifndef CPU_EMU
                __builtin_amdgcn_wave_barrier();
#endif
#ifdef CPU_EMU
                WSP(bf16, OFF_EMU_SCAN)[(size_t)(2 + d) * AS + (size_t)(b * SEQ + s) * 256 + h * 64 + i] = f2bf(acc);
#else
                pk[o + i] = f2bf(acc);
#endif
            }
        }
    }
}

DI void phase_fin(const Frame& F, int l) {
    const bf16* r7 = WSP(bf16, OFF_R7); const size_t AS = (size_t)NTOK * 256;
    const bf16* gb = WSP(bf16, OFF_G); const float* bonus = WSP(float, OFF_BONUS);
    const bf16* hh = WSP(bf16, OFF_HHGRN); bf16* ycat = WSP(bf16, OFF_YCAT);
    const float* gng = F.in[17] + l * 256; const float* gnb = F.in[18] + l * 256; const float* hng = F.in[20] + l * 256;
    for (int it = ggrp(F); it < NTOK * 8; it += ngrp()) {
        const int n = it >> 3, kind = (it >> 2) & 1, h = it & 3;
        float v[PER64];
        if (kind == 0) {
            float s1 = 0.f;
            for (int i = 0; i < PER64; ++i) { const int c = h * 64 + glane(F) + i * GRP; const size_t o = (size_t)n * 256 + c;
#ifdef CPU_EMU
                v[i] = bf2f(WSP(bf16, OFF_EMU_SCAN)[o]) + bf2f(WSP(bf16, OFF_EMU_SCAN)[AS + o]); s1 += v[i]; }
#else
                v[i] = bf2f(r7[R_W0 * AS + o]) + bf2f(r7[R_W1 * AS + o]); s1 += v[i]; }
#endif
            s1 = grp_sum(F, s1); const float mu = s1 * (1.0f / 64.0f);
            float s2 = 0.f; for (int i = 0; i < PER64; ++i) { const float dd = v[i] - mu; s2 += dd * dd; }
            s2 = grp_sum(F, s2); const float rs = 1.0f / sqrtf(s2 * (1.0f / 64.0f) + GN_EPS);
            const float bo = bonus[(size_t)n * 4 + h];
            for (int i = 0; i < PER64; ++i) { const int c = h * 64 + glane(F) + i * GRP; const size_t o = (size_t)n * 256 + c;
                const float y = (v[i] - mu) * rs * gng[c] + gnb[c];
                ycat[(size_t)n * 1024 + 256 + c] = f2bf((y + bo * bf2f(r7[R_V * AS + o])) * bf2f(gb[o])); }
        } else {
            float s2 = 0.f;
            for (int i = 0; i < PER64; ++i) { const int c = h * 64 + glane(F) + i * GRP; const size_t o = (size_t)n * 1280 + c;
#ifdef CPU_EMU
                const size_t oe = (size_t)n * 256 + c;
                v[i] = bf2f(WSP(bf16, OFF_EMU_SCAN)[2 * AS + oe]) + bf2f(WSP(bf16, OFF_EMU_SCAN)[3 * AS + oe]); s2 += v[i] * v[i]; }
#else
                v[i] = bf2f(hh[o + 256]) + bf2f(hh[o + 512]); s2 += v[i] * v[i]; }
#endif
            s2 = grp_sum(F, s2); const float rs = 1.0f / sqrtf(s2 * (1.0f / 64.0f) + RMS_EPS);
            for (int i = 0; i < PER64; ++i) { const int c = h * 64 + glane(F) + i * GRP; const size_t o = (size_t)n * 1280 + c;
                ycat[(size_t)n * 1024 + 512 + c] = f2bf(v[i] * rs * hng[c] * siluf_(bf2f(hh[o + 1024]))); }
        }
    }
}

struct EpiResid {
    float* xf; int row0, pn;
    DI void operator()(int r, int c, float a, float b, float cc, float d) const {
        float* p = xf + (size_t)(row0 + r) * DM + pn * 256 + c;
#ifndef CPU_EMU
        float4 x = *reinterpret_cast<float4*>(p);
        x.x = DN_ALPHA * x.x + a; x.y = DN_ALPHA * x.y + b; x.z = DN_ALPHA * x.z + cc; x.w = DN_ALPHA * x.w + d;
        *reinterpret_cast<float4*>(p) = x;
#else
        p[0] = DN_ALPHA * p[0] + a; p[1] = DN_ALPHA * p[1] + b; p[2] = DN_ALPHA * p[2] + cc; p[3] = DN_ALPHA * p[3] + d;
#endif
    }
};
struct EpiBf {
    bf16* o; int ld; int row0, pn;
    DI void operator()(int r, int c, float a, float b, float cc, float d) const { st_bf16x4(o + (size_t)(row0 + r) * ld + pn * 256 + c, a, b, cc, d); }
};
template <int MODE>
DI void phase_gemm_sq(const Frame& F, const bf16* A, size_t woff, bf16* outb) {
    const bf16* W = (const bf16*)((const char*)WSP(bf16, OFF_WTS) + woff);
    const int nM = (NTOK + 255) / 256;
    for (int u = blockIdx.x; u < nM * 4; u += gridDim.x) {
        const int pm = u >> 2, pn = u & 3;
#ifdef CPU_EMU
        const int mr = min(256, NTOK - pm * 256);
#endif
        if (MODE == 0) { EpiResid E{F.xf, pm * 256, pn}; gemm_unit(F, A, 1024, nullptr, pm * 256, W, 1024, pn * 256, 1024, E MR); }
        else { EpiBf E{outb, 1024, pm * 256, pn}; gemm_unit(F, A, 1024, nullptr, pm * 256, W, 1024, pn * 256, 1024, E MR); }
    }
}

DI void phase_ln(const Frame& F, const float* g, const float* b) {
    const float* xf = F.xf;
    layer_norm_rows(F, g, b, [&](int row, int c) { return xf[(size_t)row * DM + c]; }, false, nullptr);
}

DI void phase_route(const Frame& F, int l) {
    const float* xf = F.xf;
    const float* wg = F.in[33] + (size_t)l * 1024 * 4; const float* bg = F.in[34] + l * 4;
    const float* we = F.in[35] + (size_t)l * 1024 * 32; const float* be = F.in[36] + l * 32;
    int* counts = (int*)(F.ws + CTL_CNT) + l * 32;
    int* lists = WSP(int, OFF_LISTS); float* tinfo = WSP(float, OFF_TINFO);
    for (int row = ggrp(F); row < NTOK; row += ngrp()) {
        float gl[4] = {0.f, 0.f, 0.f, 0.f};
        for (int i = 0; i < PERLN; ++i) { const int c = glane(F) + i * GRP; const float x = xf[(size_t)row * DM + c];
#pragma unroll
            for (int q = 0; q < 4; ++q) gl[q] += x * wg[c * 4 + q]; }
#pragma unroll
        for (int q = 0; q < 4; ++q) gl[q] = grp_sum(F, gl[q]) + bg[q];
        int gi = 0; float gm = gl[0];
#pragma unroll
        for (int q = 1; q < 4; ++q) if (gl[q] > gm) { gm = gl[q]; gi = q; }
        float den = 0.f;
#pragma unroll
        for (int q = 0; q < 4; ++q) den += expf(gl[q] - gm);
        const float pgroup = 1.0f / den;
        float el[8] = {0.f, 0.f, 0.f, 0.f, 0.f, 0.f, 0.f, 0.f};
        for (int i = 0; i < PERLN; ++i) { const int c = glane(F) + i * GRP; const float x = xf[(size_t)row * DM + c];
#pragma unroll
            for (int q = 0; q < 8; ++q) el[q] += x * we[c * 32 + gi * 8 + q]; }
#pragma unroll
        for (int q = 0; q < 8; ++q) el[q] = grp_sum(F, el[q]) + be[gi * 8 + q];
        int i0 = 0; float v0 = el[0];
#pragma unroll
        for (int q = 1; q < 8; ++q) if (el[q] > v0) { v0 = el[q]; i0 = q; }
        int i1 = -1; float v1 = -INFINITY;
#pragma unroll
        for (int q = 0; q < 8; ++q) if (q != i0 && el[q] > v1) { v1 = el[q]; i1 = q; }
        const float e1 = expf(v1 - v0); const float g0 = pgroup / (1.0f + e1), g1 = pgroup * e1 / (1.0f + e1);
        if (glane(F) == 0) {
            const int ea = gi * 8 + i0, eb = gi * 8 + i1;
            const int pa = atomicAdd(&counts[ea], 1), pb = atomicAdd(&counts[eb], 1);
            lists[(size_t)ea * NTOK + pa] = row; lists[(size_t)eb * NTOK + pb] = row;
            int* ti = (int*)(tinfo + (size_t)row * 8);
            ti[0] = ea; ti[1] = pa; ti[2] = eb; ti[3] = pb; tinfo[(size_t)row * 8 + 4] = g0; tinfo[(size_t)row * 8 + 5] = g1;
        }
    }
}

struct EpiMoeUp {
    bf16* hm; int row0, pn;
    DI void operator()(int r, int c, float a, float b, float cc, float d) const {
        bf16* p = hm + (size_t)(row0 + r) * 256 + ((pn * 256 + c) >> 1);
        p[0] = f2bf(siluf_(a) * b); p[1] = f2bf(siluf_(cc) * d);
    }
};
DI int ld_cnt(const int* p) {
#ifdef CPU_EMU
    return *p;
#else
    return __hip_atomic_load(p, __ATOMIC_RELAXED, __HIP_MEMORY_SCOPE_AGENT);
#endif
}
DI void moe_tiles(const int* counts, int* toff  ) {
    __syncthreads();
    if (threadIdx.x == 0) { int acc = 0; for (int e = 0; e < NEXP; ++e) { toff[e] = acc; acc += (ld_cnt(counts + e) + 255) >> 8; } toff[NEXP] = acc; }
    __syncthreads();
}
DI void phase_moe_up(const Frame& F, int l) {
    const int* counts = (const int*)(F.ws + CTL_CNT) + l * 32;
    int* eoff = (int*)(F.ws + CTL_EOFF) + l * 33;
    int* rowmap = (int*)(F.smem + 131072);
    int* toff = rowmap + 256;
    moe_tiles(counts, toff);
    if (blockIdx.x == 0 && threadIdx.x == 0) for (int e = 0; e <= NEXP; ++e) eoff[e] = toff[e] * 256;
    const int* lists = WSP(int, OFF_LISTS); const bf16* xb = WSP(bf16, OFF_XB);
    const int nunit = toff[NEXP] * 2;
    for (int u = blockIdx.x; u < nunit; u += gridDim.x) {
        const int tile = u >> 1, pn = u & 1;
        int e = 0; while (toff[e + 1] <= tile) ++e;
        const int t0 = (tile - toff[e]) * 256, cnt = ld_cnt(counts + e);
        __syncthreads();
        for (int i = fresh_tid(F); i < 256; i += NTH) rowmap[i] = (t0 + i < cnt) ? lists[(size_t)e * NTOK + t0 + i] : 0;
        __syncthreads();
        EpiMoeUp E{WSP(bf16, OFF_HM), tile * 256, pn};
        gemm_unit(F, xb, 1024, rowmap, 0, WSP(bf16, OFF_W13T) + (size_t)e * 512 * 1024, 1024, pn * 256, 1024, E);
    }
}
DI void phase_moe_down(const Frame& F, int l) {
    const int* counts = (const int*)(F.ws + CTL_CNT) + l * 32;
    int* toff = (int*)(F.smem + 131072) + 256;
    moe_tiles(counts, toff);
    const int nunit = toff[NEXP] * 4;
    for (int u = blockIdx.x; u < nunit; u += gridDim.x) {
        const int tile = u >> 2, pn = u & 3;
        int e = 0; while (toff[e + 1] <= tile) ++e;
        EpiBf E{WSP(bf16, OFF_YROWS), 1024, tile * 256, pn};
        gemm_unit(F, WSP(bf16, OFF_HM), 256, nullptr, tile * 256, WSP(bf16, OFF_W2T) + (size_t)e * 1024 * 256, 256, pn * 256, 256, E);
    }
}
DI void phase_ln3(const Frame& F, int l) {
    const float* xf = F.xf; const bf16* yr = WSP(bf16, OFF_YROWS); const float* tinfo = WSP(float, OFF_TINFO);
    const int* eoff = (const int*)(F.ws + CTL_EOFF) + l * 33;
    layer_norm_rows(F, F.in[40] + l * 1024, F.in[41] + l * 1024, [&](int row, int c) {
        const int* ti = (const int*)(tinfo + (size_t)row * 8);
        const size_t ra = (size_t)eoff[ti[0]] + ti[1], rb = (size_t)eoff[ti[2]] + ti[3];
        return DN_ALPHA * xf[(size_t)row * DM + c] + tinfo[(size_t)row * 8 + 4] * bf2f(yr[ra * 1024 + c]) + tinfo[(size_t)row * 8 + 5] * bf2f(yr[rb * 1024 + c]);
    }, false, nullptr);
}

#ifndef CPU_EMU
#define XB_TMO      128
#define XB_XCNT(j)  (256  + 64 * (j))
#define XB_XSUB(j)  (1280 + 64 * (j))
#define XB_XGEN(j)  (2304 + 64 * (j))
#define XB_TOP      3328
#define XB_TOPGEN   3392
#define XCD_BAR_WORDS 3456
#define XB_SPIN_CAP (1u << 18)
#define LAS __attribute__((address_space(3)))

__device__ __forceinline__ unsigned xb_ld(unsigned* p)              { return __hip_atomic_load(p, __ATOMIC_RELAXED, __HIP_MEMORY_SCOPE_AGENT); }
__device__ __forceinline__ unsigned xb_add(unsigned* p, unsigned v) { return __hip_atomic_fetch_add(p, v, __ATOMIC_RELAXED, __HIP_MEMORY_SCOPE_AGENT); }
__device__ __forceinline__ unsigned xb_xcc_id() { return (unsigned)__builtin_amdgcn_s_getreg((3 << 11) | 20) & 0xFu; }
#define XB_SPIN(cond, bar) do { unsigned _sp = 0; while (cond) { __builtin_amdgcn_s_sleep(1); \
    if ((++_sp & 255u) == 0u) { if (xb_ld(&(bar)[XB_TMO])) break; if (_sp > XB_SPIN_CAP) { atomicAdd(&(bar)[XB_TMO], 1u); break; } } } } while (0)

struct XcdBarrier {
    unsigned* bar; unsigned x;
    volatile LAS unsigned* st;
};

__device__ __forceinline__ XcdBarrier xcd_barrier_post(unsigned* bar, volatile LAS unsigned* st) {
    XcdBarrier b; b.bar = bar; b.x = xb_xcc_id(); b.st = st;
    if (threadIdx.x == 0) (void)xb_add(&bar[XB_XCNT(b.x)], 1u);
    return b;
}
__device__ __forceinline__ void xcd_barrier_complete(unsigned* bar, unsigned x, unsigned& nloc, unsigned& nx) {
    const unsigned G = gridDim.x * gridDim.y * gridDim.z;
    unsigned sum, cnt, mine, sp = 0u;
    for (;;) {
        sum = 0u; cnt = 0u; mine = 0u;
#pragma unroll
        for (unsigned j = 0; j < 16; ++j) { const unsigned c = xb_ld(&bar[XB_XCNT(j)]); sum += c; cnt += (c > 0u) ? 1u : 0u; mine = (j == x) ? c : mine; }
        if (sum == G) break;
        __builtin_amdgcn_s_sleep(1);
        if ((++sp & 255u) == 0u) { if (xb_ld(&bar[XB_TMO])) break; if (sp > XB_SPIN_CAP) { atomicAdd(&bar[XB_TMO], 1u); break; } }
    }
    nloc = mine > 0u ? mine : 1u; nx = cnt > 0u ? cnt : 1u;
}

__device__ __forceinline__ void xcd_barrier(const XcdBarrier& b) {
    asm volatile("s_waitcnt vmcnt(0)" ::: "memory");
    __syncthreads();
    if (threadIdx.x == 0) {
        unsigned* bar = b.bar;
        __builtin_amdgcn_s_waitcnt(0);
        unsigned nloc = b.st[0], nx = b.st[1];
        if (nloc == 0u) { xcd_barrier_complete(bar, b.x, nloc, nx); b.st[0] = nloc; b.st[1] = nx; }
        const unsigned old = xb_add(&bar[XB_XSUB(b.x)], 1u);
        const unsigned gen = old / nloc;
        if (old + 1u == (gen + 1u) * nloc) {
            __builtin_amdgcn_fence(__ATOMIC_RELEASE, "agent");
            asm volatile("s_waitcnt vmcnt(0)" ::: "memory");
            const unsigned og = xb_add(&bar[XB_TOP], 1u);
            const unsigned tg = og / nx;
            if (og + 1u == (tg + 1u) * nx) xb_add(&bar[XB_TOPGEN], 1u);
            else XB_SPIN(xb_ld(&bar[XB_TOPGEN]) == tg, bar);
            __builtin_amdgcn_fence(__ATOMIC_ACQUIRE, "agent");
            xb_add(&bar[XB_XGEN(b.x)], 1u);
            asm volatile("s_waitcnt vmcnt(0)" ::: "memory");
        } else {
            XB_SPIN(xb_ld(&bar[XB_XGEN(b.x)]) == gen, bar);
            __builtin_amdgcn_fence(__ATOMIC_ACQUIRE, "agent");
            asm volatile("s_waitcnt vmcnt(0)" ::: "memory");
        }
    }
    __syncthreads();
}

#endif

constexpr int NPH_LAYER = 16;
constexpr int NPH_TOTAL = 1 + 2 * NPH_LAYER;
constexpr int SMEM_BYTES = 131072 + 2048;

template <int K>
DI void run_layer_phase(const Frame& F, int l) {
    if constexpr (K == 0) phase_cvt(F, l);
    if constexpr (K == 1) phase_gemm1(F);
    if constexpr (K == 2) phase_prep(F, l);
    if constexpr (K == 3) phase_mlaup(F);
    if constexpr (K == 4) {
#ifdef CPU_EMU
        attn_phase<64, 64>(F, desc_gqa(F)); attn_phase<96, 64>(F, desc_mla(F));
#else
        attn_phase<64, 64, 64>(F, desc_gqa(F)); attn_phase<96, 64, 64>(F, desc_mla(F));
#endif
        phase_scans(F);
    }
    if constexpr (K == 5) phase_fin(F, l);
    if constexpr (K == 6) phase_gemm_sq<0>(F, WSP(bf16, OFF_YCAT), W_OUT_T, nullptr);
    if constexpr (K == 7) phase_ln(F, F.in[26] + l * 1024, F.in[27] + l * 1024);
    if constexpr (K == 8) phase_gemm_sq<1>(F, WSP(bf16, OFF_XB), W_Q_T, WSP(bf16, OFF_QMEM));
    if constexpr (K == 9) {
#ifdef CPU_EMU
        attn_phase<256, 256>(F, desc_mem(F));
#else
        attn_phase<256, 256, 128>(F, desc_mem(F));
#endif
    }
    if constexpr (K == 10) phase_gemm_sq<0>(F, WSP(bf16, OFF_OMEM), W_O_T, nullptr);
    if constexpr (K == 11) { phase_ln(F, F.in[31] + l * 1024, F.in[32] + l * 1024); phase_cvt_moe(F, l); }
    if constexpr (K == 12) phase_route(F, l);
    if constexpr (K == 13) phase_moe_up(F, l);
    if constexpr (K == 14) phase_moe_down(F, l);
    if constexpr (K == 15) phase_ln3(F, l);
}

#ifndef CPU_EMU
template <int K>
__global__ void __launch_bounds__(512, 2) k_phase(Args a, int l) {
    extern __shared__ __attribute__((aligned(16))) unsigned char lds[];
    Frame F; F.in = (InPtr)__builtin_amdgcn_kernarg_segment_ptr(); F.xf = a.out; F.ws = a.ws; F.smem = lds; F.tid = threadIdx.x; F.wv = __builtin_amdgcn_readfirstlane((int)(threadIdx.x >> 6));
    if constexpr (K < 0) phase_pro(F); else run_layer_phase<K>(F, l);
}

template <int K>
static void launch_phase(const Args& a, int l, int grid, hipStream_t stream) {
    static bool attr = false;
    if (!attr) { (void)hipFuncSetAttribute((const void*)k_phase<K>, hipFuncAttributeMaxDynamicSharedMemorySize, SMEM_BYTES); attr = true; }
    hipLaunchKernelGGL(k_phase<K>, dim3(grid), dim3(512), SMEM_BYTES, stream, a, l);
}

__global__ void __launch_bounds__(512, 2) fwd_one(Args a) {
    extern __shared__ __attribute__((aligned(16))) unsigned char lds[];
    const int wave_s = __builtin_amdgcn_readfirstlane((int)(threadIdx.x >> 6));
    volatile LAS unsigned* st = (volatile LAS unsigned*)(lds + SMEM_BYTES - 16);
    if (threadIdx.x == 0) { st[0] = 0u; st[1] = 0u; st[2] = 0u; st[3] = 0u; }
    __syncthreads();
    XcdBarrier bar = xcd_barrier_post((unsigned*)(a.ws + OFF_CTL), st);
    Frame F;
#define FRESH do { unsigned z_ = 0u, m_ = ~0u; int ws_ = wave_s; asm volatile("" : "+s"(z_), "+s"(ws_), "+s"(m_)); \
        int t_ = ws_ * 64 + (int)__builtin_amdgcn_mbcnt_hi(m_, __builtin_amdgcn_mbcnt_lo(m_, 0u)); asm volatile("" : "+v"(t_)); \
        const __attribute__((address_space(4))) char* kp_ = (const __attribute__((address_space(4))) char*)__builtin_amdgcn_kernarg_segment_ptr() + z_; \
        F.in = (InPtr)kp_; F.xf = *(float* const __attribute__((address_space(4)))*)(kp_ + 42 * 8); F.ws = *(unsigned char* const __attribute__((address_space(4)))*)(kp_ + 43 * 8); \
        F.smem = lds; F.tid = t_; F.wv = ws_; } while (0)
#define GB do { { unsigned zb_ = 0u; unsigned xx_ = __builtin_amdgcn_readfirstlane(bar.x); asm volatile("" : "+s"(zb_), "+s"(xx_)); bar.bar = (unsigned*)(a.ws + OFF_CTL) + zb_; bar.x = xx_; } \
        xcd_barrier(bar); } while (0)
    FRESH; phase_pro(F); FRESH; phase_cvt(F, 0); GB;
    for (int l = 0; l < 2; ++l) {
        FRESH; run_layer_phase<1>(F, l); GB;
        FRESH; run_layer_phase<2>(F, l); GB;
        FRESH; run_layer_phase<3>(F, l); GB;
        FRESH; run_layer_phase<4>(F, l); GB;
        FRESH; run_layer_phase<5>(F, l); GB;
        FRESH; run_layer_phase<6>(F, l); GB;
        FRESH; run_layer_phase<7>(F, l); GB;
        FRESH; run_layer_phase<8>(F, l); GB;
        FRESH; run_layer_phase<9>(F, l); GB;
        FRESH; run_layer_phase<10>(F, l); GB;
        FRESH; run_layer_phase<11>(F, l); FRESH; run_layer_phase<12>(F, l); if (l == 0) { FRESH; phase_cvt(F, 1); } GB;
        FRESH; run_layer_phase<13>(F, l); GB;
        FRESH; run_layer_phase<14>(F, l); GB;
        FRESH; run_layer_phase<15>(F, l); if (l == 0) GB;
    }
#undef GB
#undef FRESH
}

extern "C" void kernel_launch(void* const* d_in, const int* in_sizes, int n_in, void* d_out, int out_size, void* d_ws, size_t ws_size, hipStream_t stream) {
    if (n_in != 42 || ws_size < WS_END) return;
    Args a{};
    for (int i = 0; i < 42; ++i) a.in[i] = (const float*)d_in[i];
    a.out = (float*)d_out; a.ws = (unsigned char*)d_ws; a.ph_lo = 0; a.ph_hi = NPH_TOTAL;
    (void)hipMemsetAsync(d_ws, 0, CTL_BYTES, stream);
#if N_LAUNCH_MODE == 1
    static int grid = 0;
    if (!grid) {
        int dev = 0, cus = 0, per_cu = 0;
        (void)hipGetDevice(&dev);
        (void)hipDeviceGetAttribute(&cus, hipDeviceAttributeMultiprocessorCount, dev);
        (void)hipFuncSetAttribute((const void*)fwd_one, hipFuncAttributeMaxDynamicSharedMemorySize, SMEM_BYTES);
        (void)hipOccupancyMaxActiveBlocksPerMultiprocessor(&per_cu, (const void*)fwd_one, 512, SMEM_BYTES);
        (void)hipGetLastError();
        grid = cus > 0 ? cus : 256;
    }
    hipLaunchKernelGGL(fwd_one, dim3(grid), dim3(512), SMEM_BYTES, stream, a);
#else
    const int grid = 256;
    launch_phase<-1>(a, 0, grid, stream);
    for (int l = 0; l < 2; ++l) {
        launch_phase<0>(a, l, grid, stream); launch_phase<1>(a, l, grid, stream); launch_phase<2>(a, l, grid, stream); launch_phase<3>(a, l, grid, stream);
        launch_phase<4>(a, l, grid, stream); launch_phase<5>(a, l, grid, stream); launch_phase<6>(a, l, grid, stream); launch_phase<7>(a, l, grid, stream);
        launch_phase<8>(a, l, grid, stream); launch_phase<9>(a, l, grid, stream); launch_phase<10>(a, l, grid, stream); launch_phase<11>(a, l, grid, stream);
        launch_phase<12>(a, l, grid, stream); launch_phase<13>(a, l, grid, stream); launch_phase<14>(a, l, grid, stream); launch_phase<15>(a, l, grid, stream);
    }
#endif
}
#endif
```

```cpp
#ifndef CPU_EMU
#include <hip/hip_runtime.h>
#else
#include "emu_shim.h"
#endif
#include <stdint.h>

#ifndef CFG_B
#define CFG_B 16
#endif
#ifndef CFG_S
#define CFG_S 2048
#endif
#ifndef N_LAUNCH_MODE
#define N_LAUNCH_MODE 1
#endif

typedef unsigned short bf16;
#define DI __device__ __forceinline__

constexpr int BATCH = CFG_B, SEQ = CFG_S, NTOK = BATCH * SEQ, DM = 1024;
constexpr int MEMT = 256, NMEM = BATCH * MEMT;
constexpr int GRIDW = 64;
constexpr int HP = 3328;
constexpr int IN_WIDTH = 3104;
constexpr int NEXP = 32, MOEH = 256;
constexpr int MOE_ROWS = 2 * NTOK + NEXP * 256;
constexpr float LN_EPS = 1e-5f, RMS_EPS = 1e-6f, GN_EPS = 64e-5f;
constexpr float DN_ALPHA = 1.41421356237309515f;
constexpr float DECAY_SCALE = 0.60653065971263342f;

constexpr size_t AL(size_t x) { return (x + 255) & ~(size_t)255; }
constexpr size_t OFF_CTL = 0;
constexpr size_t CTL_BYTES = 32768;
constexpr size_t CTL_CNT = 16384;
constexpr size_t CTL_EOFF = 16384 + 1024;
constexpr size_t OFF_XB = AL(OFF_CTL + CTL_BYTES);
constexpr size_t SZ_XB = (size_t)NTOK * DM * 2;
constexpr size_t OFF_WTS = AL(OFF_XB + SZ_XB);
constexpr size_t W_IN_T = 0;
constexpr size_t W_UQ_T = W_IN_T + (size_t)HP * 1024 * 2;
constexpr size_t W_UKV_T = W_UQ_T + 512 * 256 * 2;
constexpr size_t W_OUT_T = W_UKV_T + 512 * 256 * 2;
constexpr size_t W_Q_T = W_OUT_T + 1024 * 1024 * 2;
constexpr size_t W_KV_T = W_Q_T + 1024 * 1024 * 2;
constexpr size_t W_O_T = W_KV_T + 2048 * 1024 * 2;
constexpr size_t SZ_WTS = W_O_T + 1024 * 1024 * 2;
constexpr size_t OFF_KMEM = AL(OFF_WTS + SZ_WTS);
constexpr size_t OFF_VTMEM = AL(OFF_KMEM + (size_t)NMEM * 1024 * 2);
constexpr size_t OFF_MEMB = AL(OFF_VTMEM + (size_t)NMEM * 1024 * 2);
constexpr size_t OFF_VTATT = AL(OFF_MEMB + (size_t)NMEM * 1024 * 2);
constexpr size_t OFF_VTMLA = AL(OFF_VTATT + (size_t)BATCH * 2 * 64 * SEQ * 2);
constexpr size_t OFF_HATT = AL(OFF_VTMLA + (size_t)BATCH * 4 * 64 * SEQ * 2);
constexpr size_t OFF_HMLA = OFF_HATT + (size_t)NTOK * 512 * 2;
constexpr size_t OFF_HRWKV = OFF_HMLA + (size_t)NTOK * 512 * 2;
constexpr size_t OFF_R7 = OFF_HRWKV + (size_t)NTOK * 1024 * 2;
constexpr size_t SZ_R7 = (size_t)NTOK * 9 * 256 * 2;
constexpr size_t OFF_HHGRN = OFF_R7 + SZ_R7;
constexpr size_t WS_END = OFF_HHGRN + (size_t)NTOK * 1280 * 2;

constexpr size_t OFF_QMLA = OFF_XB;
constexpr size_t OFF_KNOPE = OFF_QMLA + (size_t)NTOK * 384 * 2;
constexpr size_t OFF_KROPE = OFF_KNOPE + (size_t)NTOK * 256 * 2;
constexpr size_t OFF_G = OFF_KROPE + (size_t)NTOK * 32 * 2;
constexpr size_t OFF_BONUS = OFF_G + (size_t)NTOK * 256 * 2;
static_assert(OFF_BONUS + (size_t)NTOK * 16 <= OFF_XB + SZ_XB, "xb alias region");
constexpr size_t OFF_YCAT = OFF_HRWKV;
constexpr size_t OFF_QMEM = OFF_HATT;
constexpr size_t OFF_OMEM = OFF_R7;
#ifdef CPU_EMU
constexpr size_t OFF_EMU_SCAN = WS_END;
constexpr size_t OFF_LISTS = AL(OFF_EMU_SCAN + (size_t)4 * NTOK * 256 * 2);
#else
constexpr size_t OFF_LISTS = OFF_HATT;
#endif
constexpr size_t OFF_TINFO = OFF_LISTS + (size_t)NEXP * NTOK * 4;
constexpr size_t OFF_HM = AL(OFF_TINFO + (size_t)NTOK * 32);
constexpr size_t OFF_YROWS = AL(OFF_HM + (size_t)MOE_ROWS * 256 * 2);
#ifdef CPU_EMU
constexpr size_t OFF_W13T = AL(OFF_YROWS + (size_t)MOE_ROWS * 1024 * 2);
#else
static_assert(OFF_YROWS + (size_t)MOE_ROWS * 1024 * 2 <= OFF_HHGRN, "moe alias region");
constexpr size_t OFF_W13T = OFF_HHGRN;
#endif
constexpr size_t OFF_W2T = OFF_W13T + (size_t)NEXP * 512 * 1024 * 2;
#ifdef CPU_EMU
constexpr size_t WS_END_EMU = OFF_W2T + (size_t)NEXP * 1024 * 256 * 2;
#else
static_assert(OFF_W2T + (size_t)NEXP * 1024 * 256 * 2 <= WS_END, "moe weights alias");
#endif

enum { R_R = 0, R_V = 1, R_KK = 2, R_W0 = 3, R_W1 = 4, R_KD0 = 5, R_KD1 = 6, R_AK0 = 7, R_AK1 = 8 };

DI float bf2f(bf16 v) { union { unsigned u; float f; } x; x.u = (unsigned)v << 16; return x.f; }
DI bf16 f2bf(float f) { union { unsigned u; float f; } x; x.f = f; unsigned u = x.u; u += 0x7fffu + ((u >> 16) & 1u); return (bf16)(u >> 16); }
DI float sigmoidf_(float x) { return 1.0f / (1.0f + expf(-x)); }
DI float siluf_(float x) { return x * sigmoidf_(x); }

#ifdef CPU_EMU
typedef const float* const* InPtr;
#else
typedef const float* const __attribute__((address_space(4)))* InPtr;
#endif
struct Frame {
    InPtr in;
    float* xf;
    unsigned char* ws;
    unsigned char* smem;
    int tid;
    int wv;
};
#ifdef CPU_EMU
constexpr int NTH = 1;
#else
constexpr int NTH = 512;
#endif
#ifdef CPU_EMU
constexpr int GRP = 1;
DI float grp_sum(const Frame& F, float v) { return v; }
DI int gthreads() { return 1; }
DI int gtid_(const Frame& F) { return 0; }
DI int wave_item_index(const Frame& F) { return 0; }
#else
constexpr int GRP = 64;
DI float shfl_idx(const Frame& F, float v, int src_lane) { return __builtin_bit_cast(float, __builtin_amdgcn_ds_bpermute(src_lane << 2, __builtin_bit_cast(int, v))); }
DI float shfl_xor(const Frame& F, float v, int mask) { return shfl_idx(F, v, (F.tid & 63) ^ mask); }
DI float grp_sum(const Frame& F, float v) {
#pragma unroll
    for (int o = 32; o > 0; o >>= 1) v += shfl_xor(F, v, o);
    return v;
}
DI int gthreads() { return gridDim.x * NTH; }
DI int gtid_(const Frame& F) { return blockIdx.x * NTH + F.tid; }
DI int wave_item_index(const Frame& F) { return (int)(((F.tid >> 6) * gridDim.x + blockIdx.x) * 64 + (F.tid & 63)); }
#endif
constexpr int PER64 = 64 / GRP;
constexpr int PERLN = 1024 / GRP;
DI int fresh_tid(const Frame& F) {
#ifdef CPU_EMU
    return 0;
#else
    unsigned m0 = ~0u; asm volatile("" : "+s"(m0));
    int t = F.wv * 64 + (int)__builtin_amdgcn_mbcnt_hi(m0, __builtin_amdgcn_mbcnt_lo(m0, 0u)); asm volatile("" : "+v"(t)); return t;
#endif
}
DI int glane(const Frame& F) { return (int)(F.tid % GRP); }
DI int ggrp(const Frame& F) { return gtid_(F) / GRP; }
DI int ngrp() { return gthreads() / GRP; }

struct Args {
    const float* in[42];
    float* out;
    unsigned char* ws;
    int ph_lo, ph_hi;
};

DI float rope_inv(int f, int nf) { return powf(10000.0f, -(float)f / (float)nf); }

#ifndef CPU_EMU
using bf16x8 = __attribute__((ext_vector_type(8))) short;
using bf16x4 = __attribute__((ext_vector_type(4))) short;
using f32x4 = __attribute__((ext_vector_type(4))) float;
using f32x16 = __attribute__((ext_vector_type(16))) float;
typedef __bf16 bf16v2 __attribute__((ext_vector_type(2)));
typedef float f32v2 __attribute__((ext_vector_type(2)));
DI unsigned pack_bf16(float lo, float hi) { f32v2 v = {lo, hi}; bf16v2 b = __builtin_convertvector(v, bf16v2); return __builtin_bit_cast(unsigned, b); }

constexpr int G_BM = 256, G_BK = 64, G_HALF = 128, G_HT = G_HALF * G_BK, G_SHM = 8 * G_HT * 2;
DI int g_lds_byte(int r, int c) { int st = (r >> 4) * 2 + (c >> 5), rr = r & 15, cc = c & 31, ob = rr * 64 + cc * 2; return st * 1024 + (ob ^ (((ob >> 9) & 1) << 5)); }
DI void g_stage_rc(int b, int& R, int& C) { int st = b / 1024, sb = b % 1024, swz = sb ^ (((sb >> 9) & 1) << 5); R = (st >> 1) * 16 + swz / 64; C = (st & 1) * 32 + (swz % 64) / 2; }

template <bool GATHER, class Epi>
DI void gemm_unit_t(int wv_in, bf16* shm, const bf16* __restrict__ A, int lda, const int* rowmap, int arow0,
                    const bf16* __restrict__ Bt, int ldb, int bcol0, int K, const Epi& epi) {
#define SA(b, h) (shm + ((b) * 2 + (h)) * G_HT)
#define SB(b, h) (shm + (4 + (b) * 2 + (h)) * G_HT)
#define STAGE_AX(T, P, hf, kt) do { for (int _i = 0; _i < 2; ++_i) { int _b = (T) * 16 + _i * 8192; int _r, _c; g_stage_rc(_b, _r, _c); \
        const long _row = GATHER ? (long)rowmap[(hf) * G_HALF + _r] : (long)(arow0 + (hf) * G_HALF + _r); \
        __builtin_amdgcn_global_load_lds((const unsigned*)(A + _row * lda + (long)(kt) * G_BK + _c), (unsigned*)((char*)(P) + _b), 16, 0, 0); } } while (0)
#define STAGE_BX(T, P, hf, kt) do { for (int _i = 0; _i < 2; ++_i) { int _b = (T) * 16 + _i * 8192; int _r, _c; g_stage_rc(_b, _r, _c); \
        __builtin_amdgcn_global_load_lds((const unsigned*)(Bt + (long)(bcol0 + (hf) * G_HALF + _r) * ldb + (long)(kt) * G_BK + _c), (unsigned*)((char*)(P) + _b), 16, 0, 0); } } while (0)
#define STAGE_A(P, hf, kt) STAGE_AX(t0, P, hf, kt)
#define STAGE_B(P, hf, kt) STAGE_BX(t0, P, hf, kt)
#define LDA(dst, b, h) for (int m = 0; m < 4; ++m) for (int k = 0; k < 2; ++k) \
        dst[m][k] = *reinterpret_cast<const bf16x8*>((char*)SA(b, h) + g_lds_byte(wr * 64 + m * 16 + fr, k * 32 + fq * 8))
#define LDB(dst, b, h) for (int n = 0; n < 2; ++n) for (int k = 0; k < 2; ++k) \
        dst[n][k] = *reinterpret_cast<const bf16x8*>((char*)SB(b, h) + g_lds_byte(wc * 32 + n * 16 + fr, k * 32 + fq * 8))
#define MMA(ai, bj, At, Bt_) do { __builtin_amdgcn_s_setprio(1); \
        for (int m = 0; m < 4; ++m) for (int n = 0; n < 2; ++n) for (int k = 0; k < 2; ++k) \
            acc[ai][bj][m][n] = __builtin_amdgcn_mfma_f32_16x16x32_bf16(Bt_[n][k], At[m][k], acc[ai][bj][m][n], 0, 0, 0); \
        __builtin_amdgcn_s_setprio(0); } while (0)
#define WAIT_V(n) asm volatile("s_waitcnt vmcnt(" #n ")" ::: "memory")
#define WAIT_L(n) asm volatile("s_waitcnt lgkmcnt(" #n ")" ::: "memory")
#define BAR __builtin_amdgcn_s_barrier()
#define SCHED __builtin_amdgcn_sched_barrier(0)
    unsigned m0 = ~0u; asm volatile("" : "+s"(m0));
    int t0 = wv_in * 64 + (int)__builtin_amdgcn_mbcnt_hi(m0, __builtin_amdgcn_mbcnt_lo(m0, 0u)); asm volatile("" : "+v"(t0));
    int wid = t0 >> 6, lane = t0 & 63, wr = wid >> 2, wc = wid & 3, fr = lane & 15, fq = lane >> 4;
    f32x4 acc[2][2][4][2] = {};
    bf16x8 At[4][2], B0[2][2], B1[2][2];
    const int nt = K / G_BK;
    STAGE_B(SB(0, 0), 0, 0); STAGE_A(SA(0, 0), 0, 0);
    STAGE_B(SB(0, 1), 1, 0); STAGE_A(SA(0, 1), 1, 0);
    if (wr == 1) BAR;
    WAIT_V(4); BAR;
    STAGE_B(SB(1, 0), 0, 1); STAGE_A(SA(1, 0), 0, 1); STAGE_B(SB(1, 1), 1, 1);
    WAIT_V(6); BAR;
    for (int t = 0; t < nt - 2; t += 2) {
        LDB(B0, 0, 0); SCHED; LDA(At, 0, 0); STAGE_A(SA(1, 1), 1, t + 1);
        WAIT_L(8); BAR; WAIT_L(0); MMA(0, 0, At, B0); BAR; SCHED;
        LDB(B1, 0, 1); STAGE_B(SB(0, 0), 0, t + 2);
        BAR; WAIT_L(0); MMA(0, 1, At, B1); BAR;
        LDA(At, 0, 1); STAGE_A(SA(0, 0), 0, t + 2);
        BAR; WAIT_L(0); MMA(1, 0, At, B0); BAR; SCHED;
        STAGE_B(SB(0, 1), 1, t + 2);
        WAIT_V(6); BAR; MMA(1, 1, At, B1); BAR;
        LDB(B0, 1, 0); SCHED; LDA(At, 1, 0); STAGE_A(SA(0, 1), 1, t + 2);
        WAIT_L(8); BAR; WAIT_L(0); MMA(0, 0, At, B0); BAR; SCHED;
        LDB(B1, 1, 1); STAGE_B(SB(1, 0), 0, t + 3);
        BAR; WAIT_L(0); MMA(0, 1, At, B1); BAR;
        LDA(At, 1, 1); STAGE_A(SA(1, 0), 0, t + 3);
        BAR; WAIT_L(0); MMA(1, 0, At, B0); BAR; SCHED;
        STAGE_B(SB(1, 1), 1, t + 3);
        WAIT_V(6); BAR; MMA(1, 1, At, B1); BAR;
    }
    int tz = t0; asm volatile("" : "+v"(tz)); wid = tz >> 6; lane = tz & 63; wr = wid >> 2; wc = wid & 3; fr = lane & 15; fq = lane >> 4;
    { LDB(B0, 0, 0); WAIT_V(0); LDA(At, 0, 0); STAGE_AX(tz, SA(1, 1), 1, nt - 1);
      BAR; WAIT_L(0); MMA(0, 0, At, B0); BAR;
      LDB(B1, 0, 1); BAR; WAIT_L(0); MMA(0, 1, At, B1); BAR;
      LDA(At, 0, 1); WAIT_V(4); BAR; WAIT_L(0); MMA(1, 0, At, B0); MMA(1, 1, At, B1); BAR; }
    { LDB(B0, 1, 0); LDA(At, 1, 0); WAIT_V(2); BAR; WAIT_L(0); MMA(0, 0, At, B0); BAR;
      LDB(B1, 1, 1); WAIT_V(0); BAR; WAIT_L(0); MMA(0, 1, At, B1); BAR;
      LDA(At, 1, 1); BAR; WAIT_L(0); MMA(1, 0, At, B0); MMA(1, 1, At, B1); BAR; }
    if (wr == 0) BAR;
#pragma unroll
    for (int ai = 0; ai < 2; ++ai)
#pragma unroll
        for (int m = 0; m < 4; ++m)
#pragma unroll
            for (int bj = 0; bj < 2; ++bj)
#pragma unroll
                for (int n = 0; n < 2; ++n) {
                    const f32x4 v = acc[ai][bj][m][n];
                    epi(ai * G_HALF + wr * 64 + m * 16 + fr, bj * G_HALF + wc * 32 + n * 16 + fq * 4, v[0], v[1], v[2], v[3]);
                }
#undef SA
#undef SB
#undef STAGE_A
#undef STAGE_B
#undef STAGE_AX
#undef STAGE_BX
#undef LDA
#undef LDB
#undef MMA
}
template <class Epi>
DI void gemm_unit(const Frame& F, const bf16* __restrict__ A, int lda, const int* rowmap, int arow0,
                  const bf16* __restrict__ Bt, int ldb, int bcol0, int K, const Epi& epi) {
    if (rowmap) gemm_unit_t<true>(F.wv, (bf16*)F.smem, A, lda, rowmap, arow0, Bt, ldb, bcol0, K, epi);
    else gemm_unit_t<false>(F.wv, (bf16*)F.smem, A, lda, rowmap, arow0, Bt, ldb, bcol0, K, epi);
}
#else
template <class Epi>
void gemm_unit(const Frame& F, const bf16* A, int lda, const int* rowmap, int arow0, const bf16* Bt, int ldb, int bcol0, int K, const Epi& epi, int mrows = 256) {
    for (int r = 0; r < mrows; ++r) {
        int arow = rowmap ? rowmap[r] : arow0 + r;
        for (int c = 0; c < 256; c += 4) {
            float v[4];
            for (int q = 0; q < 4; ++q) {
                double s = 0; const bf16* a = A + (long)arow * lda; const bf16* b = Bt + (long)(bcol0 + c + q) * ldb;
                for (int k = 0; k < K; ++k) s += (double)bf2f(a[k]) * bf2f(b[k]);
                v[q] = (float)s;
            }
            epi(r, c, v[0], v[1], v[2], v[3]);
        }
    }
}
#endif

DI void st_bf16x4(bf16* p, float a, float b, float c, float d) {
#ifndef CPU_EMU
    uint2 u; u.x = pack_bf16(a, b); u.y = pack_bf16(c, d); *reinterpret_cast<uint2*>(p) = u;
#else
    p[0] = f2bf(a); p[1] = f2bf(b); p[2] = f2bf(c); p[3] = f2bf(d);
#endif
}

#define WSP(T, off) ((T*)(F.ws + (off)))

DI void ln_row_write(float* xrow, bf16* brow, const float* vals_in  , const float* g, const float* b);

template <class Fn>
DI void layer_norm_rows(const Frame& F, const float* g, const float* b, Fn pre, bool write_out_extra, float* extra) {
    float* xf = F.xf; bf16* xb = WSP(bf16, OFF_XB);
    for (int row = ggrp(F); row < NTOK; row += ngrp()) {
        float v[PERLN]; float s = 0.f;
        for (int i = 0; i < PERLN; ++i) { int c = glane(F) + i * GRP; v[i] = pre(row, c); s += v[i]; }
        s = grp_sum(F, s); const float mu = s * (1.0f / 1024.0f);
        float q = 0.f;
        for (int i = 0; i < PERLN; ++i) { float d = v[i] - mu; q += d * d; }
        q = grp_sum(F, q); const float rs = 1.0f / sqrtf(q * (1.0f / 1024.0f) + LN_EPS);
        for (int i = 0; i < PERLN; ++i) { int c = glane(F) + i * GRP; float y = (v[i] - mu) * rs * g[c] + b[c];
            xf[(size_t)row * DM + c] = y; xb[(size_t)row * DM + c] = f2bf(y); if (write_out_extra) extra[(size_t)row * DM + c] = y; }
    }
}

DI void phase_pro(const Frame& F) {
    const float* x = F.in[0]; const float* mem = F.in[1];
    layer_norm_rows(F, F.in[2], F.in[3], [&](int row, int c) { return x[(size_t)row * DM + c]; }, false, nullptr);
    bf16* memb = WSP(bf16, OFF_MEMB);
    for (size_t i = gtid_(F); i < (size_t)NMEM * DM; i += gthreads()) memb[i] = f2bf(mem[i]);
}

template <class Src>
DI void cvt_transpose(const Frame& F, bf16* dst, int Nn, int Kk, Src src) {
#ifdef CPU_EMU
    for (int n = 0; n < Nn; ++n) for (int k = 0; k < Kk; ++k) dst[(size_t)n * Kk + k] = f2bf(src(k, n));
#else
    float* tile = (float*)F.smem;
    const int tn = Nn / 64, tk = Kk / 64, ntile = tn * tk;
    for (int t = blockIdx.x; t < ntile; t += gridDim.x) {
        const int n0 = (t % tn) * 64, k0 = (t / tn) * 64;
        __syncthreads();
        for (int i = F.tid; i < 4096; i += NTH) { int k = i >> 6, n = i & 63; tile[k * 65 + n] = src(k0 + k, n0 + n); }
        __syncthreads();
        for (int i = F.tid; i < 4096; i += NTH) { int n = i >> 6, k = i & 63; dst[(size_t)(n0 + n) * Kk + k0 + k] = f2bf(tile[k * 65 + n]); }
    }
#endif
}

DI int win_src_col(int n) {
    if (n < 512) return n;
    if (n < 1536) { int c = n - 512; return c < 960 ? 512 + c : -1; }
    if (n < 2816) return 1472 + (n - 1536);
    int c = n - 2816;
    if (c < 192) return 2752 + c;
    if (c < 224) return 2752 + 320 + (c - 192);
    if (c < 256) return -1;
    if (c < 384) return 2752 + 192 + (c - 256);
    return -1;
}
DI int wuq_src_col(int n) {
    if (n >= 384) return -1;
    int h = n / 96, w = n % 96;
    if (w < 64) return h * 96 + w;
    int p = w - 64, m = p >> 1, which = p & 1;
    int i = (m < 8 ? m : 16 + (m - 8)) + (which ? 8 : 0);
    return h * 96 + 64 + i;
}

DI void phase_cvt(const Frame& F, int l) {
    bf16* wts = WSP(bf16, OFF_WTS);
    { const float* w = F.in[4] + (size_t)l * 1024 * IN_WIDTH;
      cvt_transpose(F, (bf16*)((char*)wts + W_IN_T), HP, 1024, [&](int k, int n) { int s = win_src_col(n); return s < 0 ? 0.f : w[(size_t)k * IN_WIDTH + s]; }); }
    { const float* w = F.in[23] + (size_t)l * 192 * 384;
      cvt_transpose(F, (bf16*)((char*)wts + W_UQ_T), 512, 256, [&](int k, int n) { int s = wuq_src_col(n); return (s < 0 || k >= 192) ? 0.f : w[(size_t)k * 384 + s]; }); }
    { const float* w = F.in[24] + (size_t)l * 128 * 512;
      cvt_transpose(F, (bf16*)((char*)wts + W_UKV_T), 512, 256, [&](int k, int n) { return k >= 128 ? 0.f : w[(size_t)k * 512 + n]; }); }
    { const float* w = F.in[25] + (size_t)l * 1024 * 1024;
      cvt_transpose(F, (bf16*)((char*)wts + W_OUT_T), 1024, 1024, [&](int k, int n) { return w[(size_t)k * 1024 + n]; }); }
    { const float* w = F.in[28] + (size_t)l * 1024 * 1024;
      cvt_transpose(F, (bf16*)((char*)wts + W_Q_T), 1024, 1024, [&](int k, int n) { return w[(size_t)k * 1024 + n]; }); }
    { const float* w = F.in[29] + (size_t)l * 1024 * 2048;
      cvt_transpose(F, (bf16*)((char*)wts + W_KV_T), 2048, 1024, [&](int k, int n) { return w[(size_t)k * 2048 + n]; }); }
    { const float* w = F.in[30] + (size_t)l * 1024 * 1024;
      cvt_transpose(F, (bf16*)((char*)wts + W_O_T), 1024, 1024, [&](int k, int n) { return w[(size_t)k * 1024 + n]; }); }
}

DI void phase_cvt_moe(const Frame& F, int l) {
    for (int e = 0; e < NEXP; ++e) {
        const float* w1 = F.in[37] + ((size_t)l * NEXP + e) * 1024 * 256;
        const float* w3 = F.in[38] + ((size_t)l * NEXP + e) * 1024 * 256;
        const float* w2 = F.in[39] + ((size_t)l * NEXP + e) * 256 * 1024;
        cvt_transpose(F, WSP(bf16, OFF_W13T) + (size_t)e * 512 * 1024, 512, 1024,
                      [&](int k, int n) { return (n & 1) ? w3[(size_t)k * 256 + (n >> 1)] : w1[(size_t)k * 256 + (n >> 1)]; });
        cvt_transpose(F, WSP(bf16, OFF_W2T) + (size_t)e * 1024 * 256, 1024, 256, [&](int k, int n) { return w2[(size_t)k * 1024 + n]; });
    }
}

struct EpiH {
    bf16* hatt; bf16* hrwkv; bf16* hhgrn; bf16* hmla; int row0, pn;
    DI void operator()(int r, int c, float a, float b, float cc, float d) const {
        const size_t row = row0 + r;
        bf16* p;
        if (pn < 2) p = hatt + row * 512 + pn * 256 + c;
        else if (pn < 6) p = hrwkv + row * 1024 + (pn - 2) * 256 + c;
        else if (pn < 11) p = hhgrn + row * 1280 + (pn - 6) * 256 + c;
        else p = hmla + row * 512 + (pn - 11) * 256 + c;
        st_bf16x4(p, a, b, cc, d);
    }
};
struct EpiKV {
    bf16* kmem; bf16* vt; int row0, pn;
    DI void operator()(int r, int c, float a, float b, float cc, float d) const {
        const int row = row0 + r, col = pn * 256 + c;
        if (col < 1024) { st_bf16x4(kmem + (size_t)row * 1024 + col, a, b, cc, d); }
        else { const int bb = row / MEMT, key = row % MEMT, hc = col - 1024;
            bf16* p = vt + ((size_t)bb * 1024 + hc) * MEMT + key;
            p[0] = f2bf(a); p[MEMT] = f2bf(b); p[2 * MEMT] = f2bf(cc); p[3 * MEMT] = f2bf(d); }
    }
};

DI void phase_gemm1(const Frame& F) {
    const bf16* xb = WSP(bf16, OFF_XB); const bf16* wts = WSP(bf16, OFF_WTS);
    const int nM = (NTOK + 255) / 256, nN = HP / 256, n1 = nM * nN;
    const int nMk = (NMEM + 255) / 256, nNk = 8, n2 = nMk * nNk;
    for (int u = blockIdx.x; u < n1 + n2; u += gridDim.x) {
        if (u < n1) {
            const int pm = u / nN, pn = u % nN;
            EpiH E{WSP(bf16, OFF_HATT), WSP(bf16, OFF_HRWKV), WSP(bf16, OFF_HHGRN), WSP(bf16, OFF_HMLA), pm * 256, pn};
#ifdef CPU_EMU
            gemm_unit(F, xb, 1024, nullptr, pm * 256, (const bf16*)((const char*)wts + W_IN_T), 1024, pn * 256, 1024, E, min(256, NTOK - pm * 256));
#else
            gemm_unit(F, xb, 1024, nullptr, pm * 256, (const bf16*)((const char*)wts + W_IN_T), 1024, pn * 256, 1024, E);
#endif
        } else {
            const int v = u - n1, pm = v / nNk, pn = v % nNk;
            EpiKV E{WSP(bf16, OFF_KMEM), WSP(bf16, OFF_VTMEM), pm * 256, pn};
            gemm_unit(F, WSP(bf16, OFF_MEMB), 1024, nullptr, pm * 256, (const bf16*)((const char*)wts + W_KV_T), 1024, pn * 256, 1024, E);
        }
    }
}


#ifndef CPU_EMU
DI float fast_sigmoid(float x) { return 1.0f / (1.0f + __expf(-x)); }
DI float fast_tanh(float x) { const float e = __expf(2.0f * x); return 1.0f - 2.0f / (e + 1.0f); }
DI void prep_rwkv_gpu(const Frame& F, int l) {
    const bf16* hz = WSP(bf16, OFF_HRWKV); bf16* r7 = WSP(bf16, OFF_R7); bf16* gb = WSP(bf16, OFF_G); float* bonus = WSP(float, OFF_BONUS);
    const float* mup = F.in[7] + l * 960; const float* mun = F.in[8] + l * 960;
    const float* w0 = F.in[9] + l * 512; const float* w2 = F.in[10] + (size_t)l * 2 * 32 * 256;
    const float* a0 = F.in[11] + l * 512; const float* a2 = F.in[12] + (size_t)l * 2 * 32 * 256;
    const float* g2 = F.in[13] + (size_t)l * 64 * 256;
    const float* k_k = F.in[14] + l * 256; const float* k_a = F.in[15] + l * 256; const float* r_k = F.in[16] + l * 256;
    const size_t AS = (size_t)NTOK * 256;
    float* zs = (float*)F.smem;
    const int tid = F.tid;
    for (int tile = blockIdx.x; tile < NTOK / 16; tile += gridDim.x) {
        const int n0 = tile * 16;
        __syncthreads();
        for (int e = tid; e < 16 * 480; e += NTH) {
            const int t = e / 480, c = (e % 480) * 2, n = n0 + t, s = n % SEQ;
            const unsigned zc = *reinterpret_cast<const unsigned*>(hz + (size_t)n * 1024 + c);
            const unsigned zp = s > 0 ? *reinterpret_cast<const unsigned*>(hz + (size_t)(n - 1) * 1024 + c) : 0u;
            const unsigned zn = s < SEQ - 1 ? *reinterpret_cast<const unsigned*>(hz + (size_t)(n + 1) * 1024 + c) : 0u;
#pragma unroll
            for (int q = 0; q < 2; ++q) {
                const float z = q ? __uint_as_float(zc & 0xffff0000u) : __uint_as_float(zc << 16);
                const float p = q ? __uint_as_float(zp & 0xffff0000u) : __uint_as_float(zp << 16);
                const float nx = q ? __uint_as_float(zn & 0xffff0000u) : __uint_as_float(zn << 16);
                float v = z + mup[c + q] * (p - z) + mun[c + q] * (nx - z);
                const int cc = c + q;
                if (cc >= 768 && cc < 832) v = fast_tanh(v);
                else if (cc >= 896) v = fast_sigmoid(v);
                zs[t * 960 + cc] = v;
            }
        }
        __syncthreads();
        const int c = tid & 255, tg = tid >> 8;
        float wr0[8], wr1[8], ar0[8], ar1[8], gg[8];
#pragma unroll
        for (int t = 0; t < 8; ++t) { wr0[t] = w0[c]; wr1[t] = w0[256 + c]; ar0[t] = a0[c]; ar1[t] = a0[256 + c]; gg[t] = 0.f; }
        for (int q = 0; q < 32; q += 4) {
            float wa[4], wb[4], aa[4], ab[4];
#pragma unroll
            for (int u = 0; u < 4; ++u) { wa[u] = w2[(size_t)(q + u) * 256 + c]; wb[u] = w2[(size_t)(32 + q + u) * 256 + c]; aa[u] = a2[(size_t)(q + u) * 256 + c]; ab[u] = a2[(size_t)(32 + q + u) * 256 + c]; }
#pragma unroll
            for (int t = 0; t < 8; ++t) {
                const float* zr = zs + (tg * 8 + t) * 960;
                const float4 x0 = *reinterpret_cast<const float4*>(zr + 768 + q), x1 = *reinterpret_cast<const float4*>(zr + 800 + q);
                const float4 y0 = *reinterpret_cast<const float4*>(zr + 832 + q), y1 = *reinterpret_cast<const float4*>(zr + 864 + q);
                wr0[t] += x0.x * wa[0] + x0.y * wa[1] + x0.z * wa[2] + x0.w * wa[3];
                wr1[t] += x1.x * wb[0] + x1.y * wb[1] + x1.z * wb[2] + x1.w * wb[3];
                ar0[t] += y0.x * aa[0] + y0.y * aa[1] + y0.z * aa[2] + y0.w * aa[3];
                ar1[t] += y1.x * ab[0] + y1.y * ab[1] + y1.z * ab[2] + y1.w * ab[3];
            }
        }
        for (int q = 0; q < 64; q += 4) {
            float ga[4];
#pragma unroll
            for (int u = 0; u < 4; ++u) ga[u] = g2[(size_t)(q + u) * 256 + c];
#pragma unroll
            for (int t = 0; t < 8; ++t) {
                const float4 x = *reinterpret_cast<const float4*>(zs + (tg * 8 + t) * 960 + 896 + q);
                gg[t] += x.x * ga[0] + x.y * ga[1] + x.z * ga[2] + x.w * ga[3];
            }
        }
        const float kkc = k_k[c], kac = k_a[c], rkc = r_k[c];
#pragma unroll
        for (int t = 0; t < 8; ++t) {
            const int n = n0 + tg * 8 + t; const float* zr = zs + (tg * 8 + t) * 960;
            const float r = zr[c], k = zr[256 + c], v = zr[512 + c];
            const float dec0 = __expf(-DECAY_SCALE * fast_sigmoid(wr0[t])), dec1 = __expf(-DECAY_SCALE * fast_sigmoid(wr1[t]));
            const float A0 = fast_sigmoid(ar0[t]), A1 = fast_sigmoid(ar1[t]);
            const float kk = k * kkc;
            const float kd0 = k * (1.0f + (A0 - 1.0f) * kac), kd1 = k * (1.0f + (A1 - 1.0f) * kac);
            const float ss = grp_sum(F, kk * kk);
            const float bs = grp_sum(F, r * (kd0 + kd1) * rkc);
            const float kkn = kk * (1.0f / fmaxf(sqrtf(ss), 1e-12f));
            const size_t o = (size_t)n * 256 + c;
            r7[R_R * AS + o] = f2bf(r); r7[R_V * AS + o] = f2bf(v);
            r7[R_W0 * AS + o] = f2bf(dec0); r7[R_W1 * AS + o] = f2bf(dec1);
            r7[R_KD0 * AS + o] = f2bf(kd0); r7[R_KD1 * AS + o] = f2bf(kd1);
            r7[R_KK * AS + o] = f2bf(kkn); r7[R_AK0 * AS + o] = f2bf(A0 * kkn); r7[R_AK1 * AS + o] = f2bf(A1 * kkn);
            gb[o] = f2bf(gg[t]);
            if ((tid & 63) == 0) bonus[(size_t)n * 4 + (c >> 6)] = bs;
        }
    }
}
#endif

DI void phase_prep(const Frame& F, int l) {
    {
        bf16* hatt = WSP(bf16, OFF_HATT); bf16* vt = WSP(bf16, OFF_VTATT);
        const float* qn = F.in[5] + l * 64; const float* kn = F.in[6] + l * 64;
        const int nitem = NTOK * 6;
        for (int it = ggrp(F); it < nitem; it += ngrp()) {
            const int n = it / 6, hh = it % 6;
            const int s = n % SEQ;
            bf16* p = hatt + (size_t)n * 512 + hh * 64;
            const float* gn = hh < 4 ? qn : kn;
            float v[PER64]; float ss = 0.f;
            for (int i = 0; i < PER64; ++i) { int j = glane(F) + i * GRP; v[i] = bf2f(p[j]); ss += v[i] * v[i]; }
            ss = grp_sum(F, ss); const float rs = 1.0f / sqrtf(ss * (1.0f / 64.0f) + RMS_EPS);
            float o[PER64];
#ifdef CPU_EMU
            float nv[64]; for (int j = 0; j < 64; ++j) nv[j] = v[j] * rs * gn[j];
#endif
            for (int i = 0; i < PER64; ++i) {
                int j = glane(F) + i * GRP;
                const int half = j >> 5, w = j & 31, f = w & 15, second = w >> 4;
                const float pos = half == 0 ? (float)(s / GRIDW) : (float)(s % GRIDW);
                const float ang = pos * rope_inv(2 * f, 32);
                const float cs = cosf(ang), sn = sinf(ang);
                const float mine = v[i] * rs * gn[j];
                const int jp = second ? j - 16 : j + 16;
#ifdef CPU_EMU
                const float partner = nv[jp];
#else
                const float partner = shfl_idx(F, v[0], jp) * rs * gn[jp];
#endif
                o[i] = second ? (partner * sn + mine * cs) : (mine * cs - partner * sn);
            }
            for (int i = 0; i < PER64; ++i) { int j = glane(F) + i * GRP; p[j] = f2bf(o[i]); }
        }
        for (size_t i = gtid_(F); i < (size_t)NTOK * 128; i += gthreads()) {
            const int n = (int)(i / 128), c = (int)(i % 128), b = n / SEQ, s = n % SEQ;
            vt[((size_t)b * 128 + c) * SEQ + s] = hatt[(size_t)n * 512 + 384 + c];
        }
    }
    {
        bf16* hm = WSP(bf16, OFF_HMLA); bf16* kr = WSP(bf16, OFF_KROPE);
        const float* qn = F.in[21] + l * 192; const float* kvn = F.in[22] + l * 128;
        for (int it = ggrp(F); it < NTOK * 2; it += ngrp()) {
            const int n = it >> 1, which = it & 1;
            bf16* p = hm + (size_t)n * 512 + (which ? 256 : 0);
            const int len = which ? 128 : 192; const float* gn = which ? kvn : qn;
            float ss = 0.f;
            for (int j = glane(F); j < len; j += GRP) { float x = bf2f(p[j]); ss += x * x; }
            ss = grp_sum(F, ss); const float rs = 1.0f / sqrtf(ss / (float)len + RMS_EPS);
            for (int j = glane(F); j < len; j += GRP) p[j] = f2bf(bf2f(p[j]) * rs * gn[j]);
        }
        for (int i = gtid_(F); i < NTOK * 16; i += gthreads()) {
            const int n = i >> 4, m = i & 15, s = n % SEQ;
            const bf16* src = hm + (size_t)n * 512 + 192;
            const int i1 = (m < 8 ? m : 16 + (m - 8)), i2 = i1 + 8;
            const float x1 = bf2f(src[i1]), x2 = bf2f(src[i2]);
            const float pos = m < 8 ? (float)(s / GRIDW) : (float)(s % GRIDW);
            const float ang = pos * rope_inv(2 * (m & 7), 16);
            const float cs = cosf(ang), sn = sinf(ang);
            kr[(size_t)n * 32 + 2 * m] = f2bf(x1 * cs - x2 * sn);
            kr[(size_t)n * 32 + 2 * m + 1] = f2bf(x1 * sn + x2 * cs);
        }
    }
#ifdef CPU_EMU
    {
        const bf16* hz = WSP(bf16, OFF_HRWKV); bf16* r7 = WSP(bf16, OFF_R7); bf16* gb = WSP(bf16, OFF_G); float* bonus = WSP(float, OFF_BONUS);
        const float* mup = F.in[7] + l * 960; const float* mun = F.in[8] + l * 960;
        const float* w0 = F.in[9] + l * 512; const float* w2 = F.in[10] + (size_t)l * 2 * 32 * 256;
        const float* a0 = F.in[11] + l * 512; const float* a2 = F.in[12] + (size_t)l * 2 * 32 * 256;
        const float* g2 = F.in[13] + (size_t)l * 64 * 256;
        const float* k_k = F.in[14] + l * 256; const float* k_a = F.in[15] + l * 256; const float* r_k = F.in[16] + l * 256;
        const size_t AS = (size_t)NTOK * 256;
        for (int it = ggrp(F); it < NTOK * 4; it += ngrp()) {
            const int n = it >> 2, h = it & 3, s = n % SEQ;
            const bf16* z = hz + (size_t)n * 1024;
            const bool hp = s > 0, hn = s < SEQ - 1;
            auto shifted = [&](int c) -> float {
                const float zc = bf2f(z[c]);
                const float zp = hp ? bf2f(z[c - 1024]) : 0.f, zn = hn ? bf2f(z[c + 1024]) : 0.f;
                return zc + mup[c] * (zp - zc) + mun[c] * (zn - zc);
            };
            float kkv[PER64], rr[PER64], kd0[PER64], kd1[PER64], aa0[PER64], aa1[PER64];
            float ss = 0.f, bs = 0.f;
            for (int i = 0; i < PER64; ++i) {
                const int j = glane(F) + i * GRP, c = h * 64 + j;
                const float r = shifted(c), k = shifted(256 + c), v = shifted(512 + c);
                float wr0 = w0[c], wr1 = w0[256 + c], ar0 = a0[c], ar1 = a0[256 + c], g = 0.f;
                for (int q = 0; q < 32; ++q) {
                    wr0 += tanhf(shifted(768 + q)) * w2[(size_t)q * 256 + c];
                    wr1 += tanhf(shifted(800 + q)) * w2[(size_t)(32 + q) * 256 + c];
                    ar0 += shifted(832 + q) * a2[(size_t)q * 256 + c];
                    ar1 += shifted(864 + q) * a2[(size_t)(32 + q) * 256 + c];
                }
                for (int q = 0; q < 64; ++q) g += sigmoidf_(shifted(896 + q)) * g2[(size_t)q * 256 + c];
                const float dec0 = expf(-DECAY_SCALE * sigmoidf_(wr0)), dec1 = expf(-DECAY_SCALE * sigmoidf_(wr1));
                const float A0 = sigmoidf_(ar0), A1 = sigmoidf_(ar1);
                const float kk = k * k_k[c];
                kkv[i] = kk; ss += kk * kk; rr[i] = r; aa0[i] = A0; aa1[i] = A1;
                kd0[i] = k * (1.0f + (A0 - 1.0f) * k_a[c]); kd1[i] = k * (1.0f + (A1 - 1.0f) * k_a[c]);
                bs += r * (kd0[i] + kd1[i]) * r_k[c];
                const size_t o = (size_t)n * 256 + c;
                r7[R_R * AS + o] = f2bf(r); r7[R_V * AS + o] = f2bf(v);
                r7[R_W0 * AS + o] = f2bf(dec0); r7[R_W1 * AS + o] = f2bf(dec1);
                r7[R_KD0 * AS + o] = f2bf(kd0[i]); r7[R_KD1 * AS + o] = f2bf(kd1[i]);
                gb[o] = f2bf(g);
            }
            ss = grp_sum(F, ss); bs = grp_sum(F, bs);
            const float inv = 1.0f / fmaxf(sqrtf(ss), 1e-12f);
            for (int i = 0; i < PER64; ++i) {
                const int j = glane(F) + i * GRP, c = h * 64 + j; const size_t o = (size_t)n * 256 + c;
                const float kk = kkv[i] * inv;
                r7[R_KK * AS + o] = f2bf(kk); r7[R_AK0 * AS + o] = f2bf(aa0[i] * kk); r7[R_AK1 * AS + o] = f2bf(aa1[i] * kk);
            }
            if (glane(F) == 0) bonus[(size_t)n * 4 + h] = bs;
        }
    }
#else
    prep_rwkv_gpu(F, l);
#endif
    {
        bf16* hh = WSP(bf16, OFF_HHGRN);
        const float* lg = F.in[19];
        for (size_t i = gtid_(F); i < (size_t)NTOK * 768; i += gthreads()) {
            const int n = (int)(i / 768), c = (int)(i % 768);
            bf16* p = hh + (size_t)n * 1280 + c;
            const float x = bf2f(*p);
            if (c < 256) { *p = f2bf(siluf_(x)); }
            else {
                const int d = c & 255;
                float lb = 0.f;
                if (l == 1) { const float a = lg[d], b = lg[256 + d]; const float m = fmaxf(a, b); const float ea = expf(a - m), eb = expf(b - m); lb = eb / (ea + eb); }
                *p = f2bf((1.0f - lb) * sigmoidf_(-x));
            }
        }
    }
}

struct EpiQMla {
    bf16* q; int row0, pn;
    DI void operator()(int r, int c, float a, float b, float cc, float d) const {
        const int row = row0 + r, col = pn * 256 + c;
        if (col >= 384) return;
        const int w = col % 96;
        if (w >= 64) {
            const int s = row % SEQ;
#pragma unroll
            for (int t = 0; t < 2; ++t) {
                const int m = ((w - 64) >> 1) + t;
                const float pos = m < 8 ? (float)(s / GRIDW) : (float)(s % GRIDW);
                const float ang = pos * rope_inv(2 * (m & 7), 16);
                const float cs = cosf(ang), sn = sinf(ang);
                float& x1 = t ? cc : a; float& x2 = t ? d : b;
                const float y1 = x1 * cs - x2 * sn, y2 = x1 * sn + x2 * cs; x1 = y1; x2 = y2;
            }
        }
        st_bf16x4(q + (size_t)row * 384 + col, a, b, cc, d);
    }
};
struct EpiKVMla {
    bf16* kn; bf16* vt; int row0, pn;
    DI void operator()(int r, int c, float a, float b, float cc, float d) const {
        const int row = row0 + r, col = pn * 256 + c, h = col >> 7, w = col & 127;
        if (w < 64) st_bf16x4(kn + (size_t)row * 256 + h * 64 + w, a, b, cc, d);
        else { const int bb = row / SEQ, s = row % SEQ; bf16* p = vt + ((size_t)bb * 256 + h * 64 + (w - 64)) * SEQ + s;
            p[0] = f2bf(a); p[SEQ] = f2bf(b); p[2 * SEQ] = f2bf(cc); p[3 * SEQ] = f2bf(d); }
    }
};
DI void phase_mlaup(const Frame& F) {
    const bf16* hm = WSP(bf16, OFF_HMLA); const char* wts = (const char*)WSP(bf16, OFF_WTS);
    const int nM = (NTOK + 255) / 256;
    for (int u = blockIdx.x; u < nM * 4; u += gridDim.x) {
        const int pm = u >> 2, j = u & 3;
#ifdef CPU_EMU
        const int mr = min(256, NTOK - pm * 256);
#define MR , mr
#else
#define MR
#endif
        if (j < 2) { EpiQMla E{WSP(bf16, OFF_QMLA), pm * 256, j};
            gemm_unit(F, hm, 512, nullptr, pm * 256, (const bf16*)(wts + W_UQ_T), 256, j * 256, 256, E MR); }
        else { EpiKVMla E{WSP(bf16, OFF_KNOPE), WSP(bf16, OFF_VTMLA), pm * 256, j - 2};
            gemm_unit(F, hm + 256, 512, nullptr, pm * 256, (const bf16*)(wts + W_UKV_T), 256, (j - 2) * 256, 256, E MR); }
    }
}

struct AttnDesc {
    const bf16* q; int q_stride;
    int q_hstride;
    const bf16* k; int k_stride; int k_hstride;
    const bf16* k2; int k2_stride;
    int dk_main;
    const bf16* vt;
    bf16* o; int o_stride; int o_hstride;
    int H, HKV, SQ, SK;
    float scale;
};

#ifdef CPU_EMU
template <int DK, int DV>
void attn_phase(const Frame& F, const AttnDesc& A) {
    const int G = A.H / A.HKV;
    float* sc = (float*)malloc(sizeof(float) * A.SK);
    for (int b = 0; b < BATCH; ++b) for (int h = 0; h < A.H; ++h) for (int s = 0; s < A.SQ; ++s) {
        const int kv = h / G;
        const bf16* q = A.q + (size_t)(b * A.SQ + s) * A.q_stride + h * A.q_hstride;
        float mx = -1e30f;
        for (int key = 0; key < A.SK; ++key) {
            const bf16* kp = A.k + (size_t)(b * A.SK + key) * A.k_stride + kv * A.k_hstride;
            double acc = 0;
            for (int d = 0; d < DK; ++d) {
                float kvl = d < A.dk_main ? bf2f(kp[d]) : bf2f(A.k2[(size_t)(b * A.SK + key) * A.k2_stride + d - A.dk_main]);
                acc += (double)bf2f(q[d]) * kvl;
            }
            sc[key] = (float)acc * A.scale; mx = fmaxf(mx, sc[key]);
        }
        double sum = 0; for (int key = 0; key < A.SK; ++key) { sc[key] = expf(sc[key] - mx); sum += sc[key]; }
        for (int dv = 0; dv < DV; ++dv) {
            const bf16* vp = A.vt + ((size_t)(b * A.HKV + kv) * DV + dv) * A.SK;
            double acc = 0; for (int key = 0; key < A.SK; ++key) acc += (double)bf2f(f2bf(sc[key])) * bf2f(vp[key]);
            A.o[(size_t)(b * A.SQ + s) * A.o_stride + h * A.o_hstride + dv] = f2bf((float)(acc / sum));
        }
    }
    free(sc);
}
#else
DI int crow16(int reg, int h) { return (reg & 3) + 8 * (reg >> 2) + 4 * h; }
template <int DK, int DV, int DVT>
DI void attn_phase(const Frame& F, const AttnDesc& A) {
    constexpr int KP = DK + 8;
    constexpr int VP = 64 + 8;
    constexpr int NPASS = DV / DVT;
    bf16* Ks = (bf16*)F.smem;
    bf16* Vs = Ks + 64 * KP;
    const int tid = F.tid, wave = tid >> 6, lane = tid & 63, r = lane & 31, hh = lane >> 5;
    const int G = A.H / A.HKV;
    const int nqb = A.SQ / 256;
    const int nunit = BATCH * A.H * nqb * NPASS;
    const float sl2 = A.scale * 1.4426950408889634f;
    for (int u = blockIdx.x; u < nunit; u += gridDim.x) {
        int t = u; const int pass = t % NPASS; t /= NPASS; const int qb = t % nqb; t /= nqb; const int h = t % A.H; const int b = t / A.H;
        const int kv = h / G;
        const int q0 = qb * 256 + wave * 32;
        bf16x8 qf[DK / 16];
        { const bf16* qp = A.q + (size_t)(b * A.SQ + q0 + r) * A.q_stride + h * A.q_hstride + 8 * hh;
#pragma unroll
          for (int ks = 0; ks < DK / 16; ++ks) qf[ks] = *reinterpret_cast<const bf16x8*>(qp + 16 * ks); }
        f32x16 oacc[DVT / 32];
#pragma unroll
        for (int i = 0; i < DVT / 32; ++i)
#pragma unroll
            for (int j = 0; j < 16; ++j) oacc[i][j] = 0.f;
        float mrun = -INFINITY, lrun = 0.f;
        for (int kt = 0; kt < A.SK / 64; ++kt) {
            __syncthreads();
            for (int c = tid; c < 64 * (DK / 8); c += 512) {
                const int key = c / (DK / 8), d8 = (c % (DK / 8)) * 8;
                const size_t krow = (size_t)(b * A.SK + kt * 64 + key);
                uint4 v;
                if (d8 < A.dk_main) v = *reinterpret_cast<const uint4*>(A.k + krow * A.k_stride + kv * A.k_hstride + d8);
                else v = *reinterpret_cast<const uint4*>(A.k2 + krow * A.k2_stride + (d8 - A.dk_main));
                *reinterpret_cast<uint4*>(Ks + key * KP + d8) = v;
            }
            for (int c = tid; c < DVT * 8; c += 512) {
                const int dv = c >> 3, k8 = (c & 7) * 8;
                const uint4 v = *reinterpret_cast<const uint4*>(A.vt + ((size_t)(b * A.HKV + kv) * DV + pass * DVT + dv) * A.SK + kt * 64 + k8);
                *reinterpret_cast<uint4*>(Vs + dv * VP + k8) = v;
            }
            __syncthreads();
            f32x16 sacc[2];
#pragma unroll
            for (int kb = 0; kb < 2; ++kb) {
#pragma unroll
                for (int j = 0; j < 16; ++j) sacc[kb][j] = 0.f;
#pragma unroll
                for (int ks = 0; ks < DK / 16; ++ks) {
                    const bf16x8 kf = *reinterpret_cast<const bf16x8*>(Ks + (kb * 32 + r) * KP + 16 * ks + 8 * hh);
                    sacc[kb] = __builtin_amdgcn_mfma_f32_32x32x16_bf16(kf, qf[ks], sacc[kb], 0, 0, 0);
                }
            }
            float mx = -INFINITY;
#pragma unroll
            for (int kb = 0; kb < 2; ++kb)
#pragma unroll
                for (int j = 0; j < 16; ++j) mx = fmaxf(mx, sacc[kb][j]);
            mx = fmaxf(mx, shfl_xor(F, mx, 32));
            const float mnew = fmaxf(mrun, mx * sl2);
            const float alpha = exp2f(mrun - mnew);
            mrun = mnew;
            float psum = 0.f;
#pragma unroll
            for (int kb = 0; kb < 2; ++kb)
#pragma unroll
                for (int j = 0; j < 16; ++j) { const float p = exp2f(sacc[kb][j] * sl2 - mnew); sacc[kb][j] = p; psum += p; }
            lrun = lrun * alpha + psum;
#pragma unroll
            for (int i = 0; i < DVT / 32; ++i)
#pragma unroll
                for (int j = 0; j < 16; ++j) oacc[i][j] *= alpha;
#pragma unroll
            for (int kb = 0; kb < 2; ++kb)
#pragma unroll
                for (int s2 = 0; s2 < 2; ++s2) {
                    union { bf16x8 v; unsigned u[4]; } pf;
#pragma unroll
                    for (int j = 0; j < 4; ++j) pf.u[j] = pack_bf16(sacc[kb][8 * s2 + 2 * j], sacc[kb][8 * s2 + 2 * j + 1]);
#pragma unroll
                    for (int i = 0; i < DVT / 32; ++i) {
                        const bf16* vp = Vs + (i * 32 + r) * VP + kb * 32 + 16 * s2 + 4 * hh;
                        union { bf16x8 v; bf16x4 h2[2]; } vf;
                        vf.h2[0] = *reinterpret_cast<const bf16x4*>(vp);
                        vf.h2[1] = *reinterpret_cast<const bf16x4*>(vp + 8);
                        oacc[i] = __builtin_amdgcn_mfma_f32_32x32x16_bf16(vf.v, pf.v, oacc[i], 0, 0, 0);
                    }
                }
        }
        lrun += shfl_xor(F, lrun, 32);
        const float inv = 1.0f / lrun;
        bf16* op = A.o + (size_t)(b * A.SQ + q0 + r) * A.o_stride + h * A.o_hstride + pass * DVT;
#pragma unroll
        for (int i = 0; i < DVT / 32; ++i)
#pragma unroll
            for (int g = 0; g < 4; ++g)
                st_bf16x4(op + i * 32 + 8 * g + 4 * hh, oacc[i][4 * g] * inv, oacc[i][4 * g + 1] * inv, oacc[i][4 * g + 2] * inv, oacc[i][4 * g + 3] * inv);
    }
}
#endif

DI AttnDesc desc_gqa(const Frame& F) {
    AttnDesc A; A.q = WSP(bf16, OFF_HATT); A.q_stride = 512; A.q_hstride = 64;
    A.k = WSP(bf16, OFF_HATT) + 256; A.k_stride = 512; A.k_hstride = 64; A.k2 = nullptr; A.k2_stride = 0; A.dk_main = 64;
    A.vt = WSP(bf16, OFF_VTATT); A.o = WSP(bf16, OFF_YCAT); A.o_stride = 1024; A.o_hstride = 64;
    A.H = 4; A.HKV = 2; A.SQ = SEQ; A.SK = SEQ; A.scale = 0.125f; return A;
}
DI AttnDesc desc_mla(const Frame& F) {
    AttnDesc A; A.q = WSP(bf16, OFF_QMLA); A.q_stride = 384; A.q_hstride = 96;
    A.k = WSP(bf16, OFF_KNOPE); A.k_stride = 256; A.k_hstride = 64; A.k2 = WSP(bf16, OFF_KROPE); A.k2_stride = 32; A.dk_main = 64;
    A.vt = WSP(bf16, OFF_VTMLA); A.o = WSP(bf16, OFF_YCAT) + 768; A.o_stride = 1024; A.o_hstride = 64;
    A.H = 4; A.HKV = 4; A.SQ = SEQ; A.SK = SEQ; A.scale = 0.10206207261596575f; return A;
}
DI AttnDesc desc_mem(const Frame& F) {
    AttnDesc A; A.q = WSP(bf16, OFF_QMEM); A.q_stride = 1024; A.q_hstride = 256;
    A.k = WSP(bf16, OFF_KMEM); A.k_stride = 1024; A.k_hstride = 256; A.k2 = nullptr; A.k2_stride = 0; A.dk_main = 256;
    A.vt = WSP(bf16, OFF_VTMEM); A.o = WSP(bf16, OFF_OMEM); A.o_stride = 1024; A.o_hstride = 256;
    A.H = 4; A.HKV = 4; A.SQ = SEQ; A.SK = MEMT; A.scale = 0.0625f; return A;
}

#ifndef CPU_EMU
template <int CTRL> DI float dppf(float x) { return __builtin_bit_cast(float, __builtin_amdgcn_update_dpp(0, __builtin_bit_cast(int, x), CTRL, 0xf, 0xf, true)); }
DI float allsum16(float x) { x += dppf<0xB1>(x); x += dppf<0x4E>(x); x += dppf<0x141>(x); x += dppf<0x140>(x); return x; }
DI float bflo(unsigned u) { return __uint_as_float(u << 16); }
DI float bfhi(unsigned u) { return __uint_as_float(u & 0xffff0000u); }

template <int KIND>
DI void scan_chain(const Frame& F, int chain) {
    constexpr int T = 32;
    constexpr int NARR = KIND == 0 ? 6 : 3;
    constexpr int STEPB = NARR * 128;
    constexpr int NPIECE = T * NARR * 8;
    constexpr int PPT = (NPIECE + NTH - 1) / NTH;
    const int d = chain / (BATCH * 4), b = (chain / 4) % BATCH, h = chain % 4;
    const int tid = F.tid, wave = tid >> 6, lane = tid & 63, rg = lane >> 4, cg = lane & 15;
    unsigned char* buf0 = F.smem; unsigned char* buf1 = F.smem + T * STEPB;
    unsigned char* ybuf = F.smem + 2 * T * STEPB;
    const size_t AS = (size_t)NTOK * 256;
    bf16* r7 = WSP(bf16, OFF_R7); bf16* hh = WSP(bf16, OFF_HHGRN);
#define PIECE_PTR(t0, p_) ([&]() -> const uint4* { const int pc = (p_) < NPIECE ? (p_) : NPIECE - 1; \
        const int st = pc / (NARR * 8), rem = pc % (NARR * 8), arr = rem >> 3, part = rem & 7; \
        const int tt = (t0) + st, ss = d ? SEQ - 1 - tt : tt; const size_t nn = (size_t)b * SEQ + ss; \
        const bf16* base; \
        if (KIND == 0) { const int aid = arr == 0 ? R_KK : arr == 1 ? (d ? R_W1 : R_W0) : arr == 2 ? (d ? R_AK1 : R_AK0) : arr == 3 ? (d ? R_KD1 : R_KD0) : arr == 4 ? R_R : R_V; \
            base = r7 + aid * AS + nn * 256 + h * 64; } \
        else { const int off = arr == 0 ? 256 + d * 256 : arr == 1 ? 0 : 768; base = hh + nn * 1280 + off + h * 64; } \
        return reinterpret_cast<const uint4*>(base + part * 8); }())
    uint4 pre0, pre1, pre2;
    pre0 = *PIECE_PTR(0, tid); pre1 = *PIECE_PTR(0, tid + NTH); pre2 = pre1;
    if (PPT > 2) pre2 = *PIECE_PTR(0, tid + 2 * NTH);
    __syncthreads();
#define STORE_PRE(dst) do { *reinterpret_cast<uint4*>((dst) + tid * 16) = pre0; \
        if (tid + NTH < NPIECE) *reinterpret_cast<uint4*>((dst) + (tid + NTH) * 16) = pre1; \
        if (PPT > 2 && tid + 2 * NTH < NPIECE) *reinterpret_cast<uint4*>((dst) + (tid + 2 * NTH) * 16) = pre2; } while (0)
    STORE_PRE(buf0);
    __syncthreads();
    float S0[4] = {0.f, 0.f, 0.f, 0.f}, S1[4] = {0.f, 0.f, 0.f, 0.f};
    for (int ch = 0; ch < SEQ / T; ++ch) {
        const unsigned char* cur = (ch & 1) ? buf1 : buf0;
        if (ch + 1 < SEQ / T) {
            pre0 = *PIECE_PTR((ch + 1) * T, tid); pre1 = *PIECE_PTR((ch + 1) * T, tid + NTH);
            if (PPT > 2) pre2 = *PIECE_PTR((ch + 1) * T, tid + 2 * NTH);
        }
#pragma unroll 4
        for (int t = 0; t < T; ++t) {
            const unsigned char* sb = cur + t * STEPB;
            if (KIND == 0) {
                const uint2 ukk = *reinterpret_cast<const uint2*>(sb + 0 * 128 + cg * 8);
                const uint2 uw = *reinterpret_cast<const uint2*>(sb + 1 * 128 + cg * 8);
                const uint2 uak = *reinterpret_cast<const uint2*>(sb + 2 * 128 + cg * 8);
                const uint2 ukd = *reinterpret_cast<const uint2*>(sb + 3 * 128 + cg * 8);
                const uint2 ur = *reinterpret_cast<const uint2*>(sb + 4 * 128 + cg * 8);
                const unsigned uv = *reinterpret_cast<const unsigned*>(sb + 5 * 128 + (wave * 8 + rg * 2) * 2);
                const float kk[4] = {bflo(ukk.x), bfhi(ukk.x), bflo(ukk.y), bfhi(ukk.y)};
                const float w[4] = {bflo(uw.x), bfhi(uw.x), bflo(uw.y), bfhi(uw.y)};
                const float ak[4] = {bflo(uak.x), bfhi(uak.x), bflo(uak.y), bfhi(uak.y)};
                const float kd[4] = {bflo(ukd.x), bfhi(ukd.x), bflo(ukd.y), bfhi(ukd.y)};
                const float rr[4] = {bflo(ur.x), bfhi(ur.x), bflo(ur.y), bfhi(ur.y)};
                const float v0 = bflo(uv), v1 = bfhi(uv);
                float sa0 = S0[0] * kk[0] + S0[1] * kk[1] + S0[2] * kk[2] + S0[3] * kk[3];
                float sa1 = S1[0] * kk[0] + S1[1] * kk[1] + S1[2] * kk[2] + S1[3] * kk[3];
                sa0 = allsum16(sa0); sa1 = allsum16(sa1);
                float y0 = 0.f, y1 = 0.f;
#pragma unroll
                for (int c = 0; c < 4; ++c) {
                    S0[c] = S0[c] * w[c] - sa0 * ak[c] + v0 * kd[c];
                    S1[c] = S1[c] * w[c] - sa1 * ak[c] + v1 * kd[c];
                    y0 += S0[c] * rr[c]; y1 += S1[c] * rr[c];
                }
                y0 = allsum16(y0); y1 = allsum16(y1);
                if (cg == 0) *reinterpret_cast<unsigned*>(ybuf + t * 128 + (wave * 8 + rg * 2) * 2) = pack_bf16(y0, y1);
            } else {
                const uint2 uk = *reinterpret_cast<const uint2*>(sb + 0 * 128 + cg * 8);
                const uint2 uq = *reinterpret_cast<const uint2*>(sb + 1 * 128 + cg * 8);
                const unsigned uv = *reinterpret_cast<const unsigned*>(sb + 2 * 128 + (wave * 8 + rg * 2) * 2);
                const float k[4] = {bflo(uk.x), bfhi(uk.x), bflo(uk.y), bfhi(uk.y)};
                const float q[4] = {bflo(uq.x), bfhi(uq.x), bflo(uq.y), bfhi(uq.y)};
                const float v0 = bflo(uv), v1 = bfhi(uv);
                float y0 = 0.f, y1 = 0.f;
#pragma unroll
                for (int c = 0; c < 4; ++c) {
                    S0[c] += k[c] * (v0 - S0[c]); S1[c] += k[c] * (v1 - S1[c]);
                    y0 += S0[c] * q[c]; y1 += S1[c] * q[c];
                }
                y0 = allsum16(y0); y1 = allsum16(y1);
                if (cg == 0) *reinterpret_cast<unsigned*>(ybuf + t * 128 + (wave * 8 + rg * 2) * 2) = pack_bf16(y0, y1);
            }
        }
        asm volatile("s_waitcnt lgkmcnt(0)" ::: "memory");
        __builtin_amdgcn_wave_barrier();
        if (lane < T) {
            const int t = ch * T + lane, s = d ? SEQ - 1 - t : t; const size_t n = (size_t)b * SEQ + s;
            const uint4 yv = *reinterpret_cast<const uint4*>(ybuf + lane * 128 + wave * 16);
            bf16* dst = KIND == 0 ? r7 + (d ? R_W1 : R_W0) * AS + n * 256 + h * 64 + wave * 8 : hh + n * 1280 + 256 + d * 256 + h * 64 + wave * 8;
            *reinterpret_cast<uint4*>(dst) = yv;
        }
        if (ch + 1 < SEQ / T) {
            unsigned char* nxt = (ch & 1) ? buf0 : buf1;
            STORE_PRE(nxt);
        }
        __syncthreads();
    }
#undef PIECE_PTR
#undef STORE_PRE
}
DI void phase_scans(const Frame& F) {
    const int nchain = 2 * BATCH * 4;
    for (int u = blockIdx.x; u < 2 * nchain; u += gridDim.x) {
        if (u < nchain) scan_chain<0>(F, u); else scan_chain<1>(F, u - nchain);
    }
}
#else
DI void phase_scans(const Frame& F) {
    bf16* r7 = WSP(bf16, OFF_R7); const size_t AS = (size_t)NTOK * 256;
    bf16* hh = WSP(bf16, OFF_HHGRN);
    const int nitem = 2 * BATCH * 4 * 64 * 2;
    for (int it = wave_item_index(F); it < nitem; it += gthreads()) {
        const int kind = it / (2 * BATCH * 4 * 64);
        int c = (it % (2 * BATCH * 4 * 64)) / 64; const int i = it % 64;
        const int d = c / (BATCH * 4); c %= BATCH * 4; const int b = c / 4, h = c % 4;
        float S[64];
#pragma unroll
        for (int j = 0; j < 64; ++j) S[j] = 0.f;
        if (kind == 0) {
            const bf16* pr = r7 + R_R * AS, *pv = r7 + R_V * AS, *pkk = r7 + R_KK * AS;
            bf16* pw = r7 + (d ? R_W1 : R_W0) * AS; const bf16* pkd = r7 + (d ? R_KD1 : R_KD0) * AS, *pak = r7 + (d ? R_AK1 : R_AK0) * AS;
            for (int t = 0; t < SEQ; ++t) {
                const int s = d ? SEQ - 1 - t : t;
                const size_t o = ((size_t)(b * SEQ + s)) * 256 + h * 64;
                const float v = bf2f(pv[o + i]);
                float sa = 0.f;
#pragma unroll
                for (int j = 0; j < 64; ++j) sa += S[j] * bf2f(pkk[o + j]);
                float y = 0.f;
#pragma unroll
                for (int j = 0; j < 64; ++j) {
                    S[j] = S[j] * bf2f(pw[o + j]) - sa * bf2f(pak[o + j]) + v * bf2f(pkd[o + j]);
                    y += S[j] * bf2f(pr[o + j]);
                }
#ifndef CPU_EMU
                __builtin_amdgcn_wave_barrier();
#endif
#ifdef CPU_EMU
                WSP(bf16, OFF_EMU_SCAN)[(size_t)d * AS + (size_t)(b * SEQ + s) * 256 + h * 64 + i] = f2bf(y);
#else
                pw[o + i] = f2bf(y);
#endif
            }
        } else {
            const bf16* pq = hh; bf16* pk = hh + 256 + d * 256; const bf16* pi = hh + 768;
            for (int t = 0; t < SEQ; ++t) {
                const int s = d ? SEQ - 1 - t : t;
                const size_t o = ((size_t)(b * SEQ + s)) * 1280 + h * 64;
                const float v = bf2f(pi[o + i]);
                float acc = 0.f;
#pragma unroll
                for (int j = 0; j < 64; ++j) {
                    const float k = bf2f(pk[o + j]);
                    S[j] = S[j] + k * (v - S[j]);
                    acc += S[j] * bf2f(pq[o + j]);
                }
#ifndef CPU_EMU
                __builtin_amdgcn_wave_barrier();
#endif
#ifdef CPU_EMU
                WSP(bf16, OFF_EMU_SCAN)[(size_t)(2 + d) * AS + (size_t)(b * SEQ + s) * 256 + h * 64 + i] = f2bf(acc);
#else
                pk[o + i] = f2bf(acc);
#endif
            }
        }
    }
}

#endif

DI void phase_fin(const Frame& F, int l) {
    const bf16* r7 = WSP(bf16, OFF_R7); const size_t AS = (size_t)NTOK * 256;
    const bf16* gb = WSP(bf16, OFF_G); const float* bonus = WSP(float, OFF_BONUS);
    const bf16* hh = WSP(bf16, OFF_HHGRN); bf16* ycat = WSP(bf16, OFF_YCAT);
    const float* gng = F.in[17] + l * 256; const float* gnb = F.in[18] + l * 256; const float* hng = F.in[20] + l * 256;
    for (int it = ggrp(F); it < NTOK * 8; it += ngrp()) {
        const int n = it >> 3, kind = (it >> 2) & 1, h = it & 3;
        float v[PER64];
        if (kind == 0) {
            float s1 = 0.f;
            for (int i = 0; i < PER64; ++i) { const int c = h * 64 + glane(F) + i * GRP; const size_t o = (size_t)n * 256 + c;
#ifdef CPU_EMU
                v[i] = bf2f(WSP(bf16, OFF_EMU_SCAN)[o]) + bf2f(WSP(bf16, OFF_EMU_SCAN)[AS + o]); s1 += v[i]; }
#else
                v[i] = bf2f(r7[R_W0 * AS + o]) + bf2f(r7[R_W1 * AS + o]); s1 += v[i]; }
#endif
            s1 = grp_sum(F, s1); const float mu = s1 * (1.0f / 64.0f);
            float s2 = 0.f; for (int i = 0; i < PER64; ++i) { const float dd = v[i] - mu; s2 += dd * dd; }
            s2 = grp_sum(F, s2); const float rs = 1.0f / sqrtf(s2 * (1.0f / 64.0f) + GN_EPS);
            const float bo = bonus[(size_t)n * 4 + h];
            for (int i = 0; i < PER64; ++i) { const int c = h * 64 + glane(F) + i * GRP; const size_t o = (size_t)n * 256 + c;
                const float y = (v[i] - mu) * rs * gng[c] + gnb[c];
                ycat[(size_t)n * 1024 + 256 + c] = f2bf((y + bo * bf2f(r7[R_V * AS + o])) * bf2f(gb[o])); }
        } else {
            float s2 = 0.f;
            for (int i = 0; i < PER64; ++i) { const int c = h * 64 + glane(F) + i * GRP; const size_t o = (size_t)n * 1280 + c;
#ifdef CPU_EMU
                const size_t oe = (size_t)n * 256 + c;
                v[i] = bf2f(WSP(bf16, OFF_EMU_SCAN)[2 * AS + oe]) + bf2f(WSP(bf16, OFF_EMU_SCAN)[3 * AS + oe]); s2 += v[i] * v[i]; }
#else
                v[i] = bf2f(hh[o + 256]) + bf2f(hh[o + 512]); s2 += v[i] * v[i]; }
#endif
            s2 = grp_sum(F, s2); const float rs = 1.0f / sqrtf(s2 * (1.0f / 64.0f) + RMS_EPS);
            for (int i = 0; i < PER64; ++i) { const int c = h * 64 + glane(F) + i * GRP; const size_t o = (size_t)n * 1280 + c;
                ycat[(size_t)n * 1024 + 512 + c] = f2bf(v[i] * rs * hng[c] * siluf_(bf2f(hh[o + 1024]))); }
        }
    }
}

struct EpiResid {
    float* xf; int row0, pn;
    DI void operator()(int r, int c, float a, float b, float cc, float d) const {
        float* p = xf + (size_t)(row0 + r) * DM + pn * 256 + c;
#ifndef CPU_EMU
        float4 x = *reinterpret_cast<float4*>(p);
        x.x = DN_ALPHA * x.x + a; x.y = DN_ALPHA * x.y + b; x.z = DN_ALPHA * x.z + cc; x.w = DN_ALPHA * x.w + d;
        *reinterpret_cast<float4*>(p) = x;
#else
        p[0] = DN_ALPHA * p[0] + a; p[1] = DN_ALPHA * p[1] + b; p[2] = DN_ALPHA * p[2] + cc; p[3] = DN_ALPHA * p[3] + d;
#endif
    }
};
struct EpiBf {
    bf16* o; int ld; int row0, pn;
    DI void operator()(int r, int c, float a, float b, float cc, float d) const { st_bf16x4(o + (size_t)(row0 + r) * ld + pn * 256 + c, a, b, cc, d); }
};
template <int MODE>
DI void phase_gemm_sq(const Frame& F, const bf16* A, size_t woff, bf16* outb) {
    const bf16* W = (const bf16*)((const char*)WSP(bf16, OFF_WTS) + woff);
    const int nM = (NTOK + 255) / 256;
    for (int u = blockIdx.x; u < nM * 4; u += gridDim.x) {
        const int pm = u >> 2, pn = u & 3;
#ifdef CPU_EMU
        const int mr = min(256, NTOK - pm * 256);
#endif
        if (MODE == 0) { EpiResid E{F.xf, pm * 256, pn}; gemm_unit(F, A, 1024, nullptr, pm * 256, W, 1024, pn * 256, 1024, E MR); }
        else { EpiBf E{outb, 1024, pm * 256, pn}; gemm_unit(F, A, 1024, nullptr, pm * 256, W, 1024, pn * 256, 1024, E MR); }
    }
}

DI void phase_ln(const Frame& F, const float* g, const float* b) {
    const float* xf = F.xf;
    layer_norm_rows(F, g, b, [&](int row, int c) { return xf[(size_t)row * DM + c]; }, false, nullptr);
}

DI void phase_route(const Frame& F, int l) {
    const float* xf = F.xf;
    const float* wg = F.in[33] + (size_t)l * 1024 * 4; const float* bg = F.in[34] + l * 4;
    const float* we = F.in[35] + (size_t)l * 1024 * 32; const float* be = F.in[36] + l * 32;
    int* counts = (int*)(F.ws + CTL_CNT) + l * 32;
    int* lists = WSP(int, OFF_LISTS); float* tinfo = WSP(float, OFF_TINFO);
    for (int row = ggrp(F); row < NTOK; row += ngrp()) {
        float gl[4] = {0.f, 0.f, 0.f, 0.f};
        for (int i = 0; i < PERLN; ++i) { const int c = glane(F) + i * GRP; const float x = xf[(size_t)row * DM + c];
#pragma unroll
            for (int q = 0; q < 4; ++q) gl[q] += x * wg[c * 4 + q]; }
#pragma unroll
        for (int q = 0; q < 4; ++q) gl[q] = grp_sum(F, gl[q]) + bg[q];
        int gi = 0; float gm = gl[0];
#pragma unroll
        for (int q = 1; q < 4; ++q) if (gl[q] > gm) { gm = gl[q]; gi = q; }
        float den = 0.f;
#pragma unroll
        for (int q = 0; q < 4; ++q) den += expf(gl[q] - gm);
        const float pgroup = 1.0f / den;
        float el[8] = {0.f, 0.f, 0.f, 0.f, 0.f, 0.f, 0.f, 0.f};
        for (int i = 0; i < PERLN; ++i) { const int c = glane(F) + i * GRP; const float x = xf[(size_t)row * DM + c];
#pragma unroll
            for (int q = 0; q < 8; ++q) el[q] += x * we[c * 32 + gi * 8 + q]; }
#pragma unroll
        for (int q = 0; q < 8; ++q) el[q] = grp_sum(F, el[q]) + be[gi * 8 + q];
        int i0 = 0; float v0 = el[0];
#pragma unroll
        for (int q = 1; q < 8; ++q) if (el[q] > v0) { v0 = el[q]; i0 = q; }
        int i1 = -1; float v1 = -INFINITY;
#pragma unroll
        for (int q = 0; q < 8; ++q) if (q != i0 && el[q] > v1) { v1 = el[q]; i1 = q; }
        const float e1 = expf(v1 - v0); const float g0 = pgroup / (1.0f + e1), g1 = pgroup * e1 / (1.0f + e1);
        if (glane(F) == 0) {
            const int ea = gi * 8 + i0, eb = gi * 8 + i1;
            const int pa = atomicAdd(&counts[ea], 1), pb = atomicAdd(&counts[eb], 1);
            lists[(size_t)ea * NTOK + pa] = row; lists[(size_t)eb * NTOK + pb] = row;
            int* ti = (int*)(tinfo + (size_t)row * 8);
            ti[0] = ea; ti[1] = pa; ti[2] = eb; ti[3] = pb; tinfo[(size_t)row * 8 + 4] = g0; tinfo[(size_t)row * 8 + 5] = g1;
        }
    }
}

struct EpiMoeUp {
    bf16* hm; int row0, pn;
    DI void operator()(int r, int c, float a, float b, float cc, float d) const {
        bf16* p = hm + (size_t)(row0 + r) * 256 + ((pn * 256 + c) >> 1);
        p[0] = f2bf(siluf_(a) * b); p[1] = f2bf(siluf_(cc) * d);
    }
};
DI int ld_cnt(const int* p) {
#ifdef CPU_EMU
    return *p;
#else
    return __hip_atomic_load(p, __ATOMIC_RELAXED, __HIP_MEMORY_SCOPE_AGENT);
#endif
}
DI void moe_tiles(const int* counts, int* toff  ) {
    __syncthreads();
    if (threadIdx.x == 0) { int acc = 0; for (int e = 0; e < NEXP; ++e) { toff[e] = acc; acc += (ld_cnt(counts + e) + 255) >> 8; } toff[NEXP] = acc; }
    __syncthreads();
}
DI void phase_moe_up(const Frame& F, int l) {
    const int* counts = (const int*)(F.ws + CTL_CNT) + l * 32;
    int* eoff = (int*)(F.ws + CTL_EOFF) + l * 33;
    int* rowmap = (int*)(F.smem + 131072);
    int* toff = rowmap + 256;
    moe_tiles(counts, toff);
    if (blockIdx.x == 0 && threadIdx.x == 0) for (int e = 0; e <= NEXP; ++e) eoff[e] = toff[e] * 256;
    const int* lists = WSP(int, OFF_LISTS); const bf16* xb = WSP(bf16, OFF_XB);
    const int nunit = toff[NEXP] * 2;
    for (int u = blockIdx.x; u < nunit; u += gridDim.x) {
        const int tile = u >> 1, pn = u & 1;
        int e = 0; while (toff[e + 1] <= tile) ++e;
        const int t0 = (tile - toff[e]) * 256, cnt = ld_cnt(counts + e);
        __syncthreads();
        for (int i = fresh_tid(F); i < 256; i += NTH) rowmap[i] = (t0 + i < cnt) ? lists[(size_t)e * NTOK + t0 + i] : 0;
        __syncthreads();
        EpiMoeUp E{WSP(bf16, OFF_HM), tile * 256, pn};
        gemm_unit(F, xb, 1024, rowmap, 0, WSP(bf16, OFF_W13T) + (size_t)e * 512 * 1024, 1024, pn * 256, 1024, E);
    }
}
DI void phase_moe_down(const Frame& F, int l) {
    const int* counts = (const int*)(F.ws + CTL_CNT) + l * 32;
    int* toff = (int*)(F.smem + 131072) + 256;
    moe_tiles(counts, toff);
    const int nunit = toff[NEXP] * 4;
    for (int u = blockIdx.x; u < nunit; u += gridDim.x) {
        const int tile = u >> 2, pn = u & 3;
        int e = 0; while (toff[e + 1] <= tile) ++e;
        EpiBf E{WSP(bf16, OFF_YROWS), 1024, tile * 256, pn};
        gemm_unit(F, WSP(bf16, OFF_HM), 256, nullptr, tile * 256, WSP(bf16, OFF_W2T) + (size_t)e * 1024 * 256, 256, pn * 256, 256, E);
    }
}
DI void phase_ln3(const Frame& F, int l) {
    const float* xf = F.xf; const bf16* yr = WSP(bf16, OFF_YROWS); const float* tinfo = WSP(float, OFF_TINFO);
    const int* eoff = (const int*)(F.ws + CTL_EOFF) + l * 33;
    layer_norm_rows(F, F.in[40] + l * 1024, F.in[41] + l * 1024, [&](int row, int c) {
        const int* ti = (const int*)(tinfo + (size_t)row * 8);
        const size_t ra = (size_t)eoff[ti[0]] + ti[1], rb = (size_t)eoff[ti[2]] + ti[3];
        return DN_ALPHA * xf[(size_t)row * DM + c] + tinfo[(size_t)row * 8 + 4] * bf2f(yr[ra * 1024 + c]) + tinfo[(size_t)row * 8 + 5] * bf2f(yr[rb * 1024 + c]);
    }, false, nullptr);
}

#ifndef CPU_EMU
#define XB_TMO      128
#define XB_XCNT(j)  (256  + 64 * (j))
#define XB_XSUB(j)  (1280 + 64 * (j))
#define XB_XGEN(j)  (2304 + 64 * (j))
#define XB_TOP      3328
#define XB_TOPGEN   3392
#define XCD_BAR_WORDS 3456
#define XB_SPIN_CAP (1u << 18)
#define LAS __attribute__((address_space(3)))

__device__ __forceinline__ unsigned xb_ld(unsigned* p)              { return __hip_atomic_load(p, __ATOMIC_RELAXED, __HIP_MEMORY_SCOPE_AGENT); }
__device__ __forceinline__ unsigned xb_add(unsigned* p, unsigned v) { return __hip_atomic_fetch_add(p, v, __ATOMIC_RELAXED, __HIP_MEMORY_SCOPE_AGENT); }
__device__ __forceinline__ unsigned xb_xcc_id() { return (unsigned)__builtin_amdgcn_s_getreg((3 << 11) | 20) & 0xFu; }
#define XB_SPIN(cond, bar) do { unsigned _sp = 0; while (cond) { __builtin_amdgcn_s_sleep(1); \
    if ((++_sp & 255u) == 0u) { if (xb_ld(&(bar)[XB_TMO])) break; if (_sp > XB_SPIN_CAP) { atomicAdd(&(bar)[XB_TMO], 1u); break; } } } } while (0)

struct XcdBarrier {
    unsigned* bar; unsigned x;
    volatile LAS unsigned* st;
};

__device__ __forceinline__ XcdBarrier xcd_barrier_post(unsigned* bar, volatile LAS unsigned* st) {
    XcdBarrier b; b.bar = bar; b.x = xb_xcc_id(); b.st = st;
    if (threadIdx.x == 0) (void)xb_add(&bar[XB_XCNT(b.x)], 1u);
    return b;
}
__device__ __forceinline__ void xcd_barrier_complete(unsigned* bar, unsigned x, unsigned& nloc, unsigned& nx) {
    const unsigned G = gridDim.x * gridDim.y * gridDim.z;
    unsigned sum, cnt, mine, sp = 0u;
    for (;;) {
        sum = 0u; cnt = 0u; mine = 0u;
#pragma unroll
        for (unsigned j = 0; j < 16; ++j) { const unsigned c = xb_ld(&bar[XB_XCNT(j)]); sum += c; cnt += (c > 0u) ? 1u : 0u; mine = (j == x) ? c : mine; }
        if (sum == G) break;
        __builtin_amdgcn_s_sleep(1);
        if ((++sp & 255u) == 0u) { if (xb_ld(&bar[XB_TMO])) break; if (sp > XB_SPIN_CAP) { atomicAdd(&bar[XB_TMO], 1u); break; } }
    }
    nloc = mine > 0u ? mine : 1u; nx = cnt > 0u ? cnt : 1u;
}

__device__ __forceinline__ void xcd_barrier(const XcdBarrier& b) {
    asm volatile("s_waitcnt vmcnt(0)" ::: "memory");
    __syncthreads();
    if (threadIdx.x == 0) {
        unsigned* bar = b.bar;
        __builtin_amdgcn_s_waitcnt(0);
        unsigned nloc = b.st[0], nx = b.st[1];
        if (nloc == 0u) { xcd_barrier_complete(bar, b.x, nloc, nx); b.st[0] = nloc; b.st[1] = nx; }
        const unsigned old = xb_add(&bar[XB_XSUB(b.x)], 1u);
        const unsigned gen = old / nloc;
        if (old + 1u == (gen + 1u) * nloc) {
            __builtin_amdgcn_fence(__ATOMIC_RELEASE, "agent");
            asm volatile("s_waitcnt vmcnt(0)" ::: "memory");
            const unsigned og = xb_add(&bar[XB_TOP], 1u);
            const unsigned tg = og / nx;
            if (og + 1u == (tg + 1u) * nx) xb_add(&bar[XB_TOPGEN], 1u);
            else XB_SPIN(xb_ld(&bar[XB_TOPGEN]) == tg, bar);
            __builtin_amdgcn_fence(__ATOMIC_ACQUIRE, "agent");
            xb_add(&bar[XB_XGEN(b.x)], 1u);
            asm volatile("s_waitcnt vmcnt(0)" ::: "memory");
        } else {
            XB_SPIN(xb_ld(&bar[XB_XGEN(b.x)]) == gen, bar);
            __builtin_amdgcn_fence(__ATOMIC_ACQUIRE, "agent");
            asm volatile("s_waitcnt vmcnt(0)" ::: "memory");
        }
    }
    __syncthreads();
}

#endif

constexpr int NPH_LAYER = 16;
constexpr int NPH_TOTAL = 1 + 2 * NPH_LAYER;
constexpr int SMEM_BYTES = 131072 + 2048;

template <int K>
DI void run_layer_phase(const Frame& F, int l) {
    if constexpr (K == 0) phase_cvt(F, l);
    if constexpr (K == 1) phase_gemm1(F);
    if constexpr (K == 2) phase_prep(F, l);
    if constexpr (K == 3) phase_mlaup(F);
    if constexpr (K == 4) {
#ifdef CPU_EMU
        attn_phase<64, 64>(F, desc_gqa(F)); attn_phase<96, 64>(F, desc_mla(F));
#else
        attn_phase<64, 64, 64>(F, desc_gqa(F)); attn_phase<96, 64, 64>(F, desc_mla(F));
#endif
        phase_scans(F);
    }
    if constexpr (K == 5) phase_fin(F, l);
    if constexpr (K == 6) phase_gemm_sq<0>(F, WSP(bf16, OFF_YCAT), W_OUT_T, nullptr);
    if constexpr (K == 7) phase_ln(F, F.in[26] + l * 1024, F.in[27] + l * 1024);
    if constexpr (K == 8) phase_gemm_sq<1>(F, WSP(bf16, OFF_XB), W_Q_T, WSP(bf16, OFF_QMEM));
    if constexpr (K == 9) {
#ifdef CPU_EMU
        attn_phase<256, 256>(F, desc_mem(F));
#else
        attn_phase<256, 256, 128>(F, desc_mem(F));
#endif
    }
    if constexpr (K == 10) phase_gemm_sq<0>(F, WSP(bf16, OFF_OMEM), W_O_T, nullptr);
    if constexpr (K == 11) { phase_ln(F, F.in[31] + l * 1024, F.in[32] + l * 1024); phase_cvt_moe(F, l); }
    if constexpr (K == 12) phase_route(F, l);
    if constexpr (K == 13) phase_moe_up(F, l);
    if constexpr (K == 14) phase_moe_down(F, l);
    if constexpr (K == 15) phase_ln3(F, l);
}

#ifndef CPU_EMU
template <int K>
__global__ void __launch_bounds__(512, 2) k_phase(Args a, int l) {
    extern __shared__ __attribute__((aligned(16))) unsigned char lds[];
    Frame F; F.in = (InPtr)__builtin_amdgcn_kernarg_segment_ptr(); F.xf = a.out; F.ws = a.ws; F.smem = lds; F.tid = threadIdx.x; F.wv = __builtin_amdgcn_readfirstlane((int)(threadIdx.x >> 6));
    if constexpr (K < 0) phase_pro(F); else run_layer_phase<K>(F, l);
}

template <int K>
static void launch_phase(const Args& a, int l, int grid, hipStream_t stream) {
    static bool attr = false;
    if (!attr) { (void)hipFuncSetAttribute((const void*)k_phase<K>, hipFuncAttributeMaxDynamicSharedMemorySize, SMEM_BYTES); attr = true; }
    hipLaunchKernelGGL(k_phase<K>, dim3(grid), dim3(512), SMEM_BYTES, stream, a, l);
}

__global__ void __launch_bounds__(512, 2) fwd_one(Args a) {
    extern __shared__ __attribute__((aligned(16))) unsigned char lds[];
    const int wave_s = __builtin_amdgcn_readfirstlane((int)(threadIdx.x >> 6));
    volatile LAS unsigned* st = (volatile LAS unsigned*)(lds + SMEM_BYTES - 16);
    if (threadIdx.x == 0) { st[0] = 0u; st[1] = 0u; st[2] = 0u; st[3] = 0u; }
    __syncthreads();
    XcdBarrier bar = xcd_barrier_post((unsigned*)(a.ws + OFF_CTL), st);
    Frame F;
#define FRESH do { unsigned z_ = 0u, m_ = ~0u; int ws_ = wave_s; asm volatile("" : "+s"(z_), "+s"(ws_), "+s"(m_)); \
        int t_ = ws_ * 64 + (int)__builtin_amdgcn_mbcnt_hi(m_, __builtin_amdgcn_mbcnt_lo(m_, 0u)); asm volatile("" : "+v"(t_)); \
        const __attribute__((address_space(4))) char* kp_ = (const __attribute__((address_space(4))) char*)__builtin_amdgcn_kernarg_segment_ptr() + z_; \
        F.in = (InPtr)kp_; F.xf = *(float* const __attribute__((address_space(4)))*)(kp_ + 42 * 8); F.ws = *(unsigned char* const __attribute__((address_space(4)))*)(kp_ + 43 * 8); \
        F.smem = lds; F.tid = t_; F.wv = ws_; } while (0)
#define GB do { { unsigned zb_ = 0u; unsigned xx_ = __builtin_amdgcn_readfirstlane(bar.x); asm volatile("" : "+s"(zb_), "+s"(xx_)); bar.bar = (unsigned*)(a.ws + OFF_CTL) + zb_; bar.x = xx_; } \
        xcd_barrier(bar); } while (0)
    FRESH; phase_pro(F); FRESH; phase_cvt(F, 0); GB;
    for (int l = 0; l < 2; ++l) {
        FRESH; run_layer_phase<1>(F, l); GB;
        FRESH; run_layer_phase<2>(F, l); GB;
        FRESH; run_layer_phase<3>(F, l); GB;
        FRESH; run_layer_phase<4>(F, l); GB;
        FRESH; run_layer_phase<5>(F, l); GB;
        FRESH; run_layer_phase<6>(F, l); GB;
        FRESH; run_layer_phase<7>(F, l); GB;
        FRESH; run_layer_phase<8>(F, l); GB;
        FRESH; run_layer_phase<9>(F, l); GB;
        FRESH; run_layer_phase<10>(F, l); GB;
        FRESH; run_layer_phase<11>(F, l); FRESH; run_layer_phase<12>(F, l); if (l == 0) { FRESH; phase_cvt(F, 1); } GB;
        FRESH; run_layer_phase<13>(F, l); GB;
        FRESH; run_layer_phase<14>(F, l); GB;
        FRESH; run_layer_phase<15>(F, l); if (l == 0) GB;
    }
#undef GB
#undef FRESH
}

extern "C" void kernel_launch(void* const* d_in, const int* in_sizes, int n_in, void* d_out, int out_size, void* d_ws, size_t ws_size, hipStream_t stream) {
    if (n_in != 42 || ws_size < WS_END) return;
    Args a{};
    for (int i = 0; i < 42; ++i) a.in[i] = (const float*)d_in[i];
    a.out = (float*)d_out; a.ws = (unsigned char*)d_ws; a.ph_lo = 0; a.ph_hi = NPH_TOTAL;
    (void)hipMemsetAsync(d_ws, 0, CTL_BYTES, stream);
#if N_LAUNCH_MODE == 1
    static int grid = 0;
    if (!grid) {
        int dev = 0, cus = 0, per_cu = 0;
        (void)hipGetDevice(&dev);
        (void)hipDeviceGetAttribute(&cus, hipDeviceAttributeMultiprocessorCount, dev);
        (void)hipFuncSetAttribute((const void*)fwd_one, hipFuncAttributeMaxDynamicSharedMemorySize, SMEM_BYTES);
        (void)hipOccupancyMaxActiveBlocksPerMultiprocessor(&per_cu, (const void*)fwd_one, 512, SMEM_BYTES);
        (void)hipGetLastError();
        grid = cus > 0 ? cus : 256;
    }
    hipLaunchKernelGGL(fwd_one, dim3(grid), dim3(512), SMEM_BYTES, stream, a);
#else
    const int grid = 256;
    launch_phase<-1>(a, 0, grid, stream);
    for (int l = 0; l < 2; ++l) {
        launch_phase<0>(a, l, grid, stream); launch_phase<1>(a, l, grid, stream); launch_phase<2>(a, l, grid, stream); launch_phase<3>(a, l, grid, stream);
        launch_phase<4>(a, l, grid, stream); launch_phase<5>(a, l, grid, stream); launch_phase<6>(a, l, grid, stream); launch_phase<7>(a, l, grid, stream);
        launch_phase<8>(a, l, grid, stream); launch_phase<9>(a, l, grid, stream); launch_phase<10>(a, l, grid, stream); launch_phase<11>(a, l, grid, stream);
        launch_phase<12>(a, l, grid, stream); launch_phase<13>(a, l, grid, stream); launch_phase<14>(a, l, grid, stream); launch_phase<15>(a, l, grid, stream);
    }
#endif
}
#endif
```

```cpp
#ifndef CPU_EMU
#include <hip/hip_runtime.h>
#else
#include "emu_shim.h"
#endif
#include <stdint.h>

#ifndef CFG_B
#define CFG_B 16
#endif
#ifndef CFG_S
#define CFG_S 2048
#endif
#ifndef PROBE_DUP
#define PROBE_DUP 0
#endif
#ifndef N_LAUNCH_MODE
#define N_LAUNCH_MODE 1
#endif

typedef unsigned short bf16;
#define DI __device__ __forceinline__

constexpr int BATCH = CFG_B, SEQ = CFG_S, NTOK = BATCH * SEQ, DM = 1024;
constexpr int MEMT = 256, NMEM = BATCH * MEMT;
constexpr int GRIDW = 64;
constexpr int HP = 3328;
constexpr int IN_WIDTH = 3104;
constexpr int NEXP = 32, MOEH = 256;
constexpr int MOE_ROWS = 2 * NTOK + NEXP * 256;
constexpr float LN_EPS = 1e-5f, RMS_EPS = 1e-6f, GN_EPS = 64e-5f;
constexpr float DN_ALPHA = 1.41421356237309515f;
constexpr float DECAY_SCALE = 0.60653065971263342f;

constexpr size_t AL(size_t x) { return (x + 255) & ~(size_t)255; }
constexpr size_t OFF_CTL = 0;
constexpr size_t CTL_BYTES = 32768;
constexpr size_t CTL_CNT = 16384;
constexpr size_t CTL_EOFF = 16384 + 1024;
constexpr size_t CTL_QUEUE = 16384 + 2048;
constexpr size_t OFF_XB = AL(OFF_CTL + CTL_BYTES);
constexpr size_t SZ_XB = (size_t)NTOK * DM * 2;
constexpr size_t OFF_WTS = AL(OFF_XB + SZ_XB);
constexpr size_t W_IN_T = 0;
constexpr size_t W_UQ_T = W_IN_T + (size_t)HP * 1024 * 2;
constexpr size_t W_UKV_T = W_UQ_T + 512 * 256 * 2;
constexpr size_t W_OUT_T = W_UKV_T + 512 * 256 * 2;
constexpr size_t W_Q_T = W_OUT_T + 1024 * 1024 * 2;
constexpr size_t W_KV_T = W_Q_T + 1024 * 1024 * 2;
constexpr size_t W_O_T = W_KV_T + 2048 * 1024 * 2;
constexpr size_t SZ_WTS = W_O_T + 1024 * 1024 * 2;
constexpr size_t OFF_KMEM = AL(OFF_WTS + SZ_WTS);
constexpr size_t OFF_VTMEM = AL(OFF_KMEM + (size_t)NMEM * 1024 * 2);
constexpr size_t OFF_MEMB = AL(OFF_VTMEM + (size_t)NMEM * 1024 * 2);
constexpr size_t OFF_VTATT = AL(OFF_MEMB + (size_t)NMEM * 1024 * 2);
constexpr size_t OFF_VTMLA = AL(OFF_VTATT + (size_t)BATCH * 2 * 64 * SEQ * 2);
constexpr size_t OFF_HATT = AL(OFF_VTMLA + (size_t)BATCH * 4 * 64 * SEQ * 2);
constexpr size_t OFF_HMLA = OFF_HATT + (size_t)NTOK * 512 * 2;
constexpr size_t OFF_HRWKV = OFF_HMLA + (size_t)NTOK * 512 * 2;
constexpr size_t OFF_R7 = OFF_HRWKV + (size_t)NTOK * 1024 * 2;
constexpr size_t SZ_R7 = (size_t)NTOK * 9 * 256 * 2;
constexpr size_t OFF_HHGRN = OFF_R7 + SZ_R7;
constexpr size_t WS_END = OFF_HHGRN + (size_t)NTOK * 1280 * 2;

constexpr size_t OFF_QMLA = OFF_XB;
constexpr size_t OFF_KNOPE = OFF_QMLA + (size_t)NTOK * 384 * 2;
constexpr size_t OFF_KROPE = OFF_KNOPE + (size_t)NTOK * 256 * 2;
constexpr size_t OFF_G = OFF_KROPE + (size_t)NTOK * 32 * 2;
constexpr size_t OFF_BONUS = OFF_G + (size_t)NTOK * 256 * 2;
static_assert(OFF_BONUS + (size_t)NTOK * 16 <= OFF_XB + SZ_XB, "xb alias region");
constexpr size_t OFF_YCAT = OFF_HRWKV;
constexpr size_t OFF_QMEM = OFF_HATT;
constexpr size_t OFF_OMEM = OFF_R7;
#ifdef CPU_EMU
constexpr size_t OFF_EMU_SCAN = WS_END;
constexpr size_t OFF_LISTS = AL(OFF_EMU_SCAN + (size_t)4 * NTOK * 256 * 2);
#else
constexpr size_t OFF_LISTS = OFF_HATT;
#endif
constexpr size_t OFF_TINFO = OFF_LISTS + (size_t)NEXP * NTOK * 4;
constexpr size_t OFF_HM = AL(OFF_TINFO + (size_t)NTOK * 32);
constexpr size_t OFF_YROWS = AL(OFF_HM + (size_t)MOE_ROWS * 256 * 2);
#ifdef CPU_EMU
constexpr size_t OFF_W13T = AL(OFF_YROWS + (size_t)MOE_ROWS * 1024 * 2);
#else
static_assert(OFF_YROWS + (size_t)MOE_ROWS * 1024 * 2 <= OFF_HHGRN, "moe alias region");
constexpr size_t OFF_W13T = OFF_HHGRN;
#endif
constexpr size_t OFF_W2T = OFF_W13T + (size_t)NEXP * 512 * 1024 * 2;
#ifdef CPU_EMU
constexpr size_t WS_END_EMU = OFF_W2T + (size_t)NEXP * 1024 * 256 * 2;
#else
static_assert(OFF_W2T + (size_t)NEXP * 1024 * 256 * 2 <= WS_END, "moe weights alias");
#endif

enum { R_R = 0, R_V = 1, R_KK = 2, R_W0 = 3, R_W1 = 4, R_KD0 = 5, R_KD1 = 6, R_AK0 = 7, R_AK1 = 8 };

DI float bf2f(bf16 v) { union { unsigned u; float f; } x; x.u = (unsigned)v << 16; return x.f; }
DI bf16 f2bf(float f) { union { unsigned u; float f; } x; x.f = f; unsigned u = x.u; u += 0x7fffu + ((u >> 16) & 1u); return (bf16)(u >> 16); }
DI float sigmoidf_(float x) { return 1.0f / (1.0f + expf(-x)); }
DI float siluf_(float x) { return x * sigmoidf_(x); }

#ifdef CPU_EMU
typedef const float* const* InPtr;
#else
typedef const float* const __attribute__((address_space(4)))* InPtr;
#endif
struct Frame {
    InPtr in;
    float* xf;
    unsigned char* ws;
    unsigned char* smem;
    int tid;
    int wv;
    int nblk;
};
#ifdef CPU_EMU
constexpr int NTH = 1;
#else
constexpr int NTH = 512;
#endif
#ifdef CPU_EMU
constexpr int GRP = 1;
DI float grp_sum(const Frame& F, float v) { return v; }
DI int gthreads(const Frame& F) { return 1; }
DI int gtid_(const Frame& F) { return 0; }
DI int wave_item_index(const Frame& F) { return 0; }
#else
constexpr int GRP = 64;
DI float shfl_idx(const Frame& F, float v, int src_lane) { return __builtin_bit_cast(float, __builtin_amdgcn_ds_bpermute(src_lane << 2, __builtin_bit_cast(int, v))); }
DI float shfl_xor(const Frame& F, float v, int mask) { return shfl_idx(F, v, (F.tid & 63) ^ mask); }
DI float grp_sum(const Frame& F, float v) {
#pragma unroll
    for (int o = 32; o > 0; o >>= 1) v += shfl_xor(F, v, o);
    return v;
}
DI int gthreads(const Frame& F) { return F.nblk * NTH; }
DI int gtid_(const Frame& F) { return blockIdx.x * NTH + F.tid; }
DI int wave_item_index(const Frame& F) { return (int)(((F.tid >> 6) * F.nblk + blockIdx.x) * 64 + (F.tid & 63)); }
#endif
constexpr int PER64 = 64 / GRP;
constexpr int PERLN = 1024 / GRP;
DI int fresh_tid(const Frame& F) {
#ifdef CPU_EMU
    return 0;
#else
    unsigned m0 = ~0u; asm volatile("" : "+s"(m0));
    int t = F.wv * 64 + (int)__builtin_amdgcn_mbcnt_hi(m0, __builtin_amdgcn_mbcnt_lo(m0, 0u)); asm volatile("" : "+v"(t)); return t;
#endif
}
DI int glane(const Frame& F) { return (int)(F.tid % GRP); }
DI int ggrp(const Frame& F) { return gtid_(F) / GRP; }
DI int ngrp(const Frame& F) { return gthreads(F) / GRP; }

struct Args {
    const float* in[42];
    float* out;
    unsigned char* ws;
    int ph_lo, ph_hi;
};

DI float rope_inv(int f, int nf) { return powf(10000.0f, -(float)f / (float)nf); }

#ifndef CPU_EMU
using bf16x8 = __attribute__((ext_vector_type(8))) short;
using bf16x4 = __attribute__((ext_vector_type(4))) short;
using f32x4 = __attribute__((ext_vector_type(4))) float;
using f32x16 = __attribute__((ext_vector_type(16))) float;
typedef __bf16 bf16v2 __attribute__((ext_vector_type(2)));
typedef float f32v2 __attribute__((ext_vector_type(2)));
DI unsigned pack_bf16(float lo, float hi) { f32v2 v = {lo, hi}; bf16v2 b = __builtin_convertvector(v, bf16v2); return __builtin_bit_cast(unsigned, b); }

constexpr int G_BM = 256, G_BK = 64, G_HALF = 128, G_HT = G_HALF * G_BK, G_SHM = 8 * G_HT * 2;
DI int g_lds_byte(int r, int c) { int st = (r >> 4) * 2 + (c >> 5), rr = r & 15, cc = c & 31, ob = rr * 64 + cc * 2; return st * 1024 + (ob ^ (((ob >> 9) & 1) << 5)); }
DI void g_stage_rc(int b, int& R, int& C) { int st = b / 1024, sb = b % 1024, swz = sb ^ (((sb >> 9) & 1) << 5); R = (st >> 1) * 16 + swz / 64; C = (st & 1) * 32 + (swz % 64) / 2; }

template <bool GATHER, class Epi>
DI void gemm_unit_t(int wv_in, bf16* shm, const bf16* __restrict__ A, int lda, const int* rowmap, int arow0,
                    const bf16* __restrict__ Bt, int ldb, int bcol0, int K, const Epi& epi) {
#define SA(b, h) (shm + ((b) * 2 + (h)) * G_HT)
#define SB(b, h) (shm + (4 + (b) * 2 + (h)) * G_HT)
#define STAGE_AX(T, P, hf, kt) do { for (int _i = 0; _i < 2; ++_i) { int _b = (T) * 16 + _i * 8192; int _r, _c; g_stage_rc(_b, _r, _c); \
        const long _row = GATHER ? (long)rowmap[(hf) * G_HALF + _r] : (long)(arow0 + (hf) * G_HALF + _r); \
        __builtin_amdgcn_global_load_lds((const unsigned*)(A + _row * lda + (long)(kt) * G_BK + _c), (unsigned*)((char*)(P) + _b), 16, 0, 0); } } while (0)
#define STAGE_BX(T, P, hf, kt) do { for (int _i = 0; _i < 2; ++_i) { int _b = (T) * 16 + _i * 8192; int _r, _c; g_stage_rc(_b, _r, _c); \
        __builtin_amdgcn_global_load_lds((const unsigned*)(Bt + (long)(bcol0 + (hf) * G_HALF + _r) * ldb + (long)(kt) * G_BK + _c), (unsigned*)((char*)(P) + _b), 16, 0, 0); } } while (0)
#define STAGE_A(P, hf, kt) STAGE_AX(t0, P, hf, kt)
#define STAGE_B(P, hf, kt) STAGE_BX(t0, P, hf, kt)
#define LDA(dst, b, h) for (int m = 0; m < 4; ++m) for (int k = 0; k < 2; ++k) \
        dst[m][k] = *reinterpret_cast<const bf16x8*>((char*)SA(b, h) + g_lds_byte(wr * 64 + m * 16 + fr, k * 32 + fq * 8))
#define LDB(dst, b, h) for (int n = 0; n < 2; ++n) for (int k = 0; k < 2; ++k) \
        dst[n][k] = *reinterpret_cast<const bf16x8*>((char*)SB(b, h) + g_lds_byte(wc * 32 + n * 16 + fr, k * 32 + fq * 8))
#define MMA(ai, bj, At, Bt_) do { __builtin_amdgcn_s_setprio(1); \
        for (int m = 0; m < 4; ++m) for (int n = 0; n < 2; ++n) for (int k = 0; k < 2; ++k) \
            acc[ai][bj][m][n] = __builtin_amdgcn_mfma_f32_16x16x32_bf16(Bt_[n][k], At[m][k], acc[ai][bj][m][n], 0, 0, 0); \
        __builtin_amdgcn_s_setprio(0); } while (0)
#define WAIT_V(n) asm volatile("s_waitcnt vmcnt(" #n ")" ::: "memory")
#define WAIT_L(n) asm volatile("s_waitcnt lgkmcnt(" #n ")" ::: "memory")
#define BAR __builtin_amdgcn_s_barrier()
#define SCHED __builtin_amdgcn_sched_barrier(0)
    unsigned m0 = ~0u; asm volatile("" : "+s"(m0));
    int t0 = wv_in * 64 + (int)__builtin_amdgcn_mbcnt_hi(m0, __builtin_amdgcn_mbcnt_lo(m0, 0u)); asm volatile("" : "+v"(t0));
    int wid = t0 >> 6, lane = t0 & 63, wr = wid >> 2, wc = wid & 3, fr = lane & 15, fq = lane >> 4;
    f32x4 acc[2][2][4][2] = {};
    bf16x8 At[4][2], B0[2][2], B1[2][2];
    const int nt = K / G_BK;
    STAGE_B(SB(0, 0), 0, 0); STAGE_A(SA(0, 0), 0, 0);
    STAGE_B(SB(0, 1), 1, 0); STAGE_A(SA(0, 1), 1, 0);
    if (wr == 1) BAR;
    WAIT_V(4); BAR;
    STAGE_B(SB(1, 0), 0, 1); STAGE_A(SA(1, 0), 0, 1); STAGE_B(SB(1, 1), 1, 1);
    WAIT_V(6); BAR;
    for (int t = 0; t < nt - 2; t += 2) {
        LDB(B0, 0, 0); SCHED; LDA(At, 0, 0); STAGE_A(SA(1, 1), 1, t + 1);
        WAIT_L(8); BAR; WAIT_L(0); MMA(0, 0, At, B0); BAR; SCHED;
        LDB(B1, 0, 1); STAGE_B(SB(0, 0), 0, t + 2);
        BAR; WAIT_L(0); MMA(0, 1, At, B1); BAR;
        LDA(At, 0, 1); STAGE_A(SA(0, 0), 0, t + 2);
        BAR; WAIT_L(0); MMA(1, 0, At, B0); BAR; SCHED;
        STAGE_B(SB(0, 1), 1, t + 2);
        WAIT_V(6); BAR; MMA(1, 1, At, B1); BAR;
        LDB(B0, 1, 0); SCHED; LDA(At, 1, 0); STAGE_A(SA(0, 1), 1, t + 2);
        WAIT_L(8); BAR; WAIT_L(0); MMA(0, 0, At, B0); BAR; SCHED;
        LDB(B1, 1, 1); STAGE_B(SB(1, 0), 0, t + 3);
        BAR; WAIT_L(0); MMA(0, 1, At, B1); BAR;
        LDA(At, 1, 1); STAGE_A(SA(1, 0), 0, t + 3);
        BAR; WAIT_L(0); MMA(1, 0, At, B0); BAR; SCHED;
        STAGE_B(SB(1, 1), 1, t + 3);
        WAIT_V(6); BAR; MMA(1, 1, At, B1); BAR;
    }
    int tz = t0; asm volatile("" : "+v"(tz)); wid = tz >> 6; lane = tz & 63; wr = wid >> 2; wc = wid & 3; fr = lane & 15; fq = lane >> 4;
    { LDB(B0, 0, 0); WAIT_V(0); LDA(At, 0, 0); STAGE_AX(tz, SA(1, 1), 1, nt - 1);
      BAR; WAIT_L(0); MMA(0, 0, At, B0); BAR;
      LDB(B1, 0, 1); BAR; WAIT_L(0); MMA(0, 1, At, B1); BAR;
      LDA(At, 0, 1); WAIT_V(4); BAR; WAIT_L(0); MMA(1, 0, At, B0); MMA(1, 1, At, B1); BAR; }
    { LDB(B0, 1, 0); LDA(At, 1, 0); WAIT_V(2); BAR; WAIT_L(0); MMA(0, 0, At, B0); BAR;
      LDB(B1, 1, 1); WAIT_V(0); BAR; WAIT_L(0); MMA(0, 1, At, B1); BAR;
      LDA(At, 1, 1); BAR; WAIT_L(0); MMA(1, 0, At, B0); MMA(1, 1, At, B1); BAR; }
    if (wr == 0) BAR;
#pragma unroll
    for (int ai = 0; ai < 2; ++ai)
#pragma unroll
        for (int m = 0; m < 4; ++m)
#pragma unroll
            for (int bj = 0; bj < 2; ++bj)
#pragma unroll
                for (int n = 0; n < 2; ++n) {
                    const f32x4 v = acc[ai][bj][m][n];
                    epi(ai * G_HALF + wr * 64 + m * 16 + fr, bj * G_HALF + wc * 32 + n * 16 + fq * 4, v[0], v[1], v[2], v[3]);
                }
#undef SA
#undef SB
#undef STAGE_A
#undef STAGE_B
#undef STAGE_AX
#undef STAGE_BX
#undef LDA
#undef LDB
#undef MMA
}
template <class Epi>
DI void gemm_unit(const Frame& F, const bf16* __restrict__ A, int lda, const int* rowmap, int arow0,
                  const bf16* __restrict__ Bt, int ldb, int bcol0, int K, const Epi& epi) {
    if (rowmap) gemm_unit_t<true>(F.wv, (bf16*)F.smem, A, lda, rowmap, arow0, Bt, ldb, bcol0, K, epi);
    else gemm_unit_t<false>(F.wv, (bf16*)F.smem, A, lda, rowmap, arow0, Bt, ldb, bcol0, K, epi);
}
#else
template <class Epi>
void gemm_unit(const Frame& F, const bf16* A, int lda, const int* rowmap, int arow0, const bf16* Bt, int ldb, int bcol0, int K, const Epi& epi, int mrows = 256) {
    for (int r = 0; r < mrows; ++r) {
        int arow = rowmap ? rowmap[r] : arow0 + r;
        for (int c = 0; c < 256; c += 4) {
            float v[4];
            for (int q = 0; q < 4; ++q) {
                double s = 0; const bf16* a = A + (long)arow * lda; const bf16* b = Bt + (long)(bcol0 + c + q) * ldb;
                for (int k = 0; k < K; ++k) s += (double)bf2f(a[k]) * bf2f(b[k]);
                v[q] = (float)s;
            }
            epi(r, c, v[0], v[1], v[2], v[3]);
        }
    }
}
#endif

DI void st_bf16x4(bf16* p, float a, float b, float c, float d) {
#ifndef CPU_EMU
    uint2 u; u.x = pack_bf16(a, b); u.y = pack_bf16(c, d); *reinterpret_cast<uint2*>(p) = u;
#else
    p[0] = f2bf(a); p[1] = f2bf(b); p[2] = f2bf(c); p[3] = f2bf(d);
#endif
}

#define WSP(T, off) ((T*)(F.ws + (off)))

DI void ln_row_write(float* xrow, bf16* brow, const float* vals_in  , const float* g, const float* b);

template <class Fn>
DI void layer_norm_rows(const Frame& F, const float* g, const float* b, Fn pre, bool write_out_extra, float* extra) {
    float* xf = F.xf; bf16* xb = WSP(bf16, OFF_XB);
    for (int row = ggrp(F); row < NTOK; row += ngrp(F)) {
        float v[PERLN]; float s = 0.f;
        for (int i = 0; i < PERLN; ++i) { int c = glane(F) + i * GRP; v[i] = pre(row, c); s += v[i]; }
        s = grp_sum(F, s); const float mu = s * (1.0f / 1024.0f);
        float q = 0.f;
        for (int i = 0; i < PERLN; ++i) { float d = v[i] - mu; q += d * d; }
        q = grp_sum(F, q); const float rs = 1.0f / sqrtf(q * (1.0f / 1024.0f) + LN_EPS);
        for (int i = 0; i < PERLN; ++i) { int c = glane(F) + i * GRP; float y = (v[i] - mu) * rs * g[c] + b[c];
            xf[(size_t)row * DM + c] = y; xb[(size_t)row * DM + c] = f2bf(y); if (write_out_extra) extra[(size_t)row * DM + c] = y; }
    }
}

DI void phase_pro(const Frame& F) {
    const float* x = F.in[0]; const float* mem = F.in[1];
    layer_norm_rows(F, F.in[2], F.in[3], [&](int row, int c) { return x[(size_t)row * DM + c]; }, false, nullptr);
    bf16* memb = WSP(bf16, OFF_MEMB);
    for (size_t i = gtid_(F); i < (size_t)NMEM * DM; i += gthreads(F)) memb[i] = f2bf(mem[i]);
}

template <class Src>
DI void cvt_tile(const Frame& F, bf16* dst, int Kk, int n0, int k0, Src src) {
#ifndef CPU_EMU
    float* tile = (float*)F.smem;
    __syncthreads();
    for (int i = F.tid; i < 4096; i += NTH) { int k = i >> 6, n = i & 63; tile[k * 65 + n] = src(k0 + k, n0 + n); }
    __syncthreads();
    for (int i = F.tid; i < 2048; i += NTH) { int n = i >> 5, k = (i & 31) * 2;
        *reinterpret_cast<unsigned*>(dst + (size_t)(n0 + n) * Kk + k0 + k) = pack_bf16(tile[k * 65 + n], tile[(k + 1) * 65 + n]); }
#endif
}
template <class Src>
DI void cvt_transpose(const Frame& F, bf16* dst, int Nn, int Kk, Src src, int t_first, int t_total) {
#ifdef CPU_EMU
    for (int n = 0; n < Nn; ++n) for (int k = 0; k < Kk; ++k) dst[(size_t)n * Kk + k] = f2bf(src(k, n));
#else
    const int tn = Nn / 64, tk = Kk / 64, ntile = tn * tk;
    int t = (int)blockIdx.x - (t_first % (int)F.nblk); if (t < 0) t += F.nblk;
    for (; t < ntile; t += F.nblk) cvt_tile(F, dst, Kk, (t % tn) * 64, (t / tn) * 64, src);
#endif
}

DI int win_src_col(int n) {
    if (n < 512) return n;
    if (n < 1536) { int c = n - 512; return c < 960 ? 512 + c : -1; }
    if (n < 2816) return 1472 + (n - 1536);
    int c = n - 2816;
    if (c < 192) return 2752 + c;
    if (c < 224) return 2752 + 320 + (c - 192);
    if (c < 256) return -1;
    if (c < 384) return 2752 + 192 + (c - 256);
    return -1;
}
DI int wuq_src_col(int n) {
    if (n >= 384) return -1;
    int h = n / 96, w = n % 96;
    if (w < 64) return h * 96 + w;
    int p = w - 64, m = p >> 1, which = p & 1;
    int i = (m < 8 ? m : 16 + (m - 8)) + (which ? 8 : 0);
    return h * 96 + 64 + i;
}

DI void phase_cvt(const Frame& F, int l) {
    bf16* wts = WSP(bf16, OFF_WTS);
    constexpr int T0 = 0, T1 = T0 + (HP / 64) * 16, T2 = T1 + 8 * 4, T3 = T2 + 8 * 4, T4 = T3 + 256, T5 = T4 + 256, T6 = T5 + 512, TT = T6 + 256;
    { const float* w = F.in[4] + (size_t)l * 1024 * IN_WIDTH;
      cvt_transpose(F, (bf16*)((char*)wts + W_IN_T), HP, 1024, [&](int k, int n) { int s = win_src_col(n); return s < 0 ? 0.f : w[(size_t)k * IN_WIDTH + s]; }, T0, TT); }
    { const float* w = F.in[23] + (size_t)l * 192 * 384;
      cvt_transpose(F, (bf16*)((char*)wts + W_UQ_T), 512, 256, [&](int k, int n) { int s = wuq_src_col(n); return (s < 0 || k >= 192) ? 0.f : w[(size_t)k * 384 + s]; }, T1, TT); }
    { const float* w = F.in[24] + (size_t)l * 128 * 512;
      cvt_transpose(F, (bf16*)((char*)wts + W_UKV_T), 512, 256, [&](int k, int n) { return k >= 128 ? 0.f : w[(size_t)k * 512 + n]; }, T2, TT); }
    { const float* w = F.in[25] + (size_t)l * 1024 * 1024;
      cvt_transpose(F, (bf16*)((char*)wts + W_OUT_T), 1024, 1024, [&](int k, int n) { return w[(size_t)k * 1024 + n]; }, T3, TT); }
    { const float* w = F.in[28] + (size_t)l * 1024 * 1024;
      cvt_transpose(F, (bf16*)((char*)wts + W_Q_T), 1024, 1024, [&](int k, int n) { return w[(size_t)k * 1024 + n]; }, T4, TT); }
    { const float* w = F.in[29] + (size_t)l * 1024 * 2048;
      cvt_transpose(F, (bf16*)((char*)wts + W_KV_T), 2048, 1024, [&](int k, int n) { return w[(size_t)k * 2048 + n]; }, T5, TT); }
    { const float* w = F.in[30] + (size_t)l * 1024 * 1024;
      cvt_transpose(F, (bf16*)((char*)wts + W_O_T), 1024, 1024, [&](int k, int n) { return w[(size_t)k * 1024 + n]; }, T6, TT); }
}

DI void phase_cvt_moe(const Frame& F, int l) {
#ifdef CPU_EMU
    for (int e = 0; e < NEXP; ++e) {
        const float* w1 = F.in[37] + ((size_t)l * NEXP + e) * 1024 * 256;
        const float* w3 = F.in[38] + ((size_t)l * NEXP + e) * 1024 * 256;
        const float* w2 = F.in[39] + ((size_t)l * NEXP + e) * 256 * 1024;
        cvt_transpose(F, WSP(bf16, OFF_W13T) + (size_t)e * 512 * 1024, 512, 1024,
                      [&](int k, int n) { return (n & 1) ? w3[(size_t)k * 256 + (n >> 1)] : w1[(size_t)k * 256 + (n >> 1)]; }, 0, 1);
        cvt_transpose(F, WSP(bf16, OFF_W2T) + (size_t)e * 1024 * 256, 1024, 256, [&](int k, int n) { return w2[(size_t)k * 1024 + n]; }, 0, 1);
    }
#else
    const float* w1b = F.in[37] + (size_t)l * NEXP * 1024 * 256; const float* w3b = F.in[38] + (size_t)l * NEXP * 1024 * 256; const float* w2b = F.in[39] + (size_t)l * NEXP * 256 * 1024;
    for (int t = blockIdx.x; t < NEXP * 128 + NEXP * 64; t += F.nblk) {
        if (t < NEXP * 128) {
            const int e = t >> 7, tt = t & 127; const float* w1 = w1b + (size_t)e * 1024 * 256; const float* w3 = w3b + (size_t)e * 1024 * 256;
            cvt_tile(F, WSP(bf16, OFF_W13T) + (size_t)e * 512 * 1024, 1024, (tt & 7) * 64, (tt >> 3) * 64,
                     [&](int k, int n) { return (n & 1) ? w3[(size_t)k * 256 + (n >> 1)] : w1[(size_t)k * 256 + (n >> 1)]; });
        } else {
            const int u = t - NEXP * 128, e = u >> 6, tt = u & 63; const float* w2 = w2b + (size_t)e * 256 * 1024;
            cvt_tile(F, WSP(bf16, OFF_W2T) + (size_t)e * 1024 * 256, 256, (tt & 15) * 64, (tt >> 4) * 64, [&](int k, int n) { return w2[(size_t)k * 1024 + n]; });
        }
    }
#endif
}

struct EpiH {
    bf16* hatt; bf16* hrwkv; bf16* hhgrn; bf16* hmla; int row0, pn;
    DI void operator()(int r, int c, float a, float b, float cc, float d) const {
        const size_t row = row0 + r;
        bf16* p;
        if (pn < 2) p = hatt + row * 512 + pn * 256 + c;
        else if (pn < 6) p = hrwkv + row * 1024 + (pn - 2) * 256 + c;
        else if (pn < 11) p = hhgrn + row * 1280 + (pn - 6) * 256 + c;
        else p = hmla + row * 512 + (pn - 11) * 256 + c;
        st_bf16x4(p, a, b, cc, d);
    }
};
struct EpiKV {
    bf16* kmem; bf16* vt; int row0, pn;
    DI void operator()(int r, int c, float a, float b, float cc, float d) const {
        const int row = row0 + r, col = pn * 256 + c;
        if (col < 1024) { st_bf16x4(kmem + (size_t)row * 1024 + col, a, b, cc, d); }
        else { const int bb = row / MEMT, key = row % MEMT, hc = col - 1024;
            bf16* p = vt + ((size_t)bb * 1024 + hc) * MEMT + key;
            p[0] = f2bf(a); p[MEMT] = f2bf(b); p[2 * MEMT] = f2bf(cc); p[3 * MEMT] = f2bf(d); }
    }
};

DI void phase_gemm1(const Frame& F) {
    const bf16* xb = WSP(bf16, OFF_XB); const bf16* wts = WSP(bf16, OFF_WTS);
    const int nM = (NTOK + 255) / 256, nN = HP / 256, n1 = nM * nN;
    const int nMk = (NMEM + 255) / 256, nNk = 8, n2 = nMk * nNk;
    for (int u = blockIdx.x; u < n1 + n2; u += F.nblk) {
        if (u < n1) {
            const int pm = u / nN, pn = u % nN;
            EpiH E{WSP(bf16, OFF_HATT), WSP(bf16, OFF_HRWKV), WSP(bf16, OFF_HHGRN), WSP(bf16, OFF_HMLA), pm * 256, pn};
#ifdef CPU_EMU
            gemm_unit(F, xb, 1024, nullptr, pm * 256, (const bf16*)((const char*)wts + W_IN_T), 1024, pn * 256, 1024, E, min(256, NTOK - pm * 256));
#else
            gemm_unit(F, xb, 1024, nullptr, pm * 256, (const bf16*)((const char*)wts + W_IN_T), 1024, pn * 256, 1024, E);
#endif
        } else {
            const int v = u - n1, pm = v / nNk, pn = v % nNk;
            EpiKV E{WSP(bf16, OFF_KMEM), WSP(bf16, OFF_VTMEM), pm * 256, pn};
            gemm_unit(F, WSP(bf16, OFF_MEMB), 1024, nullptr, pm * 256, (const bf16*)((const char*)wts + W_KV_T), 1024, pn * 256, 1024, E);
        }
    }
}


#ifndef CPU_EMU
DI float fast_sigmoid(float x) { return 1.0f / (1.0f + __expf(-x)); }
DI float fast_tanh(float x) { const float e = __expf(2.0f * x); return 1.0f - 2.0f / (e + 1.0f); }
DI void prep_rwkv_gpu(const Frame& F, int l) {
    const bf16* hz = WSP(bf16, OFF_HRWKV); bf16* r7 = WSP(bf16, OFF_R7); bf16* gb = WSP(bf16, OFF_G); float* bonus = WSP(float, OFF_BONUS);
    const float* mup = F.in[7] + l * 960; const float* mun = F.in[8] + l * 960;
    const float* w0 = F.in[9] + l * 512; const float* w2 = F.in[10] + (size_t)l * 2 * 32 * 256;
    const float* a0 = F.in[11] + l * 512; const float* a2 = F.in[12] + (size_t)l * 2 * 32 * 256;
    const float* g2 = F.in[13] + (size_t)l * 64 * 256;
    const float* k_k = F.in[14] + l * 256; const float* k_a = F.in[15] + l * 256; const float* r_k = F.in[16] + l * 256;
    const size_t AS = (size_t)NTOK * 256;
    float* zs = (float*)F.smem;
    const int tid = F.tid;
    for (int tile = blockIdx.x; tile < NTOK / 16; tile += F.nblk) {
        const int n0 = tile * 16;
        __syncthreads();
        for (int e = tid; e < 16 * 480; e += NTH) {
            const int t = e / 480, c = (e % 480) * 2, n = n0 + t, s = n % SEQ;
            const unsigned zc = *reinterpret_cast<const unsigned*>(hz + (size_t)n * 1024 + c);
            const unsigned zp = s > 0 ? *reinterpret_cast<const unsigned*>(hz + (size_t)(n - 1) * 1024 + c) : 0u;
            const unsigned zn = s < SEQ - 1 ? *reinterpret_cast<const unsigned*>(hz + (size_t)(n + 1) * 1024 + c) : 0u;
#pragma unroll
            for (int q = 0; q < 2; ++q) {
                const float z = q ? __uint_as_float(zc & 0xffff0000u) : __uint_as_float(zc << 16);
                const float p = q ? __uint_as_float(zp & 0xffff0000u) : __uint_as_float(zp << 16);
                const float nx = q ? __uint_as_float(zn & 0xffff0000u) : __uint_as_float(zn << 16);
                float v = z + mup[c + q] * (p - z) + mun[c + q] * (nx - z);
                const int cc = c + q;
                if (cc >= 768 && cc < 832) v = fast_tanh(v);
                else if (cc >= 896) v = fast_sigmoid(v);
                zs[t * 960 + cc] = v;
            }
        }
        __syncthreads();
        const int c = tid & 255, tg = tid >> 8;
        float wr0[8], wr1[8], ar0[8], ar1[8], gg[8];
#pragma unroll
        for (int t = 0; t < 8; ++t) { wr0[t] = w0[c]; wr1[t] = w0[256 + c]; ar0[t] = a0[c]; ar1[t] = a0[256 + c]; gg[t] = 0.f; }
        for (int q = 0; q < 32; q += 4) {
            float wa[4], wb[4], aa[4], ab[4];
#pragma unroll
            for (int u = 0; u < 4; ++u) { wa[u] = w2[(size_t)(q + u) * 256 + c]; wb[u] = w2[(size_t)(32 + q + u) * 256 + c]; aa[u] = a2[(size_t)(q + u) * 256 + c]; ab[u] = a2[(size_t)(32 + q + u) * 256 + c]; }
#pragma unroll
            for (int t = 0; t < 8; ++t) {
                const float* zr = zs + (tg * 8 + t) * 960;
                const float4 x0 = *reinterpret_cast<const float4*>(zr + 768 + q), x1 = *reinterpret_cast<const float4*>(zr + 800 + q);
                const float4 y0 = *reinterpret_cast<const float4*>(zr + 832 + q), y1 = *reinterpret_cast<const float4*>(zr + 864 + q);
                wr0[t] += x0.x * wa[0] + x0.y * wa[1] + x0.z * wa[2] + x0.w * wa[3];
                wr1[t] += x1.x * wb[0] + x1.y * wb[1] + x1.z * wb[2] + x1.w * wb[3];
                ar0[t] += y0.x * aa[0] + y0.y * aa[1] + y0.z * aa[2] + y0.w * aa[3];
                ar1[t] += y1.x * ab[0] + y1.y * ab[1] + y1.z * ab[2] + y1.w * ab[3];
            }
        }
        for (int q = 0; q < 64; q += 4) {
            float ga[4];
#pragma unroll
            for (int u = 0; u < 4; ++u) ga[u] = g2[(size_t)(q + u) * 256 + c];
#pragma unroll
            for (int t = 0; t < 8; ++t) {
                const float4 x = *reinterpret_cast<const float4*>(zs + (tg * 8 + t) * 960 + 896 + q);
                gg[t] += x.x * ga[0] + x.y * ga[1] + x.z * ga[2] + x.w * ga[3];
            }
        }
        const float kkc = k_k[c], kac = k_a[c], rkc = r_k[c];
#pragma unroll
        for (int t = 0; t < 8; ++t) {
            const int n = n0 + tg * 8 + t; const float* zr = zs + (tg * 8 + t) * 960;
            const float r = zr[c], k = zr[256 + c], v = zr[512 + c];
            const float dec0 = __expf(-DECAY_SCALE * fast_sigmoid(wr0[t])), dec1 = __expf(-DECAY_SCALE * fast_sigmoid(wr1[t]));
            const float A0 = fast_sigmoid(ar0[t]), A1 = fast_sigmoid(ar1[t]);
            const float kk = k * kkc;
            const float kd0 = k * (1.0f + (A0 - 1.0f) * kac), kd1 = k * (1.0f + (A1 - 1.0f) * kac);
            const float ss = grp_sum(F, kk * kk);
            const float bs = grp_sum(F, r * (kd0 + kd1) * rkc);
            const float kkn = kk * (1.0f / fmaxf(sqrtf(ss), 1e-12f));
            const size_t o = (size_t)n * 256 + c;
            r7[R_R * AS + o] = f2bf(r); r7[R_V * AS + o] = f2bf(v);
            r7[R_W0 * AS + o] = f2bf(dec0); r7[R_W1 * AS + o] = f2bf(dec1);
            r7[R_KD0 * AS + o] = f2bf(kd0); r7[R_KD1 * AS + o] = f2bf(kd1);
            r7[R_KK * AS + o] = f2bf(kkn); r7[R_AK0 * AS + o] = f2bf(A0 * kkn); r7[R_AK1 * AS + o] = f2bf(A1 * kkn);
            gb[o] = f2bf(gg[t]);
            if ((tid & 63) == 0) bonus[(size_t)n * 4 + (c >> 6)] = bs;
        }
    }
}
#endif

DI void phase_prep(const Frame& F, int l) {
    {
        bf16* hatt = WSP(bf16, OFF_HATT); bf16* vt = WSP(bf16, OFF_VTATT);
        const float* qn = F.in[5] + l * 64; const float* kn = F.in[6] + l * 64;
        const int nitem = NTOK * 6;
        for (int it = ggrp(F); it < nitem; it += ngrp(F)) {
            const int n = it / 6, hh = it % 6;
            const int s = n % SEQ;
            bf16* p = hatt + (size_t)n * 512 + hh * 64;
            const float* gn = hh < 4 ? qn : kn;
            float v[PER64]; float ss = 0.f;
            for (int i = 0; i < PER64; ++i) { int j = glane(F) + i * GRP; v[i] = bf2f(p[j]); ss += v[i] * v[i]; }
            ss = grp_sum(F, ss); const float rs = 1.0f / sqrtf(ss * (1.0f / 64.0f) + RMS_EPS);
            float o[PER64];
#ifdef CPU_EMU
            float nv[64]; for (int j = 0; j < 64; ++j) nv[j] = v[j] * rs * gn[j];
#endif
            for (int i = 0; i < PER64; ++i) {
                int j = glane(F) + i * GRP;
                const int half = j >> 5, w = j & 31, f = w & 15, second = w >> 4;
                const float pos = half == 0 ? (float)(s / GRIDW) : (float)(s % GRIDW);
                const float ang = pos * rope_inv(2 * f, 32);
                const float cs = cosf(ang), sn = sinf(ang);
                const float mine = v[i] * rs * gn[j];
                const int jp = second ? j - 16 : j + 16;
#ifdef CPU_EMU
                const float partner = nv[jp];
#else
                const float partner = shfl_idx(F, v[0], jp) * rs * gn[jp];
#endif
                o[i] = second ? (partner * sn + mine * cs) : (mine * cs - partner * sn);
            }
            for (int i = 0; i < PER64; ++i) { int j = glane(F) + i * GRP; p[j] = f2bf(o[i]); }
        }
        for (size_t i = gtid_(F); i < (size_t)NTOK * 128; i += gthreads(F)) {
            const int n = (int)(i / 128), c = (int)(i % 128), b = n / SEQ, s = n % SEQ;
            vt[((size_t)b * 128 + c) * SEQ + s] = hatt[(size_t)n * 512 + 384 + c];
        }
    }
    {
        bf16* hm = WSP(bf16, OFF_HMLA); bf16* kr = WSP(bf16, OFF_KROPE);
        const float* qn = F.in[21] + l * 192; const float* kvn = F.in[22] + l * 128;
        for (int it = ggrp(F); it < NTOK * 2; it += ngrp(F)) {
            const int n = it >> 1, which = it & 1;
            bf16* p = hm + (size_t)n * 512 + (which ? 256 : 0);
            const int len = which ? 128 : 192; const float* gn = which ? kvn : qn;
            float ss = 0.f;
            for (int j = glane(F); j < len; j += GRP) { float x = bf2f(p[j]); ss += x * x; }
            ss = grp_sum(F, ss); const float rs = 1.0f / sqrtf(ss / (float)len + RMS_EPS);
            for (int j = glane(F); j < len; j += GRP) p[j] = f2bf(bf2f(p[j]) * rs * gn[j]);
        }
        for (int i = gtid_(F); i < NTOK * 16; i += gthreads(F)) {
            const int n = i >> 4, m = i & 15, s = n % SEQ;
            const bf16* src = hm + (size_t)n * 512 + 192;
            const int i1 = (m < 8 ? m : 16 + (m - 8)), i2 = i1 + 8;
            const float x1 = bf2f(src[i1]), x2 = bf2f(src[i2]);
            const float pos = m < 8 ? (float)(s / GRIDW) : (float)(s % GRIDW);
            const float ang = pos * rope_inv(2 * (m & 7), 16);
            const float cs = cosf(ang), sn = sinf(ang);
            kr[(size_t)n * 32 + 2 * m] = f2bf(x1 * cs - x2 * sn);
            kr[(size_t)n * 32 + 2 * m + 1] = f2bf(x1 * sn + x2 * cs);
        }
    }
#ifdef CPU_EMU
    {
        const bf16* hz = WSP(bf16, OFF_HRWKV); bf16* r7 = WSP(bf16, OFF_R7); bf16* gb = WSP(bf16, OFF_G); float* bonus = WSP(float, OFF_BONUS);
        const float* mup = F.in[7] + l * 960; const float* mun = F.in[8] + l * 960;
        const float* w0 = F.in[9] + l * 512; const float* w2 = F.in[10] + (size_t)l * 2 * 32 * 256;
        const float* a0 = F.in[11] + l * 512; const float* a2 = F.in[12] + (size_t)l * 2 * 32 * 256;
        const float* g2 = F.in[13] + (size_t)l * 64 * 256;
        const float* k_k = F.in[14] + l * 256; const float* k_a = F.in[15] + l * 256; const float* r_k = F.in[16] + l * 256;
        const size_t AS = (size_t)NTOK * 256;
        for (int it = ggrp(F); it < NTOK * 4; it += ngrp(F)) {
            const int n = it >> 2, h = it & 3, s = n % SEQ;
            const bf16* z = hz + (size_t)n * 1024;
            const bool hp = s > 0, hn = s < SEQ - 1;
            auto shifted = [&](int c) -> float {
                const float zc = bf2f(z[c]);
                const float zp = hp ? bf2f(z[c - 1024]) : 0.f, zn = hn ? bf2f(z[c + 1024]) : 0.f;
                return zc + mup[c] * (zp - zc) + mun[c] * (zn - zc);
            };
            float kkv[PER64], rr[PER64], kd0[PER64], kd1[PER64], aa0[PER64], aa1[PER64];
            float ss = 0.f, bs = 0.f;
            for (int i = 0; i < PER64; ++i) {
                const int j = glane(F) + i * GRP, c = h * 64 + j;
                const float r = shifted(c), k = shifted(256 + c), v = shifted(512 + c);
                float wr0 = w0[c], wr1 = w0[256 + c], ar0 = a0[c], ar1 = a0[256 + c], g = 0.f;
                for (int q = 0; q < 32; ++q) {
                    wr0 += tanhf(shifted(768 + q)) * w2[(size_t)q * 256 + c];
                    wr1 += tanhf(shifted(800 + q)) * w2[(size_t)(32 + q) * 256 + c];
                    ar0 += shifted(832 + q) * a2[(size_t)q * 256 + c];
                    ar1 += shifted(864 + q) * a2[(size_t)(32 + q) * 256 + c];
                }
                for (int q = 0; q < 64; ++q) g += sigmoidf_(shifted(896 + q)) * g2[(size_t)q * 256 + c];
                const float dec0 = expf(-DECAY_SCALE * sigmoidf_(wr0)), dec1 = expf(-DECAY_SCALE * sigmoidf_(wr1));
                const float A0 = sigmoidf_(ar0), A1 = sigmoidf_(ar1);
                const float kk = k * k_k[c];
                kkv[i] = kk; ss += kk * kk; rr[i] = r; aa0[i] = A0; aa1[i] = A1;
                kd0[i] = k * (1.0f + (A0 - 1.0f) * k_a[c]); kd1[i] = k * (1.0f + (A1 - 1.0f) * k_a[c]);
                bs += r * (kd0[i] + kd1[i]) * r_k[c];
                const size_t o = (size_t)n * 256 + c;
                r7[R_R * AS + o] = f2bf(r); r7[R_V * AS + o] = f2bf(v);
                r7[R_W0 * AS + o] = f2bf(dec0); r7[R_W1 * AS + o] = f2bf(dec1);
                r7[R_KD0 * AS + o] = f2bf(kd0[i]); r7[R_KD1 * AS + o] = f2bf(kd1[i]);
                gb[o] = f2bf(g);
            }
            ss = grp_sum(F, ss); bs = grp_sum(F, bs);
            const float inv = 1.0f / fmaxf(sqrtf(ss), 1e-12f);
            for (int i = 0; i < PER64; ++i) {
                const int j = glane(F) + i * GRP, c = h * 64 + j; const size_t o = (size_t)n * 256 + c;
                const float kk = kkv[i] * inv;
                r7[R_KK * AS + o] = f2bf(kk); r7[R_AK0 * AS + o] = f2bf(aa0[i] * kk); r7[R_AK1 * AS + o] = f2bf(aa1[i] * kk);
            }
            if (glane(F) == 0) bonus[(size_t)n * 4 + h] = bs;
        }
    }
#else
    prep_rwkv_gpu(F, l);
#endif
    {
        bf16* hh = WSP(bf16, OFF_HHGRN);
        const float* lg = F.in[19];
        for (size_t i = gtid_(F); i < (size_t)NTOK * 768; i += gthreads(F)) {
            const int n = (int)(i / 768), c = (int)(i % 768);
            bf16* p = hh + (size_t)n * 1280 + c;
            const float x = bf2f(*p);
            if (c < 256) { *p = f2bf(siluf_(x)); }
            else {
                const int d = c & 255;
                float lb = 0.f;
                if (l == 1) { const float a = lg[d], b = lg[256 + d]; const float m = fmaxf(a, b); const float ea = expf(a - m), eb = expf(b - m); lb = eb / (ea + eb); }
                *p = f2bf((1.0f - lb) * sigmoidf_(-x));
            }
        }
    }
}

struct EpiQMla {
    bf16* q; int row0, pn;
    DI void operator()(int r, int c, float a, float b, float cc, float d) const {
        const int row = row0 + r, col = pn * 256 + c;
        if (col >= 384) return;
        const int w = col % 96;
        if (w >= 64) {
            const int s = row % SEQ;
#pragma unroll
            for (int t = 0; t < 2; ++t) {
                const int m = ((w - 64) >> 1) + t;
                const float pos = m < 8 ? (float)(s / GRIDW) : (float)(s % GRIDW);
                const float ang = pos * rope_inv(2 * (m & 7), 16);
                const float cs = cosf(ang), sn = sinf(ang);
                float& x1 = t ? cc : a; float& x2 = t ? d : b;
                const float y1 = x1 * cs - x2 * sn, y2 = x1 * sn + x2 * cs; x1 = y1; x2 = y2;
            }
        }
        st_bf16x4(q + (size_t)row * 384 + col, a, b, cc, d);
    }
};
struct EpiKVMla {
    bf16* kn; bf16* vt; int row0, pn;
    DI void operator()(int r, int c, float a, float b, float cc, float d) const {
        const int row = row0 + r, col = pn * 256 + c, h = col >> 7, w = col & 127;
        if (w < 64) st_bf16x4(kn + (size_t)row * 256 + h * 64 + w, a, b, cc, d);
        else { const int bb = row / SEQ, s = row % SEQ; bf16* p = vt + ((size_t)bb * 256 + h * 64 + (w - 64)) * SEQ + s;
            p[0] = f2bf(a); p[SEQ] = f2bf(b); p[2 * SEQ] = f2bf(cc); p[3 * SEQ] = f2bf(d); }
    }
};
DI void phase_mlaup(const Frame& F) {
    const bf16* hm = WSP(bf16, OFF_HMLA); const char* wts = (const char*)WSP(bf16, OFF_WTS);
    const int nM = (NTOK + 255) / 256;
    for (int u = blockIdx.x; u < nM * 4; u += F.nblk) {
        const int pm = u >> 2, j = u & 3;
#ifdef CPU_EMU
        const int mr = min(256, NTOK - pm * 256);
#define MR , mr
#else
#define MR
#endif
        if (j < 2) { EpiQMla E{WSP(bf16, OFF_QMLA), pm * 256, j};
            gemm_unit(F, hm, 512, nullptr, pm * 256, (const bf16*)(wts + W_UQ_T), 256, j * 256, 256, E MR); }
        else { EpiKVMla E{WSP(bf16, OFF_KNOPE), WSP(bf16, OFF_VTMLA), pm * 256, j - 2};
            gemm_unit(F, hm + 256, 512, nullptr, pm * 256, (const bf16*)(wts + W_UKV_T), 256, (j - 2) * 256, 256, E MR); }
    }
}

struct AttnDesc {
    const bf16* q; int q_stride;
    int q_hstride;
    const bf16* k; int k_stride; int k_hstride;
    const bf16* k2; int k2_stride;
    int dk_main;
    const bf16* vt;
    bf16* o; int o_stride; int o_hstride;
    int H, HKV, SQ, SK;
    float scale;
};

#ifdef CPU_EMU
template <int DK, int DV>
void attn_phase(const Frame& F, const AttnDesc& A) {
    const int G = A.H / A.HKV;
    float* sc = (float*)malloc(sizeof(float) * A.SK);
    for (int b = 0; b < BATCH; ++b) for (int h = 0; h < A.H; ++h) for (int s = 0; s < A.SQ; ++s) {
        const int kv = h / G;
        const bf16* q = A.q + (size_t)(b * A.SQ + s) * A.q_stride + h * A.q_hstride;
        float mx = -1e30f;
        for (int key = 0; key < A.SK; ++key) {
            const bf16* kp = A.k + (size_t)(b * A.SK + key) * A.k_stride + kv * A.k_hstride;
            double acc = 0;
            for (int d = 0; d < DK; ++d) {
                float kvl = d < A.dk_main ? bf2f(kp[d]) : bf2f(A.k2[(size_t)(b * A.SK + key) * A.k2_stride + d - A.dk_main]);
                acc += (double)bf2f(q[d]) * kvl;
            }
            sc[key] = (float)acc * A.scale; mx = fmaxf(mx, sc[key]);
        }
        double sum = 0; for (int key = 0; key < A.SK; ++key) { sc[key] = expf(sc[key] - mx); sum += sc[key]; }
        for (int dv = 0; dv < DV; ++dv) {
            const bf16* vp = A.vt + ((size_t)(b * A.HKV + kv) * DV + dv) * A.SK;
            double acc = 0; for (int key = 0; key < A.SK; ++key) acc += (double)bf2f(f2bf(sc[key])) * bf2f(vp[key]);
            A.o[(size_t)(b * A.SQ + s) * A.o_stride + h * A.o_hstride + dv] = f2bf((float)(acc / sum));
        }
    }
    free(sc);
}
#else
DI int crow16(int reg, int h) { return (reg & 3) + 8 * (reg >> 2) + 4 * h; }
template <int DK, int DV, int DVT>
DI void attn_unit(const Frame& F, const AttnDesc& A, int u) {
    constexpr int KP = DK + 8;
    constexpr int VP = 64 + 8;
    constexpr int NPASS = DV / DVT;
    bf16* Ks = (bf16*)F.smem;
    bf16* Vs = Ks + 64 * KP;
    const int tid = F.tid, wave = tid >> 6, lane = tid & 63, r = lane & 31, hh = lane >> 5;
    const int G = A.H / A.HKV;
    const int nqb = A.SQ / 256;
    const float sl2 = A.scale * 1.4426950408889634f;
    {
        int t = u; const int pass = t % NPASS; t /= NPASS; const int qb = t % nqb; t /= nqb; const int h = t % A.H; const int b = t / A.H;
        const int kv = h / G;
        const int q0 = qb * 256 + wave * 32;
        bf16x8 qf[DK / 16];
        { const bf16* qp = A.q + (size_t)(b * A.SQ + q0 + r) * A.q_stride + h * A.q_hstride + 8 * hh;
#pragma unroll
          for (int ks = 0; ks < DK / 16; ++ks) qf[ks] = *reinterpret_cast<const bf16x8*>(qp + 16 * ks); }
        f32x16 oacc[DVT / 32];
#pragma unroll
        for (int i = 0; i < DVT / 32; ++i)
#pragma unroll
            for (int j = 0; j < 16; ++j) oacc[i][j] = 0.f;
        float mrun = -INFINITY, lrun = 0.f;
        for (int kt = 0; kt < A.SK / 64; ++kt) {
            __syncthreads();
            for (int c = tid; c < 64 * (DK / 8); c += 512) {
                const int key = c / (DK / 8), d8 = (c % (DK / 8)) * 8;
                const size_t krow = (size_t)(b * A.SK + kt * 64 + key);
                uint4 v;
                if (d8 < A.dk_main) v = *reinterpret_cast<const uint4*>(A.k + krow * A.k_stride + kv * A.k_hstride + d8);
                else v = *reinterpret_cast<const uint4*>(A.k2 + krow * A.k2_stride + (d8 - A.dk_main));
                *reinterpret_cast<uint4*>(Ks + key * KP + d8) = v;
            }
            for (int c = tid; c < DVT * 8; c += 512) {
                const int dv = c >> 3, k8 = (c & 7) * 8;
                const uint4 v = *reinterpret_cast<const uint4*>(A.vt + ((size_t)(b * A.HKV + kv) * DV + pass * DVT + dv) * A.SK + kt * 64 + k8);
                *reinterpret_cast<uint4*>(Vs + dv * VP + k8) = v;
            }
            __syncthreads();
            f32x16 sacc[2];
#pragma unroll
            for (int kb = 0; kb < 2; ++kb) {
#pragma unroll
                for (int j = 0; j < 16; ++j) sacc[kb][j] = 0.f;
#pragma unroll
                for (int ks = 0; ks < DK / 16; ++ks) {
                    const bf16x8 kf = *reinterpret_cast<const bf16x8*>(Ks + (kb * 32 + r) * KP + 16 * ks + 8 * hh);
                    sacc[kb] = __builtin_amdgcn_mfma_f32_32x32x16_bf16(kf, qf[ks], sacc[kb], 0, 0, 0);
                }
            }
            float mx = -INFINITY;
#pragma unroll
            for (int kb = 0; kb < 2; ++kb)
#pragma unroll
                for (int j = 0; j < 16; ++j) mx = fmaxf(mx, sacc[kb][j]);
            mx = fmaxf(mx, shfl_xor(F, mx, 32));
            const float mnew = fmaxf(mrun, mx * sl2);
            const float alpha = exp2f(mrun - mnew);
            mrun = mnew;
            float psum = 0.f;
#pragma unroll
            for (int kb = 0; kb < 2; ++kb)
#pragma unroll
                for (int j = 0; j < 16; ++j) { const float p = exp2f(sacc[kb][j] * sl2 - mnew); sacc[kb][j] = p; psum += p; }
            lrun = lrun * alpha + psum;
#pragma unroll
            for (int i = 0; i < DVT / 32; ++i)
#pragma unroll
                for (int j = 0; j < 16; ++j) oacc[i][j] *= alpha;
#pragma unroll
            for (int kb = 0; kb < 2; ++kb)
#pragma unroll
                for (int s2 = 0; s2 < 2; ++s2) {
                    union { bf16x8 v; unsigned u[4]; } pf;
#pragma unroll
                    for (int j = 0; j < 4; ++j) pf.u[j] = pack_bf16(sacc[kb][8 * s2 + 2 * j], sacc[kb][8 * s2 + 2 * j + 1]);
#pragma unroll
                    for (int i = 0; i < DVT / 32; ++i) {
                        const bf16* vp = Vs + (i * 32 + r) * VP + kb * 32 + 16 * s2 + 4 * hh;
                        union { bf16x8 v; bf16x4 h2[2]; } vf;
                        vf.h2[0] = *reinterpret_cast<const bf16x4*>(vp);
                        vf.h2[1] = *reinterpret_cast<const bf16x4*>(vp + 8);
                        oacc[i] = __builtin_amdgcn_mfma_f32_32x32x16_bf16(vf.v, pf.v, oacc[i], 0, 0, 0);
                    }
                }
        }
        lrun += shfl_xor(F, lrun, 32);
        const float inv = 1.0f / lrun;
        bf16* op = A.o + (size_t)(b * A.SQ + q0 + r) * A.o_stride + h * A.o_hstride + pass * DVT;
#pragma unroll
        for (int i = 0; i < DVT / 32; ++i)
#pragma unroll
            for (int g = 0; g < 4; ++g)
                st_bf16x4(op + i * 32 + 8 * g + 4 * hh, oacc[i][4 * g] * inv, oacc[i][4 * g + 1] * inv, oacc[i][4 * g + 2] * inv, oacc[i][4 * g + 3] * inv);
    }
}
#endif

#ifndef CPU_EMU
template <int DK, int DV, int DVT>
DI int attn_nunit(const AttnDesc& A) { return BATCH * A.H * (A.SQ / 256) * (DV / DVT); }
template <int DK, int DV, int DVT>
DI void attn_phase(const Frame& F, const AttnDesc& A) {
    const int nunit = attn_nunit<DK, DV, DVT>(A);
    for (int u = blockIdx.x; u < nunit; u += F.nblk) attn_unit<DK, DV, DVT>(F, A, u);
}
#endif
DI AttnDesc desc_gqa(const Frame& F) {
    AttnDesc A; A.q = WSP(bf16, OFF_HATT); A.q_stride = 512; A.q_hstride = 64;
    A.k = WSP(bf16, OFF_HATT) + 256; A.k_stride = 512; A.k_hstride = 64; A.k2 = nullptr; A.k2_stride = 0; A.dk_main = 64;
    A.vt = WSP(bf16, OFF_VTATT); A.o = WSP(bf16, OFF_YCAT); A.o_stride = 1024; A.o_hstride = 64;
    A.H = 4; A.HKV = 2; A.SQ = SEQ; A.SK = SEQ; A.scale = 0.125f; return A;
}
DI AttnDesc desc_mla(const Frame& F) {
    AttnDesc A; A.q = WSP(bf16, OFF_QMLA); A.q_stride = 384; A.q_hstride = 96;
    A.k = WSP(bf16, OFF_KNOPE); A.k_stride = 256; A.k_hstride = 64; A.k2 = WSP(bf16, OFF_KROPE); A.k2_stride = 32; A.dk_main = 64;
    A.vt = WSP(bf16, OFF_VTMLA); A.o = WSP(bf16, OFF_YCAT) + 768; A.o_stride = 1024; A.o_hstride = 64;
    A.H = 4; A.HKV = 4; A.SQ = SEQ; A.SK = SEQ; A.scale = 0.10206207261596575f; return A;
}
DI AttnDesc desc_mem(const Frame& F) {
    AttnDesc A; A.q = WSP(bf16, OFF_QMEM); A.q_stride = 1024; A.q_hstride = 256;
    A.k = WSP(bf16, OFF_KMEM); A.k_stride = 1024; A.k_hstride = 256; A.k2 = nullptr; A.k2_stride = 0; A.dk_main = 256;
    A.vt = WSP(bf16, OFF_VTMEM); A.o = WSP(bf16, OFF_OMEM); A.o_stride = 1024; A.o_hstride = 256;
    A.H = 4; A.HKV = 4; A.SQ = SEQ; A.SK = MEMT; A.scale = 0.0625f; return A;
}

#ifndef CPU_EMU
template <int CTRL> DI float dppf(float x) { return __builtin_bit_cast(float, __builtin_amdgcn_update_dpp(0, __builtin_bit_cast(int, x), CTRL, 0xf, 0xf, true)); }
DI float allsum16(float x) { x += dppf<0xB1>(x); x += dppf<0x4E>(x); x += dppf<0x141>(x); x += dppf<0x140>(x); return x; }
DI float bflo(unsigned u) { return __uint_as_float(u << 16); }
DI float bfhi(unsigned u) { return __uint_as_float(u & 0xffff0000u); }

typedef float f32p __attribute__((ext_vector_type(2)));
DI f32p allsum16p(f32p x) { x.x = allsum16(x.x); x.y = allsum16(x.y); return x; }
template <int KIND>
DI void scan_chain(const Frame& F, int chain) {
    constexpr int T = 32;
    constexpr int NARR = KIND == 0 ? 6 : 3;
    constexpr int STEPB = NARR * 256;
    constexpr int NPIECE = T * NARR * 8;
    constexpr int PPT = (NPIECE + NTH - 1) / NTH;
    const int d = chain / (BATCH * 4), b = (chain / 4) % BATCH, h = chain % 4;
    const int tid = F.tid, wave = tid >> 6, lane = tid & 63, rg = lane >> 4, cg = lane & 15;
    unsigned char* buf0 = F.smem; unsigned char* buf1 = F.smem + T * STEPB;
    unsigned char* ybuf = F.smem + 2 * T * STEPB;
    const size_t AS = (size_t)NTOK * 256;
    bf16* r7 = WSP(bf16, OFF_R7); bf16* hh = WSP(bf16, OFF_HHGRN);
#define PIECE_PTR(t0, p_) ([&]() -> const uint4* { const int pc = (p_) < NPIECE ? (p_) : NPIECE - 1; \
        const int st = pc / (NARR * 8), rem = pc % (NARR * 8), arr = rem >> 3, part = rem & 7; \
        const int tt = (t0) + st, ss = d ? SEQ - 1 - tt : tt; const size_t nn = (size_t)b * SEQ + ss; \
        const bf16* base; \
        if (KIND == 0) { const int aid = arr == 0 ? R_KK : arr == 1 ? (d ? R_W1 : R_W0) : arr == 2 ? (d ? R_AK1 : R_AK0) : arr == 3 ? (d ? R_KD1 : R_KD0) : arr == 4 ? R_R : R_V; \
            base = r7 + aid * AS + nn * 256 + h * 64; } \
        else { const int off = arr == 0 ? 256 + d * 256 : arr == 1 ? 0 : 768; base = hh + nn * 1280 + off + h * 64; } \
        return reinterpret_cast<const uint4*>(base + part * 8); }())
#define PUT_PIECE(dst, p_, v_) do { float4 a_, b_; a_.x = bflo((v_).x); a_.y = bfhi((v_).x); a_.z = bflo((v_).y); a_.w = bfhi((v_).y); \
        b_.x = bflo((v_).z); b_.y = bfhi((v_).z); b_.z = bflo((v_).w); b_.w = bfhi((v_).w); \
        *reinterpret_cast<float4*>((dst) + (p_) * 32) = a_; *reinterpret_cast<float4*>((dst) + (p_) * 32 + 16) = b_; } while (0)
#define STORE_PRE(dst) do { PUT_PIECE(dst, tid, pre0); \
        if (tid + NTH < NPIECE) PUT_PIECE(dst, tid + NTH, pre1); \
        if (PPT > 2 && tid + 2 * NTH < NPIECE) PUT_PIECE(dst, tid + 2 * NTH, pre2); } while (0)
    uint4 pre0, pre1, pre2;
    pre0 = *PIECE_PTR(0, tid); pre1 = *PIECE_PTR(0, tid + NTH); pre2 = pre1;
    if (PPT > 2) pre2 = *PIECE_PTR(0, tid + 2 * NTH);
    __syncthreads();
    STORE_PRE(buf0);
    __syncthreads();
    f32p P[4];
#pragma unroll
    for (int c = 0; c < 4; ++c) P[c] = (f32p){0.f, 0.f};
    const int vofs = (wave * 8 + rg * 2) * 4;
    for (int ch = 0; ch < SEQ / T; ++ch) {
        const unsigned char* cur = (ch & 1) ? buf1 : buf0;
        if (ch + 1 < SEQ / T) {
            pre0 = *PIECE_PTR((ch + 1) * T, tid); pre1 = *PIECE_PTR((ch + 1) * T, tid + NTH);
            if (PPT > 2) pre2 = *PIECE_PTR((ch + 1) * T, tid + 2 * NTH);
        }
        float4 o0, o1, o2, o3, o4; f32p ov;
        { const unsigned char* sb = cur;
          o0 = *reinterpret_cast<const float4*>(sb + 0 * 256 + cg * 16); o1 = *reinterpret_cast<const float4*>(sb + 1 * 256 + cg * 16);
          if (KIND == 0) { o2 = *reinterpret_cast<const float4*>(sb + 2 * 256 + cg * 16); o3 = *reinterpret_cast<const float4*>(sb + 3 * 256 + cg * 16); o4 = *reinterpret_cast<const float4*>(sb + 4 * 256 + cg * 16); }
          ov = *reinterpret_cast<const f32p*>(sb + (NARR - 1) * 256 + vofs); }
        unsigned ykeep = 0u;
#pragma unroll 2
        for (int t = 0; t < T; ++t) {
            const float4 c0 = o0, c1 = o1, c2 = o2, c3 = o3, c4 = o4; const f32p v = ov;
            { const unsigned char* sb = cur + ((t + 1) & (T - 1)) * STEPB;
              o0 = *reinterpret_cast<const float4*>(sb + 0 * 256 + cg * 16); o1 = *reinterpret_cast<const float4*>(sb + 1 * 256 + cg * 16);
              if (KIND == 0) { o2 = *reinterpret_cast<const float4*>(sb + 2 * 256 + cg * 16); o3 = *reinterpret_cast<const float4*>(sb + 3 * 256 + cg * 16); o4 = *reinterpret_cast<const float4*>(sb + 4 * 256 + cg * 16); }
              ov = *reinterpret_cast<const f32p*>(sb + (NARR - 1) * 256 + vofs); }
            f32p y;
            if (KIND == 0) {
                f32p sa = P[0] * c0.x + P[1] * c0.y + P[2] * c0.z + P[3] * c0.w;
                sa = allsum16p(sa);
                P[0] = P[0] * c1.x - sa * c2.x + v * c3.x;
                P[1] = P[1] * c1.y - sa * c2.y + v * c3.y;
                P[2] = P[2] * c1.z - sa * c2.z + v * c3.z;
                P[3] = P[3] * c1.w - sa * c2.w + v * c3.w;
                y = P[0] * c4.x + P[1] * c4.y + P[2] * c4.z + P[3] * c4.w;
            } else {
                P[0] += (v - P[0]) * c0.x; P[1] += (v - P[1]) * c0.y; P[2] += (v - P[2]) * c0.z; P[3] += (v - P[3]) * c0.w;
                y = P[0] * c1.x + P[1] * c1.y + P[2] * c1.z + P[3] * c1.w;
            }
            y = allsum16p(y);
            const unsigned yp = pack_bf16(y.x, y.y);
            ykeep = ((t & 15) == cg) ? yp : ykeep;
            if ((t & 15) == 15) *reinterpret_cast<unsigned*>(ybuf + ((t & ~15) + cg) * 128 + (wave * 8 + rg * 2) * 2) = ykeep;
        }
        asm volatile("s_waitcnt lgkmcnt(0)" ::: "memory");
        __builtin_amdgcn_wave_barrier();
        if (lane < T) {
            const int t = ch * T + lane, s = d ? SEQ - 1 - t : t; const size_t n = (size_t)b * SEQ + s;
            const uint4 yv = *reinterpret_cast<const uint4*>(ybuf + lane * 128 + wave * 16);
            bf16* dst = KIND == 0 ? r7 + (d ? R_W1 : R_W0) * AS + n * 256 + h * 64 + wave * 8 : hh + n * 1280 + 256 + d * 256 + h * 64 + wave * 8;
            *reinterpret_cast<uint4*>(dst) = yv;
        }
        if (ch + 1 < SEQ / T) {
            unsigned char* nxt = (ch & 1) ? buf0 : buf1;
            STORE_PRE(nxt);
        }
        __syncthreads();
    }
#undef PIECE_PTR
#undef STORE_PRE
#undef PUT_PIECE
}
DI void phase_scans(const Frame& F) {
    const int nchain = 2 * BATCH * 4;
    for (int u = blockIdx.x; u < 2 * nchain; u += F.nblk) {
        if (u < nchain) scan_chain<0>(F, u); else scan_chain<1>(F, u - nchain);
    }
}
#else
DI void phase_scans(const Frame& F) {
    bf16* r7 = WSP(bf16, OFF_R7); const size_t AS = (size_t)NTOK * 256;
    bf16* hh = WSP(bf16, OFF_HHGRN);
    const int nitem = 2 * BATCH * 4 * 64 * 2;
    for (int it = wave_item_index(F); it < nitem; it += gthreads(F)) {
        const int kind = it / (2 * BATCH * 4 * 64);
        int c = (it % (2 * BATCH * 4 * 64)) / 64; const int i = it % 64;
        const int d = c / (BATCH * 4); c %= BATCH * 4; const int b = c / 4, h = c % 4;
        float S[64];
#pragma unroll
        for (int j = 0; j < 64; ++j) S[j] = 0.f;
        if (kind == 0) {
            const bf16* pr = r7 + R_R * AS, *pv = r7 + R_V * AS, *pkk = r7 + R_KK * AS;
            bf16* pw = r7 + (d ? R_W1 : R_W0) * AS; const bf16* pkd = r7 + (d ? R_KD1 : R_KD0) * AS, *pak = r7 + (d ? R_AK1 : R_AK0) * AS;
            for (int t = 0; t < SEQ; ++t) {
                const int s = d ? SEQ - 1 - t : t;
                const size_t o = ((size_t)(b * SEQ + s)) * 256 + h * 64;
                const float v = bf2f(pv[o + i]);
                float sa = 0.f;
#pragma unroll
                for (int j = 0; j < 64; ++j) sa += S[j] * bf2f(pkk[o + j]);
                float y = 0.f;
#pragma unroll
                for (int j = 0; j < 64; ++j) {
                    S[j] = S[j] * bf2f(pw[o + j]) - sa * bf2f(pak[o + j]) + v * bf2f(pkd[o + j]);
                    y += S[j] * bf2f(pr[o + j]);
                }
#ifndef CPU_EMU
                __builtin_amdgcn_wave_barrier();
#endif
#ifdef CPU_EMU
                WSP(bf16, OFF_EMU_SCAN)[(size_t)d * AS + (size_t)(b * SEQ + s) * 256 + h * 64 + i] = f2bf(y);
#else
                pw[o + i] = f2bf(y);
#endif
            }
        } else {
            const bf16* pq = hh; bf16* pk = hh + 256 + d * 256; const bf16* pi = hh + 768;
            for (int t = 0; t < SEQ; ++t) {
                const int s = d ? SEQ - 1 - t : t;
                const size_t o = ((size_t)(b * SEQ + s)) * 1280 + h * 64;
                const float v = bf2f(pi[o + i]);
                float acc = 0.f;
#pragma unroll
                for (int j = 0; j < 64; ++j) {
                    const float k = bf2f(pk[o + j]);
                    S[j] = S[j] + k * (v - S[j]);
                    acc += S[j] * bf2f(pq[o + j]);
                }
#ifndef CPU_EMU
                __builtin_amdgcn_wave_barrier();
#endif
#ifdef CPU_EMU
                WSP(bf16, OFF_EMU_SCAN)[(size_t)(2 + d) * AS + (size_t)(b * SEQ + s) * 256 + h * 64 + i] = f2bf(acc);
#else
                pk[o + i] = f2bf(acc);
#endif
            }
        }
    }
}

#endif

DI void phase_fin(const Frame& F, int l) {
    const bf16* r7 = WSP(bf16, OFF_R7); const size_t AS = (size_t)NTOK * 256;
    const bf16* gb = WSP(bf16, OFF_G); const float* bonus = WSP(float, OFF_BONUS);
    const bf16* hh = WSP(bf16, OFF_HHGRN); bf16* ycat = WSP(bf16, OFF_YCAT);
    const float* gng = F.in[17] + l * 256; const float* gnb = F.in[18] + l * 256; const float* hng = F.in[20] + l * 256;
    for (int it = ggrp(F); it < NTOK * 8; it += ngrp(F)) {
        const int n = it >> 3, kind = (it >> 2) & 1, h = it & 3;
        float v[PER64];
        if (kind == 0) {
            float s1 = 0.f;
            for (int i = 0; i < PER64; ++i) { const int c = h * 64 + glane(F) + i * GRP; const size_t o = (size_t)n * 256 + c;
#ifdef CPU_EMU
                v[i] = bf2f(WSP(bf16, OFF_EMU_SCAN)[o]) + bf2f(WSP(bf16, OFF_EMU_SCAN)[AS + o]); s1 += v[i]; }
#else
                v[i] = bf2f(r7[R_W0 * AS + o]) + bf2f(r7[R_W1 * AS + o]); s1 += v[i]; }
#endif
            s1 = grp_sum(F, s1); const float mu = s1 * (1.0f / 64.0f);
            float s2 = 0.f; for (int i = 0; i < PER64; ++i) { const float dd = v[i] - mu; s2 += dd * dd; }
            s2 = grp_sum(F, s2); const float rs = 1.0f / sqrtf(s2 * (1.0f / 64.0f) + GN_EPS);
            const float bo = bonus[(size_t)n * 4 + h];
            for (int i = 0; i < PER64; ++i) { const int c = h * 64 + glane(F) + i * GRP; const size_t o = (size_t)n * 256 + c;
                const float y = (v[i] - mu) * rs * gng[c] + gnb[c];
                ycat[(size_t)n * 1024 + 256 + c] = f2bf((y + bo * bf2f(r7[R_V * AS + o])) * bf2f(gb[o])); }
        } else {
            float s2 = 0.f;
            for (int i = 0; i < PER64; ++i) { const int c = h * 64 + glane(F) + i * GRP; const size_t o = (size_t)n * 1280 + c;
#ifdef CPU_EMU
                const size_t oe = (size_t)n * 256 + c;
                v[i] = bf2f(WSP(bf16, OFF_EMU_SCAN)[2 * AS + oe]) + bf2f(WSP(bf16, OFF_EMU_SCAN)[3 * AS + oe]); s2 += v[i] * v[i]; }
#else
                v[i] = bf2f(hh[o + 256]) + bf2f(hh[o + 512]); s2 += v[i] * v[i]; }
#endif
            s2 = grp_sum(F, s2); const float rs = 1.0f / sqrtf(s2 * (1.0f / 64.0f) + RMS_EPS);
            for (int i = 0; i < PER64; ++i) { const int c = h * 64 + glane(F) + i * GRP; const size_t o = (size_t)n * 1280 + c;
                ycat[(size_t)n * 1024 + 512 + c] = f2bf(v[i] * rs * hng[c] * siluf_(bf2f(hh[o + 1024]))); }
        }
    }
}

struct EpiResid {
    float* xf; int row0, pn;
    DI void operator()(int r, int c, float a, float b, float cc, float d) const {
        float* p = xf + (size_t)(row0 + r) * DM + pn * 256 + c;
#ifndef CPU_EMU
        float4 x = *reinterpret_cast<float4*>(p);
        x.x = DN_ALPHA * x.x + a; x.y = DN_ALPHA * x.y + b; x.z = DN_ALPHA * x.z + cc; x.w = DN_ALPHA * x.w + d;
        *reinterpret_cast<float4*>(p) = x;
#else
        p[0] = DN_ALPHA * p[0] + a; p[1] = DN_ALPHA * p[1] + b; p[2] = DN_ALPHA * p[2] + cc; p[3] = DN_ALPHA * p[3] + d;
#endif
    }
};
struct EpiBf {
    bf16* o; int ld; int row0, pn;
    DI void operator()(int r, int c, float a, float b, float cc, float d) const { st_bf16x4(o + (size_t)(row0 + r) * ld + pn * 256 + c, a, b, cc, d); }
};
template <int MODE>
DI void phase_gemm_sq(const Frame& F, const bf16* A, size_t woff, bf16* outb) {
    const bf16* W = (const bf16*)((const char*)WSP(bf16, OFF_WTS) + woff);
    const int nM = (NTOK + 255) / 256;
    for (int u = blockIdx.x; u < nM * 4; u += F.nblk) {
        const int pm = u >> 2, pn = u & 3;
#ifdef CPU_EMU
        const int mr = min(256, NTOK - pm * 256);
#endif
        if (MODE == 0) { EpiResid E{F.xf, pm * 256, pn}; gemm_unit(F, A, 1024, nullptr, pm * 256, W, 1024, pn * 256, 1024, E MR); }
        else { EpiBf E{outb, 1024, pm * 256, pn}; gemm_unit(F, A, 1024, nullptr, pm * 256, W, 1024, pn * 256, 1024, E MR); }
    }
}

DI void phase_ln(const Frame& F, const float* g, const float* b) {
    const float* xf = F.xf;
    layer_norm_rows(F, g, b, [&](int row, int c) { return xf[(size_t)row * DM + c]; }, false, nullptr);
}

DI void phase_route(const Frame& F, int l) {
    const float* xf = F.xf;
    const float* wg = F.in[33] + (size_t)l * 1024 * 4; const float* bg = F.in[34] + l * 4;
    const float* we = F.in[35] + (size_t)l * 1024 * 32; const float* be = F.in[36] + l * 32;
    int* counts = (int*)(F.ws + CTL_CNT) + l * 32;
    int* lists = WSP(int, OFF_LISTS); float* tinfo = WSP(float, OFF_TINFO);
    for (int row = ggrp(F); row < NTOK; row += ngrp(F)) {
        float gl[4] = {0.f, 0.f, 0.f, 0.f};
        for (int i = 0; i < PERLN; ++i) { const int c = glane(F) + i * GRP; const float x = xf[(size_t)row * DM + c];
#pragma unroll
            for (int q = 0; q < 4; ++q) gl[q] += x * wg[c * 4 + q]; }
#pragma unroll
        for (int q = 0; q < 4; ++q) gl[q] = grp_sum(F, gl[q]) + bg[q];
        int gi = 0; float gm = gl[0];
#pragma unroll
        for (int q = 1; q < 4; ++q) if (gl[q] > gm) { gm = gl[q]; gi = q; }
        float den = 0.f;
#pragma unroll
        for (int q = 0; q < 4; ++q) den += expf(gl[q] - gm);
        const float pgroup = 1.0f / den;
        float el[8] = {0.f, 0.f, 0.f, 0.f, 0.f, 0.f, 0.f, 0.f};
        for (int i = 0; i < PERLN; ++i) { const int c = glane(F) + i * GRP; const float x = xf[(size_t)row * DM + c];
#pragma unroll
            for (int q = 0; q < 8; ++q) el[q] += x * we[c * 32 + gi * 8 + q]; }
#pragma unroll
        for (int q = 0; q < 8; ++q) el[q] = grp_sum(F, el[q]) + be[gi * 8 + q];
        int i0 = 0; float v0 = el[0];
#pragma unroll
        for (int q = 1; q < 8; ++q) if (el[q] > v0) { v0 = el[q]; i0 = q; }
        int i1 = -1; float v1 = -INFINITY;
#pragma unroll
        for (int q = 0; q < 8; ++q) if (q != i0 && el[q] > v1) { v1 = el[q]; i1 = q; }
        const float e1 = expf(v1 - v0); const float g0 = pgroup / (1.0f + e1), g1 = pgroup * e1 / (1.0f + e1);
        if (glane(F) == 0) {
            const int ea = gi * 8 + i0, eb = gi * 8 + i1;
            const int pa = atomicAdd(&counts[ea], 1), pb = atomicAdd(&counts[eb], 1);
            lists[(size_t)ea * NTOK + pa] = row; lists[(size_t)eb * NTOK + pb] = row;
            int* ti = (int*)(tinfo + (size_t)row * 8);
            ti[0] = ea; ti[1] = pa; ti[2] = eb; ti[3] = pb; tinfo[(size_t)row * 8 + 4] = g0; tinfo[(size_t)row * 8 + 5] = g1;
        }
    }
}

struct EpiMoeUp {
    bf16* hm; int row0, pn;
    DI void operator()(int r, int c, float a, float b, float cc, float d) const {
        bf16* p = hm + (size_t)(row0 + r) * 256 + ((pn * 256 + c) >> 1);
        p[0] = f2bf(siluf_(a) * b); p[1] = f2bf(siluf_(cc) * d);
    }
};
DI int ld_cnt(const int* p) {
#ifdef CPU_EMU
    return *p;
#else
    return __hip_atomic_load(p, __ATOMIC_RELAXED, __HIP_MEMORY_SCOPE_AGENT);
#endif
}
DI void moe_tiles(const int* counts, int* toff  ) {
    __syncthreads();
    if (threadIdx.x == 0) { int acc = 0; for (int e = 0; e < NEXP; ++e) { toff[e] = acc; acc += (ld_cnt(counts + e) + 255) >> 8; } toff[NEXP] = acc; }
    __syncthreads();
}
DI void phase_moe_up(const Frame& F, int l) {
    const int* counts = (const int*)(F.ws + CTL_CNT) + l * 32;
    int* eoff = (int*)(F.ws + CTL_EOFF) + l * 33;
    int* rowmap = (int*)(F.smem + 131072);
    int* toff = rowmap + 256;
    moe_tiles(counts, toff);
    if (blockIdx.x == 0 && threadIdx.x == 0) for (int e = 0; e <= NEXP; ++e) eoff[e] = toff[e] * 256;
    const int* lists = WSP(int, OFF_LISTS); const bf16* xb = WSP(bf16, OFF_XB);
    const int nunit = toff[NEXP] * 2;
    for (int u = blockIdx.x; u < nunit; u += F.nblk) {
        const int tile = u >> 1, pn = u & 1;
        int e = 0; while (toff[e + 1] <= tile) ++e;
        const int t0 = (tile - toff[e]) * 256, cnt = ld_cnt(counts + e);
        __syncthreads();
        for (int i = fresh_tid(F); i < 256; i += NTH) rowmap[i] = (t0 + i < cnt) ? lists[(size_t)e * NTOK + t0 + i] : 0;
        __syncthreads();
        EpiMoeUp E{WSP(bf16, OFF_HM), tile * 256, pn};
        gemm_unit(F, xb, 1024, rowmap, 0, WSP(bf16, OFF_W13T) + (size_t)e * 512 * 1024, 1024, pn * 256, 1024, E);
    }
}
DI void phase_moe_down(const Frame& F, int l) {
    const int* counts = (const int*)(F.ws + CTL_CNT) + l * 32;
    int* toff = (int*)(F.smem + 131072) + 256;
    moe_tiles(counts, toff);
    const int nunit = toff[NEXP] * 4;
    for (int u = blockIdx.x; u < nunit; u += F.nblk) {
        const int tile = u >> 2, pn = u & 3;
        int e = 0; while (toff[e + 1] <= tile) ++e;
        EpiBf E{WSP(bf16, OFF_YROWS), 1024, tile * 256, pn};
        gemm_unit(F, WSP(bf16, OFF_HM), 256, nullptr, tile * 256, WSP(bf16, OFF_W2T) + (size_t)e * 1024 * 256, 256, pn * 256, 256, E);
    }
}
DI void phase_ln3(const Frame& F, int l) {
    const float* xf = F.xf; const bf16* yr = WSP(bf16, OFF_YROWS); const float* tinfo = WSP(float, OFF_TINFO);
    const int* eoff = (const int*)(F.ws + CTL_EOFF) + l * 33;
    layer_norm_rows(F, F.in[40] + l * 1024, F.in[41] + l * 1024, [&](int row, int c) {
        const int* ti = (const int*)(tinfo + (size_t)row * 8);
        const size_t ra = (size_t)eoff[ti[0]] + ti[1], rb = (size_t)eoff[ti[2]] + ti[3];
        return DN_ALPHA * xf[(size_t)row * DM + c] + tinfo[(size_t)row * 8 + 4] * bf2f(yr[ra * 1024 + c]) + tinfo[(size_t)row * 8 + 5] * bf2f(yr[rb * 1024 + c]);
    }, false, nullptr);
}

#ifndef CPU_EMU
#define XB_TMO      128
#define XB_XCNT(j)  (256  + 64 * (j))
#define XB_XSUB(j)  (1280 + 64 * (j))
#define XB_XGEN(j)  (2304 + 64 * (j))
#define XB_TOP      3328
#define XB_TOPGEN   3392
#define XCD_BAR_WORDS 3456
#define XB_SPIN_CAP (1u << 18)
#define LAS __attribute__((address_space(3)))

__device__ __forceinline__ unsigned xb_ld(unsigned* p)              { return __hip_atomic_load(p, __ATOMIC_RELAXED, __HIP_MEMORY_SCOPE_AGENT); }
__device__ __forceinline__ unsigned xb_add(unsigned* p, unsigned v) { return __hip_atomic_fetch_add(p, v, __ATOMIC_RELAXED, __HIP_MEMORY_SCOPE_AGENT); }
__device__ __forceinline__ unsigned xb_xcc_id() { return (unsigned)__builtin_amdgcn_s_getreg((3 << 11) | 20) & 0xFu; }
#define XB_SPIN(cond, bar) do { unsigned _sp = 0; while (cond) { __builtin_amdgcn_s_sleep(1); \
    if ((++_sp & 255u) == 0u) { if (xb_ld(&(bar)[XB_TMO])) break; if (_sp > XB_SPIN_CAP) { atomicAdd(&(bar)[XB_TMO], 1u); break; } } } } while (0)

struct XcdBarrier {
    unsigned* bar; unsigned x;
    volatile LAS unsigned* st;
};

__device__ __forceinline__ XcdBarrier xcd_barrier_post(unsigned* bar, volatile LAS unsigned* st) {
    XcdBarrier b; b.bar = bar; b.x = xb_xcc_id(); b.st = st;
    if (threadIdx.x == 0) (void)xb_add(&bar[XB_XCNT(b.x)], 1u);
    return b;
}
__device__ __forceinline__ void xcd_barrier_complete(unsigned* bar, unsigned x, unsigned& nloc, unsigned& nx) {
    const unsigned G = gridDim.x * gridDim.y * gridDim.z;
    unsigned sum, cnt, mine, sp = 0u;
    for (;;) {
        sum = 0u; cnt = 0u; mine = 0u;
#pragma unroll
        for (unsigned j = 0; j < 16; ++j) { const unsigned c = xb_ld(&bar[XB_XCNT(j)]); sum += c; cnt += (c > 0u) ? 1u : 0u; mine = (j == x) ? c : mine; }
        if (sum == G) break;
        __builtin_amdgcn_s_sleep(1);
        if ((++sp & 255u) == 0u) { if (xb_ld(&bar[XB_TMO])) break; if (sp > XB_SPIN_CAP) { atomicAdd(&bar[XB_TMO], 1u); break; } }
    }
    nloc = mine > 0u ? mine : 1u; nx = cnt > 0u ? cnt : 1u;
}

__device__ __forceinline__ void xcd_barrier(const XcdBarrier& b) {
    asm volatile("s_waitcnt vmcnt(0)" ::: "memory");
    __syncthreads();
    if (threadIdx.x == 0) {
        unsigned* bar = b.bar;
        __builtin_amdgcn_s_waitcnt(0);
        unsigned nloc = b.st[0], nx = b.st[1];
        if (nloc == 0u) { xcd_barrier_complete(bar, b.x, nloc, nx); b.st[0] = nloc; b.st[1] = nx; }
        const unsigned old = xb_add(&bar[XB_XSUB(b.x)], 1u);
        const unsigned gen = old / nloc;
        if (old + 1u == (gen + 1u) * nloc) {
            __builtin_amdgcn_fence(__ATOMIC_RELEASE, "agent");
            asm volatile("s_waitcnt vmcnt(0)" ::: "memory");
            const unsigned og = xb_add(&bar[XB_TOP], 1u);
            const unsigned tg = og / nx;
            if (og + 1u == (tg + 1u) * nx) xb_add(&bar[XB_TOPGEN], 1u);
            else XB_SPIN(xb_ld(&bar[XB_TOPGEN]) == tg, bar);
            __builtin_amdgcn_fence(__ATOMIC_ACQUIRE, "agent");
            xb_add(&bar[XB_XGEN(b.x)], 1u);
            asm volatile("s_waitcnt vmcnt(0)" ::: "memory");
        } else {
            XB_SPIN(xb_ld(&bar[XB_XGEN(b.x)]) == gen, bar);
            __builtin_amdgcn_fence(__ATOMIC_ACQUIRE, "agent");
            asm volatile("s_waitcnt vmcnt(0)" ::: "memory");
        }
    }
    __syncthreads();
}

#endif

constexpr int NPH_LAYER = 16;
constexpr int NPH_TOTAL = 1 + 2 * NPH_LAYER;
constexpr int SMEM_BYTES = 131072 + 2048;

template <int K>
DI void run_layer_phase(const Frame& F, int l) {
    if constexpr (K == 0) phase_cvt(F, l);
    if constexpr (K == 1) phase_gemm1(F);
    if constexpr (K == 2) phase_prep(F, l);
    if constexpr (K == 3) phase_mlaup(F);
    if constexpr (K == 4) {
#ifdef CPU_EMU
        attn_phase<64, 64>(F, desc_gqa(F)); attn_phase<96, 64>(F, desc_mla(F)); phase_scans(F);
#else
        phase_scans(F);
        {
            const AttnDesc Ag = desc_gqa(F), Am = desc_mla(F);
            const int ng = attn_nunit<64, 64, 64>(Ag), nm = attn_nunit<96, 64, 64>(Am);
            unsigned* qctr = (unsigned*)(F.ws + CTL_QUEUE) + l * 64;
            volatile int* slot = (volatile int*)(F.smem + SMEM_BYTES - 32);
            for (;;) {
                __syncthreads();
                if (F.tid == 0) *slot = (int)atomicAdd(qctr, 1u);
                __syncthreads();
                const int u = *slot;
                if (u >= ng + nm) break;
                if (u < ng) attn_unit<64, 64, 64>(F, Ag, u); else attn_unit<96, 64, 64>(F, Am, u - ng);
            }
        }
#endif
    }
    if constexpr (K == 5) phase_fin(F, l);
    if constexpr (K == 6) phase_gemm_sq<0>(F, WSP(bf16, OFF_YCAT), W_OUT_T, nullptr);
    if constexpr (K == 7) phase_ln(F, F.in[26] + l * 1024, F.in[27] + l * 1024);
    if constexpr (K == 8) phase_gemm_sq<1>(F, WSP(bf16, OFF_XB), W_Q_T, WSP(bf16, OFF_QMEM));
    if constexpr (K == 9) {
#ifdef CPU_EMU
        attn_phase<256, 256>(F, desc_mem(F));
#else
        attn_phase<256, 256, 128>(F, desc_mem(F));
#endif
    }
    if constexpr (K == 10) phase_gemm_sq<0>(F, WSP(bf16, OFF_OMEM), W_O_T, nullptr);
    if constexpr (K == 11) { phase_ln(F, F.in[31] + l * 1024, F.in[32] + l * 1024); phase_cvt_moe(F, l); }
    if constexpr (K == 12) phase_route(F, l);
    if constexpr (K == 13) phase_moe_up(F, l);
    if constexpr (K == 14) phase_moe_down(F, l);
    if constexpr (K == 15) phase_ln3(F, l);
}

#ifndef CPU_EMU
template <int K>
__global__ void __launch_bounds__(512, 2) k_phase(Args a, int l) {
    extern __shared__ __attribute__((aligned(16))) unsigned char lds[];
    Frame F; F.in = (InPtr)__builtin_amdgcn_kernarg_segment_ptr(); F.xf = a.out; F.ws = a.ws; F.smem = lds; F.tid = threadIdx.x; F.wv = __builtin_amdgcn_readfirstlane((int)(threadIdx.x >> 6)); F.nblk = a.ph_lo;
    if constexpr (K < 0) phase_pro(F); else run_layer_phase<K>(F, l);
}

template <int K>
static void launch_phase(const Args& a, int l, int grid, hipStream_t stream) {
    static bool attr = false;
    if (!attr) { (void)hipFuncSetAttribute((const void*)k_phase<K>, hipFuncAttributeMaxDynamicSharedMemorySize, SMEM_BYTES); attr = true; }
    hipLaunchKernelGGL(k_phase<K>, dim3(grid), dim3(512), SMEM_BYTES, stream, a, l);
}

__global__ void __launch_bounds__(512, 2) fwd_one(Args a) {
    extern __shared__ __attribute__((aligned(16))) unsigned char lds[];
    const int wave_s = __builtin_amdgcn_readfirstlane((int)(threadIdx.x >> 6));
    volatile LAS unsigned* st = (volatile LAS unsigned*)(lds + SMEM_BYTES - 16);
    if (threadIdx.x == 0) { st[0] = 0u; st[1] = 0u; st[2] = 0u; st[3] = 0u; }
    __syncthreads();
    XcdBarrier bar = xcd_barrier_post((unsigned*)(a.ws + OFF_CTL), st);
    Frame F;
#define FRESH do { unsigned z_ = 0u, m_ = ~0u; int ws_ = wave_s; asm volatile("" : "+s"(z_), "+s"(ws_), "+s"(m_)); \
        int t_ = ws_ * 64 + (int)__builtin_amdgcn_mbcnt_hi(m_, __builtin_amdgcn_mbcnt_lo(m_, 0u)); asm volatile("" : "+v"(t_)); \
        const __attribute__((address_space(4))) char* kp_ = (const __attribute__((address_space(4))) char*)__builtin_amdgcn_kernarg_segment_ptr() + z_; \
        F.in = (InPtr)kp_; F.xf = *(float* const __attribute__((address_space(4)))*)(kp_ + 42 * 8); F.ws = *(unsigned char* const __attribute__((address_space(4)))*)(kp_ + 43 * 8); \
        F.smem = lds; F.tid = t_; F.wv = ws_; F.nblk = *(const int __attribute__((address_space(4)))*)(kp_ + 44 * 8); } while (0)
#define GB do { { unsigned zb_ = 0u; unsigned xx_ = __builtin_amdgcn_readfirstlane(bar.x); asm volatile("" : "+s"(zb_), "+s"(xx_)); bar.bar = (unsigned*)(a.ws + OFF_CTL) + zb_; bar.x = xx_; } \
        xcd_barrier(bar); } while (0)
#define DUP(k) ((PROBE_DUP >> (k)) & 1)
    FRESH; phase_pro(F); FRESH; phase_cvt(F, 0); GB;
    if (DUP(0)) { FRESH; phase_cvt(F, 0); GB; }
    for (int l = 0; l < 2; ++l) {
        FRESH; run_layer_phase<1>(F, l); GB;
        if (DUP(1)) { FRESH; run_layer_phase<1>(F, l); GB; }
        FRESH; run_layer_phase<2>(F, l); GB;
        FRESH; run_layer_phase<3>(F, l); GB;
        if (DUP(3)) { FRESH; run_layer_phase<3>(F, l); GB; }
        if (DUP(4)) { FRESH; attn_phase<64, 64, 64>(F, desc_gqa(F)); attn_phase<96, 64, 64>(F, desc_mla(F)); GB; }
        FRESH; run_layer_phase<4>(F, l); GB;
        FRESH; run_layer_phase<5>(F, l); GB;
        if (DUP(5)) { FRESH; run_layer_phase<5>(F, l); GB; }
        FRESH; run_layer_phase<6>(F, l); GB;
        FRESH; run_layer_phase<7>(F, l); GB;
        FRESH; run_layer_phase<8>(F, l); GB;
        if (DUP(8)) { FRESH; run_layer_phase<8>(F, l); GB; }
        FRESH; run_layer_phase<9>(F, l); GB;
        if (DUP(9)) { FRESH; run_layer_phase<9>(F, l); GB; }
        FRESH; run_layer_phase<10>(F, l); GB;
        FRESH; run_layer_phase<11>(F, l); FRESH; run_layer_phase<12>(F, l); if (l == 0) { FRESH; phase_cvt(F, 1); } GB;
        if (DUP(11)) { FRESH; phase_cvt_moe(F, l); GB; }
        FRESH; run_layer_phase<13>(F, l); GB;
        if (DUP(13)) { FRESH; run_layer_phase<13>(F, l); GB; }
        FRESH; run_layer_phase<14>(F, l); GB;
        if (DUP(14)) { FRESH; run_layer_phase<14>(F, l); GB; }
        FRESH; run_layer_phase<15>(F, l); if (l == 0) GB;
    }
#undef DUP
#undef GB
#undef FRESH
}

extern "C" void kernel_launch(void* const* d_in, const int* in_sizes, int n_in, void* d_out, int out_size, void* d_ws, size_t ws_size, hipStream_t stream) {
    if (n_in != 42 || ws_size < WS_END) return;
    Args a{};
    for (int i = 0; i < 42; ++i) a.in[i] = (const float*)d_in[i];
    a.out = (float*)d_out; a.ws = (unsigned char*)d_ws; a.ph_lo = 0; a.ph_hi = NPH_TOTAL;
    (void)hipMemsetAsync(d_ws, 0, CTL_BYTES, stream);
#if N_LAUNCH_MODE == 1
    static int grid = 0;
    if (!grid) {
        int dev = 0, cus = 0, per_cu = 0;
        (void)hipGetDevice(&dev);
        (void)hipDeviceGetAttribute(&cus, hipDeviceAttributeMultiprocessorCount, dev);
        (void)hipFuncSetAttribute((const void*)fwd_one, hipFuncAttributeMaxDynamicSharedMemorySize, SMEM_BYTES);
        (void)hipOccupancyMaxActiveBlocksPerMultiprocessor(&per_cu, (const void*)fwd_one, 512, SMEM_BYTES);
        (void)hipGetLastError();
        grid = cus > 0 ? cus : 256;
    }
    a.ph_lo = grid;
    hipLaunchKernelGGL(fwd_one, dim3(grid), dim3(512), SMEM_BYTES, stream, a);
#else
    const int grid = 256; a.ph_lo = grid;
    launch_phase<-1>(a, 0, grid, stream);
    for (int l = 0; l < 2; ++l) {
        launch_phase<0>(a, l, grid, stream); launch_phase<1>(a, l, grid, stream); launch_phase<2>(a, l, grid, stream); launch_phase<3>(a, l, grid, stream);
        launch_phase<4>(a, l, grid, stream); launch_phase<5>(a, l, grid, stream); launch_phase<6>(a, l, grid, stream); launch_phase<7>(a, l, grid, stream);
        launch_phase<8>(a, l, grid, stream); launch_phase<9>(a, l, grid, stream); launch_phase<10>(a, l, grid, stream); launch_phase<11>(a, l, grid, stream);
        launch_phase<12>(a, l, grid, stream); launch_phase<13>(a, l, grid, stream); launch_phase<14>(a, l, grid, stream); launch_phase<15>(a, l, grid, stream);
    }
#endif
}
#endif
```

```cpp
#ifndef CPU_EMU
#include <hip/hip_runtime.h>
#else
#include "emu_shim.h"
#endif
#include <stdint.h>

#ifndef CFG_B
#define CFG_B 16
#endif
#ifndef CFG_S
#define CFG_S 2048
#endif
#ifndef PROBE_DUP
#define PROBE_DUP 0
#endif
#ifndef N_LAUNCH_MODE
#define N_LAUNCH_MODE 1
#endif

typedef unsigned short bf16;
#define DI __device__ __forceinline__

constexpr int BATCH = CFG_B, SEQ = CFG_S, NTOK = BATCH * SEQ, DM = 1024;
constexpr int MEMT = 256, NMEM = BATCH * MEMT;
constexpr int GRIDW = 64;
constexpr int HP = 3328;
constexpr int IN_WIDTH = 3104;
constexpr int NEXP = 32, MOEH = 256;
constexpr int MOE_ROWS = 2 * NTOK + NEXP * 256;
constexpr float LN_EPS = 1e-5f, RMS_EPS = 1e-6f, GN_EPS = 64e-5f;
constexpr float DN_ALPHA = 1.41421356237309515f;
constexpr float DECAY_SCALE = 0.60653065971263342f;

constexpr size_t AL(size_t x) { return (x + 255) & ~(size_t)255; }
constexpr size_t OFF_CTL = 0;
constexpr size_t CTL_BYTES = 32768;
constexpr size_t CTL_CNT = 16384;
constexpr size_t CTL_EOFF = 16384 + 1024;
constexpr size_t CTL_QUEUE = 16384 + 2048;
constexpr size_t OFF_XB = AL(OFF_CTL + CTL_BYTES);
constexpr size_t SZ_XB = (size_t)NTOK * DM * 2;
constexpr size_t OFF_WTS = AL(OFF_XB + SZ_XB);
constexpr size_t W_IN_T = 0;
constexpr size_t W_UQ_T = W_IN_T + (size_t)HP * 1024 * 2;
constexpr size_t W_UKV_T = W_UQ_T + 512 * 256 * 2;
constexpr size_t W_OUT_T = W_UKV_T + 512 * 256 * 2;
constexpr size_t W_Q_T = W_OUT_T + 1024 * 1024 * 2;
constexpr size_t W_KV_T = W_Q_T + 1024 * 1024 * 2;
constexpr size_t W_O_T = W_KV_T + 2048 * 1024 * 2;
constexpr size_t W_GATE_T = W_O_T + 1024 * 1024 * 2;
constexpr size_t SZ_WTS = W_GATE_T + 2 * 48 * 1024 * 4;
constexpr size_t OFF_KMEM = AL(OFF_WTS + SZ_WTS);
constexpr size_t OFF_VTMEM = AL(OFF_KMEM + (size_t)NMEM * 1024 * 2);
constexpr size_t OFF_MEMB = AL(OFF_VTMEM + (size_t)NMEM * 1024 * 2);
constexpr size_t OFF_VTATT = AL(OFF_MEMB + (size_t)NMEM * 1024 * 2);
constexpr size_t OFF_VTMLA = AL(OFF_VTATT + (size_t)BATCH * 2 * 64 * SEQ * 2);
constexpr size_t OFF_HATT = AL(OFF_VTMLA + (size_t)BATCH * 4 * 64 * SEQ * 2);
constexpr size_t OFF_HMLA = OFF_HATT + (size_t)NTOK * 512 * 2;
constexpr size_t OFF_HRWKV = OFF_HMLA + (size_t)NTOK * 512 * 2;
constexpr size_t OFF_R7 = OFF_HRWKV + (size_t)NTOK * 1024 * 2;
constexpr size_t SZ_R7 = (size_t)NTOK * 9 * 256 * 2;
constexpr size_t OFF_HHGRN = OFF_R7 + SZ_R7;
constexpr size_t WS_END = OFF_HHGRN + (size_t)NTOK * 1280 * 2;

constexpr size_t OFF_QMLA = OFF_XB;
constexpr size_t OFF_KNOPE = OFF_QMLA + (size_t)NTOK * 384 * 2;
constexpr size_t OFF_KROPE = OFF_KNOPE + (size_t)NTOK * 256 * 2;
constexpr size_t OFF_G = OFF_KROPE + (size_t)NTOK * 32 * 2;
constexpr size_t OFF_BONUS = OFF_G + (size_t)NTOK * 256 * 2;
static_assert(OFF_BONUS + (size_t)NTOK * 16 <= OFF_XB + SZ_XB, "xb alias region");
constexpr size_t OFF_YCAT = OFF_HRWKV;
constexpr size_t OFF_QMEM = OFF_HATT;
constexpr size_t OFF_OMEM = OFF_R7;
#ifdef CPU_EMU
constexpr size_t OFF_EMU_SCAN = WS_END;
constexpr size_t OFF_LISTS = AL(OFF_EMU_SCAN + (size_t)4 * NTOK * 256 * 2);
#else
constexpr size_t OFF_LISTS = OFF_HATT;
#endif
constexpr size_t OFF_TINFO = OFF_LISTS + (size_t)NEXP * NTOK * 4;
constexpr size_t OFF_HM = AL(OFF_TINFO + (size_t)NTOK * 32);
constexpr size_t OFF_YROWS = AL(OFF_HM + (size_t)MOE_ROWS * 256 * 2);
#ifdef CPU_EMU
constexpr size_t OFF_W13T = AL(OFF_YROWS + (size_t)MOE_ROWS * 1024 * 2);
#else
static_assert(OFF_YROWS + (size_t)MOE_ROWS * 1024 * 2 <= OFF_HHGRN, "moe alias region");
constexpr size_t OFF_W13T = OFF_HHGRN;
#endif
constexpr size_t OFF_W2T = OFF_W13T + (size_t)NEXP * 512 * 1024 * 2;
#ifdef CPU_EMU
constexpr size_t WS_END_EMU = OFF_W2T + (size_t)NEXP * 1024 * 256 * 2;
#else
static_assert(OFF_W2T + (size_t)NEXP * 1024 * 256 * 2 <= WS_END, "moe weights alias");
#endif

enum { R_R = 0, R_V = 1, R_KK = 2, R_W0 = 3, R_W1 = 4, R_KD0 = 5, R_KD1 = 6, R_AK0 = 7, R_AK1 = 8 };

DI float bf2f(bf16 v) { union { unsigned u; float f; } x; x.u = (unsigned)v << 16; return x.f; }
DI bf16 f2bf(float f) { union { unsigned u; float f; } x; x.f = f; unsigned u = x.u; u += 0x7fffu + ((u >> 16) & 1u); return (bf16)(u >> 16); }
DI float sigmoidf_(float x) { return 1.0f / (1.0f + expf(-x)); }
DI float siluf_(float x) { return x * sigmoidf_(x); }

#ifdef CPU_EMU
typedef const float* const* InPtr;
#else
typedef const float* const __attribute__((address_space(4)))* InPtr;
#endif
struct Frame {
    InPtr in;
    float* xf;
    unsigned char* ws;
    unsigned char* smem;
    int tid;
    int wv;
    int nblk;
};
#ifdef CPU_EMU
constexpr int NTH = 1;
#else
constexpr int NTH = 512;
#endif
#ifdef CPU_EMU
constexpr int GRP = 1;
DI float grp_sum(const Frame& F, float v) { return v; }
DI int gthreads(const Frame& F) { return 1; }
DI int gtid_(const Frame& F) { return 0; }
DI int wave_item_index(const Frame& F) { return 0; }
#else
constexpr int GRP = 64;
DI float shfl_idx(const Frame& F, float v, int src_lane) { return __builtin_bit_cast(float, __builtin_amdgcn_ds_bpermute(src_lane << 2, __builtin_bit_cast(int, v))); }
DI float shfl_xor(const Frame& F, float v, int mask) { return shfl_idx(F, v, (F.tid & 63) ^ mask); }
template <int CTRL> DI float dppf(float x) { return __builtin_bit_cast(float, __builtin_amdgcn_update_dpp(0, __builtin_bit_cast(int, x), CTRL, 0xf, 0xf, true)); }
DI float allsum16(float x) { x += dppf<0xB1>(x); x += dppf<0x4E>(x); x += dppf<0x141>(x); x += dppf<0x140>(x); return x; }
DI float rdlane(float x, int l) { return __builtin_bit_cast(float, __builtin_amdgcn_readlane(__builtin_bit_cast(int, x), l)); }
DI float grp_sum(const Frame& F, float v) { v = allsum16(v); return (rdlane(v, 0) + rdlane(v, 16)) + (rdlane(v, 32) + rdlane(v, 48)); }
DI int gthreads(const Frame& F) { return F.nblk * NTH; }
DI int gtid_(const Frame& F) { return blockIdx.x * NTH + F.tid; }
DI int wave_item_index(const Frame& F) { return (int)(((F.tid >> 6) * F.nblk + blockIdx.x) * 64 + (F.tid & 63)); }
#endif
constexpr int PER64 = 64 / GRP;
constexpr int PERLN = 1024 / GRP;
DI int fresh_tid(const Frame& F) {
#ifdef CPU_EMU
    return 0;
#else
    unsigned m0 = ~0u; asm volatile("" : "+s"(m0));
    int t = F.wv * 64 + (int)__builtin_amdgcn_mbcnt_hi(m0, __builtin_amdgcn_mbcnt_lo(m0, 0u)); asm volatile("" : "+v"(t)); return t;
#endif
}
DI int glane(const Frame& F) { return (int)(F.tid % GRP); }
DI int ggrp(const Frame& F) { return gtid_(F) / GRP; }
DI int ngrp(const Frame& F) { return gthreads(F) / GRP; }

struct Args {
    const float* in[42];
    float* out;
    unsigned char* ws;
    int ph_lo, ph_hi;
};

DI float rope_inv(int f, int nf) { return powf(10000.0f, -(float)f / (float)nf); }

#ifndef CPU_EMU
using bf16x8 = __attribute__((ext_vector_type(8))) short;
using bf16x4 = __attribute__((ext_vector_type(4))) short;
using f32x4 = __attribute__((ext_vector_type(4))) float;
using f32x16 = __attribute__((ext_vector_type(16))) float;
typedef __bf16 bf16v2 __attribute__((ext_vector_type(2)));
typedef float f32v2 __attribute__((ext_vector_type(2)));
DI unsigned pack_bf16(float lo, float hi) { f32v2 v = {lo, hi}; bf16v2 b = __builtin_convertvector(v, bf16v2); return __builtin_bit_cast(unsigned, b); }

constexpr int G_BM = 256, G_BK = 64, G_HALF = 128, G_HT = G_HALF * G_BK, G_SHM = 8 * G_HT * 2;
DI int g_lds_byte(int r, int c) { int st = (r >> 4) * 2 + (c >> 5), rr = r & 15, cc = c & 31, ob = rr * 64 + cc * 2; return st * 1024 + (ob ^ (((ob >> 9) & 1) << 5)); }
DI void g_stage_rc(int b, int& R, int& C) { int st = b / 1024, sb = b % 1024, swz = sb ^ (((sb >> 9) & 1) << 5); R = (st >> 1) * 16 + swz / 64; C = (st & 1) * 32 + (swz % 64) / 2; }

template <bool GATHER, class Epi>
DI void gemm_unit_t(int wv_in, bf16* shm, const bf16* __restrict__ A, int lda, const int* rowmap, int arow0,
                    const bf16* __restrict__ Bt, int ldb, int bcol0, int K, const Epi& epi) {
#define SA(b, h) (shm + ((b) * 2 + (h)) * G_HT)
#define SB(b, h) (shm + (4 + (b) * 2 + (h)) * G_HT)
#define STAGE_AX(T, P, hf, kt) do { for (int _i = 0; _i < 2; ++_i) { int _b = (T) * 16 + _i * 8192; int _r, _c; g_stage_rc(_b, _r, _c); \
        const long _row = GATHER ? (long)rowmap[(hf) * G_HALF + _r] : (long)(arow0 + (hf) * G_HALF + _r); \
        __builtin_amdgcn_global_load_lds((const unsigned*)(A + _row * lda + (long)(kt) * G_BK + _c), (unsigned*)((char*)(P) + _b), 16, 0, 0); } } while (0)
#define STAGE_BX(T, P, hf, kt) do { for (int _i = 0; _i < 2; ++_i) { int _b = (T) * 16 + _i * 8192; int _r, _c; g_stage_rc(_b, _r, _c); \
        __builtin_amdgcn_global_load_lds((const unsigned*)(Bt + (long)(bcol0 + (hf) * G_HALF + _r) * ldb + (long)(kt) * G_BK + _c), (unsigned*)((char*)(P) + _b), 16, 0, 0); } } while (0)
#define STAGE_A(P, hf, kt) STAGE_AX(t0, P, hf, kt)
#define STAGE_B(P, hf, kt) STAGE_BX(t0, P, hf, kt)
#define LDA(dst, b, h) for (int m = 0; m < 4; ++m) for (int k = 0; k < 2; ++k) \
        dst[m][k] = *reinterpret_cast<const bf16x8*>((char*)SA(b, h) + g_lds_byte(wr * 64 + m * 16 + fr, k * 32 + fq * 8))
#define LDB(dst, b, h) for (int n = 0; n < 2; ++n) for (int k = 0; k < 2; ++k) \
        dst[n][k] = *reinterpret_cast<const bf16x8*>((char*)SB(b, h) + g_lds_byte(wc * 32 + n * 16 + fr, k * 32 + fq * 8))
#define MMA(ai, bj, At, Bt_) do { __builtin_amdgcn_s_setprio(1); \
        for (int m = 0; m < 4; ++m) for (int n = 0; n < 2; ++n) for (int k = 0; k < 2; ++k) \
            acc[ai][bj][m][n] = __builtin_amdgcn_mfma_f32_16x16x32_bf16(Bt_[n][k], At[m][k], acc[ai][bj][m][n], 0, 0, 0); \
        __builtin_amdgcn_s_setprio(0); } while (0)
#define WAIT_V(n) asm volatile("s_waitcnt vmcnt(" #n ")" ::: "memory")
#define WAIT_L(n) asm volatile("s_waitcnt lgkmcnt(" #n ")" ::: "memory")
#define BAR __builtin_amdgcn_s_barrier()
#define SCHED __builtin_amdgcn_sched_barrier(0)
    unsigned m0 = ~0u; asm volatile("" : "+s"(m0));
    int t0 = wv_in * 64 + (int)__builtin_amdgcn_mbcnt_hi(m0, __builtin_amdgcn_mbcnt_lo(m0, 0u)); asm volatile("" : "+v"(t0));
    int wid = t0 >> 6, lane = t0 & 63, wr = wid >> 2, wc = wid & 3, fr = lane & 15, fq = lane >> 4;
    f32x4 acc[2][2][4][2] = {};
    bf16x8 At[4][2], B0[2][2], B1[2][2];
    const int nt = K / G_BK;
    STAGE_B(SB(0, 0), 0, 0); STAGE_A(SA(0, 0), 0, 0);
    STAGE_B(SB(0, 1), 1, 0); STAGE_A(SA(0, 1), 1, 0);
    if (wr == 1) BAR;
    WAIT_V(4); BAR;
    STAGE_B(SB(1, 0), 0, 1); STAGE_A(SA(1, 0), 0, 1); STAGE_B(SB(1, 1), 1, 1);
    WAIT_V(6); BAR;
    for (int t = 0; t < nt - 2; t += 2) {
        LDB(B0, 0, 0); SCHED; LDA(At, 0, 0); STAGE_A(SA(1, 1), 1, t + 1);
        WAIT_L(8); BAR; WAIT_L(0); MMA(0, 0, At, B0); BAR; SCHED;
        LDB(B1, 0, 1); STAGE_B(SB(0, 0), 0, t + 2);
        BAR; WAIT_L(0); MMA(0, 1, At, B1); BAR;
        LDA(At, 0, 1); STAGE_A(SA(0, 0), 0, t + 2);
        BAR; WAIT_L(0); MMA(1, 0, At, B0); BAR; SCHED;
        STAGE_B(SB(0, 1), 1, t + 2);
        WAIT_V(6); BAR; MMA(1, 1, At, B1); BAR;
        LDB(B0, 1, 0); SCHED; LDA(At, 1, 0); STAGE_A(SA(0, 1), 1, t + 2);
        WAIT_L(8); BAR; WAIT_L(0); MMA(0, 0, At, B0); BAR; SCHED;
        LDB(B1, 1, 1); STAGE_B(SB(1, 0), 0, t + 3);
        BAR; WAIT_L(0); MMA(0, 1, At, B1); BAR;
        LDA(At, 1, 1); STAGE_A(SA(1, 0), 0, t + 3);
        BAR; WAIT_L(0); MMA(1, 0, At, B0); BAR; SCHED;
        STAGE_B(SB(1, 1), 1, t + 3);
        WAIT_V(6); BAR; MMA(1, 1, At, B1); BAR;
    }
    int tz = t0; asm volatile("" : "+v"(tz)); wid = tz >> 6; lane = tz & 63; wr = wid >> 2; wc = wid & 3; fr = lane & 15; fq = lane >> 4;
    { LDB(B0, 0, 0); WAIT_V(0); LDA(At, 0, 0); STAGE_AX(tz, SA(1, 1), 1, nt - 1);
      BAR; WAIT_L(0); MMA(0, 0, At, B0); BAR;
      LDB(B1, 0, 1); BAR; WAIT_L(0); MMA(0, 1, At, B1); BAR;
      LDA(At, 0, 1); WAIT_V(4); BAR; WAIT_L(0); MMA(1, 0, At, B0); MMA(1, 1, At, B1); BAR; }
    { LDB(B0, 1, 0); LDA(At, 1, 0); WAIT_V(2); BAR; WAIT_L(0); MMA(0, 0, At, B0); BAR;
      LDB(B1, 1, 1); WAIT_V(0); BAR; WAIT_L(0); MMA(0, 1, At, B1); BAR;
      LDA(At, 1, 1); BAR; WAIT_L(0); MMA(1, 0, At, B0); MMA(1, 1, At, B1); BAR; }
    if (wr == 0) BAR;
#pragma unroll
    for (int ai = 0; ai < 2; ++ai)
#pragma unroll
        for (int m = 0; m < 4; ++m)
#pragma unroll
            for (int bj = 0; bj < 2; ++bj)
#pragma unroll
                for (int n = 0; n < 2; ++n) {
                    const f32x4 v = acc[ai][bj][m][n];
                    epi(ai * G_HALF + wr * 64 + m * 16 + fr, bj * G_HALF + wc * 32 + n * 16 + fq * 4, v[0], v[1], v[2], v[3]);
                }
#undef SA
#undef SB
#undef STAGE_A
#undef STAGE_B
#undef STAGE_AX
#undef STAGE_BX
#undef LDA
#undef LDB
#undef MMA
}
template <class Epi>
DI void gemm_unit(const Frame& F, const bf16* __restrict__ A, int lda, const int* rowmap, int arow0,
                  const bf16* __restrict__ Bt, int ldb, int bcol0, int K, const Epi& epi) {
    if (rowmap) gemm_unit_t<true>(F.wv, (bf16*)F.smem, A, lda, rowmap, arow0, Bt, ldb, bcol0, K, epi);
    else gemm_unit_t<false>(F.wv, (bf16*)F.smem, A, lda, rowmap, arow0, Bt, ldb, bcol0, K, epi);
}
#else
template <class Epi>
void gemm_unit(const Frame& F, const bf16* A, int lda, const int* rowmap, int arow0, const bf16* Bt, int ldb, int bcol0, int K, const Epi& epi, int mrows = 256) {
    for (int r = 0; r < mrows; ++r) {
        int arow = rowmap ? rowmap[r] : arow0 + r;
        for (int c = 0; c < 256; c += 4) {
            float v[4];
            for (int q = 0; q < 4; ++q) {
                double s = 0; const bf16* a = A + (long)arow * lda; const bf16* b = Bt + (long)(bcol0 + c + q) * ldb;
                for (int k = 0; k < K; ++k) s += (double)bf2f(a[k]) * bf2f(b[k]);
                v[q] = (float)s;
            }
            epi(r, c, v[0], v[1], v[2], v[3]);
        }
    }
}
#endif

DI void st_bf16x4(bf16* p, float a, float b, float c, float d) {
#ifndef CPU_EMU
    uint2 u; u.x = pack_bf16(a, b); u.y = pack_bf16(c, d); *reinterpret_cast<uint2*>(p) = u;
#else
    p[0] = f2bf(a); p[1] = f2bf(b); p[2] = f2bf(c); p[3] = f2bf(d);
#endif
}

#define WSP(T, off) ((T*)(F.ws + (off)))

DI void ln_row_write(float* xrow, bf16* brow, const float* vals_in  , const float* g, const float* b);

template <class Fn>
DI void layer_norm_rows(const Frame& F, const float* g, const float* b, Fn pre, bool write_out_extra, float* extra) {
    float* xf = F.xf; bf16* xb = WSP(bf16, OFF_XB);
    for (int row = ggrp(F); row < NTOK; row += ngrp(F)) {
        float v[PERLN]; float s = 0.f;
        for (int i = 0; i < PERLN; ++i) { int c = glane(F) + i * GRP; v[i] = pre(row, c); s += v[i]; }
        s = grp_sum(F, s); const float mu = s * (1.0f / 1024.0f);
        float q = 0.f;
        for (int i = 0; i < PERLN; ++i) { float d = v[i] - mu; q += d * d; }
        q = grp_sum(F, q); const float rs = 1.0f / sqrtf(q * (1.0f / 1024.0f) + LN_EPS);
        for (int i = 0; i < PERLN; ++i) { int c = glane(F) + i * GRP; float y = (v[i] - mu) * rs * g[c] + b[c];
            xf[(size_t)row * DM + c] = y; xb[(size_t)row * DM + c] = f2bf(y); if (write_out_extra) extra[(size_t)row * DM + c] = y; }
    }
}

DI void phase_pro(const Frame& F) {
    const float* x = F.in[0]; const float* mem = F.in[1];
    layer_norm_rows(F, F.in[2], F.in[3], [&](int row, int c) { return x[(size_t)row * DM + c]; }, false, nullptr);
    bf16* memb = WSP(bf16, OFF_MEMB);
    for (size_t i = gtid_(F); i < (size_t)NMEM * DM; i += gthreads(F)) memb[i] = f2bf(mem[i]);
}

template <class Src>
DI void cvt_tile(const Frame& F, bf16* dst, int Kk, int n0, int k0, Src src) {
#ifndef CPU_EMU
    float* tile = (float*)F.smem;
    __syncthreads();
    for (int i = F.tid; i < 4096; i += NTH) { int k = i >> 6, n = i & 63; tile[k * 65 + n] = src(k0 + k, n0 + n); }
    __syncthreads();
    for (int i = F.tid; i < 2048; i += NTH) { int n = i >> 5, k = (i & 31) * 2;
        *reinterpret_cast<unsigned*>(dst + (size_t)(n0 + n) * Kk + k0 + k) = pack_bf16(tile[k * 65 + n], tile[(k + 1) * 65 + n]); }
#endif
}
template <class Src>
DI void cvt_transpose(const Frame& F, bf16* dst, int Nn, int Kk, Src src, int t_first, int t_total) {
#ifdef CPU_EMU
    for (int n = 0; n < Nn; ++n) for (int k = 0; k < Kk; ++k) dst[(size_t)n * Kk + k] = f2bf(src(k, n));
#else
    const int tn = Nn / 64, tk = Kk / 64, ntile = tn * tk;
    int t = (int)blockIdx.x - (t_first % (int)F.nblk); if (t < 0) t += F.nblk;
    for (; t < ntile; t += F.nblk) cvt_tile(F, dst, Kk, (t % tn) * 64, (t / tn) * 64, src);
#endif
}

DI int win_src_col(int n) {
    if (n < 512) return n;
    if (n < 1536) { int c = n - 512; return c < 960 ? 512 + c : -1; }
    if (n < 2816) return 1472 + (n - 1536);
    int c = n - 2816;
    if (c < 192) return 2752 + c;
    if (c < 224) return 2752 + 320 + (c - 192);
    if (c < 256) return -1;
    if (c < 384) return 2752 + 192 + (c - 256);
    return -1;
}
DI int wuq_src_col(int n) {
    if (n >= 384) return -1;
    int h = n / 96, w = n % 96;
    if (w < 64) return h * 96 + w;
    int p = w - 64, m = p >> 1, which = p & 1;
    int i = (m < 8 ? m : 16 + (m - 8)) + (which ? 8 : 0);
    return h * 96 + 64 + i;
}

DI void phase_cvt(const Frame& F, int l) {
    bf16* wts = WSP(bf16, OFF_WTS);
    constexpr int T0 = 0, T1 = T0 + (HP / 64) * 16, T2 = T1 + 8 * 4, T3 = T2 + 8 * 4, T4 = T3 + 256, T5 = T4 + 256, T6 = T5 + 512, TT = T6 + 256;
    { const float* w = F.in[4] + (size_t)l * 1024 * IN_WIDTH;
      cvt_transpose(F, (bf16*)((char*)wts + W_IN_T), HP, 1024, [&](int k, int n) { int s = win_src_col(n); return s < 0 ? 0.f : w[(size_t)k * IN_WIDTH + s]; }, T0, TT); }
    { const float* w = F.in[23] + (size_t)l * 192 * 384;
      cvt_transpose(F, (bf16*)((char*)wts + W_UQ_T), 512, 256, [&](int k, int n) { int s = wuq_src_col(n); return (s < 0 || k >= 192) ? 0.f : w[(size_t)k * 384 + s]; }, T1, TT); }
    { const float* w = F.in[24] + (size_t)l * 128 * 512;
      cvt_transpose(F, (bf16*)((char*)wts + W_UKV_T), 512, 256, [&](int k, int n) { return k >= 128 ? 0.f : w[(size_t)k * 512 + n]; }, T2, TT); }
    { const float* w = F.in[25] + (size_t)l * 1024 * 1024;
      cvt_transpose(F, (bf16*)((char*)wts + W_OUT_T), 1024, 1024, [&](int k, int n) { return w[(size_t)k * 1024 + n]; }, T3, TT); }
    { const float* w = F.in[28] + (size_t)l * 1024 * 1024;
      cvt_transpose(F, (bf16*)((char*)wts + W_Q_T), 1024, 1024, [&](int k, int n) { return w[(size_t)k * 1024 + n]; }, T4, TT); }
    { const float* w = F.in[29] + (size_t)l * 1024 * 2048;
      cvt_transpose(F, (bf16*)((char*)wts + W_KV_T), 2048, 1024, [&](int k, int n) { return w[(size_t)k * 2048 + n]; }, T5, TT); }
    { const float* w = F.in[30] + (size_t)l * 1024 * 1024;
      cvt_transpose(F, (bf16*)((char*)wts + W_O_T), 1024, 1024, [&](int k, int n) { return w[(size_t)k * 1024 + n]; }, T6, TT); }
#ifndef CPU_EMU
    { const float* wg = F.in[33] + (size_t)l * 1024 * 4; const float* we = F.in[35] + (size_t)l * 1024 * 32; float* gt = (float*)((char*)wts + W_GATE_T) + (size_t)l * 48 * 1024;
      for (int i = gtid_(F); i < 48 * 1024; i += gthreads(F)) { const int col = i >> 10, k = i & 1023;
          gt[i] = col < 4 ? wg[k * 4 + col] : col < 36 ? we[k * 32 + col - 4] : 0.f; } }
#endif
}

DI void phase_cvt_moe(const Frame& F, int l) {
#ifdef CPU_EMU
    for (int e = 0; e < NEXP; ++e) {
        const float* w1 = F.in[37] + ((size_t)l * NEXP + e) * 1024 * 256;
        const float* w3 = F.in[38] + ((size_t)l * NEXP + e) * 1024 * 256;
        const float* w2 = F.in[39] + ((size_t)l * NEXP + e) * 256 * 1024;
        cvt_transpose(F, WSP(bf16, OFF_W13T) + (size_t)e * 512 * 1024, 512, 1024,
                      [&](int k, int n) { return (n & 1) ? w3[(size_t)k * 256 + (n >> 1)] : w1[(size_t)k * 256 + (n >> 1)]; }, 0, 1);
        cvt_transpose(F, WSP(bf16, OFF_W2T) + (size_t)e * 1024 * 256, 1024, 256, [&](int k, int n) { return w2[(size_t)k * 1024 + n]; }, 0, 1);
    }
#else
    const float* w1b = F.in[37] + (size_t)l * NEXP * 1024 * 256; const float* w3b = F.in[38] + (size_t)l * NEXP * 1024 * 256; const float* w2b = F.in[39] + (size_t)l * NEXP * 256 * 1024;
    for (int t = blockIdx.x; t < NEXP * 128 + NEXP * 64; t += F.nblk) {
        if (t < NEXP * 128) {
            const int e = t >> 7, tt = t & 127; const float* w1 = w1b + (size_t)e * 1024 * 256; const float* w3 = w3b + (size_t)e * 1024 * 256;
            cvt_tile(F, WSP(bf16, OFF_W13T) + (size_t)e * 512 * 1024, 1024, (tt & 7) * 64, (tt >> 3) * 64,
                     [&](int k, int n) { return (n & 1) ? w3[(size_t)k * 256 + (n >> 1)] : w1[(size_t)k * 256 + (n >> 1)]; });
        } else {
            const int u = t - NEXP * 128, e = u >> 6, tt = u & 63; const float* w2 = w2b + (size_t)e * 256 * 1024;
            cvt_tile(F, WSP(bf16, OFF_W2T) + (size_t)e * 1024 * 256, 256, (tt & 15) * 64, (tt >> 4) * 64, [&](int k, int n) { return w2[(size_t)k * 1024 + n]; });
        }
    }
#endif
}

struct EpiH {
    bf16* hatt; bf16* hrwkv; bf16* hhgrn; bf16* hmla; int row0, pn;
    DI void operator()(int r, int c, float a, float b, float cc, float d) const {
        const size_t row = row0 + r;
        bf16* p;
        if (pn < 2) p = hatt + row * 512 + pn * 256 + c;
        else if (pn < 6) p = hrwkv + row * 1024 + (pn - 2) * 256 + c;
        else if (pn < 11) p = hhgrn + row * 1280 + (pn - 6) * 256 + c;
        else p = hmla + row * 512 + (pn - 11) * 256 + c;
        st_bf16x4(p, a, b, cc, d);
    }
};
struct EpiKV {
    bf16* kmem; bf16* vt; int row0, pn;
    DI void operator()(int r, int c, float a, float b, float cc, float d) const {
        const int row = row0 + r, col = pn * 256 + c;
        if (col < 1024) { st_bf16x4(kmem + (size_t)row * 1024 + col, a, b, cc, d); }
        else { const int bb = row / MEMT, key = row % MEMT, hc = col - 1024;
            bf16* p = vt + ((size_t)bb * 1024 + hc) * MEMT + key;
            p[0] = f2bf(a); p[MEMT] = f2bf(b); p[2 * MEMT] = f2bf(cc); p[3 * MEMT] = f2bf(d); }
    }
};

DI void phase_gemm1(const Frame& F) {
    const bf16* xb = WSP(bf16, OFF_XB); const bf16* wts = WSP(bf16, OFF_WTS);
    const int nM = (NTOK + 255) / 256, nN = HP / 256, n1 = nM * nN;
    const int nMk = (NMEM + 255) / 256, nNk = 8, n2 = nMk * nNk;
    for (int u = blockIdx.x; u < n1 + n2; u += F.nblk) {
        if (u < n1) {
            const int pm = u / nN, pn = u % nN;
            EpiH E{WSP(bf16, OFF_HATT), WSP(bf16, OFF_HRWKV), WSP(bf16, OFF_HHGRN), WSP(bf16, OFF_HMLA), pm * 256, pn};
#ifdef CPU_EMU
            gemm_unit(F, xb, 1024, nullptr, pm * 256, (const bf16*)((const char*)wts + W_IN_T), 1024, pn * 256, 1024, E, min(256, NTOK - pm * 256));
#else
            gemm_unit(F, xb, 1024, nullptr, pm * 256, (const bf16*)((const char*)wts + W_IN_T), 1024, pn * 256, 1024, E);
#endif
        } else {
            const int v = u - n1, pm = v / nNk, pn = v % nNk;
            EpiKV E{WSP(bf16, OFF_KMEM), WSP(bf16, OFF_VTMEM), pm * 256, pn};
            gemm_unit(F, WSP(bf16, OFF_MEMB), 1024, nullptr, pm * 256, (const bf16*)((const char*)wts + W_KV_T), 1024, pn * 256, 1024, E);
        }
    }
}


#ifndef CPU_EMU
DI float fast_sigmoid(float x) { return 1.0f / (1.0f + __expf(-x)); }
DI float fast_tanh(float x) { const float e = __expf(2.0f * x); return 1.0f - 2.0f / (e + 1.0f); }
DI float bflo(unsigned u) { return __uint_as_float(u << 16); }
DI float bfhi(unsigned u) { return __uint_as_float(u & 0xffff0000u); }

DI void prep_attn_gpu(const Frame& F, int l) {
    float* tabA = (float*)F.smem;
    float* tabB = tabA + 2048;
    float* gq = tabB + 1024;
    __syncthreads();
    { const int tid = fresh_tid(F);
    for (int i = tid; i < 1024; i += NTH) { const int pos = i >> 4, f = i & 15; const float ang = (float)pos * rope_inv(2 * f, 32); tabA[i] = cosf(ang); tabA[1024 + i] = sinf(ang); }
    for (int i = tid; i < 512; i += NTH) { const int pos = i >> 3, f = i & 7; const float ang = (float)pos * rope_inv(2 * f, 16); tabB[i] = cosf(ang); tabB[512 + i] = sinf(ang); }
    for (int i = tid; i < 448; i += NTH) gq[i] = i < 64 ? F.in[5][l * 64 + i] : i < 128 ? F.in[6][l * 64 + i - 64] : i < 320 ? F.in[21][l * 192 + i - 128] : F.in[22][l * 128 + i - 320]; }
    __syncthreads();
    bf16* hatt = WSP(bf16, OFF_HATT);
    for (int it = blockIdx.x * NTH + fresh_tid(F); it < NTOK * 6; it += gthreads(F)) {
        const int n = it / 6, hh = it % 6, s = n % SEQ, rowp = s / GRIDW, colp = s % GRIDW;
        uint4* p = reinterpret_cast<uint4*>(hatt + (size_t)n * 512 + hh * 64);
        const float* gn = gq + (hh < 4 ? 0 : 64);
        uint4 raw[8];
#pragma unroll
        for (int i = 0; i < 8; ++i) raw[i] = p[i];
        float x[64];
#pragma unroll
        for (int i = 0; i < 8; ++i) { x[8 * i] = bflo(raw[i].x); x[8 * i + 1] = bfhi(raw[i].x); x[8 * i + 2] = bflo(raw[i].y); x[8 * i + 3] = bfhi(raw[i].y);
            x[8 * i + 4] = bflo(raw[i].z); x[8 * i + 5] = bfhi(raw[i].z); x[8 * i + 6] = bflo(raw[i].w); x[8 * i + 7] = bfhi(raw[i].w); }
        float ss = 0.f;
#pragma unroll
        for (int j = 0; j < 64; ++j) ss += x[j] * x[j];
        const float rs = 1.0f / sqrtf(ss * (1.0f / 64.0f) + RMS_EPS);
#pragma unroll
        for (int j = 0; j < 64; ++j) x[j] *= rs * gn[j];
#pragma unroll
        for (int half = 0; half < 2; ++half) {
            const int pos = half ? colp : rowp;
#pragma unroll
            for (int f = 0; f < 16; ++f) {
                const float cs = tabA[pos * 16 + f], sn = tabA[1024 + pos * 16 + f];
                const float x1 = x[half * 32 + f], x2 = x[half * 32 + 16 + f];
                x[half * 32 + f] = x1 * cs - x2 * sn; x[half * 32 + 16 + f] = x1 * sn + x2 * cs;
            }
        }
#pragma unroll
        for (int i = 0; i < 8; ++i) { uint4 o; o.x = pack_bf16(x[8 * i], x[8 * i + 1]); o.y = pack_bf16(x[8 * i + 2], x[8 * i + 3]); o.z = pack_bf16(x[8 * i + 4], x[8 * i + 5]); o.w = pack_bf16(x[8 * i + 6], x[8 * i + 7]); p[i] = o; }
    }
    bf16* hm = WSP(bf16, OFF_HMLA); bf16* kr = WSP(bf16, OFF_KROPE);
    for (int it = blockIdx.x * NTH + fresh_tid(F); it < NTOK * 3; it += gthreads(F)) {
        const int n = it / 3, which = it % 3;
        if (which < 2) {
            const int len = which ? 128 : 192; const float* gn = gq + (which ? 320 : 128);
            uint4* p = reinterpret_cast<uint4*>(hm + (size_t)n * 512 + (which ? 256 : 0));
            float ss = 0.f;
            for (int i = 0; i < len / 8; ++i) { const uint4 r = p[i];
                const float a0 = bflo(r.x), a1 = bfhi(r.x), a2 = bflo(r.y), a3 = bfhi(r.y), a4 = bflo(r.z), a5 = bfhi(r.z), a6 = bflo(r.w), a7 = bfhi(r.w);
                ss += a0 * a0 + a1 * a1 + a2 * a2 + a3 * a3 + a4 * a4 + a5 * a5 + a6 * a6 + a7 * a7; }
            const float rs = 1.0f / sqrtf(ss / (float)len + RMS_EPS);
            for (int i = 0; i < len / 8; ++i) { const uint4 r = p[i]; const float* g = gn + 8 * i; uint4 o;
                o.x = pack_bf16(bflo(r.x) * rs * g[0], bfhi(r.x) * rs * g[1]); o.y = pack_bf16(bflo(r.y) * rs * g[2], bfhi(r.y) * rs * g[3]);
                o.z = pack_bf16(bflo(r.z) * rs * g[4], bfhi(r.z) * rs * g[5]); o.w = pack_bf16(bflo(r.w) * rs * g[6], bfhi(r.w) * rs * g[7]); p[i] = o; }
        } else {
            const int s = n % SEQ, rowp = s / GRIDW, colp = s % GRIDW;
            const uint4* p = reinterpret_cast<const uint4*>(hm + (size_t)n * 512 + 192);
            float x[32];
#pragma unroll
            for (int i = 0; i < 4; ++i) { const uint4 r = p[i]; x[8 * i] = bflo(r.x); x[8 * i + 1] = bfhi(r.x); x[8 * i + 2] = bflo(r.y); x[8 * i + 3] = bfhi(r.y);
                x[8 * i + 4] = bflo(r.z); x[8 * i + 5] = bfhi(r.z); x[8 * i + 6] = bflo(r.w); x[8 * i + 7] = bfhi(r.w); }
            unsigned o[16];
#pragma unroll
            for (int m = 0; m < 16; ++m) {
                const int i1 = m < 8 ? m : 16 + (m - 8), pos = m < 8 ? rowp : colp, f = m & 7;
                const float cs = tabB[pos * 8 + f], sn = tabB[512 + pos * 8 + f];
                o[m] = pack_bf16(x[i1] * cs - x[i1 + 8] * sn, x[i1] * sn + x[i1 + 8] * cs);
            }
            uint4* q = reinterpret_cast<uint4*>(kr + (size_t)n * 32);
#pragma unroll
            for (int i = 0; i < 4; ++i) q[i] = make_uint4(o[4 * i], o[4 * i + 1], o[4 * i + 2], o[4 * i + 3]);
        }
    }
    {
        bf16* vt = WSP(bf16, OFF_VTATT); bf16* tl = (bf16*)(gq + 512);
        for (int tile = blockIdx.x; tile < BATCH * 2 * (SEQ / 64); tile += F.nblk) {
            const int b = tile / (2 * (SEQ / 64)), kv = (tile / (SEQ / 64)) % 2, t0 = (tile % (SEQ / 64)) * 64;
            __syncthreads();
            const int tid = fresh_tid(F);
            { const int t = tid >> 3, part = tid & 7;
              const uint4 r = *reinterpret_cast<const uint4*>(hatt + (size_t)(b * SEQ + t0 + t) * 512 + 384 + kv * 64 + part * 8);
              const unsigned w[4] = {r.x, r.y, r.z, r.w};
#pragma unroll
              for (int i = 0; i < 4; ++i) { tl[(part * 8 + 2 * i) * 72 + t] = (bf16)(w[i] & 0xffffu); tl[(part * 8 + 2 * i + 1) * 72 + t] = (bf16)(w[i] >> 16); } }
            __syncthreads();
            { const int dv = tid >> 3, part = tid & 7;
              *reinterpret_cast<uint4*>(vt + ((size_t)(b * 2 + kv) * 64 + dv) * SEQ + t0 + part * 8) = *reinterpret_cast<const uint4*>(tl + dv * 72 + part * 8); }
        }
    }
}

DI void prep_hgrn_gpu(const Frame& F, int l) {
    float* lbs = (float*)F.smem + 8192;
    __syncthreads();
    for (int d = F.tid; d < 256; d += NTH) { float lb = 0.f;
        if (l == 1) { const float a = F.in[19][d], b = F.in[19][256 + d]; const float m = fmaxf(a, b); const float ea = __expf(a - m), eb = __expf(b - m); lb = eb / (ea + eb); }
        lbs[d] = 1.0f - lb; }
    __syncthreads();
    bf16* hh = WSP(bf16, OFF_HHGRN);
    for (int it = gtid_(F); it < NTOK * 96; it += gthreads(F)) {
        const int n = it / 96, g = it % 96, c0 = g * 8;
        uint4* p = reinterpret_cast<uint4*>(hh + (size_t)n * 1280 + c0);
        const uint4 r = *p; float x[8] = {bflo(r.x), bfhi(r.x), bflo(r.y), bfhi(r.y), bflo(r.z), bfhi(r.z), bflo(r.w), bfhi(r.w)};
        if (c0 < 256) {
#pragma unroll
            for (int i = 0; i < 8; ++i) x[i] = x[i] * fast_sigmoid(x[i]);
        } else {
#pragma unroll
            for (int i = 0; i < 8; ++i) x[i] = lbs[(c0 + i) & 255] * fast_sigmoid(-x[i]);
        }
        *p = make_uint4(pack_bf16(x[0], x[1]), pack_bf16(x[2], x[3]), pack_bf16(x[4], x[5]), pack_bf16(x[6], x[7]));
    }
}

DI void prep_rwkv_gpu(const Frame& F, int l) {
    const bf16* hz = WSP(bf16, OFF_HRWKV); bf16* r7 = WSP(bf16, OFF_R7); bf16* gb = WSP(bf16, OFF_G); float* bonus = WSP(float, OFF_BONUS);
    const float* mup = F.in[7] + l * 960; const float* mun = F.in[8] + l * 960;
    const float* w0 = F.in[9] + l * 512; const float* w2 = F.in[10] + (size_t)l * 2 * 32 * 256;
    const float* a0 = F.in[11] + l * 512; const float* a2 = F.in[12] + (size_t)l * 2 * 32 * 256;
    const float* g2 = F.in[13] + (size_t)l * 64 * 256;
    const size_t AS = (size_t)NTOK * 256;
    float* zs = (float*)F.smem;
    const int tid = F.tid, c = tid & 255, tg = tid >> 8;
    const float w0a = w0[c], w0b = w0[256 + c], a0a = a0[c], a0b = a0[256 + c];
    const float kkc = F.in[14][l * 256 + c], kac = F.in[15][l * 256 + c], rkc = F.in[16][l * 256 + c];
    for (int tile = blockIdx.x; tile < NTOK / 16; tile += F.nblk) {
        const int n0 = tile * 16;
        __syncthreads();
        const int tl = fresh_tid(F);
#pragma unroll
        for (int bt = 0; bt < 3; ++bt) {
            unsigned zc[5], zp[5], zn[5];
#pragma unroll
            for (int i = 0; i < 5; ++i) {
                const int e = tl + (bt * 5 + i) * NTH, t = e / 480, cc = (e % 480) * 2, n = n0 + t, s = n % SEQ;
                zc[i] = *reinterpret_cast<const unsigned*>(hz + (size_t)n * 1024 + cc);
                zp[i] = s > 0 ? *reinterpret_cast<const unsigned*>(hz + (size_t)(n - 1) * 1024 + cc) : 0u;
                zn[i] = s < SEQ - 1 ? *reinterpret_cast<const unsigned*>(hz + (size_t)(n + 1) * 1024 + cc) : 0u;
            }
#pragma unroll
            for (int i = 0; i < 5; ++i) {
                const int e = tl + (bt * 5 + i) * NTH, t = e / 480, cc = (e % 480) * 2;
                const float2 mp = *reinterpret_cast<const float2*>(mup + cc), mn = *reinterpret_cast<const float2*>(mun + cc);
                float v0 = bflo(zc[i]), v1 = bfhi(zc[i]);
                v0 = v0 + mp.x * (bflo(zp[i]) - v0) + mn.x * (bflo(zn[i]) - v0);
                v1 = v1 + mp.y * (bfhi(zp[i]) - v1) + mn.y * (bfhi(zn[i]) - v1);
                if (cc >= 768 && cc < 832) { v0 = fast_tanh(v0); v1 = fast_tanh(v1); }
                else if (cc >= 896) { v0 = fast_sigmoid(v0); v1 = fast_sigmoid(v1); }
                *reinterpret_cast<float2*>(zs + t * 960 + cc) = make_float2(v0, v1);
            }
        }
        __syncthreads();
        float wr0[8], wr1[8], ar0[8], ar1[8], gg[8];
#pragma unroll
        for (int t = 0; t < 8; ++t) { wr0[t] = w0a; wr1[t] = w0b; ar0[t] = a0a; ar1[t] = a0b; gg[t] = 0.f; }
        for (int q = 0; q < 32; q += 4) {
            float wa[4], wb[4], aa[4], ab[4];
#pragma unroll
            for (int u = 0; u < 4; ++u) { wa[u] = w2[(size_t)(q + u) * 256 + c]; wb[u] = w2[(size_t)(32 + q + u) * 256 + c]; aa[u] = a2[(size_t)(q + u) * 256 + c]; ab[u] = a2[(size_t)(32 + q + u) * 256 + c]; }
#pragma unroll
            for (int t = 0; t < 8; ++t) {
                const float* zr = zs + (tg * 8 + t) * 960;
                const float4 x0 = *reinterpret_cast<const float4*>(zr + 768 + q), x1 = *reinterpret_cast<const float4*>(zr + 800 + q);
                const float4 y0 = *reinterpret_cast<const float4*>(zr + 832 + q), y1 = *reinterpret_cast<const float4*>(zr + 864 + q);
                wr0[t] += x0.x * wa[0] + x0.y * wa[1] + x0.z * wa[2] + x0.w * wa[3];
                wr1[t] += x1.x * wb[0] + x1.y * wb[1] + x1.z * wb[2] + x1.w * wb[3];
                ar0[t] += y0.x * aa[0] + y0.y * aa[1] + y0.z * aa[2] + y0.w * aa[3];
                ar1[t] += y1.x * ab[0] + y1.y * ab[1] + y1.z * ab[2] + y1.w * ab[3];
            }
        }
        for (int q = 0; q < 64; q += 4) {
            float ga[4];
#pragma unroll
            for (int u = 0; u < 4; ++u) ga[u] = g2[(size_t)(q + u) * 256 + c];
#pragma unroll
            for (int t = 0; t < 8; ++t) {
                const float4 x = *reinterpret_cast<const float4*>(zs + (tg * 8 + t) * 960 + 896 + q);
                gg[t] += x.x * ga[0] + x.y * ga[1] + x.z * ga[2] + x.w * ga[3];
            }
        }
#pragma unroll
        for (int t = 0; t < 8; ++t) {
            const int n = n0 + tg * 8 + t; const float* zr = zs + (tg * 8 + t) * 960;
            const float r = zr[c], k = zr[256 + c], v = zr[512 + c];
            const float dec0 = __expf(-DECAY_SCALE * fast_sigmoid(wr0[t])), dec1 = __expf(-DECAY_SCALE * fast_sigmoid(wr1[t]));
            const float A0 = fast_sigmoid(ar0[t]), A1 = fast_sigmoid(ar1[t]);
            const float kk = k * kkc;
            const float kd0 = k * (1.0f + (A0 - 1.0f) * kac), kd1 = k * (1.0f + (A1 - 1.0f) * kac);
            const float ss = grp_sum(F, kk * kk);
            const float bs = grp_sum(F, r * (kd0 + kd1) * rkc);
            const float kkn = kk * (1.0f / fmaxf(sqrtf(ss), 1e-12f));
            const size_t o = (size_t)n * 256 + c;
            r7[R_R * AS + o] = f2bf(r); r7[R_V * AS + o] = f2bf(v);
            r7[R_W0 * AS + o] = f2bf(dec0); r7[R_W1 * AS + o] = f2bf(dec1);
            r7[R_KD0 * AS + o] = f2bf(kd0); r7[R_KD1 * AS + o] = f2bf(kd1);
            r7[R_KK * AS + o] = f2bf(kkn); r7[R_AK0 * AS + o] = f2bf(A0 * kkn); r7[R_AK1 * AS + o] = f2bf(A1 * kkn);
            gb[o] = f2bf(gg[t]);
            if ((tid & 63) == 0) bonus[(size_t)n * 4 + (c >> 6)] = bs;
            asm volatile("" ::: "memory");
        }
    }
}
#endif

DI void phase_prep(const Frame& F, int l) {
#ifndef CPU_EMU
    prep_attn_gpu(F, l); prep_rwkv_gpu(F, l); prep_hgrn_gpu(F, l);
#else
    {
        bf16* hatt = WSP(bf16, OFF_HATT); bf16* vt = WSP(bf16, OFF_VTATT);
        const float* qn = F.in[5] + l * 64; const float* kn = F.in[6] + l * 64;
        const int nitem = NTOK * 6;
        for (int it = ggrp(F); it < nitem; it += ngrp(F)) {
            const int n = it / 6, hh = it % 6;
            const int s = n % SEQ;
            bf16* p = hatt + (size_t)n * 512 + hh * 64;
            const float* gn = hh < 4 ? qn : kn;
            float v[PER64]; float ss = 0.f;
            for (int i = 0; i < PER64; ++i) { int j = glane(F) + i * GRP; v[i] = bf2f(p[j]); ss += v[i] * v[i]; }
            ss = grp_sum(F, ss); const float rs = 1.0f / sqrtf(ss * (1.0f / 64.0f) + RMS_EPS);
            float o[PER64];
#ifdef CPU_EMU
            float nv[64]; for (int j = 0; j < 64; ++j) nv[j] = v[j] * rs * gn[j];
#endif
            for (int i = 0; i < PER64; ++i) {
                int j = glane(F) + i * GRP;
                const int half = j >> 5, w = j & 31, f = w & 15, second = w >> 4;
                const float pos = half == 0 ? (float)(s / GRIDW) : (float)(s % GRIDW);
                const float ang = pos * rope_inv(2 * f, 32);
                const float cs = cosf(ang), sn = sinf(ang);
                const float mine = v[i] * rs * gn[j];
                const int jp = second ? j - 16 : j + 16;
#ifdef CPU_EMU
                const float partner = nv[jp];
#else
                const float partner = shfl_idx(F, v[0], jp) * rs * gn[jp];
#endif
                o[i] = second ? (partner * sn + mine * cs) : (mine * cs - partner * sn);
            }
            for (int i = 0; i < PER64; ++i) { int j = glane(F) + i * GRP; p[j] = f2bf(o[i]); }
        }
        for (size_t i = gtid_(F); i < (size_t)NTOK * 128; i += gthreads(F)) {
            const int n = (int)(i / 128), c = (int)(i % 128), b = n / SEQ, s = n % SEQ;
            vt[((size_t)b * 128 + c) * SEQ + s] = hatt[(size_t)n * 512 + 384 + c];
        }
    }
    {
        bf16* hm = WSP(bf16, OFF_HMLA); bf16* kr = WSP(bf16, OFF_KROPE);
        const float* qn = F.in[21] + l * 192; const float* kvn = F.in[22] + l * 128;
        for (int it = ggrp(F); it < NTOK * 2; it += ngrp(F)) {
            const int n = it >> 1, which = it & 1;
            bf16* p = hm + (size_t)n * 512 + (which ? 256 : 0);
            const int len = which ? 128 : 192; const float* gn = which ? kvn : qn;
            float ss = 0.f;
            for (int j = glane(F); j < len; j += GRP) { float x = bf2f(p[j]); ss += x * x; }
            ss = grp_sum(F, ss); const float rs = 1.0f / sqrtf(ss / (float)len + RMS_EPS);
            for (int j = glane(F); j < len; j += GRP) p[j] = f2bf(bf2f(p[j]) * rs * gn[j]);
        }
        for (int i = gtid_(F); i < NTOK * 16; i += gthreads(F)) {
            const int n = i >> 4, m = i & 15, s = n % SEQ;
            const bf16* src = hm + (size_t)n * 512 + 192;
            const int i1 = (m < 8 ? m : 16 + (m - 8)), i2 = i1 + 8;
            const float x1 = bf2f(src[i1]), x2 = bf2f(src[i2]);
            const float pos = m < 8 ? (float)(s / GRIDW) : (float)(s % GRIDW);
            const float ang = pos * rope_inv(2 * (m & 7), 16);
            const float cs = cosf(ang), sn = sinf(ang);
            kr[(size_t)n * 32 + 2 * m] = f2bf(x1 * cs - x2 * sn);
            kr[(size_t)n * 32 + 2 * m + 1] = f2bf(x1 * sn + x2 * cs);
        }
    }
#ifdef CPU_EMU
    {
        const bf16* hz = WSP(bf16, OFF_HRWKV); bf16* r7 = WSP(bf16, OFF_R7); bf16* gb = WSP(bf16, OFF_G); float* bonus = WSP(float, OFF_BONUS);
        const float* mup = F.in[7] + l * 960; const float* mun = F.in[8] + l * 960;
        const float* w0 = F.in[9] + l * 512; const float* w2 = F.in[10] + (size_t)l * 2 * 32 * 256;
        const float* a0 = F.in[11] + l * 512; const float* a2 = F.in[12] + (size_t)l * 2 * 32 * 256;
        const float* g2 = F.in[13] + (size_t)l * 64 * 256;
        const float* k_k = F.in[14] + l * 256; const float* k_a = F.in[15] + l * 256; const float* r_k = F.in[16] + l * 256;
        const size_t AS = (size_t)NTOK * 256;
        for (int it = ggrp(F); it < NTOK * 4; it += ngrp(F)) {
            const int n = it >> 2, h = it & 3, s = n % SEQ;
            const bf16* z = hz + (size_t)n * 1024;
            const bool hp = s > 0, hn = s < SEQ - 1;
            auto shifted = [&](int c) -> float {
                const float zc = bf2f(z[c]);
                const float zp = hp ? bf2f(z[c - 1024]) : 0.f, zn = hn ? bf2f(z[c + 1024]) : 0.f;
                return zc + mup[c] * (zp - zc) + mun[c] * (zn - zc);
            };
            float kkv[PER64], rr[PER64], kd0[PER64], kd1[PER64], aa0[PER64], aa1[PER64];
            float ss = 0.f, bs = 0.f;
            for (int i = 0; i < PER64; ++i) {
                const int j = glane(F) + i * GRP, c = h * 64 + j;
                const float r = shifted(c), k = shifted(256 + c), v = shifted(512 + c);
                float wr0 = w0[c], wr1 = w0[256 + c], ar0 = a0[c], ar1 = a0[256 + c], g = 0.f;
                for (int q = 0; q < 32; ++q) {
                    wr0 += tanhf(shifted(768 + q)) * w2[(size_t)q * 256 + c];
                    wr1 += tanhf(shifted(800 + q)) * w2[(size_t)(32 + q) * 256 + c];
                    ar0 += shifted(832 + q) * a2[(size_t)q * 256 + c];
                    ar1 += shifted(864 + q) * a2[(size_t)(32 + q) * 256 + c];
                }
                for (int q = 0; q < 64; ++q) g += sigmoidf_(shifted(896 + q)) * g2[(size_t)q * 256 + c];
                const float dec0 = expf(-DECAY_SCALE * sigmoidf_(wr0)), dec1 = expf(-DECAY_SCALE * sigmoidf_(wr1));
                const float A0 = sigmoidf_(ar0), A1 = sigmoidf_(ar1);
                const float kk = k * k_k[c];
                kkv[i] = kk; ss += kk * kk; rr[i] = r; aa0[i] = A0; aa1[i] = A1;
                kd0[i] = k * (1.0f + (A0 - 1.0f) * k_a[c]); kd1[i] = k * (1.0f + (A1 - 1.0f) * k_a[c]);
                bs += r * (kd0[i] + kd1[i]) * r_k[c];
                const size_t o = (size_t)n * 256 + c;
                r7[R_R * AS + o] = f2bf(r); r7[R_V * AS + o] = f2bf(v);
                r7[R_W0 * AS + o] = f2bf(dec0); r7[R_W1 * AS + o] = f2bf(dec1);
                r7[R_KD0 * AS + o] = f2bf(kd0[i]); r7[R_KD1 * AS + o] = f2bf(kd1[i]);
                gb[o] = f2bf(g);
            }
            ss = grp_sum(F, ss); bs = grp_sum(F, bs);
            const float inv = 1.0f / fmaxf(sqrtf(ss), 1e-12f);
            for (int i = 0; i < PER64; ++i) {
                const int j = glane(F) + i * GRP, c = h * 64 + j; const size_t o = (size_t)n * 256 + c;
                const float kk = kkv[i] * inv;
                r7[R_KK * AS + o] = f2bf(kk); r7[R_AK0 * AS + o] = f2bf(aa0[i] * kk); r7[R_AK1 * AS + o] = f2bf(aa1[i] * kk);
            }
            if (glane(F) == 0) bonus[(size_t)n * 4 + h] = bs;
        }
    }
#else
    prep_rwkv_gpu(F, l);
#endif
    {
        bf16* hh = WSP(bf16, OFF_HHGRN);
        const float* lg = F.in[19];
        for (size_t i = gtid_(F); i < (size_t)NTOK * 768; i += gthreads(F)) {
            const int n = (int)(i / 768), c = (int)(i % 768);
            bf16* p = hh + (size_t)n * 1280 + c;
            const float x = bf2f(*p);
            if (c < 256) { *p = f2bf(siluf_(x)); }
            else {
                const int d = c & 255;
                float lb = 0.f;
                if (l == 1) { const float a = lg[d], b = lg[256 + d]; const float m = fmaxf(a, b); const float ea = expf(a - m), eb = expf(b - m); lb = eb / (ea + eb); }
                *p = f2bf((1.0f - lb) * sigmoidf_(-x));
            }
        }
    }
#endif
}

struct EpiQMla {
    bf16* q; int row0, pn;
    DI void operator()(int r, int c, float a, float b, float cc, float d) const {
        const int row = row0 + r, col = pn * 256 + c;
        if (col >= 384) return;
        const int w = col % 96;
        if (w >= 64) {
            const int s = row % SEQ;
#pragma unroll
            for (int t = 0; t < 2; ++t) {
                const int m = ((w - 64) >> 1) + t;
                const float pos = m < 8 ? (float)(s / GRIDW) : (float)(s % GRIDW);
                const float ang = pos * rope_inv(2 * (m & 7), 16);
                const float cs = cosf(ang), sn = sinf(ang);
                float& x1 = t ? cc : a; float& x2 = t ? d : b;
                const float y1 = x1 * cs - x2 * sn, y2 = x1 * sn + x2 * cs; x1 = y1; x2 = y2;
            }
        }
        st_bf16x4(q + (size_t)row * 384 + col, a, b, cc, d);
    }
};
struct EpiKVMla {
    bf16* kn; bf16* vt; int row0, pn;
    DI void operator()(int r, int c, float a, float b, float cc, float d) const {
        const int row = row0 + r, col = pn * 256 + c, h = col >> 7, w = col & 127;
        if (w < 64) st_bf16x4(kn + (size_t)row * 256 + h * 64 + w, a, b, cc, d);
        else { const int bb = row / SEQ, s = row % SEQ; bf16* p = vt + ((size_t)bb * 256 + h * 64 + (w - 64)) * SEQ + s;
            p[0] = f2bf(a); p[SEQ] = f2bf(b); p[2 * SEQ] = f2bf(cc); p[3 * SEQ] = f2bf(d); }
    }
};
DI void phase_mlaup(const Frame& F) {
    const bf16* hm = WSP(bf16, OFF_HMLA); const char* wts = (const char*)WSP(bf16, OFF_WTS);
    const int nM = (NTOK + 255) / 256;
    for (int u = blockIdx.x; u < nM * 4; u += F.nblk) {
        const int pm = u >> 2, j = u & 3;
#ifdef CPU_EMU
        const int mr = min(256, NTOK - pm * 256);
#define MR , mr
#else
#define MR
#endif
        if (j < 2) { EpiQMla E{WSP(bf16, OFF_QMLA), pm * 256, j};
            gemm_unit(F, hm, 512, nullptr, pm * 256, (const bf16*)(wts + W_UQ_T), 256, j * 256, 256, E MR); }
        else { EpiKVMla E{WSP(bf16, OFF_KNOPE), WSP(bf16, OFF_VTMLA), pm * 256, j - 2};
            gemm_unit(F, hm + 256, 512, nullptr, pm * 256, (const bf16*)(wts + W_UKV_T), 256, (j - 2) * 256, 256, E MR); }
    }
}

struct AttnDesc {
    const bf16* q; int q_stride;
    int q_hstride;
    const bf16* k; int k_stride; int k_hstride;
    const bf16* k2; int k2_stride;
    int dk_main;
    const bf16* vt;
    bf16* o; int o_stride; int o_hstride;
    int H, HKV, SQ, SK;
    float scale;
};

#ifdef CPU_EMU
template <int DK, int DV>
void attn_phase(const Frame& F, const AttnDesc& A) {
    const int G = A.H / A.HKV;
    float* sc = (float*)malloc(sizeof(float) * A.SK);
    for (int b = 0; b < BATCH; ++b) for (int h = 0; h < A.H; ++h) for (int s = 0; s < A.SQ; ++s) {
        const int kv = h / G;
        const bf16* q = A.q + (size_t)(b * A.SQ + s) * A.q_stride + h * A.q_hstride;
        float mx = -1e30f;
        for (int key = 0; key < A.SK; ++key) {
            const bf16* kp = A.k + (size_t)(b * A.SK + key) * A.k_stride + kv * A.k_hstride;
            double acc = 0;
            for (int d = 0; d < DK; ++d) {
                float kvl = d < A.dk_main ? bf2f(kp[d]) : bf2f(A.k2[(size_t)(b * A.SK + key) * A.k2_stride + d - A.dk_main]);
                acc += (double)bf2f(q[d]) * kvl;
            }
            sc[key] = (float)acc * A.scale; mx = fmaxf(mx, sc[key]);
        }
        double sum = 0; for (int key = 0; key < A.SK; ++key) { sc[key] = expf(sc[key] - mx); sum += sc[key]; }
        for (int dv = 0; dv < DV; ++dv) {
            const bf16* vp = A.vt + ((size_t)(b * A.HKV + kv) * DV + dv) * A.SK;
            double acc = 0; for (int key = 0; key < A.SK; ++key) acc += (double)bf2f(f2bf(sc[key])) * bf2f(vp[key]);
            A.o[(size_t)(b * A.SQ + s) * A.o_stride + h * A.o_hstride + dv] = f2bf((float)(acc / sum));
        }
    }
    free(sc);
}
#else
DI int crow16(int reg, int h) { return (reg & 3) + 8 * (reg >> 2) + 4 * h; }
template <int DK, int DV, int DVT>
DI void attn_unit(const Frame& F, const AttnDesc& A, int u) {
    constexpr int KP = DK + 8;
    constexpr int VP = 64 + 8;
    constexpr int NPASS = DV / DVT;
    bf16* Ks = (bf16*)F.smem;
    bf16* Vs = Ks + 64 * KP;
    const int tid = F.tid, wave = tid >> 6, lane = tid & 63, r = lane & 31, hh = lane >> 5;
    const int G = A.H / A.HKV;
    const int nqb = A.SQ / 256;
    const float sl2 = A.scale * 1.4426950408889634f;
    {
        int t = u; const int pass = t % NPASS; t /= NPASS; const int qb = t % nqb; t /= nqb; const int h = t % A.H; const int b = t / A.H;
        const int kv = h / G;
        const int q0 = qb * 256 + wave * 32;
        bf16x8 qf[DK / 16];
        { const bf16* qp = A.q + (size_t)(b * A.SQ + q0 + r) * A.q_stride + h * A.q_hstride + 8 * hh;
#pragma unroll
          for (int ks = 0; ks < DK / 16; ++ks) qf[ks] = *reinterpret_cast<const bf16x8*>(qp + 16 * ks); }
        f32x16 oacc[DVT / 32];
#pragma unroll
        for (int i = 0; i < DVT / 32; ++i)
#pragma unroll
            for (int j = 0; j < 16; ++j) oacc[i][j] = 0.f;
        float mrun = -INFINITY, lrun = 0.f;
        constexpr int NKC = (64 * (DK / 8) + 511) / 512, NVC = (DVT * 8 + 511) / 512;
        uint4 kr0, kr1, kr2, kr3, vr0, vr1;
        kr0 = kr1 = kr2 = kr3 = vr0 = vr1 = make_uint4(0u, 0u, 0u, 0u);
#define ATT_FK(kt_, i_, reg_) do { if ((i_) < NKC) { int c_ = tid + (i_) * 512; if (c_ >= 64 * (DK / 8)) c_ = 64 * (DK / 8) - 1; \
            const int key_ = c_ / (DK / 8), d8_ = (c_ % (DK / 8)) * 8; const size_t krow_ = (size_t)(b * A.SK + (kt_) * 64 + key_); \
            const bf16* kp_ = (d8_ < A.dk_main) ? (A.k + krow_ * A.k_stride + kv * A.k_hstride + d8_) : (A.k2 + krow_ * A.k2_stride + (d8_ - A.dk_main)); \
            reg_ = *reinterpret_cast<const uint4*>(kp_); } } while (0)
#define ATT_FV(kt_, i_, reg_) do { if ((i_) < NVC) { int c_ = tid + (i_) * 512; if (c_ >= DVT * 8) c_ = DVT * 8 - 1; \
            const int dv_ = c_ >> 3, k8_ = (c_ & 7) * 8; \
            reg_ = *reinterpret_cast<const uint4*>(A.vt + ((size_t)(b * A.HKV + kv) * DV + pass * DVT + dv_) * A.SK + (kt_) * 64 + k8_); } } while (0)
#define ATT_FETCH(kt_) do { ATT_FK(kt_, 0, kr0); ATT_FK(kt_, 1, kr1); ATT_FK(kt_, 2, kr2); ATT_FK(kt_, 3, kr3); ATT_FV(kt_, 0, vr0); ATT_FV(kt_, 1, vr1); } while (0)
#define ATT_SK(i_, reg_) do { if ((i_) < NKC) { const int c_ = tid + (i_) * 512; if (c_ < 64 * (DK / 8)) { \
            const int key_ = c_ / (DK / 8), d8_ = (c_ % (DK / 8)) * 8; *reinterpret_cast<uint4*>(Ks + key_ * KP + d8_) = reg_; } } } while (0)
#define ATT_SV(i_, reg_) do { if ((i_) < NVC) { const int c_ = tid + (i_) * 512; if (c_ < DVT * 8) { \
            const int dv_ = c_ >> 3, k8_ = (c_ & 7) * 8; *reinterpret_cast<uint4*>(Vs + dv_ * VP + k8_) = reg_; } } } while (0)
#define ATT_STORE() do { ATT_SK(0, kr0); ATT_SK(1, kr1); ATT_SK(2, kr2); ATT_SK(3, kr3); ATT_SV(0, vr0); ATT_SV(1, vr1); } while (0)
        constexpr bool PREF = DK <= 96;
        if (PREF) ATT_FETCH(0);
        for (int kt = 0; kt < A.SK / 64; ++kt) {
            __syncthreads();
            if (PREF) { ATT_STORE(); }
            else {
                for (int c = tid; c < 64 * (DK / 8); c += 512) {
                    const int key = c / (DK / 8), d8 = (c % (DK / 8)) * 8;
                    const size_t krow = (size_t)(b * A.SK + kt * 64 + key);
                    uint4 v;
                    if (d8 < A.dk_main) v = *reinterpret_cast<const uint4*>(A.k + krow * A.k_stride + kv * A.k_hstride + d8);
                    else v = *reinterpret_cast<const uint4*>(A.k2 + krow * A.k2_stride + (d8 - A.dk_main));
                    *reinterpret_cast<uint4*>(Ks + key * KP + d8) = v;
                }
                for (int c = tid; c < DVT * 8; c += 512) {
                    const int dv = c >> 3, k8 = (c & 7) * 8;
                    const uint4 v = *reinterpret_cast<const uint4*>(A.vt + ((size_t)(b * A.HKV + kv) * DV + pass * DVT + dv) * A.SK + kt * 64 + k8);
                    *reinterpret_cast<uint4*>(Vs + dv * VP + k8) = v;
                }
            }
            __syncthreads();
            if (PREF && kt + 1 < A.SK / 64) ATT_FETCH(kt + 1);
            f32x16 sacc[2];
#pragma unroll
            for (int kb = 0; kb < 2; ++kb) {
#pragma unroll
                for (int j = 0; j < 16; ++j) sacc[kb][j] = 0.f;
#pragma unroll
                for (int ks = 0; ks < DK / 16; ++ks) {
                    const bf16x8 kf = *reinterpret_cast<const bf16x8*>(Ks + (kb * 32 + r) * KP + 16 * ks + 8 * hh);
                    sacc[kb] = __builtin_amdgcn_mfma_f32_32x32x16_bf16(kf, qf[ks], sacc[kb], 0, 0, 0);
                }
            }
            float mx = -INFINITY;
#pragma unroll
            for (int kb = 0; kb < 2; ++kb)
#pragma unroll
                for (int j = 0; j < 16; ++j) mx = fmaxf(mx, sacc[kb][j]);
            mx = fmaxf(mx, shfl_xor(F, mx, 32));
            const float mnew = fmaxf(mrun, mx * sl2);
            const float alpha = exp2f(mrun - mnew);
            mrun = mnew;
            float psum = 0.f;
#pragma unroll
            for (int kb = 0; kb < 2; ++kb)
#pragma unroll
                for (int j = 0; j < 16; ++j) { const float p = exp2f(sacc[kb][j] * sl2 - mnew); sacc[kb][j] = p; psum += p; }
            lrun = lrun * alpha + psum;
#pragma unroll
            for (int i = 0; i < DVT / 32; ++i)
#pragma unroll
                for (int j = 0; j < 16; ++j) oacc[i][j] *= alpha;
#pragma unroll
            for (int kb = 0; kb < 2; ++kb)
#pragma unroll
                for (int s2 = 0; s2 < 2; ++s2) {
                    union { bf16x8 v; unsigned u[4]; } pf;
#pragma unroll
                    for (int j = 0; j < 4; ++j) pf.u[j] = pack_bf16(sacc[kb][8 * s2 + 2 * j], sacc[kb][8 * s2 + 2 * j + 1]);
#pragma unroll
                    for (int i = 0; i < DVT / 32; ++i) {
                        const bf16* vp = Vs + (i * 32 + r) * VP + kb * 32 + 16 * s2 + 4 * hh;
                        union { bf16x8 v; bf16x4 h2[2]; } vf;
                        vf.h2[0] = *reinterpret_cast<const bf16x4*>(vp);
                        vf.h2[1] = *reinterpret_cast<const bf16x4*>(vp + 8);
                        oacc[i] = __builtin_amdgcn_mfma_f32_32x32x16_bf16(vf.v, pf.v, oacc[i], 0, 0, 0);
                    }
                }
        }
        lrun += shfl_xor(F, lrun, 32);
        const float inv = 1.0f / lrun;
        bf16* op = A.o + (size_t)(b * A.SQ + q0 + r) * A.o_stride + h * A.o_hstride + pass * DVT;
#pragma unroll
        for (int i = 0; i < DVT / 32; ++i)
#pragma unroll
            for (int g = 0; g < 4; ++g)
                st_bf16x4(op + i * 32 + 8 * g + 4 * hh, oacc[i][4 * g] * inv, oacc[i][4 * g + 1] * inv, oacc[i][4 * g + 2] * inv, oacc[i][4 * g + 3] * inv);
    }
}
#endif

#undef ATT_FETCH
#undef ATT_STORE
#undef ATT_FK
#undef ATT_FV
#undef ATT_SK
#undef ATT_SV
#ifndef CPU_EMU
template <int DK, int DV, int DVT>
DI int attn_nunit(const AttnDesc& A) { return BATCH * A.H * (A.SQ / 256) * (DV / DVT); }
template <int DK, int DV, int DVT>
DI void attn_phase(const Frame& F, const AttnDesc& A) {
    const int nunit = attn_nunit<DK, DV, DVT>(A);
    for (int u = blockIdx.x; u < nunit; u += F.nblk) attn_unit<DK, DV, DVT>(F, A, u);
}
#endif
DI AttnDesc desc_gqa(const Frame& F) {
    AttnDesc A; A.q = WSP(bf16, OFF_HATT); A.q_stride = 512; A.q_hstride = 64;
    A.k = WSP(bf16, OFF_HATT) + 256; A.k_stride = 512; A.k_hstride = 64; A.k2 = nullptr; A.k2_stride = 0; A.dk_main = 64;
    A.vt = WSP(bf16, OFF_VTATT); A.o = WSP(bf16, OFF_YCAT); A.o_stride = 1024; A.o_hstride = 64;
    A.H = 4; A.HKV = 2; A.SQ = SEQ; A.SK = SEQ; A.scale = 0.125f; return A;
}
DI AttnDesc desc_mla(const Frame& F) {
    AttnDesc A; A.q = WSP(bf16, OFF_QMLA); A.q_stride = 384; A.q_hstride = 96;
    A.k = WSP(bf16, OFF_KNOPE); A.k_stride = 256; A.k_hstride = 64; A.k2 = WSP(bf16, OFF_KROPE); A.k2_stride = 32; A.dk_main = 64;
    A.vt = WSP(bf16, OFF_VTMLA); A.o = WSP(bf16, OFF_YCAT) + 768; A.o_stride = 1024; A.o_hstride = 64;
    A.H = 4; A.HKV = 4; A.SQ = SEQ; A.SK = SEQ; A.scale = 0.10206207261596575f; return A;
}
DI AttnDesc desc_mem(const Frame& F) {
    AttnDesc A; A.q = WSP(bf16, OFF_QMEM); A.q_stride = 1024; A.q_hstride = 256;
    A.k = WSP(bf16, OFF_KMEM); A.k_stride = 1024; A.k_hstride = 256; A.k2 = nullptr; A.k2_stride = 0; A.dk_main = 256;
    A.vt = WSP(bf16, OFF_VTMEM); A.o = WSP(bf16, OFF_OMEM); A.o_stride = 1024; A.o_hstride = 256;
    A.H = 4; A.HKV = 4; A.SQ = SEQ; A.SK = MEMT; A.scale = 0.0625f; return A;
}

#ifndef CPU_EMU
typedef float f32p __attribute__((ext_vector_type(2)));
DI f32p allsum16p(f32p x) { x.x = allsum16(x.x); x.y = allsum16(x.y); return x; }
template <int KIND>
DI void scan_chain(const Frame& F, int chain) {
    constexpr int T = 32;
    constexpr int NARR = KIND == 0 ? 6 : 3;
    constexpr int STEPB = NARR * 256;
    constexpr int NPIECE = T * NARR * 8;
    constexpr int PPT = (NPIECE + NTH - 1) / NTH;
    const int d = chain / (BATCH * 4), b = (chain / 4) % BATCH, h = chain % 4;
    const int tid = F.tid, wave = tid >> 6, lane = tid & 63, rg = lane >> 4, cg = lane & 15;
    unsigned char* buf0 = F.smem; unsigned char* buf1 = F.smem + T * STEPB;
    unsigned char* ybuf = F.smem + 2 * T * STEPB;
    const size_t AS = (size_t)NTOK * 256;
    bf16* r7 = WSP(bf16, OFF_R7); bf16* hh = WSP(bf16, OFF_HHGRN);
#define PIECE_PTR(t0, p_) ([&]() -> const uint4* { const int pc = (p_) < NPIECE ? (p_) : NPIECE - 1; \
        const int st = pc / (NARR * 8), rem = pc % (NARR * 8), arr = rem >> 3, part = rem & 7; \
        const int tt = (t0) + st, ss = d ? SEQ - 1 - tt : tt; const size_t nn = (size_t)b * SEQ + ss; \
        const bf16* base; \
        if (KIND == 0) { const int aid = arr == 0 ? R_KK : arr == 1 ? (d ? R_W1 : R_W0) : arr == 2 ? (d ? R_AK1 : R_AK0) : arr == 3 ? (d ? R_KD1 : R_KD0) : arr == 4 ? R_R : R_V; \
            base = r7 + aid * AS + nn * 256 + h * 64; } \
        else { const int off = arr == 0 ? 256 + d * 256 : arr == 1 ? 0 : 768; base = hh + nn * 1280 + off + h * 64; } \
        return reinterpret_cast<const uint4*>(base + part * 8); }())
#define PUT_PIECE(dst, p_, v_) do { float4 a_, b_; a_.x = bflo((v_).x); a_.y = bfhi((v_).x); a_.z = bflo((v_).y); a_.w = bfhi((v_).y); \
        b_.x = bflo((v_).z); b_.y = bfhi((v_).z); b_.z = bflo((v_).w); b_.w = bfhi((v_).w); \
        *reinterpret_cast<float4*>((dst) + (p_) * 32) = a_; *reinterpret_cast<float4*>((dst) + (p_) * 32 + 16) = b_; } while (0)
#define STORE_PRE(dst) do { PUT_PIECE(dst, tid, pre0); \
        if (tid + NTH < NPIECE) PUT_PIECE(dst, tid + NTH, pre1); \
        if (PPT > 2 && tid + 2 * NTH < NPIECE) PUT_PIECE(dst, tid + 2 * NTH, pre2); } while (0)
    uint4 pre0, pre1, pre2;
    pre0 = *PIECE_PTR(0, tid); pre1 = *PIECE_PTR(0, tid + NTH); pre2 = pre1;
    if (PPT > 2) pre2 = *PIECE_PTR(0, tid + 2 * NTH);
    __syncthreads();
    STORE_PRE(buf0);
    __syncthreads();
    f32p P[4];
#pragma unroll
    for (int c = 0; c < 4; ++c) P[c] = (f32p){0.f, 0.f};
    const int vofs = (wave * 8 + rg * 2) * 4;
    for (int ch = 0; ch < SEQ / T; ++ch) {
        const unsigned char* cur = (ch & 1) ? buf1 : buf0;
        if (ch + 1 < SEQ / T) {
            pre0 = *PIECE_PTR((ch + 1) * T, tid); pre1 = *PIECE_PTR((ch + 1) * T, tid + NTH);
            if (PPT > 2) pre2 = *PIECE_PTR((ch + 1) * T, tid + 2 * NTH);
        }
        float4 o0, o1, o2, o3, o4; f32p ov;
        { const unsigned char* sb = cur;
          o0 = *reinterpret_cast<const float4*>(sb + 0 * 256 + cg * 16); o1 = *reinterpret_cast<const float4*>(sb + 1 * 256 + cg * 16);
          if (KIND == 0) { o2 = *reinterpret_cast<const float4*>(sb + 2 * 256 + cg * 16); o3 = *reinterpret_cast<const float4*>(sb + 3 * 256 + cg * 16); o4 = *reinterpret_cast<const float4*>(sb + 4 * 256 + cg * 16); }
          ov = *reinterpret_cast<const f32p*>(sb + (NARR - 1) * 256 + vofs); }
        unsigned ykeep = 0u;
#pragma unroll 2
        for (int t = 0; t < T; ++t) {
            const float4 c0 = o0, c1 = o1, c2 = o2, c3 = o3, c4 = o4; const f32p v = ov;
            { const unsigned char* sb = cur + ((t + 1) & (T - 1)) * STEPB;
              o0 = *reinterpret_cast<const float4*>(sb + 0 * 256 + cg * 16); o1 = *reinterpret_cast<const float4*>(sb + 1 * 256 + cg * 16);
              if (KIND == 0) { o2 = *reinterpret_cast<const float4*>(sb + 2 * 256 + cg * 16); o3 = *reinterpret_cast<const float4*>(sb + 3 * 256 + cg * 16); o4 = *reinterpret_cast<const float4*>(sb + 4 * 256 + cg * 16); }
              ov = *reinterpret_cast<const f32p*>(sb + (NARR - 1) * 256 + vofs); }
            f32p y;
            if (KIND == 0) {
                f32p sa = P[0] * c0.x + P[1] * c0.y + P[2] * c0.z + P[3] * c0.w;
                sa = allsum16p(sa);
                P[0] = P[0] * c1.x - sa * c2.x + v * c3.x;
                P[1] = P[1] * c1.y - sa * c2.y + v * c3.y;
                P[2] = P[2] * c1.z - sa * c2.z + v * c3.z;
                P[3] = P[3] * c1.w - sa * c2.w + v * c3.w;
                y = P[0] * c4.x + P[1] * c4.y + P[2] * c4.z + P[3] * c4.w;
            } else {
                P[0] += (v - P[0]) * c0.x; P[1] += (v - P[1]) * c0.y; P[2] += (v - P[2]) * c0.z; P[3] += (v - P[3]) * c0.w;
                y = P[0] * c1.x + P[1] * c1.y + P[2] * c1.z + P[3] * c1.w;
            }
            y = allsum16p(y);
            const unsigned yp = pack_bf16(y.x, y.y);
            ykeep = ((t & 15) == cg) ? yp : ykeep;
            if ((t & 15) == 15) *reinterpret_cast<unsigned*>(ybuf + ((t & ~15) + cg) * 128 + (wave * 8 + rg * 2) * 2) = ykeep;
        }
        asm volatile("s_waitcnt lgkmcnt(0)" ::: "memory");
        __builtin_amdgcn_wave_barrier();
        if (lane < T) {
            const int t = ch * T + lane, s = d ? SEQ - 1 - t : t; const size_t n = (size_t)b * SEQ + s;
            const uint4 yv = *reinterpret_cast<const uint4*>(ybuf + lane * 128 + wave * 16);
            bf16* dst = KIND == 0 ? r7 + (d ? R_W1 : R_W0) * AS + n * 256 + h * 64 + wave * 8 : hh + n * 1280 + 256 + d * 256 + h * 64 + wave * 8;
            *reinterpret_cast<uint4*>(dst) = yv;
        }
        if (ch + 1 < SEQ / T) {
            unsigned char* nxt = (ch & 1) ? buf0 : buf1;
            STORE_PRE(nxt);
        }
        __syncthreads();
    }
#undef PIECE_PTR
#undef STORE_PRE
#undef PUT_PIECE
}
DI void phase_scans(const Frame& F) {
    const int nchain = 2 * BATCH * 4;
    for (int u = blockIdx.x; u < 2 * nchain; u += F.nblk) {
        if (u < nchain) scan_chain<0>(F, u); else scan_chain<1>(F, u - nchain);
    }
}
#else
DI void phase_scans(const Frame& F) {
    bf16* r7 = WSP(bf16, OFF_R7); const size_t AS = (size_t)NTOK * 256;
    bf16* hh = WSP(bf16, OFF_HHGRN);
    const int nitem = 2 * BATCH * 4 * 64 * 2;
    for (int it = wave_item_index(F); it < nitem; it += gthreads(F)) {
        const int kind = it / (2 * BATCH * 4 * 64);
        int c = (it % (2 * BATCH * 4 * 64)) / 64; const int i = it % 64;
        const int d = c / (BATCH * 4); c %= BATCH * 4; const int b = c / 4, h = c % 4;
        float S[64];
#pragma unroll
        for (int j = 0; j < 64; ++j) S[j] = 0.f;
        if (kind == 0) {
            const bf16* pr = r7 + R_R * AS, *pv = r7 + R_V * AS, *pkk = r7 + R_KK * AS;
            bf16* pw = r7 + (d ? R_W1 : R_W0) * AS; const bf16* pkd = r7 + (d ? R_KD1 : R_KD0) * AS, *pak = r7 + (d ? R_AK1 : R_AK0) * AS;
            for (int t = 0; t < SEQ; ++t) {
                const int s = d ? SEQ - 1 - t : t;
                const size_t o = ((size_t)(b * SEQ + s)) * 256 + h * 64;
                const float v = bf2f(pv[o + i]);
                float sa = 0.f;
#pragma unroll
                for (int j = 0; j < 64; ++j) sa += S[j] * bf2f(pkk[o + j]);
                float y = 0.f;
#pragma unroll
                for (int j = 0; j < 64; ++j) {
                    S[j] = S[j] * bf2f(pw[o + j]) - sa * bf2f(pak[o + j]) + v * bf2f(pkd[o + j]);
                    y += S[j] * bf2f(pr[o + j]);
                }
#ifndef CPU_EMU
                __builtin_amdgcn_wave_barrier();
#endif
#ifdef CPU_EMU
                WSP(bf16, OFF_EMU_SCAN)[(size_t)d * AS + (size_t)(b * SEQ + s) * 256 + h * 64 + i] = f2bf(y);
#else
                pw[o + i] = f2bf(y);
#endif
            }
        } else {
            const bf16* pq = hh; bf16* pk = hh + 256 + d * 256; const bf16* pi = hh + 768;
            for (int t = 0; t < SEQ; ++t) {
                const int s = d ? SEQ - 1 - t : t;
                const size_t o = ((size_t)(b * SEQ + s)) * 1280 + h * 64;
                const float v = bf2f(pi[o + i]);
                float acc = 0.f;
#pragma unroll
                for (int j = 0; j < 64; ++j) {
                    const float k = bf2f(pk[o + j]);
                    S[j] = S[j] + k * (v - S[j]);
                    acc += S[j] * bf2f(pq[o + j]);
                }
#ifndef CPU_EMU
                __builtin_amdgcn_wave_barrier();
#endif
#ifdef CPU_EMU
                WSP(bf16, OFF_EMU_SCAN)[(size_t)(2 + d) * AS + (size_t)(b * SEQ + s) * 256 + h * 64 + i] = f2bf(acc);
#else
                pk[o + i] = f2bf(acc);
#endif
            }
        }
    }
}

#endif

DI void phase_fin(const Frame& F, int l) {
    const bf16* r7 = WSP(bf16, OFF_R7); const size_t AS = (size_t)NTOK * 256;
    const bf16* gb = WSP(bf16, OFF_G); const float* bonus = WSP(float, OFF_BONUS);
    const bf16* hh = WSP(bf16, OFF_HHGRN); bf16* ycat = WSP(bf16, OFF_YCAT);
    const float* gng = F.in[17] + l * 256; const float* gnb = F.in[18] + l * 256; const float* hng = F.in[20] + l * 256;
    for (int it = ggrp(F); it < NTOK * 8; it += ngrp(F)) {
        const int n = it >> 3, kind = (it >> 2) & 1, h = it & 3;
        float v[PER64];
        if (kind == 0) {
            float s1 = 0.f;
            for (int i = 0; i < PER64; ++i) { const int c = h * 64 + glane(F) + i * GRP; const size_t o = (size_t)n * 256 + c;
#ifdef CPU_EMU
                v[i] = bf2f(WSP(bf16, OFF_EMU_SCAN)[o]) + bf2f(WSP(bf16, OFF_EMU_SCAN)[AS + o]); s1 += v[i]; }
#else
                v[i] = bf2f(r7[R_W0 * AS + o]) + bf2f(r7[R_W1 * AS + o]); s1 += v[i]; }
#endif
            s1 = grp_sum(F, s1); const float mu = s1 * (1.0f / 64.0f);
            float s2 = 0.f; for (int i = 0; i < PER64; ++i) { const float dd = v[i] - mu; s2 += dd * dd; }
            s2 = grp_sum(F, s2); const float rs = 1.0f / sqrtf(s2 * (1.0f / 64.0f) + GN_EPS);
            const float bo = bonus[(size_t)n * 4 + h];
            for (int i = 0; i < PER64; ++i) { const int c = h * 64 + glane(F) + i * GRP; const size_t o = (size_t)n * 256 + c;
                const float y = (v[i] - mu) * rs * gng[c] + gnb[c];
                ycat[(size_t)n * 1024 + 256 + c] = f2bf((y + bo * bf2f(r7[R_V * AS + o])) * bf2f(gb[o])); }
        } else {
            float s2 = 0.f;
            for (int i = 0; i < PER64; ++i) { const int c = h * 64 + glane(F) + i * GRP; const size_t o = (size_t)n * 1280 + c;
#ifdef CPU_EMU
                const size_t oe = (size_t)n * 256 + c;
                v[i] = bf2f(WSP(bf16, OFF_EMU_SCAN)[2 * AS + oe]) + bf2f(WSP(bf16, OFF_EMU_SCAN)[3 * AS + oe]); s2 += v[i] * v[i]; }
#else
                v[i] = bf2f(hh[o + 256]) + bf2f(hh[o + 512]); s2 += v[i] * v[i]; }
#endif
            s2 = grp_sum(F, s2); const float rs = 1.0f / sqrtf(s2 * (1.0f / 64.0f) + RMS_EPS);
            for (int i = 0; i < PER64; ++i) { const int c = h * 64 + glane(F) + i * GRP; const size_t o = (size_t)n * 1280 + c;
                ycat[(size_t)n * 1024 + 512 + c] = f2bf(v[i] * rs * hng[c] * siluf_(bf2f(hh[o + 1024]))); }
        }
    }
}

struct EpiResid {
    float* xf; int row0, pn;
    DI void operator()(int r, int c, float a, float b, float cc, float d) const {
        float* p = xf + (size_t)(row0 + r) * DM + pn * 256 + c;
#ifndef CPU_EMU
        float4 x = *reinterpret_cast<float4*>(p);
        x.x = DN_ALPHA * x.x + a; x.y = DN_ALPHA * x.y + b; x.z = DN_ALPHA * x.z + cc; x.w = DN_ALPHA * x.w + d;
        *reinterpret_cast<float4*>(p) = x;
#else
        p[0] = DN_ALPHA * p[0] + a; p[1] = DN_ALPHA * p[1] + b; p[2] = DN_ALPHA * p[2] + cc; p[3] = DN_ALPHA * p[3] + d;
#endif
    }
};
struct EpiBf {
    bf16* o; int ld; int row0, pn;
    DI void operator()(int r, int c, float a, float b, float cc, float d) const { st_bf16x4(o + (size_t)(row0 + r) * ld + pn * 256 + c, a, b, cc, d); }
};
template <int MODE>
DI void phase_gemm_sq(const Frame& F, const bf16* A, size_t woff, bf16* outb) {
    const bf16* W = (const bf16*)((const char*)WSP(bf16, OFF_WTS) + woff);
    const int nM = (NTOK + 255) / 256;
    for (int u = blockIdx.x; u < nM * 4; u += F.nblk) {
        const int pm = u >> 2, pn = u & 3;
#ifdef CPU_EMU
        const int mr = min(256, NTOK - pm * 256);
#endif
        if (MODE == 0) { EpiResid E{F.xf, pm * 256, pn}; gemm_unit(F, A, 1024, nullptr, pm * 256, W, 1024, pn * 256, 1024, E MR); }
        else { EpiBf E{outb, 1024, pm * 256, pn}; gemm_unit(F, A, 1024, nullptr, pm * 256, W, 1024, pn * 256, 1024, E MR); }
    }
}

DI void phase_ln(const Frame& F, const float* g, const float* b) {
    const float* xf = F.xf;
    layer_norm_rows(F, g, b, [&](int row, int c) { return xf[(size_t)row * DM + c]; }, false, nullptr);
}

#ifndef CPU_EMU
DI void phase_route_gpu(const Frame& F, int l) {
    const float* xf = F.xf; const float* gt = (const float*)((const char*)WSP(bf16, OFF_WTS) + W_GATE_T) + (size_t)l * 48 * 1024;
    const float* bg = F.in[34] + l * 4; const float* be = F.in[36] + l * 32;
    int* counts = (int*)(F.ws + CTL_CNT) + l * 32;
    int* lists = WSP(int, OFF_LISTS); float* tinfo = WSP(float, OFF_TINFO);
    const int tid = F.tid, wave = tid >> 6, lane = tid & 63, rr = lane & 15, kq = lane >> 4;
    float* lg = (float*)F.smem + wave * (16 * 48);
    __syncthreads();
    for (int rt = blockIdx.x * 8 + wave; rt < NTOK / 16; rt += F.nblk * 8) {
        const int r0 = rt * 16;
        f32x4 acc0 = {0.f, 0.f, 0.f, 0.f}, acc1 = acc0, acc2 = acc0;
        const float* xa = xf + (size_t)(r0 + rr) * DM + 4 * kq;
        const float* wb = gt + (size_t)rr * 1024 + 4 * kq;
#pragma unroll 2
        for (int k0 = 0; k0 < 1024; k0 += 16) {
            const float4 a = *reinterpret_cast<const float4*>(xa + k0);
            const float4 b0 = *reinterpret_cast<const float4*>(wb + k0), b1 = *reinterpret_cast<const float4*>(wb + 16 * 1024 + k0), b2 = *reinterpret_cast<const float4*>(wb + 32 * 1024 + k0);
            acc0 = __builtin_amdgcn_mfma_f32_16x16x4f32(a.x, b0.x, acc0, 0, 0, 0); acc1 = __builtin_amdgcn_mfma_f32_16x16x4f32(a.x, b1.x, acc1, 0, 0, 0); acc2 = __builtin_amdgcn_mfma_f32_16x16x4f32(a.x, b2.x, acc2, 0, 0, 0);
            acc0 = __builtin_amdgcn_mfma_f32_16x16x4f32(a.y, b0.y, acc0, 0, 0, 0); acc1 = __builtin_amdgcn_mfma_f32_16x16x4f32(a.y, b1.y, acc1, 0, 0, 0); acc2 = __builtin_amdgcn_mfma_f32_16x16x4f32(a.y, b2.y, acc2, 0, 0, 0);
            acc0 = __builtin_amdgcn_mfma_f32_16x16x4f32(a.z, b0.z, acc0, 0, 0, 0); acc1 = __builtin_amdgcn_mfma_f32_16x16x4f32(a.z, b1.z, acc1, 0, 0, 0); acc2 = __builtin_amdgcn_mfma_f32_16x16x4f32(a.z, b2.z, acc2, 0, 0, 0);
            acc0 = __builtin_amdgcn_mfma_f32_16x16x4f32(a.w, b0.w, acc0, 0, 0, 0); acc1 = __builtin_amdgcn_mfma_f32_16x16x4f32(a.w, b1.w, acc1, 0, 0, 0); acc2 = __builtin_amdgcn_mfma_f32_16x16x4f32(a.w, b2.w, acc2, 0, 0, 0);
        }
#pragma unroll
        for (int r = 0; r < 4; ++r) { lg[(4 * kq + r) * 48 + rr] = acc0[r]; lg[(4 * kq + r) * 48 + 16 + rr] = acc1[r]; lg[(4 * kq + r) * 48 + 32 + rr] = acc2[r]; }
        asm volatile("s_waitcnt lgkmcnt(0)" ::: "memory");
        __builtin_amdgcn_wave_barrier();
        if (lane < 16) {
            const int row = r0 + lane; const float* L = lg + lane * 48;
            float gl[4];
#pragma unroll
            for (int q = 0; q < 4; ++q) gl[q] = L[q] + bg[q];
            int gi = 0; float gm = gl[0];
#pragma unroll
            for (int q = 1; q < 4; ++q) if (gl[q] > gm) { gm = gl[q]; gi = q; }
            float den = 0.f;
#pragma unroll
            for (int q = 0; q < 4; ++q) den += expf(gl[q] - gm);
            const float pgroup = 1.0f / den;
            float el[8];
#pragma unroll
            for (int q = 0; q < 8; ++q) el[q] = L[4 + gi * 8 + q] + be[gi * 8 + q];
            int i0 = 0; float v0 = el[0];
#pragma unroll
            for (int q = 1; q < 8; ++q) if (el[q] > v0) { v0 = el[q]; i0 = q; }
            int i1 = -1; float v1 = -INFINITY;
#pragma unroll
            for (int q = 0; q < 8; ++q) if (q != i0 && el[q] > v1) { v1 = el[q]; i1 = q; }
            const float e1 = expf(v1 - v0); const float g0 = pgroup / (1.0f + e1), g1 = pgroup * e1 / (1.0f + e1);
            const int ea = gi * 8 + i0, eb = gi * 8 + i1;
            const int pa = atomicAdd(&counts[ea], 1), pb = atomicAdd(&counts[eb], 1);
            lists[(size_t)ea * NTOK + pa] = row; lists[(size_t)eb * NTOK + pb] = row;
            int* ti = (int*)(tinfo + (size_t)row * 8);
            ti[0] = ea; ti[1] = pa; ti[2] = eb; ti[3] = pb; tinfo[(size_t)row * 8 + 4] = g0; tinfo[(size_t)row * 8 + 5] = g1;
        }
        __builtin_amdgcn_wave_barrier();
    }
}
#endif
DI void phase_route(const Frame& F, int l) {
    const float* xf = F.xf;
    const float* wg = F.in[33] + (size_t)l * 1024 * 4; const float* bg = F.in[34] + l * 4;
    const float* we = F.in[35] + (size_t)l * 1024 * 32; const float* be = F.in[36] + l * 32;
    int* counts = (int*)(F.ws + CTL_CNT) + l * 32;
    int* lists = WSP(int, OFF_LISTS); float* tinfo = WSP(float, OFF_TINFO);
    for (int row = ggrp(F); row < NTOK; row += ngrp(F)) {
        float gl[4] = {0.f, 0.f, 0.f, 0.f};
        for (int i = 0; i < PERLN; ++i) { const int c = glane(F) + i * GRP; const float x = xf[(size_t)row * DM + c];
#pragma unroll
            for (int q = 0; q < 4; ++q) gl[q] += x * wg[c * 4 + q]; }
#pragma unroll
        for (int q = 0; q < 4; ++q) gl[q] = grp_sum(F, gl[q]) + bg[q];
        int gi = 0; float gm = gl[0];
#pragma unroll
        for (int q = 1; q < 4; ++q) if (gl[q] > gm) { gm = gl[q]; gi = q; }
        float den = 0.f;
#pragma unroll
        for (int q = 0; q < 4; ++q) den += expf(gl[q] - gm);
        const float pgroup = 1.0f / den;
        float el[8] = {0.f, 0.f, 0.f, 0.f, 0.f, 0.f, 0.f, 0.f};
        for (int i = 0; i < PERLN; ++i) { const int c = glane(F) + i * GRP; const float x = xf[(size_t)row * DM + c];
#pragma unroll
            for (int q = 0; q < 8; ++q) el[q] += x * we[c * 32 + gi * 8 + q]; }
#pragma unroll
        for (int q = 0; q < 8; ++q) el[q] = grp_sum(F, el[q]) + be[gi * 8 + q];
        int i0 = 0; float v0 = el[0];
#pragma unroll
        for (int q = 1; q < 8; ++q) if (el[q] > v0) { v0 = el[q]; i0 = q; }
        int i1 = -1; float v1 = -INFINITY;
#pragma unroll
        for (int q = 0; q < 8; ++q) if (q != i0 && el[q] > v1) { v1 = el[q]; i1 = q; }
        const float e1 = expf(v1 - v0); const float g0 = pgroup / (1.0f + e1), g1 = pgroup * e1 / (1.0f + e1);
        if (glane(F) == 0) {
            const int ea = gi * 8 + i0, eb = gi * 8 + i1;
            const int pa = atomicAdd(&counts[ea], 1), pb = atomicAdd(&counts[eb], 1);
            lists[(size_t)ea * NTOK + pa] = row; lists[(size_t)eb * NTOK + pb] = row;
            int* ti = (int*)(tinfo + (size_t)row * 8);
            ti[0] = ea; ti[1] = pa; ti[2] = eb; ti[3] = pb; tinfo[(size_t)row * 8 + 4] = g0; tinfo[(size_t)row * 8 + 5] = g1;
        }
    }
}

struct EpiMoeUp {
    bf16* hm; int row0, pn;
    DI void operator()(int r, int c, float a, float b, float cc, float d) const {
        bf16* p = hm + (size_t)(row0 + r) * 256 + ((pn * 256 + c) >> 1);
        p[0] = f2bf(siluf_(a) * b); p[1] = f2bf(siluf_(cc) * d);
    }
};
DI int ld_cnt(const int* p) {
#ifdef CPU_EMU
    return *p;
#else
    return __hip_atomic_load(p, __ATOMIC_RELAXED, __HIP_MEMORY_SCOPE_AGENT);
#endif
}
DI void moe_tiles(const int* counts, int* toff  ) {
    __syncthreads();
    if (threadIdx.x == 0) { int acc = 0; for (int e = 0; e < NEXP; ++e) { toff[e] = acc; acc += (ld_cnt(counts + e) + 255) >> 8; } toff[NEXP] = acc; }
    __syncthreads();
}
DI void phase_moe_up(const Frame& F, int l) {
    const int* counts = (const int*)(F.ws + CTL_CNT) + l * 32;
    int* eoff = (int*)(F.ws + CTL_EOFF) + l * 33;
    int* rowmap = (int*)(F.smem + 131072);
    int* toff = rowmap + 256;
    moe_tiles(counts, toff);
    if (blockIdx.x == 0 && threadIdx.x == 0) for (int e = 0; e <= NEXP; ++e) eoff[e] = toff[e] * 256;
    const int* lists = WSP(int, OFF_LISTS); const bf16* xb = WSP(bf16, OFF_XB);
    const int nunit = toff[NEXP] * 2;
    for (int u = blockIdx.x; u < nunit; u += F.nblk) {
        const int tile = u >> 1, pn = u & 1;
        int e = 0; while (toff[e + 1] <= tile) ++e;
        const int t0 = (tile - toff[e]) * 256, cnt = ld_cnt(counts + e);
        __syncthreads();
        for (int i = fresh_tid(F); i < 256; i += NTH) rowmap[i] = (t0 + i < cnt) ? lists[(size_t)e * NTOK + t0 + i] : 0;
        __syncthreads();
        EpiMoeUp E{WSP(bf16, OFF_HM), tile * 256, pn};
        gemm_unit(F, xb, 1024, rowmap, 0, WSP(bf16, OFF_W13T) + (size_t)e * 512 * 1024, 1024, pn * 256, 1024, E);
    }
}
DI void phase_moe_down(const Frame& F, int l) {
    const int* counts = (const int*)(F.ws + CTL_CNT) + l * 32;
    int* toff = (int*)(F.smem + 131072) + 256;
    moe_tiles(counts, toff);
    const int nunit = toff[NEXP] * 4;
    for (int u = blockIdx.x; u < nunit; u += F.nblk) {
        const int tile = u >> 2, pn = u & 3;
        int e = 0; while (toff[e + 1] <= tile) ++e;
        EpiBf E{WSP(bf16, OFF_YROWS), 1024, tile * 256, pn};
        gemm_unit(F, WSP(bf16, OFF_HM), 256, nullptr, tile * 256, WSP(bf16, OFF_W2T) + (size_t)e * 1024 * 256, 256, pn * 256, 256, E);
    }
}
DI void phase_ln3(const Frame& F, int l) {
    const float* xf = F.xf; const bf16* yr = WSP(bf16, OFF_YROWS); const float* tinfo = WSP(float, OFF_TINFO);
    const int* eoff = (const int*)(F.ws + CTL_EOFF) + l * 33;
    layer_norm_rows(F, F.in[40] + l * 1024, F.in[41] + l * 1024, [&](int row, int c) {
        const int* ti = (const int*)(tinfo + (size_t)row * 8);
        const size_t ra = (size_t)eoff[ti[0]] + ti[1], rb = (size_t)eoff[ti[2]] + ti[3];
        return DN_ALPHA * xf[(size_t)row * DM + c] + tinfo[(size_t)row * 8 + 4] * bf2f(yr[ra * 1024 + c]) + tinfo[(size_t)row * 8 + 5] * bf2f(yr[rb * 1024 + c]);
    }, false, nullptr);
}

#ifndef CPU_EMU
#define XB_TMO      128
#define XB_XCNT(j)  (256  + 64 * (j))
#define XB_XSUB(j)  (1280 + 64 * (j))
#define XB_XGEN(j)  (2304 + 64 * (j))
#define XB_TOP      3328
#define XB_TOPGEN   3392
#define XCD_BAR_WORDS 3456
#define XB_SPIN_CAP (1u << 18)
#define LAS __attribute__((address_space(3)))

__device__ __forceinline__ unsigned xb_ld(unsigned* p)              { return __hip_atomic_load(p, __ATOMIC_RELAXED, __HIP_MEMORY_SCOPE_AGENT); }
__device__ __forceinline__ unsigned xb_add(unsigned* p, unsigned v) { return __hip_atomic_fetch_add(p, v, __ATOMIC_RELAXED, __HIP_MEMORY_SCOPE_AGENT); }
__device__ __forceinline__ unsigned xb_xcc_id() { return (unsigned)__builtin_amdgcn_s_getreg((3 << 11) | 20) & 0xFu; }
#define XB_SPIN(cond, bar) do { unsigned _sp = 0; while (cond) { __builtin_amdgcn_s_sleep(1); \
    if ((++_sp & 255u) == 0u) { if (xb_ld(&(bar)[XB_TMO])) break; if (_sp > XB_SPIN_CAP) { atomicAdd(&(bar)[XB_TMO], 1u); break; } } } } while (0)

struct XcdBarrier {
    unsigned* bar; unsigned x;
    volatile LAS unsigned* st;
};

__device__ __forceinline__ XcdBarrier xcd_barrier_post(unsigned* bar, volatile LAS unsigned* st) {
    XcdBarrier b; b.bar = bar; b.x = xb_xcc_id(); b.st = st;
    if (threadIdx.x == 0) (void)xb_add(&bar[XB_XCNT(b.x)], 1u);
    return b;
}
__device__ __forceinline__ void xcd_barrier_complete(unsigned* bar, unsigned x, unsigned& nloc, unsigned& nx) {
    const unsigned G = gridDim.x * gridDim.y * gridDim.z;
    unsigned sum, cnt, mine, sp = 0u;
    for (;;) {
        sum = 0u; cnt = 0u; mine = 0u;
#pragma unroll
        for (unsigned j = 0; j < 16; ++j) { const unsigned c = xb_ld(&bar[XB_XCNT(j)]); sum += c; cnt += (c > 0u) ? 1u : 0u; mine = (j == x) ? c : mine; }
        if (sum == G) break;
        __builtin_amdgcn_s_sleep(1);
        if ((++sp & 255u) == 0u) { if (xb_ld(&bar[XB_TMO])) break; if (sp > XB_SPIN_CAP) { atomicAdd(&bar[XB_TMO], 1u); break; } }
    }
    nloc = mine > 0u ? mine : 1u; nx = cnt > 0u ? cnt : 1u;
}

__device__ __forceinline__ void xcd_barrier(const XcdBarrier& b) {
    asm volatile("s_waitcnt vmcnt(0)" ::: "memory");
    __syncthreads();
    if (threadIdx.x == 0) {
        unsigned* bar = b.bar;
        __builtin_amdgcn_s_waitcnt(0);
        unsigned nloc = b.st[0], nx = b.st[1];
        if (nloc == 0u) { xcd_barrier_complete(bar, b.x, nloc, nx); b.st[0] = nloc; b.st[1] = nx; }
        const unsigned old = xb_add(&bar[XB_XSUB(b.x)], 1u);
        const unsigned gen = old / nloc;
        if (old + 1u == (gen + 1u) * nloc) {
            __builtin_amdgcn_fence(__ATOMIC_RELEASE, "agent");
            asm volatile("s_waitcnt vmcnt(0)" ::: "memory");
            const unsigned og = xb_add(&bar[XB_TOP], 1u);
            const unsigned tg = og / nx;
            if (og + 1u == (tg + 1u) * nx) xb_add(&bar[XB_TOPGEN], 1u);
            else XB_SPIN(xb_ld(&bar[XB_TOPGEN]) == tg, bar);
            __builtin_amdgcn_fence(__ATOMIC_ACQUIRE, "agent");
            xb_add(&bar[XB_XGEN(b.x)], 1u);
            asm volatile("s_waitcnt vmcnt(0)" ::: "memory");
        } else {
            XB_SPIN(xb_ld(&bar[XB_XGEN(b.x)]) == gen, bar);
            __builtin_amdgcn_fence(__ATOMIC_ACQUIRE, "agent");
            asm volatile("s_waitcnt vmcnt(0)" ::: "memory");
        }
    }
    __syncthreads();
}

#endif

constexpr int NPH_LAYER = 16;
constexpr int NPH_TOTAL = 1 + 2 * NPH_LAYER;
constexpr int SMEM_BYTES = 131072 + 2048;

template <int K>
DI void run_layer_phase(const Frame& F, int l) {
    if constexpr (K == 0) phase_cvt(F, l);
    if constexpr (K == 1) phase_gemm1(F);
    if constexpr (K == 2) phase_prep(F, l);
    if constexpr (K == 3) phase_mlaup(F);
    if constexpr (K == 4) {
#ifdef CPU_EMU
        attn_phase<64, 64>(F, desc_gqa(F)); attn_phase<96, 64>(F, desc_mla(F)); phase_scans(F);
#else
        phase_scans(F);
        {
            const AttnDesc Ag = desc_gqa(F), Am = desc_mla(F);
            const int ng = attn_nunit<64, 64, 64>(Ag), nm = attn_nunit<96, 64, 64>(Am);
            unsigned* qctr = (unsigned*)(F.ws + CTL_QUEUE) + l * 64;
            volatile int* slot = (volatile int*)(F.smem + SMEM_BYTES - 32);
            for (;;) {
                __syncthreads();
                if (F.tid == 0) *slot = (int)atomicAdd(qctr, 1u);
                __syncthreads();
                const int u = *slot;
                if (u >= ng + nm) break;
                if (u < ng) attn_unit<64, 64, 64>(F, Ag, u); else attn_unit<96, 64, 64>(F, Am, u - ng);
            }
        }
#endif
    }
    if constexpr (K == 5) phase_fin(F, l);
    if constexpr (K == 6) phase_gemm_sq<0>(F, WSP(bf16, OFF_YCAT), W_OUT_T, nullptr);
    if constexpr (K == 7) phase_ln(F, F.in[26] + l * 1024, F.in[27] + l * 1024);
    if constexpr (K == 8) phase_gemm_sq<1>(F, WSP(bf16, OFF_XB), W_Q_T, WSP(bf16, OFF_QMEM));
    if constexpr (K == 9) {
#ifdef CPU_EMU
        attn_phase<256, 256>(F, desc_mem(F));
#else
        attn_phase<256, 256, 128>(F, desc_mem(F));
#endif
    }
    if constexpr (K == 10) phase_gemm_sq<0>(F, WSP(bf16, OFF_OMEM), W_O_T, nullptr);
    if constexpr (K == 11) { phase_ln(F, F.in[31] + l * 1024, F.in[32] + l * 1024); phase_cvt_moe(F, l); }
#ifdef CPU_EMU
    if constexpr (K == 12) phase_route(F, l);
#else
    if constexpr (K == 12) phase_route_gpu(F, l);
#endif
    if constexpr (K == 13) phase_moe_up(F, l);
    if constexpr (K == 14) phase_moe_down(F, l);
    if constexpr (K == 15) phase_ln3(F, l);
}

#ifndef CPU_EMU
template <int K>
__global__ void __launch_bounds__(512, 2) k_phase(Args a, int l) {
    extern __shared__ __attribute__((aligned(16))) unsigned char lds[];
    Frame F; F.in = (InPtr)__builtin_amdgcn_kernarg_segment_ptr(); F.xf = a.out; F.ws = a.ws; F.smem = lds; F.tid = threadIdx.x; F.wv = __builtin_amdgcn_readfirstlane((int)(threadIdx.x >> 6)); F.nblk = a.ph_lo;
    if constexpr (K < 0) phase_pro(F); else run_layer_phase<K>(F, l);
}

template <int K>
static void launch_phase(const Args& a, int l, int grid, hipStream_t stream) {
    static bool attr = false;
    if (!attr) { (void)hipFuncSetAttribute((const void*)k_phase<K>, hipFuncAttributeMaxDynamicSharedMemorySize, SMEM_BYTES); attr = true; }
    hipLaunchKernelGGL(k_phase<K>, dim3(grid), dim3(512), SMEM_BYTES, stream, a, l);
}

__global__ void __launch_bounds__(512, 2) fwd_one(Args a) {
    extern __shared__ __attribute__((aligned(16))) unsigned char lds[];
    const int wave_s = __builtin_amdgcn_readfirstlane((int)(threadIdx.x >> 6));
    volatile LAS unsigned* st = (volatile LAS unsigned*)(lds + SMEM_BYTES - 16);
    if (threadIdx.x == 0) { st[0] = 0u; st[1] = 0u; st[2] = 0u; st[3] = 0u; }
    __syncthreads();
    XcdBarrier bar = xcd_barrier_post((unsigned*)(a.ws + OFF_CTL), st);
    Frame F;
#define FRESH do { unsigned z_ = 0u, m_ = ~0u; int ws_ = wave_s; asm volatile("" : "+s"(z_), "+s"(ws_), "+s"(m_)); \
        int t_ = ws_ * 64 + (int)__builtin_amdgcn_mbcnt_hi(m_, __builtin_amdgcn_mbcnt_lo(m_, 0u)); asm volatile("" : "+v"(t_)); \
        const __attribute__((address_space(4))) char* kp_ = (const __attribute__((address_space(4))) char*)__builtin_amdgcn_kernarg_segment_ptr() + z_; \
        F.in = (InPtr)kp_; F.xf = *(float* const __attribute__((address_space(4)))*)(kp_ + 42 * 8); F.ws = *(unsigned char* const __attribute__((address_space(4)))*)(kp_ + 43 * 8); \
        F.smem = lds; F.tid = t_; F.wv = ws_; F.nblk = *(const int __attribute__((address_space(4)))*)(kp_ + 44 * 8); } while (0)
#define GB do { { unsigned zb_ = 0u; unsigned xx_ = __builtin_amdgcn_readfirstlane(bar.x); asm volatile("" : "+s"(zb_), "+s"(xx_)); bar.bar = (unsigned*)(a.ws + OFF_CTL) + zb_; bar.x = xx_; } \
        xcd_barrier(bar); } while (0)
#define DUP(k) ((PROBE_DUP >> (k)) & 1)
    FRESH; phase_pro(F); FRESH; phase_cvt(F, 0); GB;
    if (DUP(0)) { FRESH; phase_cvt(F, 0); GB; }
    for (int l = 0; l < 2; ++l) {
        FRESH; run_layer_phase<1>(F, l); GB;
        if (DUP(1)) { FRESH; run_layer_phase<1>(F, l); GB; }
        FRESH; run_layer_phase<2>(F, l); GB;
        FRESH; run_layer_phase<3>(F, l); GB;
        if (DUP(3)) { FRESH; run_layer_phase<3>(F, l); GB; }
        if (DUP(4)) { FRESH; attn_phase<64, 64, 64>(F, desc_gqa(F)); attn_phase<96, 64, 64>(F, desc_mla(F)); GB; }
        FRESH; run_layer_phase<4>(F, l); GB;
        FRESH; run_layer_phase<5>(F, l); GB;
        if (DUP(5)) { FRESH; run_layer_phase<5>(F, l); GB; }
        FRESH; run_layer_phase<6>(F, l); GB;
        FRESH; run_layer_phase<7>(F, l); GB;
        FRESH; run_layer_phase<8>(F, l); GB;
        if (DUP(8)) { FRESH; run_layer_phase<8>(F, l); GB; }
        FRESH; run_layer_phase<9>(F, l); GB;
        if (DUP(9)) { FRESH; run_layer_phase<9>(F, l); GB; }
        FRESH; run_layer_phase<10>(F, l); GB;
        FRESH; run_layer_phase<11>(F, l); FRESH; run_layer_phase<12>(F, l); if (l == 0) { FRESH; phase_cvt(F, 1); } GB;
        if (DUP(11)) { FRESH; phase_cvt_moe(F, l); GB; }
        FRESH; run_layer_phase<13>(F, l); GB;
        if (DUP(13)) { FRESH; run_layer_phase<13>(F, l); GB; }
        FRESH; run_layer_phase<14>(F, l); GB;
        if (DUP(14)) { FRESH; run_layer_phase<14>(F, l); GB; }
        FRESH; run_layer_phase<15>(F, l); if (l == 0) GB;
    }
#undef DUP
#undef GB
#undef FRESH
}

extern "C" void kernel_launch(void* const* d_in, const int* in_sizes, int n_in, void* d_out, int out_size, void* d_ws, size_t ws_size, hipStream_t stream) {
    if (n_in != 42 || ws_size < WS_END) return;
    Args a{};
    for (int i = 0; i < 42; ++i) a.in[i] = (const float*)d_in[i];
    a.out = (float*)d_out; a.ws = (unsigned char*)d_ws; a.ph_lo = 0; a.ph_hi = NPH_TOTAL;
    (void)hipMemsetAsync(d_ws, 0, CTL_BYTES, stream);
#if N_LAUNCH_MODE == 1
    static int grid = 0;
    if (!grid) {
        int dev = 0, cus = 0, per_cu = 0;
        (void)hipGetDevice(&dev);
        (void)hipDeviceGetAttribute(&cus, hipDeviceAttributeMultiprocessorCount, dev);
        (void)hipFuncSetAttribute((const void*)fwd_one, hipFuncAttributeMaxDynamicSharedMemorySize, SMEM_BYTES);
        (void)hipOccupancyMaxActiveBlocksPerMultiprocessor(&per_cu, (const void*)fwd_one, 512, SMEM_BYTES);
        (void)hipGetLastError();
        grid = cus > 0 ? cus : 256;
    }
    a.ph_lo = grid;
    hipLaunchKernelGGL(fwd_one, dim3(grid), dim3(512), SMEM_BYTES, stream, a);
#else
    const int grid = 256; a.ph_lo = grid;
    launch_phase<-1>(a, 0, grid, stream);
    for (int l = 0; l < 2; ++l) {
        launch_phase<0>(a, l, grid, stream); launch_phase<1>(a, l, grid, stream); launch_phase<2>(a, l, grid, stream); launch_phase<3>(a, l, grid, stream);
        launch_phase<4>(a, l, grid, stream); launch_phase<5>(a, l, grid, stream); launch_phase<6>(a, l, grid, stream); launch_phase<7>(a, l, grid, stream);
        launch_phase<8>(a, l, grid, stream); launch_phase<9>(a, l, grid, stream); launch_phase<10>(a, l, grid, stream); launch_phase<11>(a, l, grid, stream);
        launch_phase<12>(a, l, grid, stream); launch_phase<13>(a, l, grid, stream); launch_phase<14>(a, l, grid, stream); launch_phase<15>(a, l, grid, stream);
    }
#endif
}
#endif
```

```cpp
#ifndef CPU_EMU
#include <hip/hip_runtime.h>
#else
#include "emu_shim.h"
#endif
#include <stdint.h>

#ifndef CFG_B
#define CFG_B 16
#endif
#ifndef CFG_S
#define CFG_S 2048
#endif
#ifndef PROBE_DUP
#define PROBE_DUP 0
#endif
#ifndef N_LAUNCH_MODE
#define N_LAUNCH_MODE 1
#endif

typedef unsigned short bf16;
#define DI __device__ __forceinline__

constexpr int BATCH = CFG_B, SEQ = CFG_S, NTOK = BATCH * SEQ, DM = 1024;
constexpr int MEMT = 256, NMEM = BATCH * MEMT;
constexpr int GRIDW = 64;
constexpr int HP = 3328;
constexpr int IN_WIDTH = 3104;
constexpr int NEXP = 32, MOEH = 256;
constexpr int MOE_ROWS = 2 * NTOK + NEXP * 256;
constexpr float LN_EPS = 1e-5f, RMS_EPS = 1e-6f, GN_EPS = 64e-5f;
constexpr float DN_ALPHA = 1.41421356237309515f;
constexpr float DECAY_SCALE = 0.60653065971263342f;

constexpr size_t AL(size_t x) { return (x + 255) & ~(size_t)255; }
constexpr size_t OFF_CTL = 0;
constexpr size_t CTL_BYTES = 32768;
constexpr size_t CTL_CNT = 16384;
constexpr size_t CTL_EOFF = 16384 + 1024;
constexpr size_t CTL_QUEUE = 16384 + 2048;
constexpr size_t OFF_XB = AL(OFF_CTL + CTL_BYTES);
constexpr size_t SZ_XB = (size_t)NTOK * DM * 2;
constexpr size_t OFF_WTS = AL(OFF_XB + SZ_XB);
constexpr size_t W_IN_T = 0;
constexpr size_t W_UQ_T = W_IN_T + (size_t)HP * 1024 * 2;
constexpr size_t W_UKV_T = W_UQ_T + 512 * 256 * 2;
constexpr size_t W_OUT_T = W_UKV_T + 512 * 256 * 2;
constexpr size_t W_Q_T = W_OUT_T + 1024 * 1024 * 2;
constexpr size_t W_KV_T = W_Q_T + 1024 * 1024 * 2;
constexpr size_t W_O_T = W_KV_T + 2048 * 1024 * 2;
constexpr size_t W_GATE_T = W_O_T + 1024 * 1024 * 2;
constexpr size_t SZ_WTS = W_GATE_T + 2 * 48 * 1024 * 4;
constexpr size_t OFF_KMEM = AL(OFF_WTS + SZ_WTS);
constexpr size_t OFF_VTMEM = AL(OFF_KMEM + (size_t)NMEM * 1024 * 2);
constexpr size_t OFF_MEMB = AL(OFF_VTMEM + (size_t)NMEM * 1024 * 2);
constexpr size_t OFF_VTATT = AL(OFF_MEMB + (size_t)NMEM * 1024 * 2);
constexpr size_t OFF_VTMLA = AL(OFF_VTATT + (size_t)BATCH * 2 * 64 * SEQ * 2);
constexpr size_t OFF_HATT = AL(OFF_VTMLA + (size_t)BATCH * 4 * 64 * SEQ * 2);
constexpr size_t OFF_HMLA = OFF_HATT + (size_t)NTOK * 512 * 2;
constexpr size_t OFF_HRWKV = OFF_HMLA + (size_t)NTOK * 512 * 2;
constexpr size_t OFF_R7 = OFF_HRWKV + (size_t)NTOK * 1024 * 2;
constexpr size_t SZ_R7 = (size_t)NTOK * 9 * 256 * 2;
constexpr size_t OFF_HHGRN = OFF_R7 + SZ_R7;
constexpr size_t OFF_HX = OFF_HHGRN + (size_t)NTOK * 1280 * 2;
constexpr size_t OFF_HAM = OFF_HX + (size_t)NTOK * 256 * 2;
constexpr size_t OFF_HEG = OFF_HAM + (size_t)(NTOK / 16) * 8 * 256 * 2;
constexpr size_t WS_END = OFF_HEG + (size_t)(NTOK / 16) * 8 * 64 * 4;

constexpr size_t OFF_QMLA = OFF_XB;
constexpr size_t OFF_KNOPE = OFF_QMLA + (size_t)NTOK * 384 * 2;
constexpr size_t OFF_KROPE = OFF_KNOPE + (size_t)NTOK * 256 * 2;
constexpr size_t OFF_G = OFF_KROPE + (size_t)NTOK * 32 * 2;
constexpr size_t OFF_BONUS = OFF_G + (size_t)NTOK * 256 * 2;
static_assert(OFF_BONUS + (size_t)NTOK * 16 <= OFF_XB + SZ_XB, "xb alias region");
constexpr size_t OFF_YCAT = OFF_HRWKV;
constexpr size_t OFF_QMEM = OFF_HATT;
constexpr size_t OFF_OMEM = OFF_R7;
#ifdef CPU_EMU
constexpr size_t OFF_EMU_SCAN = WS_END;
constexpr size_t OFF_LISTS = AL(OFF_EMU_SCAN + (size_t)4 * NTOK * 256 * 2);
#else
constexpr size_t OFF_LISTS = OFF_HATT;
#endif
constexpr size_t OFF_TINFO = OFF_LISTS + (size_t)NEXP * NTOK * 4;
constexpr size_t OFF_HM = AL(OFF_TINFO + (size_t)NTOK * 32);
constexpr size_t OFF_YROWS = AL(OFF_HM + (size_t)MOE_ROWS * 256 * 2);
#ifdef CPU_EMU
constexpr size_t OFF_W13T = AL(OFF_YROWS + (size_t)MOE_ROWS * 1024 * 2);
#else
static_assert(OFF_YROWS + (size_t)MOE_ROWS * 1024 * 2 <= OFF_HHGRN, "moe alias region");
constexpr size_t OFF_W13T = OFF_HHGRN;
#endif
constexpr size_t OFF_W2T = OFF_W13T + (size_t)NEXP * 512 * 1024 * 2;
#ifdef CPU_EMU
constexpr size_t WS_END_EMU = OFF_W2T + (size_t)NEXP * 1024 * 256 * 2;
#else
static_assert(OFF_W2T + (size_t)NEXP * 1024 * 256 * 2 <= WS_END, "moe weights alias");
#endif

enum { R_R = 0, R_V = 1, R_KK = 2, R_W0 = 3, R_W1 = 4, R_KD0 = 5, R_KD1 = 6, R_AK0 = 7, R_AK1 = 8 };

DI float bf2f(bf16 v) { union { unsigned u; float f; } x; x.u = (unsigned)v << 16; return x.f; }
DI bf16 f2bf(float f) { union { unsigned u; float f; } x; x.f = f; unsigned u = x.u; u += 0x7fffu + ((u >> 16) & 1u); return (bf16)(u >> 16); }
DI float sigmoidf_(float x) { return 1.0f / (1.0f + expf(-x)); }
DI float siluf_(float x) { return x * sigmoidf_(x); }

#ifdef CPU_EMU
typedef const float* const* InPtr;
#else
typedef const float* const __attribute__((address_space(4)))* InPtr;
#endif
struct Frame {
    InPtr in;
    float* xf;
    unsigned char* ws;
    unsigned char* smem;
    int tid;
    int wv;
    int nblk;
};
#ifdef CPU_EMU
constexpr int NTH = 1;
#else
constexpr int NTH = 512;
#endif
#ifdef CPU_EMU
constexpr int GRP = 1;
DI float grp_sum(const Frame& F, float v) { return v; }
DI int gthreads(const Frame& F) { return 1; }
DI int gtid_(const Frame& F) { return 0; }
DI int wave_item_index(const Frame& F) { return 0; }
#else
constexpr int GRP = 64;
DI float shfl_idx(const Frame& F, float v, int src_lane) { return __builtin_bit_cast(float, __builtin_amdgcn_ds_bpermute(src_lane << 2, __builtin_bit_cast(int, v))); }
DI float shfl_xor(const Frame& F, float v, int mask) { return shfl_idx(F, v, (F.tid & 63) ^ mask); }
template <int CTRL> DI float dppf(float x) { return __builtin_bit_cast(float, __builtin_amdgcn_update_dpp(0, __builtin_bit_cast(int, x), CTRL, 0xf, 0xf, true)); }
DI float allsum16(float x) { x += dppf<0xB1>(x); x += dppf<0x4E>(x); x += dppf<0x141>(x); x += dppf<0x140>(x); return x; }
DI float rdlane(float x, int l) { return __builtin_bit_cast(float, __builtin_amdgcn_readlane(__builtin_bit_cast(int, x), l)); }
DI float grp_sum(const Frame& F, float v) { v = allsum16(v); return (rdlane(v, 0) + rdlane(v, 16)) + (rdlane(v, 32) + rdlane(v, 48)); }
DI int gthreads(const Frame& F) { return F.nblk * NTH; }
DI int gtid_(const Frame& F) { return blockIdx.x * NTH + F.tid; }
DI int wave_item_index(const Frame& F) { return (int)(((F.tid >> 6) * F.nblk + blockIdx.x) * 64 + (F.tid & 63)); }
#endif
constexpr int PER64 = 64 / GRP;
constexpr int PERLN = 1024 / GRP;
DI int fresh_tid(const Frame& F) {
#ifdef CPU_EMU
    return 0;
#else
    unsigned m0 = ~0u; asm volatile("" : "+s"(m0));
    int t = F.wv * 64 + (int)__builtin_amdgcn_mbcnt_hi(m0, __builtin_amdgcn_mbcnt_lo(m0, 0u)); asm volatile("" : "+v"(t)); return t;
#endif
}
DI int glane(const Frame& F) { return (int)(F.tid % GRP); }
DI int ggrp(const Frame& F) { return gtid_(F) / GRP; }
DI int ngrp(const Frame& F) { return gthreads(F) / GRP; }

struct Args {
    const float* in[42];
    float* out;
    unsigned char* ws;
    int ph_lo, ph_hi;
};

DI float rope_inv(int f, int nf) { return powf(10000.0f, -(float)f / (float)nf); }

#ifndef CPU_EMU
using bf16x8 = __attribute__((ext_vector_type(8))) short;
using bf16x4 = __attribute__((ext_vector_type(4))) short;
using f32x4 = __attribute__((ext_vector_type(4))) float;
using f32x16 = __attribute__((ext_vector_type(16))) float;
typedef __bf16 bf16v2 __attribute__((ext_vector_type(2)));
typedef float f32v2 __attribute__((ext_vector_type(2)));
DI float bflo(unsigned u) { return __uint_as_float(u << 16); }
DI float bfhi(unsigned u) { return __uint_as_float(u & 0xffff0000u); }
DI unsigned pack_bf16(float lo, float hi) { f32v2 v = {lo, hi}; bf16v2 b = __builtin_convertvector(v, bf16v2); return __builtin_bit_cast(unsigned, b); }

constexpr int G_BM = 256, G_BK = 64, G_HALF = 128, G_HT = G_HALF * G_BK, G_SHM = 8 * G_HT * 2;
DI int g_lds_byte(int r, int c) { int st = (r >> 4) * 2 + (c >> 5), rr = r & 15, cc = c & 31, ob = rr * 64 + cc * 2; return st * 1024 + (ob ^ (((ob >> 9) & 1) << 5)); }
DI void g_stage_rc(int b, int& R, int& C) { int st = b / 1024, sb = b % 1024, swz = sb ^ (((sb >> 9) & 1) << 5); R = (st >> 1) * 16 + swz / 64; C = (st & 1) * 32 + (swz % 64) / 2; }

template <bool GATHER, class Epi>
DI void gemm_unit_t(int wv_in, bf16* shm, const bf16* __restrict__ A, int lda, const int* rowmap, int arow0,
                    const bf16* __restrict__ Bt, int ldb, int bcol0, int K, const Epi& epi) {
#define SA(b, h) (shm + ((b) * 2 + (h)) * G_HT)
#define SB(b, h) (shm + (4 + (b) * 2 + (h)) * G_HT)
#define STAGE_AX(T, P, hf, kt) do { for (int _i = 0; _i < 2; ++_i) { int _b = (T) * 16 + _i * 8192; int _r, _c; g_stage_rc(_b, _r, _c); \
        const long _row = GATHER ? (long)rowmap[(hf) * G_HALF + _r] : (long)(arow0 + (hf) * G_HALF + _r); \
        __builtin_amdgcn_global_load_lds((const unsigned*)(A + _row * lda + (long)(kt) * G_BK + _c), (unsigned*)((char*)(P) + _b), 16, 0, 0); } } while (0)
#define STAGE_BX(T, P, hf, kt) do { for (int _i = 0; _i < 2; ++_i) { int _b = (T) * 16 + _i * 8192; int _r, _c; g_stage_rc(_b, _r, _c); \
        __builtin_amdgcn_global_load_lds((const unsigned*)(Bt + (long)(bcol0 + (hf) * G_HALF + _r) * ldb + (long)(kt) * G_BK + _c), (unsigned*)((char*)(P) + _b), 16, 0, 0); } } while (0)
#define STAGE_A(P, hf, kt) STAGE_AX(t0, P, hf, kt)
#define STAGE_B(P, hf, kt) STAGE_BX(t0, P, hf, kt)
#define LDA(dst, b, h) for (int m = 0; m < 4; ++m) for (int k = 0; k < 2; ++k) \
        dst[m][k] = *reinterpret_cast<const bf16x8*>((char*)SA(b, h) + g_lds_byte(wr * 64 + m * 16 + fr, k * 32 + fq * 8))
#define LDB(dst, b, h) for (int n = 0; n < 2; ++n) for (int k = 0; k < 2; ++k) \
        dst[n][k] = *reinterpret_cast<const bf16x8*>((char*)SB(b, h) + g_lds_byte(wc * 32 + n * 16 + fr, k * 32 + fq * 8))
#define MMA(ai, bj, At, Bt_) do { __builtin_amdgcn_s_setprio(1); \
        for (int m = 0; m < 4; ++m) for (int n = 0; n < 2; ++n) for (int k = 0; k < 2; ++k) \
            acc[ai][bj][m][n] = __builtin_amdgcn_mfma_f32_16x16x32_bf16(Bt_[n][k], At[m][k], acc[ai][bj][m][n], 0, 0, 0); \
        __builtin_amdgcn_s_setprio(0); } while (0)
#define WAIT_V(n) asm volatile("s_waitcnt vmcnt(" #n ")" ::: "memory")
#define WAIT_L(n) asm volatile("s_waitcnt lgkmcnt(" #n ")" ::: "memory")
#define BAR __builtin_amdgcn_s_barrier()
#define SCHED __builtin_amdgcn_sched_barrier(0)
    unsigned m0 = ~0u; asm volatile("" : "+s"(m0));
    int t0 = wv_in * 64 + (int)__builtin_amdgcn_mbcnt_hi(m0, __builtin_amdgcn_mbcnt_lo(m0, 0u)); asm volatile("" : "+v"(t0));
    int wid = t0 >> 6, lane = t0 & 63, wr = wid >> 2, wc = wid & 3, fr = lane & 15, fq = lane >> 4;
    f32x4 acc[2][2][4][2] = {};
    bf16x8 At[4][2], B0[2][2], B1[2][2];
    const int nt = K / G_BK;
    STAGE_B(SB(0, 0), 0, 0); STAGE_A(SA(0, 0), 0, 0);
    STAGE_B(SB(0, 1), 1, 0); STAGE_A(SA(0, 1), 1, 0);
    if (wr == 1) BAR;
    WAIT_V(4); BAR;
    STAGE_B(SB(1, 0), 0, 1); STAGE_A(SA(1, 0), 0, 1); STAGE_B(SB(1, 1), 1, 1);
    WAIT_V(6); BAR;
    for (int t = 0; t < nt - 2; t += 2) {
        LDB(B0, 0, 0); SCHED; LDA(At, 0, 0); STAGE_A(SA(1, 1), 1, t + 1);
        WAIT_L(8); BAR; WAIT_L(0); MMA(0, 0, At, B0); BAR; SCHED;
        LDB(B1, 0, 1); STAGE_B(SB(0, 0), 0, t + 2);
        BAR; WAIT_L(0); MMA(0, 1, At, B1); BAR;
        LDA(At, 0, 1); STAGE_A(SA(0, 0), 0, t + 2);
        BAR; WAIT_L(0); MMA(1, 0, At, B0); BAR; SCHED;
        STAGE_B(SB(0, 1), 1, t + 2);
        WAIT_V(6); BAR; MMA(1, 1, At, B1); BAR;
        LDB(B0, 1, 0); SCHED; LDA(At, 1, 0); STAGE_A(SA(0, 1), 1, t + 2);
        WAIT_L(8); BAR; WAIT_L(0); MMA(0, 0, At, B0); BAR; SCHED;
        LDB(B1, 1, 1); STAGE_B(SB(1, 0), 0, t + 3);
        BAR; WAIT_L(0); MMA(0, 1, At, B1); BAR;
        LDA(At, 1, 1); STAGE_A(SA(1, 0), 0, t + 3);
        BAR; WAIT_L(0); MMA(1, 0, At, B0); BAR; SCHED;
        STAGE_B(SB(1, 1), 1, t + 3);
        WAIT_V(6); BAR; MMA(1, 1, At, B1); BAR;
    }
    int tz = t0; asm volatile("" : "+v"(tz)); wid = tz >> 6; lane = tz & 63; wr = wid >> 2; wc = wid & 3; fr = lane & 15; fq = lane >> 4;
    { LDB(B0, 0, 0); WAIT_V(0); LDA(At, 0, 0); STAGE_AX(tz, SA(1, 1), 1, nt - 1);
      BAR; WAIT_L(0); MMA(0, 0, At, B0); BAR;
      LDB(B1, 0, 1); BAR; WAIT_L(0); MMA(0, 1, At, B1); BAR;
      LDA(At, 0, 1); WAIT_V(4); BAR; WAIT_L(0); MMA(1, 0, At, B0); MMA(1, 1, At, B1); BAR; }
    { LDB(B0, 1, 0); LDA(At, 1, 0); WAIT_V(2); BAR; WAIT_L(0); MMA(0, 0, At, B0); BAR;
      LDB(B1, 1, 1); WAIT_V(0); BAR; WAIT_L(0); MMA(0, 1, At, B1); BAR;
      LDA(At, 1, 1); BAR; WAIT_L(0); MMA(1, 0, At, B0); MMA(1, 1, At, B1); BAR; }
    if (wr == 0) BAR;
#pragma unroll
    for (int ai = 0; ai < 2; ++ai)
#pragma unroll
        for (int m = 0; m < 4; ++m)
#pragma unroll
            for (int bj = 0; bj < 2; ++bj)
#pragma unroll
                for (int n = 0; n < 2; ++n) {
                    const f32x4 v = acc[ai][bj][m][n];
                    epi(ai * G_HALF + wr * 64 + m * 16 + fr, bj * G_HALF + wc * 32 + n * 16 + fq * 4, v[0], v[1], v[2], v[3]);
                }
#undef SA
#undef SB
#undef STAGE_A
#undef STAGE_B
#undef STAGE_AX
#undef STAGE_BX
#undef LDA
#undef LDB
#undef MMA
}
template <class Epi>
DI void gemm_unit(const Frame& F, const bf16* __restrict__ A, int lda, const int* rowmap, int arow0,
                  const bf16* __restrict__ Bt, int ldb, int bcol0, int K, const Epi& epi) {
    if (rowmap) gemm_unit_t<true>(F.wv, (bf16*)F.smem, A, lda, rowmap, arow0, Bt, ldb, bcol0, K, epi);
    else gemm_unit_t<false>(F.wv, (bf16*)F.smem, A, lda, rowmap, arow0, Bt, ldb, bcol0, K, epi);
}
#else
template <class Epi>
void gemm_unit(const Frame& F, const bf16* A, int lda, const int* rowmap, int arow0, const bf16* Bt, int ldb, int bcol0, int K, const Epi& epi, int mrows = 256) {
    for (int r = 0; r < mrows; ++r) {
        int arow = rowmap ? rowmap[r] : arow0 + r;
        for (int c = 0; c < 256; c += 4) {
            float v[4];
            for (int q = 0; q < 4; ++q) {
                double s = 0; const bf16* a = A + (long)arow * lda; const bf16* b = Bt + (long)(bcol0 + c + q) * ldb;
                for (int k = 0; k < K; ++k) s += (double)bf2f(a[k]) * bf2f(b[k]);
                v[q] = (float)s;
            }
            epi(r, c, v[0], v[1], v[2], v[3]);
        }
    }
}
#endif

DI void st_bf16x4(bf16* p, float a, float b, float c, float d) {
#ifndef CPU_EMU
    uint2 u; u.x = pack_bf16(a, b); u.y = pack_bf16(c, d); *reinterpret_cast<uint2*>(p) = u;
#else
    p[0] = f2bf(a); p[1] = f2bf(b); p[2] = f2bf(c); p[3] = f2bf(d);
#endif
}

#define WSP(T, off) ((T*)(F.ws + (off)))

DI void ln_row_write(float* xrow, bf16* brow, const float* vals_in  , const float* g, const float* b);

template <class Fn>
DI void layer_norm_rows(const Frame& F, const float* g, const float* b, Fn pre, bool write_out_extra, float* extra) {
    float* xf = F.xf; bf16* xb = WSP(bf16, OFF_XB);
    for (int row = ggrp(F); row < NTOK; row += ngrp(F)) {
        float v[PERLN]; float s = 0.f;
        for (int i = 0; i < PERLN; ++i) { int c = glane(F) + i * GRP; v[i] = pre(row, c); s += v[i]; }
        s = grp_sum(F, s); const float mu = s * (1.0f / 1024.0f);
        float q = 0.f;
        for (int i = 0; i < PERLN; ++i) { float d = v[i] - mu; q += d * d; }
        q = grp_sum(F, q); const float rs = 1.0f / sqrtf(q * (1.0f / 1024.0f) + LN_EPS);
        for (int i = 0; i < PERLN; ++i) { int c = glane(F) + i * GRP; float y = (v[i] - mu) * rs * g[c] + b[c];
            xf[(size_t)row * DM + c] = y; xb[(size_t)row * DM + c] = f2bf(y); if (write_out_extra) extra[(size_t)row * DM + c] = y; }
    }
}

#ifndef CPU_EMU
template <int MODE>
DI void ln_rows_gpu(const Frame& F, const float* __restrict__ g, const float* __restrict__ b, int l) {
    float* xf = F.xf; bf16* xb = WSP(bf16, OFF_XB);
    const float* xin = F.in[0];
    const bf16* yr = WSP(bf16, OFF_YROWS); const float* tinfo = WSP(float, OFF_TINFO);
    const int* eoff = (const int*)(F.ws + CTL_EOFF) + l * 33;
    const int tid = F.tid, wave = tid >> 6, lane = tid & 63;
    float4 gv[4], bv[4];
#pragma unroll
    for (int i = 0; i < 4; ++i) { gv[i] = *reinterpret_cast<const float4*>(g + lane * 4 + 256 * i); bv[i] = *reinterpret_cast<const float4*>(b + lane * 4 + 256 * i); }
    for (int r0 = (blockIdx.x * 8 + wave) * 4; r0 < NTOK; r0 += F.nblk * 32) {
        float4 v[4][4];
#pragma unroll
        for (int rr = 0; rr < 4; ++rr) {
            const size_t row = r0 + rr;
            if (MODE == 2) {
                const int* ti = (const int*)(tinfo + row * 8);
                const size_t ra = (size_t)eoff[ti[0]] + ti[1], rb = (size_t)eoff[ti[2]] + ti[3];
                const float g0 = tinfo[row * 8 + 4], g1 = tinfo[row * 8 + 5];
#pragma unroll
                for (int i = 0; i < 4; ++i) {
                    const int c = lane * 4 + 256 * i;
                    const float4 x = *reinterpret_cast<const float4*>(xf + row * DM + c);
                    const uint2 ya = *reinterpret_cast<const uint2*>(yr + ra * 1024 + c), yb = *reinterpret_cast<const uint2*>(yr + rb * 1024 + c);
                    v[rr][i].x = DN_ALPHA * x.x + g0 * bflo(ya.x) + g1 * bflo(yb.x); v[rr][i].y = DN_ALPHA * x.y + g0 * bfhi(ya.x) + g1 * bfhi(yb.x);
                    v[rr][i].z = DN_ALPHA * x.z + g0 * bflo(ya.y) + g1 * bflo(yb.y); v[rr][i].w = DN_ALPHA * x.w + g0 * bfhi(ya.y) + g1 * bfhi(yb.y);
                }
            } else {
                const float* src = (MODE == 1 ? xin : xf) + row * DM;
#pragma unroll
                for (int i = 0; i < 4; ++i) v[rr][i] = *reinterpret_cast<const float4*>(src + lane * 4 + 256 * i);
            }
        }
#pragma unroll
        for (int rr = 0; rr < 4; ++rr) {
            const size_t row = r0 + rr;
            float s = 0.f;
#pragma unroll
            for (int i = 0; i < 4; ++i) s += (v[rr][i].x + v[rr][i].y) + (v[rr][i].z + v[rr][i].w);
            const float mu = grp_sum(F, s) * (1.0f / 1024.0f);
            float q = 0.f;
#pragma unroll
            for (int i = 0; i < 4; ++i) { const float d0 = v[rr][i].x - mu, d1 = v[rr][i].y - mu, d2 = v[rr][i].z - mu, d3 = v[rr][i].w - mu; q += (d0 * d0 + d1 * d1) + (d2 * d2 + d3 * d3); }
            const float rs = 1.0f / sqrtf(grp_sum(F, q) * (1.0f / 1024.0f) + LN_EPS);
#pragma unroll
            for (int i = 0; i < 4; ++i) {
                const int c = lane * 4 + 256 * i;
                float4 y; y.x = (v[rr][i].x - mu) * rs * gv[i].x + bv[i].x; y.y = (v[rr][i].y - mu) * rs * gv[i].y + bv[i].y;
                y.z = (v[rr][i].z - mu) * rs * gv[i].z + bv[i].z; y.w = (v[rr][i].w - mu) * rs * gv[i].w + bv[i].w;
                *reinterpret_cast<float4*>(xf + row * DM + c) = y;
                *reinterpret_cast<uint2*>(xb + row * DM + c) = make_uint2(pack_bf16(y.x, y.y), pack_bf16(y.z, y.w));
            }
        }
    }
}
#endif

DI void phase_pro(const Frame& F) {
    const float* x = F.in[0]; const float* mem = F.in[1];
#ifdef CPU_EMU
    layer_norm_rows(F, F.in[2], F.in[3], [&](int row, int c) { return x[(size_t)row * DM + c]; }, false, nullptr);
#else
    (void)x; ln_rows_gpu<1>(F, F.in[2], F.in[3], 0);
#endif
    bf16* memb = WSP(bf16, OFF_MEMB);
    for (size_t i = gtid_(F); i < (size_t)NMEM * DM; i += gthreads(F)) memb[i] = f2bf(mem[i]);
}

template <class Src>
DI void cvt_tile(const Frame& F, bf16* dst, int Kk, int n0, int k0, Src src) {
#ifndef CPU_EMU
    float* tile = (float*)F.smem;
    __syncthreads();
    for (int i = F.tid; i < 4096; i += NTH) { int k = i >> 6, n = i & 63; tile[k * 65 + n] = src(k0 + k, n0 + n); }
    __syncthreads();
    for (int i = F.tid; i < 2048; i += NTH) { int n = i >> 5, k = (i & 31) * 2;
        *reinterpret_cast<unsigned*>(dst + (size_t)(n0 + n) * Kk + k0 + k) = pack_bf16(tile[k * 65 + n], tile[(k + 1) * 65 + n]); }
#endif
}
template <class Src>
DI void cvt_transpose(const Frame& F, bf16* dst, int Nn, int Kk, Src src, int t_first, int t_total) {
#ifdef CPU_EMU
    for (int n = 0; n < Nn; ++n) for (int k = 0; k < Kk; ++k) dst[(size_t)n * Kk + k] = f2bf(src(k, n));
#else
    const int tn = Nn / 64, tk = Kk / 64, ntile = tn * tk;
    int t = (int)blockIdx.x - (t_first % (int)F.nblk); if (t < 0) t += F.nblk;
    for (; t < ntile; t += F.nblk) cvt_tile(F, dst, Kk, (t % tn) * 64, (t / tn) * 64, src);
#endif
}

DI int win_src_col(int n) {
    if (n < 512) return n;
    if (n < 1536) { int c = n - 512; return c < 960 ? 512 + c : -1; }
    if (n < 2816) return 1472 + (n - 1536);
    int c = n - 2816;
    if (c < 192) return 2752 + c;
    if (c < 224) return 2752 + 320 + (c - 192);
    if (c < 256) return -1;
    if (c < 384) return 2752 + 192 + (c - 256);
    return -1;
}
DI int wuq_src_col(int n) {
    if (n >= 384) return -1;
    int h = n / 96, w = n % 96;
    if (w < 64) return h * 96 + w;
    int p = w - 64, m = p >> 1, which = p & 1;
    int i = (m < 8 ? m : 16 + (m - 8)) + (which ? 8 : 0);
    return h * 96 + 64 + i;
}

DI void phase_cvt(const Frame& F, int l) {
    bf16* wts = WSP(bf16, OFF_WTS);
    constexpr int T0 = 0, T1 = T0 + (HP / 64) * 16, T2 = T1 + 8 * 4, T3 = T2 + 8 * 4, T4 = T3 + 256, T5 = T4 + 256, T6 = T5 + 512, TT = T6 + 256;
    { const float* w = F.in[4] + (size_t)l * 1024 * IN_WIDTH;
      cvt_transpose(F, (bf16*)((char*)wts + W_IN_T), HP, 1024, [&](int k, int n) { int s = win_src_col(n); return s < 0 ? 0.f : w[(size_t)k * IN_WIDTH + s]; }, T0, TT); }
    { const float* w = F.in[23] + (size_t)l * 192 * 384;
      cvt_transpose(F, (bf16*)((char*)wts + W_UQ_T), 512, 256, [&](int k, int n) { int s = wuq_src_col(n); return (s < 0 || k >= 192) ? 0.f : w[(size_t)k * 384 + s]; }, T1, TT); }
    { const float* w = F.in[24] + (size_t)l * 128 * 512;
      cvt_transpose(F, (bf16*)((char*)wts + W_UKV_T), 512, 256, [&](int k, int n) { return k >= 128 ? 0.f : w[(size_t)k * 512 + n]; }, T2, TT); }
    { const float* w = F.in[25] + (size_t)l * 1024 * 1024;
      cvt_transpose(F, (bf16*)((char*)wts + W_OUT_T), 1024, 1024, [&](int k, int n) { return w[(size_t)k * 1024 + n]; }, T3, TT); }
    { const float* w = F.in[28] + (size_t)l * 1024 * 1024;
      cvt_transpose(F, (bf16*)((char*)wts + W_Q_T), 1024, 1024, [&](int k, int n) { return w[(size_t)k * 1024 + n]; }, T4, TT); }
    { const float* w = F.in[29] + (size_t)l * 1024 * 2048;
      cvt_transpose(F, (bf16*)((char*)wts + W_KV_T), 2048, 1024, [&](int k, int n) { return w[(size_t)k * 2048 + n]; }, T5, TT); }
    { const float* w = F.in[30] + (size_t)l * 1024 * 1024;
      cvt_transpose(F, (bf16*)((char*)wts + W_O_T), 1024, 1024, [&](int k, int n) { return w[(size_t)k * 1024 + n]; }, T6, TT); }
#ifndef CPU_EMU
    { const float* wg = F.in[33] + (size_t)l * 1024 * 4; const float* we = F.in[35] + (size_t)l * 1024 * 32; float* gt = (float*)((char*)wts + W_GATE_T) + (size_t)l * 48 * 1024;
      for (int i = gtid_(F); i < 48 * 1024; i += gthreads(F)) { const int col = i >> 10, k = i & 1023;
          gt[i] = col < 4 ? wg[k * 4 + col] : col < 36 ? we[k * 32 + col - 4] : 0.f; } }
#endif
}

DI void phase_cvt_moe(const Frame& F, int l) {
#ifdef CPU_EMU
    for (int e = 0; e < NEXP; ++e) {
        const float* w1 = F.in[37] + ((size_t)l * NEXP + e) * 1024 * 256;
        const float* w3 = F.in[38] + ((size_t)l * NEXP + e) * 1024 * 256;
        const float* w2 = F.in[39] + ((size_t)l * NEXP + e) * 256 * 1024;
        cvt_transpose(F, WSP(bf16, OFF_W13T) + (size_t)e * 512 * 1024, 512, 1024,
                      [&](int k, int n) { return (n & 1) ? w3[(size_t)k * 256 + (n >> 1)] : w1[(size_t)k * 256 + (n >> 1)]; }, 0, 1);
        cvt_transpose(F, WSP(bf16, OFF_W2T) + (size_t)e * 1024 * 256, 1024, 256, [&](int k, int n) { return w2[(size_t)k * 1024 + n]; }, 0, 1);
    }
#else
    const float* w1b = F.in[37] + (size_t)l * NEXP * 1024 * 256; const float* w3b = F.in[38] + (size_t)l * NEXP * 1024 * 256; const float* w2b = F.in[39] + (size_t)l * NEXP * 256 * 1024;
    float* tile = (float*)F.smem;
    const int tid = F.tid;
    constexpr int NT = NEXP * 128 + NEXP * 64;
    auto src_ptr = [&](int t, int j) -> const float* {
        const int idx = tid + 512 * j, k = idx >> 4, f4 = idx & 15;
        if (t < NEXP * 128) { const int e = t >> 7, tt = t & 127, n0 = (tt & 7) * 64, k0 = (tt >> 3) * 64;
            const float* base = (f4 < 8 ? w1b : w3b) + (size_t)e * 1024 * 256; return base + (size_t)(k0 + k) * 256 + (n0 >> 1) + 4 * (f4 & 7); }
        const int u = t - NEXP * 128, e = u >> 6, tt = u & 63, n0 = (tt & 15) * 64, k0 = (tt >> 4) * 64;
        return w2b + (size_t)e * 256 * 1024 + (size_t)(k0 + k) * 1024 + n0 + 4 * f4;
    };
    int t = blockIdx.x;
    float4 p0 = make_float4(0.f, 0.f, 0.f, 0.f), p1 = p0;
    if (t < NT) { p0 = *reinterpret_cast<const float4*>(src_ptr(t, 0)); p1 = *reinterpret_cast<const float4*>(src_ptr(t, 1)); }
    for (; t < NT; t += F.nblk) {
        const float4 c0 = p0, c1 = p1;
        const int tn = t + F.nblk;
        if (tn < NT) { p0 = *reinterpret_cast<const float4*>(src_ptr(tn, 0)); p1 = *reinterpret_cast<const float4*>(src_ptr(tn, 1)); }
        __syncthreads();
#pragma unroll
        for (int j = 0; j < 2; ++j) {
            const float4 c = j ? c1 : c0; const int idx = tid + 512 * j, k = idx >> 4, f4 = idx & 15;
            float* tr = tile + k * 65;
            if (t < NEXP * 128) { const int nb = 8 * (f4 & 7) + (f4 >> 3);
                tr[nb] = c.x; tr[nb + 2] = c.y; tr[nb + 4] = c.z; tr[nb + 6] = c.w; }
            else { tr[4 * f4] = c.x; tr[4 * f4 + 1] = c.y; tr[4 * f4 + 2] = c.z; tr[4 * f4 + 3] = c.w; }
        }
        __syncthreads();
        bf16* dst; int Kk, n0, k0;
        if (t < NEXP * 128) { const int e = t >> 7, tt = t & 127; dst = WSP(bf16, OFF_W13T) + (size_t)e * 512 * 1024; Kk = 1024; n0 = (tt & 7) * 64; k0 = (tt >> 3) * 64; }
        else { const int u = t - NEXP * 128, e = u >> 6, tt = u & 63; dst = WSP(bf16, OFF_W2T) + (size_t)e * 1024 * 256; Kk = 256; n0 = (tt & 15) * 64; k0 = (tt >> 4) * 64; }
        for (int i = tid; i < 2048; i += NTH) { const int n = i >> 5, k = (i & 31) * 2;
            *reinterpret_cast<unsigned*>(dst + (size_t)(n0 + n) * Kk + k0 + k) = pack_bf16(tile[k * 65 + n], tile[(k + 1) * 65 + n]); }
    }
#endif
}

struct EpiH {
    bf16* hatt; bf16* hrwkv; bf16* hhgrn; bf16* hmla; int row0, pn;
    DI void operator()(int r, int c, float a, float b, float cc, float d) const {
        const size_t row = row0 + r;
        bf16* p;
        if (pn < 2) p = hatt + row * 512 + pn * 256 + c;
        else if (pn < 6) p = hrwkv + row * 1024 + (pn - 2) * 256 + c;
        else if (pn < 11) p = hhgrn + row * 1280 + (pn - 6) * 256 + c;
        else p = hmla + row * 512 + (pn - 11) * 256 + c;
        st_bf16x4(p, a, b, cc, d);
    }
};
struct EpiKV {
    bf16* kmem; bf16* vt; int row0, pn;
    DI void operator()(int r, int c, float a, float b, float cc, float d) const {
        const int row = row0 + r, col = pn * 256 + c;
        if (col < 1024) { st_bf16x4(kmem + (size_t)row * 1024 + col, a, b, cc, d); }
        else { const int bb = row / MEMT, key = row % MEMT, hc = col - 1024;
            bf16* p = vt + ((size_t)bb * 1024 + hc) * MEMT + key;
            p[0] = f2bf(a); p[MEMT] = f2bf(b); p[2 * MEMT] = f2bf(cc); p[3 * MEMT] = f2bf(d); }
    }
};

DI void phase_gemm1(const Frame& F) {
    const bf16* xb = WSP(bf16, OFF_XB); const bf16* wts = WSP(bf16, OFF_WTS);
    const int nM = (NTOK + 255) / 256, nN = HP / 256, n1 = nM * nN;
    const int nMk = (NMEM + 255) / 256, nNk = 8, n2 = nMk * nNk;
    for (int u = blockIdx.x; u < n1 + n2; u += F.nblk) {
        if (u < n1) {
            const int pm = u / nN, pn = u % nN;
            EpiH E{WSP(bf16, OFF_HATT), WSP(bf16, OFF_HRWKV), WSP(bf16, OFF_HHGRN), WSP(bf16, OFF_HMLA), pm * 256, pn};
#ifdef CPU_EMU
            gemm_unit(F, xb, 1024, nullptr, pm * 256, (const bf16*)((const char*)wts + W_IN_T), 1024, pn * 256, 1024, E, min(256, NTOK - pm * 256));
#else
            gemm_unit(F, xb, 1024, nullptr, pm * 256, (const bf16*)((const char*)wts + W_IN_T), 1024, pn * 256, 1024, E);
#endif
        } else {
            const int v = u - n1, pm = v / nNk, pn = v % nNk;
            EpiKV E{WSP(bf16, OFF_KMEM), WSP(bf16, OFF_VTMEM), pm * 256, pn};
            gemm_unit(F, WSP(bf16, OFF_MEMB), 1024, nullptr, pm * 256, (const bf16*)((const char*)wts + W_KV_T), 1024, pn * 256, 1024, E);
        }
    }
}


#ifndef CPU_EMU
DI float fast_sigmoid(float x) { return 1.0f / (1.0f + __expf(-x)); }
DI float fast_tanh(float x) { const float e = __expf(2.0f * x); return 1.0f - 2.0f / (e + 1.0f); }

DI void prep_attn_gpu(const Frame& F, int l) {
    float* tabA = (float*)F.smem;
    float* tabB = tabA + 2048;
    float* gq = tabB + 1024;
    __syncthreads();
    { const int tid = fresh_tid(F);
    for (int i = tid; i < 1024; i += NTH) { const int pos = i >> 4, f = i & 15; const float ang = (float)pos * rope_inv(2 * f, 32); tabA[i] = cosf(ang); tabA[1024 + i] = sinf(ang); }
    for (int i = tid; i < 512; i += NTH) { const int pos = i >> 3, f = i & 7; const float ang = (float)pos * rope_inv(2 * f, 16); tabB[i] = cosf(ang); tabB[512 + i] = sinf(ang); }
    for (int i = tid; i < 448; i += NTH) gq[i] = i < 64 ? F.in[5][l * 64 + i] : i < 128 ? F.in[6][l * 64 + i - 64] : i < 320 ? F.in[21][l * 192 + i - 128] : F.in[22][l * 128 + i - 320]; }
    __syncthreads();
    bf16* hatt = WSP(bf16, OFF_HATT);
    for (int it = blockIdx.x * NTH + fresh_tid(F); it < NTOK * 6; it += gthreads(F)) {
        const int n = it / 6, hh = it % 6, s = n % SEQ, rowp = s / GRIDW, colp = s % GRIDW;
        uint4* p = reinterpret_cast<uint4*>(hatt + (size_t)n * 512 + hh * 64);
        const float* gn = gq + (hh < 4 ? 0 : 64);
        uint4 raw[8];
#pragma unroll
        for (int i = 0; i < 8; ++i) raw[i] = p[i];
        float x[64];
#pragma unroll
        for (int i = 0; i < 8; ++i) { x[8 * i] = bflo(raw[i].x); x[8 * i + 1] = bfhi(raw[i].x); x[8 * i + 2] = bflo(raw[i].y); x[8 * i + 3] = bfhi(raw[i].y);
            x[8 * i + 4] = bflo(raw[i].z); x[8 * i + 5] = bfhi(raw[i].z); x[8 * i + 6] = bflo(raw[i].w); x[8 * i + 7] = bfhi(raw[i].w); }
        float ss = 0.f;
#pragma unroll
        for (int j = 0; j < 64; ++j) ss += x[j] * x[j];
        const float rs = 1.0f / sqrtf(ss * (1.0f / 64.0f) + RMS_EPS);
#pragma unroll
        for (int j = 0; j < 64; ++j) x[j] *= rs * gn[j];
#pragma unroll
        for (int half = 0; half < 2; ++half) {
            const int pos = half ? colp : rowp;
#pragma unroll
            for (int f = 0; f < 16; ++f) {
                const float cs = tabA[pos * 16 + f], sn = tabA[1024 + pos * 16 + f];
                const float x1 = x[half * 32 + f], x2 = x[half * 32 + 16 + f];
                x[half * 32 + f] = x1 * cs - x2 * sn; x[half * 32 + 16 + f] = x1 * sn + x2 * cs;
            }
        }
#pragma unroll
        for (int i = 0; i < 8; ++i) { uint4 o; o.x = pack_bf16(x[8 * i], x[8 * i + 1]); o.y = pack_bf16(x[8 * i + 2], x[8 * i + 3]); o.z = pack_bf16(x[8 * i + 4], x[8 * i + 5]); o.w = pack_bf16(x[8 * i + 6], x[8 * i + 7]); p[i] = o; }
    }
    bf16* hm = WSP(bf16, OFF_HMLA); bf16* kr = WSP(bf16, OFF_KROPE);
    for (int it = blockIdx.x * NTH + fresh_tid(F); it < NTOK * 3; it += gthreads(F)) {
        const int n = it / 3, which = it % 3;
        if (which < 2) {
            const int len = which ? 128 : 192; const float* gn = gq + (which ? 320 : 128);
            uint4* p = reinterpret_cast<uint4*>(hm + (size_t)n * 512 + (which ? 256 : 0));
            float ss = 0.f;
            for (int i = 0; i < len / 8; ++i) { const uint4 r = p[i];
                const float a0 = bflo(r.x), a1 = bfhi(r.x), a2 = bflo(r.y), a3 = bfhi(r.y), a4 = bflo(r.z), a5 = bfhi(r.z), a6 = bflo(r.w), a7 = bfhi(r.w);
                ss += a0 * a0 + a1 * a1 + a2 * a2 + a3 * a3 + a4 * a4 + a5 * a5 + a6 * a6 + a7 * a7; }
            const float rs = 1.0f / sqrtf(ss / (float)len + RMS_EPS);
            for (int i = 0; i < len / 8; ++i) { const uint4 r = p[i]; const float* g = gn + 8 * i; uint4 o;
                o.x = pack_bf16(bflo(r.x) * rs * g[0], bfhi(r.x) * rs * g[1]); o.y = pack_bf16(bflo(r.y) * rs * g[2], bfhi(r.y) * rs * g[3]);
                o.z = pack_bf16(bflo(r.z) * rs * g[4], bfhi(r.z) * rs * g[5]); o.w = pack_bf16(bflo(r.w) * rs * g[6], bfhi(r.w) * rs * g[7]); p[i] = o; }
        } else {
            const int s = n % SEQ, rowp = s / GRIDW, colp = s % GRIDW;
            const uint4* p = reinterpret_cast<const uint4*>(hm + (size_t)n * 512 + 192);
            float x[32];
#pragma unroll
            for (int i = 0; i < 4; ++i) { const uint4 r = p[i]; x[8 * i] = bflo(r.x); x[8 * i + 1] = bfhi(r.x); x[8 * i + 2] = bflo(r.y); x[8 * i + 3] = bfhi(r.y);
                x[8 * i + 4] = bflo(r.z); x[8 * i + 5] = bfhi(r.z); x[8 * i + 6] = bflo(r.w); x[8 * i + 7] = bfhi(r.w); }
            unsigned o[16];
#pragma unroll
            for (int m = 0; m < 16; ++m) {
                const int i1 = m < 8 ? m : 16 + (m - 8), pos = m < 8 ? rowp : colp, f = m & 7;
                const float cs = tabB[pos * 8 + f], sn = tabB[512 + pos * 8 + f];
                o[m] = pack_bf16(x[i1] * cs - x[i1 + 8] * sn, x[i1] * sn + x[i1 + 8] * cs);
            }
            uint4* q = reinterpret_cast<uint4*>(kr + (size_t)n * 32);
#pragma unroll
            for (int i = 0; i < 4; ++i) q[i] = make_uint4(o[4 * i], o[4 * i + 1], o[4 * i + 2], o[4 * i + 3]);
        }
    }
    {
        bf16* vt = WSP(bf16, OFF_VTATT); bf16* tl = (bf16*)(gq + 512);
        for (int tile = blockIdx.x; tile < BATCH * 2 * (SEQ / 64); tile += F.nblk) {
            const int b = tile / (2 * (SEQ / 64)), kv = (tile / (SEQ / 64)) % 2, t0 = (tile % (SEQ / 64)) * 64;
            __syncthreads();
            const int tid = fresh_tid(F);
            { const int t = tid >> 3, part = tid & 7;
              const uint4 r = *reinterpret_cast<const uint4*>(hatt + (size_t)(b * SEQ + t0 + t) * 512 + 384 + kv * 64 + part * 8);
              const unsigned w[4] = {r.x, r.y, r.z, r.w};
#pragma unroll
              for (int i = 0; i < 4; ++i) { tl[(part * 8 + 2 * i) * 72 + t] = (bf16)(w[i] & 0xffffu); tl[(part * 8 + 2 * i + 1) * 72 + t] = (bf16)(w[i] >> 16); } }
            __syncthreads();
            { const int dv = tid >> 3, part = tid & 7;
              *reinterpret_cast<uint4*>(vt + ((size_t)(b * 2 + kv) * 64 + dv) * SEQ + t0 + part * 8) = *reinterpret_cast<const uint4*>(tl + dv * 72 + part * 8); }
        }
    }
}

DI void prep_hgrn_gpu(const Frame& F, int l) {
    bf16* hh = WSP(bf16, OFF_HHGRN); bf16* hx = WSP(bf16, OFF_HX); bf16* ham = WSP(bf16, OFF_HAM); float* heg = WSP(float, OFF_HEG);
    const int tid = F.tid, wave = tid >> 6, lane = tid & 63, x = lane & 15, q = lane >> 4;
    bf16* stg = (bf16*)F.smem + wave * (4 * 16 * 72);
    for (int it = blockIdx.x * 8 + wave; it < (NTOK / 16) * 4; it += F.nblk * 8) {
        const int c = it >> 2, h = it & 3, n0 = c * 16, cj = h * 64 + lane;
        float mlb = 1.0f;
        if (l == 1) { const float a = F.in[19][cj], b = F.in[19][256 + cj]; const float m = fmaxf(a, b); const float ea = __expf(a - m), eb = __expf(b - m); mlb = ea / (ea + eb); }
        float qv[16], k0[16], k1[16], g0[16], g1[16]; bf16 vraw[16];
#pragma unroll
        for (int t = 0; t < 16; ++t) {
            const bf16* row = hh + (size_t)(n0 + t) * 1280 + cj;
            const float xq = bf2f(row[0]), x0 = bf2f(row[256]), x1 = bf2f(row[512]); vraw[t] = row[768];
            qv[t] = xq * fast_sigmoid(xq); k0[t] = mlb * fast_sigmoid(-x0); k1[t] = mlb * fast_sigmoid(-x1);
            g0[t] = __logf(1.0f - k0[t]); g1[t] = __logf(1.0f - k1[t]);
        }
#pragma unroll
        for (int t = 1; t < 16; ++t) { g0[t] += g0[t - 1]; g1[15 - t] += g1[16 - t]; }
        heg[((size_t)it * 2 + 0) * 64 + lane] = __expf(g0[15]); heg[((size_t)it * 2 + 1) * 64 + lane] = __expf(g1[0]);
        unsigned kt0[8], kt1[8], vt[8];
#pragma unroll
        for (int t = 0; t < 16; t += 2) {
            const float e0a = __expf(g0[t]), e0b = __expf(g0[t + 1]), e1a = __expf(g1[t]), e1b = __expf(g1[t + 1]);
            const float q0a = qv[t] * e0a, q0b = qv[t + 1] * e0b, q1a = qv[t] * e1a, q1b = qv[t + 1] * e1b;
            const float ka0 = k0[t] / e0a, kb0 = k0[t + 1] / e0b, ka1 = k1[t] / e1a, kb1 = k1[t + 1] / e1b;
            const bf16 bq0a = f2bf(q0a), bq0b = f2bf(q0b), bq1a = f2bf(q1a), bq1b = f2bf(q1b);
            hh[(size_t)(n0 + t) * 1280 + cj] = bq0a; hh[(size_t)(n0 + t + 1) * 1280 + cj] = bq0b;
            hx[(size_t)(n0 + t) * 256 + cj] = bq1a; hx[(size_t)(n0 + t + 1) * 256 + cj] = bq1b;
            kt0[t >> 1] = pack_bf16(ka0, kb0); kt1[t >> 1] = pack_bf16(ka1, kb1); vt[t >> 1] = (unsigned)vraw[t] | ((unsigned)vraw[t + 1] << 16);
            stg[0 * 1152 + t * 72 + lane] = bq0a; stg[0 * 1152 + (t + 1) * 72 + lane] = bq0b;
            stg[2 * 1152 + t * 72 + lane] = bq1a; stg[2 * 1152 + (t + 1) * 72 + lane] = bq1b;
            stg[1 * 1152 + t * 72 + lane] = (bf16)(kt0[t >> 1] & 0xffffu); stg[1 * 1152 + (t + 1) * 72 + lane] = (bf16)(kt0[t >> 1] >> 16);
            stg[3 * 1152 + t * 72 + lane] = (bf16)(kt1[t >> 1] & 0xffffu); stg[3 * 1152 + (t + 1) * 72 + lane] = (bf16)(kt1[t >> 1] >> 16);
        }
        { bf16* blk = hh + (size_t)(n0 + (lane >> 2)) * 1280 + h * 64 + (lane & 3) * 16;
          *reinterpret_cast<uint4*>(blk + 256) = make_uint4(kt0[0], kt0[1], kt0[2], kt0[3]); *reinterpret_cast<uint4*>(blk + 256 + 8) = make_uint4(kt0[4], kt0[5], kt0[6], kt0[7]);
          *reinterpret_cast<uint4*>(blk + 512) = make_uint4(kt1[0], kt1[1], kt1[2], kt1[3]); *reinterpret_cast<uint4*>(blk + 512 + 8) = make_uint4(kt1[4], kt1[5], kt1[6], kt1[7]);
          *reinterpret_cast<uint4*>(blk + 768) = make_uint4(vt[0], vt[1], vt[2], vt[3]); *reinterpret_cast<uint4*>(blk + 768 + 8) = make_uint4(vt[4], vt[5], vt[6], vt[7]); }
        asm volatile("s_waitcnt lgkmcnt(0)" ::: "memory");
        __builtin_amdgcn_wave_barrier();
#pragma unroll
        for (int d = 0; d < 2; ++d) {
            f32x4 acc = {0.f, 0.f, 0.f, 0.f};
#pragma unroll
            for (int ks = 0; ks < 2; ++ks) {
                const bf16x8 a = *reinterpret_cast<const bf16x8*>(stg + (2 * d) * 1152 + x * 72 + 32 * ks + 8 * q);
                const bf16x8 b = *reinterpret_cast<const bf16x8*>(stg + (2 * d + 1) * 1152 + x * 72 + 32 * ks + 8 * q);
                acc = __builtin_amdgcn_mfma_f32_16x16x32_bf16(a, b, acc, 0, 0, 0);
            }
            bf16* am = ham + ((size_t)it * 2 + d) * 256;
#pragma unroll
            for (int r = 0; r < 4; ++r) { const int t = 4 * q + r; const bool keep = d ? (x >= t) : (x <= t); am[t * 16 + x] = f2bf(keep ? acc[r] : 0.f); }
        }
        __builtin_amdgcn_wave_barrier();
    }
}

DI void scan_hgrn_chunk(const Frame& F, int chain) {
    const int d = chain / (BATCH * 4), b = (chain / 4) % BATCH, h = chain % 4;
    const int lane = F.tid & 63, x = lane & 15, q = lane >> 4;
    bf16* hh = WSP(bf16, OFF_HHGRN); const bf16* hx = WSP(bf16, OFF_HX); const bf16* ham = WSP(bf16, OFF_HAM); const float* heg = WSP(float, OFF_HEG);
    f32x4 S[4][4];
#pragma unroll
    for (int a = 0; a < 4; ++a)
#pragma unroll
        for (int c = 0; c < 4; ++c) S[a][c] = (f32x4){0.f, 0.f, 0.f, 0.f};
    constexpr int NCH = SEQ / 16;
    uint2 nQ[4], nA, nK[4], nV[4]; float4 nE[4];
    const unsigned lq = (unsigned)(x * (d ? 256 : 1280) + h * 64 + 4 * q);
    const unsigned lb = (unsigned)((x >> 2) * 1280 + h * 64 + (x & 3) * 16 + 4 * q);
    const unsigned la = (unsigned)(x * 16 + 4 * q), le = (unsigned)(4 * q), lo = (unsigned)(4 * q * 1280 + x);
#define HG_LOAD(cc_) do { const int c_ = d ? NCH - 1 - (cc_) : (cc_); const unsigned n0_ = (unsigned)(b * SEQ + 16 * c_); const unsigned it_ = (n0_ >> 4) * 4 + h; \
        const bf16* qb_ = d ? hx + (size_t)n0_ * 256 : hh + (size_t)n0_ * 1280; const bf16* hb_ = hh + (size_t)n0_ * 1280; \
        const bf16* ab_ = ham + (size_t)(it_ * 2 + d) * 256; const float* eb_ = heg + (size_t)(it_ * 2 + d) * 64; \
        _Pragma("unroll") for (int u_ = 0; u_ < 4; ++u_) nQ[u_] = *reinterpret_cast<const uint2*>(qb_ + lq + 16 * u_); \
        nA = *reinterpret_cast<const uint2*>(ab_ + la); \
        _Pragma("unroll") for (int u_ = 0; u_ < 4; ++u_) { \
            nK[u_] = *reinterpret_cast<const uint2*>(hb_ + lb + (4 * u_) * 1280 + 256 + d * 256); nV[u_] = *reinterpret_cast<const uint2*>(hb_ + lb + (4 * u_) * 1280 + 768); \
            nE[u_] = *reinterpret_cast<const float4*>(eb_ + le + 16 * u_); } } while (0)
    HG_LOAD(0);
    for (int cc = 0; cc < NCH; ++cc) {
        uint2 cQ[4], cA, cK[4], cV[4]; float4 cE[4];
#pragma unroll
        for (int u = 0; u < 4; ++u) { cQ[u] = nQ[u]; cK[u] = nK[u]; cV[u] = nV[u]; cE[u] = nE[u]; }
        cA = nA;
        if (cc + 1 < NCH) HG_LOAD(cc + 1);
        const int c = d ? NCH - 1 - cc : cc; const size_t n0 = (size_t)b * SEQ + 16 * c;
        union Fr { bf16x8 v; unsigned u[4]; };
        Fr aq0, aq1, aA; aq0.u[0] = cQ[0].x; aq0.u[1] = cQ[0].y; aq0.u[2] = cQ[1].x; aq0.u[3] = cQ[1].y;
        aq1.u[0] = cQ[2].x; aq1.u[1] = cQ[2].y; aq1.u[2] = cQ[3].x; aq1.u[3] = cQ[3].y;
        aA.u[0] = cA.x; aA.u[1] = cA.y; aA.u[2] = 0u; aA.u[3] = 0u;
#pragma unroll
        for (int it = 0; it < 4; ++it) {
            Fr bS0, bS1, bV;
            bS0.u[0] = pack_bf16(S[0][it][0], S[0][it][1]); bS0.u[1] = pack_bf16(S[0][it][2], S[0][it][3]); bS0.u[2] = pack_bf16(S[1][it][0], S[1][it][1]); bS0.u[3] = pack_bf16(S[1][it][2], S[1][it][3]);
            bS1.u[0] = pack_bf16(S[2][it][0], S[2][it][1]); bS1.u[1] = pack_bf16(S[2][it][2], S[2][it][3]); bS1.u[2] = pack_bf16(S[3][it][0], S[3][it][1]); bS1.u[3] = pack_bf16(S[3][it][2], S[3][it][3]);
            bV.u[0] = cV[it].x; bV.u[1] = cV[it].y; bV.u[2] = 0u; bV.u[3] = 0u;
            f32x4 O = {0.f, 0.f, 0.f, 0.f};
            O = __builtin_amdgcn_mfma_f32_16x16x32_bf16(aq0.v, bS0.v, O, 0, 0, 0);
            O = __builtin_amdgcn_mfma_f32_16x16x32_bf16(aq1.v, bS1.v, O, 0, 0, 0);
            O = __builtin_amdgcn_mfma_f32_16x16x32_bf16(aA.v, bV.v, O, 0, 0, 0);
            bf16* od = hh + n0 * 1280 + 256 + d * 256 + h * 64 + 16 * it;
#pragma unroll
            for (int r = 0; r < 4; ++r) od[lo + (unsigned)(r * 1280)] = f2bf(O[r]);
#pragma unroll
            for (int jt = 0; jt < 4; ++jt) {
                Fr aK; aK.u[0] = cK[jt].x; aK.u[1] = cK[jt].y; aK.u[2] = 0u; aK.u[3] = 0u;
                f32x4 t = __builtin_amdgcn_mfma_f32_16x16x32_bf16(aK.v, bV.v, S[jt][it], 0, 0, 0);
                t[0] *= cE[jt].x; t[1] *= cE[jt].y; t[2] *= cE[jt].z; t[3] *= cE[jt].w;
                S[jt][it] = t;
            }
        }
    }
#undef HG_LOAD
}

DI void prep_rwkv_gpu(const Frame& F, int l) {
    const bf16* hz = WSP(bf16, OFF_HRWKV); bf16* r7 = WSP(bf16, OFF_R7); bf16* gb = WSP(bf16, OFF_G); float* bonus = WSP(float, OFF_BONUS);
    const float* mup = F.in[7] + l * 960; const float* mun = F.in[8] + l * 960;
    const float* w0 = F.in[9] + l * 512; const float* w2 = F.in[10] + (size_t)l * 2 * 32 * 256;
    const float* a0 = F.in[11] + l * 512; const float* a2 = F.in[12] + (size_t)l * 2 * 32 * 256;
    const float* g2 = F.in[13] + (size_t)l * 64 * 256;
    const size_t AS = (size_t)NTOK * 256;
    float* zs = (float*)F.smem;
    const int tid = F.tid, c = tid & 255, tg = tid >> 8;
    const float w0a = w0[c], w0b = w0[256 + c], a0a = a0[c], a0b = a0[256 + c];
    const float kkc = F.in[14][l * 256 + c], kac = F.in[15][l * 256 + c], rkc = F.in[16][l * 256 + c];
    for (int tile = blockIdx.x; tile < NTOK / 16; tile += F.nblk) {
        const int n0 = tile * 16;
        __syncthreads();
        const int tl = fresh_tid(F);
#pragma unroll
        for (int bt = 0; bt < 3; ++bt) {
            unsigned zc[5], zp[5], zn[5];
#pragma unroll
            for (int i = 0; i < 5; ++i) {
                const int e = tl + (bt * 5 + i) * NTH, t = e / 480, cc = (e % 480) * 2, n = n0 + t, s = n % SEQ;
                zc[i] = *reinterpret_cast<const unsigned*>(hz + (size_t)n * 1024 + cc);
                zp[i] = s > 0 ? *reinterpret_cast<const unsigned*>(hz + (size_t)(n - 1) * 1024 + cc) : 0u;
                zn[i] = s < SEQ - 1 ? *reinterpret_cast<const unsigned*>(hz + (size_t)(n + 1) * 1024 + cc) : 0u;
            }
#pragma unroll
            for (int i = 0; i < 5; ++i) {
                const int e = tl + (bt * 5 + i) * NTH, t = e / 480, cc = (e % 480) * 2;
                const float2 mp = *reinterpret_cast<const float2*>(mup + cc), mn = *reinterpret_cast<const float2*>(mun + cc);
                float v0 = bflo(zc[i]), v1 = bfhi(zc[i]);
                v0 = v0 + mp.x * (bflo(zp[i]) - v0) + mn.x * (bflo(zn[i]) - v0);
                v1 = v1 + mp.y * (bfhi(zp[i]) - v1) + mn.y * (bfhi(zn[i]) - v1);
                if (cc >= 768 && cc < 832) { v0 = fast_tanh(v0); v1 = fast_tanh(v1); }
                else if (cc >= 896) { v0 = fast_sigmoid(v0); v1 = fast_sigmoid(v1); }
                *reinterpret_cast<float2*>(zs + t * 960 + cc) = make_float2(v0, v1);
            }
        }
        __syncthreads();
        float wr0[8], wr1[8], ar0[8], ar1[8], gg[8];
#pragma unroll
        for (int t = 0; t < 8; ++t) { wr0[t] = w0a; wr1[t] = w0b; ar0[t] = a0a; ar1[t] = a0b; gg[t] = 0.f; }
        for (int q = 0; q < 32; q += 4) {
            float wa[4], wb[4], aa[4], ab[4];
#pragma unroll
            for (int u = 0; u < 4; ++u) { wa[u] = w2[(size_t)(q + u) * 256 + c]; wb[u] = w2[(size_t)(32 + q + u) * 256 + c]; aa[u] = a2[(size_t)(q + u) * 256 + c]; ab[u] = a2[(size_t)(32 + q + u) * 256 + c]; }
#pragma unroll
            for (int t = 0; t < 8; ++t) {
                const float* zr = zs + (tg * 8 + t) * 960;
                const float4 x0 = *reinterpret_cast<const float4*>(zr + 768 + q), x1 = *reinterpret_cast<const float4*>(zr + 800 + q);
                const float4 y0 = *reinterpret_cast<const float4*>(zr + 832 + q), y1 = *reinterpret_cast<const float4*>(zr + 864 + q);
                wr0[t] += x0.x * wa[0] + x0.y * wa[1] + x0.z * wa[2] + x0.w * wa[3];
                wr1[t] += x1.x * wb[0] + x1.y * wb[1] + x1.z * wb[2] + x1.w * wb[3];
                ar0[t] += y0.x * aa[0] + y0.y * aa[1] + y0.z * aa[2] + y0.w * aa[3];
                ar1[t] += y1.x * ab[0] + y1.y * ab[1] + y1.z * ab[2] + y1.w * ab[3];
            }
        }
        for (int q = 0; q < 64; q += 4) {
            float ga[4];
#pragma unroll
            for (int u = 0; u < 4; ++u) ga[u] = g2[(size_t)(q + u) * 256 + c];
#pragma unroll
            for (int t = 0; t < 8; ++t) {
                const float4 x = *reinterpret_cast<const float4*>(zs + (tg * 8 + t) * 960 + 896 + q);
                gg[t] += x.x * ga[0] + x.y * ga[1] + x.z * ga[2] + x.w * ga[3];
            }
        }
#pragma unroll
        for (int t = 0; t < 8; ++t) {
            const int n = n0 + tg * 8 + t; const float* zr = zs + (tg * 8 + t) * 960;
            const float r = zr[c], k = zr[256 + c], v = zr[512 + c];
            const float dec0 = __expf(-DECAY_SCALE * fast_sigmoid(wr0[t])), dec1 = __expf(-DECAY_SCALE * fast_sigmoid(wr1[t]));
            const float A0 = fast_sigmoid(ar0[t]), A1 = fast_sigmoid(ar1[t]);
            const float kk = k * kkc;
            const float kd0 = k * (1.0f + (A0 - 1.0f) * kac), kd1 = k * (1.0f + (A1 - 1.0f) * kac);
            const float ss = grp_sum(F, kk * kk);
            const float bs = grp_sum(F, r * (kd0 + kd1) * rkc);
            const float kkn = kk * (1.0f / fmaxf(sqrtf(ss), 1e-12f));
            const size_t o = (size_t)n * 256 + c;
            r7[R_R * AS + o] = f2bf(r); r7[R_V * AS + o] = f2bf(v);
            r7[R_W0 * AS + o] = f2bf(dec0); r7[R_W1 * AS + o] = f2bf(dec1);
            r7[R_KD0 * AS + o] = f2bf(kd0); r7[R_KD1 * AS + o] = f2bf(kd1);
            r7[R_KK * AS + o] = f2bf(kkn); r7[R_AK0 * AS + o] = f2bf(A0 * kkn); r7[R_AK1 * AS + o] = f2bf(A1 * kkn);
            gb[o] = f2bf(gg[t]);
            if ((tid & 63) == 0) bonus[(size_t)n * 4 + (c >> 6)] = bs;
            asm volatile("" ::: "memory");
        }
    }
}
#endif

DI void phase_prep(const Frame& F, int l) {
#ifndef CPU_EMU
    prep_attn_gpu(F, l); prep_rwkv_gpu(F, l); prep_hgrn_gpu(F, l);
#else
    {
        bf16* hatt = WSP(bf16, OFF_HATT); bf16* vt = WSP(bf16, OFF_VTATT);
        const float* qn = F.in[5] + l * 64; const float* kn = F.in[6] + l * 64;
        const int nitem = NTOK * 6;
        for (int it = ggrp(F); it < nitem; it += ngrp(F)) {
            const int n = it / 6, hh = it % 6;
            const int s = n % SEQ;
            bf16* p = hatt + (size_t)n * 512 + hh * 64;
            const float* gn = hh < 4 ? qn : kn;
            float v[PER64]; float ss = 0.f;
            for (int i = 0; i < PER64; ++i) { int j = glane(F) + i * GRP; v[i] = bf2f(p[j]); ss += v[i] * v[i]; }
            ss = grp_sum(F, ss); const float rs = 1.0f / sqrtf(ss * (1.0f / 64.0f) + RMS_EPS);
            float o[PER64];
#ifdef CPU_EMU
            float nv[64]; for (int j = 0; j < 64; ++j) nv[j] = v[j] * rs * gn[j];
#endif
            for (int i = 0; i < PER64; ++i) {
                int j = glane(F) + i * GRP;
                const int half = j >> 5, w = j & 31, f = w & 15, second = w >> 4;
                const float pos = half == 0 ? (float)(s / GRIDW) : (float)(s % GRIDW);
                const float ang = pos * rope_inv(2 * f, 32);
                const float cs = cosf(ang), sn = sinf(ang);
                const float mine = v[i] * rs * gn[j];
                const int jp = second ? j - 16 : j + 16;
#ifdef CPU_EMU
                const float partner = nv[jp];
#else
                const float partner = shfl_idx(F, v[0], jp) * rs * gn[jp];
#endif
                o[i] = second ? (partner * sn + mine * cs) : (mine * cs - partner * sn);
            }
            for (int i = 0; i < PER64; ++i) { int j = glane(F) + i * GRP; p[j] = f2bf(o[i]); }
        }
        for (size_t i = gtid_(F); i < (size_t)NTOK * 128; i += gthreads(F)) {
            const int n = (int)(i / 128), c = (int)(i % 128), b = n / SEQ, s = n % SEQ;
            vt[((size_t)b * 128 + c) * SEQ + s] = hatt[(size_t)n * 512 + 384 + c];
        }
    }
    {
        bf16* hm = WSP(bf16, OFF_HMLA); bf16* kr = WSP(bf16, OFF_KROPE);
        const float* qn = F.in[21] + l * 192; const float* kvn = F.in[22] + l * 128;
        for (int it = ggrp(F); it < NTOK * 2; it += ngrp(F)) {
            const int n = it >> 1, which = it & 1;
            bf16* p = hm + (size_t)n * 512 + (which ? 256 : 0);
            const int len = which ? 128 : 192; const float* gn = which ? kvn : qn;
            float ss = 0.f;
            for (int j = glane(F); j < len; j += GRP) { float x = bf2f(p[j]); ss += x * x; }
            ss = grp_sum(F, ss); const float rs = 1.0f / sqrtf(ss / (float)len + RMS_EPS);
            for (int j = glane(F); j < len; j += GRP) p[j] = f2bf(bf2f(p[j]) * rs * gn[j]);
        }
        for (int i = gtid_(F); i < NTOK * 16; i += gthreads(F)) {
            const int n = i >> 4, m = i & 15, s = n % SEQ;
            const bf16* src = hm + (size_t)n * 512 + 192;
            const int i1 = (m < 8 ? m : 16 + (m - 8)), i2 = i1 + 8;
            const float x1 = bf2f(src[i1]), x2 = bf2f(src[i2]);
            const float pos = m < 8 ? (float)(s / GRIDW) : (float)(s % GRIDW);
            const float ang = pos * rope_inv(2 * (m & 7), 16);
            const float cs = cosf(ang), sn = sinf(ang);
            kr[(size_t)n * 32 + 2 * m] = f2bf(x1 * cs - x2 * sn);
            kr[(size_t)n * 32 + 2 * m + 1] = f2bf(x1 * sn + x2 * cs);
        }
    }
#ifdef CPU_EMU
    {
        const bf16* hz = WSP(bf16, OFF_HRWKV); bf16* r7 = WSP(bf16, OFF_R7); bf16* gb = WSP(bf16, OFF_G); float* bonus = WSP(float, OFF_BONUS);
        const float* mup = F.in[7] + l * 960; const float* mun = F.in[8] + l * 960;
        const float* w0 = F.in[9] + l * 512; const float* w2 = F.in[10] + (size_t)l * 2 * 32 * 256;
        const float* a0 = F.in[11] + l * 512; const float* a2 = F.in[12] + (size_t)l * 2 * 32 * 256;
        const float* g2 = F.in[13] + (size_t)l * 64 * 256;
        const float* k_k = F.in[14] + l * 256; const float* k_a = F.in[15] + l * 256; const float* r_k = F.in[16] + l * 256;
        const size_t AS = (size_t)NTOK * 256;
        for (int it = ggrp(F); it < NTOK * 4; it += ngrp(F)) {
            const int n = it >> 2, h = it & 3, s = n % SEQ;
            const bf16* z = hz + (size_t)n * 1024;
            const bool hp = s > 0, hn = s < SEQ - 1;
            auto shifted = [&](int c) -> float {
                const float zc = bf2f(z[c]);
                const float zp = hp ? bf2f(z[c - 1024]) : 0.f, zn = hn ? bf2f(z[c + 1024]) : 0.f;
                return zc + mup[c] * (zp - zc) + mun[c] * (zn - zc);
            };
            float kkv[PER64], rr[PER64], kd0[PER64], kd1[PER64], aa0[PER64], aa1[PER64];
            float ss = 0.f, bs = 0.f;
            for (int i = 0; i < PER64; ++i) {
                const int j = glane(F) + i * GRP, c = h * 64 + j;
                const float r = shifted(c), k = shifted(256 + c), v = shifted(512 + c);
                float wr0 = w0[c], wr1 = w0[256 + c], ar0 = a0[c], ar1 = a0[256 + c], g = 0.f;
                for (int q = 0; q < 32; ++q) {
                    wr0 += tanhf(shifted(768 + q)) * w2[(size_t)q * 256 + c];
                    wr1 += tanhf(shifted(800 + q)) * w2[(size_t)(32 + q) * 256 + c];
                    ar0 += shifted(832 + q) * a2[(size_t)q * 256 + c];
                    ar1 += shifted(864 + q) * a2[(size_t)(32 + q) * 256 + c];
                }
                for (int q = 0; q < 64; ++q) g += sigmoidf_(shifted(896 + q)) * g2[(size_t)q * 256 + c];
                const float dec0 = expf(-DECAY_SCALE * sigmoidf_(wr0)), dec1 = expf(-DECAY_SCALE * sigmoidf_(wr1));
                const float A0 = sigmoidf_(ar0), A1 = sigmoidf_(ar1);
                const float kk = k * k_k[c];
                kkv[i] = kk; ss += kk * kk; rr[i] = r; aa0[i] = A0; aa1[i] = A1;
                kd0[i] = k * (1.0f + (A0 - 1.0f) * k_a[c]); kd1[i] = k * (1.0f + (A1 - 1.0f) * k_a[c]);
                bs += r * (kd0[i] + kd1[i]) * r_k[c];
                const size_t o = (size_t)n * 256 + c;
                r7[R_R * AS + o] = f2bf(r); r7[R_V * AS + o] = f2bf(v);
                r7[R_W0 * AS + o] = f2bf(dec0); r7[R_W1 * AS + o] = f2bf(dec1);
                r7[R_KD0 * AS + o] = f2bf(kd0[i]); r7[R_KD1 * AS + o] = f2bf(kd1[i]);
                gb[o] = f2bf(g);
            }
            ss = grp_sum(F, ss); bs = grp_sum(F, bs);
            const float inv = 1.0f / fmaxf(sqrtf(ss), 1e-12f);
            for (int i = 0; i < PER64; ++i) {
                const int j = glane(F) + i * GRP, c = h * 64 + j; const size_t o = (size_t)n * 256 + c;
                const float kk = kkv[i] * inv;
                r7[R_KK * AS + o] = f2bf(kk); r7[R_AK0 * AS + o] = f2bf(aa0[i] * kk); r7[R_AK1 * AS + o] = f2bf(aa1[i] * kk);
            }
            if (glane(F) == 0) bonus[(size_t)n * 4 + h] = bs;
        }
    }
#else
    prep_rwkv_gpu(F, l);
#endif
    {
        bf16* hh = WSP(bf16, OFF_HHGRN);
        const float* lg = F.in[19];
        for (size_t i = gtid_(F); i < (size_t)NTOK * 768; i += gthreads(F)) {
            const int n = (int)(i / 768), c = (int)(i % 768);
            bf16* p = hh + (size_t)n * 1280 + c;
            const float x = bf2f(*p);
            if (c < 256) { *p = f2bf(siluf_(x)); }
            else {
                const int d = c & 255;
                float lb = 0.f;
                if (l == 1) { const float a = lg[d], b = lg[256 + d]; const float m = fmaxf(a, b); const float ea = expf(a - m), eb = expf(b - m); lb = eb / (ea + eb); }
                *p = f2bf((1.0f - lb) * sigmoidf_(-x));
            }
        }
    }
#endif
}

struct EpiQMla {
    bf16* q; int row0, pn;
    DI void operator()(int r, int c, float a, float b, float cc, float d) const {
        const int row = row0 + r, col = pn * 256 + c;
        if (col >= 384) return;
        const int w = col % 96;
        if (w >= 64) {
            const int s = row % SEQ;
#pragma unroll
            for (int t = 0; t < 2; ++t) {
                const int m = ((w - 64) >> 1) + t;
                const float pos = m < 8 ? (float)(s / GRIDW) : (float)(s % GRIDW);
                const float ang = pos * rope_inv(2 * (m & 7), 16);
                const float cs = cosf(ang), sn = sinf(ang);
                float& x1 = t ? cc : a; float& x2 = t ? d : b;
                const float y1 = x1 * cs - x2 * sn, y2 = x1 * sn + x2 * cs; x1 = y1; x2 = y2;
            }
        }
        st_bf16x4(q + (size_t)row * 384 + col, a, b, cc, d);
    }
};
struct EpiKVMla {
    bf16* kn; bf16* vt; int row0, pn;
    DI void operator()(int r, int c, float a, float b, float cc, float d) const {
        const int row = row0 + r, col = pn * 256 + c, h = col >> 7, w = col & 127;
        if (w < 64) st_bf16x4(kn + (size_t)row * 256 + h * 64 + w, a, b, cc, d);
        else { const int bb = row / SEQ, s = row % SEQ; bf16* p = vt + ((size_t)bb * 256 + h * 64 + (w - 64)) * SEQ + s;
            p[0] = f2bf(a); p[SEQ] = f2bf(b); p[2 * SEQ] = f2bf(cc); p[3 * SEQ] = f2bf(d); }
    }
};
DI void phase_mlaup(const Frame& F) {
    const bf16* hm = WSP(bf16, OFF_HMLA); const char* wts = (const char*)WSP(bf16, OFF_WTS);
    const int nM = (NTOK + 255) / 256;
    for (int u = blockIdx.x; u < nM * 4; u += F.nblk) {
        const int pm = u >> 2, j = u & 3;
#ifdef CPU_EMU
        const int mr = min(256, NTOK - pm * 256);
#define MR , mr
#else
#define MR
#endif
        if (j < 2) { EpiQMla E{WSP(bf16, OFF_QMLA), pm * 256, j};
            gemm_unit(F, hm, 512, nullptr, pm * 256, (const bf16*)(wts + W_UQ_T), 256, j * 256, 256, E MR); }
        else { EpiKVMla E{WSP(bf16, OFF_KNOPE), WSP(bf16, OFF_VTMLA), pm * 256, j - 2};
            gemm_unit(F, hm + 256, 512, nullptr, pm * 256, (const bf16*)(wts + W_UKV_T), 256, (j - 2) * 256, 256, E MR); }
    }
}

struct AttnDesc {
    const bf16* q; int q_stride;
    int q_hstride;
    const bf16* k; int k_stride; int k_hstride;
    const bf16* k2; int k2_stride;
    int dk_main;
    const bf16* vt;
    bf16* o; int o_stride; int o_hstride;
    int H, HKV, SQ, SK;
    float scale;
};

#ifdef CPU_EMU
template <int DK, int DV>
void attn_phase(const Frame& F, const AttnDesc& A) {
    const int G = A.H / A.HKV;
    float* sc = (float*)malloc(sizeof(float) * A.SK);
    for (int b = 0; b < BATCH; ++b) for (int h = 0; h < A.H; ++h) for (int s = 0; s < A.SQ; ++s) {
        const int kv = h / G;
        const bf16* q = A.q + (size_t)(b * A.SQ + s) * A.q_stride + h * A.q_hstride;
        float mx = -1e30f;
        for (int key = 0; key < A.SK; ++key) {
            const bf16* kp = A.k + (size_t)(b * A.SK + key) * A.k_stride + kv * A.k_hstride;
            double acc = 0;
            for (int d = 0; d < DK; ++d) {
                float kvl = d < A.dk_main ? bf2f(kp[d]) : bf2f(A.k2[(size_t)(b * A.SK + key) * A.k2_stride + d - A.dk_main]);
                acc += (double)bf2f(q[d]) * kvl;
            }
            sc[key] = (float)acc * A.scale; mx = fmaxf(mx, sc[key]);
        }
        double sum = 0; for (int key = 0; key < A.SK; ++key) { sc[key] = expf(sc[key] - mx); sum += sc[key]; }
        for (int dv = 0; dv < DV; ++dv) {
            const bf16* vp = A.vt + ((size_t)(b * A.HKV + kv) * DV + dv) * A.SK;
            double acc = 0; for (int key = 0; key < A.SK; ++key) acc += (double)bf2f(f2bf(sc[key])) * bf2f(vp[key]);
            A.o[(size_t)(b * A.SQ + s) * A.o_stride + h * A.o_hstride + dv] = f2bf((float)(acc / sum));
        }
    }
    free(sc);
}
#else
DI int crow16(int reg, int h) { return (reg & 3) + 8 * (reg >> 2) + 4 * h; }
template <int DK, int DV, int DVT>
DI void attn_unit(const Frame& F, const AttnDesc& A, int u) {
    constexpr int KP = DK + 8;
    constexpr int VP = 64 + 8;
    constexpr int NPASS = DV / DVT;
    bf16* Ks = (bf16*)F.smem;
    bf16* Vs = Ks + 64 * KP;
    const int tid = F.tid, wave = tid >> 6, lane = tid & 63, r = lane & 31, hh = lane >> 5;
    const int G = A.H / A.HKV;
    const int nqb = A.SQ / 256;
    const float sl2 = A.scale * 1.4426950408889634f;
    {
        int t = u; const int pass = t % NPASS; t /= NPASS; const int qb = t % nqb; t /= nqb; const int h = t % A.H; const int b = t / A.H;
        const int kv = h / G;
        const int q0 = qb * 256 + wave * 32;
        bf16x8 qf[DK / 16];
        { const bf16* qp = A.q + (size_t)(b * A.SQ + q0 + r) * A.q_stride + h * A.q_hstride + 8 * hh;
#pragma unroll
          for (int ks = 0; ks < DK / 16; ++ks) qf[ks] = *reinterpret_cast<const bf16x8*>(qp + 16 * ks); }
        f32x16 oacc[DVT / 32];
#pragma unroll
        for (int i = 0; i < DVT / 32; ++i)
#pragma unroll
            for (int j = 0; j < 16; ++j) oacc[i][j] = 0.f;
        float mrun = -INFINITY, lrun = 0.f;
        constexpr int NKC = (64 * (DK / 8) + 511) / 512, NVC = (DVT * 8 + 511) / 512;
        uint4 kr0, kr1, kr2, kr3, vr0, vr1;
        kr0 = kr1 = kr2 = kr3 = vr0 = vr1 = make_uint4(0u, 0u, 0u, 0u);
#define ATT_FK(kt_, i_, reg_) do { if ((i_) < NKC) { int c_ = tid + (i_) * 512; if (c_ >= 64 * (DK / 8)) c_ = 64 * (DK / 8) - 1; \
            const int key_ = c_ / (DK / 8), d8_ = (c_ % (DK / 8)) * 8; const size_t krow_ = (size_t)(b * A.SK + (kt_) * 64 + key_); \
            const bf16* kp_ = (d8_ < A.dk_main) ? (A.k + krow_ * A.k_stride + kv * A.k_hstride + d8_) : (A.k2 + krow_ * A.k2_stride + (d8_ - A.dk_main)); \
            reg_ = *reinterpret_cast<const uint4*>(kp_); } } while (0)
#define ATT_FV(kt_, i_, reg_) do { if ((i_) < NVC) { int c_ = tid + (i_) * 512; if (c_ >= DVT * 8) c_ = DVT * 8 - 1; \
            const int dv_ = c_ >> 3, k8_ = (c_ & 7) * 8; \
            reg_ = *reinterpret_cast<const uint4*>(A.vt + ((size_t)(b * A.HKV + kv) * DV + pass * DVT + dv_) * A.SK + (kt_) * 64 + k8_); } } while (0)
#define ATT_FETCH(kt_) do { ATT_FK(kt_, 0, kr0); ATT_FK(kt_, 1, kr1); ATT_FK(kt_, 2, kr2); ATT_FK(kt_, 3, kr3); ATT_FV(kt_, 0, vr0); ATT_FV(kt_, 1, vr1); } while (0)
#define ATT_SK(i_, reg_) do { if ((i_) < NKC) { const int c_ = tid + (i_) * 512; if (c_ < 64 * (DK / 8)) { \
            const int key_ = c_ / (DK / 8), d8_ = (c_ % (DK / 8)) * 8; *reinterpret_cast<uint4*>(Ks + key_ * KP + d8_) = reg_; } } } while (0)
#define ATT_SV(i_, reg_) do { if ((i_) < NVC) { const int c_ = tid + (i_) * 512; if (c_ < DVT * 8) { \
            const int dv_ = c_ >> 3, k8_ = (c_ & 7) * 8; *reinterpret_cast<uint4*>(Vs + dv_ * VP + k8_) = reg_; } } } while (0)
#define ATT_STORE() do { ATT_SK(0, kr0); ATT_SK(1, kr1); ATT_SK(2, kr2); ATT_SK(3, kr3); ATT_SV(0, vr0); ATT_SV(1, vr1); } while (0)
        constexpr bool PREF = DK <= 96;
        if (PREF) ATT_FETCH(0);
        for (int kt = 0; kt < A.SK / 64; ++kt) {
            __syncthreads();
            if (PREF) { ATT_STORE(); }
            else {
                for (int c = tid; c < 64 * (DK / 8); c += 512) {
                    const int key = c / (DK / 8), d8 = (c % (DK / 8)) * 8;
                    const size_t krow = (size_t)(b * A.SK + kt * 64 + key);
                    uint4 v;
                    if (d8 < A.dk_main) v = *reinterpret_cast<const uint4*>(A.k + krow * A.k_stride + kv * A.k_hstride + d8);
                    else v = *reinterpret_cast<const uint4*>(A.k2 + krow * A.k2_stride + (d8 - A.dk_main));
                    *reinterpret_cast<uint4*>(Ks + key * KP + d8) = v;
                }
                for (int c = tid; c < DVT * 8; c += 512) {
                    const int dv = c >> 3, k8 = (c & 7) * 8;
                    const uint4 v = *reinterpret_cast<const uint4*>(A.vt + ((size_t)(b * A.HKV + kv) * DV + pass * DVT + dv) * A.SK + kt * 64 + k8);
                    *reinterpret_cast<uint4*>(Vs + dv * VP + k8) = v;
                }
            }
            __syncthreads();
            if (PREF && kt + 1 < A.SK / 64) ATT_FETCH(kt + 1);
            f32x16 sacc[2];
#pragma unroll
            for (int kb = 0; kb < 2; ++kb) {
#pragma unroll
                for (int j = 0; j < 16; ++j) sacc[kb][j] = 0.f;
#pragma unroll
                for (int ks = 0; ks < DK / 16; ++ks) {
                    const bf16x8 kf = *reinterpret_cast<const bf16x8*>(Ks + (kb * 32 + r) * KP + 16 * ks + 8 * hh);
                    sacc[kb] = __builtin_amdgcn_mfma_f32_32x32x16_bf16(kf, qf[ks], sacc[kb], 0, 0, 0);
                }
            }
            float mx = -INFINITY;
#pragma unroll
            for (int kb = 0; kb < 2; ++kb)
#pragma unroll
                for (int j = 0; j < 16; ++j) mx = fmaxf(mx, sacc[kb][j]);
            mx = fmaxf(mx, shfl_xor(F, mx, 32));
            const float mnew = fmaxf(mrun, mx * sl2);
            const float alpha = exp2f(mrun - mnew);
            mrun = mnew;
            float psum = 0.f;
#pragma unroll
            for (int kb = 0; kb < 2; ++kb)
#pragma unroll
                for (int j = 0; j < 16; ++j) { const float p = exp2f(sacc[kb][j] * sl2 - mnew); sacc[kb][j] = p; psum += p; }
            lrun = lrun * alpha + psum;
#pragma unroll
            for (int i = 0; i < DVT / 32; ++i)
#pragma unroll
                for (int j = 0; j < 16; ++j) oacc[i][j] *= alpha;
#pragma unroll
            for (int kb = 0; kb < 2; ++kb)
#pragma unroll
                for (int s2 = 0; s2 < 2; ++s2) {
                    union { bf16x8 v; unsigned u[4]; } pf;
#pragma unroll
                    for (int j = 0; j < 4; ++j) pf.u[j] = pack_bf16(sacc[kb][8 * s2 + 2 * j], sacc[kb][8 * s2 + 2 * j + 1]);
#pragma unroll
                    for (int i = 0; i < DVT / 32; ++i) {
                        const bf16* vp = Vs + (i * 32 + r) * VP + kb * 32 + 16 * s2 + 4 * hh;
                        union { bf16x8 v; bf16x4 h2[2]; } vf;
                        vf.h2[0] = *reinterpret_cast<const bf16x4*>(vp);
                        vf.h2[1] = *reinterpret_cast<const bf16x4*>(vp + 8);
                        oacc[i] = __builtin_amdgcn_mfma_f32_32x32x16_bf16(vf.v, pf.v, oacc[i], 0, 0, 0);
                    }
                }
        }
        lrun += shfl_xor(F, lrun, 32);
        const float inv = 1.0f / lrun;
        bf16* op = A.o + (size_t)(b * A.SQ + q0 + r) * A.o_stride + h * A.o_hstride + pass * DVT;
#pragma unroll
        for (int i = 0; i < DVT / 32; ++i)
#pragma unroll
            for (int g = 0; g < 4; ++g)
                st_bf16x4(op + i * 32 + 8 * g + 4 * hh, oacc[i][4 * g] * inv, oacc[i][4 * g + 1] * inv, oacc[i][4 * g + 2] * inv, oacc[i][4 * g + 3] * inv);
    }
}
#endif

#undef ATT_FETCH
#undef ATT_STORE
#undef ATT_FK
#undef ATT_FV
#undef ATT_SK
#undef ATT_SV
#ifndef CPU_EMU
template <int DK, int DV, int DVT>
DI int attn_nunit(const AttnDesc& A) { return BATCH * A.H * (A.SQ / 256) * (DV / DVT); }
template <int DK, int DV, int DVT>
DI void attn_phase(const Frame& F, const AttnDesc& A) {
    const int nunit = attn_nunit<DK, DV, DVT>(A);
    for (int u = blockIdx.x; u < nunit; u += F.nblk) attn_unit<DK, DV, DVT>(F, A, u);
}
#endif
DI AttnDesc desc_gqa(const Frame& F) {
    AttnDesc A; A.q = WSP(bf16, OFF_HATT); A.q_stride = 512; A.q_hstride = 64;
    A.k = WSP(bf16, OFF_HATT) + 256; A.k_stride = 512; A.k_hstride = 64; A.k2 = nullptr; A.k2_stride = 0; A.dk_main = 64;
    A.vt = WSP(bf16, OFF_VTATT); A.o = WSP(bf16, OFF_YCAT); A.o_stride = 1024; A.o_hstride = 64;
    A.H = 4; A.HKV = 2; A.SQ = SEQ; A.SK = SEQ; A.scale = 0.125f; return A;
}
DI AttnDesc desc_mla(const Frame& F) {
    AttnDesc A; A.q = WSP(bf16, OFF_QMLA); A.q_stride = 384; A.q_hstride = 96;
    A.k = WSP(bf16, OFF_KNOPE); A.k_stride = 256; A.k_hstride = 64; A.k2 = WSP(bf16, OFF_KROPE); A.k2_stride = 32; A.dk_main = 64;
    A.vt = WSP(bf16, OFF_VTMLA); A.o = WSP(bf16, OFF_YCAT) + 768; A.o_stride = 1024; A.o_hstride = 64;
    A.H = 4; A.HKV = 4; A.SQ = SEQ; A.SK = SEQ; A.scale = 0.10206207261596575f; return A;
}
DI AttnDesc desc_mem(const Frame& F) {
    AttnDesc A; A.q = WSP(bf16, OFF_QMEM); A.q_stride = 1024; A.q_hstride = 256;
    A.k = WSP(bf16, OFF_KMEM); A.k_stride = 1024; A.k_hstride = 256; A.k2 = nullptr; A.k2_stride = 0; A.dk_main = 256;
    A.vt = WSP(bf16, OFF_VTMEM); A.o = WSP(bf16, OFF_OMEM); A.o_stride = 1024; A.o_hstride = 256;
    A.H = 4; A.HKV = 4; A.SQ = SEQ; A.SK = MEMT; A.scale = 0.0625f; return A;
}

#ifndef CPU_EMU
typedef float f32p __attribute__((ext_vector_type(2)));
DI f32p allsum16p(f32p x) { x.x = allsum16(x.x); x.y = allsum16(x.y); return x; }
template <int KIND>
DI void scan_chain(const Frame& F, int chain) {
    constexpr int T = 32;
    constexpr int NARR = KIND == 0 ? 6 : 3;
    constexpr int STEPB = NARR * 256;
    constexpr int NPIECE = T * NARR * 8;
    constexpr int PPT = (NPIECE + NTH - 1) / NTH;
    const int d = chain / (BATCH * 4), b = (chain / 4) % BATCH, h = chain % 4;
    const int tid = F.tid, wave = tid >> 6, lane = tid & 63, rg = lane >> 4, cg = lane & 15;
    unsigned char* buf0 = F.smem; unsigned char* buf1 = F.smem + T * STEPB;
    unsigned char* ybuf = F.smem + 2 * T * STEPB;
    const size_t AS = (size_t)NTOK * 256;
    bf16* r7 = WSP(bf16, OFF_R7); bf16* hh = WSP(bf16, OFF_HHGRN);
#define PIECE_PTR(t0, p_) ([&]() -> const uint4* { const int pc = (p_) < NPIECE ? (p_) : NPIECE - 1; \
        const int st = pc / (NARR * 8), rem = pc % (NARR * 8), arr = rem >> 3, part = rem & 7; \
        const int tt = (t0) + st, ss = d ? SEQ - 1 - tt : tt; const size_t nn = (size_t)b * SEQ + ss; \
        const bf16* base; \
        if (KIND == 0) { const int aid = arr == 0 ? R_KK : arr == 1 ? (d ? R_W1 : R_W0) : arr == 2 ? (d ? R_AK1 : R_AK0) : arr == 3 ? (d ? R_KD1 : R_KD0) : arr == 4 ? R_R : R_V; \
            base = r7 + aid * AS + nn * 256 + h * 64; } \
        else { const int off = arr == 0 ? 256 + d * 256 : arr == 1 ? 0 : 768; base = hh + nn * 1280 + off + h * 64; } \
        return reinterpret_cast<const uint4*>(base + part * 8); }())
#define PUT_PIECE(dst, p_, v_) do { float4 a_, b_; a_.x = bflo((v_).x); a_.y = bfhi((v_).x); a_.z = bflo((v_).y); a_.w = bfhi((v_).y); \
        b_.x = bflo((v_).z); b_.y = bfhi((v_).z); b_.z = bflo((v_).w); b_.w = bfhi((v_).w); \
        *reinterpret_cast<float4*>((dst) + (p_) * 32) = a_; *reinterpret_cast<float4*>((dst) + (p_) * 32 + 16) = b_; } while (0)
#define STORE_PRE(dst) do { PUT_PIECE(dst, tid, pre0); \
        if (tid + NTH < NPIECE) PUT_PIECE(dst, tid + NTH, pre1); \
        if (PPT > 2 && tid + 2 * NTH < NPIECE) PUT_PIECE(dst, tid + 2 * NTH, pre2); } while (0)
    uint4 pre0, pre1, pre2;
    pre0 = *PIECE_PTR(0, tid); pre1 = *PIECE_PTR(0, tid + NTH); pre2 = pre1;
    if (PPT > 2) pre2 = *PIECE_PTR(0, tid + 2 * NTH);
    __syncthreads();
    STORE_PRE(buf0);
    __syncthreads();
    f32p P[4];
#pragma unroll
    for (int c = 0; c < 4; ++c) P[c] = (f32p){0.f, 0.f};
    const int vofs = (wave * 8 + rg * 2) * 4;
    for (int ch = 0; ch < SEQ / T; ++ch) {
        const unsigned char* cur = (ch & 1) ? buf1 : buf0;
        if (ch + 1 < SEQ / T) {
            pre0 = *PIECE_PTR((ch + 1) * T, tid); pre1 = *PIECE_PTR((ch + 1) * T, tid + NTH);
            if (PPT > 2) pre2 = *PIECE_PTR((ch + 1) * T, tid + 2 * NTH);
        }
        float4 o0, o1, o2, o3, o4; f32p ov;
        { const unsigned char* sb = cur;
          o0 = *reinterpret_cast<const float4*>(sb + 0 * 256 + cg * 16); o1 = *reinterpret_cast<const float4*>(sb + 1 * 256 + cg * 16);
          if (KIND == 0) { o2 = *reinterpret_cast<const float4*>(sb + 2 * 256 + cg * 16); o3 = *reinterpret_cast<const float4*>(sb + 3 * 256 + cg * 16); o4 = *reinterpret_cast<const float4*>(sb + 4 * 256 + cg * 16); }
          ov = *reinterpret_cast<const f32p*>(sb + (NARR - 1) * 256 + vofs); }
        unsigned ykeep = 0u;
#pragma unroll 2
        for (int t = 0; t < T; ++t) {
            const float4 c0 = o0, c1 = o1, c2 = o2, c3 = o3, c4 = o4; const f32p v = ov;
            { const unsigned char* sb = cur + ((t + 1) & (T - 1)) * STEPB;
              o0 = *reinterpret_cast<const float4*>(sb + 0 * 256 + cg * 16); o1 = *reinterpret_cast<const float4*>(sb + 1 * 256 + cg * 16);
              if (KIND == 0) { o2 = *reinterpret_cast<const float4*>(sb + 2 * 256 + cg * 16); o3 = *reinterpret_cast<const float4*>(sb + 3 * 256 + cg * 16); o4 = *reinterpret_cast<const float4*>(sb + 4 * 256 + cg * 16); }
              ov = *reinterpret_cast<const f32p*>(sb + (NARR - 1) * 256 + vofs); }
            f32p y;
            if (KIND == 0) {
                f32p sa = P[0] * c0.x + P[1] * c0.y + P[2] * c0.z + P[3] * c0.w;
                sa = allsum16p(sa);
                P[0] = P[0] * c1.x - sa * c2.x + v * c3.x;
                P[1] = P[1] * c1.y - sa * c2.y + v * c3.y;
                P[2] = P[2] * c1.z - sa * c2.z + v * c3.z;
                P[3] = P[3] * c1.w - sa * c2.w + v * c3.w;
                y = P[0] * c4.x + P[1] * c4.y + P[2] * c4.z + P[3] * c4.w;
            } else {
                P[0] += (v - P[0]) * c0.x; P[1] += (v - P[1]) * c0.y; P[2] += (v - P[2]) * c0.z; P[3] += (v - P[3]) * c0.w;
                y = P[0] * c1.x + P[1] * c1.y + P[2] * c1.z + P[3] * c1.w;
            }
            y = allsum16p(y);
            const unsigned yp = pack_bf16(y.x, y.y);
            ykeep = ((t & 15) == cg) ? yp : ykeep;
            if ((t & 15) == 15) *reinterpret_cast<unsigned*>(ybuf + ((t & ~15) + cg) * 128 + (wave * 8 + rg * 2) * 2) = ykeep;
        }
        asm volatile("s_waitcnt lgkmcnt(0)" ::: "memory");
        __builtin_amdgcn_wave_barrier();
        if (lane < T) {
            const int t = ch * T + lane, s = d ? SEQ - 1 - t : t; const size_t n = (size_t)b * SEQ + s;
            const uint4 yv = *reinterpret_cast<const uint4*>(ybuf + lane * 128 + wave * 16);
            bf16* dst = KIND == 0 ? r7 + (d ? R_W1 : R_W0) * AS + n * 256 + h * 64 + wave * 8 : hh + n * 1280 + 256 + d * 256 + h * 64 + wave * 8;
            *reinterpret_cast<uint4*>(dst) = yv;
        }
        if (ch + 1 < SEQ / T) {
            unsigned char* nxt = (ch & 1) ? buf0 : buf1;
            STORE_PRE(nxt);
        }
        __syncthreads();
    }
#undef PIECE_PTR
#undef STORE_PRE
#undef PUT_PIECE
}
DI void phase_scans(const Frame& F) {
    const int nchain = 2 * BATCH * 4;
    for (int u = blockIdx.x; u < nchain; u += F.nblk) scan_chain<0>(F, u);
    int hb = (int)blockIdx.x - (nchain % F.nblk); if (hb < 0) hb += F.nblk;
    for (int g = hb; g < nchain / 8; g += F.nblk) scan_hgrn_chunk(F, g * 8 + (F.tid >> 6));
}
#else
DI void phase_scans(const Frame& F) {
    bf16* r7 = WSP(bf16, OFF_R7); const size_t AS = (size_t)NTOK * 256;
    bf16* hh = WSP(bf16, OFF_HHGRN);
    const int nitem = 2 * BATCH * 4 * 64 * 2;
    for (int it = wave_item_index(F); it < nitem; it += gthreads(F)) {
        const int kind = it / (2 * BATCH * 4 * 64);
        int c = (it % (2 * BATCH * 4 * 64)) / 64; const int i = it % 64;
        const int d = c / (BATCH * 4); c %= BATCH * 4; const int b = c / 4, h = c % 4;
        float S[64];
#pragma unroll
        for (int j = 0; j < 64; ++j) S[j] = 0.f;
        if (kind == 0) {
            const bf16* pr = r7 + R_R * AS, *pv = r7 + R_V * AS, *pkk = r7 + R_KK * AS;
            bf16* pw = r7 + (d ? R_W1 : R_W0) * AS; const bf16* pkd = r7 + (d ? R_KD1 : R_KD0) * AS, *pak = r7 + (d ? R_AK1 : R_AK0) * AS;
            for (int t = 0; t < SEQ; ++t) {
                const int s = d ? SEQ - 1 - t : t;
                const size_t o = ((size_t)(b * SEQ + s)) * 256 + h * 64;
                const float v = bf2f(pv[o + i]);
                float sa = 0.f;
#pragma unroll
                for (int j = 0; j < 64; ++j) sa += S[j] * bf2f(pkk[o + j]);
                float y = 0.f;
#pragma unroll
                for (int j = 0; j < 64; ++j) {
                    S[j] = S[j] * bf2f(pw[o + j]) - sa * bf2f(pak[o + j]) + v * bf2f(pkd[o + j]);
                    y += S[j] * bf2f(pr[o + j]);
                }
#ifndef CPU_EMU
                __builtin_amdgcn_wave_barrier();
#endif
#ifdef CPU_EMU
                WSP(bf16, OFF_EMU_SCAN)[(size_t)d * AS + (size_t)(b * SEQ + s) * 256 + h * 64 + i] = f2bf(y);
#else
                pw[o + i] = f2bf(y);
#endif
            }
        } else {
            const bf16* pq = hh; bf16* pk = hh + 256 + d * 256; const bf16* pi = hh + 768;
            for (int t = 0; t < SEQ; ++t) {
                const int s = d ? SEQ - 1 - t : t;
                const size_t o = ((size_t)(b * SEQ + s)) * 1280 + h * 64;
                const float v = bf2f(pi[o + i]);
                float acc = 0.f;
#pragma unroll
                for (int j = 0; j < 64; ++j) {
                    const float k = bf2f(pk[o + j]);
                    S[j] = S[j] + k * (v - S[j]);
                    acc += S[j] * bf2f(pq[o + j]);
                }
#ifndef CPU_EMU
                __builtin_amdgcn_wave_barrier();
#endif
#ifdef CPU_EMU
                WSP(bf16, OFF_EMU_SCAN)[(size_t)(2 + d) * AS + (size_t)(b * SEQ + s) * 256 + h * 64 + i] = f2bf(acc);
#else
                pk[o + i] = f2bf(acc);
#endif
            }
        }
    }
}

#endif

#ifndef CPU_EMU
DI void phase_fin_gpu(const Frame& F, int l) {
    const bf16* r7 = WSP(bf16, OFF_R7); const size_t AS = (size_t)NTOK * 256;
    const bf16* gb = WSP(bf16, OFF_G); const float* bonus = WSP(float, OFF_BONUS);
    const bf16* hh = WSP(bf16, OFF_HHGRN); bf16* ycat = WSP(bf16, OFF_YCAT);
    float* par = (float*)F.smem;
    __syncthreads();
    for (int i = F.tid; i < 768; i += NTH) par[i] = i < 256 ? F.in[17][l * 256 + i] : i < 512 ? F.in[18][l * 256 + i - 256] : F.in[20][l * 256 + i - 512];
    __syncthreads();
    for (int it = blockIdx.x * NTH + fresh_tid(F); it < NTOK * 8; it += gthreads(F)) {
        const int n = it >> 3, kind = (it >> 2) & 1, h = it & 3;
        const uint4* pa; const uint4* pb;
        if (kind == 0) { pa = reinterpret_cast<const uint4*>(r7 + R_W0 * AS + (size_t)n * 256 + h * 64); pb = reinterpret_cast<const uint4*>(r7 + R_W1 * AS + (size_t)n * 256 + h * 64); }
        else { pa = reinterpret_cast<const uint4*>(hh + (size_t)n * 1280 + 256 + h * 64); pb = reinterpret_cast<const uint4*>(hh + (size_t)n * 1280 + 512 + h * 64); }
        float y[64];
#pragma unroll
        for (int i = 0; i < 8; ++i) { const uint4 a = pa[i], b = pb[i];
            y[8 * i] = bflo(a.x) + bflo(b.x); y[8 * i + 1] = bfhi(a.x) + bfhi(b.x); y[8 * i + 2] = bflo(a.y) + bflo(b.y); y[8 * i + 3] = bfhi(a.y) + bfhi(b.y);
            y[8 * i + 4] = bflo(a.z) + bflo(b.z); y[8 * i + 5] = bfhi(a.z) + bfhi(b.z); y[8 * i + 6] = bflo(a.w) + bflo(b.w); y[8 * i + 7] = bfhi(a.w) + bfhi(b.w); }
        uint4* po = reinterpret_cast<uint4*>(ycat + (size_t)n * 1024 + (kind ? 512 : 256) + h * 64);
        if (kind == 0) {
            float s1 = 0.f;
#pragma unroll
            for (int j = 0; j < 64; ++j) s1 += y[j];
            const float mu = s1 * (1.0f / 64.0f);
            float s2 = 0.f;
#pragma unroll
            for (int j = 0; j < 64; ++j) { const float d = y[j] - mu; s2 += d * d; }
            const float rs = 1.0f / sqrtf(s2 * (1.0f / 64.0f) + GN_EPS);
            const float bo = bonus[(size_t)n * 4 + h];
            const uint4* pv = reinterpret_cast<const uint4*>(r7 + R_V * AS + (size_t)n * 256 + h * 64);
            const uint4* pg = reinterpret_cast<const uint4*>(gb + (size_t)n * 256 + h * 64);
            const float* gg = par + h * 64; const float* gbias = par + 256 + h * 64;
#pragma unroll
            for (int i = 0; i < 8; ++i) { const uint4 vv = pv[i], g4 = pg[i];
                const float vf[8] = {bflo(vv.x), bfhi(vv.x), bflo(vv.y), bfhi(vv.y), bflo(vv.z), bfhi(vv.z), bflo(vv.w), bfhi(vv.w)};
                const float gf[8] = {bflo(g4.x), bfhi(g4.x), bflo(g4.y), bfhi(g4.y), bflo(g4.z), bfhi(g4.z), bflo(g4.w), bfhi(g4.w)};
                float o[8];
#pragma unroll
                for (int j = 0; j < 8; ++j) o[j] = ((y[8 * i + j] - mu) * rs * gg[8 * i + j] + gbias[8 * i + j] + bo * vf[j]) * gf[j];
                po[i] = make_uint4(pack_bf16(o[0], o[1]), pack_bf16(o[2], o[3]), pack_bf16(o[4], o[5]), pack_bf16(o[6], o[7])); }
        } else {
            float s2 = 0.f;
#pragma unroll
            for (int j = 0; j < 64; ++j) s2 += y[j] * y[j];
            const float rs = 1.0f / sqrtf(s2 * (1.0f / 64.0f) + RMS_EPS);
            const uint4* pg = reinterpret_cast<const uint4*>(hh + (size_t)n * 1280 + 1024 + h * 64);
            const float* gg = par + 512 + h * 64;
#pragma unroll
            for (int i = 0; i < 8; ++i) { const uint4 g4 = pg[i];
                const float gf[8] = {bflo(g4.x), bfhi(g4.x), bflo(g4.y), bfhi(g4.y), bflo(g4.z), bfhi(g4.z), bflo(g4.w), bfhi(g4.w)};
                float o[8];
#pragma unroll
                for (int j = 0; j < 8; ++j) o[j] = y[8 * i + j] * rs * gg[8 * i + j] * (gf[j] * fast_sigmoid(gf[j]));
                po[i] = make_uint4(pack_bf16(o[0], o[1]), pack_bf16(o[2], o[3]), pack_bf16(o[4], o[5]), pack_bf16(o[6], o[7])); }
        }
    }
}
#endif
DI void phase_fin(const Frame& F, int l) {
    const bf16* r7 = WSP(bf16, OFF_R7); const size_t AS = (size_t)NTOK * 256;
    const bf16* gb = WSP(bf16, OFF_G); const float* bonus = WSP(float, OFF_BONUS);
    const bf16* hh = WSP(bf16, OFF_HHGRN); bf16* ycat = WSP(bf16, OFF_YCAT);
    const float* gng = F.in[17] + l * 256; const float* gnb = F.in[18] + l * 256; const float* hng = F.in[20] + l * 256;
    for (int it = ggrp(F); it < NTOK * 8; it += ngrp(F)) {
        const int n = it >> 3, kind = (it >> 2) & 1, h = it & 3;
        float v[PER64];
        if (kind == 0) {
            float s1 = 0.f;
            for (int i = 0; i < PER64; ++i) { const int c = h * 64 + glane(F) + i * GRP; const size_t o = (size_t)n * 256 + c;
#ifdef CPU_EMU
                v[i] = bf2f(WSP(bf16, OFF_EMU_SCAN)[o]) + bf2f(WSP(bf16, OFF_EMU_SCAN)[AS + o]); s1 += v[i]; }
#else
                v[i] = bf2f(r7[R_W0 * AS + o]) + bf2f(r7[R_W1 * AS + o]); s1 += v[i]; }
#endif
            s1 = grp_sum(F, s1); const float mu = s1 * (1.0f / 64.0f);
            float s2 = 0.f; for (int i = 0; i < PER64; ++i) { const float dd = v[i] - mu; s2 += dd * dd; }
            s2 = grp_sum(F, s2); const float rs = 1.0f / sqrtf(s2 * (1.0f / 64.0f) + GN_EPS);
            const float bo = bonus[(size_t)n * 4 + h];
            for (int i = 0; i < PER64; ++i) { const int c = h * 64 + glane(F) + i * GRP; const size_t o = (size_t)n * 256 + c;
                const float y = (v[i] - mu) * rs * gng[c] + gnb[c];
                ycat[(size_t)n * 1024 + 256 + c] = f2bf((y + bo * bf2f(r7[R_V * AS + o])) * bf2f(gb[o])); }
        } else {
            float s2 = 0.f;
            for (int i = 0; i < PER64; ++i) { const int c = h * 64 + glane(F) + i * GRP; const size_t o = (size_t)n * 1280 + c;
#ifdef CPU_EMU
                const size_t oe = (size_t)n * 256 + c;
                v[i] = bf2f(WSP(bf16, OFF_EMU_SCAN)[2 * AS + oe]) + bf2f(WSP(bf16, OFF_EMU_SCAN)[3 * AS + oe]); s2 += v[i] * v[i]; }
#else
                v[i] = bf2f(hh[o + 256]) + bf2f(hh[o + 512]); s2 += v[i] * v[i]; }
#endif
            s2 = grp_sum(F, s2); const float rs = 1.0f / sqrtf(s2 * (1.0f / 64.0f) + RMS_EPS);
            for (int i = 0; i < PER64; ++i) { const int c = h * 64 + glane(F) + i * GRP; const size_t o = (size_t)n * 1280 + c;
                ycat[(size_t)n * 1024 + 512 + c] = f2bf(v[i] * rs * hng[c] * siluf_(bf2f(hh[o + 1024]))); }
        }
    }
}

struct EpiResid {
    float* xf; int row0, pn;
    DI void operator()(int r, int c, float a, float b, float cc, float d) const {
        float* p = xf + (size_t)(row0 + r) * DM + pn * 256 + c;
#ifndef CPU_EMU
        float4 x = *reinterpret_cast<float4*>(p);
        x.x = DN_ALPHA * x.x + a; x.y = DN_ALPHA * x.y + b; x.z = DN_ALPHA * x.z + cc; x.w = DN_ALPHA * x.w + d;
        *reinterpret_cast<float4*>(p) = x;
#else
        p[0] = DN_ALPHA * p[0] + a; p[1] = DN_ALPHA * p[1] + b; p[2] = DN_ALPHA * p[2] + cc; p[3] = DN_ALPHA * p[3] + d;
#endif
    }
};
struct EpiBf {
    bf16* o; int ld; int row0, pn;
    DI void operator()(int r, int c, float a, float b, float cc, float d) const { st_bf16x4(o + (size_t)(row0 + r) * ld + pn * 256 + c, a, b, cc, d); }
};
template <int MODE>
DI void phase_gemm_sq(const Frame& F, const bf16* A, size_t woff, bf16* outb) {
    const bf16* W = (const bf16*)((const char*)WSP(bf16, OFF_WTS) + woff);
    const int nM = (NTOK + 255) / 256;
    for (int u = blockIdx.x; u < nM * 4; u += F.nblk) {
        const int pm = u >> 2, pn = u & 3;
#ifdef CPU_EMU
        const int mr = min(256, NTOK - pm * 256);
#endif
        if (MODE == 0) { EpiResid E{F.xf, pm * 256, pn}; gemm_unit(F, A, 1024, nullptr, pm * 256, W, 1024, pn * 256, 1024, E MR); }
        else { EpiBf E{outb, 1024, pm * 256, pn}; gemm_unit(F, A, 1024, nullptr, pm * 256, W, 1024, pn * 256, 1024, E MR); }
    }
}

DI void phase_ln(const Frame& F, const float* g, const float* b) {
#ifdef CPU_EMU
    const float* xf = F.xf;
    layer_norm_rows(F, g, b, [&](int row, int c) { return xf[(size_t)row * DM + c]; }, false, nullptr);
#else
    ln_rows_gpu<0>(F, g, b, 0);
#endif
}

#ifndef CPU_EMU
DI void phase_route_gpu(const Frame& F, int l) {
    const float* xf = F.xf; const float* gt = (const float*)((const char*)WSP(bf16, OFF_WTS) + W_GATE_T) + (size_t)l * 48 * 1024;
    const float* bg = F.in[34] + l * 4; const float* be = F.in[36] + l * 32;
    int* counts = (int*)(F.ws + CTL_CNT) + l * 32;
    int* lists = WSP(int, OFF_LISTS); float* tinfo = WSP(float, OFF_TINFO);
    const int tid = F.tid, wave = tid >> 6, lane = tid & 63, rr = lane & 15, kq = lane >> 4;
    float* lg = (float*)F.smem + wave * (16 * 48);
    __syncthreads();
    for (int rt = blockIdx.x * 8 + wave; rt < NTOK / 16; rt += F.nblk * 8) {
        const int r0 = rt * 16;
        f32x4 acc0 = {0.f, 0.f, 0.f, 0.f}, acc1 = acc0, acc2 = acc0;
        const float* xa = xf + (size_t)(r0 + rr) * DM + 4 * kq;
        const float* wb = gt + (size_t)rr * 1024 + 4 * kq;
#pragma unroll 2
        for (int k0 = 0; k0 < 1024; k0 += 16) {
            const float4 a = *reinterpret_cast<const float4*>(xa + k0);
            const float4 b0 = *reinterpret_cast<const float4*>(wb + k0), b1 = *reinterpret_cast<const float4*>(wb + 16 * 1024 + k0), b2 = *reinterpret_cast<const float4*>(wb + 32 * 1024 + k0);
            acc0 = __builtin_amdgcn_mfma_f32_16x16x4f32(a.x, b0.x, acc0, 0, 0, 0); acc1 = __builtin_amdgcn_mfma_f32_16x16x4f32(a.x, b1.x, acc1, 0, 0, 0); acc2 = __builtin_amdgcn_mfma_f32_16x16x4f32(a.x, b2.x, acc2, 0, 0, 0);
            acc0 = __builtin_amdgcn_mfma_f32_16x16x4f32(a.y, b0.y, acc0, 0, 0, 0); acc1 = __builtin_amdgcn_mfma_f32_16x16x4f32(a.y, b1.y, acc1, 0, 0, 0); acc2 = __builtin_amdgcn_mfma_f32_16x16x4f32(a.y, b2.y, acc2, 0, 0, 0);
            acc0 = __builtin_amdgcn_mfma_f32_16x16x4f32(a.z, b0.z, acc0, 0, 0, 0); acc1 = __builtin_amdgcn_mfma_f32_16x16x4f32(a.z, b1.z, acc1, 0, 0, 0); acc2 = __builtin_amdgcn_mfma_f32_16x16x4f32(a.z, b2.z, acc2, 0, 0, 0);
            acc0 = __builtin_amdgcn_mfma_f32_16x16x4f32(a.w, b0.w, acc0, 0, 0, 0); acc1 = __builtin_amdgcn_mfma_f32_16x16x4f32(a.w, b1.w, acc1, 0, 0, 0); acc2 = __builtin_amdgcn_mfma_f32_16x16x4f32(a.w, b2.w, acc2, 0, 0, 0);
        }
#pragma unroll
        for (int r = 0; r < 4; ++r) { lg[(4 * kq + r) * 48 + rr] = acc0[r]; lg[(4 * kq + r) * 48 + 16 + rr] = acc1[r]; lg[(4 * kq + r) * 48 + 32 + rr] = acc2[r]; }
        asm volatile("s_waitcnt lgkmcnt(0)" ::: "memory");
        __builtin_amdgcn_wave_barrier();
        if (lane < 16) {
            const int row = r0 + lane; const float* L = lg + lane * 48;
            float gl[4];
#pragma unroll
            for (int q = 0; q < 4; ++q) gl[q] = L[q] + bg[q];
            int gi = 0; float gm = gl[0];
#pragma unroll
            for (int q = 1; q < 4; ++q) if (gl[q] > gm) { gm = gl[q]; gi = q; }
            float den = 0.f;
#pragma unroll
            for (int q = 0; q < 4; ++q) den += expf(gl[q] - gm);
            const float pgroup = 1.0f / den;
            float el[8];
#pragma unroll
            for (int q = 0; q < 8; ++q) el[q] = L[4 + gi * 8 + q] + be[gi * 8 + q];
            int i0 = 0; float v0 = el[0];
#pragma unroll
            for (int q = 1; q < 8; ++q) if (el[q] > v0) { v0 = el[q]; i0 = q; }
            int i1 = -1; float v1 = -INFINITY;
#pragma unroll
            for (int q = 0; q < 8; ++q) if (q != i0 && el[q] > v1) { v1 = el[q]; i1 = q; }
            const float e1 = expf(v1 - v0); const float g0 = pgroup / (1.0f + e1), g1 = pgroup * e1 / (1.0f + e1);
            const int ea = gi * 8 + i0, eb = gi * 8 + i1;
            const int pa = atomicAdd(&counts[ea], 1), pb = atomicAdd(&counts[eb], 1);
            lists[(size_t)ea * NTOK + pa] = row; lists[(size_t)eb * NTOK + pb] = row;
            int* ti = (int*)(tinfo + (size_t)row * 8);
            ti[0] = ea; ti[1] = pa; ti[2] = eb; ti[3] = pb; tinfo[(size_t)row * 8 + 4] = g0; tinfo[(size_t)row * 8 + 5] = g1;
        }
        __builtin_amdgcn_wave_barrier();
    }
}
#endif
DI void phase_route(const Frame& F, int l) {
    const float* xf = F.xf;
    const float* wg = F.in[33] + (size_t)l * 1024 * 4; const float* bg = F.in[34] + l * 4;
    const float* we = F.in[35] + (size_t)l * 1024 * 32; const float* be = F.in[36] + l * 32;
    int* counts = (int*)(F.ws + CTL_CNT) + l * 32;
    int* lists = WSP(int, OFF_LISTS); float* tinfo = WSP(float, OFF_TINFO);
    for (int row = ggrp(F); row < NTOK; row += ngrp(F)) {
        float gl[4] = {0.f, 0.f, 0.f, 0.f};
        for (int i = 0; i < PERLN; ++i) { const int c = glane(F) + i * GRP; const float x = xf[(size_t)row * DM + c];
#pragma unroll
            for (int q = 0; q < 4; ++q) gl[q] += x * wg[c * 4 + q]; }
#pragma unroll
        for (int q = 0; q < 4; ++q) gl[q] = grp_sum(F, gl[q]) + bg[q];
        int gi = 0; float gm = gl[0];
#pragma unroll
        for (int q = 1; q < 4; ++q) if (gl[q] > gm) { gm = gl[q]; gi = q; }
        float den = 0.f;
#pragma unroll
        for (int q = 0; q < 4; ++q) den += expf(gl[q] - gm);
        const float pgroup = 1.0f / den;
        float el[8] = {0.f, 0.f, 0.f, 0.f, 0.f, 0.f, 0.f, 0.f};
        for (int i = 0; i < PERLN; ++i) { const int c = glane(F) + i * GRP; const float x = xf[(size_t)row * DM + c];
#pragma unroll
            for (int q = 0; q < 8; ++q) el[q] += x * we[c * 32 + gi * 8 + q]; }
#pragma unroll
        for (int q = 0; q < 8; ++q) el[q] = grp_sum(F, el[q]) + be[gi * 8 + q];
        int i0 = 0; float v0 = el[0];
#pragma unroll
        for (int q = 1; q < 8; ++q) if (el[q] > v0) { v0 = el[q]; i0 = q; }
        int i1 = -1; float v1 = -INFINITY;
#pragma unroll
        for (int q = 0; q < 8; ++q) if (q != i0 && el[q] > v1) { v1 = el[q]; i1 = q; }
        const float e1 = expf(v1 - v0); const float g0 = pgroup / (1.0f + e1), g1 = pgroup * e1 / (1.0f + e1);
        if (glane(F) == 0) {
            const int ea = gi * 8 + i0, eb = gi * 8 + i1;
            const int pa = atomicAdd(&counts[ea], 1), pb = atomicAdd(&counts[eb], 1);
            lists[(size_t)ea * NTOK + pa] = row; lists[(size_t)eb * NTOK + pb] = row;
            int* ti = (int*)(tinfo + (size_t)row * 8);
            ti[0] = ea; ti[1] = pa; ti[2] = eb; ti[3] = pb; tinfo[(size_t)row * 8 + 4] = g0; tinfo[(size_t)row * 8 + 5] = g1;
        }
    }
}

struct EpiMoeUp {
    bf16* hm; int row0, pn;
    DI void operator()(int r, int c, float a, float b, float cc, float d) const {
        bf16* p = hm + (size_t)(row0 + r) * 256 + ((pn * 256 + c) >> 1);
        p[0] = f2bf(siluf_(a) * b); p[1] = f2bf(siluf_(cc) * d);
    }
};
DI int ld_cnt(const int* p) {
#ifdef CPU_EMU
    return *p;
#else
    return __hip_atomic_load(p, __ATOMIC_RELAXED, __HIP_MEMORY_SCOPE_AGENT);
#endif
}
DI void moe_tiles(const int* counts, int* toff  ) {
    __syncthreads();
    if (threadIdx.x == 0) { int acc = 0; for (int e = 0; e < NEXP; ++e) { toff[e] = acc; acc += (ld_cnt(counts + e) + 255) >> 8; } toff[NEXP] = acc; }
    __syncthreads();
}
DI void phase_moe_up(const Frame& F, int l) {
    const int* counts = (const int*)(F.ws + CTL_CNT) + l * 32;
    int* eoff = (int*)(F.ws + CTL_EOFF) + l * 33;
    int* rowmap = (int*)(F.smem + 131072);
    int* toff = rowmap + 256;
    moe_tiles(counts, toff);
    if (blockIdx.x == 0 && threadIdx.x == 0) for (int e = 0; e <= NEXP; ++e) eoff[e] = toff[e] * 256;
    const int* lists = WSP(int, OFF_LISTS); const bf16* xb = WSP(bf16, OFF_XB);
    const int nunit = toff[NEXP] * 2;
    for (int u = blockIdx.x; u < nunit; u += F.nblk) {
        const int tile = u >> 1, pn = u & 1;
        int e = 0; while (toff[e + 1] <= tile) ++e;
        const int t0 = (tile - toff[e]) * 256, cnt = ld_cnt(counts + e);
        __syncthreads();
        for (int i = fresh_tid(F); i < 256; i += NTH) rowmap[i] = (t0 + i < cnt) ? lists[(size_t)e * NTOK + t0 + i] : 0;
        __syncthreads();
        EpiMoeUp E{WSP(bf16, OFF_HM), tile * 256, pn};
        gemm_unit(F, xb, 1024, rowmap, 0, WSP(bf16, OFF_W13T) + (size_t)e * 512 * 1024, 1024, pn * 256, 1024, E);
    }
}
DI void phase_moe_down(const Frame& F, int l) {
    const int* counts = (const int*)(F.ws + CTL_CNT) + l * 32;
    int* toff = (int*)(F.smem + 131072) + 256;
    moe_tiles(counts, toff);
    const int nunit = toff[NEXP] * 4;
    for (int u = blockIdx.x; u < nunit; u += F.nblk) {
        const int tile = u >> 2, pn = u & 3;
        int e = 0; while (toff[e + 1] <= tile) ++e;
        EpiBf E{WSP(bf16, OFF_YROWS), 1024, tile * 256, pn};
        gemm_unit(F, WSP(bf16, OFF_HM), 256, nullptr, tile * 256, WSP(bf16, OFF_W2T) + (size_t)e * 1024 * 256, 256, pn * 256, 256, E);
    }
}
DI void phase_ln3(const Frame& F, int l) {
#ifndef CPU_EMU
    ln_rows_gpu<2>(F, F.in[40] + l * 1024, F.in[41] + l * 1024, l);
#else
    const float* xf = F.xf; const bf16* yr = WSP(bf16, OFF_YROWS); const float* tinfo = WSP(float, OFF_TINFO);
    const int* eoff = (const int*)(F.ws + CTL_EOFF) + l * 33;
    layer_norm_rows(F, F.in[40] + l * 1024, F.in[41] + l * 1024, [&](int row, int c) {
        const int* ti = (const int*)(tinfo + (size_t)row * 8);
        const size_t ra = (size_t)eoff[ti[0]] + ti[1], rb = (size_t)eoff[ti[2]] + ti[3];
        return DN_ALPHA * xf[(size_t)row * DM + c] + tinfo[(size_t)row * 8 + 4] * bf2f(yr[ra * 1024 + c]) + tinfo[(size_t)row * 8 + 5] * bf2f(yr[rb * 1024 + c]);
    }, false, nullptr);
#endif
}

#ifndef CPU_EMU
#define XB_TMO      128
#define XB_XCNT(j)  (256  + 64 * (j))
#define XB_XSUB(j)  (1280 + 64 * (j))
#define XB_XGEN(j)  (2304 + 64 * (j))
#define XB_TOP      3328
#define XB_TOPGEN   3392
#define XCD_BAR_WORDS 3456
#define XB_SPIN_CAP (1u << 18)
#define LAS __attribute__((address_space(3)))

__device__ __forceinline__ unsigned xb_ld(unsigned* p)              { return __hip_atomic_load(p, __ATOMIC_RELAXED, __HIP_MEMORY_SCOPE_AGENT); }
__device__ __forceinline__ unsigned xb_add(unsigned* p, unsigned v) { return __hip_atomic_fetch_add(p, v, __ATOMIC_RELAXED, __HIP_MEMORY_SCOPE_AGENT); }
__device__ __forceinline__ unsigned xb_xcc_id() { return (unsigned)__builtin_amdgcn_s_getreg((3 << 11) | 20) & 0xFu; }
#define XB_SPIN(cond, bar) do { unsigned _sp = 0; while (cond) { __builtin_amdgcn_s_sleep(1); \
    if ((++_sp & 255u) == 0u) { if (xb_ld(&(bar)[XB_TMO])) break; if (_sp > XB_SPIN_CAP) { atomicAdd(&(bar)[XB_TMO], 1u); break; } } } } while (0)

struct XcdBarrier {
    unsigned* bar; unsigned x;
    volatile LAS unsigned* st;
};

__device__ __forceinline__ XcdBarrier xcd_barrier_post(unsigned* bar, volatile LAS unsigned* st) {
    XcdBarrier b; b.bar = bar; b.x = xb_xcc_id(); b.st = st;
    if (threadIdx.x == 0) (void)xb_add(&bar[XB_XCNT(b.x)], 1u);
    return b;
}
__device__ __forceinline__ void xcd_barrier_complete(unsigned* bar, unsigned x, unsigned& nloc, unsigned& nx) {
    const unsigned G = gridDim.x * gridDim.y * gridDim.z;
    unsigned sum, cnt, mine, sp = 0u;
    for (;;) {
        sum = 0u; cnt = 0u; mine = 0u;
#pragma unroll
        for (unsigned j = 0; j < 16; ++j) { const unsigned c = xb_ld(&bar[XB_XCNT(j)]); sum += c; cnt += (c > 0u) ? 1u : 0u; mine = (j == x) ? c : mine; }
        if (sum == G) break;
        __builtin_amdgcn_s_sleep(1);
        if ((++sp & 255u) == 0u) { if (xb_ld(&bar[XB_TMO])) break; if (sp > XB_SPIN_CAP) { atomicAdd(&bar[XB_TMO], 1u); break; } }
    }
    nloc = mine > 0u ? mine : 1u; nx = cnt > 0u ? cnt : 1u;
}

__device__ __forceinline__ void xcd_barrier(const XcdBarrier& b) {
    asm volatile("s_waitcnt vmcnt(0)" ::: "memory");
    __syncthreads();
    if (threadIdx.x == 0) {
        unsigned* bar = b.bar;
        __builtin_amdgcn_s_waitcnt(0);
        unsigned nloc = b.st[0], nx = b.st[1];
        if (nloc == 0u) { xcd_barrier_complete(bar, b.x, nloc, nx); b.st[0] = nloc; b.st[1] = nx; }
        const unsigned old = xb_add(&bar[XB_XSUB(b.x)], 1u);
        const unsigned gen = old / nloc;
        if (old + 1u == (gen + 1u) * nloc) {
            __builtin_amdgcn_fence(__ATOMIC_RELEASE, "agent");
            asm volatile("s_waitcnt vmcnt(0)" ::: "memory");
            const unsigned og = xb_add(&bar[XB_TOP], 1u);
            const unsigned tg = og / nx;
            if (og + 1u == (tg + 1u) * nx) xb_add(&bar[XB_TOPGEN], 1u);
            else XB_SPIN(xb_ld(&bar[XB_TOPGEN]) == tg, bar);
            __builtin_amdgcn_fence(__ATOMIC_ACQUIRE, "agent");
            xb_add(&bar[XB_XGEN(b.x)], 1u);
            asm volatile("s_waitcnt vmcnt(0)" ::: "memory");
        } else {
            XB_SPIN(xb_ld(&bar[XB_XGEN(b.x)]) == gen, bar);
            __builtin_amdgcn_fence(__ATOMIC_ACQUIRE, "agent");
            asm volatile("s_waitcnt vmcnt(0)" ::: "memory");
        }
    }
    __syncthreads();
}

#endif

constexpr int NPH_LAYER = 16;
constexpr int NPH_TOTAL = 1 + 2 * NPH_LAYER;
constexpr int SMEM_BYTES = 131072 + 2048;

template <int K>
DI void run_layer_phase(const Frame& F, int l) {
    if constexpr (K == 0) phase_cvt(F, l);
    if constexpr (K == 1) phase_gemm1(F);
    if constexpr (K == 2) phase_prep(F, l);
    if constexpr (K == 3) phase_mlaup(F);
    if constexpr (K == 4) {
#ifdef CPU_EMU
        attn_phase<64, 64>(F, desc_gqa(F)); attn_phase<96, 64>(F, desc_mla(F)); phase_scans(F);
#else
        phase_scans(F);
        {
            const AttnDesc Ag = desc_gqa(F), Am = desc_mla(F);
            const int ng = attn_nunit<64, 64, 64>(Ag), nm = attn_nunit<96, 64, 64>(Am);
            unsigned* qctr = (unsigned*)(F.ws + CTL_QUEUE) + l * 64;
            volatile int* slot = (volatile int*)(F.smem + SMEM_BYTES - 32);
            for (;;) {
                __syncthreads();
                if (F.tid == 0) *slot = (int)atomicAdd(qctr, 1u);
                __syncthreads();
                const int u = *slot;
                if (u >= ng + nm) break;
                if (u < ng) attn_unit<64, 64, 64>(F, Ag, u); else attn_unit<96, 64, 64>(F, Am, u - ng);
            }
        }
#endif
    }
#ifdef CPU_EMU
    if constexpr (K == 5) phase_fin(F, l);
#else
    if constexpr (K == 5) phase_fin_gpu(F, l);
#endif
    if constexpr (K == 6) phase_gemm_sq<0>(F, WSP(bf16, OFF_YCAT), W_OUT_T, nullptr);
    if constexpr (K == 7) phase_ln(F, F.in[26] + l * 1024, F.in[27] + l * 1024);
    if constexpr (K == 8) phase_gemm_sq<1>(F, WSP(bf16, OFF_XB), W_Q_T, WSP(bf16, OFF_QMEM));
    if constexpr (K == 9) {
#ifdef CPU_EMU
        attn_phase<256, 256>(F, desc_mem(F));
#else
        attn_phase<256, 256, 128>(F, desc_mem(F));
#endif
    }
    if constexpr (K == 10) phase_gemm_sq<0>(F, WSP(bf16, OFF_OMEM), W_O_T, nullptr);
    if constexpr (K == 11) { phase_ln(F, F.in[31] + l * 1024, F.in[32] + l * 1024); phase_cvt_moe(F, l); }
#ifdef CPU_EMU
    if constexpr (K == 12) phase_route(F, l);
#else
    if constexpr (K == 12) phase_route_gpu(F, l);
#endif
    if constexpr (K == 13) phase_moe_up(F, l);
    if constexpr (K == 14) phase_moe_down(F, l);
    if constexpr (K == 15) phase_ln3(F, l);
}

#ifndef CPU_EMU
template <int K>
__global__ void __launch_bounds__(512, 2) k_phase(Args a, int l) {
    extern __shared__ __attribute__((aligned(16))) unsigned char lds[];
    Frame F; F.in = (InPtr)__builtin_amdgcn_kernarg_segment_ptr(); F.xf = a.out; F.ws = a.ws; F.smem = lds; F.tid = threadIdx.x; F.wv = __builtin_amdgcn_readfirstlane((int)(threadIdx.x >> 6)); F.nblk = a.ph_lo;
    if constexpr (K < 0) phase_pro(F); else run_layer_phase<K>(F, l);
}

template <int K>
static void launch_phase(const Args& a, int l, int grid, hipStream_t stream) {
    static bool attr = false;
    if (!attr) { (void)hipFuncSetAttribute((const void*)k_phase<K>, hipFuncAttributeMaxDynamicSharedMemorySize, SMEM_BYTES); attr = true; }
    hipLaunchKernelGGL(k_phase<K>, dim3(grid), dim3(512), SMEM_BYTES, stream, a, l);
}

__global__ void __launch_bounds__(512, 2) fwd_one(Args a) {
    extern __shared__ __attribute__((aligned(16))) unsigned char lds[];
    const int wave_s = __builtin_amdgcn_readfirstlane((int)(threadIdx.x >> 6));
    volatile LAS unsigned* st = (volatile LAS unsigned*)(lds + SMEM_BYTES - 16);
    if (threadIdx.x == 0) { st[0] = 0u; st[1] = 0u; st[2] = 0u; st[3] = 0u; }
    __syncthreads();
    XcdBarrier bar = xcd_barrier_post((unsigned*)(a.ws + OFF_CTL), st);
    Frame F;
#define FRESH do { unsigned z_ = 0u, m_ = ~0u; int ws_ = wave_s; asm volatile("" : "+s"(z_), "+s"(ws_), "+s"(m_)); \
        int t_ = ws_ * 64 + (int)__builtin_amdgcn_mbcnt_hi(m_, __builtin_amdgcn_mbcnt_lo(m_, 0u)); asm volatile("" : "+v"(t_)); \
        const __attribute__((address_space(4))) char* kp_ = (const __attribute__((address_space(4))) char*)__builtin_amdgcn_kernarg_segment_ptr() + z_; \
        F.in = (InPtr)kp_; F.xf = *(float* const __attribute__((address_space(4)))*)(kp_ + 42 * 8); F.ws = *(unsigned char* const __attribute__((address_space(4)))*)(kp_ + 43 * 8); \
        F.smem = lds; F.tid = t_; F.wv = ws_; F.nblk = *(const int __attribute__((address_space(4)))*)(kp_ + 44 * 8); } while (0)
#define GB do { { unsigned zb_ = 0u; unsigned xx_ = __builtin_amdgcn_readfirstlane(bar.x); asm volatile("" : "+s"(zb_), "+s"(xx_)); bar.bar = (unsigned*)(a.ws + OFF_CTL) + zb_; bar.x = xx_; } \
        xcd_barrier(bar); } while (0)
#define DUP(k) ((PROBE_DUP >> (k)) & 1)
    FRESH; phase_pro(F); FRESH; phase_cvt(F, 0); GB;
    if (DUP(0)) { FRESH; phase_cvt(F, 0); GB; }
    for (int l = 0; l < 2; ++l) {
        FRESH; run_layer_phase<1>(F, l); GB;
        if (DUP(1)) { FRESH; run_layer_phase<1>(F, l); GB; }
        FRESH; run_layer_phase<2>(F, l); GB;
        FRESH; run_layer_phase<3>(F, l); GB;
        if (DUP(3)) { FRESH; run_layer_phase<3>(F, l); GB; }
        if (DUP(4)) { FRESH; attn_phase<64, 64, 64>(F, desc_gqa(F)); attn_phase<96, 64, 64>(F, desc_mla(F)); GB; }
        FRESH; run_layer_phase<4>(F, l); GB;
        FRESH; run_layer_phase<5>(F, l); GB;
        if (DUP(5)) { FRESH; run_layer_phase<5>(F, l); GB; }
        FRESH; run_layer_phase<6>(F, l); GB;
        FRESH; run_layer_phase<7>(F, l); GB;
        FRESH; run_layer_phase<8>(F, l); GB;
        if (DUP(8)) { FRESH; run_layer_phase<8>(F, l); GB; }
        FRESH; run_layer_phase<9>(F, l); GB;
        if (DUP(9)) { FRESH; run_layer_phase<9>(F, l); GB; }
        FRESH; run_layer_phase<10>(F, l); GB;
        FRESH; run_layer_phase<11>(F, l); FRESH; run_layer_phase<12>(F, l); if (l == 0) { FRESH; phase_cvt(F, 1); } GB;
        if (DUP(11)) { FRESH; phase_cvt_moe(F, l); GB; }
        FRESH; run_layer_phase<13>(F, l); GB;
        if (DUP(13)) { FRESH; run_layer_phase<13>(F, l); GB; }
        FRESH; run_layer_phase<14>(F, l); GB;
        if (DUP(14)) { FRESH; run_layer_phase<14>(F, l); GB; }
        FRESH; run_layer_phase<15>(F, l); if (l == 0) GB;
    }
#undef DUP
#undef GB
#undef FRESH
}

extern "C" void kernel_launch(void* const* d_in, const int* in_sizes, int n_in, void* d_out, int out_size, void* d_ws, size_t ws_size, hipStream_t stream) {
    if (n_in != 42 || ws_size < WS_END) return;
    Args a{};
    for (int i = 0; i < 42; ++i) a.in[i] = (const float*)d_in[i];
    a.out = (float*)d_out; a.ws = (unsigned char*)d_ws; a.ph_lo = 0; a.ph_hi = NPH_TOTAL;
    (void)hipMemsetAsync(d_ws, 0, CTL_BYTES, stream);
#if N_LAUNCH_MODE == 1
    static int grid = 0;
    if (!grid) {
        int dev = 0, cus = 0, per_cu = 0;
        (void)hipGetDevice(&dev);
        (void)hipDeviceGetAttribute(&cus, hipDeviceAttributeMultiprocessorCount, dev);
        (void)hipFuncSetAttribute((const void*)fwd_one, hipFuncAttributeMaxDynamicSharedMemorySize, SMEM_BYTES);
        (void)hipOccupancyMaxActiveBlocksPerMultiprocessor(&per_cu, (const void*)fwd_one, 512, SMEM_BYTES);
        (void)hipGetLastError();
        grid = cus > 0 ? cus : 256;
    }
    a.ph_lo = grid;
    hipLaunchKernelGGL(fwd_one, dim3(grid), dim3(512), SMEM_BYTES, stream, a);
#else
    const int grid = 256; a.ph_lo = grid;
    launch_phase<-1>(a, 0, grid, stream);
    for (int l = 0; l < 2; ++l) {
        launch_phase<0>(a, l, grid, stream); launch_phase<1>(a, l, grid, stream); launch_phase<2>(a, l, grid, stream); launch_phase<3>(a, l, grid, stream);
        launch_phase<4>(a, l, grid, stream); launch_phase<5>(a, l, grid, stream); launch_phase<6>(a, l, grid, stream); launch_phase<7>(a, l, grid, stream);
        launch_phase<8>(a, l, grid, stream); launch_phase<9>(a, l, grid, stream); launch_phase<10>(a, l, grid, stream); launch_phase<11>(a, l, grid, stream);
        launch_phase<12>(a, l, grid, stream); launch_phase<13>(a, l, grid, stream); launch_phase<14>(a, l, grid, stream); launch_phase<15>(a, l, grid, stream);
    }
#endif
}
#endif
```

```cpp
#ifndef CPU_EMU
#include <hip/hip_runtime.h>
#else
#include "emu_shim.h"
#endif
#include <stdint.h>

#ifndef CFG_B
#define CFG_B 16
#endif
#ifndef CFG_S
#define CFG_S 2048
#endif
#ifndef PROBE_DUP
#define PROBE_DUP 0
#endif
#ifndef N_LAUNCH_MODE
#define N_LAUNCH_MODE 1
#endif

typedef unsigned short bf16;
#define DI __device__ __forceinline__

constexpr int BATCH = CFG_B, SEQ = CFG_S, NTOK = BATCH * SEQ, DM = 1024;
constexpr int MEMT = 256, NMEM = BATCH * MEMT;
constexpr int GRIDW = 64;
constexpr int HP = 3328;
constexpr int IN_WIDTH = 3104;
constexpr int NEXP = 32, MOEH = 256;
constexpr int MOE_ROWS = 2 * NTOK + NEXP * 256;
constexpr float LN_EPS = 1e-5f, RMS_EPS = 1e-6f, GN_EPS = 64e-5f;
constexpr float DN_ALPHA = 1.41421356237309515f;
constexpr float DECAY_SCALE = 0.60653065971263342f;

constexpr size_t AL(size_t x) { return (x + 255) & ~(size_t)255; }
constexpr size_t OFF_CTL = 0;
constexpr size_t CTL_BYTES = 32768;
constexpr size_t CTL_CNT = 16384;
constexpr size_t CTL_EOFF = 16384 + 1024;
constexpr size_t CTL_QUEUE = 16384 + 2048;
constexpr size_t OFF_XB = AL(OFF_CTL + CTL_BYTES);
constexpr size_t SZ_XB = (size_t)NTOK * DM * 2;
constexpr size_t OFF_WTS = AL(OFF_XB + SZ_XB);
constexpr size_t W_IN_T = 0;
constexpr size_t W_UQ_T = W_IN_T + (size_t)HP * 1024 * 2;
constexpr size_t W_UKV_T = W_UQ_T + 512 * 256 * 2;
constexpr size_t W_OUT_T = W_UKV_T + 512 * 256 * 2;
constexpr size_t W_Q_T = W_OUT_T + 1024 * 1024 * 2;
constexpr size_t W_KV_T = W_Q_T + 1024 * 1024 * 2;
constexpr size_t W_O_T = W_KV_T + 2048 * 1024 * 2;
constexpr size_t W_GATE_T = W_O_T + 1024 * 1024 * 2;
constexpr size_t SZ_WTS = W_GATE_T + 2 * 48 * 1024 * 4;
constexpr size_t OFF_KMEM = AL(OFF_WTS + SZ_WTS);
constexpr size_t OFF_VTMEM = AL(OFF_KMEM + (size_t)NMEM * 1024 * 2);
constexpr size_t OFF_MEMB = AL(OFF_VTMEM + (size_t)NMEM * 1024 * 2);
constexpr size_t OFF_VTATT = AL(OFF_MEMB + (size_t)NMEM * 1024 * 2);
constexpr size_t OFF_VTMLA = AL(OFF_VTATT + (size_t)BATCH * 2 * 64 * SEQ * 2);
constexpr size_t OFF_HATT = AL(OFF_VTMLA + (size_t)BATCH * 4 * 64 * SEQ * 2);
constexpr size_t OFF_HMLA = OFF_HATT + (size_t)NTOK * 512 * 2;
constexpr size_t OFF_HRWKV = OFF_HMLA + (size_t)NTOK * 512 * 2;
constexpr size_t OFF_R7 = OFF_HRWKV + (size_t)NTOK * 1024 * 2;
constexpr size_t SZ_R7 = (size_t)NTOK * 9 * 256 * 2;
constexpr size_t OFF_HHGRN = OFF_R7 + SZ_R7;
constexpr size_t OFF_HX = OFF_HHGRN + (size_t)NTOK * 1280 * 2;
constexpr size_t OFF_HAM = OFF_HX + (size_t)NTOK * 256 * 2;
constexpr size_t OFF_HEG = OFF_HAM + (size_t)(NTOK / 16) * 8 * 256 * 2;
constexpr size_t OFF_REG = OFF_HEG + (size_t)(NTOK / 16) * 8 * 64 * 4;
constexpr size_t WS_END = OFF_REG + (size_t)(NTOK / 16) * 8 * 64 * 2;
static_assert(WS_END <= (size_t)4 * NTOK * DM * 4 || CFG_B != 16, "workspace must fit 4 x the largest tensor");

constexpr size_t OFF_QMLA = OFF_XB;
constexpr size_t OFF_KNOPE = OFF_QMLA + (size_t)NTOK * 384 * 2;
constexpr size_t OFF_KROPE = OFF_KNOPE + (size_t)NTOK * 256 * 2;
constexpr size_t OFF_G = OFF_KROPE + (size_t)NTOK * 32 * 2;
constexpr size_t OFF_BONUS = OFF_G + (size_t)NTOK * 256 * 2;
constexpr size_t OFF_RSIDE = OFF_BONUS + (size_t)NTOK * 16;
static_assert(OFF_RSIDE + (size_t)(NTOK / 16) * 2 * 512 * 2 <= OFF_XB + SZ_XB, "xb alias region");
constexpr size_t OFF_YCAT = OFF_HRWKV;
constexpr size_t OFF_QMEM = OFF_HATT;
constexpr size_t OFF_OMEM = OFF_R7;
#ifdef CPU_EMU
constexpr size_t OFF_EMU_SCAN = WS_END;
constexpr size_t OFF_LISTS = AL(OFF_EMU_SCAN + (size_t)4 * NTOK * 256 * 2);
#else
constexpr size_t OFF_LISTS = OFF_HATT;
#endif
constexpr size_t OFF_TINFO = OFF_LISTS + (size_t)NEXP * NTOK * 4;
constexpr size_t OFF_HM = AL(OFF_TINFO + (size_t)NTOK * 32);
constexpr size_t OFF_YROWS = AL(OFF_HM + (size_t)MOE_ROWS * 256 * 2);
#ifdef CPU_EMU
constexpr size_t OFF_W13T = AL(OFF_YROWS + (size_t)MOE_ROWS * 1024 * 2);
#else
static_assert(OFF_YROWS + (size_t)MOE_ROWS * 1024 * 2 <= OFF_HHGRN, "moe alias region");
constexpr size_t OFF_W13T = OFF_HHGRN;
#endif
constexpr size_t OFF_W2T = OFF_W13T + (size_t)NEXP * 512 * 1024 * 2;
#ifdef CPU_EMU
constexpr size_t WS_END_EMU = OFF_W2T + (size_t)NEXP * 1024 * 256 * 2;
#else
static_assert(OFF_W2T + (size_t)NEXP * 1024 * 256 * 2 <= WS_END, "moe weights alias");
#endif

enum { C_KT0 = 0, C_KT1 = 1, C_RT0 = 2, C_RT1 = 3, C_KK0 = 4, C_KK1 = 5, C_AT0 = 6, C_AT1 = 7, C_VT = 8 };
enum { R_R = 0, R_V = 1, R_KK = 2, R_W0 = 3, R_W1 = 4, R_KD0 = 5, R_KD1 = 6, R_AK0 = 7, R_AK1 = 8 };

DI float bf2f(bf16 v) { union { unsigned u; float f; } x; x.u = (unsigned)v << 16; return x.f; }
DI bf16 f2bf(float f) { union { unsigned u; float f; } x; x.f = f; unsigned u = x.u; u += 0x7fffu + ((u >> 16) & 1u); return (bf16)(u >> 16); }
DI float sigmoidf_(float x) { return 1.0f / (1.0f + expf(-x)); }
DI float siluf_(float x) { return x * sigmoidf_(x); }

#ifdef CPU_EMU
typedef const float* const* InPtr;
#else
typedef const float* const __attribute__((address_space(4)))* InPtr;
#endif
struct Frame {
    InPtr in;
    float* xf;
    unsigned char* ws;
    unsigned char* smem;
    int tid;
    int wv;
    int nblk;
};
#ifdef CPU_EMU
constexpr int NTH = 1;
#else
constexpr int NTH = 512;
#endif
#ifdef CPU_EMU
constexpr int GRP = 1;
DI float grp_sum(const Frame& F, float v) { return v; }
DI int gthreads(const Frame& F) { return 1; }
DI int gtid_(const Frame& F) { return 0; }
DI int wave_item_index(const Frame& F) { return 0; }
#else
constexpr int GRP = 64;
DI float shfl_idx(const Frame& F, float v, int src_lane) { return __builtin_bit_cast(float, __builtin_amdgcn_ds_bpermute(src_lane << 2, __builtin_bit_cast(int, v))); }
DI float shfl_xor(const Frame& F, float v, int mask) { return shfl_idx(F, v, (F.tid & 63) ^ mask); }
template <int CTRL> DI float dppf(float x) { return __builtin_bit_cast(float, __builtin_amdgcn_update_dpp(0, __builtin_bit_cast(int, x), CTRL, 0xf, 0xf, true)); }
DI float allsum16(float x) { x += dppf<0xB1>(x); x += dppf<0x4E>(x); x += dppf<0x141>(x); x += dppf<0x140>(x); return x; }
DI float rdlane(float x, int l) { return __builtin_bit_cast(float, __builtin_amdgcn_readlane(__builtin_bit_cast(int, x), l)); }
DI float grp_sum(const Frame& F, float v) { v = allsum16(v); return (rdlane(v, 0) + rdlane(v, 16)) + (rdlane(v, 32) + rdlane(v, 48)); }
DI int gthreads(const Frame& F) { return F.nblk * NTH; }
DI int gtid_(const Frame& F) { return blockIdx.x * NTH + F.tid; }
DI int wave_item_index(const Frame& F) { return (int)(((F.tid >> 6) * F.nblk + blockIdx.x) * 64 + (F.tid & 63)); }
#endif
constexpr int PER64 = 64 / GRP;
constexpr int PERLN = 1024 / GRP;
DI int fresh_tid(const Frame& F) {
#ifdef CPU_EMU
    return 0;
#else
    unsigned m0 = ~0u; asm volatile("" : "+s"(m0));
    int t = F.wv * 64 + (int)__builtin_amdgcn_mbcnt_hi(m0, __builtin_amdgcn_mbcnt_lo(m0, 0u)); asm volatile("" : "+v"(t)); return t;
#endif
}
DI int glane(const Frame& F) { return (int)(F.tid % GRP); }
DI int ggrp(const Frame& F) { return gtid_(F) / GRP; }
DI int ngrp(const Frame& F) { return gthreads(F) / GRP; }

struct Args {
    const float* in[42];
    float* out;
    unsigned char* ws;
    int ph_lo, ph_hi;
};

DI float rope_inv(int f, int nf) { return powf(10000.0f, -(float)f / (float)nf); }

#ifndef CPU_EMU
using bf16x8 = __attribute__((ext_vector_type(8))) short;
using bf16x4 = __attribute__((ext_vector_type(4))) short;
using f32x4 = __attribute__((ext_vector_type(4))) float;
using f32x16 = __attribute__((ext_vector_type(16))) float;
typedef __bf16 bf16v2 __attribute__((ext_vector_type(2)));
typedef float f32v2 __attribute__((ext_vector_type(2)));
DI float bflo(unsigned u) { return __uint_as_float(u << 16); }
DI float bfhi(unsigned u) { return __uint_as_float(u & 0xffff0000u); }
DI unsigned pack_bf16(float lo, float hi) { f32v2 v = {lo, hi}; bf16v2 b = __builtin_convertvector(v, bf16v2); return __builtin_bit_cast(unsigned, b); }

constexpr int G_BM = 256, G_BK = 64, G_HALF = 128, G_HT = G_HALF * G_BK, G_SHM = 8 * G_HT * 2;
DI int g_lds_byte(int r, int c) { int st = (r >> 4) * 2 + (c >> 5), rr = r & 15, cc = c & 31, ob = rr * 64 + cc * 2; return st * 1024 + (ob ^ (((ob >> 9) & 1) << 5)); }
DI void g_stage_rc(int b, int& R, int& C) { int st = b / 1024, sb = b % 1024, swz = sb ^ (((sb >> 9) & 1) << 5); R = (st >> 1) * 16 + swz / 64; C = (st & 1) * 32 + (swz % 64) / 2; }

template <bool GATHER, class Epi>
DI void gemm_unit_t(int wv_in, bf16* shm, const bf16* __restrict__ A, int lda, const int* rowmap, int arow0,
                    const bf16* __restrict__ Bt, int ldb, int bcol0, int K, const Epi& epi) {
#define SA(b, h) (shm + ((b) * 2 + (h)) * G_HT)
#define SB(b, h) (shm + (4 + (b) * 2 + (h)) * G_HT)
#define STAGE_AX(T, P, hf, kt) do { for (int _i = 0; _i < 2; ++_i) { int _b = (T) * 16 + _i * 8192; int _r, _c; g_stage_rc(_b, _r, _c); \
        const long _row = GATHER ? (long)rowmap[(hf) * G_HALF + _r] : (long)(arow0 + (hf) * G_HALF + _r); \
        __builtin_amdgcn_global_load_lds((const unsigned*)(A + _row * lda + (long)(kt) * G_BK + _c), (unsigned*)((char*)(P) + _b), 16, 0, 0); } } while (0)
#define STAGE_BX(T, P, hf, kt) do { for (int _i = 0; _i < 2; ++_i) { int _b = (T) * 16 + _i * 8192; int _r, _c; g_stage_rc(_b, _r, _c); \
        __builtin_amdgcn_global_load_lds((const unsigned*)(Bt + (long)(bcol0 + (hf) * G_HALF + _r) * ldb + (long)(kt) * G_BK + _c), (unsigned*)((char*)(P) + _b), 16, 0, 0); } } while (0)
#define STAGE_A(P, hf, kt) STAGE_AX(t0, P, hf, kt)
#define STAGE_B(P, hf, kt) STAGE_BX(t0, P, hf, kt)
#define LDA(dst, b, h) for (int m = 0; m < 4; ++m) for (int k = 0; k < 2; ++k) \
        dst[m][k] = *reinterpret_cast<const bf16x8*>((char*)SA(b, h) + g_lds_byte(wr * 64 + m * 16 + fr, k * 32 + fq * 8))
#define LDB(dst, b, h) for (int n = 0; n < 2; ++n) for (int k = 0; k < 2; ++k) \
        dst[n][k] = *reinterpret_cast<const bf16x8*>((char*)SB(b, h) + g_lds_byte(wc * 32 + n * 16 + fr, k * 32 + fq * 8))
#define MMA(ai, bj, At, Bt_) do { __builtin_amdgcn_s_setprio(1); \
        for (int m = 0; m < 4; ++m) for (int n = 0; n < 2; ++n) for (int k = 0; k < 2; ++k) \
            acc[ai][bj][m][n] = __builtin_amdgcn_mfma_f32_16x16x32_bf16(Bt_[n][k], At[m][k], acc[ai][bj][m][n], 0, 0, 0); \
        __builtin_amdgcn_s_setprio(0); } while (0)
#define WAIT_V(n) asm volatile("s_waitcnt vmcnt(" #n ")" ::: "memory")
#define WAIT_L(n) asm volatile("s_waitcnt lgkmcnt(" #n ")" ::: "memory")
#define BAR __builtin_amdgcn_s_barrier()
#define SCHED __builtin_amdgcn_sched_barrier(0)
    unsigned m0 = ~0u; asm volatile("" : "+s"(m0));
    int t0 = wv_in * 64 + (int)__builtin_amdgcn_mbcnt_hi(m0, __builtin_amdgcn_mbcnt_lo(m0, 0u)); asm volatile("" : "+v"(t0));
    int wid = t0 >> 6, lane = t0 & 63, wr = wid >> 2, wc = wid & 3, fr = lane & 15, fq = lane >> 4;
    f32x4 acc[2][2][4][2] = {};
    bf16x8 At[4][2], B0[2][2], B1[2][2];
    const int nt = K / G_BK;
    STAGE_B(SB(0, 0), 0, 0); STAGE_A(SA(0, 0), 0, 0);
    STAGE_B(SB(0, 1), 1, 0); STAGE_A(SA(0, 1), 1, 0);
    if (wr == 1) BAR;
    WAIT_V(4); BAR;
    STAGE_B(SB(1, 0), 0, 1); STAGE_A(SA(1, 0), 0, 1); STAGE_B(SB(1, 1), 1, 1);
    WAIT_V(6); BAR;
    for (int t = 0; t < nt - 2; t += 2) {
        LDB(B0, 0, 0); SCHED; LDA(At, 0, 0); STAGE_A(SA(1, 1), 1, t + 1);
        WAIT_L(8); BAR; WAIT_L(0); MMA(0, 0, At, B0); BAR; SCHED;
        LDB(B1, 0, 1); STAGE_B(SB(0, 0), 0, t + 2);
        BAR; WAIT_L(0); MMA(0, 1, At, B1); BAR;
        LDA(At, 0, 1); STAGE_A(SA(0, 0), 0, t + 2);
        BAR; WAIT_L(0); MMA(1, 0, At, B0); BAR; SCHED;
        STAGE_B(SB(0, 1), 1, t + 2);
        WAIT_V(6); BAR; MMA(1, 1, At, B1); BAR;
        LDB(B0, 1, 0); SCHED; LDA(At, 1, 0); STAGE_A(SA(0, 1), 1, t + 2);
        WAIT_L(8); BAR; WAIT_L(0); MMA(0, 0, At, B0); BAR; SCHED;
        LDB(B1, 1, 1); STAGE_B(SB(1, 0), 0, t + 3);
        BAR; WAIT_L(0); MMA(0, 1, At, B1); BAR;
        LDA(At, 1, 1); STAGE_A(SA(1, 0), 0, t + 3);
        BAR; WAIT_L(0); MMA(1, 0, At, B0); BAR; SCHED;
        STAGE_B(SB(1, 1), 1, t + 3);
        WAIT_V(6); BAR; MMA(1, 1, At, B1); BAR;
    }
    int tz = t0; asm volatile("" : "+v"(tz)); wid = tz >> 6; lane = tz & 63; wr = wid >> 2; wc = wid & 3; fr = lane & 15; fq = lane >> 4;
    { LDB(B0, 0, 0); WAIT_V(0); LDA(At, 0, 0); STAGE_AX(tz, SA(1, 1), 1, nt - 1);
      BAR; WAIT_L(0); MMA(0, 0, At, B0); BAR;
      LDB(B1, 0, 1); BAR; WAIT_L(0); MMA(0, 1, At, B1); BAR;
      LDA(At, 0, 1); WAIT_V(4); BAR; WAIT_L(0); MMA(1, 0, At, B0); MMA(1, 1, At, B1); BAR; }
    { LDB(B0, 1, 0); LDA(At, 1, 0); WAIT_V(2); BAR; WAIT_L(0); MMA(0, 0, At, B0); BAR;
      LDB(B1, 1, 1); WAIT_V(0); BAR; WAIT_L(0); MMA(0, 1, At, B1); BAR;
      LDA(At, 1, 1); BAR; WAIT_L(0); MMA(1, 0, At, B0); MMA(1, 1, At, B1); BAR; }
    if (wr == 0) BAR;
#pragma unroll
    for (int ai = 0; ai < 2; ++ai)
#pragma unroll
        for (int m = 0; m < 4; ++m)
#pragma unroll
            for (int bj = 0; bj < 2; ++bj)
#pragma unroll
                for (int n = 0; n < 2; ++n) {
                    const f32x4 v = acc[ai][bj][m][n];
                    epi(ai * G_HALF + wr * 64 + m * 16 + fr, bj * G_HALF + wc * 32 + n * 16 + fq * 4, v[0], v[1], v[2], v[3]);
                }
#undef SA
#undef SB
#undef STAGE_A
#undef STAGE_B
#undef STAGE_AX
#undef STAGE_BX
#undef LDA
#undef LDB
#undef MMA
}
template <class Epi>
DI void gemm_unit(const Frame& F, const bf16* __restrict__ A, int lda, const int* rowmap, int arow0,
                  const bf16* __restrict__ Bt, int ldb, int bcol0, int K, const Epi& epi) {
    if (rowmap) gemm_unit_t<true>(F.wv, (bf16*)F.smem, A, lda, rowmap, arow0, Bt, ldb, bcol0, K, epi);
    else gemm_unit_t<false>(F.wv, (bf16*)F.smem, A, lda, rowmap, arow0, Bt, ldb, bcol0, K, epi);
}
#else
template <class Epi>
void gemm_unit(const Frame& F, const bf16* A, int lda, const int* rowmap, int arow0, const bf16* Bt, int ldb, int bcol0, int K, const Epi& epi, int mrows = 256) {
    for (int r = 0; r < mrows; ++r) {
        int arow = rowmap ? rowmap[r] : arow0 + r;
        for (int c = 0; c < 256; c += 4) {
            float v[4];
            for (int q = 0; q < 4; ++q) {
                double s = 0; const bf16* a = A + (long)arow * lda; const bf16* b = Bt + (long)(bcol0 + c + q) * ldb;
                for (int k = 0; k < K; ++k) s += (double)bf2f(a[k]) * bf2f(b[k]);
                v[q] = (float)s;
            }
            epi(r, c, v[0], v[1], v[2], v[3]);
        }
    }
}
#endif

DI void st_bf16x4(bf16* p, float a, float b, float c, float d) {
#ifndef CPU_EMU
    uint2 u; u.x = pack_bf16(a, b); u.y = pack_bf16(c, d); *reinterpret_cast<uint2*>(p) = u;
#else
    p[0] = f2bf(a); p[1] = f2bf(b); p[2] = f2bf(c); p[3] = f2bf(d);
#endif
}

#define WSP(T, off) ((T*)(F.ws + (off)))

DI void ln_row_write(float* xrow, bf16* brow, const float* vals_in  , const float* g, const float* b);

template <class Fn>
DI void layer_norm_rows(const Frame& F, const float* g, const float* b, Fn pre, bool write_out_extra, float* extra) {
    float* xf = F.xf; bf16* xb = WSP(bf16, OFF_XB);
    for (int row = ggrp(F); row < NTOK; row += ngrp(F)) {
        float v[PERLN]; float s = 0.f;
        for (int i = 0; i < PERLN; ++i) { int c = glane(F) + i * GRP; v[i] = pre(row, c); s += v[i]; }
        s = grp_sum(F, s); const float mu = s * (1.0f / 1024.0f);
        float q = 0.f;
        for (int i = 0; i < PERLN; ++i) { float d = v[i] - mu; q += d * d; }
        q = grp_sum(F, q); const float rs = 1.0f / sqrtf(q * (1.0f / 1024.0f) + LN_EPS);
        for (int i = 0; i < PERLN; ++i) { int c = glane(F) + i * GRP; float y = (v[i] - mu) * rs * g[c] + b[c];
            xf[(size_t)row * DM + c] = y; xb[(size_t)row * DM + c] = f2bf(y); if (write_out_extra) extra[(size_t)row * DM + c] = y; }
    }
}

#ifndef CPU_EMU
template <int MODE>
DI void ln_rows_gpu(const Frame& F, const float* __restrict__ g, const float* __restrict__ b, int l) {
    float* xf = F.xf; bf16* xb = WSP(bf16, OFF_XB);
    const float* xin = F.in[0];
    const bf16* yr = WSP(bf16, OFF_YROWS); const float* tinfo = WSP(float, OFF_TINFO);
    const int* eoff = (const int*)(F.ws + CTL_EOFF) + l * 33;
    const int tid = F.tid, wave = tid >> 6, lane = tid & 63;
    float4 gv[4], bv[4];
#pragma unroll
    for (int i = 0; i < 4; ++i) { gv[i] = *reinterpret_cast<const float4*>(g + lane * 4 + 256 * i); bv[i] = *reinterpret_cast<const float4*>(b + lane * 4 + 256 * i); }
    for (int r0 = (blockIdx.x * 8 + wave) * 4; r0 < NTOK; r0 += F.nblk * 32) {
        float4 v[4][4];
#pragma unroll
        for (int rr = 0; rr < 4; ++rr) {
            const size_t row = r0 + rr;
            if (MODE == 2) {
                const int* ti = (const int*)(tinfo + row * 8);
                const size_t ra = (size_t)eoff[ti[0]] + ti[1], rb = (size_t)eoff[ti[2]] + ti[3];
                const float g0 = tinfo[row * 8 + 4], g1 = tinfo[row * 8 + 5];
#pragma unroll
                for (int i = 0; i < 4; ++i) {
                    const int c = lane * 4 + 256 * i;
                    const float4 x = *reinterpret_cast<const float4*>(xf + row * DM + c);
                    const uint2 ya = *reinterpret_cast<const uint2*>(yr + ra * 1024 + c), yb = *reinterpret_cast<const uint2*>(yr + rb * 1024 + c);
                    v[rr][i].x = DN_ALPHA * x.x + g0 * bflo(ya.x) + g1 * bflo(yb.x); v[rr][i].y = DN_ALPHA * x.y + g0 * bfhi(ya.x) + g1 * bfhi(yb.x);
                    v[rr][i].z = DN_ALPHA * x.z + g0 * bflo(ya.y) + g1 * bflo(yb.y); v[rr][i].w = DN_ALPHA * x.w + g0 * bfhi(ya.y) + g1 * bfhi(yb.y);
                }
            } else {
                const float* src = (MODE == 1 ? xin : xf) + row * DM;
#pragma unroll
                for (int i = 0; i < 4; ++i) v[rr][i] = *reinterpret_cast<const float4*>(src + lane * 4 + 256 * i);
            }
        }
#pragma unroll
        for (int rr = 0; rr < 4; ++rr) {
            const size_t row = r0 + rr;
            float s = 0.f;
#pragma unroll
            for (int i = 0; i < 4; ++i) s += (v[rr][i].x + v[rr][i].y) + (v[rr][i].z + v[rr][i].w);
            const float mu = grp_sum(F, s) * (1.0f / 1024.0f);
            float q = 0.f;
#pragma unroll
            for (int i = 0; i < 4; ++i) { const float d0 = v[rr][i].x - mu, d1 = v[rr][i].y - mu, d2 = v[rr][i].z - mu, d3 = v[rr][i].w - mu; q += (d0 * d0 + d1 * d1) + (d2 * d2 + d3 * d3); }
            const float rs = 1.0f / sqrtf(grp_sum(F, q) * (1.0f / 1024.0f) + LN_EPS);
#pragma unroll
            for (int i = 0; i < 4; ++i) {
                const int c = lane * 4 + 256 * i;
                float4 y; y.x = (v[rr][i].x - mu) * rs * gv[i].x + bv[i].x; y.y = (v[rr][i].y - mu) * rs * gv[i].y + bv[i].y;
                y.z = (v[rr][i].z - mu) * rs * gv[i].z + bv[i].z; y.w = (v[rr][i].w - mu) * rs * gv[i].w + bv[i].w;
                *reinterpret_cast<float4*>(xf + row * DM + c) = y;
                *reinterpret_cast<uint2*>(xb + row * DM + c) = make_uint2(pack_bf16(y.x, y.y), pack_bf16(y.z, y.w));
            }
        }
    }
}
#endif

DI void phase_pro(const Frame& F) {
    const float* x = F.in[0]; const float* mem = F.in[1];
#ifdef CPU_EMU
    layer_norm_rows(F, F.in[2], F.in[3], [&](int row, int c) { return x[(size_t)row * DM + c]; }, false, nullptr);
#else
    (void)x; ln_rows_gpu<1>(F, F.in[2], F.in[3], 0);
#endif
    bf16* memb = WSP(bf16, OFF_MEMB);
    for (size_t i = gtid_(F); i < (size_t)NMEM * DM; i += gthreads(F)) memb[i] = f2bf(mem[i]);
}

template <class Src>
DI void cvt_tile(const Frame& F, bf16* dst, int Kk, int n0, int k0, Src src) {
#ifndef CPU_EMU
    float* tile = (float*)F.smem;
    __syncthreads();
    for (int i = F.tid; i < 4096; i += NTH) { int k = i >> 6, n = i & 63; tile[k * 65 + n] = src(k0 + k, n0 + n); }
    __syncthreads();
    for (int i = F.tid; i < 2048; i += NTH) { int n = i >> 5, k = (i & 31) * 2;
        *reinterpret_cast<unsigned*>(dst + (size_t)(n0 + n) * Kk + k0 + k) = pack_bf16(tile[k * 65 + n], tile[(k + 1) * 65 + n]); }
#endif
}
template <class Src>
DI void cvt_transpose(const Frame& F, bf16* dst, int Nn, int Kk, Src src, int t_first, int t_total) {
#ifdef CPU_EMU
    for (int n = 0; n < Nn; ++n) for (int k = 0; k < Kk; ++k) dst[(size_t)n * Kk + k] = f2bf(src(k, n));
#else
    const int tn = Nn / 64, tk = Kk / 64, ntile = tn * tk;
    int t = (int)blockIdx.x - (t_first % (int)F.nblk); if (t < 0) t += F.nblk;
    for (; t < ntile; t += F.nblk) cvt_tile(F, dst, Kk, (t % tn) * 64, (t / tn) * 64, src);
#endif
}

DI int win_src_col(int n) {
    if (n < 512) return n;
    if (n < 1536) { int c = n - 512; return c < 960 ? 512 + c : -1; }
    if (n < 2816) return 1472 + (n - 1536);
    int c = n - 2816;
    if (c < 192) return 2752 + c;
    if (c < 224) return 2752 + 320 + (c - 192);
    if (c < 256) return -1;
    if (c < 384) return 2752 + 192 + (c - 256);
    return -1;
}
DI int wuq_src_col(int n) {
    if (n >= 384) return -1;
    int h = n / 96, w = n % 96;
    if (w < 64) return h * 96 + w;
    int p = w - 64, m = p >> 1, which = p & 1;
    int i = (m < 8 ? m : 16 + (m - 8)) + (which ? 8 : 0);
    return h * 96 + 64 + i;
}

DI void phase_cvt(const Frame& F, int l) {
    bf16* wts = WSP(bf16, OFF_WTS);
    constexpr int T0 = 0, T1 = T0 + (HP / 64) * 16, T2 = T1 + 8 * 4, T3 = T2 + 8 * 4, T4 = T3 + 256, T5 = T4 + 256, T6 = T5 + 512, TT = T6 + 256;
    { const float* w = F.in[4] + (size_t)l * 1024 * IN_WIDTH;
      cvt_transpose(F, (bf16*)((char*)wts + W_IN_T), HP, 1024, [&](int k, int n) { int s = win_src_col(n); return s < 0 ? 0.f : w[(size_t)k * IN_WIDTH + s]; }, T0, TT); }
    { const float* w = F.in[23] + (size_t)l * 192 * 384;
      cvt_transpose(F, (bf16*)((char*)wts + W_UQ_T), 512, 256, [&](int k, int n) { int s = wuq_src_col(n); return (s < 0 || k >= 192) ? 0.f : w[(size_t)k * 384 + s]; }, T1, TT); }
    { const float* w = F.in[24] + (size_t)l * 128 * 512;
      cvt_transpose(F, (bf16*)((char*)wts + W_UKV_T), 512, 256, [&](int k, int n) { return k >= 128 ? 0.f : w[(size_t)k * 512 + n]; }, T2, TT); }
    { const float* w = F.in[25] + (size_t)l * 1024 * 1024;
      cvt_transpose(F, (bf16*)((char*)wts + W_OUT_T), 1024, 1024, [&](int k, int n) { return w[(size_t)k * 1024 + n]; }, T3, TT); }
    { const float* w = F.in[28] + (size_t)l * 1024 * 1024;
      cvt_transpose(F, (bf16*)((char*)wts + W_Q_T), 1024, 1024, [&](int k, int n) { return w[(size_t)k * 1024 + n]; }, T4, TT); }
    { const float* w = F.in[29] + (size_t)l * 1024 * 2048;
      cvt_transpose(F, (bf16*)((char*)wts + W_KV_T), 2048, 1024, [&](int k, int n) { return w[(size_t)k * 2048 + n]; }, T5, TT); }
    { const float* w = F.in[30] + (size_t)l * 1024 * 1024;
      cvt_transpose(F, (bf16*)((char*)wts + W_O_T), 1024, 1024, [&](int k, int n) { return w[(size_t)k * 1024 + n]; }, T6, TT); }
#ifndef CPU_EMU
    { const float* wg = F.in[33] + (size_t)l * 1024 * 4; const float* we = F.in[35] + (size_t)l * 1024 * 32; float* gt = (float*)((char*)wts + W_GATE_T) + (size_t)l * 48 * 1024;
      for (int i = gtid_(F); i < 48 * 1024; i += gthreads(F)) { const int col = i >> 10, k = i & 1023;
          gt[i] = col < 4 ? wg[k * 4 + col] : col < 36 ? we[k * 32 + col - 4] : 0.f; } }
#endif
}

DI void phase_cvt_moe(const Frame& F, int l) {
#ifdef CPU_EMU
    for (int e = 0; e < NEXP; ++e) {
        const float* w1 = F.in[37] + ((size_t)l * NEXP + e) * 1024 * 256;
        const float* w3 = F.in[38] + ((size_t)l * NEXP + e) * 1024 * 256;
        const float* w2 = F.in[39] + ((size_t)l * NEXP + e) * 256 * 1024;
        cvt_transpose(F, WSP(bf16, OFF_W13T) + (size_t)e * 512 * 1024, 512, 1024,
                      [&](int k, int n) { return (n & 1) ? w3[(size_t)k * 256 + (n >> 1)] : w1[(size_t)k * 256 + (n >> 1)]; }, 0, 1);
        cvt_transpose(F, WSP(bf16, OFF_W2T) + (size_t)e * 1024 * 256, 1024, 256, [&](int k, int n) { return w2[(size_t)k * 1024 + n]; }, 0, 1);
    }
#else
    const float* w1b = F.in[37] + (size_t)l * NEXP * 1024 * 256; const float* w3b = F.in[38] + (size_t)l * NEXP * 1024 * 256; const float* w2b = F.in[39] + (size_t)l * NEXP * 256 * 1024;
    float* tile = (float*)F.smem;
    const int tid = F.tid;
    constexpr int NT = NEXP * 128 + NEXP * 64;
    auto src_ptr = [&](int t, int j) -> const float* {
        const int idx = tid + 512 * j, k = idx >> 4, f4 = idx & 15;
        if (t < NEXP * 128) { const int e = t >> 7, tt = t & 127, n0 = (tt & 7) * 64, k0 = (tt >> 3) * 64;
            const float* base = (f4 < 8 ? w1b : w3b) + (size_t)e * 1024 * 256; return base + (size_t)(k0 + k) * 256 + (n0 >> 1) + 4 * (f4 & 7); }
        const int u = t - NEXP * 128, e = u >> 6, tt = u & 63, n0 = (tt & 15) * 64, k0 = (tt >> 4) * 64;
        return w2b + (size_t)e * 256 * 1024 + (size_t)(k0 + k) * 1024 + n0 + 4 * f4;
    };
    int t = blockIdx.x;
    float4 p0 = make_float4(0.f, 0.f, 0.f, 0.f), p1 = p0;
    if (t < NT) { p0 = *reinterpret_cast<const float4*>(src_ptr(t, 0)); p1 = *reinterpret_cast<const float4*>(src_ptr(t, 1)); }
    for (; t < NT; t += F.nblk) {
        const float4 c0 = p0, c1 = p1;
        const int tn = t + F.nblk;
        if (tn < NT) { p0 = *reinterpret_cast<const float4*>(src_ptr(tn, 0)); p1 = *reinterpret_cast<const float4*>(src_ptr(tn, 1)); }
        __syncthreads();
#pragma unroll
        for (int j = 0; j < 2; ++j) {
            const float4 c = j ? c1 : c0; const int idx = tid + 512 * j, k = idx >> 4, f4 = idx & 15;
            float* tr = tile + k * 65;
            if (t < NEXP * 128) { const int nb = 8 * (f4 & 7) + (f4 >> 3);
                tr[nb] = c.x; tr[nb + 2] = c.y; tr[nb + 4] = c.z; tr[nb + 6] = c.w; }
            else { tr[4 * f4] = c.x; tr[4 * f4 + 1] = c.y; tr[4 * f4 + 2] = c.z; tr[4 * f4 + 3] = c.w; }
        }
        __syncthreads();
        bf16* dst; int Kk, n0, k0;
        if (t < NEXP * 128) { const int e = t >> 7, tt = t & 127; dst = WSP(bf16, OFF_W13T) + (size_t)e * 512 * 1024; Kk = 1024; n0 = (tt & 7) * 64; k0 = (tt >> 3) * 64; }
        else { const int u = t - NEXP * 128, e = u >> 6, tt = u & 63; dst = WSP(bf16, OFF_W2T) + (size_t)e * 1024 * 256; Kk = 256; n0 = (tt & 15) * 64; k0 = (tt >> 4) * 64; }
        for (int i = tid; i < 2048; i += NTH) { const int n = i >> 5, k = (i & 31) * 2;
            *reinterpret_cast<unsigned*>(dst + (size_t)(n0 + n) * Kk + k0 + k) = pack_bf16(tile[k * 65 + n], tile[(k + 1) * 65 + n]); }
    }
#endif
}

struct EpiH {
    bf16* hatt; bf16* hrwkv; bf16* hhgrn; bf16* hmla; int row0, pn;
    DI void operator()(int r, int c, float a, float b, float cc, float d) const {
        const size_t row = row0 + r;
        bf16* p;
        if (pn < 2) p = hatt + row * 512 + pn * 256 + c;
        else if (pn < 6) p = hrwkv + row * 1024 + (pn - 2) * 256 + c;
        else if (pn < 11) p = hhgrn + row * 1280 + (pn - 6) * 256 + c;
        else p = hmla + row * 512 + (pn - 11) * 256 + c;
        st_bf16x4(p, a, b, cc, d);
    }
};
struct EpiKV {
    bf16* kmem; bf16* vt; int row0, pn;
    DI void operator()(int r, int c, float a, float b, float cc, float d) const {
        const int row = row0 + r, col = pn * 256 + c;
        if (col < 1024) { st_bf16x4(kmem + (size_t)row * 1024 + col, a, b, cc, d); }
        else { const int bb = row / MEMT, key = row % MEMT, hc = col - 1024;
            bf16* p = vt + ((size_t)bb * 1024 + hc) * MEMT + key;
            p[0] = f2bf(a); p[MEMT] = f2bf(b); p[2 * MEMT] = f2bf(cc); p[3 * MEMT] = f2bf(d); }
    }
};

DI void phase_gemm1(const Frame& F) {
    const bf16* xb = WSP(bf16, OFF_XB); const bf16* wts = WSP(bf16, OFF_WTS);
    const int nM = (NTOK + 255) / 256, nN = HP / 256, n1 = nM * nN;
    const int nMk = (NMEM + 255) / 256, nNk = 8, n2 = nMk * nNk;
    for (int u = blockIdx.x; u < n1 + n2; u += F.nblk) {
        if (u < n1) {
            const int pm = u / nN, pn = u % nN;
            EpiH E{WSP(bf16, OFF_HATT), WSP(bf16, OFF_HRWKV), WSP(bf16, OFF_HHGRN), WSP(bf16, OFF_HMLA), pm * 256, pn};
#ifdef CPU_EMU
            gemm_unit(F, xb, 1024, nullptr, pm * 256, (const bf16*)((const char*)wts + W_IN_T), 1024, pn * 256, 1024, E, min(256, NTOK - pm * 256));
#else
            gemm_unit(F, xb, 1024, nullptr, pm * 256, (const bf16*)((const char*)wts + W_IN_T), 1024, pn * 256, 1024, E);
#endif
        } else {
            const int v = u - n1, pm = v / nNk, pn = v % nNk;
            EpiKV E{WSP(bf16, OFF_KMEM), WSP(bf16, OFF_VTMEM), pm * 256, pn};
            gemm_unit(F, WSP(bf16, OFF_MEMB), 1024, nullptr, pm * 256, (const bf16*)((const char*)wts + W_KV_T), 1024, pn * 256, 1024, E);
        }
    }
}


#ifndef CPU_EMU
DI float fast_sigmoid(float x) { return 1.0f / (1.0f + __expf(-x)); }
DI float fast_tanh(float x) { const float e = __expf(2.0f * x); return 1.0f - 2.0f / (e + 1.0f); }

DI void prep_attn_gpu(const Frame& F, int l) {
    float* tabA = (float*)F.smem;
    float* tabB = tabA + 2048;
    float* gq = tabB + 1024;
    __syncthreads();
    { const int tid = fresh_tid(F);
    for (int i = tid; i < 1024; i += NTH) { const int pos = i >> 4, f = i & 15; const float ang = (float)pos * rope_inv(2 * f, 32); tabA[i] = cosf(ang); tabA[1024 + i] = sinf(ang); }
    for (int i = tid; i < 512; i += NTH) { const int pos = i >> 3, f = i & 7; const float ang = (float)pos * rope_inv(2 * f, 16); tabB[i] = cosf(ang); tabB[512 + i] = sinf(ang); }
    for (int i = tid; i < 448; i += NTH) gq[i] = i < 64 ? F.in[5][l * 64 + i] : i < 128 ? F.in[6][l * 64 + i - 64] : i < 320 ? F.in[21][l * 192 + i - 128] : F.in[22][l * 128 + i - 320]; }
    __syncthreads();
    bf16* hatt = WSP(bf16, OFF_HATT);
    for (int it = blockIdx.x * NTH + fresh_tid(F); it < NTOK * 6; it += gthreads(F)) {
        const int n = it / 6, hh = it % 6, s = n % SEQ, rowp = s / GRIDW, colp = s % GRIDW;
        uint4* p = reinterpret_cast<uint4*>(hatt + (size_t)n * 512 + hh * 64);
        const float* gn = gq + (hh < 4 ? 0 : 64);
        uint4 raw[8];
#pragma unroll
        for (int i = 0; i < 8; ++i) raw[i] = p[i];
        float x[64];
#pragma unroll
        for (int i = 0; i < 8; ++i) { x[8 * i] = bflo(raw[i].x); x[8 * i + 1] = bfhi(raw[i].x); x[8 * i + 2] = bflo(raw[i].y); x[8 * i + 3] = bfhi(raw[i].y);
            x[8 * i + 4] = bflo(raw[i].z); x[8 * i + 5] = bfhi(raw[i].z); x[8 * i + 6] = bflo(raw[i].w); x[8 * i + 7] = bfhi(raw[i].w); }
        float ss = 0.f;
#pragma unroll
        for (int j = 0; j < 64; ++j) ss += x[j] * x[j];
        const float rs = 1.0f / sqrtf(ss * (1.0f / 64.0f) + RMS_EPS);
#pragma unroll
        for (int j = 0; j < 64; ++j) x[j] *= rs * gn[j];
#pragma unroll
        for (int half = 0; half < 2; ++half) {
            const int pos = half ? colp : rowp;
#pragma unroll
            for (int f = 0; f < 16; ++f) {
                const float cs = tabA[pos * 16 + f], sn = tabA[1024 + pos * 16 + f];
                const float x1 = x[half * 32 + f], x2 = x[half * 32 + 16 + f];
                x[half * 32 + f] = x1 * cs - x2 * sn; x[half * 32 + 16 + f] = x1 * sn + x2 * cs;
            }
        }
#pragma unroll
        for (int i = 0; i < 8; ++i) { uint4 o; o.x = pack_bf16(x[8 * i], x[8 * i + 1]); o.y = pack_bf16(x[8 * i + 2], x[8 * i + 3]); o.z = pack_bf16(x[8 * i + 4], x[8 * i + 5]); o.w = pack_bf16(x[8 * i + 6], x[8 * i + 7]); p[i] = o; }
    }
    bf16* hm = WSP(bf16, OFF_HMLA); bf16* kr = WSP(bf16, OFF_KROPE);
    for (int it = blockIdx.x * NTH + fresh_tid(F); it < NTOK * 3; it += gthreads(F)) {
        const int n = it / 3, which = it % 3;
        if (which < 2) {
            const int len = which ? 128 : 192; const float* gn = gq + (which ? 320 : 128);
            uint4* p = reinterpret_cast<uint4*>(hm + (size_t)n * 512 + (which ? 256 : 0));
            float ss = 0.f;
            for (int i = 0; i < len / 8; ++i) { const uint4 r = p[i];
                const float a0 = bflo(r.x), a1 = bfhi(r.x), a2 = bflo(r.y), a3 = bfhi(r.y), a4 = bflo(r.z), a5 = bfhi(r.z), a6 = bflo(r.w), a7 = bfhi(r.w);
                ss += a0 * a0 + a1 * a1 + a2 * a2 + a3 * a3 + a4 * a4 + a5 * a5 + a6 * a6 + a7 * a7; }
            const float rs = 1.0f / sqrtf(ss / (float)len + RMS_EPS);
            for (int i = 0; i < len / 8; ++i) { const uint4 r = p[i]; const float* g = gn + 8 * i; uint4 o;
                o.x = pack_bf16(bflo(r.x) * rs * g[0], bfhi(r.x) * rs * g[1]); o.y = pack_bf16(bflo(r.y) * rs * g[2], bfhi(r.y) * rs * g[3]);
                o.z = pack_bf16(bflo(r.z) * rs * g[4], bfhi(r.z) * rs * g[5]); o.w = pack_bf16(bflo(r.w) * rs * g[6], bfhi(r.w) * rs * g[7]); p[i] = o; }
        } else {
            const int s = n % SEQ, rowp = s / GRIDW, colp = s % GRIDW;
            const uint4* p = reinterpret_cast<const uint4*>(hm + (size_t)n * 512 + 192);
            float x[32];
#pragma unroll
            for (int i = 0; i < 4; ++i) { const uint4 r = p[i]; x[8 * i] = bflo(r.x); x[8 * i + 1] = bfhi(r.x); x[8 * i + 2] = bflo(r.y); x[8 * i + 3] = bfhi(r.y);
                x[8 * i + 4] = bflo(r.z); x[8 * i + 5] = bfhi(r.z); x[8 * i + 6] = bflo(r.w); x[8 * i + 7] = bfhi(r.w); }
            unsigned o[16];
#pragma unroll
            for (int m = 0; m < 16; ++m) {
                const int i1 = m < 8 ? m : 16 + (m - 8), pos = m < 8 ? rowp : colp, f = m & 7;
                const float cs = tabB[pos * 8 + f], sn = tabB[512 + pos * 8 + f];
                o[m] = pack_bf16(x[i1] * cs - x[i1 + 8] * sn, x[i1] * sn + x[i1 + 8] * cs);
            }
            uint4* q = reinterpret_cast<uint4*>(kr + (size_t)n * 32);
#pragma unroll
            for (int i = 0; i < 4; ++i) q[i] = make_uint4(o[4 * i], o[4 * i + 1], o[4 * i + 2], o[4 * i + 3]);
        }
    }
    {
        bf16* vt = WSP(bf16, OFF_VTATT); bf16* tl = (bf16*)(gq + 512);
        for (int tile = blockIdx.x; tile < BATCH * 2 * (SEQ / 64); tile += F.nblk) {
            const int b = tile / (2 * (SEQ / 64)), kv = (tile / (SEQ / 64)) % 2, t0 = (tile % (SEQ / 64)) * 64;
            __syncthreads();
            const int tid = fresh_tid(F);
            { const int t = tid >> 3, part = tid & 7;
              const uint4 r = *reinterpret_cast<const uint4*>(hatt + (size_t)(b * SEQ + t0 + t) * 512 + 384 + kv * 64 + part * 8);
              const unsigned w[4] = {r.x, r.y, r.z, r.w};
#pragma unroll
              for (int i = 0; i < 4; ++i) { tl[(part * 8 + 2 * i) * 72 + t] = (bf16)(w[i] & 0xffffu); tl[(part * 8 + 2 * i + 1) * 72 + t] = (bf16)(w[i] >> 16); } }
            __syncthreads();
            { const int dv = tid >> 3, part = tid & 7;
              *reinterpret_cast<uint4*>(vt + ((size_t)(b * 2 + kv) * 64 + dv) * SEQ + t0 + part * 8) = *reinterpret_cast<const uint4*>(tl + dv * 72 + part * 8); }
        }
    }
}

DI void prep_hgrn_gpu(const Frame& F, int l) {
    bf16* hh = WSP(bf16, OFF_HHGRN); bf16* hx = WSP(bf16, OFF_HX); bf16* ham = WSP(bf16, OFF_HAM); float* heg = WSP(float, OFF_HEG);
    const int tid = F.tid, wave = tid >> 6, lane = tid & 63, x = lane & 15, q = lane >> 4;
    bf16* stg = (bf16*)F.smem + wave * (4 * 16 * 72);
    for (int it = blockIdx.x * 8 + wave; it < (NTOK / 16) * 4; it += F.nblk * 8) {
        const int c = it >> 2, h = it & 3, n0 = c * 16, cj = h * 64 + lane;
        float mlb = 1.0f;
        if (l == 1) { const float a = F.in[19][cj], b = F.in[19][256 + cj]; const float m = fmaxf(a, b); const float ea = __expf(a - m), eb = __expf(b - m); mlb = ea / (ea + eb); }
        float qv[16], k0[16], k1[16], g0[16], g1[16]; bf16 vraw[16];
#pragma unroll
        for (int t = 0; t < 16; ++t) {
            const bf16* row = hh + (size_t)(n0 + t) * 1280 + cj;
            const float xq = bf2f(row[0]), x0 = bf2f(row[256]), x1 = bf2f(row[512]); vraw[t] = row[768];
            qv[t] = xq * fast_sigmoid(xq); k0[t] = mlb * fast_sigmoid(-x0); k1[t] = mlb * fast_sigmoid(-x1);
            g0[t] = __logf(1.0f - k0[t]); g1[t] = __logf(1.0f - k1[t]);
        }
#pragma unroll
        for (int t = 1; t < 16; ++t) { g0[t] += g0[t - 1]; g1[15 - t] += g1[16 - t]; }
        heg[((size_t)it * 2 + 0) * 64 + lane] = __expf(g0[15]); heg[((size_t)it * 2 + 1) * 64 + lane] = __expf(g1[0]);
        unsigned kt0[8], kt1[8], vt[8];
#pragma unroll
        for (int t = 0; t < 16; t += 2) {
            const float e0a = __expf(g0[t]), e0b = __expf(g0[t + 1]), e1a = __expf(g1[t]), e1b = __expf(g1[t + 1]);
            const float q0a = qv[t] * e0a, q0b = qv[t + 1] * e0b, q1a = qv[t] * e1a, q1b = qv[t + 1] * e1b;
            const float ka0 = k0[t] / e0a, kb0 = k0[t + 1] / e0b, ka1 = k1[t] / e1a, kb1 = k1[t + 1] / e1b;
            const bf16 bq0a = f2bf(q0a), bq0b = f2bf(q0b), bq1a = f2bf(q1a), bq1b = f2bf(q1b);
            hh[(size_t)(n0 + t) * 1280 + cj] = bq0a; hh[(size_t)(n0 + t + 1) * 1280 + cj] = bq0b;
            hx[(size_t)(n0 + t) * 256 + cj] = bq1a; hx[(size_t)(n0 + t + 1) * 256 + cj] = bq1b;
            kt0[t >> 1] = pack_bf16(ka0, kb0); kt1[t >> 1] = pack_bf16(ka1, kb1); vt[t >> 1] = (unsigned)vraw[t] | ((unsigned)vraw[t + 1] << 16);
            stg[0 * 1152 + t * 72 + lane] = bq0a; stg[0 * 1152 + (t + 1) * 72 + lane] = bq0b;
            stg[2 * 1152 + t * 72 + lane] = bq1a; stg[2 * 1152 + (t + 1) * 72 + lane] = bq1b;
            stg[1 * 1152 + t * 72 + lane] = (bf16)(kt0[t >> 1] & 0xffffu); stg[1 * 1152 + (t + 1) * 72 + lane] = (bf16)(kt0[t >> 1] >> 16);
            stg[3 * 1152 + t * 72 + lane] = (bf16)(kt1[t >> 1] & 0xffffu); stg[3 * 1152 + (t + 1) * 72 + lane] = (bf16)(kt1[t >> 1] >> 16);
        }
        { bf16* blk = hh + (size_t)(n0 + (lane >> 2)) * 1280 + h * 64 + (lane & 3) * 16;
          *reinterpret_cast<uint4*>(blk + 256) = make_uint4(kt0[0], kt0[1], kt0[2], kt0[3]); *reinterpret_cast<uint4*>(blk + 256 + 8) = make_uint4(kt0[4], kt0[5], kt0[6], kt0[7]);
          *reinterpret_cast<uint4*>(blk + 512) = make_uint4(kt1[0], kt1[1], kt1[2], kt1[3]); *reinterpret_cast<uint4*>(blk + 512 + 8) = make_uint4(kt1[4], kt1[5], kt1[6], kt1[7]);
          *reinterpret_cast<uint4*>(blk + 768) = make_uint4(vt[0], vt[1], vt[2], vt[3]); *reinterpret_cast<uint4*>(blk + 768 + 8) = make_uint4(vt[4], vt[5], vt[6], vt[7]); }
        asm volatile("s_waitcnt lgkmcnt(0)" ::: "memory");
        __builtin_amdgcn_wave_barrier();
#pragma unroll
        for (int d = 0; d < 2; ++d) {
            f32x4 acc = {0.f, 0.f, 0.f, 0.f};
#pragma unroll
            for (int ks = 0; ks < 2; ++ks) {
                const bf16x8 a = *reinterpret_cast<const bf16x8*>(stg + (2 * d) * 1152 + x * 72 + 32 * ks + 8 * q);
                const bf16x8 b = *reinterpret_cast<const bf16x8*>(stg + (2 * d + 1) * 1152 + x * 72 + 32 * ks + 8 * q);
                acc = __builtin_amdgcn_mfma_f32_16x16x32_bf16(a, b, acc, 0, 0, 0);
            }
            bf16* am = ham + ((size_t)it * 2 + d) * 256;
#pragma unroll
            for (int r = 0; r < 4; ++r) { const int t = 4 * q + r; const bool keep = d ? (x >= t) : (x <= t); am[t * 16 + x] = f2bf(keep ? acc[r] : 0.f); }
        }
        __builtin_amdgcn_wave_barrier();
    }
}

DI void scan_hgrn_chunk(const Frame& F, int chain) {
    const int d = chain / (BATCH * 4), b = (chain / 4) % BATCH, h = chain % 4;
    const int lane = fresh_tid(F) & 63, x = lane & 15, q = lane >> 4;
    bf16* hh = WSP(bf16, OFF_HHGRN); const bf16* hx = WSP(bf16, OFF_HX); const bf16* ham = WSP(bf16, OFF_HAM); const float* heg = WSP(float, OFF_HEG);
    f32x4 S[4][4];
#pragma unroll
    for (int a = 0; a < 4; ++a)
#pragma unroll
        for (int c = 0; c < 4; ++c) S[a][c] = (f32x4){0.f, 0.f, 0.f, 0.f};
    constexpr int NCH = SEQ / 16;
    uint2 nQ[4], nA, nK[4], nV[4]; float4 nE[4];
    const unsigned lq = (unsigned)(x * (d ? 256 : 1280) + h * 64 + 4 * q);
    const unsigned lb = (unsigned)((x >> 2) * 1280 + h * 64 + (x & 3) * 16 + 4 * q);
    const unsigned la = (unsigned)(x * 16 + 4 * q), le = (unsigned)(4 * q), lo = (unsigned)(4 * q * 1280 + x);
#define HG_LOAD(cc_) do { const int c_ = d ? NCH - 1 - (cc_) : (cc_); const unsigned n0_ = (unsigned)(b * SEQ + 16 * c_); const unsigned it_ = (n0_ >> 4) * 4 + h; \
        const bf16* qb_ = d ? hx + (size_t)n0_ * 256 : hh + (size_t)n0_ * 1280; const bf16* hb_ = hh + (size_t)n0_ * 1280; \
        const bf16* ab_ = ham + (size_t)(it_ * 2 + d) * 256; const float* eb_ = heg + (size_t)(it_ * 2 + d) * 64; \
        _Pragma("unroll") for (int u_ = 0; u_ < 4; ++u_) nQ[u_] = *reinterpret_cast<const uint2*>(qb_ + lq + 16 * u_); \
        nA = *reinterpret_cast<const uint2*>(ab_ + la); \
        _Pragma("unroll") for (int u_ = 0; u_ < 4; ++u_) { \
            nK[u_] = *reinterpret_cast<const uint2*>(hb_ + lb + (4 * u_) * 1280 + 256 + d * 256); nV[u_] = *reinterpret_cast<const uint2*>(hb_ + lb + (4 * u_) * 1280 + 768); \
            nE[u_] = *reinterpret_cast<const float4*>(eb_ + le + 16 * u_); } } while (0)
    HG_LOAD(0);
    for (int cc = 0; cc < NCH; ++cc) {
        uint2 cQ[4], cA, cK[4], cV[4]; float4 cE[4];
#pragma unroll
        for (int u = 0; u < 4; ++u) { cQ[u] = nQ[u]; cK[u] = nK[u]; cV[u] = nV[u]; cE[u] = nE[u]; }
        cA = nA;
        if (cc + 1 < NCH) HG_LOAD(cc + 1);
        const int c = d ? NCH - 1 - cc : cc; const size_t n0 = (size_t)b * SEQ + 16 * c;
        union Fr { bf16x8 v; unsigned u[4]; };
        Fr aq0, aq1, aA; aq0.u[0] = cQ[0].x; aq0.u[1] = cQ[0].y; aq0.u[2] = cQ[1].x; aq0.u[3] = cQ[1].y;
        aq1.u[0] = cQ[2].x; aq1.u[1] = cQ[2].y; aq1.u[2] = cQ[3].x; aq1.u[3] = cQ[3].y;
        aA.u[0] = cA.x; aA.u[1] = cA.y; aA.u[2] = 0u; aA.u[3] = 0u;
#pragma unroll
        for (int it = 0; it < 4; ++it) {
            Fr bS0, bS1, bV;
            bS0.u[0] = pack_bf16(S[0][it][0], S[0][it][1]); bS0.u[1] = pack_bf16(S[0][it][2], S[0][it][3]); bS0.u[2] = pack_bf16(S[1][it][0], S[1][it][1]); bS0.u[3] = pack_bf16(S[1][it][2], S[1][it][3]);
            bS1.u[0] = pack_bf16(S[2][it][0], S[2][it][1]); bS1.u[1] = pack_bf16(S[2][it][2], S[2][it][3]); bS1.u[2] = pack_bf16(S[3][it][0], S[3][it][1]); bS1.u[3] = pack_bf16(S[3][it][2], S[3][it][3]);
            bV.u[0] = cV[it].x; bV.u[1] = cV[it].y; bV.u[2] = 0u; bV.u[3] = 0u;
            f32x4 O = {0.f, 0.f, 0.f, 0.f};
            O = __builtin_amdgcn_mfma_f32_16x16x32_bf16(aq0.v, bS0.v, O, 0, 0, 0);
            O = __builtin_amdgcn_mfma_f32_16x16x32_bf16(aq1.v, bS1.v, O, 0, 0, 0);
            O = __builtin_amdgcn_mfma_f32_16x16x32_bf16(aA.v, bV.v, O, 0, 0, 0);
            bf16* od = hh + n0 * 1280 + 256 + d * 256 + h * 64 + 16 * it;
#pragma unroll
            for (int r = 0; r < 4; ++r) od[lo + (unsigned)(r * 1280)] = f2bf(O[r]);
#pragma unroll
            for (int jt = 0; jt < 4; ++jt) {
                Fr aK; aK.u[0] = cK[jt].x; aK.u[1] = cK[jt].y; aK.u[2] = 0u; aK.u[3] = 0u;
                f32x4 t = __builtin_amdgcn_mfma_f32_16x16x32_bf16(aK.v, bV.v, S[jt][it], 0, 0, 0);
                t[0] *= cE[jt].x; t[1] *= cE[jt].y; t[2] *= cE[jt].z; t[3] *= cE[jt].w;
                S[jt][it] = t;
            }
        }
    }
#undef HG_LOAD
}

DI void prep_rwkv_gpu(const Frame& F, int l) {
    const bf16* hz = WSP(bf16, OFF_HRWKV); bf16* r7 = WSP(bf16, OFF_R7); bf16* gb = WSP(bf16, OFF_G); float* bonus = WSP(float, OFF_BONUS);
    const float* mup = F.in[7] + l * 960; const float* mun = F.in[8] + l * 960;
    const float* w0 = F.in[9] + l * 512; const float* w2 = F.in[10] + (size_t)l * 2 * 32 * 256;
    const float* a0 = F.in[11] + l * 512; const float* a2 = F.in[12] + (size_t)l * 2 * 32 * 256;
    const float* g2 = F.in[13] + (size_t)l * 64 * 256;
    const size_t AS = (size_t)NTOK * 256;
    float* zs = (float*)F.smem;
    const int tid = F.tid, c = tid & 255, tg = tid >> 8;
    const float w0a = w0[c], w0b = w0[256 + c], a0a = a0[c], a0b = a0[256 + c];
    const float kkc = F.in[14][l * 256 + c], kac = F.in[15][l * 256 + c], rkc = F.in[16][l * 256 + c];
    for (int tile = blockIdx.x; tile < NTOK / 16; tile += F.nblk) {
        const int n0 = tile * 16;
        __syncthreads();
        const int tl = fresh_tid(F);
#pragma unroll
        for (int bt = 0; bt < 3; ++bt) {
            unsigned zc[5], zp[5], zn[5];
#pragma unroll
            for (int i = 0; i < 5; ++i) {
                const int e = tl + (bt * 5 + i) * NTH, t = e / 480, cc = (e % 480) * 2, n = n0 + t, s = n % SEQ;
                zc[i] = *reinterpret_cast<const unsigned*>(hz + (size_t)n * 1024 + cc);
                zp[i] = s > 0 ? *reinterpret_cast<const unsigned*>(hz + (size_t)(n - 1) * 1024 + cc) : 0u;
                zn[i] = s < SEQ - 1 ? *reinterpret_cast<const unsigned*>(hz + (size_t)(n + 1) * 1024 + cc) : 0u;
            }
#pragma unroll
            for (int i = 0; i < 5; ++i) {
                const int e = tl + (bt * 5 + i) * NTH, t = e / 480, cc = (e % 480) * 2;
                const float2 mp = *reinterpret_cast<const float2*>(mup + cc), mn = *reinterpret_cast<const float2*>(mun + cc);
                float v0 = bflo(zc[i]), v1 = bfhi(zc[i]);
                v0 = v0 + mp.x * (bflo(zp[i]) - v0) + mn.x * (bflo(zn[i]) - v0);
                v1 = v1 + mp.y * (bfhi(zp[i]) - v1) + mn.y * (bfhi(zn[i]) - v1);
                if (cc >= 768 && cc < 832) { v0 = fast_tanh(v0); v1 = fast_tanh(v1); }
                else if (cc >= 896) { v0 = fast_sigmoid(v0); v1 = fast_sigmoid(v1); }
                *reinterpret_cast<float2*>(zs + t * 960 + cc) = make_float2(v0, v1);
            }
        }
        __syncthreads();
        float wr0[8], wr1[8], ar0[8], ar1[8], gg[8];
#pragma unroll
        for (int t = 0; t < 8; ++t) { wr0[t] = w0a; wr1[t] = w0b; ar0[t] = a0a; ar1[t] = a0b; gg[t] = 0.f; }
        for (int q = 0; q < 32; q += 4) {
            float wa[4], wb[4], aa[4], ab[4];
#pragma unroll
            for (int u = 0; u < 4; ++u) { wa[u] = w2[(size_t)(q + u) * 256 + c]; wb[u] = w2[(size_t)(32 + q + u) * 256 + c]; aa[u] = a2[(size_t)(q + u) * 256 + c]; ab[u] = a2[(size_t)(32 + q + u) * 256 + c]; }
#pragma unroll
            for (int t = 0; t < 8; ++t) {
                const float* zr = zs + (tg * 8 + t) * 960;
                const float4 x0 = *reinterpret_cast<const float4*>(zr + 768 + q), x1 = *reinterpret_cast<const float4*>(zr + 800 + q);
                const float4 y0 = *reinterpret_cast<const float4*>(zr + 832 + q), y1 = *reinterpret_cast<const float4*>(zr + 864 + q);
                wr0[t] += x0.x * wa[0] + x0.y * wa[1] + x0.z * wa[2] + x0.w * wa[3];
                wr1[t] += x1.x * wb[0] + x1.y * wb[1] + x1.z * wb[2] + x1.w * wb[3];
                ar0[t] += y0.x * aa[0] + y0.y * aa[1] + y0.z * aa[2] + y0.w * aa[3];
                ar1[t] += y1.x * ab[0] + y1.y * ab[1] + y1.z * ab[2] + y1.w * ab[3];
            }
        }
        for (int q = 0; q < 64; q += 4) {
            float ga[4];
#pragma unroll
            for (int u = 0; u < 4; ++u) ga[u] = g2[(size_t)(q + u) * 256 + c];
#pragma unroll
            for (int t = 0; t < 8; ++t) {
                const float4 x = *reinterpret_cast<const float4*>(zs + (tg * 8 + t) * 960 + 896 + q);
                gg[t] += x.x * ga[0] + x.y * ga[1] + x.z * ga[2] + x.w * ga[3];
            }
        }
        bf16* stg = (bf16*)(F.smem + 61440);
        float* nts = (float*)(F.smem + 61440 + 73728);
        float* xch = (float*)(F.smem + 61440 + 73728 + 8192);
        const int hh_ = c >> 6, j = c & 63;
        float lw0[8], lw1[8], G0[8], G1[8];
#pragma unroll
        for (int t = 0; t < 8; ++t) { lw0[t] = -DECAY_SCALE * fast_sigmoid(wr0[t]); lw1[t] = -DECAY_SCALE * fast_sigmoid(wr1[t]); }
        G0[0] = lw0[0]; G1[7] = lw1[7];
#pragma unroll
        for (int t = 1; t < 8; ++t) { G0[t] = G0[t - 1] + lw0[t]; G1[7 - t] = G1[8 - t] + lw1[7 - t]; }
        xch[(tg * 256 + c) * 2] = G0[7]; xch[(tg * 256 + c) * 2 + 1] = G1[0];
        __syncthreads();
        const float tot0 = xch[c * 2] + xch[(256 + c) * 2], tot1 = xch[c * 2 + 1] + xch[(256 + c) * 2 + 1];
        const float off0 = tg ? xch[c * 2] : 0.f, off1 = tg ? 0.f : xch[(256 + c) * 2 + 1];
        unsigned pk0[4], pk1[4], pa0[4], pa1[4], pv[4];
        float kkq[2], aq0[2], aq1[2], vq[2], kq0[2], kq1[2];
#pragma unroll
        for (int t = 0; t < 8; ++t) {
            const int tau = tg * 8 + t, n = n0 + tau; const float* zr = zs + tau * 960;
            const float r = zr[c], k = zr[256 + c], v = zr[512 + c];
            const float A0 = fast_sigmoid(ar0[t]), A1 = fast_sigmoid(ar1[t]);
            const float kk = k * kkc;
            const float kd0 = k * (1.0f + (A0 - 1.0f) * kac), kd1 = k * (1.0f + (A1 - 1.0f) * kac);
            const float ss = grp_sum(F, kk * kk);
            const float bs = grp_sum(F, r * (kd0 + kd1) * rkc);
            const float kkn = kk * (1.0f / fmaxf(sqrtf(ss), 1e-12f));
            const float g0 = G0[t] + off0, g1 = G1[t] + off1;
            const float e0 = __expf(g0), e1 = __expf(g1), i0 = __expf(-g0), i1 = __expf(-g1);
            const float kt0 = kkn * __expf(g0 - lw0[t]), kt1 = kkn * __expf(g1 - lw1[t]);
            const float rt0 = r * e0, rt1 = r * e1, ks0 = kd0 * i0, ks1 = kd1 * i1, as0 = A0 * kkn * i0, as1 = A1 * kkn * i1;
            const size_t o = (size_t)n * 256 + c;
            const bf16 bkt0 = f2bf(kt0), bkt1 = f2bf(kt1), brt0 = f2bf(rt0), brt1 = f2bf(rt1), bks0 = f2bf(ks0), bks1 = f2bf(ks1), bas0 = f2bf(as0), bas1 = f2bf(as1);
            r7[C_KT0 * AS + o] = bkt0; r7[C_KT1 * AS + o] = bkt1; r7[C_RT0 * AS + o] = brt0; r7[C_RT1 * AS + o] = brt1;
            gb[o] = f2bf(gg[t]);
            if ((tid & 63) == 0) bonus[(size_t)n * 4 + hh_] = bs;
            bf16* s0 = stg + (size_t)((hh_ * 2 + 0) * 4) * 1152 + tau * 72 + j; bf16* s1 = stg + (size_t)((hh_ * 2 + 1) * 4) * 1152 + tau * 72 + j;
            s0[0] = bkt0; s0[1152] = brt0; s0[2 * 1152] = bas0; s0[3 * 1152] = bks0;
            s1[0] = bkt1; s1[1152] = brt1; s1[2 * 1152] = bas1; s1[3 * 1152] = bks1;
            if (t & 1) { pk0[t >> 1] = pack_bf16(kq0[0], ks0); pk1[t >> 1] = pack_bf16(kq1[0], ks1); pa0[t >> 1] = pack_bf16(-aq0[0], -as0); pa1[t >> 1] = pack_bf16(-aq1[0], -as1); pv[t >> 1] = pack_bf16(vq[0], v); }
            else { kq0[0] = ks0; kq1[0] = ks1; aq0[0] = as0; aq1[0] = as1; vq[0] = v; }
            asm volatile("" ::: "memory");
        }
        (void)kkq;
        { const size_t tb = (size_t)(n0 + (j >> 2)) * 256 + hh_ * 64 + (j & 3) * 16 + 8 * tg;
          *reinterpret_cast<uint4*>(r7 + C_KK0 * AS + tb) = make_uint4(pk0[0], pk0[1], pk0[2], pk0[3]); *reinterpret_cast<uint4*>(r7 + C_KK1 * AS + tb) = make_uint4(pk1[0], pk1[1], pk1[2], pk1[3]);
          *reinterpret_cast<uint4*>(r7 + C_AT0 * AS + tb) = make_uint4(pa0[0], pa0[1], pa0[2], pa0[3]); *reinterpret_cast<uint4*>(r7 + C_AT1 * AS + tb) = make_uint4(pa1[0], pa1[1], pa1[2], pa1[3]);
          *reinterpret_cast<uint4*>(r7 + C_VT * AS + tb) = make_uint4(pv[0], pv[1], pv[2], pv[3]); }
        if (tg == 0) { bf16* reg = WSP(bf16, OFF_REG) + ((size_t)(tile * 4 + hh_) * 2) * 64 + j; reg[0] = f2bf(__expf(tot0)); reg[64] = f2bf(__expf(tot1)); }
        __syncthreads();
        {
            const int wv = tid >> 6, lane = tid & 63, x = lane & 15, q = lane >> 4, dd = wv & 1;
            const bf16* base = stg + (size_t)(wv * 4) * 1152;
            f32x4 nt = {0.f, 0.f, 0.f, 0.f}, mkk = nt, mkr = nt, mar = nt;
#pragma unroll
            for (int ks = 0; ks < 2; ++ks) {
                const bf16x8 fk = *reinterpret_cast<const bf16x8*>(base + x * 72 + 32 * ks + 8 * q);
                const bf16x8 fr = *reinterpret_cast<const bf16x8*>(base + 1152 + x * 72 + 32 * ks + 8 * q);
                const bf16x8 fa = *reinterpret_cast<const bf16x8*>(base + 2 * 1152 + x * 72 + 32 * ks + 8 * q);
                const bf16x8 fs = *reinterpret_cast<const bf16x8*>(base + 3 * 1152 + x * 72 + 32 * ks + 8 * q);
                nt = __builtin_amdgcn_mfma_f32_16x16x32_bf16(fk, fa, nt, 0, 0, 0);
                mkk = __builtin_amdgcn_mfma_f32_16x16x32_bf16(fk, fs, mkk, 0, 0, 0);
                mkr = __builtin_amdgcn_mfma_f32_16x16x32_bf16(fr, fs, mkr, 0, 0, 0);
                mar = __builtin_amdgcn_mfma_f32_16x16x32_bf16(fr, fa, mar, 0, 0, 0);
            }
            bf16* yc = WSP(bf16, OFF_YCAT); bf16* side = WSP(bf16, OFF_RSIDE);
            float* ntw = nts + wv * 256;
#pragma unroll
            for (int r = 0; r < 4; ++r) {
                const int t = 4 * q + r; const bool strict = dd ? (x > t) : (x < t), beq = dd ? (x >= t) : (x <= t);
                bf16* row = (t >= 1 && t <= 14) ? yc + (size_t)(n0 + t) * 1024 + 256 : side + ((size_t)tile * 2 + (t == 15 ? 1 : 0)) * 512;
                row += (wv * 4) * 16 + x;
                ntw[t * 16 + x] = strict ? nt[r] : 0.f;
                row[0] = f2bf(strict ? mkk[r] : 0.f); row[32] = f2bf(beq ? mkr[r] : 0.f); row[48] = f2bf(beq ? -mar[r] : 0.f);
            }
            asm volatile("s_waitcnt lgkmcnt(0)" ::: "memory");
            __builtin_amdgcn_wave_barrier();
            if (lane < 16) {
                float X[16];
                if (dd == 0) {
#pragma unroll
                    for (int t = 0; t < 16; ++t) { float a = (t == lane) ? 1.f : 0.f;
#pragma unroll
                        for (int s2 = 0; s2 < t; ++s2) a -= ntw[t * 16 + s2] * X[s2];
                        X[t] = a; }
                } else {
#pragma unroll
                    for (int t = 15; t >= 0; --t) { float a = (t == lane) ? 1.f : 0.f;
#pragma unroll
                        for (int s2 = t + 1; s2 < 16; ++s2) a -= ntw[t * 16 + s2] * X[s2];
                        X[t] = a; }
                }
#pragma unroll
                for (int t = 0; t < 16; ++t) {
                    bf16* row = (t >= 1 && t <= 14) ? yc + (size_t)(n0 + t) * 1024 + 256 : side + ((size_t)tile * 2 + (t == 15 ? 1 : 0)) * 512;
                    row[(wv * 4 + 1) * 16 + lane] = f2bf(X[t]);
                }
            }
        }
    }
}

DI void scan_rwkv_chunk(const Frame& F, int chain) {
    const int d = chain / (BATCH * 4), b = (chain / 4) % BATCH, h = chain % 4, combo = h * 2 + d;
    const int lane = fresh_tid(F) & 63, x = lane & 15, q = lane >> 4;
    const size_t AS = (size_t)NTOK * 256;
    bf16* r7 = WSP(bf16, OFF_R7); const bf16* yc = WSP(bf16, OFF_YCAT); const bf16* side = WSP(bf16, OFF_RSIDE); const bf16* reg = WSP(bf16, OFF_REG);
    bf16* akt = r7 + (d ? C_KT1 : C_KT0) * AS; const bf16* art = r7 + (d ? C_RT1 : C_RT0) * AS;
    const bf16* akk = r7 + (d ? C_KK1 : C_KK0) * AS; const bf16* aat = r7 + (d ? C_AT1 : C_AT0) * AS; const bf16* avt = r7 + C_VT * AS;
    f32x4 Z[4][4];
#pragma unroll
    for (int a = 0; a < 4; ++a)
#pragma unroll
        for (int c = 0; c < 4; ++c) Z[a][c] = (f32x4){0.f, 0.f, 0.f, 0.f};
    constexpr int NCH = SEQ / 16;
    const unsigned lq = (unsigned)(x * 256 + h * 64 + 4 * q);
    const unsigned lb = (unsigned)((x >> 2) * 256 + h * 64 + (x & 3) * 16 + 4 * q);
    const unsigned lm = (unsigned)((combo * 4) * 16 + 4 * q), le = (unsigned)(4 * q), lo = (unsigned)(4 * q * 256 + x);
    const bool edge = (x == 0) || (x == 15);
    uint2 nK[4], nR[4], nM[4], nV[4];
#define RW_LOAD(cc_) do { const int c_ = d ? NCH - 1 - (cc_) : (cc_); const unsigned n0_ = (unsigned)(b * SEQ + 16 * c_); const unsigned tl_ = n0_ >> 4; \
        const bf16* mrow_ = edge ? side + ((size_t)tl_ * 2 + (x == 15 ? 1 : 0)) * 512 : yc + (size_t)(n0_ + x) * 1024 + 256; const size_t rb_ = (size_t)n0_ * 256; \
        _Pragma("unroll") for (int u_ = 0; u_ < 4; ++u_) { \
            nK[u_] = *reinterpret_cast<const uint2*>(akt + rb_ + lq + 16 * u_); nR[u_] = *reinterpret_cast<const uint2*>(art + rb_ + lq + 16 * u_); \
            nM[u_] = *reinterpret_cast<const uint2*>(mrow_ + lm + 16 * u_); nV[u_] = *reinterpret_cast<const uint2*>(avt + rb_ + lb + (4 * u_) * 256); } } while (0)
    RW_LOAD(0);
    for (int cc = 0; cc < NCH; ++cc) {
        uint2 cK[4], cR[4], cM[4], cS[4], cA[4], cV[4], cE[4];
        const int c = d ? NCH - 1 - cc : cc; const size_t n0 = (size_t)b * SEQ + 16 * c;
        { const bf16* eb_ = reg + (size_t)(((unsigned)(n0 >> 4) * 4 + h) * 2 + d) * 64; const size_t rb_ = n0 * 256;
#pragma unroll
          for (int u = 0; u < 4; ++u) { cS[u] = *reinterpret_cast<const uint2*>(akk + rb_ + lb + (4 * u) * 256); cA[u] = *reinterpret_cast<const uint2*>(aat + rb_ + lb + (4 * u) * 256);
              cE[u] = *reinterpret_cast<const uint2*>(eb_ + le + 16 * u); } }
#pragma unroll
        for (int u = 0; u < 4; ++u) { cK[u] = nK[u]; cR[u] = nR[u]; cM[u] = nM[u]; cV[u] = nV[u]; }
        if (cc + 1 < NCH) RW_LOAD(cc + 1);
        union Fr { bf16x8 v; unsigned u[4]; };
        Fr aK0, aK1, aR0, aR1, aMk, aTT, aY;
        aK0.u[0] = cK[0].x; aK0.u[1] = cK[0].y; aK0.u[2] = cK[1].x; aK0.u[3] = cK[1].y; aK1.u[0] = cK[2].x; aK1.u[1] = cK[2].y; aK1.u[2] = cK[3].x; aK1.u[3] = cK[3].y;
        aR0.u[0] = cR[0].x; aR0.u[1] = cR[0].y; aR0.u[2] = cR[1].x; aR0.u[3] = cR[1].y; aR1.u[0] = cR[2].x; aR1.u[1] = cR[2].y; aR1.u[2] = cR[3].x; aR1.u[3] = cR[3].y;
        aMk.u[0] = cM[0].x; aMk.u[1] = cM[0].y; aMk.u[2] = 0u; aMk.u[3] = 0u;
        aTT.u[0] = cM[1].x; aTT.u[1] = cM[1].y; aTT.u[2] = 0u; aTT.u[3] = 0u;
        aY.u[0] = cM[2].x; aY.u[1] = cM[2].y; aY.u[2] = cM[3].x; aY.u[3] = cM[3].y;
        float eg[4][4];
#pragma unroll
        for (int u = 0; u < 4; ++u) { eg[u][0] = bflo(cE[u].x); eg[u][1] = bfhi(cE[u].x); eg[u][2] = bflo(cE[u].y); eg[u][3] = bfhi(cE[u].y); }
#pragma unroll
        for (int it = 0; it < 4; ++it) {
            Fr bZ0, bZ1, bV, bB, bVU;
            bZ0.u[0] = pack_bf16(Z[0][it][0], Z[0][it][1]); bZ0.u[1] = pack_bf16(Z[0][it][2], Z[0][it][3]); bZ0.u[2] = pack_bf16(Z[1][it][0], Z[1][it][1]); bZ0.u[3] = pack_bf16(Z[1][it][2], Z[1][it][3]);
            bZ1.u[0] = pack_bf16(Z[2][it][0], Z[2][it][1]); bZ1.u[1] = pack_bf16(Z[2][it][2], Z[2][it][3]); bZ1.u[2] = pack_bf16(Z[3][it][0], Z[3][it][1]); bZ1.u[3] = pack_bf16(Z[3][it][2], Z[3][it][3]);
            const f32x4 zero = {0.f, 0.f, 0.f, 0.f};
            f32x4 P1 = __builtin_amdgcn_mfma_f32_16x16x32_bf16(aK0.v, bZ0.v, zero, 0, 0, 0); P1 = __builtin_amdgcn_mfma_f32_16x16x32_bf16(aK1.v, bZ1.v, P1, 0, 0, 0);
            f32x4 P2 = __builtin_amdgcn_mfma_f32_16x16x32_bf16(aR0.v, bZ0.v, zero, 0, 0, 0); P2 = __builtin_amdgcn_mfma_f32_16x16x32_bf16(aR1.v, bZ1.v, P2, 0, 0, 0);
            bV.u[0] = cV[it].x; bV.u[1] = cV[it].y; bV.u[2] = 0u; bV.u[3] = 0u;
            const f32x4 Bt = __builtin_amdgcn_mfma_f32_16x16x32_bf16(aMk.v, bV.v, P1, 0, 0, 0);
            bB.u[0] = pack_bf16(Bt[0], Bt[1]); bB.u[1] = pack_bf16(Bt[2], Bt[3]); bB.u[2] = 0u; bB.u[3] = 0u;
            const f32x4 Ut = __builtin_amdgcn_mfma_f32_16x16x32_bf16(aTT.v, bB.v, zero, 0, 0, 0);
            bVU.u[0] = cV[it].x; bVU.u[1] = cV[it].y; bVU.u[2] = pack_bf16(Ut[0], Ut[1]); bVU.u[3] = pack_bf16(Ut[2], Ut[3]);
            const f32x4 Y = __builtin_amdgcn_mfma_f32_16x16x32_bf16(aY.v, bVU.v, P2, 0, 0, 0);
            bf16* od = akt + n0 * 256 + h * 64 + 16 * it;
#pragma unroll
            for (int r = 0; r < 4; ++r) od[lo + (unsigned)(r * 256)] = f2bf(Y[r]);
#pragma unroll
            for (int jt = 0; jt < 4; ++jt) {
                Fr aS; aS.u[0] = cS[jt].x; aS.u[1] = cS[jt].y; aS.u[2] = cA[jt].x; aS.u[3] = cA[jt].y;
                f32x4 t = __builtin_amdgcn_mfma_f32_16x16x32_bf16(aS.v, bVU.v, Z[jt][it], 0, 0, 0);
                t[0] *= eg[jt][0]; t[1] *= eg[jt][1]; t[2] *= eg[jt][2]; t[3] *= eg[jt][3];
                Z[jt][it] = t;
            }
        }
    }
#undef RW_LOAD
}
#endif

DI void phase_prep(const Frame& F, int l) {
#ifndef CPU_EMU
    prep_attn_gpu(F, l); prep_rwkv_gpu(F, l); prep_hgrn_gpu(F, l);
#else
    {
        bf16* hatt = WSP(bf16, OFF_HATT); bf16* vt = WSP(bf16, OFF_VTATT);
        const float* qn = F.in[5] + l * 64; const float* kn = F.in[6] + l * 64;
        const int nitem = NTOK * 6;
        for (int it = ggrp(F); it < nitem; it += ngrp(F)) {
            const int n = it / 6, hh = it % 6;
            const int s = n % SEQ;
            bf16* p = hatt + (size_t)n * 512 + hh * 64;
            const float* gn = hh < 4 ? qn : kn;
            float v[PER64]; float ss = 0.f;
            for (int i = 0; i < PER64; ++i) { int j = glane(F) + i * GRP; v[i] = bf2f(p[j]); ss += v[i] * v[i]; }
            ss = grp_sum(F, ss); const float rs = 1.0f / sqrtf(ss * (1.0f / 64.0f) + RMS_EPS);
            float o[PER64];
#ifdef CPU_EMU
            float nv[64]; for (int j = 0; j < 64; ++j) nv[j] = v[j] * rs * gn[j];
#endif
            for (int i = 0; i < PER64; ++i) {
                int j = glane(F) + i * GRP;
                const int half = j >> 5, w = j & 31, f = w & 15, second = w >> 4;
                const float pos = half == 0 ? (float)(s / GRIDW) : (float)(s % GRIDW);
                const float ang = pos * rope_inv(2 * f, 32);
                const float cs = cosf(ang), sn = sinf(ang);
                const float mine = v[i] * rs * gn[j];
                const int jp = second ? j - 16 : j + 16;
#ifdef CPU_EMU
                const float partner = nv[jp];
#else
                const float partner = shfl_idx(F, v[0], jp) * rs * gn[jp];
#endif
                o[i] = second ? (partner * sn + mine * cs) : (mine * cs - partner * sn);
            }
            for (int i = 0; i < PER64; ++i) { int j = glane(F) + i * GRP; p[j] = f2bf(o[i]); }
        }
        for (size_t i = gtid_(F); i < (size_t)NTOK * 128; i += gthreads(F)) {
            const int n = (int)(i / 128), c = (int)(i % 128), b = n / SEQ, s = n % SEQ;
            vt[((size_t)b * 128 + c) * SEQ + s] = hatt[(size_t)n * 512 + 384 + c];
        }
    }
    {
        bf16* hm = WSP(bf16, OFF_HMLA); bf16* kr = WSP(bf16, OFF_KROPE);
        const float* qn = F.in[21] + l * 192; const float* kvn = F.in[22] + l * 128;
        for (int it = ggrp(F); it < NTOK * 2; it += ngrp(F)) {
            const int n = it >> 1, which = it & 1;
            bf16* p = hm + (size_t)n * 512 + (which ? 256 : 0);
            const int len = which ? 128 : 192; const float* gn = which ? kvn : qn;
            float ss = 0.f;
            for (int j = glane(F); j < len; j += GRP) { float x = bf2f(p[j]); ss += x * x; }
            ss = grp_sum(F, ss); const float rs = 1.0f / sqrtf(ss / (float)len + RMS_EPS);
            for (int j = glane(F); j < len; j += GRP) p[j] = f2bf(bf2f(p[j]) * rs * gn[j]);
        }
        for (int i = gtid_(F); i < NTOK * 16; i += gthreads(F)) {
            const int n = i >> 4, m = i & 15, s = n % SEQ;
            const bf16* src = hm + (size_t)n * 512 + 192;
            const int i1 = (m < 8 ? m : 16 + (m - 8)), i2 = i1 + 8;
            const float x1 = bf2f(src[i1]), x2 = bf2f(src[i2]);
            const float pos = m < 8 ? (float)(s / GRIDW) : (float)(s % GRIDW);
            const float ang = pos * rope_inv(2 * (m & 7), 16);
            const float cs = cosf(ang), sn = sinf(ang);
            kr[(size_t)n * 32 + 2 * m] = f2bf(x1 * cs - x2 * sn);
            kr[(size_t)n * 32 + 2 * m + 1] = f2bf(x1 * sn + x2 * cs);
        }
    }
#ifdef CPU_EMU
    {
        const bf16* hz = WSP(bf16, OFF_HRWKV); bf16* r7 = WSP(bf16, OFF_R7); bf16* gb = WSP(bf16, OFF_G); float* bonus = WSP(float, OFF_BONUS);
        const float* mup = F.in[7] + l * 960; const float* mun = F.in[8] + l * 960;
        const float* w0 = F.in[9] + l * 512; const float* w2 = F.in[10] + (size_t)l * 2 * 32 * 256;
        const float* a0 = F.in[11] + l * 512; const float* a2 = F.in[12] + (size_t)l * 2 * 32 * 256;
        const float* g2 = F.in[13] + (size_t)l * 64 * 256;
        const float* k_k = F.in[14] + l * 256; const float* k_a = F.in[15] + l * 256; const float* r_k = F.in[16] + l * 256;
        const size_t AS = (size_t)NTOK * 256;
        for (int it = ggrp(F); it < NTOK * 4; it += ngrp(F)) {
            const int n = it >> 2, h = it & 3, s = n % SEQ;
            const bf16* z = hz + (size_t)n * 1024;
            const bool hp = s > 0, hn = s < SEQ - 1;
            auto shifted = [&](int c) -> float {
                const float zc = bf2f(z[c]);
                const float zp = hp ? bf2f(z[c - 1024]) : 0.f, zn = hn ? bf2f(z[c + 1024]) : 0.f;
                return zc + mup[c] * (zp - zc) + mun[c] * (zn - zc);
            };
            float kkv[PER64], rr[PER64], kd0[PER64], kd1[PER64], aa0[PER64], aa1[PER64];
            float ss = 0.f, bs = 0.f;
            for (int i = 0; i < PER64; ++i) {
                const int j = glane(F) + i * GRP, c = h * 64 + j;
                const float r = shifted(c), k = shifted(256 + c), v = shifted(512 + c);
                float wr0 = w0[c], wr1 = w0[256 + c], ar0 = a0[c], ar1 = a0[256 + c], g = 0.f;
                for (int q = 0; q < 32; ++q) {
                    wr0 += tanhf(shifted(768 + q)) * w2[(size_t)q * 256 + c];
                    wr1 += tanhf(shifted(800 + q)) * w2[(size_t)(32 + q) * 256 + c];
                    ar0 += shifted(832 + q) * a2[(size_t)q * 256 + c];
                    ar1 += shifted(864 + q) * a2[(size_t)(32 + q) * 256 + c];
                }
                for (int q = 0; q < 64; ++q) g += sigmoidf_(shifted(896 + q)) * g2[(size_t)q * 256 + c];
                const float dec0 = expf(-DECAY_SCALE * sigmoidf_(wr0)), dec1 = expf(-DECAY_SCALE * sigmoidf_(wr1));
                const float A0 = sigmoidf_(ar0), A1 = sigmoidf_(ar1);
                const float kk = k * k_k[c];
                kkv[i] = kk; ss += kk * kk; rr[i] = r; aa0[i] = A0; aa1[i] = A1;
                kd0[i] = k * (1.0f + (A0 - 1.0f) * k_a[c]); kd1[i] = k * (1.0f + (A1 - 1.0f) * k_a[c]);
                bs += r * (kd0[i] + kd1[i]) * r_k[c];
                const size_t o = (size_t)n * 256 + c;
                r7[R_R * AS + o] = f2bf(r); r7[R_V * AS + o] = f2bf(v);
                r7[R_W0 * AS + o] = f2bf(dec0); r7[R_W1 * AS + o] = f2bf(dec1);
                r7[R_KD0 * AS + o] = f2bf(kd0[i]); r7[R_KD1 * AS + o] = f2bf(kd1[i]);
                gb[o] = f2bf(g);
            }
            ss = grp_sum(F, ss); bs = grp_sum(F, bs);
            const float inv = 1.0f / fmaxf(sqrtf(ss), 1e-12f);
            for (int i = 0; i < PER64; ++i) {
                const int j = glane(F) + i * GRP, c = h * 64 + j; const size_t o = (size_t)n * 256 + c;
                const float kk = kkv[i] * inv;
                r7[R_KK * AS + o] = f2bf(kk); r7[R_AK0 * AS + o] = f2bf(aa0[i] * kk); r7[R_AK1 * AS + o] = f2bf(aa1[i] * kk);
            }
            if (glane(F) == 0) bonus[(size_t)n * 4 + h] = bs;
        }
    }
#else
    prep_rwkv_gpu(F, l);
#endif
    {
        bf16* hh = WSP(bf16, OFF_HHGRN);
        const float* lg = F.in[19];
        for (size_t i = gtid_(F); i < (size_t)NTOK * 768; i += gthreads(F)) {
            const int n = (int)(i / 768), c = (int)(i % 768);
            bf16* p = hh + (size_t)n * 1280 + c;
            const float x = bf2f(*p);
            if (c < 256) { *p = f2bf(siluf_(x)); }
            else {
                const int d = c & 255;
                float lb = 0.f;
                if (l == 1) { const float a = lg[d], b = lg[256 + d]; const float m = fmaxf(a, b); const float ea = expf(a - m), eb = expf(b - m); lb = eb / (ea + eb); }
                *p = f2bf((1.0f - lb) * sigmoidf_(-x));
            }
        }
    }
#endif
}

struct EpiQMla {
    bf16* q; int row0, pn;
    DI void operator()(int r, int c, float a, float b, float cc, float d) const {
        const int row = row0 + r, col = pn * 256 + c;
        if (col >= 384) return;
        const int w = col % 96;
        if (w >= 64) {
            const int s = row % SEQ;
#pragma unroll
            for (int t = 0; t < 2; ++t) {
                const int m = ((w - 64) >> 1) + t;
                const float pos = m < 8 ? (float)(s / GRIDW) : (float)(s % GRIDW);
                const float ang = pos * rope_inv(2 * (m & 7), 16);
                const float cs = cosf(ang), sn = sinf(ang);
                float& x1 = t ? cc : a; float& x2 = t ? d : b;
                const float y1 = x1 * cs - x2 * sn, y2 = x1 * sn + x2 * cs; x1 = y1; x2 = y2;
            }
        }
        st_bf16x4(q + (size_t)row * 384 + col, a, b, cc, d);
    }
};
struct EpiKVMla {
    bf16* kn; bf16* vt; int row0, pn;
    DI void operator()(int r, int c, float a, float b, float cc, float d) const {
        const int row = row0 + r, col = pn * 256 + c, h = col >> 7, w = col & 127;
        if (w < 64) st_bf16x4(kn + (size_t)row * 256 + h * 64 + w, a, b, cc, d);
        else { const int bb = row / SEQ, s = row % SEQ; bf16* p = vt + ((size_t)bb * 256 + h * 64 + (w - 64)) * SEQ + s;
            p[0] = f2bf(a); p[SEQ] = f2bf(b); p[2 * SEQ] = f2bf(cc); p[3 * SEQ] = f2bf(d); }
    }
};
DI void phase_mlaup(const Frame& F) {
    const bf16* hm = WSP(bf16, OFF_HMLA); const char* wts = (const char*)WSP(bf16, OFF_WTS);
    const int nM = (NTOK + 255) / 256;
    for (int u = blockIdx.x; u < nM * 4; u += F.nblk) {
        const int pm = u >> 2, j = u & 3;
#ifdef CPU_EMU
        const int mr = min(256, NTOK - pm * 256);
#define MR , mr
#else
#define MR
#endif
        if (j < 2) { EpiQMla E{WSP(bf16, OFF_QMLA), pm * 256, j};
            gemm_unit(F, hm, 512, nullptr, pm * 256, (const bf16*)(wts + W_UQ_T), 256, j * 256, 256, E MR); }
        else { EpiKVMla E{WSP(bf16, OFF_KNOPE), WSP(bf16, OFF_VTMLA), pm * 256, j - 2};
            gemm_unit(F, hm + 256, 512, nullptr, pm * 256, (const bf16*)(wts + W_UKV_T), 256, (j - 2) * 256, 256, E MR); }
    }
}

struct AttnDesc {
    const bf16* q; int q_stride;
    int q_hstride;
    const bf16* k; int k_stride; int k_hstride;
    const bf16* k2; int k2_stride;
    int dk_main;
    const bf16* vt;
    bf16* o; int o_stride; int o_hstride;
    int H, HKV, SQ, SK;
    float scale;
};

#ifdef CPU_EMU
template <int DK, int DV>
void attn_phase(const Frame& F, const AttnDesc& A) {
    const int G = A.H / A.HKV;
    float* sc = (float*)malloc(sizeof(float) * A.SK);
    for (int b = 0; b < BATCH; ++b) for (int h = 0; h < A.H; ++h) for (int s = 0; s < A.SQ; ++s) {
        const int kv = h / G;
        const bf16* q = A.q + (size_t)(b * A.SQ + s) * A.q_stride + h * A.q_hstride;
        float mx = -1e30f;
        for (int key = 0; key < A.SK; ++key) {
            const bf16* kp = A.k + (size_t)(b * A.SK + key) * A.k_stride + kv * A.k_hstride;
            double acc = 0;
            for (int d = 0; d < DK; ++d) {
                float kvl = d < A.dk_main ? bf2f(kp[d]) : bf2f(A.k2[(size_t)(b * A.SK + key) * A.k2_stride + d - A.dk_main]);
                acc += (double)bf2f(q[d]) * kvl;
            }
            sc[key] = (float)acc * A.scale; mx = fmaxf(mx, sc[key]);
        }
        double sum = 0; for (int key = 0; key < A.SK; ++key) { sc[key] = expf(sc[key] - mx); sum += sc[key]; }
        for (int dv = 0; dv < DV; ++dv) {
            const bf16* vp = A.vt + ((size_t)(b * A.HKV + kv) * DV + dv) * A.SK;
            double acc = 0; for (int key = 0; key < A.SK; ++key) acc += (double)bf2f(f2bf(sc[key])) * bf2f(vp[key]);
            A.o[(size_t)(b * A.SQ + s) * A.o_stride + h * A.o_hstride + dv] = f2bf((float)(acc / sum));
        }
    }
    free(sc);
}
#else
DI int crow16(int reg, int h) { return (reg & 3) + 8 * (reg >> 2) + 4 * h; }
template <int DK, int DV, int DVT>
DI void attn_unit(const Frame& F, const AttnDesc& A, int u) {
    constexpr int KP = DK + 8;
    constexpr int VP = 64 + 8;
    constexpr int NPASS = DV / DVT;
    bf16* Ks = (bf16*)F.smem;
    bf16* Vs = Ks + 64 * KP;
    const int tid = F.tid, wave = tid >> 6, lane = tid & 63, r = lane & 31, hh = lane >> 5;
    const int G = A.H / A.HKV;
    const int nqb = A.SQ / 256;
    const float sl2 = A.scale * 1.4426950408889634f;
    {
        int t = u; const int pass = t % NPASS; t /= NPASS; const int qb = t % nqb; t /= nqb; const int h = t % A.H; const int b = t / A.H;
        const int kv = h / G;
        const int q0 = qb * 256 + wave * 32;
        bf16x8 qf[DK / 16];
        { const bf16* qp = A.q + (size_t)(b * A.SQ + q0 + r) * A.q_stride + h * A.q_hstride + 8 * hh;
#pragma unroll
          for (int ks = 0; ks < DK / 16; ++ks) qf[ks] = *reinterpret_cast<const bf16x8*>(qp + 16 * ks); }
        f32x16 oacc[DVT / 32];
#pragma unroll
        for (int i = 0; i < DVT / 32; ++i)
#pragma unroll
            for (int j = 0; j < 16; ++j) oacc[i][j] = 0.f;
        float mrun = -INFINITY, lrun = 0.f;
        constexpr int NKC = (64 * (DK / 8) + 511) / 512, NVC = (DVT * 8 + 511) / 512;
        uint4 kr0, kr1, kr2, kr3, vr0, vr1;
        kr0 = kr1 = kr2 = kr3 = vr0 = vr1 = make_uint4(0u, 0u, 0u, 0u);
#define ATT_FK(kt_, i_, reg_) do { if ((i_) < NKC) { int c_ = tid + (i_) * 512; if (c_ >= 64 * (DK / 8)) c_ = 64 * (DK / 8) - 1; \
            const int key_ = c_ / (DK / 8), d8_ = (c_ % (DK / 8)) * 8; const size_t krow_ = (size_t)(b * A.SK + (kt_) * 64 + key_); \
            const bf16* kp_ = (d8_ < A.dk_main) ? (A.k + krow_ * A.k_stride + kv * A.k_hstride + d8_) : (A.k2 + krow_ * A.k2_stride + (d8_ - A.dk_main)); \
            reg_ = *reinterpret_cast<const uint4*>(kp_); } } while (0)
#define ATT_FV(kt_, i_, reg_) do { if ((i_) < NVC) { int c_ = tid + (i_) * 512; if (c_ >= DVT * 8) c_ = DVT * 8 - 1; \
            const int dv_ = c_ >> 3, k8_ = (c_ & 7) * 8; \
            reg_ = *reinterpret_cast<const uint4*>(A.vt + ((size_t)(b * A.HKV + kv) * DV + pass * DVT + dv_) * A.SK + (kt_) * 64 + k8_); } } while (0)
#define ATT_FETCH(kt_) do { ATT_FK(kt_, 0, kr0); ATT_FK(kt_, 1, kr1); ATT_FK(kt_, 2, kr2); ATT_FK(kt_, 3, kr3); ATT_FV(kt_, 0, vr0); ATT_FV(kt_, 1, vr1); } while (0)
#define ATT_SK(i_, reg_) do { if ((i_) < NKC) { const int c_ = tid + (i_) * 512; if (c_ < 64 * (DK / 8)) { \
            const int key_ = c_ / (DK / 8), d8_ = (c_ % (DK / 8)) * 8; *reinterpret_cast<uint4*>(Ks + key_ * KP + d8_) = reg_; } } } while (0)
#define ATT_SV(i_, reg_) do { if ((i_) < NVC) { const int c_ = tid + (i_) * 512; if (c_ < DVT * 8) { \
            const int dv_ = c_ >> 3, k8_ = (c_ & 7) * 8; *reinterpret_cast<uint4*>(Vs + dv_ * VP + k8_) = reg_; } } } while (0)
#define ATT_STORE() do { ATT_SK(0, kr0); ATT_SK(1, kr1); ATT_SK(2, kr2); ATT_SK(3, kr3); ATT_SV(0, vr0); ATT_SV(1, vr1); } while (0)
        constexpr bool PREF = DK <= 96;
        if (PREF) ATT_FETCH(0);
        for (int kt = 0; kt < A.SK / 64; ++kt) {
            __syncthreads();
            if (PREF) { ATT_STORE(); }
            else {
                for (int c = tid; c < 64 * (DK / 8); c += 512) {
                    const int key = c / (DK / 8), d8 = (c % (DK / 8)) * 8;
                    const size_t krow = (size_t)(b * A.SK + kt * 64 + key);
                    uint4 v;
                    if (d8 < A.dk_main) v = *reinterpret_cast<const uint4*>(A.k + krow * A.k_stride + kv * A.k_hstride + d8);
                    else v = *reinterpret_cast<const uint4*>(A.k2 + krow * A.k2_stride + (d8 - A.dk_main));
                    *reinterpret_cast<uint4*>(Ks + key * KP + d8) = v;
                }
                for (int c = tid; c < DVT * 8; c += 512) {
                    const int dv = c >> 3, k8 = (c & 7) * 8;
                    const uint4 v = *reinterpret_cast<const uint4*>(A.vt + ((size_t)(b * A.HKV + kv) * DV + pass * DVT + dv) * A.SK + kt * 64 + k8);
                    *reinterpret_cast<uint4*>(Vs + dv * VP + k8) = v;
                }
            }
            __syncthreads();
            if (PREF && kt + 1 < A.SK / 64) ATT_FETCH(kt + 1);
            f32x16 sacc[2];
#pragma unroll
            for (int kb = 0; kb < 2; ++kb) {
#pragma unroll
                for (int j = 0; j < 16; ++j) sacc[kb][j] = 0.f;
#pragma unroll
                for (int ks = 0; ks < DK / 16; ++ks) {
                    const bf16x8 kf = *reinterpret_cast<const bf16x8*>(Ks + (kb * 32 + r) * KP + 16 * ks + 8 * hh);
                    sacc[kb] = __builtin_amdgcn_mfma_f32_32x32x16_bf16(kf, qf[ks], sacc[kb], 0, 0, 0);
                }
            }
            float mx = -INFINITY;
#pragma unroll
            for (int kb = 0; kb < 2; ++kb)
#pragma unroll
                for (int j = 0; j < 16; ++j) mx = fmaxf(mx, sacc[kb][j]);
            mx = fmaxf(mx, shfl_xor(F, mx, 32));
            const float mnew = fmaxf(mrun, mx * sl2);
            const float alpha = exp2f(mrun - mnew);
            mrun = mnew;
            float psum = 0.f;
#pragma unroll
            for (int kb = 0; kb < 2; ++kb)
#pragma unroll
                for (int j = 0; j < 16; ++j) { const float p = exp2f(sacc[kb][j] * sl2 - mnew); sacc[kb][j] = p; psum += p; }
            lrun = lrun * alpha + psum;
#pragma unroll
            for (int i = 0; i < DVT / 32; ++i)
#pragma unroll
                for (int j = 0; j < 16; ++j) oacc[i][j] *= alpha;
#pragma unroll
            for (int kb = 0; kb < 2; ++kb)
#pragma unroll
                for (int s2 = 0; s2 < 2; ++s2) {
                    union { bf16x8 v; unsigned u[4]; } pf;
#pragma unroll
                    for (int j = 0; j < 4; ++j) pf.u[j] = pack_bf16(sacc[kb][8 * s2 + 2 * j], sacc[kb][8 * s2 + 2 * j + 1]);
#pragma unroll
                    for (int i = 0; i < DVT / 32; ++i) {
                        const bf16* vp = Vs + (i * 32 + r) * VP + kb * 32 + 16 * s2 + 4 * hh;
                        union { bf16x8 v; bf16x4 h2[2]; } vf;
                        vf.h2[0] = *reinterpret_cast<const bf16x4*>(vp);
                        vf.h2[1] = *reinterpret_cast<const bf16x4*>(vp + 8);
                        oacc[i] = __builtin_amdgcn_mfma_f32_32x32x16_bf16(vf.v, pf.v, oacc[i], 0, 0, 0);
                    }
                }
        }
        lrun += shfl_xor(F, lrun, 32);
        const float inv = 1.0f / lrun;
        bf16* op = A.o + (size_t)(b * A.SQ + q0 + r) * A.o_stride + h * A.o_hstride + pass * DVT;
#pragma unroll
        for (int i = 0; i < DVT / 32; ++i)
#pragma unroll
            for (int g = 0; g < 4; ++g)
                st_bf16x4(op + i * 32 + 8 * g + 4 * hh, oacc[i][4 * g] * inv, oacc[i][4 * g + 1] * inv, oacc[i][4 * g + 2] * inv, oacc[i][4 * g + 3] * inv);
    }
}
#endif

#undef ATT_FETCH
#undef ATT_STORE
#undef ATT_FK
#undef ATT_FV
#undef ATT_SK
#undef ATT_SV
#ifndef CPU_EMU
template <int DK, int DV, int DVT>
DI int attn_nunit(const AttnDesc& A) { return BATCH * A.H * (A.SQ / 256) * (DV / DVT); }
template <int DK, int DV, int DVT>
DI void attn_phase(const Frame& F, const AttnDesc& A) {
    const int nunit = attn_nunit<DK, DV, DVT>(A);
    for (int u = blockIdx.x; u < nunit; u += F.nblk) attn_unit<DK, DV, DVT>(F, A, u);
}
#endif
DI AttnDesc desc_gqa(const Frame& F) {
    AttnDesc A; A.q = WSP(bf16, OFF_HATT); A.q_stride = 512; A.q_hstride = 64;
    A.k = WSP(bf16, OFF_HATT) + 256; A.k_stride = 512; A.k_hstride = 64; A.k2 = nullptr; A.k2_stride = 0; A.dk_main = 64;
    A.vt = WSP(bf16, OFF_VTATT); A.o = WSP(bf16, OFF_YCAT); A.o_stride = 1024; A.o_hstride = 64;
    A.H = 4; A.HKV = 2; A.SQ = SEQ; A.SK = SEQ; A.scale = 0.125f; return A;
}
DI AttnDesc desc_mla(const Frame& F) {
    AttnDesc A; A.q = WSP(bf16, OFF_QMLA); A.q_stride = 384; A.q_hstride = 96;
    A.k = WSP(bf16, OFF_KNOPE); A.k_stride = 256; A.k_hstride = 64; A.k2 = WSP(bf16, OFF_KROPE); A.k2_stride = 32; A.dk_main = 64;
    A.vt = WSP(bf16, OFF_VTMLA); A.o = WSP(bf16, OFF_YCAT) + 768; A.o_stride = 1024; A.o_hstride = 64;
    A.H = 4; A.HKV = 4; A.SQ = SEQ; A.SK = SEQ; A.scale = 0.10206207261596575f; return A;
}
DI AttnDesc desc_mem(const Frame& F) {
    AttnDesc A; A.q = WSP(bf16, OFF_QMEM); A.q_stride = 1024; A.q_hstride = 256;
    A.k = WSP(bf16, OFF_KMEM); A.k_stride = 1024; A.k_hstride = 256; A.k2 = nullptr; A.k2_stride = 0; A.dk_main = 256;
    A.vt = WSP(bf16, OFF_VTMEM); A.o = WSP(bf16, OFF_OMEM); A.o_stride = 1024; A.o_hstride = 256;
    A.H = 4; A.HKV = 4; A.SQ = SEQ; A.SK = MEMT; A.scale = 0.0625f; return A;
}

#ifndef CPU_EMU
typedef float f32p __attribute__((ext_vector_type(2)));
DI f32p allsum16p(f32p x) { x.x = allsum16(x.x); x.y = allsum16(x.y); return x; }
template <int KIND>
DI void scan_chain(const Frame& F, int chain) {
    constexpr int T = 32;
    constexpr int NARR = KIND == 0 ? 6 : 3;
    constexpr int STEPB = NARR * 256;
    constexpr int NPIECE = T * NARR * 8;
    constexpr int PPT = (NPIECE + NTH - 1) / NTH;
    const int d = chain / (BATCH * 4), b = (chain / 4) % BATCH, h = chain % 4;
    const int tid = F.tid, wave = tid >> 6, lane = tid & 63, rg = lane >> 4, cg = lane & 15;
    unsigned char* buf0 = F.smem; unsigned char* buf1 = F.smem + T * STEPB;
    unsigned char* ybuf = F.smem + 2 * T * STEPB;
    const size_t AS = (size_t)NTOK * 256;
    bf16* r7 = WSP(bf16, OFF_R7); bf16* hh = WSP(bf16, OFF_HHGRN);
#define PIECE_PTR(t0, p_) ([&]() -> const uint4* { const int pc = (p_) < NPIECE ? (p_) : NPIECE - 1; \
        const int st = pc / (NARR * 8), rem = pc % (NARR * 8), arr = rem >> 3, part = rem & 7; \
        const int tt = (t0) + st, ss = d ? SEQ - 1 - tt : tt; const size_t nn = (size_t)b * SEQ + ss; \
        const bf16* base; \
        if (KIND == 0) { const int aid = arr == 0 ? R_KK : arr == 1 ? (d ? R_W1 : R_W0) : arr == 2 ? (d ? R_AK1 : R_AK0) : arr == 3 ? (d ? R_KD1 : R_KD0) : arr == 4 ? R_R : R_V; \
            base = r7 + aid * AS + nn * 256 + h * 64; } \
        else { const int off = arr == 0 ? 256 + d * 256 : arr == 1 ? 0 : 768; base = hh + nn * 1280 + off + h * 64; } \
        return reinterpret_cast<const uint4*>(base + part * 8); }())
#define PUT_PIECE(dst, p_, v_) do { float4 a_, b_; a_.x = bflo((v_).x); a_.y = bfhi((v_).x); a_.z = bflo((v_).y); a_.w = bfhi((v_).y); \
        b_.x = bflo((v_).z); b_.y = bfhi((v_).z); b_.z = bflo((v_).w); b_.w = bfhi((v_).w); \
        *reinterpret_cast<float4*>((dst) + (p_) * 32) = a_; *reinterpret_cast<float4*>((dst) + (p_) * 32 + 16) = b_; } while (0)
#define STORE_PRE(dst) do { PUT_PIECE(dst, tid, pre0); \
        if (tid + NTH < NPIECE) PUT_PIECE(dst, tid + NTH, pre1); \
        if (PPT > 2 && tid + 2 * NTH < NPIECE) PUT_PIECE(dst, tid + 2 * NTH, pre2); } while (0)
    uint4 pre0, pre1, pre2;
    pre0 = *PIECE_PTR(0, tid); pre1 = *PIECE_PTR(0, tid + NTH); pre2 = pre1;
    if (PPT > 2) pre2 = *PIECE_PTR(0, tid + 2 * NTH);
    __syncthreads();
    STORE_PRE(buf0);
    __syncthreads();
    f32p P[4];
#pragma unroll
    for (int c = 0; c < 4; ++c) P[c] = (f32p){0.f, 0.f};
    const int vofs = (wave * 8 + rg * 2) * 4;
    for (int ch = 0; ch < SEQ / T; ++ch) {
        const unsigned char* cur = (ch & 1) ? buf1 : buf0;
        if (ch + 1 < SEQ / T) {
            pre0 = *PIECE_PTR((ch + 1) * T, tid); pre1 = *PIECE_PTR((ch + 1) * T, tid + NTH);
            if (PPT > 2) pre2 = *PIECE_PTR((ch + 1) * T, tid + 2 * NTH);
        }
        float4 o0, o1, o2, o3, o4; f32p ov;
        { const unsigned char* sb = cur;
          o0 = *reinterpret_cast<const float4*>(sb + 0 * 256 + cg * 16); o1 = *reinterpret_cast<const float4*>(sb + 1 * 256 + cg * 16);
          if (KIND == 0) { o2 = *reinterpret_cast<const float4*>(sb + 2 * 256 + cg * 16); o3 = *reinterpret_cast<const float4*>(sb + 3 * 256 + cg * 16); o4 = *reinterpret_cast<const float4*>(sb + 4 * 256 + cg * 16); }
          ov = *reinterpret_cast<const f32p*>(sb + (NARR - 1) * 256 + vofs); }
        unsigned ykeep = 0u;
#pragma unroll 2
        for (int t = 0; t < T; ++t) {
            const float4 c0 = o0, c1 = o1, c2 = o2, c3 = o3, c4 = o4; const f32p v = ov;
            { const unsigned char* sb = cur + ((t + 1) & (T - 1)) * STEPB;
              o0 = *reinterpret_cast<const float4*>(sb + 0 * 256 + cg * 16); o1 = *reinterpret_cast<const float4*>(sb + 1 * 256 + cg * 16);
              if (KIND == 0) { o2 = *reinterpret_cast<const float4*>(sb + 2 * 256 + cg * 16); o3 = *reinterpret_cast<const float4*>(sb + 3 * 256 + cg * 16); o4 = *reinterpret_cast<const float4*>(sb + 4 * 256 + cg * 16); }
              ov = *reinterpret_cast<const f32p*>(sb + (NARR - 1) * 256 + vofs); }
            f32p y;
            if (KIND == 0) {
                f32p sa = P[0] * c0.x + P[1] * c0.y + P[2] * c0.z + P[3] * c0.w;
                sa = allsum16p(sa);
                P[0] = P[0] * c1.x - sa * c2.x + v * c3.x;
                P[1] = P[1] * c1.y - sa * c2.y + v * c3.y;
                P[2] = P[2] * c1.z - sa * c2.z + v * c3.z;
                P[3] = P[3] * c1.w - sa * c2.w + v * c3.w;
                y = P[0] * c4.x + P[1] * c4.y + P[2] * c4.z + P[3] * c4.w;
            } else {
                P[0] += (v - P[0]) * c0.x; P[1] += (v - P[1]) * c0.y; P[2] += (v - P[2]) * c0.z; P[3] += (v - P[3]) * c0.w;
                y = P[0] * c1.x + P[1] * c1.y + P[2] * c1.z + P[3] * c1.w;
            }
            y = allsum16p(y);
            const unsigned yp = pack_bf16(y.x, y.y);
            ykeep = ((t & 15) == cg) ? yp : ykeep;
            if ((t & 15) == 15) *reinterpret_cast<unsigned*>(ybuf + ((t & ~15) + cg) * 128 + (wave * 8 + rg * 2) * 2) = ykeep;
        }
        asm volatile("s_waitcnt lgkmcnt(0)" ::: "memory");
        __builtin_amdgcn_wave_barrier();
        if (lane < T) {
            const int t = ch * T + lane, s = d ? SEQ - 1 - t : t; const size_t n = (size_t)b * SEQ + s;
            const uint4 yv = *reinterpret_cast<const uint4*>(ybuf + lane * 128 + wave * 16);
            bf16* dst = KIND == 0 ? r7 + (d ? R_W1 : R_W0) * AS + n * 256 + h * 64 + wave * 8 : hh + n * 1280 + 256 + d * 256 + h * 64 + wave * 8;
            *reinterpret_cast<uint4*>(dst) = yv;
        }
        if (ch + 1 < SEQ / T) {
            unsigned char* nxt = (ch & 1) ? buf0 : buf1;
            STORE_PRE(nxt);
        }
        __syncthreads();
    }
#undef PIECE_PTR
#undef STORE_PRE
#undef PUT_PIECE
}
DI void phase_scans(const Frame& F) {
    const int nchain = 2 * BATCH * 4;
    for (int g = blockIdx.x; g < nchain / 4; g += F.nblk) {
        if (F.wv < 4) scan_rwkv_chunk(F, g * 4 + F.wv); else scan_hgrn_chunk(F, g * 4 + F.wv - 4);
    }
}
#else
DI void phase_scans(const Frame& F) {
    bf16* r7 = WSP(bf16, OFF_R7); const size_t AS = (size_t)NTOK * 256;
    bf16* hh = WSP(bf16, OFF_HHGRN);
    const int nitem = 2 * BATCH * 4 * 64 * 2;
    for (int it = wave_item_index(F); it < nitem; it += gthreads(F)) {
        const int kind = it / (2 * BATCH * 4 * 64);
        int c = (it % (2 * BATCH * 4 * 64)) / 64; const int i = it % 64;
        const int d = c / (BATCH * 4); c %= BATCH * 4; const int b = c / 4, h = c % 4;
        float S[64];
#pragma unroll
        for (int j = 0; j < 64; ++j) S[j] = 0.f;
        if (kind == 0) {
            const bf16* pr = r7 + R_R * AS, *pv = r7 + R_V * AS, *pkk = r7 + R_KK * AS;
            bf16* pw = r7 + (d ? R_W1 : R_W0) * AS; const bf16* pkd = r7 + (d ? R_KD1 : R_KD0) * AS, *pak = r7 + (d ? R_AK1 : R_AK0) * AS;
            for (int t = 0; t < SEQ; ++t) {
                const int s = d ? SEQ - 1 - t : t;
                const size_t o = ((size_t)(b * SEQ + s)) * 256 + h * 64;
                const float v = bf2f(pv[o + i]);
                float sa = 0.f;
#pragma unroll
                for (int j = 0; j < 64; ++j) sa += S[j] * bf2f(pkk[o + j]);
                float y = 0.f;
#pragma unroll
                for (int j = 0; j < 64; ++j) {
                    S[j] = S[j] * bf2f(pw[o + j]) - sa * bf2f(pak[o + j]) + v * bf2f(pkd[o + j]);
                    y += S[j] * bf2f(pr[o + j]);
                }
#ifndef CPU_EMU
                __builtin_amdgcn_wave_barrier();
#endif
#ifdef CPU_EMU
                WSP(bf16, OFF_EMU_SCAN)[(size_t)d * AS + (size_t)(b * SEQ + s) * 256 + h * 64 + i] = f2bf(y);
#else
                pw[o + i] = f2bf(y);
#endif
            }
        } else {
            const bf16* pq = hh; bf16* pk = hh + 256 + d * 256; const bf16* pi = hh + 768;
            for (int t = 0; t < SEQ; ++t) {
                const int s = d ? SEQ - 1 - t : t;
                const size_t o = ((size_t)(b * SEQ + s)) * 1280 + h * 64;
                const float v = bf2f(pi[o + i]);
                float acc = 0.f;
#pragma unroll
                for (int j = 0; j < 64; ++j) {
                    const float k = bf2f(pk[o + j]);
                    S[j] = S[j] + k * (v - S[j]);
                    acc += S[j] * bf2f(pq[o + j]);
                }
#ifndef CPU_EMU
                __builtin_amdgcn_wave_barrier();
#endif
#ifdef CPU_EMU
                WSP(bf16, OFF_EMU_SCAN)[(size_t)(2 + d) * AS + (size_t)(b * SEQ + s) * 256 + h * 64 + i] = f2bf(acc);
#else
                pk[o + i] = f2bf(acc);
#endif
            }
        }
    }
}

#endif

#ifndef CPU_EMU
DI void phase_fin_gpu(const Frame& F, int l) {
    const bf16* r7 = WSP(bf16, OFF_R7); const size_t AS = (size_t)NTOK * 256;
    const bf16* gb = WSP(bf16, OFF_G); const float* bonus = WSP(float, OFF_BONUS);
    const bf16* hh = WSP(bf16, OFF_HHGRN); bf16* ycat = WSP(bf16, OFF_YCAT);
    float* par = (float*)F.smem;
    __syncthreads();
    for (int i = F.tid; i < 768; i += NTH) par[i] = i < 256 ? F.in[17][l * 256 + i] : i < 512 ? F.in[18][l * 256 + i - 256] : F.in[20][l * 256 + i - 512];
    __syncthreads();
    for (int it = blockIdx.x * NTH + fresh_tid(F); it < NTOK * 8; it += gthreads(F)) {
        const int n = it >> 3, kind = (it >> 2) & 1, h = it & 3;
        const uint4* pa; const uint4* pb;
        if (kind == 0) { pa = reinterpret_cast<const uint4*>(r7 + C_KT0 * AS + (size_t)n * 256 + h * 64); pb = reinterpret_cast<const uint4*>(r7 + C_KT1 * AS + (size_t)n * 256 + h * 64); }
        else { pa = reinterpret_cast<const uint4*>(hh + (size_t)n * 1280 + 256 + h * 64); pb = reinterpret_cast<const uint4*>(hh + (size_t)n * 1280 + 512 + h * 64); }
        float y[64];
#pragma unroll
        for (int i = 0; i < 8; ++i) { const uint4 a = pa[i], b = pb[i];
            y[8 * i] = bflo(a.x) + bflo(b.x); y[8 * i + 1] = bfhi(a.x) + bfhi(b.x); y[8 * i + 2] = bflo(a.y) + bflo(b.y); y[8 * i + 3] = bfhi(a.y) + bfhi(b.y);
            y[8 * i + 4] = bflo(a.z) + bflo(b.z); y[8 * i + 5] = bfhi(a.z) + bfhi(b.z); y[8 * i + 6] = bflo(a.w) + bflo(b.w); y[8 * i + 7] = bfhi(a.w) + bfhi(b.w); }
        uint4* po = reinterpret_cast<uint4*>(ycat + (size_t)n * 1024 + (kind ? 512 : 256) + h * 64);
        if (kind == 0) {
            float s1 = 0.f;
#pragma unroll
            for (int j = 0; j < 64; ++j) s1 += y[j];
            const float mu = s1 * (1.0f / 64.0f);
            float s2 = 0.f;
#pragma unroll
            for (int j = 0; j < 64; ++j) { const float d = y[j] - mu; s2 += d * d; }
            const float rs = 1.0f / sqrtf(s2 * (1.0f / 64.0f) + GN_EPS);
            const float bo = bonus[(size_t)n * 4 + h];
            const bf16* pvt = r7 + C_VT * AS + (size_t)(n & ~15) * 256 + h * 64 + (n & 15);
            const uint4* pg = reinterpret_cast<const uint4*>(gb + (size_t)n * 256 + h * 64);
            const float* gg = par + h * 64; const float* gbias = par + 256 + h * 64;
#pragma unroll
            for (int i = 0; i < 8; ++i) { const uint4 g4 = pg[i];
                float vf[8];
#pragma unroll
                for (int j = 0; j < 8; ++j) { const int ci = 8 * i + j; vf[j] = bf2f(pvt[(size_t)(ci >> 2) * 256 + (ci & 3) * 16]); }
                const float gf[8] = {bflo(g4.x), bfhi(g4.x), bflo(g4.y), bfhi(g4.y), bflo(g4.z), bfhi(g4.z), bflo(g4.w), bfhi(g4.w)};
                float o[8];
#pragma unroll
                for (int j = 0; j < 8; ++j) o[j] = ((y[8 * i + j] - mu) * rs * gg[8 * i + j] + gbias[8 * i + j] + bo * vf[j]) * gf[j];
                po[i] = make_uint4(pack_bf16(o[0], o[1]), pack_bf16(o[2], o[3]), pack_bf16(o[4], o[5]), pack_bf16(o[6], o[7])); }
        } else {
            float s2 = 0.f;
#pragma unroll
            for (int j = 0; j < 64; ++j) s2 += y[j] * y[j];
            const float rs = 1.0f / sqrtf(s2 * (1.0f / 64.0f) + RMS_EPS);
            const uint4* pg = reinterpret_cast<const uint4*>(hh + (size_t)n * 1280 + 1024 + h * 64);
            const float* gg = par + 512 + h * 64;
#pragma unroll
            for (int i = 0; i < 8; ++i) { const uint4 g4 = pg[i];
                const float gf[8] = {bflo(g4.x), bfhi(g4.x), bflo(g4.y), bfhi(g4.y), bflo(g4.z), bfhi(g4.z), bflo(g4.w), bfhi(g4.w)};
                float o[8];
#pragma unroll
                for (int j = 0; j < 8; ++j) o[j] = y[8 * i + j] * rs * gg[8 * i + j] * (gf[j] * fast_sigmoid(gf[j]));
                po[i] = make_uint4(pack_bf16(o[0], o[1]), pack_bf16(o[2], o[3]), pack_bf16(o[4], o[5]), pack_bf16(o[6], o[7])); }
        }
    }
}
#endif
DI void phase_fin(const Frame& F, int l) {
    const bf16* r7 = WSP(bf16, OFF_R7); const size_t AS = (size_t)NTOK * 256;
    const bf16* gb = WSP(bf16, OFF_G); const float* bonus = WSP(float, OFF_BONUS);
    const bf16* hh = WSP(bf16, OFF_HHGRN); bf16* ycat = WSP(bf16, OFF_YCAT);
    const float* gng = F.in[17] + l * 256; const float* gnb = F.in[18] + l * 256; const float* hng = F.in[20] + l * 256;
    for (int it = ggrp(F); it < NTOK * 8; it += ngrp(F)) {
        const int n = it >> 3, kind = (it >> 2) & 1, h = it & 3;
        float v[PER64];
        if (kind == 0) {
            float s1 = 0.f;
            for (int i = 0; i < PER64; ++i) { const int c = h * 64 + glane(F) + i * GRP; const size_t o = (size_t)n * 256 + c;
#ifdef CPU_EMU
                v[i] = bf2f(WSP(bf16, OFF_EMU_SCAN)[o]) + bf2f(WSP(bf16, OFF_EMU_SCAN)[AS + o]); s1 += v[i]; }
#else
                v[i] = bf2f(r7[R_W0 * AS + o]) + bf2f(r7[R_W1 * AS + o]); s1 += v[i]; }
#endif
            s1 = grp_sum(F, s1); const float mu = s1 * (1.0f / 64.0f);
            float s2 = 0.f; for (int i = 0; i < PER64; ++i) { const float dd = v[i] - mu; s2 += dd * dd; }
            s2 = grp_sum(F, s2); const float rs = 1.0f / sqrtf(s2 * (1.0f / 64.0f) + GN_EPS);
            const float bo = bonus[(size_t)n * 4 + h];
            for (int i = 0; i < PER64; ++i) { const int c = h * 64 + glane(F) + i * GRP; const size_t o = (size_t)n * 256 + c;
                const float y = (v[i] - mu) * rs * gng[c] + gnb[c];
                ycat[(size_t)n * 1024 + 256 + c] = f2bf((y + bo * bf2f(r7[R_V * AS + o])) * bf2f(gb[o])); }
        } else {
            float s2 = 0.f;
            for (int i = 0; i < PER64; ++i) { const int c = h * 64 + glane(F) + i * GRP; const size_t o = (size_t)n * 1280 + c;
#ifdef CPU_EMU
                const size_t oe = (size_t)n * 256 + c;
                v[i] = bf2f(WSP(bf16, OFF_EMU_SCAN)[2 * AS + oe]) + bf2f(WSP(bf16, OFF_EMU_SCAN)[3 * AS + oe]); s2 += v[i] * v[i]; }
#else
                v[i] = bf2f(hh[o + 256]) + bf2f(hh[o + 512]); s2 += v[i] * v[i]; }
#endif
            s2 = grp_sum(F, s2); const float rs = 1.0f / sqrtf(s2 * (1.0f / 64.0f) + RMS_EPS);
            for (int i = 0; i < PER64; ++i) { const int c = h * 64 + glane(F) + i * GRP; const size_t o = (size_t)n * 1280 + c;
                ycat[(size_t)n * 1024 + 512 + c] = f2bf(v[i] * rs * hng[c] * siluf_(bf2f(hh[o + 1024]))); }
        }
    }
}

struct EpiResid {
    float* xf; int row0, pn;
    DI void operator()(int r, int c, float a, float b, float cc, float d) const {
        float* p = xf + (size_t)(row0 + r) * DM + pn * 256 + c;
#ifndef CPU_EMU
        float4 x = *reinterpret_cast<float4*>(p);
        x.x = DN_ALPHA * x.x + a; x.y = DN_ALPHA * x.y + b; x.z = DN_ALPHA * x.z + cc; x.w = DN_ALPHA * x.w + d;
        *reinterpret_cast<float4*>(p) = x;
#else
        p[0] = DN_ALPHA * p[0] + a; p[1] = DN_ALPHA * p[1] + b; p[2] = DN_ALPHA * p[2] + cc; p[3] = DN_ALPHA * p[3] + d;
#endif
    }
};
struct EpiBf {
    bf16* o; int ld; int row0, pn;
    DI void operator()(int r, int c, float a, float b, float cc, float d) const { st_bf16x4(o + (size_t)(row0 + r) * ld + pn * 256 + c, a, b, cc, d); }
};
template <int MODE>
DI void phase_gemm_sq(const Frame& F, const bf16* A, size_t woff, bf16* outb) {
    const bf16* W = (const bf16*)((const char*)WSP(bf16, OFF_WTS) + woff);
    const int nM = (NTOK + 255) / 256;
    for (int u = blockIdx.x; u < nM * 4; u += F.nblk) {
        const int pm = u >> 2, pn = u & 3;
#ifdef CPU_EMU
        const int mr = min(256, NTOK - pm * 256);
#endif
        if (MODE == 0) { EpiResid E{F.xf, pm * 256, pn}; gemm_unit(F, A, 1024, nullptr, pm * 256, W, 1024, pn * 256, 1024, E MR); }
        else { EpiBf E{outb, 1024, pm * 256, pn}; gemm_unit(F, A, 1024, nullptr, pm * 256, W, 1024, pn * 256, 1024, E MR); }
    }
}

DI void phase_ln(const Frame& F, const float* g, const float* b) {
#ifdef CPU_EMU
    const float* xf = F.xf;
    layer_norm_rows(F, g, b, [&](int row, int c) { return xf[(size_t)row * DM + c]; }, false, nullptr);
#else
    ln_rows_gpu<0>(F, g, b, 0);
#endif
}

#ifndef CPU_EMU
DI void phase_route_gpu(const Frame& F, int l) {
    const float* xf = F.xf; const float* gt = (const float*)((const char*)WSP(bf16, OFF_WTS) + W_GATE_T) + (size_t)l * 48 * 1024;
    const float* bg = F.in[34] + l * 4; const float* be = F.in[36] + l * 32;
    int* counts = (int*)(F.ws + CTL_CNT) + l * 32;
    int* lists = WSP(int, OFF_LISTS); float* tinfo = WSP(float, OFF_TINFO);
    const int tid = F.tid, wave = tid >> 6, lane = tid & 63, rr = lane & 15, kq = lane >> 4;
    float* lg = (float*)F.smem + wave * (16 * 48);
    __syncthreads();
    for (int rt = blockIdx.x * 8 + wave; rt < NTOK / 16; rt += F.nblk * 8) {
        const int r0 = rt * 16;
        f32x4 acc0 = {0.f, 0.f, 0.f, 0.f}, acc1 = acc0, acc2 = acc0;
        const float* xa = xf + (size_t)(r0 + rr) * DM + 4 * kq;
        const float* wb = gt + (size_t)rr * 1024 + 4 * kq;
#pragma unroll 2
        for (int k0 = 0; k0 < 1024; k0 += 16) {
            const float4 a = *reinterpret_cast<const float4*>(xa + k0);
            const float4 b0 = *reinterpret_cast<const float4*>(wb + k0), b1 = *reinterpret_cast<const float4*>(wb + 16 * 1024 + k0), b2 = *reinterpret_cast<const float4*>(wb + 32 * 1024 + k0);
            acc0 = __builtin_amdgcn_mfma_f32_16x16x4f32(a.x, b0.x, acc0, 0, 0, 0); acc1 = __builtin_amdgcn_mfma_f32_16x16x4f32(a.x, b1.x, acc1, 0, 0, 0); acc2 = __builtin_amdgcn_mfma_f32_16x16x4f32(a.x, b2.x, acc2, 0, 0, 0);
            acc0 = __builtin_amdgcn_mfma_f32_16x16x4f32(a.y, b0.y, acc0, 0, 0, 0); acc1 = __builtin_amdgcn_mfma_f32_16x16x4f32(a.y, b1.y, acc1, 0, 0, 0); acc2 = __builtin_amdgcn_mfma_f32_16x16x4f32(a.y, b2.y, acc2, 0, 0, 0);
            acc0 = __builtin_amdgcn_mfma_f32_16x16x4f32(a.z, b0.z, acc0, 0, 0, 0); acc1 = __builtin_amdgcn_mfma_f32_16x16x4f32(a.z, b1.z, acc1, 0, 0, 0); acc2 = __builtin_amdgcn_mfma_f32_16x16x4f32(a.z, b2.z, acc2, 0, 0, 0);
            acc0 = __builtin_amdgcn_mfma_f32_16x16x4f32(a.w, b0.w, acc0, 0, 0, 0); acc1 = __builtin_amdgcn_mfma_f32_16x16x4f32(a.w, b1.w, acc1, 0, 0, 0); acc2 = __builtin_amdgcn_mfma_f32_16x16x4f32(a.w, b2.w, acc2, 0, 0, 0);
        }
#pragma unroll
        for (int r = 0; r < 4; ++r) { lg[(4 * kq + r) * 48 + rr] = acc0[r]; lg[(4 * kq + r) * 48 + 16 + rr] = acc1[r]; lg[(4 * kq + r) * 48 + 32 + rr] = acc2[r]; }
        asm volatile("s_waitcnt lgkmcnt(0)" ::: "memory");
        __builtin_amdgcn_wave_barrier();
        if (lane < 16) {
            const int row = r0 + lane; const float* L = lg + lane * 48;
            float gl[4];
#pragma unroll
            for (int q = 0; q < 4; ++q) gl[q] = L[q] + bg[q];
            int gi = 0; float gm = gl[0];
#pragma unroll
            for (int q = 1; q < 4; ++q) if (gl[q] > gm) { gm = gl[q]; gi = q; }
            float den = 0.f;
#pragma unroll
            for (int q = 0; q < 4; ++q) den += expf(gl[q] - gm);
            const float pgroup = 1.0f / den;
            float el[8];
#pragma unroll
            for (int q = 0; q < 8; ++q) el[q] = L[4 + gi * 8 + q] + be[gi * 8 + q];
            int i0 = 0; float v0 = el[0];
#pragma unroll
            for (int q = 1; q < 8; ++q) if (el[q] > v0) { v0 = el[q]; i0 = q; }
            int i1 = -1; float v1 = -INFINITY;
#pragma unroll
            for (int q = 0; q < 8; ++q) if (q != i0 && el[q] > v1) { v1 = el[q]; i1 = q; }
            const float e1 = expf(v1 - v0); const float g0 = pgroup / (1.0f + e1), g1 = pgroup * e1 / (1.0f + e1);
            const int ea = gi * 8 + i0, eb = gi * 8 + i1;
            const int pa = atomicAdd(&counts[ea], 1), pb = atomicAdd(&counts[eb], 1);
            lists[(size_t)ea * NTOK + pa] = row; lists[(size_t)eb * NTOK + pb] = row;
            int* ti = (int*)(tinfo + (size_t)row * 8);
            ti[0] = ea; ti[1] = pa; ti[2] = eb; ti[3] = pb; tinfo[(size_t)row * 8 + 4] = g0; tinfo[(size_t)row * 8 + 5] = g1;
        }
        __builtin_amdgcn_wave_barrier();
    }
}
#endif
DI void phase_route(const Frame& F, int l) {
    const float* xf = F.xf;
    const float* wg = F.in[33] + (size_t)l * 1024 * 4; const float* bg = F.in[34] + l * 4;
    const float* we = F.in[35] + (size_t)l * 1024 * 32; const float* be = F.in[36] + l * 32;
    int* counts = (int*)(F.ws + CTL_CNT) + l * 32;
    int* lists = WSP(int, OFF_LISTS); float* tinfo = WSP(float, OFF_TINFO);
    for (int row = ggrp(F); row < NTOK; row += ngrp(F)) {
        float gl[4] = {0.f, 0.f, 0.f, 0.f};
        for (int i = 0; i < PERLN; ++i) { const int c = glane(F) + i * GRP; const float x = xf[(size_t)row * DM + c];
#pragma unroll
            for (int q = 0; q < 4; ++q) gl[q] += x * wg[c * 4 + q]; }
#pragma unroll
        for (int q = 0; q < 4; ++q) gl[q] = grp_sum(F, gl[q]) + bg[q];
        int gi = 0; float gm = gl[0];
#pragma unroll
        for (int q = 1; q < 4; ++q) if (gl[q] > gm) { gm = gl[q]; gi = q; }
        float den = 0.f;
#pragma unroll
        for (int q = 0; q < 4; ++q) den += expf(gl[q] - gm);
        const float pgroup = 1.0f / den;
        float el[8] = {0.f, 0.f, 0.f, 0.f, 0.f, 0.f, 0.f, 0.f};
        for (int i = 0; i < PERLN; ++i) { const int c = glane(F) + i * GRP; const float x = xf[(size_t)row * DM + c];
#pragma unroll
            for (int q = 0; q < 8; ++q) el[q] += x * we[c * 32 + gi * 8 + q]; }
#pragma unroll
        for (int q = 0; q < 8; ++q) el[q] = grp_sum(F, el[q]) + be[gi * 8 + q];
        int i0 = 0; float v0 = el[0];
#pragma unroll
        for (int q = 1; q < 8; ++q) if (el[q] > v0) { v0 = el[q]; i0 = q; }
        int i1 = -1; float v1 = -INFINITY;
#pragma unroll
        for (int q = 0; q < 8; ++q) if (q != i0 && el[q] > v1) { v1 = el[q]; i1 = q; }
        const float e1 = expf(v1 - v0); const float g0 = pgroup / (1.0f + e1), g1 = pgroup * e1 / (1.0f + e1);
        if (glane(F) == 0) {
            const int ea = gi * 8 + i0, eb = gi * 8 + i1;
            const int pa = atomicAdd(&counts[ea], 1), pb = atomicAdd(&counts[eb], 1);
            lists[(size_t)ea * NTOK + pa] = row; lists[(size_t)eb * NTOK + pb] = row;
            int* ti = (int*)(tinfo + (size_t)row * 8);
            ti[0] = ea; ti[1] = pa; ti[2] = eb; ti[3] = pb; tinfo[(size_t)row * 8 + 4] = g0; tinfo[(size_t)row * 8 + 5] = g1;
        }
    }
}

struct EpiMoeUp {
    bf16* hm; int row0, pn;
    DI void operator()(int r, int c, float a, float b, float cc, float d) const {
        bf16* p = hm + (size_t)(row0 + r) * 256 + ((pn * 256 + c) >> 1);
        p[0] = f2bf(siluf_(a) * b); p[1] = f2bf(siluf_(cc) * d);
    }
};
DI int ld_cnt(const int* p) {
#ifdef CPU_EMU
    return *p;
#else
    return __hip_atomic_load(p, __ATOMIC_RELAXED, __HIP_MEMORY_SCOPE_AGENT);
#endif
}
DI void moe_tiles(const int* counts, int* toff  ) {
    __syncthreads();
    if (threadIdx.x == 0) { int acc = 0; for (int e = 0; e < NEXP; ++e) { toff[e] = acc; acc += (ld_cnt(counts + e) + 255) >> 8; } toff[NEXP] = acc; }
    __syncthreads();
}
DI void phase_moe_up(const Frame& F, int l) {
    const int* counts = (const int*)(F.ws + CTL_CNT) + l * 32;
    int* eoff = (int*)(F.ws + CTL_EOFF) + l * 33;
    int* rowmap = (int*)(F.smem + 131072);
    int* toff = rowmap + 256;
    moe_tiles(counts, toff);
    if (blockIdx.x == 0 && threadIdx.x == 0) for (int e = 0; e <= NEXP; ++e) eoff[e] = toff[e] * 256;
    const int* lists = WSP(int, OFF_LISTS); const bf16* xb = WSP(bf16, OFF_XB);
    const int nunit = toff[NEXP] * 2;
    for (int u = blockIdx.x; u < nunit; u += F.nblk) {
        const int tile = u >> 1, pn = u & 1;
        int e = 0; while (toff[e + 1] <= tile) ++e;
        const int t0 = (tile - toff[e]) * 256, cnt = ld_cnt(counts + e);
        __syncthreads();
        for (int i = fresh_tid(F); i < 256; i += NTH) rowmap[i] = (t0 + i < cnt) ? lists[(size_t)e * NTOK + t0 + i] : 0;
        __syncthreads();
        EpiMoeUp E{WSP(bf16, OFF_HM), tile * 256, pn};
        gemm_unit(F, xb, 1024, rowmap, 0, WSP(bf16, OFF_W13T) + (size_t)e * 512 * 1024, 1024, pn * 256, 1024, E);
    }
}
DI void phase_moe_down(const Frame& F, int l) {
    const int* counts = (const int*)(F.ws + CTL_CNT) + l * 32;
    int* toff = (int*)(F.smem + 131072) + 256;
    moe_tiles(counts, toff);
    const int nunit = toff[NEXP] * 4;
    for (int u = blockIdx.x; u < nunit; u += F.nblk) {
        const int tile = u >> 2, pn = u & 3;
        int e = 0; while (toff[e + 1] <= tile) ++e;
        EpiBf E{WSP(bf16, OFF_YROWS), 1024, tile * 256, pn};
        gemm_unit(F, WSP(bf16, OFF_HM), 256, nullptr, tile * 256, WSP(bf16, OFF_W2T) + (size_t)e * 1024 * 256, 256, pn * 256, 256, E);
    }
}
DI void phase_ln3(const Frame& F, int l) {
#ifndef CPU_EMU
    ln_rows_gpu<2>(F, F.in[40] + l * 1024, F.in[41] + l * 1024, l);
#else
    const float* xf = F.xf; const bf16* yr = WSP(bf16, OFF_YROWS); const float* tinfo = WSP(float, OFF_TINFO);
    const int* eoff = (const int*)(F.ws + CTL_EOFF) + l * 33;
    layer_norm_rows(F, F.in[40] + l * 1024, F.in[41] + l * 1024, [&](int row, int c) {
        const int* ti = (const int*)(tinfo + (size_t)row * 8);
        const size_t ra = (size_t)eoff[ti[0]] + ti[1], rb = (size_t)eoff[ti[2]] + ti[3];
        return DN_ALPHA * xf[(size_t)row * DM + c] + tinfo[(size_t)row * 8 + 4] * bf2f(yr[ra * 1024 + c]) + tinfo[(size_t)row * 8 + 5] * bf2f(yr[rb * 1024 + c]);
    }, false, nullptr);
#endif
}

#ifndef CPU_EMU
#define XB_TMO      128
#define XB_XCNT(j)  (256  + 64 * (j))
#define XB_XSUB(j)  (1280 + 64 * (j))
#define XB_XGEN(j)  (2304 + 64 * (j))
#define XB_TOP      3328
#define XB_TOPGEN   3392
#define XCD_BAR_WORDS 3456
#define XB_SPIN_CAP (1u << 18)
#define LAS __attribute__((address_space(3)))

__device__ __forceinline__ unsigned xb_ld(unsigned* p)              { return __hip_atomic_load(p, __ATOMIC_RELAXED, __HIP_MEMORY_SCOPE_AGENT); }
__device__ __forceinline__ unsigned xb_add(unsigned* p, unsigned v) { return __hip_atomic_fetch_add(p, v, __ATOMIC_RELAXED, __HIP_MEMORY_SCOPE_AGENT); }
__device__ __forceinline__ unsigned xb_xcc_id() { return (unsigned)__builtin_amdgcn_s_getreg((3 << 11) | 20) & 0xFu; }
#define XB_SPIN(cond, bar) do { unsigned _sp = 0; while (cond) { __builtin_amdgcn_s_sleep(1); \
    if ((++_sp & 255u) == 0u) { if (xb_ld(&(bar)[XB_TMO])) break; if (_sp > XB_SPIN_CAP) { atomicAdd(&(bar)[XB_TMO], 1u); break; } } } } while (0)

struct XcdBarrier {
    unsigned* bar; unsigned x;
    volatile LAS unsigned* st;
};

__device__ __forceinline__ XcdBarrier xcd_barrier_post(unsigned* bar, volatile LAS unsigned* st) {
    XcdBarrier b; b.bar = bar; b.x = xb_xcc_id(); b.st = st;
    if (threadIdx.x == 0) (void)xb_add(&bar[XB_XCNT(b.x)], 1u);
    return b;
}
__device__ __forceinline__ void xcd_barrier_complete(unsigned* bar, unsigned x, unsigned& nloc, unsigned& nx) {
    const unsigned G = gridDim.x * gridDim.y * gridDim.z;
    unsigned sum, cnt, mine, sp = 0u;
    for (;;) {
        sum = 0u; cnt = 0u; mine = 0u;
#pragma unroll
        for (unsigned j = 0; j < 16; ++j) { const unsigned c = xb_ld(&bar[XB_XCNT(j)]); sum += c; cnt += (c > 0u) ? 1u : 0u; mine = (j == x) ? c : mine; }
        if (sum == G) break;
        __builtin_amdgcn_s_sleep(1);
        if ((++sp & 255u) == 0u) { if (xb_ld(&bar[XB_TMO])) break; if (sp > XB_SPIN_CAP) { atomicAdd(&bar[XB_TMO], 1u); break; } }
    }
    nloc = mine > 0u ? mine : 1u; nx = cnt > 0u ? cnt : 1u;
}

__device__ __forceinline__ void xcd_barrier(const XcdBarrier& b) {
    asm volatile("s_waitcnt vmcnt(0)" ::: "memory");
    __syncthreads();
    if (threadIdx.x == 0) {
        unsigned* bar = b.bar;
        __builtin_amdgcn_s_waitcnt(0);
        unsigned nloc = b.st[0], nx = b.st[1];
        if (nloc == 0u) { xcd_barrier_complete(bar, b.x, nloc, nx); b.st[0] = nloc; b.st[1] = nx; }
        const unsigned old = xb_add(&bar[XB_XSUB(b.x)], 1u);
        const unsigned gen = old / nloc;
        if (old + 1u == (gen + 1u) * nloc) {
            __builtin_amdgcn_fence(__ATOMIC_RELEASE, "agent");
            asm volatile("s_waitcnt vmcnt(0)" ::: "memory");
            const unsigned og = xb_add(&bar[XB_TOP], 1u);
            const unsigned tg = og / nx;
            if (og + 1u == (tg + 1u) * nx) xb_add(&bar[XB_TOPGEN], 1u);
            else XB_SPIN(xb_ld(&bar[XB_TOPGEN]) == tg, bar);
            __builtin_amdgcn_fence(__ATOMIC_ACQUIRE, "agent");
            xb_add(&bar[XB_XGEN(b.x)], 1u);
            asm volatile("s_waitcnt vmcnt(0)" ::: "memory");
        } else {
            XB_SPIN(xb_ld(&bar[XB_XGEN(b.x)]) == gen, bar);
            __builtin_amdgcn_fence(__ATOMIC_ACQUIRE, "agent");
            asm volatile("s_waitcnt vmcnt(0)" ::: "memory");
        }
    }
    __syncthreads();
}

#endif

constexpr int NPH_LAYER = 16;
constexpr int NPH_TOTAL = 1 + 2 * NPH_LAYER;
constexpr int SMEM_BYTES = 147456 + 1024;

#ifndef CPU_EMU
DI void phase_attn_queue(const Frame& F, int l) {
    {
            const AttnDesc Ag = desc_gqa(F), Am = desc_mla(F);
            const int ng = attn_nunit<64, 64, 64>(Ag), nm = attn_nunit<96, 64, 64>(Am);
            unsigned* qctr = (unsigned*)(F.ws + CTL_QUEUE) + l * 64;
            volatile int* slot = (volatile int*)(F.smem + SMEM_BYTES - 32);
            for (;;) {
                __syncthreads();
                if (F.tid == 0) *slot = (int)atomicAdd(qctr, 1u);
                __syncthreads();
                const int u = *slot;
                if (u >= ng + nm) break;
                if (u < ng) attn_unit<64, 64, 64>(F, Ag, u); else attn_unit<96, 64, 64>(F, Am, u - ng);
            }
        }
}
#endif

template <int K>
DI void run_layer_phase(const Frame& F, int l) {
    if constexpr (K == 0) phase_cvt(F, l);
    if constexpr (K == 1) phase_gemm1(F);
    if constexpr (K == 2) phase_prep(F, l);
    if constexpr (K == 3) phase_mlaup(F);
    if constexpr (K == 4) {
#ifdef CPU_EMU
        attn_phase<64, 64>(F, desc_gqa(F)); attn_phase<96, 64>(F, desc_mla(F)); phase_scans(F);
#else
        phase_scans(F);
        phase_attn_queue(F, l);
#endif
    }
#ifdef CPU_EMU
    if constexpr (K == 5) phase_fin(F, l);
#else
    if constexpr (K == 5) phase_fin_gpu(F, l);
#endif
    if constexpr (K == 6) phase_gemm_sq<0>(F, WSP(bf16, OFF_YCAT), W_OUT_T, nullptr);
    if constexpr (K == 7) phase_ln(F, F.in[26] + l * 1024, F.in[27] + l * 1024);
    if constexpr (K == 8) phase_gemm_sq<1>(F, WSP(bf16, OFF_XB), W_Q_T, WSP(bf16, OFF_QMEM));
    if constexpr (K == 9) {
#ifdef CPU_EMU
        attn_phase<256, 256>(F, desc_mem(F));
#else
        attn_phase<256, 256, 128>(F, desc_mem(F));
#endif
    }
    if constexpr (K == 10) phase_gemm_sq<0>(F, WSP(bf16, OFF_OMEM), W_O_T, nullptr);
    if constexpr (K == 11) { phase_ln(F, F.in[31] + l * 1024, F.in[32] + l * 1024); phase_cvt_moe(F, l); }
#ifdef CPU_EMU
    if constexpr (K == 12) phase_route(F, l);
#else
    if constexpr (K == 12) phase_route_gpu(F, l);
#endif
    if constexpr (K == 13) phase_moe_up(F, l);
    if constexpr (K == 14) phase_moe_down(F, l);
    if constexpr (K == 15) phase_ln3(F, l);
}

#ifndef CPU_EMU
template <int K>
__global__ void __launch_bounds__(512, 2) k_phase(Args a, int l) {
    extern __shared__ __attribute__((aligned(16))) unsigned char lds[];
    Frame F; F.in = (InPtr)__builtin_amdgcn_kernarg_segment_ptr(); F.xf = a.out; F.ws = a.ws; F.smem = lds; F.tid = threadIdx.x; F.wv = __builtin_amdgcn_readfirstlane((int)(threadIdx.x >> 6)); F.nblk = a.ph_lo;
    if constexpr (K < 0) phase_pro(F); else run_layer_phase<K>(F, l);
}

template <int K>
static void launch_phase(const Args& a, int l, int grid, hipStream_t stream) {
    static bool attr = false;
    if (!attr) { (void)hipFuncSetAttribute((const void*)k_phase<K>, hipFuncAttributeMaxDynamicSharedMemorySize, SMEM_BYTES); attr = true; }
    hipLaunchKernelGGL(k_phase<K>, dim3(grid), dim3(512), SMEM_BYTES, stream, a, l);
}

__global__ void __launch_bounds__(512, 2) fwd_one(Args a) {
    extern __shared__ __attribute__((aligned(16))) unsigned char lds[];
    const int wave_s = __builtin_amdgcn_readfirstlane((int)(threadIdx.x >> 6));
    volatile LAS unsigned* st = (volatile LAS unsigned*)(lds + SMEM_BYTES - 16);
    if (threadIdx.x == 0) { st[0] = 0u; st[1] = 0u; st[2] = 0u; st[3] = 0u; }
    __syncthreads();
    XcdBarrier bar = xcd_barrier_post((unsigned*)(a.ws + OFF_CTL), st);
    Frame F;
#define FRESH do { unsigned z_ = 0u, m_ = ~0u; int ws_ = wave_s; asm volatile("" : "+s"(z_), "+s"(ws_), "+s"(m_)); \
        int t_ = ws_ * 64 + (int)__builtin_amdgcn_mbcnt_hi(m_, __builtin_amdgcn_mbcnt_lo(m_, 0u)); asm volatile("" : "+v"(t_)); \
        const __attribute__((address_space(4))) char* kp_ = (const __attribute__((address_space(4))) char*)__builtin_amdgcn_kernarg_segment_ptr() + z_; \
        F.in = (InPtr)kp_; F.xf = *(float* const __attribute__((address_space(4)))*)(kp_ + 42 * 8); F.ws = *(unsigned char* const __attribute__((address_space(4)))*)(kp_ + 43 * 8); \
        F.smem = lds; F.tid = t_; F.wv = ws_; F.nblk = *(const int __attribute__((address_space(4)))*)(kp_ + 44 * 8); } while (0)
#define GB do { { unsigned zb_ = 0u; unsigned xx_ = __builtin_amdgcn_readfirstlane(bar.x); asm volatile("" : "+s"(zb_), "+s"(xx_)); bar.bar = (unsigned*)(a.ws + OFF_CTL) + zb_; bar.x = xx_; } \
        xcd_barrier(bar); } while (0)
#define DUP(k) ((PROBE_DUP >> (k)) & 1)
    FRESH; phase_pro(F); FRESH; phase_cvt(F, 0); GB;
    if (DUP(0)) { FRESH; phase_cvt(F, 0); GB; }
    for (int l = 0; l < 2; ++l) {
        FRESH; run_layer_phase<1>(F, l); GB;
        if (DUP(1)) { FRESH; run_layer_phase<1>(F, l); GB; }
        FRESH; run_layer_phase<2>(F, l); GB;
        FRESH; run_layer_phase<3>(F, l); GB;
        if (DUP(3)) { FRESH; run_layer_phase<3>(F, l); GB; }
        if (DUP(4)) { FRESH; attn_phase<64, 64, 64>(F, desc_gqa(F)); attn_phase<96, 64, 64>(F, desc_mla(F)); GB; }
        FRESH; run_layer_phase<4>(F, l); GB;
        FRESH; run_layer_phase<5>(F, l); GB;
        if (DUP(5)) { FRESH; run_layer_phase<5>(F, l); GB; }
        FRESH; run_layer_phase<6>(F, l); GB;
        FRESH; run_layer_phase<7>(F, l); GB;
        FRESH; run_layer_phase<8>(F, l); GB;
        if (DUP(8)) { FRESH; run_layer_phase<8>(F, l); GB; }
        FRESH; run_layer_phase<9>(F, l); GB;
        if (DUP(9)) { FRESH; run_layer_phase<9>(F, l); GB; }
        FRESH; run_layer_phase<10>(F, l); GB;
        FRESH; run_layer_phase<11>(F, l); FRESH; run_layer_phase<12>(F, l); if (l == 0) { FRESH; phase_cvt(F, 1); } GB;
        if (DUP(11)) { FRESH; phase_cvt_moe(F, l); GB; }
        FRESH; run_layer_phase<13>(F, l); GB;
        if (DUP(13)) { FRESH; run_layer_phase<13>(F, l); GB; }
        FRESH; run_layer_phase<14>(F, l); GB;
        if (DUP(14)) { FRESH; run_layer_phase<14>(F, l); GB; }
        FRESH; run_layer_phase<15>(F, l); if (l == 0) GB;
    }
#undef DUP
#undef GB
#undef FRESH
}

extern "C" void kernel_launch(void* const* d_in, const int* in_sizes, int n_in, void* d_out, int out_size, void* d_ws, size_t ws_size, hipStream_t stream) {
    if (n_in != 42 || ws_size < WS_END) return;
    Args a{};
    for (int i = 0; i < 42; ++i) a.in[i] = (const float*)d_in[i];
    a.out = (float*)d_out; a.ws = (unsigned char*)d_ws; a.ph_lo = 0; a.ph_hi = NPH_TOTAL;
    (void)hipMemsetAsync(d_ws, 0, CTL_BYTES, stream);
#if N_LAUNCH_MODE == 1
    static int grid = 0;
    if (!grid) {
        int dev = 0, cus = 0, per_cu = 0;
        (void)hipGetDevice(&dev);
        (void)hipDeviceGetAttribute(&cus, hipDeviceAttributeMultiprocessorCount, dev);
        (void)hipFuncSetAttribute((const void*)fwd_one, hipFuncAttributeMaxDynamicSharedMemorySize, SMEM_BYTES);
        (void)hipOccupancyMaxActiveBlocksPerMultiprocessor(&per_cu, (const void*)fwd_one, 512, SMEM_BYTES);
        (void)hipGetLastError();
        grid = cus > 0 ? cus : 256;
    }
    a.ph_lo = grid;
    hipLaunchKernelGGL(fwd_one, dim3(grid), dim3(512), SMEM_BYTES, stream, a);
#else
    const int grid = 256; a.ph_lo = grid;
    launch_phase<-1>(a, 0, grid, stream);
    for (int l = 0; l < 2; ++l) {
        launch_phase<0>(a, l, grid, stream); launch_phase<1>(a, l, grid, stream); launch_phase<2>(a, l, grid, stream); launch_phase<3>(a, l, grid, stream);
        launch_phase<4>(a, l, grid, stream); launch_phase<5>(a, l, grid, stream); launch_phase<6>(a, l, grid, stream); launch_phase<7>(a, l, grid, stream);
        launch_phase<8>(a, l, grid, stream); launch_phase<9>(a, l, grid, stream); launch_phase<10>(a, l, grid, stream); launch_phase<11>(a, l, grid, stream);
        launch_phase<12>(a, l, grid, stream); launch_phase<13>(a, l, grid, stream); launch_phase<14>(a, l, grid, stream); launch_phase<15>(a, l, grid, stream);
    }
#endif
}
#endif
```

```cpp
#ifndef CPU_EMU
#include <hip/hip_runtime.h>
#else
#include "emu_shim.h"
#endif
#include <stdint.h>

#ifndef CFG_B
#define CFG_B 16
#endif
#ifndef CFG_S
#define CFG_S 2048
#endif
#ifndef PROBE_DUP
#define PROBE_DUP 0
#endif
#ifndef N_LAUNCH_MODE
#define N_LAUNCH_MODE 1
#endif

typedef unsigned short bf16;
#define DI __device__ __forceinline__

constexpr int BATCH = CFG_B, SEQ = CFG_S, NTOK = BATCH * SEQ, DM = 1024;
constexpr int MEMT = 256, NMEM = BATCH * MEMT;
constexpr int GRIDW = 64;
constexpr int HP = 3328;
constexpr int IN_WIDTH = 3104;
constexpr int NEXP = 32, MOEH = 256;
constexpr int MOE_ROWS = 2 * NTOK + NEXP * 256;
constexpr float LN_EPS = 1e-5f, RMS_EPS = 1e-6f, GN_EPS = 64e-5f;
constexpr float DN_ALPHA = 1.41421356237309515f;
constexpr float DECAY_SCALE = 0.60653065971263342f;

constexpr size_t AL(size_t x) { return (x + 255) & ~(size_t)255; }
constexpr size_t OFF_CTL = 0;
constexpr size_t CTL_BYTES = 32768;
constexpr size_t CTL_CNT = 16384;
constexpr size_t CTL_EOFF = 16384 + 1024;
constexpr size_t CTL_QUEUE = 16384 + 2048;
constexpr size_t OFF_XB = AL(OFF_CTL + CTL_BYTES);
constexpr size_t SZ_XB = (size_t)NTOK * DM * 2;
constexpr size_t OFF_WTS = AL(OFF_XB + SZ_XB);
constexpr size_t W_IN_T = 0;
constexpr size_t W_UQ_T = W_IN_T + (size_t)HP * 1024 * 2;
constexpr size_t W_UKV_T = W_UQ_T + 512 * 256 * 2;
constexpr size_t W_OUT_T = W_UKV_T + 512 * 256 * 2;
constexpr size_t W_Q_T = W_OUT_T + 1024 * 1024 * 2;
constexpr size_t W_KV_T = W_Q_T + 1024 * 1024 * 2;
constexpr size_t W_O_T = W_KV_T + 2048 * 1024 * 2;
constexpr size_t W_GATE_T = W_O_T + 1024 * 1024 * 2;
constexpr size_t SZ_WTS = W_GATE_T + 2 * 48 * 1024 * 4;
constexpr size_t OFF_KMEM = AL(OFF_WTS + SZ_WTS);
constexpr size_t OFF_VTMEM = AL(OFF_KMEM + (size_t)NMEM * 1024 * 2);
constexpr size_t OFF_MEMB = AL(OFF_VTMEM + (size_t)NMEM * 1024 * 2);
constexpr size_t OFF_VTATT = AL(OFF_MEMB + (size_t)NMEM * 1024 * 2);
constexpr size_t OFF_VTMLA = AL(OFF_VTATT + (size_t)BATCH * 2 * 64 * SEQ * 2);
constexpr size_t OFF_HATT = AL(OFF_VTMLA + (size_t)BATCH * 4 * 64 * SEQ * 2);
constexpr size_t OFF_HMLA = OFF_HATT + (size_t)NTOK * 512 * 2;
constexpr size_t OFF_HRWKV = OFF_HMLA + (size_t)NTOK * 512 * 2;
constexpr size_t OFF_R7 = OFF_HRWKV + (size_t)NTOK * 1024 * 2;
constexpr size_t SZ_R7 = (size_t)NTOK * 9 * 256 * 2;
constexpr size_t OFF_HHGRN = OFF_R7 + SZ_R7;
constexpr size_t OFF_HX = OFF_HHGRN + (size_t)NTOK * 1280 * 2;
constexpr size_t OFF_HAM = OFF_HX + (size_t)NTOK * 256 * 2;
constexpr size_t OFF_HEG = OFF_HAM + (size_t)(NTOK / 16) * 8 * 256 * 2;
constexpr size_t OFF_REG = OFF_HEG + (size_t)(NTOK / 16) * 8 * 64 * 4;
constexpr size_t WS_END = OFF_REG + (size_t)(NTOK / 16) * 8 * 64 * 2;
static_assert(WS_END <= (size_t)4 * NTOK * DM * 4 || CFG_B != 16, "workspace must fit 4 x the largest tensor");

constexpr size_t OFF_QMLA = OFF_XB;
constexpr size_t OFF_KNOPE = OFF_QMLA + (size_t)NTOK * 384 * 2;
constexpr size_t OFF_KROPE = OFF_KNOPE + (size_t)NTOK * 256 * 2;
constexpr size_t OFF_G = OFF_KROPE + (size_t)NTOK * 32 * 2;
constexpr size_t OFF_BONUS = OFF_G + (size_t)NTOK * 256 * 2;
constexpr size_t OFF_RSIDE = OFF_BONUS + (size_t)NTOK * 16;
static_assert(OFF_RSIDE + (size_t)(NTOK / 16) * 2 * 512 * 2 <= OFF_XB + SZ_XB, "xb alias region");
constexpr size_t OFF_YCAT = OFF_HRWKV;
constexpr size_t OFF_QMEM = OFF_HATT;
constexpr size_t OFF_OMEM = OFF_R7;
#ifdef CPU_EMU
constexpr size_t OFF_EMU_SCAN = WS_END;
constexpr size_t OFF_LISTS = AL(OFF_EMU_SCAN + (size_t)4 * NTOK * 256 * 2);
#else
constexpr size_t OFF_LISTS = OFF_HATT;
#endif
constexpr size_t OFF_TINFO = OFF_LISTS + (size_t)NEXP * NTOK * 4;
constexpr size_t OFF_HM = AL(OFF_TINFO + (size_t)NTOK * 32);
constexpr size_t OFF_YROWS = AL(OFF_HM + (size_t)MOE_ROWS * 256 * 2);
#ifdef CPU_EMU
constexpr size_t OFF_W13T = AL(OFF_YROWS + (size_t)MOE_ROWS * 1024 * 2);
#else
static_assert(OFF_YROWS + (size_t)MOE_ROWS * 1024 * 2 <= OFF_HHGRN, "moe alias region");
constexpr size_t OFF_W13T = OFF_HHGRN;
#endif
constexpr size_t OFF_W2T = OFF_W13T + (size_t)NEXP * 512 * 1024 * 2;
#ifdef CPU_EMU
constexpr size_t WS_END_EMU = OFF_W2T + (size_t)NEXP * 1024 * 256 * 2;
#else
static_assert(OFF_W2T + (size_t)NEXP * 1024 * 256 * 2 <= WS_END, "moe weights alias");
#endif

enum { C_KT0 = 0, C_KT1 = 1, C_RT0 = 2, C_RT1 = 3, C_KK0 = 4, C_KK1 = 5, C_AT0 = 6, C_AT1 = 7, C_VT = 8 };
enum { R_R = 0, R_V = 1, R_KK = 2, R_W0 = 3, R_W1 = 4, R_KD0 = 5, R_KD1 = 6, R_AK0 = 7, R_AK1 = 8 };

DI float bf2f(bf16 v) { union { unsigned u; float f; } x; x.u = (unsigned)v << 16; return x.f; }
DI bf16 f2bf(float f) { union { unsigned u; float f; } x; x.f = f; unsigned u = x.u; u += 0x7fffu + ((u >> 16) & 1u); return (bf16)(u >> 16); }
DI float sigmoidf_(float x) { return 1.0f / (1.0f + expf(-x)); }
DI float siluf_(float x) { return x * sigmoidf_(x); }

#ifdef CPU_EMU
typedef const float* const* InPtr;
#else
typedef const float* const __attribute__((address_space(4)))* InPtr;
#endif
struct Frame {
    InPtr in;
    float* xf;
    unsigned char* ws;
    unsigned char* smem;
    int tid;
    int wv;
    int nblk;
};
#ifdef CPU_EMU
constexpr int NTH = 1;
#else
constexpr int NTH = 512;
#endif
#ifdef CPU_EMU
constexpr int GRP = 1;
DI float grp_sum(const Frame& F, float v) { return v; }
DI int gthreads(const Frame& F) { return 1; }
DI int gtid_(const Frame& F) { return 0; }
DI int wave_item_index(const Frame& F) { return 0; }
#else
constexpr int GRP = 64;
DI float shfl_idx(const Frame& F, float v, int src_lane) { return __builtin_bit_cast(float, __builtin_amdgcn_ds_bpermute(src_lane << 2, __builtin_bit_cast(int, v))); }
DI float shfl_xor(const Frame& F, float v, int mask) {
    unsigned m0 = ~0u; asm volatile("" : "+s"(m0));
    const int lane = (int)__builtin_amdgcn_mbcnt_hi(m0, __builtin_amdgcn_mbcnt_lo(m0, 0u));
    return shfl_idx(F, v, lane ^ mask); }
template <int CTRL> DI float dppf(float x) { return __builtin_bit_cast(float, __builtin_amdgcn_update_dpp(0, __builtin_bit_cast(int, x), CTRL, 0xf, 0xf, true)); }
DI float allsum16(float x) { x += dppf<0xB1>(x); x += dppf<0x4E>(x); x += dppf<0x141>(x); x += dppf<0x140>(x); return x; }
DI float rdlane(float x, int l) { return __builtin_bit_cast(float, __builtin_amdgcn_readlane(__builtin_bit_cast(int, x), l)); }
DI float grp_sum(const Frame& F, float v) { v = allsum16(v); return (rdlane(v, 0) + rdlane(v, 16)) + (rdlane(v, 32) + rdlane(v, 48)); }
DI int gthreads(const Frame& F) { return F.nblk * NTH; }
DI int gtid_(const Frame& F) { return blockIdx.x * NTH + F.tid; }
DI int wave_item_index(const Frame& F) { return (int)(((F.tid >> 6) * F.nblk + blockIdx.x) * 64 + (F.tid & 63)); }
#endif
constexpr int PER64 = 64 / GRP;
constexpr int PERLN = 1024 / GRP;
DI int fresh_tid(const Frame& F) {
#ifdef CPU_EMU
    return 0;
#else
    unsigned m0 = ~0u; asm volatile("" : "+s"(m0));
    int t = F.wv * 64 + (int)__builtin_amdgcn_mbcnt_hi(m0, __builtin_amdgcn_mbcnt_lo(m0, 0u)); asm volatile("" : "+v"(t)); return t;
#endif
}
DI int glane(const Frame& F) { return (int)(F.tid % GRP); }
DI int ggrp(const Frame& F) { return gtid_(F) / GRP; }
DI int ngrp(const Frame& F) { return gthreads(F) / GRP; }

struct Args {
    const float* in[42];
    float* out;
    unsigned char* ws;
    int ph_lo, ph_hi;
};

DI float rope_inv(int f, int nf) { return powf(10000.0f, -(float)f / (float)nf); }

#ifndef CPU_EMU
using bf16x8 = __attribute__((ext_vector_type(8))) short;
using bf16x4 = __attribute__((ext_vector_type(4))) short;
using f32x4 = __attribute__((ext_vector_type(4))) float;
using f32x16 = __attribute__((ext_vector_type(16))) float;
typedef __bf16 bf16v2 __attribute__((ext_vector_type(2)));
typedef float f32v2 __attribute__((ext_vector_type(2)));
DI float bflo(unsigned u) { return __uint_as_float(u << 16); }
DI float bfhi(unsigned u) { return __uint_as_float(u & 0xffff0000u); }
DI unsigned pack_bf16(float lo, float hi) { f32v2 v = {lo, hi}; bf16v2 b = __builtin_convertvector(v, bf16v2); return __builtin_bit_cast(unsigned, b); }

constexpr int G_BM = 256, G_BK = 64, G_HALF = 128, G_HT = G_HALF * G_BK, G_SHM = 8 * G_HT * 2;
DI int g_lds_byte(int r, int c) { int st = (r >> 4) * 2 + (c >> 5), rr = r & 15, cc = c & 31, ob = rr * 64 + cc * 2; return st * 1024 + (ob ^ (((ob >> 9) & 1) << 5)); }
DI void g_stage_rc(int b, int& R, int& C) { int st = b / 1024, sb = b % 1024, swz = sb ^ (((sb >> 9) & 1) << 5); R = (st >> 1) * 16 + swz / 64; C = (st & 1) * 32 + (swz % 64) / 2; }

template <bool GATHER, class Epi>
DI void gemm_unit_t(int wv_in, bf16* shm, const bf16* __restrict__ A, int lda, const int* rowmap, int arow0,
                    const bf16* __restrict__ Bt, int ldb, int bcol0, int K, const Epi& epi) {
#define SA(b, h) (shm + ((b) * 2 + (h)) * G_HT)
#define SB(b, h) (shm + (4 + (b) * 2 + (h)) * G_HT)
#define STAGE_AX(T, P, hf, kt) do { for (int _i = 0; _i < 2; ++_i) { int _b = (T) * 16 + _i * 8192; int _r, _c; g_stage_rc(_b, _r, _c); \
        const long _row = GATHER ? (long)rowmap[(hf) * G_HALF + _r] : (long)(arow0 + (hf) * G_HALF + _r); \
        __builtin_amdgcn_global_load_lds((const unsigned*)(A + _row * lda + (long)(kt) * G_BK + _c), (unsigned*)((char*)(P) + _b), 16, 0, 0); } } while (0)
#define STAGE_BX(T, P, hf, kt) do { for (int _i = 0; _i < 2; ++_i) { int _b = (T) * 16 + _i * 8192; int _r, _c; g_stage_rc(_b, _r, _c); \
        __builtin_amdgcn_global_load_lds((const unsigned*)(Bt + (long)(bcol0 + (hf) * G_HALF + _r) * ldb + (long)(kt) * G_BK + _c), (unsigned*)((char*)(P) + _b), 16, 0, 0); } } while (0)
#define STAGE_A(P, hf, kt) STAGE_AX(t0, P, hf, kt)
#define STAGE_B(P, hf, kt) STAGE_BX(t0, P, hf, kt)
#define LDA(dst, b, h) for (int m = 0; m < 4; ++m) for (int k = 0; k < 2; ++k) \
        dst[m][k] = *reinterpret_cast<const bf16x8*>((char*)SA(b, h) + g_lds_byte(wr * 64 + m * 16 + fr, k * 32 + fq * 8))
#define LDB(dst, b, h) for (int n = 0; n < 2; ++n) for (int k = 0; k < 2; ++k) \
        dst[n][k] = *reinterpret_cast<const bf16x8*>((char*)SB(b, h) + g_lds_byte(wc * 32 + n * 16 + fr, k * 32 + fq * 8))
#define MMA(ai, bj, At, Bt_) do { __builtin_amdgcn_s_setprio(1); \
        for (int m = 0; m < 4; ++m) for (int n = 0; n < 2; ++n) for (int k = 0; k < 2; ++k) \
            acc[ai][bj][m][n] = __builtin_amdgcn_mfma_f32_16x16x32_bf16(Bt_[n][k], At[m][k], acc[ai][bj][m][n], 0, 0, 0); \
        __builtin_amdgcn_s_setprio(0); } while (0)
#define WAIT_V(n) asm volatile("s_waitcnt vmcnt(" #n ")" ::: "memory")
#define WAIT_L(n) asm volatile("s_waitcnt lgkmcnt(" #n ")" ::: "memory")
#define BAR __builtin_amdgcn_s_barrier()
#define SCHED __builtin_amdgcn_sched_barrier(0)
    unsigned m0 = ~0u; asm volatile("" : "+s"(m0));
    int t0 = wv_in * 64 + (int)__builtin_amdgcn_mbcnt_hi(m0, __builtin_amdgcn_mbcnt_lo(m0, 0u)); asm volatile("" : "+v"(t0));
    int wid = t0 >> 6, lane = t0 & 63, wr = wid >> 2, wc = wid & 3, fr = lane & 15, fq = lane >> 4;
    f32x4 acc[2][2][4][2] = {};
    bf16x8 At[4][2], B0[2][2], B1[2][2];
    const int nt = K / G_BK;
    STAGE_B(SB(0, 0), 0, 0); STAGE_A(SA(0, 0), 0, 0);
    STAGE_B(SB(0, 1), 1, 0); STAGE_A(SA(0, 1), 1, 0);
    if (wr == 1) BAR;
    WAIT_V(4); BAR;
    STAGE_B(SB(1, 0), 0, 1); STAGE_A(SA(1, 0), 0, 1); STAGE_B(SB(1, 1), 1, 1);
    WAIT_V(6); BAR;
    for (int t = 0; t < nt - 2; t += 2) {
        LDB(B0, 0, 0); SCHED; LDA(At, 0, 0); STAGE_A(SA(1, 1), 1, t + 1);
        WAIT_L(8); BAR; WAIT_L(0); MMA(0, 0, At, B0); BAR; SCHED;
        LDB(B1, 0, 1); STAGE_B(SB(0, 0), 0, t + 2);
        BAR; WAIT_L(0); MMA(0, 1, At, B1); BAR;
        LDA(At, 0, 1); STAGE_A(SA(0, 0), 0, t + 2);
        BAR; WAIT_L(0); MMA(1, 0, At, B0); BAR; SCHED;
        STAGE_B(SB(0, 1), 1, t + 2);
        WAIT_V(6); BAR; MMA(1, 1, At, B1); BAR;
        LDB(B0, 1, 0); SCHED; LDA(At, 1, 0); STAGE_A(SA(0, 1), 1, t + 2);
        WAIT_L(8); BAR; WAIT_L(0); MMA(0, 0, At, B0); BAR; SCHED;
        LDB(B1, 1, 1); STAGE_B(SB(1, 0), 0, t + 3);
        BAR; WAIT_L(0); MMA(0, 1, At, B1); BAR;
        LDA(At, 1, 1); STAGE_A(SA(1, 0), 0, t + 3);
        BAR; WAIT_L(0); MMA(1, 0, At, B0); BAR; SCHED;
        STAGE_B(SB(1, 1), 1, t + 3);
        WAIT_V(6); BAR; MMA(1, 1, At, B1); BAR;
    }
    int tz = t0; asm volatile("" : "+v"(tz)); wid = tz >> 6; lane = tz & 63; wr = wid >> 2; wc = wid & 3; fr = lane & 15; fq = lane >> 4;
    { LDB(B0, 0, 0); WAIT_V(0); LDA(At, 0, 0); STAGE_AX(tz, SA(1, 1), 1, nt - 1);
      BAR; WAIT_L(0); MMA(0, 0, At, B0); BAR;
      LDB(B1, 0, 1); BAR; WAIT_L(0); MMA(0, 1, At, B1); BAR;
      LDA(At, 0, 1); WAIT_V(4); BAR; WAIT_L(0); MMA(1, 0, At, B0); MMA(1, 1, At, B1); BAR; }
    { LDB(B0, 1, 0); LDA(At, 1, 0); WAIT_V(2); BAR; WAIT_L(0); MMA(0, 0, At, B0); BAR;
      LDB(B1, 1, 1); WAIT_V(0); BAR; WAIT_L(0); MMA(0, 1, At, B1); BAR;
      LDA(At, 1, 1); BAR; WAIT_L(0); MMA(1, 0, At, B0); MMA(1, 1, At, B1); BAR; }
    if (wr == 0) BAR;
#pragma unroll
    for (int ai = 0; ai < 2; ++ai)
#pragma unroll
        for (int m = 0; m < 4; ++m)
#pragma unroll
            for (int bj = 0; bj < 2; ++bj)
#pragma unroll
                for (int n = 0; n < 2; ++n) {
                    const f32x4 v = acc[ai][bj][m][n];
                    epi(ai * G_HALF + wr * 64 + m * 16 + fr, bj * G_HALF + wc * 32 + n * 16 + fq * 4, v[0], v[1], v[2], v[3]);
                }
#undef SA
#undef SB
#undef STAGE_A
#undef STAGE_B
#undef STAGE_AX
#undef STAGE_BX
#undef LDA
#undef LDB
#undef MMA
}
template <class Epi>
DI void gemm_unit(const Frame& F, const bf16* __restrict__ A, int lda, const int* rowmap, int arow0,
                  const bf16* __restrict__ Bt, int ldb, int bcol0, int K, const Epi& epi) {
    if (rowmap) gemm_unit_t<true>(F.wv, (bf16*)F.smem, A, lda, rowmap, arow0, Bt, ldb, bcol0, K, epi);
    else gemm_unit_t<false>(F.wv, (bf16*)F.smem, A, lda, rowmap, arow0, Bt, ldb, bcol0, K, epi);
}
#else
template <class Epi>
void gemm_unit(const Frame& F, const bf16* A, int lda, const int* rowmap, int arow0, const bf16* Bt, int ldb, int bcol0, int K, const Epi& epi, int mrows = 256) {
    for (int r = 0; r < mrows; ++r) {
        int arow = rowmap ? rowmap[r] : arow0 + r;
        for (int c = 0; c < 256; c += 4) {
            float v[4];
            for (int q = 0; q < 4; ++q) {
                double s = 0; const bf16* a = A + (long)arow * lda; const bf16* b = Bt + (long)(bcol0 + c + q) * ldb;
                for (int k = 0; k < K; ++k) s += (double)bf2f(a[k]) * bf2f(b[k]);
                v[q] = (float)s;
            }
            epi(r, c, v[0], v[1], v[2], v[3]);
        }
    }
}
#endif

DI void st_bf16x4(bf16* p, float a, float b, float c, float d) {
#ifndef CPU_EMU
    uint2 u; u.x = pack_bf16(a, b); u.y = pack_bf16(c, d); *reinterpret_cast<uint2*>(p) = u;
#else
    p[0] = f2bf(a); p[1] = f2bf(b); p[2] = f2bf(c); p[3] = f2bf(d);
#endif
}

#define WSP(T, off) ((T*)(F.ws + (off)))

DI void ln_row_write(float* xrow, bf16* brow, const float* vals_in  , const float* g, const float* b);

template <class Fn>
DI void layer_norm_rows(const Frame& F, const float* g, const float* b, Fn pre, bool write_out_extra, float* extra) {
    float* xf = F.xf; bf16* xb = WSP(bf16, OFF_XB);
    for (int row = ggrp(F); row < NTOK; row += ngrp(F)) {
        float v[PERLN]; float s = 0.f;
        for (int i = 0; i < PERLN; ++i) { int c = glane(F) + i * GRP; v[i] = pre(row, c); s += v[i]; }
        s = grp_sum(F, s); const float mu = s * (1.0f / 1024.0f);
        float q = 0.f;
        for (int i = 0; i < PERLN; ++i) { float d = v[i] - mu; q += d * d; }
        q = grp_sum(F, q); const float rs = 1.0f / sqrtf(q * (1.0f / 1024.0f) + LN_EPS);
        for (int i = 0; i < PERLN; ++i) { int c = glane(F) + i * GRP; float y = (v[i] - mu) * rs * g[c] + b[c];
            xf[(size_t)row * DM + c] = y; xb[(size_t)row * DM + c] = f2bf(y); if (write_out_extra) extra[(size_t)row * DM + c] = y; }
    }
}

#ifndef CPU_EMU
template <int MODE, bool BLOCKED = false>
DI void ln_rows_gpu(const Frame& F, const float* __restrict__ g, const float* __restrict__ b, int l) {
    float* xf = F.xf; bf16* xb = WSP(bf16, OFF_XB);
    const float* xin = F.in[0];
    const bf16* yr = WSP(bf16, OFF_YROWS); const float* tinfo = WSP(float, OFF_TINFO);
    const int* eoff = (const int*)(F.ws + CTL_EOFF) + l * 33;
    const int tid = F.tid, wave = tid >> 6, lane = tid & 63;
    float4 gv[4], bv[4];
#pragma unroll
    for (int i = 0; i < 4; ++i) { gv[i] = *reinterpret_cast<const float4*>(g + lane * 4 + 256 * i); bv[i] = *reinterpret_cast<const float4*>(b + lane * 4 + 256 * i); }
    const bool blk_ok = BLOCKED && (NTOK % (F.nblk * 32) == 0);
    const int rpb = NTOK / F.nblk;
    const int r_first = blk_ok ? blockIdx.x * rpb + wave * 4 : (blockIdx.x * 8 + wave) * 4;
    const int r_end = blk_ok ? (blockIdx.x + 1) * rpb : NTOK;
    const int r_step = blk_ok ? 32 : F.nblk * 32;
    for (int r0 = r_first; r0 < r_end; r0 += r_step) {
        float4 v[4][4];
#pragma unroll
        for (int rr = 0; rr < 4; ++rr) {
            const size_t row = r0 + rr;
            if (MODE == 2) {
                const int* ti = (const int*)(tinfo + row * 8);
                const size_t ra = (size_t)eoff[ti[0]] + ti[1], rb = (size_t)eoff[ti[2]] + ti[3];
                const float g0 = tinfo[row * 8 + 4], g1 = tinfo[row * 8 + 5];
#pragma unroll
                for (int i = 0; i < 4; ++i) {
                    const int c = lane * 4 + 256 * i;
                    const float4 x = *reinterpret_cast<const float4*>(xf + row * DM + c);
                    const uint2 ya = *reinterpret_cast<const uint2*>(yr + ra * 1024 + c), yb = *reinterpret_cast<const uint2*>(yr + rb * 1024 + c);
                    v[rr][i].x = DN_ALPHA * x.x + g0 * bflo(ya.x) + g1 * bflo(yb.x); v[rr][i].y = DN_ALPHA * x.y + g0 * bfhi(ya.x) + g1 * bfhi(yb.x);
                    v[rr][i].z = DN_ALPHA * x.z + g0 * bflo(ya.y) + g1 * bflo(yb.y); v[rr][i].w = DN_ALPHA * x.w + g0 * bfhi(ya.y) + g1 * bfhi(yb.y);
                }
            } else {
                const float* src = (MODE == 1 ? xin : xf) + row * DM;
#pragma unroll
                for (int i = 0; i < 4; ++i) v[rr][i] = *reinterpret_cast<const float4*>(src + lane * 4 + 256 * i);
            }
        }
#pragma unroll
        for (int rr = 0; rr < 4; ++rr) {
            const size_t row = r0 + rr;
            float s = 0.f;
#pragma unroll
            for (int i = 0; i < 4; ++i) s += (v[rr][i].x + v[rr][i].y) + (v[rr][i].z + v[rr][i].w);
            const float mu = grp_sum(F, s) * (1.0f / 1024.0f);
            float q = 0.f;
#pragma unroll
            for (int i = 0; i < 4; ++i) { const float d0 = v[rr][i].x - mu, d1 = v[rr][i].y - mu, d2 = v[rr][i].z - mu, d3 = v[rr][i].w - mu; q += (d0 * d0 + d1 * d1) + (d2 * d2 + d3 * d3); }
            const float rs = 1.0f / sqrtf(grp_sum(F, q) * (1.0f / 1024.0f) + LN_EPS);
#pragma unroll
            for (int i = 0; i < 4; ++i) {
                const int c = lane * 4 + 256 * i;
                float4 y; y.x = (v[rr][i].x - mu) * rs * gv[i].x + bv[i].x; y.y = (v[rr][i].y - mu) * rs * gv[i].y + bv[i].y;
                y.z = (v[rr][i].z - mu) * rs * gv[i].z + bv[i].z; y.w = (v[rr][i].w - mu) * rs * gv[i].w + bv[i].w;
                *reinterpret_cast<float4*>(xf + row * DM + c) = y;
                *reinterpret_cast<uint2*>(xb + row * DM + c) = make_uint2(pack_bf16(y.x, y.y), pack_bf16(y.z, y.w));
            }
        }
    }
}
#endif

DI void phase_pro(const Frame& F) {
    const float* x = F.in[0]; const float* mem = F.in[1];
#ifdef CPU_EMU
    layer_norm_rows(F, F.in[2], F.in[3], [&](int row, int c) { return x[(size_t)row * DM + c]; }, false, nullptr);
#else
    (void)x; ln_rows_gpu<1>(F, F.in[2], F.in[3], 0);
#endif
    bf16* memb = WSP(bf16, OFF_MEMB);
    for (size_t i = gtid_(F); i < (size_t)NMEM * DM; i += gthreads(F)) memb[i] = f2bf(mem[i]);
}

template <class Src>
DI void cvt_tile(const Frame& F, bf16* dst, int Kk, int n0, int k0, Src src) {
#ifndef CPU_EMU
    float* tile = (float*)F.smem;
    __syncthreads();
    for (int i = F.tid; i < 4096; i += NTH) { int k = i >> 6, n = i & 63; tile[k * 65 + n] = src(k0 + k, n0 + n); }
    __syncthreads();
    for (int i = F.tid; i < 2048; i += NTH) { int n = i >> 5, k = (i & 31) * 2;
        *reinterpret_cast<unsigned*>(dst + (size_t)(n0 + n) * Kk + k0 + k) = pack_bf16(tile[k * 65 + n], tile[(k + 1) * 65 + n]); }
#endif
}
template <class Src>
DI void cvt_transpose(const Frame& F, bf16* dst, int Nn, int Kk, Src src, int t_first, int t_total) {
#ifdef CPU_EMU
    for (int n = 0; n < Nn; ++n) for (int k = 0; k < Kk; ++k) dst[(size_t)n * Kk + k] = f2bf(src(k, n));
#else
    const int tn = Nn / 64, tk = Kk / 64, ntile = tn * tk;
    int t = (int)blockIdx.x - (t_first % (int)F.nblk); if (t < 0) t += F.nblk;
    for (; t < ntile; t += F.nblk) cvt_tile(F, dst, Kk, (t % tn) * 64, (t / tn) * 64, src);
#endif
}

#ifndef CPU_EMU
template <bool VEC, class CM>
DI void cvt_job(const Frame& F, int& tbase, bf16* dst, int ldd, int Nn, int Kk, int Ksrc, const float* __restrict__ src, int lds, CM cm) {
    const int nw = F.nblk * 8, gw = blockIdx.x * 8 + F.wv;
    const int lane = fresh_tid(F) & 63, kq = lane & 15, nq = lane >> 4;
    const int tk = Kk / 64, T = tk * (Nn / 16);
    int t = gw - (tbase % nw); if (t < 0) t += nw;
    tbase += T;
    for (; t < T; t += nw) {
        const int k = (t % tk) * 64 + 4 * kq, n = (t / tk) * 16 + 4 * nq;
        float4 v[4];
        if (VEC) {
            const int s = cm(n);
#pragma unroll
            for (int i = 0; i < 4; ++i) v[i] = (s >= 0 && k + i < Ksrc) ? *reinterpret_cast<const float4*>(src + (size_t)(k + i) * lds + s) : make_float4(0.f, 0.f, 0.f, 0.f);
        } else {
            const int s0 = cm(n), s1 = cm(n + 1), s2 = cm(n + 2), s3 = cm(n + 3);
#pragma unroll
            for (int i = 0; i < 4; ++i) { const float* row = src + (size_t)(k + i) * lds; const bool ok = k + i < Ksrc;
                v[i].x = (ok && s0 >= 0) ? row[s0] : 0.f; v[i].y = (ok && s1 >= 0) ? row[s1] : 0.f; v[i].z = (ok && s2 >= 0) ? row[s2] : 0.f; v[i].w = (ok && s3 >= 0) ? row[s3] : 0.f; }
        }
        bf16* d = dst + (size_t)n * ldd + k;
        *reinterpret_cast<uint2*>(d) = make_uint2(pack_bf16(v[0].x, v[1].x), pack_bf16(v[2].x, v[3].x));
        *reinterpret_cast<uint2*>(d + ldd) = make_uint2(pack_bf16(v[0].y, v[1].y), pack_bf16(v[2].y, v[3].y));
        *reinterpret_cast<uint2*>(d + 2 * (size_t)ldd) = make_uint2(pack_bf16(v[0].z, v[1].z), pack_bf16(v[2].z, v[3].z));
        *reinterpret_cast<uint2*>(d + 3 * (size_t)ldd) = make_uint2(pack_bf16(v[0].w, v[1].w), pack_bf16(v[2].w, v[3].w));
    }
}
#endif

DI int win_src_col(int n) {
    if (n < 512) return n;
    if (n < 1536) { int c = n - 512; return c < 960 ? 512 + c : -1; }
    if (n < 2816) return 1472 + (n - 1536);
    int c = n - 2816;
    if (c < 192) return 2752 + c;
    if (c < 224) return 2752 + 320 + (c - 192);
    if (c < 256) return -1;
    if (c < 384) return 2752 + 192 + (c - 256);
    return -1;
}
DI int wuq_src_col(int n) {
    if (n >= 384) return -1;
    int h = n / 96, w = n % 96;
    if (w < 64) return h * 96 + w;
    int p = w - 64, m = p >> 1, which = p & 1;
    int i = (m < 8 ? m : 16 + (m - 8)) + (which ? 8 : 0);
    return h * 96 + 64 + i;
}

DI void phase_cvt(const Frame& F, int l) {
    bf16* wts = WSP(bf16, OFF_WTS);
#ifndef CPU_EMU
    {
        int tb = 0;
        auto ident = [](int n) { return n; };
        cvt_job<true>(F, tb, (bf16*)((char*)wts + W_IN_T), 1024, HP, 1024, 1024, F.in[4] + (size_t)l * 1024 * IN_WIDTH, IN_WIDTH, [](int n) { return win_src_col(n); });
        cvt_job<false>(F, tb, (bf16*)((char*)wts + W_UQ_T), 256, 512, 256, 192, F.in[23] + (size_t)l * 192 * 384, 384, [](int n) { return wuq_src_col(n); });
        cvt_job<true>(F, tb, (bf16*)((char*)wts + W_UKV_T), 256, 512, 256, 128, F.in[24] + (size_t)l * 128 * 512, 512, ident);
        cvt_job<true>(F, tb, (bf16*)((char*)wts + W_OUT_T), 1024, 1024, 1024, 1024, F.in[25] + (size_t)l * 1024 * 1024, 1024, ident);
        cvt_job<true>(F, tb, (bf16*)((char*)wts + W_Q_T), 1024, 1024, 1024, 1024, F.in[28] + (size_t)l * 1024 * 1024, 1024, ident);
        cvt_job<true>(F, tb, (bf16*)((char*)wts + W_KV_T), 1024, 2048, 1024, 1024, F.in[29] + (size_t)l * 1024 * 2048, 2048, ident);
        cvt_job<true>(F, tb, (bf16*)((char*)wts + W_O_T), 1024, 1024, 1024, 1024, F.in[30] + (size_t)l * 1024 * 1024, 1024, ident);
        const float* wg = F.in[33] + (size_t)l * 1024 * 4; const float* we = F.in[35] + (size_t)l * 1024 * 32; float* gt = (float*)((char*)wts + W_GATE_T) + (size_t)l * 48 * 1024;
        for (int i = gtid_(F); i < 48 * 1024; i += gthreads(F)) { const int col = i >> 10, k = i & 1023; gt[i] = col < 4 ? wg[k * 4 + col] : col < 36 ? we[k * 32 + col - 4] : 0.f; }
        return;
    }
#endif
    constexpr int T0 = 0, T1 = T0 + (HP / 64) * 16, T2 = T1 + 8 * 4, T3 = T2 + 8 * 4, T4 = T3 + 256, T5 = T4 + 256, T6 = T5 + 512, TT = T6 + 256;
    { const float* w = F.in[4] + (size_t)l * 1024 * IN_WIDTH;
      cvt_transpose(F, (bf16*)((char*)wts + W_IN_T), HP, 1024, [&](int k, int n) { int s = win_src_col(n); return s < 0 ? 0.f : w[(size_t)k * IN_WIDTH + s]; }, T0, TT); }
    { const float* w = F.in[23] + (size_t)l * 192 * 384;
      cvt_transpose(F, (bf16*)((char*)wts + W_UQ_T), 512, 256, [&](int k, int n) { int s = wuq_src_col(n); return (s < 0 || k >= 192) ? 0.f : w[(size_t)k * 384 + s]; }, T1, TT); }
    { const float* w = F.in[24] + (size_t)l * 128 * 512;
      cvt_transpose(F, (bf16*)((char*)wts + W_UKV_T), 512, 256, [&](int k, int n) { return k >= 128 ? 0.f : w[(size_t)k * 512 + n]; }, T2, TT); }
    { const float* w = F.in[25] + (size_t)l * 1024 * 1024;
      cvt_transpose(F, (bf16*)((char*)wts + W_OUT_T), 1024, 1024, [&](int k, int n) { return w[(size_t)k * 1024 + n]; }, T3, TT); }
    { const float* w = F.in[28] + (size_t)l * 1024 * 1024;
      cvt_transpose(F, (bf16*)((char*)wts + W_Q_T), 1024, 1024, [&](int k, int n) { return w[(size_t)k * 1024 + n]; }, T4, TT); }
    { const float* w = F.in[29] + (size_t)l * 1024 * 2048;
      cvt_transpose(F, (bf16*)((char*)wts + W_KV_T), 2048, 1024, [&](int k, int n) { return w[(size_t)k * 2048 + n]; }, T5, TT); }
    { const float* w = F.in[30] + (size_t)l * 1024 * 1024;
      cvt_transpose(F, (bf16*)((char*)wts + W_O_T), 1024, 1024, [&](int k, int n) { return w[(size_t)k * 1024 + n]; }, T6, TT); }
#ifndef CPU_EMU
    { const float* wg = F.in[33] + (size_t)l * 1024 * 4; const float* we = F.in[35] + (size_t)l * 1024 * 32; float* gt = (float*)((char*)wts + W_GATE_T) + (size_t)l * 48 * 1024;
      for (int i = gtid_(F); i < 48 * 1024; i += gthreads(F)) { const int col = i >> 10, k = i & 1023;
          gt[i] = col < 4 ? wg[k * 4 + col] : col < 36 ? we[k * 32 + col - 4] : 0.f; } }
#endif
}

DI void phase_cvt_moe(const Frame& F, int l) {
#ifdef CPU_EMU
    for (int e = 0; e < NEXP; ++e) {
        const float* w1 = F.in[37] + ((size_t)l * NEXP + e) * 1024 * 256;
        const float* w3 = F.in[38] + ((size_t)l * NEXP + e) * 1024 * 256;
        const float* w2 = F.in[39] + ((size_t)l * NEXP + e) * 256 * 1024;
        cvt_transpose(F, WSP(bf16, OFF_W13T) + (size_t)e * 512 * 1024, 512, 1024,
                      [&](int k, int n) { return (n & 1) ? w3[(size_t)k * 256 + (n >> 1)] : w1[(size_t)k * 256 + (n >> 1)]; }, 0, 1);
        cvt_transpose(F, WSP(bf16, OFF_W2T) + (size_t)e * 1024 * 256, 1024, 256, [&](int k, int n) { return w2[(size_t)k * 1024 + n]; }, 0, 1);
    }
#else
    {
        int tb = 0;
        auto ident = [](int n) { return n; };
        for (int e = 0; e < NEXP; ++e) {
            const float* w1 = F.in[37] + ((size_t)l * NEXP + e) * 1024 * 256; const float* w3 = F.in[38] + ((size_t)l * NEXP + e) * 1024 * 256; const float* w2 = F.in[39] + ((size_t)l * NEXP + e) * 256 * 1024;
            bf16* d13 = WSP(bf16, OFF_W13T) + (size_t)e * 512 * 1024;
            cvt_job<true>(F, tb, d13, 2048, 256, 1024, 1024, w1, 256, ident);
            cvt_job<true>(F, tb, d13 + 1024, 2048, 256, 1024, 1024, w3, 256, ident);
            cvt_job<true>(F, tb, WSP(bf16, OFF_W2T) + (size_t)e * 1024 * 256, 256, 1024, 256, 256, w2, 1024, ident);
        }
    }
#endif
}

struct EpiH {
    bf16* hatt; bf16* hrwkv; bf16* hhgrn; bf16* hmla; int row0, pn;
    DI void operator()(int r, int c, float a, float b, float cc, float d) const {
        const size_t row = row0 + r;
        bf16* p;
        if (pn < 2) p = hatt + row * 512 + pn * 256 + c;
        else if (pn < 6) p = hrwkv + row * 1024 + (pn - 2) * 256 + c;
        else if (pn < 11) p = hhgrn + row * 1280 + (pn - 6) * 256 + c;
        else p = hmla + row * 512 + (pn - 11) * 256 + c;
        st_bf16x4(p, a, b, cc, d);
    }
};
struct EpiKV {
    bf16* kmem; bf16* vt; int row0, pn;
    DI void operator()(int r, int c, float a, float b, float cc, float d) const {
        const int row = row0 + r, col = pn * 256 + c;
        if (col < 1024) { st_bf16x4(kmem + (size_t)row * 1024 + col, a, b, cc, d); }
        else { const int bb = row / MEMT, key = row % MEMT, hc = col - 1024;
            bf16* p = vt + ((size_t)bb * 1024 + hc) * MEMT + key;
            p[0] = f2bf(a); p[MEMT] = f2bf(b); p[2 * MEMT] = f2bf(cc); p[3 * MEMT] = f2bf(d); }
    }
};

DI void phase_gemm1(const Frame& F) {
    const bf16* xb = WSP(bf16, OFF_XB); const bf16* wts = WSP(bf16, OFF_WTS);
    const int nM = (NTOK + 255) / 256, nN = HP / 256, n1 = nM * nN;
    const int nMk = (NMEM + 255) / 256, nNk = 8, n2 = nMk * nNk;
    for (int u = blockIdx.x; u < n1 + n2; u += F.nblk) {
        if (u < n1) {
            const int pm = u / nN, pn = u % nN;
            EpiH E{WSP(bf16, OFF_HATT), WSP(bf16, OFF_HRWKV), WSP(bf16, OFF_HHGRN), WSP(bf16, OFF_HMLA), pm * 256, pn};
#ifdef CPU_EMU
            gemm_unit(F, xb, 1024, nullptr, pm * 256, (const bf16*)((const char*)wts + W_IN_T), 1024, pn * 256, 1024, E, min(256, NTOK - pm * 256));
#else
            gemm_unit(F, xb, 1024, nullptr, pm * 256, (const bf16*)((const char*)wts + W_IN_T), 1024, pn * 256, 1024, E);
#endif
        } else {
            const int v = u - n1, pm = v / nNk, pn = v % nNk;
            EpiKV E{WSP(bf16, OFF_KMEM), WSP(bf16, OFF_VTMEM), pm * 256, pn};
            gemm_unit(F, WSP(bf16, OFF_MEMB), 1024, nullptr, pm * 256, (const bf16*)((const char*)wts + W_KV_T), 1024, pn * 256, 1024, E);
        }
    }
}


#ifndef CPU_EMU
DI float fast_sigmoid(float x) { return 1.0f / (1.0f + __expf(-x)); }
DI float fast_tanh(float x) { const float e = __expf(2.0f * x); return 1.0f - 2.0f / (e + 1.0f); }

DI void prep_attn_gpu(const Frame& F, int l) {
    float* tabA = (float*)F.smem;
    float* tabB = tabA + 2048;
    float* gq = tabB + 1024;
    __syncthreads();
    { const int tid = fresh_tid(F);
    for (int i = tid; i < 1024; i += NTH) { const int pos = i >> 4, f = i & 15; const float ang = (float)pos * rope_inv(2 * f, 32); tabA[i] = cosf(ang); tabA[1024 + i] = sinf(ang); }
    for (int i = tid; i < 512; i += NTH) { const int pos = i >> 3, f = i & 7; const float ang = (float)pos * rope_inv(2 * f, 16); tabB[i] = cosf(ang); tabB[512 + i] = sinf(ang); }
    for (int i = tid; i < 448; i += NTH) gq[i] = i < 64 ? F.in[5][l * 64 + i] : i < 128 ? F.in[6][l * 64 + i - 64] : i < 320 ? F.in[21][l * 192 + i - 128] : F.in[22][l * 128 + i - 320]; }
    __syncthreads();
    bf16* hatt = WSP(bf16, OFF_HATT);
    for (int it = blockIdx.x * NTH + fresh_tid(F); it < NTOK * 6; it += gthreads(F)) {
        const int n = it / 6, hh = it % 6, s = n % SEQ, rowp = s / GRIDW, colp = s % GRIDW;
        uint4* p = reinterpret_cast<uint4*>(hatt + (size_t)n * 512 + hh * 64);
        const float* gn = gq + (hh < 4 ? 0 : 64);
        uint4 raw[8];
#pragma unroll
        for (int i = 0; i < 8; ++i) raw[i] = p[i];
        float x[64];
#pragma unroll
        for (int i = 0; i < 8; ++i) { x[8 * i] = bflo(raw[i].x); x[8 * i + 1] = bfhi(raw[i].x); x[8 * i + 2] = bflo(raw[i].y); x[8 * i + 3] = bfhi(raw[i].y);
            x[8 * i + 4] = bflo(raw[i].z); x[8 * i + 5] = bfhi(raw[i].z); x[8 * i + 6] = bflo(raw[i].w); x[8 * i + 7] = bfhi(raw[i].w); }
        float ss = 0.f;
#pragma unroll
        for (int j = 0; j < 64; ++j) ss += x[j] * x[j];
        const float rs = 1.0f / sqrtf(ss * (1.0f / 64.0f) + RMS_EPS);
#pragma unroll
        for (int j = 0; j < 64; ++j) x[j] *= rs * gn[j];
#pragma unroll
        for (int half = 0; half < 2; ++half) {
            const int pos = half ? colp : rowp;
#pragma unroll
            for (int f = 0; f < 16; ++f) {
                const float cs = tabA[pos * 16 + f], sn = tabA[1024 + pos * 16 + f];
                const float x1 = x[half * 32 + f], x2 = x[half * 32 + 16 + f];
                x[half * 32 + f] = x1 * cs - x2 * sn; x[half * 32 + 16 + f] = x1 * sn + x2 * cs;
            }
        }
#pragma unroll
        for (int i = 0; i < 8; ++i) { uint4 o; o.x = pack_bf16(x[8 * i], x[8 * i + 1]); o.y = pack_bf16(x[8 * i + 2], x[8 * i + 3]); o.z = pack_bf16(x[8 * i + 4], x[8 * i + 5]); o.w = pack_bf16(x[8 * i + 6], x[8 * i + 7]); p[i] = o; }
    }
    bf16* hm = WSP(bf16, OFF_HMLA); bf16* kr = WSP(bf16, OFF_KROPE);
    for (int it = blockIdx.x * NTH + fresh_tid(F); it < NTOK * 3; it += gthreads(F)) {
        const int n = it / 3, which = it % 3;
        if (which < 2) {
            const int len = which ? 128 : 192; const float* gn = gq + (which ? 320 : 128);
            uint4* p = reinterpret_cast<uint4*>(hm + (size_t)n * 512 + (which ? 256 : 0));
            float ss = 0.f;
            for (int i = 0; i < len / 8; ++i) { const uint4 r = p[i];
                const float a0 = bflo(r.x), a1 = bfhi(r.x), a2 = bflo(r.y), a3 = bfhi(r.y), a4 = bflo(r.z), a5 = bfhi(r.z), a6 = bflo(r.w), a7 = bfhi(r.w);
                ss += a0 * a0 + a1 * a1 + a2 * a2 + a3 * a3 + a4 * a4 + a5 * a5 + a6 * a6 + a7 * a7; }
            const float rs = 1.0f / sqrtf(ss / (float)len + RMS_EPS);
            for (int i = 0; i < len / 8; ++i) { const uint4 r = p[i]; const float* g = gn + 8 * i; uint4 o;
                o.x = pack_bf16(bflo(r.x) * rs * g[0], bfhi(r.x) * rs * g[1]); o.y = pack_bf16(bflo(r.y) * rs * g[2], bfhi(r.y) * rs * g[3]);
                o.z = pack_bf16(bflo(r.z) * rs * g[4], bfhi(r.z) * rs * g[5]); o.w = pack_bf16(bflo(r.w) * rs * g[6], bfhi(r.w) * rs * g[7]); p[i] = o; }
        } else {
            const int s = n % SEQ, rowp = s / GRIDW, colp = s % GRIDW;
            const uint4* p = reinterpret_cast<const uint4*>(hm + (size_t)n * 512 + 192);
            float x[32];
#pragma unroll
            for (int i = 0; i < 4; ++i) { const uint4 r = p[i]; x[8 * i] = bflo(r.x); x[8 * i + 1] = bfhi(r.x); x[8 * i + 2] = bflo(r.y); x[8 * i + 3] = bfhi(r.y);
                x[8 * i + 4] = bflo(r.z); x[8 * i + 5] = bfhi(r.z); x[8 * i + 6] = bflo(r.w); x[8 * i + 7] = bfhi(r.w); }
            unsigned o[16];
#pragma unroll
            for (int m = 0; m < 16; ++m) {
                const int i1 = m < 8 ? m : 16 + (m - 8), pos = m < 8 ? rowp : colp, f = m & 7;
                const float cs = tabB[pos * 8 + f], sn = tabB[512 + pos * 8 + f];
                o[m] = pack_bf16(x[i1] * cs - x[i1 + 8] * sn, x[i1] * sn + x[i1 + 8] * cs);
            }
            uint4* q = reinterpret_cast<uint4*>(kr + (size_t)n * 32);
#pragma unroll
            for (int i = 0; i < 4; ++i) q[i] = make_uint4(o[4 * i], o[4 * i + 1], o[4 * i + 2], o[4 * i + 3]);
        }
    }
    {
        bf16* vt = WSP(bf16, OFF_VTATT); bf16* tl = (bf16*)(gq + 512);
        for (int tile = blockIdx.x; tile < BATCH * 2 * (SEQ / 64); tile += F.nblk) {
            const int b = tile / (2 * (SEQ / 64)), kv = (tile / (SEQ / 64)) % 2, t0 = (tile % (SEQ / 64)) * 64;
            __syncthreads();
            const int tid = fresh_tid(F);
            { const int t = tid >> 3, part = tid & 7;
              const uint4 r = *reinterpret_cast<const uint4*>(hatt + (size_t)(b * SEQ + t0 + t) * 512 + 384 + kv * 64 + part * 8);
              const unsigned w[4] = {r.x, r.y, r.z, r.w};
#pragma unroll
              for (int i = 0; i < 4; ++i) { tl[(part * 8 + 2 * i) * 72 + t] = (bf16)(w[i] & 0xffffu); tl[(part * 8 + 2 * i + 1) * 72 + t] = (bf16)(w[i] >> 16); } }
            __syncthreads();
            { const int dv = tid >> 3, part = tid & 7;
              *reinterpret_cast<uint4*>(vt + ((size_t)(b * 2 + kv) * 64 + dv) * SEQ + t0 + part * 8) = *reinterpret_cast<const uint4*>(tl + dv * 72 + part * 8); }
        }
    }
}

DI void prep_hgrn_gpu(const Frame& F, int l) {
    bf16* hh = WSP(bf16, OFF_HHGRN); bf16* hx = WSP(bf16, OFF_HX); bf16* ham = WSP(bf16, OFF_HAM); float* heg = WSP(float, OFF_HEG);
    const int tid = F.tid, wave = tid >> 6, lane = tid & 63, x = lane & 15, q = lane >> 4;
    bf16* stg = (bf16*)F.smem + wave * (4 * 16 * 72);
    for (int it = blockIdx.x * 8 + wave; it < (NTOK / 16) * 4; it += F.nblk * 8) {
        const int c = it >> 2, h = it & 3, n0 = c * 16, cj = h * 64 + lane;
        float mlb = 1.0f;
        if (l == 1) { const float a = F.in[19][cj], b = F.in[19][256 + cj]; const float m = fmaxf(a, b); const float ea = __expf(a - m), eb = __expf(b - m); mlb = ea / (ea + eb); }
        float qv[16], k0[16], k1[16], g0[16], g1[16]; bf16 vraw[16];
#pragma unroll
        for (int t = 0; t < 16; ++t) {
            const bf16* row = hh + (size_t)(n0 + t) * 1280 + cj;
            const float xq = bf2f(row[0]), x0 = bf2f(row[256]), x1 = bf2f(row[512]); vraw[t] = row[768];
            qv[t] = xq * fast_sigmoid(xq); k0[t] = mlb * fast_sigmoid(-x0); k1[t] = mlb * fast_sigmoid(-x1);
            g0[t] = __logf(1.0f - k0[t]); g1[t] = __logf(1.0f - k1[t]);
        }
#pragma unroll
        for (int t = 1; t < 16; ++t) { g0[t] += g0[t - 1]; g1[15 - t] += g1[16 - t]; }
        heg[((size_t)it * 2 + 0) * 64 + lane] = __expf(g0[15]); heg[((size_t)it * 2 + 1) * 64 + lane] = __expf(g1[0]);
        unsigned kt0[8], kt1[8], vt[8];
#pragma unroll
        for (int t = 0; t < 16; t += 2) {
            const float e0a = __expf(g0[t]), e0b = __expf(g0[t + 1]), e1a = __expf(g1[t]), e1b = __expf(g1[t + 1]);
            const float q0a = qv[t] * e0a, q0b = qv[t + 1] * e0b, q1a = qv[t] * e1a, q1b = qv[t + 1] * e1b;
            const float ka0 = k0[t] / e0a, kb0 = k0[t + 1] / e0b, ka1 = k1[t] / e1a, kb1 = k1[t + 1] / e1b;
            const bf16 bq0a = f2bf(q0a), bq0b = f2bf(q0b), bq1a = f2bf(q1a), bq1b = f2bf(q1b);
            hh[(size_t)(n0 + t) * 1280 + cj] = bq0a; hh[(size_t)(n0 + t + 1) * 1280 + cj] = bq0b;
            hx[(size_t)(n0 + t) * 256 + cj] = bq1a; hx[(size_t)(n0 + t + 1) * 256 + cj] = bq1b;
            kt0[t >> 1] = pack_bf16(ka0, kb0); kt1[t >> 1] = pack_bf16(ka1, kb1); vt[t >> 1] = (unsigned)vraw[t] | ((unsigned)vraw[t + 1] << 16);
            stg[0 * 1152 + t * 72 + lane] = bq0a; stg[0 * 1152 + (t + 1) * 72 + lane] = bq0b;
            stg[2 * 1152 + t * 72 + lane] = bq1a; stg[2 * 1152 + (t + 1) * 72 + lane] = bq1b;
            stg[1 * 1152 + t * 72 + lane] = (bf16)(kt0[t >> 1] & 0xffffu); stg[1 * 1152 + (t + 1) * 72 + lane] = (bf16)(kt0[t >> 1] >> 16);
            stg[3 * 1152 + t * 72 + lane] = (bf16)(kt1[t >> 1] & 0xffffu); stg[3 * 1152 + (t + 1) * 72 + lane] = (bf16)(kt1[t >> 1] >> 16);
        }
        { bf16* blk = hh + (size_t)(n0 + (lane >> 2)) * 1280 + h * 64 + (lane & 3) * 16;
          *reinterpret_cast<uint4*>(blk + 256) = make_uint4(kt0[0], kt0[1], kt0[2], kt0[3]); *reinterpret_cast<uint4*>(blk + 256 + 8) = make_uint4(kt0[4], kt0[5], kt0[6], kt0[7]);
          *reinterpret_cast<uint4*>(blk + 512) = make_uint4(kt1[0], kt1[1], kt1[2], kt1[3]); *reinterpret_cast<uint4*>(blk + 512 + 8) = make_uint4(kt1[4], kt1[5], kt1[6], kt1[7]);
          *reinterpret_cast<uint4*>(blk + 768) = make_uint4(vt[0], vt[1], vt[2], vt[3]); *reinterpret_cast<uint4*>(blk + 768 + 8) = make_uint4(vt[4], vt[5], vt[6], vt[7]); }
        asm volatile("s_waitcnt lgkmcnt(0)" ::: "memory");
        __builtin_amdgcn_wave_barrier();
#pragma unroll
        for (int d = 0; d < 2; ++d) {
            f32x4 acc = {0.f, 0.f, 0.f, 0.f};
#pragma unroll
            for (int ks = 0; ks < 2; ++ks) {
                const bf16x8 a = *reinterpret_cast<const bf16x8*>(stg + (2 * d) * 1152 + x * 72 + 32 * ks + 8 * q);
                const bf16x8 b = *reinterpret_cast<const bf16x8*>(stg + (2 * d + 1) * 1152 + x * 72 + 32 * ks + 8 * q);
                acc = __builtin_amdgcn_mfma_f32_16x16x32_bf16(a, b, acc, 0, 0, 0);
            }
            bf16* am = ham + ((size_t)it * 2 + d) * 256;
#pragma unroll
            for (int r = 0; r < 4; ++r) { const int t = 4 * q + r; const bool keep = d ? (x >= t) : (x <= t); am[t * 16 + x] = f2bf(keep ? acc[r] : 0.f); }
        }
        __builtin_amdgcn_wave_barrier();
    }
}

DI void scan_hgrn_chunk(const Frame& F, int chain) {
    const int d = chain / (BATCH * 4), b = (chain / 4) % BATCH, h = chain % 4;
    const int lane = fresh_tid(F) & 63, x = lane & 15, q = lane >> 4;
    bf16* hh = WSP(bf16, OFF_HHGRN); const bf16* hx = WSP(bf16, OFF_HX); const bf16* ham = WSP(bf16, OFF_HAM); const float* heg = WSP(float, OFF_HEG);
    f32x4 S[4][4];
#pragma unroll
    for (int a = 0; a < 4; ++a)
#pragma unroll
        for (int c = 0; c < 4; ++c) S[a][c] = (f32x4){0.f, 0.f, 0.f, 0.f};
    constexpr int NCH = SEQ / 16;
    uint2 nQ[4], nA, nK[4], nV[4]; float4 nE[4];
    const unsigned lq = (unsigned)(x * (d ? 256 : 1280) + h * 64 + 4 * q);
    const unsigned lb = (unsigned)((x >> 2) * 1280 + h * 64 + (x & 3) * 16 + 4 * q);
    const unsigned la = (unsigned)(x * 16 + 4 * q), le = (unsigned)(4 * q), lo = (unsigned)(4 * q * 1280 + x);
#define HG_LOAD(cc_) do { const int c_ = d ? NCH - 1 - (cc_) : (cc_); const unsigned n0_ = (unsigned)(b * SEQ + 16 * c_); const unsigned it_ = (n0_ >> 4) * 4 + h; \
        const bf16* qb_ = d ? hx + (size_t)n0_ * 256 : hh + (size_t)n0_ * 1280; const bf16* hb_ = hh + (size_t)n0_ * 1280; \
        const bf16* ab_ = ham + (size_t)(it_ * 2 + d) * 256; const float* eb_ = heg + (size_t)(it_ * 2 + d) * 64; \
        _Pragma("unroll") for (int u_ = 0; u_ < 4; ++u_) nQ[u_] = *reinterpret_cast<const uint2*>(qb_ + lq + 16 * u_); \
        nA = *reinterpret_cast<const uint2*>(ab_ + la); \
        _Pragma("unroll") for (int u_ = 0; u_ < 4; ++u_) { \
            nK[u_] = *reinterpret_cast<const uint2*>(hb_ + lb + (4 * u_) * 1280 + 256 + d * 256); nV[u_] = *reinterpret_cast<const uint2*>(hb_ + lb + (4 * u_) * 1280 + 768); \
            nE[u_] = *reinterpret_cast<const float4*>(eb_ + le + 16 * u_); } } while (0)
    HG_LOAD(0);
    for (int cc = 0; cc < NCH; ++cc) {
        uint2 cQ[4], cA, cK[4], cV[4]; float4 cE[4];
#pragma unroll
        for (int u = 0; u < 4; ++u) { cQ[u] = nQ[u]; cK[u] = nK[u]; cV[u] = nV[u]; cE[u] = nE[u]; }
        cA = nA;
        if (cc + 1 < NCH) HG_LOAD(cc + 1);
        const int c = d ? NCH - 1 - cc : cc; const size_t n0 = (size_t)b * SEQ + 16 * c;
        union Fr { bf16x8 v; unsigned u[4]; };
        Fr aq0, aq1, aA; aq0.u[0] = cQ[0].x; aq0.u[1] = cQ[0].y; aq0.u[2] = cQ[1].x; aq0.u[3] = cQ[1].y;
        aq1.u[0] = cQ[2].x; aq1.u[1] = cQ[2].y; aq1.u[2] = cQ[3].x; aq1.u[3] = cQ[3].y;
        aA.u[0] = cA.x; aA.u[1] = cA.y; aA.u[2] = 0u; aA.u[3] = 0u;
#pragma unroll
        for (int it = 0; it < 4; ++it) {
            Fr bS0, bS1, bV;
            bS0.u[0] = pack_bf16(S[0][it][0], S[0][it][1]); bS0.u[1] = pack_bf16(S[0][it][2], S[0][it][3]); bS0.u[2] = pack_bf16(S[1][it][0], S[1][it][1]); bS0.u[3] = pack_bf16(S[1][it][2], S[1][it][3]);
            bS1.u[0] = pack_bf16(S[2][it][0], S[2][it][1]); bS1.u[1] = pack_bf16(S[2][it][2], S[2][it][3]); bS1.u[2] = pack_bf16(S[3][it][0], S[3][it][1]); bS1.u[3] = pack_bf16(S[3][it][2], S[3][it][3]);
            bV.u[0] = cV[it].x; bV.u[1] = cV[it].y; bV.u[2] = 0u; bV.u[3] = 0u;
            f32x4 O = {0.f, 0.f, 0.f, 0.f};
            O = __builtin_amdgcn_mfma_f32_16x16x32_bf16(aq0.v, bS0.v, O, 0, 0, 0);
            O = __builtin_amdgcn_mfma_f32_16x16x32_bf16(aq1.v, bS1.v, O, 0, 0, 0);
            O = __builtin_amdgcn_mfma_f32_16x16x32_bf16(aA.v, bV.v, O, 0, 0, 0);
            bf16* od = hh + n0 * 1280 + 256 + d * 256 + h * 64 + 16 * it;
#pragma unroll
            for (int r = 0; r < 4; ++r) od[lo + (unsigned)(r * 1280)] = f2bf(O[r]);
#pragma unroll
            for (int jt = 0; jt < 4; ++jt) {
                Fr aK; aK.u[0] = cK[jt].x; aK.u[1] = cK[jt].y; aK.u[2] = 0u; aK.u[3] = 0u;
                f32x4 t = __builtin_amdgcn_mfma_f32_16x16x32_bf16(aK.v, bV.v, S[jt][it], 0, 0, 0);
                t[0] *= cE[jt].x; t[1] *= cE[jt].y; t[2] *= cE[jt].z; t[3] *= cE[jt].w;
                S[jt][it] = t;
            }
        }
    }
#undef HG_LOAD
}

DI void prep_rwkv_gpu(const Frame& F, int l) {
    const bf16* hz = WSP(bf16, OFF_HRWKV); bf16* r7 = WSP(bf16, OFF_R7); bf16* gb = WSP(bf16, OFF_G); float* bonus = WSP(float, OFF_BONUS);
    const float* mup = F.in[7] + l * 960; const float* mun = F.in[8] + l * 960;
    const float* w0 = F.in[9] + l * 512; const float* w2 = F.in[10] + (size_t)l * 2 * 32 * 256;
    const float* a0 = F.in[11] + l * 512; const float* a2 = F.in[12] + (size_t)l * 2 * 32 * 256;
    const float* g2 = F.in[13] + (size_t)l * 64 * 256;
    const size_t AS = (size_t)NTOK * 256;
    float* zs = (float*)F.smem;
    const int tid = F.tid, c = tid & 255, tg = tid >> 8;
    const float w0a = w0[c], w0b = w0[256 + c], a0a = a0[c], a0b = a0[256 + c];
    const float kkc = F.in[14][l * 256 + c], kac = F.in[15][l * 256 + c], rkc = F.in[16][l * 256 + c];
    for (int tile = blockIdx.x; tile < NTOK / 16; tile += F.nblk) {
        const int n0 = tile * 16;
        __syncthreads();
        const int tl = fresh_tid(F);
#pragma unroll
        for (int bt = 0; bt < 3; ++bt) {
            unsigned zc[5], zp[5], zn[5];
#pragma unroll
            for (int i = 0; i < 5; ++i) {
                const int e = tl + (bt * 5 + i) * NTH, t = e / 480, cc = (e % 480) * 2, n = n0 + t, s = n % SEQ;
                zc[i] = *reinterpret_cast<const unsigned*>(hz + (size_t)n * 1024 + cc);
                zp[i] = s > 0 ? *reinterpret_cast<const unsigned*>(hz + (size_t)(n - 1) * 1024 + cc) : 0u;
                zn[i] = s < SEQ - 1 ? *reinterpret_cast<const unsigned*>(hz + (size_t)(n + 1) * 1024 + cc) : 0u;
            }
#pragma unroll
            for (int i = 0; i < 5; ++i) {
                const int e = tl + (bt * 5 + i) * NTH, t = e / 480, cc = (e % 480) * 2;
                const float2 mp = *reinterpret_cast<const float2*>(mup + cc), mn = *reinterpret_cast<const float2*>(mun + cc);
                float v0 = bflo(zc[i]), v1 = bfhi(zc[i]);
                v0 = v0 + mp.x * (bflo(zp[i]) - v0) + mn.x * (bflo(zn[i]) - v0);
                v1 = v1 + mp.y * (bfhi(zp[i]) - v1) + mn.y * (bfhi(zn[i]) - v1);
                if (cc >= 768 && cc < 832) { v0 = fast_tanh(v0); v1 = fast_tanh(v1); }
                else if (cc >= 896) { v0 = fast_sigmoid(v0); v1 = fast_sigmoid(v1); }
                *reinterpret_cast<float2*>(zs + t * 960 + cc) = make_float2(v0, v1);
            }
        }
        __syncthreads();
        float wr0[8], wr1[8], ar0[8], ar1[8], gg[8];
#pragma unroll
        for (int t = 0; t < 8; ++t) { wr0[t] = w0a; wr1[t] = w0b; ar0[t] = a0a; ar1[t] = a0b; gg[t] = 0.f; }
        for (int q = 0; q < 32; q += 4) {
            float wa[4], wb[4], aa[4], ab[4];
#pragma unroll
            for (int u = 0; u < 4; ++u) { wa[u] = w2[(size_t)(q + u) * 256 + c]; wb[u] = w2[(size_t)(32 + q + u) * 256 + c]; aa[u] = a2[(size_t)(q + u) * 256 + c]; ab[u] = a2[(size_t)(32 + q + u) * 256 + c]; }
#pragma unroll
            for (int t = 0; t < 8; ++t) {
                const float* zr = zs + (tg * 8 + t) * 960;
                const float4 x0 = *reinterpret_cast<const float4*>(zr + 768 + q), x1 = *reinterpret_cast<const float4*>(zr + 800 + q);
                const float4 y0 = *reinterpret_cast<const float4*>(zr + 832 + q), y1 = *reinterpret_cast<const float4*>(zr + 864 + q);
                wr0[t] += x0.x * wa[0] + x0.y * wa[1] + x0.z * wa[2] + x0.w * wa[3];
                wr1[t] += x1.x * wb[0] + x1.y * wb[1] + x1.z * wb[2] + x1.w * wb[3];
                ar0[t] += y0.x * aa[0] + y0.y * aa[1] + y0.z * aa[2] + y0.w * aa[3];
                ar1[t] += y1.x * ab[0] + y1.y * ab[1] + y1.z * ab[2] + y1.w * ab[3];
            }
        }
        for (int q = 0; q < 64; q += 4) {
            float ga[4];
#pragma unroll
            for (int u = 0; u < 4; ++u) ga[u] = g2[(size_t)(q + u) * 256 + c];
#pragma unroll
            for (int t = 0; t < 8; ++t) {
                const float4 x = *reinterpret_cast<const float4*>(zs + (tg * 8 + t) * 960 + 896 + q);
                gg[t] += x.x * ga[0] + x.y * ga[1] + x.z * ga[2] + x.w * ga[3];
            }
        }
        bf16* stg = (bf16*)(F.smem + 61440);
        float* nts = (float*)(F.smem + 61440 + 73728);
        float* xch = (float*)(F.smem + 61440 + 73728 + 8192);
        const int hh_ = c >> 6, j = c & 63;
        float lw0[8], lw1[8], G0[8], G1[8];
#pragma unroll
        for (int t = 0; t < 8; ++t) { lw0[t] = -DECAY_SCALE * fast_sigmoid(wr0[t]); lw1[t] = -DECAY_SCALE * fast_sigmoid(wr1[t]); }
        G0[0] = lw0[0]; G1[7] = lw1[7];
#pragma unroll
        for (int t = 1; t < 8; ++t) { G0[t] = G0[t - 1] + lw0[t]; G1[7 - t] = G1[8 - t] + lw1[7 - t]; }
        xch[(tg * 256 + c) * 2] = G0[7]; xch[(tg * 256 + c) * 2 + 1] = G1[0];
        __syncthreads();
        const float tot0 = xch[c * 2] + xch[(256 + c) * 2], tot1 = xch[c * 2 + 1] + xch[(256 + c) * 2 + 1];
        const float off0 = tg ? xch[c * 2] : 0.f, off1 = tg ? 0.f : xch[(256 + c) * 2 + 1];
#pragma unroll
        for (int t = 0; t < 8; ++t) {
            const int tau = tg * 8 + t, n = n0 + tau; const float* zr = zs + tau * 960;
            const float r = zr[c], k = zr[256 + c], v = zr[512 + c];
            const float A0 = fast_sigmoid(ar0[t]), A1 = fast_sigmoid(ar1[t]);
            const float kk = k * kkc;
            const float kd0 = k * (1.0f + (A0 - 1.0f) * kac), kd1 = k * (1.0f + (A1 - 1.0f) * kac);
            const float ss = grp_sum(F, kk * kk);
            const float bs = grp_sum(F, r * (kd0 + kd1) * rkc);
            const float kkn = kk * (1.0f / fmaxf(sqrtf(ss), 1e-12f));
            const float g0 = G0[t] + off0, g1 = G1[t] + off1;
            const float e0 = __expf(g0), e1 = __expf(g1), i0 = __expf(-g0), i1 = __expf(-g1);
            const float kt0 = kkn * __expf(g0 - lw0[t]), kt1 = kkn * __expf(g1 - lw1[t]);
            const float rt0 = r * e0, rt1 = r * e1, ks0 = kd0 * i0, ks1 = kd1 * i1, as0 = A0 * kkn * i0, as1 = A1 * kkn * i1;
            const size_t o = (size_t)n * 256 + c;
            const bf16 bkt0 = f2bf(kt0), bkt1 = f2bf(kt1), brt0 = f2bf(rt0), brt1 = f2bf(rt1), bks0 = f2bf(ks0), bks1 = f2bf(ks1), bas0 = f2bf(as0), bas1 = f2bf(as1);
            gb[o] = f2bf(gg[t]);
            if ((tid & 63) == 0) bonus[(size_t)n * 4 + hh_] = bs;
            bf16* s0 = stg + (size_t)((hh_ * 2 + 0) * 4) * 1152 + tau * 72 + j; bf16* s1 = stg + (size_t)((hh_ * 2 + 1) * 4) * 1152 + tau * 72 + j;
            s0[0] = bkt0; s0[1152] = brt0; s0[2 * 1152] = bas0; s0[3 * 1152] = bks0;
            s1[0] = bkt1; s1[1152] = brt1; s1[2 * 1152] = bas1; s1[3 * 1152] = bks1;
            asm volatile("" ::: "memory");
        }
        if (tg == 0) { bf16* reg = WSP(bf16, OFF_REG) + ((size_t)(tile * 4 + hh_) * 2) * 64 + j; reg[0] = f2bf(__expf(tot0)); reg[64] = f2bf(__expf(tot1)); }
        __syncthreads();
        {
            const int wv = F.wv, lane = fresh_tid(F) & 63, x = lane & 15, q = lane >> 4, dd = wv & 1;
            const bf16* base = stg + (size_t)(wv * 4) * 1152;
            f32x4 nt = {0.f, 0.f, 0.f, 0.f}, mkk = nt, mkr = nt, mar = nt;
#pragma unroll
            for (int ks = 0; ks < 2; ++ks) {
                const bf16x8 fk = *reinterpret_cast<const bf16x8*>(base + x * 72 + 32 * ks + 8 * q);
                const bf16x8 fr = *reinterpret_cast<const bf16x8*>(base + 1152 + x * 72 + 32 * ks + 8 * q);
                const bf16x8 fa = *reinterpret_cast<const bf16x8*>(base + 2 * 1152 + x * 72 + 32 * ks + 8 * q);
                const bf16x8 fs = *reinterpret_cast<const bf16x8*>(base + 3 * 1152 + x * 72 + 32 * ks + 8 * q);
                nt = __builtin_amdgcn_mfma_f32_16x16x32_bf16(fk, fa, nt, 0, 0, 0);
                mkk = __builtin_amdgcn_mfma_f32_16x16x32_bf16(fk, fs, mkk, 0, 0, 0);
                mkr = __builtin_amdgcn_mfma_f32_16x16x32_bf16(fr, fs, mkr, 0, 0, 0);
                mar = __builtin_amdgcn_mfma_f32_16x16x32_bf16(fr, fa, mar, 0, 0, 0);
            }
            bf16* yc = WSP(bf16, OFF_YCAT); bf16* side = WSP(bf16, OFF_RSIDE);
            float* ntw = nts + wv * 256;
            auto mat_ptr = [&](int m) -> bf16* { const int sidx = wv * 4 + m;
                return sidx < 28 ? yc + (size_t)(n0 + 1 + (sidx >> 1)) * 1024 + 256 + (sidx & 1) * 256 : side + ((size_t)tile * 4 + (sidx - 28)) * 256; };
            bf16* m0 = mat_ptr(0); bf16* m2 = mat_ptr(2); bf16* m3 = mat_ptr(3);
#pragma unroll
            for (int r = 0; r < 4; ++r) {
                const int t = 4 * q + r; const bool strict = dd ? (x > t) : (x < t), beq = dd ? (x >= t) : (x <= t);
                const int pos = ((x >> 2) * 16 + t) * 4 + (x & 3);
                ntw[t * 16 + x] = strict ? nt[r] : 0.f;
                m0[pos] = f2bf(strict ? mkk[r] : 0.f); m2[pos] = f2bf(beq ? mkr[r] : 0.f); m3[pos] = f2bf(beq ? -mar[r] : 0.f);
            }
            const size_t blk = ((size_t)tile * 4 + (wv >> 1)) * 1024;
            {
                bf16* dk = r7 + (dd ? C_KT1 : C_KT0) * AS + blk; bf16* dr = r7 + (dd ? C_RT1 : C_RT0) * AS + blk;
#pragma unroll
                for (int ks = 0; ks < 2; ++ks) {
                    const uint2 k0 = *reinterpret_cast<const uint2*>(base + x * 72 + 32 * ks + 4 * q), k1 = *reinterpret_cast<const uint2*>(base + x * 72 + 32 * ks + 16 + 4 * q);
                    const uint2 r0 = *reinterpret_cast<const uint2*>(base + 1152 + x * 72 + 32 * ks + 4 * q), r1 = *reinterpret_cast<const uint2*>(base + 1152 + x * 72 + 32 * ks + 16 + 4 * q);
                    *reinterpret_cast<uint4*>(dk + (ks * 64 + lane) * 8) = make_uint4(k0.x, k0.y, k1.x, k1.y);
                    *reinterpret_cast<uint4*>(dr + (ks * 64 + lane) * 8) = make_uint4(r0.x, r0.y, r1.x, r1.y);
                }
            }
            {
                bf16* ds_ = r7 + (dd ? C_KK1 : C_KK0) * AS + blk; bf16* da = r7 + (dd ? C_AT1 : C_AT0) * AS + blk; bf16* dv = r7 + C_VT * AS + blk;
                const bf16* sa = base + 2 * 1152; const bf16* sk = base + 3 * 1152;
                const float* zv = zs + 512 + (wv >> 1) * 64;
#pragma unroll
                for (int u = 0; u < 4; ++u) {
                    const int ch = 16 * u + x;
                    const unsigned a0 = sa[(4 * q) * 72 + ch], a1 = sa[(4 * q + 1) * 72 + ch], a2 = sa[(4 * q + 2) * 72 + ch], a3 = sa[(4 * q + 3) * 72 + ch];
                    const unsigned k0 = sk[(4 * q) * 72 + ch], k1 = sk[(4 * q + 1) * 72 + ch], k2 = sk[(4 * q + 2) * 72 + ch], k3 = sk[(4 * q + 3) * 72 + ch];
                    *reinterpret_cast<uint2*>(ds_ + (u * 64 + lane) * 4) = make_uint2(k0 | (k1 << 16), k2 | (k3 << 16));
                    *reinterpret_cast<uint2*>(da + (u * 64 + lane) * 4) = make_uint2((a0 | (a1 << 16)) ^ 0x80008000u, (a2 | (a3 << 16)) ^ 0x80008000u);
                    if (dd == 0) *reinterpret_cast<uint2*>(dv + (u * 64 + lane) * 4) =
                        make_uint2(pack_bf16(zv[(4 * q) * 960 + ch], zv[(4 * q + 1) * 960 + ch]), pack_bf16(zv[(4 * q + 2) * 960 + ch], zv[(4 * q + 3) * 960 + ch]));
                }
            }
            asm volatile("s_waitcnt lgkmcnt(0)" ::: "memory");
            __builtin_amdgcn_wave_barrier();
            if (lane < 16) {
                float X[16];
                if (dd == 0) {
#pragma unroll
                    for (int t = 0; t < 16; ++t) { float a = (t == lane) ? 1.f : 0.f;
#pragma unroll
                        for (int s2 = 0; s2 < t; ++s2) a -= ntw[t * 16 + s2] * X[s2];
                        X[t] = a; }
                } else {
#pragma unroll
                    for (int t = 15; t >= 0; --t) { float a = (t == lane) ? 1.f : 0.f;
#pragma unroll
                        for (int s2 = t + 1; s2 < 16; ++s2) a -= ntw[t * 16 + s2] * X[s2];
                        X[t] = a; }
                }
                bf16* m1 = mat_ptr(1);
#pragma unroll
                for (int t = 0; t < 16; ++t) m1[((lane >> 2) * 16 + t) * 4 + (lane & 3)] = f2bf(X[t]);
            }
        }
    }
}

DI void scan_rwkv_chunk(const Frame& F, int chain) {
    const int d = chain / (BATCH * 4), b = (chain / 4) % BATCH, h = chain % 4, combo = h * 2 + d;
    const int lane = fresh_tid(F) & 63, q = lane >> 4;
    const size_t AS = (size_t)NTOK * 256;
    bf16* r7 = WSP(bf16, OFF_R7); const bf16* yc = WSP(bf16, OFF_YCAT); const bf16* side = WSP(bf16, OFF_RSIDE); const bf16* reg = WSP(bf16, OFF_REG);
    bf16* akt = r7 + (d ? C_KT1 : C_KT0) * AS; const bf16* art = r7 + (d ? C_RT1 : C_RT0) * AS;
    const bf16* akk = r7 + (d ? C_KK1 : C_KK0) * AS; const bf16* aat = r7 + (d ? C_AT1 : C_AT0) * AS; const bf16* avt = r7 + C_VT * AS;
    f32x4 Z[4][4];
#pragma unroll
    for (int a = 0; a < 4; ++a)
#pragma unroll
        for (int c = 0; c < 4; ++c) Z[a][c] = (f32x4){0.f, 0.f, 0.f, 0.f};
    constexpr int NCH = SEQ / 16;
    const unsigned l8 = (unsigned)lane * 8, l4 = (unsigned)lane * 4, le = (unsigned)(4 * q);
    uint4 nK[2], nR[2]; uint2 nM[4], nV[4];
#define RW_MPTR(tl_, m_) ((combo * 4 + (m_)) < 28 ? yc + (size_t)((tl_) * 16 + 1 + ((combo * 4 + (m_)) >> 1)) * 1024 + 256 + ((combo * 4 + (m_)) & 1) * 256 \
                                                   : side + ((size_t)(tl_) * 4 + (combo * 4 + (m_) - 28)) * 256)
#define RW_LOAD(cc_) do { const int c_ = d ? NCH - 1 - (cc_) : (cc_); const unsigned tl_ = (unsigned)(b * NCH + c_); const size_t bo_ = ((size_t)tl_ * 4 + h) * 1024; \
        nK[0] = *reinterpret_cast<const uint4*>(akt + bo_ + l8); nK[1] = *reinterpret_cast<const uint4*>(akt + bo_ + 512 + l8); \
        nR[0] = *reinterpret_cast<const uint4*>(art + bo_ + l8); nR[1] = *reinterpret_cast<const uint4*>(art + bo_ + 512 + l8); \
        _Pragma("unroll") for (int u_ = 0; u_ < 4; ++u_) { nM[u_] = *reinterpret_cast<const uint2*>(RW_MPTR(tl_, u_) + l4); nV[u_] = *reinterpret_cast<const uint2*>(avt + bo_ + u_ * 256 + l4); } } while (0)
    RW_LOAD(0);
    for (int cc = 0; cc < NCH; ++cc) {
        const int c = d ? NCH - 1 - cc : cc; const unsigned tl = (unsigned)(b * NCH + c); const size_t bo = ((size_t)tl * 4 + h) * 1024;
        uint2 cS[4], cA[4], cE[4];
        { const bf16* eb_ = reg + (size_t)((tl * 4 + h) * 2 + d) * 64;
#pragma unroll
          for (int u = 0; u < 4; ++u) { cS[u] = *reinterpret_cast<const uint2*>(akk + bo + u * 256 + l4); cA[u] = *reinterpret_cast<const uint2*>(aat + bo + u * 256 + l4);
              cE[u] = *reinterpret_cast<const uint2*>(eb_ + le + 16 * u); } }
        union Fr { bf16x8 v; unsigned u[4]; uint4 w; };
        Fr aK0, aK1, aR0, aR1, aMk, aTT, aY;
        aK0.w = nK[0]; aK1.w = nK[1]; aR0.w = nR[0]; aR1.w = nR[1];
        aMk.u[0] = nM[0].x; aMk.u[1] = nM[0].y; aMk.u[2] = 0u; aMk.u[3] = 0u;
        aTT.u[0] = nM[1].x; aTT.u[1] = nM[1].y; aTT.u[2] = 0u; aTT.u[3] = 0u;
        aY.u[0] = nM[2].x; aY.u[1] = nM[2].y; aY.u[2] = nM[3].x; aY.u[3] = nM[3].y;
        uint2 cV[4];
#pragma unroll
        for (int u = 0; u < 4; ++u) cV[u] = nV[u];
        if (cc + 1 < NCH) RW_LOAD(cc + 1);
        float eg[4][4];
#pragma unroll
        for (int u = 0; u < 4; ++u) { eg[u][0] = bflo(cE[u].x); eg[u][1] = bfhi(cE[u].x); eg[u][2] = bflo(cE[u].y); eg[u][3] = bfhi(cE[u].y); }
#pragma unroll
        for (int it = 0; it < 4; ++it) {
            Fr bZ0, bZ1, bV, bB, bVU;
            bZ0.u[0] = pack_bf16(Z[0][it][0], Z[0][it][1]); bZ0.u[1] = pack_bf16(Z[0][it][2], Z[0][it][3]); bZ0.u[2] = pack_bf16(Z[1][it][0], Z[1][it][1]); bZ0.u[3] = pack_bf16(Z[1][it][2], Z[1][it][3]);
            bZ1.u[0] = pack_bf16(Z[2][it][0], Z[2][it][1]); bZ1.u[1] = pack_bf16(Z[2][it][2], Z[2][it][3]); bZ1.u[2] = pack_bf16(Z[3][it][0], Z[3][it][1]); bZ1.u[3] = pack_bf16(Z[3][it][2], Z[3][it][3]);
            const f32x4 zero = {0.f, 0.f, 0.f, 0.f};
            f32x4 P1 = __builtin_amdgcn_mfma_f32_16x16x32_bf16(aK0.v, bZ0.v, zero, 0, 0, 0); P1 = __builtin_amdgcn_mfma_f32_16x16x32_bf16(aK1.v, bZ1.v, P1, 0, 0, 0);
            f32x4 P2 = __builtin_amdgcn_mfma_f32_16x16x32_bf16(aR0.v, bZ0.v, zero, 0, 0, 0); P2 = __builtin_amdgcn_mfma_f32_16x16x32_bf16(aR1.v, bZ1.v, P2, 0, 0, 0);
            bV.u[0] = cV[it].x; bV.u[1] = cV[it].y; bV.u[2] = 0u; bV.u[3] = 0u;
            const f32x4 Bt = __builtin_amdgcn_mfma_f32_16x16x32_bf16(aMk.v, bV.v, P1, 0, 0, 0);
            bB.u[0] = pack_bf16(Bt[0], Bt[1]); bB.u[1] = pack_bf16(Bt[2], Bt[3]); bB.u[2] = 0u; bB.u[3] = 0u;
            const f32x4 Ut = __builtin_amdgcn_mfma_f32_16x16x32_bf16(aTT.v, bB.v, zero, 0, 0, 0);
            bVU.u[0] = cV[it].x; bVU.u[1] = cV[it].y; bVU.u[2] = pack_bf16(Ut[0], Ut[1]); bVU.u[3] = pack_bf16(Ut[2], Ut[3]);
            const f32x4 Y = __builtin_amdgcn_mfma_f32_16x16x32_bf16(aY.v, bVU.v, P2, 0, 0, 0);
            *reinterpret_cast<uint2*>(akt + bo + it * 256 + l4) = make_uint2(pack_bf16(Y[0], Y[1]), pack_bf16(Y[2], Y[3]));
#pragma unroll
            for (int jt = 0; jt < 4; ++jt) {
                Fr aS; aS.u[0] = cS[jt].x; aS.u[1] = cS[jt].y; aS.u[2] = cA[jt].x; aS.u[3] = cA[jt].y;
                f32x4 t = __builtin_amdgcn_mfma_f32_16x16x32_bf16(aS.v, bVU.v, Z[jt][it], 0, 0, 0);
                t[0] *= eg[jt][0]; t[1] *= eg[jt][1]; t[2] *= eg[jt][2]; t[3] *= eg[jt][3];
                Z[jt][it] = t;
            }
        }
    }
#undef RW_LOAD
#undef RW_MPTR
}
#endif

DI void phase_prep(const Frame& F, int l) {
#ifndef CPU_EMU
    prep_attn_gpu(F, l); prep_rwkv_gpu(F, l); prep_hgrn_gpu(F, l);
#else
    {
        bf16* hatt = WSP(bf16, OFF_HATT); bf16* vt = WSP(bf16, OFF_VTATT);
        const float* qn = F.in[5] + l * 64; const float* kn = F.in[6] + l * 64;
        const int nitem = NTOK * 6;
        for (int it = ggrp(F); it < nitem; it += ngrp(F)) {
            const int n = it / 6, hh = it % 6;
            const int s = n % SEQ;
            bf16* p = hatt + (size_t)n * 512 + hh * 64;
            const float* gn = hh < 4 ? qn : kn;
            float v[PER64]; float ss = 0.f;
            for (int i = 0; i < PER64; ++i) { int j = glane(F) + i * GRP; v[i] = bf2f(p[j]); ss += v[i] * v[i]; }
            ss = grp_sum(F, ss); const float rs = 1.0f / sqrtf(ss * (1.0f / 64.0f) + RMS_EPS);
            float o[PER64];
#ifdef CPU_EMU
            float nv[64]; for (int j = 0; j < 64; ++j) nv[j] = v[j] * rs * gn[j];
#endif
            for (int i = 0; i < PER64; ++i) {
                int j = glane(F) + i * GRP;
                const int half = j >> 5, w = j & 31, f = w & 15, second = w >> 4;
                const float pos = half == 0 ? (float)(s / GRIDW) : (float)(s % GRIDW);
                const float ang = pos * rope_inv(2 * f, 32);
                const float cs = cosf(ang), sn = sinf(ang);
                const float mine = v[i] * rs * gn[j];
                const int jp = second ? j - 16 : j + 16;
#ifdef CPU_EMU
                const float partner = nv[jp];
#else
                const float partner = shfl_idx(F, v[0], jp) * rs * gn[jp];
#endif
                o[i] = second ? (partner * sn + mine * cs) : (mine * cs - partner * sn);
            }
            for (int i = 0; i < PER64; ++i) { int j = glane(F) + i * GRP; p[j] = f2bf(o[i]); }
        }
        for (size_t i = gtid_(F); i < (size_t)NTOK * 128; i += gthreads(F)) {
            const int n = (int)(i / 128), c = (int)(i % 128), b = n / SEQ, s = n % SEQ;
            vt[((size_t)b * 128 + c) * SEQ + s] = hatt[(size_t)n * 512 + 384 + c];
        }
    }
    {
        bf16* hm = WSP(bf16, OFF_HMLA); bf16* kr = WSP(bf16, OFF_KROPE);
        const float* qn = F.in[21] + l * 192; const float* kvn = F.in[22] + l * 128;
        for (int it = ggrp(F); it < NTOK * 2; it += ngrp(F)) {
            const int n = it >> 1, which = it & 1;
            bf16* p = hm + (size_t)n * 512 + (which ? 256 : 0);
            const int len = which ? 128 : 192; const float* gn = which ? kvn : qn;
            float ss = 0.f;
            for (int j = glane(F); j < len; j += GRP) { float x = bf2f(p[j]); ss += x * x; }
            ss = grp_sum(F, ss); const float rs = 1.0f / sqrtf(ss / (float)len + RMS_EPS);
            for (int j = glane(F); j < len; j += GRP) p[j] = f2bf(bf2f(p[j]) * rs * gn[j]);
        }
        for (int i = gtid_(F); i < NTOK * 16; i += gthreads(F)) {
            const int n = i >> 4, m = i & 15, s = n % SEQ;
            const bf16* src = hm + (size_t)n * 512 + 192;
            const int i1 = (m < 8 ? m : 16 + (m - 8)), i2 = i1 + 8;
            const float x1 = bf2f(src[i1]), x2 = bf2f(src[i2]);
            const float pos = m < 8 ? (float)(s / GRIDW) : (float)(s % GRIDW);
            const float ang = pos * rope_inv(2 * (m & 7), 16);
            const float cs = cosf(ang), sn = sinf(ang);
            kr[(size_t)n * 32 + 2 * m] = f2bf(x1 * cs - x2 * sn);
            kr[(size_t)n * 32 + 2 * m + 1] = f2bf(x1 * sn + x2 * cs);
        }
    }
#ifdef CPU_EMU
    {
        const bf16* hz = WSP(bf16, OFF_HRWKV); bf16* r7 = WSP(bf16, OFF_R7); bf16* gb = WSP(bf16, OFF_G); float* bonus = WSP(float, OFF_BONUS);
        const float* mup = F.in[7] + l * 960; const float* mun = F.in[8] + l * 960;
        const float* w0 = F.in[9] + l * 512; const float* w2 = F.in[10] + (size_t)l * 2 * 32 * 256;
        const float* a0 = F.in[11] + l * 512; const float* a2 = F.in[12] + (size_t)l * 2 * 32 * 256;
        const float* g2 = F.in[13] + (size_t)l * 64 * 256;
        const float* k_k = F.in[14] + l * 256; const float* k_a = F.in[15] + l * 256; const float* r_k = F.in[16] + l * 256;
        const size_t AS = (size_t)NTOK * 256;
        for (int it = ggrp(F); it < NTOK * 4; it += ngrp(F)) {
            const int n = it >> 2, h = it & 3, s = n % SEQ;
            const bf16* z = hz + (size_t)n * 1024;
            const bool hp = s > 0, hn = s < SEQ - 1;
            auto shifted = [&](int c) -> float {
                const float zc = bf2f(z[c]);
                const float zp = hp ? bf2f(z[c - 1024]) : 0.f, zn = hn ? bf2f(z[c + 1024]) : 0.f;
                return zc + mup[c] * (zp - zc) + mun[c] * (zn - zc);
            };
            float kkv[PER64], rr[PER64], kd0[PER64], kd1[PER64], aa0[PER64], aa1[PER64];
            float ss = 0.f, bs = 0.f;
            for (int i = 0; i < PER64; ++i) {
                const int j = glane(F) + i * GRP, c = h * 64 + j;
                const float r = shifted(c), k = shifted(256 + c), v = shifted(512 + c);
                float wr0 = w0[c], wr1 = w0[256 + c], ar0 = a0[c], ar1 = a0[256 + c], g = 0.f;
                for (int q = 0; q < 32; ++q) {
                    wr0 += tanhf(shifted(768 + q)) * w2[(size_t)q * 256 + c];
                    wr1 += tanhf(shifted(800 + q)) * w2[(size_t)(32 + q) * 256 + c];
                    ar0 += shifted(832 + q) * a2[(size_t)q * 256 + c];
                    ar1 += shifted(864 + q) * a2[(size_t)(32 + q) * 256 + c];
                }
                for (int q = 0; q < 64; ++q) g += sigmoidf_(shifted(896 + q)) * g2[(size_t)q * 256 + c];
                const float dec0 = expf(-DECAY_SCALE * sigmoidf_(wr0)), dec1 = expf(-DECAY_SCALE * sigmoidf_(wr1));
                const float A0 = sigmoidf_(ar0), A1 = sigmoidf_(ar1);
                const float kk = k * k_k[c];
                kkv[i] = kk; ss += kk * kk; rr[i] = r; aa0[i] = A0; aa1[i] = A1;
                kd0[i] = k * (1.0f + (A0 - 1.0f) * k_a[c]); kd1[i] = k * (1.0f + (A1 - 1.0f) * k_a[c]);
                bs += r * (kd0[i] + kd1[i]) * r_k[c];
                const size_t o = (size_t)n * 256 + c;
                r7[R_R * AS + o] = f2bf(r); r7[R_V * AS + o] = f2bf(v);
                r7[R_W0 * AS + o] = f2bf(dec0); r7[R_W1 * AS + o] = f2bf(dec1);
                r7[R_KD0 * AS + o] = f2bf(kd0[i]); r7[R_KD1 * AS + o] = f2bf(kd1[i]);
                gb[o] = f2bf(g);
            }
            ss = grp_sum(F, ss); bs = grp_sum(F, bs);
            const float inv = 1.0f / fmaxf(sqrtf(ss), 1e-12f);
            for (int i = 0; i < PER64; ++i) {
                const int j = glane(F) + i * GRP, c = h * 64 + j; const size_t o = (size_t)n * 256 + c;
                const float kk = kkv[i] * inv;
                r7[R_KK * AS + o] = f2bf(kk); r7[R_AK0 * AS + o] = f2bf(aa0[i] * kk); r7[R_AK1 * AS + o] = f2bf(aa1[i] * kk);
            }
            if (glane(F) == 0) bonus[(size_t)n * 4 + h] = bs;
        }
    }
#else
    prep_rwkv_gpu(F, l);
#endif
    {
        bf16* hh = WSP(bf16, OFF_HHGRN);
        const float* lg = F.in[19];
        for (size_t i = gtid_(F); i < (size_t)NTOK * 768; i += gthreads(F)) {
            const int n = (int)(i / 768), c = (int)(i % 768);
            bf16* p = hh + (size_t)n * 1280 + c;
            const float x = bf2f(*p);
            if (c < 256) { *p = f2bf(siluf_(x)); }
            else {
                const int d = c & 255;
                float lb = 0.f;
                if (l == 1) { const float a = lg[d], b = lg[256 + d]; const float m = fmaxf(a, b); const float ea = expf(a - m), eb = expf(b - m); lb = eb / (ea + eb); }
                *p = f2bf((1.0f - lb) * sigmoidf_(-x));
            }
        }
    }
#endif
}

struct EpiQMla {
    bf16* q; int row0, pn;
    DI void operator()(int r, int c, float a, float b, float cc, float d) const {
        const int row = row0 + r, col = pn * 256 + c;
        if (col >= 384) return;
        const int w = col % 96;
        if (w >= 64) {
            const int s = row % SEQ;
#pragma unroll
            for (int t = 0; t < 2; ++t) {
                const int m = ((w - 64) >> 1) + t;
                const float pos = m < 8 ? (float)(s / GRIDW) : (float)(s % GRIDW);
                const float ang = pos * rope_inv(2 * (m & 7), 16);
                const float cs = cosf(ang), sn = sinf(ang);
                float& x1 = t ? cc : a; float& x2 = t ? d : b;
                const float y1 = x1 * cs - x2 * sn, y2 = x1 * sn + x2 * cs; x1 = y1; x2 = y2;
            }
        }
        st_bf16x4(q + (size_t)row * 384 + col, a, b, cc, d);
    }
};
struct EpiKVMla {
    bf16* kn; bf16* vt; int row0, pn;
    DI void operator()(int r, int c, float a, float b, float cc, float d) const {
        const int row = row0 + r, col = pn * 256 + c, h = col >> 7, w = col & 127;
        if (w < 64) st_bf16x4(kn + (size_t)row * 256 + h * 64 + w, a, b, cc, d);
        else { const int bb = row / SEQ, s = row % SEQ; bf16* p = vt + ((size_t)bb * 256 + h * 64 + (w - 64)) * SEQ + s;
            p[0] = f2bf(a); p[SEQ] = f2bf(b); p[2 * SEQ] = f2bf(cc); p[3 * SEQ] = f2bf(d); }
    }
};
DI void phase_mlaup(const Frame& F) {
    const bf16* hm = WSP(bf16, OFF_HMLA); const char* wts = (const char*)WSP(bf16, OFF_WTS);
    const int nM = (NTOK + 255) / 256;
    for (int u = blockIdx.x; u < nM * 4; u += F.nblk) {
        const int pm = u >> 2, j = u & 3;
#ifdef CPU_EMU
        const int mr = min(256, NTOK - pm * 256);
#define MR , mr
#else
#define MR
#endif
        if (j < 2) { EpiQMla E{WSP(bf16, OFF_QMLA), pm * 256, j};
            gemm_unit(F, hm, 512, nullptr, pm * 256, (const bf16*)(wts + W_UQ_T), 256, j * 256, 256, E MR); }
        else { EpiKVMla E{WSP(bf16, OFF_KNOPE), WSP(bf16, OFF_VTMLA), pm * 256, j - 2};
            gemm_unit(F, hm + 256, 512, nullptr, pm * 256, (const bf16*)(wts + W_UKV_T), 256, (j - 2) * 256, 256, E MR); }
    }
}

struct AttnDesc {
    const bf16* q; int q_stride;
    int q_hstride;
    const bf16* k; int k_stride; int k_hstride;
    const bf16* k2; int k2_stride;
    int dk_main;
    const bf16* vt;
    bf16* o; int o_stride; int o_hstride;
    int H, HKV, SQ, SK;
    float scale;
};

#ifdef CPU_EMU
template <int DK, int DV>
void attn_phase(const Frame& F, const AttnDesc& A) {
    const int G = A.H / A.HKV;
    float* sc = (float*)malloc(sizeof(float) * A.SK);
    for (int b = 0; b < BATCH; ++b) for (int h = 0; h < A.H; ++h) for (int s = 0; s < A.SQ; ++s) {
        const int kv = h / G;
        const bf16* q = A.q + (size_t)(b * A.SQ + s) * A.q_stride + h * A.q_hstride;
        float mx = -1e30f;
        for (int key = 0; key < A.SK; ++key) {
            const bf16* kp = A.k + (size_t)(b * A.SK + key) * A.k_stride + kv * A.k_hstride;
            double acc = 0;
            for (int d = 0; d < DK; ++d) {
                float kvl = d < A.dk_main ? bf2f(kp[d]) : bf2f(A.k2[(size_t)(b * A.SK + key) * A.k2_stride + d - A.dk_main]);
                acc += (double)bf2f(q[d]) * kvl;
            }
            sc[key] = (float)acc * A.scale; mx = fmaxf(mx, sc[key]);
        }
        double sum = 0; for (int key = 0; key < A.SK; ++key) { sc[key] = expf(sc[key] - mx); sum += sc[key]; }
        for (int dv = 0; dv < DV; ++dv) {
            const bf16* vp = A.vt + ((size_t)(b * A.HKV + kv) * DV + dv) * A.SK;
            double acc = 0; for (int key = 0; key < A.SK; ++key) acc += (double)bf2f(f2bf(sc[key])) * bf2f(vp[key]);
            A.o[(size_t)(b * A.SQ + s) * A.o_stride + h * A.o_hstride + dv] = f2bf((float)(acc / sum));
        }
    }
    free(sc);
}
#else
DI int crow16(int reg, int h) { return (reg & 3) + 8 * (reg >> 2) + 4 * h; }
template <int DK, int DV, int DVT, int NQB>
DI void attn_unit(const Frame& F, const AttnDesc& A, int u) {
    constexpr int KP = DK + 8;
    constexpr int VP = 64 + 8;
    constexpr int NPASS = DV / DVT;
    constexpr int UQ = 256 * NQB;
    bf16* Ks = (bf16*)F.smem;
    bf16* Vs = Ks + 64 * KP;
    const int tid = fresh_tid(F), wave = F.wv, lane = tid & 63, r = lane & 31, hh = lane >> 5;
    const int G = A.H / A.HKV;
    const int nqb = A.SQ / UQ;
    const float sl2 = A.scale * 1.4426950408889634f;
    {
        int t = u; const int pass = t % NPASS; t /= NPASS; const int qb = t % nqb; t /= nqb; const int h = t % A.H; const int b = t / A.H;
        const int kv = h / G;
        const int q0 = qb * UQ + wave * 32 * NQB;
        bf16x8 qf[NQB][DK / 16];
#pragma unroll
        for (int qi = 0; qi < NQB; ++qi) { const bf16* qp = A.q + (size_t)(b * A.SQ + q0 + 32 * qi + r) * A.q_stride + h * A.q_hstride + 8 * hh;
#pragma unroll
          for (int ks = 0; ks < DK / 16; ++ks) qf[qi][ks] = *reinterpret_cast<const bf16x8*>(qp + 16 * ks); }
        f32x16 oacc[NQB][DVT / 32];
#pragma unroll
        for (int qi = 0; qi < NQB; ++qi)
#pragma unroll
            for (int i = 0; i < DVT / 32; ++i)
#pragma unroll
                for (int j = 0; j < 16; ++j) oacc[qi][i][j] = 0.f;
        float mrun[NQB], lrun[NQB];
#pragma unroll
        for (int qi = 0; qi < NQB; ++qi) { mrun[qi] = -INFINITY; lrun[qi] = 0.f; }
        constexpr int NKC = (64 * (DK / 8) + 511) / 512, NVC = (DVT * 8 + 511) / 512;
        uint4 kr0, kr1, kr2, kr3, vr0, vr1;
        kr0 = kr1 = kr2 = kr3 = vr0 = vr1 = make_uint4(0u, 0u, 0u, 0u);
#define ATT_FK(kt_, i_, reg_) do { if ((i_) < NKC) { int c_ = tid + (i_) * 512; if (c_ >= 64 * (DK / 8)) c_ = 64 * (DK / 8) - 1; \
            const int key_ = c_ / (DK / 8), d8_ = (c_ % (DK / 8)) * 8; const size_t krow_ = (size_t)(b * A.SK + (kt_) * 64 + key_); \
            const bf16* kp_ = (d8_ < A.dk_main) ? (A.k + krow_ * A.k_stride + kv * A.k_hstride + d8_) : (A.k2 + krow_ * A.k2_stride + (d8_ - A.dk_main)); \
            reg_ = *reinterpret_cast<const uint4*>(kp_); } } while (0)
#define ATT_FV(kt_, i_, reg_) do { if ((i_) < NVC) { int c_ = tid + (i_) * 512; if (c_ >= DVT * 8) c_ = DVT * 8 - 1; \
            const int dv_ = c_ >> 3, k8_ = (c_ & 7) * 8; \
            reg_ = *reinterpret_cast<const uint4*>(A.vt + ((size_t)(b * A.HKV + kv) * DV + pass * DVT + dv_) * A.SK + (kt_) * 64 + k8_); } } while (0)
#define ATT_FETCH(kt_) do { ATT_FK(kt_, 0, kr0); ATT_FK(kt_, 1, kr1); ATT_FK(kt_, 2, kr2); ATT_FK(kt_, 3, kr3); ATT_FV(kt_, 0, vr0); ATT_FV(kt_, 1, vr1); } while (0)
#define ATT_SK(kb_, i_, reg_) do { if ((i_) < NKC) { const int c_ = tid + (i_) * 512; if (c_ < 64 * (DK / 8)) { \
            const int key_ = c_ / (DK / 8), d8_ = (c_ % (DK / 8)) * 8; *reinterpret_cast<uint4*>((kb_) + key_ * KP + d8_) = reg_; } } } while (0)
#define ATT_SV(vb_, i_, reg_) do { if ((i_) < NVC) { const int c_ = tid + (i_) * 512; if (c_ < DVT * 8) { \
            const int dv_ = c_ >> 3, k8_ = (c_ & 7) * 8; *reinterpret_cast<uint4*>((vb_) + dv_ * VP + k8_) = reg_; } } } while (0)
#define ATT_STORE(kb_, vb_) do { ATT_SK(kb_, 0, kr0); ATT_SK(kb_, 1, kr1); ATT_SK(kb_, 2, kr2); ATT_SK(kb_, 3, kr3); ATT_SV(vb_, 0, vr0); ATT_SV(vb_, 1, vr1); } while (0)
        constexpr bool PREF = DK <= 96;
        constexpr int BUFE = 64 * KP + DVT * VP;
        const int ntile = A.SK / 64;
        if (PREF) { ATT_FETCH(0); ATT_STORE(Ks, Vs); if (ntile > 1) ATT_FETCH(1); __syncthreads(); }
        for (int kt = 0; kt < ntile; ++kt) {
            if (PREF) {
                if (kt + 1 < ntile) { bf16* kb = Ks + ((kt + 1) & 1) * BUFE; ATT_STORE(kb, kb + 64 * KP); if (kt + 2 < ntile) ATT_FETCH(kt + 2); }
            } else {
            __syncthreads();
            {
                for (int c = tid; c < 64 * (DK / 8); c += 512) {
                    const int key = c / (DK / 8), d8 = (c % (DK / 8)) * 8;
                    const size_t krow = (size_t)(b * A.SK + kt * 64 + key);
                    uint4 v;
                    if (d8 < A.dk_main) v = *reinterpret_cast<const uint4*>(A.k + krow * A.k_stride + kv * A.k_hstride + d8);
                    else v = *reinterpret_cast<const uint4*>(A.k2 + krow * A.k2_stride + (d8 - A.dk_main));
                    *reinterpret_cast<uint4*>(Ks + key * KP + d8) = v;
                }
                for (int c = tid; c < DVT * 8; c += 512) {
                    const int dv = c >> 3, k8 = (c & 7) * 8;
                    const uint4 v = *reinterpret_cast<const uint4*>(A.vt + ((size_t)(b * A.HKV + kv) * DV + pass * DVT + dv) * A.SK + kt * 64 + k8);
                    *reinterpret_cast<uint4*>(Vs + dv * VP + k8) = v;
                }
            }
            __syncthreads();
            }
            const bf16* Kc = PREF ? Ks + (kt & 1) * BUFE : Ks; const bf16* Vc = Kc + 64 * KP;
            f32x16 sacc[NQB][2];
#pragma unroll
            for (int kb = 0; kb < 2; ++kb) {
#pragma unroll
                for (int qi = 0; qi < NQB; ++qi)
#pragma unroll
                    for (int j = 0; j < 16; ++j) sacc[qi][kb][j] = 0.f;
#pragma unroll
                for (int ks = 0; ks < DK / 16; ++ks) {
                    const bf16x8 kf = *reinterpret_cast<const bf16x8*>(Kc + (kb * 32 + r) * KP + 16 * ks + 8 * hh);
#pragma unroll
                    for (int qi = 0; qi < NQB; ++qi) sacc[qi][kb] = __builtin_amdgcn_mfma_f32_32x32x16_bf16(kf, qf[qi][ks], sacc[qi][kb], 0, 0, 0);
                }
            }
#pragma unroll
            for (int qi = 0; qi < NQB; ++qi) {
                float mx = -INFINITY;
#pragma unroll
                for (int kb = 0; kb < 2; ++kb)
#pragma unroll
                    for (int j = 0; j < 16; ++j) mx = fmaxf(mx, sacc[qi][kb][j]);
                mx = fmaxf(mx, shfl_xor(F, mx, 32));
                const float mnew = fmaxf(mrun[qi], mx * sl2);
                const float alpha = __builtin_amdgcn_exp2f(mrun[qi] - mnew);
                mrun[qi] = mnew;
                float psum = 0.f;
#pragma unroll
                for (int kb = 0; kb < 2; ++kb)
#pragma unroll
                    for (int j = 0; j < 16; ++j) { const float p = __builtin_amdgcn_exp2f(sacc[qi][kb][j] * sl2 - mnew); sacc[qi][kb][j] = p; psum += p; }
                lrun[qi] = lrun[qi] * alpha + psum;
                if (!PREF || __ballot(alpha != 1.0f)) {
#pragma unroll
                    for (int i = 0; i < DVT / 32; ++i)
#pragma unroll
                        for (int j = 0; j < 16; ++j) oacc[qi][i][j] *= alpha;
                }
            }
#pragma unroll
            for (int kb = 0; kb < 2; ++kb)
#pragma unroll
                for (int s2 = 0; s2 < 2; ++s2) {
                    union PF { bf16x8 v; unsigned u[4]; };
                    PF pf[NQB];
#pragma unroll
                    for (int qi = 0; qi < NQB; ++qi)
#pragma unroll
                        for (int j = 0; j < 4; ++j) pf[qi].u[j] = pack_bf16(sacc[qi][kb][8 * s2 + 2 * j], sacc[qi][kb][8 * s2 + 2 * j + 1]);
#pragma unroll
                    for (int i = 0; i < DVT / 32; ++i) {
                        const bf16* vp = Vc + (i * 32 + r) * VP + kb * 32 + 16 * s2 + 4 * hh;
                        union { bf16x8 v; bf16x4 h2[2]; } vf;
                        vf.h2[0] = *reinterpret_cast<const bf16x4*>(vp);
                        vf.h2[1] = *reinterpret_cast<const bf16x4*>(vp + 8);
#pragma unroll
                        for (int qi = 0; qi < NQB; ++qi) oacc[qi][i] = __builtin_amdgcn_mfma_f32_32x32x16_bf16(vf.v, pf[qi].v, oacc[qi][i], 0, 0, 0);
                    }
                }
            if (PREF) __syncthreads();
        }
#pragma unroll
        for (int qi = 0; qi < NQB; ++qi) {
            const float lsum = lrun[qi] + shfl_xor(F, lrun[qi], 32);
            const float inv = 1.0f / lsum;
            bf16* op = A.o + (size_t)(b * A.SQ + q0 + 32 * qi + r) * A.o_stride + h * A.o_hstride + pass * DVT;
#pragma unroll
            for (int i = 0; i < DVT / 32; ++i)
#pragma unroll
                for (int g = 0; g < 4; ++g)
                    st_bf16x4(op + i * 32 + 8 * g + 4 * hh, oacc[qi][i][4 * g] * inv, oacc[qi][i][4 * g + 1] * inv, oacc[qi][i][4 * g + 2] * inv, oacc[qi][i][4 * g + 3] * inv);
        }
    }
}
#endif

#undef ATT_FETCH
#undef ATT_STORE
#undef ATT_FK
#undef ATT_FV
#undef ATT_SK
#undef ATT_SV
#ifndef CPU_EMU
template <int DK, int DV, int DVT, int NQB>
DI int attn_nunit(const AttnDesc& A) { return BATCH * A.H * (A.SQ / (256 * NQB)) * (DV / DVT); }
template <int DK, int DV, int DVT, int NQB>
DI void attn_phase(const Frame& F, const AttnDesc& A) {
    const int nunit = attn_nunit<DK, DV, DVT, NQB>(A);
    for (int u = blockIdx.x; u < nunit; u += F.nblk) attn_unit<DK, DV, DVT, NQB>(F, A, u);
}
#endif
DI AttnDesc desc_gqa(const Frame& F) {
    AttnDesc A; A.q = WSP(bf16, OFF_HATT); A.q_stride = 512; A.q_hstride = 64;
    A.k = WSP(bf16, OFF_HATT) + 256; A.k_stride = 512; A.k_hstride = 64; A.k2 = nullptr; A.k2_stride = 0; A.dk_main = 64;
    A.vt = WSP(bf16, OFF_VTATT); A.o = WSP(bf16, OFF_YCAT); A.o_stride = 1024; A.o_hstride = 64;
    A.H = 4; A.HKV = 2; A.SQ = SEQ; A.SK = SEQ; A.scale = 0.125f; return A;
}
DI AttnDesc desc_mla(const Frame& F) {
    AttnDesc A; A.q = WSP(bf16, OFF_QMLA); A.q_stride = 384; A.q_hstride = 96;
    A.k = WSP(bf16, OFF_KNOPE); A.k_stride = 256; A.k_hstride = 64; A.k2 = WSP(bf16, OFF_KROPE); A.k2_stride = 32; A.dk_main = 64;
    A.vt = WSP(bf16, OFF_VTMLA); A.o = WSP(bf16, OFF_YCAT) + 768; A.o_stride = 1024; A.o_hstride = 64;
    A.H = 4; A.HKV = 4; A.SQ = SEQ; A.SK = SEQ; A.scale = 0.10206207261596575f; return A;
}
DI AttnDesc desc_mem(const Frame& F) {
    AttnDesc A; A.q = WSP(bf16, OFF_QMEM); A.q_stride = 1024; A.q_hstride = 256;
    A.k = WSP(bf16, OFF_KMEM); A.k_stride = 1024; A.k_hstride = 256; A.k2 = nullptr; A.k2_stride = 0; A.dk_main = 256;
    A.vt = WSP(bf16, OFF_VTMEM); A.o = WSP(bf16, OFF_OMEM); A.o_stride = 1024; A.o_hstride = 256;
    A.H = 4; A.HKV = 4; A.SQ = SEQ; A.SK = MEMT; A.scale = 0.0625f; return A;
}

#ifndef CPU_EMU
typedef float f32p __attribute__((ext_vector_type(2)));
DI f32p allsum16p(f32p x) { x.x = allsum16(x.x); x.y = allsum16(x.y); return x; }
template <int KIND>
DI void scan_chain(const Frame& F, int chain) {
    constexpr int T = 32;
    constexpr int NARR = KIND == 0 ? 6 : 3;
    constexpr int STEPB = NARR * 256;
    constexpr int NPIECE = T * NARR * 8;
    constexpr int PPT = (NPIECE + NTH - 1) / NTH;
    const int d = chain / (BATCH * 4), b = (chain / 4) % BATCH, h = chain % 4;
    const int tid = F.tid, wave = tid >> 6, lane = tid & 63, rg = lane >> 4, cg = lane & 15;
    unsigned char* buf0 = F.smem; unsigned char* buf1 = F.smem + T * STEPB;
    unsigned char* ybuf = F.smem + 2 * T * STEPB;
    const size_t AS = (size_t)NTOK * 256;
    bf16* r7 = WSP(bf16, OFF_R7); bf16* hh = WSP(bf16, OFF_HHGRN);
#define PIECE_PTR(t0, p_) ([&]() -> const uint4* { const int pc = (p_) < NPIECE ? (p_) : NPIECE - 1; \
        const int st = pc / (NARR * 8), rem = pc % (NARR * 8), arr = rem >> 3, part = rem & 7; \
        const int tt = (t0) + st, ss = d ? SEQ - 1 - tt : tt; const size_t nn = (size_t)b * SEQ + ss; \
        const bf16* base; \
        if (KIND == 0) { const int aid = arr == 0 ? R_KK : arr == 1 ? (d ? R_W1 : R_W0) : arr == 2 ? (d ? R_AK1 : R_AK0) : arr == 3 ? (d ? R_KD1 : R_KD0) : arr == 4 ? R_R : R_V; \
            base = r7 + aid * AS + nn * 256 + h * 64; } \
        else { const int off = arr == 0 ? 256 + d * 256 : arr == 1 ? 0 : 768; base = hh + nn * 1280 + off + h * 64; } \
        return reinterpret_cast<const uint4*>(base + part * 8); }())
#define PUT_PIECE(dst, p_, v_) do { float4 a_, b_; a_.x = bflo((v_).x); a_.y = bfhi((v_).x); a_.z = bflo((v_).y); a_.w = bfhi((v_).y); \
        b_.x = bflo((v_).z); b_.y = bfhi((v_).z); b_.z = bflo((v_).w); b_.w = bfhi((v_).w); \
        *reinterpret_cast<float4*>((dst) + (p_) * 32) = a_; *reinterpret_cast<float4*>((dst) + (p_) * 32 + 16) = b_; } while (0)
#define STORE_PRE(dst) do { PUT_PIECE(dst, tid, pre0); \
        if (tid + NTH < NPIECE) PUT_PIECE(dst, tid + NTH, pre1); \
        if (PPT > 2 && tid + 2 * NTH < NPIECE) PUT_PIECE(dst, tid + 2 * NTH, pre2); } while (0)
    uint4 pre0, pre1, pre2;
    pre0 = *PIECE_PTR(0, tid); pre1 = *PIECE_PTR(0, tid + NTH); pre2 = pre1;
    if (PPT > 2) pre2 = *PIECE_PTR(0, tid + 2 * NTH);
    __syncthreads();
    STORE_PRE(buf0);
    __syncthreads();
    f32p P[4];
#pragma unroll
    for (int c = 0; c < 4; ++c) P[c] = (f32p){0.f, 0.f};
    const int vofs = (wave * 8 + rg * 2) * 4;
    for (int ch = 0; ch < SEQ / T; ++ch) {
        const unsigned char* cur = (ch & 1) ? buf1 : buf0;
        if (ch + 1 < SEQ / T) {
            pre0 = *PIECE_PTR((ch + 1) * T, tid); pre1 = *PIECE_PTR((ch + 1) * T, tid + NTH);
            if (PPT > 2) pre2 = *PIECE_PTR((ch + 1) * T, tid + 2 * NTH);
        }
        float4 o0, o1, o2, o3, o4; f32p ov;
        { const unsigned char* sb = cur;
          o0 = *reinterpret_cast<const float4*>(sb + 0 * 256 + cg * 16); o1 = *reinterpret_cast<const float4*>(sb + 1 * 256 + cg * 16);
          if (KIND == 0) { o2 = *reinterpret_cast<const float4*>(sb + 2 * 256 + cg * 16); o3 = *reinterpret_cast<const float4*>(sb + 3 * 256 + cg * 16); o4 = *reinterpret_cast<const float4*>(sb + 4 * 256 + cg * 16); }
          ov = *reinterpret_cast<const f32p*>(sb + (NARR - 1) * 256 + vofs); }
        unsigned ykeep = 0u;
#pragma unroll 2
        for (int t = 0; t < T; ++t) {
            const float4 c0 = o0, c1 = o1, c2 = o2, c3 = o3, c4 = o4; const f32p v = ov;
            { const unsigned char* sb = cur + ((t + 1) & (T - 1)) * STEPB;
              o0 = *reinterpret_cast<const float4*>(sb + 0 * 256 + cg * 16); o1 = *reinterpret_cast<const float4*>(sb + 1 * 256 + cg * 16);
              if (KIND == 0) { o2 = *reinterpret_cast<const float4*>(sb + 2 * 256 + cg * 16); o3 = *reinterpret_cast<const float4*>(sb + 3 * 256 + cg * 16); o4 = *reinterpret_cast<const float4*>(sb + 4 * 256 + cg * 16); }
              ov = *reinterpret_cast<const f32p*>(sb + (NARR - 1) * 256 + vofs); }
            f32p y;
            if (KIND == 0) {
                f32p sa = P[0] * c0.x + P[1] * c0.y + P[2] * c0.z + P[3] * c0.w;
                sa = allsum16p(sa);
                P[0] = P[0] * c1.x - sa * c2.x + v * c3.x;
                P[1] = P[1] * c1.y - sa * c2.y + v * c3.y;
                P[2] = P[2] * c1.z - sa * c2.z + v * c3.z;
                P[3] = P[3] * c1.w - sa * c2.w + v * c3.w;
                y = P[0] * c4.x + P[1] * c4.y + P[2] * c4.z + P[3] * c4.w;
            } else {
                P[0] += (v - P[0]) * c0.x; P[1] += (v - P[1]) * c0.y; P[2] += (v - P[2]) * c0.z; P[3] += (v - P[3]) * c0.w;
                y = P[0] * c1.x + P[1] * c1.y + P[2] * c1.z + P[3] * c1.w;
            }
            y = allsum16p(y);
            const unsigned yp = pack_bf16(y.x, y.y);
            ykeep = ((t & 15) == cg) ? yp : ykeep;
            if ((t & 15) == 15) *reinterpret_cast<unsigned*>(ybuf + ((t & ~15) + cg) * 128 + (wave * 8 + rg * 2) * 2) = ykeep;
        }
        asm volatile("s_waitcnt lgkmcnt(0)" ::: "memory");
        __builtin_amdgcn_wave_barrier();
        if (lane < T) {
            const int t = ch * T + lane, s = d ? SEQ - 1 - t : t; const size_t n = (size_t)b * SEQ + s;
            const uint4 yv = *reinterpret_cast<const uint4*>(ybuf + lane * 128 + wave * 16);
            bf16* dst = KIND == 0 ? r7 + (d ? R_W1 : R_W0) * AS + n * 256 + h * 64 + wave * 8 : hh + n * 1280 + 256 + d * 256 + h * 64 + wave * 8;
            *reinterpret_cast<uint4*>(dst) = yv;
        }
        if (ch + 1 < SEQ / T) {
            unsigned char* nxt = (ch & 1) ? buf0 : buf1;
            STORE_PRE(nxt);
        }
        __syncthreads();
    }
#undef PIECE_PTR
#undef STORE_PRE
#undef PUT_PIECE
}
DI void phase_scans(const Frame& F) {
    const int nchain = 2 * BATCH * 4;
    for (int g = blockIdx.x; g < nchain / 4; g += F.nblk) {
        if (F.wv < 4) scan_rwkv_chunk(F, g * 4 + F.wv); else scan_hgrn_chunk(F, g * 4 + F.wv - 4);
    }
}
#else
DI void phase_scans(const Frame& F) {
    bf16* r7 = WSP(bf16, OFF_R7); const size_t AS = (size_t)NTOK * 256;
    bf16* hh = WSP(bf16, OFF_HHGRN);
    const int nitem = 2 * BATCH * 4 * 64 * 2;
    for (int it = wave_item_index(F); it < nitem; it += gthreads(F)) {
        const int kind = it / (2 * BATCH * 4 * 64);
        int c = (it % (2 * BATCH * 4 * 64)) / 64; const int i = it % 64;
        const int d = c / (BATCH * 4); c %= BATCH * 4; const int b = c / 4, h = c % 4;
        float S[64];
#pragma unroll
        for (int j = 0; j < 64; ++j) S[j] = 0.f;
        if (kind == 0) {
            const bf16* pr = r7 + R_R * AS, *pv = r7 + R_V * AS, *pkk = r7 + R_KK * AS;
            bf16* pw = r7 + (d ? R_W1 : R_W0) * AS; const bf16* pkd = r7 + (d ? R_KD1 : R_KD0) * AS, *pak = r7 + (d ? R_AK1 : R_AK0) * AS;
            for (int t = 0; t < SEQ; ++t) {
                const int s = d ? SEQ - 1 - t : t;
                const size_t o = ((size_t)(b * SEQ + s)) * 256 + h * 64;
                const float v = bf2f(pv[o + i]);
                float sa = 0.f;
#pragma unroll
                for (int j = 0; j < 64; ++j) sa += S[j] * bf2f(pkk[o + j]);
                float y = 0.f;
#pragma unroll
                for (int j = 0; j < 64; ++j) {
                    S[j] = S[j] * bf2f(pw[o + j]) - sa * bf2f(pak[o + j]) + v * bf2f(pkd[o + j]);
                    y += S[j] * bf2f(pr[o + j]);
                }
#ifndef CPU_EMU
                __builtin_amdgcn_wave_barrier();
#endif
#ifdef CPU_EMU
                WSP(bf16, OFF_EMU_SCAN)[(size_t)d * AS + (size_t)(b * SEQ + s) * 256 + h * 64 + i] = f2bf(y);
#else
                pw[o + i] = f2bf(y);
#endif
            }
        } else {
            const bf16* pq = hh; bf16* pk = hh + 256 + d * 256; const bf16* pi = hh + 768;
            for (int t = 0; t < SEQ; ++t) {
                const int s = d ? SEQ - 1 - t : t;
                const size_t o = ((size_t)(b * SEQ + s)) * 1280 + h * 64;
                const float v = bf2f(pi[o + i]);
                float acc = 0.f;
#pragma unroll
                for (int j = 0; j < 64; ++j) {
                    const float k = bf2f(pk[o + j]);
                    S[j] = S[j] + k * (v - S[j]);
                    acc += S[j] * bf2f(pq[o + j]);
                }
#ifndef CPU_EMU
                __builtin_amdgcn_wave_barrier();
#endif
#ifdef CPU_EMU
                WSP(bf16, OFF_EMU_SCAN)[(size_t)(2 + d) * AS + (size_t)(b * SEQ + s) * 256 + h * 64 + i] = f2bf(acc);
#else
                pk[o + i] = f2bf(acc);
#endif
            }
        }
    }
}

#endif

#ifndef CPU_EMU
DI void phase_fin_gpu(const Frame& F, int l) {
    const bf16* r7 = WSP(bf16, OFF_R7); const size_t AS = (size_t)NTOK * 256;
    const bf16* gb = WSP(bf16, OFF_G); const float* bonus = WSP(float, OFF_BONUS);
    const bf16* hh = WSP(bf16, OFF_HHGRN); bf16* ycat = WSP(bf16, OFF_YCAT);
    float* par = (float*)F.smem;
    __syncthreads();
    for (int i = F.tid; i < 768; i += NTH) par[i] = i < 256 ? F.in[17][l * 256 + i] : i < 512 ? F.in[18][l * 256 + i - 256] : F.in[20][l * 256 + i - 512];
    __syncthreads();
    {
        for (int item = blockIdx.x * 8 + F.wv; item < (NTOK / 16) * 4; item += F.nblk * 8) {
            const int lane = fresh_tid(F) & 63, x = lane & 15, q = lane >> 4;
            const int h = item & 3; const size_t n0 = (size_t)(item >> 2) * 16, blk = (size_t)item * 1024;
            const bf16* y0 = r7 + C_KT0 * AS + blk; const bf16* y1 = r7 + C_KT1 * AS + blk; const bf16* vt = r7 + C_VT * AS + blk;
            float y[4][4], v[4][4];
#pragma unroll
            for (int u = 0; u < 4; ++u) {
                const uint2 a = *reinterpret_cast<const uint2*>(y0 + (u * 64 + lane) * 4), b = *reinterpret_cast<const uint2*>(y1 + (u * 64 + lane) * 4), c = *reinterpret_cast<const uint2*>(vt + (u * 64 + lane) * 4);
                y[u][0] = bflo(a.x) + bflo(b.x); y[u][1] = bfhi(a.x) + bfhi(b.x); y[u][2] = bflo(a.y) + bflo(b.y); y[u][3] = bfhi(a.y) + bfhi(b.y);
                v[u][0] = bflo(c.x); v[u][1] = bfhi(c.x); v[u][2] = bflo(c.y); v[u][3] = bfhi(c.y);
            }
#pragma unroll
            for (int r = 0; r < 4; ++r) {
                const size_t n = n0 + 4 * q + r;
                const float mu = allsum16((y[0][r] + y[1][r]) + (y[2][r] + y[3][r])) * (1.0f / 64.0f);
                const float d0 = y[0][r] - mu, d1 = y[1][r] - mu, d2 = y[2][r] - mu, d3 = y[3][r] - mu;
                const float rs = 1.0f / sqrtf(allsum16((d0 * d0 + d1 * d1) + (d2 * d2 + d3 * d3)) * (1.0f / 64.0f) + GN_EPS);
                const float bo = bonus[n * 4 + h];
                const float dv[4] = {d0, d1, d2, d3};
#pragma unroll
                for (int u = 0; u < 4; ++u) {
                    const int c = h * 64 + 16 * u + x;
                    ycat[n * 1024 + 256 + c] = f2bf((dv[u] * rs * par[c] + par[256 + c] + bo * v[u][r]) * bf2f(gb[n * 256 + c]));
                }
            }
        }
    }
    for (int it = blockIdx.x * NTH + fresh_tid(F); it < NTOK * 4; it += gthreads(F)) {
        const int n = it >> 2, h = it & 3;
        const uint4* pa = reinterpret_cast<const uint4*>(hh + (size_t)n * 1280 + 256 + h * 64); const uint4* pb = reinterpret_cast<const uint4*>(hh + (size_t)n * 1280 + 512 + h * 64);
        float s2 = 0.f;
#pragma unroll
        for (int i = 0; i < 8; ++i) { const uint4 a = pa[i], b = pb[i];
            const float y0 = bflo(a.x) + bflo(b.x), y1 = bfhi(a.x) + bfhi(b.x), y2 = bflo(a.y) + bflo(b.y), y3 = bfhi(a.y) + bfhi(b.y);
            const float y4 = bflo(a.z) + bflo(b.z), y5 = bfhi(a.z) + bfhi(b.z), y6 = bflo(a.w) + bflo(b.w), y7 = bfhi(a.w) + bfhi(b.w);
            s2 += (y0 * y0 + y1 * y1) + (y2 * y2 + y3 * y3) + (y4 * y4 + y5 * y5) + (y6 * y6 + y7 * y7); }
        const float rs = 1.0f / sqrtf(s2 * (1.0f / 64.0f) + RMS_EPS);
        uint4* po = reinterpret_cast<uint4*>(ycat + (size_t)n * 1024 + 512 + h * 64);
        const uint4* pg = reinterpret_cast<const uint4*>(hh + (size_t)n * 1280 + 1024 + h * 64);
        const float* gg = par + 512 + h * 64;
#pragma unroll 2
        for (int i = 0; i < 8; ++i) { const uint4 a = pa[i], b = pb[i], g4 = pg[i];
            const float yv[8] = {bflo(a.x) + bflo(b.x), bfhi(a.x) + bfhi(b.x), bflo(a.y) + bflo(b.y), bfhi(a.y) + bfhi(b.y), bflo(a.z) + bflo(b.z), bfhi(a.z) + bfhi(b.z), bflo(a.w) + bflo(b.w), bfhi(a.w) + bfhi(b.w)};
            const float gf[8] = {bflo(g4.x), bfhi(g4.x), bflo(g4.y), bfhi(g4.y), bflo(g4.z), bfhi(g4.z), bflo(g4.w), bfhi(g4.w)};
            float o[8];
#pragma unroll
            for (int j = 0; j < 8; ++j) o[j] = yv[j] * rs * gg[8 * i + j] * (gf[j] * fast_sigmoid(gf[j]));
            po[i] = make_uint4(pack_bf16(o[0], o[1]), pack_bf16(o[2], o[3]), pack_bf16(o[4], o[5]), pack_bf16(o[6], o[7])); }
    }
}
#endif
DI void phase_fin(const Frame& F, int l) {
    const bf16* r7 = WSP(bf16, OFF_R7); const size_t AS = (size_t)NTOK * 256;
    const bf16* gb = WSP(bf16, OFF_G); const float* bonus = WSP(float, OFF_BONUS);
    const bf16* hh = WSP(bf16, OFF_HHGRN); bf16* ycat = WSP(bf16, OFF_YCAT);
    const float* gng = F.in[17] + l * 256; const float* gnb = F.in[18] + l * 256; const float* hng = F.in[20] + l * 256;
    for (int it = ggrp(F); it < NTOK * 8; it += ngrp(F)) {
        const int n = it >> 3, kind = (it >> 2) & 1, h = it & 3;
        float v[PER64];
        if (kind == 0) {
            float s1 = 0.f;
            for (int i = 0; i < PER64; ++i) { const int c = h * 64 + glane(F) + i * GRP; const size_t o = (size_t)n * 256 + c;
#ifdef CPU_EMU
                v[i] = bf2f(WSP(bf16, OFF_EMU_SCAN)[o]) + bf2f(WSP(bf16, OFF_EMU_SCAN)[AS + o]); s1 += v[i]; }
#else
                v[i] = bf2f(r7[R_W0 * AS + o]) + bf2f(r7[R_W1 * AS + o]); s1 += v[i]; }
#endif
            s1 = grp_sum(F, s1); const float mu = s1 * (1.0f / 64.0f);
            float s2 = 0.f; for (int i = 0; i < PER64; ++i) { const float dd = v[i] - mu; s2 += dd * dd; }
            s2 = grp_sum(F, s2); const float rs = 1.0f / sqrtf(s2 * (1.0f / 64.0f) + GN_EPS);
            const float bo = bonus[(size_t)n * 4 + h];
            for (int i = 0; i < PER64; ++i) { const int c = h * 64 + glane(F) + i * GRP; const size_t o = (size_t)n * 256 + c;
                const float y = (v[i] - mu) * rs * gng[c] + gnb[c];
                ycat[(size_t)n * 1024 + 256 + c] = f2bf((y + bo * bf2f(r7[R_V * AS + o])) * bf2f(gb[o])); }
        } else {
            float s2 = 0.f;
            for (int i = 0; i < PER64; ++i) { const int c = h * 64 + glane(F) + i * GRP; const size_t o = (size_t)n * 1280 + c;
#ifdef CPU_EMU
                const size_t oe = (size_t)n * 256 + c;
                v[i] = bf2f(WSP(bf16, OFF_EMU_SCAN)[2 * AS + oe]) + bf2f(WSP(bf16, OFF_EMU_SCAN)[3 * AS + oe]); s2 += v[i] * v[i]; }
#else
                v[i] = bf2f(hh[o + 256]) + bf2f(hh[o + 512]); s2 += v[i] * v[i]; }
#endif
            s2 = grp_sum(F, s2); const float rs = 1.0f / sqrtf(s2 * (1.0f / 64.0f) + RMS_EPS);
            for (int i = 0; i < PER64; ++i) { const int c = h * 64 + glane(F) + i * GRP; const size_t o = (size_t)n * 1280 + c;
                ycat[(size_t)n * 1024 + 512 + c] = f2bf(v[i] * rs * hng[c] * siluf_(bf2f(hh[o + 1024]))); }
        }
    }
}

struct EpiResid {
    float* xf; int row0, pn;
    DI void operator()(int r, int c, float a, float b, float cc, float d) const {
        float* p = xf + (size_t)(row0 + r) * DM + pn * 256 + c;
#ifndef CPU_EMU
        float4 x = *reinterpret_cast<float4*>(p);
        x.x = DN_ALPHA * x.x + a; x.y = DN_ALPHA * x.y + b; x.z = DN_ALPHA * x.z + cc; x.w = DN_ALPHA * x.w + d;
        *reinterpret_cast<float4*>(p) = x;
#else
        p[0] = DN_ALPHA * p[0] + a; p[1] = DN_ALPHA * p[1] + b; p[2] = DN_ALPHA * p[2] + cc; p[3] = DN_ALPHA * p[3] + d;
#endif
    }
};
struct EpiBf {
    bf16* o; int ld; int row0, pn;
    DI void operator()(int r, int c, float a, float b, float cc, float d) const { st_bf16x4(o + (size_t)(row0 + r) * ld + pn * 256 + c, a, b, cc, d); }
};
template <int MODE>
DI void phase_gemm_sq(const Frame& F, const bf16* A, size_t woff, bf16* outb) {
    const bf16* W = (const bf16*)((const char*)WSP(bf16, OFF_WTS) + woff);
    const int nM = (NTOK + 255) / 256;
    for (int u = blockIdx.x; u < nM * 4; u += F.nblk) {
        const int pm = u >> 2, pn = u & 3;
#ifdef CPU_EMU
        const int mr = min(256, NTOK - pm * 256);
#endif
        if (MODE == 0) { EpiResid E{F.xf, pm * 256, pn}; gemm_unit(F, A, 1024, nullptr, pm * 256, W, 1024, pn * 256, 1024, E MR); }
        else { EpiBf E{outb, 1024, pm * 256, pn}; gemm_unit(F, A, 1024, nullptr, pm * 256, W, 1024, pn * 256, 1024, E MR); }
    }
}

template <bool BLOCKED = false>
DI void phase_ln(const Frame& F, const float* g, const float* b) {
#ifdef CPU_EMU
    const float* xf = F.xf;
    layer_norm_rows(F, g, b, [&](int row, int c) { return xf[(size_t)row * DM + c]; }, false, nullptr);
#else
    ln_rows_gpu<0, BLOCKED>(F, g, b, 0);
#endif
}

#ifndef CPU_EMU
DI void phase_route_gpu(const Frame& F, int l) {
    const float* xf = F.xf; const float* gt = (const float*)((const char*)WSP(bf16, OFF_WTS) + W_GATE_T) + (size_t)l * 48 * 1024;
    const float* bg = F.in[34] + l * 4; const float* be = F.in[36] + l * 32;
    int* counts = (int*)(F.ws + CTL_CNT) + l * 32;
    int* lists = WSP(int, OFF_LISTS); float* tinfo = WSP(float, OFF_TINFO);
    const int tid = F.tid, wave = tid >> 6, lane = tid & 63, rr = lane & 15, kq = lane >> 4;
    float* lg = (float*)F.smem + wave * (16 * 48);
    const bool blk_ok = (NTOK % (F.nblk * 32) == 0);
    const int rpb = NTOK / F.nblk;
    __syncthreads();
    for (int rt = blk_ok ? wave : blockIdx.x * 8 + wave; rt < (blk_ok ? rpb / 16 : NTOK / 16); rt += (blk_ok ? 8 : F.nblk * 8)) {
        const int r0 = blk_ok ? blockIdx.x * rpb + rt * 16 : rt * 16;
        f32x4 acc0 = {0.f, 0.f, 0.f, 0.f}, acc1 = acc0, acc2 = acc0;
        const float* xa = xf + (size_t)(r0 + rr) * DM + 4 * kq;
        const float* wb = gt + (size_t)rr * 1024 + 4 * kq;
#pragma unroll 2
        for (int k0 = 0; k0 < 1024; k0 += 16) {
            const float4 a = *reinterpret_cast<const float4*>(xa + k0);
            const float4 b0 = *reinterpret_cast<const float4*>(wb + k0), b1 = *reinterpret_cast<const float4*>(wb + 16 * 1024 + k0), b2 = *reinterpret_cast<const float4*>(wb + 32 * 1024 + k0);
            acc0 = __builtin_amdgcn_mfma_f32_16x16x4f32(a.x, b0.x, acc0, 0, 0, 0); acc1 = __builtin_amdgcn_mfma_f32_16x16x4f32(a.x, b1.x, acc1, 0, 0, 0); acc2 = __builtin_amdgcn_mfma_f32_16x16x4f32(a.x, b2.x, acc2, 0, 0, 0);
            acc0 = __builtin_amdgcn_mfma_f32_16x16x4f32(a.y, b0.y, acc0, 0, 0, 0); acc1 = __builtin_amdgcn_mfma_f32_16x16x4f32(a.y, b1.y, acc1, 0, 0, 0); acc2 = __builtin_amdgcn_mfma_f32_16x16x4f32(a.y, b2.y, acc2, 0, 0, 0);
            acc0 = __builtin_amdgcn_mfma_f32_16x16x4f32(a.z, b0.z, acc0, 0, 0, 0); acc1 = __builtin_amdgcn_mfma_f32_16x16x4f32(a.z, b1.z, acc1, 0, 0, 0); acc2 = __builtin_amdgcn_mfma_f32_16x16x4f32(a.z, b2.z, acc2, 0, 0, 0);
            acc0 = __builtin_amdgcn_mfma_f32_16x16x4f32(a.w, b0.w, acc0, 0, 0, 0); acc1 = __builtin_amdgcn_mfma_f32_16x16x4f32(a.w, b1.w, acc1, 0, 0, 0); acc2 = __builtin_amdgcn_mfma_f32_16x16x4f32(a.w, b2.w, acc2, 0, 0, 0);
        }
#pragma unroll
        for (int r = 0; r < 4; ++r) { lg[(4 * kq + r) * 48 + rr] = acc0[r]; lg[(4 * kq + r) * 48 + 16 + rr] = acc1[r]; lg[(4 * kq + r) * 48 + 32 + rr] = acc2[r]; }
        asm volatile("s_waitcnt lgkmcnt(0)" ::: "memory");
        __builtin_amdgcn_wave_barrier();
        if (lane < 16) {
            const int row = r0 + lane; const float* L = lg + lane * 48;
            float gl[4];
#pragma unroll
            for (int q = 0; q < 4; ++q) gl[q] = L[q] + bg[q];
            int gi = 0; float gm = gl[0];
#pragma unroll
            for (int q = 1; q < 4; ++q) if (gl[q] > gm) { gm = gl[q]; gi = q; }
            float den = 0.f;
#pragma unroll
            for (int q = 0; q < 4; ++q) den += expf(gl[q] - gm);
            const float pgroup = 1.0f / den;
            float el[8];
#pragma unroll
            for (int q = 0; q < 8; ++q) el[q] = L[4 + gi * 8 + q] + be[gi * 8 + q];
            int i0 = 0; float v0 = el[0];
#pragma unroll
            for (int q = 1; q < 8; ++q) if (el[q] > v0) { v0 = el[q]; i0 = q; }
            int i1 = -1; float v1 = -INFINITY;
#pragma unroll
            for (int q = 0; q < 8; ++q) if (q != i0 && el[q] > v1) { v1 = el[q]; i1 = q; }
            const float e1 = expf(v1 - v0); const float g0 = pgroup / (1.0f + e1), g1 = pgroup * e1 / (1.0f + e1);
            const int ea = gi * 8 + i0, eb = gi * 8 + i1;
            const int pa = atomicAdd(&counts[ea], 1), pb = atomicAdd(&counts[eb], 1);
            lists[(size_t)ea * NTOK + pa] = row; lists[(size_t)eb * NTOK + pb] = row;
            int* ti = (int*)(tinfo + (size_t)row * 8);
            ti[0] = ea; ti[1] = pa; ti[2] = eb; ti[3] = pb; tinfo[(size_t)row * 8 + 4] = g0; tinfo[(size_t)row * 8 + 5] = g1;
        }
        __builtin_amdgcn_wave_barrier();
    }
}
#endif
DI void phase_route(const Frame& F, int l) {
    const float* xf = F.xf;
    const float* wg = F.in[33] + (size_t)l * 1024 * 4; const float* bg = F.in[34] + l * 4;
    const float* we = F.in[35] + (size_t)l * 1024 * 32; const float* be = F.in[36] + l * 32;
    int* counts = (int*)(F.ws + CTL_CNT) + l * 32;
    int* lists = WSP(int, OFF_LISTS); float* tinfo = WSP(float, OFF_TINFO);
    for (int row = ggrp(F); row < NTOK; row += ngrp(F)) {
        float gl[4] = {0.f, 0.f, 0.f, 0.f};
        for (int i = 0; i < PERLN; ++i) { const int c = glane(F) + i * GRP; const float x = xf[(size_t)row * DM + c];
#pragma unroll
            for (int q = 0; q < 4; ++q) gl[q] += x * wg[c * 4 + q]; }
#pragma unroll
        for (int q = 0; q < 4; ++q) gl[q] = grp_sum(F, gl[q]) + bg[q];
        int gi = 0; float gm = gl[0];
#pragma unroll
        for (int q = 1; q < 4; ++q) if (gl[q] > gm) { gm = gl[q]; gi = q; }
        float den = 0.f;
#pragma unroll
        for (int q = 0; q < 4; ++q) den += expf(gl[q] - gm);
        const float pgroup = 1.0f / den;
        float el[8] = {0.f, 0.f, 0.f, 0.f, 0.f, 0.f, 0.f, 0.f};
        for (int i = 0; i < PERLN; ++i) { const int c = glane(F) + i * GRP; const float x = xf[(size_t)row * DM + c];
#pragma unroll
            for (int q = 0; q < 8; ++q) el[q] += x * we[c * 32 + gi * 8 + q]; }
#pragma unroll
        for (int q = 0; q < 8; ++q) el[q] = grp_sum(F, el[q]) + be[gi * 8 + q];
        int i0 = 0; float v0 = el[0];
#pragma unroll
        for (int q = 1; q < 8; ++q) if (el[q] > v0) { v0 = el[q]; i0 = q; }
        int i1 = -1; float v1 = -INFINITY;
#pragma unroll
        for (int q = 0; q < 8; ++q) if (q != i0 && el[q] > v1) { v1 = el[q]; i1 = q; }
        const float e1 = expf(v1 - v0); const float g0 = pgroup / (1.0f + e1), g1 = pgroup * e1 / (1.0f + e1);
        if (glane(F) == 0) {
            const int ea = gi * 8 + i0, eb = gi * 8 + i1;
            const int pa = atomicAdd(&counts[ea], 1), pb = atomicAdd(&counts[eb], 1);
            lists[(size_t)ea * NTOK + pa] = row; lists[(size_t)eb * NTOK + pb] = row;
            int* ti = (int*)(tinfo + (size_t)row * 8);
            ti[0] = ea; ti[1] = pa; ti[2] = eb; ti[3] = pb; tinfo[(size_t)row * 8 + 4] = g0; tinfo[(size_t)row * 8 + 5] = g1;
        }
    }
}

struct EpiMoeUp {
    bf16* hm; int row0, pn;
    DI void operator()(int r, int c, float a, float b, float cc, float d) const {
        bf16* p = hm + (size_t)(row0 + r) * 256 + ((pn * 256 + c) >> 1);
        p[0] = f2bf(siluf_(a) * b); p[1] = f2bf(siluf_(cc) * d);
    }
};
DI int ld_cnt(const int* p) {
#ifdef CPU_EMU
    return *p;
#else
    return __hip_atomic_load(p, __ATOMIC_RELAXED, __HIP_MEMORY_SCOPE_AGENT);
#endif
}
DI void moe_tiles(const int* counts, int* toff  ) {
    __syncthreads();
    if (threadIdx.x == 0) { int acc = 0; for (int e = 0; e < NEXP; ++e) { toff[e] = acc; acc += (ld_cnt(counts + e) + 255) >> 8; } toff[NEXP] = acc; }
    __syncthreads();
}
DI void phase_moe_up(const Frame& F, int l) {
    const int* counts = (const int*)(F.ws + CTL_CNT) + l * 32;
    int* eoff = (int*)(F.ws + CTL_EOFF) + l * 33;
    int* rowmap = (int*)(F.smem + 131072);
    int* toff = rowmap + 256;
    moe_tiles(counts, toff);
    if (blockIdx.x == 0 && threadIdx.x == 0) for (int e = 0; e <= NEXP; ++e) eoff[e] = toff[e] * 256;
    const int* lists = WSP(int, OFF_LISTS); const bf16* xb = WSP(bf16, OFF_XB);
    const int nunit = toff[NEXP] * 2;
    for (int u = blockIdx.x; u < nunit; u += F.nblk) {
        const int tile = u >> 1, pn = u & 1;
        int e = 0; while (toff[e + 1] <= tile) ++e;
        const int t0 = (tile - toff[e]) * 256, cnt = ld_cnt(counts + e);
        __syncthreads();
        for (int i = fresh_tid(F); i < 256; i += NTH) rowmap[i] = (t0 + i < cnt) ? lists[(size_t)e * NTOK + t0 + i] : 0;
        __syncthreads();
        EpiMoeUp E{WSP(bf16, OFF_HM), tile * 256, pn};
        gemm_unit(F, xb, 1024, rowmap, 0, WSP(bf16, OFF_W13T) + (size_t)e * 512 * 1024, 1024, pn * 256, 1024, E);
    }
}
DI void phase_moe_down(const Frame& F, int l) {
    const int* counts = (const int*)(F.ws + CTL_CNT) + l * 32;
    int* toff = (int*)(F.smem + 131072) + 256;
    moe_tiles(counts, toff);
    const int nunit = toff[NEXP] * 4;
    for (int u = blockIdx.x; u < nunit; u += F.nblk) {
        const int tile = u >> 2, pn = u & 3;
        int e = 0; while (toff[e + 1] <= tile) ++e;
        EpiBf E{WSP(bf16, OFF_YROWS), 1024, tile * 256, pn};
        gemm_unit(F, WSP(bf16, OFF_HM), 256, nullptr, tile * 256, WSP(bf16, OFF_W2T) + (size_t)e * 1024 * 256, 256, pn * 256, 256, E);
    }
}
DI void phase_ln3(const Frame& F, int l) {
#ifndef CPU_EMU
    ln_rows_gpu<2>(F, F.in[40] + l * 1024, F.in[41] + l * 1024, l);
#else
    const float* xf = F.xf; const bf16* yr = WSP(bf16, OFF_YROWS); const float* tinfo = WSP(float, OFF_TINFO);
    const int* eoff = (const int*)(F.ws + CTL_EOFF) + l * 33;
    layer_norm_rows(F, F.in[40] + l * 1024, F.in[41] + l * 1024, [&](int row, int c) {
        const int* ti = (const int*)(tinfo + (size_t)row * 8);
        const size_t ra = (size_t)eoff[ti[0]] + ti[1], rb = (size_t)eoff[ti[2]] + ti[3];
        return DN_ALPHA * xf[(size_t)row * DM + c] + tinfo[(size_t)row * 8 + 4] * bf2f(yr[ra * 1024 + c]) + tinfo[(size_t)row * 8 + 5] * bf2f(yr[rb * 1024 + c]);
    }, false, nullptr);
#endif
}

#ifndef CPU_EMU
#define XB_TMO      128
#define XB_XCNT(j)  (256  + 64 * (j))
#define XB_XSUB(j)  (1280 + 64 * (j))
#define XB_XGEN(j)  (2304 + 64 * (j))
#define XB_TOP      3328
#define XB_TOPGEN   3392
#define XCD_BAR_WORDS 3456
#define XB_SPIN_CAP (1u << 18)
#define LAS __attribute__((address_space(3)))

__device__ __forceinline__ unsigned xb_ld(unsigned* p)              { return __hip_atomic_load(p, __ATOMIC_RELAXED, __HIP_MEMORY_SCOPE_AGENT); }
__device__ __forceinline__ unsigned xb_add(unsigned* p, unsigned v) { return __hip_atomic_fetch_add(p, v, __ATOMIC_RELAXED, __HIP_MEMORY_SCOPE_AGENT); }
__device__ __forceinline__ unsigned xb_xcc_id() { return (unsigned)__builtin_amdgcn_s_getreg((3 << 11) | 20) & 0xFu; }
#define XB_SPIN(cond, bar) do { unsigned _sp = 0; while (cond) { __builtin_amdgcn_s_sleep(1); \
    if ((++_sp & 255u) == 0u) { if (xb_ld(&(bar)[XB_TMO])) break; if (_sp > XB_SPIN_CAP) { atomicAdd(&(bar)[XB_TMO], 1u); break; } } } } while (0)

struct XcdBarrier {
    unsigned* bar; unsigned x;
    volatile LAS unsigned* st;
};

__device__ __forceinline__ XcdBarrier xcd_barrier_post(unsigned* bar, volatile LAS unsigned* st) {
    XcdBarrier b; b.bar = bar; b.x = xb_xcc_id(); b.st = st;
    if (threadIdx.x == 0) (void)xb_add(&bar[XB_XCNT(b.x)], 1u);
    return b;
}
__device__ __forceinline__ void xcd_barrier_complete(unsigned* bar, unsigned x, unsigned& nloc, unsigned& nx) {
    const unsigned G = gridDim.x * gridDim.y * gridDim.z;
    unsigned sum, cnt, mine, sp = 0u;
    for (;;) {
        sum = 0u; cnt = 0u; mine = 0u;
#pragma unroll
        for (unsigned j = 0; j < 16; ++j) { const unsigned c = xb_ld(&bar[XB_XCNT(j)]); sum += c; cnt += (c > 0u) ? 1u : 0u; mine = (j == x) ? c : mine; }
        if (sum == G) break;
        __builtin_amdgcn_s_sleep(1);
        if ((++sp & 255u) == 0u) { if (xb_ld(&bar[XB_TMO])) break; if (sp > XB_SPIN_CAP) { atomicAdd(&bar[XB_TMO], 1u); break; } }
    }
    nloc = mine > 0u ? mine : 1u; nx = cnt > 0u ? cnt : 1u;
}

__device__ __forceinline__ void xcd_barrier(const XcdBarrier& b) {
    asm volatile("s_waitcnt vmcnt(0)" ::: "memory");
    __syncthreads();
    if (threadIdx.x == 0) {
        unsigned* bar = b.bar;
        __builtin_amdgcn_s_waitcnt(0);
        unsigned nloc = b.st[0], nx = b.st[1];
        if (nloc == 0u) { xcd_barrier_complete(bar, b.x, nloc, nx); b.st[0] = nloc; b.st[1] = nx; }
        const unsigned old = xb_add(&bar[XB_XSUB(b.x)], 1u);
        const unsigned gen = old / nloc;
        if (old + 1u == (gen + 1u) * nloc) {
            __builtin_amdgcn_fence(__ATOMIC_RELEASE, "agent");
            asm volatile("s_waitcnt vmcnt(0)" ::: "memory");
            const unsigned og = xb_add(&bar[XB_TOP], 1u);
            const unsigned tg = og / nx;
            if (og + 1u == (tg + 1u) * nx) xb_add(&bar[XB_TOPGEN], 1u);
            else XB_SPIN(xb_ld(&bar[XB_TOPGEN]) == tg, bar);
            __builtin_amdgcn_fence(__ATOMIC_ACQUIRE, "agent");
            xb_add(&bar[XB_XGEN(b.x)], 1u);
            asm volatile("s_waitcnt vmcnt(0)" ::: "memory");
        } else {
            XB_SPIN(xb_ld(&bar[XB_XGEN(b.x)]) == gen, bar);
            __builtin_amdgcn_fence(__ATOMIC_ACQUIRE, "agent");
            asm volatile("s_waitcnt vmcnt(0)" ::: "memory");
        }
    }
    __syncthreads();
}

#endif

constexpr int NPH_LAYER = 16;
constexpr int NPH_TOTAL = 1 + 2 * NPH_LAYER;
constexpr int SMEM_BYTES = 147456 + 1024;

#ifndef CPU_EMU
DI void phase_attn_queue(const Frame& F, int l) {
    {
            const AttnDesc Ag = desc_gqa(F), Am = desc_mla(F);
            const int ng = attn_nunit<64, 64, 64, 2>(Ag), nm = attn_nunit<96, 64, 64, 1>(Am);
            unsigned* qctr = (unsigned*)(F.ws + CTL_QUEUE) + l * 64;
            volatile int* slot = (volatile int*)(F.smem + SMEM_BYTES - 32);
            for (;;) {
                __syncthreads();
                if (fresh_tid(F) == 0) *slot = (int)atomicAdd(qctr, 1u);
                __syncthreads();
                const int u = *slot;
                if (u >= ng + nm) break;
                if (u < ng) attn_unit<64, 64, 64, 2>(F, Ag, u); else attn_unit<96, 64, 64, 1>(F, Am, u - ng);
            }
        }
}
#endif

template <int K>
DI void run_layer_phase(const Frame& F, int l) {
    if constexpr (K == 0) phase_cvt(F, l);
    if constexpr (K == 1) phase_gemm1(F);
    if constexpr (K == 2) phase_prep(F, l);
    if constexpr (K == 3) phase_mlaup(F);
    if constexpr (K == 4) {
#ifdef CPU_EMU
        attn_phase<64, 64>(F, desc_gqa(F)); attn_phase<96, 64>(F, desc_mla(F)); phase_scans(F);
#else
        phase_scans(F);
        phase_attn_queue(F, l);
#endif
    }
#ifdef CPU_EMU
    if constexpr (K == 5) phase_fin(F, l);
#else
    if constexpr (K == 5) phase_fin_gpu(F, l);
#endif
    if constexpr (K == 6) phase_gemm_sq<0>(F, WSP(bf16, OFF_YCAT), W_OUT_T, nullptr);
    if constexpr (K == 7) phase_ln(F, F.in[26] + l * 1024, F.in[27] + l * 1024);
    if constexpr (K == 8) phase_gemm_sq<1>(F, WSP(bf16, OFF_XB), W_Q_T, WSP(bf16, OFF_QMEM));
    if constexpr (K == 9) {
#ifdef CPU_EMU
        attn_phase<256, 256>(F, desc_mem(F));
#else
        attn_phase<256, 256, 128, 1>(F, desc_mem(F));
#endif
    }
    if constexpr (K == 10) phase_gemm_sq<0>(F, WSP(bf16, OFF_OMEM), W_O_T, nullptr);
    if constexpr (K == 11) { phase_ln<true>(F, F.in[31] + l * 1024, F.in[32] + l * 1024); phase_cvt_moe(F, l); }
#ifdef CPU_EMU
    if constexpr (K == 12) phase_route(F, l);
#else
    if constexpr (K == 12) phase_route_gpu(F, l);
#endif
    if constexpr (K == 13) phase_moe_up(F, l);
    if constexpr (K == 14) phase_moe_down(F, l);
    if constexpr (K == 15) phase_ln3(F, l);
}

#ifndef CPU_EMU
template <int K>
__global__ void __launch_bounds__(512, 2) k_phase(Args a, int l) {
    extern __shared__ __attribute__((aligned(16))) unsigned char lds[];
    Frame F; F.in = (InPtr)__builtin_amdgcn_kernarg_segment_ptr(); F.xf = a.out; F.ws = a.ws; F.smem = lds; F.tid = threadIdx.x; F.wv = __builtin_amdgcn_readfirstlane((int)(threadIdx.x >> 6)); F.nblk = a.ph_lo;
    if constexpr (K < 0) phase_pro(F); else run_layer_phase<K>(F, l);
}

template <int K>
static void launch_phase(const Args& a, int l, int grid, hipStream_t stream) {
    static bool attr = false;
    if (!attr) { (void)hipFuncSetAttribute((const void*)k_phase<K>, hipFuncAttributeMaxDynamicSharedMemorySize, SMEM_BYTES); attr = true; }
    hipLaunchKernelGGL(k_phase<K>, dim3(grid), dim3(512), SMEM_BYTES, stream, a, l);
}

__global__ void __launch_bounds__(512, 2) fwd_one(Args a) {
    extern __shared__ __attribute__((aligned(16))) unsigned char lds[];
    const int wave_s = __builtin_amdgcn_readfirstlane((int)(threadIdx.x >> 6));
    volatile LAS unsigned* st = (volatile LAS unsigned*)(lds + SMEM_BYTES - 16);
    if (threadIdx.x == 0) { st[0] = 0u; st[1] = 0u; st[2] = 0u; st[3] = 0u; }
    __syncthreads();
    XcdBarrier bar = xcd_barrier_post((unsigned*)(a.ws + OFF_CTL), st);
    Frame F;
#define FRESH do { unsigned z_ = 0u, m_ = ~0u; int ws_ = wave_s; asm volatile("" : "+s"(z_), "+s"(ws_), "+s"(m_)); \
        int t_ = ws_ * 64 + (int)__builtin_amdgcn_mbcnt_hi(m_, __builtin_amdgcn_mbcnt_lo(m_, 0u)); asm volatile("" : "+v"(t_)); \
        const __attribute__((address_space(4))) char* kp_ = (const __attribute__((address_space(4))) char*)__builtin_amdgcn_kernarg_segment_ptr() + z_; \
        F.in = (InPtr)kp_; F.xf = *(float* const __attribute__((address_space(4)))*)(kp_ + 42 * 8); F.ws = *(unsigned char* const __attribute__((address_space(4)))*)(kp_ + 43 * 8); \
        F.smem = lds; F.tid = t_; F.wv = ws_; F.nblk = *(const int __attribute__((address_space(4)))*)(kp_ + 44 * 8); } while (0)
#define GB do { { unsigned zb_ = 0u; unsigned xx_ = __builtin_amdgcn_readfirstlane(bar.x); asm volatile("" : "+s"(zb_), "+s"(xx_)); bar.bar = (unsigned*)(a.ws + OFF_CTL) + zb_; bar.x = xx_; } \
        xcd_barrier(bar); } while (0)
#define DUP(k) ((PROBE_DUP >> (k)) & 1)
    FRESH; phase_pro(F); FRESH; phase_cvt(F, 0); GB;
    if (DUP(0)) { FRESH; phase_cvt(F, 0); GB; }
    for (int l = 0; l < 2; ++l) {
        FRESH; run_layer_phase<1>(F, l); GB;
        if (DUP(1)) { FRESH; run_layer_phase<1>(F, l); GB; }
        FRESH; run_layer_phase<2>(F, l); GB;
        FRESH; run_layer_phase<3>(F, l); GB;
        if (DUP(3)) { FRESH; run_layer_phase<3>(F, l); GB; }
        if (DUP(4)) { FRESH; attn_phase<64, 64, 64, 2>(F, desc_gqa(F)); attn_phase<96, 64, 64, 1>(F, desc_mla(F)); GB; }
        FRESH; run_layer_phase<4>(F, l); GB;
        FRESH; run_layer_phase<5>(F, l); GB;
        if (DUP(5)) { FRESH; run_layer_phase<5>(F, l); GB; }
        FRESH; run_layer_phase<6>(F, l); GB;
        FRESH; run_layer_phase<7>(F, l); GB;
        FRESH; run_layer_phase<8>(F, l); GB;
        if (DUP(8)) { FRESH; run_layer_phase<8>(F, l); GB; }
        FRESH; run_layer_phase<9>(F, l); GB;
        if (DUP(9)) { FRESH; run_layer_phase<9>(F, l); GB; }
        FRESH; run_layer_phase<10>(F, l); GB;
        FRESH; run_layer_phase<11>(F, l); if (NTOK % (F.nblk * 32) != 0) GB; FRESH; run_layer_phase<12>(F, l); if (l == 0) { FRESH; phase_cvt(F, 1); } GB;
        if (DUP(11)) { FRESH; phase_cvt_moe(F, l); GB; }
        FRESH; run_layer_phase<13>(F, l); GB;
        if (DUP(13)) { FRESH; run_layer_phase<13>(F, l); GB; }
        FRESH; run_layer_phase<14>(F, l); GB;
        if (DUP(14)) { FRESH; run_layer_phase<14>(F, l); GB; }
        FRESH; run_layer_phase<15>(F, l); if (l == 0) GB;
    }
#undef DUP
#undef GB
#undef FRESH
}

extern "C" void kernel_launch(void* const* d_in, const int* in_sizes, int n_in, void* d_out, int out_size, void* d_ws, size_t ws_size, hipStream_t stream) {
    if (n_in != 42 || ws_size < WS_END) return;
    Args a{};
    for (int i = 0; i < 42; ++i) a.in[i] = (const float*)d_in[i];
    a.out = (float*)d_out; a.ws = (unsigned char*)d_ws; a.ph_lo = 0; a.ph_hi = NPH_TOTAL;
    (void)hipMemsetAsync(d_ws, 0, CTL_BYTES, stream);
#if N_LAUNCH_MODE == 1
    static int grid = 0;
    if (!grid) {
        int dev = 0, cus = 0, per_cu = 0;
        (void)hipGetDevice(&dev);
        (void)hipDeviceGetAttribute(&cus, hipDeviceAttributeMultiprocessorCount, dev);
        (void)hipFuncSetAttribute((const void*)fwd_one, hipFuncAttributeMaxDynamicSharedMemorySize, SMEM_BYTES);
        (void)hipOccupancyMaxActiveBlocksPerMultiprocessor(&per_cu, (const void*)fwd_one, 512, SMEM_BYTES);
        (void)hipGetLastError();
        grid = cus > 0 ? cus : 256;
    }
    a.ph_lo = grid;
    hipLaunchKernelGGL(fwd_one, dim3(grid), dim3(512), SMEM_BYTES, stream, a);
#else
    const int grid = 256; a.ph_lo = grid;
    launch_phase<-1>(a, 0, grid, stream);
    for (int l = 0; l < 2; ++l) {
        launch_phase<0>(a, l, grid, stream); launch_phase<1>(a, l, grid, stream); launch_phase<2>(a, l, grid, stream); launch_phase<3>(a, l, grid, stream);
        launch_phase<4>(a, l, grid, stream); launch_phase<5>(a, l, grid, stream); launch_phase<6>(a, l, grid, stream); launch_phase<7>(a, l, grid, stream);
        launch_phase<8>(a, l, grid, stream); launch_phase<9>(a, l, grid, stream); launch_phase<10>(a, l, grid, stream); launch_phase<11>(a, l, grid, stream);
        launch_phase<12>(a, l, grid, stream); launch_phase<13>(a, l, grid, stream); launch_phase<14>(a, l, grid, stream); launch_phase<15>(a, l, grid, stream);
    }
#endif
}
#endif
```

```cpp
#ifndef CPU_EMU
#include <hip/hip_runtime.h>
#else
#include "emu_shim.h"
#endif
#include <stdint.h>

#ifndef CFG_B
#define CFG_B 16
#endif
#ifndef CFG_S
#define CFG_S 2048
#endif
#ifndef PROBE_DUP
#define PROBE_DUP 0
#endif
#ifndef N_LAUNCH_MODE
#define N_LAUNCH_MODE 1
#endif

typedef unsigned short bf16;
#define DI __device__ __forceinline__

constexpr int BATCH = CFG_B, SEQ = CFG_S, NTOK = BATCH * SEQ, DM = 1024;
constexpr int MEMT = 256, NMEM = BATCH * MEMT;
constexpr int GRIDW = 64;
constexpr int HP = 3328;
constexpr int IN_WIDTH = 3104;
constexpr int NEXP = 32, MOEH = 256;
constexpr int MOE_ROWS = 2 * NTOK + NEXP * 256;
constexpr float LN_EPS = 1e-5f, RMS_EPS = 1e-6f, GN_EPS = 64e-5f;
constexpr float DN_ALPHA = 1.41421356237309515f;
constexpr float DECAY_SCALE = 0.60653065971263342f;

constexpr size_t AL(size_t x) { return (x + 255) & ~(size_t)255; }
constexpr size_t OFF_CTL = 0;
constexpr size_t CTL_BYTES = 32768;
constexpr size_t CTL_CNT = 16384;
constexpr size_t CTL_EOFF = 16384 + 1024;
constexpr size_t CTL_QUEUE = 16384 + 2048;
constexpr size_t OFF_XB = AL(OFF_CTL + CTL_BYTES);
constexpr size_t SZ_XB = (size_t)NTOK * DM * 2;
constexpr size_t OFF_WTS = AL(OFF_XB + SZ_XB);
constexpr size_t W_IN_T = 0;
constexpr size_t W_UQ_T = W_IN_T + (size_t)HP * 1024 * 2;
constexpr size_t W_UKV_T = W_UQ_T + 512 * 256 * 2;
constexpr size_t W_OUT_T = W_UKV_T + 512 * 256 * 2;
constexpr size_t W_Q_T = W_OUT_T + 1024 * 1024 * 2;
constexpr size_t W_KV_T = W_Q_T + 1024 * 1024 * 2;
constexpr size_t W_O_T = W_KV_T + 2048 * 1024 * 2;
constexpr size_t W_GATE_T = W_O_T + 1024 * 1024 * 2;
constexpr size_t SZ_WTS = W_GATE_T + 2 * 48 * 1024 * 4;
constexpr size_t OFF_KMEM = AL(OFF_WTS + SZ_WTS);
constexpr size_t OFF_VTMEM = AL(OFF_KMEM + (size_t)NMEM * 1024 * 2);
constexpr size_t OFF_MEMB = AL(OFF_VTMEM + (size_t)NMEM * 1024 * 2);
constexpr size_t OFF_VTATT = AL(OFF_MEMB + (size_t)NMEM * 1024 * 2);
constexpr size_t OFF_VTMLA = AL(OFF_VTATT + (size_t)BATCH * 2 * 64 * SEQ * 2);
constexpr size_t OFF_HATT = AL(OFF_VTMLA + (size_t)BATCH * 4 * 64 * SEQ * 2);
constexpr size_t OFF_HMLA = OFF_HATT + (size_t)NTOK * 512 * 2;
constexpr size_t OFF_HRWKV = OFF_HMLA + (size_t)NTOK * 512 * 2;
constexpr size_t OFF_R7 = OFF_HRWKV + (size_t)NTOK * 1024 * 2;
constexpr size_t SZ_R7 = (size_t)NTOK * 9 * 256 * 2;
constexpr size_t OFF_HHGRN = OFF_R7 + SZ_R7;
constexpr size_t OFF_HX = OFF_HHGRN + (size_t)NTOK * 1280 * 2;
constexpr size_t OFF_HAM = OFF_HX + (size_t)NTOK * 256 * 2;
constexpr size_t OFF_HEG = OFF_HAM + (size_t)(NTOK / 16) * 8 * 256 * 2;
constexpr size_t OFF_REG = OFF_HEG + (size_t)(NTOK / 16) * 8 * 64 * 4;
constexpr size_t WS_END = OFF_REG + (size_t)(NTOK / 16) * 8 * 64 * 2;
static_assert(WS_END <= (size_t)4 * NTOK * DM * 4 || CFG_B != 16, "workspace must fit 4 x the largest tensor");

constexpr size_t OFF_QMLA = OFF_XB;
constexpr size_t OFF_KNOPE = OFF_QMLA + (size_t)NTOK * 384 * 2;
constexpr size_t OFF_KROPE = OFF_KNOPE + (size_t)NTOK * 256 * 2;
constexpr size_t OFF_G = OFF_KROPE + (size_t)NTOK * 32 * 2;
constexpr size_t OFF_BONUS = OFF_G + (size_t)NTOK * 256 * 2;
constexpr size_t OFF_RSIDE = OFF_BONUS + (size_t)NTOK * 16;
static_assert(OFF_RSIDE + (size_t)(NTOK / 16) * 2 * 512 * 2 <= OFF_XB + SZ_XB, "xb alias region");
constexpr size_t OFF_YCAT = OFF_HRWKV;
constexpr size_t OFF_QMEM = OFF_HATT;
constexpr size_t OFF_OMEM = OFF_R7;
#ifdef CPU_EMU
constexpr size_t OFF_EMU_SCAN = WS_END;
constexpr size_t OFF_LISTS = AL(OFF_EMU_SCAN + (size_t)4 * NTOK * 256 * 2);
#else
constexpr size_t OFF_LISTS = OFF_HATT;
#endif
constexpr size_t OFF_TINFO = OFF_LISTS + (size_t)NEXP * NTOK * 4;
constexpr size_t OFF_HM = AL(OFF_TINFO + (size_t)NTOK * 32);
constexpr size_t OFF_YROWS = AL(OFF_HM + (size_t)MOE_ROWS * 256 * 2);
#ifdef CPU_EMU
constexpr size_t OFF_W13T = AL(OFF_YROWS + (size_t)MOE_ROWS * 1024 * 2);
#else
static_assert(OFF_YROWS + (size_t)MOE_ROWS * 1024 * 2 <= OFF_HHGRN, "moe alias region");
constexpr size_t OFF_W13T = OFF_HHGRN;
#endif
constexpr size_t OFF_W2T = OFF_W13T + (size_t)NEXP * 512 * 1024 * 2;
#ifdef CPU_EMU
constexpr size_t WS_END_EMU = OFF_W2T + (size_t)NEXP * 1024 * 256 * 2;
#else
static_assert(OFF_W2T + (size_t)NEXP * 1024 * 256 * 2 <= WS_END, "moe weights alias");
#endif

enum { C_KT0 = 0, C_KT1 = 1, C_RT0 = 2, C_RT1 = 3, C_KK0 = 4, C_KK1 = 5, C_AT0 = 6, C_AT1 = 7, C_VT = 8 };
enum { R_R = 0, R_V = 1, R_KK = 2, R_W0 = 3, R_W1 = 4, R_KD0 = 5, R_KD1 = 6, R_AK0 = 7, R_AK1 = 8 };

DI float bf2f(bf16 v) { union { unsigned u; float f; } x; x.u = (unsigned)v << 16; return x.f; }
DI bf16 f2bf(float f) { union { unsigned u; float f; } x; x.f = f; unsigned u = x.u; u += 0x7fffu + ((u >> 16) & 1u); return (bf16)(u >> 16); }
DI float sigmoidf_(float x) { return 1.0f / (1.0f + expf(-x)); }
DI float siluf_(float x) { return x * sigmoidf_(x); }

#ifdef CPU_EMU
typedef const float* const* InPtr;
#else
typedef const float* const __attribute__((address_space(4)))* InPtr;
#endif
struct Frame {
    InPtr in;
    float* xf;
    unsigned char* ws;
    unsigned char* smem;
    int tid;
    int wv;
    int nblk;
};
#ifdef CPU_EMU
constexpr int NTH = 1;
#else
constexpr int NTH = 512;
#endif
#ifdef CPU_EMU
constexpr int GRP = 1;
DI float grp_sum(const Frame& F, float v) { return v; }
DI int gthreads(const Frame& F) { return 1; }
DI int gtid_(const Frame& F) { return 0; }
DI int wave_item_index(const Frame& F) { return 0; }
#else
constexpr int GRP = 64;
DI float shfl_idx(const Frame& F, float v, int src_lane) { return __builtin_bit_cast(float, __builtin_amdgcn_ds_bpermute(src_lane << 2, __builtin_bit_cast(int, v))); }
DI float shfl_xor(const Frame& F, float v, int mask) {
    unsigned m0 = ~0u; asm volatile("" : "+s"(m0));
    const int lane = (int)__builtin_amdgcn_mbcnt_hi(m0, __builtin_amdgcn_mbcnt_lo(m0, 0u));
    return shfl_idx(F, v, lane ^ mask); }
template <int CTRL> DI float dppf(float x) { return __builtin_bit_cast(float, __builtin_amdgcn_update_dpp(0, __builtin_bit_cast(int, x), CTRL, 0xf, 0xf, true)); }
DI float allsum16(float x) { x += dppf<0xB1>(x); x += dppf<0x4E>(x); x += dppf<0x141>(x); x += dppf<0x140>(x); return x; }
DI float rdlane(float x, int l) { return __builtin_bit_cast(float, __builtin_amdgcn_readlane(__builtin_bit_cast(int, x), l)); }
DI float grp_sum(const Frame& F, float v) { v = allsum16(v); return (rdlane(v, 0) + rdlane(v, 16)) + (rdlane(v, 32) + rdlane(v, 48)); }
DI int gthreads(const Frame& F) { return F.nblk * NTH; }
DI int gtid_(const Frame& F) { return blockIdx.x * NTH + F.tid; }
DI int wave_item_index(const Frame& F) { return (int)(((F.tid >> 6) * F.nblk + blockIdx.x) * 64 + (F.tid & 63)); }
#endif
constexpr int PER64 = 64 / GRP;
constexpr int PERLN = 1024 / GRP;
DI int fresh_tid(const Frame& F) {
#ifdef CPU_EMU
    return 0;
#else
    unsigned m0 = ~0u; asm volatile("" : "+s"(m0));
    int t = F.wv * 64 + (int)__builtin_amdgcn_mbcnt_hi(m0, __builtin_amdgcn_mbcnt_lo(m0, 0u)); asm volatile("" : "+v"(t)); return t;
#endif
}
DI int glane(const Frame& F) { return (int)(F.tid % GRP); }
DI int ggrp(const Frame& F) { return gtid_(F) / GRP; }
DI int ngrp(const Frame& F) { return gthreads(F) / GRP; }

struct Args {
    const float* in[42];
    float* out;
    unsigned char* ws;
    int ph_lo, ph_hi;
};

DI float rope_inv(int f, int nf) { return powf(10000.0f, -(float)f / (float)nf); }

#ifndef CPU_EMU
using bf16x8 = __attribute__((ext_vector_type(8))) short;
using bf16x4 = __attribute__((ext_vector_type(4))) short;
using f32x4 = __attribute__((ext_vector_type(4))) float;
using f32x16 = __attribute__((ext_vector_type(16))) float;
typedef __bf16 bf16v2 __attribute__((ext_vector_type(2)));
typedef float f32v2 __attribute__((ext_vector_type(2)));
DI float bflo(unsigned u) { return __uint_as_float(u << 16); }
DI float bfhi(unsigned u) { return __uint_as_float(u & 0xffff0000u); }
DI unsigned pack_bf16(float lo, float hi) { f32v2 v = {lo, hi}; bf16v2 b = __builtin_convertvector(v, bf16v2); return __builtin_bit_cast(unsigned, b); }

constexpr int G_BM = 256, G_BK = 64, G_HALF = 128, G_HT = G_HALF * G_BK, G_SHM = 8 * G_HT * 2;
DI int g_lds_byte(int r, int c) { int st = (r >> 4) * 2 + (c >> 5), rr = r & 15, cc = c & 31, ob = rr * 64 + cc * 2; return st * 1024 + (ob ^ (((ob >> 9) & 1) << 5)); }
DI void g_stage_rc(int b, int& R, int& C) { int st = b / 1024, sb = b % 1024, swz = sb ^ (((sb >> 9) & 1) << 5); R = (st >> 1) * 16 + swz / 64; C = (st & 1) * 32 + (swz % 64) / 2; }

template <bool GATHER, class Epi>
DI void gemm_unit_t(int wv_in, bf16* shm, const bf16* __restrict__ A, int lda, const int* rowmap, int arow0,
                    const bf16* __restrict__ Bt, int ldb, int bcol0, int K, const Epi& epi) {
#define SA(b, h) (shm + ((b) * 2 + (h)) * G_HT)
#define SB(b, h) (shm + (4 + (b) * 2 + (h)) * G_HT)
#define STAGE_AX(T, P, hf, kt) do { for (int _i = 0; _i < 2; ++_i) { int _b = (T) * 16 + _i * 8192; int _r, _c; g_stage_rc(_b, _r, _c); \
        const long _row = GATHER ? (long)rowmap[(hf) * G_HALF + _r] : (long)(arow0 + (hf) * G_HALF + _r); \
        __builtin_amdgcn_global_load_lds((const unsigned*)(A + _row * lda + (long)(kt) * G_BK + _c), (unsigned*)((char*)(P) + _b), 16, 0, 0); } } while (0)
#define STAGE_BX(T, P, hf, kt) do { for (int _i = 0; _i < 2; ++_i) { int _b = (T) * 16 + _i * 8192; int _r, _c; g_stage_rc(_b, _r, _c); \
        __builtin_amdgcn_global_load_lds((const unsigned*)(Bt + (long)(bcol0 + (hf) * G_HALF + _r) * ldb + (long)(kt) * G_BK + _c), (unsigned*)((char*)(P) + _b), 16, 0, 0); } } while (0)
#define STAGE_A(P, hf, kt) STAGE_AX(t0, P, hf, kt)
#define STAGE_B(P, hf, kt) STAGE_BX(t0, P, hf, kt)
#define LDA(dst, b, h) for (int m = 0; m < 4; ++m) for (int k = 0; k < 2; ++k) \
        dst[m][k] = *reinterpret_cast<const bf16x8*>((char*)SA(b, h) + g_lds_byte(wr * 64 + m * 16 + fr, k * 32 + fq * 8))
#define LDB(dst, b, h) for (int n = 0; n < 2; ++n) for (int k = 0; k < 2; ++k) \
        dst[n][k] = *reinterpret_cast<const bf16x8*>((char*)SB(b, h) + g_lds_byte(wc * 32 + n * 16 + fr, k * 32 + fq * 8))
#define MMA(ai, bj, At, Bt_) do { __builtin_amdgcn_s_setprio(1); \
        for (int m = 0; m < 4; ++m) for (int n = 0; n < 2; ++n) for (int k = 0; k < 2; ++k) \
            acc[ai][bj][m][n] = __builtin_amdgcn_mfma_f32_16x16x32_bf16(Bt_[n][k], At[m][k], acc[ai][bj][m][n], 0, 0, 0); \
        __builtin_amdgcn_s_setprio(0); } while (0)
#define WAIT_V(n) asm volatile("s_waitcnt vmcnt(" #n ")" ::: "memory")
#define WAIT_L(n) asm volatile("s_waitcnt lgkmcnt(" #n ")" ::: "memory")
#define BAR __builtin_amdgcn_s_barrier()
#define SCHED __builtin_amdgcn_sched_barrier(0)
    unsigned m0 = ~0u; asm volatile("" : "+s"(m0));
    int t0 = wv_in * 64 + (int)__builtin_amdgcn_mbcnt_hi(m0, __builtin_amdgcn_mbcnt_lo(m0, 0u)); asm volatile("" : "+v"(t0));
    int wid = t0 >> 6, lane = t0 & 63, wr = wid >> 2, wc = wid & 3, fr = lane & 15, fq = lane >> 4;
    f32x4 acc[2][2][4][2] = {};
    bf16x8 At[4][2], B0[2][2], B1[2][2];
    const int nt = K / G_BK;
    STAGE_B(SB(0, 0), 0, 0); STAGE_A(SA(0, 0), 0, 0);
    STAGE_B(SB(0, 1), 1, 0); STAGE_A(SA(0, 1), 1, 0);
    if (wr == 1) BAR;
    WAIT_V(4); BAR;
    STAGE_B(SB(1, 0), 0, 1); STAGE_A(SA(1, 0), 0, 1); STAGE_B(SB(1, 1), 1, 1);
    WAIT_V(6); BAR;
    for (int t = 0; t < nt - 2; t += 2) {
        LDB(B0, 0, 0); SCHED; LDA(At, 0, 0); STAGE_A(SA(1, 1), 1, t + 1);
        WAIT_L(8); BAR; WAIT_L(0); MMA(0, 0, At, B0); BAR; SCHED;
        LDB(B1, 0, 1); STAGE_B(SB(0, 0), 0, t + 2);
        BAR; WAIT_L(0); MMA(0, 1, At, B1); BAR;
        LDA(At, 0, 1); STAGE_A(SA(0, 0), 0, t + 2);
        BAR; WAIT_L(0); MMA(1, 0, At, B0); BAR; SCHED;
        STAGE_B(SB(0, 1), 1, t + 2);
        WAIT_V(6); BAR; MMA(1, 1, At, B1); BAR;
        LDB(B0, 1, 0); SCHED; LDA(At, 1, 0); STAGE_A(SA(0, 1), 1, t + 2);
        WAIT_L(8); BAR; WAIT_L(0); MMA(0, 0, At, B0); BAR; SCHED;
        LDB(B1, 1, 1); STAGE_B(SB(1, 0), 0, t + 3);
        BAR; WAIT_L(0); MMA(0, 1, At, B1); BAR;
        LDA(At, 1, 1); STAGE_A(SA(1, 0), 0, t + 3);
        BAR; WAIT_L(0); MMA(1, 0, At, B0); BAR; SCHED;
        STAGE_B(SB(1, 1), 1, t + 3);
        WAIT_V(6); BAR; MMA(1, 1, At, B1); BAR;
    }
    int tz = t0; asm volatile("" : "+v"(tz)); wid = tz >> 6; lane = tz & 63; wr = wid >> 2; wc = wid & 3; fr = lane & 15; fq = lane >> 4;
    { LDB(B0, 0, 0); WAIT_V(0); LDA(At, 0, 0); STAGE_AX(tz, SA(1, 1), 1, nt - 1);
      BAR; WAIT_L(0); MMA(0, 0, At, B0); BAR;
      LDB(B1, 0, 1); BAR; WAIT_L(0); MMA(0, 1, At, B1); BAR;
      LDA(At, 0, 1); WAIT_V(4); BAR; WAIT_L(0); MMA(1, 0, At, B0); MMA(1, 1, At, B1); BAR; }
    { LDB(B0, 1, 0); LDA(At, 1, 0); WAIT_V(2); BAR; WAIT_L(0); MMA(0, 0, At, B0); BAR;
      LDB(B1, 1, 1); WAIT_V(0); BAR; WAIT_L(0); MMA(0, 1, At, B1); BAR;
      LDA(At, 1, 1); BAR; WAIT_L(0); MMA(1, 0, At, B0); MMA(1, 1, At, B1); BAR; }
    if (wr == 0) BAR;
#pragma unroll
    for (int ai = 0; ai < 2; ++ai)
#pragma unroll
        for (int m = 0; m < 4; ++m)
#pragma unroll
            for (int bj = 0; bj < 2; ++bj)
#pragma unroll
                for (int n = 0; n < 2; ++n) {
                    const f32x4 v = acc[ai][bj][m][n];
                    epi(ai * G_HALF + wr * 64 + m * 16 + fr, bj * G_HALF + wc * 32 + n * 16 + fq * 4, v[0], v[1], v[2], v[3]);
                }
#undef SA
#undef SB
#undef STAGE_A
#undef STAGE_B
#undef STAGE_AX
#undef STAGE_BX
#undef LDA
#undef LDB
#undef MMA
}
template <class Epi>
DI void gemm_unit(const Frame& F, const bf16* __restrict__ A, int lda, const int* rowmap, int arow0,
                  const bf16* __restrict__ Bt, int ldb, int bcol0, int K, const Epi& epi) {
    if (rowmap) gemm_unit_t<true>(F.wv, (bf16*)F.smem, A, lda, rowmap, arow0, Bt, ldb, bcol0, K, epi);
    else gemm_unit_t<false>(F.wv, (bf16*)F.smem, A, lda, rowmap, arow0, Bt, ldb, bcol0, K, epi);
}
#else
template <class Epi>
void gemm_unit(const Frame& F, const bf16* A, int lda, const int* rowmap, int arow0, const bf16* Bt, int ldb, int bcol0, int K, const Epi& epi, int mrows = 256) {
    for (int r = 0; r < mrows; ++r) {
        int arow = rowmap ? rowmap[r] : arow0 + r;
        for (int c = 0; c < 256; c += 4) {
            float v[4];
            for (int q = 0; q < 4; ++q) {
                double s = 0; const bf16* a = A + (long)arow * lda; const bf16* b = Bt + (long)(bcol0 + c + q) * ldb;
                for (int k = 0; k < K; ++k) s += (double)bf2f(a[k]) * bf2f(b[k]);
                v[q] = (float)s;
            }
            epi(r, c, v[0], v[1], v[2], v[3]);
        }
    }
}
#endif

DI void st_bf16x4(bf16* p, float a, float b, float c, float d) {
#ifndef CPU_EMU
    uint2 u; u.x = pack_bf16(a, b); u.y = pack_bf16(c, d); *reinterpret_cast<uint2*>(p) = u;
#else
    p[0] = f2bf(a); p[1] = f2bf(b); p[2] = f2bf(c); p[3] = f2bf(d);
#endif
}

#define WSP(T, off) ((T*)(F.ws + (off)))

DI void ln_row_write(float* xrow, bf16* brow, const float* vals_in  , const float* g, const float* b);

template <class Fn>
DI void layer_norm_rows(const Frame& F, const float* g, const float* b, Fn pre, bool write_out_extra, float* extra) {
    float* xf = F.xf; bf16* xb = WSP(bf16, OFF_XB);
    for (int row = ggrp(F); row < NTOK; row += ngrp(F)) {
        float v[PERLN]; float s = 0.f;
        for (int i = 0; i < PERLN; ++i) { int c = glane(F) + i * GRP; v[i] = pre(row, c); s += v[i]; }
        s = grp_sum(F, s); const float mu = s * (1.0f / 1024.0f);
        float q = 0.f;
        for (int i = 0; i < PERLN; ++i) { float d = v[i] - mu; q += d * d; }
        q = grp_sum(F, q); const float rs = 1.0f / sqrtf(q * (1.0f / 1024.0f) + LN_EPS);
        for (int i = 0; i < PERLN; ++i) { int c = glane(F) + i * GRP; float y = (v[i] - mu) * rs * g[c] + b[c];
            xf[(size_t)row * DM + c] = y; xb[(size_t)row * DM + c] = f2bf(y); if (write_out_extra) extra[(size_t)row * DM + c] = y; }
    }
}

#ifndef CPU_EMU
template <int MODE, bool BLOCKED = false>
DI void ln_rows_gpu(const Frame& F, const float* __restrict__ g, const float* __restrict__ b, int l) {
    float* xf = F.xf; bf16* xb = WSP(bf16, OFF_XB);
    const float* xin = F.in[0];
    const bf16* yr = WSP(bf16, OFF_YROWS); const float* tinfo = WSP(float, OFF_TINFO);
    const int* eoff = (const int*)(F.ws + CTL_EOFF) + l * 33;
    const int tid = F.tid, wave = tid >> 6, lane = tid & 63;
    float4 gv[4], bv[4];
#pragma unroll
    for (int i = 0; i < 4; ++i) { gv[i] = *reinterpret_cast<const float4*>(g + lane * 4 + 256 * i); bv[i] = *reinterpret_cast<const float4*>(b + lane * 4 + 256 * i); }
    const bool blk_ok = BLOCKED && (NTOK % (F.nblk * 32) == 0);
    const int rpb = NTOK / F.nblk;
    const int r_first = blk_ok ? blockIdx.x * rpb + wave * 4 : (blockIdx.x * 8 + wave) * 4;
    const int r_end = blk_ok ? (blockIdx.x + 1) * rpb : NTOK;
    const int r_step = blk_ok ? 32 : F.nblk * 32;
    for (int r0 = r_first; r0 < r_end; r0 += r_step) {
        float4 v[4][4];
#pragma unroll
        for (int rr = 0; rr < 4; ++rr) {
            const size_t row = r0 + rr;
            if (MODE == 2) {
                const int* ti = (const int*)(tinfo + row * 8);
                const size_t ra = (size_t)eoff[ti[0]] + ti[1], rb = (size_t)eoff[ti[2]] + ti[3];
                const float g0 = tinfo[row * 8 + 4], g1 = tinfo[row * 8 + 5];
#pragma unroll
                for (int i = 0; i < 4; ++i) {
                    const int c = lane * 4 + 256 * i;
                    const float4 x = *reinterpret_cast<const float4*>(xf + row * DM + c);
                    const uint2 ya = *reinterpret_cast<const uint2*>(yr + ra * 1024 + c), yb = *reinterpret_cast<const uint2*>(yr + rb * 1024 + c);
                    v[rr][i].x = DN_ALPHA * x.x + g0 * bflo(ya.x) + g1 * bflo(yb.x); v[rr][i].y = DN_ALPHA * x.y + g0 * bfhi(ya.x) + g1 * bfhi(yb.x);
                    v[rr][i].z = DN_ALPHA * x.z + g0 * bflo(ya.y) + g1 * bflo(yb.y); v[rr][i].w = DN_ALPHA * x.w + g0 * bfhi(ya.y) + g1 * bfhi(yb.y);
                }
            } else {
                const float* src = (MODE == 1 ? xin : xf) + row * DM;
#pragma unroll
                for (int i = 0; i < 4; ++i) v[rr][i] = *reinterpret_cast<const float4*>(src + lane * 4 + 256 * i);
            }
        }
#pragma unroll
        for (int rr = 0; rr < 4; ++rr) {
            const size_t row = r0 + rr;
            float s = 0.f;
#pragma unroll
            for (int i = 0; i < 4; ++i) s += (v[rr][i].x + v[rr][i].y) + (v[rr][i].z + v[rr][i].w);
            const float mu = grp_sum(F, s) * (1.0f / 1024.0f);
            float q = 0.f;
#pragma unroll
            for (int i = 0; i < 4; ++i) { const float d0 = v[rr][i].x - mu, d1 = v[rr][i].y - mu, d2 = v[rr][i].z - mu, d3 = v[rr][i].w - mu; q += (d0 * d0 + d1 * d1) + (d2 * d2 + d3 * d3); }
            const float rs = 1.0f / sqrtf(grp_sum(F, q) * (1.0f / 1024.0f) + LN_EPS);
#pragma unroll
            for (int i = 0; i < 4; ++i) {
                const int c = lane * 4 + 256 * i;
                float4 y; y.x = (v[rr][i].x - mu) * rs * gv[i].x + bv[i].x; y.y = (v[rr][i].y - mu) * rs * gv[i].y + bv[i].y;
                y.z = (v[rr][i].z - mu) * rs * gv[i].z + bv[i].z; y.w = (v[rr][i].w - mu) * rs * gv[i].w + bv[i].w;
                *reinterpret_cast<float4*>(xf + row * DM + c) = y;
                *reinterpret_cast<uint2*>(xb + row * DM + c) = make_uint2(pack_bf16(y.x, y.y), pack_bf16(y.z, y.w));
            }
        }
    }
}
#endif

DI void phase_pro(const Frame& F) {
    const float* x = F.in[0]; const float* mem = F.in[1];
#ifdef CPU_EMU
    layer_norm_rows(F, F.in[2], F.in[3], [&](int row, int c) { return x[(size_t)row * DM + c]; }, false, nullptr);
#else
    (void)x; ln_rows_gpu<1>(F, F.in[2], F.in[3], 0);
#endif
    bf16* memb = WSP(bf16, OFF_MEMB);
    for (size_t i = gtid_(F); i < (size_t)NMEM * DM; i += gthreads(F)) memb[i] = f2bf(mem[i]);
}

template <class Src>
DI void cvt_tile(const Frame& F, bf16* dst, int Kk, int n0, int k0, Src src) {
#ifndef CPU_EMU
    float* tile = (float*)F.smem;
    __syncthreads();
    for (int i = F.tid; i < 4096; i += NTH) { int k = i >> 6, n = i & 63; tile[k * 65 + n] = src(k0 + k, n0 + n); }
    __syncthreads();
    for (int i = F.tid; i < 2048; i += NTH) { int n = i >> 5, k = (i & 31) * 2;
        *reinterpret_cast<unsigned*>(dst + (size_t)(n0 + n) * Kk + k0 + k) = pack_bf16(tile[k * 65 + n], tile[(k + 1) * 65 + n]); }
#endif
}
template <class Src>
DI void cvt_transpose(const Frame& F, bf16* dst, int Nn, int Kk, Src src, int t_first, int t_total) {
#ifdef CPU_EMU
    for (int n = 0; n < Nn; ++n) for (int k = 0; k < Kk; ++k) dst[(size_t)n * Kk + k] = f2bf(src(k, n));
#else
    const int tn = Nn / 64, tk = Kk / 64, ntile = tn * tk;
    int t = (int)blockIdx.x - (t_first % (int)F.nblk); if (t < 0) t += F.nblk;
    for (; t < ntile; t += F.nblk) cvt_tile(F, dst, Kk, (t % tn) * 64, (t / tn) * 64, src);
#endif
}

#ifndef CPU_EMU
template <bool VEC, class CM>
DI void cvt_job(const Frame& F, int& tbase, bf16* dst, int ldd, int Nn, int Kk, int Ksrc, const float* __restrict__ src, int lds, CM cm) {
    const int nw = F.nblk * 8, gw = blockIdx.x * 8 + F.wv;
    const int lane = fresh_tid(F) & 63, kq = lane & 15, nq = lane >> 4;
    const int tk = Kk / 64, T = tk * (Nn / 16);
    int t = gw - (tbase % nw); if (t < 0) t += nw;
    tbase += T;
    for (; t < T; t += nw) {
        const int k = (t % tk) * 64 + 4 * kq, n = (t / tk) * 16 + 4 * nq;
        float4 v[4];
        if (VEC) {
            const int s = cm(n);
#pragma unroll
            for (int i = 0; i < 4; ++i) v[i] = (s >= 0 && k + i < Ksrc) ? *reinterpret_cast<const float4*>(src + (size_t)(k + i) * lds + s) : make_float4(0.f, 0.f, 0.f, 0.f);
        } else {
            const int s0 = cm(n), s1 = cm(n + 1), s2 = cm(n + 2), s3 = cm(n + 3);
#pragma unroll
            for (int i = 0; i < 4; ++i) { const float* row = src + (size_t)(k + i) * lds; const bool ok = k + i < Ksrc;
                v[i].x = (ok && s0 >= 0) ? row[s0] : 0.f; v[i].y = (ok && s1 >= 0) ? row[s1] : 0.f; v[i].z = (ok && s2 >= 0) ? row[s2] : 0.f; v[i].w = (ok && s3 >= 0) ? row[s3] : 0.f; }
        }
        bf16* d = dst + (size_t)n * ldd + k;
        *reinterpret_cast<uint2*>(d) = make_uint2(pack_bf16(v[0].x, v[1].x), pack_bf16(v[2].x, v[3].x));
        *reinterpret_cast<uint2*>(d + ldd) = make_uint2(pack_bf16(v[0].y, v[1].y), pack_bf16(v[2].y, v[3].y));
        *reinterpret_cast<uint2*>(d + 2 * (size_t)ldd) = make_uint2(pack_bf16(v[0].z, v[1].z), pack_bf16(v[2].z, v[3].z));
        *reinterpret_cast<uint2*>(d + 3 * (size_t)ldd) = make_uint2(pack_bf16(v[0].w, v[1].w), pack_bf16(v[2].w, v[3].w));
    }
}
#endif

DI int win_src_col(int n) {
    if (n < 512) return n;
    if (n < 1536) { int c = n - 512; return c < 960 ? 512 + c : -1; }
    if (n < 2816) return 1472 + (n - 1536);
    int c = n - 2816;
    if (c < 192) return 2752 + c;
    if (c < 224) return 2752 + 320 + (c - 192);
    if (c < 256) return -1;
    if (c < 384) return 2752 + 192 + (c - 256);
    return -1;
}
DI int wuq_src_col(int n) {
    if (n >= 384) return -1;
    int h = n / 96, w = n % 96;
    if (w < 64) return h * 96 + w;
    int p = w - 64, m = p >> 1, which = p & 1;
    int i = (m < 8 ? m : 16 + (m - 8)) + (which ? 8 : 0);
    return h * 96 + 64 + i;
}

DI void phase_cvt(const Frame& F, int l) {
    bf16* wts = WSP(bf16, OFF_WTS);
#ifndef CPU_EMU
    {
        int tb = 0;
        auto ident = [](int n) { return n; };
        cvt_job<true>(F, tb, (bf16*)((char*)wts + W_IN_T), 1024, HP, 1024, 1024, F.in[4] + (size_t)l * 1024 * IN_WIDTH, IN_WIDTH, [](int n) { return win_src_col(n); });
        cvt_job<false>(F, tb, (bf16*)((char*)wts + W_UQ_T), 256, 512, 256, 192, F.in[23] + (size_t)l * 192 * 384, 384, [](int n) { return wuq_src_col(n); });
        cvt_job<true>(F, tb, (bf16*)((char*)wts + W_UKV_T), 256, 512, 256, 128, F.in[24] + (size_t)l * 128 * 512, 512, ident);
        cvt_job<true>(F, tb, (bf16*)((char*)wts + W_OUT_T), 1024, 1024, 1024, 1024, F.in[25] + (size_t)l * 1024 * 1024, 1024, ident);
        cvt_job<true>(F, tb, (bf16*)((char*)wts + W_Q_T), 1024, 1024, 1024, 1024, F.in[28] + (size_t)l * 1024 * 1024, 1024, ident);
        cvt_job<true>(F, tb, (bf16*)((char*)wts + W_KV_T), 1024, 2048, 1024, 1024, F.in[29] + (size_t)l * 1024 * 2048, 2048, ident);
        cvt_job<true>(F, tb, (bf16*)((char*)wts + W_O_T), 1024, 1024, 1024, 1024, F.in[30] + (size_t)l * 1024 * 1024, 1024, ident);
        const float* wg = F.in[33] + (size_t)l * 1024 * 4; const float* we = F.in[35] + (size_t)l * 1024 * 32; float* gt = (float*)((char*)wts + W_GATE_T) + (size_t)l * 48 * 1024;
        for (int i = gtid_(F); i < 48 * 1024; i += gthreads(F)) { const int col = i >> 10, k = i & 1023; gt[i] = col < 4 ? wg[k * 4 + col] : col < 36 ? we[k * 32 + col - 4] : 0.f; }
        return;
    }
#endif
    constexpr int T0 = 0, T1 = T0 + (HP / 64) * 16, T2 = T1 + 8 * 4, T3 = T2 + 8 * 4, T4 = T3 + 256, T5 = T4 + 256, T6 = T5 + 512, TT = T6 + 256;
    { const float* w = F.in[4] + (size_t)l * 1024 * IN_WIDTH;
      cvt_transpose(F, (bf16*)((char*)wts + W_IN_T), HP, 1024, [&](int k, int n) { int s = win_src_col(n); return s < 0 ? 0.f : w[(size_t)k * IN_WIDTH + s]; }, T0, TT); }
    { const float* w = F.in[23] + (size_t)l * 192 * 384;
      cvt_transpose(F, (bf16*)((char*)wts + W_UQ_T), 512, 256, [&](int k, int n) { int s = wuq_src_col(n); return (s < 0 || k >= 192) ? 0.f : w[(size_t)k * 384 + s]; }, T1, TT); }
    { const float* w = F.in[24] + (size_t)l * 128 * 512;
      cvt_transpose(F, (bf16*)((char*)wts + W_UKV_T), 512, 256, [&](int k, int n) { return k >= 128 ? 0.f : w[(size_t)k * 512 + n]; }, T2, TT); }
    { const float* w = F.in[25] + (size_t)l * 1024 * 1024;
      cvt_transpose(F, (bf16*)((char*)wts + W_OUT_T), 1024, 1024, [&](int k, int n) { return w[(size_t)k * 1024 + n]; }, T3, TT); }
    { const float* w = F.in[28] + (size_t)l * 1024 * 1024;
      cvt_transpose(F, (bf16*)((char*)wts + W_Q_T), 1024, 1024, [&](int k, int n) { return w[(size_t)k * 1024 + n]; }, T4, TT); }
    { const float* w = F.in[29] + (size_t)l * 1024 * 2048;
      cvt_transpose(F, (bf16*)((char*)wts + W_KV_T), 2048, 1024, [&](int k, int n) { return w[(size_t)k * 2048 + n]; }, T5, TT); }
    { const float* w = F.in[30] + (size_t)l * 1024 * 1024;
      cvt_transpose(F, (bf16*)((char*)wts + W_O_T), 1024, 1024, [&](int k, int n) { return w[(size_t)k * 1024 + n]; }, T6, TT); }
#ifndef CPU_EMU
    { const float* wg = F.in[33] + (size_t)l * 1024 * 4; const float* we = F.in[35] + (size_t)l * 1024 * 32; float* gt = (float*)((char*)wts + W_GATE_T) + (size_t)l * 48 * 1024;
      for (int i = gtid_(F); i < 48 * 1024; i += gthreads(F)) { const int col = i >> 10, k = i & 1023;
          gt[i] = col < 4 ? wg[k * 4 + col] : col < 36 ? we[k * 32 + col - 4] : 0.f; } }
#endif
}

DI void phase_cvt_moe(const Frame& F, int l) {
#ifdef CPU_EMU
    for (int e = 0; e < NEXP; ++e) {
        const float* w1 = F.in[37] + ((size_t)l * NEXP + e) * 1024 * 256;
        const float* w3 = F.in[38] + ((size_t)l * NEXP + e) * 1024 * 256;
        const float* w2 = F.in[39] + ((size_t)l * NEXP + e) * 256 * 1024;
        cvt_transpose(F, WSP(bf16, OFF_W13T) + (size_t)e * 512 * 1024, 512, 1024,
                      [&](int k, int n) { return (n & 1) ? w3[(size_t)k * 256 + (n >> 1)] : w1[(size_t)k * 256 + (n >> 1)]; }, 0, 1);
        cvt_transpose(F, WSP(bf16, OFF_W2T) + (size_t)e * 1024 * 256, 1024, 256, [&](int k, int n) { return w2[(size_t)k * 1024 + n]; }, 0, 1);
    }
#else
    {
        int tb = 0;
        auto ident = [](int n) { return n; };
        for (int e = 0; e < NEXP; ++e) {
            const float* w1 = F.in[37] + ((size_t)l * NEXP + e) * 1024 * 256; const float* w3 = F.in[38] + ((size_t)l * NEXP + e) * 1024 * 256; const float* w2 = F.in[39] + ((size_t)l * NEXP + e) * 256 * 1024;
            bf16* d13 = WSP(bf16, OFF_W13T) + (size_t)e * 512 * 1024;
            cvt_job<true>(F, tb, d13, 2048, 256, 1024, 1024, w1, 256, ident);
            cvt_job<true>(F, tb, d13 + 1024, 2048, 256, 1024, 1024, w3, 256, ident);
            cvt_job<true>(F, tb, WSP(bf16, OFF_W2T) + (size_t)e * 1024 * 256, 256, 1024, 256, 256, w2, 1024, ident);
        }
    }
#endif
}

struct EpiH {
    bf16* hatt; bf16* hrwkv; bf16* hhgrn; bf16* hmla; int row0, pn;
    DI void operator()(int r, int c, float a, float b, float cc, float d) const {
        const size_t row = row0 + r;
        bf16* p;
        if (pn < 2) p = hatt + row * 512 + pn * 256 + c;
        else if (pn < 6) p = hrwkv + row * 1024 + (pn - 2) * 256 + c;
        else if (pn < 11) p = hhgrn + row * 1280 + (pn - 6) * 256 + c;
        else p = hmla + row * 512 + (pn - 11) * 256 + c;
        st_bf16x4(p, a, b, cc, d);
    }
};
struct EpiKV {
    bf16* kmem; bf16* vt; int row0, pn;
    DI void operator()(int r, int c, float a, float b, float cc, float d) const {
        const int row = row0 + r, col = pn * 256 + c;
        if (col < 1024) { st_bf16x4(kmem + (size_t)row * 1024 + col, a, b, cc, d); }
        else { const int bb = row / MEMT, key = row % MEMT, hc = col - 1024;
            bf16* p = vt + ((size_t)bb * 1024 + hc) * MEMT + key;
            p[0] = f2bf(a); p[MEMT] = f2bf(b); p[2 * MEMT] = f2bf(cc); p[3 * MEMT] = f2bf(d); }
    }
};

DI void phase_gemm1(const Frame& F) {
    const bf16* xb = WSP(bf16, OFF_XB); const bf16* wts = WSP(bf16, OFF_WTS);
    const int nM = (NTOK + 255) / 256, nN = HP / 256, n1 = nM * nN;
    const int nMk = (NMEM + 255) / 256, nNk = 8, n2 = nMk * nNk;
    for (int u = blockIdx.x; u < n1 + n2; u += F.nblk) {
        if (u < n1) {
            const int pm = u / nN, pn = u % nN;
            EpiH E{WSP(bf16, OFF_HATT), WSP(bf16, OFF_HRWKV), WSP(bf16, OFF_HHGRN), WSP(bf16, OFF_HMLA), pm * 256, pn};
#ifdef CPU_EMU
            gemm_unit(F, xb, 1024, nullptr, pm * 256, (const bf16*)((const char*)wts + W_IN_T), 1024, pn * 256, 1024, E, min(256, NTOK - pm * 256));
#else
            gemm_unit(F, xb, 1024, nullptr, pm * 256, (const bf16*)((const char*)wts + W_IN_T), 1024, pn * 256, 1024, E);
#endif
        } else {
            const int v = u - n1, pm = v / nNk, pn = v % nNk;
            EpiKV E{WSP(bf16, OFF_KMEM), WSP(bf16, OFF_VTMEM), pm * 256, pn};
            gemm_unit(F, WSP(bf16, OFF_MEMB), 1024, nullptr, pm * 256, (const bf16*)((const char*)wts + W_KV_T), 1024, pn * 256, 1024, E);
        }
    }
}


#ifndef CPU_EMU
DI float fast_sigmoid(float x) { return 1.0f / (1.0f + __expf(-x)); }
DI float fast_tanh(float x) { const float e = __expf(2.0f * x); return 1.0f - 2.0f / (e + 1.0f); }

DI void prep_attn_gpu(const Frame& F, int l) {
    float* tabA = (float*)F.smem;
    float* tabB = tabA + 2048;
    float* gq = tabB + 1024;
    __syncthreads();
    { const int tid = fresh_tid(F);
    for (int i = tid; i < 1024; i += NTH) { const int pos = i >> 4, f = i & 15; const float ang = (float)pos * rope_inv(2 * f, 32); tabA[i] = cosf(ang); tabA[1024 + i] = sinf(ang); }
    for (int i = tid; i < 512; i += NTH) { const int pos = i >> 3, f = i & 7; const float ang = (float)pos * rope_inv(2 * f, 16); tabB[i] = cosf(ang); tabB[512 + i] = sinf(ang); }
    for (int i = tid; i < 448; i += NTH) gq[i] = i < 64 ? F.in[5][l * 64 + i] : i < 128 ? F.in[6][l * 64 + i - 64] : i < 320 ? F.in[21][l * 192 + i - 128] : F.in[22][l * 128 + i - 320]; }
    __syncthreads();
    bf16* hatt = WSP(bf16, OFF_HATT);
    for (int it = blockIdx.x * NTH + fresh_tid(F); it < NTOK * 6; it += gthreads(F)) {
        const int n = it / 6, hh = it % 6, s = n % SEQ, rowp = s / GRIDW, colp = s % GRIDW;
        uint4* p = reinterpret_cast<uint4*>(hatt + (size_t)n * 512 + hh * 64);
        const float* gn = gq + (hh < 4 ? 0 : 64);
        uint4 raw[8];
#pragma unroll
        for (int i = 0; i < 8; ++i) raw[i] = p[i];
        float x[64];
#pragma unroll
        for (int i = 0; i < 8; ++i) { x[8 * i] = bflo(raw[i].x); x[8 * i + 1] = bfhi(raw[i].x); x[8 * i + 2] = bflo(raw[i].y); x[8 * i + 3] = bfhi(raw[i].y);
            x[8 * i + 4] = bflo(raw[i].z); x[8 * i + 5] = bfhi(raw[i].z); x[8 * i + 6] = bflo(raw[i].w); x[8 * i + 7] = bfhi(raw[i].w); }
        float ss = 0.f;
#pragma unroll
        for (int j = 0; j < 64; ++j) ss += x[j] * x[j];
        const float rs = 1.0f / sqrtf(ss * (1.0f / 64.0f) + RMS_EPS);
#pragma unroll
        for (int j = 0; j < 64; ++j) x[j] *= rs * gn[j];
#pragma unroll
        for (int half = 0; half < 2; ++half) {
            const int pos = half ? colp : rowp;
#pragma unroll
            for (int f = 0; f < 16; ++f) {
                const float cs = tabA[pos * 16 + f], sn = tabA[1024 + pos * 16 + f];
                const float x1 = x[half * 32 + f], x2 = x[half * 32 + 16 + f];
                x[half * 32 + f] = x1 * cs - x2 * sn; x[half * 32 + 16 + f] = x1 * sn + x2 * cs;
            }
        }
#pragma unroll
        for (int i = 0; i < 8; ++i) { uint4 o; o.x = pack_bf16(x[8 * i], x[8 * i + 1]); o.y = pack_bf16(x[8 * i + 2], x[8 * i + 3]); o.z = pack_bf16(x[8 * i + 4], x[8 * i + 5]); o.w = pack_bf16(x[8 * i + 6], x[8 * i + 7]); p[i] = o; }
    }
    bf16* hm = WSP(bf16, OFF_HMLA); bf16* kr = WSP(bf16, OFF_KROPE);
    for (int it = blockIdx.x * NTH + fresh_tid(F); it < NTOK * 3; it += gthreads(F)) {
        const int n = it / 3, which = it % 3;
        if (which < 2) {
            const int len = which ? 128 : 192; const float* gn = gq + (which ? 320 : 128);
            uint4* p = reinterpret_cast<uint4*>(hm + (size_t)n * 512 + (which ? 256 : 0));
            float ss = 0.f;
            for (int i = 0; i < len / 8; ++i) { const uint4 r = p[i];
                const float a0 = bflo(r.x), a1 = bfhi(r.x), a2 = bflo(r.y), a3 = bfhi(r.y), a4 = bflo(r.z), a5 = bfhi(r.z), a6 = bflo(r.w), a7 = bfhi(r.w);
                ss += a0 * a0 + a1 * a1 + a2 * a2 + a3 * a3 + a4 * a4 + a5 * a5 + a6 * a6 + a7 * a7; }
            const float rs = 1.0f / sqrtf(ss / (float)len + RMS_EPS);
            for (int i = 0; i < len / 8; ++i) { const uint4 r = p[i]; const float* g = gn + 8 * i; uint4 o;
                o.x = pack_bf16(bflo(r.x) * rs * g[0], bfhi(r.x) * rs * g[1]); o.y = pack_bf16(bflo(r.y) * rs * g[2], bfhi(r.y) * rs * g[3]);
                o.z = pack_bf16(bflo(r.z) * rs * g[4], bfhi(r.z) * rs * g[5]); o.w = pack_bf16(bflo(r.w) * rs * g[6], bfhi(r.w) * rs * g[7]); p[i] = o; }
        } else {
            const int s = n % SEQ, rowp = s / GRIDW, colp = s % GRIDW;
            const uint4* p = reinterpret_cast<const uint4*>(hm + (size_t)n * 512 + 192);
            float x[32];
#pragma unroll
            for (int i = 0; i < 4; ++i) { const uint4 r = p[i]; x[8 * i] = bflo(r.x); x[8 * i + 1] = bfhi(r.x); x[8 * i + 2] = bflo(r.y); x[8 * i + 3] = bfhi(r.y);
                x[8 * i + 4] = bflo(r.z); x[8 * i + 5] = bfhi(r.z); x[8 * i + 6] = bflo(r.w); x[8 * i + 7] = bfhi(r.w); }
            unsigned o[16];
#pragma unroll
            for (int m = 0; m < 16; ++m) {
                const int i1 = m < 8 ? m : 16 + (m - 8), pos = m < 8 ? rowp : colp, f = m & 7;
                const float cs = tabB[pos * 8 + f], sn = tabB[512 + pos * 8 + f];
                o[m] = pack_bf16(x[i1] * cs - x[i1 + 8] * sn, x[i1] * sn + x[i1 + 8] * cs);
            }
            uint4* q = reinterpret_cast<uint4*>(kr + (size_t)n * 32);
#pragma unroll
            for (int i = 0; i < 4; ++i) q[i] = make_uint4(o[4 * i], o[4 * i + 1], o[4 * i + 2], o[4 * i + 3]);
        }
    }
    {
        bf16* vt = WSP(bf16, OFF_VTATT); bf16* tl = (bf16*)(gq + 512);
        for (int tile = blockIdx.x; tile < BATCH * 2 * (SEQ / 64); tile += F.nblk) {
            const int b = tile / (2 * (SEQ / 64)), kv = (tile / (SEQ / 64)) % 2, t0 = (tile % (SEQ / 64)) * 64;
            __syncthreads();
            const int tid = fresh_tid(F);
            { const int t = tid >> 3, part = tid & 7;
              const uint4 r = *reinterpret_cast<const uint4*>(hatt + (size_t)(b * SEQ + t0 + t) * 512 + 384 + kv * 64 + part * 8);
              const unsigned w[4] = {r.x, r.y, r.z, r.w};
#pragma unroll
              for (int i = 0; i < 4; ++i) { tl[(part * 8 + 2 * i) * 72 + t] = (bf16)(w[i] & 0xffffu); tl[(part * 8 + 2 * i + 1) * 72 + t] = (bf16)(w[i] >> 16); } }
            __syncthreads();
            { const int dv = tid >> 3, part = tid & 7;
              *reinterpret_cast<uint4*>(vt + ((size_t)(b * 2 + kv) * 64 + dv) * SEQ + t0 + part * 8) = *reinterpret_cast<const uint4*>(tl + dv * 72 + part * 8); }
        }
    }
}

DI void prep_hgrn_gpu(const Frame& F, int l) {
    bf16* hh = WSP(bf16, OFF_HHGRN); bf16* hx = WSP(bf16, OFF_HX); bf16* ham = WSP(bf16, OFF_HAM); float* heg = WSP(float, OFF_HEG);
    const int tid = F.tid, wave = tid >> 6, lane = tid & 63, x = lane & 15, q = lane >> 4;
    bf16* stg = (bf16*)F.smem + wave * (4 * 16 * 72);
    for (int it = blockIdx.x * 8 + wave; it < (NTOK / 16) * 4; it += F.nblk * 8) {
        const int c = it >> 2, h = it & 3, n0 = c * 16, cj = h * 64 + lane;
        float mlb = 1.0f;
        if (l == 1) { const float a = F.in[19][cj], b = F.in[19][256 + cj]; const float m = fmaxf(a, b); const float ea = __expf(a - m), eb = __expf(b - m); mlb = ea / (ea + eb); }
        float qv[16], k0[16], k1[16], g0[16], g1[16]; bf16 vraw[16];
#pragma unroll
        for (int t = 0; t < 16; ++t) {
            const bf16* row = hh + (size_t)(n0 + t) * 1280 + cj;
            const float xq = bf2f(row[0]), x0 = bf2f(row[256]), x1 = bf2f(row[512]); vraw[t] = row[768];
            qv[t] = xq * fast_sigmoid(xq); k0[t] = mlb * fast_sigmoid(-x0); k1[t] = mlb * fast_sigmoid(-x1);
            g0[t] = __logf(1.0f - k0[t]); g1[t] = __logf(1.0f - k1[t]);
        }
#pragma unroll
        for (int t = 1; t < 16; ++t) { g0[t] += g0[t - 1]; g1[15 - t] += g1[16 - t]; }
        heg[((size_t)it * 2 + 0) * 64 + lane] = __expf(g0[15]); heg[((size_t)it * 2 + 1) * 64 + lane] = __expf(g1[0]);
        unsigned kt0[8], kt1[8], vt[8];
#pragma unroll
        for (int t = 0; t < 16; t += 2) {
            const float e0a = __expf(g0[t]), e0b = __expf(g0[t + 1]), e1a = __expf(g1[t]), e1b = __expf(g1[t + 1]);
            const float q0a = qv[t] * e0a, q0b = qv[t + 1] * e0b, q1a = qv[t] * e1a, q1b = qv[t + 1] * e1b;
            const float ka0 = k0[t] / e0a, kb0 = k0[t + 1] / e0b, ka1 = k1[t] / e1a, kb1 = k1[t + 1] / e1b;
            const bf16 bq0a = f2bf(q0a), bq0b = f2bf(q0b), bq1a = f2bf(q1a), bq1b = f2bf(q1b);
            hh[(size_t)(n0 + t) * 1280 + cj] = bq0a; hh[(size_t)(n0 + t + 1) * 1280 + cj] = bq0b;
            hx[(size_t)(n0 + t) * 256 + cj] = bq1a; hx[(size_t)(n0 + t + 1) * 256 + cj] = bq1b;
            kt0[t >> 1] = pack_bf16(ka0, kb0); kt1[t >> 1] = pack_bf16(ka1, kb1); vt[t >> 1] = (unsigned)vraw[t] | ((unsigned)vraw[t + 1] << 16);
            stg[0 * 1152 + t * 72 + lane] = bq0a; stg[0 * 1152 + (t + 1) * 72 + lane] = bq0b;
            stg[2 * 1152 + t * 72 + lane] = bq1a; stg[2 * 1152 + (t + 1) * 72 + lane] = bq1b;
            stg[1 * 1152 + t * 72 + lane] = (bf16)(kt0[t >> 1] & 0xffffu); stg[1 * 1152 + (t + 1) * 72 + lane] = (bf16)(kt0[t >> 1] >> 16);
            stg[3 * 1152 + t * 72 + lane] = (bf16)(kt1[t >> 1] & 0xffffu); stg[3 * 1152 + (t + 1) * 72 + lane] = (bf16)(kt1[t >> 1] >> 16);
        }
        { bf16* blk = hh + (size_t)(n0 + (lane >> 2)) * 1280 + h * 64 + (lane & 3) * 16;
          *reinterpret_cast<uint4*>(blk + 256) = make_uint4(kt0[0], kt0[1], kt0[2], kt0[3]); *reinterpret_cast<uint4*>(blk + 256 + 8) = make_uint4(kt0[4], kt0[5], kt0[6], kt0[7]);
          *reinterpret_cast<uint4*>(blk + 512) = make_uint4(kt1[0], kt1[1], kt1[2], kt1[3]); *reinterpret_cast<uint4*>(blk + 512 + 8) = make_uint4(kt1[4], kt1[5], kt1[6], kt1[7]);
          *reinterpret_cast<uint4*>(blk + 768) = make_uint4(vt[0], vt[1], vt[2], vt[3]); *reinterpret_cast<uint4*>(blk + 768 + 8) = make_uint4(vt[4], vt[5], vt[6], vt[7]); }
        asm volatile("s_waitcnt lgkmcnt(0)" ::: "memory");
        __builtin_amdgcn_wave_barrier();
#pragma unroll
        for (int d = 0; d < 2; ++d) {
            f32x4 acc = {0.f, 0.f, 0.f, 0.f};
#pragma unroll
            for (int ks = 0; ks < 2; ++ks) {
                const bf16x8 a = *reinterpret_cast<const bf16x8*>(stg + (2 * d) * 1152 + x * 72 + 32 * ks + 8 * q);
                const bf16x8 b = *reinterpret_cast<const bf16x8*>(stg + (2 * d + 1) * 1152 + x * 72 + 32 * ks + 8 * q);
                acc = __builtin_amdgcn_mfma_f32_16x16x32_bf16(a, b, acc, 0, 0, 0);
            }
            bf16* am = ham + ((size_t)it * 2 + d) * 256;
#pragma unroll
            for (int r = 0; r < 4; ++r) { const int t = 4 * q + r; const bool keep = d ? (x >= t) : (x <= t); am[t * 16 + x] = f2bf(keep ? acc[r] : 0.f); }
        }
        __builtin_amdgcn_wave_barrier();
    }
}

DI void scan_hgrn_chunk(const Frame& F, int chain) {
    const int d = chain / (BATCH * 4), b = (chain / 4) % BATCH, h = chain % 4;
    const int lane = fresh_tid(F) & 63, x = lane & 15, q = lane >> 4;
    bf16* hh = WSP(bf16, OFF_HHGRN); const bf16* hx = WSP(bf16, OFF_HX); const bf16* ham = WSP(bf16, OFF_HAM); const float* heg = WSP(float, OFF_HEG);
    f32x4 S[4][4];
#pragma unroll
    for (int a = 0; a < 4; ++a)
#pragma unroll
        for (int c = 0; c < 4; ++c) S[a][c] = (f32x4){0.f, 0.f, 0.f, 0.f};
    constexpr int NCH = SEQ / 16;
    uint2 nQ[4], nA, nK[4], nV[4]; float4 nE[4];
    const unsigned lq = (unsigned)(x * (d ? 256 : 1280) + h * 64 + 4 * q);
    const unsigned lb = (unsigned)((x >> 2) * 1280 + h * 64 + (x & 3) * 16 + 4 * q);
    const unsigned la = (unsigned)(x * 16 + 4 * q), le = (unsigned)(4 * q), lo = (unsigned)(4 * q * 1280 + x);
#define HG_LOAD(cc_) do { const int c_ = d ? NCH - 1 - (cc_) : (cc_); const unsigned n0_ = (unsigned)(b * SEQ + 16 * c_); const unsigned it_ = (n0_ >> 4) * 4 + h; \
        const bf16* qb_ = d ? hx + (size_t)n0_ * 256 : hh + (size_t)n0_ * 1280; const bf16* hb_ = hh + (size_t)n0_ * 1280; \
        const bf16* ab_ = ham + (size_t)(it_ * 2 + d) * 256; const float* eb_ = heg + (size_t)(it_ * 2 + d) * 64; \
        _Pragma("unroll") for (int u_ = 0; u_ < 4; ++u_) nQ[u_] = *reinterpret_cast<const uint2*>(qb_ + lq + 16 * u_); \
        nA = *reinterpret_cast<const uint2*>(ab_ + la); \
        _Pragma("unroll") for (int u_ = 0; u_ < 4; ++u_) { \
            nK[u_] = *reinterpret_cast<const uint2*>(hb_ + lb + (4 * u_) * 1280 + 256 + d * 256); nV[u_] = *reinterpret_cast<const uint2*>(hb_ + lb + (4 * u_) * 1280 + 768); \
            nE[u_] = *reinterpret_cast<const float4*>(eb_ + le + 16 * u_); } } while (0)
    HG_LOAD(0);
    for (int cc = 0; cc < NCH; ++cc) {
        uint2 cQ[4], cA, cK[4], cV[4]; float4 cE[4];
#pragma unroll
        for (int u = 0; u < 4; ++u) { cQ[u] = nQ[u]; cK[u] = nK[u]; cV[u] = nV[u]; cE[u] = nE[u]; }
        cA = nA;
        if (cc + 1 < NCH) HG_LOAD(cc + 1);
        const int c = d ? NCH - 1 - cc : cc; const size_t n0 = (size_t)b * SEQ + 16 * c;
        union Fr { bf16x8 v; unsigned u[4]; };
        Fr aq0, aq1, aA; aq0.u[0] = cQ[0].x; aq0.u[1] = cQ[0].y; aq0.u[2] = cQ[1].x; aq0.u[3] = cQ[1].y;
        aq1.u[0] = cQ[2].x; aq1.u[1] = cQ[2].y; aq1.u[2] = cQ[3].x; aq1.u[3] = cQ[3].y;
        aA.u[0] = cA.x; aA.u[1] = cA.y; aA.u[2] = 0u; aA.u[3] = 0u;
#pragma unroll
        for (int it = 0; it < 4; ++it) {
            Fr bS0, bS1, bV;
            bS0.u[0] = pack_bf16(S[0][it][0], S[0][it][1]); bS0.u[1] = pack_bf16(S[0][it][2], S[0][it][3]); bS0.u[2] = pack_bf16(S[1][it][0], S[1][it][1]); bS0.u[3] = pack_bf16(S[1][it][2], S[1][it][3]);
            bS1.u[0] = pack_bf16(S[2][it][0], S[2][it][1]); bS1.u[1] = pack_bf16(S[2][it][2], S[2][it][3]); bS1.u[2] = pack_bf16(S[3][it][0], S[3][it][1]); bS1.u[3] = pack_bf16(S[3][it][2], S[3][it][3]);
            bV.u[0] = cV[it].x; bV.u[1] = cV[it].y; bV.u[2] = 0u; bV.u[3] = 0u;
            f32x4 O = {0.f, 0.f, 0.f, 0.f};
            O = __builtin_amdgcn_mfma_f32_16x16x32_bf16(aq0.v, bS0.v, O, 0, 0, 0);
            O = __builtin_amdgcn_mfma_f32_16x16x32_bf16(aq1.v, bS1.v, O, 0, 0, 0);
            O = __builtin_amdgcn_mfma_f32_16x16x32_bf16(aA.v, bV.v, O, 0, 0, 0);
            bf16* od = hh + n0 * 1280 + 256 + d * 256 + h * 64 + 16 * it;
#pragma unroll
            for (int r = 0; r < 4; ++r) od[lo + (unsigned)(r * 1280)] = f2bf(O[r]);
#pragma unroll
            for (int jt = 0; jt < 4; ++jt) {
                Fr aK; aK.u[0] = cK[jt].x; aK.u[1] = cK[jt].y; aK.u[2] = 0u; aK.u[3] = 0u;
                f32x4 t = __builtin_amdgcn_mfma_f32_16x16x32_bf16(aK.v, bV.v, S[jt][it], 0, 0, 0);
                t[0] *= cE[jt].x; t[1] *= cE[jt].y; t[2] *= cE[jt].z; t[3] *= cE[jt].w;
                S[jt][it] = t;
            }
        }
    }
#undef HG_LOAD
}

DI void prep_rwkv_gpu(const Frame& F, int l) {
    const bf16* hz = WSP(bf16, OFF_HRWKV); bf16* r7 = WSP(bf16, OFF_R7); bf16* gb = WSP(bf16, OFF_G); float* bonus = WSP(float, OFF_BONUS);
    const float* mup = F.in[7] + l * 960; const float* mun = F.in[8] + l * 960;
    const float* w0 = F.in[9] + l * 512; const float* w2 = F.in[10] + (size_t)l * 2 * 32 * 256;
    const float* a0 = F.in[11] + l * 512; const float* a2 = F.in[12] + (size_t)l * 2 * 32 * 256;
    const float* g2 = F.in[13] + (size_t)l * 64 * 256;
    const size_t AS = (size_t)NTOK * 256;
    float* zs = (float*)F.smem;
    const int tid = F.tid, c = tid & 255, tg = tid >> 8;
    const float w0a = w0[c], w0b = w0[256 + c], a0a = a0[c], a0b = a0[256 + c];
    const float kkc = F.in[14][l * 256 + c], kac = F.in[15][l * 256 + c], rkc = F.in[16][l * 256 + c];
    for (int tile = blockIdx.x; tile < NTOK / 16; tile += F.nblk) {
        const int n0 = tile * 16;
        __syncthreads();
        const int tl = fresh_tid(F);
#pragma unroll
        for (int bt = 0; bt < 3; ++bt) {
            unsigned zc[5], zp[5], zn[5];
#pragma unroll
            for (int i = 0; i < 5; ++i) {
                const int e = tl + (bt * 5 + i) * NTH, t = e / 480, cc = (e % 480) * 2, n = n0 + t, s = n % SEQ;
                zc[i] = *reinterpret_cast<const unsigned*>(hz + (size_t)n * 1024 + cc);
                zp[i] = s > 0 ? *reinterpret_cast<const unsigned*>(hz + (size_t)(n - 1) * 1024 + cc) : 0u;
                zn[i] = s < SEQ - 1 ? *reinterpret_cast<const unsigned*>(hz + (size_t)(n + 1) * 1024 + cc) : 0u;
            }
#pragma unroll
            for (int i = 0; i < 5; ++i) {
                const int e = tl + (bt * 5 + i) * NTH, t = e / 480, cc = (e % 480) * 2;
                const float2 mp = *reinterpret_cast<const float2*>(mup + cc), mn = *reinterpret_cast<const float2*>(mun + cc);
                float v0 = bflo(zc[i]), v1 = bfhi(zc[i]);
                v0 = v0 + mp.x * (bflo(zp[i]) - v0) + mn.x * (bflo(zn[i]) - v0);
                v1 = v1 + mp.y * (bfhi(zp[i]) - v1) + mn.y * (bfhi(zn[i]) - v1);
                if (cc >= 768 && cc < 832) { v0 = fast_tanh(v0); v1 = fast_tanh(v1); }
                else if (cc >= 896) { v0 = fast_sigmoid(v0); v1 = fast_sigmoid(v1); }
                *reinterpret_cast<float2*>(zs + t * 960 + cc) = make_float2(v0, v1);
            }
        }
        __syncthreads();
        float wr0[8], wr1[8], ar0[8], ar1[8], gg[8];
#pragma unroll
        for (int t = 0; t < 8; ++t) { wr0[t] = w0a; wr1[t] = w0b; ar0[t] = a0a; ar1[t] = a0b; gg[t] = 0.f; }
        for (int q = 0; q < 32; q += 4) {
            float wa[4], wb[4], aa[4], ab[4];
#pragma unroll
            for (int u = 0; u < 4; ++u) { wa[u] = w2[(size_t)(q + u) * 256 + c]; wb[u] = w2[(size_t)(32 + q + u) * 256 + c]; aa[u] = a2[(size_t)(q + u) * 256 + c]; ab[u] = a2[(size_t)(32 + q + u) * 256 + c]; }
#pragma unroll
            for (int t = 0; t < 8; ++t) {
                const float* zr = zs + (tg * 8 + t) * 960;
                const float4 x0 = *reinterpret_cast<const float4*>(zr + 768 + q), x1 = *reinterpret_cast<const float4*>(zr + 800 + q);
                const float4 y0 = *reinterpret_cast<const float4*>(zr + 832 + q), y1 = *reinterpret_cast<const float4*>(zr + 864 + q);
                wr0[t] += x0.x * wa[0] + x0.y * wa[1] + x0.z * wa[2] + x0.w * wa[3];
                wr1[t] += x1.x * wb[0] + x1.y * wb[1] + x1.z * wb[2] + x1.w * wb[3];
                ar0[t] += y0.x * aa[0] + y0.y * aa[1] + y0.z * aa[2] + y0.w * aa[3];
                ar1[t] += y1.x * ab[0] + y1.y * ab[1] + y1.z * ab[2] + y1.w * ab[3];
            }
        }
        for (int q = 0; q < 64; q += 4) {
            float ga[4];
#pragma unroll
            for (int u = 0; u < 4; ++u) ga[u] = g2[(size_t)(q + u) * 256 + c];
#pragma unroll
            for (int t = 0; t < 8; ++t) {
                const float4 x = *reinterpret_cast<const float4*>(zs + (tg * 8 + t) * 960 + 896 + q);
                gg[t] += x.x * ga[0] + x.y * ga[1] + x.z * ga[2] + x.w * ga[3];
            }
        }
        bf16* stg = (bf16*)(F.smem + 61440);
        float* nts = (float*)(F.smem + 61440 + 73728);
        float* xch = (float*)(F.smem + 61440 + 73728 + 8192);
        const int hh_ = c >> 6, j = c & 63;
        float lw0[8], lw1[8], G0[8], G1[8];
#pragma unroll
        for (int t = 0; t < 8; ++t) { lw0[t] = -DECAY_SCALE * fast_sigmoid(wr0[t]); lw1[t] = -DECAY_SCALE * fast_sigmoid(wr1[t]); }
        G0[0] = lw0[0]; G1[7] = lw1[7];
#pragma unroll
        for (int t = 1; t < 8; ++t) { G0[t] = G0[t - 1] + lw0[t]; G1[7 - t] = G1[8 - t] + lw1[7 - t]; }
        xch[(tg * 256 + c) * 2] = G0[7]; xch[(tg * 256 + c) * 2 + 1] = G1[0];
        __syncthreads();
        const float tot0 = xch[c * 2] + xch[(256 + c) * 2], tot1 = xch[c * 2 + 1] + xch[(256 + c) * 2 + 1];
        const float off0 = tg ? xch[c * 2] : 0.f, off1 = tg ? 0.f : xch[(256 + c) * 2 + 1];
#pragma unroll
        for (int t = 0; t < 8; ++t) {
            const int tau = tg * 8 + t, n = n0 + tau; const float* zr = zs + tau * 960;
            const float r = zr[c], k = zr[256 + c], v = zr[512 + c];
            const float A0 = fast_sigmoid(ar0[t]), A1 = fast_sigmoid(ar1[t]);
            const float kk = k * kkc;
            const float kd0 = k * (1.0f + (A0 - 1.0f) * kac), kd1 = k * (1.0f + (A1 - 1.0f) * kac);
            const float ss = grp_sum(F, kk * kk);
            const float bs = grp_sum(F, r * (kd0 + kd1) * rkc);
            const float kkn = kk * (1.0f / fmaxf(sqrtf(ss), 1e-12f));
            const float g0 = G0[t] + off0, g1 = G1[t] + off1;
            const float e0 = __expf(g0), e1 = __expf(g1), i0 = __expf(-g0), i1 = __expf(-g1);
            const float kt0 = kkn * __expf(g0 - lw0[t]), kt1 = kkn * __expf(g1 - lw1[t]);
            const float rt0 = r * e0, rt1 = r * e1, ks0 = kd0 * i0, ks1 = kd1 * i1, as0 = A0 * kkn * i0, as1 = A1 * kkn * i1;
            const size_t o = (size_t)n * 256 + c;
            const bf16 bkt0 = f2bf(kt0), bkt1 = f2bf(kt1), brt0 = f2bf(rt0), brt1 = f2bf(rt1), bks0 = f2bf(ks0), bks1 = f2bf(ks1), bas0 = f2bf(as0), bas1 = f2bf(as1);
            gb[o] = f2bf(gg[t]);
            if ((tid & 63) == 0) bonus[(size_t)n * 4 + hh_] = bs;
            bf16* s0 = stg + (size_t)((hh_ * 2 + 0) * 4) * 1152 + tau * 72 + j; bf16* s1 = stg + (size_t)((hh_ * 2 + 1) * 4) * 1152 + tau * 72 + j;
            s0[0] = bkt0; s0[1152] = brt0; s0[2 * 1152] = bas0; s0[3 * 1152] = bks0;
            s1[0] = bkt1; s1[1152] = brt1; s1[2 * 1152] = bas1; s1[3 * 1152] = bks1;
            asm volatile("" ::: "memory");
        }
        if (tg == 0) { bf16* reg = WSP(bf16, OFF_REG) + ((size_t)(tile * 4 + hh_) * 2) * 64 + j; reg[0] = f2bf(__expf(tot0)); reg[64] = f2bf(__expf(tot1)); }
        __syncthreads();
        {
            const int wv = F.wv, lane = fresh_tid(F) & 63, x = lane & 15, q = lane >> 4, dd = wv & 1;
            const bf16* base = stg + (size_t)(wv * 4) * 1152;
            f32x4 nt = {0.f, 0.f, 0.f, 0.f}, mkk = nt, mkr = nt, mar = nt;
#pragma unroll
            for (int ks = 0; ks < 2; ++ks) {
                const bf16x8 fk = *reinterpret_cast<const bf16x8*>(base + x * 72 + 32 * ks + 8 * q);
                const bf16x8 fr = *reinterpret_cast<const bf16x8*>(base + 1152 + x * 72 + 32 * ks + 8 * q);
                const bf16x8 fa = *reinterpret_cast<const bf16x8*>(base + 2 * 1152 + x * 72 + 32 * ks + 8 * q);
                const bf16x8 fs = *reinterpret_cast<const bf16x8*>(base + 3 * 1152 + x * 72 + 32 * ks + 8 * q);
                nt = __builtin_amdgcn_mfma_f32_16x16x32_bf16(fk, fa, nt, 0, 0, 0);
                mkk = __builtin_amdgcn_mfma_f32_16x16x32_bf16(fk, fs, mkk, 0, 0, 0);
                mkr = __builtin_amdgcn_mfma_f32_16x16x32_bf16(fr, fs, mkr, 0, 0, 0);
                mar = __builtin_amdgcn_mfma_f32_16x16x32_bf16(fr, fa, mar, 0, 0, 0);
            }
            bf16* yc = WSP(bf16, OFF_YCAT); bf16* side = WSP(bf16, OFF_RSIDE);
            float* ntw = nts + wv * 256;
            auto mat_ptr = [&](int m) -> bf16* { const int sidx = wv * 4 + m;
                return sidx < 28 ? yc + (size_t)(n0 + 1 + (sidx >> 1)) * 1024 + 256 + (sidx & 1) * 256 : side + ((size_t)tile * 4 + (sidx - 28)) * 256; };
            bf16* m0 = mat_ptr(0); bf16* m2 = mat_ptr(2); bf16* m3 = mat_ptr(3);
#pragma unroll
            for (int r = 0; r < 4; ++r) {
                const int t = 4 * q + r; const bool strict = dd ? (x > t) : (x < t), beq = dd ? (x >= t) : (x <= t);
                const int pos = ((x >> 2) * 16 + t) * 4 + (x & 3);
                ntw[t * 16 + x] = strict ? nt[r] : 0.f;
                m0[pos] = f2bf(strict ? mkk[r] : 0.f); m2[pos] = f2bf(beq ? mkr[r] : 0.f); m3[pos] = f2bf(beq ? -mar[r] : 0.f);
            }
            const size_t blk = ((size_t)tile * 4 + (wv >> 1)) * 1024;
            {
                bf16* dk = r7 + (dd ? C_KT1 : C_KT0) * AS + blk; bf16* dr = r7 + (dd ? C_RT1 : C_RT0) * AS + blk;
#pragma unroll
                for (int ks = 0; ks < 2; ++ks) {
                    const uint2 k0 = *reinterpret_cast<const uint2*>(base + x * 72 + 32 * ks + 4 * q), k1 = *reinterpret_cast<const uint2*>(base + x * 72 + 32 * ks + 16 + 4 * q);
                    const uint2 r0 = *reinterpret_cast<const uint2*>(base + 1152 + x * 72 + 32 * ks + 4 * q), r1 = *reinterpret_cast<const uint2*>(base + 1152 + x * 72 + 32 * ks + 16 + 4 * q);
                    *reinterpret_cast<uint4*>(dk + (ks * 64 + lane) * 8) = make_uint4(k0.x, k0.y, k1.x, k1.y);
                    *reinterpret_cast<uint4*>(dr + (ks * 64 + lane) * 8) = make_uint4(r0.x, r0.y, r1.x, r1.y);
                }
            }
            {
                bf16* ds_ = r7 + (dd ? C_KK1 : C_KK0) * AS + blk; bf16* da = r7 + (dd ? C_AT1 : C_AT0) * AS + blk; bf16* dv = r7 + C_VT * AS + blk;
                const bf16* sa = base + 2 * 1152; const bf16* sk = base + 3 * 1152;
                const float* zv = zs + 512 + (wv >> 1) * 64;
#pragma unroll
                for (int u = 0; u < 4; ++u) {
                    const int ch = 16 * u + x;
                    const unsigned a0 = sa[(4 * q) * 72 + ch], a1 = sa[(4 * q + 1) * 72 + ch], a2 = sa[(4 * q + 2) * 72 + ch], a3 = sa[(4 * q + 3) * 72 + ch];
                    const unsigned k0 = sk[(4 * q) * 72 + ch], k1 = sk[(4 * q + 1) * 72 + ch], k2 = sk[(4 * q + 2) * 72 + ch], k3 = sk[(4 * q + 3) * 72 + ch];
                    *reinterpret_cast<uint2*>(ds_ + (u * 64 + lane) * 4) = make_uint2(k0 | (k1 << 16), k2 | (k3 << 16));
                    *reinterpret_cast<uint2*>(da + (u * 64 + lane) * 4) = make_uint2((a0 | (a1 << 16)) ^ 0x80008000u, (a2 | (a3 << 16)) ^ 0x80008000u);
                    if (dd == 0) *reinterpret_cast<uint2*>(dv + (u * 64 + lane) * 4) =
                        make_uint2(pack_bf16(zv[(4 * q) * 960 + ch], zv[(4 * q + 1) * 960 + ch]), pack_bf16(zv[(4 * q + 2) * 960 + ch], zv[(4 * q + 3) * 960 + ch]));
                }
            }
            asm volatile("s_waitcnt lgkmcnt(0)" ::: "memory");
            __builtin_amdgcn_wave_barrier();
            if (lane < 16) {
                float X[16];
                if (dd == 0) {
#pragma unroll
                    for (int t = 0; t < 16; ++t) { float a = (t == lane) ? 1.f : 0.f;
#pragma unroll
                        for (int s2 = 0; s2 < t; ++s2) a -= ntw[t * 16 + s2] * X[s2];
                        X[t] = a; }
                } else {
#pragma unroll
                    for (int t = 15; t >= 0; --t) { float a = (t == lane) ? 1.f : 0.f;
#pragma unroll
                        for (int s2 = t + 1; s2 < 16; ++s2) a -= ntw[t * 16 + s2] * X[s2];
                        X[t] = a; }
                }
                bf16* m1 = mat_ptr(1);
#pragma unroll
                for (int t = 0; t < 16; ++t) m1[((lane >> 2) * 16 + t) * 4 + (lane & 3)] = f2bf(X[t]);
            }
        }
    }
}

DI void scan_rwkv_chunk(const Frame& F, int chain) {
    const int d = chain / (BATCH * 4), b = (chain / 4) % BATCH, h = chain % 4, combo = h * 2 + d;
    const int lane = fresh_tid(F) & 63, q = lane >> 4;
    const size_t AS = (size_t)NTOK * 256;
    bf16* r7 = WSP(bf16, OFF_R7); const bf16* yc = WSP(bf16, OFF_YCAT); const bf16* side = WSP(bf16, OFF_RSIDE); const bf16* reg = WSP(bf16, OFF_REG);
    bf16* akt = r7 + (d ? C_KT1 : C_KT0) * AS; const bf16* art = r7 + (d ? C_RT1 : C_RT0) * AS;
    const bf16* akk = r7 + (d ? C_KK1 : C_KK0) * AS; const bf16* aat = r7 + (d ? C_AT1 : C_AT0) * AS; const bf16* avt = r7 + C_VT * AS;
    f32x4 Z[4][4];
#pragma unroll
    for (int a = 0; a < 4; ++a)
#pragma unroll
        for (int c = 0; c < 4; ++c) Z[a][c] = (f32x4){0.f, 0.f, 0.f, 0.f};
    constexpr int NCH = SEQ / 16;
    const unsigned l8 = (unsigned)lane * 8, l4 = (unsigned)lane * 4, le = (unsigned)(4 * q);
    uint4 nK[2], nR[2]; uint2 nM[4], nV[4];
#define RW_MPTR(tl_, m_) ((combo * 4 + (m_)) < 28 ? yc + (size_t)((tl_) * 16 + 1 + ((combo * 4 + (m_)) >> 1)) * 1024 + 256 + ((combo * 4 + (m_)) & 1) * 256 \
                                                   : side + ((size_t)(tl_) * 4 + (combo * 4 + (m_) - 28)) * 256)
#define RW_LOAD(cc_) do { const int c_ = d ? NCH - 1 - (cc_) : (cc_); const unsigned tl_ = (unsigned)(b * NCH + c_); const size_t bo_ = ((size_t)tl_ * 4 + h) * 1024; \
        nK[0] = *reinterpret_cast<const uint4*>(akt + bo_ + l8); nK[1] = *reinterpret_cast<const uint4*>(akt + bo_ + 512 + l8); \
        nR[0] = *reinterpret_cast<const uint4*>(art + bo_ + l8); nR[1] = *reinterpret_cast<const uint4*>(art + bo_ + 512 + l8); \
        _Pragma("unroll") for (int u_ = 0; u_ < 4; ++u_) { nM[u_] = *reinterpret_cast<const uint2*>(RW_MPTR(tl_, u_) + l4); nV[u_] = *reinterpret_cast<const uint2*>(avt + bo_ + u_ * 256 + l4); } } while (0)
    RW_LOAD(0);
    for (int cc = 0; cc < NCH; ++cc) {
        const int c = d ? NCH - 1 - cc : cc; const unsigned tl = (unsigned)(b * NCH + c); const size_t bo = ((size_t)tl * 4 + h) * 1024;
        uint2 cS[4], cA[4], cE[4];
        { const bf16* eb_ = reg + (size_t)((tl * 4 + h) * 2 + d) * 64;
#pragma unroll
          for (int u = 0; u < 4; ++u) { cS[u] = *reinterpret_cast<const uint2*>(akk + bo + u * 256 + l4); cA[u] = *reinterpret_cast<const uint2*>(aat + bo + u * 256 + l4);
              cE[u] = *reinterpret_cast<const uint2*>(eb_ + le + 16 * u); } }
        union Fr { bf16x8 v; unsigned u[4]; uint4 w; };
        Fr aK0, aK1, aR0, aR1, aMk, aTT, aY;
        aK0.w = nK[0]; aK1.w = nK[1]; aR0.w = nR[0]; aR1.w = nR[1];
        aMk.u[0] = nM[0].x; aMk.u[1] = nM[0].y; aMk.u[2] = 0u; aMk.u[3] = 0u;
        aTT.u[0] = nM[1].x; aTT.u[1] = nM[1].y; aTT.u[2] = 0u; aTT.u[3] = 0u;
        aY.u[0] = nM[2].x; aY.u[1] = nM[2].y; aY.u[2] = nM[3].x; aY.u[3] = nM[3].y;
        uint2 cV[4];
#pragma unroll
        for (int u = 0; u < 4; ++u) cV[u] = nV[u];
        if (cc + 1 < NCH) RW_LOAD(cc + 1);
        float eg[4][4];
#pragma unroll
        for (int u = 0; u < 4; ++u) { eg[u][0] = bflo(cE[u].x); eg[u][1] = bfhi(cE[u].x); eg[u][2] = bflo(cE[u].y); eg[u][3] = bfhi(cE[u].y); }
#pragma unroll
        for (int it = 0; it < 4; ++it) {
            Fr bZ0, bZ1, bV, bB, bVU;
            bZ0.u[0] = pack_bf16(Z[0][it][0], Z[0][it][1]); bZ0.u[1] = pack_bf16(Z[0][it][2], Z[0][it][3]); bZ0.u[2] = pack_bf16(Z[1][it][0], Z[1][it][1]); bZ0.u[3] = pack_bf16(Z[1][it][2], Z[1][it][3]);
            bZ1.u[0] = pack_bf16(Z[2][it][0], Z[2][it][1]); bZ1.u[1] = pack_bf16(Z[2][it][2], Z[2][it][3]); bZ1.u[2] = pack_bf16(Z[3][it][0], Z[3][it][1]); bZ1.u[3] = pack_bf16(Z[3][it][2], Z[3][it][3]);
            const f32x4 zero = {0.f, 0.f, 0.f, 0.f};
            f32x4 P1 = __builtin_amdgcn_mfma_f32_16x16x32_bf16(aK0.v, bZ0.v, zero, 0, 0, 0); P1 = __builtin_amdgcn_mfma_f32_16x16x32_bf16(aK1.v, bZ1.v, P1, 0, 0, 0);
            f32x4 P2 = __builtin_amdgcn_mfma_f32_16x16x32_bf16(aR0.v, bZ0.v, zero, 0, 0, 0); P2 = __builtin_amdgcn_mfma_f32_16x16x32_bf16(aR1.v, bZ1.v, P2, 0, 0, 0);
            bV.u[0] = cV[it].x; bV.u[1] = cV[it].y; bV.u[2] = 0u; bV.u[3] = 0u;
            const f32x4 Bt = __builtin_amdgcn_mfma_f32_16x16x32_bf16(aMk.v, bV.v, P1, 0, 0, 0);
            bB.u[0] = pack_bf16(Bt[0], Bt[1]); bB.u[1] = pack_bf16(Bt[2], Bt[3]); bB.u[2] = 0u; bB.u[3] = 0u;
            const f32x4 Ut = __builtin_amdgcn_mfma_f32_16x16x32_bf16(aTT.v, bB.v, zero, 0, 0, 0);
            bVU.u[0] = cV[it].x; bVU.u[1] = cV[it].y; bVU.u[2] = pack_bf16(Ut[0], Ut[1]); bVU.u[3] = pack_bf16(Ut[2], Ut[3]);
            const f32x4 Y = __builtin_amdgcn_mfma_f32_16x16x32_bf16(aY.v, bVU.v, P2, 0, 0, 0);
            *reinterpret_cast<uint2*>(akt + bo + it * 256 + l4) = make_uint2(pack_bf16(Y[0], Y[1]), pack_bf16(Y[2], Y[3]));
#pragma unroll
            for (int jt = 0; jt < 4; ++jt) {
                Fr aS; aS.u[0] = cS[jt].x; aS.u[1] = cS[jt].y; aS.u[2] = cA[jt].x; aS.u[3] = cA[jt].y;
                f32x4 t = __builtin_amdgcn_mfma_f32_16x16x32_bf16(aS.v, bVU.v, Z[jt][it], 0, 0, 0);
                t[0] *= eg[jt][0]; t[1] *= eg[jt][1]; t[2] *= eg[jt][2]; t[3] *= eg[jt][3];
                Z[jt][it] = t;
            }
        }
    }
#undef RW_LOAD
#undef RW_MPTR
}
#endif

DI void phase_prep(const Frame& F, int l) {
#ifndef CPU_EMU
    prep_attn_gpu(F, l); prep_rwkv_gpu(F, l); prep_hgrn_gpu(F, l);
#else
    {
        bf16* hatt = WSP(bf16, OFF_HATT); bf16* vt = WSP(bf16, OFF_VTATT);
        const float* qn = F.in[5] + l * 64; const float* kn = F.in[6] + l * 64;
        const int nitem = NTOK * 6;
        for (int it = ggrp(F); it < nitem; it += ngrp(F)) {
            const int n = it / 6, hh = it % 6;
            const int s = n % SEQ;
            bf16* p = hatt + (size_t)n * 512 + hh * 64;
            const float* gn = hh < 4 ? qn : kn;
            float v[PER64]; float ss = 0.f;
            for (int i = 0; i < PER64; ++i) { int j = glane(F) + i * GRP; v[i] = bf2f(p[j]); ss += v[i] * v[i]; }
            ss = grp_sum(F, ss); const float rs = 1.0f / sqrtf(ss * (1.0f / 64.0f) + RMS_EPS);
            float o[PER64];
#ifdef CPU_EMU
            float nv[64]; for (int j = 0; j < 64; ++j) nv[j] = v[j] * rs * gn[j];
#endif
            for (int i = 0; i < PER64; ++i) {
                int j = glane(F) + i * GRP;
                const int half = j >> 5, w = j & 31, f = w & 15, second = w >> 4;
                const float pos = half == 0 ? (float)(s / GRIDW) : (float)(s % GRIDW);
                const float ang = pos * rope_inv(2 * f, 32);
                const float cs = cosf(ang), sn = sinf(ang);
                const float mine = v[i] * rs * gn[j];
                const int jp = second ? j - 16 : j + 16;
#ifdef CPU_EMU
                const float partner = nv[jp];
#else
                const float partner = shfl_idx(F, v[0], jp) * rs * gn[jp];
#endif
                o[i] = second ? (partner * sn + mine * cs) : (mine * cs - partner * sn);
            }
            for (int i = 0; i < PER64; ++i) { int j = glane(F) + i * GRP; p[j] = f2bf(o[i]); }
        }
        for (size_t i = gtid_(F); i < (size_t)NTOK * 128; i += gthreads(F)) {
            const int n = (int)(i / 128), c = (int)(i % 128), b = n / SEQ, s = n % SEQ;
            vt[((size_t)b * 128 + c) * SEQ + s] = hatt[(size_t)n * 512 + 384 + c];
        }
    }
    {
        bf16* hm = WSP(bf16, OFF_HMLA); bf16* kr = WSP(bf16, OFF_KROPE);
        const float* qn = F.in[21] + l * 192; const float* kvn = F.in[22] + l * 128;
        for (int it = ggrp(F); it < NTOK * 2; it += ngrp(F)) {
            const int n = it >> 1, which = it & 1;
            bf16* p = hm + (size_t)n * 512 + (which ? 256 : 0);
            const int len = which ? 128 : 192; const float* gn = which ? kvn : qn;
            float ss = 0.f;
            for (int j = glane(F); j < len; j += GRP) { float x = bf2f(p[j]); ss += x * x; }
            ss = grp_sum(F, ss); const float rs = 1.0f / sqrtf(ss / (float)len + RMS_EPS);
            for (int j = glane(F); j < len; j += GRP) p[j] = f2bf(bf2f(p[j]) * rs * gn[j]);
        }
        for (int i = gtid_(F); i < NTOK * 16; i += gthreads(F)) {
            const int n = i >> 4, m = i & 15, s = n % SEQ;
            const bf16* src = hm + (size_t)n * 512 + 192;
            const int i1 = (m < 8 ? m : 16 + (m - 8)), i2 = i1 + 8;
            const float x1 = bf2f(src[i1]), x2 = bf2f(src[i2]);
            const float pos = m < 8 ? (float)(s / GRIDW) : (float)(s % GRIDW);
            const float ang = pos * rope_inv(2 * (m & 7), 16);
            const float cs = cosf(ang), sn = sinf(ang);
            kr[(size_t)n * 32 + 2 * m] = f2bf(x1 * cs - x2 * sn);
            kr[(size_t)n * 32 + 2 * m + 1] = f2bf(x1 * sn + x2 * cs);
        }
    }
#ifdef CPU_EMU
    {
        const bf16* hz = WSP(bf16, OFF_HRWKV); bf16* r7 = WSP(bf16, OFF_R7); bf16* gb = WSP(bf16, OFF_G); float* bonus = WSP(float, OFF_BONUS);
        const float* mup = F.in[7] + l * 960; const float* mun = F.in[8] + l * 960;
        const float* w0 = F.in[9] + l * 512; const float* w2 = F.in[10] + (size_t)l * 2 * 32 * 256;
        const float* a0 = F.in[11] + l * 512; const float* a2 = F.in[12] + (size_t)l * 2 * 32 * 256;
        const float* g2 = F.in[13] + (size_t)l * 64 * 256;
        const float* k_k = F.in[14] + l * 256; const float* k_a = F.in[15] + l * 256; const float* r_k = F.in[16] + l * 256;
        const size_t AS = (size_t)NTOK * 256;
        for (int it = ggrp(F); it < NTOK * 4; it += ngrp(F)) {
            const int n = it >> 2, h = it & 3, s = n % SEQ;
            const bf16* z = hz + (size_t)n * 1024;
            const bool hp = s > 0, hn = s < SEQ - 1;
            auto shifted = [&](int c) -> float {
                const float zc = bf2f(z[c]);
                const float zp = hp ? bf2f(z[c - 1024]) : 0.f, zn = hn ? bf2f(z[c + 1024]) : 0.f;
                return zc + mup[c] * (zp - zc) + mun[c] * (zn - zc);
            };
            float kkv[PER64], rr[PER64], kd0[PER64], kd1[PER64], aa0[PER64], aa1[PER64];
            float ss = 0.f, bs = 0.f;
            for (int i = 0; i < PER64; ++i) {
                const int j = glane(F) + i * GRP, c = h * 64 + j;
                const float r = shifted(c), k = shifted(256 + c), v = shifted(512 + c);
                float wr0 = w0[c], wr1 = w0[256 + c], ar0 = a0[c], ar1 = a0[256 + c], g = 0.f;
                for (int q = 0; q < 32; ++q) {
                    wr0 += tanhf(shifted(768 + q)) * w2[(size_t)q * 256 + c];
                    wr1 += tanhf(shifted(800 + q)) * w2[(size_t)(32 + q) * 256 + c];
                    ar0 += shifted(832 + q) * a2[(size_t)q * 256 + c];
                    ar1 += shifted(864 + q) * a2[(size_t)(32 + q) * 256 + c];
                }
                for (int q = 0; q < 64; ++q) g += sigmoidf_(shifted(896 + q)) * g2[(size_t)q * 256 + c];
                const float dec0 = expf(-DECAY_SCALE * sigmoidf_(wr0)), dec1 = expf(-DECAY_SCALE * sigmoidf_(wr1));
                const float A0 = sigmoidf_(ar0), A1 = sigmoidf_(ar1);
                const float kk = k * k_k[c];
                kkv[i] = kk; ss += kk * kk; rr[i] = r; aa0[i] = A0; aa1[i] = A1;
                kd0[i] = k * (1.0f + (A0 - 1.0f) * k_a[c]); kd1[i] = k * (1.0f + (A1 - 1.0f) * k_a[c]);
                bs += r * (kd0[i] + kd1[i]) * r_k[c];
                const size_t o = (size_t)n * 256 + c;
                r7[R_R * AS + o] = f2bf(r); r7[R_V * AS + o] = f2bf(v);
                r7[R_W0 * AS + o] = f2bf(dec0); r7[R_W1 * AS + o] = f2bf(dec1);
                r7[R_KD0 * AS + o] = f2bf(kd0[i]); r7[R_KD1 * AS + o] = f2bf(kd1[i]);
                gb[o] = f2bf(g);
            }
            ss = grp_sum(F, ss); bs = grp_sum(F, bs);
            const float inv = 1.0f / fmaxf(sqrtf(ss), 1e-12f);
            for (int i = 0; i < PER64; ++i) {
                const int j = glane(F) + i * GRP, c = h * 64 + j; const size_t o = (size_t)n * 256 + c;
                const float kk = kkv[i] * inv;
                r7[R_KK * AS + o] = f2bf(kk); r7[R_AK0 * AS + o] = f2bf(aa0[i] * kk); r7[R_AK1 * AS + o] = f2bf(aa1[i] * kk);
            }
            if (glane(F) == 0) bonus[(size_t)n * 4 + h] = bs;
        }
    }
#else
    prep_rwkv_gpu(F, l);
#endif
    {
        bf16* hh = WSP(bf16, OFF_HHGRN);
        const float* lg = F.in[19];
        for (size_t i = gtid_(F); i < (size_t)NTOK * 768; i += gthreads(F)) {
            const int n = (int)(i / 768), c = (int)(i % 768);
            bf16* p = hh + (size_t)n * 1280 + c;
            const float x = bf2f(*p);
            if (c < 256) { *p = f2bf(siluf_(x)); }
            else {
                const int d = c & 255;
                float lb = 0.f;
                if (l == 1) { const float a = lg[d], b = lg[256 + d]; const float m = fmaxf(a, b); const float ea = expf(a - m), eb = expf(b - m); lb = eb / (ea + eb); }
                *p = f2bf((1.0f - lb) * sigmoidf_(-x));
            }
        }
    }
#endif
}

struct EpiQMla {
    bf16* q; int row0, pn;
    DI void operator()(int r, int c, float a, float b, float cc, float d) const {
        const int row = row0 + r, col = pn * 256 + c;
        if (col >= 384) return;
        const int w = col % 96;
        if (w >= 64) {
            const int s = row % SEQ;
#pragma unroll
            for (int t = 0; t < 2; ++t) {
                const int m = ((w - 64) >> 1) + t;
                const float pos = m < 8 ? (float)(s / GRIDW) : (float)(s % GRIDW);
                const float ang = pos * rope_inv(2 * (m & 7), 16);
                const float cs = cosf(ang), sn = sinf(ang);
                float& x1 = t ? cc : a; float& x2 = t ? d : b;
                const float y1 = x1 * cs - x2 * sn, y2 = x1 * sn + x2 * cs; x1 = y1; x2 = y2;
            }
        }
        st_bf16x4(q + (size_t)row * 384 + col, a, b, cc, d);
    }
};
struct EpiKVMla {
    bf16* kn; bf16* vt; int row0, pn;
    DI void operator()(int r, int c, float a, float b, float cc, float d) const {
        const int row = row0 + r, col = pn * 256 + c, h = col >> 7, w = col & 127;
        if (w < 64) st_bf16x4(kn + (size_t)row * 256 + h * 64 + w, a, b, cc, d);
        else { const int bb = row / SEQ, s = row % SEQ; bf16* p = vt + ((size_t)bb * 256 + h * 64 + (w - 64)) * SEQ + s;
            p[0] = f2bf(a); p[SEQ] = f2bf(b); p[2 * SEQ] = f2bf(cc); p[3 * SEQ] = f2bf(d); }
    }
};
DI void phase_mlaup(const Frame& F) {
    const bf16* hm = WSP(bf16, OFF_HMLA); const char* wts = (const char*)WSP(bf16, OFF_WTS);
    const int nM = (NTOK + 255) / 256;
    for (int u = blockIdx.x; u < nM * 4; u += F.nblk) {
        const int pm = u >> 2, j = u & 3;
#ifdef CPU_EMU
        const int mr = min(256, NTOK - pm * 256);
#define MR , mr
#else
#define MR
#endif
        if (j < 2) { EpiQMla E{WSP(bf16, OFF_QMLA), pm * 256, j};
            gemm_unit(F, hm, 512, nullptr, pm * 256, (const bf16*)(wts + W_UQ_T), 256, j * 256, 256, E MR); }
        else { EpiKVMla E{WSP(bf16, OFF_KNOPE), WSP(bf16, OFF_VTMLA), pm * 256, j - 2};
            gemm_unit(F, hm + 256, 512, nullptr, pm * 256, (const bf16*)(wts + W_UKV_T), 256, (j - 2) * 256, 256, E MR); }
    }
}

struct AttnDesc {
    const bf16* q; int q_stride;
    int q_hstride;
    const bf16* k; int k_stride; int k_hstride;
    const bf16* k2; int k2_stride;
    int dk_main;
    const bf16* vt;
    bf16* o; int o_stride; int o_hstride;
    int H, HKV, SQ, SK;
    float scale;
};

#ifdef CPU_EMU
template <int DK, int DV>
void attn_phase(const Frame& F, const AttnDesc& A) {
    const int G = A.H / A.HKV;
    float* sc = (float*)malloc(sizeof(float) * A.SK);
    for (int b = 0; b < BATCH; ++b) for (int h = 0; h < A.H; ++h) for (int s = 0; s < A.SQ; ++s) {
        const int kv = h / G;
        const bf16* q = A.q + (size_t)(b * A.SQ + s) * A.q_stride + h * A.q_hstride;
        float mx = -1e30f;
        for (int key = 0; key < A.SK; ++key) {
            const bf16* kp = A.k + (size_t)(b * A.SK + key) * A.k_stride + kv * A.k_hstride;
            double acc = 0;
            for (int d = 0; d < DK; ++d) {
                float kvl = d < A.dk_main ? bf2f(kp[d]) : bf2f(A.k2[(size_t)(b * A.SK + key) * A.k2_stride + d - A.dk_main]);
                acc += (double)bf2f(q[d]) * kvl;
            }
            sc[key] = (float)acc * A.scale; mx = fmaxf(mx, sc[key]);
        }
        double sum = 0; for (int key = 0; key < A.SK; ++key) { sc[key] = expf(sc[key] - mx); sum += sc[key]; }
        for (int dv = 0; dv < DV; ++dv) {
            const bf16* vp = A.vt + ((size_t)(b * A.HKV + kv) * DV + dv) * A.SK;
            double acc = 0; for (int key = 0; key < A.SK; ++key) acc += (double)bf2f(f2bf(sc[key])) * bf2f(vp[key]);
            A.o[(size_t)(b * A.SQ + s) * A.o_stride + h * A.o_hstride + dv] = f2bf((float)(acc / sum));
        }
    }
    free(sc);
}
#else
DI int crow16(int reg, int h) { return (reg & 3) + 8 * (reg >> 2) + 4 * h; }
template <int DK, int DV, int DVT, int NQB>
DI void attn_unit(const Frame& F, const AttnDesc& A, int u) {
    constexpr int KP = DK + 8;
    constexpr int VP = 64 + 8;
    constexpr int NPASS = DV / DVT;
    constexpr int UQ = 256 * NQB;
    bf16* Ks = (bf16*)F.smem;
    bf16* Vs = Ks + 64 * KP;
    const int tid = fresh_tid(F), wave = F.wv, lane = tid & 63, r = lane & 31, hh = lane >> 5;
    const int G = A.H / A.HKV;
    const int nqb = A.SQ / UQ;
    const float sl2 = A.scale * 1.4426950408889634f;
    {
        int t = u; const int pass = t % NPASS; t /= NPASS; const int qb = t % nqb; t /= nqb; const int h = t % A.H; const int b = t / A.H;
        const int kv = h / G;
        const int q0 = qb * UQ + wave * 32 * NQB;
        bf16x8 qf[NQB][DK / 16];
#pragma unroll
        for (int qi = 0; qi < NQB; ++qi) { const bf16* qp = A.q + (size_t)(b * A.SQ + q0 + 32 * qi + r) * A.q_stride + h * A.q_hstride + 8 * hh;
#pragma unroll
          for (int ks = 0; ks < DK / 16; ++ks) qf[qi][ks] = *reinterpret_cast<const bf16x8*>(qp + 16 * ks); }
        f32x16 oacc[NQB][DVT / 32];
#pragma unroll
        for (int qi = 0; qi < NQB; ++qi)
#pragma unroll
            for (int i = 0; i < DVT / 32; ++i)
#pragma unroll
                for (int j = 0; j < 16; ++j) oacc[qi][i][j] = 0.f;
        float mrun[NQB], lrun[NQB];
#pragma unroll
        for (int qi = 0; qi < NQB; ++qi) { mrun[qi] = -INFINITY; lrun[qi] = 0.f; }
        constexpr int NKC = (64 * (DK / 8) + 511) / 512, NVC = (DVT * 8 + 511) / 512;
        uint4 kr0, kr1, kr2, kr3, vr0, vr1;
        kr0 = kr1 = kr2 = kr3 = vr0 = vr1 = make_uint4(0u, 0u, 0u, 0u);
#define ATT_FK(kt_, i_, reg_) do { if ((i_) < NKC) { int c_ = tid + (i_) * 512; if (c_ >= 64 * (DK / 8)) c_ = 64 * (DK / 8) - 1; \
            const int key_ = c_ / (DK / 8), d8_ = (c_ % (DK / 8)) * 8; const size_t krow_ = (size_t)(b * A.SK + (kt_) * 64 + key_); \
            const bf16* kp_ = (d8_ < A.dk_main) ? (A.k + krow_ * A.k_stride + kv * A.k_hstride + d8_) : (A.k2 + krow_ * A.k2_stride + (d8_ - A.dk_main)); \
            reg_ = *reinterpret_cast<const uint4*>(kp_); } } while (0)
#define ATT_FV(kt_, i_, reg_) do { if ((i_) < NVC) { int c_ = tid + (i_) * 512; if (c_ >= DVT * 8) c_ = DVT * 8 - 1; \
            const int dv_ = c_ >> 3, k8_ = (c_ & 7) * 8; \
            reg_ = *reinterpret_cast<const uint4*>(A.vt + ((size_t)(b * A.HKV + kv) * DV + pass * DVT + dv_) * A.SK + (kt_) * 64 + k8_); } } while (0)
#define ATT_FETCH(kt_) do { ATT_FK(kt_, 0, kr0); ATT_FK(kt_, 1, kr1); ATT_FK(kt_, 2, kr2); ATT_FK(kt_, 3, kr3); ATT_FV(kt_, 0, vr0); ATT_FV(kt_, 1, vr1); } while (0)
#define ATT_SK(kb_, i_, reg_) do { if ((i_) < NKC) { const int c_ = tid + (i_) * 512; if (c_ < 64 * (DK / 8)) { \
            const int key_ = c_ / (DK / 8), d8_ = (c_ % (DK / 8)) * 8; *reinterpret_cast<uint4*>((kb_) + key_ * KP + d8_) = reg_; } } } while (0)
#define ATT_SV(vb_, i_, reg_) do { if ((i_) < NVC) { const int c_ = tid + (i_) * 512; if (c_ < DVT * 8) { \
            const int dv_ = c_ >> 3, k8_ = (c_ & 7) * 8; *reinterpret_cast<uint4*>((vb_) + dv_ * VP + k8_) = reg_; } } } while (0)
#define ATT_STORE(kb_, vb_) do { ATT_SK(kb_, 0, kr0); ATT_SK(kb_, 1, kr1); ATT_SK(kb_, 2, kr2); ATT_SK(kb_, 3, kr3); ATT_SV(vb_, 0, vr0); ATT_SV(vb_, 1, vr1); } while (0)
        constexpr bool PREF = DK <= 96;
        constexpr int BUFE = 64 * KP + DVT * VP;
        const int ntile = A.SK / 64;
        if (PREF) { ATT_FETCH(0); ATT_STORE(Ks, Vs); if (ntile > 1) ATT_FETCH(1); __syncthreads(); }
        for (int kt = 0; kt < ntile; ++kt) {
            if (PREF) {
                if (kt + 1 < ntile) { bf16* kb = Ks + ((kt + 1) & 1) * BUFE; ATT_STORE(kb, kb + 64 * KP); if (kt + 2 < ntile) ATT_FETCH(kt + 2); }
            } else {
            __syncthreads();
            {
                for (int c = tid; c < 64 * (DK / 8); c += 512) {
                    const int key = c / (DK / 8), d8 = (c % (DK / 8)) * 8;
                    const size_t krow = (size_t)(b * A.SK + kt * 64 + key);
                    uint4 v;
                    if (d8 < A.dk_main) v = *reinterpret_cast<const uint4*>(A.k + krow * A.k_stride + kv * A.k_hstride + d8);
                    else v = *reinterpret_cast<const uint4*>(A.k2 + krow * A.k2_stride + (d8 - A.dk_main));
                    *reinterpret_cast<uint4*>(Ks + key * KP + d8) = v;
                }
                for (int c = tid; c < DVT * 8; c += 512) {
                    const int dv = c >> 3, k8 = (c & 7) * 8;
                    const uint4 v = *reinterpret_cast<const uint4*>(A.vt + ((size_t)(b * A.HKV + kv) * DV + pass * DVT + dv) * A.SK + kt * 64 + k8);
                    *reinterpret_cast<uint4*>(Vs + dv * VP + k8) = v;
                }
            }
            __syncthreads();
            }
            const bf16* Kc = PREF ? Ks + (kt & 1) * BUFE : Ks; const bf16* Vc = Kc + 64 * KP;
            f32x16 sacc[NQB][2];
#pragma unroll
            for (int kb = 0; kb < 2; ++kb) {
#pragma unroll
                for (int qi = 0; qi < NQB; ++qi)
#pragma unroll
                    for (int j = 0; j < 16; ++j) sacc[qi][kb][j] = 0.f;
#pragma unroll
                for (int ks = 0; ks < DK / 16; ++ks) {
                    const bf16x8 kf = *reinterpret_cast<const bf16x8*>(Kc + (kb * 32 + r) * KP + 16 * ks + 8 * hh);
#pragma unroll
                    for (int qi = 0; qi < NQB; ++qi) sacc[qi][kb] = __builtin_amdgcn_mfma_f32_32x32x16_bf16(kf, qf[qi][ks], sacc[qi][kb], 0, 0, 0);
                }
            }
#pragma unroll
            for (int qi = 0; qi < NQB; ++qi) {
                float mx = -INFINITY;
#pragma unroll
                for (int kb = 0; kb < 2; ++kb)
#pragma unroll
                    for (int j = 0; j < 16; ++j) mx = fmaxf(mx, sacc[qi][kb][j]);
                mx = fmaxf(mx, shfl_xor(F, mx, 32));
                const float mnew = fmaxf(mrun[qi], mx * sl2);
                const float alpha = __builtin_amdgcn_exp2f(mrun[qi] - mnew);
                mrun[qi] = mnew;
                float psum = 0.f;
#pragma unroll
                for (int kb = 0; kb < 2; ++kb)
#pragma unroll
                    for (int j = 0; j < 16; ++j) { const float p = __builtin_amdgcn_exp2f(sacc[qi][kb][j] * sl2 - mnew); sacc[qi][kb][j] = p; psum += p; }
                lrun[qi] = lrun[qi] * alpha + psum;
                if (!PREF || __ballot(alpha != 1.0f)) {
#pragma unroll
                    for (int i = 0; i < DVT / 32; ++i)
#pragma unroll
                        for (int j = 0; j < 16; ++j) oacc[qi][i][j] *= alpha;
                }
            }
#pragma unroll
            for (int kb = 0; kb < 2; ++kb)
#pragma unroll
                for (int s2 = 0; s2 < 2; ++s2) {
                    union PF { bf16x8 v; unsigned u[4]; };
                    PF pf[NQB];
#pragma unroll
                    for (int qi = 0; qi < NQB; ++qi)
#pragma unroll
                        for (int j = 0; j < 4; ++j) pf[qi].u[j] = pack_bf16(sacc[qi][kb][8 * s2 + 2 * j], sacc[qi][kb][8 * s2 + 2 * j + 1]);
#pragma unroll
                    for (int i = 0; i < DVT / 32; ++i) {
                        const bf16* vp = Vc + (i * 32 + r) * VP + kb * 32 + 16 * s2 + 4 * hh;
                        union { bf16x8 v; bf16x4 h2[2]; } vf;
                        vf.h2[0] = *reinterpret_cast<const bf16x4*>(vp);
                        vf.h2[1] = *reinterpret_cast<const bf16x4*>(vp + 8);
#pragma unroll
                        for (int qi = 0; qi < NQB; ++qi) oacc[qi][i] = __builtin_amdgcn_mfma_f32_32x32x16_bf16(vf.v, pf[qi].v, oacc[qi][i], 0, 0, 0);
                    }
                }
            if (PREF) __syncthreads();
        }
#pragma unroll
        for (int qi = 0; qi < NQB; ++qi) {
            const float lsum = lrun[qi] + shfl_xor(F, lrun[qi], 32);
            const float inv = 1.0f / lsum;
            bf16* op = A.o + (size_t)(b * A.SQ + q0 + 32 * qi + r) * A.o_stride + h * A.o_hstride + pass * DVT;
#pragma unroll
            for (int i = 0; i < DVT / 32; ++i)
#pragma unroll
                for (int g = 0; g < 4; ++g)
                    st_bf16x4(op + i * 32 + 8 * g + 4 * hh, oacc[qi][i][4 * g] * inv, oacc[qi][i][4 * g + 1] * inv, oacc[qi][i][4 * g + 2] * inv, oacc[qi][i][4 * g + 3] * inv);
        }
    }
}
#endif

#undef ATT_FETCH
#undef ATT_STORE
#undef ATT_FK
#undef ATT_FV
#undef ATT_SK
#undef ATT_SV
#ifndef CPU_EMU
template <int DK, int DV, int DVT, int NQB>
DI int attn_nunit(const AttnDesc& A) { return BATCH * A.H * (A.SQ / (256 * NQB)) * (DV / DVT); }
template <int DK, int DV, int DVT, int NQB>
DI void attn_phase(const Frame& F, const AttnDesc& A) {
    const int nunit = attn_nunit<DK, DV, DVT, NQB>(A);
    for (int u = blockIdx.x; u < nunit; u += F.nblk) attn_unit<DK, DV, DVT, NQB>(F, A, u);
}
#endif
DI AttnDesc desc_gqa(const Frame& F) {
    AttnDesc A; A.q = WSP(bf16, OFF_HATT); A.q_stride = 512; A.q_hstride = 64;
    A.k = WSP(bf16, OFF_HATT) + 256; A.k_stride = 512; A.k_hstride = 64; A.k2 = nullptr; A.k2_stride = 0; A.dk_main = 64;
    A.vt = WSP(bf16, OFF_VTATT); A.o = WSP(bf16, OFF_YCAT); A.o_stride = 1024; A.o_hstride = 64;
    A.H = 4; A.HKV = 2; A.SQ = SEQ; A.SK = SEQ; A.scale = 0.125f; return A;
}
DI AttnDesc desc_mla(const Frame& F) {
    AttnDesc A; A.q = WSP(bf16, OFF_QMLA); A.q_stride = 384; A.q_hstride = 96;
    A.k = WSP(bf16, OFF_KNOPE); A.k_stride = 256; A.k_hstride = 64; A.k2 = WSP(bf16, OFF_KROPE); A.k2_stride = 32; A.dk_main = 64;
    A.vt = WSP(bf16, OFF_VTMLA); A.o = WSP(bf16, OFF_YCAT) + 768; A.o_stride = 1024; A.o_hstride = 64;
    A.H = 4; A.HKV = 4; A.SQ = SEQ; A.SK = SEQ; A.scale = 0.10206207261596575f; return A;
}
DI AttnDesc desc_mem(const Frame& F) {
    AttnDesc A; A.q = WSP(bf16, OFF_QMEM); A.q_stride = 1024; A.q_hstride = 256;
    A.k = WSP(bf16, OFF_KMEM); A.k_stride = 1024; A.k_hstride = 256; A.k2 = nullptr; A.k2_stride = 0; A.dk_main = 256;
    A.vt = WSP(bf16, OFF_VTMEM); A.o = WSP(bf16, OFF_OMEM); A.o_stride = 1024; A.o_hstride = 256;
    A.H = 4; A.HKV = 4; A.SQ = SEQ; A.SK = MEMT; A.scale = 0.0625f; return A;
}

#ifndef CPU_EMU
typedef float f32p __attribute__((ext_vector_type(2)));
DI f32p allsum16p(f32p x) { x.x = allsum16(x.x); x.y = allsum16(x.y); return x; }
template <int KIND>
DI void scan_chain(const Frame& F, int chain) {
    constexpr int T = 32;
    constexpr int NARR = KIND == 0 ? 6 : 3;
    constexpr int STEPB = NARR * 256;
    constexpr int NPIECE = T * NARR * 8;
    constexpr int PPT = (NPIECE + NTH - 1) / NTH;
    const int d = chain / (BATCH * 4), b = (chain / 4) % BATCH, h = chain % 4;
    const int tid = F.tid, wave = tid >> 6, lane = tid & 63, rg = lane >> 4, cg = lane & 15;
    unsigned char* buf0 = F.smem; unsigned char* buf1 = F.smem + T * STEPB;
    unsigned char* ybuf = F.smem + 2 * T * STEPB;
    const size_t AS = (size_t)NTOK * 256;
    bf16* r7 = WSP(bf16, OFF_R7); bf16* hh = WSP(bf16, OFF_HHGRN);
#define PIECE_PTR(t0, p_) ([&]() -> const uint4* { const int pc = (p_) < NPIECE ? (p_) : NPIECE - 1; \
        const int st = pc / (NARR * 8), rem = pc % (NARR * 8), arr = rem >> 3, part = rem & 7; \
        const int tt = (t0) + st, ss = d ? SEQ - 1 - tt : tt; const size_t nn = (size_t)b * SEQ + ss; \
        const bf16* base; \
        if (KIND == 0) { const int aid = arr == 0 ? R_KK : arr == 1 ? (d ? R_W1 : R_W0) : arr == 2 ? (d ? R_AK1 : R_AK0) : arr == 3 ? (d ? R_KD1 : R_KD0) : arr == 4 ? R_R : R_V; \
            base = r7 + aid * AS + nn * 256 + h * 64; } \
        else { const int off = arr == 0 ? 256 + d * 256 : arr == 1 ? 0 : 768; base = hh + nn * 1280 + off + h * 64; } \
        return reinterpret_cast<const uint4*>(base + part * 8); }())
#define PUT_PIECE(dst, p_, v_) do { float4 a_, b_; a_.x = bflo((v_).x); a_.y = bfhi((v_).x); a_.z = bflo((v_).y); a_.w = bfhi((v_).y); \
        b_.x = bflo((v_).z); b_.y = bfhi((v_).z); b_.z = bflo((v_).w); b_.w = bfhi((v_).w); \
        *reinterpret_cast<float4*>((dst) + (p_) * 32) = a_; *reinterpret_cast<float4*>((dst) + (p_) * 32 + 16) = b_; } while (0)
#define STORE_PRE(dst) do { PUT_PIECE(dst, tid, pre0); \
        if (tid + NTH < NPIECE) PUT_PIECE(dst, tid + NTH, pre1); \
        if (PPT > 2 && tid + 2 * NTH < NPIECE) PUT_PIECE(dst, tid + 2 * NTH, pre2); } while (0)
    uint4 pre0, pre1, pre2;
    pre0 = *PIECE_PTR(0, tid); pre1 = *PIECE_PTR(0, tid + NTH); pre2 = pre1;
    if (PPT > 2) pre2 = *PIECE_PTR(0, tid + 2 * NTH);
    __syncthreads();
    STORE_PRE(buf0);
    __syncthreads();
    f32p P[4];
#pragma unroll
    for (int c = 0; c < 4; ++c) P[c] = (f32p){0.f, 0.f};
    const int vofs = (wave * 8 + rg * 2) * 4;
    for (int ch = 0; ch < SEQ / T; ++ch) {
        const unsigned char* cur = (ch & 1) ? buf1 : buf0;
        if (ch + 1 < SEQ / T) {
            pre0 = *PIECE_PTR((ch + 1) * T, tid); pre1 = *PIECE_PTR((ch + 1) * T, tid + NTH);
            if (PPT > 2) pre2 = *PIECE_PTR((ch + 1) * T, tid + 2 * NTH);
        }
        float4 o0, o1, o2, o3, o4; f32p ov;
        { const unsigned char* sb = cur;
          o0 = *reinterpret_cast<const float4*>(sb + 0 * 256 + cg * 16); o1 = *reinterpret_cast<const float4*>(sb + 1 * 256 + cg * 16);
          if (KIND == 0) { o2 = *reinterpret_cast<const float4*>(sb + 2 * 256 + cg * 16); o3 = *reinterpret_cast<const float4*>(sb + 3 * 256 + cg * 16); o4 = *reinterpret_cast<const float4*>(sb + 4 * 256 + cg * 16); }
          ov = *reinterpret_cast<const f32p*>(sb + (NARR - 1) * 256 + vofs); }
        unsigned ykeep = 0u;
#pragma unroll 2
        for (int t = 0; t < T; ++t) {
            const float4 c0 = o0, c1 = o1, c2 = o2, c3 = o3, c4 = o4; const f32p v = ov;
            { const unsigned char* sb = cur + ((t + 1) & (T - 1)) * STEPB;
              o0 = *reinterpret_cast<const float4*>(sb + 0 * 256 + cg * 16); o1 = *reinterpret_cast<const float4*>(sb + 1 * 256 + cg * 16);
              if (KIND == 0) { o2 = *reinterpret_cast<const float4*>(sb + 2 * 256 + cg * 16); o3 = *reinterpret_cast<const float4*>(sb + 3 * 256 + cg * 16); o4 = *reinterpret_cast<const float4*>(sb + 4 * 256 + cg * 16); }
              ov = *reinterpret_cast<const f32p*>(sb + (NARR - 1) * 256 + vofs); }
            f32p y;
            if (KIND == 0) {
                f32p sa = P[0] * c0.x + P[1] * c0.y + P[2] * c0.z + P[3] * c0.w;
                sa = allsum16p(sa);
                P[0] = P[0] * c1.x - sa * c2.x + v * c3.x;
                P[1] = P[1] * c1.y - sa * c2.y + v * c3.y;
                P[2] = P[2] * c1.z - sa * c2.z + v * c3.z;
                P[3] = P[3] * c1.w - sa * c2.w + v * c3.w;
                y = P[0] * c4.x + P[1] * c4.y + P[2] * c4.z + P[3] * c4.w;
            } else {
                P[0] += (v - P[0]) * c0.x; P[1] += (v - P[1]) * c0.y; P[2] += (v - P[2]) * c0.z; P[3] += (v - P[3]) * c0.w;
                y = P[0] * c1.x + P[1] * c1.y + P[2] * c1.z + P[3] * c1.w;
            }
            y = allsum16p(y);
            const unsigned yp = pack_bf16(y.x, y.y);
            ykeep = ((t & 15) == cg) ? yp : ykeep;
            if ((t & 15) == 15) *reinterpret_cast<unsigned*>(ybuf + ((t & ~15) + cg) * 128 + (wave * 8 + rg * 2) * 2) = ykeep;
        }
        asm volatile("s_waitcnt lgkmcnt(0)" ::: "memory");
        __builtin_amdgcn_wave_barrier();
        if (lane < T) {
            const int t = ch * T + lane, s = d ? SEQ - 1 - t : t; const size_t n = (size_t)b * SEQ + s;
            const uint4 yv = *reinterpret_cast<const uint4*>(ybuf + lane * 128 + wave * 16);
            bf16* dst = KIND == 0 ? r7 + (d ? R_W1 : R_W0) * AS + n * 256 + h * 64 + wave * 8 : hh + n * 1280 + 256 + d * 256 + h * 64 + wave * 8;
            *reinterpret_cast<uint4*>(dst) = yv;
        }
        if (ch + 1 < SEQ / T) {
            unsigned char* nxt = (ch & 1) ? buf0 : buf1;
            STORE_PRE(nxt);
        }
        __syncthreads();
    }
#undef PIECE_PTR
#undef STORE_PRE
#undef PUT_PIECE
}
DI void phase_scans(const Frame& F) {
    const int nchain = 2 * BATCH * 4;
    for (int g = blockIdx.x; g < nchain / 2; g += F.nblk) {
        if (F.wv < 2) scan_rwkv_chunk(F, g * 2 + F.wv); else if (F.wv < 4) scan_hgrn_chunk(F, g * 2 + F.wv - 2);
    }
}
#else
DI void phase_scans(const Frame& F) {
    bf16* r7 = WSP(bf16, OFF_R7); const size_t AS = (size_t)NTOK * 256;
    bf16* hh = WSP(bf16, OFF_HHGRN);
    const int nitem = 2 * BATCH * 4 * 64 * 2;
    for (int it = wave_item_index(F); it < nitem; it += gthreads(F)) {
        const int kind = it / (2 * BATCH * 4 * 64);
        int c = (it % (2 * BATCH * 4 * 64)) / 64; const int i = it % 64;
        const int d = c / (BATCH * 4); c %= BATCH * 4; const int b = c / 4, h = c % 4;
        float S[64];
#pragma unroll
        for (int j = 0; j < 64; ++j) S[j] = 0.f;
        if (kind == 0) {
            const bf16* pr = r7 + R_R * AS, *pv = r7 + R_V * AS, *pkk = r7 + R_KK * AS;
            bf16* pw = r7 + (d ? R_W1 : R_W0) * AS; const bf16* pkd = r7 + (d ? R_KD1 : R_KD0) * AS, *pak = r7 + (d ? R_AK1 : R_AK0) * AS;
            for (int t = 0; t < SEQ; ++t) {
                const int s = d ? SEQ - 1 - t : t;
                const size_t o = ((size_t)(b * SEQ + s)) * 256 + h * 64;
                const float v = bf2f(pv[o + i]);
                float sa = 0.f;
#pragma unroll
                for (int j = 0; j < 64; ++j) sa += S[j] * bf2f(pkk[o + j]);
                float y = 0.f;
#pragma unroll
                for (int j = 0; j < 64; ++j) {
                    S[j] = S[j] * bf2f(pw[o + j]) - sa * bf2f(pak[o + j]) + v * bf2f(pkd[o + j]);
                    y += S[j] * bf2f(pr[o + j]);
                }
#ifndef CPU_EMU
                __builtin_amdgcn_wave_barrier();
#endif
#ifdef CPU_EMU
                WSP(bf16, OFF_EMU_SCAN)[(size_t)d * AS + (size_t)(b * SEQ + s) * 256 + h * 64 + i] = f2bf(y);
#else
                pw[o + i] = f2bf(y);
#endif
            }
        } else {
            const bf16* pq = hh; bf16* pk = hh + 256 + d * 256; const bf16* pi = hh + 768;
            for (int t = 0; t < SEQ; ++t) {
                const int s = d ? SEQ - 1 - t : t;
                const size_t o = ((size_t)(b * SEQ + s)) * 1280 + h * 64;
                const float v = bf2f(pi[o + i]);
                float acc = 0.f;
#pragma unroll
                for (int j = 0; j < 64; ++j) {
                    const float k = bf2f(pk[o + j]);
                    S[j] = S[j] + k * (v - S[j]);
                    acc += S[j] * bf2f(pq[o + j]);
                }
#ifndef CPU_EMU
                __builtin_amdgcn_wave_barrier();
#endif
#ifdef CPU_EMU
                WSP(bf16, OFF_EMU_SCAN)[(size_t)(2 + d) * AS + (size_t)(b * SEQ + s) * 256 + h * 64 + i] = f2bf(acc);
#else
                pk[o + i] = f2bf(acc);
#endif
            }
        }
    }
}

#endif

#ifndef CPU_EMU
DI void phase_fin_gpu(const Frame& F, int l) {
    const bf16* r7 = WSP(bf16, OFF_R7); const size_t AS = (size_t)NTOK * 256;
    const bf16* gb = WSP(bf16, OFF_G); const float* bonus = WSP(float, OFF_BONUS);
    const bf16* hh = WSP(bf16, OFF_HHGRN); bf16* ycat = WSP(bf16, OFF_YCAT);
    float* par = (float*)F.smem;
    __syncthreads();
    for (int i = F.tid; i < 768; i += NTH) par[i] = i < 256 ? F.in[17][l * 256 + i] : i < 512 ? F.in[18][l * 256 + i - 256] : F.in[20][l * 256 + i - 512];
    __syncthreads();
    {
        for (int item = blockIdx.x * 8 + F.wv; item < (NTOK / 16) * 4; item += F.nblk * 8) {
            const int lane = fresh_tid(F) & 63, x = lane & 15, q = lane >> 4;
            const int h = item & 3; const size_t n0 = (size_t)(item >> 2) * 16, blk = (size_t)item * 1024;
            const bf16* y0 = r7 + C_KT0 * AS + blk; const bf16* y1 = r7 + C_KT1 * AS + blk; const bf16* vt = r7 + C_VT * AS + blk;
            float y[4][4], v[4][4];
#pragma unroll
            for (int u = 0; u < 4; ++u) {
                const uint2 a = *reinterpret_cast<const uint2*>(y0 + (u * 64 + lane) * 4), b = *reinterpret_cast<const uint2*>(y1 + (u * 64 + lane) * 4), c = *reinterpret_cast<const uint2*>(vt + (u * 64 + lane) * 4);
                y[u][0] = bflo(a.x) + bflo(b.x); y[u][1] = bfhi(a.x) + bfhi(b.x); y[u][2] = bflo(a.y) + bflo(b.y); y[u][3] = bfhi(a.y) + bfhi(b.y);
                v[u][0] = bflo(c.x); v[u][1] = bfhi(c.x); v[u][2] = bflo(c.y); v[u][3] = bfhi(c.y);
            }
#pragma unroll
            for (int r = 0; r < 4; ++r) {
                const size_t n = n0 + 4 * q + r;
                const float mu = allsum16((y[0][r] + y[1][r]) + (y[2][r] + y[3][r])) * (1.0f / 64.0f);
                const float d0 = y[0][r] - mu, d1 = y[1][r] - mu, d2 = y[2][r] - mu, d3 = y[3][r] - mu;
                const float rs = 1.0f / sqrtf(allsum16((d0 * d0 + d1 * d1) + (d2 * d2 + d3 * d3)) * (1.0f / 64.0f) + GN_EPS);
                const float bo = bonus[n * 4 + h];
                const float dv[4] = {d0, d1, d2, d3};
#pragma unroll
                for (int u = 0; u < 4; ++u) {
                    const int c = h * 64 + 16 * u + x;
                    ycat[n * 1024 + 256 + c] = f2bf((dv[u] * rs * par[c] + par[256 + c] + bo * v[u][r]) * bf2f(gb[n * 256 + c]));
                }
            }
        }
    }
    for (int it = blockIdx.x * NTH + fresh_tid(F); it < NTOK * 4; it += gthreads(F)) {
        const int n = it >> 2, h = it & 3;
        const uint4* pa = reinterpret_cast<const uint4*>(hh + (size_t)n * 1280 + 256 + h * 64); const uint4* pb = reinterpret_cast<const uint4*>(hh + (size_t)n * 1280 + 512 + h * 64);
        float s2 = 0.f;
#pragma unroll
        for (int i = 0; i < 8; ++i) { const uint4 a = pa[i], b = pb[i];
            const float y0 = bflo(a.x) + bflo(b.x), y1 = bfhi(a.x) + bfhi(b.x), y2 = bflo(a.y) + bflo(b.y), y3 = bfhi(a.y) + bfhi(b.y);
            const float y4 = bflo(a.z) + bflo(b.z), y5 = bfhi(a.z) + bfhi(b.z), y6 = bflo(a.w) + bflo(b.w), y7 = bfhi(a.w) + bfhi(b.w);
            s2 += (y0 * y0 + y1 * y1) + (y2 * y2 + y3 * y3) + (y4 * y4 + y5 * y5) + (y6 * y6 + y7 * y7); }
        const float rs = 1.0f / sqrtf(s2 * (1.0f / 64.0f) + RMS_EPS);
        uint4* po = reinterpret_cast<uint4*>(ycat + (size_t)n * 1024 + 512 + h * 64);
        const uint4* pg = reinterpret_cast<const uint4*>(hh + (size_t)n * 1280 + 1024 + h * 64);
        const float* gg = par + 512 + h * 64;
#pragma unroll 2
        for (int i = 0; i < 8; ++i) { const uint4 a = pa[i], b = pb[i], g4 = pg[i];
            const float yv[8] = {bflo(a.x) + bflo(b.x), bfhi(a.x) + bfhi(b.x), bflo(a.y) + bflo(b.y), bfhi(a.y) + bfhi(b.y), bflo(a.z) + bflo(b.z), bfhi(a.z) + bfhi(b.z), bflo(a.w) + bflo(b.w), bfhi(a.w) + bfhi(b.w)};
            const float gf[8] = {bflo(g4.x), bfhi(g4.x), bflo(g4.y), bfhi(g4.y), bflo(g4.z), bfhi(g4.z), bflo(g4.w), bfhi(g4.w)};
            float o[8];
#pragma unroll
            for (int j = 0; j < 8; ++j) o[j] = yv[j] * rs * gg[8 * i + j] * (gf[j] * fast_sigmoid(gf[j]));
            po[i] = make_uint4(pack_bf16(o[0], o[1]), pack_bf16(o[2], o[3]), pack_bf16(o[4], o[5]), pack_bf16(o[6], o[7])); }
    }
}
#endif
DI void phase_fin(const Frame& F, int l) {
    const bf16* r7 = WSP(bf16, OFF_R7); const size_t AS = (size_t)NTOK * 256;
    const bf16* gb = WSP(bf16, OFF_G); const float* bonus = WSP(float, OFF_BONUS);
    const bf16* hh = WSP(bf16, OFF_HHGRN); bf16* ycat = WSP(bf16, OFF_YCAT);
    const float* gng = F.in[17] + l * 256; const float* gnb = F.in[18] + l * 256; const float* hng = F.in[20] + l * 256;
    for (int it = ggrp(F); it < NTOK * 8; it += ngrp(F)) {
        const int n = it >> 3, kind = (it >> 2) & 1, h = it & 3;
        float v[PER64];
        if (kind == 0) {
            float s1 = 0.f;
            for (int i = 0; i < PER64; ++i) { const int c = h * 64 + glane(F) + i * GRP; const size_t o = (size_t)n * 256 + c;
#ifdef CPU_EMU
                v[i] = bf2f(WSP(bf16, OFF_EMU_SCAN)[o]) + bf2f(WSP(bf16, OFF_EMU_SCAN)[AS + o]); s1 += v[i]; }
#else
                v[i] = bf2f(r7[R_W0 * AS + o]) + bf2f(r7[R_W1 * AS + o]); s1 += v[i]; }
#endif
            s1 = grp_sum(F, s1); const float mu = s1 * (1.0f / 64.0f);
            float s2 = 0.f; for (int i = 0; i < PER64; ++i) { const float dd = v[i] - mu; s2 += dd * dd; }
            s2 = grp_sum(F, s2); const float rs = 1.0f / sqrtf(s2 * (1.0f / 64.0f) + GN_EPS);
            const float bo = bonus[(size_t)n * 4 + h];
            for (int i = 0; i < PER64; ++i) { const int c = h * 64 + glane(F) + i * GRP; const size_t o = (size_t)n * 256 + c;
                const float y = (v[i] - mu) * rs * gng[c] + gnb[c];
                ycat[(size_t)n * 1024 + 256 + c] = f2bf((y + bo * bf2f(r7[R_V * AS + o])) * bf2f(gb[o])); }
        } else {
            float s2 = 0.f;
            for (int i = 0; i < PER64; ++i) { const int c = h * 64 + glane(F) + i * GRP; const size_t o = (size_t)n * 1280 + c;
#ifdef CPU_EMU
                const size_t oe = (size_t)n * 256 + c;
                v[i] = bf2f(WSP(bf16, OFF_EMU_SCAN)[2 * AS + oe]) + bf2f(WSP(bf16, OFF_EMU_SCAN)[3 * AS + oe]); s2 += v[i] * v[i]; }
#else
                v[i] = bf2f(hh[o + 256]) + bf2f(hh[o + 512]); s2 += v[i] * v[i]; }
#endif
            s2 = grp_sum(F, s2); const float rs = 1.0f / sqrtf(s2 * (1.0f / 64.0f) + RMS_EPS);
            for (int i = 0; i < PER64; ++i) { const int c = h * 64 + glane(F) + i * GRP; const size_t o = (size_t)n * 1280 + c;
                ycat[(size_t)n * 1024 + 512 + c] = f2bf(v[i] * rs * hng[c] * siluf_(bf2f(hh[o + 1024]))); }
        }
    }
}

struct EpiResid {
    float* xf; int row0, pn;
    DI void operator()(int r, int c, float a, float b, float cc, float d) const {
        float* p = xf + (size_t)(row0 + r) * DM + pn * 256 + c;
#ifndef CPU_EMU
        float4 x = *reinterpret_cast<float4*>(p);
        x.x = DN_ALPHA * x.x + a; x.y = DN_ALPHA * x.y + b; x.z = DN_ALPHA * x.z + cc; x.w = DN_ALPHA * x.w + d;
        *reinterpret_cast<float4*>(p) = x;
#else
        p[0] = DN_ALPHA * p[0] + a; p[1] = DN_ALPHA * p[1] + b; p[2] = DN_ALPHA * p[2] + cc; p[3] = DN_ALPHA * p[3] + d;
#endif
    }
};
struct EpiBf {
    bf16* o; int ld; int row0, pn;
    DI void operator()(int r, int c, float a, float b, float cc, float d) const { st_bf16x4(o + (size_t)(row0 + r) * ld + pn * 256 + c, a, b, cc, d); }
};
template <int MODE>
DI void phase_gemm_sq(const Frame& F, const bf16* A, size_t woff, bf16* outb) {
    const bf16* W = (const bf16*)((const char*)WSP(bf16, OFF_WTS) + woff);
    const int nM = (NTOK + 255) / 256;
    for (int u = blockIdx.x; u < nM * 4; u += F.nblk) {
        const int pm = u >> 2, pn = u & 3;
#ifdef CPU_EMU
        const int mr = min(256, NTOK - pm * 256);
#endif
        if (MODE == 0) { EpiResid E{F.xf, pm * 256, pn}; gemm_unit(F, A, 1024, nullptr, pm * 256, W, 1024, pn * 256, 1024, E MR); }
        else { EpiBf E{outb, 1024, pm * 256, pn}; gemm_unit(F, A, 1024, nullptr, pm * 256, W, 1024, pn * 256, 1024, E MR); }
    }
}

template <bool BLOCKED = false>
DI void phase_ln(const Frame& F, const float* g, const float* b) {
#ifdef CPU_EMU
    const float* xf = F.xf;
    layer_norm_rows(F, g, b, [&](int row, int c) { return xf[(size_t)row * DM + c]; }, false, nullptr);
#else
    ln_rows_gpu<0, BLOCKED>(F, g, b, 0);
#endif
}

#ifndef CPU_EMU
DI void phase_route_gpu(const Frame& F, int l) {
    const float* xf = F.xf; const float* gt = (const float*)((const char*)WSP(bf16, OFF_WTS) + W_GATE_T) + (size_t)l * 48 * 1024;
    const float* bg = F.in[34] + l * 4; const float* be = F.in[36] + l * 32;
    int* counts = (int*)(F.ws + CTL_CNT) + l * 32;
    int* lists = WSP(int, OFF_LISTS); float* tinfo = WSP(float, OFF_TINFO);
    const int tid = F.tid, wave = tid >> 6, lane = tid & 63, rr = lane & 15, kq = lane >> 4;
    float* lg = (float*)F.smem + wave * (16 * 48);
    const bool blk_ok = (NTOK % (F.nblk * 32) == 0);
    const int rpb = NTOK / F.nblk;
    int* hcnt = (int*)(F.smem + 32768); int* hbase = hcnt + 32;
    __syncthreads();
    const int rt_first = blk_ok ? 0 : blockIdx.x * 8, rt_lim = blk_ok ? rpb / 16 : NTOK / 16, rt_step = blk_ok ? 8 : F.nblk * 8;
    for (int rtb = rt_first; rtb < rt_lim; rtb += rt_step) {
        const int rt = rtb + wave; const bool live = rt < rt_lim;
        if (tid < 32) hcnt[tid] = 0;
        __syncthreads();
        int ea = 0, eb = 0, pa = 0, pb = 0, row = 0; float g0 = 0.f, g1 = 0.f;
        if (live) {
        const int r0 = blk_ok ? blockIdx.x * rpb + rt * 16 : rt * 16;
        f32x4 acc0 = {0.f, 0.f, 0.f, 0.f}, acc1 = acc0, acc2 = acc0;
        const float* xa = xf + (size_t)(r0 + rr) * DM + 4 * kq;
        const float* wb = gt + (size_t)rr * 1024 + 4 * kq;
#pragma unroll 1
        for (int kb = 0; kb < 1024; kb += 64) {
            float4 a[4], b0[4], b1[4], b2[4];
#pragma unroll
            for (int u = 0; u < 4; ++u) { const int k0 = kb + 16 * u;
                a[u] = *reinterpret_cast<const float4*>(xa + k0); b0[u] = *reinterpret_cast<const float4*>(wb + k0);
                b1[u] = *reinterpret_cast<const float4*>(wb + 16 * 1024 + k0); b2[u] = *reinterpret_cast<const float4*>(wb + 32 * 1024 + k0); }
#pragma unroll
            for (int u = 0; u < 4; ++u) {
                acc0 = __builtin_amdgcn_mfma_f32_16x16x4f32(a[u].x, b0[u].x, acc0, 0, 0, 0); acc1 = __builtin_amdgcn_mfma_f32_16x16x4f32(a[u].x, b1[u].x, acc1, 0, 0, 0); acc2 = __builtin_amdgcn_mfma_f32_16x16x4f32(a[u].x, b2[u].x, acc2, 0, 0, 0);
                acc0 = __builtin_amdgcn_mfma_f32_16x16x4f32(a[u].y, b0[u].y, acc0, 0, 0, 0); acc1 = __builtin_amdgcn_mfma_f32_16x16x4f32(a[u].y, b1[u].y, acc1, 0, 0, 0); acc2 = __builtin_amdgcn_mfma_f32_16x16x4f32(a[u].y, b2[u].y, acc2, 0, 0, 0);
                acc0 = __builtin_amdgcn_mfma_f32_16x16x4f32(a[u].z, b0[u].z, acc0, 0, 0, 0); acc1 = __builtin_amdgcn_mfma_f32_16x16x4f32(a[u].z, b1[u].z, acc1, 0, 0, 0); acc2 = __builtin_amdgcn_mfma_f32_16x16x4f32(a[u].z, b2[u].z, acc2, 0, 0, 0);
                acc0 = __builtin_amdgcn_mfma_f32_16x16x4f32(a[u].w, b0[u].w, acc0, 0, 0, 0); acc1 = __builtin_amdgcn_mfma_f32_16x16x4f32(a[u].w, b1[u].w, acc1, 0, 0, 0); acc2 = __builtin_amdgcn_mfma_f32_16x16x4f32(a[u].w, b2[u].w, acc2, 0, 0, 0);
            }
        }
#pragma unroll
        for (int r = 0; r < 4; ++r) { lg[(4 * kq + r) * 48 + rr] = acc0[r]; lg[(4 * kq + r) * 48 + 16 + rr] = acc1[r]; lg[(4 * kq + r) * 48 + 32 + rr] = acc2[r]; }
        asm volatile("s_waitcnt lgkmcnt(0)" ::: "memory");
        __builtin_amdgcn_wave_barrier();
        if (lane < 16) {
            row = r0 + lane; const float* L = lg + lane * 48;
            float gl[4];
#pragma unroll
            for (int q = 0; q < 4; ++q) gl[q] = L[q] + bg[q];
            int gi = 0; float gm = gl[0];
#pragma unroll
            for (int q = 1; q < 4; ++q) if (gl[q] > gm) { gm = gl[q]; gi = q; }
            float den = 0.f;
#pragma unroll
            for (int q = 0; q < 4; ++q) den += expf(gl[q] - gm);
            const float pgroup = 1.0f / den;
            float el[8];
#pragma unroll
            for (int q = 0; q < 8; ++q) el[q] = L[4 + gi * 8 + q] + be[gi * 8 + q];
            int i0 = 0; float v0 = el[0];
#pragma unroll
            for (int q = 1; q < 8; ++q) if (el[q] > v0) { v0 = el[q]; i0 = q; }
            int i1 = -1; float v1 = -INFINITY;
#pragma unroll
            for (int q = 0; q < 8; ++q) if (q != i0 && el[q] > v1) { v1 = el[q]; i1 = q; }
            const float e1 = expf(v1 - v0); g0 = pgroup / (1.0f + e1); g1 = pgroup * e1 / (1.0f + e1);
            ea = gi * 8 + i0; eb = gi * 8 + i1;
            pa = atomicAdd(&hcnt[ea], 1); pb = atomicAdd(&hcnt[eb], 1);
        }
        __builtin_amdgcn_wave_barrier();
        }
        __syncthreads();
        if (tid < 32) { const int c = hcnt[tid]; hbase[tid] = c ? atomicAdd(&counts[tid], c) : 0; }
        __syncthreads();
        if (live && lane < 16) {
            pa += hbase[ea]; pb += hbase[eb];
            lists[(size_t)ea * NTOK + pa] = row; lists[(size_t)eb * NTOK + pb] = row;
            int* ti = (int*)(tinfo + (size_t)row * 8);
            ti[0] = ea; ti[1] = pa; ti[2] = eb; ti[3] = pb; tinfo[(size_t)row * 8 + 4] = g0; tinfo[(size_t)row * 8 + 5] = g1;
        }
    }
}
#endif
DI void phase_route(const Frame& F, int l) {
    const float* xf = F.xf;
    const float* wg = F.in[33] + (size_t)l * 1024 * 4; const float* bg = F.in[34] + l * 4;
    const float* we = F.in[35] + (size_t)l * 1024 * 32; const float* be = F.in[36] + l * 32;
    int* counts = (int*)(F.ws + CTL_CNT) + l * 32;
    int* lists = WSP(int, OFF_LISTS); float* tinfo = WSP(float, OFF_TINFO);
    for (int row = ggrp(F); row < NTOK; row += ngrp(F)) {
        float gl[4] = {0.f, 0.f, 0.f, 0.f};
        for (int i = 0; i < PERLN; ++i) { const int c = glane(F) + i * GRP; const float x = xf[(size_t)row * DM + c];
#pragma unroll
            for (int q = 0; q < 4; ++q) gl[q] += x * wg[c * 4 + q]; }
#pragma unroll
        for (int q = 0; q < 4; ++q) gl[q] = grp_sum(F, gl[q]) + bg[q];
        int gi = 0; float gm = gl[0];
#pragma unroll
        for (int q = 1; q < 4; ++q) if (gl[q] > gm) { gm = gl[q]; gi = q; }
        float den = 0.f;
#pragma unroll
        for (int q = 0; q < 4; ++q) den += expf(gl[q] - gm);
        const float pgroup = 1.0f / den;
        float el[8] = {0.f, 0.f, 0.f, 0.f, 0.f, 0.f, 0.f, 0.f};
        for (int i = 0; i < PERLN; ++i) { const int c = glane(F) + i * GRP; const float x = xf[(size_t)row * DM + c];
#pragma unroll
            for (int q = 0; q < 8; ++q) el[q] += x * we[c * 32 + gi * 8 + q]; }
#pragma unroll
        for (int q = 0; q < 8; ++q) el[q] = grp_sum(F, el[q]) + be[gi * 8 + q];
        int i0 = 0; float v0 = el[0];
#pragma unroll
        for (int q = 1; q < 8; ++q) if (el[q] > v0) { v0 = el[q]; i0 = q; }
        int i1 = -1; float v1 = -INFINITY;
#pragma unroll
        for (int q = 0; q < 8; ++q) if (q != i0 && el[q] > v1) { v1 = el[q]; i1 = q; }
        const float e1 = expf(v1 - v0); const float g0 = pgroup / (1.0f + e1), g1 = pgroup * e1 / (1.0f + e1);
        if (glane(F) == 0) {
            const int ea = gi * 8 + i0, eb = gi * 8 + i1;
            const int pa = atomicAdd(&counts[ea], 1), pb = atomicAdd(&counts[eb], 1);
            lists[(size_t)ea * NTOK + pa] = row; lists[(size_t)eb * NTOK + pb] = row;
            int* ti = (int*)(tinfo + (size_t)row * 8);
            ti[0] = ea; ti[1] = pa; ti[2] = eb; ti[3] = pb; tinfo[(size_t)row * 8 + 4] = g0; tinfo[(size_t)row * 8 + 5] = g1;
        }
    }
}

struct EpiMoeUp {
    bf16* hm; int row0, pn;
    DI void operator()(int r, int c, float a, float b, float cc, float d) const {
        bf16* p = hm + (size_t)(row0 + r) * 256 + ((pn * 256 + c) >> 1);
        p[0] = f2bf(siluf_(a) * b); p[1] = f2bf(siluf_(cc) * d);
    }
};
DI int ld_cnt(const int* p) {
#ifdef CPU_EMU
    return *p;
#else
    return __hip_atomic_load(p, __ATOMIC_RELAXED, __HIP_MEMORY_SCOPE_AGENT);
#endif
}
DI void moe_tiles(const int* counts, int* toff  ) {
    __syncthreads();
    if (threadIdx.x == 0) { int acc = 0; for (int e = 0; e < NEXP; ++e) { toff[e] = acc; acc += (ld_cnt(counts + e) + 255) >> 8; } toff[NEXP] = acc; }
    __syncthreads();
}
DI void phase_moe_up(const Frame& F, int l) {
    const int* counts = (const int*)(F.ws + CTL_CNT) + l * 32;
    int* eoff = (int*)(F.ws + CTL_EOFF) + l * 33;
    int* rowmap = (int*)(F.smem + 131072);
    int* toff = rowmap + 256;
    moe_tiles(counts, toff);
    if (blockIdx.x == 0 && threadIdx.x == 0) for (int e = 0; e <= NEXP; ++e) eoff[e] = toff[e] * 256;
    const int* lists = WSP(int, OFF_LISTS); const bf16* xb = WSP(bf16, OFF_XB);
    const int nunit = toff[NEXP] * 2;
    for (int u = blockIdx.x; u < nunit; u += F.nblk) {
        const int tile = u >> 1, pn = u & 1;
        int e = 0; while (toff[e + 1] <= tile) ++e;
        const int t0 = (tile - toff[e]) * 256, cnt = ld_cnt(counts + e);
        __syncthreads();
        for (int i = fresh_tid(F); i < 256; i += NTH) rowmap[i] = (t0 + i < cnt) ? lists[(size_t)e * NTOK + t0 + i] : 0;
        __syncthreads();
        EpiMoeUp E{WSP(bf16, OFF_HM), tile * 256, pn};
        gemm_unit(F, xb, 1024, rowmap, 0, WSP(bf16, OFF_W13T) + (size_t)e * 512 * 1024, 1024, pn * 256, 1024, E);
    }
}
DI void phase_moe_down(const Frame& F, int l) {
    const int* counts = (const int*)(F.ws + CTL_CNT) + l * 32;
    int* toff = (int*)(F.smem + 131072) + 256;
    moe_tiles(counts, toff);
    const int nunit = toff[NEXP] * 4;
    for (int u = blockIdx.x; u < nunit; u += F.nblk) {
        const int tile = u >> 2, pn = u & 3;
        int e = 0; while (toff[e + 1] <= tile) ++e;
        EpiBf E{WSP(bf16, OFF_YROWS), 1024, tile * 256, pn};
        gemm_unit(F, WSP(bf16, OFF_HM), 256, nullptr, tile * 256, WSP(bf16, OFF_W2T) + (size_t)e * 1024 * 256, 256, pn * 256, 256, E);
    }
}
DI void phase_ln3(const Frame& F, int l) {
#ifndef CPU_EMU
    ln_rows_gpu<2>(F, F.in[40] + l * 1024, F.in[41] + l * 1024, l);
#else
    const float* xf = F.xf; const bf16* yr = WSP(bf16, OFF_YROWS); const float* tinfo = WSP(float, OFF_TINFO);
    const int* eoff = (const int*)(F.ws + CTL_EOFF) + l * 33;
    layer_norm_rows(F, F.in[40] + l * 1024, F.in[41] + l * 1024, [&](int row, int c) {
        const int* ti = (const int*)(tinfo + (size_t)row * 8);
        const size_t ra = (size_t)eoff[ti[0]] + ti[1], rb = (size_t)eoff[ti[2]] + ti[3];
        return DN_ALPHA * xf[(size_t)row * DM + c] + tinfo[(size_t)row * 8 + 4] * bf2f(yr[ra * 1024 + c]) + tinfo[(size_t)row * 8 + 5] * bf2f(yr[rb * 1024 + c]);
    }, false, nullptr);
#endif
}

#ifndef CPU_EMU
#define XB_TMO      128
#define XB_XCNT(j)  (256  + 64 * (j))
#define XB_XSUB(j)  (1280 + 64 * (j))
#define XB_XGEN(j)  (2304 + 64 * (j))
#define XB_TOP      3328
#define XB_TOPGEN   3392
#define XCD_BAR_WORDS 3456
#define XB_SPIN_CAP (1u << 18)
#define LAS __attribute__((address_space(3)))

__device__ __forceinline__ unsigned xb_ld(unsigned* p)              { return __hip_atomic_load(p, __ATOMIC_RELAXED, __HIP_MEMORY_SCOPE_AGENT); }
__device__ __forceinline__ unsigned xb_add(unsigned* p, unsigned v) { return __hip_atomic_fetch_add(p, v, __ATOMIC_RELAXED, __HIP_MEMORY_SCOPE_AGENT); }
__device__ __forceinline__ unsigned xb_xcc_id() { return (unsigned)__builtin_amdgcn_s_getreg((3 << 11) | 20) & 0xFu; }
#define XB_SPIN(cond, bar) do { unsigned _sp = 0; while (cond) { __builtin_amdgcn_s_sleep(1); \
    if ((++_sp & 255u) == 0u) { if (xb_ld(&(bar)[XB_TMO])) break; if (_sp > XB_SPIN_CAP) { atomicAdd(&(bar)[XB_TMO], 1u); break; } } } } while (0)

struct XcdBarrier {
    unsigned* bar; unsigned x;
    volatile LAS unsigned* st;
};

__device__ __forceinline__ XcdBarrier xcd_barrier_post(unsigned* bar, volatile LAS unsigned* st) {
    XcdBarrier b; b.bar = bar; b.x = xb_xcc_id(); b.st = st;
    if (threadIdx.x == 0) (void)xb_add(&bar[XB_XCNT(b.x)], 1u);
    return b;
}
__device__ __forceinline__ void xcd_barrier_complete(unsigned* bar, unsigned x, unsigned& nloc, unsigned& nx) {
    const unsigned G = gridDim.x * gridDim.y * gridDim.z;
    unsigned sum, cnt, mine, sp = 0u;
    for (;;) {
        sum = 0u; cnt = 0u; mine = 0u;
#pragma unroll
        for (unsigned j = 0; j < 16; ++j) { const unsigned c = xb_ld(&bar[XB_XCNT(j)]); sum += c; cnt += (c > 0u) ? 1u : 0u; mine = (j == x) ? c : mine; }
        if (sum == G) break;
        __builtin_amdgcn_s_sleep(1);
        if ((++sp & 255u) == 0u) { if (xb_ld(&bar[XB_TMO])) break; if (sp > XB_SPIN_CAP) { atomicAdd(&bar[XB_TMO], 1u); break; } }
    }
    nloc = mine > 0u ? mine : 1u; nx = cnt > 0u ? cnt : 1u;
}

__device__ __forceinline__ void xcd_barrier(const XcdBarrier& b) {
    asm volatile("s_waitcnt vmcnt(0)" ::: "memory");
    __syncthreads();
    if (threadIdx.x == 0) {
        unsigned* bar = b.bar;
        __builtin_amdgcn_s_waitcnt(0);
        unsigned nloc = b.st[0], nx = b.st[1];
        if (nloc == 0u) { xcd_barrier_complete(bar, b.x, nloc, nx); b.st[0] = nloc; b.st[1] = nx; }
        const unsigned old = xb_add(&bar[XB_XSUB(b.x)], 1u);
        const unsigned gen = old / nloc;
        if (old + 1u == (gen + 1u) * nloc) {
            __builtin_amdgcn_fence(__ATOMIC_RELEASE, "agent");
            asm volatile("s_waitcnt vmcnt(0)" ::: "memory");
            const unsigned og = xb_add(&bar[XB_TOP], 1u);
            const unsigned tg = og / nx;
            if (og + 1u == (tg + 1u) * nx) xb_add(&bar[XB_TOPGEN], 1u);
            else XB_SPIN(xb_ld(&bar[XB_TOPGEN]) == tg, bar);
            __builtin_amdgcn_fence(__ATOMIC_ACQUIRE, "agent");
            xb_add(&bar[XB_XGEN(b.x)], 1u);
            asm volatile("s_waitcnt vmcnt(0)" ::: "memory");
        } else {
            XB_SPIN(xb_ld(&bar[XB_XGEN(b.x)]) == gen, bar);
            __builtin_amdgcn_fence(__ATOMIC_ACQUIRE, "agent");
            asm volatile("s_waitcnt vmcnt(0)" ::: "memory");
        }
    }
    __syncthreads();
}

#endif

constexpr int NPH_LAYER = 16;
constexpr int NPH_TOTAL = 1 + 2 * NPH_LAYER;
constexpr int SMEM_BYTES = 147456 + 1024;

#ifndef CPU_EMU
DI void phase_attn_queue(const Frame& F, int l) {
    {
            const AttnDesc Ag = desc_gqa(F), Am = desc_mla(F);
            const int ng = attn_nunit<64, 64, 64, 2>(Ag), nm = attn_nunit<96, 64, 64, 1>(Am);
            unsigned* qctr = (unsigned*)(F.ws + CTL_QUEUE) + l * 64;
            volatile int* slot = (volatile int*)(F.smem + SMEM_BYTES - 32);
            for (;;) {
                __syncthreads();
                if (fresh_tid(F) == 0) *slot = (int)atomicAdd(qctr, 1u);
                __syncthreads();
                const int u = *slot;
                if (u >= ng + nm) break;
                if (u < ng) attn_unit<64, 64, 64, 2>(F, Ag, u); else attn_unit<96, 64, 64, 1>(F, Am, u - ng);
            }
        }
}
#endif

template <int K>
DI void run_layer_phase(const Frame& F, int l) {
    if constexpr (K == 0) phase_cvt(F, l);
    if constexpr (K == 1) phase_gemm1(F);
    if constexpr (K == 2) phase_prep(F, l);
    if constexpr (K == 3) phase_mlaup(F);
    if constexpr (K == 4) {
#ifdef CPU_EMU
        attn_phase<64, 64>(F, desc_gqa(F)); attn_phase<96, 64>(F, desc_mla(F)); phase_scans(F);
#else
        phase_scans(F);
        phase_attn_queue(F, l);
#endif
    }
#ifdef CPU_EMU
    if constexpr (K == 5) phase_fin(F, l);
#else
    if constexpr (K == 5) phase_fin_gpu(F, l);
#endif
    if constexpr (K == 6) phase_gemm_sq<0>(F, WSP(bf16, OFF_YCAT), W_OUT_T, nullptr);
    if constexpr (K == 7) phase_ln(F, F.in[26] + l * 1024, F.in[27] + l * 1024);
    if constexpr (K == 8) phase_gemm_sq<1>(F, WSP(bf16, OFF_XB), W_Q_T, WSP(bf16, OFF_QMEM));
    if constexpr (K == 9) {
#ifdef CPU_EMU
        attn_phase<256, 256>(F, desc_mem(F));
#else
        attn_phase<256, 256, 128, 1>(F, desc_mem(F));
#endif
    }
    if constexpr (K == 10) phase_gemm_sq<0>(F, WSP(bf16, OFF_OMEM), W_O_T, nullptr);
    if constexpr (K == 11) { phase_ln<true>(F, F.in[31] + l * 1024, F.in[32] + l * 1024); phase_cvt_moe(F, l); }
#ifdef CPU_EMU
    if constexpr (K == 12) phase_route(F, l);
#else
    if constexpr (K == 12) phase_route_gpu(F, l);
#endif
    if constexpr (K == 13) phase_moe_up(F, l);
    if constexpr (K == 14) phase_moe_down(F, l);
    if constexpr (K == 15) phase_ln3(F, l);
}

#ifndef CPU_EMU
template <int K>
__global__ void __launch_bounds__(512, 2) k_phase(Args a, int l) {
    extern __shared__ __attribute__((aligned(16))) unsigned char lds[];
    Frame F; F.in = (InPtr)__builtin_amdgcn_kernarg_segment_ptr(); F.xf = a.out; F.ws = a.ws; F.smem = lds; F.tid = threadIdx.x; F.wv = __builtin_amdgcn_readfirstlane((int)(threadIdx.x >> 6)); F.nblk = a.ph_lo;
    if constexpr (K < 0) phase_pro(F); else run_layer_phase<K>(F, l);
}

template <int K>
static void launch_phase(const Args& a, int l, int grid, hipStream_t stream) {
    static bool attr = false;
    if (!attr) { (void)hipFuncSetAttribute((const void*)k_phase<K>, hipFuncAttributeMaxDynamicSharedMemorySize, SMEM_BYTES); attr = true; }
    hipLaunchKernelGGL(k_phase<K>, dim3(grid), dim3(512), SMEM_BYTES, stream, a, l);
}

__global__ void __launch_bounds__(512, 2) fwd_one(Args a) {
    extern __shared__ __attribute__((aligned(16))) unsigned char lds[];
    const int wave_s = __builtin_amdgcn_readfirstlane((int)(threadIdx.x >> 6));
    volatile LAS unsigned* st = (volatile LAS unsigned*)(lds + SMEM_BYTES - 16);
    if (threadIdx.x == 0) { st[0] = 0u; st[1] = 0u; st[2] = 0u; st[3] = 0u; }
    __syncthreads();
    XcdBarrier bar = xcd_barrier_post((unsigned*)(a.ws + OFF_CTL), st);
    Frame F;
#define FRESH do { unsigned z_ = 0u, m_ = ~0u; int ws_ = wave_s; asm volatile("" : "+s"(z_), "+s"(ws_), "+s"(m_)); \
        int t_ = ws_ * 64 + (int)__builtin_amdgcn_mbcnt_hi(m_, __builtin_amdgcn_mbcnt_lo(m_, 0u)); asm volatile("" : "+v"(t_)); \
        const __attribute__((address_space(4))) char* kp_ = (const __attribute__((address_space(4))) char*)__builtin_amdgcn_kernarg_segment_ptr() + z_; \
        F.in = (InPtr)kp_; F.xf = *(float* const __attribute__((address_space(4)))*)(kp_ + 42 * 8); F.ws = *(unsigned char* const __attribute__((address_space(4)))*)(kp_ + 43 * 8); \
        F.smem = lds; F.tid = t_; F.wv = ws_; F.nblk = *(const int __attribute__((address_space(4)))*)(kp_ + 44 * 8); } while (0)
#define GB do { { unsigned zb_ = 0u; unsigned xx_ = __builtin_amdgcn_readfirstlane(bar.x); asm volatile("" : "+s"(zb_), "+s"(xx_)); bar.bar = (unsigned*)(a.ws + OFF_CTL) + zb_; bar.x = xx_; } \
        xcd_barrier(bar); } while (0)
#define DUP(k) ((PROBE_DUP >> (k)) & 1)
    FRESH; phase_pro(F); FRESH; phase_cvt(F, 0); GB;
    if (DUP(0)) { FRESH; phase_cvt(F, 0); GB; }
    for (int l = 0; l < 2; ++l) {
        FRESH; run_layer_phase<1>(F, l); GB;
        if (DUP(1)) { FRESH; run_layer_phase<1>(F, l); GB; }
        FRESH; run_layer_phase<2>(F, l); GB;
        FRESH; run_layer_phase<3>(F, l); GB;
        if (DUP(3)) { FRESH; run_layer_phase<3>(F, l); GB; }
        if (DUP(4)) { FRESH; attn_phase<64, 64, 64, 2>(F, desc_gqa(F)); attn_phase<96, 64, 64, 1>(F, desc_mla(F)); GB; }
        FRESH; run_layer_phase<4>(F, l); GB;
        FRESH; run_layer_phase<5>(F, l); GB;
        if (DUP(5)) { FRESH; run_layer_phase<5>(F, l); GB; }
        FRESH; run_layer_phase<6>(F, l); GB;
        FRESH; run_layer_phase<7>(F, l); GB;
        FRESH; run_layer_phase<8>(F, l); GB;
        if (DUP(8)) { FRESH; run_layer_phase<8>(F, l); GB; }
        FRESH; run_layer_phase<9>(F, l); GB;
        if (DUP(9)) { FRESH; run_layer_phase<9>(F, l); GB; }
        FRESH; run_layer_phase<10>(F, l); GB;
        FRESH; run_layer_phase<11>(F, l); if (NTOK % (F.nblk * 32) != 0) GB; FRESH; run_layer_phase<12>(F, l); if (l == 0) { FRESH; phase_cvt(F, 1); } GB;
        if (DUP(11)) { FRESH; phase_cvt_moe(F, l); GB; }
        FRESH; run_layer_phase<13>(F, l); GB;
        if (DUP(13)) { FRESH; run_layer_phase<13>(F, l); GB; }
        FRESH; run_layer_phase<14>(F, l); GB;
        if (DUP(14)) { FRESH; run_layer_phase<14>(F, l); GB; }
        FRESH; run_layer_phase<15>(F, l); if (l == 0) GB;
    }
#undef DUP
#undef GB
#undef FRESH
}

extern "C" void kernel_launch(void* const* d_in, const int* in_sizes, int n_in, void* d_out, int out_size, void* d_ws, size_t ws_size, hipStream_t stream) {
    if (n_in != 42 || ws_size < WS_END) return;
    Args a{};
    for (int i = 0; i < 42; ++i) a.in[i] = (const float*)d_in[i];
    a.out = (float*)d_out; a.ws = (unsigned char*)d_ws; a.ph_lo = 0; a.ph_hi = NPH_TOTAL;
    (void)hipMemsetAsync(d_ws, 0, CTL_BYTES, stream);
#if N_LAUNCH_MODE == 1
    static int grid = 0;
    if (!grid) {
        int dev = 0, cus = 0, per_cu = 0;
        (void)hipGetDevice(&dev);
        (void)hipDeviceGetAttribute(&cus, hipDeviceAttributeMultiprocessorCount, dev);
        (void)hipFuncSetAttribute((const void*)fwd_one, hipFuncAttributeMaxDynamicSharedMemorySize, SMEM_BYTES);
        (void)hipOccupancyMaxActiveBlocksPerMultiprocessor(&per_cu, (const void*)fwd_one, 512, SMEM_BYTES);
        (void)hipGetLastError();
        grid = cus > 0 ? cus : 256;
    }
    a.ph_lo = grid;
    hipLaunchKernelGGL(fwd_one, dim3(grid), dim3(512), SMEM_BYTES, stream, a);
#else
    const int grid = 256; a.ph_lo = grid;
    launch_phase<-1>(a, 0, grid, stream);
    for (int l = 0; l < 2; ++l) {
        launch_phase<0>(a, l, grid, stream); launch_phase<1>(a, l, grid, stream); launch_phase<2>(a, l, grid, stream); launch_phase<3>(a, l, grid, stream);
        launch_phase<4>(a, l, grid, stream); launch_phase<5>(a, l, grid, stream); launch_phase<6>(a, l, grid, stream); launch_phase<7>(a, l, grid, stream);
        launch_phase<8>(a, l, grid, stream); launch_phase<9>(a, l, grid, stream); launch_phase<10>(a, l, grid, stream); launch_phase<11>(a, l, grid, stream);
        launch_phase<12>(a, l, grid, stream); launch_phase<13>(a, l, grid, stream); launch_phase<14>(a, l, grid, stream); launch_phase<15>(a, l, grid, stream);
    }
#endif
}
#endif
```

```cpp
#ifndef CPU_EMU
#include <hip/hip_runtime.h>
#else
#include "emu_shim.h"
#endif
#include <stdint.h>

#ifndef CFG_B
#define CFG_B 16
#endif
#ifndef CFG_S
#define CFG_S 2048
#endif
#ifndef PROBE_DUP
#define PROBE_DUP 0
#endif
#ifndef N_LAUNCH_MODE
#define N_LAUNCH_MODE 1
#endif

typedef unsigned short bf16;
#define DI __device__ __forceinline__

constexpr int BATCH = CFG_B, SEQ = CFG_S, NTOK = BATCH * SEQ, DM = 1024;
constexpr int MEMT = 256, NMEM = BATCH * MEMT;
constexpr int GRIDW = 64;
constexpr int HP = 3328;
constexpr int IN_WIDTH = 3104;
constexpr int NEXP = 32, MOEH = 256;
constexpr int MOE_ROWS = 2 * NTOK + NEXP * 256;
constexpr float LN_EPS = 1e-5f, RMS_EPS = 1e-6f, GN_EPS = 64e-5f;
constexpr float DN_ALPHA = 1.41421356237309515f;
constexpr float DECAY_SCALE = 0.60653065971263342f;

constexpr size_t AL(size_t x) { return (x + 255) & ~(size_t)255; }
constexpr size_t OFF_CTL = 0;
constexpr size_t CTL_BYTES = 32768;
constexpr size_t CTL_CNT = 16384;
constexpr size_t CTL_EOFF = 16384 + 1024;
constexpr size_t CTL_QUEUE = 16384 + 2048;
constexpr size_t OFF_XB = AL(OFF_CTL + CTL_BYTES);
constexpr size_t SZ_XB = (size_t)NTOK * DM * 2;
constexpr size_t OFF_WTS = AL(OFF_XB + SZ_XB);
constexpr size_t W_IN_T = 0;
constexpr size_t W_UQ_T = W_IN_T + (size_t)HP * 1024 * 2;
constexpr size_t W_UKV_T = W_UQ_T + 512 * 256 * 2;
constexpr size_t W_OUT_T = W_UKV_T + 512 * 256 * 2;
constexpr size_t W_Q_T = W_OUT_T + 1024 * 1024 * 2;
constexpr size_t W_KV_T = W_Q_T + 1024 * 1024 * 2;
constexpr size_t W_O_T = W_KV_T + 2048 * 1024 * 2;
constexpr size_t W_GATE_T = W_O_T + 1024 * 1024 * 2;
constexpr size_t SZ_WTS = W_GATE_T + 2 * 48 * 1024 * 4;
constexpr size_t OFF_KMEM = AL(OFF_WTS + SZ_WTS);
constexpr size_t OFF_VTMEM = AL(OFF_KMEM + (size_t)NMEM * 1024 * 2);
constexpr size_t OFF_MEMB = AL(OFF_VTMEM + (size_t)NMEM * 1024 * 2);
constexpr size_t OFF_VTATT = AL(OFF_MEMB + (size_t)NMEM * 1024 * 2);
constexpr size_t OFF_VTMLA = AL(OFF_VTATT + (size_t)BATCH * 2 * 64 * SEQ * 2);
constexpr size_t OFF_HATT = AL(OFF_VTMLA + (size_t)BATCH * 4 * 64 * SEQ * 2);
constexpr size_t OFF_HMLA = OFF_HATT + (size_t)NTOK * 512 * 2;
constexpr size_t OFF_HRWKV = OFF_HMLA + (size_t)NTOK * 512 * 2;
constexpr size_t OFF_R7 = OFF_HRWKV + (size_t)NTOK * 1024 * 2;
constexpr size_t SZ_R7 = (size_t)NTOK * 9 * 256 * 2;
constexpr size_t OFF_HHGRN = OFF_R7 + SZ_R7;
constexpr size_t OFF_HX = OFF_HHGRN + (size_t)NTOK * 1280 * 2;
constexpr size_t OFF_HAM = OFF_HX + (size_t)NTOK * 256 * 2;
constexpr size_t OFF_HEG = OFF_HAM + (size_t)(NTOK / 16) * 8 * 256 * 2;
constexpr size_t OFF_REG = OFF_HEG + (size_t)(NTOK / 16) * 8 * 64 * 4;
constexpr size_t WS_END = OFF_REG + (size_t)(NTOK / 16) * 8 * 64 * 2;
static_assert(WS_END <= (size_t)4 * NTOK * DM * 4 || CFG_B != 16, "workspace must fit 4 x the largest tensor");

constexpr size_t OFF_QMLA = OFF_XB;
constexpr size_t OFF_KNOPE = OFF_QMLA + (size_t)NTOK * 384 * 2;
constexpr size_t OFF_KROPE = OFF_KNOPE + (size_t)NTOK * 256 * 2;
constexpr size_t OFF_G = OFF_KROPE + (size_t)NTOK * 32 * 2;
constexpr size_t OFF_BONUS = OFF_G + (size_t)NTOK * 256 * 2;
constexpr size_t OFF_RSIDE = OFF_BONUS + (size_t)NTOK * 16;
static_assert(OFF_RSIDE + (size_t)(NTOK / 16) * 2 * 512 * 2 <= OFF_XB + SZ_XB, "xb alias region");
constexpr size_t OFF_YCAT = OFF_HRWKV;
constexpr size_t OFF_QMEM = OFF_HATT;
constexpr size_t OFF_OMEM = OFF_R7;
#ifdef CPU_EMU
constexpr size_t OFF_EMU_SCAN = WS_END;
constexpr size_t OFF_LISTS = AL(OFF_EMU_SCAN + (size_t)4 * NTOK * 256 * 2);
#else
constexpr size_t OFF_LISTS = OFF_HATT;
#endif
constexpr size_t OFF_TINFO = OFF_LISTS + (size_t)NEXP * NTOK * 4;
constexpr size_t OFF_HM = AL(OFF_TINFO + (size_t)NTOK * 32);
constexpr size_t OFF_YROWS = AL(OFF_HM + (size_t)MOE_ROWS * 256 * 2);
#ifdef CPU_EMU
constexpr size_t OFF_W13T = AL(OFF_YROWS + (size_t)MOE_ROWS * 1024 * 2);
#else
static_assert(OFF_YROWS + (size_t)MOE_ROWS * 1024 * 2 <= OFF_HHGRN, "moe alias region");
constexpr size_t OFF_W13T = OFF_HHGRN;
#endif
constexpr size_t OFF_W2T = OFF_W13T + (size_t)NEXP * 512 * 1024 * 2;
#ifdef CPU_EMU
constexpr size_t WS_END_EMU = OFF_W2T + (size_t)NEXP * 1024 * 256 * 2;
#else
static_assert(OFF_W2T + (size_t)NEXP * 1024 * 256 * 2 <= WS_END, "moe weights alias");
#endif

enum { C_KT0 = 0, C_KT1 = 1, C_RT0 = 2, C_RT1 = 3, C_KK0 = 4, C_KK1 = 5, C_AT0 = 6, C_AT1 = 7, C_VT = 8 };
enum { R_R = 0, R_V = 1, R_KK = 2, R_W0 = 3, R_W1 = 4, R_KD0 = 5, R_KD1 = 6, R_AK0 = 7, R_AK1 = 8 };

DI float bf2f(bf16 v) { union { unsigned u; float f; } x; x.u = (unsigned)v << 16; return x.f; }
DI bf16 f2bf(float f) { union { unsigned u; float f; } x; x.f = f; unsigned u = x.u; u += 0x7fffu + ((u >> 16) & 1u); return (bf16)(u >> 16); }
DI float sigmoidf_(float x) { return 1.0f / (1.0f + expf(-x)); }
DI float siluf_(float x) { return x * sigmoidf_(x); }

#ifdef CPU_EMU
typedef const float* const* InPtr;
#else
typedef const float* const __attribute__((address_space(4)))* InPtr;
#endif
struct Frame {
    InPtr in;
    float* xf;
    unsigned char* ws;
    unsigned char* smem;
    int tid;
    int wv;
    int nblk;
};
#ifdef CPU_EMU
constexpr int NTH = 1;
#else
constexpr int NTH = 512;
#endif
#ifdef CPU_EMU
constexpr int GRP = 1;
DI float grp_sum(const Frame& F, float v) { return v; }
DI int gthreads(const Frame& F) { return 1; }
DI int gtid_(const Frame& F) { return 0; }
DI int wave_item_index(const Frame& F) { return 0; }
#else
constexpr int GRP = 64;
DI float shfl_idx(const Frame& F, float v, int src_lane) { return __builtin_bit_cast(float, __builtin_amdgcn_ds_bpermute(src_lane << 2, __builtin_bit_cast(int, v))); }
DI float shfl_xor(const Frame& F, float v, int mask) {
    unsigned m0 = ~0u; asm volatile("" : "+s"(m0));
    const int lane = (int)__builtin_amdgcn_mbcnt_hi(m0, __builtin_amdgcn_mbcnt_lo(m0, 0u));
    return shfl_idx(F, v, lane ^ mask); }
template <int CTRL> DI float dppf(float x) { return __builtin_bit_cast(float, __builtin_amdgcn_update_dpp(0, __builtin_bit_cast(int, x), CTRL, 0xf, 0xf, true)); }
DI float allsum16(float x) { x += dppf<0xB1>(x); x += dppf<0x4E>(x); x += dppf<0x141>(x); x += dppf<0x140>(x); return x; }
DI float rdlane(float x, int l) { return __builtin_bit_cast(float, __builtin_amdgcn_readlane(__builtin_bit_cast(int, x), l)); }
DI float grp_sum(const Frame& F, float v) { v = allsum16(v); return (rdlane(v, 0) + rdlane(v, 16)) + (rdlane(v, 32) + rdlane(v, 48)); }
DI int gthreads(const Frame& F) { return F.nblk * NTH; }
DI int gtid_(const Frame& F) { return blockIdx.x * NTH + F.tid; }
DI int wave_item_index(const Frame& F) { return (int)(((F.tid >> 6) * F.nblk + blockIdx.x) * 64 + (F.tid & 63)); }
#endif
constexpr int PER64 = 64 / GRP;
constexpr int PERLN = 1024 / GRP;
DI int fresh_tid(const Frame& F) {
#ifdef CPU_EMU
    return 0;
#else
    unsigned m0 = ~0u; asm volatile("" : "+s"(m0));
    int t = F.wv * 64 + (int)__builtin_amdgcn_mbcnt_hi(m0, __builtin_amdgcn_mbcnt_lo(m0, 0u)); asm volatile("" : "+v"(t)); return t;
#endif
}
DI int glane(const Frame& F) { return (int)(F.tid % GRP); }
DI int ggrp(const Frame& F) { return gtid_(F) / GRP; }
DI int ngrp(const Frame& F) { return gthreads(F) / GRP; }

struct Args {
    const float* in[42];
    float* out;
    unsigned char* ws;
    int ph_lo, ph_hi;
};

DI float rope_inv(int f, int nf) { return powf(10000.0f, -(float)f / (float)nf); }

#ifndef CPU_EMU
using bf16x8 = __attribute__((ext_vector_type(8))) short;
using bf16x4 = __attribute__((ext_vector_type(4))) short;
using f32x4 = __attribute__((ext_vector_type(4))) float;
using f32x16 = __attribute__((ext_vector_type(16))) float;
typedef __bf16 bf16v2 __attribute__((ext_vector_type(2)));
typedef float f32v2 __attribute__((ext_vector_type(2)));
DI float bflo(unsigned u) { return __uint_as_float(u << 16); }
DI float bfhi(unsigned u) { return __uint_as_float(u & 0xffff0000u); }
DI unsigned pack_bf16(float lo, float hi) { f32v2 v = {lo, hi}; bf16v2 b = __builtin_convertvector(v, bf16v2); return __builtin_bit_cast(unsigned, b); }

constexpr int G_BM = 256, G_BK = 64, G_HALF = 128, G_HT = G_HALF * G_BK, G_SHM = 8 * G_HT * 2;
DI int g_lds_byte(int r, int c) { int st = (r >> 4) * 2 + (c >> 5), rr = r & 15, cc = c & 31, ob = rr * 64 + cc * 2; return st * 1024 + (ob ^ (((ob >> 9) & 1) << 5)); }
DI void g_stage_rc(int b, int& R, int& C) { int st = b / 1024, sb = b % 1024, swz = sb ^ (((sb >> 9) & 1) << 5); R = (st >> 1) * 16 + swz / 64; C = (st & 1) * 32 + (swz % 64) / 2; }

template <bool GATHER, class Epi>
DI void gemm_unit_t(int wv_in, bf16* shm, const bf16* __restrict__ A, int lda, const int* rowmap, int arow0,
                    const bf16* __restrict__ Bt, int ldb, int bcol0, int K, const Epi& epi) {
#define SA(b, h) (shm + ((b) * 2 + (h)) * G_HT)
#define SB(b, h) (shm + (4 + (b) * 2 + (h)) * G_HT)
#define STAGE_AX(T, P, hf, kt) do { for (int _i = 0; _i < 2; ++_i) { int _b = (T) * 16 + _i * 8192; int _r, _c; g_stage_rc(_b, _r, _c); \
        const long _row = GATHER ? (long)rowmap[(hf) * G_HALF + _r] : (long)(arow0 + (hf) * G_HALF + _r); \
        __builtin_amdgcn_global_load_lds((const unsigned*)(A + _row * lda + (long)(kt) * G_BK + _c), (unsigned*)((char*)(P) + _b), 16, 0, 0); } } while (0)
#define STAGE_BX(T, P, hf, kt) do { for (int _i = 0; _i < 2; ++_i) { int _b = (T) * 16 + _i * 8192; int _r, _c; g_stage_rc(_b, _r, _c); \
        __builtin_amdgcn_global_load_lds((const unsigned*)(Bt + (long)(bcol0 + (hf) * G_HALF + _r) * ldb + (long)(kt) * G_BK + _c), (unsigned*)((char*)(P) + _b), 16, 0, 0); } } while (0)
#define STAGE_A(P, hf, kt) STAGE_AX(t0, P, hf, kt)
#define STAGE_B(P, hf, kt) STAGE_BX(t0, P, hf, kt)
#define LDA(dst, b, h) for (int m = 0; m < 4; ++m) for (int k = 0; k < 2; ++k) \
        dst[m][k] = *reinterpret_cast<const bf16x8*>((char*)SA(b, h) + g_lds_byte(wr * 64 + m * 16 + fr, k * 32 + fq * 8))
#define LDB(dst, b, h) for (int n = 0; n < 2; ++n) for (int k = 0; k < 2; ++k) \
        dst[n][k] = *reinterpret_cast<const bf16x8*>((char*)SB(b, h) + g_lds_byte(wc * 32 + n * 16 + fr, k * 32 + fq * 8))
#define MMA(ai, bj, At, Bt_) do { __builtin_amdgcn_s_setprio(1); \
        for (int m = 0; m < 4; ++m) for (int n = 0; n < 2; ++n) for (int k = 0; k < 2; ++k) \
            acc[ai][bj][m][n] = __builtin_amdgcn_mfma_f32_16x16x32_bf16(Bt_[n][k], At[m][k], acc[ai][bj][m][n], 0, 0, 0); \
        __builtin_amdgcn_s_setprio(0); } while (0)
#define WAIT_V(n) asm volatile("s_waitcnt vmcnt(" #n ")" ::: "memory")
#define WAIT_L(n) asm volatile("s_waitcnt lgkmcnt(" #n ")" ::: "memory")
#define BAR __builtin_amdgcn_s_barrier()
#define SCHED __builtin_amdgcn_sched_barrier(0)
    unsigned m0 = ~0u; asm volatile("" : "+s"(m0));
    int t0 = wv_in * 64 + (int)__builtin_amdgcn_mbcnt_hi(m0, __builtin_amdgcn_mbcnt_lo(m0, 0u)); asm volatile("" : "+v"(t0));
    int wid = t0 >> 6, lane = t0 & 63, wr = wid >> 2, wc = wid & 3, fr = lane & 15, fq = lane >> 4;
    f32x4 acc[2][2][4][2] = {};
    bf16x8 At[4][2], B0[2][2], B1[2][2];
    const int nt = K / G_BK;
    STAGE_B(SB(0, 0), 0, 0); STAGE_A(SA(0, 0), 0, 0);
    STAGE_B(SB(0, 1), 1, 0); STAGE_A(SA(0, 1), 1, 0);
    if (wr == 1) BAR;
    WAIT_V(4); BAR;
    STAGE_B(SB(1, 0), 0, 1); STAGE_A(SA(1, 0), 0, 1); STAGE_B(SB(1, 1), 1, 1);
    WAIT_V(6); BAR;
    for (int t = 0; t < nt - 2; t += 2) {
        LDB(B0, 0, 0); SCHED; LDA(At, 0, 0); STAGE_A(SA(1, 1), 1, t + 1);
        WAIT_L(8); BAR; WAIT_L(0); MMA(0, 0, At, B0); BAR; SCHED;
        LDB(B1, 0, 1); STAGE_B(SB(0, 0), 0, t + 2);
        BAR; WAIT_L(0); MMA(0, 1, At, B1); BAR;
        LDA(At, 0, 1); STAGE_A(SA(0, 0), 0, t + 2);
        BAR; WAIT_L(0); MMA(1, 0, At, B0); BAR; SCHED;
        STAGE_B(SB(0, 1), 1, t + 2);
        WAIT_V(6); BAR; MMA(1, 1, At, B1); BAR;
        LDB(B0, 1, 0); SCHED; LDA(At, 1, 0); STAGE_A(SA(0, 1), 1, t + 2);
        WAIT_L(8); BAR; WAIT_L(0); MMA(0, 0, At, B0); BAR; SCHED;
        LDB(B1, 1, 1); STAGE_B(SB(1, 0), 0, t + 3);
        BAR; WAIT_L(0); MMA(0, 1, At, B1); BAR;
        LDA(At, 1, 1); STAGE_A(SA(1, 0), 0, t + 3);
        BAR; WAIT_L(0); MMA(1, 0, At, B0); BAR; SCHED;
        STAGE_B(SB(1, 1), 1, t + 3);
        WAIT_V(6); BAR; MMA(1, 1, At, B1); BAR;
    }
    int tz = t0; asm volatile("" : "+v"(tz)); wid = tz >> 6; lane = tz & 63; wr = wid >> 2; wc = wid & 3; fr = lane & 15; fq = lane >> 4;
    { LDB(B0, 0, 0); WAIT_V(0); LDA(At, 0, 0); STAGE_AX(tz, SA(1, 1), 1, nt - 1);
      BAR; WAIT_L(0); MMA(0, 0, At, B0); BAR;
      LDB(B1, 0, 1); BAR; WAIT_L(0); MMA(0, 1, At, B1); BAR;
      LDA(At, 0, 1); WAIT_V(4); BAR; WAIT_L(0); MMA(1, 0, At, B0); MMA(1, 1, At, B1); BAR; }
    { LDB(B0, 1, 0); LDA(At, 1, 0); WAIT_V(2); BAR; WAIT_L(0); MMA(0, 0, At, B0); BAR;
      LDB(B1, 1, 1); WAIT_V(0); BAR; WAIT_L(0); MMA(0, 1, At, B1); BAR;
      LDA(At, 1, 1); BAR; WAIT_L(0); MMA(1, 0, At, B0); MMA(1, 1, At, B1); BAR; }
    if (wr == 0) BAR;
#pragma unroll
    for (int ai = 0; ai < 2; ++ai)
#pragma unroll
        for (int m = 0; m < 4; ++m)
#pragma unroll
            for (int bj = 0; bj < 2; ++bj)
#pragma unroll
                for (int n = 0; n < 2; ++n) {
                    const f32x4 v = acc[ai][bj][m][n];
                    epi(ai * G_HALF + wr * 64 + m * 16 + fr, bj * G_HALF + wc * 32 + n * 16 + fq * 4, v[0], v[1], v[2], v[3]);
                }
#undef SA
#undef SB
#undef STAGE_A
#undef STAGE_B
#undef STAGE_AX
#undef STAGE_BX
#undef LDA
#undef LDB
#undef MMA
}
template <class Epi>
DI void gemm_unit(const Frame& F, const bf16* __restrict__ A, int lda, const int* rowmap, int arow0,
                  const bf16* __restrict__ Bt, int ldb, int bcol0, int K, const Epi& epi) {
    if (rowmap) gemm_unit_t<true>(F.wv, (bf16*)F.smem, A, lda, rowmap, arow0, Bt, ldb, bcol0, K, epi);
    else gemm_unit_t<false>(F.wv, (bf16*)F.smem, A, lda, rowmap, arow0, Bt, ldb, bcol0, K, epi);
}
#else
template <class Epi>
void gemm_unit(const Frame& F, const bf16* A, int lda, const int* rowmap, int arow0, const bf16* Bt, int ldb, int bcol0, int K, const Epi& epi, int mrows = 256) {
    for (int r = 0; r < mrows; ++r) {
        int arow = rowmap ? rowmap[r] : arow0 + r;
        for (int c = 0; c < 256; c += 4) {
            float v[4];
            for (int q = 0; q < 4; ++q) {
                double s = 0; const bf16* a = A + (long)arow * lda; const bf16* b = Bt + (long)(bcol0 + c + q) * ldb;
                for (int k = 0; k < K; ++k) s += (double)bf2f(a[k]) * bf2f(b[k]);
                v[q] = (float)s;
            }
            epi(r, c, v[0], v[1], v[2], v[3]);
        }
    }
}
#endif

DI void st_bf16x4(bf16* p, float a, float b, float c, float d) {
#ifndef CPU_EMU
    uint2 u; u.x = pack_bf16(a, b); u.y = pack_bf16(c, d); *reinterpret_cast<uint2*>(p) = u;
#else
    p[0] = f2bf(a); p[1] = f2bf(b); p[2] = f2bf(c); p[3] = f2bf(d);
#endif
}

#define WSP(T, off) ((T*)(F.ws + (off)))

DI void ln_row_write(float* xrow, bf16* brow, const float* vals_in  , const float* g, const float* b);

template <class Fn>
DI void layer_norm_rows(const Frame& F, const float* g, const float* b, Fn pre, bool write_out_extra, float* extra) {
    float* xf = F.xf; bf16* xb = WSP(bf16, OFF_XB);
    for (int row = ggrp(F); row < NTOK; row += ngrp(F)) {
        float v[PERLN]; float s = 0.f;
        for (int i = 0; i < PERLN; ++i) { int c = glane(F) + i * GRP; v[i] = pre(row, c); s += v[i]; }
        s = grp_sum(F, s); const float mu = s * (1.0f / 1024.0f);
        float q = 0.f;
        for (int i = 0; i < PERLN; ++i) { float d = v[i] - mu; q += d * d; }
        q = grp_sum(F, q); const float rs = 1.0f / sqrtf(q * (1.0f / 1024.0f) + LN_EPS);
        for (int i = 0; i < PERLN; ++i) { int c = glane(F) + i * GRP; float y = (v[i] - mu) * rs * g[c] + b[c];
            xf[(size_t)row * DM + c] = y; xb[(size_t)row * DM + c] = f2bf(y); if (write_out_extra) extra[(size_t)row * DM + c] = y; }
    }
}

#ifndef CPU_EMU
template <int MODE, bool BLOCKED = false>
DI void ln_rows_gpu(const Frame& F, const float* __restrict__ g, const float* __restrict__ b, int l) {
    float* xf = F.xf; bf16* xb = WSP(bf16, OFF_XB);
    const float* xin = F.in[0];
    const bf16* yr = WSP(bf16, OFF_YROWS); const float* tinfo = WSP(float, OFF_TINFO);
    const int* eoff = (const int*)(F.ws + CTL_EOFF) + l * 33;
    const int tid = F.tid, wave = tid >> 6, lane = tid & 63;
    float4 gv[4], bv[4];
#pragma unroll
    for (int i = 0; i < 4; ++i) { gv[i] = *reinterpret_cast<const float4*>(g + lane * 4 + 256 * i); bv[i] = *reinterpret_cast<const float4*>(b + lane * 4 + 256 * i); }
    const bool blk_ok = BLOCKED && (NTOK % (F.nblk * 32) == 0);
    const int rpb = NTOK / F.nblk;
    const int r_first = blk_ok ? blockIdx.x * rpb + wave * 4 : (blockIdx.x * 8 + wave) * 4;
    const int r_end = blk_ok ? (blockIdx.x + 1) * rpb : NTOK;
    const int r_step = blk_ok ? 32 : F.nblk * 32;
    unsigned nra[4] = {0u, 0u, 0u, 0u}, nrb[4] = {0u, 0u, 0u, 0u}; float ng0[4] = {0.f, 0.f, 0.f, 0.f}, ng1[4] = {0.f, 0.f, 0.f, 0.f};
#define LN_META(r0_) do { if (MODE == 2) { _Pragma("unroll") for (int rr_ = 0; rr_ < 4; ++rr_) { const size_t row_ = (size_t)(r0_) + rr_; \
        const int4 ti_ = *reinterpret_cast<const int4*>(tinfo + row_ * 8); const float2 tg_ = *reinterpret_cast<const float2*>(tinfo + row_ * 8 + 4); \
        nra[rr_] = (unsigned)(eoff[ti_.x] + ti_.y); nrb[rr_] = (unsigned)(eoff[ti_.z] + ti_.w); ng0[rr_] = tg_.x; ng1[rr_] = tg_.y; } } } while (0)
    if (r_first < r_end) LN_META(r_first);
    for (int r0 = r_first; r0 < r_end; r0 += r_step) {
        float4 v[4][4];
        unsigned cra[4], crb[4]; float cg0[4], cg1[4];
#pragma unroll
        for (int rr = 0; rr < 4; ++rr) { cra[rr] = nra[rr]; crb[rr] = nrb[rr]; cg0[rr] = ng0[rr]; cg1[rr] = ng1[rr]; }
        if (r0 + r_step < r_end) LN_META(r0 + r_step);
#pragma unroll
        for (int rr = 0; rr < 4; ++rr) {
            const size_t row = r0 + rr;
            if (MODE == 2) {
                const size_t ra = cra[rr], rb = crb[rr];
                const float g0 = cg0[rr], g1 = cg1[rr];
#pragma unroll
                for (int i = 0; i < 4; ++i) {
                    const int c = lane * 4 + 256 * i;
                    const float4 x = *reinterpret_cast<const float4*>(xf + row * DM + c);
                    const uint2 ya = *reinterpret_cast<const uint2*>(yr + ra * 1024 + c), yb = *reinterpret_cast<const uint2*>(yr + rb * 1024 + c);
                    v[rr][i].x = DN_ALPHA * x.x + g0 * bflo(ya.x) + g1 * bflo(yb.x); v[rr][i].y = DN_ALPHA * x.y + g0 * bfhi(ya.x) + g1 * bfhi(yb.x);
                    v[rr][i].z = DN_ALPHA * x.z + g0 * bflo(ya.y) + g1 * bflo(yb.y); v[rr][i].w = DN_ALPHA * x.w + g0 * bfhi(ya.y) + g1 * bfhi(yb.y);
                }
            } else {
                const float* src = (MODE == 1 ? xin : xf) + row * DM;
#pragma unroll
                for (int i = 0; i < 4; ++i) v[rr][i] = *reinterpret_cast<const float4*>(src + lane * 4 + 256 * i);
            }
        }
#pragma unroll
        for (int rr = 0; rr < 4; ++rr) {
            const size_t row = r0 + rr;
            float s = 0.f;
#pragma unroll
            for (int i = 0; i < 4; ++i) s += (v[rr][i].x + v[rr][i].y) + (v[rr][i].z + v[rr][i].w);
            const float mu = grp_sum(F, s) * (1.0f / 1024.0f);
            float q = 0.f;
#pragma unroll
            for (int i = 0; i < 4; ++i) { const float d0 = v[rr][i].x - mu, d1 = v[rr][i].y - mu, d2 = v[rr][i].z - mu, d3 = v[rr][i].w - mu; q += (d0 * d0 + d1 * d1) + (d2 * d2 + d3 * d3); }
            const float rs = 1.0f / sqrtf(grp_sum(F, q) * (1.0f / 1024.0f) + LN_EPS);
#pragma unroll
            for (int i = 0; i < 4; ++i) {
                const int c = lane * 4 + 256 * i;
                float4 y; y.x = (v[rr][i].x - mu) * rs * gv[i].x + bv[i].x; y.y = (v[rr][i].y - mu) * rs * gv[i].y + bv[i].y;
                y.z = (v[rr][i].z - mu) * rs * gv[i].z + bv[i].z; y.w = (v[rr][i].w - mu) * rs * gv[i].w + bv[i].w;
                *reinterpret_cast<float4*>(xf + row * DM + c) = y;
                *reinterpret_cast<uint2*>(xb + row * DM + c) = make_uint2(pack_bf16(y.x, y.y), pack_bf16(y.z, y.w));
            }
        }
    }
#undef LN_META
}
#endif

DI void phase_pro(const Frame& F) {
    const float* x = F.in[0]; const float* mem = F.in[1];
#ifdef CPU_EMU
    layer_norm_rows(F, F.in[2], F.in[3], [&](int row, int c) { return x[(size_t)row * DM + c]; }, false, nullptr);
#else
    (void)x; ln_rows_gpu<1>(F, F.in[2], F.in[3], 0);
#endif
    bf16* memb = WSP(bf16, OFF_MEMB);
    for (size_t i = gtid_(F); i < (size_t)NMEM * DM; i += gthreads(F)) memb[i] = f2bf(mem[i]);
}

template <class Src>
DI void cvt_tile(const Frame& F, bf16* dst, int Kk, int n0, int k0, Src src) {
#ifndef CPU_EMU
    float* tile = (float*)F.smem;
    __syncthreads();
    for (int i = F.tid; i < 4096; i += NTH) { int k = i >> 6, n = i & 63; tile[k * 65 + n] = src(k0 + k, n0 + n); }
    __syncthreads();
    for (int i = F.tid; i < 2048; i += NTH) { int n = i >> 5, k = (i & 31) * 2;
        *reinterpret_cast<unsigned*>(dst + (size_t)(n0 + n) * Kk + k0 + k) = pack_bf16(tile[k * 65 + n], tile[(k + 1) * 65 + n]); }
#endif
}
template <class Src>
DI void cvt_transpose(const Frame& F, bf16* dst, int Nn, int Kk, Src src, int t_first, int t_total) {
#ifdef CPU_EMU
    for (int n = 0; n < Nn; ++n) for (int k = 0; k < Kk; ++k) dst[(size_t)n * Kk + k] = f2bf(src(k, n));
#else
    const int tn = Nn / 64, tk = Kk / 64, ntile = tn * tk;
    int t = (int)blockIdx.x - (t_first % (int)F.nblk); if (t < 0) t += F.nblk;
    for (; t < ntile; t += F.nblk) cvt_tile(F, dst, Kk, (t % tn) * 64, (t / tn) * 64, src);
#endif
}

#ifndef CPU_EMU
template <bool VEC, class CM>
DI void cvt_job(const Frame& F, int& tbase, bf16* dst, int ldd, int Nn, int Kk, int Ksrc, const float* __restrict__ src, int lds, CM cm) {
    const int nw = F.nblk * 8, gw = blockIdx.x * 8 + F.wv;
    const int lane = fresh_tid(F) & 63, kq = lane & 15, nq = lane >> 4;
    const int tk = Kk / 64, T = tk * (Nn / 16);
    int t = gw - (tbase % nw); if (t < 0) t += nw;
    tbase += T;
    for (; t < T; t += nw) {
        const int k = (t % tk) * 64 + 4 * kq, n = (t / tk) * 16 + 4 * nq;
        float4 v[4];
        if (VEC) {
            const int s = cm(n);
#pragma unroll
            for (int i = 0; i < 4; ++i) v[i] = (s >= 0 && k + i < Ksrc) ? *reinterpret_cast<const float4*>(src + (size_t)(k + i) * lds + s) : make_float4(0.f, 0.f, 0.f, 0.f);
        } else {
            const int s0 = cm(n), s1 = cm(n + 1), s2 = cm(n + 2), s3 = cm(n + 3);
#pragma unroll
            for (int i = 0; i < 4; ++i) { const float* row = src + (size_t)(k + i) * lds; const bool ok = k + i < Ksrc;
                v[i].x = (ok && s0 >= 0) ? row[s0] : 0.f; v[i].y = (ok && s1 >= 0) ? row[s1] : 0.f; v[i].z = (ok && s2 >= 0) ? row[s2] : 0.f; v[i].w = (ok && s3 >= 0) ? row[s3] : 0.f; }
        }
        bf16* d = dst + (size_t)n * ldd + k;
        *reinterpret_cast<uint2*>(d) = make_uint2(pack_bf16(v[0].x, v[1].x), pack_bf16(v[2].x, v[3].x));
        *reinterpret_cast<uint2*>(d + ldd) = make_uint2(pack_bf16(v[0].y, v[1].y), pack_bf16(v[2].y, v[3].y));
        *reinterpret_cast<uint2*>(d + 2 * (size_t)ldd) = make_uint2(pack_bf16(v[0].z, v[1].z), pack_bf16(v[2].z, v[3].z));
        *reinterpret_cast<uint2*>(d + 3 * (size_t)ldd) = make_uint2(pack_bf16(v[0].w, v[1].w), pack_bf16(v[2].w, v[3].w));
    }
}
#endif

DI int win_src_col(int n) {
    if (n < 512) return n;
    if (n < 1536) { int c = n - 512; return c < 960 ? 512 + c : -1; }
    if (n < 2816) return 1472 + (n - 1536);
    int c = n - 2816;
    if (c < 192) return 2752 + c;
    if (c < 224) return 2752 + 320 + (c - 192);
    if (c < 256) return -1;
    if (c < 384) return 2752 + 192 + (c - 256);
    return -1;
}
DI int wuq_src_col(int n) {
    if (n >= 384) return -1;
    int h = n / 96, w = n % 96;
    if (w < 64) return h * 96 + w;
    int p = w - 64, m = p >> 1, which = p & 1;
    int i = (m < 8 ? m : 16 + (m - 8)) + (which ? 8 : 0);
    return h * 96 + 64 + i;
}

DI void phase_cvt(const Frame& F, int l) {
    bf16* wts = WSP(bf16, OFF_WTS);
#ifndef CPU_EMU
    {
        int tb = 0;
        auto ident = [](int n) { return n; };
        cvt_job<true>(F, tb, (bf16*)((char*)wts + W_IN_T), 1024, HP, 1024, 1024, F.in[4] + (size_t)l * 1024 * IN_WIDTH, IN_WIDTH, [](int n) { return win_src_col(n); });
        cvt_job<false>(F, tb, (bf16*)((char*)wts + W_UQ_T), 256, 512, 256, 192, F.in[23] + (size_t)l * 192 * 384, 384, [](int n) { return wuq_src_col(n); });
        cvt_job<true>(F, tb, (bf16*)((char*)wts + W_UKV_T), 256, 512, 256, 128, F.in[24] + (size_t)l * 128 * 512, 512, ident);
        cvt_job<true>(F, tb, (bf16*)((char*)wts + W_OUT_T), 1024, 1024, 1024, 1024, F.in[25] + (size_t)l * 1024 * 1024, 1024, ident);
        cvt_job<true>(F, tb, (bf16*)((char*)wts + W_Q_T), 1024, 1024, 1024, 1024, F.in[28] + (size_t)l * 1024 * 1024, 1024, ident);
        cvt_job<true>(F, tb, (bf16*)((char*)wts + W_KV_T), 1024, 2048, 1024, 1024, F.in[29] + (size_t)l * 1024 * 2048, 2048, ident);
        cvt_job<true>(F, tb, (bf16*)((char*)wts + W_O_T), 1024, 1024, 1024, 1024, F.in[30] + (size_t)l * 1024 * 1024, 1024, ident);
        const float* wg = F.in[33] + (size_t)l * 1024 * 4; const float* we = F.in[35] + (size_t)l * 1024 * 32; float* gt = (float*)((char*)wts + W_GATE_T) + (size_t)l * 48 * 1024;
        for (int i = gtid_(F); i < 48 * 1024; i += gthreads(F)) { const int col = i >> 10, k = i & 1023; gt[i] = col < 4 ? wg[k * 4 + col] : col < 36 ? we[k * 32 + col - 4] : 0.f; }
        return;
    }
#endif
    constexpr int T0 = 0, T1 = T0 + (HP / 64) * 16, T2 = T1 + 8 * 4, T3 = T2 + 8 * 4, T4 = T3 + 256, T5 = T4 + 256, T6 = T5 + 512, TT = T6 + 256;
    { const float* w = F.in[4] + (size_t)l * 1024 * IN_WIDTH;
      cvt_transpose(F, (bf16*)((char*)wts + W_IN_T), HP, 1024, [&](int k, int n) { int s = win_src_col(n); return s < 0 ? 0.f : w[(size_t)k * IN_WIDTH + s]; }, T0, TT); }
    { const float* w = F.in[23] + (size_t)l * 192 * 384;
      cvt_transpose(F, (bf16*)((char*)wts + W_UQ_T), 512, 256, [&](int k, int n) { int s = wuq_src_col(n); return (s < 0 || k >= 192) ? 0.f : w[(size_t)k * 384 + s]; }, T1, TT); }
    { const float* w = F.in[24] + (size_t)l * 128 * 512;
      cvt_transpose(F, (bf16*)((char*)wts + W_UKV_T), 512, 256, [&](int k, int n) { return k >= 128 ? 0.f : w[(size_t)k * 512 + n]; }, T2, TT); }
    { const float* w = F.in[25] + (size_t)l * 1024 * 1024;
      cvt_transpose(F, (bf16*)((char*)wts + W_OUT_T), 1024, 1024, [&](int k, int n) { return w[(size_t)k * 1024 + n]; }, T3, TT); }
    { const float* w = F.in[28] + (size_t)l * 1024 * 1024;
      cvt_transpose(F, (bf16*)((char*)wts + W_Q_T), 1024, 1024, [&](int k, int n) { return w[(size_t)k * 1024 + n]; }, T4, TT); }
    { const float* w = F.in[29] + (size_t)l * 1024 * 2048;
      cvt_transpose(F, (bf16*)((char*)wts + W_KV_T), 2048, 1024, [&](int k, int n) { return w[(size_t)k * 2048 + n]; }, T5, TT); }
    { const float* w = F.in[30] + (size_t)l * 1024 * 1024;
      cvt_transpose(F, (bf16*)((char*)wts + W_O_T), 1024, 1024, [&](int k, int n) { return w[(size_t)k * 1024 + n]; }, T6, TT); }
#ifndef CPU_EMU
    { const float* wg = F.in[33] + (size_t)l * 1024 * 4; const float* we = F.in[35] + (size_t)l * 1024 * 32; float* gt = (float*)((char*)wts + W_GATE_T) + (size_t)l * 48 * 1024;
      for (int i = gtid_(F); i < 48 * 1024; i += gthreads(F)) { const int col = i >> 10, k = i & 1023;
          gt[i] = col < 4 ? wg[k * 4 + col] : col < 36 ? we[k * 32 + col - 4] : 0.f; } }
#endif
}

DI void phase_cvt_moe(const Frame& F, int l) {
#ifdef CPU_EMU
    for (int e = 0; e < NEXP; ++e) {
        const float* w1 = F.in[37] + ((size_t)l * NEXP + e) * 1024 * 256;
        const float* w3 = F.in[38] + ((size_t)l * NEXP + e) * 1024 * 256;
        const float* w2 = F.in[39] + ((size_t)l * NEXP + e) * 256 * 1024;
        cvt_transpose(F, WSP(bf16, OFF_W13T) + (size_t)e * 512 * 1024, 512, 1024,
                      [&](int k, int n) { return (n & 1) ? w3[(size_t)k * 256 + (n >> 1)] : w1[(size_t)k * 256 + (n >> 1)]; }, 0, 1);
        cvt_transpose(F, WSP(bf16, OFF_W2T) + (size_t)e * 1024 * 256, 1024, 256, [&](int k, int n) { return w2[(size_t)k * 1024 + n]; }, 0, 1);
    }
#else
    {
        int tb = 0;
        auto ident = [](int n) { return n; };
        for (int e = 0; e < NEXP; ++e) {
            const float* w1 = F.in[37] + ((size_t)l * NEXP + e) * 1024 * 256; const float* w3 = F.in[38] + ((size_t)l * NEXP + e) * 1024 * 256; const float* w2 = F.in[39] + ((size_t)l * NEXP + e) * 256 * 1024;
            bf16* d13 = WSP(bf16, OFF_W13T) + (size_t)e * 512 * 1024;
            cvt_job<true>(F, tb, d13, 2048, 256, 1024, 1024, w1, 256, ident);
            cvt_job<true>(F, tb, d13 + 1024, 2048, 256, 1024, 1024, w3, 256, ident);
            cvt_job<true>(F, tb, WSP(bf16, OFF_W2T) + (size_t)e * 1024 * 256, 256, 1024, 256, 256, w2, 1024, ident);
        }
    }
#endif
}

struct EpiH {
    bf16* hatt; bf16* hrwkv; bf16* hhgrn; bf16* hmla; int row0, pn;
    DI void operator()(int r, int c, float a, float b, float cc, float d) const {
        const size_t row = row0 + r;
        bf16* p;
        if (pn < 2) p = hatt + row * 512 + pn * 256 + c;
        else if (pn < 6) p = hrwkv + row * 1024 + (pn - 2) * 256 + c;
        else if (pn < 11) p = hhgrn + row * 1280 + (pn - 6) * 256 + c;
        else p = hmla + row * 512 + (pn - 11) * 256 + c;
        st_bf16x4(p, a, b, cc, d);
    }
};
struct EpiKV {
    bf16* kmem; bf16* vt; int row0, pn;
    DI void operator()(int r, int c, float a, float b, float cc, float d) const {
        const int row = row0 + r, col = pn * 256 + c;
        if (col < 1024) { st_bf16x4(kmem + (size_t)row * 1024 + col, a, b, cc, d); }
        else { const int bb = row / MEMT, key = row % MEMT, hc = col - 1024;
            bf16* p = vt + ((size_t)bb * 1024 + hc) * MEMT + key;
            p[0] = f2bf(a); p[MEMT] = f2bf(b); p[2 * MEMT] = f2bf(cc); p[3 * MEMT] = f2bf(d); }
    }
};

DI void phase_gemm1(const Frame& F) {
    const bf16* xb = WSP(bf16, OFF_XB); const bf16* wts = WSP(bf16, OFF_WTS);
    const int nM = (NTOK + 255) / 256, nN = HP / 256, n1 = nM * nN;
    const int nMk = (NMEM + 255) / 256, nNk = 8, n2 = nMk * nNk;
    for (int u = blockIdx.x; u < n1 + n2; u += F.nblk) {
        if (u < n1) {
            const int pm = u / nN, pn = u % nN;
            EpiH E{WSP(bf16, OFF_HATT), WSP(bf16, OFF_HRWKV), WSP(bf16, OFF_HHGRN), WSP(bf16, OFF_HMLA), pm * 256, pn};
#ifdef CPU_EMU
            gemm_unit(F, xb, 1024, nullptr, pm * 256, (const bf16*)((const char*)wts + W_IN_T), 1024, pn * 256, 1024, E, min(256, NTOK - pm * 256));
#else
            gemm_unit(F, xb, 1024, nullptr, pm * 256, (const bf16*)((const char*)wts + W_IN_T), 1024, pn * 256, 1024, E);
#endif
        } else {
            const int v = u - n1, pm = v / nNk, pn = v % nNk;
            EpiKV E{WSP(bf16, OFF_KMEM), WSP(bf16, OFF_VTMEM), pm * 256, pn};
            gemm_unit(F, WSP(bf16, OFF_MEMB), 1024, nullptr, pm * 256, (const bf16*)((const char*)wts + W_KV_T), 1024, pn * 256, 1024, E);
        }
    }
}


#ifndef CPU_EMU
DI float fast_sigmoid(float x) { return 1.0f / (1.0f + __expf(-x)); }
DI float fast_tanh(float x) { const float e = __expf(2.0f * x); return 1.0f - 2.0f / (e + 1.0f); }

DI void prep_attn_gpu(const Frame& F, int l) {
    float* tabA = (float*)F.smem;
    float* tabB = tabA + 2048;
    float* gq = tabB + 1024;
    __syncthreads();
    { const int tid = fresh_tid(F);
    for (int i = tid; i < 1024; i += NTH) { const int pos = i >> 4, f = i & 15; const float ang = (float)pos * rope_inv(2 * f, 32); tabA[i] = cosf(ang); tabA[1024 + i] = sinf(ang); }
    for (int i = tid; i < 512; i += NTH) { const int pos = i >> 3, f = i & 7; const float ang = (float)pos * rope_inv(2 * f, 16); tabB[i] = cosf(ang); tabB[512 + i] = sinf(ang); }
    for (int i = tid; i < 448; i += NTH) gq[i] = i < 64 ? F.in[5][l * 64 + i] : i < 128 ? F.in[6][l * 64 + i - 64] : i < 320 ? F.in[21][l * 192 + i - 128] : F.in[22][l * 128 + i - 320]; }
    __syncthreads();
    bf16* hatt = WSP(bf16, OFF_HATT);
    for (int it = blockIdx.x * NTH + fresh_tid(F); it < NTOK * 6; it += gthreads(F)) {
        const int n = it / 6, hh = it % 6, s = n % SEQ, rowp = s / GRIDW, colp = s % GRIDW;
        uint4* p = reinterpret_cast<uint4*>(hatt + (size_t)n * 512 + hh * 64);
        const float* gn = gq + (hh < 4 ? 0 : 64);
        uint4 raw[8];
#pragma unroll
        for (int i = 0; i < 8; ++i) raw[i] = p[i];
        float x[64];
#pragma unroll
        for (int i = 0; i < 8; ++i) { x[8 * i] = bflo(raw[i].x); x[8 * i + 1] = bfhi(raw[i].x); x[8 * i + 2] = bflo(raw[i].y); x[8 * i + 3] = bfhi(raw[i].y);
            x[8 * i + 4] = bflo(raw[i].z); x[8 * i + 5] = bfhi(raw[i].z); x[8 * i + 6] = bflo(raw[i].w); x[8 * i + 7] = bfhi(raw[i].w); }
        float ss = 0.f;
#pragma unroll
        for (int j = 0; j < 64; ++j) ss += x[j] * x[j];
        const float rs = 1.0f / sqrtf(ss * (1.0f / 64.0f) + RMS_EPS);
#pragma unroll
        for (int j = 0; j < 64; ++j) x[j] *= rs * gn[j];
#pragma unroll
        for (int half = 0; half < 2; ++half) {
            const int pos = half ? colp : rowp;
#pragma unroll
            for (int f = 0; f < 16; ++f) {
                const float cs = tabA[pos * 16 + f], sn = tabA[1024 + pos * 16 + f];
                const float x1 = x[half * 32 + f], x2 = x[half * 32 + 16 + f];
                x[half * 32 + f] = x1 * cs - x2 * sn; x[half * 32 + 16 + f] = x1 * sn + x2 * cs;
            }
        }
#pragma unroll
        for (int i = 0; i < 8; ++i) { uint4 o; o.x = pack_bf16(x[8 * i], x[8 * i + 1]); o.y = pack_bf16(x[8 * i + 2], x[8 * i + 3]); o.z = pack_bf16(x[8 * i + 4], x[8 * i + 5]); o.w = pack_bf16(x[8 * i + 6], x[8 * i + 7]); p[i] = o; }
    }
    bf16* hm = WSP(bf16, OFF_HMLA); bf16* kr = WSP(bf16, OFF_KROPE);
    for (int it = blockIdx.x * NTH + fresh_tid(F); it < NTOK * 3; it += gthreads(F)) {
        const int n = it / 3, which = it % 3;
        if (which < 2) {
            const int len = which ? 128 : 192; const float* gn = gq + (which ? 320 : 128);
            uint4* p = reinterpret_cast<uint4*>(hm + (size_t)n * 512 + (which ? 256 : 0));
            float ss = 0.f;
            for (int i = 0; i < len / 8; ++i) { const uint4 r = p[i];
                const float a0 = bflo(r.x), a1 = bfhi(r.x), a2 = bflo(r.y), a3 = bfhi(r.y), a4 = bflo(r.z), a5 = bfhi(r.z), a6 = bflo(r.w), a7 = bfhi(r.w);
                ss += a0 * a0 + a1 * a1 + a2 * a2 + a3 * a3 + a4 * a4 + a5 * a5 + a6 * a6 + a7 * a7; }
            const float rs = 1.0f / sqrtf(ss / (float)len + RMS_EPS);
            for (int i = 0; i < len / 8; ++i) { const uint4 r = p[i]; const float* g = gn + 8 * i; uint4 o;
                o.x = pack_bf16(bflo(r.x) * rs * g[0], bfhi(r.x) * rs * g[1]); o.y = pack_bf16(bflo(r.y) * rs * g[2], bfhi(r.y) * rs * g[3]);
                o.z = pack_bf16(bflo(r.z) * rs * g[4], bfhi(r.z) * rs * g[5]); o.w = pack_bf16(bflo(r.w) * rs * g[6], bfhi(r.w) * rs * g[7]); p[i] = o; }
        } else {
            const int s = n % SEQ, rowp = s / GRIDW, colp = s % GRIDW;
            const uint4* p = reinterpret_cast<const uint4*>(hm + (size_t)n * 512 + 192);
            float x[32];
#pragma unroll
            for (int i = 0; i < 4; ++i) { const uint4 r = p[i]; x[8 * i] = bflo(r.x); x[8 * i + 1] = bfhi(r.x); x[8 * i + 2] = bflo(r.y); x[8 * i + 3] = bfhi(r.y);
                x[8 * i + 4] = bflo(r.z); x[8 * i + 5] = bfhi(r.z); x[8 * i + 6] = bflo(r.w); x[8 * i + 7] = bfhi(r.w); }
            unsigned o[16];
#pragma unroll
            for (int m = 0; m < 16; ++m) {
                const int i1 = m < 8 ? m : 16 + (m - 8), pos = m < 8 ? rowp : colp, f = m & 7;
                const float cs = tabB[pos * 8 + f], sn = tabB[512 + pos * 8 + f];
                o[m] = pack_bf16(x[i1] * cs - x[i1 + 8] * sn, x[i1] * sn + x[i1 + 8] * cs);
            }
            uint4* q = reinterpret_cast<uint4*>(kr + (size_t)n * 32);
#pragma unroll
            for (int i = 0; i < 4; ++i) q[i] = make_uint4(o[4 * i], o[4 * i + 1], o[4 * i + 2], o[4 * i + 3]);
        }
    }
    {
        bf16* vt = WSP(bf16, OFF_VTATT); bf16* tl = (bf16*)(gq + 512);
        for (int tile = blockIdx.x; tile < BATCH * 2 * (SEQ / 64); tile += F.nblk) {
            const int b = tile / (2 * (SEQ / 64)), kv = (tile / (SEQ / 64)) % 2, t0 = (tile % (SEQ / 64)) * 64;
            __syncthreads();
            const int tid = fresh_tid(F);
            { const int t = tid >> 3, part = tid & 7;
              const uint4 r = *reinterpret_cast<const uint4*>(hatt + (size_t)(b * SEQ + t0 + t) * 512 + 384 + kv * 64 + part * 8);
              const unsigned w[4] = {r.x, r.y, r.z, r.w};
#pragma unroll
              for (int i = 0; i < 4; ++i) { tl[(part * 8 + 2 * i) * 72 + t] = (bf16)(w[i] & 0xffffu); tl[(part * 8 + 2 * i + 1) * 72 + t] = (bf16)(w[i] >> 16); } }
            __syncthreads();
            { const int dv = tid >> 3, part = tid & 7;
              *reinterpret_cast<uint4*>(vt + ((size_t)(b * 2 + kv) * 64 + dv) * SEQ + t0 + part * 8) = *reinterpret_cast<const uint4*>(tl + dv * 72 + part * 8); }
        }
    }
}

DI void prep_hgrn_gpu(const Frame& F, int l) {
    bf16* hh = WSP(bf16, OFF_HHGRN); bf16* hx = WSP(bf16, OFF_HX); bf16* ham = WSP(bf16, OFF_HAM); float* heg = WSP(float, OFF_HEG);
    const int tid = F.tid, wave = tid >> 6, lane = tid & 63, x = lane & 15, q = lane >> 4;
    bf16* stg = (bf16*)F.smem + wave * (4 * 16 * 72);
    for (int it = blockIdx.x * 8 + wave; it < (NTOK / 16) * 4; it += F.nblk * 8) {
        const int c = it >> 2, h = it & 3, n0 = c * 16, cj = h * 64 + lane;
        float mlb = 1.0f;
        if (l == 1) { const float a = F.in[19][cj], b = F.in[19][256 + cj]; const float m = fmaxf(a, b); const float ea = __expf(a - m), eb = __expf(b - m); mlb = ea / (ea + eb); }
        float qv[16], k0[16], k1[16], g0[16], g1[16]; bf16 vraw[16];
#pragma unroll
        for (int t = 0; t < 16; ++t) {
            const bf16* row = hh + (size_t)(n0 + t) * 1280 + cj;
            const float xq = bf2f(row[0]), x0 = bf2f(row[256]), x1 = bf2f(row[512]); vraw[t] = row[768];
            qv[t] = xq * fast_sigmoid(xq); k0[t] = mlb * fast_sigmoid(-x0); k1[t] = mlb * fast_sigmoid(-x1);
            g0[t] = __logf(1.0f - k0[t]); g1[t] = __logf(1.0f - k1[t]);
        }
#pragma unroll
        for (int t = 1; t < 16; ++t) { g0[t] += g0[t - 1]; g1[15 - t] += g1[16 - t]; }
        heg[((size_t)it * 2 + 0) * 64 + lane] = __expf(g0[15]); heg[((size_t)it * 2 + 1) * 64 + lane] = __expf(g1[0]);
        unsigned kt0[8], kt1[8], vt[8];
#pragma unroll
        for (int t = 0; t < 16; t += 2) {
            const float e0a = __expf(g0[t]), e0b = __expf(g0[t + 1]), e1a = __expf(g1[t]), e1b = __expf(g1[t + 1]);
            const float q0a = qv[t] * e0a, q0b = qv[t + 1] * e0b, q1a = qv[t] * e1a, q1b = qv[t + 1] * e1b;
            const float ka0 = k0[t] / e0a, kb0 = k0[t + 1] / e0b, ka1 = k1[t] / e1a, kb1 = k1[t + 1] / e1b;
            const bf16 bq0a = f2bf(q0a), bq0b = f2bf(q0b), bq1a = f2bf(q1a), bq1b = f2bf(q1b);
            hh[(size_t)(n0 + t) * 1280 + cj] = bq0a; hh[(size_t)(n0 + t + 1) * 1280 + cj] = bq0b;
            hx[(size_t)(n0 + t) * 256 + cj] = bq1a; hx[(size_t)(n0 + t + 1) * 256 + cj] = bq1b;
            kt0[t >> 1] = pack_bf16(ka0, kb0); kt1[t >> 1] = pack_bf16(ka1, kb1); vt[t >> 1] = (unsigned)vraw[t] | ((unsigned)vraw[t + 1] << 16);
            stg[0 * 1152 + t * 72 + lane] = bq0a; stg[0 * 1152 + (t + 1) * 72 + lane] = bq0b;
            stg[2 * 1152 + t * 72 + lane] = bq1a; stg[2 * 1152 + (t + 1) * 72 + lane] = bq1b;
            stg[1 * 1152 + t * 72 + lane] = (bf16)(kt0[t >> 1] & 0xffffu); stg[1 * 1152 + (t + 1) * 72 + lane] = (bf16)(kt0[t >> 1] >> 16);
            stg[3 * 1152 + t * 72 + lane] = (bf16)(kt1[t >> 1] & 0xffffu); stg[3 * 1152 + (t + 1) * 72 + lane] = (bf16)(kt1[t >> 1] >> 16);
        }
        { bf16* blk = hh + (size_t)(n0 + (lane >> 2)) * 1280 + h * 64 + (lane & 3) * 16;
          *reinterpret_cast<uint4*>(blk + 256) = make_uint4(kt0[0], kt0[1], kt0[2], kt0[3]); *reinterpret_cast<uint4*>(blk + 256 + 8) = make_uint4(kt0[4], kt0[5], kt0[6], kt0[7]);
          *reinterpret_cast<uint4*>(blk + 512) = make_uint4(kt1[0], kt1[1], kt1[2], kt1[3]); *reinterpret_cast<uint4*>(blk + 512 + 8) = make_uint4(kt1[4], kt1[5], kt1[6], kt1[7]);
          *reinterpret_cast<uint4*>(blk + 768) = make_uint4(vt[0], vt[1], vt[2], vt[3]); *reinterpret_cast<uint4*>(blk + 768 + 8) = make_uint4(vt[4], vt[5], vt[6], vt[7]); }
        asm volatile("s_waitcnt lgkmcnt(0)" ::: "memory");
        __builtin_amdgcn_wave_barrier();
#pragma unroll
        for (int d = 0; d < 2; ++d) {
            f32x4 acc = {0.f, 0.f, 0.f, 0.f};
#pragma unroll
            for (int ks = 0; ks < 2; ++ks) {
                const bf16x8 a = *reinterpret_cast<const bf16x8*>(stg + (2 * d) * 1152 + x * 72 + 32 * ks + 8 * q);
                const bf16x8 b = *reinterpret_cast<const bf16x8*>(stg + (2 * d + 1) * 1152 + x * 72 + 32 * ks + 8 * q);
                acc = __builtin_amdgcn_mfma_f32_16x16x32_bf16(a, b, acc, 0, 0, 0);
            }
            bf16* am = ham + ((size_t)it * 2 + d) * 256;
#pragma unroll
            for (int r = 0; r < 4; ++r) { const int t = 4 * q + r; const bool keep = d ? (x >= t) : (x <= t); am[t * 16 + x] = f2bf(keep ? acc[r] : 0.f); }
        }
        __builtin_amdgcn_wave_barrier();
    }
}

DI void scan_hgrn_chunk(const Frame& F, int chain) {
    const int d = chain / (BATCH * 4), b = (chain / 4) % BATCH, h = chain % 4;
    const int lane = fresh_tid(F) & 63, x = lane & 15, q = lane >> 4;
    bf16* hh = WSP(bf16, OFF_HHGRN); const bf16* hx = WSP(bf16, OFF_HX); const bf16* ham = WSP(bf16, OFF_HAM); const float* heg = WSP(float, OFF_HEG);
    f32x4 S[4][4];
#pragma unroll
    for (int a = 0; a < 4; ++a)
#pragma unroll
        for (int c = 0; c < 4; ++c) S[a][c] = (f32x4){0.f, 0.f, 0.f, 0.f};
    constexpr int NCH = SEQ / 16;
    uint2 nQ[4], nA, nK[4], nV[4]; float4 nE[4];
    const unsigned lq = (unsigned)(x * (d ? 256 : 1280) + h * 64 + 4 * q);
    const unsigned lb = (unsigned)((x >> 2) * 1280 + h * 64 + (x & 3) * 16 + 4 * q);
    const unsigned la = (unsigned)(x * 16 + 4 * q), le = (unsigned)(4 * q), lo = (unsigned)(4 * q * 1280 + x);
#define HG_LOAD(cc_) do { const int c_ = d ? NCH - 1 - (cc_) : (cc_); const unsigned n0_ = (unsigned)(b * SEQ + 16 * c_); const unsigned it_ = (n0_ >> 4) * 4 + h; \
        const bf16* qb_ = d ? hx + (size_t)n0_ * 256 : hh + (size_t)n0_ * 1280; const bf16* hb_ = hh + (size_t)n0_ * 1280; \
        const bf16* ab_ = ham + (size_t)(it_ * 2 + d) * 256; const float* eb_ = heg + (size_t)(it_ * 2 + d) * 64; \
        _Pragma("unroll") for (int u_ = 0; u_ < 4; ++u_) nQ[u_] = *reinterpret_cast<const uint2*>(qb_ + lq + 16 * u_); \
        nA = *reinterpret_cast<const uint2*>(ab_ + la); \
        _Pragma("unroll") for (int u_ = 0; u_ < 4; ++u_) { \
            nK[u_] = *reinterpret_cast<const uint2*>(hb_ + lb + (4 * u_) * 1280 + 256 + d * 256); nV[u_] = *reinterpret_cast<const uint2*>(hb_ + lb + (4 * u_) * 1280 + 768); \
            nE[u_] = *reinterpret_cast<const float4*>(eb_ + le + 16 * u_); } } while (0)
    HG_LOAD(0);
    for (int cc = 0; cc < NCH; ++cc) {
        uint2 cQ[4], cA, cK[4], cV[4]; float4 cE[4];
#pragma unroll
        for (int u = 0; u < 4; ++u) { cQ[u] = nQ[u]; cK[u] = nK[u]; cV[u] = nV[u]; cE[u] = nE[u]; }
        cA = nA;
        if (cc + 1 < NCH) HG_LOAD(cc + 1);
        const int c = d ? NCH - 1 - cc : cc; const size_t n0 = (size_t)b * SEQ + 16 * c;
        union Fr { bf16x8 v; unsigned u[4]; };
        Fr aq0, aq1, aA; aq0.u[0] = cQ[0].x; aq0.u[1] = cQ[0].y; aq0.u[2] = cQ[1].x; aq0.u[3] = cQ[1].y;
        aq1.u[0] = cQ[2].x; aq1.u[1] = cQ[2].y; aq1.u[2] = cQ[3].x; aq1.u[3] = cQ[3].y;
        aA.u[0] = cA.x; aA.u[1] = cA.y; aA.u[2] = 0u; aA.u[3] = 0u;
#pragma unroll
        for (int it = 0; it < 4; ++it) {
            Fr bS0, bS1, bV;
            bS0.u[0] = pack_bf16(S[0][it][0], S[0][it][1]); bS0.u[1] = pack_bf16(S[0][it][2], S[0][it][3]); bS0.u[2] = pack_bf16(S[1][it][0], S[1][it][1]); bS0.u[3] = pack_bf16(S[1][it][2], S[1][it][3]);
            bS1.u[0] = pack_bf16(S[2][it][0], S[2][it][1]); bS1.u[1] = pack_bf16(S[2][it][2], S[2][it][3]); bS1.u[2] = pack_bf16(S[3][it][0], S[3][it][1]); bS1.u[3] = pack_bf16(S[3][it][2], S[3][it][3]);
            bV.u[0] = cV[it].x; bV.u[1] = cV[it].y; bV.u[2] = 0u; bV.u[3] = 0u;
            f32x4 O = {0.f, 0.f, 0.f, 0.f};
            O = __builtin_amdgcn_mfma_f32_16x16x32_bf16(aq0.v, bS0.v, O, 0, 0, 0);
            O = __builtin_amdgcn_mfma_f32_16x16x32_bf16(aq1.v, bS1.v, O, 0, 0, 0);
            O = __builtin_amdgcn_mfma_f32_16x16x32_bf16(aA.v, bV.v, O, 0, 0, 0);
            bf16* od = hh + n0 * 1280 + 256 + d * 256 + h * 64 + 16 * it;
#pragma unroll
            for (int r = 0; r < 4; ++r) od[lo + (unsigned)(r * 1280)] = f2bf(O[r]);
#pragma unroll
            for (int jt = 0; jt < 4; ++jt) {
                Fr aK; aK.u[0] = cK[jt].x; aK.u[1] = cK[jt].y; aK.u[2] = 0u; aK.u[3] = 0u;
                f32x4 t = __builtin_amdgcn_mfma_f32_16x16x32_bf16(aK.v, bV.v, S[jt][it], 0, 0, 0);
                t[0] *= cE[jt].x; t[1] *= cE[jt].y; t[2] *= cE[jt].z; t[3] *= cE[jt].w;
                S[jt][it] = t;
            }
        }
    }
#undef HG_LOAD
}

DI void prep_rwkv_gpu(const Frame& F, int l) {
    const bf16* hz = WSP(bf16, OFF_HRWKV); bf16* r7 = WSP(bf16, OFF_R7); bf16* gb = WSP(bf16, OFF_G); float* bonus = WSP(float, OFF_BONUS);
    const float* mup = F.in[7] + l * 960; const float* mun = F.in[8] + l * 960;
    const float* w0 = F.in[9] + l * 512; const float* w2 = F.in[10] + (size_t)l * 2 * 32 * 256;
    const float* a0 = F.in[11] + l * 512; const float* a2 = F.in[12] + (size_t)l * 2 * 32 * 256;
    const float* g2 = F.in[13] + (size_t)l * 64 * 256;
    const size_t AS = (size_t)NTOK * 256;
    float* zs = (float*)F.smem;
    bf16* stg = (bf16*)(F.smem + 61440);
    float* nts = (float*)(F.smem + 61440 + 73728);
    float* xch = (float*)(F.smem + 143360);
    bf16* lin = (bf16*)(F.smem + 152576);
    float* kkp = xch; float* bop = xch + 128; float* csum = xch + 256;
    const int tid = F.tid, wv = F.wv;
    union WF { bf16x8 v; unsigned u[4]; };
    WF fw0[2], fw1[2], fa0[2], fa1[2], fg0[2], fg1[2];
    float cw0[2], cw1[2], ca0[2], ca1[2], ckk[2], cka[2], crk[2];
    { const int lane0 = tid & 63, x0 = lane0 & 15, q0 = lane0 >> 4;
#pragma unroll
      for (int ci = 0; ci < 2; ++ci) {
          const int c = 32 * wv + 16 * ci + x0;
#pragma unroll
          for (int p = 0; p < 4; ++p) { const int k = 8 * q0 + 2 * p;
              fw0[ci].u[p] = pack_bf16(w2[(size_t)k * 256 + c], w2[(size_t)(k + 1) * 256 + c]); fw1[ci].u[p] = pack_bf16(w2[(size_t)(32 + k) * 256 + c], w2[(size_t)(33 + k) * 256 + c]);
              fa0[ci].u[p] = pack_bf16(a2[(size_t)k * 256 + c], a2[(size_t)(k + 1) * 256 + c]); fa1[ci].u[p] = pack_bf16(a2[(size_t)(32 + k) * 256 + c], a2[(size_t)(33 + k) * 256 + c]);
              fg0[ci].u[p] = pack_bf16(g2[(size_t)k * 256 + c], g2[(size_t)(k + 1) * 256 + c]); fg1[ci].u[p] = pack_bf16(g2[(size_t)(32 + k) * 256 + c], g2[(size_t)(33 + k) * 256 + c]); }
          cw0[ci] = w0[c]; cw1[ci] = w0[256 + c]; ca0[ci] = a0[c]; ca1[ci] = a0[256 + c];
          ckk[ci] = F.in[14][l * 256 + c]; cka[ci] = F.in[15][l * 256 + c]; crk[ci] = F.in[16][l * 256 + c];
      } }
    for (int tile = blockIdx.x; tile < NTOK / 16; tile += F.nblk) {
        const int n0 = tile * 16;
        __syncthreads();
        const int tl = fresh_tid(F);
#pragma unroll
        for (int bt = 0; bt < 3; ++bt) {
            unsigned zc[5], zp[5], zn[5];
#pragma unroll
            for (int i = 0; i < 5; ++i) {
                const int e = tl + (bt * 5 + i) * NTH, t = e / 480, cc = (e % 480) * 2, n = n0 + t, s = n % SEQ;
                zc[i] = *reinterpret_cast<const unsigned*>(hz + (size_t)n * 1024 + cc);
                zp[i] = s > 0 ? *reinterpret_cast<const unsigned*>(hz + (size_t)(n - 1) * 1024 + cc) : 0u;
                zn[i] = s < SEQ - 1 ? *reinterpret_cast<const unsigned*>(hz + (size_t)(n + 1) * 1024 + cc) : 0u;
            }
#pragma unroll
            for (int i = 0; i < 5; ++i) {
                const int e = tl + (bt * 5 + i) * NTH, t = e / 480, cc = (e % 480) * 2;
                const float2 mp = *reinterpret_cast<const float2*>(mup + cc), mn = *reinterpret_cast<const float2*>(mun + cc);
                float v0 = bflo(zc[i]), v1 = bfhi(zc[i]);
                v0 = v0 + mp.x * (bflo(zp[i]) - v0) + mn.x * (bflo(zn[i]) - v0);
                v1 = v1 + mp.y * (bfhi(zp[i]) - v1) + mn.y * (bfhi(zn[i]) - v1);
                if (cc >= 768) {
                    if (cc < 832) { v0 = fast_tanh(v0); v1 = fast_tanh(v1); }
                    else if (cc >= 896) { v0 = fast_sigmoid(v0); v1 = fast_sigmoid(v1); }
                    *reinterpret_cast<unsigned*>(lin + t * 200 + (cc - 768)) = pack_bf16(v0, v1);
                } else *reinterpret_cast<float2*>(zs + t * 960 + cc) = make_float2(v0, v1);
            }
        }
        __syncthreads();
        const int lane = tl & 63, x = lane & 15, q = lane >> 4, hh_ = wv >> 1;
        f32x4 dW0[2], dW1[2], dA0[2], dA1[2], dG[2];
        { const bf16* lr = lin + x * 200 + 8 * q;
          const bf16x8 iw0 = *reinterpret_cast<const bf16x8*>(lr), iw1 = *reinterpret_cast<const bf16x8*>(lr + 32), ia0 = *reinterpret_cast<const bf16x8*>(lr + 64), ia1 = *reinterpret_cast<const bf16x8*>(lr + 96);
          const bf16x8 ig0 = *reinterpret_cast<const bf16x8*>(lr + 128), ig1 = *reinterpret_cast<const bf16x8*>(lr + 160);
          const f32x4 z4 = {0.f, 0.f, 0.f, 0.f};
#pragma unroll
          for (int ci = 0; ci < 2; ++ci) {
              dW0[ci] = __builtin_amdgcn_mfma_f32_16x16x32_bf16(iw0, fw0[ci].v, z4, 0, 0, 0); dW1[ci] = __builtin_amdgcn_mfma_f32_16x16x32_bf16(iw1, fw1[ci].v, z4, 0, 0, 0);
              dA0[ci] = __builtin_amdgcn_mfma_f32_16x16x32_bf16(ia0, fa0[ci].v, z4, 0, 0, 0); dA1[ci] = __builtin_amdgcn_mfma_f32_16x16x32_bf16(ia1, fa1[ci].v, z4, 0, 0, 0);
              dG[ci] = __builtin_amdgcn_mfma_f32_16x16x32_bf16(ig0, fg0[ci].v, z4, 0, 0, 0); dG[ci] = __builtin_amdgcn_mfma_f32_16x16x32_bf16(ig1, fg1[ci].v, dG[ci], 0, 0, 0);
          } }
        float lw0[2][4], lw1[2][4], G0[2][4], G1[2][4];
        float kp[4] = {0.f, 0.f, 0.f, 0.f};
#pragma unroll
        for (int ci = 0; ci < 2; ++ci) {
            const int c = 32 * wv + 16 * ci + x;
#pragma unroll
            for (int r = 0; r < 4; ++r) { lw0[ci][r] = -DECAY_SCALE * fast_sigmoid(dW0[ci][r] + cw0[ci]); lw1[ci][r] = -DECAY_SCALE * fast_sigmoid(dW1[ci][r] + cw1[ci]);
                const float kk = zs[(4 * q + r) * 960 + 256 + c] * ckk[ci]; kp[r] += kk * kk; }
            G0[ci][0] = lw0[ci][0]; G1[ci][3] = lw1[ci][3];
#pragma unroll
            for (int r = 1; r < 4; ++r) { G0[ci][r] = G0[ci][r - 1] + lw0[ci][r]; G1[ci][3 - r] = G1[ci][4 - r] + lw1[ci][3 - r]; }
            csum[(0 * 4 + q) * 256 + c] = G0[ci][3]; csum[(1 * 4 + q) * 256 + c] = G1[ci][0];
        }
#pragma unroll
        for (int r = 0; r < 4; ++r) { const float s = allsum16(kp[r]); if (x == 0) kkp[(4 * q + r) * 8 + wv] = s; }
        __syncthreads();
        float bp[4] = {0.f, 0.f, 0.f, 0.f};
#pragma unroll
        for (int ci = 0; ci < 2; ++ci) {
            const int c = 32 * wv + 16 * ci + x, j = c & 63;
            float off0 = 0.f, off1 = 0.f, tot0 = 0.f, tot1 = 0.f;
#pragma unroll
            for (int qq = 0; qq < 4; ++qq) { const float a = csum[(0 * 4 + qq) * 256 + c], b = csum[(1 * 4 + qq) * 256 + c]; tot0 += a; tot1 += b; if (qq < q) off0 += a; if (qq > q) off1 += b; }
            if (q == 0) { bf16* reg = WSP(bf16, OFF_REG) + ((size_t)(tile * 4 + hh_) * 2) * 64 + j; reg[0] = f2bf(__expf(tot0)); reg[64] = f2bf(__expf(tot1)); }
#pragma unroll
            for (int r = 0; r < 4; ++r) {
                const int tau = 4 * q + r, n = n0 + tau; const float* zr = zs + tau * 960;
                const float rv = zr[c], k = zr[256 + c];
                const float A0 = fast_sigmoid(dA0[ci][r] + ca0[ci]), A1 = fast_sigmoid(dA1[ci][r] + ca1[ci]);
                const float ss = kkp[tau * 8 + 2 * hh_] + kkp[tau * 8 + 2 * hh_ + 1];
                const float kkn = k * ckk[ci] * (1.0f / fmaxf(sqrtf(ss), 1e-12f));
                const float kd0 = k * (1.0f + (A0 - 1.0f) * cka[ci]), kd1 = k * (1.0f + (A1 - 1.0f) * cka[ci]);
                bp[r] += rv * (kd0 + kd1) * crk[ci];
                const float g0 = G0[ci][r] + off0, g1 = G1[ci][r] + off1;
                const float e0 = __expf(g0), e1 = __expf(g1), i0 = __expf(-g0), i1 = __expf(-g1);
                const float kt0 = kkn * __expf(g0 - lw0[ci][r]), kt1 = kkn * __expf(g1 - lw1[ci][r]);
                bf16* s0 = stg + (size_t)((hh_ * 2 + 0) * 4) * 1152 + tau * 72 + j; bf16* s1 = stg + (size_t)((hh_ * 2 + 1) * 4) * 1152 + tau * 72 + j;
                s0[0] = f2bf(kt0); s0[1152] = f2bf(rv * e0); s0[2 * 1152] = f2bf(A0 * kkn * i0); s0[3 * 1152] = f2bf(kd0 * i0);
                s1[0] = f2bf(kt1); s1[1152] = f2bf(rv * e1); s1[2 * 1152] = f2bf(A1 * kkn * i1); s1[3 * 1152] = f2bf(kd1 * i1);
                gb[(size_t)n * 256 + c] = f2bf(dG[ci][r]);
            }
        }
#pragma unroll
        for (int r = 0; r < 4; ++r) { const float s = allsum16(bp[r]); if (x == 0) bop[(4 * q + r) * 8 + wv] = s; }
        __syncthreads();
        if (tl < 64) bonus[(size_t)(n0 + (tl >> 2)) * 4 + (tl & 3)] = bop[(tl >> 2) * 8 + 2 * (tl & 3)] + bop[(tl >> 2) * 8 + 2 * (tl & 3) + 1];
        __syncthreads();
        {
            const int wv = F.wv, lane = fresh_tid(F) & 63, x = lane & 15, q = lane >> 4, dd = wv & 1;
            const bf16* base = stg + (size_t)(wv * 4) * 1152;
            f32x4 nt = {0.f, 0.f, 0.f, 0.f}, mkk = nt, mkr = nt, mar = nt;
#pragma unroll
            for (int ks = 0; ks < 2; ++ks) {
                const bf16x8 fk = *reinterpret_cast<const bf16x8*>(base + x * 72 + 32 * ks + 8 * q);
                const bf16x8 fr = *reinterpret_cast<const bf16x8*>(base + 1152 + x * 72 + 32 * ks + 8 * q);
                const bf16x8 fa = *reinterpret_cast<const bf16x8*>(base + 2 * 1152 + x * 72 + 32 * ks + 8 * q);
                const bf16x8 fs = *reinterpret_cast<const bf16x8*>(base + 3 * 1152 + x * 72 + 32 * ks + 8 * q);
                nt = __builtin_amdgcn_mfma_f32_16x16x32_bf16(fk, fa, nt, 0, 0, 0);
                mkk = __builtin_amdgcn_mfma_f32_16x16x32_bf16(fk, fs, mkk, 0, 0, 0);
                mkr = __builtin_amdgcn_mfma_f32_16x16x32_bf16(fr, fs, mkr, 0, 0, 0);
                mar = __builtin_amdgcn_mfma_f32_16x16x32_bf16(fr, fa, mar, 0, 0, 0);
            }
            bf16* yc = WSP(bf16, OFF_YCAT); bf16* side = WSP(bf16, OFF_RSIDE);
            float* ntw = nts + wv * 256;
            auto mat_ptr = [&](int m) -> bf16* { const int sidx = wv * 4 + m;
                return sidx < 28 ? yc + (size_t)(n0 + 1 + (sidx >> 1)) * 1024 + 256 + (sidx & 1) * 256 : side + ((size_t)tile * 4 + (sidx - 28)) * 256; };
            bf16* m0 = mat_ptr(0); bf16* m2 = mat_ptr(2); bf16* m3 = mat_ptr(3);
#pragma unroll
            for (int r = 0; r < 4; ++r) {
                const int t = 4 * q + r; const bool strict = dd ? (x > t) : (x < t), beq = dd ? (x >= t) : (x <= t);
                const int pos = ((x >> 2) * 16 + t) * 4 + (x & 3);
                ntw[t * 16 + x] = strict ? nt[r] : 0.f;
                m0[pos] = f2bf(strict ? mkk[r] : 0.f); m2[pos] = f2bf(beq ? mkr[r] : 0.f); m3[pos] = f2bf(beq ? -mar[r] : 0.f);
            }
            const size_t blk = ((size_t)tile * 4 + (wv >> 1)) * 1024;
            {
                bf16* dk = r7 + (dd ? C_KT1 : C_KT0) * AS + blk; bf16* dr = r7 + (dd ? C_RT1 : C_RT0) * AS + blk;
#pragma unroll
                for (int ks = 0; ks < 2; ++ks) {
                    const uint2 k0 = *reinterpret_cast<const uint2*>(base + x * 72 + 32 * ks + 4 * q), k1 = *reinterpret_cast<const uint2*>(base + x * 72 + 32 * ks + 16 + 4 * q);
                    const uint2 r0 = *reinterpret_cast<const uint2*>(base + 1152 + x * 72 + 32 * ks + 4 * q), r1 = *reinterpret_cast<const uint2*>(base + 1152 + x * 72 + 32 * ks + 16 + 4 * q);
                    *reinterpret_cast<uint4*>(dk + (ks * 64 + lane) * 8) = make_uint4(k0.x, k0.y, k1.x, k1.y);
                    *reinterpret_cast<uint4*>(dr + (ks * 64 + lane) * 8) = make_uint4(r0.x, r0.y, r1.x, r1.y);
                }
            }
            {
                bf16* ds_ = r7 + (dd ? C_KK1 : C_KK0) * AS + blk; bf16* da = r7 + (dd ? C_AT1 : C_AT0) * AS + blk; bf16* dv = r7 + C_VT * AS + blk;
                const bf16* sa = base + 2 * 1152; const bf16* sk = base + 3 * 1152;
                const float* zv = zs + 512 + (wv >> 1) * 64;
#pragma unroll
                for (int u = 0; u < 4; ++u) {
                    const int ch = 16 * u + x;
                    const unsigned a0 = sa[(4 * q) * 72 + ch], a1 = sa[(4 * q + 1) * 72 + ch], a2 = sa[(4 * q + 2) * 72 + ch], a3 = sa[(4 * q + 3) * 72 + ch];
                    const unsigned k0 = sk[(4 * q) * 72 + ch], k1 = sk[(4 * q + 1) * 72 + ch], k2 = sk[(4 * q + 2) * 72 + ch], k3 = sk[(4 * q + 3) * 72 + ch];
                    *reinterpret_cast<uint2*>(ds_ + (u * 64 + lane) * 4) = make_uint2(k0 | (k1 << 16), k2 | (k3 << 16));
                    *reinterpret_cast<uint2*>(da + (u * 64 + lane) * 4) = make_uint2((a0 | (a1 << 16)) ^ 0x80008000u, (a2 | (a3 << 16)) ^ 0x80008000u);
                    if (dd == 0) *reinterpret_cast<uint2*>(dv + (u * 64 + lane) * 4) =
                        make_uint2(pack_bf16(zv[(4 * q) * 960 + ch], zv[(4 * q + 1) * 960 + ch]), pack_bf16(zv[(4 * q + 2) * 960 + ch], zv[(4 * q + 3) * 960 + ch]));
                }
            }
            asm volatile("s_waitcnt lgkmcnt(0)" ::: "memory");
            __builtin_amdgcn_wave_barrier();
            if (lane < 16) {
                float X[16];
                if (dd == 0) {
#pragma unroll
                    for (int t = 0; t < 16; ++t) { float a = (t == lane) ? 1.f : 0.f;
#pragma unroll
                        for (int s2 = 0; s2 < t; ++s2) a -= ntw[t * 16 + s2] * X[s2];
                        X[t] = a; }
                } else {
#pragma unroll
                    for (int t = 15; t >= 0; --t) { float a = (t == lane) ? 1.f : 0.f;
#pragma unroll
                        for (int s2 = t + 1; s2 < 16; ++s2) a -= ntw[t * 16 + s2] * X[s2];
                        X[t] = a; }
                }
                bf16* m1 = mat_ptr(1);
#pragma unroll
                for (int t = 0; t < 16; ++t) m1[((lane >> 2) * 16 + t) * 4 + (lane & 3)] = f2bf(X[t]);
            }
        }
    }
}

DI void scan_rwkv_chunk(const Frame& F, int chain) {
    const int d = chain / (BATCH * 4), b = (chain / 4) % BATCH, h = chain % 4, combo = h * 2 + d;
    const int lane = fresh_tid(F) & 63, q = lane >> 4;
    const size_t AS = (size_t)NTOK * 256;
    bf16* r7 = WSP(bf16, OFF_R7); const bf16* yc = WSP(bf16, OFF_YCAT); const bf16* side = WSP(bf16, OFF_RSIDE); const bf16* reg = WSP(bf16, OFF_REG);
    bf16* akt = r7 + (d ? C_KT1 : C_KT0) * AS; const bf16* art = r7 + (d ? C_RT1 : C_RT0) * AS;
    const bf16* akk = r7 + (d ? C_KK1 : C_KK0) * AS; const bf16* aat = r7 + (d ? C_AT1 : C_AT0) * AS; const bf16* avt = r7 + C_VT * AS;
    f32x4 Z[4][4];
#pragma unroll
    for (int a = 0; a < 4; ++a)
#pragma unroll
        for (int c = 0; c < 4; ++c) Z[a][c] = (f32x4){0.f, 0.f, 0.f, 0.f};
    constexpr int NCH = SEQ / 16;
    const unsigned l8 = (unsigned)lane * 8, l4 = (unsigned)lane * 4, le = (unsigned)(4 * q);
    uint4 nK[2], nR[2]; uint2 nM[4], nV[4];
#define RW_MPTR(tl_, m_) ((combo * 4 + (m_)) < 28 ? yc + (size_t)((tl_) * 16 + 1 + ((combo * 4 + (m_)) >> 1)) * 1024 + 256 + ((combo * 4 + (m_)) & 1) * 256 \
                                                   : side + ((size_t)(tl_) * 4 + (combo * 4 + (m_) - 28)) * 256)
#define RW_LOAD(cc_) do { const int c_ = d ? NCH - 1 - (cc_) : (cc_); const unsigned tl_ = (unsigned)(b * NCH + c_); const size_t bo_ = ((size_t)tl_ * 4 + h) * 1024; \
        nK[0] = *reinterpret_cast<const uint4*>(akt + bo_ + l8); nK[1] = *reinterpret_cast<const uint4*>(akt + bo_ + 512 + l8); \
        nR[0] = *reinterpret_cast<const uint4*>(art + bo_ + l8); nR[1] = *reinterpret_cast<const uint4*>(art + bo_ + 512 + l8); \
        _Pragma("unroll") for (int u_ = 0; u_ < 4; ++u_) { nM[u_] = *reinterpret_cast<const uint2*>(RW_MPTR(tl_, u_) + l4); nV[u_] = *reinterpret_cast<const uint2*>(avt + bo_ + u_ * 256 + l4); } } while (0)
    RW_LOAD(0);
    for (int cc = 0; cc < NCH; ++cc) {
        const int c = d ? NCH - 1 - cc : cc; const unsigned tl = (unsigned)(b * NCH + c); const size_t bo = ((size_t)tl * 4 + h) * 1024;
        uint2 cS[4], cA[4], cE[4];
        { const bf16* eb_ = reg + (size_t)((tl * 4 + h) * 2 + d) * 64;
#pragma unroll
          for (int u = 0; u < 4; ++u) { cS[u] = *reinterpret_cast<const uint2*>(akk + bo + u * 256 + l4); cA[u] = *reinterpret_cast<const uint2*>(aat + bo + u * 256 + l4);
              cE[u] = *reinterpret_cast<const uint2*>(eb_ + le + 16 * u); } }
        union Fr { bf16x8 v; unsigned u[4]; uint4 w; };
        Fr aK0, aK1, aR0, aR1, aMk, aTT, aY;
        aK0.w = nK[0]; aK1.w = nK[1]; aR0.w = nR[0]; aR1.w = nR[1];
        aMk.u[0] = nM[0].x; aMk.u[1] = nM[0].y; aMk.u[2] = 0u; aMk.u[3] = 0u;
        aTT.u[0] = nM[1].x; aTT.u[1] = nM[1].y; aTT.u[2] = 0u; aTT.u[3] = 0u;
        aY.u[0] = nM[2].x; aY.u[1] = nM[2].y; aY.u[2] = nM[3].x; aY.u[3] = nM[3].y;
        uint2 cV[4];
#pragma unroll
        for (int u = 0; u < 4; ++u) cV[u] = nV[u];
        if (cc + 1 < NCH) RW_LOAD(cc + 1);
        float eg[4][4];
#pragma unroll
        for (int u = 0; u < 4; ++u) { eg[u][0] = bflo(cE[u].x); eg[u][1] = bfhi(cE[u].x); eg[u][2] = bflo(cE[u].y); eg[u][3] = bfhi(cE[u].y); }
#pragma unroll
        for (int it = 0; it < 4; ++it) {
            Fr bZ0, bZ1, bV, bB, bVU;
            bZ0.u[0] = pack_bf16(Z[0][it][0], Z[0][it][1]); bZ0.u[1] = pack_bf16(Z[0][it][2], Z[0][it][3]); bZ0.u[2] = pack_bf16(Z[1][it][0], Z[1][it][1]); bZ0.u[3] = pack_bf16(Z[1][it][2], Z[1][it][3]);
            bZ1.u[0] = pack_bf16(Z[2][it][0], Z[2][it][1]); bZ1.u[1] = pack_bf16(Z[2][it][2], Z[2][it][3]); bZ1.u[2] = pack_bf16(Z[3][it][0], Z[3][it][1]); bZ1.u[3] = pack_bf16(Z[3][it][2], Z[3][it][3]);
            const f32x4 zero = {0.f, 0.f, 0.f, 0.f};
            f32x4 P1 = __builtin_amdgcn_mfma_f32_16x16x32_bf16(aK0.v, bZ0.v, zero, 0, 0, 0); P1 = __builtin_amdgcn_mfma_f32_16x16x32_bf16(aK1.v, bZ1.v, P1, 0, 0, 0);
            f32x4 P2 = __builtin_amdgcn_mfma_f32_16x16x32_bf16(aR0.v, bZ0.v, zero, 0, 0, 0); P2 = __builtin_amdgcn_mfma_f32_16x16x32_bf16(aR1.v, bZ1.v, P2, 0, 0, 0);
            bV.u[0] = cV[it].x; bV.u[1] = cV[it].y; bV.u[2] = 0u; bV.u[3] = 0u;
            const f32x4 Bt = __builtin_amdgcn_mfma_f32_16x16x32_bf16(aMk.v, bV.v, P1, 0, 0, 0);
            bB.u[0] = pack_bf16(Bt[0], Bt[1]); bB.u[1] = pack_bf16(Bt[2], Bt[3]); bB.u[2] = 0u; bB.u[3] = 0u;
            const f32x4 Ut = __builtin_amdgcn_mfma_f32_16x16x32_bf16(aTT.v, bB.v, zero, 0, 0, 0);
            bVU.u[0] = cV[it].x; bVU.u[1] = cV[it].y; bVU.u[2] = pack_bf16(Ut[0], Ut[1]); bVU.u[3] = pack_bf16(Ut[2], Ut[3]);
            const f32x4 Y = __builtin_amdgcn_mfma_f32_16x16x32_bf16(aY.v, bVU.v, P2, 0, 0, 0);
            *reinterpret_cast<uint2*>(akt + bo + it * 256 + l4) = make_uint2(pack_bf16(Y[0], Y[1]), pack_bf16(Y[2], Y[3]));
#pragma unroll
            for (int jt = 0; jt < 4; ++jt) {
                Fr aS; aS.u[0] = cS[jt].x; aS.u[1] = cS[jt].y; aS.u[2] = cA[jt].x; aS.u[3] = cA[jt].y;
                f32x4 t = __builtin_amdgcn_mfma_f32_16x16x32_bf16(aS.v, bVU.v, Z[jt][it], 0, 0, 0);
                t[0] *= eg[jt][0]; t[1] *= eg[jt][1]; t[2] *= eg[jt][2]; t[3] *= eg[jt][3];
                Z[jt][it] = t;
            }
        }
    }
#undef RW_LOAD
#undef RW_MPTR
}
#endif

DI void phase_prep(const Frame& F, int l) {
#ifndef CPU_EMU
    prep_attn_gpu(F, l); prep_rwkv_gpu(F, l); prep_hgrn_gpu(F, l);
#else
    {
        bf16* hatt = WSP(bf16, OFF_HATT); bf16* vt = WSP(bf16, OFF_VTATT);
        const float* qn = F.in[5] + l * 64; const float* kn = F.in[6] + l * 64;
        const int nitem = NTOK * 6;
        for (int it = ggrp(F); it < nitem; it += ngrp(F)) {
            const int n = it / 6, hh = it % 6;
            const int s = n % SEQ;
            bf16* p = hatt + (size_t)n * 512 + hh * 64;
            const float* gn = hh < 4 ? qn : kn;
            float v[PER64]; float ss = 0.f;
            for (int i = 0; i < PER64; ++i) { int j = glane(F) + i * GRP; v[i] = bf2f(p[j]); ss += v[i] * v[i]; }
            ss = grp_sum(F, ss); const float rs = 1.0f / sqrtf(ss * (1.0f / 64.0f) + RMS_EPS);
            float o[PER64];
#ifdef CPU_EMU
            float nv[64]; for (int j = 0; j < 64; ++j) nv[j] = v[j] * rs * gn[j];
#endif
            for (int i = 0; i < PER64; ++i) {
                int j = glane(F) + i * GRP;
                const int half = j >> 5, w = j & 31, f = w & 15, second = w >> 4;
                const float pos = half == 0 ? (float)(s / GRIDW) : (float)(s % GRIDW);
                const float ang = pos * rope_inv(2 * f, 32);
                const float cs = cosf(ang), sn = sinf(ang);
                const float mine = v[i] * rs * gn[j];
                const int jp = second ? j - 16 : j + 16;
#ifdef CPU_EMU
                const float partner = nv[jp];
#else
                const float partner = shfl_idx(F, v[0], jp) * rs * gn[jp];
#endif
                o[i] = second ? (partner * sn + mine * cs) : (mine * cs - partner * sn);
            }
            for (int i = 0; i < PER64; ++i) { int j = glane(F) + i * GRP; p[j] = f2bf(o[i]); }
        }
        for (size_t i = gtid_(F); i < (size_t)NTOK * 128; i += gthreads(F)) {
            const int n = (int)(i / 128), c = (int)(i % 128), b = n / SEQ, s = n % SEQ;
            vt[((size_t)b * 128 + c) * SEQ + s] = hatt[(size_t)n * 512 + 384 + c];
        }
    }
    {
        bf16* hm = WSP(bf16, OFF_HMLA); bf16* kr = WSP(bf16, OFF_KROPE);
        const float* qn = F.in[21] + l * 192; const float* kvn = F.in[22] + l * 128;
        for (int it = ggrp(F); it < NTOK * 2; it += ngrp(F)) {
            const int n = it >> 1, which = it & 1;
            bf16* p = hm + (size_t)n * 512 + (which ? 256 : 0);
            const int len = which ? 128 : 192; const float* gn = which ? kvn : qn;
            float ss = 0.f;
            for (int j = glane(F); j < len; j += GRP) { float x = bf2f(p[j]); ss += x * x; }
            ss = grp_sum(F, ss); const float rs = 1.0f / sqrtf(ss / (float)len + RMS_EPS);
            for (int j = glane(F); j < len; j += GRP) p[j] = f2bf(bf2f(p[j]) * rs * gn[j]);
        }
        for (int i = gtid_(F); i < NTOK * 16; i += gthreads(F)) {
            const int n = i >> 4, m = i & 15, s = n % SEQ;
            const bf16* src = hm + (size_t)n * 512 + 192;
            const int i1 = (m < 8 ? m : 16 + (m - 8)), i2 = i1 + 8;
            const float x1 = bf2f(src[i1]), x2 = bf2f(src[i2]);
            const float pos = m < 8 ? (float)(s / GRIDW) : (float)(s % GRIDW);
            const float ang = pos * rope_inv(2 * (m & 7), 16);
            const float cs = cosf(ang), sn = sinf(ang);
            kr[(size_t)n * 32 + 2 * m] = f2bf(x1 * cs - x2 * sn);
            kr[(size_t)n * 32 + 2 * m + 1] = f2bf(x1 * sn + x2 * cs);
        }
    }
#ifdef CPU_EMU
    {
        const bf16* hz = WSP(bf16, OFF_HRWKV); bf16* r7 = WSP(bf16, OFF_R7); bf16* gb = WSP(bf16, OFF_G); float* bonus = WSP(float, OFF_BONUS);
        const float* mup = F.in[7] + l * 960; const float* mun = F.in[8] + l * 960;
        const float* w0 = F.in[9] + l * 512; const float* w2 = F.in[10] + (size_t)l * 2 * 32 * 256;
        const float* a0 = F.in[11] + l * 512; const float* a2 = F.in[12] + (size_t)l * 2 * 32 * 256;
        const float* g2 = F.in[13] + (size_t)l * 64 * 256;
        const float* k_k = F.in[14] + l * 256; const float* k_a = F.in[15] + l * 256; const float* r_k = F.in[16] + l * 256;
        const size_t AS = (size_t)NTOK * 256;
        for (int it = ggrp(F); it < NTOK * 4; it += ngrp(F)) {
            const int n = it >> 2, h = it & 3, s = n % SEQ;
            const bf16* z = hz + (size_t)n * 1024;
            const bool hp = s > 0, hn = s < SEQ - 1;
            auto shifted = [&](int c) -> float {
                const float zc = bf2f(z[c]);
                const float zp = hp ? bf2f(z[c - 1024]) : 0.f, zn = hn ? bf2f(z[c + 1024]) : 0.f;
                return zc + mup[c] * (zp - zc) + mun[c] * (zn - zc);
            };
            float kkv[PER64], rr[PER64], kd0[PER64], kd1[PER64], aa0[PER64], aa1[PER64];
            float ss = 0.f, bs = 0.f;
            for (int i = 0; i < PER64; ++i) {
                const int j = glane(F) + i * GRP, c = h * 64 + j;
                const float r = shifted(c), k = shifted(256 + c), v = shifted(512 + c);
                float wr0 = w0[c], wr1 = w0[256 + c], ar0 = a0[c], ar1 = a0[256 + c], g = 0.f;
                for (int q = 0; q < 32; ++q) {
                    wr0 += tanhf(shifted(768 + q)) * w2[(size_t)q * 256 + c];
                    wr1 += tanhf(shifted(800 + q)) * w2[(size_t)(32 + q) * 256 + c];
                    ar0 += shifted(832 + q) * a2[(size_t)q * 256 + c];
                    ar1 += shifted(864 + q) * a2[(size_t)(32 + q) * 256 + c];
                }
                for (int q = 0; q < 64; ++q) g += sigmoidf_(shifted(896 + q)) * g2[(size_t)q * 256 + c];
                const float dec0 = expf(-DECAY_SCALE * sigmoidf_(wr0)), dec1 = expf(-DECAY_SCALE * sigmoidf_(wr1));
                const float A0 = sigmoidf_(ar0), A1 = sigmoidf_(ar1);
                const float kk = k * k_k[c];
                kkv[i] = kk; ss += kk * kk; rr[i] = r; aa0[i] = A0; aa1[i] = A1;
                kd0[i] = k * (1.0f + (A0 - 1.0f) * k_a[c]); kd1[i] = k * (1.0f + (A1 - 1.0f) * k_a[c]);
                bs += r * (kd0[i] + kd1[i]) * r_k[c];
                const size_t o = (size_t)n * 256 + c;
                r7[R_R * AS + o] = f2bf(r); r7[R_V * AS + o] = f2bf(v);
                r7[R_W0 * AS + o] = f2bf(dec0); r7[R_W1 * AS + o] = f2bf(dec1);
                r7[R_KD0 * AS + o] = f2bf(kd0[i]); r7[R_KD1 * AS + o] = f2bf(kd1[i]);
                gb[o] = f2bf(g);
            }
            ss = grp_sum(F, ss); bs = grp_sum(F, bs);
            const float inv = 1.0f / fmaxf(sqrtf(ss), 1e-12f);
            for (int i = 0; i < PER64; ++i) {
                const int j = glane(F) + i * GRP, c = h * 64 + j; const size_t o = (size_t)n * 256 + c;
                const float kk = kkv[i] * inv;
                r7[R_KK * AS + o] = f2bf(kk); r7[R_AK0 * AS + o] = f2bf(aa0[i] * kk); r7[R_AK1 * AS + o] = f2bf(aa1[i] * kk);
            }
            if (glane(F) == 0) bonus[(size_t)n * 4 + h] = bs;
        }
    }
#else
    prep_rwkv_gpu(F, l);
#endif
    {
        bf16* hh = WSP(bf16, OFF_HHGRN);
        const float* lg = F.in[19];
        for (size_t i = gtid_(F); i < (size_t)NTOK * 768; i += gthreads(F)) {
            const int n = (int)(i / 768), c = (int)(i % 768);
            bf16* p = hh + (size_t)n * 1280 + c;
            const float x = bf2f(*p);
            if (c < 256) { *p = f2bf(siluf_(x)); }
            else {
                const int d = c & 255;
                float lb = 0.f;
                if (l == 1) { const float a = lg[d], b = lg[256 + d]; const float m = fmaxf(a, b); const float ea = expf(a - m), eb = expf(b - m); lb = eb / (ea + eb); }
                *p = f2bf((1.0f - lb) * sigmoidf_(-x));
            }
        }
    }
#endif
}

struct EpiQMla {
    bf16* q; int row0, pn; const float* tab;
    DI void operator()(int r, int c, float a, float b, float cc, float d) const {
        const int row = row0 + r, col = pn * 256 + c;
        if (col >= 384) return;
        const int w = col % 96;
        if (w >= 64) {
            const int s = row % SEQ;
#pragma unroll
            for (int t = 0; t < 2; ++t) {
                const int m = ((w - 64) >> 1) + t;
#ifdef CPU_EMU
                const float pos = m < 8 ? (float)(s / GRIDW) : (float)(s % GRIDW);
                const float ang = pos * rope_inv(2 * (m & 7), 16);
                const float cs = cosf(ang), sn = sinf(ang);
#else
                const int pi = m < 8 ? s / GRIDW : s % GRIDW;
                const float cs = tab[pi * 8 + (m & 7)], sn = tab[512 + pi * 8 + (m & 7)];
#endif
                float& x1 = t ? cc : a; float& x2 = t ? d : b;
                const float y1 = x1 * cs - x2 * sn, y2 = x1 * sn + x2 * cs; x1 = y1; x2 = y2;
            }
        }
        st_bf16x4(q + (size_t)row * 384 + col, a, b, cc, d);
    }
};
struct EpiKVMla {
    bf16* kn; bf16* vt; int row0, pn;
    DI void operator()(int r, int c, float a, float b, float cc, float d) const {
        const int row = row0 + r, col = pn * 256 + c, h = col >> 7, w = col & 127;
        if (w < 64) st_bf16x4(kn + (size_t)row * 256 + h * 64 + w, a, b, cc, d);
        else { const int bb = row / SEQ, s = row % SEQ; bf16* p = vt + ((size_t)bb * 256 + h * 64 + (w - 64)) * SEQ + s;
            p[0] = f2bf(a); p[SEQ] = f2bf(b); p[2 * SEQ] = f2bf(cc); p[3 * SEQ] = f2bf(d); }
    }
};
DI void phase_mlaup(const Frame& F) {
    const bf16* hm = WSP(bf16, OFF_HMLA); const char* wts = (const char*)WSP(bf16, OFF_WTS);
    const int nM = (NTOK + 255) / 256;
    float* rtab = (float*)(F.smem + 139264);
#ifndef CPU_EMU
    __syncthreads();
    { const int i = fresh_tid(F); const int pos = i >> 3, f = i & 7; const float ang = (float)pos * rope_inv(2 * f, 16); rtab[i] = cosf(ang); rtab[512 + i] = sinf(ang); }
    __syncthreads();
#endif
    for (int u = blockIdx.x; u < nM * 4; u += F.nblk) {
        const int pm = u >> 2, j = u & 3;
#ifdef CPU_EMU
        const int mr = min(256, NTOK - pm * 256);
#define MR , mr
#else
#define MR
#endif
        if (j < 2) { EpiQMla E{WSP(bf16, OFF_QMLA), pm * 256, j, rtab};
            gemm_unit(F, hm, 512, nullptr, pm * 256, (const bf16*)(wts + W_UQ_T), 256, j * 256, 256, E MR); }
        else { EpiKVMla E{WSP(bf16, OFF_KNOPE), WSP(bf16, OFF_VTMLA), pm * 256, j - 2};
            gemm_unit(F, hm + 256, 512, nullptr, pm * 256, (const bf16*)(wts + W_UKV_T), 256, (j - 2) * 256, 256, E MR); }
    }
}

struct AttnDesc {
    const bf16* q; int q_stride;
    int q_hstride;
    const bf16* k; int k_stride; int k_hstride;
    const bf16* k2; int k2_stride;
    int dk_main;
    const bf16* vt;
    bf16* o; int o_stride; int o_hstride;
    int H, HKV, SQ, SK;
    float scale;
};

#ifdef CPU_EMU
template <int DK, int DV>
void attn_phase(const Frame& F, const AttnDesc& A) {
    const int G = A.H / A.HKV;
    float* sc = (float*)malloc(sizeof(float) * A.SK);
    for (int b = 0; b < BATCH; ++b) for (int h = 0; h < A.H; ++h) for (int s = 0; s < A.SQ; ++s) {
        const int kv = h / G;
        const bf16* q = A.q + (size_t)(b * A.SQ + s) * A.q_stride + h * A.q_hstride;
        float mx = -1e30f;
        for (int key = 0; key < A.SK; ++key) {
            const bf16* kp = A.k + (size_t)(b * A.SK + key) * A.k_stride + kv * A.k_hstride;
            double acc = 0;
            for (int d = 0; d < DK; ++d) {
                float kvl = d < A.dk_main ? bf2f(kp[d]) : bf2f(A.k2[(size_t)(b * A.SK + key) * A.k2_stride + d - A.dk_main]);
                acc += (double)bf2f(q[d]) * kvl;
            }
            sc[key] = (float)acc * A.scale; mx = fmaxf(mx, sc[key]);
        }
        double sum = 0; for (int key = 0; key < A.SK; ++key) { sc[key] = expf(sc[key] - mx); sum += sc[key]; }
        for (int dv = 0; dv < DV; ++dv) {
            const bf16* vp = A.vt + ((size_t)(b * A.HKV + kv) * DV + dv) * A.SK;
            double acc = 0; for (int key = 0; key < A.SK; ++key) acc += (double)bf2f(f2bf(sc[key])) * bf2f(vp[key]);
            A.o[(size_t)(b * A.SQ + s) * A.o_stride + h * A.o_hstride + dv] = f2bf((float)(acc / sum));
        }
    }
    free(sc);
}
#else
DI int crow16(int reg, int h) { return (reg & 3) + 8 * (reg >> 2) + 4 * h; }
template <int DK, int DV, int DVT, int NQB>
DI void attn_unit(const Frame& F, const AttnDesc& A, int u) {
    constexpr int KP = DK + 8;
    constexpr int VP = 64 + 8;
    constexpr int NPASS = DV / DVT;
    constexpr int UQ = 256 * NQB;
    bf16* Ks = (bf16*)F.smem;
    bf16* Vs = Ks + 64 * KP;
    const int tid = fresh_tid(F), wave = F.wv, lane = tid & 63, r = lane & 31, hh = lane >> 5;
    const int G = A.H / A.HKV;
    const int nqb = A.SQ / UQ;
    const float sl2 = A.scale * 1.4426950408889634f;
    {
        int t = u; const int pass = t % NPASS; t /= NPASS; const int qb = t % nqb; t /= nqb; const int h = t % A.H; const int b = t / A.H;
        const int kv = h / G;
        const int q0 = qb * UQ + wave * 32 * NQB;
        bf16x8 qf[NQB][DK / 16];
#pragma unroll
        for (int qi = 0; qi < NQB; ++qi) { const bf16* qp = A.q + (size_t)(b * A.SQ + q0 + 32 * qi + r) * A.q_stride + h * A.q_hstride + 8 * hh;
#pragma unroll
          for (int ks = 0; ks < DK / 16; ++ks) qf[qi][ks] = *reinterpret_cast<const bf16x8*>(qp + 16 * ks); }
        f32x16 oacc[NQB][DVT / 32];
#pragma unroll
        for (int qi = 0; qi < NQB; ++qi)
#pragma unroll
            for (int i = 0; i < DVT / 32; ++i)
#pragma unroll
                for (int j = 0; j < 16; ++j) oacc[qi][i][j] = 0.f;
        float mrun[NQB], lrun[NQB];
#pragma unroll
        for (int qi = 0; qi < NQB; ++qi) { mrun[qi] = -INFINITY; lrun[qi] = 0.f; }
        constexpr int NKC = (64 * (DK / 8) + 511) / 512, NVC = (DVT * 8 + 511) / 512;
        uint4 kr0, kr1, kr2, kr3, vr0, vr1;
        kr0 = kr1 = kr2 = kr3 = vr0 = vr1 = make_uint4(0u, 0u, 0u, 0u);
#define ATT_FK(kt_, i_, reg_) do { if ((i_) < NKC) { int c_ = tid + (i_) * 512; if (c_ >= 64 * (DK / 8)) c_ = 64 * (DK / 8) - 1; \
            const int key_ = c_ / (DK / 8), d8_ = (c_ % (DK / 8)) * 8; const size_t krow_ = (size_t)(b * A.SK + (kt_) * 64 + key_); \
            const bf16* kp_ = (d8_ < A.dk_main) ? (A.k + krow_ * A.k_stride + kv * A.k_hstride + d8_) : (A.k2 + krow_ * A.k2_stride + (d8_ - A.dk_main)); \
            reg_ = *reinterpret_cast<const uint4*>(kp_); } } while (0)
#define ATT_FV(kt_, i_, reg_) do { if ((i_) < NVC) { int c_ = tid + (i_) * 512; if (c_ >= DVT * 8) c_ = DVT * 8 - 1; \
            const int dv_ = c_ >> 3, k8_ = (c_ & 7) * 8; \
            reg_ = *reinterpret_cast<const uint4*>(A.vt + ((size_t)(b * A.HKV + kv) * DV + pass * DVT + dv_) * A.SK + (kt_) * 64 + k8_); } } while (0)
#define ATT_FETCH(kt_) do { ATT_FK(kt_, 0, kr0); ATT_FK(kt_, 1, kr1); ATT_FK(kt_, 2, kr2); ATT_FK(kt_, 3, kr3); ATT_FV(kt_, 0, vr0); ATT_FV(kt_, 1, vr1); } while (0)
#define ATT_SK(kb_, i_, reg_) do { if ((i_) < NKC) { const int c_ = tid + (i_) * 512; if (c_ < 64 * (DK / 8)) { \
            const int key_ = c_ / (DK / 8), d8_ = (c_ % (DK / 8)) * 8; *reinterpret_cast<uint4*>((kb_) + key_ * KP + d8_) = reg_; } } } while (0)
#define ATT_SV(vb_, i_, reg_) do { if ((i_) < NVC) { const int c_ = tid + (i_) * 512; if (c_ < DVT * 8) { \
            const int dv_ = c_ >> 3, k8_ = (c_ & 7) * 8; *reinterpret_cast<uint4*>((vb_) + dv_ * VP + k8_) = reg_; } } } while (0)
#define ATT_STORE(kb_, vb_) do { ATT_SK(kb_, 0, kr0); ATT_SK(kb_, 1, kr1); ATT_SK(kb_, 2, kr2); ATT_SK(kb_, 3, kr3); ATT_SV(vb_, 0, vr0); ATT_SV(vb_, 1, vr1); } while (0)
        constexpr bool PREF = DK <= 96;
        constexpr int BUFE = 64 * KP + DVT * VP;
        const int ntile = A.SK / 64;
        if (PREF) { ATT_FETCH(0); ATT_STORE(Ks, Vs); if (ntile > 1) ATT_FETCH(1); __syncthreads(); }
        for (int kt = 0; kt < ntile; ++kt) {
            if (PREF) {
                if (kt + 1 < ntile) { bf16* kb = Ks + ((kt + 1) & 1) * BUFE; ATT_STORE(kb, kb + 64 * KP); if (kt + 2 < ntile) ATT_FETCH(kt + 2); }
            } else {
            __syncthreads();
            {
                for (int c = tid; c < 64 * (DK / 8); c += 512) {
                    const int key = c / (DK / 8), d8 = (c % (DK / 8)) * 8;
                    const size_t krow = (size_t)(b * A.SK + kt * 64 + key);
                    uint4 v;
                    if (d8 < A.dk_main) v = *reinterpret_cast<const uint4*>(A.k + krow * A.k_stride + kv * A.k_hstride + d8);
                    else v = *reinterpret_cast<const uint4*>(A.k2 + krow * A.k2_stride + (d8 - A.dk_main));
                    *reinterpret_cast<uint4*>(Ks + key * KP + d8) = v;
                }
                for (int c = tid; c < DVT * 8; c += 512) {
                    const int dv = c >> 3, k8 = (c & 7) * 8;
                    const uint4 v = *reinterpret_cast<const uint4*>(A.vt + ((size_t)(b * A.HKV + kv) * DV + pass * DVT + dv) * A.SK + kt * 64 + k8);
                    *reinterpret_cast<uint4*>(Vs + dv * VP + k8) = v;
                }
            }
            __syncthreads();
            }
            const bf16* Kc = PREF ? Ks + (kt & 1) * BUFE : Ks; const bf16* Vc = Kc + 64 * KP;
            f32x16 sacc[NQB][2];
#pragma unroll
            for (int kb = 0; kb < 2; ++kb) {
#pragma unroll
                for (int qi = 0; qi < NQB; ++qi)
#pragma unroll
                    for (int j = 0; j < 16; ++j) sacc[qi][kb][j] = 0.f;
#pragma unroll
                for (int ks = 0; ks < DK / 16; ++ks) {
                    const bf16x8 kf = *reinterpret_cast<const bf16x8*>(Kc + (kb * 32 + r) * KP + 16 * ks + 8 * hh);
#pragma unroll
                    for (int qi = 0; qi < NQB; ++qi) sacc[qi][kb] = __builtin_amdgcn_mfma_f32_32x32x16_bf16(kf, qf[qi][ks], sacc[qi][kb], 0, 0, 0);
                }
            }
#pragma unroll
            for (int qi = 0; qi < NQB; ++qi) {
                float mx = -INFINITY;
#pragma unroll
                for (int kb = 0; kb < 2; ++kb)
#pragma unroll
                    for (int j = 0; j < 16; ++j) mx = fmaxf(mx, sacc[qi][kb][j]);
                mx = fmaxf(mx, shfl_xor(F, mx, 32));
                const float mnew = fmaxf(mrun[qi], mx * sl2);
                const float alpha = __builtin_amdgcn_exp2f(mrun[qi] - mnew);
                mrun[qi] = mnew;
                float psum = 0.f;
#pragma unroll
                for (int kb = 0; kb < 2; ++kb)
#pragma unroll
                    for (int j = 0; j < 16; ++j) { const float p = __builtin_amdgcn_exp2f(sacc[qi][kb][j] * sl2 - mnew); sacc[qi][kb][j] = p; psum += p; }
                lrun[qi] = lrun[qi] * alpha + psum;
                if (!PREF || __ballot(alpha != 1.0f)) {
#pragma unroll
                    for (int i = 0; i < DVT / 32; ++i)
#pragma unroll
                        for (int j = 0; j < 16; ++j) oacc[qi][i][j] *= alpha;
                }
            }
#pragma unroll
            for (int kb = 0; kb < 2; ++kb)
#pragma unroll
                for (int s2 = 0; s2 < 2; ++s2) {
                    union PF { bf16x8 v; unsigned u[4]; };
                    PF pf[NQB];
#pragma unroll
                    for (int qi = 0; qi < NQB; ++qi)
#pragma unroll
                        for (int j = 0; j < 4; ++j) pf[qi].u[j] = pack_bf16(sacc[qi][kb][8 * s2 + 2 * j], sacc[qi][kb][8 * s2 + 2 * j + 1]);
#pragma unroll
                    for (int i = 0; i < DVT / 32; ++i) {
                        const bf16* vp = Vc + (i * 32 + r) * VP + kb * 32 + 16 * s2 + 4 * hh;
                        union { bf16x8 v; bf16x4 h2[2]; } vf;
                        vf.h2[0] = *reinterpret_cast<const bf16x4*>(vp);
                        vf.h2[1] = *reinterpret_cast<const bf16x4*>(vp + 8);
#pragma unroll
                        for (int qi = 0; qi < NQB; ++qi) oacc[qi][i] = __builtin_amdgcn_mfma_f32_32x32x16_bf16(vf.v, pf[qi].v, oacc[qi][i], 0, 0, 0);
                    }
                }
            if (PREF) __syncthreads();
        }
#pragma unroll
        for (int qi = 0; qi < NQB; ++qi) {
            const float lsum = lrun[qi] + shfl_xor(F, lrun[qi], 32);
            const float inv = 1.0f / lsum;
            bf16* op = A.o + (size_t)(b * A.SQ + q0 + 32 * qi + r) * A.o_stride + h * A.o_hstride + pass * DVT;
#pragma unroll
            for (int i = 0; i < DVT / 32; ++i)
#pragma unroll
                for (int g = 0; g < 4; ++g)
                    st_bf16x4(op + i * 32 + 8 * g + 4 * hh, oacc[qi][i][4 * g] * inv, oacc[qi][i][4 * g + 1] * inv, oacc[qi][i][4 * g + 2] * inv, oacc[qi][i][4 * g + 3] * inv);
        }
    }
}
#endif

#undef ATT_FETCH
#undef ATT_STORE
#undef ATT_FK
#undef ATT_FV
#undef ATT_SK
#undef ATT_SV
#ifndef CPU_EMU
template <int DK, int DV, int DVT, int NQB>
DI int attn_nunit(const AttnDesc& A) { return BATCH * A.H * (A.SQ / (256 * NQB)) * (DV / DVT); }
template <int DK, int DV, int DVT, int NQB>
DI void attn_phase(const Frame& F, const AttnDesc& A) {
    const int nunit = attn_nunit<DK, DV, DVT, NQB>(A);
    for (int u = blockIdx.x; u < nunit; u += F.nblk) attn_unit<DK, DV, DVT, NQB>(F, A, u);
}
#endif
DI AttnDesc desc_gqa(const Frame& F) {
    AttnDesc A; A.q = WSP(bf16, OFF_HATT); A.q_stride = 512; A.q_hstride = 64;
    A.k = WSP(bf16, OFF_HATT) + 256; A.k_stride = 512; A.k_hstride = 64; A.k2 = nullptr; A.k2_stride = 0; A.dk_main = 64;
    A.vt = WSP(bf16, OFF_VTATT); A.o = WSP(bf16, OFF_YCAT); A.o_stride = 1024; A.o_hstride = 64;
    A.H = 4; A.HKV = 2; A.SQ = SEQ; A.SK = SEQ; A.scale = 0.125f; return A;
}
DI AttnDesc desc_mla(const Frame& F) {
    AttnDesc A; A.q = WSP(bf16, OFF_QMLA); A.q_stride = 384; A.q_hstride = 96;
    A.k = WSP(bf16, OFF_KNOPE); A.k_stride = 256; A.k_hstride = 64; A.k2 = WSP(bf16, OFF_KROPE); A.k2_stride = 32; A.dk_main = 64;
    A.vt = WSP(bf16, OFF_VTMLA); A.o = WSP(bf16, OFF_YCAT) + 768; A.o_stride = 1024; A.o_hstride = 64;
    A.H = 4; A.HKV = 4; A.SQ = SEQ; A.SK = SEQ; A.scale = 0.10206207261596575f; return A;
}
DI AttnDesc desc_mem(const Frame& F) {
    AttnDesc A; A.q = WSP(bf16, OFF_QMEM); A.q_stride = 1024; A.q_hstride = 256;
    A.k = WSP(bf16, OFF_KMEM); A.k_stride = 1024; A.k_hstride = 256; A.k2 = nullptr; A.k2_stride = 0; A.dk_main = 256;
    A.vt = WSP(bf16, OFF_VTMEM); A.o = WSP(bf16, OFF_OMEM); A.o_stride = 1024; A.o_hstride = 256;
    A.H = 4; A.HKV = 4; A.SQ = SEQ; A.SK = MEMT; A.scale = 0.0625f; return A;
}

#ifndef CPU_EMU
typedef float f32p __attribute__((ext_vector_type(2)));
DI f32p allsum16p(f32p x) { x.x = allsum16(x.x); x.y = allsum16(x.y); return x; }
template <int KIND>
DI void scan_chain(const Frame& F, int chain) {
    constexpr int T = 32;
    constexpr int NARR = KIND == 0 ? 6 : 3;
    constexpr int STEPB = NARR * 256;
    constexpr int NPIECE = T * NARR * 8;
    constexpr int PPT = (NPIECE + NTH - 1) / NTH;
    const int d = chain / (BATCH * 4), b = (chain / 4) % BATCH, h = chain % 4;
    const int tid = F.tid, wave = tid >> 6, lane = tid & 63, rg = lane >> 4, cg = lane & 15;
    unsigned char* buf0 = F.smem; unsigned char* buf1 = F.smem + T * STEPB;
    unsigned char* ybuf = F.smem + 2 * T * STEPB;
    const size_t AS = (size_t)NTOK * 256;
    bf16* r7 = WSP(bf16, OFF_R7); bf16* hh = WSP(bf16, OFF_HHGRN);
#define PIECE_PTR(t0, p_) ([&]() -> const uint4* { const int pc = (p_) < NPIECE ? (p_) : NPIECE - 1; \
        const int st = pc / (NARR * 8), rem = pc % (NARR * 8), arr = rem >> 3, part = rem & 7; \
        const int tt = (t0) + st, ss = d ? SEQ - 1 - tt : tt; const size_t nn = (size_t)b * SEQ + ss; \
        const bf16* base; \
        if (KIND == 0) { const int aid = arr == 0 ? R_KK : arr == 1 ? (d ? R_W1 : R_W0) : arr == 2 ? (d ? R_AK1 : R_AK0) : arr == 3 ? (d ? R_KD1 : R_KD0) : arr == 4 ? R_R : R_V; \
            base = r7 + aid * AS + nn * 256 + h * 64; } \
        else { const int off = arr == 0 ? 256 + d * 256 : arr == 1 ? 0 : 768; base = hh + nn * 1280 + off + h * 64; } \
        return reinterpret_cast<const uint4*>(base + part * 8); }())
#define PUT_PIECE(dst, p_, v_) do { float4 a_, b_; a_.x = bflo((v_).x); a_.y = bfhi((v_).x); a_.z = bflo((v_).y); a_.w = bfhi((v_).y); \
        b_.x = bflo((v_).z); b_.y = bfhi((v_).z); b_.z = bflo((v_).w); b_.w = bfhi((v_).w); \
        *reinterpret_cast<float4*>((dst) + (p_) * 32) = a_; *reinterpret_cast<float4*>((dst) + (p_) * 32 + 16) = b_; } while (0)
#define STORE_PRE(dst) do { PUT_PIECE(dst, tid, pre0); \
        if (tid + NTH < NPIECE) PUT_PIECE(dst, tid + NTH, pre1); \
        if (PPT > 2 && tid + 2 * NTH < NPIECE) PUT_PIECE(dst, tid + 2 * NTH, pre2); } while (0)
    uint4 pre0, pre1, pre2;
    pre0 = *PIECE_PTR(0, tid); pre1 = *PIECE_PTR(0, tid + NTH); pre2 = pre1;
    if (PPT > 2) pre2 = *PIECE_PTR(0, tid + 2 * NTH);
    __syncthreads();
    STORE_PRE(buf0);
    __syncthreads();
    f32p P[4];
#pragma unroll
    for (int c = 0; c < 4; ++c) P[c] = (f32p){0.f, 0.f};
    const int vofs = (wave * 8 + rg * 2) * 4;
    for (int ch = 0; ch < SEQ / T; ++ch) {
        const unsigned char* cur = (ch & 1) ? buf1 : buf0;
        if (ch + 1 < SEQ / T) {
            pre0 = *PIECE_PTR((ch + 1) * T, tid); pre1 = *PIECE_PTR((ch + 1) * T, tid + NTH);
            if (PPT > 2) pre2 = *PIECE_PTR((ch + 1) * T, tid + 2 * NTH);
        }
        float4 o0, o1, o2, o3, o4; f32p ov;
        { const unsigned char* sb = cur;
          o0 = *reinterpret_cast<const float4*>(sb + 0 * 256 + cg * 16); o1 = *reinterpret_cast<const float4*>(sb + 1 * 256 + cg * 16);
          if (KIND == 0) { o2 = *reinterpret_cast<const float4*>(sb + 2 * 256 + cg * 16); o3 = *reinterpret_cast<const float4*>(sb + 3 * 256 + cg * 16); o4 = *reinterpret_cast<const float4*>(sb + 4 * 256 + cg * 16); }
          ov = *reinterpret_cast<const f32p*>(sb + (NARR - 1) * 256 + vofs); }
        unsigned ykeep = 0u;
#pragma unroll 2
        for (int t = 0; t < T; ++t) {
            const float4 c0 = o0, c1 = o1, c2 = o2, c3 = o3, c4 = o4; const f32p v = ov;
            { const unsigned char* sb = cur + ((t + 1) & (T - 1)) * STEPB;
              o0 = *reinterpret_cast<const float4*>(sb + 0 * 256 + cg * 16); o1 = *reinterpret_cast<const float4*>(sb + 1 * 256 + cg * 16);
              if (KIND == 0) { o2 = *reinterpret_cast<const float4*>(sb + 2 * 256 + cg * 16); o3 = *reinterpret_cast<const float4*>(sb + 3 * 256 + cg * 16); o4 = *reinterpret_cast<const float4*>(sb + 4 * 256 + cg * 16); }
              ov = *reinterpret_cast<const f32p*>(sb + (NARR - 1) * 256 + vofs); }
            f32p y;
            if (KIND == 0) {
                f32p sa = P[0] * c0.x + P[1] * c0.y + P[2] * c0.z + P[3] * c0.w;
                sa = allsum16p(sa);
                P[0] = P[0] * c1.x - sa * c2.x + v * c3.x;
                P[1] = P[1] * c1.y - sa * c2.y + v * c3.y;
                P[2] = P[2] * c1.z - sa * c2.z + v * c3.z;
                P[3] = P[3] * c1.w - sa * c2.w + v * c3.w;
                y = P[0] * c4.x + P[1] * c4.y + P[2] * c4.z + P[3] * c4.w;
            } else {
                P[0] += (v - P[0]) * c0.x; P[1] += (v - P[1]) * c0.y; P[2] += (v - P[2]) * c0.z; P[3] += (v - P[3]) * c0.w;
                y = P[0] * c1.x + P[1] * c1.y + P[2] * c1.z + P[3] * c1.w;
            }
            y = allsum16p(y);
            const unsigned yp = pack_bf16(y.x, y.y);
            ykeep = ((t & 15) == cg) ? yp : ykeep;
            if ((t & 15) == 15) *reinterpret_cast<unsigned*>(ybuf + ((t & ~15) + cg) * 128 + (wave * 8 + rg * 2) * 2) = ykeep;
        }
        asm volatile("s_waitcnt lgkmcnt(0)" ::: "memory");
        __builtin_amdgcn_wave_barrier();
        if (lane < T) {
            const int t = ch * T + lane, s = d ? SEQ - 1 - t : t; const size_t n = (size_t)b * SEQ + s;
            const uint4 yv = *reinterpret_cast<const uint4*>(ybuf + lane * 128 + wave * 16);
            bf16* dst = KIND == 0 ? r7 + (d ? R_W1 : R_W0) * AS + n * 256 + h * 64 + wave * 8 : hh + n * 1280 + 256 + d * 256 + h * 64 + wave * 8;
            *reinterpret_cast<uint4*>(dst) = yv;
        }
        if (ch + 1 < SEQ / T) {
            unsigned char* nxt = (ch & 1) ? buf0 : buf1;
            STORE_PRE(nxt);
        }
        __syncthreads();
    }
#undef PIECE_PTR
#undef STORE_PRE
#undef PUT_PIECE
}
DI void phase_scans(const Frame& F) {
    const int nchain = 2 * BATCH * 4;
    for (int g = blockIdx.x; g < nchain / 2; g += F.nblk) {
        if (F.wv < 2) scan_rwkv_chunk(F, g * 2 + F.wv); else if (F.wv < 4) scan_hgrn_chunk(F, g * 2 + F.wv - 2);
    }
}
#else
DI void phase_scans(const Frame& F) {
    bf16* r7 = WSP(bf16, OFF_R7); const size_t AS = (size_t)NTOK * 256;
    bf16* hh = WSP(bf16, OFF_HHGRN);
    const int nitem = 2 * BATCH * 4 * 64 * 2;
    for (int it = wave_item_index(F); it < nitem; it += gthreads(F)) {
        const int kind = it / (2 * BATCH * 4 * 64);
        int c = (it % (2 * BATCH * 4 * 64)) / 64; const int i = it % 64;
        const int d = c / (BATCH * 4); c %= BATCH * 4; const int b = c / 4, h = c % 4;
        float S[64];
#pragma unroll
        for (int j = 0; j < 64; ++j) S[j] = 0.f;
        if (kind == 0) {
            const bf16* pr = r7 + R_R * AS, *pv = r7 + R_V * AS, *pkk = r7 + R_KK * AS;
            bf16* pw = r7 + (d ? R_W1 : R_W0) * AS; const bf16* pkd = r7 + (d ? R_KD1 : R_KD0) * AS, *pak = r7 + (d ? R_AK1 : R_AK0) * AS;
            for (int t = 0; t < SEQ; ++t) {
                const int s = d ? SEQ - 1 - t : t;
                const size_t o = ((size_t)(b * SEQ + s)) * 256 + h * 64;
                const float v = bf2f(pv[o + i]);
                float sa = 0.f;
#pragma unroll
                for (int j = 0; j < 64; ++j) sa += S[j] * bf2f(pkk[o + j]);
                float y = 0.f;
#pragma unroll
                for (int j = 0; j < 64; ++j) {
                    S[j] = S[j] * bf2f(pw[o + j]) - sa * bf2f(pak[o + j]) + v * bf2f(pkd[o + j]);
                    y += S[j] * bf2f(pr[o + j]);
                }
#ifndef CPU_EMU
                __builtin_amdgcn_wave_barrier();
#endif
#ifdef CPU_EMU
                WSP(bf16, OFF_EMU_SCAN)[(size_t)d * AS + (size_t)(b * SEQ + s) * 256 + h * 64 + i] = f2bf(y);
#else
                pw[o + i] = f2bf(y);
#endif
            }
        } else {
            const bf16* pq = hh; bf16* pk = hh + 256 + d * 256; const bf16* pi = hh + 768;
            for (int t = 0; t < SEQ; ++t) {
                const int s = d ? SEQ - 1 - t : t;
                const size_t o = ((size_t)(b * SEQ + s)) * 1280 + h * 64;
                const float v = bf2f(pi[o + i]);
                float acc = 0.f;
#pragma unroll
                for (int j = 0; j < 64; ++j) {
                    const float k = bf2f(pk[o + j]);
                    S[j] = S[j] + k * (v - S[j]);
                    acc += S[j] * bf2f(pq[o + j]);
                }
#ifndef CPU_EMU
                __builtin_amdgcn_wave_barrier();
#endif
#ifdef CPU_EMU
                WSP(bf16, OFF_EMU_SCAN)[(size_t)(2 + d) * AS + (size_t)(b * SEQ + s) * 256 + h * 64 + i] = f2bf(acc);
#else
                pk[o + i] = f2bf(acc);
#endif
            }
        }
    }
}

#endif

#ifndef CPU_EMU
DI void phase_fin_gpu(const Frame& F, int l) {
    const bf16* r7 = WSP(bf16, OFF_R7); const size_t AS = (size_t)NTOK * 256;
    const bf16* gb = WSP(bf16, OFF_G); const float* bonus = WSP(float, OFF_BONUS);
    const bf16* hh = WSP(bf16, OFF_HHGRN); bf16* ycat = WSP(bf16, OFF_YCAT);
    float* par = (float*)F.smem;
    __syncthreads();
    for (int i = F.tid; i < 768; i += NTH) par[i] = i < 256 ? F.in[17][l * 256 + i] : i < 512 ? F.in[18][l * 256 + i - 256] : F.in[20][l * 256 + i - 512];
    __syncthreads();
    {
        for (int item = blockIdx.x * 8 + F.wv; item < (NTOK / 16) * 4; item += F.nblk * 8) {
            const int lane = fresh_tid(F) & 63, x = lane & 15, q = lane >> 4;
            const int h = item & 3; const size_t n0 = (size_t)(item >> 2) * 16, blk = (size_t)item * 1024;
            const bf16* y0 = r7 + C_KT0 * AS + blk; const bf16* y1 = r7 + C_KT1 * AS + blk; const bf16* vt = r7 + C_VT * AS + blk;
            float y[4][4], v[4][4];
#pragma unroll
            for (int u = 0; u < 4; ++u) {
                const uint2 a = *reinterpret_cast<const uint2*>(y0 + (u * 64 + lane) * 4), b = *reinterpret_cast<const uint2*>(y1 + (u * 64 + lane) * 4), c = *reinterpret_cast<const uint2*>(vt + (u * 64 + lane) * 4);
                y[u][0] = bflo(a.x) + bflo(b.x); y[u][1] = bfhi(a.x) + bfhi(b.x); y[u][2] = bflo(a.y) + bflo(b.y); y[u][3] = bfhi(a.y) + bfhi(b.y);
                v[u][0] = bflo(c.x); v[u][1] = bfhi(c.x); v[u][2] = bflo(c.y); v[u][3] = bfhi(c.y);
            }
#pragma unroll
            for (int r = 0; r < 4; ++r) {
                const size_t n = n0 + 4 * q + r;
                const float mu = allsum16((y[0][r] + y[1][r]) + (y[2][r] + y[3][r])) * (1.0f / 64.0f);
                const float d0 = y[0][r] - mu, d1 = y[1][r] - mu, d2 = y[2][r] - mu, d3 = y[3][r] - mu;
                const float rs = 1.0f / sqrtf(allsum16((d0 * d0 + d1 * d1) + (d2 * d2 + d3 * d3)) * (1.0f / 64.0f) + GN_EPS);
                const float bo = bonus[n * 4 + h];
                const float dv[4] = {d0, d1, d2, d3};
#pragma unroll
                for (int u = 0; u < 4; ++u) {
                    const int c = h * 64 + 16 * u + x;
                    ycat[n * 1024 + 256 + c] = f2bf((dv[u] * rs * par[c] + par[256 + c] + bo * v[u][r]) * bf2f(gb[n * 256 + c]));
                }
            }
        }
    }
    for (int it = blockIdx.x * NTH + fresh_tid(F); it < NTOK * 4; it += gthreads(F)) {
        const int n = it >> 2, h = it & 3;
        const uint4* pa = reinterpret_cast<const uint4*>(hh + (size_t)n * 1280 + 256 + h * 64); const uint4* pb = reinterpret_cast<const uint4*>(hh + (size_t)n * 1280 + 512 + h * 64);
        float s2 = 0.f;
#pragma unroll
        for (int i = 0; i < 8; ++i) { const uint4 a = pa[i], b = pb[i];
            const float y0 = bflo(a.x) + bflo(b.x), y1 = bfhi(a.x) + bfhi(b.x), y2 = bflo(a.y) + bflo(b.y), y3 = bfhi(a.y) + bfhi(b.y);
            const float y4 = bflo(a.z) + bflo(b.z), y5 = bfhi(a.z) + bfhi(b.z), y6 = bflo(a.w) + bflo(b.w), y7 = bfhi(a.w) + bfhi(b.w);
            s2 += (y0 * y0 + y1 * y1) + (y2 * y2 + y3 * y3) + (y4 * y4 + y5 * y5) + (y6 * y6 + y7 * y7); }
        const float rs = 1.0f / sqrtf(s2 * (1.0f / 64.0f) + RMS_EPS);
        uint4* po = reinterpret_cast<uint4*>(ycat + (size_t)n * 1024 + 512 + h * 64);
        const uint4* pg = reinterpret_cast<const uint4*>(hh + (size_t)n * 1280 + 1024 + h * 64);
        const float* gg = par + 512 + h * 64;
#pragma unroll 2
        for (int i = 0; i < 8; ++i) { const uint4 a = pa[i], b = pb[i], g4 = pg[i];
            const float yv[8] = {bflo(a.x) + bflo(b.x), bfhi(a.x) + bfhi(b.x), bflo(a.y) + bflo(b.y), bfhi(a.y) + bfhi(b.y), bflo(a.z) + bflo(b.z), bfhi(a.z) + bfhi(b.z), bflo(a.w) + bflo(b.w), bfhi(a.w) + bfhi(b.w)};
            const float gf[8] = {bflo(g4.x), bfhi(g4.x), bflo(g4.y), bfhi(g4.y), bflo(g4.z), bfhi(g4.z), bflo(g4.w), bfhi(g4.w)};
            float o[8];
#pragma unroll
            for (int j = 0; j < 8; ++j) o[j] = yv[j] * rs * gg[8 * i + j] * (gf[j] * fast_sigmoid(gf[j]));
            po[i] = make_uint4(pack_bf16(o[0], o[1]), pack_bf16(o[2], o[3]), pack_bf16(o[4], o[5]), pack_bf16(o[6], o[7])); }
    }
}
#endif
DI void phase_fin(const Frame& F, int l) {
    const bf16* r7 = WSP(bf16, OFF_R7); const size_t AS = (size_t)NTOK * 256;
    const bf16* gb = WSP(bf16, OFF_G); const float* bonus = WSP(float, OFF_BONUS);
    const bf16* hh = WSP(bf16, OFF_HHGRN); bf16* ycat = WSP(bf16, OFF_YCAT);
    const float* gng = F.in[17] + l * 256; const float* gnb = F.in[18] + l * 256; const float* hng = F.in[20] + l * 256;
    for (int it = ggrp(F); it < NTOK * 8; it += ngrp(F)) {
        const int n = it >> 3, kind = (it >> 2) & 1, h = it & 3;
        float v[PER64];
        if (kind == 0) {
            float s1 = 0.f;
            for (int i = 0; i < PER64; ++i) { const int c = h * 64 + glane(F) + i * GRP; const size_t o = (size_t)n * 256 + c;
#ifdef CPU_EMU
                v[i] = bf2f(WSP(bf16, OFF_EMU_SCAN)[o]) + bf2f(WSP(bf16, OFF_EMU_SCAN)[AS + o]); s1 += v[i]; }
#else
                v[i] = bf2f(r7[R_W0 * AS + o]) + bf2f(r7[R_W1 * AS + o]); s1 += v[i]; }
#endif
            s1 = grp_sum(F, s1); const float mu = s1 * (1.0f / 64.0f);
            float s2 = 0.f; for (int i = 0; i < PER64; ++i) { const float dd = v[i] - mu; s2 += dd * dd; }
            s2 = grp_sum(F, s2); const float rs = 1.0f / sqrtf(s2 * (1.0f / 64.0f) + GN_EPS);
            const float bo = bonus[(size_t)n * 4 + h];
            for (int i = 0; i < PER64; ++i) { const int c = h * 64 + glane(F) + i * GRP; const size_t o = (size_t)n * 256 + c;
                const float y = (v[i] - mu) * rs * gng[c] + gnb[c];
                ycat[(size_t)n * 1024 + 256 + c] = f2bf((y + bo * bf2f(r7[R_V * AS + o])) * bf2f(gb[o])); }
        } else {
            float s2 = 0.f;
            for (int i = 0; i < PER64; ++i) { const int c = h * 64 + glane(F) + i * GRP; const size_t o = (size_t)n * 1280 + c;
#ifdef CPU_EMU
                const size_t oe = (size_t)n * 256 + c;
                v[i] = bf2f(WSP(bf16, OFF_EMU_SCAN)[2 * AS + oe]) + bf2f(WSP(bf16, OFF_EMU_SCAN)[3 * AS + oe]); s2 += v[i] * v[i]; }
#else
                v[i] = bf2f(hh[o + 256]) + bf2f(hh[o + 512]); s2 += v[i] * v[i]; }
#endif
            s2 = grp_sum(F, s2); const float rs = 1.0f / sqrtf(s2 * (1.0f / 64.0f) + RMS_EPS);
            for (int i = 0; i < PER64; ++i) { const int c = h * 64 + glane(F) + i * GRP; const size_t o = (size_t)n * 1280 + c;
                ycat[(size_t)n * 1024 + 512 + c] = f2bf(v[i] * rs * hng[c] * siluf_(bf2f(hh[o + 1024]))); }
        }
    }
}

struct EpiResid {
    float* xf; int row0, pn;
    DI void operator()(int r, int c, float a, float b, float cc, float d) const {
        float* p = xf + (size_t)(row0 + r) * DM + pn * 256 + c;
#ifndef CPU_EMU
        float4 x = *reinterpret_cast<float4*>(p);
        x.x = DN_ALPHA * x.x + a; x.y = DN_ALPHA * x.y + b; x.z = DN_ALPHA * x.z + cc; x.w = DN_ALPHA * x.w + d;
        *reinterpret_cast<float4*>(p) = x;
#else
        p[0] = DN_ALPHA * p[0] + a; p[1] = DN_ALPHA * p[1] + b; p[2] = DN_ALPHA * p[2] + cc; p[3] = DN_ALPHA * p[3] + d;
#endif
    }
};
struct EpiBf {
    bf16* o; int ld; int row0, pn;
    DI void operator()(int r, int c, float a, float b, float cc, float d) const { st_bf16x4(o + (size_t)(row0 + r) * ld + pn * 256 + c, a, b, cc, d); }
};
template <int MODE>
DI void phase_gemm_sq(const Frame& F, const bf16* A, size_t woff, bf16* outb) {
    const bf16* W = (const bf16*)((const char*)WSP(bf16, OFF_WTS) + woff);
    const int nM = (NTOK + 255) / 256;
    for (int u = blockIdx.x; u < nM * 4; u += F.nblk) {
        const int pm = u >> 2, pn = u & 3;
#ifdef CPU_EMU
        const int mr = min(256, NTOK - pm * 256);
#endif
        if (MODE == 0) { EpiResid E{F.xf, pm * 256, pn}; gemm_unit(F, A, 1024, nullptr, pm * 256, W, 1024, pn * 256, 1024, E MR); }
        else { EpiBf E{outb, 1024, pm * 256, pn}; gemm_unit(F, A, 1024, nullptr, pm * 256, W, 1024, pn * 256, 1024, E MR); }
    }
}

template <bool BLOCKED = false>
DI void phase_ln(const Frame& F, const float* g, const float* b) {
#ifdef CPU_EMU
    const float* xf = F.xf;
    layer_norm_rows(F, g, b, [&](int row, int c) { return xf[(size_t)row * DM + c]; }, false, nullptr);
#else
    ln_rows_gpu<0, BLOCKED>(F, g, b, 0);
#endif
}

#ifndef CPU_EMU
DI void phase_route_gpu(const Frame& F, int l) {
    const float* xf = F.xf; const float* gt = (const float*)((const char*)WSP(bf16, OFF_WTS) + W_GATE_T) + (size_t)l * 48 * 1024;
    const float* bg = F.in[34] + l * 4; const float* be = F.in[36] + l * 32;
    int* counts = (int*)(F.ws + CTL_CNT) + l * 32;
    int* lists = WSP(int, OFF_LISTS); float* tinfo = WSP(float, OFF_TINFO);
    const int tid = F.tid, wave = tid >> 6, lane = tid & 63, rr = lane & 15, kq = lane >> 4;
    float* lg = (float*)F.smem + wave * (16 * 48);
    const bool blk_ok = (NTOK % (F.nblk * 32) == 0);
    const int rpb = NTOK / F.nblk;
    int* hcnt = (int*)(F.smem + 32768); int* hbase = hcnt + 32;
    __syncthreads();
    const int rt_first = blk_ok ? 0 : blockIdx.x * 8, rt_lim = blk_ok ? rpb / 16 : NTOK / 16, rt_step = blk_ok ? 8 : F.nblk * 8;
    for (int rtb = rt_first; rtb < rt_lim; rtb += rt_step) {
        const int rt = rtb + wave; const bool live = rt < rt_lim;
        if (tid < 32) hcnt[tid] = 0;
        __syncthreads();
        int ea = 0, eb = 0, pa = 0, pb = 0, row = 0; float g0 = 0.f, g1 = 0.f;
        if (live) {
        const int r0 = blk_ok ? blockIdx.x * rpb + rt * 16 : rt * 16;
        f32x4 acc0 = {0.f, 0.f, 0.f, 0.f}, acc1 = acc0, acc2 = acc0;
        const float* xa = xf + (size_t)(r0 + rr) * DM + 4 * kq;
        const float* wb = gt + (size_t)rr * 1024 + 4 * kq;
#pragma unroll 1
        for (int kb = 0; kb < 1024; kb += 64) {
            float4 a[4], b0[4], b1[4], b2[4];
#pragma unroll
            for (int u = 0; u < 4; ++u) { const int k0 = kb + 16 * u;
                a[u] = *reinterpret_cast<const float4*>(xa + k0); b0[u] = *reinterpret_cast<const float4*>(wb + k0);
                b1[u] = *reinterpret_cast<const float4*>(wb + 16 * 1024 + k0); b2[u] = *reinterpret_cast<const float4*>(wb + 32 * 1024 + k0); }
#pragma unroll
            for (int u = 0; u < 4; ++u) {
                acc0 = __builtin_amdgcn_mfma_f32_16x16x4f32(a[u].x, b0[u].x, acc0, 0, 0, 0); acc1 = __builtin_amdgcn_mfma_f32_16x16x4f32(a[u].x, b1[u].x, acc1, 0, 0, 0); acc2 = __builtin_amdgcn_mfma_f32_16x16x4f32(a[u].x, b2[u].x, acc2, 0, 0, 0);
                acc0 = __builtin_amdgcn_mfma_f32_16x16x4f32(a[u].y, b0[u].y, acc0, 0, 0, 0); acc1 = __builtin_amdgcn_mfma_f32_16x16x4f32(a[u].y, b1[u].y, acc1, 0, 0, 0); acc2 = __builtin_amdgcn_mfma_f32_16x16x4f32(a[u].y, b2[u].y, acc2, 0, 0, 0);
                acc0 = __builtin_amdgcn_mfma_f32_16x16x4f32(a[u].z, b0[u].z, acc0, 0, 0, 0); acc1 = __builtin_amdgcn_mfma_f32_16x16x4f32(a[u].z, b1[u].z, acc1, 0, 0, 0); acc2 = __builtin_amdgcn_mfma_f32_16x16x4f32(a[u].z, b2[u].z, acc2, 0, 0, 0);
                acc0 = __builtin_amdgcn_mfma_f32_16x16x4f32(a[u].w, b0[u].w, acc0, 0, 0, 0); acc1 = __builtin_amdgcn_mfma_f32_16x16x4f32(a[u].w, b1[u].w, acc1, 0, 0, 0); acc2 = __builtin_amdgcn_mfma_f32_16x16x4f32(a[u].w, b2[u].w, acc2, 0, 0, 0);
            }
        }
#pragma unroll
        for (int r = 0; r < 4; ++r) { lg[(4 * kq + r) * 48 + rr] = acc0[r]; lg[(4 * kq + r) * 48 + 16 + rr] = acc1[r]; lg[(4 * kq + r) * 48 + 32 + rr] = acc2[r]; }
        asm volatile("s_waitcnt lgkmcnt(0)" ::: "memory");
        __builtin_amdgcn_wave_barrier();
        if (lane < 16) {
            row = r0 + lane; const float* L = lg + lane * 48;
            float gl[4];
#pragma unroll
            for (int q = 0; q < 4; ++q) gl[q] = L[q] + bg[q];
            int gi = 0; float gm = gl[0];
#pragma unroll
            for (int q = 1; q < 4; ++q) if (gl[q] > gm) { gm = gl[q]; gi = q; }
            float den = 0.f;
#pragma unroll
            for (int q = 0; q < 4; ++q) den += expf(gl[q] - gm);
            const float pgroup = 1.0f / den;
            float el[8];
#pragma unroll
            for (int q = 0; q < 8; ++q) el[q] = L[4 + gi * 8 + q] + be[gi * 8 + q];
            int i0 = 0; float v0 = el[0];
#pragma unroll
            for (int q = 1; q < 8; ++q) if (el[q] > v0) { v0 = el[q]; i0 = q; }
            int i1 = -1; float v1 = -INFINITY;
#pragma unroll
            for (int q = 0; q < 8; ++q) if (q != i0 && el[q] > v1) { v1 = el[q]; i1 = q; }
            const float e1 = expf(v1 - v0); g0 = pgroup / (1.0f + e1); g1 = pgroup * e1 / (1.0f + e1);
            ea = gi * 8 + i0; eb = gi * 8 + i1;
            pa = atomicAdd(&hcnt[ea], 1); pb = atomicAdd(&hcnt[eb], 1);
        }
        __builtin_amdgcn_wave_barrier();
        }
        __syncthreads();
        if (tid < 32) { const int c = hcnt[tid]; hbase[tid] = c ? atomicAdd(&counts[tid], c) : 0; }
        __syncthreads();
        if (live && lane < 16) {
            pa += hbase[ea]; pb += hbase[eb];
            lists[(size_t)ea * NTOK + pa] = row; lists[(size_t)eb * NTOK + pb] = row;
            int* ti = (int*)(tinfo + (size_t)row * 8);
            ti[0] = ea; ti[1] = pa; ti[2] = eb; ti[3] = pb; tinfo[(size_t)row * 8 + 4] = g0; tinfo[(size_t)row * 8 + 5] = g1;
        }
    }
}
#endif
DI void phase_route(const Frame& F, int l) {
    const float* xf = F.xf;
    const float* wg = F.in[33] + (size_t)l * 1024 * 4; const float* bg = F.in[34] + l * 4;
    const float* we = F.in[35] + (size_t)l * 1024 * 32; const float* be = F.in[36] + l * 32;
    int* counts = (int*)(F.ws + CTL_CNT) + l * 32;
    int* lists = WSP(int, OFF_LISTS); float* tinfo = WSP(float, OFF_TINFO);
    for (int row = ggrp(F); row < NTOK; row += ngrp(F)) {
        float gl[4] = {0.f, 0.f, 0.f, 0.f};
        for (int i = 0; i < PERLN; ++i) { const int c = glane(F) + i * GRP; const float x = xf[(size_t)row * DM + c];
#pragma unroll
            for (int q = 0; q < 4; ++q) gl[q] += x * wg[c * 4 + q]; }
#pragma unroll
        for (int q = 0; q < 4; ++q) gl[q] = grp_sum(F, gl[q]) + bg[q];
        int gi = 0; float gm = gl[0];
#pragma unroll
        for (int q = 1; q < 4; ++q) if (gl[q] > gm) { gm = gl[q]; gi = q; }
        float den = 0.f;
#pragma unroll
        for (int q = 0; q < 4; ++q) den += expf(gl[q] - gm);
        const float pgroup = 1.0f / den;
        float el[8] = {0.f, 0.f, 0.f, 0.f, 0.f, 0.f, 0.f, 0.f};
        for (int i = 0; i < PERLN; ++i) { const int c = glane(F) + i * GRP; const float x = xf[(size_t)row * DM + c];
#pragma unroll
            for (int q = 0; q < 8; ++q) el[q] += x * we[c * 32 + gi * 8 + q]; }
#pragma unroll
        for (int q = 0; q < 8; ++q) el[q] = grp_sum(F, el[q]) + be[gi * 8 + q];
        int i0 = 0; float v0 = el[0];
#pragma unroll
        for (int q = 1; q < 8; ++q) if (el[q] > v0) { v0 = el[q]; i0 = q; }
        int i1 = -1; float v1 = -INFINITY;
#pragma unroll
        for (int q = 0; q < 8; ++q) if (q != i0 && el[q] > v1) { v1 = el[q]; i1 = q; }
        const float e1 = expf(v1 - v0); const float g0 = pgroup / (1.0f + e1), g1 = pgroup * e1 / (1.0f + e1);
        if (glane(F) == 0) {
            const int ea = gi * 8 + i0, eb = gi * 8 + i1;
            const int pa = atomicAdd(&counts[ea], 1), pb = atomicAdd(&counts[eb], 1);
            lists[(size_t)ea * NTOK + pa] = row; lists[(size_t)eb * NTOK + pb] = row;
            int* ti = (int*)(tinfo + (size_t)row * 8);
            ti[0] = ea; ti[1] = pa; ti[2] = eb; ti[3] = pb; tinfo[(size_t)row * 8 + 4] = g0; tinfo[(size_t)row * 8 + 5] = g1;
        }
    }
}

struct EpiMoeUp {
    bf16* hm; int row0, pn;
    DI void operator()(int r, int c, float a, float b, float cc, float d) const {
        bf16* p = hm + (size_t)(row0 + r) * 256 + ((pn * 256 + c) >> 1);
        p[0] = f2bf(siluf_(a) * b); p[1] = f2bf(siluf_(cc) * d);
    }
};
DI int ld_cnt(const int* p) {
#ifdef CPU_EMU
    return *p;
#else
    return __hip_atomic_load(p, __ATOMIC_RELAXED, __HIP_MEMORY_SCOPE_AGENT);
#endif
}
DI void moe_tiles(const int* counts, int* toff  ) {
    __syncthreads();
    if (threadIdx.x == 0) { int acc = 0; for (int e = 0; e < NEXP; ++e) { toff[e] = acc; acc += (ld_cnt(counts + e) + 255) >> 8; } toff[NEXP] = acc; }
    __syncthreads();
}
DI void phase_moe_up(const Frame& F, int l) {
    const int* counts = (const int*)(F.ws + CTL_CNT) + l * 32;
    int* eoff = (int*)(F.ws + CTL_EOFF) + l * 33;
    int* rowmap = (int*)(F.smem + 131072);
    int* toff = rowmap + 256;
    moe_tiles(counts, toff);
    if (blockIdx.x == 0 && threadIdx.x == 0) for (int e = 0; e <= NEXP; ++e) eoff[e] = toff[e] * 256;
    const int* lists = WSP(int, OFF_LISTS); const bf16* xb = WSP(bf16, OFF_XB);
    const int nunit = toff[NEXP] * 2;
    for (int u = blockIdx.x; u < nunit; u += F.nblk) {
        const int tile = u >> 1, pn = u & 1;
        int e = 0; while (toff[e + 1] <= tile) ++e;
        const int t0 = (tile - toff[e]) * 256, cnt = ld_cnt(counts + e);
        __syncthreads();
        for (int i = fresh_tid(F); i < 256; i += NTH) rowmap[i] = (t0 + i < cnt) ? lists[(size_t)e * NTOK + t0 + i] : 0;
        __syncthreads();
        EpiMoeUp E{WSP(bf16, OFF_HM), tile * 256, pn};
        gemm_unit(F, xb, 1024, rowmap, 0, WSP(bf16, OFF_W13T) + (size_t)e * 512 * 1024, 1024, pn * 256, 1024, E);
    }
}
DI void phase_moe_down(const Frame& F, int l) {
    const int* counts = (const int*)(F.ws + CTL_CNT) + l * 32;
    int* toff = (int*)(F.smem + 131072) + 256;
    moe_tiles(counts, toff);
    const int nunit = toff[NEXP] * 4;
    for (int u = blockIdx.x; u < nunit; u += F.nblk) {
        const int tile = u >> 2, pn = u & 3;
        int e = 0; while (toff[e + 1] <= tile) ++e;
        EpiBf E{WSP(bf16, OFF_YROWS), 1024, tile * 256, pn};
        gemm_unit(F, WSP(bf16, OFF_HM), 256, nullptr, tile * 256, WSP(bf16, OFF_W2T) + (size_t)e * 1024 * 256, 256, pn * 256, 256, E);
    }
}
DI void phase_ln3(const Frame& F, int l) {
#ifndef CPU_EMU
    ln_rows_gpu<2>(F, F.in[40] + l * 1024, F.in[41] + l * 1024, l);
#else
    const float* xf = F.xf; const bf16* yr = WSP(bf16, OFF_YROWS); const float* tinfo = WSP(float, OFF_TINFO);
    const int* eoff = (const int*)(F.ws + CTL_EOFF) + l * 33;
    layer_norm_rows(F, F.in[40] + l * 1024, F.in[41] + l * 1024, [&](int row, int c) {
        const int* ti = (const int*)(tinfo + (size_t)row * 8);
        const size_t ra = (size_t)eoff[ti[0]] + ti[1], rb = (size_t)eoff[ti[2]] + ti[3];
        return DN_ALPHA * xf[(size_t)row * DM + c] + tinfo[(size_t)row * 8 + 4] * bf2f(yr[ra * 1024 + c]) + tinfo[(size_t)row * 8 + 5] * bf2f(yr[rb * 1024 + c]);
    }, false, nullptr);
#endif
}

#ifndef CPU_EMU
#define XB_TMO      128
#define XB_XCNT(j)  (256  + 64 * (j))
#define XB_XSUB(j)  (1280 + 64 * (j))
#define XB_XGEN(j)  (2304 + 64 * (j))
#define XB_TOP      3328
#define XB_TOPGEN   3392
#define XCD_BAR_WORDS 3456
#define XB_SPIN_CAP (1u << 18)
#define LAS __attribute__((address_space(3)))

__device__ __forceinline__ unsigned xb_ld(unsigned* p)              { return __hip_atomic_load(p, __ATOMIC_RELAXED, __HIP_MEMORY_SCOPE_AGENT); }
__device__ __forceinline__ unsigned xb_add(unsigned* p, unsigned v) { return __hip_atomic_fetch_add(p, v, __ATOMIC_RELAXED, __HIP_MEMORY_SCOPE_AGENT); }
__device__ __forceinline__ unsigned xb_xcc_id() { return (unsigned)__builtin_amdgcn_s_getreg((3 << 11) | 20) & 0xFu; }
#define XB_SPIN(cond, bar) do { unsigned _sp = 0; while (cond) { __builtin_amdgcn_s_sleep(1); \
    if ((++_sp & 255u) == 0u) { if (xb_ld(&(bar)[XB_TMO])) break; if (_sp > XB_SPIN_CAP) { atomicAdd(&(bar)[XB_TMO], 1u); break; } } } } while (0)

struct XcdBarrier {
    unsigned* bar; unsigned x;
    volatile LAS unsigned* st;
};

__device__ __forceinline__ XcdBarrier xcd_barrier_post(unsigned* bar, volatile LAS unsigned* st) {
    XcdBarrier b; b.bar = bar; b.x = xb_xcc_id(); b.st = st;
    if (threadIdx.x == 0) (void)xb_add(&bar[XB_XCNT(b.x)], 1u);
    return b;
}
__device__ __forceinline__ void xcd_barrier_complete(unsigned* bar, unsigned x, unsigned& nloc, unsigned& nx) {
    const unsigned G = gridDim.x * gridDim.y * gridDim.z;
    unsigned sum, cnt, mine, sp = 0u;
    for (;;) {
        sum = 0u; cnt = 0u; mine = 0u;
#pragma unroll
        for (unsigned j = 0; j < 16; ++j) { const unsigned c = xb_ld(&bar[XB_XCNT(j)]); sum += c; cnt += (c > 0u) ? 1u : 0u; mine = (j == x) ? c : mine; }
        if (sum == G) break;
        __builtin_amdgcn_s_sleep(1);
        if ((++sp & 255u) == 0u) { if (xb_ld(&bar[XB_TMO])) break; if (sp > XB_SPIN_CAP) { atomicAdd(&bar[XB_TMO], 1u); break; } }
    }
    nloc = mine > 0u ? mine : 1u; nx = cnt > 0u ? cnt : 1u;
}

__device__ __forceinline__ void xcd_barrier(const XcdBarrier& b) {
    asm volatile("s_waitcnt vmcnt(0)" ::: "memory");
    __syncthreads();
    if (threadIdx.x == 0) {
        unsigned* bar = b.bar;
        __builtin_amdgcn_s_waitcnt(0);
        unsigned nloc = b.st[0], nx = b.st[1];
        if (nloc == 0u) { xcd_barrier_complete(bar, b.x, nloc, nx); b.st[0] = nloc; b.st[1] = nx; }
        const unsigned old = xb_add(&bar[XB_XSUB(b.x)], 1u);
        const unsigned gen = old / nloc;
        if (old + 1u == (gen + 1u) * nloc) {
            __builtin_amdgcn_fence(__ATOMIC_RELEASE, "agent");
            asm volatile("s_waitcnt vmcnt(0)" ::: "memory");
            const unsigned og = xb_add(&bar[XB_TOP], 1u);
            const unsigned tg = og / nx;
            if (og + 1u == (tg + 1u) * nx) xb_add(&bar[XB_TOPGEN], 1u);
            else XB_SPIN(xb_ld(&bar[XB_TOPGEN]) == tg, bar);
            __builtin_amdgcn_fence(__ATOMIC_ACQUIRE, "agent");
            xb_add(&bar[XB_XGEN(b.x)], 1u);
            asm volatile("s_waitcnt vmcnt(0)" ::: "memory");
        } else {
            XB_SPIN(xb_ld(&bar[XB_XGEN(b.x)]) == gen, bar);
            __builtin_amdgcn_fence(__ATOMIC_ACQUIRE, "agent");
            asm volatile("s_waitcnt vmcnt(0)" ::: "memory");
        }
    }
    __syncthreads();
}

#endif

constexpr int NPH_LAYER = 16;
constexpr int NPH_TOTAL = 1 + 2 * NPH_LAYER;
constexpr int SMEM_BYTES = 158976 + 1024;

#ifndef CPU_EMU
DI void phase_attn_queue(const Frame& F, int l) {
    {
            const AttnDesc Ag = desc_gqa(F), Am = desc_mla(F);
            const int ng = attn_nunit<64, 64, 64, 2>(Ag), nm = attn_nunit<96, 64, 64, 1>(Am);
            unsigned* qctr = (unsigned*)(F.ws + CTL_QUEUE) + l * 64;
            volatile int* slot = (volatile int*)(F.smem + SMEM_BYTES - 32);
            for (;;) {
                __syncthreads();
                if (fresh_tid(F) == 0) *slot = (int)atomicAdd(qctr, 1u);
                __syncthreads();
                const int u = *slot;
                if (u >= ng + nm) break;
                if (u < ng) attn_unit<64, 64, 64, 2>(F, Ag, u); else attn_unit<96, 64, 64, 1>(F, Am, u - ng);
            }
        }
}
#endif

template <int K>
DI void run_layer_phase(const Frame& F, int l) {
    if constexpr (K == 0) phase_cvt(F, l);
    if constexpr (K == 1) phase_gemm1(F);
    if constexpr (K == 2) phase_prep(F, l);
    if constexpr (K == 3) phase_mlaup(F);
    if constexpr (K == 4) {
#ifdef CPU_EMU
        attn_phase<64, 64>(F, desc_gqa(F)); attn_phase<96, 64>(F, desc_mla(F)); phase_scans(F);
#else
        phase_scans(F);
        phase_attn_queue(F, l);
#endif
    }
#ifdef CPU_EMU
    if constexpr (K == 5) phase_fin(F, l);
#else
    if constexpr (K == 5) phase_fin_gpu(F, l);
#endif
    if constexpr (K == 6) phase_gemm_sq<0>(F, WSP(bf16, OFF_YCAT), W_OUT_T, nullptr);
    if constexpr (K == 7) phase_ln(F, F.in[26] + l * 1024, F.in[27] + l * 1024);
    if constexpr (K == 8) phase_gemm_sq<1>(F, WSP(bf16, OFF_XB), W_Q_T, WSP(bf16, OFF_QMEM));
    if constexpr (K == 9) {
#ifdef CPU_EMU
        attn_phase<256, 256>(F, desc_mem(F));
#else
        attn_phase<256, 256, 128, 1>(F, desc_mem(F));
#endif
    }
    if constexpr (K == 10) phase_gemm_sq<0>(F, WSP(bf16, OFF_OMEM), W_O_T, nullptr);
    if constexpr (K == 11) { phase_ln<true>(F, F.in[31] + l * 1024, F.in[32] + l * 1024); phase_cvt_moe(F, l); }
#ifdef CPU_EMU
    if constexpr (K == 12) phase_route(F, l);
#else
    if constexpr (K == 12) phase_route_gpu(F, l);
#endif
    if constexpr (K == 13) phase_moe_up(F, l);
    if constexpr (K == 14) phase_moe_down(F, l);
    if constexpr (K == 15) phase_ln3(F, l);
}

#ifndef CPU_EMU
template <int K>
__global__ void __launch_bounds__(512, 2) k_phase(Args a, int l) {
    extern __shared__ __attribute__((aligned(16))) unsigned char lds[];
    Frame F; F.in = (InPtr)__builtin_amdgcn_kernarg_segment_ptr(); F.xf = a.out; F.ws = a.ws; F.smem = lds; F.tid = threadIdx.x; F.wv = __builtin_amdgcn_readfirstlane((int)(threadIdx.x >> 6)); F.nblk = a.ph_lo;
    if constexpr (K < 0) phase_pro(F); else run_layer_phase<K>(F, l);
}

template <int K>
static void launch_phase(const Args& a, int l, int grid, hipStream_t stream) {
    static bool attr = false;
    if (!attr) { (void)hipFuncSetAttribute((const void*)k_phase<K>, hipFuncAttributeMaxDynamicSharedMemorySize, SMEM_BYTES); attr = true; }
    hipLaunchKernelGGL(k_phase<K>, dim3(grid), dim3(512), SMEM_BYTES, stream, a, l);
}

__global__ void __launch_bounds__(512, 2) fwd_one(Args a) {
    extern __shared__ __attribute__((aligned(16))) unsigned char lds[];
    const int wave_s = __builtin_amdgcn_readfirstlane((int)(threadIdx.x >> 6));
    volatile LAS unsigned* st = (volatile LAS unsigned*)(lds + SMEM_BYTES - 16);
    if (threadIdx.x == 0) { st[0] = 0u; st[1] = 0u; st[2] = 0u; st[3] = 0u; }
    __syncthreads();
    XcdBarrier bar = xcd_barrier_post((unsigned*)(a.ws + OFF_CTL), st);
    Frame F;
#define FRESH do { unsigned z_ = 0u, m_ = ~0u; int ws_ = wave_s; asm volatile("" : "+s"(z_), "+s"(ws_), "+s"(m_)); \
        int t_ = ws_ * 64 + (int)__builtin_amdgcn_mbcnt_hi(m_, __builtin_amdgcn_mbcnt_lo(m_, 0u)); asm volatile("" : "+v"(t_)); \
        const __attribute__((address_space(4))) char* kp_ = (const __attribute__((address_space(4))) char*)__builtin_amdgcn_kernarg_segment_ptr() + z_; \
        F.in = (InPtr)kp_; F.xf = *(float* const __attribute__((address_space(4)))*)(kp_ + 42 * 8); F.ws = *(unsigned char* const __attribute__((address_space(4)))*)(kp_ + 43 * 8); \
        F.smem = lds; F.tid = t_; F.wv = ws_; F.nblk = *(const int __attribute__((address_space(4)))*)(kp_ + 44 * 8); } while (0)
#define GB do { { unsigned zb_ = 0u; unsigned xx_ = __builtin_amdgcn_readfirstlane(bar.x); asm volatile("" : "+s"(zb_), "+s"(xx_)); bar.bar = (unsigned*)(a.ws + OFF_CTL) + zb_; bar.x = xx_; } \
        xcd_barrier(bar); } while (0)
#define DUP(k) ((PROBE_DUP >> (k)) & 1)
    FRESH; phase_pro(F); FRESH; phase_cvt(F, 0); GB;
    if (DUP(0)) { FRESH; phase_cvt(F, 0); GB; }
    for (int l = 0; l < 2; ++l) {
        FRESH; run_layer_phase<1>(F, l); GB;
        if (DUP(1)) { FRESH; run_layer_phase<1>(F, l); GB; }
        FRESH; run_layer_phase<2>(F, l); GB;
        FRESH; run_layer_phase<3>(F, l); GB;
        if (DUP(3)) { FRESH; run_layer_phase<3>(F, l); GB; }
        if (DUP(4)) { FRESH; attn_phase<64, 64, 64, 2>(F, desc_gqa(F)); attn_phase<96, 64, 64, 1>(F, desc_mla(F)); GB; }
        FRESH; run_layer_phase<4>(F, l); GB;
        FRESH; run_layer_phase<5>(F, l); GB;
        if (DUP(5)) { FRESH; run_layer_phase<5>(F, l); GB; }
        FRESH; run_layer_phase<6>(F, l); GB;
        FRESH; run_layer_phase<7>(F, l); GB;
        FRESH; run_layer_phase<8>(F, l); GB;
        if (DUP(8)) { FRESH; run_layer_phase<8>(F, l); GB; }
        FRESH; run_layer_phase<9>(F, l); GB;
        if (DUP(9)) { FRESH; run_layer_phase<9>(F, l); GB; }
        FRESH; run_layer_phase<10>(F, l); GB;
        FRESH; run_layer_phase<11>(F, l); if (NTOK % (F.nblk * 32) != 0) GB; FRESH; run_layer_phase<12>(F, l); if (l == 0) { FRESH; phase_cvt(F, 1); } GB;
        if (DUP(11)) { FRESH; phase_cvt_moe(F, l); GB; }
        FRESH; run_layer_phase<13>(F, l); GB;
        if (DUP(13)) { FRESH; run_layer_phase<13>(F, l); GB; }
        FRESH; run_layer_phase<14>(F, l); GB;
        if (DUP(14)) { FRESH; run_layer_phase<14>(F, l); GB; }
        FRESH; run_layer_phase<15>(F, l); if (l == 0) GB;
    }
#undef DUP
#undef GB
#undef FRESH
}

extern "C" void kernel_launch(void* const* d_in, const int* in_sizes, int n_in, void* d_out, int out_size, void* d_ws, size_t ws_size, hipStream_t stream) {
    if (n_in != 42 || ws_size < WS_END) return;
    Args a{};
    for (int i = 0; i < 42; ++i) a.in[i] = (const float*)d_in[i];
    a.out = (float*)d_out; a.ws = (unsigned char*)d_ws; a.ph_lo = 0; a.ph_hi = NPH_TOTAL;
    (void)hipMemsetAsync(d_ws, 0, CTL_BYTES, stream);
#if N_LAUNCH_MODE == 1
    static int grid = 0;
    if (!grid) {
        int dev = 0, cus = 0, per_cu = 0;
        (void)hipGetDevice(&dev);
        (void)hipDeviceGetAttribute(&cus, hipDeviceAttributeMultiprocessorCount, dev);
        (void)hipFuncSetAttribute((const void*)fwd_one, hipFuncAttributeMaxDynamicSharedMemorySize, SMEM_BYTES);
        (void)hipOccupancyMaxActiveBlocksPerMultiprocessor(&per_cu, (const void*)fwd_one, 512, SMEM_BYTES);
        (void)hipGetLastError();
        grid = cus > 0 ? cus : 256;
    }
    a.ph_lo = grid;
    hipLaunchKernelGGL(fwd_one, dim3(grid), dim3(512), SMEM_BYTES, stream, a);
#else
    const int grid = 256; a.ph_lo = grid;
    launch_phase<-1>(a, 0, grid, stream);
    for (int l = 0; l < 2; ++l) {
        launch_phase<0>(a, l, grid, stream); launch_phase<1>(a, l, grid, stream); launch_phase<2>(a, l, grid, stream); launch_phase<3>(a, l, grid, stream);
        launch_phase<4>(a, l, grid, stream); launch_phase<5>(a, l, grid, stream); launch_phase<6>(a, l, grid, stream); launch_phase<7>(a, l, grid, stream);
        launch_phase<8>(a, l, grid, stream); launch_phase<9>(a, l, grid, stream); launch_phase<10>(a, l, grid, stream); launch_phase<11>(a, l, grid, stream);
        launch_phase<12>(a, l, grid, stream); launch_phase<13>(a, l, grid, stream); launch_phase<14>(a, l, grid, stream); launch_phase<15>(a, l, grid, stream);
    }
#endif
}
#endif
```

```cpp
#ifndef CPU_EMU
#include <hip/hip_runtime.h>
#else
#include "emu_shim.h"
#endif
#include <stdint.h>

#ifndef CFG_B
#define CFG_B 16
#endif
#ifndef CFG_S
#define CFG_S 2048
#endif
#ifndef PROBE_DUP
#define PROBE_DUP 0
#endif
#ifndef N_LAUNCH_MODE
#define N_LAUNCH_MODE 1
#endif

typedef unsigned short bf16;
#define DI __device__ __forceinline__

constexpr int BATCH = CFG_B, SEQ = CFG_S, NTOK = BATCH * SEQ, DM = 1024;
constexpr int MEMT = 256, NMEM = BATCH * MEMT;
constexpr int GRIDW = 64;
constexpr int HP = 3328;
constexpr int IN_WIDTH = 3104;
constexpr int NEXP = 32, MOEH = 256;
constexpr int MOE_ROWS = 2 * NTOK + NEXP * 256;
constexpr float LN_EPS = 1e-5f, RMS_EPS = 1e-6f, GN_EPS = 64e-5f;
constexpr float DN_ALPHA = 1.41421356237309515f;
constexpr float DECAY_SCALE = 0.60653065971263342f;

constexpr size_t AL(size_t x) { return (x + 255) & ~(size_t)255; }
constexpr size_t OFF_CTL = 0;
constexpr size_t CTL_BYTES = 32768;
constexpr size_t CTL_CNT = 16384;
constexpr size_t CTL_EOFF = 16384 + 1024;
constexpr size_t CTL_QUEUE = 16384 + 2048;
constexpr size_t OFF_XB = AL(OFF_CTL + CTL_BYTES);
constexpr size_t SZ_XB = (size_t)NTOK * DM * 2;
constexpr size_t OFF_WTS = AL(OFF_XB + SZ_XB);
constexpr size_t W_IN_T = 0;
constexpr size_t W_UQ_T = W_IN_T + (size_t)HP * 1024 * 2;
constexpr size_t W_UKV_T = W_UQ_T + 512 * 256 * 2;
constexpr size_t W_OUT_T = W_UKV_T + 512 * 256 * 2;
constexpr size_t W_Q_T = W_OUT_T + 1024 * 1024 * 2;
constexpr size_t W_KV_T = W_Q_T + 1024 * 1024 * 2;
constexpr size_t W_O_T = W_KV_T + 2048 * 1024 * 2;
constexpr size_t W_GATE_T = W_O_T + 1024 * 1024 * 2;
constexpr size_t SZ_WTS = W_GATE_T + 2 * 48 * 1024 * 4;
constexpr size_t OFF_KMEM = AL(OFF_WTS + SZ_WTS);
constexpr size_t OFF_VTMEM = AL(OFF_KMEM + (size_t)NMEM * 1024 * 2);
constexpr size_t OFF_MEMB = AL(OFF_VTMEM + (size_t)NMEM * 1024 * 2);
constexpr size_t OFF_VTATT = AL(OFF_MEMB + (size_t)NMEM * 1024 * 2);
constexpr size_t OFF_VTMLA = AL(OFF_VTATT + (size_t)BATCH * 2 * 64 * SEQ * 2);
constexpr size_t OFF_HATT = AL(OFF_VTMLA + (size_t)BATCH * 4 * 64 * SEQ * 2);
constexpr size_t OFF_HMLA = OFF_HATT + (size_t)NTOK * 512 * 2;
constexpr size_t OFF_HRWKV = OFF_HMLA + (size_t)NTOK * 512 * 2;
constexpr size_t OFF_R7 = OFF_HRWKV + (size_t)NTOK * 1024 * 2;
constexpr size_t SZ_R7 = (size_t)NTOK * 9 * 256 * 2;
constexpr size_t OFF_HHGRN = OFF_R7 + SZ_R7;
constexpr size_t OFF_HX = OFF_HHGRN + (size_t)NTOK * 1280 * 2;
constexpr size_t OFF_HAM = OFF_HX + (size_t)NTOK * 256 * 2;
constexpr size_t OFF_HEG = OFF_HAM + (size_t)(NTOK / 16) * 8 * 256 * 2;
constexpr size_t OFF_REG = OFF_HEG + (size_t)(NTOK / 16) * 8 * 64 * 4;
constexpr size_t WS_END = OFF_REG + (size_t)(NTOK / 16) * 8 * 64 * 2;
static_assert(WS_END <= (size_t)4 * NTOK * DM * 4 || CFG_B != 16, "workspace must fit 4 x the largest tensor");

constexpr size_t OFF_QMLA = OFF_XB;
constexpr size_t OFF_KNOPE = OFF_QMLA + (size_t)NTOK * 384 * 2;
constexpr size_t OFF_KROPE = OFF_KNOPE + (size_t)NTOK * 256 * 2;
constexpr size_t OFF_G = OFF_KROPE + (size_t)NTOK * 32 * 2;
constexpr size_t OFF_BONUS = OFF_G + (size_t)NTOK * 256 * 2;
constexpr size_t OFF_RSIDE = OFF_BONUS + (size_t)NTOK * 16;
static_assert(OFF_RSIDE + (size_t)(NTOK / 16) * 2 * 512 * 2 <= OFF_XB + SZ_XB, "xb alias region");
constexpr size_t OFF_YCAT = OFF_HRWKV;
constexpr size_t OFF_QMEM = OFF_HATT;
constexpr size_t OFF_OMEM = OFF_R7;
#ifdef CPU_EMU
constexpr size_t OFF_EMU_SCAN = WS_END;
constexpr size_t OFF_LISTS = AL(OFF_EMU_SCAN + (size_t)4 * NTOK * 256 * 2);
#else
constexpr size_t OFF_LISTS = OFF_HATT;
#endif
constexpr size_t OFF_TINFO = OFF_LISTS + (size_t)NEXP * NTOK * 4;
constexpr size_t OFF_HM = AL(OFF_TINFO + (size_t)NTOK * 32);
constexpr size_t OFF_YROWS = AL(OFF_HM + (size_t)MOE_ROWS * 256 * 2);
#ifdef CPU_EMU
constexpr size_t OFF_W13T = AL(OFF_YROWS + (size_t)MOE_ROWS * 1024 * 2);
#else
static_assert(OFF_YROWS + (size_t)MOE_ROWS * 1024 * 2 <= OFF_HHGRN, "moe alias region");
constexpr size_t OFF_W13T = OFF_HHGRN;
#endif
constexpr size_t OFF_W2T = OFF_W13T + (size_t)NEXP * 512 * 1024 * 2;
#ifdef CPU_EMU
constexpr size_t WS_END_EMU = OFF_W2T + (size_t)NEXP * 1024 * 256 * 2;
#else
static_assert(OFF_W2T + (size_t)NEXP * 1024 * 256 * 2 <= WS_END, "moe weights alias");
#endif

enum { C_KT0 = 0, C_KT1 = 1, C_RT0 = 2, C_RT1 = 3, C_KK0 = 4, C_KK1 = 5, C_AT0 = 6, C_AT1 = 7, C_VT = 8 };
enum { R_R = 0, R_V = 1, R_KK = 2, R_W0 = 3, R_W1 = 4, R_KD0 = 5, R_KD1 = 6, R_AK0 = 7, R_AK1 = 8 };

DI float bf2f(bf16 v) { union { unsigned u; float f; } x; x.u = (unsigned)v << 16; return x.f; }
DI bf16 f2bf(float f) { union { unsigned u; float f; } x; x.f = f; unsigned u = x.u; u += 0x7fffu + ((u >> 16) & 1u); return (bf16)(u >> 16); }
DI float sigmoidf_(float x) { return 1.0f / (1.0f + expf(-x)); }
DI float siluf_(float x) { return x * sigmoidf_(x); }

#ifdef CPU_EMU
typedef const float* const* InPtr;
#else
typedef const float* const __attribute__((address_space(4)))* InPtr;
#endif
struct Frame {
    InPtr in;
    float* xf;
    unsigned char* ws;
    unsigned char* smem;
    int tid;
    int wv;
    int nblk;
};
#ifdef CPU_EMU
constexpr int NTH = 1;
#else
constexpr int NTH = 512;
#endif
#ifdef CPU_EMU
constexpr int GRP = 1;
DI float grp_sum(const Frame& F, float v) { return v; }
DI int gthreads(const Frame& F) { return 1; }
DI int gtid_(const Frame& F) { return 0; }
DI int wave_item_index(const Frame& F) { return 0; }
#else
constexpr int GRP = 64;
DI float shfl_idx(const Frame& F, float v, int src_lane) { return __builtin_bit_cast(float, __builtin_amdgcn_ds_bpermute(src_lane << 2, __builtin_bit_cast(int, v))); }
DI float shfl_xor(const Frame& F, float v, int mask) {
    unsigned m0 = ~0u; asm volatile("" : "+s"(m0));
    const int lane = (int)__builtin_amdgcn_mbcnt_hi(m0, __builtin_amdgcn_mbcnt_lo(m0, 0u));
    return shfl_idx(F, v, lane ^ mask); }
template <int CTRL> DI float dppf(float x) { return __builtin_bit_cast(float, __builtin_amdgcn_update_dpp(0, __builtin_bit_cast(int, x), CTRL, 0xf, 0xf, true)); }
DI float allsum16(float x) { x += dppf<0xB1>(x); x += dppf<0x4E>(x); x += dppf<0x141>(x); x += dppf<0x140>(x); return x; }
DI float rdlane(float x, int l) { return __builtin_bit_cast(float, __builtin_amdgcn_readlane(__builtin_bit_cast(int, x), l)); }
DI float grp_sum(const Frame& F, float v) { v = allsum16(v); return (rdlane(v, 0) + rdlane(v, 16)) + (rdlane(v, 32) + rdlane(v, 48)); }
DI int gthreads(const Frame& F) { return F.nblk * NTH; }
DI int gtid_(const Frame& F) { return blockIdx.x * NTH + F.tid; }
DI int wave_item_index(const Frame& F) { return (int)(((F.tid >> 6) * F.nblk + blockIdx.x) * 64 + (F.tid & 63)); }
#endif
constexpr int PER64 = 64 / GRP;
constexpr int PERLN = 1024 / GRP;
DI int fresh_tid(const Frame& F) {
#ifdef CPU_EMU
    return 0;
#else
    unsigned m0 = ~0u; asm volatile("" : "+s"(m0));
    int t = F.wv * 64 + (int)__builtin_amdgcn_mbcnt_hi(m0, __builtin_amdgcn_mbcnt_lo(m0, 0u)); asm volatile("" : "+v"(t)); return t;
#endif
}
DI int glane(const Frame& F) { return (int)(F.tid % GRP); }
DI int ggrp(const Frame& F) { return gtid_(F) / GRP; }
DI int ngrp(const Frame& F) { return gthreads(F) / GRP; }

struct Args {
    const float* in[42];
    float* out;
    unsigned char* ws;
    int ph_lo, ph_hi;
};

DI float rope_inv(int f, int nf) { return powf(10000.0f, -(float)f / (float)nf); }

#ifndef CPU_EMU
using bf16x8 = __attribute__((ext_vector_type(8))) short;
using bf16x4 = __attribute__((ext_vector_type(4))) short;
using f32x4 = __attribute__((ext_vector_type(4))) float;
using f32x16 = __attribute__((ext_vector_type(16))) float;
typedef __bf16 bf16v2 __attribute__((ext_vector_type(2)));
typedef float f32v2 __attribute__((ext_vector_type(2)));
DI float bflo(unsigned u) { return __uint_as_float(u << 16); }
DI float bfhi(unsigned u) { return __uint_as_float(u & 0xffff0000u); }
DI unsigned pack_bf16(float lo, float hi) { f32v2 v = {lo, hi}; bf16v2 b = __builtin_convertvector(v, bf16v2); return __builtin_bit_cast(unsigned, b); }

constexpr int G_BM = 256, G_BK = 64, G_HALF = 128, G_HT = G_HALF * G_BK, G_SHM = 8 * G_HT * 2;
DI int g_lds_byte(int r, int c) { int st = (r >> 4) * 2 + (c >> 5), rr = r & 15, cc = c & 31, ob = rr * 64 + cc * 2; return st * 1024 + (ob ^ (((ob >> 9) & 1) << 5)); }
DI void g_stage_rc(int b, int& R, int& C) { int st = b / 1024, sb = b % 1024, swz = sb ^ (((sb >> 9) & 1) << 5); R = (st >> 1) * 16 + swz / 64; C = (st & 1) * 32 + (swz % 64) / 2; }

template <bool GATHER, class Epi>
DI void gemm_unit_t(int wv_in, bf16* shm, const bf16* __restrict__ A, int lda, const int* rowmap, int arow0,
                    const bf16* __restrict__ Bt, int ldb, int bcol0, int K, const Epi& epi) {
#define SA(b, h) (shm + ((b) * 2 + (h)) * G_HT)
#define SB(b, h) (shm + (4 + (b) * 2 + (h)) * G_HT)
#define STAGE_AX(T, P, hf, kt) do { for (int _i = 0; _i < 2; ++_i) { int _b = (T) * 16 + _i * 8192; int _r, _c; g_stage_rc(_b, _r, _c); \
        const long _row = GATHER ? (long)rowmap[(hf) * G_HALF + _r] : (long)(arow0 + (hf) * G_HALF + _r); \
        __builtin_amdgcn_global_load_lds((const unsigned*)(A + _row * lda + (long)(kt) * G_BK + _c), (unsigned*)((char*)(P) + _b), 16, 0, 0); } } while (0)
#define STAGE_BX(T, P, hf, kt) do { for (int _i = 0; _i < 2; ++_i) { int _b = (T) * 16 + _i * 8192; int _r, _c; g_stage_rc(_b, _r, _c); \
        __builtin_amdgcn_global_load_lds((const unsigned*)(Bt + (long)(bcol0 + (hf) * G_HALF + _r) * ldb + (long)(kt) * G_BK + _c), (unsigned*)((char*)(P) + _b), 16, 0, 0); } } while (0)
#define STAGE_A(P, hf, kt) STAGE_AX(t0, P, hf, kt)
#define STAGE_B(P, hf, kt) STAGE_BX(t0, P, hf, kt)
#define LDA(dst, b, h) for (int m = 0; m < 4; ++m) for (int k = 0; k < 2; ++k) \
        dst[m][k] = *reinterpret_cast<const bf16x8*>((char*)SA(b, h) + g_lds_byte(wr * 64 + m * 16 + fr, k * 32 + fq * 8))
#define LDB(dst, b, h) for (int n = 0; n < 2; ++n) for (int k = 0; k < 2; ++k) \
        dst[n][k] = *reinterpret_cast<const bf16x8*>((char*)SB(b, h) + g_lds_byte(wc * 32 + n * 16 + fr, k * 32 + fq * 8))
#define MMA(ai, bj, At, Bt_) do { __builtin_amdgcn_s_setprio(1); \
        for (int m = 0; m < 4; ++m) for (int n = 0; n < 2; ++n) for (int k = 0; k < 2; ++k) \
            acc[ai][bj][m][n] = __builtin_amdgcn_mfma_f32_16x16x32_bf16(Bt_[n][k], At[m][k], acc[ai][bj][m][n], 0, 0, 0); \
        __builtin_amdgcn_s_setprio(0); } while (0)
#define WAIT_V(n) asm volatile("s_waitcnt vmcnt(" #n ")" ::: "memory")
#define WAIT_L(n) asm volatile("s_waitcnt lgkmcnt(" #n ")" ::: "memory")
#define BAR __builtin_amdgcn_s_barrier()
#define SCHED __builtin_amdgcn_sched_barrier(0)
    unsigned m0 = ~0u; asm volatile("" : "+s"(m0));
    int t0 = wv_in * 64 + (int)__builtin_amdgcn_mbcnt_hi(m0, __builtin_amdgcn_mbcnt_lo(m0, 0u)); asm volatile("" : "+v"(t0));
    int wid = t0 >> 6, lane = t0 & 63, wr = wid >> 2, wc = wid & 3, fr = lane & 15, fq = lane >> 4;
    f32x4 acc[2][2][4][2] = {};
    bf16x8 At[4][2], B0[2][2], B1[2][2];
    const int nt = K / G_BK;
    STAGE_B(SB(0, 0), 0, 0); STAGE_A(SA(0, 0), 0, 0);
    STAGE_B(SB(0, 1), 1, 0); STAGE_A(SA(0, 1), 1, 0);
    if (wr == 1) BAR;
    WAIT_V(4); BAR;
    STAGE_B(SB(1, 0), 0, 1); STAGE_A(SA(1, 0), 0, 1); STAGE_B(SB(1, 1), 1, 1);
    WAIT_V(6); BAR;
    for (int t = 0; t < nt - 2; t += 2) {
        LDB(B0, 0, 0); SCHED; LDA(At, 0, 0); STAGE_A(SA(1, 1), 1, t + 1);
        WAIT_L(8); BAR; WAIT_L(0); MMA(0, 0, At, B0); BAR; SCHED;
        LDB(B1, 0, 1); STAGE_B(SB(0, 0), 0, t + 2);
        BAR; WAIT_L(0); MMA(0, 1, At, B1); BAR;
        LDA(At, 0, 1); STAGE_A(SA(0, 0), 0, t + 2);
        BAR; WAIT_L(0); MMA(1, 0, At, B0); BAR; SCHED;
        STAGE_B(SB(0, 1), 1, t + 2);
        WAIT_V(6); BAR; MMA(1, 1, At, B1); BAR;
        LDB(B0, 1, 0); SCHED; LDA(At, 1, 0); STAGE_A(SA(0, 1), 1, t + 2);
        WAIT_L(8); BAR; WAIT_L(0); MMA(0, 0, At, B0); BAR; SCHED;
        LDB(B1, 1, 1); STAGE_B(SB(1, 0), 0, t + 3);
        BAR; WAIT_L(0); MMA(0, 1, At, B1); BAR;
        LDA(At, 1, 1); STAGE_A(SA(1, 0), 0, t + 3);
        BAR; WAIT_L(0); MMA(1, 0, At, B0); BAR; SCHED;
        STAGE_B(SB(1, 1), 1, t + 3);
        WAIT_V(6); BAR; MMA(1, 1, At, B1); BAR;
    }
    int tz = t0; asm volatile("" : "+v"(tz)); wid = tz >> 6; lane = tz & 63; wr = wid >> 2; wc = wid & 3; fr = lane & 15; fq = lane >> 4;
    { LDB(B0, 0, 0); WAIT_V(0); LDA(At, 0, 0); STAGE_AX(tz, SA(1, 1), 1, nt - 1);
      BAR; WAIT_L(0); MMA(0, 0, At, B0); BAR;
      LDB(B1, 0, 1); BAR; WAIT_L(0); MMA(0, 1, At, B1); BAR;
      LDA(At, 0, 1); WAIT_V(4); BAR; WAIT_L(0); MMA(1, 0, At, B0); MMA(1, 1, At, B1); BAR; }
    { LDB(B0, 1, 0); LDA(At, 1, 0); WAIT_V(2); BAR; WAIT_L(0); MMA(0, 0, At, B0); BAR;
      LDB(B1, 1, 1); WAIT_V(0); BAR; WAIT_L(0); MMA(0, 1, At, B1); BAR;
      LDA(At, 1, 1); BAR; WAIT_L(0); MMA(1, 0, At, B0); MMA(1, 1, At, B1); BAR; }
    if (wr == 0) BAR;
#pragma unroll
    for (int ai = 0; ai < 2; ++ai)
#pragma unroll
        for (int m = 0; m < 4; ++m)
#pragma unroll
            for (int bj = 0; bj < 2; ++bj)
#pragma unroll
                for (int n = 0; n < 2; ++n) {
                    const f32x4 v = acc[ai][bj][m][n];
                    epi(ai * G_HALF + wr * 64 + m * 16 + fr, bj * G_HALF + wc * 32 + n * 16 + fq * 4, v[0], v[1], v[2], v[3]);
                }
#undef SA
#undef SB
#undef STAGE_A
#undef STAGE_B
#undef STAGE_AX
#undef STAGE_BX
#undef LDA
#undef LDB
#undef MMA
}
template <class Epi>
DI void gemm_unit(const Frame& F, const bf16* __restrict__ A, int lda, const int* rowmap, int arow0,
                  const bf16* __restrict__ Bt, int ldb, int bcol0, int K, const Epi& epi) {
    if (rowmap) gemm_unit_t<true>(F.wv, (bf16*)F.smem, A, lda, rowmap, arow0, Bt, ldb, bcol0, K, epi);
    else gemm_unit_t<false>(F.wv, (bf16*)F.smem, A, lda, rowmap, arow0, Bt, ldb, bcol0, K, epi);
}
#else
template <class Epi>
void gemm_unit(const Frame& F, const bf16* A, int lda, const int* rowmap, int arow0, const bf16* Bt, int ldb, int bcol0, int K, const Epi& epi, int mrows = 256) {
    for (int r = 0; r < mrows; ++r) {
        int arow = rowmap ? rowmap[r] : arow0 + r;
        for (int c = 0; c < 256; c += 4) {
            float v[4];
            for (int q = 0; q < 4; ++q) {
                double s = 0; const bf16* a = A + (long)arow * lda; const bf16* b = Bt + (long)(bcol0 + c + q) * ldb;
                for (int k = 0; k < K; ++k) s += (double)bf2f(a[k]) * bf2f(b[k]);
                v[q] = (float)s;
            }
            epi(r, c, v[0], v[1], v[2], v[3]);
        }
    }
}
#endif

DI void st_bf16x4(bf16* p, float a, float b, float c, float d) {
#ifndef CPU_EMU
    uint2 u; u.x = pack_bf16(a, b); u.y = pack_bf16(c, d); *reinterpret_cast<uint2*>(p) = u;
#else
    p[0] = f2bf(a); p[1] = f2bf(b); p[2] = f2bf(c); p[3] = f2bf(d);
#endif
}

#define WSP(T, off) ((T*)(F.ws + (off)))

DI void ln_row_write(float* xrow, bf16* brow, const float* vals_in  , const float* g, const float* b);

template <class Fn>
DI void layer_norm_rows(const Frame& F, const float* g, const float* b, Fn pre, bool write_out_extra, float* extra) {
    float* xf = F.xf; bf16* xb = WSP(bf16, OFF_XB);
    for (int row = ggrp(F); row < NTOK; row += ngrp(F)) {
        float v[PERLN]; float s = 0.f;
        for (int i = 0; i < PERLN; ++i) { int c = glane(F) + i * GRP; v[i] = pre(row, c); s += v[i]; }
        s = grp_sum(F, s); const float mu = s * (1.0f / 1024.0f);
        float q = 0.f;
        for (int i = 0; i < PERLN; ++i) { float d = v[i] - mu; q += d * d; }
        q = grp_sum(F, q); const float rs = 1.0f / sqrtf(q * (1.0f / 1024.0f) + LN_EPS);
        for (int i = 0; i < PERLN; ++i) { int c = glane(F) + i * GRP; float y = (v[i] - mu) * rs * g[c] + b[c];
            xf[(size_t)row * DM + c] = y; xb[(size_t)row * DM + c] = f2bf(y); if (write_out_extra) extra[(size_t)row * DM + c] = y; }
    }
}

#ifndef CPU_EMU
template <int MODE, bool BLOCKED = false, bool WXF = true>
DI void ln_rows_gpu(const Frame& F, const float* __restrict__ g, const float* __restrict__ b, int l) {
    float* xf = F.xf; bf16* xb = WSP(bf16, OFF_XB);
    const float* xin = F.in[0];
    const bf16* yr = WSP(bf16, OFF_YROWS); const float* tinfo = WSP(float, OFF_TINFO);
    const int* eoff = (const int*)(F.ws + CTL_EOFF) + l * 33;
    const int tid = F.tid, wave = tid >> 6, lane = tid & 63;
    float4 gv[4], bv[4];
#pragma unroll
    for (int i = 0; i < 4; ++i) { gv[i] = *reinterpret_cast<const float4*>(g + lane * 4 + 256 * i); bv[i] = *reinterpret_cast<const float4*>(b + lane * 4 + 256 * i); }
    const bool blk_ok = BLOCKED && (NTOK % (F.nblk * 32) == 0);
    const int rpb = NTOK / F.nblk;
    const int r_first = blk_ok ? blockIdx.x * rpb + wave * 4 : (blockIdx.x * 8 + wave) * 4;
    const int r_end = blk_ok ? (blockIdx.x + 1) * rpb : NTOK;
    const int r_step = blk_ok ? 32 : F.nblk * 32;
    unsigned nra[4] = {0u, 0u, 0u, 0u}, nrb[4] = {0u, 0u, 0u, 0u}; float ng0[4] = {0.f, 0.f, 0.f, 0.f}, ng1[4] = {0.f, 0.f, 0.f, 0.f};
#define LN_META(r0_) do { if (MODE == 2) { _Pragma("unroll") for (int rr_ = 0; rr_ < 4; ++rr_) { const size_t row_ = (size_t)(r0_) + rr_; \
        const int4 ti_ = *reinterpret_cast<const int4*>(tinfo + row_ * 8); const float2 tg_ = *reinterpret_cast<const float2*>(tinfo + row_ * 8 + 4); \
        nra[rr_] = (unsigned)(eoff[ti_.x] + ti_.y); nrb[rr_] = (unsigned)(eoff[ti_.z] + ti_.w); ng0[rr_] = tg_.x; ng1[rr_] = tg_.y; } } } while (0)
    if (r_first < r_end) LN_META(r_first);
    for (int r0 = r_first; r0 < r_end; r0 += r_step) {
        float4 v[4][4];
        unsigned cra[4], crb[4]; float cg0[4], cg1[4];
#pragma unroll
        for (int rr = 0; rr < 4; ++rr) { cra[rr] = nra[rr]; crb[rr] = nrb[rr]; cg0[rr] = ng0[rr]; cg1[rr] = ng1[rr]; }
        if (r0 + r_step < r_end) LN_META(r0 + r_step);
#pragma unroll
        for (int rr = 0; rr < 4; ++rr) {
            const size_t row = r0 + rr;
            if (MODE == 2) {
                const size_t ra = cra[rr], rb = crb[rr];
                const float g0 = cg0[rr], g1 = cg1[rr];
#pragma unroll
                for (int i = 0; i < 4; ++i) {
                    const int c = lane * 4 + 256 * i;
                    const uint2 xq = *reinterpret_cast<const uint2*>(xb + row * DM + c);
                    float4 x; x.x = bflo(xq.x); x.y = bfhi(xq.x); x.z = bflo(xq.y); x.w = bfhi(xq.y);
                    const uint2 ya = *reinterpret_cast<const uint2*>(yr + ra * 1024 + c), yb = *reinterpret_cast<const uint2*>(yr + rb * 1024 + c);
                    v[rr][i].x = DN_ALPHA * x.x + g0 * bflo(ya.x) + g1 * bflo(yb.x); v[rr][i].y = DN_ALPHA * x.y + g0 * bfhi(ya.x) + g1 * bfhi(yb.x);
                    v[rr][i].z = DN_ALPHA * x.z + g0 * bflo(ya.y) + g1 * bflo(yb.y); v[rr][i].w = DN_ALPHA * x.w + g0 * bfhi(ya.y) + g1 * bfhi(yb.y);
                }
            } else if (MODE == 0) {
#pragma unroll
                for (int i = 0; i < 4; ++i) {
                    const uint2 xq = *reinterpret_cast<const uint2*>(xb + row * DM + lane * 4 + 256 * i);
                    v[rr][i].x = bflo(xq.x); v[rr][i].y = bfhi(xq.x); v[rr][i].z = bflo(xq.y); v[rr][i].w = bfhi(xq.y);
                }
            } else {
                const float* src = xin + row * DM;
#pragma unroll
                for (int i = 0; i < 4; ++i) v[rr][i] = *reinterpret_cast<const float4*>(src + lane * 4 + 256 * i);
            }
        }
#pragma unroll
        for (int rr = 0; rr < 4; ++rr) {
            const size_t row = r0 + rr;
            float s = 0.f;
#pragma unroll
            for (int i = 0; i < 4; ++i) s += (v[rr][i].x + v[rr][i].y) + (v[rr][i].z + v[rr][i].w);
            const float mu = grp_sum(F, s) * (1.0f / 1024.0f);
            float q = 0.f;
#pragma unroll
            for (int i = 0; i < 4; ++i) { const float d0 = v[rr][i].x - mu, d1 = v[rr][i].y - mu, d2 = v[rr][i].z - mu, d3 = v[rr][i].w - mu; q += (d0 * d0 + d1 * d1) + (d2 * d2 + d3 * d3); }
            const float rs = 1.0f / sqrtf(grp_sum(F, q) * (1.0f / 1024.0f) + LN_EPS);
#pragma unroll
            for (int i = 0; i < 4; ++i) {
                const int c = lane * 4 + 256 * i;
                float4 y; y.x = (v[rr][i].x - mu) * rs * gv[i].x + bv[i].x; y.y = (v[rr][i].y - mu) * rs * gv[i].y + bv[i].y;
                y.z = (v[rr][i].z - mu) * rs * gv[i].z + bv[i].z; y.w = (v[rr][i].w - mu) * rs * gv[i].w + bv[i].w;
                if (WXF) *reinterpret_cast<float4*>(xf + row * DM + c) = y;
                *reinterpret_cast<uint2*>(xb + row * DM + c) = make_uint2(pack_bf16(y.x, y.y), pack_bf16(y.z, y.w));
            }
        }
    }
#undef LN_META
}
#endif

DI void phase_pro(const Frame& F) {
    const float* x = F.in[0]; const float* mem = F.in[1];
#ifdef CPU_EMU
    layer_norm_rows(F, F.in[2], F.in[3], [&](int row, int c) { return x[(size_t)row * DM + c]; }, false, nullptr);
#else
    (void)x; ln_rows_gpu<1>(F, F.in[2], F.in[3], 0);
#endif
    bf16* memb = WSP(bf16, OFF_MEMB);
    for (size_t i = gtid_(F); i < (size_t)NMEM * DM; i += gthreads(F)) memb[i] = f2bf(mem[i]);
}

template <class Src>
DI void cvt_tile(const Frame& F, bf16* dst, int Kk, int n0, int k0, Src src) {
#ifndef CPU_EMU
    float* tile = (float*)F.smem;
    __syncthreads();
    for (int i = F.tid; i < 4096; i += NTH) { int k = i >> 6, n = i & 63; tile[k * 65 + n] = src(k0 + k, n0 + n); }
    __syncthreads();
    for (int i = F.tid; i < 2048; i += NTH) { int n = i >> 5, k = (i & 31) * 2;
        *reinterpret_cast<unsigned*>(dst + (size_t)(n0 + n) * Kk + k0 + k) = pack_bf16(tile[k * 65 + n], tile[(k + 1) * 65 + n]); }
#endif
}
template <class Src>
DI void cvt_transpose(const Frame& F, bf16* dst, int Nn, int Kk, Src src, int t_first, int t_total) {
#ifdef CPU_EMU
    for (int n = 0; n < Nn; ++n) for (int k = 0; k < Kk; ++k) dst[(size_t)n * Kk + k] = f2bf(src(k, n));
#else
    const int tn = Nn / 64, tk = Kk / 64, ntile = tn * tk;
    int t = (int)blockIdx.x - (t_first % (int)F.nblk); if (t < 0) t += F.nblk;
    for (; t < ntile; t += F.nblk) cvt_tile(F, dst, Kk, (t % tn) * 64, (t / tn) * 64, src);
#endif
}

#ifndef CPU_EMU
template <bool VEC, class CM>
DI void cvt_job(const Frame& F, int& tbase, bf16* dst, int ldd, int Nn, int Kk, int Ksrc, const float* __restrict__ src, int lds, CM cm) {
    const int nw = F.nblk * 8, gw = blockIdx.x * 8 + F.wv;
    const int lane = fresh_tid(F) & 63, kq = lane & 15, nq = lane >> 4;
    const int tk = Kk / 64, T = tk * (Nn / 16);
    int t = gw - (tbase % nw); if (t < 0) t += nw;
    tbase += T;
    for (; t < T; t += nw) {
        const int k = (t % tk) * 64 + 4 * kq, n = (t / tk) * 16 + 4 * nq;
        float4 v[4];
        if (VEC) {
            const int s = cm(n);
#pragma unroll
            for (int i = 0; i < 4; ++i) v[i] = (s >= 0 && k + i < Ksrc) ? *reinterpret_cast<const float4*>(src + (size_t)(k + i) * lds + s) : make_float4(0.f, 0.f, 0.f, 0.f);
        } else {
            const int s0 = cm(n), s1 = cm(n + 1), s2 = cm(n + 2), s3 = cm(n + 3);
#pragma unroll
            for (int i = 0; i < 4; ++i) { const float* row = src + (size_t)(k + i) * lds; const bool ok = k + i < Ksrc;
                v[i].x = (ok && s0 >= 0) ? row[s0] : 0.f; v[i].y = (ok && s1 >= 0) ? row[s1] : 0.f; v[i].z = (ok && s2 >= 0) ? row[s2] : 0.f; v[i].w = (ok && s3 >= 0) ? row[s3] : 0.f; }
        }
        bf16* d = dst + (size_t)n * ldd + k;
        *reinterpret_cast<uint2*>(d) = make_uint2(pack_bf16(v[0].x, v[1].x), pack_bf16(v[2].x, v[3].x));
        *reinterpret_cast<uint2*>(d + ldd) = make_uint2(pack_bf16(v[0].y, v[1].y), pack_bf16(v[2].y, v[3].y));
        *reinterpret_cast<uint2*>(d + 2 * (size_t)ldd) = make_uint2(pack_bf16(v[0].z, v[1].z), pack_bf16(v[2].z, v[3].z));
        *reinterpret_cast<uint2*>(d + 3 * (size_t)ldd) = make_uint2(pack_bf16(v[0].w, v[1].w), pack_bf16(v[2].w, v[3].w));
    }
}
#endif

DI int win_src_col(int n) {
    if (n < 512) return n;
    if (n < 1536) { int c = n - 512; return c < 960 ? 512 + c : -1; }
    if (n < 2816) return 1472 + (n - 1536);
    int c = n - 2816;
    if (c < 192) return 2752 + c;
    if (c < 224) return 2752 + 320 + (c - 192);
    if (c < 256) return -1;
    if (c < 384) return 2752 + 192 + (c - 256);
    return -1;
}
DI int wuq_src_col(int n) {
    if (n >= 384) return -1;
    int h = n / 96, w = n % 96;
    if (w < 64) return h * 96 + w;
    int p = w - 64, m = p >> 1, which = p & 1;
    int i = (m < 8 ? m : 16 + (m - 8)) + (which ? 8 : 0);
    return h * 96 + 64 + i;
}

DI void phase_cvt(const Frame& F, int l) {
    bf16* wts = WSP(bf16, OFF_WTS);
#ifndef CPU_EMU
    {
        int tb = 0;
        auto ident = [](int n) { return n; };
        cvt_job<true>(F, tb, (bf16*)((char*)wts + W_IN_T), 1024, HP, 1024, 1024, F.in[4] + (size_t)l * 1024 * IN_WIDTH, IN_WIDTH, [](int n) { return win_src_col(n); });
        cvt_job<false>(F, tb, (bf16*)((char*)wts + W_UQ_T), 256, 512, 256, 192, F.in[23] + (size_t)l * 192 * 384, 384, [](int n) { return wuq_src_col(n); });
        cvt_job<true>(F, tb, (bf16*)((char*)wts + W_UKV_T), 256, 512, 256, 128, F.in[24] + (size_t)l * 128 * 512, 512, ident);
        cvt_job<true>(F, tb, (bf16*)((char*)wts + W_OUT_T), 1024, 1024, 1024, 1024, F.in[25] + (size_t)l * 1024 * 1024, 1024, ident);
        cvt_job<true>(F, tb, (bf16*)((char*)wts + W_Q_T), 1024, 1024, 1024, 1024, F.in[28] + (size_t)l * 1024 * 1024, 1024, ident);
        cvt_job<true>(F, tb, (bf16*)((char*)wts + W_KV_T), 1024, 2048, 1024, 1024, F.in[29] + (size_t)l * 1024 * 2048, 2048, ident);
        cvt_job<true>(F, tb, (bf16*)((char*)wts + W_O_T), 1024, 1024, 1024, 1024, F.in[30] + (size_t)l * 1024 * 1024, 1024, ident);
        const float* wg = F.in[33] + (size_t)l * 1024 * 4; const float* we = F.in[35] + (size_t)l * 1024 * 32; float* gt = (float*)((char*)wts + W_GATE_T) + (size_t)l * 48 * 1024;
        for (int i = gtid_(F); i < 48 * 1024; i += gthreads(F)) { const int col = i >> 10, k = i & 1023; gt[i] = col < 4 ? wg[k * 4 + col] : col < 36 ? we[k * 32 + col - 4] : 0.f; }
        return;
    }
#endif
    constexpr int T0 = 0, T1 = T0 + (HP / 64) * 16, T2 = T1 + 8 * 4, T3 = T2 + 8 * 4, T4 = T3 + 256, T5 = T4 + 256, T6 = T5 + 512, TT = T6 + 256;
    { const float* w = F.in[4] + (size_t)l * 1024 * IN_WIDTH;
      cvt_transpose(F, (bf16*)((char*)wts + W_IN_T), HP, 1024, [&](int k, int n) { int s = win_src_col(n); return s < 0 ? 0.f : w[(size_t)k * IN_WIDTH + s]; }, T0, TT); }
    { const float* w = F.in[23] + (size_t)l * 192 * 384;
      cvt_transpose(F, (bf16*)((char*)wts + W_UQ_T), 512, 256, [&](int k, int n) { int s = wuq_src_col(n); return (s < 0 || k >= 192) ? 0.f : w[(size_t)k * 384 + s]; }, T1, TT); }
    { const float* w = F.in[24] + (size_t)l * 128 * 512;
      cvt_transpose(F, (bf16*)((char*)wts + W_UKV_T), 512, 256, [&](int k, int n) { return k >= 128 ? 0.f : w[(size_t)k * 512 + n]; }, T2, TT); }
    { const float* w = F.in[25] + (size_t)l * 1024 * 1024;
      cvt_transpose(F, (bf16*)((char*)wts + W_OUT_T), 1024, 1024, [&](int k, int n) { return w[(size_t)k * 1024 + n]; }, T3, TT); }
    { const float* w = F.in[28] + (size_t)l * 1024 * 1024;
      cvt_transpose(F, (bf16*)((char*)wts + W_Q_T), 1024, 1024, [&](int k, int n) { return w[(size_t)k * 1024 + n]; }, T4, TT); }
    { const float* w = F.in[29] + (size_t)l * 1024 * 2048;
      cvt_transpose(F, (bf16*)((char*)wts + W_KV_T), 2048, 1024, [&](int k, int n) { return w[(size_t)k * 2048 + n]; }, T5, TT); }
    { const float* w = F.in[30] + (size_t)l * 1024 * 1024;
      cvt_transpose(F, (bf16*)((char*)wts + W_O_T), 1024, 1024, [&](int k, int n) { return w[(size_t)k * 1024 + n]; }, T6, TT); }
#ifndef CPU_EMU
    { const float* wg = F.in[33] + (size_t)l * 1024 * 4; const float* we = F.in[35] + (size_t)l * 1024 * 32; float* gt = (float*)((char*)wts + W_GATE_T) + (size_t)l * 48 * 1024;
      for (int i = gtid_(F); i < 48 * 1024; i += gthreads(F)) { const int col = i >> 10, k = i & 1023;
          gt[i] = col < 4 ? wg[k * 4 + col] : col < 36 ? we[k * 32 + col - 4] : 0.f; } }
#endif
}

DI void phase_cvt_moe(const Frame& F, int l) {
#ifdef CPU_EMU
    for (int e = 0; e < NEXP; ++e) {
        const float* w1 = F.in[37] + ((size_t)l * NEXP + e) * 1024 * 256;
        const float* w3 = F.in[38] + ((size_t)l * NEXP + e) * 1024 * 256;
        const float* w2 = F.in[39] + ((size_t)l * NEXP + e) * 256 * 1024;
        cvt_transpose(F, WSP(bf16, OFF_W13T) + (size_t)e * 512 * 1024, 512, 1024,
                      [&](int k, int n) { return (n & 1) ? w3[(size_t)k * 256 + (n >> 1)] : w1[(size_t)k * 256 + (n >> 1)]; }, 0, 1);
        cvt_transpose(F, WSP(bf16, OFF_W2T) + (size_t)e * 1024 * 256, 1024, 256, [&](int k, int n) { return w2[(size_t)k * 1024 + n]; }, 0, 1);
    }
#else
    {
        int tb = 0;
        auto ident = [](int n) { return n; };
        for (int e = 0; e < NEXP; ++e) {
            const float* w1 = F.in[37] + ((size_t)l * NEXP + e) * 1024 * 256; const float* w3 = F.in[38] + ((size_t)l * NEXP + e) * 1024 * 256; const float* w2 = F.in[39] + ((size_t)l * NEXP + e) * 256 * 1024;
            bf16* d13 = WSP(bf16, OFF_W13T) + (size_t)e * 512 * 1024;
            cvt_job<true>(F, tb, d13, 2048, 256, 1024, 1024, w1, 256, ident);
            cvt_job<true>(F, tb, d13 + 1024, 2048, 256, 1024, 1024, w3, 256, ident);
            cvt_job<true>(F, tb, WSP(bf16, OFF_W2T) + (size_t)e * 1024 * 256, 256, 1024, 256, 256, w2, 1024, ident);
        }
    }
#endif
}

struct EpiH {
    bf16* hatt; bf16* hrwkv; bf16* hhgrn; bf16* hmla; int row0, pn;
    DI void operator()(int r, int c, float a, float b, float cc, float d) const {
        const size_t row = row0 + r;
        bf16* p;
        if (pn < 2) p = hatt + row * 512 + pn * 256 + c;
        else if (pn < 6) p = hrwkv + row * 1024 + (pn - 2) * 256 + c;
        else if (pn < 11) p = hhgrn + row * 1280 + (pn - 6) * 256 + c;
        else p = hmla + row * 512 + (pn - 11) * 256 + c;
        st_bf16x4(p, a, b, cc, d);
    }
};
struct EpiKV {
    bf16* kmem; bf16* vt; int row0, pn;
    DI void operator()(int r, int c, float a, float b, float cc, float d) const {
        const int row = row0 + r, col = pn * 256 + c;
        if (col < 1024) { st_bf16x4(kmem + (size_t)row * 1024 + col, a, b, cc, d); }
        else { const int bb = row / MEMT, key = row % MEMT, hc = col - 1024;
            bf16* p = vt + ((size_t)bb * 1024 + hc) * MEMT + key;
            p[0] = f2bf(a); p[MEMT] = f2bf(b); p[2 * MEMT] = f2bf(cc); p[3 * MEMT] = f2bf(d); }
    }
};

DI void phase_gemm1(const Frame& F) {
    const bf16* xb = WSP(bf16, OFF_XB); const bf16* wts = WSP(bf16, OFF_WTS);
    const int nM = (NTOK + 255) / 256, nN = HP / 256, n1 = nM * nN;
    const int nMk = (NMEM + 255) / 256, nNk = 8, n2 = nMk * nNk;
    for (int u = blockIdx.x; u < n1 + n2; u += F.nblk) {
        if (u < n1) {
            const int pm = u / nN, pn = u % nN;
            EpiH E{WSP(bf16, OFF_HATT), WSP(bf16, OFF_HRWKV), WSP(bf16, OFF_HHGRN), WSP(bf16, OFF_HMLA), pm * 256, pn};
#ifdef CPU_EMU
            gemm_unit(F, xb, 1024, nullptr, pm * 256, (const bf16*)((const char*)wts + W_IN_T), 1024, pn * 256, 1024, E, min(256, NTOK - pm * 256));
#else
            gemm_unit(F, xb, 1024, nullptr, pm * 256, (const bf16*)((const char*)wts + W_IN_T), 1024, pn * 256, 1024, E);
#endif
        } else {
            const int v = u - n1, pm = v / nNk, pn = v % nNk;
            EpiKV E{WSP(bf16, OFF_KMEM), WSP(bf16, OFF_VTMEM), pm * 256, pn};
            gemm_unit(F, WSP(bf16, OFF_MEMB), 1024, nullptr, pm * 256, (const bf16*)((const char*)wts + W_KV_T), 1024, pn * 256, 1024, E);
        }
    }
}


#ifndef CPU_EMU
DI float fast_sigmoid(float x) { return 1.0f / (1.0f + __expf(-x)); }
DI float fast_tanh(float x) { const float e = __expf(2.0f * x); return 1.0f - 2.0f / (e + 1.0f); }

DI void prep_attn_gpu(const Frame& F, int l) {
    float* tabA = (float*)F.smem;
    float* tabB = tabA + 2048;
    float* gq = tabB + 1024;
    __syncthreads();
    { const int tid = fresh_tid(F);
    for (int i = tid; i < 1024; i += NTH) { const int pos = i >> 4, f = i & 15; const float ang = (float)pos * rope_inv(2 * f, 32); tabA[i] = cosf(ang); tabA[1024 + i] = sinf(ang); }
    for (int i = tid; i < 512; i += NTH) { const int pos = i >> 3, f = i & 7; const float ang = (float)pos * rope_inv(2 * f, 16); tabB[i] = cosf(ang); tabB[512 + i] = sinf(ang); }
    for (int i = tid; i < 448; i += NTH) gq[i] = i < 64 ? F.in[5][l * 64 + i] : i < 128 ? F.in[6][l * 64 + i - 64] : i < 320 ? F.in[21][l * 192 + i - 128] : F.in[22][l * 128 + i - 320]; }
    __syncthreads();
    bf16* hatt = WSP(bf16, OFF_HATT);
    for (int it = blockIdx.x * NTH + fresh_tid(F); it < NTOK * 6; it += gthreads(F)) {
        const int n = it / 6, hh = it % 6, s = n % SEQ, rowp = s / GRIDW, colp = s % GRIDW;
        uint4* p = reinterpret_cast<uint4*>(hatt + (size_t)n * 512 + hh * 64);
        const float* gn = gq + (hh < 4 ? 0 : 64);
        uint4 raw[8];
#pragma unroll
        for (int i = 0; i < 8; ++i) raw[i] = p[i];
        float x[64];
#pragma unroll
        for (int i = 0; i < 8; ++i) { x[8 * i] = bflo(raw[i].x); x[8 * i + 1] = bfhi(raw[i].x); x[8 * i + 2] = bflo(raw[i].y); x[8 * i + 3] = bfhi(raw[i].y);
            x[8 * i + 4] = bflo(raw[i].z); x[8 * i + 5] = bfhi(raw[i].z); x[8 * i + 6] = bflo(raw[i].w); x[8 * i + 7] = bfhi(raw[i].w); }
        float ss = 0.f;
#pragma unroll
        for (int j = 0; j < 64; ++j) ss += x[j] * x[j];
        const float rs = 1.0f / sqrtf(ss * (1.0f / 64.0f) + RMS_EPS);
#pragma unroll
        for (int j = 0; j < 64; ++j) x[j] *= rs * gn[j];
#pragma unroll
        for (int half = 0; half < 2; ++half) {
            const int pos = half ? colp : rowp;
#pragma unroll
            for (int f = 0; f < 16; ++f) {
                const float cs = tabA[pos * 16 + f], sn = tabA[1024 + pos * 16 + f];
                const float x1 = x[half * 32 + f], x2 = x[half * 32 + 16 + f];
                x[half * 32 + f] = x1 * cs - x2 * sn; x[half * 32 + 16 + f] = x1 * sn + x2 * cs;
            }
        }
#pragma unroll
        for (int i = 0; i < 8; ++i) { uint4 o; o.x = pack_bf16(x[8 * i], x[8 * i + 1]); o.y = pack_bf16(x[8 * i + 2], x[8 * i + 3]); o.z = pack_bf16(x[8 * i + 4], x[8 * i + 5]); o.w = pack_bf16(x[8 * i + 6], x[8 * i + 7]); p[i] = o; }
    }
    bf16* hm = WSP(bf16, OFF_HMLA); bf16* kr = WSP(bf16, OFF_KROPE);
    for (int it = blockIdx.x * NTH + fresh_tid(F); it < NTOK * 3; it += gthreads(F)) {
        const int n = it / 3, which = it % 3;
        if (which < 2) {
            const int len = which ? 128 : 192; const float* gn = gq + (which ? 320 : 128);
            uint4* p = reinterpret_cast<uint4*>(hm + (size_t)n * 512 + (which ? 256 : 0));
            float ss = 0.f;
            for (int i = 0; i < len / 8; ++i) { const uint4 r = p[i];
                const float a0 = bflo(r.x), a1 = bfhi(r.x), a2 = bflo(r.y), a3 = bfhi(r.y), a4 = bflo(r.z), a5 = bfhi(r.z), a6 = bflo(r.w), a7 = bfhi(r.w);
                ss += a0 * a0 + a1 * a1 + a2 * a2 + a3 * a3 + a4 * a4 + a5 * a5 + a6 * a6 + a7 * a7; }
            const float rs = 1.0f / sqrtf(ss / (float)len + RMS_EPS);
            for (int i = 0; i < len / 8; ++i) { const uint4 r = p[i]; const float* g = gn + 8 * i; uint4 o;
                o.x = pack_bf16(bflo(r.x) * rs * g[0], bfhi(r.x) * rs * g[1]); o.y = pack_bf16(bflo(r.y) * rs * g[2], bfhi(r.y) * rs * g[3]);
                o.z = pack_bf16(bflo(r.z) * rs * g[4], bfhi(r.z) * rs * g[5]); o.w = pack_bf16(bflo(r.w) * rs * g[6], bfhi(r.w) * rs * g[7]); p[i] = o; }
        } else {
            const int s = n % SEQ, rowp = s / GRIDW, colp = s % GRIDW;
            const uint4* p = reinterpret_cast<const uint4*>(hm + (size_t)n * 512 + 192);
            float x[32];
#pragma unroll
            for (int i = 0; i < 4; ++i) { const uint4 r = p[i]; x[8 * i] = bflo(r.x); x[8 * i + 1] = bfhi(r.x); x[8 * i + 2] = bflo(r.y); x[8 * i + 3] = bfhi(r.y);
                x[8 * i + 4] = bflo(r.z); x[8 * i + 5] = bfhi(r.z); x[8 * i + 6] = bflo(r.w); x[8 * i + 7] = bfhi(r.w); }
            unsigned o[16];
#pragma unroll
            for (int m = 0; m < 16; ++m) {
                const int i1 = m < 8 ? m : 16 + (m - 8), pos = m < 8 ? rowp : colp, f = m & 7;
                const float cs = tabB[pos * 8 + f], sn = tabB[512 + pos * 8 + f];
                o[m] = pack_bf16(x[i1] * cs - x[i1 + 8] * sn, x[i1] * sn + x[i1 + 8] * cs);
            }
            uint4* q = reinterpret_cast<uint4*>(kr + (size_t)n * 32);
#pragma unroll
            for (int i = 0; i < 4; ++i) q[i] = make_uint4(o[4 * i], o[4 * i + 1], o[4 * i + 2], o[4 * i + 3]);
        }
    }
    {
        bf16* vt = WSP(bf16, OFF_VTATT); bf16* tl = (bf16*)(gq + 512);
        for (int tile = blockIdx.x; tile < BATCH * 2 * (SEQ / 64); tile += F.nblk) {
            const int b = tile / (2 * (SEQ / 64)), kv = (tile / (SEQ / 64)) % 2, t0 = (tile % (SEQ / 64)) * 64;
            __syncthreads();
            const int tid = fresh_tid(F);
            { const int t = tid >> 3, part = tid & 7;
              const uint4 r = *reinterpret_cast<const uint4*>(hatt + (size_t)(b * SEQ + t0 + t) * 512 + 384 + kv * 64 + part * 8);
              const unsigned w[4] = {r.x, r.y, r.z, r.w};
#pragma unroll
              for (int i = 0; i < 4; ++i) { tl[(part * 8 + 2 * i) * 72 + t] = (bf16)(w[i] & 0xffffu); tl[(part * 8 + 2 * i + 1) * 72 + t] = (bf16)(w[i] >> 16); } }
            __syncthreads();
            { const int dv = tid >> 3, part = tid & 7;
              *reinterpret_cast<uint4*>(vt + ((size_t)(b * 2 + kv) * 64 + dv) * SEQ + t0 + part * 8) = *reinterpret_cast<const uint4*>(tl + dv * 72 + part * 8); }
        }
    }
}

DI void prep_hgrn_gpu(const Frame& F, int l) {
    bf16* hh = WSP(bf16, OFF_HHGRN); bf16* hx = WSP(bf16, OFF_HX); bf16* ham = WSP(bf16, OFF_HAM); float* heg = WSP(float, OFF_HEG);
    const int tid = F.tid, wave = tid >> 6, lane = tid & 63, x = lane & 15, q = lane >> 4;
    bf16* stg = (bf16*)F.smem + wave * (4 * 16 * 72);
    for (int it = blockIdx.x * 8 + wave; it < (NTOK / 16) * 4; it += F.nblk * 8) {
        const int c = it >> 2, h = it & 3, n0 = c * 16, cj = h * 64 + lane;
        float mlb = 1.0f;
        if (l == 1) { const float a = F.in[19][cj], b = F.in[19][256 + cj]; const float m = fmaxf(a, b); const float ea = __expf(a - m), eb = __expf(b - m); mlb = ea / (ea + eb); }
        float qv[16], k0[16], k1[16], g0[16], g1[16]; bf16 vraw[16];
#pragma unroll
        for (int t = 0; t < 16; ++t) {
            const bf16* row = hh + (size_t)(n0 + t) * 1280 + cj;
            const float xq = bf2f(row[0]), x0 = bf2f(row[256]), x1 = bf2f(row[512]); vraw[t] = row[768];
            qv[t] = xq * fast_sigmoid(xq); k0[t] = mlb * fast_sigmoid(-x0); k1[t] = mlb * fast_sigmoid(-x1);
            g0[t] = __logf(1.0f - k0[t]); g1[t] = __logf(1.0f - k1[t]);
        }
#pragma unroll
        for (int t = 1; t < 16; ++t) { g0[t] += g0[t - 1]; g1[15 - t] += g1[16 - t]; }
        heg[((size_t)it * 2 + 0) * 64 + lane] = __expf(g0[15]); heg[((size_t)it * 2 + 1) * 64 + lane] = __expf(g1[0]);
        unsigned kt0[8], kt1[8], vt[8];
#pragma unroll
        for (int t = 0; t < 16; t += 2) {
            const float e0a = __expf(g0[t]), e0b = __expf(g0[t + 1]), e1a = __expf(g1[t]), e1b = __expf(g1[t + 1]);
            const float q0a = qv[t] * e0a, q0b = qv[t + 1] * e0b, q1a = qv[t] * e1a, q1b = qv[t + 1] * e1b;
            const float ka0 = k0[t] / e0a, kb0 = k0[t + 1] / e0b, ka1 = k1[t] / e1a, kb1 = k1[t + 1] / e1b;
            const bf16 bq0a = f2bf(q0a), bq0b = f2bf(q0b), bq1a = f2bf(q1a), bq1b = f2bf(q1b);
            hh[(size_t)(n0 + t) * 1280 + cj] = bq0a; hh[(size_t)(n0 + t + 1) * 1280 + cj] = bq0b;
            hx[(size_t)(n0 + t) * 256 + cj] = bq1a; hx[(size_t)(n0 + t + 1) * 256 + cj] = bq1b;
            kt0[t >> 1] = pack_bf16(ka0, kb0); kt1[t >> 1] = pack_bf16(ka1, kb1); vt[t >> 1] = (unsigned)vraw[t] | ((unsigned)vraw[t + 1] << 16);
            stg[0 * 1152 + t * 72 + lane] = bq0a; stg[0 * 1152 + (t + 1) * 72 + lane] = bq0b;
            stg[2 * 1152 + t * 72 + lane] = bq1a; stg[2 * 1152 + (t + 1) * 72 + lane] = bq1b;
            stg[1 * 1152 + t * 72 + lane] = (bf16)(kt0[t >> 1] & 0xffffu); stg[1 * 1152 + (t + 1) * 72 + lane] = (bf16)(kt0[t >> 1] >> 16);
            stg[3 * 1152 + t * 72 + lane] = (bf16)(kt1[t >> 1] & 0xffffu); stg[3 * 1152 + (t + 1) * 72 + lane] = (bf16)(kt1[t >> 1] >> 16);
        }
        { bf16* blk = hh + (size_t)(n0 + (lane >> 2)) * 1280 + h * 64 + (lane & 3) * 16;
          *reinterpret_cast<uint4*>(blk + 256) = make_uint4(kt0[0], kt0[1], kt0[2], kt0[3]); *reinterpret_cast<uint4*>(blk + 256 + 8) = make_uint4(kt0[4], kt0[5], kt0[6], kt0[7]);
          *reinterpret_cast<uint4*>(blk + 512) = make_uint4(kt1[0], kt1[1], kt1[2], kt1[3]); *reinterpret_cast<uint4*>(blk + 512 + 8) = make_uint4(kt1[4], kt1[5], kt1[6], kt1[7]);
          *reinterpret_cast<uint4*>(blk + 768) = make_uint4(vt[0], vt[1], vt[2], vt[3]); *reinterpret_cast<uint4*>(blk + 768 + 8) = make_uint4(vt[4], vt[5], vt[6], vt[7]); }
        asm volatile("s_waitcnt lgkmcnt(0)" ::: "memory");
        __builtin_amdgcn_wave_barrier();
#pragma unroll
        for (int d = 0; d < 2; ++d) {
            f32x4 acc = {0.f, 0.f, 0.f, 0.f};
#pragma unroll
            for (int ks = 0; ks < 2; ++ks) {
                const bf16x8 a = *reinterpret_cast<const bf16x8*>(stg + (2 * d) * 1152 + x * 72 + 32 * ks + 8 * q);
                const bf16x8 b = *reinterpret_cast<const bf16x8*>(stg + (2 * d + 1) * 1152 + x * 72 + 32 * ks + 8 * q);
                acc = __builtin_amdgcn_mfma_f32_16x16x32_bf16(a, b, acc, 0, 0, 0);
            }
            bf16* am = ham + ((size_t)it * 2 + d) * 256;
#pragma unroll
            for (int r = 0; r < 4; ++r) { const int t = 4 * q + r; const bool keep = d ? (x >= t) : (x <= t); am[t * 16 + x] = f2bf(keep ? acc[r] : 0.f); }
        }
        __builtin_amdgcn_wave_barrier();
    }
}

DI void scan_hgrn_chunk(const Frame& F, int chain) {
    const int d = chain / (BATCH * 4), b = (chain / 4) % BATCH, h = chain % 4;
    const int lane = fresh_tid(F) & 63, x = lane & 15, q = lane >> 4;
    bf16* hh = WSP(bf16, OFF_HHGRN); const bf16* hx = WSP(bf16, OFF_HX); const bf16* ham = WSP(bf16, OFF_HAM); const float* heg = WSP(float, OFF_HEG);
    f32x4 S[4][4];
#pragma unroll
    for (int a = 0; a < 4; ++a)
#pragma unroll
        for (int c = 0; c < 4; ++c) S[a][c] = (f32x4){0.f, 0.f, 0.f, 0.f};
    constexpr int NCH = SEQ / 16;
    uint2 nQ[4], nA, nK[4], nV[4]; float4 nE[4];
    const unsigned lq = (unsigned)(x * (d ? 256 : 1280) + h * 64 + 4 * q);
    const unsigned lb = (unsigned)((x >> 2) * 1280 + h * 64 + (x & 3) * 16 + 4 * q);
    const unsigned la = (unsigned)(x * 16 + 4 * q), le = (unsigned)(4 * q), lo = (unsigned)(4 * q * 1280 + x);
#define HG_LOAD(cc_) do { const int c_ = d ? NCH - 1 - (cc_) : (cc_); const unsigned n0_ = (unsigned)(b * SEQ + 16 * c_); const unsigned it_ = (n0_ >> 4) * 4 + h; \
        const bf16* qb_ = d ? hx + (size_t)n0_ * 256 : hh + (size_t)n0_ * 1280; const bf16* hb_ = hh + (size_t)n0_ * 1280; \
        const bf16* ab_ = ham + (size_t)(it_ * 2 + d) * 256; const float* eb_ = heg + (size_t)(it_ * 2 + d) * 64; \
        _Pragma("unroll") for (int u_ = 0; u_ < 4; ++u_) nQ[u_] = *reinterpret_cast<const uint2*>(qb_ + lq + 16 * u_); \
        nA = *reinterpret_cast<const uint2*>(ab_ + la); \
        _Pragma("unroll") for (int u_ = 0; u_ < 4; ++u_) { \
            nK[u_] = *reinterpret_cast<const uint2*>(hb_ + lb + (4 * u_) * 1280 + 256 + d * 256); nV[u_] = *reinterpret_cast<const uint2*>(hb_ + lb + (4 * u_) * 1280 + 768); \
            nE[u_] = *reinterpret_cast<const float4*>(eb_ + le + 16 * u_); } } while (0)
    HG_LOAD(0);
    for (int cc = 0; cc < NCH; ++cc) {
        uint2 cQ[4], cA, cK[4], cV[4]; float4 cE[4];
#pragma unroll
        for (int u = 0; u < 4; ++u) { cQ[u] = nQ[u]; cK[u] = nK[u]; cV[u] = nV[u]; cE[u] = nE[u]; }
        cA = nA;
        if (cc + 1 < NCH) HG_LOAD(cc + 1);
        const int c = d ? NCH - 1 - cc : cc; const size_t n0 = (size_t)b * SEQ + 16 * c;
        union Fr { bf16x8 v; unsigned u[4]; };
        Fr aq0, aq1, aA; aq0.u[0] = cQ[0].x; aq0.u[1] = cQ[0].y; aq0.u[2] = cQ[1].x; aq0.u[3] = cQ[1].y;
        aq1.u[0] = cQ[2].x; aq1.u[1] = cQ[2].y; aq1.u[2] = cQ[3].x; aq1.u[3] = cQ[3].y;
        aA.u[0] = cA.x; aA.u[1] = cA.y; aA.u[2] = 0u; aA.u[3] = 0u;
#pragma unroll
        for (int it = 0; it < 4; ++it) {
            Fr bS0, bS1, bV;
            bS0.u[0] = pack_bf16(S[0][it][0], S[0][it][1]); bS0.u[1] = pack_bf16(S[0][it][2], S[0][it][3]); bS0.u[2] = pack_bf16(S[1][it][0], S[1][it][1]); bS0.u[3] = pack_bf16(S[1][it][2], S[1][it][3]);
            bS1.u[0] = pack_bf16(S[2][it][0], S[2][it][1]); bS1.u[1] = pack_bf16(S[2][it][2], S[2][it][3]); bS1.u[2] = pack_bf16(S[3][it][0], S[3][it][1]); bS1.u[3] = pack_bf16(S[3][it][2], S[3][it][3]);
            bV.u[0] = cV[it].x; bV.u[1] = cV[it].y; bV.u[2] = 0u; bV.u[3] = 0u;
            f32x4 O = {0.f, 0.f, 0.f, 0.f};
            O = __builtin_amdgcn_mfma_f32_16x16x32_bf16(aq0.v, bS0.v, O, 0, 0, 0);
            O = __builtin_amdgcn_mfma_f32_16x16x32_bf16(aq1.v, bS1.v, O, 0, 0, 0);
            O = __builtin_amdgcn_mfma_f32_16x16x32_bf16(aA.v, bV.v, O, 0, 0, 0);
            bf16* od = hh + n0 * 1280 + 256 + d * 256 + h * 64 + 16 * it;
#pragma unroll
            for (int r = 0; r < 4; ++r) od[lo + (unsigned)(r * 1280)] = f2bf(O[r]);
#pragma unroll
            for (int jt = 0; jt < 4; ++jt) {
                Fr aK; aK.u[0] = cK[jt].x; aK.u[1] = cK[jt].y; aK.u[2] = 0u; aK.u[3] = 0u;
                f32x4 t = __builtin_amdgcn_mfma_f32_16x16x32_bf16(aK.v, bV.v, S[jt][it], 0, 0, 0);
                t[0] *= cE[jt].x; t[1] *= cE[jt].y; t[2] *= cE[jt].z; t[3] *= cE[jt].w;
                S[jt][it] = t;
            }
        }
    }
#undef HG_LOAD
}

DI void prep_rwkv_gpu(const Frame& F, int l) {
    const bf16* hz = WSP(bf16, OFF_HRWKV); bf16* r7 = WSP(bf16, OFF_R7); bf16* gb = WSP(bf16, OFF_G); float* bonus = WSP(float, OFF_BONUS);
    const float* mup = F.in[7] + l * 960; const float* mun = F.in[8] + l * 960;
    const float* w0 = F.in[9] + l * 512; const float* w2 = F.in[10] + (size_t)l * 2 * 32 * 256;
    const float* a0 = F.in[11] + l * 512; const float* a2 = F.in[12] + (size_t)l * 2 * 32 * 256;
    const float* g2 = F.in[13] + (size_t)l * 64 * 256;
    const size_t AS = (size_t)NTOK * 256;
    float* zs = (float*)F.smem;
    bf16* stg = (bf16*)(F.smem + 61440);
    float* nts = (float*)(F.smem + 61440 + 73728);
    float* xch = (float*)(F.smem + 143360);
    bf16* lin = (bf16*)(F.smem + 152576);
    float* kkp = xch; float* bop = xch + 128; float* csum = xch + 256;
    const int tid = F.tid, wv = F.wv;
    union WF { bf16x8 v; unsigned u[4]; };
    WF fw0[2], fw1[2], fa0[2], fa1[2], fg0[2], fg1[2];
    float cw0[2], cw1[2], ca0[2], ca1[2], ckk[2], cka[2], crk[2];
    { const int lane0 = tid & 63, x0 = lane0 & 15, q0 = lane0 >> 4;
#pragma unroll
      for (int ci = 0; ci < 2; ++ci) {
          const int c = 32 * wv + 16 * ci + x0;
#pragma unroll
          for (int p = 0; p < 4; ++p) { const int k = 8 * q0 + 2 * p;
              fw0[ci].u[p] = pack_bf16(w2[(size_t)k * 256 + c], w2[(size_t)(k + 1) * 256 + c]); fw1[ci].u[p] = pack_bf16(w2[(size_t)(32 + k) * 256 + c], w2[(size_t)(33 + k) * 256 + c]);
              fa0[ci].u[p] = pack_bf16(a2[(size_t)k * 256 + c], a2[(size_t)(k + 1) * 256 + c]); fa1[ci].u[p] = pack_bf16(a2[(size_t)(32 + k) * 256 + c], a2[(size_t)(33 + k) * 256 + c]);
              fg0[ci].u[p] = pack_bf16(g2[(size_t)k * 256 + c], g2[(size_t)(k + 1) * 256 + c]); fg1[ci].u[p] = pack_bf16(g2[(size_t)(32 + k) * 256 + c], g2[(size_t)(33 + k) * 256 + c]); }
          cw0[ci] = w0[c]; cw1[ci] = w0[256 + c]; ca0[ci] = a0[c]; ca1[ci] = a0[256 + c];
          ckk[ci] = F.in[14][l * 256 + c]; cka[ci] = F.in[15][l * 256 + c]; crk[ci] = F.in[16][l * 256 + c];
      } }
    for (int tile = blockIdx.x; tile < NTOK / 16; tile += F.nblk) {
        const int n0 = tile * 16;
        __syncthreads();
        const int tl = fresh_tid(F);
#pragma unroll
        for (int bt = 0; bt < 3; ++bt) {
            unsigned zc[5], zp[5], zn[5];
#pragma unroll
            for (int i = 0; i < 5; ++i) {
                const int e = tl + (bt * 5 + i) * NTH, t = e / 480, cc = (e % 480) * 2, n = n0 + t, s = n % SEQ;
                zc[i] = *reinterpret_cast<const unsigned*>(hz + (size_t)n * 1024 + cc);
                zp[i] = s > 0 ? *reinterpret_cast<const unsigned*>(hz + (size_t)(n - 1) * 1024 + cc) : 0u;
                zn[i] = s < SEQ - 1 ? *reinterpret_cast<const unsigned*>(hz + (size_t)(n + 1) * 1024 + cc) : 0u;
            }
#pragma unroll
            for (int i = 0; i < 5; ++i) {
                const int e = tl + (bt * 5 + i) * NTH, t = e / 480, cc = (e % 480) * 2;
                const float2 mp = *reinterpret_cast<const float2*>(mup + cc), mn = *reinterpret_cast<const float2*>(mun + cc);
                float v0 = bflo(zc[i]), v1 = bfhi(zc[i]);
                v0 = v0 + mp.x * (bflo(zp[i]) - v0) + mn.x * (bflo(zn[i]) - v0);
                v1 = v1 + mp.y * (bfhi(zp[i]) - v1) + mn.y * (bfhi(zn[i]) - v1);
                if (cc >= 768) {
                    if (cc < 832) { v0 = fast_tanh(v0); v1 = fast_tanh(v1); }
                    else if (cc >= 896) { v0 = fast_sigmoid(v0); v1 = fast_sigmoid(v1); }
                    *reinterpret_cast<unsigned*>(lin + t * 200 + (cc - 768)) = pack_bf16(v0, v1);
                } else *reinterpret_cast<float2*>(zs + t * 960 + cc) = make_float2(v0, v1);
            }
        }
        __syncthreads();
        const int lane = tl & 63, x = lane & 15, q = lane >> 4, hh_ = wv >> 1;
        f32x4 dW0[2], dW1[2], dA0[2], dA1[2], dG[2];
        { const bf16* lr = lin + x * 200 + 8 * q;
          const bf16x8 iw0 = *reinterpret_cast<const bf16x8*>(lr), iw1 = *reinterpret_cast<const bf16x8*>(lr + 32), ia0 = *reinterpret_cast<const bf16x8*>(lr + 64), ia1 = *reinterpret_cast<const bf16x8*>(lr + 96);
          const bf16x8 ig0 = *reinterpret_cast<const bf16x8*>(lr + 128), ig1 = *reinterpret_cast<const bf16x8*>(lr + 160);
          const f32x4 z4 = {0.f, 0.f, 0.f, 0.f};
#pragma unroll
          for (int ci = 0; ci < 2; ++ci) {
              dW0[ci] = __builtin_amdgcn_mfma_f32_16x16x32_bf16(iw0, fw0[ci].v, z4, 0, 0, 0); dW1[ci] = __builtin_amdgcn_mfma_f32_16x16x32_bf16(iw1, fw1[ci].v, z4, 0, 0, 0);
              dA0[ci] = __builtin_amdgcn_mfma_f32_16x16x32_bf16(ia0, fa0[ci].v, z4, 0, 0, 0); dA1[ci] = __builtin_amdgcn_mfma_f32_16x16x32_bf16(ia1, fa1[ci].v, z4, 0, 0, 0);
              dG[ci] = __builtin_amdgcn_mfma_f32_16x16x32_bf16(ig0, fg0[ci].v, z4, 0, 0, 0); dG[ci] = __builtin_amdgcn_mfma_f32_16x16x32_bf16(ig1, fg1[ci].v, dG[ci], 0, 0, 0);
          } }
        float lw0[2][4], lw1[2][4], G0[2][4], G1[2][4];
        float kp[4] = {0.f, 0.f, 0.f, 0.f};
#pragma unroll
        for (int ci = 0; ci < 2; ++ci) {
            const int c = 32 * wv + 16 * ci + x;
#pragma unroll
            for (int r = 0; r < 4; ++r) { lw0[ci][r] = -DECAY_SCALE * fast_sigmoid(dW0[ci][r] + cw0[ci]); lw1[ci][r] = -DECAY_SCALE * fast_sigmoid(dW1[ci][r] + cw1[ci]);
                const float kk = zs[(4 * q + r) * 960 + 256 + c] * ckk[ci]; kp[r] += kk * kk; }
            G0[ci][0] = lw0[ci][0]; G1[ci][3] = lw1[ci][3];
#pragma unroll
            for (int r = 1; r < 4; ++r) { G0[ci][r] = G0[ci][r - 1] + lw0[ci][r]; G1[ci][3 - r] = G1[ci][4 - r] + lw1[ci][3 - r]; }
            csum[(0 * 4 + q) * 256 + c] = G0[ci][3]; csum[(1 * 4 + q) * 256 + c] = G1[ci][0];
        }
#pragma unroll
        for (int r = 0; r < 4; ++r) { const float s = allsum16(kp[r]); if (x == 0) kkp[(4 * q + r) * 8 + wv] = s; }
        __syncthreads();
        float bp[4] = {0.f, 0.f, 0.f, 0.f};
#pragma unroll
        for (int ci = 0; ci < 2; ++ci) {
            const int c = 32 * wv + 16 * ci + x, j = c & 63;
            float off0 = 0.f, off1 = 0.f, tot0 = 0.f, tot1 = 0.f;
#pragma unroll
            for (int qq = 0; qq < 4; ++qq) { const float a = csum[(0 * 4 + qq) * 256 + c], b = csum[(1 * 4 + qq) * 256 + c]; tot0 += a; tot1 += b; if (qq < q) off0 += a; if (qq > q) off1 += b; }
            if (q == 0) { bf16* reg = WSP(bf16, OFF_REG) + ((size_t)(tile * 4 + hh_) * 2) * 64 + j; reg[0] = f2bf(__expf(tot0)); reg[64] = f2bf(__expf(tot1)); }
#pragma unroll
            for (int r = 0; r < 4; ++r) {
                const int tau = 4 * q + r, n = n0 + tau; const float* zr = zs + tau * 960;
                const float rv = zr[c], k = zr[256 + c];
                const float A0 = fast_sigmoid(dA0[ci][r] + ca0[ci]), A1 = fast_sigmoid(dA1[ci][r] + ca1[ci]);
                const float ss = kkp[tau * 8 + 2 * hh_] + kkp[tau * 8 + 2 * hh_ + 1];
                const float kkn = k * ckk[ci] * (1.0f / fmaxf(sqrtf(ss), 1e-12f));
                const float kd0 = k * (1.0f + (A0 - 1.0f) * cka[ci]), kd1 = k * (1.0f + (A1 - 1.0f) * cka[ci]);
                bp[r] += rv * (kd0 + kd1) * crk[ci];
                const float g0 = G0[ci][r] + off0, g1 = G1[ci][r] + off1;
                const float e0 = __expf(g0), e1 = __expf(g1), i0 = __expf(-g0), i1 = __expf(-g1);
                const float kt0 = kkn * __expf(g0 - lw0[ci][r]), kt1 = kkn * __expf(g1 - lw1[ci][r]);
                bf16* s0 = stg + (size_t)((hh_ * 2 + 0) * 4) * 1152 + tau * 72 + j; bf16* s1 = stg + (size_t)((hh_ * 2 + 1) * 4) * 1152 + tau * 72 + j;
                s0[0] = f2bf(kt0); s0[1152] = f2bf(rv * e0); s0[2 * 1152] = f2bf(A0 * kkn * i0); s0[3 * 1152] = f2bf(kd0 * i0);
                s1[0] = f2bf(kt1); s1[1152] = f2bf(rv * e1); s1[2 * 1152] = f2bf(A1 * kkn * i1); s1[3 * 1152] = f2bf(kd1 * i1);
                gb[(size_t)n * 256 + c] = f2bf(dG[ci][r]);
            }
        }
#pragma unroll
        for (int r = 0; r < 4; ++r) { const float s = allsum16(bp[r]); if (x == 0) bop[(4 * q + r) * 8 + wv] = s; }
        __syncthreads();
        if (tl < 64) bonus[(size_t)(n0 + (tl >> 2)) * 4 + (tl & 3)] = bop[(tl >> 2) * 8 + 2 * (tl & 3)] + bop[(tl >> 2) * 8 + 2 * (tl & 3) + 1];
        __syncthreads();
        {
            const int wv = F.wv, lane = fresh_tid(F) & 63, x = lane & 15, q = lane >> 4, dd = wv & 1;
            const bf16* base = stg + (size_t)(wv * 4) * 1152;
            f32x4 nt = {0.f, 0.f, 0.f, 0.f}, mkk = nt, mkr = nt, mar = nt;
#pragma unroll
            for (int ks = 0; ks < 2; ++ks) {
                const bf16x8 fk = *reinterpret_cast<const bf16x8*>(base + x * 72 + 32 * ks + 8 * q);
                const bf16x8 fr = *reinterpret_cast<const bf16x8*>(base + 1152 + x * 72 + 32 * ks + 8 * q);
                const bf16x8 fa = *reinterpret_cast<const bf16x8*>(base + 2 * 1152 + x * 72 + 32 * ks + 8 * q);
                const bf16x8 fs = *reinterpret_cast<const bf16x8*>(base + 3 * 1152 + x * 72 + 32 * ks + 8 * q);
                nt = __builtin_amdgcn_mfma_f32_16x16x32_bf16(fk, fa, nt, 0, 0, 0);
                mkk = __builtin_amdgcn_mfma_f32_16x16x32_bf16(fk, fs, mkk, 0, 0, 0);
                mkr = __builtin_amdgcn_mfma_f32_16x16x32_bf16(fr, fs, mkr, 0, 0, 0);
                mar = __builtin_amdgcn_mfma_f32_16x16x32_bf16(fr, fa, mar, 0, 0, 0);
            }
            bf16* yc = WSP(bf16, OFF_YCAT); bf16* side = WSP(bf16, OFF_RSIDE);
            float* ntw = nts + wv * 256;
            auto mat_ptr = [&](int m) -> bf16* { const int sidx = wv * 4 + m;
                return sidx < 28 ? yc + (size_t)(n0 + 1 + (sidx >> 1)) * 1024 + 256 + (sidx & 1) * 256 : side + ((size_t)tile * 4 + (sidx - 28)) * 256; };
            bf16* m0 = mat_ptr(0); bf16* m2 = mat_ptr(2); bf16* m3 = mat_ptr(3);
#pragma unroll
            for (int r = 0; r < 4; ++r) {
                const int t = 4 * q + r; const bool strict = dd ? (x > t) : (x < t), beq = dd ? (x >= t) : (x <= t);
                const int pos = ((x >> 2) * 16 + t) * 4 + (x & 3);
                ntw[t * 16 + x] = strict ? nt[r] : 0.f;
                m0[pos] = f2bf(strict ? mkk[r] : 0.f); m2[pos] = f2bf(beq ? mkr[r] : 0.f); m3[pos] = f2bf(beq ? -mar[r] : 0.f);
            }
            const size_t blk = ((size_t)tile * 4 + (wv >> 1)) * 1024;
            {
                bf16* dk = r7 + (dd ? C_KT1 : C_KT0) * AS + blk; bf16* dr = r7 + (dd ? C_RT1 : C_RT0) * AS + blk;
#pragma unroll
                for (int ks = 0; ks < 2; ++ks) {
                    const uint2 k0 = *reinterpret_cast<const uint2*>(base + x * 72 + 32 * ks + 4 * q), k1 = *reinterpret_cast<const uint2*>(base + x * 72 + 32 * ks + 16 + 4 * q);
                    const uint2 r0 = *reinterpret_cast<const uint2*>(base + 1152 + x * 72 + 32 * ks + 4 * q), r1 = *reinterpret_cast<const uint2*>(base + 1152 + x * 72 + 32 * ks + 16 + 4 * q);
                    *reinterpret_cast<uint4*>(dk + (ks * 64 + lane) * 8) = make_uint4(k0.x, k0.y, k1.x, k1.y);
                    *reinterpret_cast<uint4*>(dr + (ks * 64 + lane) * 8) = make_uint4(r0.x, r0.y, r1.x, r1.y);
                }
            }
            {
                bf16* ds_ = r7 + (dd ? C_KK1 : C_KK0) * AS + blk; bf16* da = r7 + (dd ? C_AT1 : C_AT0) * AS + blk; bf16* dv = r7 + C_VT * AS + blk;
                const bf16* sa = base + 2 * 1152; const bf16* sk = base + 3 * 1152;
                const float* zv = zs + 512 + (wv >> 1) * 64;
#pragma unroll
                for (int u = 0; u < 4; ++u) {
                    const int ch = 16 * u + x;
                    const unsigned a0 = sa[(4 * q) * 72 + ch], a1 = sa[(4 * q + 1) * 72 + ch], a2 = sa[(4 * q + 2) * 72 + ch], a3 = sa[(4 * q + 3) * 72 + ch];
                    const unsigned k0 = sk[(4 * q) * 72 + ch], k1 = sk[(4 * q + 1) * 72 + ch], k2 = sk[(4 * q + 2) * 72 + ch], k3 = sk[(4 * q + 3) * 72 + ch];
                    *reinterpret_cast<uint2*>(ds_ + (u * 64 + lane) * 4) = make_uint2(k0 | (k1 << 16), k2 | (k3 << 16));
                    *reinterpret_cast<uint2*>(da + (u * 64 + lane) * 4) = make_uint2((a0 | (a1 << 16)) ^ 0x80008000u, (a2 | (a3 << 16)) ^ 0x80008000u);
                    if (dd == 0) *reinterpret_cast<uint2*>(dv + (u * 64 + lane) * 4) =
                        make_uint2(pack_bf16(zv[(4 * q) * 960 + ch], zv[(4 * q + 1) * 960 + ch]), pack_bf16(zv[(4 * q + 2) * 960 + ch], zv[(4 * q + 3) * 960 + ch]));
                }
            }
            asm volatile("s_waitcnt lgkmcnt(0)" ::: "memory");
            __builtin_amdgcn_wave_barrier();
            if (lane < 16) {
                float X[16];
                if (dd == 0) {
#pragma unroll
                    for (int t = 0; t < 16; ++t) { float a = (t == lane) ? 1.f : 0.f;
#pragma unroll
                        for (int s2 = 0; s2 < t; ++s2) a -= ntw[t * 16 + s2] * X[s2];
                        X[t] = a; }
                } else {
#pragma unroll
                    for (int t = 15; t >= 0; --t) { float a = (t == lane) ? 1.f : 0.f;
#pragma unroll
                        for (int s2 = t + 1; s2 < 16; ++s2) a -= ntw[t * 16 + s2] * X[s2];
                        X[t] = a; }
                }
                bf16* m1 = mat_ptr(1);
#pragma unroll
                for (int t = 0; t < 16; ++t) m1[((lane >> 2) * 16 + t) * 4 + (lane & 3)] = f2bf(X[t]);
            }
        }
    }
}

DI void scan_rwkv_chunk(const Frame& F, int chain) {
    const int d = chain / (BATCH * 4), b = (chain / 4) % BATCH, h = chain % 4, combo = h * 2 + d;
    const int lane = fresh_tid(F) & 63, q = lane >> 4;
    const size_t AS = (size_t)NTOK * 256;
    bf16* r7 = WSP(bf16, OFF_R7); const bf16* yc = WSP(bf16, OFF_YCAT); const bf16* side = WSP(bf16, OFF_RSIDE); const bf16* reg = WSP(bf16, OFF_REG);
    bf16* akt = r7 + (d ? C_KT1 : C_KT0) * AS; const bf16* art = r7 + (d ? C_RT1 : C_RT0) * AS;
    const bf16* akk = r7 + (d ? C_KK1 : C_KK0) * AS; const bf16* aat = r7 + (d ? C_AT1 : C_AT0) * AS; const bf16* avt = r7 + C_VT * AS;
    f32x4 Z[4][4];
#pragma unroll
    for (int a = 0; a < 4; ++a)
#pragma unroll
        for (int c = 0; c < 4; ++c) Z[a][c] = (f32x4){0.f, 0.f, 0.f, 0.f};
    constexpr int NCH = SEQ / 16;
    const unsigned l8 = (unsigned)lane * 8, l4 = (unsigned)lane * 4, le = (unsigned)(4 * q);
    uint4 nK[2], nR[2]; uint2 nM[4], nV[4];
#define RW_MPTR(tl_, m_) ((combo * 4 + (m_)) < 28 ? yc + (size_t)((tl_) * 16 + 1 + ((combo * 4 + (m_)) >> 1)) * 1024 + 256 + ((combo * 4 + (m_)) & 1) * 256 \
                                                   : side + ((size_t)(tl_) * 4 + (combo * 4 + (m_) - 28)) * 256)
#define RW_LOAD(cc_) do { const int c_ = d ? NCH - 1 - (cc_) : (cc_); const unsigned tl_ = (unsigned)(b * NCH + c_); const size_t bo_ = ((size_t)tl_ * 4 + h) * 1024; \
        nK[0] = *reinterpret_cast<const uint4*>(akt + bo_ + l8); nK[1] = *reinterpret_cast<const uint4*>(akt + bo_ + 512 + l8); \
        nR[0] = *reinterpret_cast<const uint4*>(art + bo_ + l8); nR[1] = *reinterpret_cast<const uint4*>(art + bo_ + 512 + l8); \
        _Pragma("unroll") for (int u_ = 0; u_ < 4; ++u_) { nM[u_] = *reinterpret_cast<const uint2*>(RW_MPTR(tl_, u_) + l4); nV[u_] = *reinterpret_cast<const uint2*>(avt + bo_ + u_ * 256 + l4); } } while (0)
    RW_LOAD(0);
    for (int cc = 0; cc < NCH; ++cc) {
        const int c = d ? NCH - 1 - cc : cc; const unsigned tl = (unsigned)(b * NCH + c); const size_t bo = ((size_t)tl * 4 + h) * 1024;
        uint2 cS[4], cA[4], cE[4];
        { const bf16* eb_ = reg + (size_t)((tl * 4 + h) * 2 + d) * 64;
#pragma unroll
          for (int u = 0; u < 4; ++u) { cS[u] = *reinterpret_cast<const uint2*>(akk + bo + u * 256 + l4); cA[u] = *reinterpret_cast<const uint2*>(aat + bo + u * 256 + l4);
              cE[u] = *reinterpret_cast<const uint2*>(eb_ + le + 16 * u); } }
        union Fr { bf16x8 v; unsigned u[4]; uint4 w; };
        Fr aK0, aK1, aR0, aR1, aMk, aTT, aY;
        aK0.w = nK[0]; aK1.w = nK[1]; aR0.w = nR[0]; aR1.w = nR[1];
        aMk.u[0] = nM[0].x; aMk.u[1] = nM[0].y; aMk.u[2] = 0u; aMk.u[3] = 0u;
        aTT.u[0] = nM[1].x; aTT.u[1] = nM[1].y; aTT.u[2] = 0u; aTT.u[3] = 0u;
        aY.u[0] = nM[2].x; aY.u[1] = nM[2].y; aY.u[2] = nM[3].x; aY.u[3] = nM[3].y;
        uint2 cV[4];
#pragma unroll
        for (int u = 0; u < 4; ++u) cV[u] = nV[u];
        if (cc + 1 < NCH) RW_LOAD(cc + 1);
        float eg[4][4];
#pragma unroll
        for (int u = 0; u < 4; ++u) { eg[u][0] = bflo(cE[u].x); eg[u][1] = bfhi(cE[u].x); eg[u][2] = bflo(cE[u].y); eg[u][3] = bfhi(cE[u].y); }
#pragma unroll
        for (int it = 0; it < 4; ++it) {
            Fr bZ0, bZ1, bV, bB, bVU;
            bZ0.u[0] = pack_bf16(Z[0][it][0], Z[0][it][1]); bZ0.u[1] = pack_bf16(Z[0][it][2], Z[0][it][3]); bZ0.u[2] = pack_bf16(Z[1][it][0], Z[1][it][1]); bZ0.u[3] = pack_bf16(Z[1][it][2], Z[1][it][3]);
            bZ1.u[0] = pack_bf16(Z[2][it][0], Z[2][it][1]); bZ1.u[1] = pack_bf16(Z[2][it][2], Z[2][it][3]); bZ1.u[2] = pack_bf16(Z[3][it][0], Z[3][it][1]); bZ1.u[3] = pack_bf16(Z[3][it][2], Z[3][it][3]);
            const f32x4 zero = {0.f, 0.f, 0.f, 0.f};
            f32x4 P1 = __builtin_amdgcn_mfma_f32_16x16x32_bf16(aK0.v, bZ0.v, zero, 0, 0, 0); P1 = __builtin_amdgcn_mfma_f32_16x16x32_bf16(aK1.v, bZ1.v, P1, 0, 0, 0);
            f32x4 P2 = __builtin_amdgcn_mfma_f32_16x16x32_bf16(aR0.v, bZ0.v, zero, 0, 0, 0); P2 = __builtin_amdgcn_mfma_f32_16x16x32_bf16(aR1.v, bZ1.v, P2, 0, 0, 0);
            bV.u[0] = cV[it].x; bV.u[1] = cV[it].y; bV.u[2] = 0u; bV.u[3] = 0u;
            const f32x4 Bt = __builtin_amdgcn_mfma_f32_16x16x32_bf16(aMk.v, bV.v, P1, 0, 0, 0);
            bB.u[0] = pack_bf16(Bt[0], Bt[1]); bB.u[1] = pack_bf16(Bt[2], Bt[3]); bB.u[2] = 0u; bB.u[3] = 0u;
            const f32x4 Ut = __builtin_amdgcn_mfma_f32_16x16x32_bf16(aTT.v, bB.v, zero, 0, 0, 0);
            bVU.u[0] = cV[it].x; bVU.u[1] = cV[it].y; bVU.u[2] = pack_bf16(Ut[0], Ut[1]); bVU.u[3] = pack_bf16(Ut[2], Ut[3]);
            const f32x4 Y = __builtin_amdgcn_mfma_f32_16x16x32_bf16(aY.v, bVU.v, P2, 0, 0, 0);
            *reinterpret_cast<uint2*>(akt + bo + it * 256 + l4) = make_uint2(pack_bf16(Y[0], Y[1]), pack_bf16(Y[2], Y[3]));
#pragma unroll
            for (int jt = 0; jt < 4; ++jt) {
                Fr aS; aS.u[0] = cS[jt].x; aS.u[1] = cS[jt].y; aS.u[2] = cA[jt].x; aS.u[3] = cA[jt].y;
                f32x4 t = __builtin_amdgcn_mfma_f32_16x16x32_bf16(aS.v, bVU.v, Z[jt][it], 0, 0, 0);
                t[0] *= eg[jt][0]; t[1] *= eg[jt][1]; t[2] *= eg[jt][2]; t[3] *= eg[jt][3];
                Z[jt][it] = t;
            }
        }
    }
#undef RW_LOAD
#undef RW_MPTR
}
#endif

DI void phase_prep(const Frame& F, int l) {
#ifndef CPU_EMU
    prep_attn_gpu(F, l); prep_rwkv_gpu(F, l); prep_hgrn_gpu(F, l);
#else
    {
        bf16* hatt = WSP(bf16, OFF_HATT); bf16* vt = WSP(bf16, OFF_VTATT);
        const float* qn = F.in[5] + l * 64; const float* kn = F.in[6] + l * 64;
        const int nitem = NTOK * 6;
        for (int it = ggrp(F); it < nitem; it += ngrp(F)) {
            const int n = it / 6, hh = it % 6;
            const int s = n % SEQ;
            bf16* p = hatt + (size_t)n * 512 + hh * 64;
            const float* gn = hh < 4 ? qn : kn;
            float v[PER64]; float ss = 0.f;
            for (int i = 0; i < PER64; ++i) { int j = glane(F) + i * GRP; v[i] = bf2f(p[j]); ss += v[i] * v[i]; }
            ss = grp_sum(F, ss); const float rs = 1.0f / sqrtf(ss * (1.0f / 64.0f) + RMS_EPS);
            float o[PER64];
#ifdef CPU_EMU
            float nv[64]; for (int j = 0; j < 64; ++j) nv[j] = v[j] * rs * gn[j];
#endif
            for (int i = 0; i < PER64; ++i) {
                int j = glane(F) + i * GRP;
                const int half = j >> 5, w = j & 31, f = w & 15, second = w >> 4;
                const float pos = half == 0 ? (float)(s / GRIDW) : (float)(s % GRIDW);
                const float ang = pos * rope_inv(2 * f, 32);
                const float cs = cosf(ang), sn = sinf(ang);
                const float mine = v[i] * rs * gn[j];
                const int jp = second ? j - 16 : j + 16;
#ifdef CPU_EMU
                const float partner = nv[jp];
#else
                const float partner = shfl_idx(F, v[0], jp) * rs * gn[jp];
#endif
                o[i] = second ? (partner * sn + mine * cs) : (mine * cs - partner * sn);
            }
            for (int i = 0; i < PER64; ++i) { int j = glane(F) + i * GRP; p[j] = f2bf(o[i]); }
        }
        for (size_t i = gtid_(F); i < (size_t)NTOK * 128; i += gthreads(F)) {
            const int n = (int)(i / 128), c = (int)(i % 128), b = n / SEQ, s = n % SEQ;
            vt[((size_t)b * 128 + c) * SEQ + s] = hatt[(size_t)n * 512 + 384 + c];
        }
    }
    {
        bf16* hm = WSP(bf16, OFF_HMLA); bf16* kr = WSP(bf16, OFF_KROPE);
        const float* qn = F.in[21] + l * 192; const float* kvn = F.in[22] + l * 128;
        for (int it = ggrp(F); it < NTOK * 2; it += ngrp(F)) {
            const int n = it >> 1, which = it & 1;
            bf16* p = hm + (size_t)n * 512 + (which ? 256 : 0);
            const int len = which ? 128 : 192; const float* gn = which ? kvn : qn;
            float ss = 0.f;
            for (int j = glane(F); j < len; j += GRP) { float x = bf2f(p[j]); ss += x * x; }
            ss = grp_sum(F, ss); const float rs = 1.0f / sqrtf(ss / (float)len + RMS_EPS);
            for (int j = glane(F); j < len; j += GRP) p[j] = f2bf(bf2f(p[j]) * rs * gn[j]);
        }
        for (int i = gtid_(F); i < NTOK * 16; i += gthreads(F)) {
            const int n = i >> 4, m = i & 15, s = n % SEQ;
            const bf16* src = hm + (size_t)n * 512 + 192;
            const int i1 = (m < 8 ? m : 16 + (m - 8)), i2 = i1 + 8;
            const float x1 = bf2f(src[i1]), x2 = bf2f(src[i2]);
            const float pos = m < 8 ? (float)(s / GRIDW) : (float)(s % GRIDW);
            const float ang = pos * rope_inv(2 * (m & 7), 16);
            const float cs = cosf(ang), sn = sinf(ang);
            kr[(size_t)n * 32 + 2 * m] = f2bf(x1 * cs - x2 * sn);
            kr[(size_t)n * 32 + 2 * m + 1] = f2bf(x1 * sn + x2 * cs);
        }
    }
#ifdef CPU_EMU
    {
        const bf16* hz = WSP(bf16, OFF_HRWKV); bf16* r7 = WSP(bf16, OFF_R7); bf16* gb = WSP(bf16, OFF_G); float* bonus = WSP(float, OFF_BONUS);
        const float* mup = F.in[7] + l * 960; const float* mun = F.in[8] + l * 960;
        const float* w0 = F.in[9] + l * 512; const float* w2 = F.in[10] + (size_t)l * 2 * 32 * 256;
        const float* a0 = F.in[11] + l * 512; const float* a2 = F.in[12] + (size_t)l * 2 * 32 * 256;
        const float* g2 = F.in[13] + (size_t)l * 64 * 256;
        const float* k_k = F.in[14] + l * 256; const float* k_a = F.in[15] + l * 256; const float* r_k = F.in[16] + l * 256;
        const size_t AS = (size_t)NTOK * 256;
        for (int it = ggrp(F); it < NTOK * 4; it += ngrp(F)) {
            const int n = it >> 2, h = it & 3, s = n % SEQ;
            const bf16* z = hz + (size_t)n * 1024;
            const bool hp = s > 0, hn = s < SEQ - 1;
            auto shifted = [&](int c) -> float {
                const float zc = bf2f(z[c]);
                const float zp = hp ? bf2f(z[c - 1024]) : 0.f, zn = hn ? bf2f(z[c + 1024]) : 0.f;
                return zc + mup[c] * (zp - zc) + mun[c] * (zn - zc);
            };
            float kkv[PER64], rr[PER64], kd0[PER64], kd1[PER64], aa0[PER64], aa1[PER64];
            float ss = 0.f, bs = 0.f;
            for (int i = 0; i < PER64; ++i) {
                const int j = glane(F) + i * GRP, c = h * 64 + j;
                const float r = shifted(c), k = shifted(256 + c), v = shifted(512 + c);
                float wr0 = w0[c], wr1 = w0[256 + c], ar0 = a0[c], ar1 = a0[256 + c], g = 0.f;
                for (int q = 0; q < 32; ++q) {
                    wr0 += tanhf(shifted(768 + q)) * w2[(size_t)q * 256 + c];
                    wr1 += tanhf(shifted(800 + q)) * w2[(size_t)(32 + q) * 256 + c];
                    ar0 += shifted(832 + q) * a2[(size_t)q * 256 + c];
                    ar1 += shifted(864 + q) * a2[(size_t)(32 + q) * 256 + c];
                }
                for (int q = 0; q < 64; ++q) g += sigmoidf_(shifted(896 + q)) * g2[(size_t)q * 256 + c];
                const float dec0 = expf(-DECAY_SCALE * sigmoidf_(wr0)), dec1 = expf(-DECAY_SCALE * sigmoidf_(wr1));
                const float A0 = sigmoidf_(ar0), A1 = sigmoidf_(ar1);
                const float kk = k * k_k[c];
                kkv[i] = kk; ss += kk * kk; rr[i] = r; aa0[i] = A0; aa1[i] = A1;
                kd0[i] = k * (1.0f + (A0 - 1.0f) * k_a[c]); kd1[i] = k * (1.0f + (A1 - 1.0f) * k_a[c]);
                bs += r * (kd0[i] + kd1[i]) * r_k[c];
                const size_t o = (size_t)n * 256 + c;
                r7[R_R * AS + o] = f2bf(r); r7[R_V * AS + o] = f2bf(v);
                r7[R_W0 * AS + o] = f2bf(dec0); r7[R_W1 * AS + o] = f2bf(dec1);
                r7[R_KD0 * AS + o] = f2bf(kd0[i]); r7[R_KD1 * AS + o] = f2bf(kd1[i]);
                gb[o] = f2bf(g);
            }
            ss = grp_sum(F, ss); bs = grp_sum(F, bs);
            const float inv = 1.0f / fmaxf(sqrtf(ss), 1e-12f);
            for (int i = 0; i < PER64; ++i) {
                const int j = glane(F) + i * GRP, c = h * 64 + j; const size_t o = (size_t)n * 256 + c;
                const float kk = kkv[i] * inv;
                r7[R_KK * AS + o] = f2bf(kk); r7[R_AK0 * AS + o] = f2bf(aa0[i] * kk); r7[R_AK1 * AS + o] = f2bf(aa1[i] * kk);
            }
            if (glane(F) == 0) bonus[(size_t)n * 4 + h] = bs;
        }
    }
#else
    prep_rwkv_gpu(F, l);
#endif
    {
        bf16* hh = WSP(bf16, OFF_HHGRN);
        const float* lg = F.in[19];
        for (size_t i = gtid_(F); i < (size_t)NTOK * 768; i += gthreads(F)) {
            const int n = (int)(i / 768), c = (int)(i % 768);
            bf16* p = hh + (size_t)n * 1280 + c;
            const float x = bf2f(*p);
            if (c < 256) { *p = f2bf(siluf_(x)); }
            else {
                const int d = c & 255;
                float lb = 0.f;
                if (l == 1) { const float a = lg[d], b = lg[256 + d]; const float m = fmaxf(a, b); const float ea = expf(a - m), eb = expf(b - m); lb = eb / (ea + eb); }
                *p = f2bf((1.0f - lb) * sigmoidf_(-x));
            }
        }
    }
#endif
}

struct EpiQMla {
    bf16* q; int row0, pn; const float* tab;
    DI void operator()(int r, int c, float a, float b, float cc, float d) const {
        const int row = row0 + r, col = pn * 256 + c;
        if (col >= 384) return;
        const int w = col % 96;
        if (w >= 64) {
            const int s = row % SEQ;
#pragma unroll
            for (int t = 0; t < 2; ++t) {
                const int m = ((w - 64) >> 1) + t;
#ifdef CPU_EMU
                const float pos = m < 8 ? (float)(s / GRIDW) : (float)(s % GRIDW);
                const float ang = pos * rope_inv(2 * (m & 7), 16);
                const float cs = cosf(ang), sn = sinf(ang);
#else
                const int pi = m < 8 ? s / GRIDW : s % GRIDW;
                const float cs = tab[pi * 8 + (m & 7)], sn = tab[512 + pi * 8 + (m & 7)];
#endif
                float& x1 = t ? cc : a; float& x2 = t ? d : b;
                const float y1 = x1 * cs - x2 * sn, y2 = x1 * sn + x2 * cs; x1 = y1; x2 = y2;
            }
        }
        st_bf16x4(q + (size_t)row * 384 + col, a, b, cc, d);
    }
};
struct EpiKVMla {
    bf16* kn; bf16* vt; int row0, pn;
    DI void operator()(int r, int c, float a, float b, float cc, float d) const {
        const int row = row0 + r, col = pn * 256 + c, h = col >> 7, w = col & 127;
        if (w < 64) st_bf16x4(kn + (size_t)row * 256 + h * 64 + w, a, b, cc, d);
        else { const int bb = row / SEQ, s = row % SEQ; bf16* p = vt + ((size_t)bb * 256 + h * 64 + (w - 64)) * SEQ + s;
            p[0] = f2bf(a); p[SEQ] = f2bf(b); p[2 * SEQ] = f2bf(cc); p[3 * SEQ] = f2bf(d); }
    }
};
DI void phase_mlaup(const Frame& F) {
    const bf16* hm = WSP(bf16, OFF_HMLA); const char* wts = (const char*)WSP(bf16, OFF_WTS);
    const int nM = (NTOK + 255) / 256;
    float* rtab = (float*)(F.smem + 139264);
#ifndef CPU_EMU
    __syncthreads();
    { const int i = fresh_tid(F); const int pos = i >> 3, f = i & 7; const float ang = (float)pos * rope_inv(2 * f, 16); rtab[i] = cosf(ang); rtab[512 + i] = sinf(ang); }
    __syncthreads();
#endif
    for (int u = blockIdx.x; u < nM * 4; u += F.nblk) {
        const int pm = u >> 2, j = u & 3;
#ifdef CPU_EMU
        const int mr = min(256, NTOK - pm * 256);
#define MR , mr
#else
#define MR
#endif
        if (j < 2) { EpiQMla E{WSP(bf16, OFF_QMLA), pm * 256, j, rtab};
            gemm_unit(F, hm, 512, nullptr, pm * 256, (const bf16*)(wts + W_UQ_T), 256, j * 256, 256, E MR); }
        else { EpiKVMla E{WSP(bf16, OFF_KNOPE), WSP(bf16, OFF_VTMLA), pm * 256, j - 2};
            gemm_unit(F, hm + 256, 512, nullptr, pm * 256, (const bf16*)(wts + W_UKV_T), 256, (j - 2) * 256, 256, E MR); }
    }
}

struct AttnDesc {
    const bf16* q; int q_stride;
    int q_hstride;
    const bf16* k; int k_stride; int k_hstride;
    const bf16* k2; int k2_stride;
    int dk_main;
    const bf16* vt;
    bf16* o; int o_stride; int o_hstride;
    int H, HKV, SQ, SK;
    float scale;
};

#ifdef CPU_EMU
template <int DK, int DV>
void attn_phase(const Frame& F, const AttnDesc& A) {
    const int G = A.H / A.HKV;
    float* sc = (float*)malloc(sizeof(float) * A.SK);
    for (int b = 0; b < BATCH; ++b) for (int h = 0; h < A.H; ++h) for (int s = 0; s < A.SQ; ++s) {
        const int kv = h / G;
        const bf16* q = A.q + (size_t)(b * A.SQ + s) * A.q_stride + h * A.q_hstride;
        float mx = -1e30f;
        for (int key = 0; key < A.SK; ++key) {
            const bf16* kp = A.k + (size_t)(b * A.SK + key) * A.k_stride + kv * A.k_hstride;
            double acc = 0;
            for (int d = 0; d < DK; ++d) {
                float kvl = d < A.dk_main ? bf2f(kp[d]) : bf2f(A.k2[(size_t)(b * A.SK + key) * A.k2_stride + d - A.dk_main]);
                acc += (double)bf2f(q[d]) * kvl;
            }
            sc[key] = (float)acc * A.scale; mx = fmaxf(mx, sc[key]);
        }
        double sum = 0; for (int key = 0; key < A.SK; ++key) { sc[key] = expf(sc[key] - mx); sum += sc[key]; }
        for (int dv = 0; dv < DV; ++dv) {
            const bf16* vp = A.vt + ((size_t)(b * A.HKV + kv) * DV + dv) * A.SK;
            double acc = 0; for (int key = 0; key < A.SK; ++key) acc += (double)bf2f(f2bf(sc[key])) * bf2f(vp[key]);
            A.o[(size_t)(b * A.SQ + s) * A.o_stride + h * A.o_hstride + dv] = f2bf((float)(acc / sum));
        }
    }
    free(sc);
}
#else
DI int crow16(int reg, int h) { return (reg & 3) + 8 * (reg >> 2) + 4 * h; }
template <int DK, int DV, int DVT, int NQB>
DI void attn_unit(const Frame& F, const AttnDesc& A, int u) {
    constexpr int KP = DK + 8;
    constexpr int VP = 64 + 8;
    constexpr int NPASS = DV / DVT;
    constexpr int UQ = 256 * NQB;
    bf16* Ks = (bf16*)F.smem;
    bf16* Vs = Ks + 64 * KP;
    const int tid = fresh_tid(F), wave = F.wv, lane = tid & 63, r = lane & 31, hh = lane >> 5;
    const int G = A.H / A.HKV;
    const int nqb = A.SQ / UQ;
    const float sl2 = A.scale * 1.4426950408889634f;
    {
        int t = u; const int pass = t % NPASS; t /= NPASS; const int qb = t % nqb; t /= nqb; const int h = t % A.H; const int b = t / A.H;
        const int kv = h / G;
        const int q0 = qb * UQ + wave * 32 * NQB;
        bf16x8 qf[NQB][DK / 16];
#pragma unroll
        for (int qi = 0; qi < NQB; ++qi) { const bf16* qp = A.q + (size_t)(b * A.SQ + q0 + 32 * qi + r) * A.q_stride + h * A.q_hstride + 8 * hh;
#pragma unroll
          for (int ks = 0; ks < DK / 16; ++ks) qf[qi][ks] = *reinterpret_cast<const bf16x8*>(qp + 16 * ks); }
        f32x16 oacc[NQB][DVT / 32];
#pragma unroll
        for (int qi = 0; qi < NQB; ++qi)
#pragma unroll
            for (int i = 0; i < DVT / 32; ++i)
#pragma unroll
                for (int j = 0; j < 16; ++j) oacc[qi][i][j] = 0.f;
        float mrun[NQB], lrun[NQB];
#pragma unroll
        for (int qi = 0; qi < NQB; ++qi) { mrun[qi] = -INFINITY; lrun[qi] = 0.f; }
        constexpr int NKC = (64 * (DK / 8) + 511) / 512, NVC = (DVT * 8 + 511) / 512;
        uint4 kr0, kr1, kr2, kr3, vr0, vr1;
        kr0 = kr1 = kr2 = kr3 = vr0 = vr1 = make_uint4(0u, 0u, 0u, 0u);
#define ATT_FK(kt_, i_, reg_) do { if ((i_) < NKC) { int c_ = tid + (i_) * 512; if (c_ >= 64 * (DK / 8)) c_ = 64 * (DK / 8) - 1; \
            const int key_ = c_ / (DK / 8), d8_ = (c_ % (DK / 8)) * 8; const size_t krow_ = (size_t)(b * A.SK + (kt_) * 64 + key_); \
            const bf16* kp_ = (d8_ < A.dk_main) ? (A.k + krow_ * A.k_stride + kv * A.k_hstride + d8_) : (A.k2 + krow_ * A.k2_stride + (d8_ - A.dk_main)); \
            reg_ = *reinterpret_cast<const uint4*>(kp_); } } while (0)
#define ATT_FV(kt_, i_, reg_) do { if ((i_) < NVC) { int c_ = tid + (i_) * 512; if (c_ >= DVT * 8) c_ = DVT * 8 - 1; \
            const int dv_ = c_ >> 3, k8_ = (c_ & 7) * 8; \
            reg_ = *reinterpret_cast<const uint4*>(A.vt + ((size_t)(b * A.HKV + kv) * DV + pass * DVT + dv_) * A.SK + (kt_) * 64 + k8_); } } while (0)
#define ATT_FETCH(kt_) do { ATT_FK(kt_, 0, kr0); ATT_FK(kt_, 1, kr1); ATT_FK(kt_, 2, kr2); ATT_FK(kt_, 3, kr3); ATT_FV(kt_, 0, vr0); ATT_FV(kt_, 1, vr1); } while (0)
#define ATT_SK(kb_, i_, reg_) do { if ((i_) < NKC) { const int c_ = tid + (i_) * 512; if (c_ < 64 * (DK / 8)) { \
            const int key_ = c_ / (DK / 8), d8_ = (c_ % (DK / 8)) * 8; *reinterpret_cast<uint4*>((kb_) + key_ * KP + d8_) = reg_; } } } while (0)
#define ATT_SV(vb_, i_, reg_) do { if ((i_) < NVC) { const int c_ = tid + (i_) * 512; if (c_ < DVT * 8) { \
            const int dv_ = c_ >> 3, k8_ = (c_ & 7) * 8; *reinterpret_cast<uint4*>((vb_) + dv_ * VP + k8_) = reg_; } } } while (0)
#define ATT_STORE(kb_, vb_) do { ATT_SK(kb_, 0, kr0); ATT_SK(kb_, 1, kr1); ATT_SK(kb_, 2, kr2); ATT_SK(kb_, 3, kr3); ATT_SV(vb_, 0, vr0); ATT_SV(vb_, 1, vr1); } while (0)
        constexpr bool PREF = DK <= 96;
        constexpr int BUFE = 64 * KP + DVT * VP;
        const int ntile = A.SK / 64;
        if (PREF) { ATT_FETCH(0); ATT_STORE(Ks, Vs); if (ntile > 1) ATT_FETCH(1); __syncthreads(); }
        for (int kt = 0; kt < ntile; ++kt) {
            if (PREF) {
                if (kt + 1 < ntile) { bf16* kb = Ks + ((kt + 1) & 1) * BUFE; ATT_STORE(kb, kb + 64 * KP); if (kt + 2 < ntile) ATT_FETCH(kt + 2); }
            } else {
            __syncthreads();
            {
                for (int c = tid; c < 64 * (DK / 8); c += 512) {
                    const int key = c / (DK / 8), d8 = (c % (DK / 8)) * 8;
                    const size_t krow = (size_t)(b * A.SK + kt * 64 + key);
                    uint4 v;
                    if (d8 < A.dk_main) v = *reinterpret_cast<const uint4*>(A.k + krow * A.k_stride + kv * A.k_hstride + d8);
                    else v = *reinterpret_cast<const uint4*>(A.k2 + krow * A.k2_stride + (d8 - A.dk_main));
                    *reinterpret_cast<uint4*>(Ks + key * KP + d8) = v;
                }
                for (int c = tid; c < DVT * 8; c += 512) {
                    const int dv = c >> 3, k8 = (c & 7) * 8;
                    const uint4 v = *reinterpret_cast<const uint4*>(A.vt + ((size_t)(b * A.HKV + kv) * DV + pass * DVT + dv) * A.SK + kt * 64 + k8);
                    *reinterpret_cast<uint4*>(Vs + dv * VP + k8) = v;
                }
            }
            __syncthreads();
            }
            const bf16* Kc = PREF ? Ks + (kt & 1) * BUFE : Ks; const bf16* Vc = Kc + 64 * KP;
            f32x16 sacc[NQB][2];
#pragma unroll
            for (int kb = 0; kb < 2; ++kb) {
#pragma unroll
                for (int qi = 0; qi < NQB; ++qi)
#pragma unroll
                    for (int j = 0; j < 16; ++j) sacc[qi][kb][j] = 0.f;
#pragma unroll
                for (int ks = 0; ks < DK / 16; ++ks) {
                    const bf16x8 kf = *reinterpret_cast<const bf16x8*>(Kc + (kb * 32 + r) * KP + 16 * ks + 8 * hh);
#pragma unroll
                    for (int qi = 0; qi < NQB; ++qi) sacc[qi][kb] = __builtin_amdgcn_mfma_f32_32x32x16_bf16(kf, qf[qi][ks], sacc[qi][kb], 0, 0, 0);
                }
            }
#pragma unroll
            for (int qi = 0; qi < NQB; ++qi) {
                float mx = -INFINITY;
#pragma unroll
                for (int kb = 0; kb < 2; ++kb)
#pragma unroll
                    for (int j = 0; j < 16; ++j) mx = fmaxf(mx, sacc[qi][kb][j]);
                mx = fmaxf(mx, shfl_xor(F, mx, 32));
                const float mnew = fmaxf(mrun[qi], mx * sl2);
                const float alpha = __builtin_amdgcn_exp2f(mrun[qi] - mnew);
                mrun[qi] = mnew;
                float psum = 0.f;
#pragma unroll
                for (int kb = 0; kb < 2; ++kb)
#pragma unroll
                    for (int j = 0; j < 16; ++j) { const float p = __builtin_amdgcn_exp2f(sacc[qi][kb][j] * sl2 - mnew); sacc[qi][kb][j] = p; psum += p; }
                lrun[qi] = lrun[qi] * alpha + psum;
                if (!PREF || __ballot(alpha != 1.0f)) {
#pragma unroll
                    for (int i = 0; i < DVT / 32; ++i)
#pragma unroll
                        for (int j = 0; j < 16; ++j) oacc[qi][i][j] *= alpha;
                }
            }
#pragma unroll
            for (int kb = 0; kb < 2; ++kb)
#pragma unroll
                for (int s2 = 0; s2 < 2; ++s2) {
                    union PF { bf16x8 v; unsigned u[4]; };
                    PF pf[NQB];
#pragma unroll
                    for (int qi = 0; qi < NQB; ++qi)
#pragma unroll
                        for (int j = 0; j < 4; ++j) pf[qi].u[j] = pack_bf16(sacc[qi][kb][8 * s2 + 2 * j], sacc[qi][kb][8 * s2 + 2 * j + 1]);
#pragma unroll
                    for (int i = 0; i < DVT / 32; ++i) {
                        const bf16* vp = Vc + (i * 32 + r) * VP + kb * 32 + 16 * s2 + 4 * hh;
                        union { bf16x8 v; bf16x4 h2[2]; } vf;
                        vf.h2[0] = *reinterpret_cast<const bf16x4*>(vp);
                        vf.h2[1] = *reinterpret_cast<const bf16x4*>(vp + 8);
#pragma unroll
                        for (int qi = 0; qi < NQB; ++qi) oacc[qi][i] = __builtin_amdgcn_mfma_f32_32x32x16_bf16(vf.v, pf[qi].v, oacc[qi][i], 0, 0, 0);
                    }
                }
            if (PREF) __syncthreads();
        }
#pragma unroll
        for (int qi = 0; qi < NQB; ++qi) {
            const float lsum = lrun[qi] + shfl_xor(F, lrun[qi], 32);
            const float inv = 1.0f / lsum;
            bf16* op = A.o + (size_t)(b * A.SQ + q0 + 32 * qi + r) * A.o_stride + h * A.o_hstride + pass * DVT;
#pragma unroll
            for (int i = 0; i < DVT / 32; ++i)
#pragma unroll
                for (int g = 0; g < 4; ++g)
                    st_bf16x4(op + i * 32 + 8 * g + 4 * hh, oacc[qi][i][4 * g] * inv, oacc[qi][i][4 * g + 1] * inv, oacc[qi][i][4 * g + 2] * inv, oacc[qi][i][4 * g + 3] * inv);
        }
    }
}
#endif

#undef ATT_FETCH
#undef ATT_STORE
#undef ATT_FK
#undef ATT_FV
#undef ATT_SK
#undef ATT_SV
#ifndef CPU_EMU
template <int DK, int DV, int DVT, int NQB>
DI int attn_nunit(const AttnDesc& A) { return BATCH * A.H * (A.SQ / (256 * NQB)) * (DV / DVT); }
template <int DK, int DV, int DVT, int NQB>
DI void attn_phase(const Frame& F, const AttnDesc& A) {
    const int nunit = attn_nunit<DK, DV, DVT, NQB>(A);
    for (int u = blockIdx.x; u < nunit; u += F.nblk) attn_unit<DK, DV, DVT, NQB>(F, A, u);
}
#endif
DI AttnDesc desc_gqa(const Frame& F) {
    AttnDesc A; A.q = WSP(bf16, OFF_HATT); A.q_stride = 512; A.q_hstride = 64;
    A.k = WSP(bf16, OFF_HATT) + 256; A.k_stride = 512; A.k_hstride = 64; A.k2 = nullptr; A.k2_stride = 0; A.dk_main = 64;
    A.vt = WSP(bf16, OFF_VTATT); A.o = WSP(bf16, OFF_YCAT); A.o_stride = 1024; A.o_hstride = 64;
    A.H = 4; A.HKV = 2; A.SQ = SEQ; A.SK = SEQ; A.scale = 0.125f; return A;
}
DI AttnDesc desc_mla(const Frame& F) {
    AttnDesc A; A.q = WSP(bf16, OFF_QMLA); A.q_stride = 384; A.q_hstride = 96;
    A.k = WSP(bf16, OFF_KNOPE); A.k_stride = 256; A.k_hstride = 64; A.k2 = WSP(bf16, OFF_KROPE); A.k2_stride = 32; A.dk_main = 64;
    A.vt = WSP(bf16, OFF_VTMLA); A.o = WSP(bf16, OFF_YCAT) + 768; A.o_stride = 1024; A.o_hstride = 64;
    A.H = 4; A.HKV = 4; A.SQ = SEQ; A.SK = SEQ; A.scale = 0.10206207261596575f; return A;
}
DI AttnDesc desc_mem(const Frame& F) {
    AttnDesc A; A.q = WSP(bf16, OFF_QMEM); A.q_stride = 1024; A.q_hstride = 256;
    A.k = WSP(bf16, OFF_KMEM); A.k_stride = 1024; A.k_hstride = 256; A.k2 = nullptr; A.k2_stride = 0; A.dk_main = 256;
    A.vt = WSP(bf16, OFF_VTMEM); A.o = WSP(bf16, OFF_OMEM); A.o_stride = 1024; A.o_hstride = 256;
    A.H = 4; A.HKV = 4; A.SQ = SEQ; A.SK = MEMT; A.scale = 0.0625f; return A;
}

#ifndef CPU_EMU
typedef float f32p __attribute__((ext_vector_type(2)));
DI f32p allsum16p(f32p x) { x.x = allsum16(x.x); x.y = allsum16(x.y); return x; }
template <int KIND>
DI void scan_chain(const Frame& F, int chain) {
    constexpr int T = 32;
    constexpr int NARR = KIND == 0 ? 6 : 3;
    constexpr int STEPB = NARR * 256;
    constexpr int NPIECE = T * NARR * 8;
    constexpr int PPT = (NPIECE + NTH - 1) / NTH;
    const int d = chain / (BATCH * 4), b = (chain / 4) % BATCH, h = chain % 4;
    const int tid = F.tid, wave = tid >> 6, lane = tid & 63, rg = lane >> 4, cg = lane & 15;
    unsigned char* buf0 = F.smem; unsigned char* buf1 = F.smem + T * STEPB;
    unsigned char* ybuf = F.smem + 2 * T * STEPB;
    const size_t AS = (size_t)NTOK * 256;
    bf16* r7 = WSP(bf16, OFF_R7); bf16* hh = WSP(bf16, OFF_HHGRN);
#define PIECE_PTR(t0, p_) ([&]() -> const uint4* { const int pc = (p_) < NPIECE ? (p_) : NPIECE - 1; \
        const int st = pc / (NARR * 8), rem = pc % (NARR * 8), arr = rem >> 3, part = rem & 7; \
        const int tt = (t0) + st, ss = d ? SEQ - 1 - tt : tt; const size_t nn = (size_t)b * SEQ + ss; \
        const bf16* base; \
        if (KIND == 0) { const int aid = arr == 0 ? R_KK : arr == 1 ? (d ? R_W1 : R_W0) : arr == 2 ? (d ? R_AK1 : R_AK0) : arr == 3 ? (d ? R_KD1 : R_KD0) : arr == 4 ? R_R : R_V; \
            base = r7 + aid * AS + nn * 256 + h * 64; } \
        else { const int off = arr == 0 ? 256 + d * 256 : arr == 1 ? 0 : 768; base = hh + nn * 1280 + off + h * 64; } \
        return reinterpret_cast<const uint4*>(base + part * 8); }())
#define PUT_PIECE(dst, p_, v_) do { float4 a_, b_; a_.x = bflo((v_).x); a_.y = bfhi((v_).x); a_.z = bflo((v_).y); a_.w = bfhi((v_).y); \
        b_.x = bflo((v_).z); b_.y = bfhi((v_).z); b_.z = bflo((v_).w); b_.w = bfhi((v_).w); \
        *reinterpret_cast<float4*>((dst) + (p_) * 32) = a_; *reinterpret_cast<float4*>((dst) + (p_) * 32 + 16) = b_; } while (0)
#define STORE_PRE(dst) do { PUT_PIECE(dst, tid, pre0); \
        if (tid + NTH < NPIECE) PUT_PIECE(dst, tid + NTH, pre1); \
        if (PPT > 2 && tid + 2 * NTH < NPIECE) PUT_PIECE(dst, tid + 2 * NTH, pre2); } while (0)
    uint4 pre0, pre1, pre2;
    pre0 = *PIECE_PTR(0, tid); pre1 = *PIECE_PTR(0, tid + NTH); pre2 = pre1;
    if (PPT > 2) pre2 = *PIECE_PTR(0, tid + 2 * NTH);
    __syncthreads();
    STORE_PRE(buf0);
    __syncthreads();
    f32p P[4];
#pragma unroll
    for (int c = 0; c < 4; ++c) P[c] = (f32p){0.f, 0.f};
    const int vofs = (wave * 8 + rg * 2) * 4;
    for (int ch = 0; ch < SEQ / T; ++ch) {
        const unsigned char* cur = (ch & 1) ? buf1 : buf0;
        if (ch + 1 < SEQ / T) {
            pre0 = *PIECE_PTR((ch + 1) * T, tid); pre1 = *PIECE_PTR((ch + 1) * T, tid + NTH);
            if (PPT > 2) pre2 = *PIECE_PTR((ch + 1) * T, tid + 2 * NTH);
        }
        float4 o0, o1, o2, o3, o4; f32p ov;
        { const unsigned char* sb = cur;
          o0 = *reinterpret_cast<const float4*>(sb + 0 * 256 + cg * 16); o1 = *reinterpret_cast<const float4*>(sb + 1 * 256 + cg * 16);
          if (KIND == 0) { o2 = *reinterpret_cast<const float4*>(sb + 2 * 256 + cg * 16); o3 = *reinterpret_cast<const float4*>(sb + 3 * 256 + cg * 16); o4 = *reinterpret_cast<const float4*>(sb + 4 * 256 + cg * 16); }
          ov = *reinterpret_cast<const f32p*>(sb + (NARR - 1) * 256 + vofs); }
        unsigned ykeep = 0u;
#pragma unroll 2
        for (int t = 0; t < T; ++t) {
            const float4 c0 = o0, c1 = o1, c2 = o2, c3 = o3, c4 = o4; const f32p v = ov;
            { const unsigned char* sb = cur + ((t + 1) & (T - 1)) * STEPB;
              o0 = *reinterpret_cast<const float4*>(sb + 0 * 256 + cg * 16); o1 = *reinterpret_cast<const float4*>(sb + 1 * 256 + cg * 16);
              if (KIND == 0) { o2 = *reinterpret_cast<const float4*>(sb + 2 * 256 + cg * 16); o3 = *reinterpret_cast<const float4*>(sb + 3 * 256 + cg * 16); o4 = *reinterpret_cast<const float4*>(sb + 4 * 256 + cg * 16); }
              ov = *reinterpret_cast<const f32p*>(sb + (NARR - 1) * 256 + vofs); }
            f32p y;
            if (KIND == 0) {
                f32p sa = P[0] * c0.x + P[1] * c0.y + P[2] * c0.z + P[3] * c0.w;
                sa = allsum16p(sa);
                P[0] = P[0] * c1.x - sa * c2.x + v * c3.x;
                P[1] = P[1] * c1.y - sa * c2.y + v * c3.y;
                P[2] = P[2] * c1.z - sa * c2.z + v * c3.z;
                P[3] = P[3] * c1.w - sa * c2.w + v * c3.w;
                y = P[0] * c4.x + P[1] * c4.y + P[2] * c4.z + P[3] * c4.w;
            } else {
                P[0] += (v - P[0]) * c0.x; P[1] += (v - P[1]) * c0.y; P[2] += (v - P[2]) * c0.z; P[3] += (v - P[3]) * c0.w;
                y = P[0] * c1.x + P[1] * c1.y + P[2] * c1.z + P[3] * c1.w;
            }
            y = allsum16p(y);
            const unsigned yp = pack_bf16(y.x, y.y);
            ykeep = ((t & 15) == cg) ? yp : ykeep;
            if ((t & 15) == 15) *reinterpret_cast<unsigned*>(ybuf + ((t & ~15) + cg) * 128 + (wave * 8 + rg * 2) * 2) = ykeep;
        }
        asm volatile("s_waitcnt lgkmcnt(0)" ::: "memory");
        __builtin_amdgcn_wave_barrier();
        if (lane < T) {
            const int t = ch * T + lane, s = d ? SEQ - 1 - t : t; const size_t n = (size_t)b * SEQ + s;
            const uint4 yv = *reinterpret_cast<const uint4*>(ybuf + lane * 128 + wave * 16);
            bf16* dst = KIND == 0 ? r7 + (d ? R_W1 : R_W0) * AS + n * 256 + h * 64 + wave * 8 : hh + n * 1280 + 256 + d * 256 + h * 64 + wave * 8;
            *reinterpret_cast<uint4*>(dst) = yv;
        }
        if (ch + 1 < SEQ / T) {
            unsigned char* nxt = (ch & 1) ? buf0 : buf1;
            STORE_PRE(nxt);
        }
        __syncthreads();
    }
#undef PIECE_PTR
#undef STORE_PRE
#undef PUT_PIECE
}
DI void phase_scans(const Frame& F) {
    const int nchain = 2 * BATCH * 4;
    for (int g = blockIdx.x; g < nchain / 2; g += F.nblk) {
        if (F.wv < 2) scan_rwkv_chunk(F, g * 2 + F.wv); else if (F.wv < 4) scan_hgrn_chunk(F, g * 2 + F.wv - 2);
    }
}
#else
DI void phase_scans(const Frame& F) {
    bf16* r7 = WSP(bf16, OFF_R7); const size_t AS = (size_t)NTOK * 256;
    bf16* hh = WSP(bf16, OFF_HHGRN);
    const int nitem = 2 * BATCH * 4 * 64 * 2;
    for (int it = wave_item_index(F); it < nitem; it += gthreads(F)) {
        const int kind = it / (2 * BATCH * 4 * 64);
        int c = (it % (2 * BATCH * 4 * 64)) / 64; const int i = it % 64;
        const int d = c / (BATCH * 4); c %= BATCH * 4; const int b = c / 4, h = c % 4;
        float S[64];
#pragma unroll
        for (int j = 0; j < 64; ++j) S[j] = 0.f;
        if (kind == 0) {
            const bf16* pr = r7 + R_R * AS, *pv = r7 + R_V * AS, *pkk = r7 + R_KK * AS;
            bf16* pw = r7 + (d ? R_W1 : R_W0) * AS; const bf16* pkd = r7 + (d ? R_KD1 : R_KD0) * AS, *pak = r7 + (d ? R_AK1 : R_AK0) * AS;
            for (int t = 0; t < SEQ; ++t) {
                const int s = d ? SEQ - 1 - t : t;
                const size_t o = ((size_t)(b * SEQ + s)) * 256 + h * 64;
                const float v = bf2f(pv[o + i]);
                float sa = 0.f;
#pragma unroll
                for (int j = 0; j < 64; ++j) sa += S[j] * bf2f(pkk[o + j]);
                float y = 0.f;
#pragma unroll
                for (int j = 0; j < 64; ++j) {
                    S[j] = S[j] * bf2f(pw[o + j]) - sa * bf2f(pak[o + j]) + v * bf2f(pkd[o + j]);
                    y += S[j] * bf2f(pr[o + j]);
                }
#ifndef CPU_EMU
                __builtin_amdgcn_wave_barrier();
#endif
#ifdef CPU_EMU
                WSP(bf16, OFF_EMU_SCAN)[(size_t)d * AS + (size_t)(b * SEQ + s) * 256 + h * 64 + i] = f2bf(y);
#else
                pw[o + i] = f2bf(y);
#endif
            }
        } else {
            const bf16* pq = hh; bf16* pk = hh + 256 + d * 256; const bf16* pi = hh + 768;
            for (int t = 0; t < SEQ; ++t) {
                const int s = d ? SEQ - 1 - t : t;
                const size_t o = ((size_t)(b * SEQ + s)) * 1280 + h * 64;
                const float v = bf2f(pi[o + i]);
                float acc = 0.f;
#pragma unroll
                for (int j = 0; j < 64; ++j) {
                    const float k = bf2f(pk[o + j]);
                    S[j] = S[j] + k * (v - S[j]);
                    acc += S[j] * bf2f(pq[o + j]);
                }
#ifndef CPU_EMU
                __builtin_amdgcn_wave_barrier();
#endif
#ifdef CPU_EMU
                WSP(bf16, OFF_EMU_SCAN)[(size_t)(2 + d) * AS + (size_t)(b * SEQ + s) * 256 + h * 64 + i] = f2bf(acc);
#else
                pk[o + i] = f2bf(acc);
#endif
            }
        }
    }
}

#endif

#ifndef CPU_EMU
DI void phase_fin_gpu(const Frame& F, int l) {
    const bf16* r7 = WSP(bf16, OFF_R7); const size_t AS = (size_t)NTOK * 256;
    const bf16* gb = WSP(bf16, OFF_G); const float* bonus = WSP(float, OFF_BONUS);
    const bf16* hh = WSP(bf16, OFF_HHGRN); bf16* ycat = WSP(bf16, OFF_YCAT);
    float* par = (float*)F.smem;
    __syncthreads();
    for (int i = F.tid; i < 768; i += NTH) par[i] = i < 256 ? F.in[17][l * 256 + i] : i < 512 ? F.in[18][l * 256 + i - 256] : F.in[20][l * 256 + i - 512];
    __syncthreads();
    {
        for (int item = blockIdx.x * 8 + F.wv; item < (NTOK / 16) * 4; item += F.nblk * 8) {
            const int lane = fresh_tid(F) & 63, x = lane & 15, q = lane >> 4;
            const int h = item & 3; const size_t n0 = (size_t)(item >> 2) * 16, blk = (size_t)item * 1024;
            const bf16* y0 = r7 + C_KT0 * AS + blk; const bf16* y1 = r7 + C_KT1 * AS + blk; const bf16* vt = r7 + C_VT * AS + blk;
            float y[4][4], v[4][4];
#pragma unroll
            for (int u = 0; u < 4; ++u) {
                const uint2 a = *reinterpret_cast<const uint2*>(y0 + (u * 64 + lane) * 4), b = *reinterpret_cast<const uint2*>(y1 + (u * 64 + lane) * 4), c = *reinterpret_cast<const uint2*>(vt + (u * 64 + lane) * 4);
                y[u][0] = bflo(a.x) + bflo(b.x); y[u][1] = bfhi(a.x) + bfhi(b.x); y[u][2] = bflo(a.y) + bflo(b.y); y[u][3] = bfhi(a.y) + bfhi(b.y);
                v[u][0] = bflo(c.x); v[u][1] = bfhi(c.x); v[u][2] = bflo(c.y); v[u][3] = bfhi(c.y);
            }
#pragma unroll
            for (int r = 0; r < 4; ++r) {
                const size_t n = n0 + 4 * q + r;
                const float mu = allsum16((y[0][r] + y[1][r]) + (y[2][r] + y[3][r])) * (1.0f / 64.0f);
                const float d0 = y[0][r] - mu, d1 = y[1][r] - mu, d2 = y[2][r] - mu, d3 = y[3][r] - mu;
                const float rs = 1.0f / sqrtf(allsum16((d0 * d0 + d1 * d1) + (d2 * d2 + d3 * d3)) * (1.0f / 64.0f) + GN_EPS);
                const float bo = bonus[n * 4 + h];
                const float dv[4] = {d0, d1, d2, d3};
#pragma unroll
                for (int u = 0; u < 4; ++u) {
                    const int c = h * 64 + 16 * u + x;
                    ycat[n * 1024 + 256 + c] = f2bf((dv[u] * rs * par[c] + par[256 + c] + bo * v[u][r]) * bf2f(gb[n * 256 + c]));
                }
            }
        }
    }
    for (int it = blockIdx.x * NTH + fresh_tid(F); it < NTOK * 4; it += gthreads(F)) {
        const int n = it >> 2, h = it & 3;
        const uint4* pa = reinterpret_cast<const uint4*>(hh + (size_t)n * 1280 + 256 + h * 64); const uint4* pb = reinterpret_cast<const uint4*>(hh + (size_t)n * 1280 + 512 + h * 64);
        float s2 = 0.f;
#pragma unroll
        for (int i = 0; i < 8; ++i) { const uint4 a = pa[i], b = pb[i];
            const float y0 = bflo(a.x) + bflo(b.x), y1 = bfhi(a.x) + bfhi(b.x), y2 = bflo(a.y) + bflo(b.y), y3 = bfhi(a.y) + bfhi(b.y);
            const float y4 = bflo(a.z) + bflo(b.z), y5 = bfhi(a.z) + bfhi(b.z), y6 = bflo(a.w) + bflo(b.w), y7 = bfhi(a.w) + bfhi(b.w);
            s2 += (y0 * y0 + y1 * y1) + (y2 * y2 + y3 * y3) + (y4 * y4 + y5 * y5) + (y6 * y6 + y7 * y7); }
        const float rs = 1.0f / sqrtf(s2 * (1.0f / 64.0f) + RMS_EPS);
        uint4* po = reinterpret_cast<uint4*>(ycat + (size_t)n * 1024 + 512 + h * 64);
        const uint4* pg = reinterpret_cast<const uint4*>(hh + (size_t)n * 1280 + 1024 + h * 64);
        const float* gg = par + 512 + h * 64;
#pragma unroll 2
        for (int i = 0; i < 8; ++i) { const uint4 a = pa[i], b = pb[i], g4 = pg[i];
            const float yv[8] = {bflo(a.x) + bflo(b.x), bfhi(a.x) + bfhi(b.x), bflo(a.y) + bflo(b.y), bfhi(a.y) + bfhi(b.y), bflo(a.z) + bflo(b.z), bfhi(a.z) + bfhi(b.z), bflo(a.w) + bflo(b.w), bfhi(a.w) + bfhi(b.w)};
            const float gf[8] = {bflo(g4.x), bfhi(g4.x), bflo(g4.y), bfhi(g4.y), bflo(g4.z), bfhi(g4.z), bflo(g4.w), bfhi(g4.w)};
            float o[8];
#pragma unroll
            for (int j = 0; j < 8; ++j) o[j] = yv[j] * rs * gg[8 * i + j] * (gf[j] * fast_sigmoid(gf[j]));
            po[i] = make_uint4(pack_bf16(o[0], o[1]), pack_bf16(o[2], o[3]), pack_bf16(o[4], o[5]), pack_bf16(o[6], o[7])); }
    }
}
#endif
DI void phase_fin(const Frame& F, int l) {
    const bf16* r7 = WSP(bf16, OFF_R7); const size_t AS = (size_t)NTOK * 256;
    const bf16* gb = WSP(bf16, OFF_G); const float* bonus = WSP(float, OFF_BONUS);
    const bf16* hh = WSP(bf16, OFF_HHGRN); bf16* ycat = WSP(bf16, OFF_YCAT);
    const float* gng = F.in[17] + l * 256; const float* gnb = F.in[18] + l * 256; const float* hng = F.in[20] + l * 256;
    for (int it = ggrp(F); it < NTOK * 8; it += ngrp(F)) {
        const int n = it >> 3, kind = (it >> 2) & 1, h = it & 3;
        float v[PER64];
        if (kind == 0) {
            float s1 = 0.f;
            for (int i = 0; i < PER64; ++i) { const int c = h * 64 + glane(F) + i * GRP; const size_t o = (size_t)n * 256 + c;
#ifdef CPU_EMU
                v[i] = bf2f(WSP(bf16, OFF_EMU_SCAN)[o]) + bf2f(WSP(bf16, OFF_EMU_SCAN)[AS + o]); s1 += v[i]; }
#else
                v[i] = bf2f(r7[R_W0 * AS + o]) + bf2f(r7[R_W1 * AS + o]); s1 += v[i]; }
#endif
            s1 = grp_sum(F, s1); const float mu = s1 * (1.0f / 64.0f);
            float s2 = 0.f; for (int i = 0; i < PER64; ++i) { const float dd = v[i] - mu; s2 += dd * dd; }
            s2 = grp_sum(F, s2); const float rs = 1.0f / sqrtf(s2 * (1.0f / 64.0f) + GN_EPS);
            const float bo = bonus[(size_t)n * 4 + h];
            for (int i = 0; i < PER64; ++i) { const int c = h * 64 + glane(F) + i * GRP; const size_t o = (size_t)n * 256 + c;
                const float y = (v[i] - mu) * rs * gng[c] + gnb[c];
                ycat[(size_t)n * 1024 + 256 + c] = f2bf((y + bo * bf2f(r7[R_V * AS + o])) * bf2f(gb[o])); }
        } else {
            float s2 = 0.f;
            for (int i = 0; i < PER64; ++i) { const int c = h * 64 + glane(F) + i * GRP; const size_t o = (size_t)n * 1280 + c;
#ifdef CPU_EMU
                const size_t oe = (size_t)n * 256 + c;
                v[i] = bf2f(WSP(bf16, OFF_EMU_SCAN)[2 * AS + oe]) + bf2f(WSP(bf16, OFF_EMU_SCAN)[3 * AS + oe]); s2 += v[i] * v[i]; }
#else
                v[i] = bf2f(hh[o + 256]) + bf2f(hh[o + 512]); s2 += v[i] * v[i]; }
#endif
            s2 = grp_sum(F, s2); const float rs = 1.0f / sqrtf(s2 * (1.0f / 64.0f) + RMS_EPS);
            for (int i = 0; i < PER64; ++i) { const int c = h * 64 + glane(F) + i * GRP; const size_t o = (size_t)n * 1280 + c;
                ycat[(size_t)n * 1024 + 512 + c] = f2bf(v[i] * rs * hng[c] * siluf_(bf2f(hh[o + 1024]))); }
        }
    }
}

struct EpiResid {
    float* xf; int row0, pn;
    DI void operator()(int r, int c, float a, float b, float cc, float d) const {
        float* p = xf + (size_t)(row0 + r) * DM + pn * 256 + c;
#ifndef CPU_EMU
        float4 x = *reinterpret_cast<float4*>(p);
        x.x = DN_ALPHA * x.x + a; x.y = DN_ALPHA * x.y + b; x.z = DN_ALPHA * x.z + cc; x.w = DN_ALPHA * x.w + d;
        *reinterpret_cast<float4*>(p) = x;
#else
        p[0] = DN_ALPHA * p[0] + a; p[1] = DN_ALPHA * p[1] + b; p[2] = DN_ALPHA * p[2] + cc; p[3] = DN_ALPHA * p[3] + d;
#endif
    }
};
#ifndef CPU_EMU
struct EpiResidFB {
    const float* xf; bf16* xb; int row0, pn;
    DI void operator()(int r, int c, float a, float b, float cc, float d) const {
        const size_t o = (size_t)(row0 + r) * DM + pn * 256 + c;
        const float4 x = *reinterpret_cast<const float4*>(xf + o);
        *reinterpret_cast<uint2*>(xb + o) = make_uint2(pack_bf16(DN_ALPHA * x.x + a, DN_ALPHA * x.y + b), pack_bf16(DN_ALPHA * x.z + cc, DN_ALPHA * x.w + d));
    }
};
struct EpiResidBB {
    bf16* xb; int row0, pn;
    DI void operator()(int r, int c, float a, float b, float cc, float d) const {
        const size_t o = (size_t)(row0 + r) * DM + pn * 256 + c;
        const uint2 x = *reinterpret_cast<const uint2*>(xb + o);
        *reinterpret_cast<uint2*>(xb + o) = make_uint2(pack_bf16(DN_ALPHA * bflo(x.x) + a, DN_ALPHA * bfhi(x.x) + b), pack_bf16(DN_ALPHA * bflo(x.y) + cc, DN_ALPHA * bfhi(x.y) + d));
    }
};
#endif
struct EpiBf {
    bf16* o; int ld; int row0, pn;
    DI void operator()(int r, int c, float a, float b, float cc, float d) const { st_bf16x4(o + (size_t)(row0 + r) * ld + pn * 256 + c, a, b, cc, d); }
};
template <int MODE>
DI void phase_gemm_sq(const Frame& F, const bf16* A, size_t woff, bf16* outb) {
    const bf16* W = (const bf16*)((const char*)WSP(bf16, OFF_WTS) + woff);
    const int nM = (NTOK + 255) / 256;
    for (int u = blockIdx.x; u < nM * 4; u += F.nblk) {
        const int pm = u >> 2, pn = u & 3;
#ifdef CPU_EMU
        const int mr = min(256, NTOK - pm * 256);
#endif
#ifndef CPU_EMU
        if (MODE == 0) { EpiResidFB E{F.xf, WSP(bf16, OFF_XB), pm * 256, pn}; gemm_unit(F, A, 1024, nullptr, pm * 256, W, 1024, pn * 256, 1024, E MR); }
        else if (MODE == 2) { EpiResidBB E{WSP(bf16, OFF_XB), pm * 256, pn}; gemm_unit(F, A, 1024, nullptr, pm * 256, W, 1024, pn * 256, 1024, E MR); }
#else
        if (MODE == 0 || MODE == 2) { EpiResid E{F.xf, pm * 256, pn}; gemm_unit(F, A, 1024, nullptr, pm * 256, W, 1024, pn * 256, 1024, E MR); }
#endif
        else { EpiBf E{outb, 1024, pm * 256, pn}; gemm_unit(F, A, 1024, nullptr, pm * 256, W, 1024, pn * 256, 1024, E MR); }
    }
}

template <bool BLOCKED = false>
DI void phase_ln(const Frame& F, const float* g, const float* b) {
#ifdef CPU_EMU
    const float* xf = F.xf;
    layer_norm_rows(F, g, b, [&](int row, int c) { return xf[(size_t)row * DM + c]; }, false, nullptr);
#else
    ln_rows_gpu<0, BLOCKED, BLOCKED>(F, g, b, 0);
#endif
}

#ifndef CPU_EMU
DI void phase_route_gpu(const Frame& F, int l) {
    const float* xf = F.xf; const float* gt = (const float*)((const char*)WSP(bf16, OFF_WTS) + W_GATE_T) + (size_t)l * 48 * 1024;
    const float* bg = F.in[34] + l * 4; const float* be = F.in[36] + l * 32;
    int* counts = (int*)(F.ws + CTL_CNT) + l * 32;
    int* lists = WSP(int, OFF_LISTS); float* tinfo = WSP(float, OFF_TINFO);
    const int tid = F.tid, wave = tid >> 6, lane = tid & 63, rr = lane & 15, kq = lane >> 4;
    float* lg = (float*)F.smem + wave * (16 * 48);
    const bool blk_ok = (NTOK % (F.nblk * 32) == 0);
    const int rpb = NTOK / F.nblk;
    int* hcnt = (int*)(F.smem + 32768); int* hbase = hcnt + 32;
    __syncthreads();
    const int rt_first = blk_ok ? 0 : blockIdx.x * 8, rt_lim = blk_ok ? rpb / 16 : NTOK / 16, rt_step = blk_ok ? 8 : F.nblk * 8;
    for (int rtb = rt_first; rtb < rt_lim; rtb += rt_step) {
        const int rt = rtb + wave; const bool live = rt < rt_lim;
        if (tid < 32) hcnt[tid] = 0;
        __syncthreads();
        int ea = 0, eb = 0, pa = 0, pb = 0, row = 0; float g0 = 0.f, g1 = 0.f;
        if (live) {
        const int r0 = blk_ok ? blockIdx.x * rpb + rt * 16 : rt * 16;
        f32x4 acc0 = {0.f, 0.f, 0.f, 0.f}, acc1 = acc0, acc2 = acc0;
        const float* xa = xf + (size_t)(r0 + rr) * DM + 4 * kq;
        const float* wb = gt + (size_t)rr * 1024 + 4 * kq;
#pragma unroll 1
        for (int kb = 0; kb < 1024; kb += 64) {
            float4 a[4], b0[4], b1[4], b2[4];
#pragma unroll
            for (int u = 0; u < 4; ++u) { const int k0 = kb + 16 * u;
                a[u] = *reinterpret_cast<const float4*>(xa + k0); b0[u] = *reinterpret_cast<const float4*>(wb + k0);
                b1[u] = *reinterpret_cast<const float4*>(wb + 16 * 1024 + k0); b2[u] = *reinterpret_cast<const float4*>(wb + 32 * 1024 + k0); }
#pragma unroll
            for (int u = 0; u < 4; ++u) {
                acc0 = __builtin_amdgcn_mfma_f32_16x16x4f32(a[u].x, b0[u].x, acc0, 0, 0, 0); acc1 = __builtin_amdgcn_mfma_f32_16x16x4f32(a[u].x, b1[u].x, acc1, 0, 0, 0); acc2 = __builtin_amdgcn_mfma_f32_16x16x4f32(a[u].x, b2[u].x, acc2, 0, 0, 0);
                acc0 = __builtin_amdgcn_mfma_f32_16x16x4f32(a[u].y, b0[u].y, acc0, 0, 0, 0); acc1 = __builtin_amdgcn_mfma_f32_16x16x4f32(a[u].y, b1[u].y, acc1, 0, 0, 0); acc2 = __builtin_amdgcn_mfma_f32_16x16x4f32(a[u].y, b2[u].y, acc2, 0, 0, 0);
                acc0 = __builtin_amdgcn_mfma_f32_16x16x4f32(a[u].z, b0[u].z, acc0, 0, 0, 0); acc1 = __builtin_amdgcn_mfma_f32_16x16x4f32(a[u].z, b1[u].z, acc1, 0, 0, 0); acc2 = __builtin_amdgcn_mfma_f32_16x16x4f32(a[u].z, b2[u].z, acc2, 0, 0, 0);
                acc0 = __builtin_amdgcn_mfma_f32_16x16x4f32(a[u].w, b0[u].w, acc0, 0, 0, 0); acc1 = __builtin_amdgcn_mfma_f32_16x16x4f32(a[u].w, b1[u].w, acc1, 0, 0, 0); acc2 = __builtin_amdgcn_mfma_f32_16x16x4f32(a[u].w, b2[u].w, acc2, 0, 0, 0);
            }
        }
#pragma unroll
        for (int r = 0; r < 4; ++r) { lg[(4 * kq + r) * 48 + rr] = acc0[r]; lg[(4 * kq + r) * 48 + 16 + rr] = acc1[r]; lg[(4 * kq + r) * 48 + 32 + rr] = acc2[r]; }
        asm volatile("s_waitcnt lgkmcnt(0)" ::: "memory");
        __builtin_amdgcn_wave_barrier();
        if (lane < 16) {
            row = r0 + lane; const float* L = lg + lane * 48;
            float gl[4];
#pragma unroll
            for (int q = 0; q < 4; ++q) gl[q] = L[q] + bg[q];
            int gi = 0; float gm = gl[0];
#pragma unroll
            for (int q = 1; q < 4; ++q) if (gl[q] > gm) { gm = gl[q]; gi = q; }
            float den = 0.f;
#pragma unroll
            for (int q = 0; q < 4; ++q) den += expf(gl[q] - gm);
            const float pgroup = 1.0f / den;
            float el[8];
#pragma unroll
            for (int q = 0; q < 8; ++q) el[q] = L[4 + gi * 8 + q] + be[gi * 8 + q];
            int i0 = 0; float v0 = el[0];
#pragma unroll
            for (int q = 1; q < 8; ++q) if (el[q] > v0) { v0 = el[q]; i0 = q; }
            int i1 = -1; float v1 = -INFINITY;
#pragma unroll
            for (int q = 0; q < 8; ++q) if (q != i0 && el[q] > v1) { v1 = el[q]; i1 = q; }
            const float e1 = expf(v1 - v0); g0 = pgroup / (1.0f + e1); g1 = pgroup * e1 / (1.0f + e1);
            ea = gi * 8 + i0; eb = gi * 8 + i1;
            pa = atomicAdd(&hcnt[ea], 1); pb = atomicAdd(&hcnt[eb], 1);
        }
        __builtin_amdgcn_wave_barrier();
        }
        __syncthreads();
        if (tid < 32) { const int c = hcnt[tid]; hbase[tid] = c ? atomicAdd(&counts[tid], c) : 0; }
        __syncthreads();
        if (live && lane < 16) {
            pa += hbase[ea]; pb += hbase[eb];
            lists[(size_t)ea * NTOK + pa] = row; lists[(size_t)eb * NTOK + pb] = row;
            int* ti = (int*)(tinfo + (size_t)row * 8);
            ti[0] = ea; ti[1] = pa; ti[2] = eb; ti[3] = pb; tinfo[(size_t)row * 8 + 4] = g0; tinfo[(size_t)row * 8 + 5] = g1;
        }
    }
}
#endif
DI void phase_route(const Frame& F, int l) {
    const float* xf = F.xf;
    const float* wg = F.in[33] + (size_t)l * 1024 * 4; const float* bg = F.in[34] + l * 4;
    const float* we = F.in[35] + (size_t)l * 1024 * 32; const float* be = F.in[36] + l * 32;
    int* counts = (int*)(F.ws + CTL_CNT) + l * 32;
    int* lists = WSP(int, OFF_LISTS); float* tinfo = WSP(float, OFF_TINFO);
    for (int row = ggrp(F); row < NTOK; row += ngrp(F)) {
        float gl[4] = {0.f, 0.f, 0.f, 0.f};
        for (int i = 0; i < PERLN; ++i) { const int c = glane(F) + i * GRP; const float x = xf[(size_t)row * DM + c];
#pragma unroll
            for (int q = 0; q < 4; ++q) gl[q] += x * wg[c * 4 + q]; }
#pragma unroll
        for (int q = 0; q < 4; ++q) gl[q] = grp_sum(F, gl[q]) + bg[q];
        int gi = 0; float gm = gl[0];
#pragma unroll
        for (int q = 1; q < 4; ++q) if (gl[q] > gm) { gm = gl[q]; gi = q; }
        float den = 0.f;
#pragma unroll
        for (int q = 0; q < 4; ++q) den += expf(gl[q] - gm);
        const float pgroup = 1.0f / den;
        float el[8] = {0.f, 0.f, 0.f, 0.f, 0.f, 0.f, 0.f, 0.f};
        for (int i = 0; i < PERLN; ++i) { const int c = glane(F) + i * GRP; const float x = xf[(size_t)row * DM + c];
#pragma unroll
            for (int q = 0; q < 8; ++q) el[q] += x * we[c * 32 + gi * 8 + q]; }
#pragma unroll
        for (int q = 0; q < 8; ++q) el[q] = grp_sum(F, el[q]) + be[gi * 8 + q];
        int i0 = 0; float v0 = el[0];
#pragma unroll
        for (int q = 1; q < 8; ++q) if (el[q] > v0) { v0 = el[q]; i0 = q; }
        int i1 = -1; float v1 = -INFINITY;
#pragma unroll
        for (int q = 0; q < 8; ++q) if (q != i0 && el[q] > v1) { v1 = el[q]; i1 = q; }
        const float e1 = expf(v1 - v0); const float g0 = pgroup / (1.0f + e1), g1 = pgroup * e1 / (1.0f + e1);
        if (glane(F) == 0) {
            const int ea = gi * 8 + i0, eb = gi * 8 + i1;
            const int pa = atomicAdd(&counts[ea], 1), pb = atomicAdd(&counts[eb], 1);
            lists[(size_t)ea * NTOK + pa] = row; lists[(size_t)eb * NTOK + pb] = row;
            int* ti = (int*)(tinfo + (size_t)row * 8);
            ti[0] = ea; ti[1] = pa; ti[2] = eb; ti[3] = pb; tinfo[(size_t)row * 8 + 4] = g0; tinfo[(size_t)row * 8 + 5] = g1;
        }
    }
}

struct EpiMoeUp {
    bf16* hm; int row0, pn;
    DI void operator()(int r, int c, float a, float b, float cc, float d) const {
        bf16* p = hm + (size_t)(row0 + r) * 256 + ((pn * 256 + c) >> 1);
        p[0] = f2bf(siluf_(a) * b); p[1] = f2bf(siluf_(cc) * d);
    }
};
DI int ld_cnt(const int* p) {
#ifdef CPU_EMU
    return *p;
#else
    return __hip_atomic_load(p, __ATOMIC_RELAXED, __HIP_MEMORY_SCOPE_AGENT);
#endif
}
DI void moe_tiles(const int* counts, int* toff  ) {
    __syncthreads();
    if (threadIdx.x == 0) { int acc = 0; for (int e = 0; e < NEXP; ++e) { toff[e] = acc; acc += (ld_cnt(counts + e) + 255) >> 8; } toff[NEXP] = acc; }
    __syncthreads();
}
DI void phase_moe_up(const Frame& F, int l) {
    const int* counts = (const int*)(F.ws + CTL_CNT) + l * 32;
    int* eoff = (int*)(F.ws + CTL_EOFF) + l * 33;
    int* rowmap = (int*)(F.smem + 131072);
    int* toff = rowmap + 256;
    moe_tiles(counts, toff);
    if (blockIdx.x == 0 && threadIdx.x == 0) for (int e = 0; e <= NEXP; ++e) eoff[e] = toff[e] * 256;
    const int* lists = WSP(int, OFF_LISTS); const bf16* xb = WSP(bf16, OFF_XB);
    const int nunit = toff[NEXP] * 2;
    for (int u = blockIdx.x; u < nunit; u += F.nblk) {
        const int tile = u >> 1, pn = u & 1;
        int e = 0; while (toff[e + 1] <= tile) ++e;
        const int t0 = (tile - toff[e]) * 256, cnt = ld_cnt(counts + e);
        __syncthreads();
        for (int i = fresh_tid(F); i < 256; i += NTH) rowmap[i] = (t0 + i < cnt) ? lists[(size_t)e * NTOK + t0 + i] : 0;
        __syncthreads();
        EpiMoeUp E{WSP(bf16, OFF_HM), tile * 256, pn};
        gemm_unit(F, xb, 1024, rowmap, 0, WSP(bf16, OFF_W13T) + (size_t)e * 512 * 1024, 1024, pn * 256, 1024, E);
    }
}
DI void phase_moe_down(const Frame& F, int l) {
    const int* counts = (const int*)(F.ws + CTL_CNT) + l * 32;
    int* toff = (int*)(F.smem + 131072) + 256;
    moe_tiles(counts, toff);
    const int nunit = toff[NEXP] * 4;
    for (int u = blockIdx.x; u < nunit; u += F.nblk) {
        const int tile = u >> 2, pn = u & 3;
        int e = 0; while (toff[e + 1] <= tile) ++e;
        EpiBf E{WSP(bf16, OFF_YROWS), 1024, tile * 256, pn};
        gemm_unit(F, WSP(bf16, OFF_HM), 256, nullptr, tile * 256, WSP(bf16, OFF_W2T) + (size_t)e * 1024 * 256, 256, pn * 256, 256, E);
    }
}
DI void phase_ln3(const Frame& F, int l) {
#ifndef CPU_EMU
    ln_rows_gpu<2>(F, F.in[40] + l * 1024, F.in[41] + l * 1024, l);
#else
    const float* xf = F.xf; const bf16* yr = WSP(bf16, OFF_YROWS); const float* tinfo = WSP(float, OFF_TINFO);
    const int* eoff = (const int*)(F.ws + CTL_EOFF) + l * 33;
    layer_norm_rows(F, F.in[40] + l * 1024, F.in[41] + l * 1024, [&](int row, int c) {
        const int* ti = (const int*)(tinfo + (size_t)row * 8);
        const size_t ra = (size_t)eoff[ti[0]] + ti[1], rb = (size_t)eoff[ti[2]] + ti[3];
        return DN_ALPHA * xf[(size_t)row * DM + c] + tinfo[(size_t)row * 8 + 4] * bf2f(yr[ra * 1024 + c]) + tinfo[(size_t)row * 8 + 5] * bf2f(yr[rb * 1024 + c]);
    }, false, nullptr);
#endif
}

#ifndef CPU_EMU
#define XB_TMO      128
#define XB_XCNT(j)  (256  + 64 * (j))
#define XB_XSUB(j)  (1280 + 64 * (j))
#define XB_XGEN(j)  (2304 + 64 * (j))
#define XB_TOP      3328
#define XB_TOPGEN   3392
#define XCD_BAR_WORDS 3456
#define XB_SPIN_CAP (1u << 18)
#define LAS __attribute__((address_space(3)))

__device__ __forceinline__ unsigned xb_ld(unsigned* p)              { return __hip_atomic_load(p, __ATOMIC_RELAXED, __HIP_MEMORY_SCOPE_AGENT); }
__device__ __forceinline__ unsigned xb_add(unsigned* p, unsigned v) { return __hip_atomic_fetch_add(p, v, __ATOMIC_RELAXED, __HIP_MEMORY_SCOPE_AGENT); }
__device__ __forceinline__ unsigned xb_xcc_id() { return (unsigned)__builtin_amdgcn_s_getreg((3 << 11) | 20) & 0xFu; }
#define XB_SPIN(cond, bar) do { unsigned _sp = 0; while (cond) { __builtin_amdgcn_s_sleep(1); \
    if ((++_sp & 255u) == 0u) { if (xb_ld(&(bar)[XB_TMO])) break; if (_sp > XB_SPIN_CAP) { atomicAdd(&(bar)[XB_TMO], 1u); break; } } } } while (0)

struct XcdBarrier {
    unsigned* bar; unsigned x;
    volatile LAS unsigned* st;
};

__device__ __forceinline__ XcdBarrier xcd_barrier_post(unsigned* bar, volatile LAS unsigned* st) {
    XcdBarrier b; b.bar = bar; b.x = xb_xcc_id(); b.st = st;
    if (threadIdx.x == 0) (void)xb_add(&bar[XB_XCNT(b.x)], 1u);
    return b;
}
__device__ __forceinline__ void xcd_barrier_complete(unsigned* bar, unsigned x, unsigned& nloc, unsigned& nx) {
    const unsigned G = gridDim.x * gridDim.y * gridDim.z;
    unsigned sum, cnt, mine, sp = 0u;
    for (;;) {
        sum = 0u; cnt = 0u; mine = 0u;
#pragma unroll
        for (unsigned j = 0; j < 16; ++j) { const unsigned c = xb_ld(&bar[XB_XCNT(j)]); sum += c; cnt += (c > 0u) ? 1u : 0u; mine = (j == x) ? c : mine; }
        if (sum == G) break;
        __builtin_amdgcn_s_sleep(1);
        if ((++sp & 255u) == 0u) { if (xb_ld(&bar[XB_TMO])) break; if (sp > XB_SPIN_CAP) { atomicAdd(&bar[XB_TMO], 1u); break; } }
    }
    nloc = mine > 0u ? mine : 1u; nx = cnt > 0u ? cnt : 1u;
}

__device__ __forceinline__ void xcd_barrier(const XcdBarrier& b) {
    asm volatile("s_waitcnt vmcnt(0)" ::: "memory");
    __syncthreads();
    if (threadIdx.x == 0) {
        unsigned* bar = b.bar;
        __builtin_amdgcn_s_waitcnt(0);
        unsigned nloc = b.st[0], nx = b.st[1];
        if (nloc == 0u) { xcd_barrier_complete(bar, b.x, nloc, nx); b.st[0] = nloc; b.st[1] = nx; }
        const unsigned old = xb_add(&bar[XB_XSUB(b.x)], 1u);
        const unsigned gen = old / nloc;
        if (old + 1u == (gen + 1u) * nloc) {
            __builtin_amdgcn_fence(__ATOMIC_RELEASE, "agent");
            asm volatile("s_waitcnt vmcnt(0)" ::: "memory");
            const unsigned og = xb_add(&bar[XB_TOP], 1u);
            const unsigned tg = og / nx;
            if (og + 1u == (tg + 1u) * nx) xb_add(&bar[XB_TOPGEN], 1u);
            else XB_SPIN(xb_ld(&bar[XB_TOPGEN]) == tg, bar);
            __builtin_amdgcn_fence(__ATOMIC_ACQUIRE, "agent");
            xb_add(&bar[XB_XGEN(b.x)], 1u);
            asm volatile("s_waitcnt vmcnt(0)" ::: "memory");
        } else {
            XB_SPIN(xb_ld(&bar[XB_XGEN(b.x)]) == gen, bar);
            __builtin_amdgcn_fence(__ATOMIC_ACQUIRE, "agent");
            asm volatile("s_waitcnt vmcnt(0)" ::: "memory");
        }
    }
    __syncthreads();
}

#endif

constexpr int NPH_LAYER = 16;
constexpr int NPH_TOTAL = 1 + 2 * NPH_LAYER;
constexpr int SMEM_BYTES = 158976 + 1024;

#ifndef CPU_EMU
DI void phase_attn_queue(const Frame& F, int l) {
    {
            const AttnDesc Ag = desc_gqa(F), Am = desc_mla(F);
            const int ng = attn_nunit<64, 64, 64, 2>(Ag), nm = attn_nunit<96, 64, 64, 1>(Am);
            unsigned* qctr = (unsigned*)(F.ws + CTL_QUEUE) + l * 64;
            volatile int* slot = (volatile int*)(F.smem + SMEM_BYTES - 32);
            for (;;) {
                __syncthreads();
                if (fresh_tid(F) == 0) *slot = (int)atomicAdd(qctr, 1u);
                __syncthreads();
                const int u = *slot;
                if (u >= ng + nm) break;
                if (u < ng) attn_unit<64, 64, 64, 2>(F, Ag, u); else attn_unit<96, 64, 64, 1>(F, Am, u - ng);
            }
        }
}
#endif

template <int K>
DI void run_layer_phase(const Frame& F, int l) {
    if constexpr (K == 0) phase_cvt(F, l);
    if constexpr (K == 1) phase_gemm1(F);
    if constexpr (K == 2) phase_prep(F, l);
    if constexpr (K == 3) phase_mlaup(F);
    if constexpr (K == 4) {
#ifdef CPU_EMU
        attn_phase<64, 64>(F, desc_gqa(F)); attn_phase<96, 64>(F, desc_mla(F)); phase_scans(F);
#else
        phase_scans(F);
        phase_attn_queue(F, l);
#endif
    }
#ifdef CPU_EMU
    if constexpr (K == 5) phase_fin(F, l);
#else
    if constexpr (K == 5) phase_fin_gpu(F, l);
#endif
    if constexpr (K == 6) phase_gemm_sq<0>(F, WSP(bf16, OFF_YCAT), W_OUT_T, nullptr);
    if constexpr (K == 7) phase_ln(F, F.in[26] + l * 1024, F.in[27] + l * 1024);
    if constexpr (K == 8) phase_gemm_sq<1>(F, WSP(bf16, OFF_XB), W_Q_T, WSP(bf16, OFF_QMEM));
    if constexpr (K == 9) {
#ifdef CPU_EMU
        attn_phase<256, 256>(F, desc_mem(F));
#else
        attn_phase<256, 256, 128, 1>(F, desc_mem(F));
#endif
    }
    if constexpr (K == 10) phase_gemm_sq<2>(F, WSP(bf16, OFF_OMEM), W_O_T, nullptr);
    if constexpr (K == 11) { phase_ln<true>(F, F.in[31] + l * 1024, F.in[32] + l * 1024); phase_cvt_moe(F, l); }
#ifdef CPU_EMU
    if constexpr (K == 12) phase_route(F, l);
#else
    if constexpr (K == 12) phase_route_gpu(F, l);
#endif
    if constexpr (K == 13) phase_moe_up(F, l);
    if constexpr (K == 14) phase_moe_down(F, l);
    if constexpr (K == 15) phase_ln3(F, l);
}

#ifndef CPU_EMU
template <int K>
__global__ void __launch_bounds__(512, 2) k_phase(Args a, int l) {
    extern __shared__ __attribute__((aligned(16))) unsigned char lds[];
    Frame F; F.in = (InPtr)__builtin_amdgcn_kernarg_segment_ptr(); F.xf = a.out; F.ws = a.ws; F.smem = lds; F.tid = threadIdx.x; F.wv = __builtin_amdgcn_readfirstlane((int)(threadIdx.x >> 6)); F.nblk = a.ph_lo;
    if constexpr (K < 0) phase_pro(F); else run_layer_phase<K>(F, l);
}

template <int K>
static void launch_phase(const Args& a, int l, int grid, hipStream_t stream) {
    static bool attr = false;
    if (!attr) { (void)hipFuncSetAttribute((const void*)k_phase<K>, hipFuncAttributeMaxDynamicSharedMemorySize, SMEM_BYTES); attr = true; }
    hipLaunchKernelGGL(k_phase<K>, dim3(grid), dim3(512), SMEM_BYTES, stream, a, l);
}

__global__ void __launch_bounds__(512, 2) fwd_one(Args a) {
    extern __shared__ __attribute__((aligned(16))) unsigned char lds[];
    const int wave_s = __builtin_amdgcn_readfirstlane((int)(threadIdx.x >> 6));
    volatile LAS unsigned* st = (volatile LAS unsigned*)(lds + SMEM_BYTES - 16);
    if (threadIdx.x == 0) { st[0] = 0u; st[1] = 0u; st[2] = 0u; st[3] = 0u; }
    __syncthreads();
    XcdBarrier bar = xcd_barrier_post((unsigned*)(a.ws + OFF_CTL), st);
    Frame F;
#define FRESH do { unsigned z_ = 0u, m_ = ~0u; int ws_ = wave_s; asm volatile("" : "+s"(z_), "+s"(ws_), "+s"(m_)); \
        int t_ = ws_ * 64 + (int)__builtin_amdgcn_mbcnt_hi(m_, __builtin_amdgcn_mbcnt_lo(m_, 0u)); asm volatile("" : "+v"(t_)); \
        const __attribute__((address_space(4))) char* kp_ = (const __attribute__((address_space(4))) char*)__builtin_amdgcn_kernarg_segment_ptr() + z_; \
        F.in = (InPtr)kp_; F.xf = *(float* const __attribute__((address_space(4)))*)(kp_ + 42 * 8); F.ws = *(unsigned char* const __attribute__((address_space(4)))*)(kp_ + 43 * 8); \
        F.smem = lds; F.tid = t_; F.wv = ws_; F.nblk = *(const int __attribute__((address_space(4)))*)(kp_ + 44 * 8); } while (0)
#define GB do { { unsigned zb_ = 0u; unsigned xx_ = __builtin_amdgcn_readfirstlane(bar.x); asm volatile("" : "+s"(zb_), "+s"(xx_)); bar.bar = (unsigned*)(a.ws + OFF_CTL) + zb_; bar.x = xx_; } \
        xcd_barrier(bar); } while (0)
#define DUP(k) ((PROBE_DUP >> (k)) & 1)
    FRESH; phase_pro(F); FRESH; phase_cvt(F, 0); GB;
    if (DUP(0)) { FRESH; phase_cvt(F, 0); GB; }
    for (int l = 0; l < 2; ++l) {
        FRESH; run_layer_phase<1>(F, l); GB;
        if (DUP(1)) { FRESH; run_layer_phase<1>(F, l); GB; }
        FRESH; run_layer_phase<2>(F, l); GB;
        FRESH; run_layer_phase<3>(F, l); GB;
        if (DUP(3)) { FRESH; run_layer_phase<3>(F, l); GB; }
        if (DUP(4)) { FRESH; attn_phase<64, 64, 64, 2>(F, desc_gqa(F)); attn_phase<96, 64, 64, 1>(F, desc_mla(F)); GB; }
        FRESH; run_layer_phase<4>(F, l); GB;
        FRESH; run_layer_phase<5>(F, l); GB;
        if (DUP(5)) { FRESH; run_layer_phase<5>(F, l); GB; }
        FRESH; run_layer_phase<6>(F, l); GB;
        FRESH; run_layer_phase<7>(F, l); GB;
        FRESH; run_layer_phase<8>(F, l); GB;
        if (DUP(8)) { FRESH; run_layer_phase<8>(F, l); GB; }
        FRESH; run_layer_phase<9>(F, l); GB;
        if (DUP(9)) { FRESH; run_layer_phase<9>(F, l); GB; }
        FRESH; run_layer_phase<10>(F, l); GB;
        FRESH; run_layer_phase<11>(F, l); if (NTOK % (F.nblk * 32) != 0) GB; FRESH; run_layer_phase<12>(F, l); if (l == 0) { FRESH; phase_cvt(F, 1); } GB;
        if (DUP(11)) { FRESH; phase_cvt_moe(F, l); GB; }
        FRESH; run_layer_phase<13>(F, l); GB;
        if (DUP(13)) { FRESH; run_layer_phase<13>(F, l); GB; }
        FRESH; run_layer_phase<14>(F, l); GB;
        if (DUP(14)) { FRESH; run_layer_phase<14>(F, l); GB; }
        FRESH; run_layer_phase<15>(F, l); if (l == 0) GB;
    }
#undef DUP
#undef GB
#undef FRESH
}

extern "C" void kernel_launch(void* const* d_in, const int* in_sizes, int n_in, void* d_out, int out_size, void* d_ws, size_t ws_size, hipStream_t stream) {
    if (n_in != 42 || ws_size < WS_END) return;
    Args a{};
    for (int i = 0; i < 42; ++i) a.in[i] = (const float*)d_in[i];
    a.out = (float*)d_out; a.ws = (unsigned char*)d_ws; a.ph_lo = 0; a.ph_hi = NPH_TOTAL;
    (void)hipMemsetAsync(d_ws, 0, CTL_BYTES, stream);
#if N_LAUNCH_MODE == 1
    static int grid = 0;
    if (!grid) {
        int dev = 0, cus = 0, per_cu = 0;
        (void)hipGetDevice(&dev);
        (void)hipDeviceGetAttribute(&cus, hipDeviceAttributeMultiprocessorCount, dev);
        (void)hipFuncSetAttribute((const void*)fwd_one, hipFuncAttributeMaxDynamicSharedMemorySize, SMEM_BYTES);
        (void)hipOccupancyMaxActiveBlocksPerMultiprocessor(&per_cu, (const void*)fwd_one, 512, SMEM_BYTES);
        (void)hipGetLastError();
        grid = cus > 0 ? cus : 256;
    }
    a.ph_lo = grid;
    hipLaunchKernelGGL(fwd_one, dim3(grid), dim3(512), SMEM_BYTES, stream, a);
#else
    const int grid = 256; a.ph_lo = grid;
    launch_phase<-1>(a, 0, grid, stream);
    for (int l = 0; l < 2; ++l) {
        launch_phase<0>(a, l, grid, stream); launch_phase<1>(a, l, grid, stream); launch_phase<2>(a, l, grid, stream); launch_phase<3>(a, l, grid, stream);
        launch_phase<4>(a, l, grid, stream); launch_phase<5>(a, l, grid, stream); launch_phase<6>(a, l, grid, stream); launch_phase<7>(a, l, grid, stream);
        launch_phase<8>(a, l, grid, stream); launch_phase<9>(a, l, grid, stream); launch_phase<10>(a, l, grid, stream); launch_phase<11>(a, l, grid, stream);
        launch_phase<12>(a, l, grid, stream); launch_phase<13>(a, l, grid, stream); launch_phase<14>(a, l, grid, stream); launch_phase<15>(a, l, grid, stream);
    }
#endif
}
#endif
```

```cpp
#ifndef CPU_EMU
#include <hip/hip_runtime.h>
#else
#include "emu_shim.h"
#endif
#include <stdint.h>

#ifndef CFG_B
#define CFG_B 16
#endif
#ifndef CFG_S
#define CFG_S 2048
#endif
#ifndef PROBE_DUP
#define PROBE_DUP 0
#endif
#ifndef N_LAUNCH_MODE
#define N_LAUNCH_MODE 1
#endif

typedef unsigned short bf16;
#define DI __device__ __forceinline__

constexpr int BATCH = CFG_B, SEQ = CFG_S, NTOK = BATCH * SEQ, DM = 1024;
constexpr int MEMT = 256, NMEM = BATCH * MEMT;
constexpr int GRIDW = 64;
constexpr int HP = 3328;
constexpr int IN_WIDTH = 3104;
constexpr int NEXP = 32, MOEH = 256;
constexpr int MOE_ROWS = 2 * NTOK + NEXP * 256;
constexpr float LN_EPS = 1e-5f, RMS_EPS = 1e-6f, GN_EPS = 64e-5f;
constexpr float DN_ALPHA = 1.41421356237309515f;
constexpr float DECAY_SCALE = 0.60653065971263342f;

constexpr size_t AL(size_t x) { return (x + 255) & ~(size_t)255; }
constexpr size_t OFF_CTL = 0;
constexpr size_t CTL_BYTES = 32768;
constexpr size_t CTL_CNT = 16384;
constexpr size_t CTL_EOFF = 16384 + 1024;
constexpr size_t CTL_QUEUE = 16384 + 2048;
constexpr size_t OFF_XB = AL(OFF_CTL + CTL_BYTES);
constexpr size_t SZ_XB = (size_t)NTOK * DM * 2;
constexpr size_t OFF_WTS = AL(OFF_XB + SZ_XB);
constexpr size_t W_IN_T = 0;
constexpr size_t W_UQ_T = W_IN_T + (size_t)HP * 1024 * 2;
constexpr size_t W_UKV_T = W_UQ_T + 512 * 256 * 2;
constexpr size_t W_OUT_T = W_UKV_T + 512 * 256 * 2;
constexpr size_t W_Q_T = W_OUT_T + 1024 * 1024 * 2;
constexpr size_t W_KV_T = W_Q_T + 1024 * 1024 * 2;
constexpr size_t W_O_T = W_KV_T + 2048 * 1024 * 2;
constexpr size_t W_GATE_T = W_O_T + 1024 * 1024 * 2;
constexpr size_t SZ_WTS = W_GATE_T + 2 * 48 * 1024 * 4;
constexpr size_t OFF_KMEM = AL(OFF_WTS + SZ_WTS);
constexpr size_t OFF_VTMEM = AL(OFF_KMEM + (size_t)NMEM * 1024 * 2);
constexpr size_t OFF_MEMB = AL(OFF_VTMEM + (size_t)NMEM * 1024 * 2);
constexpr size_t OFF_VTATT = AL(OFF_MEMB + (size_t)NMEM * 1024 * 2);
constexpr size_t OFF_VTMLA = AL(OFF_VTATT + (size_t)BATCH * 2 * 64 * SEQ * 2);
constexpr size_t OFF_HATT = AL(OFF_VTMLA + (size_t)BATCH * 4 * 64 * SEQ * 2);
constexpr size_t OFF_HMLA = OFF_HATT + (size_t)NTOK * 512 * 2;
constexpr size_t OFF_HRWKV = OFF_HMLA + (size_t)NTOK * 512 * 2;
constexpr size_t OFF_R7 = OFF_HRWKV + (size_t)NTOK * 1024 * 2;
constexpr size_t SZ_R7 = (size_t)NTOK * 9 * 256 * 2;
constexpr size_t OFF_HHGRN = OFF_R7 + SZ_R7;
constexpr size_t OFF_HX = OFF_HHGRN + (size_t)NTOK * 1280 * 2;
constexpr size_t OFF_HAM = OFF_HX + (size_t)NTOK * 256 * 2;
constexpr size_t OFF_HEG = OFF_HAM + (size_t)(NTOK / 16) * 8 * 256 * 2;
constexpr size_t OFF_REG = OFF_HEG + (size_t)(NTOK / 16) * 8 * 64 * 4;
constexpr size_t WS_END = OFF_REG + (size_t)(NTOK / 16) * 8 * 64 * 2;
static_assert(WS_END <= (size_t)4 * NTOK * DM * 4 || CFG_B != 16, "workspace must fit 4 x the largest tensor");

constexpr size_t OFF_QMLA = OFF_XB;
constexpr size_t OFF_KNOPE = OFF_QMLA + (size_t)NTOK * 384 * 2;
constexpr size_t OFF_KROPE = OFF_KNOPE + (size_t)NTOK * 256 * 2;
constexpr size_t OFF_G = OFF_KROPE + (size_t)NTOK * 32 * 2;
constexpr size_t OFF_BONUS = OFF_G + (size_t)NTOK * 256 * 2;
constexpr size_t OFF_RSIDE = OFF_BONUS + (size_t)NTOK * 16;
static_assert(OFF_RSIDE + (size_t)(NTOK / 16) * 2 * 512 * 2 <= OFF_XB + SZ_XB, "xb alias region");
constexpr size_t OFF_YCAT = OFF_HRWKV;
constexpr size_t OFF_QMEM = OFF_HATT;
constexpr size_t OFF_OMEM = OFF_R7;
#ifdef CPU_EMU
constexpr size_t OFF_EMU_SCAN = WS_END;
constexpr size_t OFF_LISTS = AL(OFF_EMU_SCAN + (size_t)4 * NTOK * 256 * 2);
#else
constexpr size_t OFF_LISTS = OFF_HATT;
#endif
constexpr size_t OFF_TINFO = OFF_LISTS + (size_t)NEXP * NTOK * 4;
constexpr size_t OFF_HM = AL(OFF_TINFO + (size_t)NTOK * 32);
constexpr size_t OFF_YROWS = AL(OFF_HM + (size_t)MOE_ROWS * 256 * 2);
#ifdef CPU_EMU
constexpr size_t OFF_W13T = AL(OFF_YROWS + (size_t)MOE_ROWS * 1024 * 2);
#else
static_assert(OFF_YROWS + (size_t)MOE_ROWS * 1024 * 2 <= OFF_HHGRN, "moe alias region");
constexpr size_t OFF_W13T = OFF_HHGRN;
#endif
constexpr size_t OFF_W2T = OFF_W13T + (size_t)NEXP * 512 * 1024 * 2;
#ifdef CPU_EMU
constexpr size_t WS_END_EMU = OFF_W2T + (size_t)NEXP * 1024 * 256 * 2;
#else
static_assert(OFF_W2T + (size_t)NEXP * 1024 * 256 * 2 <= WS_END, "moe weights alias");
#endif

enum { C_KT0 = 0, C_KT1 = 1, C_RT0 = 2, C_RT1 = 3, C_KK0 = 4, C_KK1 = 5, C_AT0 = 6, C_AT1 = 7, C_VT = 8 };
enum { R_R = 0, R_V = 1, R_KK = 2, R_W0 = 3, R_W1 = 4, R_KD0 = 5, R_KD1 = 6, R_AK0 = 7, R_AK1 = 8 };

DI float bf2f(bf16 v) { union { unsigned u; float f; } x; x.u = (unsigned)v << 16; return x.f; }
DI bf16 f2bf(float f) { union { unsigned u; float f; } x; x.f = f; unsigned u = x.u; u += 0x7fffu + ((u >> 16) & 1u); return (bf16)(u >> 16); }
DI float sigmoidf_(float x) { return 1.0f / (1.0f + expf(-x)); }
DI float siluf_(float x) { return x * sigmoidf_(x); }

#ifdef CPU_EMU
typedef const float* const* InPtr;
#else
typedef const float* const __attribute__((address_space(4)))* InPtr;
#endif
struct Frame {
    InPtr in;
    float* xf;
    unsigned char* ws;
    unsigned char* smem;
    int tid;
    int wv;
    int nblk;
};
#ifdef CPU_EMU
constexpr int NTH = 1;
#else
constexpr int NTH = 512;
#endif
#ifdef CPU_EMU
constexpr int GRP = 1;
DI float grp_sum(const Frame& F, float v) { return v; }
DI int gthreads(const Frame& F) { return 1; }
DI int gtid_(const Frame& F) { return 0; }
DI int wave_item_index(const Frame& F) { return 0; }
#else
constexpr int GRP = 64;
DI float shfl_idx(const Frame& F, float v, int src_lane) { return __builtin_bit_cast(float, __builtin_amdgcn_ds_bpermute(src_lane << 2, __builtin_bit_cast(int, v))); }
DI float shfl_xor(const Frame& F, float v, int mask) {
    unsigned m0 = ~0u; asm volatile("" : "+s"(m0));
    const int lane = (int)__builtin_amdgcn_mbcnt_hi(m0, __builtin_amdgcn_mbcnt_lo(m0, 0u));
    return shfl_idx(F, v, lane ^ mask); }
template <int CTRL> DI float dppf(float x) { return __builtin_bit_cast(float, __builtin_amdgcn_update_dpp(0, __builtin_bit_cast(int, x), CTRL, 0xf, 0xf, true)); }
DI float allsum16(float x) { x += dppf<0xB1>(x); x += dppf<0x4E>(x); x += dppf<0x141>(x); x += dppf<0x140>(x); return x; }
DI float rdlane(float x, int l) { return __builtin_bit_cast(float, __builtin_amdgcn_readlane(__builtin_bit_cast(int, x), l)); }
DI float grp_sum(const Frame& F, float v) { v = allsum16(v); return (rdlane(v, 0) + rdlane(v, 16)) + (rdlane(v, 32) + rdlane(v, 48)); }
DI int gthreads(const Frame& F) { return F.nblk * NTH; }
DI int gtid_(const Frame& F) { return blockIdx.x * NTH + F.tid; }
DI int wave_item_index(const Frame& F) { return (int)(((F.tid >> 6) * F.nblk + blockIdx.x) * 64 + (F.tid & 63)); }
#endif
constexpr int PER64 = 64 / GRP;
constexpr int PERLN = 1024 / GRP;
DI int fresh_tid(const Frame& F) {
#ifdef CPU_EMU
    return 0;
#else
    unsigned m0 = ~0u; asm volatile("" : "+s"(m0));
    int t = F.wv * 64 + (int)__builtin_amdgcn_mbcnt_hi(m0, __builtin_amdgcn_mbcnt_lo(m0, 0u)); asm volatile("" : "+v"(t)); return t;
#endif
}
DI int glane(const Frame& F) { return (int)(F.tid % GRP); }
DI int ggrp(const Frame& F) { return gtid_(F) / GRP; }
DI int ngrp(const Frame& F) { return gthreads(F) / GRP; }

struct Args {
    const float* in[42];
    float* out;
    unsigned char* ws;
    int ph_lo, ph_hi;
};

DI float rope_inv(int f, int nf) { return powf(10000.0f, -(float)f / (float)nf); }

#ifndef CPU_EMU
using bf16x8 = __attribute__((ext_vector_type(8))) short;
using bf16x4 = __attribute__((ext_vector_type(4))) short;
using f32x4 = __attribute__((ext_vector_type(4))) float;
using f32x16 = __attribute__((ext_vector_type(16))) float;
typedef __bf16 bf16v2 __attribute__((ext_vector_type(2)));
typedef float f32v2 __attribute__((ext_vector_type(2)));
DI float bflo(unsigned u) { return __uint_as_float(u << 16); }
DI float bfhi(unsigned u) { return __uint_as_float(u & 0xffff0000u); }
DI unsigned pack_bf16(float lo, float hi) { f32v2 v = {lo, hi}; bf16v2 b = __builtin_convertvector(v, bf16v2); return __builtin_bit_cast(unsigned, b); }

constexpr int G_BM = 256, G_BK = 64, G_HALF = 128, G_HT = G_HALF * G_BK, G_SHM = 8 * G_HT * 2;
DI int g_lds_byte(int r, int c) { int st = (r >> 4) * 2 + (c >> 5), rr = r & 15, cc = c & 31, ob = rr * 64 + cc * 2; return st * 1024 + (ob ^ (((ob >> 9) & 1) << 5)); }
DI void g_stage_rc(int b, int& R, int& C) { int st = b / 1024, sb = b % 1024, swz = sb ^ (((sb >> 9) & 1) << 5); R = (st >> 1) * 16 + swz / 64; C = (st & 1) * 32 + (swz % 64) / 2; }

template <bool GATHER, class Epi>
DI void gemm_unit_t(int wv_in, bf16* shm, const bf16* __restrict__ A, int lda, const int* rowmap, int arow0,
                    const bf16* __restrict__ Bt, int ldb, int bcol0, int K, const Epi& epi) {
#define SA(b, h) (shm + ((b) * 2 + (h)) * G_HT)
#define SB(b, h) (shm + (4 + (b) * 2 + (h)) * G_HT)
#define STAGE_AX(T, P, hf, kt) do { for (int _i = 0; _i < 2; ++_i) { int _b = (T) * 16 + _i * 8192; int _r, _c; g_stage_rc(_b, _r, _c); \
        const long _row = GATHER ? (long)rowmap[(hf) * G_HALF + _r] : (long)(arow0 + (hf) * G_HALF + _r); \
        __builtin_amdgcn_global_load_lds((const unsigned*)(A + _row * lda + (long)(kt) * G_BK + _c), (unsigned*)((char*)(P) + _b), 16, 0, 0); } } while (0)
#define STAGE_BX(T, P, hf, kt) do { for (int _i = 0; _i < 2; ++_i) { int _b = (T) * 16 + _i * 8192; int _r, _c; g_stage_rc(_b, _r, _c); \
        __builtin_amdgcn_global_load_lds((const unsigned*)(Bt + (long)(bcol0 + (hf) * G_HALF + _r) * ldb + (long)(kt) * G_BK + _c), (unsigned*)((char*)(P) + _b), 16, 0, 0); } } while (0)
#define STAGE_A(P, hf, kt) STAGE_AX(t0, P, hf, kt)
#define STAGE_B(P, hf, kt) STAGE_BX(t0, P, hf, kt)
#define LDA(dst, b, h) for (int m = 0; m < 4; ++m) for (int k = 0; k < 2; ++k) \
        dst[m][k] = *reinterpret_cast<const bf16x8*>((char*)SA(b, h) + g_lds_byte(wr * 64 + m * 16 + fr, k * 32 + fq * 8))
#define LDB(dst, b, h) for (int n = 0; n < 2; ++n) for (int k = 0; k < 2; ++k) \
        dst[n][k] = *reinterpret_cast<const bf16x8*>((char*)SB(b, h) + g_lds_byte(wc * 32 + n * 16 + fr, k * 32 + fq * 8))
#define MMA(ai, bj, At, Bt_) do { __builtin_amdgcn_s_setprio(1); \
        for (int m = 0; m < 4; ++m) for (int n = 0; n < 2; ++n) for (int k = 0; k < 2; ++k) \
            acc[ai][bj][m][n] = __builtin_amdgcn_mfma_f32_16x16x32_bf16(Bt_[n][k], At[m][k], acc[ai][bj][m][n], 0, 0, 0); \
        __builtin_amdgcn_s_setprio(0); } while (0)
#define WAIT_V(n) asm volatile("s_waitcnt vmcnt(" #n ")" ::: "memory")
#define WAIT_L(n) asm volatile("s_waitcnt lgkmcnt(" #n ")" ::: "memory")
#define BAR __builtin_amdgcn_s_barrier()
#define SCHED __builtin_amdgcn_sched_barrier(0)
    unsigned m0 = ~0u; asm volatile("" : "+s"(m0));
    int t0 = wv_in * 64 + (int)__builtin_amdgcn_mbcnt_hi(m0, __builtin_amdgcn_mbcnt_lo(m0, 0u)); asm volatile("" : "+v"(t0));
    int wid = t0 >> 6, lane = t0 & 63, wr = wid >> 2, wc = wid & 3, fr = lane & 15, fq = lane >> 4;
    f32x4 acc[2][2][4][2] = {};
    bf16x8 At[4][2], B0[2][2], B1[2][2];
    const int nt = K / G_BK;
    STAGE_B(SB(0, 0), 0, 0); STAGE_A(SA(0, 0), 0, 0);
    STAGE_B(SB(0, 1), 1, 0); STAGE_A(SA(0, 1), 1, 0);
    if (wr == 1) BAR;
    WAIT_V(4); BAR;
    STAGE_B(SB(1, 0), 0, 1); STAGE_A(SA(1, 0), 0, 1); STAGE_B(SB(1, 1), 1, 1);
    WAIT_V(6); BAR;
    for (int t = 0; t < nt - 2; t += 2) {
        LDB(B0, 0, 0); SCHED; LDA(At, 0, 0); STAGE_A(SA(1, 1), 1, t + 1);
        WAIT_L(8); BAR; WAIT_L(0); MMA(0, 0, At, B0); BAR; SCHED;
        LDB(B1, 0, 1); STAGE_B(SB(0, 0), 0, t + 2);
        BAR; WAIT_L(0); MMA(0, 1, At, B1); BAR;
        LDA(At, 0, 1); STAGE_A(SA(0, 0), 0, t + 2);
        BAR; WAIT_L(0); MMA(1, 0, At, B0); BAR; SCHED;
        STAGE_B(SB(0, 1), 1, t + 2);
        WAIT_V(6); BAR; MMA(1, 1, At, B1); BAR;
        LDB(B0, 1, 0); SCHED; LDA(At, 1, 0); STAGE_A(SA(0, 1), 1, t + 2);
        WAIT_L(8); BAR; WAIT_L(0); MMA(0, 0, At, B0); BAR; SCHED;
        LDB(B1, 1, 1); STAGE_B(SB(1, 0), 0, t + 3);
        BAR; WAIT_L(0); MMA(0, 1, At, B1); BAR;
        LDA(At, 1, 1); STAGE_A(SA(1, 0), 0, t + 3);
        BAR; WAIT_L(0); MMA(1, 0, At, B0); BAR; SCHED;
        STAGE_B(SB(1, 1), 1, t + 3);
        WAIT_V(6); BAR; MMA(1, 1, At, B1); BAR;
    }
    int tz = t0; asm volatile("" : "+v"(tz)); wid = tz >> 6; lane = tz & 63; wr = wid >> 2; wc = wid & 3; fr = lane & 15; fq = lane >> 4;
    { LDB(B0, 0, 0); WAIT_V(0); LDA(At, 0, 0); STAGE_AX(tz, SA(1, 1), 1, nt - 1);
      BAR; WAIT_L(0); MMA(0, 0, At, B0); BAR;
      LDB(B1, 0, 1); BAR; WAIT_L(0); MMA(0, 1, At, B1); BAR;
      LDA(At, 0, 1); WAIT_V(4); BAR; WAIT_L(0); MMA(1, 0, At, B0); MMA(1, 1, At, B1); BAR; }
    { LDB(B0, 1, 0); LDA(At, 1, 0); WAIT_V(2); BAR; WAIT_L(0); MMA(0, 0, At, B0); BAR;
      LDB(B1, 1, 1); WAIT_V(0); BAR; WAIT_L(0); MMA(0, 1, At, B1); BAR;
      LDA(At, 1, 1); BAR; WAIT_L(0); MMA(1, 0, At, B0); MMA(1, 1, At, B1); BAR; }
    if (wr == 0) BAR;
#pragma unroll
    for (int ai = 0; ai < 2; ++ai)
#pragma unroll
        for (int m = 0; m < 4; ++m)
#pragma unroll
            for (int bj = 0; bj < 2; ++bj)
#pragma unroll
                for (int n = 0; n < 2; ++n) {
                    const f32x4 v = acc[ai][bj][m][n];
                    epi(ai * G_HALF + wr * 64 + m * 16 + fr, bj * G_HALF + wc * 32 + n * 16 + fq * 4, v[0], v[1], v[2], v[3]);
                }
#undef SA
#undef SB
#undef STAGE_A
#undef STAGE_B
#undef STAGE_AX
#undef STAGE_BX
#undef LDA
#undef LDB
#undef MMA
}
template <class Epi>
DI void gemm_unit(const Frame& F, const bf16* __restrict__ A, int lda, const int* rowmap, int arow0,
                  const bf16* __restrict__ Bt, int ldb, int bcol0, int K, const Epi& epi) {
    if (rowmap) gemm_unit_t<true>(F.wv, (bf16*)F.smem, A, lda, rowmap, arow0, Bt, ldb, bcol0, K, epi);
    else gemm_unit_t<false>(F.wv, (bf16*)F.smem, A, lda, rowmap, arow0, Bt, ldb, bcol0, K, epi);
}
#else
template <class Epi>
void gemm_unit(const Frame& F, const bf16* A, int lda, const int* rowmap, int arow0, const bf16* Bt, int ldb, int bcol0, int K, const Epi& epi, int mrows = 256) {
    for (int r = 0; r < mrows; ++r) {
        int arow = rowmap ? rowmap[r] : arow0 + r;
        for (int c = 0; c < 256; c += 4) {
            float v[4];
            for (int q = 0; q < 4; ++q) {
                double s = 0; const bf16* a = A + (long)arow * lda; const bf16* b = Bt + (long)(bcol0 + c + q) * ldb;
                for (int k = 0; k < K; ++k) s += (double)bf2f(a[k]) * bf2f(b[k]);
                v[q] = (float)s;
            }
            epi(r, c, v[0], v[1], v[2], v[3]);
        }
    }
}
#endif

DI void st_bf16x4(bf16* p, float a, float b, float c, float d) {
#ifndef CPU_EMU
    uint2 u; u.x = pack_bf16(a, b); u.y = pack_bf16(c, d); *reinterpret_cast<uint2*>(p) = u;
#else
    p[0] = f2bf(a); p[1] = f2bf(b); p[2] = f2bf(c); p[3] = f2bf(d);
#endif
}

#define WSP(T, off) ((T*)(F.ws + (off)))

DI void ln_row_write(float* xrow, bf16* brow, const float* vals_in  , const float* g, const float* b);

template <class Fn>
DI void layer_norm_rows(const Frame& F, const float* g, const float* b, Fn pre, bool write_out_extra, float* extra) {
    float* xf = F.xf; bf16* xb = WSP(bf16, OFF_XB);
    for (int row = ggrp(F); row < NTOK; row += ngrp(F)) {
        float v[PERLN]; float s = 0.f;
        for (int i = 0; i < PERLN; ++i) { int c = glane(F) + i * GRP; v[i] = pre(row, c); s += v[i]; }
        s = grp_sum(F, s); const float mu = s * (1.0f / 1024.0f);
        float q = 0.f;
        for (int i = 0; i < PERLN; ++i) { float d = v[i] - mu; q += d * d; }
        q = grp_sum(F, q); const float rs = 1.0f / sqrtf(q * (1.0f / 1024.0f) + LN_EPS);
        for (int i = 0; i < PERLN; ++i) { int c = glane(F) + i * GRP; float y = (v[i] - mu) * rs * g[c] + b[c];
            xf[(size_t)row * DM + c] = y; xb[(size_t)row * DM + c] = f2bf(y); if (write_out_extra) extra[(size_t)row * DM + c] = y; }
    }
}

#ifndef CPU_EMU
template <int MODE, bool BLOCKED = false, bool WXF = true>
DI void ln_rows_gpu(const Frame& F, const float* __restrict__ g, const float* __restrict__ b, int l) {
    float* xf = F.xf; bf16* xb = WSP(bf16, OFF_XB);
    const float* xin = F.in[0];
    const bf16* yr = WSP(bf16, OFF_YROWS); const float* tinfo = WSP(float, OFF_TINFO);
    const int* eoff = (const int*)(F.ws + CTL_EOFF) + l * 33;
    const int tid = F.tid, wave = tid >> 6, lane = tid & 63;
    float4 gv[4], bv[4];
#pragma unroll
    for (int i = 0; i < 4; ++i) { gv[i] = *reinterpret_cast<const float4*>(g + lane * 4 + 256 * i); bv[i] = *reinterpret_cast<const float4*>(b + lane * 4 + 256 * i); }
    const bool blk_ok = BLOCKED && (NTOK % (F.nblk * 32) == 0);
    const int rpb = NTOK / F.nblk;
    const int r_first = blk_ok ? blockIdx.x * rpb + wave * 4 : (blockIdx.x * 8 + wave) * 4;
    const int r_end = blk_ok ? (blockIdx.x + 1) * rpb : NTOK;
    const int r_step = blk_ok ? 32 : F.nblk * 32;
    unsigned nra[4] = {0u, 0u, 0u, 0u}, nrb[4] = {0u, 0u, 0u, 0u}; float ng0[4] = {0.f, 0.f, 0.f, 0.f}, ng1[4] = {0.f, 0.f, 0.f, 0.f};
#define LN_META(r0_) do { if (MODE == 2) { _Pragma("unroll") for (int rr_ = 0; rr_ < 4; ++rr_) { const size_t row_ = (size_t)(r0_) + rr_; \
        const int4 ti_ = *reinterpret_cast<const int4*>(tinfo + row_ * 8); const float2 tg_ = *reinterpret_cast<const float2*>(tinfo + row_ * 8 + 4); \
        nra[rr_] = (unsigned)(eoff[ti_.x] + ti_.y); nrb[rr_] = (unsigned)(eoff[ti_.z] + ti_.w); ng0[rr_] = tg_.x; ng1[rr_] = tg_.y; } } } while (0)
    if (r_first < r_end) LN_META(r_first);
    for (int r0 = r_first; r0 < r_end; r0 += r_step) {
        float4 v[4][4];
        unsigned cra[4], crb[4]; float cg0[4], cg1[4];
#pragma unroll
        for (int rr = 0; rr < 4; ++rr) { cra[rr] = nra[rr]; crb[rr] = nrb[rr]; cg0[rr] = ng0[rr]; cg1[rr] = ng1[rr]; }
        if (r0 + r_step < r_end) LN_META(r0 + r_step);
#pragma unroll
        for (int rr = 0; rr < 4; ++rr) {
            const size_t row = r0 + rr;
            if (MODE == 2) {
                const size_t ra = cra[rr], rb = crb[rr];
                const float g0 = cg0[rr], g1 = cg1[rr];
#pragma unroll
                for (int i = 0; i < 4; ++i) {
                    const int c = lane * 4 + 256 * i;
                    const uint2 xq = *reinterpret_cast<const uint2*>(xb + row * DM + c);
                    float4 x; x.x = bflo(xq.x); x.y = bfhi(xq.x); x.z = bflo(xq.y); x.w = bfhi(xq.y);
                    const uint2 ya = *reinterpret_cast<const uint2*>(yr + ra * 1024 + c), yb = *reinterpret_cast<const uint2*>(yr + rb * 1024 + c);
                    v[rr][i].x = DN_ALPHA * x.x + g0 * bflo(ya.x) + g1 * bflo(yb.x); v[rr][i].y = DN_ALPHA * x.y + g0 * bfhi(ya.x) + g1 * bfhi(yb.x);
                    v[rr][i].z = DN_ALPHA * x.z + g0 * bflo(ya.y) + g1 * bflo(yb.y); v[rr][i].w = DN_ALPHA * x.w + g0 * bfhi(ya.y) + g1 * bfhi(yb.y);
                }
            } else if (MODE == 0) {
#pragma unroll
                for (int i = 0; i < 4; ++i) {
                    const uint2 xq = *reinterpret_cast<const uint2*>(xb + row * DM + lane * 4 + 256 * i);
                    v[rr][i].x = bflo(xq.x); v[rr][i].y = bfhi(xq.x); v[rr][i].z = bflo(xq.y); v[rr][i].w = bfhi(xq.y);
                }
            } else {
                const float* src = xin + row * DM;
#pragma unroll
                for (int i = 0; i < 4; ++i) v[rr][i] = *reinterpret_cast<const float4*>(src + lane * 4 + 256 * i);
            }
        }
#pragma unroll
        for (int rr = 0; rr < 4; ++rr) {
            const size_t row = r0 + rr;
            float s = 0.f;
#pragma unroll
            for (int i = 0; i < 4; ++i) s += (v[rr][i].x + v[rr][i].y) + (v[rr][i].z + v[rr][i].w);
            const float mu = grp_sum(F, s) * (1.0f / 1024.0f);
            float q = 0.f;
#pragma unroll
            for (int i = 0; i < 4; ++i) { const float d0 = v[rr][i].x - mu, d1 = v[rr][i].y - mu, d2 = v[rr][i].z - mu, d3 = v[rr][i].w - mu; q += (d0 * d0 + d1 * d1) + (d2 * d2 + d3 * d3); }
            const float rs = 1.0f / sqrtf(grp_sum(F, q) * (1.0f / 1024.0f) + LN_EPS);
#pragma unroll
            for (int i = 0; i < 4; ++i) {
                const int c = lane * 4 + 256 * i;
                float4 y; y.x = (v[rr][i].x - mu) * rs * gv[i].x + bv[i].x; y.y = (v[rr][i].y - mu) * rs * gv[i].y + bv[i].y;
                y.z = (v[rr][i].z - mu) * rs * gv[i].z + bv[i].z; y.w = (v[rr][i].w - mu) * rs * gv[i].w + bv[i].w;
                if (WXF) *reinterpret_cast<float4*>(xf + row * DM + c) = y;
                *reinterpret_cast<uint2*>(xb + row * DM + c) = make_uint2(pack_bf16(y.x, y.y), pack_bf16(y.z, y.w));
            }
        }
    }
#undef LN_META
}
#endif

DI void phase_pro(const Frame& F) {
    const float* x = F.in[0]; const float* mem = F.in[1];
#ifdef CPU_EMU
    layer_norm_rows(F, F.in[2], F.in[3], [&](int row, int c) { return x[(size_t)row * DM + c]; }, false, nullptr);
#else
    (void)x; ln_rows_gpu<1>(F, F.in[2], F.in[3], 0);
#endif
    bf16* memb = WSP(bf16, OFF_MEMB);
    for (size_t i = gtid_(F); i < (size_t)NMEM * DM; i += gthreads(F)) memb[i] = f2bf(mem[i]);
}

template <class Src>
DI void cvt_tile(const Frame& F, bf16* dst, int Kk, int n0, int k0, Src src) {
#ifndef CPU_EMU
    float* tile = (float*)F.smem;
    __syncthreads();
    for (int i = F.tid; i < 4096; i += NTH) { int k = i >> 6, n = i & 63; tile[k * 65 + n] = src(k0 + k, n0 + n); }
    __syncthreads();
    for (int i = F.tid; i < 2048; i += NTH) { int n = i >> 5, k = (i & 31) * 2;
        *reinterpret_cast<unsigned*>(dst + (size_t)(n0 + n) * Kk + k0 + k) = pack_bf16(tile[k * 65 + n], tile[(k + 1) * 65 + n]); }
#endif
}
template <class Src>
DI void cvt_transpose(const Frame& F, bf16* dst, int Nn, int Kk, Src src, int t_first, int t_total) {
#ifdef CPU_EMU
    for (int n = 0; n < Nn; ++n) for (int k = 0; k < Kk; ++k) dst[(size_t)n * Kk + k] = f2bf(src(k, n));
#else
    const int tn = Nn / 64, tk = Kk / 64, ntile = tn * tk;
    int t = (int)blockIdx.x - (t_first % (int)F.nblk); if (t < 0) t += F.nblk;
    for (; t < ntile; t += F.nblk) cvt_tile(F, dst, Kk, (t % tn) * 64, (t / tn) * 64, src);
#endif
}

#ifndef CPU_EMU
template <bool VEC, class CM>
DI void cvt_job(const Frame& F, int& tbase, bf16* dst, int ldd, int Nn, int Kk, int Ksrc, const float* __restrict__ src, int lds, CM cm) {
    const int nw = F.nblk * 8, gw = blockIdx.x * 8 + F.wv;
    const int lane = fresh_tid(F) & 63, kq = lane & 15, nq = lane >> 4;
    const int tk = Kk / 64, T = tk * (Nn / 16);
    int t = gw - (tbase % nw); if (t < 0) t += nw;
    tbase += T;
    for (; t < T; t += nw) {
        const int k = (t % tk) * 64 + 4 * kq, n = (t / tk) * 16 + 4 * nq;
        float4 v[4];
        if (VEC) {
            const int s = cm(n);
#pragma unroll
            for (int i = 0; i < 4; ++i) v[i] = (s >= 0 && k + i < Ksrc) ? *reinterpret_cast<const float4*>(src + (size_t)(k + i) * lds + s) : make_float4(0.f, 0.f, 0.f, 0.f);
        } else {
            const int s0 = cm(n), s1 = cm(n + 1), s2 = cm(n + 2), s3 = cm(n + 3);
#pragma unroll
            for (int i = 0; i < 4; ++i) { const float* row = src + (size_t)(k + i) * lds; const bool ok = k + i < Ksrc;
                v[i].x = (ok && s0 >= 0) ? row[s0] : 0.f; v[i].y = (ok && s1 >= 0) ? row[s1] : 0.f; v[i].z = (ok && s2 >= 0) ? row[s2] : 0.f; v[i].w = (ok && s3 >= 0) ? row[s3] : 0.f; }
        }
        bf16* d = dst + (size_t)n * ldd + k;
        *reinterpret_cast<uint2*>(d) = make_uint2(pack_bf16(v[0].x, v[1].x), pack_bf16(v[2].x, v[3].x));
        *reinterpret_cast<uint2*>(d + ldd) = make_uint2(pack_bf16(v[0].y, v[1].y), pack_bf16(v[2].y, v[3].y));
        *reinterpret_cast<uint2*>(d + 2 * (size_t)ldd) = make_uint2(pack_bf16(v[0].z, v[1].z), pack_bf16(v[2].z, v[3].z));
        *reinterpret_cast<uint2*>(d + 3 * (size_t)ldd) = make_uint2(pack_bf16(v[0].w, v[1].w), pack_bf16(v[2].w, v[3].w));
    }
}
#endif

DI int win_src_col(int n) {
    if (n < 512) return n;
    if (n < 1536) { int c = n - 512; return c < 960 ? 512 + c : -1; }
    if (n < 2816) return 1472 + (n - 1536);
    int c = n - 2816;
    if (c < 192) return 2752 + c;
    if (c < 224) return 2752 + 320 + (c - 192);
    if (c < 256) return -1;
    if (c < 384) return 2752 + 192 + (c - 256);
    return -1;
}
DI int wuq_src_col(int n) {
    if (n >= 384) return -1;
    int h = n / 96, w = n % 96;
    if (w < 64) return h * 96 + w;
    int p = w - 64, m = p >> 1, which = p & 1;
    int i = (m < 8 ? m : 16 + (m - 8)) + (which ? 8 : 0);
    return h * 96 + 64 + i;
}

DI void phase_cvt(const Frame& F, int l) {
    bf16* wts = WSP(bf16, OFF_WTS);
#ifndef CPU_EMU
    {
        int tb = 0;
        auto ident = [](int n) { return n; };
        cvt_job<true>(F, tb, (bf16*)((char*)wts + W_IN_T), 1024, HP, 1024, 1024, F.in[4] + (size_t)l * 1024 * IN_WIDTH, IN_WIDTH, [](int n) { return win_src_col(n); });
        cvt_job<false>(F, tb, (bf16*)((char*)wts + W_UQ_T), 256, 512, 256, 192, F.in[23] + (size_t)l * 192 * 384, 384, [](int n) { return wuq_src_col(n); });
        cvt_job<true>(F, tb, (bf16*)((char*)wts + W_UKV_T), 256, 512, 256, 128, F.in[24] + (size_t)l * 128 * 512, 512, ident);
        cvt_job<true>(F, tb, (bf16*)((char*)wts + W_OUT_T), 1024, 1024, 1024, 1024, F.in[25] + (size_t)l * 1024 * 1024, 1024, ident);
        cvt_job<true>(F, tb, (bf16*)((char*)wts + W_Q_T), 1024, 1024, 1024, 1024, F.in[28] + (size_t)l * 1024 * 1024, 1024, ident);
        cvt_job<true>(F, tb, (bf16*)((char*)wts + W_KV_T), 1024, 2048, 1024, 1024, F.in[29] + (size_t)l * 1024 * 2048, 2048, ident);
        cvt_job<true>(F, tb, (bf16*)((char*)wts + W_O_T), 1024, 1024, 1024, 1024, F.in[30] + (size_t)l * 1024 * 1024, 1024, ident);
        const float* wg = F.in[33] + (size_t)l * 1024 * 4; const float* we = F.in[35] + (size_t)l * 1024 * 32; float* gt = (float*)((char*)wts + W_GATE_T) + (size_t)l * 48 * 1024;
        for (int i = gtid_(F); i < 48 * 1024; i += gthreads(F)) { const int col = i >> 10, k = i & 1023; gt[i] = col < 4 ? wg[k * 4 + col] : col < 36 ? we[k * 32 + col - 4] : 0.f; }
        return;
    }
#endif
    constexpr int T0 = 0, T1 = T0 + (HP / 64) * 16, T2 = T1 + 8 * 4, T3 = T2 + 8 * 4, T4 = T3 + 256, T5 = T4 + 256, T6 = T5 + 512, TT = T6 + 256;
    { const float* w = F.in[4] + (size_t)l * 1024 * IN_WIDTH;
      cvt_transpose(F, (bf16*)((char*)wts + W_IN_T), HP, 1024, [&](int k, int n) { int s = win_src_col(n); return s < 0 ? 0.f : w[(size_t)k * IN_WIDTH + s]; }, T0, TT); }
    { const float* w = F.in[23] + (size_t)l * 192 * 384;
      cvt_transpose(F, (bf16*)((char*)wts + W_UQ_T), 512, 256, [&](int k, int n) { int s = wuq_src_col(n); return (s < 0 || k >= 192) ? 0.f : w[(size_t)k * 384 + s]; }, T1, TT); }
    { const float* w = F.in[24] + (size_t)l * 128 * 512;
      cvt_transpose(F, (bf16*)((char*)wts + W_UKV_T), 512, 256, [&](int k, int n) { return k >= 128 ? 0.f : w[(size_t)k * 512 + n]; }, T2, TT); }
    { const float* w = F.in[25] + (size_t)l * 1024 * 1024;
      cvt_transpose(F, (bf16*)((char*)wts + W_OUT_T), 1024, 1024, [&](int k, int n) { return w[(size_t)k * 1024 + n]; }, T3, TT); }
    { const float* w = F.in[28] + (size_t)l * 1024 * 1024;
      cvt_transpose(F, (bf16*)((char*)wts + W_Q_T), 1024, 1024, [&](int k, int n) { return w[(size_t)k * 1024 + n]; }, T4, TT); }
    { const float* w = F.in[29] + (size_t)l * 1024 * 2048;
      cvt_transpose(F, (bf16*)((char*)wts + W_KV_T), 2048, 1024, [&](int k, int n) { return w[(size_t)k * 2048 + n]; }, T5, TT); }
    { const float* w = F.in[30] + (size_t)l * 1024 * 1024;
      cvt_transpose(F, (bf16*)((char*)wts + W_O_T), 1024, 1024, [&](int k, int n) { return w[(size_t)k * 1024 + n]; }, T6, TT); }
#ifndef CPU_EMU
    { const float* wg = F.in[33] + (size_t)l * 1024 * 4; const float* we = F.in[35] + (size_t)l * 1024 * 32; float* gt = (float*)((char*)wts + W_GATE_T) + (size_t)l * 48 * 1024;
      for (int i = gtid_(F); i < 48 * 1024; i += gthreads(F)) { const int col = i >> 10, k = i & 1023;
          gt[i] = col < 4 ? wg[k * 4 + col] : col < 36 ? we[k * 32 + col - 4] : 0.f; } }
#endif
}

DI void phase_cvt_moe(const Frame& F, int l) {
#ifdef CPU_EMU
    for (int e = 0; e < NEXP; ++e) {
        const float* w1 = F.in[37] + ((size_t)l * NEXP + e) * 1024 * 256;
        const float* w3 = F.in[38] + ((size_t)l * NEXP + e) * 1024 * 256;
        const float* w2 = F.in[39] + ((size_t)l * NEXP + e) * 256 * 1024;
        cvt_transpose(F, WSP(bf16, OFF_W13T) + (size_t)e * 512 * 1024, 512, 1024,
                      [&](int k, int n) { return (n & 1) ? w3[(size_t)k * 256 + (n >> 1)] : w1[(size_t)k * 256 + (n >> 1)]; }, 0, 1);
        cvt_transpose(F, WSP(bf16, OFF_W2T) + (size_t)e * 1024 * 256, 1024, 256, [&](int k, int n) { return w2[(size_t)k * 1024 + n]; }, 0, 1);
    }
#else
    {
        int tb = 0;
        auto ident = [](int n) { return n; };
        for (int e = 0; e < NEXP; ++e) {
            const float* w1 = F.in[37] + ((size_t)l * NEXP + e) * 1024 * 256; const float* w3 = F.in[38] + ((size_t)l * NEXP + e) * 1024 * 256; const float* w2 = F.in[39] + ((size_t)l * NEXP + e) * 256 * 1024;
            bf16* d13 = WSP(bf16, OFF_W13T) + (size_t)e * 512 * 1024;
            cvt_job<true>(F, tb, d13, 2048, 256, 1024, 1024, w1, 256, ident);
            cvt_job<true>(F, tb, d13 + 1024, 2048, 256, 1024, 1024, w3, 256, ident);
            cvt_job<true>(F, tb, WSP(bf16, OFF_W2T) + (size_t)e * 1024 * 256, 256, 1024, 256, 256, w2, 1024, ident);
        }
    }
#endif
}

struct EpiH {
    bf16* hatt; bf16* hrwkv; bf16* hhgrn; bf16* hmla; int row0, pn;
    DI void operator()(int r, int c, float a, float b, float cc, float d) const {
        const size_t row = row0 + r;
        bf16* p;
        if (pn < 2) p = hatt + row * 512 + pn * 256 + c;
        else if (pn < 6) p = hrwkv + row * 1024 + (pn - 2) * 256 + c;
        else if (pn < 11) p = hhgrn + row * 1280 + (pn - 6) * 256 + c;
        else p = hmla + row * 512 + (pn - 11) * 256 + c;
        st_bf16x4(p, a, b, cc, d);
    }
};
struct EpiKV {
    bf16* kmem; bf16* vt; int row0, pn;
    DI void operator()(int r, int c, float a, float b, float cc, float d) const {
        const int row = row0 + r, col = pn * 256 + c;
        if (col < 1024) { st_bf16x4(kmem + (size_t)row * 1024 + col, a, b, cc, d); }
        else { const int bb = row / MEMT, key = row % MEMT, hc = col - 1024;
            bf16* p = vt + ((size_t)bb * 1024 + hc) * MEMT + key;
            p[0] = f2bf(a); p[MEMT] = f2bf(b); p[2 * MEMT] = f2bf(cc); p[3 * MEMT] = f2bf(d); }
    }
};

DI void phase_gemm1(const Frame& F) {
    const bf16* xb = WSP(bf16, OFF_XB); const bf16* wts = WSP(bf16, OFF_WTS);
    const int nM = (NTOK + 255) / 256, nN = HP / 256, n1 = nM * nN;
    const int nMk = (NMEM + 255) / 256, nNk = 8, n2 = nMk * nNk;
    for (int u = blockIdx.x; u < n1 + n2; u += F.nblk) {
        if (u < n1) {
            const int pm = u / nN, pn = u % nN;
            EpiH E{WSP(bf16, OFF_HATT), WSP(bf16, OFF_HRWKV), WSP(bf16, OFF_HHGRN), WSP(bf16, OFF_HMLA), pm * 256, pn};
#ifdef CPU_EMU
            gemm_unit(F, xb, 1024, nullptr, pm * 256, (const bf16*)((const char*)wts + W_IN_T), 1024, pn * 256, 1024, E, min(256, NTOK - pm * 256));
#else
            gemm_unit(F, xb, 1024, nullptr, pm * 256, (const bf16*)((const char*)wts + W_IN_T), 1024, pn * 256, 1024, E);
#endif
        } else {
            const int v = u - n1, pm = v / nNk, pn = v % nNk;
            EpiKV E{WSP(bf16, OFF_KMEM), WSP(bf16, OFF_VTMEM), pm * 256, pn};
            gemm_unit(F, WSP(bf16, OFF_MEMB), 1024, nullptr, pm * 256, (const bf16*)((const char*)wts + W_KV_T), 1024, pn * 256, 1024, E);
        }
    }
}


#ifndef CPU_EMU
DI float fast_sigmoid(float x) { return 1.0f / (1.0f + __expf(-x)); }
DI float fast_tanh(float x) { const float e = __expf(2.0f * x); return 1.0f - 2.0f / (e + 1.0f); }

DI void prep_attn_gpu(const Frame& F, int l) {
    float* tabA = (float*)F.smem;
    float* tabB = tabA + 2048;
    float* gq = tabB + 1024;
    __syncthreads();
    { const int tid = fresh_tid(F);
    for (int i = tid; i < 1024; i += NTH) { const int pos = i >> 4, f = i & 15; const float ang = (float)pos * rope_inv(2 * f, 32); tabA[i] = cosf(ang); tabA[1024 + i] = sinf(ang); }
    for (int i = tid; i < 512; i += NTH) { const int pos = i >> 3, f = i & 7; const float ang = (float)pos * rope_inv(2 * f, 16); tabB[i] = cosf(ang); tabB[512 + i] = sinf(ang); }
    for (int i = tid; i < 448; i += NTH) gq[i] = i < 64 ? F.in[5][l * 64 + i] : i < 128 ? F.in[6][l * 64 + i - 64] : i < 320 ? F.in[21][l * 192 + i - 128] : F.in[22][l * 128 + i - 320]; }
    __syncthreads();
    bf16* hatt = WSP(bf16, OFF_HATT);
    for (int it = blockIdx.x * NTH + fresh_tid(F); it < NTOK * 6; it += gthreads(F)) {
        const int n = it / 6, hh = it % 6, s = n % SEQ, rowp = s / GRIDW, colp = s % GRIDW;
        uint4* p = reinterpret_cast<uint4*>(hatt + (size_t)n * 512 + hh * 64);
        const float* gn = gq + (hh < 4 ? 0 : 64);
        uint4 raw[8];
#pragma unroll
        for (int i = 0; i < 8; ++i) raw[i] = p[i];
        float x[64];
#pragma unroll
        for (int i = 0; i < 8; ++i) { x[8 * i] = bflo(raw[i].x); x[8 * i + 1] = bfhi(raw[i].x); x[8 * i + 2] = bflo(raw[i].y); x[8 * i + 3] = bfhi(raw[i].y);
            x[8 * i + 4] = bflo(raw[i].z); x[8 * i + 5] = bfhi(raw[i].z); x[8 * i + 6] = bflo(raw[i].w); x[8 * i + 7] = bfhi(raw[i].w); }
        float ss = 0.f;
#pragma unroll
        for (int j = 0; j < 64; ++j) ss += x[j] * x[j];
        const float rs = 1.0f / sqrtf(ss * (1.0f / 64.0f) + RMS_EPS);
#pragma unroll
        for (int j = 0; j < 64; ++j) x[j] *= rs * gn[j];
#pragma unroll
        for (int half = 0; half < 2; ++half) {
            const int pos = half ? colp : rowp;
#pragma unroll
            for (int f = 0; f < 16; ++f) {
                const float cs = tabA[pos * 16 + f], sn = tabA[1024 + pos * 16 + f];
                const float x1 = x[half * 32 + f], x2 = x[half * 32 + 16 + f];
                x[half * 32 + f] = x1 * cs - x2 * sn; x[half * 32 + 16 + f] = x1 * sn + x2 * cs;
            }
        }
#pragma unroll
        for (int i = 0; i < 8; ++i) { uint4 o; o.x = pack_bf16(x[8 * i], x[8 * i + 1]); o.y = pack_bf16(x[8 * i + 2], x[8 * i + 3]); o.z = pack_bf16(x[8 * i + 4], x[8 * i + 5]); o.w = pack_bf16(x[8 * i + 6], x[8 * i + 7]); p[i] = o; }
    }
    bf16* hm = WSP(bf16, OFF_HMLA); bf16* kr = WSP(bf16, OFF_KROPE);
    for (int it = blockIdx.x * NTH + fresh_tid(F); it < NTOK * 3; it += gthreads(F)) {
        const int n = it / 3, which = it % 3;
        if (which < 2) {
            const int len = which ? 128 : 192; const float* gn = gq + (which ? 320 : 128);
            uint4* p = reinterpret_cast<uint4*>(hm + (size_t)n * 512 + (which ? 256 : 0));
            float ss = 0.f;
            for (int i = 0; i < len / 8; ++i) { const uint4 r = p[i];
                const float a0 = bflo(r.x), a1 = bfhi(r.x), a2 = bflo(r.y), a3 = bfhi(r.y), a4 = bflo(r.z), a5 = bfhi(r.z), a6 = bflo(r.w), a7 = bfhi(r.w);
                ss += a0 * a0 + a1 * a1 + a2 * a2 + a3 * a3 + a4 * a4 + a5 * a5 + a6 * a6 + a7 * a7; }
            const float rs = 1.0f / sqrtf(ss / (float)len + RMS_EPS);
            for (int i = 0; i < len / 8; ++i) { const uint4 r = p[i]; const float* g = gn + 8 * i; uint4 o;
                o.x = pack_bf16(bflo(r.x) * rs * g[0], bfhi(r.x) * rs * g[1]); o.y = pack_bf16(bflo(r.y) * rs * g[2], bfhi(r.y) * rs * g[3]);
                o.z = pack_bf16(bflo(r.z) * rs * g[4], bfhi(r.z) * rs * g[5]); o.w = pack_bf16(bflo(r.w) * rs * g[6], bfhi(r.w) * rs * g[7]); p[i] = o; }
        } else {
            const int s = n % SEQ, rowp = s / GRIDW, colp = s % GRIDW;
            const uint4* p = reinterpret_cast<const uint4*>(hm + (size_t)n * 512 + 192);
            float x[32];
#pragma unroll
            for (int i = 0; i < 4; ++i) { const uint4 r = p[i]; x[8 * i] = bflo(r.x); x[8 * i + 1] = bfhi(r.x); x[8 * i + 2] = bflo(r.y); x[8 * i + 3] = bfhi(r.y);
                x[8 * i + 4] = bflo(r.z); x[8 * i + 5] = bfhi(r.z); x[8 * i + 6] = bflo(r.w); x[8 * i + 7] = bfhi(r.w); }
            unsigned o[16];
#pragma unroll
            for (int m = 0; m < 16; ++m) {
                const int i1 = m < 8 ? m : 16 + (m - 8), pos = m < 8 ? rowp : colp, f = m & 7;
                const float cs = tabB[pos * 8 + f], sn = tabB[512 + pos * 8 + f];
                o[m] = pack_bf16(x[i1] * cs - x[i1 + 8] * sn, x[i1] * sn + x[i1 + 8] * cs);
            }
            uint4* q = reinterpret_cast<uint4*>(kr + (size_t)n * 32);
#pragma unroll
            for (int i = 0; i < 4; ++i) q[i] = make_uint4(o[4 * i], o[4 * i + 1], o[4 * i + 2], o[4 * i + 3]);
        }
    }
    {
        bf16* vt = WSP(bf16, OFF_VTATT); bf16* tl = (bf16*)(gq + 512);
        for (int tile = blockIdx.x; tile < BATCH * 2 * (SEQ / 64); tile += F.nblk) {
            const int b = tile / (2 * (SEQ / 64)), kv = (tile / (SEQ / 64)) % 2, t0 = (tile % (SEQ / 64)) * 64;
            __syncthreads();
            const int tid = fresh_tid(F);
            { const int t = tid >> 3, part = tid & 7;
              const uint4 r = *reinterpret_cast<const uint4*>(hatt + (size_t)(b * SEQ + t0 + t) * 512 + 384 + kv * 64 + part * 8);
              const unsigned w[4] = {r.x, r.y, r.z, r.w};
#pragma unroll
              for (int i = 0; i < 4; ++i) { tl[(part * 8 + 2 * i) * 72 + t] = (bf16)(w[i] & 0xffffu); tl[(part * 8 + 2 * i + 1) * 72 + t] = (bf16)(w[i] >> 16); } }
            __syncthreads();
            { const int dv = tid >> 3, part = tid & 7;
              *reinterpret_cast<uint4*>(vt + ((size_t)(b * 2 + kv) * 64 + dv) * SEQ + t0 + part * 8) = *reinterpret_cast<const uint4*>(tl + dv * 72 + part * 8); }
        }
    }
}

DI void prep_hgrn_gpu(const Frame& F, int l) {
    bf16* hh = WSP(bf16, OFF_HHGRN); bf16* hx = WSP(bf16, OFF_HX); bf16* ham = WSP(bf16, OFF_HAM); float* heg = WSP(float, OFF_HEG);
    const int tid = F.tid, wave = tid >> 6, lane = tid & 63, x = lane & 15, q = lane >> 4;
    bf16* stg = (bf16*)F.smem + wave * (4 * 16 * 72);
    for (int it = blockIdx.x * 8 + wave; it < (NTOK / 16) * 4; it += F.nblk * 8) {
        const int c = it >> 2, h = it & 3, n0 = c * 16, cj = h * 64 + lane;
        float mlb = 1.0f;
        if (l == 1) { const float a = F.in[19][cj], b = F.in[19][256 + cj]; const float m = fmaxf(a, b); const float ea = __expf(a - m), eb = __expf(b - m); mlb = ea / (ea + eb); }
        float qv[16], k0[16], k1[16], g0[16], g1[16]; bf16 vraw[16];
#pragma unroll
        for (int t = 0; t < 16; ++t) {
            const bf16* row = hh + (size_t)(n0 + t) * 1280 + cj;
            const float xq = bf2f(row[0]), x0 = bf2f(row[256]), x1 = bf2f(row[512]); vraw[t] = row[768];
            qv[t] = xq * fast_sigmoid(xq); k0[t] = mlb * fast_sigmoid(-x0); k1[t] = mlb * fast_sigmoid(-x1);
            g0[t] = __logf(1.0f - k0[t]); g1[t] = __logf(1.0f - k1[t]);
        }
#pragma unroll
        for (int t = 1; t < 16; ++t) { g0[t] += g0[t - 1]; g1[15 - t] += g1[16 - t]; }
        heg[((size_t)it * 2 + 0) * 64 + lane] = __expf(g0[15]); heg[((size_t)it * 2 + 1) * 64 + lane] = __expf(g1[0]);
        unsigned kt0[8], kt1[8], vt[8];
#pragma unroll
        for (int t = 0; t < 16; t += 2) {
            const float e0a = __expf(g0[t]), e0b = __expf(g0[t + 1]), e1a = __expf(g1[t]), e1b = __expf(g1[t + 1]);
            const float q0a = qv[t] * e0a, q0b = qv[t + 1] * e0b, q1a = qv[t] * e1a, q1b = qv[t + 1] * e1b;
            const float ka0 = k0[t] / e0a, kb0 = k0[t + 1] / e0b, ka1 = k1[t] / e1a, kb1 = k1[t + 1] / e1b;
            const bf16 bq0a = f2bf(q0a), bq0b = f2bf(q0b), bq1a = f2bf(q1a), bq1b = f2bf(q1b);
            hh[(size_t)(n0 + t) * 1280 + cj] = bq0a; hh[(size_t)(n0 + t + 1) * 1280 + cj] = bq0b;
            hx[(size_t)(n0 + t) * 256 + cj] = bq1a; hx[(size_t)(n0 + t + 1) * 256 + cj] = bq1b;
            kt0[t >> 1] = pack_bf16(ka0, kb0); kt1[t >> 1] = pack_bf16(ka1, kb1); vt[t >> 1] = (unsigned)vraw[t] | ((unsigned)vraw[t + 1] << 16);
            stg[0 * 1152 + t * 72 + lane] = bq0a; stg[0 * 1152 + (t + 1) * 72 + lane] = bq0b;
            stg[2 * 1152 + t * 72 + lane] = bq1a; stg[2 * 1152 + (t + 1) * 72 + lane] = bq1b;
            stg[1 * 1152 + t * 72 + lane] = (bf16)(kt0[t >> 1] & 0xffffu); stg[1 * 1152 + (t + 1) * 72 + lane] = (bf16)(kt0[t >> 1] >> 16);
            stg[3 * 1152 + t * 72 + lane] = (bf16)(kt1[t >> 1] & 0xffffu); stg[3 * 1152 + (t + 1) * 72 + lane] = (bf16)(kt1[t >> 1] >> 16);
        }
        { bf16* blk = hh + (size_t)(n0 + (lane >> 2)) * 1280 + h * 64 + (lane & 3) * 16;
          *reinterpret_cast<uint4*>(blk + 256) = make_uint4(kt0[0], kt0[1], kt0[2], kt0[3]); *reinterpret_cast<uint4*>(blk + 256 + 8) = make_uint4(kt0[4], kt0[5], kt0[6], kt0[7]);
          *reinterpret_cast<uint4*>(blk + 512) = make_uint4(kt1[0], kt1[1], kt1[2], kt1[3]); *reinterpret_cast<uint4*>(blk + 512 + 8) = make_uint4(kt1[4], kt1[5], kt1[6], kt1[7]);
          *reinterpret_cast<uint4*>(blk + 768) = make_uint4(vt[0], vt[1], vt[2], vt[3]); *reinterpret_cast<uint4*>(blk + 768 + 8) = make_uint4(vt[4], vt[5], vt[6], vt[7]); }
        asm volatile("s_waitcnt lgkmcnt(0)" ::: "memory");
        __builtin_amdgcn_wave_barrier();
#pragma unroll
        for (int d = 0; d < 2; ++d) {
            f32x4 acc = {0.f, 0.f, 0.f, 0.f};
#pragma unroll
            for (int ks = 0; ks < 2; ++ks) {
                const bf16x8 a = *reinterpret_cast<const bf16x8*>(stg + (2 * d) * 1152 + x * 72 + 32 * ks + 8 * q);
                const bf16x8 b = *reinterpret_cast<const bf16x8*>(stg + (2 * d + 1) * 1152 + x * 72 + 32 * ks + 8 * q);
                acc = __builtin_amdgcn_mfma_f32_16x16x32_bf16(a, b, acc, 0, 0, 0);
            }
            bf16* am = ham + ((size_t)it * 2 + d) * 256;
#pragma unroll
            for (int r = 0; r < 4; ++r) { const int t = 4 * q + r; const bool keep = d ? (x >= t) : (x <= t); am[t * 16 + x] = f2bf(keep ? acc[r] : 0.f); }
        }
        __builtin_amdgcn_wave_barrier();
    }
}

DI void scan_hgrn_chunk(const Frame& F, int chain) {
    const int d = chain / (BATCH * 4), b = (chain / 4) % BATCH, h = chain % 4;
    const int lane = fresh_tid(F) & 63, x = lane & 15, q = lane >> 4;
    bf16* hh = WSP(bf16, OFF_HHGRN); const bf16* hx = WSP(bf16, OFF_HX); const bf16* ham = WSP(bf16, OFF_HAM); const float* heg = WSP(float, OFF_HEG);
    f32x4 S[4][4];
#pragma unroll
    for (int a = 0; a < 4; ++a)
#pragma unroll
        for (int c = 0; c < 4; ++c) S[a][c] = (f32x4){0.f, 0.f, 0.f, 0.f};
    constexpr int NCH = SEQ / 16;
    uint2 nQ[4], nA, nK[4], nV[4]; float4 nE[4];
    const unsigned lq = (unsigned)(x * (d ? 256 : 1280) + h * 64 + 4 * q);
    const unsigned lb = (unsigned)((x >> 2) * 1280 + h * 64 + (x & 3) * 16 + 4 * q);
    const unsigned la = (unsigned)(x * 16 + 4 * q), le = (unsigned)(4 * q), lo = (unsigned)(4 * q * 1280 + x);
#define HG_LOAD(cc_) do { const int c_ = d ? NCH - 1 - (cc_) : (cc_); const unsigned n0_ = (unsigned)(b * SEQ + 16 * c_); const unsigned it_ = (n0_ >> 4) * 4 + h; \
        const bf16* qb_ = d ? hx + (size_t)n0_ * 256 : hh + (size_t)n0_ * 1280; const bf16* hb_ = hh + (size_t)n0_ * 1280; \
        const bf16* ab_ = ham + (size_t)(it_ * 2 + d) * 256; const float* eb_ = heg + (size_t)(it_ * 2 + d) * 64; \
        _Pragma("unroll") for (int u_ = 0; u_ < 4; ++u_) nQ[u_] = *reinterpret_cast<const uint2*>(qb_ + lq + 16 * u_); \
        nA = *reinterpret_cast<const uint2*>(ab_ + la); \
        _Pragma("unroll") for (int u_ = 0; u_ < 4; ++u_) { \
            nK[u_] = *reinterpret_cast<const uint2*>(hb_ + lb + (4 * u_) * 1280 + 256 + d * 256); nV[u_] = *reinterpret_cast<const uint2*>(hb_ + lb + (4 * u_) * 1280 + 768); \
            nE[u_] = *reinterpret_cast<const float4*>(eb_ + le + 16 * u_); } } while (0)
    HG_LOAD(0);
    for (int cc = 0; cc < NCH; ++cc) {
        uint2 cQ[4], cA, cK[4], cV[4]; float4 cE[4];
#pragma unroll
        for (int u = 0; u < 4; ++u) { cQ[u] = nQ[u]; cK[u] = nK[u]; cV[u] = nV[u]; cE[u] = nE[u]; }
        cA = nA;
        if (cc + 1 < NCH) HG_LOAD(cc + 1);
        const int c = d ? NCH - 1 - cc : cc; const size_t n0 = (size_t)b * SEQ + 16 * c;
        union Fr { bf16x8 v; unsigned u[4]; };
        Fr aq0, aq1, aA; aq0.u[0] = cQ[0].x; aq0.u[1] = cQ[0].y; aq0.u[2] = cQ[1].x; aq0.u[3] = cQ[1].y;
        aq1.u[0] = cQ[2].x; aq1.u[1] = cQ[2].y; aq1.u[2] = cQ[3].x; aq1.u[3] = cQ[3].y;
        aA.u[0] = cA.x; aA.u[1] = cA.y; aA.u[2] = 0u; aA.u[3] = 0u;
#pragma unroll
        for (int it = 0; it < 4; ++it) {
            Fr bS0, bS1, bV;
            bS0.u[0] = pack_bf16(S[0][it][0], S[0][it][1]); bS0.u[1] = pack_bf16(S[0][it][2], S[0][it][3]); bS0.u[2] = pack_bf16(S[1][it][0], S[1][it][1]); bS0.u[3] = pack_bf16(S[1][it][2], S[1][it][3]);
            bS1.u[0] = pack_bf16(S[2][it][0], S[2][it][1]); bS1.u[1] = pack_bf16(S[2][it][2], S[2][it][3]); bS1.u[2] = pack_bf16(S[3][it][0], S[3][it][1]); bS1.u[3] = pack_bf16(S[3][it][2], S[3][it][3]);
            bV.u[0] = cV[it].x; bV.u[1] = cV[it].y; bV.u[2] = 0u; bV.u[3] = 0u;
            f32x4 O = {0.f, 0.f, 0.f, 0.f};
            O = __builtin_amdgcn_mfma_f32_16x16x32_bf16(aq0.v, bS0.v, O, 0, 0, 0);
            O = __builtin_amdgcn_mfma_f32_16x16x32_bf16(aq1.v, bS1.v, O, 0, 0, 0);
            O = __builtin_amdgcn_mfma_f32_16x16x32_bf16(aA.v, bV.v, O, 0, 0, 0);
            bf16* od = hh + n0 * 1280 + 256 + d * 256 + h * 64 + 16 * it;
#pragma unroll
            for (int r = 0; r < 4; ++r) od[lo + (unsigned)(r * 1280)] = f2bf(O[r]);
#pragma unroll
            for (int jt = 0; jt < 4; ++jt) {
                Fr aK; aK.u[0] = cK[jt].x; aK.u[1] = cK[jt].y; aK.u[2] = 0u; aK.u[3] = 0u;
                f32x4 t = __builtin_amdgcn_mfma_f32_16x16x32_bf16(aK.v, bV.v, S[jt][it], 0, 0, 0);
                t[0] *= cE[jt].x; t[1] *= cE[jt].y; t[2] *= cE[jt].z; t[3] *= cE[jt].w;
                S[jt][it] = t;
            }
        }
    }
#undef HG_LOAD
}

DI void prep_rwkv_gpu(const Frame& F, int l) {
    const bf16* hz = WSP(bf16, OFF_HRWKV); bf16* r7 = WSP(bf16, OFF_R7); bf16* gb = WSP(bf16, OFF_G); float* bonus = WSP(float, OFF_BONUS);
    const float* mup = F.in[7] + l * 960; const float* mun = F.in[8] + l * 960;
    const float* w0 = F.in[9] + l * 512; const float* w2 = F.in[10] + (size_t)l * 2 * 32 * 256;
    const float* a0 = F.in[11] + l * 512; const float* a2 = F.in[12] + (size_t)l * 2 * 32 * 256;
    const float* g2 = F.in[13] + (size_t)l * 64 * 256;
    const size_t AS = (size_t)NTOK * 256;
    float* zs = (float*)F.smem;
    bf16* stg = (bf16*)(F.smem + 61440);
    float* nts = (float*)(F.smem + 61440 + 73728);
    float* xch = (float*)(F.smem + 143360);
    bf16* lin = (bf16*)(F.smem + 152576);
    float* kkp = xch; float* bop = xch + 128; float* csum = xch + 256;
    const int tid = F.tid, wv = F.wv;
    union WF { bf16x8 v; unsigned u[4]; };
    WF fw0[2], fw1[2], fa0[2], fa1[2], fg0[2], fg1[2];
    float cw0[2], cw1[2], ca0[2], ca1[2], ckk[2], cka[2], crk[2];
    { const int lane0 = tid & 63, x0 = lane0 & 15, q0 = lane0 >> 4;
#pragma unroll
      for (int ci = 0; ci < 2; ++ci) {
          const int c = 32 * wv + 16 * ci + x0;
#pragma unroll
          for (int p = 0; p < 4; ++p) { const int k = 8 * q0 + 2 * p;
              fw0[ci].u[p] = pack_bf16(w2[(size_t)k * 256 + c], w2[(size_t)(k + 1) * 256 + c]); fw1[ci].u[p] = pack_bf16(w2[(size_t)(32 + k) * 256 + c], w2[(size_t)(33 + k) * 256 + c]);
              fa0[ci].u[p] = pack_bf16(a2[(size_t)k * 256 + c], a2[(size_t)(k + 1) * 256 + c]); fa1[ci].u[p] = pack_bf16(a2[(size_t)(32 + k) * 256 + c], a2[(size_t)(33 + k) * 256 + c]);
              fg0[ci].u[p] = pack_bf16(g2[(size_t)k * 256 + c], g2[(size_t)(k + 1) * 256 + c]); fg1[ci].u[p] = pack_bf16(g2[(size_t)(32 + k) * 256 + c], g2[(size_t)(33 + k) * 256 + c]); }
          cw0[ci] = w0[c]; cw1[ci] = w0[256 + c]; ca0[ci] = a0[c]; ca1[ci] = a0[256 + c];
          ckk[ci] = F.in[14][l * 256 + c]; cka[ci] = F.in[15][l * 256 + c]; crk[ci] = F.in[16][l * 256 + c];
      } }
    for (int tile = blockIdx.x; tile < NTOK / 16; tile += F.nblk) {
        const int n0 = tile * 16;
        __syncthreads();
        const int tl = fresh_tid(F);
#pragma unroll
        for (int bt = 0; bt < 3; ++bt) {
            unsigned zc[5], zp[5], zn[5];
#pragma unroll
            for (int i = 0; i < 5; ++i) {
                const int e = tl + (bt * 5 + i) * NTH, t = e / 480, cc = (e % 480) * 2, n = n0 + t, s = n % SEQ;
                zc[i] = *reinterpret_cast<const unsigned*>(hz + (size_t)n * 1024 + cc);
                zp[i] = s > 0 ? *reinterpret_cast<const unsigned*>(hz + (size_t)(n - 1) * 1024 + cc) : 0u;
                zn[i] = s < SEQ - 1 ? *reinterpret_cast<const unsigned*>(hz + (size_t)(n + 1) * 1024 + cc) : 0u;
            }
#pragma unroll
            for (int i = 0; i < 5; ++i) {
                const int e = tl + (bt * 5 + i) * NTH, t = e / 480, cc = (e % 480) * 2;
                const float2 mp = *reinterpret_cast<const float2*>(mup + cc), mn = *reinterpret_cast<const float2*>(mun + cc);
                float v0 = bflo(zc[i]), v1 = bfhi(zc[i]);
                v0 = v0 + mp.x * (bflo(zp[i]) - v0) + mn.x * (bflo(zn[i]) - v0);
                v1 = v1 + mp.y * (bfhi(zp[i]) - v1) + mn.y * (bfhi(zn[i]) - v1);
                if (cc >= 768) {
                    if (cc < 832) { v0 = fast_tanh(v0); v1 = fast_tanh(v1); }
                    else if (cc >= 896) { v0 = fast_sigmoid(v0); v1 = fast_sigmoid(v1); }
                    *reinterpret_cast<unsigned*>(lin + t * 200 + (cc - 768)) = pack_bf16(v0, v1);
                } else *reinterpret_cast<float2*>(zs + t * 960 + cc) = make_float2(v0, v1);
            }
        }
        __syncthreads();
        const int lane = tl & 63, x = lane & 15, q = lane >> 4, hh_ = wv >> 1;
        f32x4 dW0[2], dW1[2], dA0[2], dA1[2], dG[2];
        { const bf16* lr = lin + x * 200 + 8 * q;
          const bf16x8 iw0 = *reinterpret_cast<const bf16x8*>(lr), iw1 = *reinterpret_cast<const bf16x8*>(lr + 32), ia0 = *reinterpret_cast<const bf16x8*>(lr + 64), ia1 = *reinterpret_cast<const bf16x8*>(lr + 96);
          const bf16x8 ig0 = *reinterpret_cast<const bf16x8*>(lr + 128), ig1 = *reinterpret_cast<const bf16x8*>(lr + 160);
          const f32x4 z4 = {0.f, 0.f, 0.f, 0.f};
#pragma unroll
          for (int ci = 0; ci < 2; ++ci) {
              dW0[ci] = __builtin_amdgcn_mfma_f32_16x16x32_bf16(iw0, fw0[ci].v, z4, 0, 0, 0); dW1[ci] = __builtin_amdgcn_mfma_f32_16x16x32_bf16(iw1, fw1[ci].v, z4, 0, 0, 0);
              dA0[ci] = __builtin_amdgcn_mfma_f32_16x16x32_bf16(ia0, fa0[ci].v, z4, 0, 0, 0); dA1[ci] = __builtin_amdgcn_mfma_f32_16x16x32_bf16(ia1, fa1[ci].v, z4, 0, 0, 0);
              dG[ci] = __builtin_amdgcn_mfma_f32_16x16x32_bf16(ig0, fg0[ci].v, z4, 0, 0, 0); dG[ci] = __builtin_amdgcn_mfma_f32_16x16x32_bf16(ig1, fg1[ci].v, dG[ci], 0, 0, 0);
          } }
        float lw0[2][4], lw1[2][4], G0[2][4], G1[2][4];
        float kp[4] = {0.f, 0.f, 0.f, 0.f};
#pragma unroll
        for (int ci = 0; ci < 2; ++ci) {
            const int c = 32 * wv + 16 * ci + x;
#pragma unroll
            for (int r = 0; r < 4; ++r) { lw0[ci][r] = -DECAY_SCALE * fast_sigmoid(dW0[ci][r] + cw0[ci]); lw1[ci][r] = -DECAY_SCALE * fast_sigmoid(dW1[ci][r] + cw1[ci]);
                const float kk = zs[(4 * q + r) * 960 + 256 + c] * ckk[ci]; kp[r] += kk * kk; }
            G0[ci][0] = lw0[ci][0]; G1[ci][3] = lw1[ci][3];
#pragma unroll
            for (int r = 1; r < 4; ++r) { G0[ci][r] = G0[ci][r - 1] + lw0[ci][r]; G1[ci][3 - r] = G1[ci][4 - r] + lw1[ci][3 - r]; }
            csum[(0 * 4 + q) * 256 + c] = G0[ci][3]; csum[(1 * 4 + q) * 256 + c] = G1[ci][0];
        }
#pragma unroll
        for (int r = 0; r < 4; ++r) { const float s = allsum16(kp[r]); if (x == 0) kkp[(4 * q + r) * 8 + wv] = s; }
        __syncthreads();
        float bp[4] = {0.f, 0.f, 0.f, 0.f};
#pragma unroll
        for (int ci = 0; ci < 2; ++ci) {
            const int c = 32 * wv + 16 * ci + x, j = c & 63;
            float off0 = 0.f, off1 = 0.f, tot0 = 0.f, tot1 = 0.f;
#pragma unroll
            for (int qq = 0; qq < 4; ++qq) { const float a = csum[(0 * 4 + qq) * 256 + c], b = csum[(1 * 4 + qq) * 256 + c]; tot0 += a; tot1 += b; if (qq < q) off0 += a; if (qq > q) off1 += b; }
            if (q == 0) { bf16* reg = WSP(bf16, OFF_REG) + ((size_t)(tile * 4 + hh_) * 2) * 64 + j; reg[0] = f2bf(__expf(tot0)); reg[64] = f2bf(__expf(tot1)); }
#pragma unroll
            for (int r = 0; r < 4; ++r) {
                const int tau = 4 * q + r, n = n0 + tau; const float* zr = zs + tau * 960;
                const float rv = zr[c], k = zr[256 + c];
                const float A0 = fast_sigmoid(dA0[ci][r] + ca0[ci]), A1 = fast_sigmoid(dA1[ci][r] + ca1[ci]);
                const float ss = kkp[tau * 8 + 2 * hh_] + kkp[tau * 8 + 2 * hh_ + 1];
                const float kkn = k * ckk[ci] * (1.0f / fmaxf(sqrtf(ss), 1e-12f));
                const float kd0 = k * (1.0f + (A0 - 1.0f) * cka[ci]), kd1 = k * (1.0f + (A1 - 1.0f) * cka[ci]);
                bp[r] += rv * (kd0 + kd1) * crk[ci];
                const float g0 = G0[ci][r] + off0, g1 = G1[ci][r] + off1;
                const float e0 = __expf(g0), e1 = __expf(g1), i0 = __expf(-g0), i1 = __expf(-g1);
                const float kt0 = kkn * __expf(g0 - lw0[ci][r]), kt1 = kkn * __expf(g1 - lw1[ci][r]);
                bf16* s0 = stg + (size_t)((hh_ * 2 + 0) * 4) * 1152 + tau * 72 + j; bf16* s1 = stg + (size_t)((hh_ * 2 + 1) * 4) * 1152 + tau * 72 + j;
                s0[0] = f2bf(kt0); s0[1152] = f2bf(rv * e0); s0[2 * 1152] = f2bf(A0 * kkn * i0); s0[3 * 1152] = f2bf(kd0 * i0);
                s1[0] = f2bf(kt1); s1[1152] = f2bf(rv * e1); s1[2 * 1152] = f2bf(A1 * kkn * i1); s1[3 * 1152] = f2bf(kd1 * i1);
                gb[(size_t)n * 256 + c] = f2bf(dG[ci][r]);
            }
        }
#pragma unroll
        for (int r = 0; r < 4; ++r) { const float s = allsum16(bp[r]); if (x == 0) bop[(4 * q + r) * 8 + wv] = s; }
        __syncthreads();
        if (tl < 64) bonus[(size_t)(n0 + (tl >> 2)) * 4 + (tl & 3)] = bop[(tl >> 2) * 8 + 2 * (tl & 3)] + bop[(tl >> 2) * 8 + 2 * (tl & 3) + 1];
        __syncthreads();
        {
            const int wv = F.wv, lane = fresh_tid(F) & 63, x = lane & 15, q = lane >> 4, dd = wv & 1;
            const bf16* base = stg + (size_t)(wv * 4) * 1152;
            f32x4 nt = {0.f, 0.f, 0.f, 0.f}, mkk = nt, mkr = nt, mar = nt;
#pragma unroll
            for (int ks = 0; ks < 2; ++ks) {
                const bf16x8 fk = *reinterpret_cast<const bf16x8*>(base + x * 72 + 32 * ks + 8 * q);
                const bf16x8 fr = *reinterpret_cast<const bf16x8*>(base + 1152 + x * 72 + 32 * ks + 8 * q);
                const bf16x8 fa = *reinterpret_cast<const bf16x8*>(base + 2 * 1152 + x * 72 + 32 * ks + 8 * q);
                const bf16x8 fs = *reinterpret_cast<const bf16x8*>(base + 3 * 1152 + x * 72 + 32 * ks + 8 * q);
                nt = __builtin_amdgcn_mfma_f32_16x16x32_bf16(fk, fa, nt, 0, 0, 0);
                mkk = __builtin_amdgcn_mfma_f32_16x16x32_bf16(fk, fs, mkk, 0, 0, 0);
                mkr = __builtin_amdgcn_mfma_f32_16x16x32_bf16(fr, fs, mkr, 0, 0, 0);
                mar = __builtin_amdgcn_mfma_f32_16x16x32_bf16(fr, fa, mar, 0, 0, 0);
            }
            bf16* yc = WSP(bf16, OFF_YCAT); bf16* side = WSP(bf16, OFF_RSIDE);
            float* ntw = nts + wv * 256;
            auto mat_ptr = [&](int m) -> bf16* { const int sidx = wv * 4 + m;
                return sidx < 28 ? yc + (size_t)(n0 + 1 + (sidx >> 1)) * 1024 + 256 + (sidx & 1) * 256 : side + ((size_t)tile * 4 + (sidx - 28)) * 256; };
            bf16* m0 = mat_ptr(0); bf16* m2 = mat_ptr(2); bf16* m3 = mat_ptr(3);
#pragma unroll
            for (int r = 0; r < 4; ++r) {
                const int t = 4 * q + r; const bool strict = dd ? (x > t) : (x < t), beq = dd ? (x >= t) : (x <= t);
                const int pos = ((x >> 2) * 16 + t) * 4 + (x & 3);
                ntw[t * 16 + x] = strict ? nt[r] : 0.f;
                m0[pos] = f2bf(strict ? mkk[r] : 0.f); m2[pos] = f2bf(beq ? mkr[r] : 0.f); m3[pos] = f2bf(beq ? -mar[r] : 0.f);
            }
            const size_t blk = ((size_t)tile * 4 + (wv >> 1)) * 1024;
            {
                bf16* dk = r7 + (dd ? C_KT1 : C_KT0) * AS + blk; bf16* dr = r7 + (dd ? C_RT1 : C_RT0) * AS + blk;
#pragma unroll
                for (int ks = 0; ks < 2; ++ks) {
                    const uint2 k0 = *reinterpret_cast<const uint2*>(base + x * 72 + 32 * ks + 4 * q), k1 = *reinterpret_cast<const uint2*>(base + x * 72 + 32 * ks + 16 + 4 * q);
                    const uint2 r0 = *reinterpret_cast<const uint2*>(base + 1152 + x * 72 + 32 * ks + 4 * q), r1 = *reinterpret_cast<const uint2*>(base + 1152 + x * 72 + 32 * ks + 16 + 4 * q);
                    *reinterpret_cast<uint4*>(dk + (ks * 64 + lane) * 8) = make_uint4(k0.x, k0.y, k1.x, k1.y);
                    *reinterpret_cast<uint4*>(dr + (ks * 64 + lane) * 8) = make_uint4(r0.x, r0.y, r1.x, r1.y);
                }
            }
            {
                bf16* ds_ = r7 + (dd ? C_KK1 : C_KK0) * AS + blk; bf16* da = r7 + (dd ? C_AT1 : C_AT0) * AS + blk; bf16* dv = r7 + C_VT * AS + blk;
                const bf16* sa = base + 2 * 1152; const bf16* sk = base + 3 * 1152;
                const float* zv = zs + 512 + (wv >> 1) * 64;
#pragma unroll
                for (int u = 0; u < 4; ++u) {
                    const int ch = 16 * u + x;
                    const unsigned a0 = sa[(4 * q) * 72 + ch], a1 = sa[(4 * q + 1) * 72 + ch], a2 = sa[(4 * q + 2) * 72 + ch], a3 = sa[(4 * q + 3) * 72 + ch];
                    const unsigned k0 = sk[(4 * q) * 72 + ch], k1 = sk[(4 * q + 1) * 72 + ch], k2 = sk[(4 * q + 2) * 72 + ch], k3 = sk[(4 * q + 3) * 72 + ch];
                    *reinterpret_cast<uint2*>(ds_ + (u * 64 + lane) * 4) = make_uint2(k0 | (k1 << 16), k2 | (k3 << 16));
                    *reinterpret_cast<uint2*>(da + (u * 64 + lane) * 4) = make_uint2((a0 | (a1 << 16)) ^ 0x80008000u, (a2 | (a3 << 16)) ^ 0x80008000u);
                    if (dd == 0) *reinterpret_cast<uint2*>(dv + (u * 64 + lane) * 4) =
                        make_uint2(pack_bf16(zv[(4 * q) * 960 + ch], zv[(4 * q + 1) * 960 + ch]), pack_bf16(zv[(4 * q + 2) * 960 + ch], zv[(4 * q + 3) * 960 + ch]));
                }
            }
            asm volatile("s_waitcnt lgkmcnt(0)" ::: "memory");
            __builtin_amdgcn_wave_barrier();
            if (lane < 16) {
                float X[16];
                if (dd == 0) {
#pragma unroll
                    for (int t = 0; t < 16; ++t) { float a = (t == lane) ? 1.f : 0.f;
#pragma unroll
                        for (int s2 = 0; s2 < t; ++s2) a -= ntw[t * 16 + s2] * X[s2];
                        X[t] = a; }
                } else {
#pragma unroll
                    for (int t = 15; t >= 0; --t) { float a = (t == lane) ? 1.f : 0.f;
#pragma unroll
                        for (int s2 = t + 1; s2 < 16; ++s2) a -= ntw[t * 16 + s2] * X[s2];
                        X[t] = a; }
                }
                bf16* m1 = mat_ptr(1);
#pragma unroll
                for (int t = 0; t < 16; ++t) m1[((lane >> 2) * 16 + t) * 4 + (lane & 3)] = f2bf(X[t]);
            }
        }
    }
}

DI void scan_rwkv_chunk(const Frame& F, int chain) {
    const int d = chain / (BATCH * 4), b = (chain / 4) % BATCH, h = chain % 4, combo = h * 2 + d;
    const int lane = fresh_tid(F) & 63, q = lane >> 4;
    const size_t AS = (size_t)NTOK * 256;
    bf16* r7 = WSP(bf16, OFF_R7); const bf16* yc = WSP(bf16, OFF_YCAT); const bf16* side = WSP(bf16, OFF_RSIDE); const bf16* reg = WSP(bf16, OFF_REG);
    bf16* akt = r7 + (d ? C_KT1 : C_KT0) * AS; const bf16* art = r7 + (d ? C_RT1 : C_RT0) * AS;
    const bf16* akk = r7 + (d ? C_KK1 : C_KK0) * AS; const bf16* aat = r7 + (d ? C_AT1 : C_AT0) * AS; const bf16* avt = r7 + C_VT * AS;
    f32x4 Z[4][4];
#pragma unroll
    for (int a = 0; a < 4; ++a)
#pragma unroll
        for (int c = 0; c < 4; ++c) Z[a][c] = (f32x4){0.f, 0.f, 0.f, 0.f};
    constexpr int NCH = SEQ / 16;
    const unsigned l8 = (unsigned)lane * 8, l4 = (unsigned)lane * 4, le = (unsigned)(4 * q);
    uint4 nK[2], nR[2]; uint2 nM[4], nV[4];
#define RW_MPTR(tl_, m_) ((combo * 4 + (m_)) < 28 ? yc + (size_t)((tl_) * 16 + 1 + ((combo * 4 + (m_)) >> 1)) * 1024 + 256 + ((combo * 4 + (m_)) & 1) * 256 \
                                                   : side + ((size_t)(tl_) * 4 + (combo * 4 + (m_) - 28)) * 256)
#define RW_LOAD(cc_) do { const int c_ = d ? NCH - 1 - (cc_) : (cc_); const unsigned tl_ = (unsigned)(b * NCH + c_); const size_t bo_ = ((size_t)tl_ * 4 + h) * 1024; \
        nK[0] = *reinterpret_cast<const uint4*>(akt + bo_ + l8); nK[1] = *reinterpret_cast<const uint4*>(akt + bo_ + 512 + l8); \
        nR[0] = *reinterpret_cast<const uint4*>(art + bo_ + l8); nR[1] = *reinterpret_cast<const uint4*>(art + bo_ + 512 + l8); \
        _Pragma("unroll") for (int u_ = 0; u_ < 4; ++u_) { nM[u_] = *reinterpret_cast<const uint2*>(RW_MPTR(tl_, u_) + l4); nV[u_] = *reinterpret_cast<const uint2*>(avt + bo_ + u_ * 256 + l4); } } while (0)
    RW_LOAD(0);
    for (int cc = 0; cc < NCH; ++cc) {
        const int c = d ? NCH - 1 - cc : cc; const unsigned tl = (unsigned)(b * NCH + c); const size_t bo = ((size_t)tl * 4 + h) * 1024;
        uint2 cS[4], cA[4], cE[4];
        { const bf16* eb_ = reg + (size_t)((tl * 4 + h) * 2 + d) * 64;
#pragma unroll
          for (int u = 0; u < 4; ++u) { cS[u] = *reinterpret_cast<const uint2*>(akk + bo + u * 256 + l4); cA[u] = *reinterpret_cast<const uint2*>(aat + bo + u * 256 + l4);
              cE[u] = *reinterpret_cast<const uint2*>(eb_ + le + 16 * u); } }
        union Fr { bf16x8 v; unsigned u[4]; uint4 w; };
        Fr aK0, aK1, aR0, aR1, aMk, aTT, aY;
        aK0.w = nK[0]; aK1.w = nK[1]; aR0.w = nR[0]; aR1.w = nR[1];
        aMk.u[0] = nM[0].x; aMk.u[1] = nM[0].y; aMk.u[2] = 0u; aMk.u[3] = 0u;
        aTT.u[0] = nM[1].x; aTT.u[1] = nM[1].y; aTT.u[2] = 0u; aTT.u[3] = 0u;
        aY.u[0] = nM[2].x; aY.u[1] = nM[2].y; aY.u[2] = nM[3].x; aY.u[3] = nM[3].y;
        uint2 cV[4];
#pragma unroll
        for (int u = 0; u < 4; ++u) cV[u] = nV[u];
        if (cc + 1 < NCH) RW_LOAD(cc + 1);
        float eg[4][4];
#pragma unroll
        for (int u = 0; u < 4; ++u) { eg[u][0] = bflo(cE[u].x); eg[u][1] = bfhi(cE[u].x); eg[u][2] = bflo(cE[u].y); eg[u][3] = bfhi(cE[u].y); }
#pragma unroll
        for (int it = 0; it < 4; ++it) {
            Fr bZ0, bZ1, bV, bB, bVU;
            bZ0.u[0] = pack_bf16(Z[0][it][0], Z[0][it][1]); bZ0.u[1] = pack_bf16(Z[0][it][2], Z[0][it][3]); bZ0.u[2] = pack_bf16(Z[1][it][0], Z[1][it][1]); bZ0.u[3] = pack_bf16(Z[1][it][2], Z[1][it][3]);
            bZ1.u[0] = pack_bf16(Z[2][it][0], Z[2][it][1]); bZ1.u[1] = pack_bf16(Z[2][it][2], Z[2][it][3]); bZ1.u[2] = pack_bf16(Z[3][it][0], Z[3][it][1]); bZ1.u[3] = pack_bf16(Z[3][it][2], Z[3][it][3]);
            const f32x4 zero = {0.f, 0.f, 0.f, 0.f};
            f32x4 P1 = __builtin_amdgcn_mfma_f32_16x16x32_bf16(aK0.v, bZ0.v, zero, 0, 0, 0); P1 = __builtin_amdgcn_mfma_f32_16x16x32_bf16(aK1.v, bZ1.v, P1, 0, 0, 0);
            f32x4 P2 = __builtin_amdgcn_mfma_f32_16x16x32_bf16(aR0.v, bZ0.v, zero, 0, 0, 0); P2 = __builtin_amdgcn_mfma_f32_16x16x32_bf16(aR1.v, bZ1.v, P2, 0, 0, 0);
            bV.u[0] = cV[it].x; bV.u[1] = cV[it].y; bV.u[2] = 0u; bV.u[3] = 0u;
            const f32x4 Bt = __builtin_amdgcn_mfma_f32_16x16x32_bf16(aMk.v, bV.v, P1, 0, 0, 0);
            bB.u[0] = pack_bf16(Bt[0], Bt[1]); bB.u[1] = pack_bf16(Bt[2], Bt[3]); bB.u[2] = 0u; bB.u[3] = 0u;
            const f32x4 Ut = __builtin_amdgcn_mfma_f32_16x16x32_bf16(aTT.v, bB.v, zero, 0, 0, 0);
            bVU.u[0] = cV[it].x; bVU.u[1] = cV[it].y; bVU.u[2] = pack_bf16(Ut[0], Ut[1]); bVU.u[3] = pack_bf16(Ut[2], Ut[3]);
            const f32x4 Y = __builtin_amdgcn_mfma_f32_16x16x32_bf16(aY.v, bVU.v, P2, 0, 0, 0);
            *reinterpret_cast<uint2*>(akt + bo + it * 256 + l4) = make_uint2(pack_bf16(Y[0], Y[1]), pack_bf16(Y[2], Y[3]));
#pragma unroll
            for (int jt = 0; jt < 4; ++jt) {
                Fr aS; aS.u[0] = cS[jt].x; aS.u[1] = cS[jt].y; aS.u[2] = cA[jt].x; aS.u[3] = cA[jt].y;
                f32x4 t = __builtin_amdgcn_mfma_f32_16x16x32_bf16(aS.v, bVU.v, Z[jt][it], 0, 0, 0);
                t[0] *= eg[jt][0]; t[1] *= eg[jt][1]; t[2] *= eg[jt][2]; t[3] *= eg[jt][3];
                Z[jt][it] = t;
            }
        }
    }
#undef RW_LOAD
#undef RW_MPTR
}
#endif

DI void phase_prep(const Frame& F, int l) {
#ifndef CPU_EMU
    prep_attn_gpu(F, l); prep_rwkv_gpu(F, l); prep_hgrn_gpu(F, l);
#else
    {
        bf16* hatt = WSP(bf16, OFF_HATT); bf16* vt = WSP(bf16, OFF_VTATT);
        const float* qn = F.in[5] + l * 64; const float* kn = F.in[6] + l * 64;
        const int nitem = NTOK * 6;
        for (int it = ggrp(F); it < nitem; it += ngrp(F)) {
            const int n = it / 6, hh = it % 6;
            const int s = n % SEQ;
            bf16* p = hatt + (size_t)n * 512 + hh * 64;
            const float* gn = hh < 4 ? qn : kn;
            float v[PER64]; float ss = 0.f;
            for (int i = 0; i < PER64; ++i) { int j = glane(F) + i * GRP; v[i] = bf2f(p[j]); ss += v[i] * v[i]; }
            ss = grp_sum(F, ss); const float rs = 1.0f / sqrtf(ss * (1.0f / 64.0f) + RMS_EPS);
            float o[PER64];
#ifdef CPU_EMU
            float nv[64]; for (int j = 0; j < 64; ++j) nv[j] = v[j] * rs * gn[j];
#endif
            for (int i = 0; i < PER64; ++i) {
                int j = glane(F) + i * GRP;
                const int half = j >> 5, w = j & 31, f = w & 15, second = w >> 4;
                const float pos = half == 0 ? (float)(s / GRIDW) : (float)(s % GRIDW);
                const float ang = pos * rope_inv(2 * f, 32);
                const float cs = cosf(ang), sn = sinf(ang);
                const float mine = v[i] * rs * gn[j];
                const int jp = second ? j - 16 : j + 16;
#ifdef CPU_EMU
                const float partner = nv[jp];
#else
                const float partner = shfl_idx(F, v[0], jp) * rs * gn[jp];
#endif
                o[i] = second ? (partner * sn + mine * cs) : (mine * cs - partner * sn);
            }
            for (int i = 0; i < PER64; ++i) { int j = glane(F) + i * GRP; p[j] = f2bf(o[i]); }
        }
        for (size_t i = gtid_(F); i < (size_t)NTOK * 128; i += gthreads(F)) {
            const int n = (int)(i / 128), c = (int)(i % 128), b = n / SEQ, s = n % SEQ;
            vt[((size_t)b * 128 + c) * SEQ + s] = hatt[(size_t)n * 512 + 384 + c];
        }
    }
    {
        bf16* hm = WSP(bf16, OFF_HMLA); bf16* kr = WSP(bf16, OFF_KROPE);
        const float* qn = F.in[21] + l * 192; const float* kvn = F.in[22] + l * 128;
        for (int it = ggrp(F); it < NTOK * 2; it += ngrp(F)) {
            const int n = it >> 1, which = it & 1;
            bf16* p = hm + (size_t)n * 512 + (which ? 256 : 0);
            const int len = which ? 128 : 192; const float* gn = which ? kvn : qn;
            float ss = 0.f;
            for (int j = glane(F); j < len; j += GRP) { float x = bf2f(p[j]); ss += x * x; }
            ss = grp_sum(F, ss); const float rs = 1.0f / sqrtf(ss / (float)len + RMS_EPS);
            for (int j = glane(F); j < len; j += GRP) p[j] = f2bf(bf2f(p[j]) * rs * gn[j]);
        }
        for (int i = gtid_(F); i < NTOK * 16; i += gthreads(F)) {
            const int n = i >> 4, m = i & 15, s = n % SEQ;
            const bf16* src = hm + (size_t)n * 512 + 192;
            const int i1 = (m < 8 ? m : 16 + (m - 8)), i2 = i1 + 8;
            const float x1 = bf2f(src[i1]), x2 = bf2f(src[i2]);
            const float pos = m < 8 ? (float)(s / GRIDW) : (float)(s % GRIDW);
            const float ang = pos * rope_inv(2 * (m & 7), 16);
            const float cs = cosf(ang), sn = sinf(ang);
            kr[(size_t)n * 32 + 2 * m] = f2bf(x1 * cs - x2 * sn);
            kr[(size_t)n * 32 + 2 * m + 1] = f2bf(x1 * sn + x2 * cs);
        }
    }
#ifdef CPU_EMU
    {
        const bf16* hz = WSP(bf16, OFF_HRWKV); bf16* r7 = WSP(bf16, OFF_R7); bf16* gb = WSP(bf16, OFF_G); float* bonus = WSP(float, OFF_BONUS);
        const float* mup = F.in[7] + l * 960; const float* mun = F.in[8] + l * 960;
        const float* w0 = F.in[9] + l * 512; const float* w2 = F.in[10] + (size_t)l * 2 * 32 * 256;
        const float* a0 = F.in[11] + l * 512; const float* a2 = F.in[12] + (size_t)l * 2 * 32 * 256;
        const float* g2 = F.in[13] + (size_t)l * 64 * 256;
        const float* k_k = F.in[14] + l * 256; const float* k_a = F.in[15] + l * 256; const float* r_k = F.in[16] + l * 256;
        const size_t AS = (size_t)NTOK * 256;
        for (int it = ggrp(F); it < NTOK * 4; it += ngrp(F)) {
            const int n = it >> 2, h = it & 3, s = n % SEQ;
            const bf16* z = hz + (size_t)n * 1024;
            const bool hp = s > 0, hn = s < SEQ - 1;
            auto shifted = [&](int c) -> float {
                const float zc = bf2f(z[c]);
                const float zp = hp ? bf2f(z[c - 1024]) : 0.f, zn = hn ? bf2f(z[c + 1024]) : 0.f;
                return zc + mup[c] * (zp - zc) + mun[c] * (zn - zc);
            };
            float kkv[PER64], rr[PER64], kd0[PER64], kd1[PER64], aa0[PER64], aa1[PER64];
            float ss = 0.f, bs = 0.f;
            for (int i = 0; i < PER64; ++i) {
                const int j = glane(F) + i * GRP, c = h * 64 + j;
                const float r = shifted(c), k = shifted(256 + c), v = shifted(512 + c);
                float wr0 = w0[c], wr1 = w0[256 + c], ar0 = a0[c], ar1 = a0[256 + c], g = 0.f;
                for (int q = 0; q < 32; ++q) {
                    wr0 += tanhf(shifted(768 + q)) * w2[(size_t)q * 256 + c];
                    wr1 += tanhf(shifted(800 + q)) * w2[(size_t)(32 + q) * 256 + c];
                    ar0 += shifted(832 + q) * a2[(size_t)q * 256 + c];
                    ar1 += shifted(864 + q) * a2[(size_t)(32 + q) * 256 + c];
                }
                for (int q = 0; q < 64; ++q) g += sigmoidf_(shifted(896 + q)) * g2[(size_t)q * 256 + c];
                const float dec0 = expf(-DECAY_SCALE * sigmoidf_(wr0)), dec1 = expf(-DECAY_SCALE * sigmoidf_(wr1));
                const float A0 = sigmoidf_(ar0), A1 = sigmoidf_(ar1);
                const float kk = k * k_k[c];
                kkv[i] = kk; ss += kk * kk; rr[i] = r; aa0[i] = A0; aa1[i] = A1;
                kd0[i] = k * (1.0f + (A0 - 1.0f) * k_a[c]); kd1[i] = k * (1.0f + (A1 - 1.0f) * k_a[c]);
                bs += r * (kd0[i] + kd1[i]) * r_k[c];
                const size_t o = (size_t)n * 256 + c;
                r7[R_R * AS + o] = f2bf(r); r7[R_V * AS + o] = f2bf(v);
                r7[R_W0 * AS + o] = f2bf(dec0); r7[R_W1 * AS + o] = f2bf(dec1);
                r7[R_KD0 * AS + o] = f2bf(kd0[i]); r7[R_KD1 * AS + o] = f2bf(kd1[i]);
                gb[o] = f2bf(g);
            }
            ss = grp_sum(F, ss); bs = grp_sum(F, bs);
            const float inv = 1.0f / fmaxf(sqrtf(ss), 1e-12f);
            for (int i = 0; i < PER64; ++i) {
                const int j = glane(F) + i * GRP, c = h * 64 + j; const size_t o = (size_t)n * 256 + c;
                const float kk = kkv[i] * inv;
                r7[R_KK * AS + o] = f2bf(kk); r7[R_AK0 * AS + o] = f2bf(aa0[i] * kk); r7[R_AK1 * AS + o] = f2bf(aa1[i] * kk);
            }
            if (glane(F) == 0) bonus[(size_t)n * 4 + h] = bs;
        }
    }
#else
    prep_rwkv_gpu(F, l);
#endif
    {
        bf16* hh = WSP(bf16, OFF_HHGRN);
        const float* lg = F.in[19];
        for (size_t i = gtid_(F); i < (size_t)NTOK * 768; i += gthreads(F)) {
            const int n = (int)(i / 768), c = (int)(i % 768);
            bf16* p = hh + (size_t)n * 1280 + c;
            const float x = bf2f(*p);
            if (c < 256) { *p = f2bf(siluf_(x)); }
            else {
                const int d = c & 255;
                float lb = 0.f;
                if (l == 1) { const float a = lg[d], b = lg[256 + d]; const float m = fmaxf(a, b); const float ea = expf(a - m), eb = expf(b - m); lb = eb / (ea + eb); }
                *p = f2bf((1.0f - lb) * sigmoidf_(-x));
            }
        }
    }
#endif
}

struct EpiQMla {
    bf16* q; int row0, pn; const float* tab;
    DI void operator()(int r, int c, float a, float b, float cc, float d) const {
        const int row = row0 + r, col = pn * 256 + c;
        if (col >= 384) return;
        const int w = col % 96;
        if (w >= 64) {
            const int s = row % SEQ;
#pragma unroll
            for (int t = 0; t < 2; ++t) {
                const int m = ((w - 64) >> 1) + t;
#ifdef CPU_EMU
                const float pos = m < 8 ? (float)(s / GRIDW) : (float)(s % GRIDW);
                const float ang = pos * rope_inv(2 * (m & 7), 16);
                const float cs = cosf(ang), sn = sinf(ang);
#else
                const int pi = m < 8 ? s / GRIDW : s % GRIDW;
                const float cs = tab[pi * 8 + (m & 7)], sn = tab[512 + pi * 8 + (m & 7)];
#endif
                float& x1 = t ? cc : a; float& x2 = t ? d : b;
                const float y1 = x1 * cs - x2 * sn, y2 = x1 * sn + x2 * cs; x1 = y1; x2 = y2;
            }
        }
        st_bf16x4(q + (size_t)row * 384 + col, a, b, cc, d);
    }
};
struct EpiKVMla {
    bf16* kn; bf16* vt; int row0, pn;
    DI void operator()(int r, int c, float a, float b, float cc, float d) const {
        const int row = row0 + r, col = pn * 256 + c, h = col >> 7, w = col & 127;
        if (w < 64) st_bf16x4(kn + (size_t)row * 256 + h * 64 + w, a, b, cc, d);
        else { const int bb = row / SEQ, s = row % SEQ; bf16* p = vt + ((size_t)bb * 256 + h * 64 + (w - 64)) * SEQ + s;
            p[0] = f2bf(a); p[SEQ] = f2bf(b); p[2 * SEQ] = f2bf(cc); p[3 * SEQ] = f2bf(d); }
    }
};
DI void phase_mlaup(const Frame& F) {
    const bf16* hm = WSP(bf16, OFF_HMLA); const char* wts = (const char*)WSP(bf16, OFF_WTS);
    const int nM = (NTOK + 255) / 256;
    float* rtab = (float*)(F.smem + 139264);
#ifndef CPU_EMU
    __syncthreads();
    { const int i = fresh_tid(F); const int pos = i >> 3, f = i & 7; const float ang = (float)pos * rope_inv(2 * f, 16); rtab[i] = cosf(ang); rtab[512 + i] = sinf(ang); }
    __syncthreads();
#endif
    for (int u = blockIdx.x; u < nM * 4; u += F.nblk) {
        const int pm = u >> 2, j = u & 3;
#ifdef CPU_EMU
        const int mr = min(256, NTOK - pm * 256);
#define MR , mr
#else
#define MR
#endif
        if (j < 2) { EpiQMla E{WSP(bf16, OFF_QMLA), pm * 256, j, rtab};
            gemm_unit(F, hm, 512, nullptr, pm * 256, (const bf16*)(wts + W_UQ_T), 256, j * 256, 256, E MR); }
        else { EpiKVMla E{WSP(bf16, OFF_KNOPE), WSP(bf16, OFF_VTMLA), pm * 256, j - 2};
            gemm_unit(F, hm + 256, 512, nullptr, pm * 256, (const bf16*)(wts + W_UKV_T), 256, (j - 2) * 256, 256, E MR); }
    }
}

struct AttnDesc {
    const bf16* q; int q_stride;
    int q_hstride;
    const bf16* k; int k_stride; int k_hstride;
    const bf16* k2; int k2_stride;
    int dk_main;
    const bf16* vt;
    bf16* o; int o_stride; int o_hstride;
    int H, HKV, SQ, SK;
    float scale;
};

#ifdef CPU_EMU
template <int DK, int DV>
void attn_phase(const Frame& F, const AttnDesc& A) {
    const int G = A.H / A.HKV;
    float* sc = (float*)malloc(sizeof(float) * A.SK);
    for (int b = 0; b < BATCH; ++b) for (int h = 0; h < A.H; ++h) for (int s = 0; s < A.SQ; ++s) {
        const int kv = h / G;
        const bf16* q = A.q + (size_t)(b * A.SQ + s) * A.q_stride + h * A.q_hstride;
        float mx = -1e30f;
        for (int key = 0; key < A.SK; ++key) {
            const bf16* kp = A.k + (size_t)(b * A.SK + key) * A.k_stride + kv * A.k_hstride;
            double acc = 0;
            for (int d = 0; d < DK; ++d) {
                float kvl = d < A.dk_main ? bf2f(kp[d]) : bf2f(A.k2[(size_t)(b * A.SK + key) * A.k2_stride + d - A.dk_main]);
                acc += (double)bf2f(q[d]) * kvl;
            }
            sc[key] = (float)acc * A.scale; mx = fmaxf(mx, sc[key]);
        }
        double sum = 0; for (int key = 0; key < A.SK; ++key) { sc[key] = expf(sc[key] - mx); sum += sc[key]; }
        for (int dv = 0; dv < DV; ++dv) {
            const bf16* vp = A.vt + ((size_t)(b * A.HKV + kv) * DV + dv) * A.SK;
            double acc = 0; for (int key = 0; key < A.SK; ++key) acc += (double)bf2f(f2bf(sc[key])) * bf2f(vp[key]);
            A.o[(size_t)(b * A.SQ + s) * A.o_stride + h * A.o_hstride + dv] = f2bf((float)(acc / sum));
        }
    }
    free(sc);
}
#else
DI int crow16(int reg, int h) { return (reg & 3) + 8 * (reg >> 2) + 4 * h; }
template <int DK, int DV, int DVT, int NQB>
DI void attn_unit(const Frame& F, const AttnDesc& A, int u) {
    constexpr int KP = DK + 8;
    constexpr int VP = 64 + 8;
    constexpr int NPASS = DV / DVT;
    constexpr int UQ = 256 * NQB;
    bf16* Ks = (bf16*)F.smem;
    bf16* Vs = Ks + 64 * KP;
    const int tid = fresh_tid(F), wave = F.wv, lane = tid & 63, r = lane & 31, hh = lane >> 5;
    const int G = A.H / A.HKV;
    const int nqb = A.SQ / UQ;
    const float sl2 = A.scale * 1.4426950408889634f;
    {
        int t = u; const int pass = t % NPASS; t /= NPASS; const int qb = t % nqb; t /= nqb; const int h = t % A.H; const int b = t / A.H;
        const int kv = h / G;
        const int q0 = qb * UQ + wave * 32 * NQB;
        bf16x8 qf[NQB][DK / 16];
#pragma unroll
        for (int qi = 0; qi < NQB; ++qi) { const bf16* qp = A.q + (size_t)(b * A.SQ + q0 + 32 * qi + r) * A.q_stride + h * A.q_hstride + 8 * hh;
#pragma unroll
          for (int ks = 0; ks < DK / 16; ++ks) qf[qi][ks] = *reinterpret_cast<const bf16x8*>(qp + 16 * ks); }
        f32x16 oacc[NQB][DVT / 32];
#pragma unroll
        for (int qi = 0; qi < NQB; ++qi)
#pragma unroll
            for (int i = 0; i < DVT / 32; ++i)
#pragma unroll
                for (int j = 0; j < 16; ++j) oacc[qi][i][j] = 0.f;
        float mrun[NQB], lrun[NQB];
#pragma unroll
        for (int qi = 0; qi < NQB; ++qi) { mrun[qi] = -INFINITY; lrun[qi] = 0.f; }
        constexpr int NKC = (64 * (DK / 8) + 511) / 512, NVC = (DVT * 8 + 511) / 512;
        uint4 kr0, kr1, kr2, kr3, vr0, vr1;
        kr0 = kr1 = kr2 = kr3 = vr0 = vr1 = make_uint4(0u, 0u, 0u, 0u);
#define ATT_FK(kt_, i_, reg_) do { if ((i_) < NKC) { int c_ = tid + (i_) * 512; if (c_ >= 64 * (DK / 8)) c_ = 64 * (DK / 8) - 1; \
            const int key_ = c_ / (DK / 8), d8_ = (c_ % (DK / 8)) * 8; const size_t krow_ = (size_t)(b * A.SK + (kt_) * 64 + key_); \
            const bf16* kp_ = (d8_ < A.dk_main) ? (A.k + krow_ * A.k_stride + kv * A.k_hstride + d8_) : (A.k2 + krow_ * A.k2_stride + (d8_ - A.dk_main)); \
            reg_ = *reinterpret_cast<const uint4*>(kp_); } } while (0)
#define ATT_FV(kt_, i_, reg_) do { if ((i_) < NVC) { int c_ = tid + (i_) * 512; if (c_ >= DVT * 8) c_ = DVT * 8 - 1; \
            const int dv_ = c_ >> 3, k8_ = (c_ & 7) * 8; \
            reg_ = *reinterpret_cast<const uint4*>(A.vt + ((size_t)(b * A.HKV + kv) * DV + pass * DVT + dv_) * A.SK + (kt_) * 64 + k8_); } } while (0)
#define ATT_FETCH(kt_) do { ATT_FK(kt_, 0, kr0); ATT_FK(kt_, 1, kr1); ATT_FK(kt_, 2, kr2); ATT_FK(kt_, 3, kr3); ATT_FV(kt_, 0, vr0); ATT_FV(kt_, 1, vr1); } while (0)
#define ATT_SK(kb_, i_, reg_) do { if ((i_) < NKC) { const int c_ = tid + (i_) * 512; if (c_ < 64 * (DK / 8)) { \
            const int key_ = c_ / (DK / 8), d8_ = (c_ % (DK / 8)) * 8; *reinterpret_cast<uint4*>((kb_) + key_ * KP + d8_) = reg_; } } } while (0)
#define ATT_SV(vb_, i_, reg_) do { if ((i_) < NVC) { const int c_ = tid + (i_) * 512; if (c_ < DVT * 8) { \
            const int dv_ = c_ >> 3, k8_ = (c_ & 7) * 8; *reinterpret_cast<uint4*>((vb_) + dv_ * VP + k8_) = reg_; } } } while (0)
#define ATT_STORE(kb_, vb_) do { ATT_SK(kb_, 0, kr0); ATT_SK(kb_, 1, kr1); ATT_SK(kb_, 2, kr2); ATT_SK(kb_, 3, kr3); ATT_SV(vb_, 0, vr0); ATT_SV(vb_, 1, vr1); } while (0)
        constexpr bool PREF = DK <= 96;
        constexpr int BUFE = 64 * KP + DVT * VP;
        const int ntile = A.SK / 64;
        if (PREF) { ATT_FETCH(0); ATT_STORE(Ks, Vs); if (ntile > 1) ATT_FETCH(1); __syncthreads(); }
        for (int kt = 0; kt < ntile; ++kt) {
            if (PREF) {
                if (kt + 1 < ntile) { bf16* kb = Ks + ((kt + 1) & 1) * BUFE; ATT_STORE(kb, kb + 64 * KP); if (kt + 2 < ntile) ATT_FETCH(kt + 2); }
            } else {
            __syncthreads();
            {
                for (int c = tid; c < 64 * (DK / 8); c += 512) {
                    const int key = c / (DK / 8), d8 = (c % (DK / 8)) * 8;
                    const size_t krow = (size_t)(b * A.SK + kt * 64 + key);
                    uint4 v;
                    if (d8 < A.dk_main) v = *reinterpret_cast<const uint4*>(A.k + krow * A.k_stride + kv * A.k_hstride + d8);
                    else v = *reinterpret_cast<const uint4*>(A.k2 + krow * A.k2_stride + (d8 - A.dk_main));
                    *reinterpret_cast<uint4*>(Ks + key * KP + d8) = v;
                }
                for (int c = tid; c < DVT * 8; c += 512) {
                    const int dv = c >> 3, k8 = (c & 7) * 8;
                    const uint4 v = *reinterpret_cast<const uint4*>(A.vt + ((size_t)(b * A.HKV + kv) * DV + pass * DVT + dv) * A.SK + kt * 64 + k8);
                    *reinterpret_cast<uint4*>(Vs + dv * VP + k8) = v;
                }
            }
            __syncthreads();
            }
            const bf16* Kc = PREF ? Ks + (kt & 1) * BUFE : Ks; const bf16* Vc = Kc + 64 * KP;
            f32x16 sacc[NQB][2];
#pragma unroll
            for (int kb = 0; kb < 2; ++kb) {
#pragma unroll
                for (int qi = 0; qi < NQB; ++qi)
#pragma unroll
                    for (int j = 0; j < 16; ++j) sacc[qi][kb][j] = 0.f;
#pragma unroll
                for (int ks = 0; ks < DK / 16; ++ks) {
                    const bf16x8 kf = *reinterpret_cast<const bf16x8*>(Kc + (kb * 32 + r) * KP + 16 * ks + 8 * hh);
#pragma unroll
                    for (int qi = 0; qi < NQB; ++qi) sacc[qi][kb] = __builtin_amdgcn_mfma_f32_32x32x16_bf16(kf, qf[qi][ks], sacc[qi][kb], 0, 0, 0);
                }
            }
#pragma unroll
            for (int qi = 0; qi < NQB; ++qi) {
                float mx = -INFINITY;
#pragma unroll
                for (int kb = 0; kb < 2; ++kb)
#pragma unroll
                    for (int j = 0; j < 16; ++j) mx = fmaxf(mx, sacc[qi][kb][j]);
                mx = fmaxf(mx, shfl_xor(F, mx, 32));
                const float mnew = fmaxf(mrun[qi], mx * sl2);
                const float alpha = __builtin_amdgcn_exp2f(mrun[qi] - mnew);
                mrun[qi] = mnew;
                float psum = 0.f;
#pragma unroll
                for (int kb = 0; kb < 2; ++kb)
#pragma unroll
                    for (int j = 0; j < 16; ++j) { const float p = __builtin_amdgcn_exp2f(sacc[qi][kb][j] * sl2 - mnew); sacc[qi][kb][j] = p; psum += p; }
                lrun[qi] = lrun[qi] * alpha + psum;
                if (!PREF || __ballot(alpha != 1.0f)) {
#pragma unroll
                    for (int i = 0; i < DVT / 32; ++i)
#pragma unroll
                        for (int j = 0; j < 16; ++j) oacc[qi][i][j] *= alpha;
                }
            }
#pragma unroll
            for (int kb = 0; kb < 2; ++kb)
#pragma unroll
                for (int s2 = 0; s2 < 2; ++s2) {
                    union PF { bf16x8 v; unsigned u[4]; };
                    PF pf[NQB];
#pragma unroll
                    for (int qi = 0; qi < NQB; ++qi)
#pragma unroll
                        for (int j = 0; j < 4; ++j) pf[qi].u[j] = pack_bf16(sacc[qi][kb][8 * s2 + 2 * j], sacc[qi][kb][8 * s2 + 2 * j + 1]);
#pragma unroll
                    for (int i = 0; i < DVT / 32; ++i) {
                        const bf16* vp = Vc + (i * 32 + r) * VP + kb * 32 + 16 * s2 + 4 * hh;
                        union { bf16x8 v; bf16x4 h2[2]; } vf;
                        vf.h2[0] = *reinterpret_cast<const bf16x4*>(vp);
                        vf.h2[1] = *reinterpret_cast<const bf16x4*>(vp + 8);
#pragma unroll
                        for (int qi = 0; qi < NQB; ++qi) oacc[qi][i] = __builtin_amdgcn_mfma_f32_32x32x16_bf16(vf.v, pf[qi].v, oacc[qi][i], 0, 0, 0);
                    }
                }
            if (PREF) __syncthreads();
        }
#pragma unroll
        for (int qi = 0; qi < NQB; ++qi) {
            const float lsum = lrun[qi] + shfl_xor(F, lrun[qi], 32);
            const float inv = 1.0f / lsum;
            bf16* op = A.o + (size_t)(b * A.SQ + q0 + 32 * qi + r) * A.o_stride + h * A.o_hstride + pass * DVT;
#pragma unroll
            for (int i = 0; i < DVT / 32; ++i)
#pragma unroll
                for (int g = 0; g < 4; ++g)
                    st_bf16x4(op + i * 32 + 8 * g + 4 * hh, oacc[qi][i][4 * g] * inv, oacc[qi][i][4 * g + 1] * inv, oacc[qi][i][4 * g + 2] * inv, oacc[qi][i][4 * g + 3] * inv);
        }
    }
}
#endif

#undef ATT_FETCH
#undef ATT_STORE
#undef ATT_FK
#undef ATT_FV
#undef ATT_SK
#undef ATT_SV
#ifndef CPU_EMU
template <int DK, int DV, int DVT, int NQB>
DI int attn_nunit(const AttnDesc& A) { return BATCH * A.H * (A.SQ / (256 * NQB)) * (DV / DVT); }
template <int DK, int DV, int DVT, int NQB>
DI void attn_phase(const Frame& F, const AttnDesc& A) {
    const int nunit = attn_nunit<DK, DV, DVT, NQB>(A);
    for (int u = blockIdx.x; u < nunit; u += F.nblk) attn_unit<DK, DV, DVT, NQB>(F, A, u);
}
#endif
#ifndef CPU_EMU
DI void memattn_unit(const Frame& F, const AttnDesc& A, int u) {
    constexpr int KP = 256 + 8;
    bf16* Ks = (bf16*)F.smem;
    const int tid = fresh_tid(F), wave = F.wv, lane = tid & 63, r = lane & 31, hh = lane >> 5;
    const float sl2 = A.scale * 1.4426950408889634f;
    const int nqb = A.SQ / 256;
    int t = u; const int qb = t % nqb; t /= nqb; const int h = t & 3; const int b = t >> 2;
    const int q0 = qb * 256 + wave * 32;
    bf16x8 qf[16];
    { const bf16* qp = A.q + (size_t)(b * A.SQ + q0 + r) * A.q_stride + h * A.q_hstride + 8 * hh;
#pragma unroll
      for (int ks = 0; ks < 16; ++ks) qf[ks] = *reinterpret_cast<const bf16x8*>(qp + 16 * ks); }
    __syncthreads();
    { const bf16* kg = A.k + (size_t)(b * A.SK) * A.k_stride + h * A.k_hstride;
#pragma unroll 1
      for (int i0 = 0; i0 < 16; i0 += 8) {
#define MA_L(i_) const uint4 t##i_ = *reinterpret_cast<const uint4*>(kg + (size_t)((tid + (i0 + i_) * 512) >> 5) * A.k_stride + (tid & 31) * 8)
#define MA_S(i_) *reinterpret_cast<uint4*>(Ks + ((tid + (i0 + i_) * 512) >> 5) * KP + (tid & 31) * 8) = t##i_
          MA_L(0); MA_L(1); MA_L(2); MA_L(3); MA_L(4); MA_L(5); MA_L(6); MA_L(7);
          MA_S(0); MA_S(1); MA_S(2); MA_S(3); MA_S(4); MA_S(5); MA_S(6); MA_S(7);
#undef MA_L
      } }
    __syncthreads();
    f32x16 sacc[8];
#pragma unroll
    for (int t8 = 0; t8 < 8; ++t8) {
#pragma unroll
        for (int j = 0; j < 16; ++j) sacc[t8][j] = 0.f;
#pragma unroll
        for (int ks = 0; ks < 16; ++ks) {
            const bf16x8 kf = *reinterpret_cast<const bf16x8*>(Ks + (t8 * 32 + r) * KP + 16 * ks + 8 * hh);
            sacc[t8] = __builtin_amdgcn_mfma_f32_32x32x16_bf16(kf, qf[ks], sacc[t8], 0, 0, 0);
        }
        asm volatile("" ::: "memory");
    }
    float mx = -INFINITY;
#pragma unroll
    for (int t8 = 0; t8 < 8; ++t8)
#pragma unroll
        for (int j = 0; j < 16; ++j) mx = fmaxf(mx, sacc[t8][j]);
    mx = fmaxf(mx, shfl_xor(F, mx, 32));
    const float mref = mx * sl2;
    float psum = 0.f;
    union PF { bf16x8 v; unsigned u[4]; };
    PF pf[8][2];
#pragma unroll
    for (int t8 = 0; t8 < 8; ++t8) {
#pragma unroll
        for (int j = 0; j < 16; ++j) { const float p = __builtin_amdgcn_exp2f(sacc[t8][j] * sl2 - mref); sacc[t8][j] = p; psum += p; }
#pragma unroll
        for (int s2 = 0; s2 < 2; ++s2)
#pragma unroll
            for (int j = 0; j < 4; ++j) pf[t8][s2].u[j] = pack_bf16(sacc[t8][8 * s2 + 2 * j], sacc[t8][8 * s2 + 2 * j + 1]);
    }
    const float inv = 1.0f / (psum + shfl_xor(F, psum, 32));
    __syncthreads();
    { const bf16* vg = A.vt + (size_t)(b * A.HKV + h) * 256 * 256;
#pragma unroll 1
      for (int i0 = 0; i0 < 16; i0 += 8) {
#define MA_L(i_) const uint4 t##i_ = *reinterpret_cast<const uint4*>(vg + (size_t)(tid + (i0 + i_) * 512) * 8)
          MA_L(0); MA_L(1); MA_L(2); MA_L(3); MA_L(4); MA_L(5); MA_L(6); MA_L(7);
          MA_S(0); MA_S(1); MA_S(2); MA_S(3); MA_S(4); MA_S(5); MA_S(6); MA_S(7);
#undef MA_L
#undef MA_S
      } }
    __syncthreads();
    bf16* op = A.o + (size_t)(b * A.SQ + q0 + r) * A.o_stride + h * A.o_hstride;
#pragma unroll
    for (int i = 0; i < 8; ++i) {
        f32x16 o;
#pragma unroll
        for (int j = 0; j < 16; ++j) o[j] = 0.f;
#pragma unroll
        for (int t8 = 0; t8 < 8; ++t8)
#pragma unroll
            for (int s2 = 0; s2 < 2; ++s2) {
                const bf16* vp = Ks + (i * 32 + r) * KP + t8 * 32 + 16 * s2 + 4 * hh;
                union { bf16x8 v; bf16x4 h2[2]; } vf;
                vf.h2[0] = *reinterpret_cast<const bf16x4*>(vp);
                vf.h2[1] = *reinterpret_cast<const bf16x4*>(vp + 8);
                o = __builtin_amdgcn_mfma_f32_32x32x16_bf16(vf.v, pf[t8][s2].v, o, 0, 0, 0);
            }
#pragma unroll
        for (int g = 0; g < 4; ++g) st_bf16x4(op + i * 32 + 8 * g + 4 * hh, o[4 * g] * inv, o[4 * g + 1] * inv, o[4 * g + 2] * inv, o[4 * g + 3] * inv);
    }
}
DI void memattn_phase(const Frame& F, const AttnDesc& A) {
    const int nunit = BATCH * 4 * (A.SQ / 256);
    for (int u = blockIdx.x; u < nunit; u += F.nblk) memattn_unit(F, A, u);
}
#endif
DI AttnDesc desc_gqa(const Frame& F) {
    AttnDesc A; A.q = WSP(bf16, OFF_HATT); A.q_stride = 512; A.q_hstride = 64;
    A.k = WSP(bf16, OFF_HATT) + 256; A.k_stride = 512; A.k_hstride = 64; A.k2 = nullptr; A.k2_stride = 0; A.dk_main = 64;
    A.vt = WSP(bf16, OFF_VTATT); A.o = WSP(bf16, OFF_YCAT); A.o_stride = 1024; A.o_hstride = 64;
    A.H = 4; A.HKV = 2; A.SQ = SEQ; A.SK = SEQ; A.scale = 0.125f; return A;
}
DI AttnDesc desc_mla(const Frame& F) {
    AttnDesc A; A.q = WSP(bf16, OFF_QMLA); A.q_stride = 384; A.q_hstride = 96;
    A.k = WSP(bf16, OFF_KNOPE); A.k_stride = 256; A.k_hstride = 64; A.k2 = WSP(bf16, OFF_KROPE); A.k2_stride = 32; A.dk_main = 64;
    A.vt = WSP(bf16, OFF_VTMLA); A.o = WSP(bf16, OFF_YCAT) + 768; A.o_stride = 1024; A.o_hstride = 64;
    A.H = 4; A.HKV = 4; A.SQ = SEQ; A.SK = SEQ; A.scale = 0.10206207261596575f; return A;
}
DI AttnDesc desc_mem(const Frame& F) {
    AttnDesc A; A.q = WSP(bf16, OFF_QMEM); A.q_stride = 1024; A.q_hstride = 256;
    A.k = WSP(bf16, OFF_KMEM); A.k_stride = 1024; A.k_hstride = 256; A.k2 = nullptr; A.k2_stride = 0; A.dk_main = 256;
    A.vt = WSP(bf16, OFF_VTMEM); A.o = WSP(bf16, OFF_OMEM); A.o_stride = 1024; A.o_hstride = 256;
    A.H = 4; A.HKV = 4; A.SQ = SEQ; A.SK = MEMT; A.scale = 0.0625f; return A;
}

#ifndef CPU_EMU
typedef float f32p __attribute__((ext_vector_type(2)));
DI f32p allsum16p(f32p x) { x.x = allsum16(x.x); x.y = allsum16(x.y); return x; }
template <int KIND>
DI void scan_chain(const Frame& F, int chain) {
    constexpr int T = 32;
    constexpr int NARR = KIND == 0 ? 6 : 3;
    constexpr int STEPB = NARR * 256;
    constexpr int NPIECE = T * NARR * 8;
    constexpr int PPT = (NPIECE + NTH - 1) / NTH;
    const int d = chain / (BATCH * 4), b = (chain / 4) % BATCH, h = chain % 4;
    const int tid = F.tid, wave = tid >> 6, lane = tid & 63, rg = lane >> 4, cg = lane & 15;
    unsigned char* buf0 = F.smem; unsigned char* buf1 = F.smem + T * STEPB;
    unsigned char* ybuf = F.smem + 2 * T * STEPB;
    const size_t AS = (size_t)NTOK * 256;
    bf16* r7 = WSP(bf16, OFF_R7); bf16* hh = WSP(bf16, OFF_HHGRN);
#define PIECE_PTR(t0, p_) ([&]() -> const uint4* { const int pc = (p_) < NPIECE ? (p_) : NPIECE - 1; \
        const int st = pc / (NARR * 8), rem = pc % (NARR * 8), arr = rem >> 3, part = rem & 7; \
        const int tt = (t0) + st, ss = d ? SEQ - 1 - tt : tt; const size_t nn = (size_t)b * SEQ + ss; \
        const bf16* base; \
        if (KIND == 0) { const int aid = arr == 0 ? R_KK : arr == 1 ? (d ? R_W1 : R_W0) : arr == 2 ? (d ? R_AK1 : R_AK0) : arr == 3 ? (d ? R_KD1 : R_KD0) : arr == 4 ? R_R : R_V; \
            base = r7 + aid * AS + nn * 256 + h * 64; } \
        else { const int off = arr == 0 ? 256 + d * 256 : arr == 1 ? 0 : 768; base = hh + nn * 1280 + off + h * 64; } \
        return reinterpret_cast<const uint4*>(base + part * 8); }())
#define PUT_PIECE(dst, p_, v_) do { float4 a_, b_; a_.x = bflo((v_).x); a_.y = bfhi((v_).x); a_.z = bflo((v_).y); a_.w = bfhi((v_).y); \
        b_.x = bflo((v_).z); b_.y = bfhi((v_).z); b_.z = bflo((v_).w); b_.w = bfhi((v_).w); \
        *reinterpret_cast<float4*>((dst) + (p_) * 32) = a_; *reinterpret_cast<float4*>((dst) + (p_) * 32 + 16) = b_; } while (0)
#define STORE_PRE(dst) do { PUT_PIECE(dst, tid, pre0); \
        if (tid + NTH < NPIECE) PUT_PIECE(dst, tid + NTH, pre1); \
        if (PPT > 2 && tid + 2 * NTH < NPIECE) PUT_PIECE(dst, tid + 2 * NTH, pre2); } while (0)
    uint4 pre0, pre1, pre2;
    pre0 = *PIECE_PTR(0, tid); pre1 = *PIECE_PTR(0, tid + NTH); pre2 = pre1;
    if (PPT > 2) pre2 = *PIECE_PTR(0, tid + 2 * NTH);
    __syncthreads();
    STORE_PRE(buf0);
    __syncthreads();
    f32p P[4];
#pragma unroll
    for (int c = 0; c < 4; ++c) P[c] = (f32p){0.f, 0.f};
    const int vofs = (wave * 8 + rg * 2) * 4;
    for (int ch = 0; ch < SEQ / T; ++ch) {
        const unsigned char* cur = (ch & 1) ? buf1 : buf0;
        if (ch + 1 < SEQ / T) {
            pre0 = *PIECE_PTR((ch + 1) * T, tid); pre1 = *PIECE_PTR((ch + 1) * T, tid + NTH);
            if (PPT > 2) pre2 = *PIECE_PTR((ch + 1) * T, tid + 2 * NTH);
        }
        float4 o0, o1, o2, o3, o4; f32p ov;
        { const unsigned char* sb = cur;
          o0 = *reinterpret_cast<const float4*>(sb + 0 * 256 + cg * 16); o1 = *reinterpret_cast<const float4*>(sb + 1 * 256 + cg * 16);
          if (KIND == 0) { o2 = *reinterpret_cast<const float4*>(sb + 2 * 256 + cg * 16); o3 = *reinterpret_cast<const float4*>(sb + 3 * 256 + cg * 16); o4 = *reinterpret_cast<const float4*>(sb + 4 * 256 + cg * 16); }
          ov = *reinterpret_cast<const f32p*>(sb + (NARR - 1) * 256 + vofs); }
        unsigned ykeep = 0u;
#pragma unroll 2
        for (int t = 0; t < T; ++t) {
            const float4 c0 = o0, c1 = o1, c2 = o2, c3 = o3, c4 = o4; const f32p v = ov;
            { const unsigned char* sb = cur + ((t + 1) & (T - 1)) * STEPB;
              o0 = *reinterpret_cast<const float4*>(sb + 0 * 256 + cg * 16); o1 = *reinterpret_cast<const float4*>(sb + 1 * 256 + cg * 16);
              if (KIND == 0) { o2 = *reinterpret_cast<const float4*>(sb + 2 * 256 + cg * 16); o3 = *reinterpret_cast<const float4*>(sb + 3 * 256 + cg * 16); o4 = *reinterpret_cast<const float4*>(sb + 4 * 256 + cg * 16); }
              ov = *reinterpret_cast<const f32p*>(sb + (NARR - 1) * 256 + vofs); }
            f32p y;
            if (KIND == 0) {
                f32p sa = P[0] * c0.x + P[1] * c0.y + P[2] * c0.z + P[3] * c0.w;
                sa = allsum16p(sa);
                P[0] = P[0] * c1.x - sa * c2.x + v * c3.x;
                P[1] = P[1] * c1.y - sa * c2.y + v * c3.y;
                P[2] = P[2] * c1.z - sa * c2.z + v * c3.z;
                P[3] = P[3] * c1.w - sa * c2.w + v * c3.w;
                y = P[0] * c4.x + P[1] * c4.y + P[2] * c4.z + P[3] * c4.w;
            } else {
                P[0] += (v - P[0]) * c0.x; P[1] += (v - P[1]) * c0.y; P[2] += (v - P[2]) * c0.z; P[3] += (v - P[3]) * c0.w;
                y = P[0] * c1.x + P[1] * c1.y + P[2] * c1.z + P[3] * c1.w;
            }
            y = allsum16p(y);
            const unsigned yp = pack_bf16(y.x, y.y);
            ykeep = ((t & 15) == cg) ? yp : ykeep;
            if ((t & 15) == 15) *reinterpret_cast<unsigned*>(ybuf + ((t & ~15) + cg) * 128 + (wave * 8 + rg * 2) * 2) = ykeep;
        }
        asm volatile("s_waitcnt lgkmcnt(0)" ::: "memory");
        __builtin_amdgcn_wave_barrier();
        if (lane < T) {
            const int t = ch * T + lane, s = d ? SEQ - 1 - t : t; const size_t n = (size_t)b * SEQ + s;
            const uint4 yv = *reinterpret_cast<const uint4*>(ybuf + lane * 128 + wave * 16);
            bf16* dst = KIND == 0 ? r7 + (d ? R_W1 : R_W0) * AS + n * 256 + h * 64 + wave * 8 : hh + n * 1280 + 256 + d * 256 + h * 64 + wave * 8;
            *reinterpret_cast<uint4*>(dst) = yv;
        }
        if (ch + 1 < SEQ / T) {
            unsigned char* nxt = (ch & 1) ? buf0 : buf1;
            STORE_PRE(nxt);
        }
        __syncthreads();
    }
#undef PIECE_PTR
#undef STORE_PRE
#undef PUT_PIECE
}
DI void phase_scans(const Frame& F) {
    const int nchain = 2 * BATCH * 4;
    for (int g = blockIdx.x; g < nchain / 2; g += F.nblk) {
        if (F.wv < 2) scan_rwkv_chunk(F, g * 2 + F.wv); else if (F.wv < 4) scan_hgrn_chunk(F, g * 2 + F.wv - 2);
    }
}
#else
DI void phase_scans(const Frame& F) {
    bf16* r7 = WSP(bf16, OFF_R7); const size_t AS = (size_t)NTOK * 256;
    bf16* hh = WSP(bf16, OFF_HHGRN);
    const int nitem = 2 * BATCH * 4 * 64 * 2;
    for (int it = wave_item_index(F); it < nitem; it += gthreads(F)) {
        const int kind = it / (2 * BATCH * 4 * 64);
        int c = (it % (2 * BATCH * 4 * 64)) / 64; const int i = it % 64;
        const int d = c / (BATCH * 4); c %= BATCH * 4; const int b = c / 4, h = c % 4;
        float S[64];
#pragma unroll
        for (int j = 0; j < 64; ++j) S[j] = 0.f;
        if (kind == 0) {
            const bf16* pr = r7 + R_R * AS, *pv = r7 + R_V * AS, *pkk = r7 + R_KK * AS;
            bf16* pw = r7 + (d ? R_W1 : R_W0) * AS; const bf16* pkd = r7 + (d ? R_KD1 : R_KD0) * AS, *pak = r7 + (d ? R_AK1 : R_AK0) * AS;
            for (int t = 0; t < SEQ; ++t) {
                const int s = d ? SEQ - 1 - t : t;
                const size_t o = ((size_t)(b * SEQ + s)) * 256 + h * 64;
                const float v = bf2f(pv[o + i]);
                float sa = 0.f;
#pragma unroll
                for (int j = 0; j < 64; ++j) sa += S[j] * bf2f(pkk[o + j]);
                float y = 0.f;
#pragma unroll
                for (int j = 0; j < 64; ++j) {
                    S[j] = S[j] * bf2f(pw[o + j]) - sa * bf2f(pak[o + j]) + v * bf2f(pkd[o + j]);
                    y += S[j] * bf2f(pr[o + j]);
                }
#ifndef CPU_EMU
                __builtin_amdgcn_wave_barrier();
#endif
#ifdef CPU_EMU
                WSP(bf16, OFF_EMU_SCAN)[(size_t)d * AS + (size_t)(b * SEQ + s) * 256 + h * 64 + i] = f2bf(y);
#else
                pw[o + i] = f2bf(y);
#endif
            }
        } else {
            const bf16* pq = hh; bf16* pk = hh + 256 + d * 256; const bf16* pi = hh + 768;
            for (int t = 0; t < SEQ; ++t) {
                const int s = d ? SEQ - 1 - t : t;
                const size_t o = ((size_t)(b * SEQ + s)) * 1280 + h * 64;
                const float v = bf2f(pi[o + i]);
                float acc = 0.f;
#pragma unroll
                for (int j = 0; j < 64; ++j) {
                    const float k = bf2f(pk[o + j]);
                    S[j] = S[j] + k * (v - S[j]);
                    acc += S[j] * bf2f(pq[o + j]);
                }
#ifndef CPU_EMU
                __builtin_amdgcn_wave_barrier();
#endif
#ifdef CPU_EMU
                WSP(bf16, OFF_EMU_SCAN)[(size_t)(2 + d) * AS + (size_t)(b * SEQ + s) * 256 + h * 64 + i] = f2bf(acc);
#else
                pk[o + i] = f2bf(acc);
#endif
            }
        }
    }
}

#endif

#ifndef CPU_EMU
DI void phase_fin_gpu(const Frame& F, int l) {
    const bf16* r7 = WSP(bf16, OFF_R7); const size_t AS = (size_t)NTOK * 256;
    const bf16* gb = WSP(bf16, OFF_G); const float* bonus = WSP(float, OFF_BONUS);
    const bf16* hh = WSP(bf16, OFF_HHGRN); bf16* ycat = WSP(bf16, OFF_YCAT);
    float* par = (float*)F.smem;
    __syncthreads();
    for (int i = F.tid; i < 768; i += NTH) par[i] = i < 256 ? F.in[17][l * 256 + i] : i < 512 ? F.in[18][l * 256 + i - 256] : F.in[20][l * 256 + i - 512];
    __syncthreads();
    {
        for (int item = blockIdx.x * 8 + F.wv; item < (NTOK / 16) * 4; item += F.nblk * 8) {
            const int lane = fresh_tid(F) & 63, x = lane & 15, q = lane >> 4;
            const int h = item & 3; const size_t n0 = (size_t)(item >> 2) * 16, blk = (size_t)item * 1024;
            const bf16* y0 = r7 + C_KT0 * AS + blk; const bf16* y1 = r7 + C_KT1 * AS + blk; const bf16* vt = r7 + C_VT * AS + blk;
            float y[4][4], v[4][4];
#pragma unroll
            for (int u = 0; u < 4; ++u) {
                const uint2 a = *reinterpret_cast<const uint2*>(y0 + (u * 64 + lane) * 4), b = *reinterpret_cast<const uint2*>(y1 + (u * 64 + lane) * 4), c = *reinterpret_cast<const uint2*>(vt + (u * 64 + lane) * 4);
                y[u][0] = bflo(a.x) + bflo(b.x); y[u][1] = bfhi(a.x) + bfhi(b.x); y[u][2] = bflo(a.y) + bflo(b.y); y[u][3] = bfhi(a.y) + bfhi(b.y);
                v[u][0] = bflo(c.x); v[u][1] = bfhi(c.x); v[u][2] = bflo(c.y); v[u][3] = bfhi(c.y);
            }
#pragma unroll
            for (int r = 0; r < 4; ++r) {
                const size_t n = n0 + 4 * q + r;
                const float mu = allsum16((y[0][r] + y[1][r]) + (y[2][r] + y[3][r])) * (1.0f / 64.0f);
                const float d0 = y[0][r] - mu, d1 = y[1][r] - mu, d2 = y[2][r] - mu, d3 = y[3][r] - mu;
                const float rs = 1.0f / sqrtf(allsum16((d0 * d0 + d1 * d1) + (d2 * d2 + d3 * d3)) * (1.0f / 64.0f) + GN_EPS);
                const float bo = bonus[n * 4 + h];
                const float dv[4] = {d0, d1, d2, d3};
#pragma unroll
                for (int u = 0; u < 4; ++u) {
                    const int c = h * 64 + 16 * u + x;
                    ycat[n * 1024 + 256 + c] = f2bf((dv[u] * rs * par[c] + par[256 + c] + bo * v[u][r]) * bf2f(gb[n * 256 + c]));
                }
            }
        }
    }
    for (int it = blockIdx.x * NTH + fresh_tid(F); it < NTOK * 4; it += gthreads(F)) {
        const int n = it >> 2, h = it & 3;
        const uint4* pa = reinterpret_cast<const uint4*>(hh + (size_t)n * 1280 + 256 + h * 64); const uint4* pb = reinterpret_cast<const uint4*>(hh + (size_t)n * 1280 + 512 + h * 64);
        float s2 = 0.f;
#pragma unroll
        for (int i = 0; i < 8; ++i) { const uint4 a = pa[i], b = pb[i];
            const float y0 = bflo(a.x) + bflo(b.x), y1 = bfhi(a.x) + bfhi(b.x), y2 = bflo(a.y) + bflo(b.y), y3 = bfhi(a.y) + bfhi(b.y);
            const float y4 = bflo(a.z) + bflo(b.z), y5 = bfhi(a.z) + bfhi(b.z), y6 = bflo(a.w) + bflo(b.w), y7 = bfhi(a.w) + bfhi(b.w);
            s2 += (y0 * y0 + y1 * y1) + (y2 * y2 + y3 * y3) + (y4 * y4 + y5 * y5) + (y6 * y6 + y7 * y7); }
        const float rs = 1.0f / sqrtf(s2 * (1.0f / 64.0f) + RMS_EPS);
        uint4* po = reinterpret_cast<uint4*>(ycat + (size_t)n * 1024 + 512 + h * 64);
        const uint4* pg = reinterpret_cast<const uint4*>(hh + (size_t)n * 1280 + 1024 + h * 64);
        const float* gg = par + 512 + h * 64;
#pragma unroll 2
        for (int i = 0; i < 8; ++i) { const uint4 a = pa[i], b = pb[i], g4 = pg[i];
            const float yv[8] = {bflo(a.x) + bflo(b.x), bfhi(a.x) + bfhi(b.x), bflo(a.y) + bflo(b.y), bfhi(a.y) + bfhi(b.y), bflo(a.z) + bflo(b.z), bfhi(a.z) + bfhi(b.z), bflo(a.w) + bflo(b.w), bfhi(a.w) + bfhi(b.w)};
            const float gf[8] = {bflo(g4.x), bfhi(g4.x), bflo(g4.y), bfhi(g4.y), bflo(g4.z), bfhi(g4.z), bflo(g4.w), bfhi(g4.w)};
            float o[8];
#pragma unroll
            for (int j = 0; j < 8; ++j) o[j] = yv[j] * rs * gg[8 * i + j] * (gf[j] * fast_sigmoid(gf[j]));
            po[i] = make_uint4(pack_bf16(o[0], o[1]), pack_bf16(o[2], o[3]), pack_bf16(o[4], o[5]), pack_bf16(o[6], o[7])); }
    }
}
#endif
DI void phase_fin(const Frame& F, int l) {
    const bf16* r7 = WSP(bf16, OFF_R7); const size_t AS = (size_t)NTOK * 256;
    const bf16* gb = WSP(bf16, OFF_G); const float* bonus = WSP(float, OFF_BONUS);
    const bf16* hh = WSP(bf16, OFF_HHGRN); bf16* ycat = WSP(bf16, OFF_YCAT);
    const float* gng = F.in[17] + l * 256; const float* gnb = F.in[18] + l * 256; const float* hng = F.in[20] + l * 256;
    for (int it = ggrp(F); it < NTOK * 8; it += ngrp(F)) {
        const int n = it >> 3, kind = (it >> 2) & 1, h = it & 3;
        float v[PER64];
        if (kind == 0) {
            float s1 = 0.f;
            for (int i = 0; i < PER64; ++i) { const int c = h * 64 + glane(F) + i * GRP; const size_t o = (size_t)n * 256 + c;
#ifdef CPU_EMU
                v[i] = bf2f(WSP(bf16, OFF_EMU_SCAN)[o]) + bf2f(WSP(bf16, OFF_EMU_SCAN)[AS + o]); s1 += v[i]; }
#else
                v[i] = bf2f(r7[R_W0 * AS + o]) + bf2f(r7[R_W1 * AS + o]); s1 += v[i]; }
#endif
            s1 = grp_sum(F, s1); const float mu = s1 * (1.0f / 64.0f);
            float s2 = 0.f; for (int i = 0; i < PER64; ++i) { const float dd = v[i] - mu; s2 += dd * dd; }
            s2 = grp_sum(F, s2); const float rs = 1.0f / sqrtf(s2 * (1.0f / 64.0f) + GN_EPS);
            const float bo = bonus[(size_t)n * 4 + h];
            for (int i = 0; i < PER64; ++i) { const int c = h * 64 + glane(F) + i * GRP; const size_t o = (size_t)n * 256 + c;
                const float y = (v[i] - mu) * rs * gng[c] + gnb[c];
                ycat[(size_t)n * 1024 + 256 + c] = f2bf((y + bo * bf2f(r7[R_V * AS + o])) * bf2f(gb[o])); }
        } else {
            float s2 = 0.f;
            for (int i = 0; i < PER64; ++i) { const int c = h * 64 + glane(F) + i * GRP; const size_t o = (size_t)n * 1280 + c;
#ifdef CPU_EMU
                const size_t oe = (size_t)n * 256 + c;
                v[i] = bf2f(WSP(bf16, OFF_EMU_SCAN)[2 * AS + oe]) + bf2f(WSP(bf16, OFF_EMU_SCAN)[3 * AS + oe]); s2 += v[i] * v[i]; }
#else
                v[i] = bf2f(hh[o + 256]) + bf2f(hh[o + 512]); s2 += v[i] * v[i]; }
#endif
            s2 = grp_sum(F, s2); const float rs = 1.0f / sqrtf(s2 * (1.0f / 64.0f) + RMS_EPS);
            for (int i = 0; i < PER64; ++i) { const int c = h * 64 + glane(F) + i * GRP; const size_t o = (size_t)n * 1280 + c;
                ycat[(size_t)n * 1024 + 512 + c] = f2bf(v[i] * rs * hng[c] * siluf_(bf2f(hh[o + 1024]))); }
        }
    }
}

struct EpiResid {
    float* xf; int row0, pn;
    DI void operator()(int r, int c, float a, float b, float cc, float d) const {
        float* p = xf + (size_t)(row0 + r) * DM + pn * 256 + c;
#ifndef CPU_EMU
        float4 x = *reinterpret_cast<float4*>(p);
        x.x = DN_ALPHA * x.x + a; x.y = DN_ALPHA * x.y + b; x.z = DN_ALPHA * x.z + cc; x.w = DN_ALPHA * x.w + d;
        *reinterpret_cast<float4*>(p) = x;
#else
        p[0] = DN_ALPHA * p[0] + a; p[1] = DN_ALPHA * p[1] + b; p[2] = DN_ALPHA * p[2] + cc; p[3] = DN_ALPHA * p[3] + d;
#endif
    }
};
#ifndef CPU_EMU
struct EpiResidFB {
    const float* xf; bf16* xb; int row0, pn;
    DI void operator()(int r, int c, float a, float b, float cc, float d) const {
        const size_t o = (size_t)(row0 + r) * DM + pn * 256 + c;
        const float4 x = *reinterpret_cast<const float4*>(xf + o);
        *reinterpret_cast<uint2*>(xb + o) = make_uint2(pack_bf16(DN_ALPHA * x.x + a, DN_ALPHA * x.y + b), pack_bf16(DN_ALPHA * x.z + cc, DN_ALPHA * x.w + d));
    }
};
struct EpiResidBB {
    bf16* xb; int row0, pn;
    DI void operator()(int r, int c, float a, float b, float cc, float d) const {
        const size_t o = (size_t)(row0 + r) * DM + pn * 256 + c;
        const uint2 x = *reinterpret_cast<const uint2*>(xb + o);
        *reinterpret_cast<uint2*>(xb + o) = make_uint2(pack_bf16(DN_ALPHA * bflo(x.x) + a, DN_ALPHA * bfhi(x.x) + b), pack_bf16(DN_ALPHA * bflo(x.y) + cc, DN_ALPHA * bfhi(x.y) + d));
    }
};
#endif
struct EpiBf {
    bf16* o; int ld; int row0, pn;
    DI void operator()(int r, int c, float a, float b, float cc, float d) const { st_bf16x4(o + (size_t)(row0 + r) * ld + pn * 256 + c, a, b, cc, d); }
};
template <int MODE>
DI void phase_gemm_sq(const Frame& F, const bf16* A, size_t woff, bf16* outb) {
    const bf16* W = (const bf16*)((const char*)WSP(bf16, OFF_WTS) + woff);
    const int nM = (NTOK + 255) / 256;
    for (int u = blockIdx.x; u < nM * 4; u += F.nblk) {
        const int pm = u >> 2, pn = u & 3;
#ifdef CPU_EMU
        const int mr = min(256, NTOK - pm * 256);
#endif
#ifndef CPU_EMU
        if (MODE == 0) { EpiResidFB E{F.xf, WSP(bf16, OFF_XB), pm * 256, pn}; gemm_unit(F, A, 1024, nullptr, pm * 256, W, 1024, pn * 256, 1024, E MR); }
        else if (MODE == 2) { EpiResidBB E{WSP(bf16, OFF_XB), pm * 256, pn}; gemm_unit(F, A, 1024, nullptr, pm * 256, W, 1024, pn * 256, 1024, E MR); }
#else
        if (MODE == 0 || MODE == 2) { EpiResid E{F.xf, pm * 256, pn}; gemm_unit(F, A, 1024, nullptr, pm * 256, W, 1024, pn * 256, 1024, E MR); }
#endif
        else { EpiBf E{outb, 1024, pm * 256, pn}; gemm_unit(F, A, 1024, nullptr, pm * 256, W, 1024, pn * 256, 1024, E MR); }
    }
}

template <bool BLOCKED = false>
DI void phase_ln(const Frame& F, const float* g, const float* b) {
#ifdef CPU_EMU
    const float* xf = F.xf;
    layer_norm_rows(F, g, b, [&](int row, int c) { return xf[(size_t)row * DM + c]; }, false, nullptr);
#else
    ln_rows_gpu<0, BLOCKED, BLOCKED>(F, g, b, 0);
#endif
}

#ifndef CPU_EMU
DI void phase_route_gpu(const Frame& F, int l) {
    const float* xf = F.xf; const float* gt = (const float*)((const char*)WSP(bf16, OFF_WTS) + W_GATE_T) + (size_t)l * 48 * 1024;
    const float* bg = F.in[34] + l * 4; const float* be = F.in[36] + l * 32;
    int* counts = (int*)(F.ws + CTL_CNT) + l * 32;
    int* lists = WSP(int, OFF_LISTS); float* tinfo = WSP(float, OFF_TINFO);
    const int tid = F.tid, wave = tid >> 6, lane = tid & 63, rr = lane & 15, kq = lane >> 4;
    float* lg = (float*)F.smem + wave * (16 * 48);
    const bool blk_ok = (NTOK % (F.nblk * 32) == 0);
    const int rpb = NTOK / F.nblk;
    int* hcnt = (int*)(F.smem + 32768); int* hbase = hcnt + 32;
    __syncthreads();
    const int rt_first = blk_ok ? 0 : blockIdx.x * 8, rt_lim = blk_ok ? rpb / 16 : NTOK / 16, rt_step = blk_ok ? 8 : F.nblk * 8;
    for (int rtb = rt_first; rtb < rt_lim; rtb += rt_step) {
        const int rt = rtb + wave; const bool live = rt < rt_lim;
        if (tid < 32) hcnt[tid] = 0;
        __syncthreads();
        int ea = 0, eb = 0, pa = 0, pb = 0, row = 0; float g0 = 0.f, g1 = 0.f;
        if (live) {
        const int r0 = blk_ok ? blockIdx.x * rpb + rt * 16 : rt * 16;
        f32x4 acc0 = {0.f, 0.f, 0.f, 0.f}, acc1 = acc0, acc2 = acc0;
        const float* xa = xf + (size_t)(r0 + rr) * DM + 4 * kq;
        const float* wb = gt + (size_t)rr * 1024 + 4 * kq;
#pragma unroll 1
        for (int kb = 0; kb < 1024; kb += 64) {
            float4 a[4], b0[4], b1[4], b2[4];
#pragma unroll
            for (int u = 0; u < 4; ++u) { const int k0 = kb + 16 * u;
                a[u] = *reinterpret_cast<const float4*>(xa + k0); b0[u] = *reinterpret_cast<const float4*>(wb + k0);
                b1[u] = *reinterpret_cast<const float4*>(wb + 16 * 1024 + k0); b2[u] = *reinterpret_cast<const float4*>(wb + 32 * 1024 + k0); }
#pragma unroll
            for (int u = 0; u < 4; ++u) {
                acc0 = __builtin_amdgcn_mfma_f32_16x16x4f32(a[u].x, b0[u].x, acc0, 0, 0, 0); acc1 = __builtin_amdgcn_mfma_f32_16x16x4f32(a[u].x, b1[u].x, acc1, 0, 0, 0); acc2 = __builtin_amdgcn_mfma_f32_16x16x4f32(a[u].x, b2[u].x, acc2, 0, 0, 0);
                acc0 = __builtin_amdgcn_mfma_f32_16x16x4f32(a[u].y, b0[u].y, acc0, 0, 0, 0); acc1 = __builtin_amdgcn_mfma_f32_16x16x4f32(a[u].y, b1[u].y, acc1, 0, 0, 0); acc2 = __builtin_amdgcn_mfma_f32_16x16x4f32(a[u].y, b2[u].y, acc2, 0, 0, 0);
                acc0 = __builtin_amdgcn_mfma_f32_16x16x4f32(a[u].z, b0[u].z, acc0, 0, 0, 0); acc1 = __builtin_amdgcn_mfma_f32_16x16x4f32(a[u].z, b1[u].z, acc1, 0, 0, 0); acc2 = __builtin_amdgcn_mfma_f32_16x16x4f32(a[u].z, b2[u].z, acc2, 0, 0, 0);
                acc0 = __builtin_amdgcn_mfma_f32_16x16x4f32(a[u].w, b0[u].w, acc0, 0, 0, 0); acc1 = __builtin_amdgcn_mfma_f32_16x16x4f32(a[u].w, b1[u].w, acc1, 0, 0, 0); acc2 = __builtin_amdgcn_mfma_f32_16x16x4f32(a[u].w, b2[u].w, acc2, 0, 0, 0);
            }
        }
#pragma unroll
        for (int r = 0; r < 4; ++r) { lg[(4 * kq + r) * 48 + rr] = acc0[r]; lg[(4 * kq + r) * 48 + 16 + rr] = acc1[r]; lg[(4 * kq + r) * 48 + 32 + rr] = acc2[r]; }
        asm volatile("s_waitcnt lgkmcnt(0)" ::: "memory");
        __builtin_amdgcn_wave_barrier();
        if (lane < 16) {
            row = r0 + lane; const float* L = lg + lane * 48;
            float gl[4];
#pragma unroll
            for (int q = 0; q < 4; ++q) gl[q] = L[q] + bg[q];
            int gi = 0; float gm = gl[0];
#pragma unroll
            for (int q = 1; q < 4; ++q) if (gl[q] > gm) { gm = gl[q]; gi = q; }
            float den = 0.f;
#pragma unroll
            for (int q = 0; q < 4; ++q) den += expf(gl[q] - gm);
            const float pgroup = 1.0f / den;
            float el[8];
#pragma unroll
            for (int q = 0; q < 8; ++q) el[q] = L[4 + gi * 8 + q] + be[gi * 8 + q];
            int i0 = 0; float v0 = el[0];
#pragma unroll
            for (int q = 1; q < 8; ++q) if (el[q] > v0) { v0 = el[q]; i0 = q; }
            int i1 = -1; float v1 = -INFINITY;
#pragma unroll
            for (int q = 0; q < 8; ++q) if (q != i0 && el[q] > v1) { v1 = el[q]; i1 = q; }
            const float e1 = expf(v1 - v0); g0 = pgroup / (1.0f + e1); g1 = pgroup * e1 / (1.0f + e1);
            ea = gi * 8 + i0; eb = gi * 8 + i1;
            pa = atomicAdd(&hcnt[ea], 1); pb = atomicAdd(&hcnt[eb], 1);
        }
        __builtin_amdgcn_wave_barrier();
        }
        __syncthreads();
        if (tid < 32) { const int c = hcnt[tid]; hbase[tid] = c ? atomicAdd(&counts[tid], c) : 0; }
        __syncthreads();
        if (live && lane < 16) {
            pa += hbase[ea]; pb += hbase[eb];
            lists[(size_t)ea * NTOK + pa] = row; lists[(size_t)eb * NTOK + pb] = row;
            int* ti = (int*)(tinfo + (size_t)row * 8);
            ti[0] = ea; ti[1] = pa; ti[2] = eb; ti[3] = pb; tinfo[(size_t)row * 8 + 4] = g0; tinfo[(size_t)row * 8 + 5] = g1;
        }
    }
}
#endif
DI void phase_route(const Frame& F, int l) {
    const float* xf = F.xf;
    const float* wg = F.in[33] + (size_t)l * 1024 * 4; const float* bg = F.in[34] + l * 4;
    const float* we = F.in[35] + (size_t)l * 1024 * 32; const float* be = F.in[36] + l * 32;
    int* counts = (int*)(F.ws + CTL_CNT) + l * 32;
    int* lists = WSP(int, OFF_LISTS); float* tinfo = WSP(float, OFF_TINFO);
    for (int row = ggrp(F); row < NTOK; row += ngrp(F)) {
        float gl[4] = {0.f, 0.f, 0.f, 0.f};
        for (int i = 0; i < PERLN; ++i) { const int c = glane(F) + i * GRP; const float x = xf[(size_t)row * DM + c];
#pragma unroll
            for (int q = 0; q < 4; ++q) gl[q] += x * wg[c * 4 + q]; }
#pragma unroll
        for (int q = 0; q < 4; ++q) gl[q] = grp_sum(F, gl[q]) + bg[q];
        int gi = 0; float gm = gl[0];
#pragma unroll
        for (int q = 1; q < 4; ++q) if (gl[q] > gm) { gm = gl[q]; gi = q; }
        float den = 0.f;
#pragma unroll
        for (int q = 0; q < 4; ++q) den += expf(gl[q] - gm);
        const float pgroup = 1.0f / den;
        float el[8] = {0.f, 0.f, 0.f, 0.f, 0.f, 0.f, 0.f, 0.f};
        for (int i = 0; i < PERLN; ++i) { const int c = glane(F) + i * GRP; const float x = xf[(size_t)row * DM + c];
#pragma unroll
            for (int q = 0; q < 8; ++q) el[q] += x * we[c * 32 + gi * 8 + q]; }
#pragma unroll
        for (int q = 0; q < 8; ++q) el[q] = grp_sum(F, el[q]) + be[gi * 8 + q];
        int i0 = 0; float v0 = el[0];
#pragma unroll
        for (int q = 1; q < 8; ++q) if (el[q] > v0) { v0 = el[q]; i0 = q; }
        int i1 = -1; float v1 = -INFINITY;
#pragma unroll
        for (int q = 0; q < 8; ++q) if (q != i0 && el[q] > v1) { v1 = el[q]; i1 = q; }
        const float e1 = expf(v1 - v0); const float g0 = pgroup / (1.0f + e1), g1 = pgroup * e1 / (1.0f + e1);
        if (glane(F) == 0) {
            const int ea = gi * 8 + i0, eb = gi * 8 + i1;
            const int pa = atomicAdd(&counts[ea], 1), pb = atomicAdd(&counts[eb], 1);
            lists[(size_t)ea * NTOK + pa] = row; lists[(size_t)eb * NTOK + pb] = row;
            int* ti = (int*)(tinfo + (size_t)row * 8);
            ti[0] = ea; ti[1] = pa; ti[2] = eb; ti[3] = pb; tinfo[(size_t)row * 8 + 4] = g0; tinfo[(size_t)row * 8 + 5] = g1;
        }
    }
}

struct EpiMoeUp {
    bf16* hm; int row0, pn;
    DI void operator()(int r, int c, float a, float b, float cc, float d) const {
        bf16* p = hm + (size_t)(row0 + r) * 256 + ((pn * 256 + c) >> 1);
        p[0] = f2bf(siluf_(a) * b); p[1] = f2bf(siluf_(cc) * d);
    }
};
DI int ld_cnt(const int* p) {
#ifdef CPU_EMU
    return *p;
#else
    return __hip_atomic_load(p, __ATOMIC_RELAXED, __HIP_MEMORY_SCOPE_AGENT);
#endif
}
DI void moe_tiles(const int* counts, int* toff  ) {
    __syncthreads();
    if (threadIdx.x == 0) { int acc = 0; for (int e = 0; e < NEXP; ++e) { toff[e] = acc; acc += (ld_cnt(counts + e) + 255) >> 8; } toff[NEXP] = acc; }
    __syncthreads();
}
DI void phase_moe_up(const Frame& F, int l) {
    const int* counts = (const int*)(F.ws + CTL_CNT) + l * 32;
    int* eoff = (int*)(F.ws + CTL_EOFF) + l * 33;
    int* rowmap = (int*)(F.smem + 131072);
    int* toff = rowmap + 256;
    moe_tiles(counts, toff);
    if (blockIdx.x == 0 && threadIdx.x == 0) for (int e = 0; e <= NEXP; ++e) eoff[e] = toff[e] * 256;
    const int* lists = WSP(int, OFF_LISTS); const bf16* xb = WSP(bf16, OFF_XB);
    const int nunit = toff[NEXP] * 2;
    for (int u = blockIdx.x; u < nunit; u += F.nblk) {
        const int tile = u >> 1, pn = u & 1;
        int e = 0; while (toff[e + 1] <= tile) ++e;
        const int t0 = (tile - toff[e]) * 256, cnt = ld_cnt(counts + e);
        __syncthreads();
        for (int i = fresh_tid(F); i < 256; i += NTH) rowmap[i] = (t0 + i < cnt) ? lists[(size_t)e * NTOK + t0 + i] : 0;
        __syncthreads();
        EpiMoeUp E{WSP(bf16, OFF_HM), tile * 256, pn};
        gemm_unit(F, xb, 1024, rowmap, 0, WSP(bf16, OFF_W13T) + (size_t)e * 512 * 1024, 1024, pn * 256, 1024, E);
    }
}
DI void phase_moe_down(const Frame& F, int l) {
    const int* counts = (const int*)(F.ws + CTL_CNT) + l * 32;
    int* toff = (int*)(F.smem + 131072) + 256;
    moe_tiles(counts, toff);
    const int nunit = toff[NEXP] * 4;
    for (int u = blockIdx.x; u < nunit; u += F.nblk) {
        const int tile = u >> 2, pn = u & 3;
        int e = 0; while (toff[e + 1] <= tile) ++e;
        EpiBf E{WSP(bf16, OFF_YROWS), 1024, tile * 256, pn};
        gemm_unit(F, WSP(bf16, OFF_HM), 256, nullptr, tile * 256, WSP(bf16, OFF_W2T) + (size_t)e * 1024 * 256, 256, pn * 256, 256, E);
    }
}
DI void phase_ln3(const Frame& F, int l) {
#ifndef CPU_EMU
    ln_rows_gpu<2>(F, F.in[40] + l * 1024, F.in[41] + l * 1024, l);
#else
    const float* xf = F.xf; const bf16* yr = WSP(bf16, OFF_YROWS); const float* tinfo = WSP(float, OFF_TINFO);
    const int* eoff = (const int*)(F.ws + CTL_EOFF) + l * 33;
    layer_norm_rows(F, F.in[40] + l * 1024, F.in[41] + l * 1024, [&](int row, int c) {
        const int* ti = (const int*)(tinfo + (size_t)row * 8);
        const size_t ra = (size_t)eoff[ti[0]] + ti[1], rb = (size_t)eoff[ti[2]] + ti[3];
        return DN_ALPHA * xf[(size_t)row * DM + c] + tinfo[(size_t)row * 8 + 4] * bf2f(yr[ra * 1024 + c]) + tinfo[(size_t)row * 8 + 5] * bf2f(yr[rb * 1024 + c]);
    }, false, nullptr);
#endif
}

#ifndef CPU_EMU
#define XB_TMO      128
#define XB_XCNT(j)  (256  + 64 * (j))
#define XB_XSUB(j)  (1280 + 64 * (j))
#define XB_XGEN(j)  (2304 + 64 * (j))
#define XB_TOP      3328
#define XB_TOPGEN   3392
#define XCD_BAR_WORDS 3456
#define XB_SPIN_CAP (1u << 18)
#define LAS __attribute__((address_space(3)))

__device__ __forceinline__ unsigned xb_ld(unsigned* p)              { return __hip_atomic_load(p, __ATOMIC_RELAXED, __HIP_MEMORY_SCOPE_AGENT); }
__device__ __forceinline__ unsigned xb_add(unsigned* p, unsigned v) { return __hip_atomic_fetch_add(p, v, __ATOMIC_RELAXED, __HIP_MEMORY_SCOPE_AGENT); }
__device__ __forceinline__ unsigned xb_xcc_id() { return (unsigned)__builtin_amdgcn_s_getreg((3 << 11) | 20) & 0xFu; }
#define XB_SPIN(cond, bar) do { unsigned _sp = 0; while (cond) { __builtin_amdgcn_s_sleep(1); \
    if ((++_sp & 255u) == 0u) { if (xb_ld(&(bar)[XB_TMO])) break; if (_sp > XB_SPIN_CAP) { atomicAdd(&(bar)[XB_TMO], 1u); break; } } } } while (0)

struct XcdBarrier {
    unsigned* bar; unsigned x;
    volatile LAS unsigned* st;
};

__device__ __forceinline__ XcdBarrier xcd_barrier_post(unsigned* bar, volatile LAS unsigned* st) {
    XcdBarrier b; b.bar = bar; b.x = xb_xcc_id(); b.st = st;
    if (threadIdx.x == 0) (void)xb_add(&bar[XB_XCNT(b.x)], 1u);
    return b;
}
__device__ __forceinline__ void xcd_barrier_complete(unsigned* bar, unsigned x, unsigned& nloc, unsigned& nx) {
    const unsigned G = gridDim.x * gridDim.y * gridDim.z;
    unsigned sum, cnt, mine, sp = 0u;
    for (;;) {
        sum = 0u; cnt = 0u; mine = 0u;
#pragma unroll
        for (unsigned j = 0; j < 16; ++j) { const unsigned c = xb_ld(&bar[XB_XCNT(j)]); sum += c; cnt += (c > 0u) ? 1u : 0u; mine = (j == x) ? c : mine; }
        if (sum == G) break;
        __builtin_amdgcn_s_sleep(1);
        if ((++sp & 255u) == 0u) { if (xb_ld(&bar[XB_TMO])) break; if (sp > XB_SPIN_CAP) { atomicAdd(&bar[XB_TMO], 1u); break; } }
    }
    nloc = mine > 0u ? mine : 1u; nx = cnt > 0u ? cnt : 1u;
}

__device__ __forceinline__ void xcd_barrier(const XcdBarrier& b) {
    asm volatile("s_waitcnt vmcnt(0)" ::: "memory");
    __syncthreads();
    if (threadIdx.x == 0) {
        unsigned* bar = b.bar;
        __builtin_amdgcn_s_waitcnt(0);
        unsigned nloc = b.st[0], nx = b.st[1];
        if (nloc == 0u) { xcd_barrier_complete(bar, b.x, nloc, nx); b.st[0] = nloc; b.st[1] = nx; }
        const unsigned old = xb_add(&bar[XB_XSUB(b.x)], 1u);
        const unsigned gen = old / nloc;
        if (old + 1u == (gen + 1u) * nloc) {
            __builtin_amdgcn_fence(__ATOMIC_RELEASE, "agent");
            asm volatile("s_waitcnt vmcnt(0)" ::: "memory");
            const unsigned og = xb_add(&bar[XB_TOP], 1u);
            const unsigned tg = og / nx;
            if (og + 1u == (tg + 1u) * nx) xb_add(&bar[XB_TOPGEN], 1u);
            else XB_SPIN(xb_ld(&bar[XB_TOPGEN]) == tg, bar);
            __builtin_amdgcn_fence(__ATOMIC_ACQUIRE, "agent");
            xb_add(&bar[XB_XGEN(b.x)], 1u);
            asm volatile("s_waitcnt vmcnt(0)" ::: "memory");
        } else {
            XB_SPIN(xb_ld(&bar[XB_XGEN(b.x)]) == gen, bar);
            __builtin_amdgcn_fence(__ATOMIC_ACQUIRE, "agent");
            asm volatile("s_waitcnt vmcnt(0)" ::: "memory");
        }
    }
    __syncthreads();
}

#endif

constexpr int NPH_LAYER = 16;
constexpr int NPH_TOTAL = 1 + 2 * NPH_LAYER;
constexpr int SMEM_BYTES = 158976 + 1024;

#ifndef CPU_EMU
DI void phase_attn_queue(const Frame& F, int l) {
    {
            const AttnDesc Ag = desc_gqa(F), Am = desc_mla(F);
            const int ng = attn_nunit<64, 64, 64, 2>(Ag), nm = attn_nunit<96, 64, 64, 1>(Am);
            unsigned* qctr = (unsigned*)(F.ws + CTL_QUEUE) + l * 64;
            volatile int* slot = (volatile int*)(F.smem + SMEM_BYTES - 32);
            for (;;) {
                __syncthreads();
                if (fresh_tid(F) == 0) *slot = (int)atomicAdd(qctr, 1u);
                __syncthreads();
                const int u = *slot;
                if (u >= ng + nm) break;
                if (u < ng) attn_unit<64, 64, 64, 2>(F, Ag, u); else attn_unit<96, 64, 64, 1>(F, Am, u - ng);
            }
        }
}
#endif

template <int K>
DI void run_layer_phase(const Frame& F, int l) {
    if constexpr (K == 0) phase_cvt(F, l);
    if constexpr (K == 1) phase_gemm1(F);
    if constexpr (K == 2) phase_prep(F, l);
    if constexpr (K == 3) phase_mlaup(F);
    if constexpr (K == 4) {
#ifdef CPU_EMU
        attn_phase<64, 64>(F, desc_gqa(F)); attn_phase<96, 64>(F, desc_mla(F)); phase_scans(F);
#else
        phase_scans(F);
        phase_attn_queue(F, l);
#endif
    }
#ifdef CPU_EMU
    if constexpr (K == 5) phase_fin(F, l);
#else
    if constexpr (K == 5) phase_fin_gpu(F, l);
#endif
    if constexpr (K == 6) phase_gemm_sq<0>(F, WSP(bf16, OFF_YCAT), W_OUT_T, nullptr);
    if constexpr (K == 7) phase_ln(F, F.in[26] + l * 1024, F.in[27] + l * 1024);
    if constexpr (K == 8) phase_gemm_sq<1>(F, WSP(bf16, OFF_XB), W_Q_T, WSP(bf16, OFF_QMEM));
    if constexpr (K == 9) {
#ifdef CPU_EMU
        attn_phase<256, 256>(F, desc_mem(F));
#else
        memattn_phase(F, desc_mem(F));
#endif
    }
    if constexpr (K == 10) phase_gemm_sq<2>(F, WSP(bf16, OFF_OMEM), W_O_T, nullptr);
    if constexpr (K == 11) { phase_ln<true>(F, F.in[31] + l * 1024, F.in[32] + l * 1024); phase_cvt_moe(F, l); }
#ifdef CPU_EMU
    if constexpr (K == 12) phase_route(F, l);
#else
    if constexpr (K == 12) phase_route_gpu(F, l);
#endif
    if constexpr (K == 13) phase_moe_up(F, l);
    if constexpr (K == 14) phase_moe_down(F, l);
    if constexpr (K == 15) phase_ln3(F, l);
}

#ifndef CPU_EMU
template <int K>
__global__ void __launch_bounds__(512, 2) k_phase(Args a, int l) {
    extern __shared__ __attribute__((aligned(16))) unsigned char lds[];
    Frame F; F.in = (InPtr)__builtin_amdgcn_kernarg_segment_ptr(); F.xf = a.out; F.ws = a.ws; F.smem = lds; F.tid = threadIdx.x; F.wv = __builtin_amdgcn_readfirstlane((int)(threadIdx.x >> 6)); F.nblk = a.ph_lo;
    if constexpr (K < 0) phase_pro(F); else run_layer_phase<K>(F, l);
}

template <int K>
static void launch_phase(const Args& a, int l, int grid, hipStream_t stream) {
    static bool attr = false;
    if (!attr) { (void)hipFuncSetAttribute((const void*)k_phase<K>, hipFuncAttributeMaxDynamicSharedMemorySize, SMEM_BYTES); attr = true; }
    hipLaunchKernelGGL(k_phase<K>, dim3(grid), dim3(512), SMEM_BYTES, stream, a, l);
}

__global__ void __launch_bounds__(512, 2) fwd_one(Args a) {
    extern __shared__ __attribute__((aligned(16))) unsigned char lds[];
    const int wave_s = __builtin_amdgcn_readfirstlane((int)(threadIdx.x >> 6));
    volatile LAS unsigned* st = (volatile LAS unsigned*)(lds + SMEM_BYTES - 16);
    if (threadIdx.x == 0) { st[0] = 0u; st[1] = 0u; st[2] = 0u; st[3] = 0u; }
    __syncthreads();
    XcdBarrier bar = xcd_barrier_post((unsigned*)(a.ws + OFF_CTL), st);
    Frame F;
#define FRESH do { unsigned z_ = 0u, m_ = ~0u; int ws_ = wave_s; asm volatile("" : "+s"(z_), "+s"(ws_), "+s"(m_)); \
        int t_ = ws_ * 64 + (int)__builtin_amdgcn_mbcnt_hi(m_, __builtin_amdgcn_mbcnt_lo(m_, 0u)); asm volatile("" : "+v"(t_)); \
        const __attribute__((address_space(4))) char* kp_ = (const __attribute__((address_space(4))) char*)__builtin_amdgcn_kernarg_segment_ptr() + z_; \
        F.in = (InPtr)kp_; F.xf = *(float* const __attribute__((address_space(4)))*)(kp_ + 42 * 8); F.ws = *(unsigned char* const __attribute__((address_space(4)))*)(kp_ + 43 * 8); \
        F.smem = lds; F.tid = t_; F.wv = ws_; F.nblk = *(const int __attribute__((address_space(4)))*)(kp_ + 44 * 8); } while (0)
#define GB do { { unsigned zb_ = 0u; unsigned xx_ = __builtin_amdgcn_readfirstlane(bar.x); asm volatile("" : "+s"(zb_), "+s"(xx_)); bar.bar = (unsigned*)(a.ws + OFF_CTL) + zb_; bar.x = xx_; } \
        xcd_barrier(bar); } while (0)
#define DUP(k) ((PROBE_DUP >> (k)) & 1)
    FRESH; phase_pro(F); FRESH; phase_cvt(F, 0); GB;
    if (DUP(0)) { FRESH; phase_cvt(F, 0); GB; }
    for (int l = 0; l < 2; ++l) {
        FRESH; run_layer_phase<1>(F, l); GB;
        if (DUP(1)) { FRESH; run_layer_phase<1>(F, l); GB; }
        FRESH; run_layer_phase<2>(F, l); GB;
        FRESH; run_layer_phase<3>(F, l); GB;
        if (DUP(3)) { FRESH; run_layer_phase<3>(F, l); GB; }
        if (DUP(4)) { FRESH; attn_phase<64, 64, 64, 2>(F, desc_gqa(F)); attn_phase<96, 64, 64, 1>(F, desc_mla(F)); GB; }
        FRESH; run_layer_phase<4>(F, l); GB;
        FRESH; run_layer_phase<5>(F, l); GB;
        if (DUP(5)) { FRESH; run_layer_phase<5>(F, l); GB; }
        FRESH; run_layer_phase<6>(F, l); GB;
        FRESH; run_layer_phase<7>(F, l); GB;
        FRESH; run_layer_phase<8>(F, l); GB;
        if (DUP(8)) { FRESH; run_layer_phase<8>(F, l); GB; }
        FRESH; run_layer_phase<9>(F, l); GB;
        if (DUP(9)) { FRESH; run_layer_phase<9>(F, l); GB; }
        FRESH; run_layer_phase<10>(F, l); GB;
        FRESH; run_layer_phase<11>(F, l); if (NTOK % (F.nblk * 32) != 0) GB; FRESH; run_layer_phase<12>(F, l); if (l == 0) { FRESH; phase_cvt(F, 1); } GB;
        if (DUP(11)) { FRESH; phase_cvt_moe(F, l); GB; }
        FRESH; run_layer_phase<13>(F, l); GB;
        if (DUP(13)) { FRESH; run_layer_phase<13>(F, l); GB; }
        FRESH; run_layer_phase<14>(F, l); GB;
        if (DUP(14)) { FRESH; run_layer_phase<14>(F, l); GB; }
        FRESH; run_layer_phase<15>(F, l); if (l == 0) GB;
    }
#undef DUP
#undef GB
#undef FRESH
}

extern "C" void kernel_launch(void* const* d_in, const int* in_sizes, int n_in, void* d_out, int out_size, void* d_ws, size_t ws_size, hipStream_t stream) {
    if (n_in != 42 || ws_size < WS_END) return;
    Args a{};
    for (int i = 0; i < 42; ++i) a.in[i] = (const float*)d_in[i];
    a.out = (float*)d_out; a.ws = (unsigned char*)d_ws; a.ph_lo = 0; a.ph_hi = NPH_TOTAL;
    (void)hipMemsetAsync(d_ws, 0, CTL_BYTES, stream);
#if N_LAUNCH_MODE == 1
    static int grid = 0;
    if (!grid) {
        int dev = 0, cus = 0, per_cu = 0;
        (void)hipGetDevice(&dev);
        (void)hipDeviceGetAttribute(&cus, hipDeviceAttributeMultiprocessorCount, dev);
        (void)hipFuncSetAttribute((const void*)fwd_one, hipFuncAttributeMaxDynamicSharedMemorySize, SMEM_BYTES);
        (void)hipOccupancyMaxActiveBlocksPerMultiprocessor(&per_cu, (const void*)fwd_one, 512, SMEM_BYTES);
        (void)hipGetLastError();
        grid = cus > 0 ? cus : 256;
    }
    a.ph_lo = grid;
    hipLaunchKernelGGL(fwd_one, dim3(grid), dim3(512), SMEM_BYTES, stream, a);
#else
    const int grid = 256; a.ph_lo = grid;
    launch_phase<-1>(a, 0, grid, stream);
    for (int l = 0; l < 2; ++l) {
        launch_phase<0>(a, l, grid, stream); launch_phase<1>(a, l, grid, stream); launch_phase<2>(a, l, grid, stream); launch_phase<3>(a, l, grid, stream);
        launch_phase<4>(a, l, grid, stream); launch_phase<5>(a, l, grid, stream); launch_phase<6>(a, l, grid, stream); launch_phase<7>(a, l, grid, stream);
        launch_phase<8>(a, l, grid, stream); launch_phase<9>(a, l, grid, stream); launch_phase<10>(a, l, grid, stream); launch_phase<11>(a, l, grid, stream);
        launch_phase<12>(a, l, grid, stream); launch_phase<13>(a, l, grid, stream); launch_phase<14>(a, l, grid, stream); launch_phase<15>(a, l, grid, stream);
    }
#endif
}
#endif
```

```cpp
#ifndef CPU_EMU
#include <hip/hip_runtime.h>
#else
#include "emu_shim.h"
#endif
#include <stdint.h>

#ifndef CFG_B
#define CFG_B 16
#endif
#ifndef CFG_S
#define CFG_S 2048
#endif
#ifndef PROBE_DUP
#define PROBE_DUP 0
#endif
#ifndef N_LAUNCH_MODE
#define N_LAUNCH_MODE 1
#endif

typedef unsigned short bf16;
#define DI __device__ __forceinline__

constexpr int BATCH = CFG_B, SEQ = CFG_S, NTOK = BATCH * SEQ, DM = 1024;
constexpr int MEMT = 256, NMEM = BATCH * MEMT;
constexpr int GRIDW = 64;
constexpr int HP = 3328;
constexpr int IN_WIDTH = 3104;
constexpr int NEXP = 32, MOEH = 256;
constexpr int MOE_ROWS = 2 * NTOK + NEXP * 256;
constexpr float LN_EPS = 1e-5f, RMS_EPS = 1e-6f, GN_EPS = 64e-5f;
constexpr float DN_ALPHA = 1.41421356237309515f;
constexpr float DECAY_SCALE = 0.60653065971263342f;

constexpr size_t AL(size_t x) { return (x + 255) & ~(size_t)255; }
constexpr size_t OFF_CTL = 0;
constexpr size_t CTL_BYTES = 32768;
constexpr size_t CTL_CNT = 16384;
constexpr size_t CTL_EOFF = 16384 + 1024;
constexpr size_t CTL_QUEUE = 16384 + 2048;
constexpr size_t CTL_MOEQ = 16384 + 3072;
constexpr size_t CTL_MOED = 16384 + 4096;
constexpr size_t CTL_AQ = 16384 + 7168;
constexpr size_t OFF_XB = AL(OFF_CTL + CTL_BYTES);
constexpr size_t SZ_XB = (size_t)NTOK * DM * 2;
constexpr size_t OFF_WTS = AL(OFF_XB + SZ_XB);
constexpr size_t W_IN_T = 0;
constexpr size_t W_UQ_T = W_IN_T + (size_t)HP * 1024 * 2;
constexpr size_t W_UKV_T = W_UQ_T + 512 * 256 * 2;
constexpr size_t W_OUT_T = W_UKV_T + 512 * 256 * 2;
constexpr size_t W_Q_T = W_OUT_T + 1024 * 1024 * 2;
constexpr size_t W_KV_T = W_Q_T + 1024 * 1024 * 2;
constexpr size_t W_O_T = W_KV_T + 2048 * 1024 * 2;
constexpr size_t W_GATE_T = W_O_T + 1024 * 1024 * 2;
constexpr size_t SZ_WTS = W_GATE_T + 2 * 48 * 1024 * 4;
constexpr size_t OFF_KMEM = AL(OFF_WTS + SZ_WTS);
constexpr size_t OFF_VTMEM = AL(OFF_KMEM + (size_t)NMEM * 1024 * 2);
constexpr size_t OFF_MEMB = AL(OFF_VTMEM + (size_t)NMEM * 1024 * 2);
constexpr size_t OFF_VTATT = AL(OFF_MEMB + (size_t)NMEM * 1024 * 2);
constexpr size_t OFF_VTMLA = AL(OFF_VTATT + (size_t)BATCH * 2 * 64 * SEQ * 2);
constexpr size_t OFF_HATT = AL(OFF_VTMLA + (size_t)BATCH * 4 * 64 * SEQ * 2);
constexpr size_t OFF_HMLA = OFF_HATT + (size_t)NTOK * 512 * 2;
constexpr size_t OFF_HRWKV = OFF_HMLA + (size_t)NTOK * 512 * 2;
constexpr size_t OFF_R7 = OFF_HRWKV + (size_t)NTOK * 1024 * 2;
constexpr size_t SZ_R7 = (size_t)NTOK * 9 * 256 * 2;
constexpr size_t OFF_HHGRN = OFF_R7 + SZ_R7;
constexpr size_t OFF_HX = OFF_HHGRN + (size_t)NTOK * 1280 * 2;
constexpr size_t OFF_HAM = OFF_HX + (size_t)NTOK * 256 * 2;
constexpr size_t OFF_HEG = OFF_HAM + (size_t)(NTOK / 16) * 8 * 256 * 2;
constexpr size_t OFF_REG = OFF_HEG + (size_t)(NTOK / 16) * 8 * 64 * 4;
constexpr size_t WS_END = OFF_REG + (size_t)(NTOK / 16) * 8 * 64 * 2;
static_assert(WS_END <= (size_t)4 * NTOK * DM * 4 || CFG_B != 16, "workspace must fit 4 x the largest tensor");

#ifdef CPU_EMU
constexpr size_t XTAG = 0;
constexpr size_t OFF_QMLA = OFF_XB;
#else
constexpr size_t XTAG = (size_t)1 << 62;
constexpr size_t OFF_QMLA = XTAG;
#endif
constexpr size_t OFF_KNOPE = OFF_QMLA + (size_t)NTOK * 384 * 2;
constexpr size_t OFF_KROPE = OFF_KNOPE + (size_t)NTOK * 256 * 2;
constexpr size_t OFF_G = OFF_KROPE + (size_t)NTOK * 32 * 2;
constexpr size_t OFF_BONUS = OFF_G + (size_t)NTOK * 256 * 2;
constexpr size_t OFF_RSIDE = OFF_BONUS + (size_t)NTOK * 16;
#ifdef CPU_EMU
static_assert(OFF_RSIDE + (size_t)(NTOK / 16) * 2 * 512 * 2 <= OFF_XB + SZ_XB, "xb alias region");
#else
static_assert(((OFF_RSIDE & ~XTAG) + (size_t)(NTOK / 16) * 2 * 512 * 2) <= (size_t)NTOK * DM * 4, "output-buffer alias region");
#endif
constexpr size_t OFF_YCAT = OFF_HRWKV;
constexpr size_t OFF_QMEM = OFF_HATT;
constexpr size_t OFF_OMEM = OFF_R7;
#ifdef CPU_EMU
constexpr size_t OFF_EMU_SCAN = WS_END;
constexpr size_t OFF_LISTS = AL(OFF_EMU_SCAN + (size_t)4 * NTOK * 256 * 2);
#else
constexpr size_t OFF_LISTS = OFF_HATT;
#endif
constexpr size_t OFF_TINFO = OFF_LISTS + (size_t)NEXP * NTOK * 4;
constexpr size_t OFF_HM = AL(OFF_TINFO + (size_t)NTOK * 32);
constexpr size_t OFF_YROWS = AL(OFF_HM + (size_t)MOE_ROWS * 256 * 2);
#ifdef CPU_EMU
constexpr size_t OFF_W13T = AL(OFF_YROWS + (size_t)MOE_ROWS * 1024 * 2);
#else
static_assert(OFF_YROWS + (size_t)MOE_ROWS * 1024 * 2 <= OFF_HHGRN, "moe alias region");
constexpr size_t OFF_W13T = XTAG | ((size_t)NTOK * DM * 2);
#endif
constexpr size_t OFF_W2T = OFF_W13T + (size_t)NEXP * 512 * 1024 * 2;
#ifdef CPU_EMU
constexpr size_t WS_END_EMU = OFF_W2T + (size_t)NEXP * 1024 * 256 * 2;
#else
static_assert(((OFF_W2T & ~XTAG) + (size_t)NEXP * 1024 * 256 * 2) <= (size_t)NTOK * DM * 4, "moe weights in the output buffer");
#endif

enum { C_KT0 = 0, C_KT1 = 1, C_RT0 = 2, C_RT1 = 3, C_KK0 = 4, C_KK1 = 5, C_AT0 = 6, C_AT1 = 7, C_VT = 8 };
enum { R_R = 0, R_V = 1, R_KK = 2, R_W0 = 3, R_W1 = 4, R_KD0 = 5, R_KD1 = 6, R_AK0 = 7, R_AK1 = 8 };

DI float bf2f(bf16 v) { union { unsigned u; float f; } x; x.u = (unsigned)v << 16; return x.f; }
#ifdef CPU_EMU
DI bf16 f2bf(float f) { union { unsigned u; float f; } x; x.f = f; unsigned u = x.u; u += 0x7fffu + ((u >> 16) & 1u); return (bf16)(u >> 16); }
#else
DI bf16 f2bf(float f) { return __builtin_bit_cast(bf16, (__bf16)f); }
#endif
DI float sigmoidf_(float x) { return 1.0f / (1.0f + expf(-x)); }
DI float siluf_(float x) { return x * sigmoidf_(x); }

#ifdef CPU_EMU
typedef const float* const* InPtr;
#else
typedef const float* const __attribute__((address_space(4)))* InPtr;
#endif
struct Frame {
    InPtr in;
    float* xf;
    unsigned char* ws;
    unsigned char* smem;
    int tid;
    int wv;
    int nblk;
};
#ifdef CPU_EMU
constexpr int NTH = 1;
#else
constexpr int NTH = 512;
#endif
#ifdef CPU_EMU
constexpr int GRP = 1;
DI float grp_sum(const Frame& F, float v) { return v; }
DI int gthreads(const Frame& F) { return 1; }
DI int gtid_(const Frame& F) { return 0; }
DI int wave_item_index(const Frame& F) { return 0; }
#else
constexpr int GRP = 64;
DI float shfl_idx(const Frame& F, float v, int src_lane) { return __builtin_bit_cast(float, __builtin_amdgcn_ds_bpermute(src_lane << 2, __builtin_bit_cast(int, v))); }
DI float shfl_xor(const Frame& F, float v, int mask) {
    unsigned m0 = ~0u; asm volatile("" : "+s"(m0));
    const int lane = (int)__builtin_amdgcn_mbcnt_hi(m0, __builtin_amdgcn_mbcnt_lo(m0, 0u));
    return shfl_idx(F, v, lane ^ mask); }
template <int CTRL> DI float dppf(float x) { return __builtin_bit_cast(float, __builtin_amdgcn_update_dpp(0, __builtin_bit_cast(int, x), CTRL, 0xf, 0xf, true)); }
DI float allsum16(float x) { x += dppf<0xB1>(x); x += dppf<0x4E>(x); x += dppf<0x141>(x); x += dppf<0x140>(x); return x; }
DI float rdlane(float x, int l) { return __builtin_bit_cast(float, __builtin_amdgcn_readlane(__builtin_bit_cast(int, x), l)); }
DI float grp_sum(const Frame& F, float v) { v = allsum16(v); return (rdlane(v, 0) + rdlane(v, 16)) + (rdlane(v, 32) + rdlane(v, 48)); }
DI int gthreads(const Frame& F) { return F.nblk * NTH; }
DI int gtid_(const Frame& F) { return blockIdx.x * NTH + F.tid; }
DI int wave_item_index(const Frame& F) { return (int)(((F.tid >> 6) * F.nblk + blockIdx.x) * 64 + (F.tid & 63)); }
#endif
constexpr int PER64 = 64 / GRP;
constexpr int PERLN = 1024 / GRP;
DI int fresh_tid(const Frame& F) {
#ifdef CPU_EMU
    return 0;
#else
    unsigned m0 = ~0u; asm volatile("" : "+s"(m0));
    int t = F.wv * 64 + (int)__builtin_amdgcn_mbcnt_hi(m0, __builtin_amdgcn_mbcnt_lo(m0, 0u)); asm volatile("" : "+v"(t)); return t;
#endif
}
DI int glane(const Frame& F) { return (int)(F.tid % GRP); }
DI int ggrp(const Frame& F) { return gtid_(F) / GRP; }
DI int ngrp(const Frame& F) { return gthreads(F) / GRP; }

struct Args {
    const float* in[42];
    float* out;
    unsigned char* ws;
    int ph_lo, ph_hi;
};

DI float rope_inv(int f, int nf) { return powf(10000.0f, -(float)f / (float)nf); }

#ifndef CPU_EMU
using bf16x8 = __attribute__((ext_vector_type(8))) short;
using bf16x4 = __attribute__((ext_vector_type(4))) short;
using f32x4 = __attribute__((ext_vector_type(4))) float;
using f32x16 = __attribute__((ext_vector_type(16))) float;
typedef __bf16 bf16v2 __attribute__((ext_vector_type(2)));
typedef float f32v2 __attribute__((ext_vector_type(2)));
DI float bflo(unsigned u) { return __uint_as_float(u << 16); }
DI float bfhi(unsigned u) { return __uint_as_float(u & 0xffff0000u); }
DI unsigned pack_bf16(float lo, float hi) { f32v2 v = {lo, hi}; bf16v2 b = __builtin_convertvector(v, bf16v2); return __builtin_bit_cast(unsigned, b); }

constexpr int G_BM = 256, G_BK = 64, G_HALF = 128, G_HT = G_HALF * G_BK, G_SHM = 8 * G_HT * 2;
DI int g_lds_byte(int r, int c) { int st = (r >> 4) * 2 + (c >> 5), rr = r & 15, cc = c & 31, ob = rr * 64 + cc * 2; return st * 1024 + (ob ^ (((ob >> 9) & 1) << 5)); }
DI void g_stage_rc(int b, int& R, int& C) { int st = b / 1024, sb = b % 1024, swz = sb ^ (((sb >> 9) & 1) << 5); R = (st >> 1) * 16 + swz / 64; C = (st & 1) * 32 + (swz % 64) / 2; }

template <class E> DI auto epi_wide(const E& e, int r, int c, const f32x4& u, const f32x4& v, int) -> decltype(e.wide(r, c, u, v), void()) { e.wide(r, c, u, v); }
template <class E> DI void epi_wide(const E& e, int r, int c, const f32x4& u, const f32x4& v, long) { e(r, c, u[0], u[1], u[2], u[3]); e(r, c + 4, v[0], v[1], v[2], v[3]); }
template <bool GATHER, class Epi>
DI void gemm_unit_t(int wv_in, bf16* shm, const bf16* __restrict__ A, int lda, const int* rowmap, int arow0,
                    const bf16* __restrict__ Bt, int ldb, int bcol0, int K, const Epi& epi) {
#define SA(b, h) (shm + ((b) * 2 + (h)) * G_HT)
#define SB(b, h) (shm + (4 + (b) * 2 + (h)) * G_HT)
#define STAGE_AX(T, P, hf, kt) do { for (int _i = 0; _i < 2; ++_i) { int _b = (T) * 16 + _i * 8192; int _r, _c; g_stage_rc(_b, _r, _c); \
        const long _row = GATHER ? (long)rowmap[(hf) * G_HALF + _r] : (long)(arow0 + (hf) * G_HALF + _r); \
        __builtin_amdgcn_global_load_lds((const unsigned*)(A + _row * lda + (long)(kt) * G_BK + _c), (unsigned*)((char*)(P) + _b), 16, 0, 0); } } while (0)
#define STAGE_BX(T, P, hf, kt) do { for (int _i = 0; _i < 2; ++_i) { int _b = (T) * 16 + _i * 8192; int _r, _c; g_stage_rc(_b, _r, _c); \
        _r = (_r & ~31) | (((_r & 15) >> 2) << 3) | (((_r >> 4) & 1) << 2) | (_r & 3);     \
        __builtin_amdgcn_global_load_lds((const unsigned*)(Bt + (long)(bcol0 + (hf) * G_HALF + _r) * ldb + (long)(kt) * G_BK + _c), (unsigned*)((char*)(P) + _b), 16, 0, 0); } } while (0)
#define STAGE_A(P, hf, kt) STAGE_AX(t0, P, hf, kt)
#define STAGE_B(P, hf, kt) STAGE_BX(t0, P, hf, kt)
#define LDA(dst, b, h) for (int m = 0; m < 4; ++m) for (int k = 0; k < 2; ++k) \
        dst[m][k] = *reinterpret_cast<const bf16x8*>((char*)SA(b, h) + g_lds_byte(wr * 64 + m * 16 + fr, k * 32 + fq * 8))
#define LDB(dst, b, h) for (int n = 0; n < 2; ++n) for (int k = 0; k < 2; ++k) \
        dst[n][k] = *reinterpret_cast<const bf16x8*>((char*)SB(b, h) + g_lds_byte(wc * 32 + n * 16 + fr, k * 32 + fq * 8))
#define MMA(ai, bj, At, Bt_) do { __builtin_amdgcn_s_setprio(1); \
        for (int m = 0; m < 4; ++m) for (int n = 0; n < 2; ++n) for (int k = 0; k < 2; ++k) \
            acc[ai][bj][m][n] = __builtin_amdgcn_mfma_f32_16x16x32_bf16(Bt_[n][k], At[m][k], acc[ai][bj][m][n], 0, 0, 0); \
        __builtin_amdgcn_s_setprio(0); } while (0)
#define WAIT_V(n) asm volatile("s_waitcnt vmcnt(" #n ")" ::: "memory")
#define WAIT_L(n) asm volatile("s_waitcnt lgkmcnt(" #n ")" ::: "memory")
#define BAR __builtin_amdgcn_s_barrier()
#define SCHED __builtin_amdgcn_sched_barrier(0)
    unsigned m0 = ~0u; asm volatile("" : "+s"(m0));
    int t0 = wv_in * 64 + (int)__builtin_amdgcn_mbcnt_hi(m0, __builtin_amdgcn_mbcnt_lo(m0, 0u)); asm volatile("" : "+v"(t0));
    int wid = t0 >> 6, lane = t0 & 63, wr = wid >> 2, wc = wid & 3, fr = lane & 15, fq = lane >> 4;
    f32x4 acc[2][2][4][2] = {};
    bf16x8 At[4][2], B0[2][2], B1[2][2];
    const int nt = K / G_BK;
    STAGE_B(SB(0, 0), 0, 0); STAGE_A(SA(0, 0), 0, 0);
    STAGE_B(SB(0, 1), 1, 0); STAGE_A(SA(0, 1), 1, 0);
    if (wr == 1) BAR;
    WAIT_V(4); BAR;
    STAGE_B(SB(1, 0), 0, 1); STAGE_A(SA(1, 0), 0, 1); STAGE_B(SB(1, 1), 1, 1);
    WAIT_V(6); BAR;
    for (int t = 0; t < nt - 2; t += 2) {
        LDB(B0, 0, 0); SCHED; LDA(At, 0, 0); STAGE_A(SA(1, 1), 1, t + 1);
        WAIT_L(8); BAR; WAIT_L(0); MMA(0, 0, At, B0); BAR; SCHED;
        LDB(B1, 0, 1); STAGE_B(SB(0, 0), 0, t + 2);
        BAR; WAIT_L(0); MMA(0, 1, At, B1); BAR;
        LDA(At, 0, 1); STAGE_A(SA(0, 0), 0, t + 2);
        BAR; WAIT_L(0); MMA(1, 0, At, B0); BAR; SCHED;
        STAGE_B(SB(0, 1), 1, t + 2);
        WAIT_V(6); BAR; MMA(1, 1, At, B1); BAR;
        LDB(B0, 1, 0); SCHED; LDA(At, 1, 0); STAGE_A(SA(0, 1), 1, t + 2);
        WAIT_L(8); BAR; WAIT_L(0); MMA(0, 0, At, B0); BAR; SCHED;
        LDB(B1, 1, 1); STAGE_B(SB(1, 0), 0, t + 3);
        BAR; WAIT_L(0); MMA(0, 1, At, B1); BAR;
        LDA(At, 1, 1); STAGE_A(SA(1, 0), 0, t + 3);
        BAR; WAIT_L(0); MMA(1, 0, At, B0); BAR; SCHED;
        STAGE_B(SB(1, 1), 1, t + 3);
        WAIT_V(6); BAR; MMA(1, 1, At, B1); BAR;
    }
    int tz = t0; asm volatile("" : "+v"(tz)); wid = tz >> 6; lane = tz & 63; wr = wid >> 2; wc = wid & 3; fr = lane & 15; fq = lane >> 4;
    { LDB(B0, 0, 0); WAIT_V(0); LDA(At, 0, 0); STAGE_AX(tz, SA(1, 1), 1, nt - 1);
      BAR; WAIT_L(0); MMA(0, 0, At, B0); BAR;
      LDB(B1, 0, 1); BAR; WAIT_L(0); MMA(0, 1, At, B1); BAR;
      LDA(At, 0, 1); WAIT_V(4); BAR; WAIT_L(0); MMA(1, 0, At, B0); MMA(1, 1, At, B1); BAR; }
    { LDB(B0, 1, 0); LDA(At, 1, 0); WAIT_V(2); BAR; WAIT_L(0); MMA(0, 0, At, B0); BAR;
      LDB(B1, 1, 1); WAIT_V(0); BAR; WAIT_L(0); MMA(0, 1, At, B1); BAR;
      LDA(At, 1, 1); BAR; WAIT_L(0); MMA(1, 0, At, B0); MMA(1, 1, At, B1); BAR; }
    if (wr == 0) BAR;
#pragma unroll
    for (int ai = 0; ai < 2; ++ai)
#pragma unroll
        for (int m = 0; m < 4; ++m)
#pragma unroll
            for (int bj = 0; bj < 2; ++bj)
                epi_wide(epi, ai * G_HALF + wr * 64 + m * 16 + fr, bj * G_HALF + wc * 32 + fq * 8, acc[ai][bj][m][0], acc[ai][bj][m][1], 0);
#undef SA
#undef SB
#undef STAGE_A
#undef STAGE_B
#undef STAGE_AX
#undef STAGE_BX
#undef LDA
#undef LDB
#undef MMA
}
template <class Epi>
DI void gemm_unit(const Frame& F, const bf16* __restrict__ A, int lda, const int* rowmap, int arow0,
                  const bf16* __restrict__ Bt, int ldb, int bcol0, int K, const Epi& epi) {
    if (rowmap) gemm_unit_t<true>(F.wv, (bf16*)F.smem, A, lda, rowmap, arow0, Bt, ldb, bcol0, K, epi);
    else gemm_unit_t<false>(F.wv, (bf16*)F.smem, A, lda, rowmap, arow0, Bt, ldb, bcol0, K, epi);
}
#else
template <class Epi>
void gemm_unit(const Frame& F, const bf16* A, int lda, const int* rowmap, int arow0, const bf16* Bt, int ldb, int bcol0, int K, const Epi& epi, int mrows = 256) {
    for (int r = 0; r < mrows; ++r) {
        int arow = rowmap ? rowmap[r] : arow0 + r;
        for (int c = 0; c < 256; c += 4) {
            float v[4];
            for (int q = 0; q < 4; ++q) {
                double s = 0; const bf16* a = A + (long)arow * lda; const bf16* b = Bt + (long)(bcol0 + c + q) * ldb;
                for (int k = 0; k < K; ++k) s += (double)bf2f(a[k]) * bf2f(b[k]);
                v[q] = (float)s;
            }
            epi(r, c, v[0], v[1], v[2], v[3]);
        }
    }
}
#endif

#ifndef CPU_EMU
DI int xcd_unit(int u0, int nblk, int total) {
    if ((nblk & 7) || (total & 7) || (total % nblk)) return u0;
    return (int)(blockIdx.x & 7) * (total >> 3) + (int)(blockIdx.x >> 3) + (nblk >> 3) * (u0 / nblk);
}
#endif
DI void st_bf16x4(bf16* p, float a, float b, float c, float d) {
#ifndef CPU_EMU
    uint2 u; u.x = pack_bf16(a, b); u.y = pack_bf16(c, d); *reinterpret_cast<uint2*>(p) = u;
#else
    p[0] = f2bf(a); p[1] = f2bf(b); p[2] = f2bf(c); p[3] = f2bf(d);
#endif
}

#ifndef CPU_EMU
DI void st_bf16x8(bf16* p, const f32x4& u, const f32x4& v) {
    *reinterpret_cast<uint4*>(p) = make_uint4(pack_bf16(u[0], u[1]), pack_bf16(u[2], u[3]), pack_bf16(v[0], v[1]), pack_bf16(v[2], v[3]));
}
#endif
struct EpiBf {
    bf16* o; int ld; int row0, pn;
    DI void operator()(int r, int c, float a, float b, float cc, float d) const { st_bf16x4(o + (size_t)(row0 + r) * ld + pn * 256 + c, a, b, cc, d); }
#ifndef CPU_EMU
    DI void wide(int r, int c, const f32x4& u, const f32x4& v) const { st_bf16x8(o + (size_t)(row0 + r) * ld + pn * 256 + c, u, v); }
#endif
};
#ifdef CPU_EMU
#define WSP(T, off) ((T*)(F.ws + (off)))
#else
#define WSP(T, off) ((T*)((((size_t)(off)) & XTAG) ? (unsigned char*)F.xf + (((size_t)(off)) & ~XTAG) : F.ws + (off)))
#endif

DI void ln_row_write(float* xrow, bf16* brow, const float* vals_in  , const float* g, const float* b);

template <class Fn>
DI void layer_norm_rows(const Frame& F, const float* g, const float* b, Fn pre, bool write_out_extra, float* extra) {
    float* xf = F.xf; bf16* xb = WSP(bf16, OFF_XB);
    for (int row = ggrp(F); row < NTOK; row += ngrp(F)) {
        float v[PERLN]; float s = 0.f;
        for (int i = 0; i < PERLN; ++i) { int c = glane(F) + i * GRP; v[i] = pre(row, c); s += v[i]; }
        s = grp_sum(F, s); const float mu = s * (1.0f / 1024.0f);
        float q = 0.f;
        for (int i = 0; i < PERLN; ++i) { float d = v[i] - mu; q += d * d; }
        q = grp_sum(F, q); const float rs = 1.0f / sqrtf(q * (1.0f / 1024.0f) + LN_EPS);
        for (int i = 0; i < PERLN; ++i) { int c = glane(F) + i * GRP; float y = (v[i] - mu) * rs * g[c] + b[c];
            xf[(size_t)row * DM + c] = y; xb[(size_t)row * DM + c] = f2bf(y); if (write_out_extra) extra[(size_t)row * DM + c] = y; }
    }
}

#ifndef CPU_EMU
template <int MODE, bool BLOCKED = false, bool WXF = true>
DI void ln_rows_gpu(const Frame& F, const float* __restrict__ g, const float* __restrict__ b, int l) {
    float* xf = F.xf; bf16* xb = WSP(bf16, OFF_XB);
    const float* xin = F.in[0];
    const bf16* yr = WSP(bf16, OFF_YROWS); const float* tinfo = WSP(float, OFF_TINFO);
    const int* eoff = (const int*)(F.ws + CTL_EOFF) + l * 33;
    const int tid = F.tid, wave = tid >> 6, lane = tid & 63;
    float4 gv[4], bv[4];
#pragma unroll
    for (int i = 0; i < 4; ++i) { gv[i] = *reinterpret_cast<const float4*>(g + lane * 4 + 256 * i); bv[i] = *reinterpret_cast<const float4*>(b + lane * 4 + 256 * i); }
    const bool blk_ok = BLOCKED && (NTOK % (F.nblk * 32) == 0);
    const int rpb = NTOK / F.nblk;
    const int bx = (F.nblk & 7) ? (int)blockIdx.x : (int)(blockIdx.x & 7) * (F.nblk >> 3) + (int)(blockIdx.x >> 3);
#define LN_ACT(v_) (blk_ok ? (v_) : xcd_unit((v_) >> 5, F.nblk, NTOK / 32) * 32 + ((v_) & 31))
    const int r_first = blk_ok ? bx * rpb + wave * 4 : (blockIdx.x * 8 + wave) * 4;
    const int r_end = blk_ok ? (bx + 1) * rpb : NTOK;
    const int r_step = blk_ok ? 32 : F.nblk * 32;
    unsigned nra[4] = {0u, 0u, 0u, 0u}, nrb[4] = {0u, 0u, 0u, 0u}; float ng0[4] = {0.f, 0.f, 0.f, 0.f}, ng1[4] = {0.f, 0.f, 0.f, 0.f};
#define LN_META(r0_) do { if (MODE == 2) { _Pragma("unroll") for (int rr_ = 0; rr_ < 4; ++rr_) { const size_t row_ = (size_t)(r0_) + rr_; \
        const int4 ti_ = *reinterpret_cast<const int4*>(tinfo + row_ * 8); const float2 tg_ = *reinterpret_cast<const float2*>(tinfo + row_ * 8 + 4); \
        nra[rr_] = (unsigned)(eoff[ti_.x] + ti_.y); nrb[rr_] = (unsigned)(eoff[ti_.z] + ti_.w); ng0[rr_] = tg_.x; ng1[rr_] = tg_.y; } } } while (0)
    if (r_first < r_end) LN_META(LN_ACT(r_first));
    for (int r0 = r_first; r0 < r_end; r0 += r_step) {
        float4 v[4][4];
        unsigned cra[4], crb[4]; float cg0[4], cg1[4];
#pragma unroll
        for (int rr = 0; rr < 4; ++rr) { cra[rr] = nra[rr]; crb[rr] = nrb[rr]; cg0[rr] = ng0[rr]; cg1[rr] = ng1[rr]; }
        if (r0 + r_step < r_end) LN_META(LN_ACT(r0 + r_step));
#pragma unroll
        for (int rr = 0; rr < 4; ++rr) {
            const size_t row = (size_t)LN_ACT(r0) + rr;
            if (MODE == 2) {
                const size_t ra = cra[rr], rb = crb[rr];
                const float g0 = cg0[rr], g1 = cg1[rr];
#pragma unroll
                for (int i = 0; i < 4; ++i) {
                    const int c = lane * 4 + 256 * i;
                    const uint2 xq = *reinterpret_cast<const uint2*>(xb + row * DM + c);
                    float4 x; x.x = bflo(xq.x); x.y = bfhi(xq.x); x.z = bflo(xq.y); x.w = bfhi(xq.y);
                    const uint2 ya = *reinterpret_cast<const uint2*>(yr + ra * 1024 + c), yb = *reinterpret_cast<const uint2*>(yr + rb * 1024 + c);
                    v[rr][i].x = DN_ALPHA * x.x + g0 * bflo(ya.x) + g1 * bflo(yb.x); v[rr][i].y = DN_ALPHA * x.y + g0 * bfhi(ya.x) + g1 * bfhi(yb.x);
                    v[rr][i].z = DN_ALPHA * x.z + g0 * bflo(ya.y) + g1 * bflo(yb.y); v[rr][i].w = DN_ALPHA * x.w + g0 * bfhi(ya.y) + g1 * bfhi(yb.y);
                }
            } else if (MODE == 0) {
#pragma unroll
                for (int i = 0; i < 4; ++i) {
                    const uint2 xq = *reinterpret_cast<const uint2*>(xb + row * DM + lane * 4 + 256 * i);
                    v[rr][i].x = bflo(xq.x); v[rr][i].y = bfhi(xq.x); v[rr][i].z = bflo(xq.y); v[rr][i].w = bfhi(xq.y);
                }
            } else {
                const float* src = xin + row * DM;
#pragma unroll
                for (int i = 0; i < 4; ++i) v[rr][i] = *reinterpret_cast<const float4*>(src + lane * 4 + 256 * i);
            }
        }
#pragma unroll
        for (int rr = 0; rr < 4; ++rr) {
            const size_t row = (size_t)LN_ACT(r0) + rr;
            float s = 0.f;
#pragma unroll
            for (int i = 0; i < 4; ++i) s += (v[rr][i].x + v[rr][i].y) + (v[rr][i].z + v[rr][i].w);
            const float mu = grp_sum(F, s) * (1.0f / 1024.0f);
            float q = 0.f;
#pragma unroll
            for (int i = 0; i < 4; ++i) { const float d0 = v[rr][i].x - mu, d1 = v[rr][i].y - mu, d2 = v[rr][i].z - mu, d3 = v[rr][i].w - mu; q += (d0 * d0 + d1 * d1) + (d2 * d2 + d3 * d3); }
            const float rs = 1.0f / sqrtf(grp_sum(F, q) * (1.0f / 1024.0f) + LN_EPS);
#pragma unroll
            for (int i = 0; i < 4; ++i) {
                const int c = lane * 4 + 256 * i;
                float4 y; y.x = (v[rr][i].x - mu) * rs * gv[i].x + bv[i].x; y.y = (v[rr][i].y - mu) * rs * gv[i].y + bv[i].y;
                y.z = (v[rr][i].z - mu) * rs * gv[i].z + bv[i].z; y.w = (v[rr][i].w - mu) * rs * gv[i].w + bv[i].w;
                const uint2 hi2 = make_uint2(pack_bf16(y.x, y.y), pack_bf16(y.z, y.w));
                if (MODE == 2) { if (l == 1) *reinterpret_cast<float4*>(xf + row * DM + c) = y; }
                else if (WXF)
                    *reinterpret_cast<uint2*>((bf16*)xf + row * DM + c) = make_uint2(pack_bf16(y.x - bflo(hi2.x), y.y - bfhi(hi2.x)), pack_bf16(y.z - bflo(hi2.y), y.w - bfhi(hi2.y)));
                *reinterpret_cast<uint2*>(xb + row * DM + c) = hi2;
            }
        }
    }
#undef LN_META
#undef LN_ACT
}
#endif

DI void phase_pro(const Frame& F) {
    const float* x = F.in[0]; const float* mem = F.in[1];
#ifdef CPU_EMU
    layer_norm_rows(F, F.in[2], F.in[3], [&](int row, int c) { return x[(size_t)row * DM + c]; }, false, nullptr);
#else
    (void)x; ln_rows_gpu<1, false, false>(F, F.in[2], F.in[3], 0);
#endif
    bf16* memb = WSP(bf16, OFF_MEMB);
    for (size_t i = gtid_(F); i < (size_t)NMEM * DM; i += gthreads(F)) memb[i] = f2bf(mem[i]);
}

template <class Src>
DI void cvt_tile(const Frame& F, bf16* dst, int Kk, int n0, int k0, Src src) {
#ifndef CPU_EMU
    float* tile = (float*)F.smem;
    __syncthreads();
    for (int i = F.tid; i < 4096; i += NTH) { int k = i >> 6, n = i & 63; tile[k * 65 + n] = src(k0 + k, n0 + n); }
    __syncthreads();
    for (int i = F.tid; i < 2048; i += NTH) { int n = i >> 5, k = (i & 31) * 2;
        *reinterpret_cast<unsigned*>(dst + (size_t)(n0 + n) * Kk + k0 + k) = pack_bf16(tile[k * 65 + n], tile[(k + 1) * 65 + n]); }
#endif
}
template <class Src>
DI void cvt_transpose(const Frame& F, bf16* dst, int Nn, int Kk, Src src, int t_first, int t_total) {
#ifdef CPU_EMU
    for (int n = 0; n < Nn; ++n) for (int k = 0; k < Kk; ++k) dst[(size_t)n * Kk + k] = f2bf(src(k, n));
#else
    const int tn = Nn / 64, tk = Kk / 64, ntile = tn * tk;
    int t = (int)blockIdx.x - (t_first % (int)F.nblk); if (t < 0) t += F.nblk;
    for (; t < ntile; t += F.nblk) cvt_tile(F, dst, Kk, (t % tn) * 64, (t / tn) * 64, src);
#endif
}

#ifndef CPU_EMU
template <bool VEC, class CM>
DI void cvt_job(const Frame& F, int& tbase, bf16* dst, int ldd, int Nn, int Kk, int Ksrc, const float* __restrict__ src, int lds, CM cm, int nw_ = 0, int gw_ = 0) {
    const int nw = nw_ ? nw_ : F.nblk * 8, gw = nw_ ? gw_ : blockIdx.x * 8 + F.wv;
    const int lane = fresh_tid(F) & 63, kq = lane & 15, nq = lane >> 4;
    const int tk = Kk / 64, T = tk * (Nn / 16);
    int t = gw - (tbase % nw); if (t < 0) t += nw;
    tbase += T;
    if (VEC && nw_) {
        for (; t < T; t += 2 * nw) {
            const int t2 = t + nw; const bool two = t2 < T;
            const int k = (t % tk) * 64 + 4 * kq, n = (t / tk) * 16 + 4 * nq, s = cm(n);
            const int k2 = two ? (t2 % tk) * 64 + 4 * kq : k, n2 = two ? (t2 / tk) * 16 + 4 * nq : n, s2 = cm(n2);
            float4 v[4], w[4];
#pragma unroll
            for (int i = 0; i < 4; ++i) v[i] = (s >= 0 && k + i < Ksrc) ? *reinterpret_cast<const float4*>(src + (size_t)(k + i) * lds + s) : make_float4(0.f, 0.f, 0.f, 0.f);
#pragma unroll
            for (int i = 0; i < 4; ++i) w[i] = (s2 >= 0 && k2 + i < Ksrc) ? *reinterpret_cast<const float4*>(src + (size_t)(k2 + i) * lds + s2) : make_float4(0.f, 0.f, 0.f, 0.f);
            { bf16* d = dst + (size_t)n * ldd + k;
              *reinterpret_cast<uint2*>(d) = make_uint2(pack_bf16(v[0].x, v[1].x), pack_bf16(v[2].x, v[3].x));
              *reinterpret_cast<uint2*>(d + ldd) = make_uint2(pack_bf16(v[0].y, v[1].y), pack_bf16(v[2].y, v[3].y));
              *reinterpret_cast<uint2*>(d + 2 * (size_t)ldd) = make_uint2(pack_bf16(v[0].z, v[1].z), pack_bf16(v[2].z, v[3].z));
              *reinterpret_cast<uint2*>(d + 3 * (size_t)ldd) = make_uint2(pack_bf16(v[0].w, v[1].w), pack_bf16(v[2].w, v[3].w)); }
            if (two) { bf16* d = dst + (size_t)n2 * ldd + k2;
              *reinterpret_cast<uint2*>(d) = make_uint2(pack_bf16(w[0].x, w[1].x), pack_bf16(w[2].x, w[3].x));
              *reinterpret_cast<uint2*>(d + ldd) = make_uint2(pack_bf16(w[0].y, w[1].y), pack_bf16(w[2].y, w[3].y));
              *reinterpret_cast<uint2*>(d + 2 * (size_t)ldd) = make_uint2(pack_bf16(w[0].z, w[1].z), pack_bf16(w[2].z, w[3].z));
              *reinterpret_cast<uint2*>(d + 3 * (size_t)ldd) = make_uint2(pack_bf16(w[0].w, w[1].w), pack_bf16(w[2].w, w[3].w)); }
        }
        return;
    }
    for (; t < T; t += nw) {
        const int k = (t % tk) * 64 + 4 * kq, n = (t / tk) * 16 + 4 * nq;
        float4 v[4];
        if (VEC) {
            const int s = cm(n);
#pragma unroll
            for (int i = 0; i < 4; ++i) v[i] = (s >= 0 && k + i < Ksrc) ? *reinterpret_cast<const float4*>(src + (size_t)(k + i) * lds + s) : make_float4(0.f, 0.f, 0.f, 0.f);
        } else {
            const int s0 = cm(n), s1 = cm(n + 1), s2 = cm(n + 2), s3 = cm(n + 3);
#pragma unroll
            for (int i = 0; i < 4; ++i) { const float* row = src + (size_t)(k + i) * lds; const bool ok = k + i < Ksrc;
                v[i].x = (ok && s0 >= 0) ? row[s0] : 0.f; v[i].y = (ok && s1 >= 0) ? row[s1] : 0.f; v[i].z = (ok && s2 >= 0) ? row[s2] : 0.f; v[i].w = (ok && s3 >= 0) ? row[s3] : 0.f; }
        }
        bf16* d = dst + (size_t)n * ldd + k;
        *reinterpret_cast<uint2*>(d) = make_uint2(pack_bf16(v[0].x, v[1].x), pack_bf16(v[2].x, v[3].x));
        *reinterpret_cast<uint2*>(d + ldd) = make_uint2(pack_bf16(v[0].y, v[1].y), pack_bf16(v[2].y, v[3].y));
        *reinterpret_cast<uint2*>(d + 2 * (size_t)ldd) = make_uint2(pack_bf16(v[0].z, v[1].z), pack_bf16(v[2].z, v[3].z));
        *reinterpret_cast<uint2*>(d + 3 * (size_t)ldd) = make_uint2(pack_bf16(v[0].w, v[1].w), pack_bf16(v[2].w, v[3].w));
    }
}
#endif

DI int win_src_col(int n) {
    if (n < 512) return n;
    if (n < 1536) { int c = n - 512; return c < 960 ? 512 + c : -1; }
    if (n < 2816) return 1472 + (n - 1536);
    int c = n - 2816;
    if (c < 192) return 2752 + c;
    if (c < 224) return 2752 + 320 + (c - 192);
    if (c < 256) return -1;
    if (c < 384) return 2752 + 192 + (c - 256);
    return -1;
}
DI int wuq_src_col(int n) {
    if (n >= 384) return -1;
    int h = n / 96, w = n % 96;
    if (w < 64) return h * 96 + w;
    int p = w - 64, m = p >> 1, which = p & 1;
    int i = (m < 8 ? m : 16 + (m - 8)) + (which ? 8 : 0);
    return h * 96 + 64 + i;
}

DI void phase_cvt(const Frame& F, int l) {
    bf16* wts = WSP(bf16, OFF_WTS);
#ifndef CPU_EMU
    {
        int tb = 0;
        auto ident = [](int n) { return n; };
        cvt_job<true>(F, tb, (bf16*)((char*)wts + W_IN_T), 1024, HP, 1024, 1024, F.in[4] + (size_t)l * 1024 * IN_WIDTH, IN_WIDTH, [](int n) { return win_src_col(n); });
        cvt_job<false>(F, tb, (bf16*)((char*)wts + W_UQ_T), 256, 512, 256, 192, F.in[23] + (size_t)l * 192 * 384, 384, [](int n) { return wuq_src_col(n); });
        cvt_job<true>(F, tb, (bf16*)((char*)wts + W_UKV_T), 256, 512, 256, 128, F.in[24] + (size_t)l * 128 * 512, 512, [](int n) { return ((n & 255) >> 6) * 128 + (n & 63) + (n >> 8) * 64; });
        cvt_job<true>(F, tb, (bf16*)((char*)wts + W_OUT_T), 1024, 1024, 1024, 1024, F.in[25] + (size_t)l * 1024 * 1024, 1024, ident);
        cvt_job<true>(F, tb, (bf16*)((char*)wts + W_Q_T), 1024, 1024, 1024, 1024, F.in[28] + (size_t)l * 1024 * 1024, 1024, ident);
        cvt_job<true>(F, tb, (bf16*)((char*)wts + W_KV_T), 1024, 2048, 1024, 1024, F.in[29] + (size_t)l * 1024 * 2048, 2048, ident);
        cvt_job<true>(F, tb, (bf16*)((char*)wts + W_O_T), 1024, 1024, 1024, 1024, F.in[30] + (size_t)l * 1024 * 1024, 1024, ident);
        const float* wg = F.in[33] + (size_t)l * 1024 * 4; const float* we = F.in[35] + (size_t)l * 1024 * 32; bf16* gt = (bf16*)((char*)wts + W_GATE_T) + (size_t)l * 2 * 48 * 1024;
        for (int i = gtid_(F); i < 9216 * 8; i += gthreads(F)) {
            const int unit = i >> 3, e = i & 7; int k32, hl, kq, col;
            if (unit < 8192) { k32 = unit >> 8; const int t = (unit >> 6) & 3, ln = unit & 63; kq = ln >> 4; col = 16 * (t & 1) + (ln & 15); hl = t >> 1; }
            else { const int u2 = unit - 8192; k32 = u2 >> 5; hl = (u2 >> 4) & 1; kq = (u2 >> 2) & 3; col = 32 + (u2 & 3); }
            const int k = 32 * k32 + 8 * kq + e;
            const float v = col < 4 ? wg[k * 4 + col] : we[k * 32 + col - 4];
            const bf16 hi = f2bf(v); gt[i] = hl ? f2bf(v - bf2f(hi)) : hi; }
        return;
    }
#endif
    constexpr int T0 = 0, T1 = T0 + (HP / 64) * 16, T2 = T1 + 8 * 4, T3 = T2 + 8 * 4, T4 = T3 + 256, T5 = T4 + 256, T6 = T5 + 512, TT = T6 + 256;
    { const float* w = F.in[4] + (size_t)l * 1024 * IN_WIDTH;
      cvt_transpose(F, (bf16*)((char*)wts + W_IN_T), HP, 1024, [&](int k, int n) { int s = win_src_col(n); return s < 0 ? 0.f : w[(size_t)k * IN_WIDTH + s]; }, T0, TT); }
    { const float* w = F.in[23] + (size_t)l * 192 * 384;
      cvt_transpose(F, (bf16*)((char*)wts + W_UQ_T), 512, 256, [&](int k, int n) { int s = wuq_src_col(n); return (s < 0 || k >= 192) ? 0.f : w[(size_t)k * 384 + s]; }, T1, TT); }
    { const float* w = F.in[24] + (size_t)l * 128 * 512;
      cvt_transpose(F, (bf16*)((char*)wts + W_UKV_T), 512, 256, [&](int k, int n) { return k >= 128 ? 0.f : w[(size_t)k * 512 + n]; }, T2, TT); }
    { const float* w = F.in[25] + (size_t)l * 1024 * 1024;
      cvt_transpose(F, (bf16*)((char*)wts + W_OUT_T), 1024, 1024, [&](int k, int n) { return w[(size_t)k * 1024 + n]; }, T3, TT); }
    { const float* w = F.in[28] + (size_t)l * 1024 * 1024;
      cvt_transpose(F, (bf16*)((char*)wts + W_Q_T), 1024, 1024, [&](int k, int n) { return w[(size_t)k * 1024 + n]; }, T4, TT); }
    { const float* w = F.in[29] + (size_t)l * 1024 * 2048;
      cvt_transpose(F, (bf16*)((char*)wts + W_KV_T), 2048, 1024, [&](int k, int n) { return w[(size_t)k * 2048 + n]; }, T5, TT); }
    { const float* w = F.in[30] + (size_t)l * 1024 * 1024;
      cvt_transpose(F, (bf16*)((char*)wts + W_O_T), 1024, 1024, [&](int k, int n) { return w[(size_t)k * 1024 + n]; }, T6, TT); }
#ifndef CPU_EMU
    { const float* wg = F.in[33] + (size_t)l * 1024 * 4; const float* we = F.in[35] + (size_t)l * 1024 * 32; float* gt = (float*)((char*)wts + W_GATE_T) + (size_t)l * 48 * 1024;
      for (int i = gtid_(F); i < 48 * 1024; i += gthreads(F)) { const int col = i >> 10, k = i & 1023;
          gt[i] = col < 4 ? wg[k * 4 + col] : col < 36 ? we[k * 32 + col - 4] : 0.f; } }
#endif
}

DI void phase_cvt_moe(const Frame& F, int l, int nw_ = 0, int gw_ = 0, int which = 7) {
#ifdef CPU_EMU
    for (int e = 0; e < NEXP; ++e) {
        const float* w1 = F.in[37] + ((size_t)l * NEXP + e) * 1024 * 256;
        const float* w3 = F.in[38] + ((size_t)l * NEXP + e) * 1024 * 256;
        const float* w2 = F.in[39] + ((size_t)l * NEXP + e) * 256 * 1024;
        cvt_transpose(F, WSP(bf16, OFF_W13T) + (size_t)e * 512 * 1024, 512, 1024,
                      [&](int k, int n) { return (n & 1) ? w3[(size_t)k * 256 + (n >> 1)] : w1[(size_t)k * 256 + (n >> 1)]; }, 0, 1);
        cvt_transpose(F, WSP(bf16, OFF_W2T) + (size_t)e * 1024 * 256, 1024, 256, [&](int k, int n) { return w2[(size_t)k * 1024 + n]; }, 0, 1);
    }
#else
    {
        int tb = 0;
        auto ident = [](int n) { return n; };
        for (int e = 0; e < NEXP; ++e) {
            const float* w1 = F.in[37] + ((size_t)l * NEXP + e) * 1024 * 256; const float* w3 = F.in[38] + ((size_t)l * NEXP + e) * 1024 * 256; const float* w2 = F.in[39] + ((size_t)l * NEXP + e) * 256 * 1024;
            bf16* d13 = WSP(bf16, OFF_W13T) + (size_t)e * 512 * 1024;
            if (which & 1) cvt_job<true>(F, tb, d13, 2048, 256, 1024, 1024, w1, 256, ident, nw_, gw_);
            if (which & 4) cvt_job<true>(F, tb, d13 + 1024, 2048, 256, 1024, 1024, w3, 256, ident, nw_, gw_);
            if (which & 2) cvt_job<true>(F, tb, WSP(bf16, OFF_W2T) + (size_t)e * 1024 * 256, 256, 1024, 256, 256, w2, 1024, ident, nw_, gw_);
        }
    }
#endif
}

struct EpiH {
    bf16* hatt; bf16* hrwkv; bf16* hhgrn; bf16* hmla; int row0, pn;
    DI void operator()(int r, int c, float a, float b, float cc, float d) const {
        const size_t row = row0 + r;
        bf16* p;
        if (pn < 2) p = hatt + row * 512 + pn * 256 + c;
        else if (pn < 6) p = hrwkv + row * 1024 + (pn - 2) * 256 + c;
        else if (pn < 11) p = hhgrn + row * 1280 + (pn - 6) * 256 + c;
        else p = hmla + row * 512 + (pn - 11) * 256 + c;
        st_bf16x4(p, a, b, cc, d);
    }
#ifndef CPU_EMU
    DI void wide(int r, int c, const f32x4& u, const f32x4& v) const {
        const size_t row = row0 + r;
        bf16* p;
        if (pn < 2) p = hatt + row * 512 + pn * 256 + c;
        else if (pn < 6) p = hrwkv + row * 1024 + (pn - 2) * 256 + c;
        else if (pn < 11) p = hhgrn + row * 1280 + (pn - 6) * 256 + c;
        else p = hmla + row * 512 + (pn - 11) * 256 + c;
        st_bf16x8(p, u, v);
    }
#endif
};
struct EpiKV {
    bf16* kmem; bf16* vt; int row0, pn;
    DI void operator()(int r, int c, float a, float b, float cc, float d) const {
        const int row = row0 + r, col = pn * 256 + c;
        if (col < 1024) { st_bf16x4(kmem + (size_t)row * 1024 + col, a, b, cc, d); }
        else { const int bb = row / MEMT, key = row % MEMT, hc = col - 1024;
            bf16* p = vt + ((size_t)bb * 1024 + hc) * MEMT + key;
            p[0] = f2bf(a); p[MEMT] = f2bf(b); p[2 * MEMT] = f2bf(cc); p[3 * MEMT] = f2bf(d); }
    }
};

DI void phase_gemm1(const Frame& F) {
    const bf16* xb = WSP(bf16, OFF_XB); const bf16* wts = WSP(bf16, OFF_WTS);
    const int nM = (NTOK + 255) / 256, nN = HP / 256, n1 = nM * nN;
    const int nMk = (NMEM + 255) / 256, nNk = 8, n2 = nMk * nNk;
    for (int u0 = blockIdx.x; u0 < n1 + n2; u0 += F.nblk) {
        int u = u0;
#ifndef CPU_EMU
        if ((F.nblk & 7) == 0 && (n1 & 7) == 0 && (n2 & 7) == 0 && (n1 + n2) % F.nblk == 0) {
            const int x = blockIdx.x & 7, j = (blockIdx.x >> 3) + (F.nblk >> 3) * (u0 / F.nblk), per1 = n1 >> 3, per2 = n2 >> 3;
            u = j < per1 ? x * per1 + j : n1 + x * per2 + (j - per1);
        }
#endif
        if (u < n1) {
            const int pm = u / nN, pn = u % nN;
            EpiH E{WSP(bf16, OFF_HATT), WSP(bf16, OFF_HRWKV), WSP(bf16, OFF_HHGRN), WSP(bf16, OFF_HMLA), pm * 256, pn};
#ifdef CPU_EMU
            gemm_unit(F, xb, 1024, nullptr, pm * 256, (const bf16*)((const char*)wts + W_IN_T), 1024, pn * 256, 1024, E, min(256, NTOK - pm * 256));
#else
            gemm_unit(F, xb, 1024, nullptr, pm * 256, (const bf16*)((const char*)wts + W_IN_T), 1024, pn * 256, 1024, E);
#endif
        } else {
            const int v = u - n1, pm = v / nNk, pn = v % nNk;
#ifndef CPU_EMU
            if (pn < 4) { EpiBf E{WSP(bf16, OFF_KMEM), 1024, pm * 256, pn};
                gemm_unit(F, WSP(bf16, OFF_MEMB), 1024, nullptr, pm * 256, (const bf16*)((const char*)wts + W_KV_T), 1024, pn * 256, 1024, E); }
            else {
                EpiBf E{WSP(bf16, OFF_VTMEM) + (size_t)pm * 1024 * MEMT + (size_t)(pn - 4) * 256 * MEMT, MEMT, 0, 0};
                gemm_unit(F, (const bf16*)((const char*)wts + W_KV_T), 1024, nullptr, 1024 + (pn - 4) * 256, WSP(bf16, OFF_MEMB), 1024, pm * 256, 1024, E); }
#else
            EpiKV E{WSP(bf16, OFF_KMEM), WSP(bf16, OFF_VTMEM), pm * 256, pn};
            gemm_unit(F, WSP(bf16, OFF_MEMB), 1024, nullptr, pm * 256, (const bf16*)((const char*)wts + W_KV_T), 1024, pn * 256, 1024, E);
#endif
        }
    }
}


#ifndef CPU_EMU
DI float fast_sigmoid(float x) { return __builtin_amdgcn_rcpf(1.0f + __expf(-x)); }
DI float fast_tanh(float x) { const float e = __expf(2.0f * x); return 1.0f - 2.0f * __builtin_amdgcn_rcpf(e + 1.0f); }

DI void prep_attn_gpu(const Frame& F, int l) {
    float* tabA = (float*)F.smem;
    float* tabB = tabA + 2048;
    float* gq = tabB + 1024;
    __syncthreads();
    { const int tid = fresh_tid(F);
    for (int i = tid; i < 1024; i += NTH) { const int pos = i >> 4, f = i & 15; const float ang = (float)pos * rope_inv(2 * f, 32); tabA[i] = cosf(ang); tabA[1024 + i] = sinf(ang); }
    for (int i = tid; i < 512; i += NTH) { const int pos = i >> 3, f = i & 7; const float ang = (float)pos * rope_inv(2 * f, 16); tabB[i] = cosf(ang); tabB[512 + i] = sinf(ang); }
    for (int i = tid; i < 448; i += NTH) gq[i] = i < 64 ? F.in[5][l * 64 + i] : i < 128 ? F.in[6][l * 64 + i - 64] : i < 320 ? F.in[21][l * 192 + i - 128] : F.in[22][l * 128 + i - 320]; }
    __syncthreads();
    bf16* hatt = WSP(bf16, OFF_HATT);
    for (int ub = blockIdx.x; ub < NTOK * 48 / NTH; ub += F.nblk) {
        const int it = xcd_unit(ub, F.nblk, NTOK * 48 / NTH) * NTH + fresh_tid(F);
        const int grp = it >> 3, j = it & 7;
        const int n = grp / 6, hh = grp % 6, s = n % SEQ, rowp = s / GRIDW, colp = s % GRIDW;
        uint4* p = reinterpret_cast<uint4*>(hatt + (size_t)n * 512 + hh * 64 + j * 8);
        const float* gn = gq + (hh < 4 ? 0 : 64) + j * 8;
        const uint4 raw = *p;
        float x[8] = {bflo(raw.x), bfhi(raw.x), bflo(raw.y), bfhi(raw.y), bflo(raw.z), bfhi(raw.z), bflo(raw.w), bfhi(raw.w)};
        float ss = (x[0] * x[0] + x[1] * x[1]) + (x[2] * x[2] + x[3] * x[3]) + (x[4] * x[4] + x[5] * x[5]) + (x[6] * x[6] + x[7] * x[7]);
        ss += dppf<0xB1>(ss); ss += dppf<0x4E>(ss); ss += dppf<0x141>(ss);
        const float rs = 1.0f / sqrtf(ss * (1.0f / 64.0f) + RMS_EPS);
        const int pos = (j & 4) ? colp : rowp;
        const float* ct = tabA + pos * 16 + (j & 1) * 8;
        const float sgn = (j & 2) ? 1.0f : -1.0f;
        const float qsc = hh < 4 ? 0.125f * 1.4426950408889634f : 1.0f;
        float o[8];
#pragma unroll
        for (int e = 0; e < 8; ++e) {
            const float own = x[e] * rs * gn[e];
            const float oth = dppf<0x4E>(own);
            o[e] = (own * ct[e] + sgn * oth * ct[1024 + e]) * qsc;
        }
        *p = make_uint4(pack_bf16(o[0], o[1]), pack_bf16(o[2], o[3]), pack_bf16(o[4], o[5]), pack_bf16(o[6], o[7]));
    }
    bf16* hm = WSP(bf16, OFF_HMLA); bf16* kr = WSP(bf16, OFF_KROPE);
    int it0 = blockIdx.x * NTH + fresh_tid(F);
    { const int T = NTOK * 3 / NTH;
      if ((F.nblk & 7) == 0 && (T & 7) == 0 && T <= F.nblk && NTOK * 3 % NTH == 0)
          it0 = ((int)(blockIdx.x >> 3) < (T >> 3)) ? ((int)(blockIdx.x & 7) * (T >> 3) + (int)(blockIdx.x >> 3)) * NTH + fresh_tid(F) : NTOK * 3; }
    for (int it = it0; it < NTOK * 3; it += (it0 == (int)(blockIdx.x * NTH) + fresh_tid(F) ? gthreads(F) : NTOK * 3)) {
        const int n = it / 3, which = it % 3;
        if (which < 2) {
            const int len = which ? 128 : 192; const float* gn = gq + (which ? 320 : 128);
            uint4* p = reinterpret_cast<uint4*>(hm + (size_t)n * 512 + (which ? 256 : 0));
            float ss = 0.f;
            for (int i = 0; i < len / 8; ++i) { const uint4 r = p[i];
                const float a0 = bflo(r.x), a1 = bfhi(r.x), a2 = bflo(r.y), a3 = bfhi(r.y), a4 = bflo(r.z), a5 = bfhi(r.z), a6 = bflo(r.w), a7 = bfhi(r.w);
                ss += a0 * a0 + a1 * a1 + a2 * a2 + a3 * a3 + a4 * a4 + a5 * a5 + a6 * a6 + a7 * a7; }
            const float rs = 1.0f / sqrtf(ss / (float)len + RMS_EPS);
            for (int i = 0; i < len / 8; ++i) { const uint4 r = p[i]; const float* g = gn + 8 * i; uint4 o;
                o.x = pack_bf16(bflo(r.x) * rs * g[0], bfhi(r.x) * rs * g[1]); o.y = pack_bf16(bflo(r.y) * rs * g[2], bfhi(r.y) * rs * g[3]);
                o.z = pack_bf16(bflo(r.z) * rs * g[4], bfhi(r.z) * rs * g[5]); o.w = pack_bf16(bflo(r.w) * rs * g[6], bfhi(r.w) * rs * g[7]); p[i] = o; }
        } else {
            const int s = n % SEQ, rowp = s / GRIDW, colp = s % GRIDW;
            const uint4* p = reinterpret_cast<const uint4*>(hm + (size_t)n * 512 + 192);
            float x[32];
#pragma unroll
            for (int i = 0; i < 4; ++i) { const uint4 r = p[i]; x[8 * i] = bflo(r.x); x[8 * i + 1] = bfhi(r.x); x[8 * i + 2] = bflo(r.y); x[8 * i + 3] = bfhi(r.y);
                x[8 * i + 4] = bflo(r.z); x[8 * i + 5] = bfhi(r.z); x[8 * i + 6] = bflo(r.w); x[8 * i + 7] = bfhi(r.w); }
            unsigned o[16];
#pragma unroll
            for (int m = 0; m < 16; ++m) {
                const int i1 = m < 8 ? m : 16 + (m - 8), pos = m < 8 ? rowp : colp, f = m & 7;
                const float cs = tabB[pos * 8 + f], sn = tabB[512 + pos * 8 + f];
                o[m] = pack_bf16(x[i1] * cs - x[i1 + 8] * sn, x[i1] * sn + x[i1 + 8] * cs);
            }
            uint4* q = reinterpret_cast<uint4*>(kr + (size_t)n * 32);
#pragma unroll
            for (int i = 0; i < 4; ++i) q[i] = make_uint4(o[4 * i], o[4 * i + 1], o[4 * i + 2], o[4 * i + 3]);
        }
    }
    {
        bf16* vt = WSP(bf16, OFF_VTATT); bf16* tl = (bf16*)(gq + 512);
        for (int tile0 = blockIdx.x; tile0 < BATCH * 2 * (SEQ / 64); tile0 += F.nblk) {
            const int tile = xcd_unit(tile0, F.nblk, BATCH * 2 * (SEQ / 64));
            const int b = tile / (2 * (SEQ / 64)), kv = (tile / (SEQ / 64)) % 2, t0 = (tile % (SEQ / 64)) * 64;
            __syncthreads();
            const int tid = fresh_tid(F);
            { const int t = tid >> 3, part = tid & 7;
              const uint4 r = *reinterpret_cast<const uint4*>(hatt + (size_t)(b * SEQ + t0 + t) * 512 + 384 + kv * 64 + part * 8);
              const unsigned w[4] = {r.x, r.y, r.z, r.w};
#pragma unroll
              for (int i = 0; i < 4; ++i) { tl[(part * 8 + 2 * i) * 72 + t] = (bf16)(w[i] & 0xffffu); tl[(part * 8 + 2 * i + 1) * 72 + t] = (bf16)(w[i] >> 16); } }
            __syncthreads();
            { const int dv = tid >> 3, part = tid & 7;
              *reinterpret_cast<uint4*>(vt + ((size_t)(b * 2 + kv) * 64 + dv) * SEQ + t0 + part * 8) = *reinterpret_cast<const uint4*>(tl + dv * 72 + part * 8); }
        }
    }
}

DI void prep_hgrn_gpu(const Frame& F, int l) {
    bf16* hh = WSP(bf16, OFF_HHGRN); bf16* hx = WSP(bf16, OFF_HX); bf16* ham = WSP(bf16, OFF_HAM); float* heg = WSP(float, OFF_HEG);
    const int tid = F.tid, wave = tid >> 6, lane = tid & 63, x = lane & 15, q = lane >> 4;
    bf16* stg = (bf16*)F.smem + wave * (4 * 16 * 72);
    for (int ib = blockIdx.x; ib < (NTOK / 16) * 4 / 8; ib += F.nblk) {
        const int it = xcd_unit(ib, F.nblk, (NTOK / 16) * 4 / 8) * 8 + wave;
        const int c = it >> 2, h = it & 3, n0 = c * 16, cj = h * 64 + lane;
        float mlb = 1.0f;
        if (l == 1) { const float a = F.in[19][cj], b = F.in[19][256 + cj]; const float m = fmaxf(a, b); const float ea = __expf(a - m), eb = __expf(b - m); mlb = ea / (ea + eb); }
        float qv[16], k0[16], k1[16], g0[16], g1[16]; bf16 vraw[16];
        bf16* rawt = (bf16*)(F.smem + 73728) + wave * 4096;
        {
#define HP_L(i_) const uint4 w##i_ = *reinterpret_cast<const uint4*>(hh + (size_t)(n0 + (((lane + 64 * i_) & 127) >> 3)) * 1280 + ((lane + 64 * i_) >> 7) * 256 + h * 64 + (lane & 7) * 8)
#define HP_S(i_) *reinterpret_cast<uint4*>(rawt + (lane + 64 * i_) * 8) = w##i_
            HP_L(0); HP_L(1); HP_L(2); HP_L(3); HP_L(4); HP_L(5); HP_L(6); HP_L(7);
            HP_S(0); HP_S(1); HP_S(2); HP_S(3); HP_S(4); HP_S(5); HP_S(6); HP_S(7);
#undef HP_L
#undef HP_S
        }
        asm volatile("s_waitcnt lgkmcnt(0)" ::: "memory");
        __builtin_amdgcn_wave_barrier();
#pragma unroll
        for (int t = 0; t < 16; ++t) {
            const bf16* row = rawt + t * 64 + lane;
            const float xq = bf2f(row[0]), x0 = bf2f(row[1024]), x1 = bf2f(row[2048]); vraw[t] = row[3072];
            qv[t] = xq * fast_sigmoid(xq); k0[t] = mlb * fast_sigmoid(-x0); k1[t] = mlb * fast_sigmoid(-x1);
            g0[t] = __logf(1.0f - k0[t]); g1[t] = __logf(1.0f - k1[t]);
        }
#pragma unroll
        for (int t = 1; t < 16; ++t) { g0[t] += g0[t - 1]; g1[15 - t] += g1[16 - t]; }
        heg[((size_t)it * 2 + 0) * 64 + lane] = __expf(g0[15]); heg[((size_t)it * 2 + 1) * 64 + lane] = __expf(g1[0]);
        unsigned kt0[8], kt1[8], vt[8];
#pragma unroll
        for (int t = 0; t < 16; t += 2) {
            const float e0a = __expf(g0[t]), e0b = __expf(g0[t + 1]), e1a = __expf(g1[t]), e1b = __expf(g1[t + 1]);
            const float q0a = qv[t] * e0a, q0b = qv[t + 1] * e0b, q1a = qv[t] * e1a, q1b = qv[t + 1] * e1b;
            const float ka0 = k0[t] * __builtin_amdgcn_rcpf(e0a), kb0 = k0[t + 1] * __builtin_amdgcn_rcpf(e0b), ka1 = k1[t] * __builtin_amdgcn_rcpf(e1a), kb1 = k1[t + 1] * __builtin_amdgcn_rcpf(e1b);
            const bf16 bq0a = f2bf(q0a), bq0b = f2bf(q0b), bq1a = f2bf(q1a), bq1b = f2bf(q1b);
            kt0[t >> 1] = pack_bf16(ka0, kb0); kt1[t >> 1] = pack_bf16(ka1, kb1); vt[t >> 1] = (unsigned)vraw[t] | ((unsigned)vraw[t + 1] << 16);
            stg[0 * 1152 + t * 72 + lane] = bq0a; stg[0 * 1152 + (t + 1) * 72 + lane] = bq0b;
            stg[2 * 1152 + t * 72 + lane] = bq1a; stg[2 * 1152 + (t + 1) * 72 + lane] = bq1b;
            stg[1 * 1152 + t * 72 + lane] = (bf16)(kt0[t >> 1] & 0xffffu); stg[1 * 1152 + (t + 1) * 72 + lane] = (bf16)(kt0[t >> 1] >> 16);
            stg[3 * 1152 + t * 72 + lane] = (bf16)(kt1[t >> 1] & 0xffffu); stg[3 * 1152 + (t + 1) * 72 + lane] = (bf16)(kt1[t >> 1] >> 16);
        }
        { bf16* blk = hh + (size_t)(n0 + (lane >> 2)) * 1280 + h * 64 + (lane & 3) * 16;
          *reinterpret_cast<uint4*>(blk + 256) = make_uint4(kt0[0], kt0[1], kt0[2], kt0[3]); *reinterpret_cast<uint4*>(blk + 256 + 8) = make_uint4(kt0[4], kt0[5], kt0[6], kt0[7]);
          *reinterpret_cast<uint4*>(blk + 512) = make_uint4(kt1[0], kt1[1], kt1[2], kt1[3]); *reinterpret_cast<uint4*>(blk + 512 + 8) = make_uint4(kt1[4], kt1[5], kt1[6], kt1[7]);
          *reinterpret_cast<uint4*>(blk + 768) = make_uint4(vt[0], vt[1], vt[2], vt[3]); *reinterpret_cast<uint4*>(blk + 768 + 8) = make_uint4(vt[4], vt[5], vt[6], vt[7]); }
        asm volatile("s_waitcnt lgkmcnt(0)" ::: "memory");
        __builtin_amdgcn_wave_barrier();
#pragma unroll
        for (int i = 0; i < 2; ++i) { const int idx = lane + 64 * i, t = idx >> 3, ch = idx & 7;
            *reinterpret_cast<uint4*>(hh + (size_t)(n0 + t) * 1280 + h * 64 + ch * 8) = *reinterpret_cast<const uint4*>(stg + 0 * 1152 + t * 72 + ch * 8);
            *reinterpret_cast<uint4*>(hx + (size_t)(n0 + t) * 256 + h * 64 + ch * 8) = *reinterpret_cast<const uint4*>(stg + 2 * 1152 + t * 72 + ch * 8); }
#pragma unroll
        for (int d = 0; d < 2; ++d) {
            f32x4 acc = {0.f, 0.f, 0.f, 0.f};
#pragma unroll
            for (int ks = 0; ks < 2; ++ks) {
                const bf16x8 a = *reinterpret_cast<const bf16x8*>(stg + (2 * d) * 1152 + x * 72 + 32 * ks + 8 * q);
                const bf16x8 b = *reinterpret_cast<const bf16x8*>(stg + (2 * d + 1) * 1152 + x * 72 + 32 * ks + 8 * q);
                acc = __builtin_amdgcn_mfma_f32_16x16x32_bf16(a, b, acc, 0, 0, 0);
            }
            bf16* am = ham + ((size_t)it * 2 + d) * 256;
#pragma unroll
            for (int r = 0; r < 4; ++r) { const int t = 4 * q + r; const bool keep = d ? (x >= t) : (x <= t); am[t * 16 + x] = f2bf(keep ? acc[r] : 0.f); }
        }
        __builtin_amdgcn_wave_barrier();
    }
}

DI void scan_hgrn_chunk(const Frame& F, int chain) {
    const int d = chain / (BATCH * 4), b = (chain / 4) % BATCH, h = chain % 4;
    const int lane = fresh_tid(F) & 63, x = lane & 15, q = lane >> 4;
    bf16* hh = WSP(bf16, OFF_HHGRN); const bf16* hx = WSP(bf16, OFF_HX); const bf16* ham = WSP(bf16, OFF_HAM); const float* heg = WSP(float, OFF_HEG);
    f32x4 S[4][4];
#pragma unroll
    for (int a = 0; a < 4; ++a)
#pragma unroll
        for (int c = 0; c < 4; ++c) S[a][c] = (f32x4){0.f, 0.f, 0.f, 0.f};
    constexpr int NCH = SEQ / 16;
    uint2 nQ[4], nA, nK[4], nV[4]; float4 nE[4];
    const unsigned lq = (unsigned)(x * (d ? 256 : 1280) + h * 64 + 4 * q);
    const unsigned lb = (unsigned)((x >> 2) * 1280 + h * 64 + (x & 3) * 16 + 4 * q);
    const unsigned la = (unsigned)(x * 16 + 4 * q), le = (unsigned)(4 * q), lo = (unsigned)(4 * q * 1280 + x);
#define HG_LOAD(cc_) do { const int c_ = d ? NCH - 1 - (cc_) : (cc_); const unsigned n0_ = (unsigned)(b * SEQ + 16 * c_); const unsigned it_ = (n0_ >> 4) * 4 + h; \
        const bf16* qb_ = d ? hx + (size_t)n0_ * 256 : hh + (size_t)n0_ * 1280; const bf16* hb_ = hh + (size_t)n0_ * 1280; \
        const bf16* ab_ = ham + (size_t)(it_ * 2 + d) * 256; const float* eb_ = heg + (size_t)(it_ * 2 + d) * 64; \
        _Pragma("unroll") for (int u_ = 0; u_ < 4; ++u_) nQ[u_] = *reinterpret_cast<const uint2*>(qb_ + lq + 16 * u_); \
        nA = *reinterpret_cast<const uint2*>(ab_ + la); \
        _Pragma("unroll") for (int u_ = 0; u_ < 4; ++u_) { \
            nK[u_] = *reinterpret_cast<const uint2*>(hb_ + lb + (4 * u_) * 1280 + 256 + d * 256); nV[u_] = *reinterpret_cast<const uint2*>(hb_ + lb + (4 * u_) * 1280 + 768); \
            nE[u_] = *reinterpret_cast<const float4*>(eb_ + le + 16 * u_); } } while (0)
    HG_LOAD(0);
    for (int cc = 0; cc < NCH; ++cc) {
        uint2 cQ[4], cA, cK[4], cV[4]; float4 cE[4];
#pragma unroll
        for (int u = 0; u < 4; ++u) { cQ[u] = nQ[u]; cK[u] = nK[u]; cV[u] = nV[u]; cE[u] = nE[u]; }
        cA = nA;
        if (cc + 1 < NCH) HG_LOAD(cc + 1);
        const int c = d ? NCH - 1 - cc : cc; const size_t n0 = (size_t)b * SEQ + 16 * c;
        union Fr { bf16x8 v; unsigned u[4]; };
        Fr aq0, aq1, aA; aq0.u[0] = cQ[0].x; aq0.u[1] = cQ[0].y; aq0.u[2] = cQ[1].x; aq0.u[3] = cQ[1].y;
        aq1.u[0] = cQ[2].x; aq1.u[1] = cQ[2].y; aq1.u[2] = cQ[3].x; aq1.u[3] = cQ[3].y;
        aA.u[0] = cA.x; aA.u[1] = cA.y; aA.u[2] = 0u; aA.u[3] = 0u;
#pragma unroll
        for (int it = 0; it < 4; ++it) {
            Fr bS0, bS1, bV;
            bS0.u[0] = pack_bf16(S[0][it][0], S[0][it][1]); bS0.u[1] = pack_bf16(S[0][it][2], S[0][it][3]); bS0.u[2] = pack_bf16(S[1][it][0], S[1][it][1]); bS0.u[3] = pack_bf16(S[1][it][2], S[1][it][3]);
            bS1.u[0] = pack_bf16(S[2][it][0], S[2][it][1]); bS1.u[1] = pack_bf16(S[2][it][2], S[2][it][3]); bS1.u[2] = pack_bf16(S[3][it][0], S[3][it][1]); bS1.u[3] = pack_bf16(S[3][it][2], S[3][it][3]);
            bV.u[0] = cV[it].x; bV.u[1] = cV[it].y; bV.u[2] = 0u; bV.u[3] = 0u;
            f32x4 O = {0.f, 0.f, 0.f, 0.f};
            O = __builtin_amdgcn_mfma_f32_16x16x32_bf16(aq0.v, bS0.v, O, 0, 0, 0);
            O = __builtin_amdgcn_mfma_f32_16x16x32_bf16(aq1.v, bS1.v, O, 0, 0, 0);
            O = __builtin_amdgcn_mfma_f32_16x16x32_bf16(aA.v, bV.v, O, 0, 0, 0);
            bf16* od = hh + n0 * 1280 + 256 + d * 256 + h * 64 + 16 * it;
#pragma unroll
            for (int r = 0; r < 4; ++r) od[lo + (unsigned)(r * 1280)] = f2bf(O[r]);
#pragma unroll
            for (int jt = 0; jt < 4; ++jt) {
                Fr aK; aK.u[0] = cK[jt].x; aK.u[1] = cK[jt].y; aK.u[2] = 0u; aK.u[3] = 0u;
                f32x4 t = __builtin_amdgcn_mfma_f32_16x16x32_bf16(aK.v, bV.v, S[jt][it], 0, 0, 0);
                t[0] *= cE[jt].x; t[1] *= cE[jt].y; t[2] *= cE[jt].z; t[3] *= cE[jt].w;
                S[jt][it] = t;
            }
        }
    }
#undef HG_LOAD
}

DI void prep_rwkv_gpu(const Frame& F, int l) {
    const bf16* hz = WSP(bf16, OFF_HRWKV); bf16* r7 = WSP(bf16, OFF_R7); bf16* gb = WSP(bf16, OFF_G); float* bonus = WSP(float, OFF_BONUS);
    const float* mup = F.in[7] + l * 960; const float* mun = F.in[8] + l * 960;
    const float* w0 = F.in[9] + l * 512; const float* w2 = F.in[10] + (size_t)l * 2 * 32 * 256;
    const float* a0 = F.in[11] + l * 512; const float* a2 = F.in[12] + (size_t)l * 2 * 32 * 256;
    const float* g2 = F.in[13] + (size_t)l * 64 * 256;
    const size_t AS = (size_t)NTOK * 256;
    float* zs = (float*)F.smem;
    bf16* stg = (bf16*)(F.smem + 61440);
    float* nts = (float*)(F.smem + 61440 + 73728);
    float* xch = (float*)(F.smem + 143360);
    bf16* lin = (bf16*)(F.smem + 152576);
    float* kkp = xch; float* bop = xch + 128; float* csum = xch + 256;
    const int tid = F.tid, wv = F.wv;
    union WF { bf16x8 v; unsigned u[4]; };
    WF fw0[2], fw1[2], fa0[2], fa1[2], fg0[2], fg1[2];
    float cw0[2], cw1[2], ca0[2], ca1[2], ckk[2], cka[2], crk[2];
    { const int lane0 = tid & 63, x0 = lane0 & 15, q0 = lane0 >> 4;
#pragma unroll
      for (int ci = 0; ci < 2; ++ci) {
          const int c = 32 * wv + 16 * ci + x0;
#pragma unroll
          for (int p = 0; p < 4; ++p) { const int k = 8 * q0 + 2 * p;
              fw0[ci].u[p] = pack_bf16(w2[(size_t)k * 256 + c], w2[(size_t)(k + 1) * 256 + c]); fw1[ci].u[p] = pack_bf16(w2[(size_t)(32 + k) * 256 + c], w2[(size_t)(33 + k) * 256 + c]);
              fa0[ci].u[p] = pack_bf16(a2[(size_t)k * 256 + c], a2[(size_t)(k + 1) * 256 + c]); fa1[ci].u[p] = pack_bf16(a2[(size_t)(32 + k) * 256 + c], a2[(size_t)(33 + k) * 256 + c]);
              fg0[ci].u[p] = pack_bf16(g2[(size_t)k * 256 + c], g2[(size_t)(k + 1) * 256 + c]); fg1[ci].u[p] = pack_bf16(g2[(size_t)(32 + k) * 256 + c], g2[(size_t)(33 + k) * 256 + c]); }
          cw0[ci] = w0[c]; cw1[ci] = w0[256 + c]; ca0[ci] = a0[c]; ca1[ci] = a0[256 + c];
          ckk[ci] = F.in[14][l * 256 + c]; cka[ci] = F.in[15][l * 256 + c]; crk[ci] = F.in[16][l * 256 + c];
      } }
    for (int tile0 = blockIdx.x; tile0 < NTOK / 16; tile0 += F.nblk) {
        const int tile = xcd_unit(tile0, F.nblk, NTOK / 16);
        const int n0 = tile * 16;
        __syncthreads();
        const int tl = fresh_tid(F);
        {
            bf16* raw = stg;
            const int s0 = n0 % SEQ;
            uint4 w0, w1, w2, w3, w4;
#define RW_WIN(i_, reg_) do { const int idx_ = tl + (i_) * NTH; reg_ = make_uint4(0u, 0u, 0u, 0u); if (idx_ < 18 * 120) { const int row_ = idx_ / 120, ch_ = idx_ % 120; \
                if (!((row_ == 0 && s0 == 0) || (row_ == 17 && s0 + 16 == SEQ))) reg_ = *reinterpret_cast<const uint4*>(hz + (size_t)(n0 - 1 + row_) * 1024 + ch_ * 8); } } while (0)
#define RW_WST(i_, reg_) do { const int idx_ = tl + (i_) * NTH; if (idx_ < 18 * 120) *reinterpret_cast<uint4*>(raw + (idx_ / 120) * 960 + (idx_ % 120) * 8) = reg_; } while (0)
            RW_WIN(0, w0); RW_WIN(1, w1); RW_WIN(2, w2); RW_WIN(3, w3); RW_WIN(4, w4);
            RW_WST(0, w0); RW_WST(1, w1); RW_WST(2, w2); RW_WST(3, w3); RW_WST(4, w4);
#undef RW_WIN
#undef RW_WST
            __syncthreads();
#pragma unroll
            for (int i = 0; i < 15; ++i) {
                const int e = tl + i * NTH, t = e / 480, cc = (e % 480) * 2;
                const float2 mp = *reinterpret_cast<const float2*>(mup + cc), mn = *reinterpret_cast<const float2*>(mun + cc);
                const unsigned zc = *reinterpret_cast<const unsigned*>(raw + (t + 1) * 960 + cc), zp = *reinterpret_cast<const unsigned*>(raw + t * 960 + cc), zn = *reinterpret_cast<const unsigned*>(raw + (t + 2) * 960 + cc);
                float v0 = bflo(zc), v1 = bfhi(zc);
                v0 = v0 + mp.x * (bflo(zp) - v0) + mn.x * (bflo(zn) - v0);
                v1 = v1 + mp.y * (bfhi(zp) - v1) + mn.y * (bfhi(zn) - v1);
                if (cc >= 768) {
                    if (cc < 832) { v0 = fast_tanh(v0); v1 = fast_tanh(v1); }
                    else if (cc >= 896) { v0 = fast_sigmoid(v0); v1 = fast_sigmoid(v1); }
                    *reinterpret_cast<unsigned*>(lin + t * 200 + (cc - 768)) = pack_bf16(v0, v1);
                } else *reinterpret_cast<float2*>(zs + t * 960 + cc) = make_float2(v0, v1);
            }
        }
        __syncthreads();
        const int lane = tl & 63, x = lane & 15, q = lane >> 4, hh_ = wv >> 1;
        f32x4 dW0[2], dW1[2], dA0[2], dA1[2], dG[2];
        { const bf16* lr = lin + x * 200 + 8 * q;
          const bf16x8 iw0 = *reinterpret_cast<const bf16x8*>(lr), iw1 = *reinterpret_cast<const bf16x8*>(lr + 32), ia0 = *reinterpret_cast<const bf16x8*>(lr + 64), ia1 = *reinterpret_cast<const bf16x8*>(lr + 96);
          const bf16x8 ig0 = *reinterpret_cast<const bf16x8*>(lr + 128), ig1 = *reinterpret_cast<const bf16x8*>(lr + 160);
          const f32x4 z4 = {0.f, 0.f, 0.f, 0.f};
#pragma unroll
          for (int ci = 0; ci < 2; ++ci) {
              dW0[ci] = __builtin_amdgcn_mfma_f32_16x16x32_bf16(iw0, fw0[ci].v, z4, 0, 0, 0); dW1[ci] = __builtin_amdgcn_mfma_f32_16x16x32_bf16(iw1, fw1[ci].v, z4, 0, 0, 0);
              dA0[ci] = __builtin_amdgcn_mfma_f32_16x16x32_bf16(ia0, fa0[ci].v, z4, 0, 0, 0); dA1[ci] = __builtin_amdgcn_mfma_f32_16x16x32_bf16(ia1, fa1[ci].v, z4, 0, 0, 0);
              dG[ci] = __builtin_amdgcn_mfma_f32_16x16x32_bf16(ig0, fg0[ci].v, z4, 0, 0, 0); dG[ci] = __builtin_amdgcn_mfma_f32_16x16x32_bf16(ig1, fg1[ci].v, dG[ci], 0, 0, 0);
          } }
        float lw0[2][4], lw1[2][4], G0[2][4], G1[2][4];
        float kp[4] = {0.f, 0.f, 0.f, 0.f};
#pragma unroll
        for (int ci = 0; ci < 2; ++ci) {
            const int c = 32 * wv + 16 * ci + x;
#pragma unroll
            for (int r = 0; r < 4; ++r) { lw0[ci][r] = -DECAY_SCALE * fast_sigmoid(dW0[ci][r] + cw0[ci]); lw1[ci][r] = -DECAY_SCALE * fast_sigmoid(dW1[ci][r] + cw1[ci]);
                const float kk = zs[(4 * q + r) * 960 + 256 + c] * ckk[ci]; kp[r] += kk * kk; }
            G0[ci][0] = lw0[ci][0]; G1[ci][3] = lw1[ci][3];
#pragma unroll
            for (int r = 1; r < 4; ++r) { G0[ci][r] = G0[ci][r - 1] + lw0[ci][r]; G1[ci][3 - r] = G1[ci][4 - r] + lw1[ci][3 - r]; }
            csum[(0 * 4 + q) * 256 + c] = G0[ci][3]; csum[(1 * 4 + q) * 256 + c] = G1[ci][0];
        }
#pragma unroll
        for (int r = 0; r < 4; ++r) { const float s = allsum16(kp[r]); if (x == 0) kkp[(4 * q + r) * 8 + wv] = s; }
        __syncthreads();
        float bp[4] = {0.f, 0.f, 0.f, 0.f};
#pragma unroll
        for (int ci = 0; ci < 2; ++ci) {
            const int c = 32 * wv + 16 * ci + x, j = c & 63;
            float off0 = 0.f, off1 = 0.f, tot0 = 0.f, tot1 = 0.f;
#pragma unroll
            for (int qq = 0; qq < 4; ++qq) { const float a = csum[(0 * 4 + qq) * 256 + c], b = csum[(1 * 4 + qq) * 256 + c]; tot0 += a; tot1 += b; if (qq < q) off0 += a; if (qq > q) off1 += b; }
            if (q == 0) { bf16* reg = WSP(bf16, OFF_REG) + ((size_t)(tile * 4 + hh_) * 2) * 64 + j; reg[0] = f2bf(__expf(tot0)); reg[64] = f2bf(__expf(tot1)); }
#pragma unroll
            for (int r = 0; r < 4; ++r) {
                const int tau = 4 * q + r, n = n0 + tau; const float* zr = zs + tau * 960;
                const float rv = zr[c], k = zr[256 + c];
                const float A0 = fast_sigmoid(dA0[ci][r] + ca0[ci]), A1 = fast_sigmoid(dA1[ci][r] + ca1[ci]);
                const float ss = kkp[tau * 8 + 2 * hh_] + kkp[tau * 8 + 2 * hh_ + 1];
                const float kkn = k * ckk[ci] * __builtin_amdgcn_rcpf(fmaxf(__builtin_amdgcn_sqrtf(ss), 1e-12f));
                const float kd0 = k * (1.0f + (A0 - 1.0f) * cka[ci]), kd1 = k * (1.0f + (A1 - 1.0f) * cka[ci]);
                bp[r] += rv * (kd0 + kd1) * crk[ci];
                const float g0 = G0[ci][r] + off0, g1 = G1[ci][r] + off1;
                const float e0 = __expf(g0), e1 = __expf(g1), i0 = __expf(-g0), i1 = __expf(-g1);
                const float kt0 = kkn * __expf(g0 - lw0[ci][r]), kt1 = kkn * __expf(g1 - lw1[ci][r]);
                bf16* s0 = stg + (size_t)((hh_ * 2 + 0) * 4) * 1152 + tau * 72 + j; bf16* s1 = stg + (size_t)((hh_ * 2 + 1) * 4) * 1152 + tau * 72 + j;
                s0[0] = f2bf(kt0); s0[1152] = f2bf(rv * e0); s0[2 * 1152] = f2bf(A0 * kkn * i0); s0[3 * 1152] = f2bf(kd0 * i0);
                s1[0] = f2bf(kt1); s1[1152] = f2bf(rv * e1); s1[2 * 1152] = f2bf(A1 * kkn * i1); s1[3 * 1152] = f2bf(kd1 * i1);
                gb[(size_t)n * 256 + c] = f2bf(dG[ci][r]);
            }
        }
#pragma unroll
        for (int r = 0; r < 4; ++r) { const float s = allsum16(bp[r]); if (x == 0) bop[(4 * q + r) * 8 + wv] = s; }
        __syncthreads();
        if (tl < 64) bonus[(size_t)(n0 + (tl >> 2)) * 4 + (tl & 3)] = bop[(tl >> 2) * 8 + 2 * (tl & 3)] + bop[(tl >> 2) * 8 + 2 * (tl & 3) + 1];
        __syncthreads();
        {
            const int wv = F.wv, lane = fresh_tid(F) & 63, x = lane & 15, q = lane >> 4, dd = wv & 1;
            const bf16* base = stg + (size_t)(wv * 4) * 1152;
            f32x4 nt = {0.f, 0.f, 0.f, 0.f}, mkk = nt, mkr = nt, mar = nt;
#pragma unroll
            for (int ks = 0; ks < 2; ++ks) {
                const bf16x8 fk = *reinterpret_cast<const bf16x8*>(base + x * 72 + 32 * ks + 8 * q);
                const bf16x8 fr = *reinterpret_cast<const bf16x8*>(base + 1152 + x * 72 + 32 * ks + 8 * q);
                const bf16x8 fa = *reinterpret_cast<const bf16x8*>(base + 2 * 1152 + x * 72 + 32 * ks + 8 * q);
                const bf16x8 fs = *reinterpret_cast<const bf16x8*>(base + 3 * 1152 + x * 72 + 32 * ks + 8 * q);
                nt = __builtin_amdgcn_mfma_f32_16x16x32_bf16(fk, fa, nt, 0, 0, 0);
                mkk = __builtin_amdgcn_mfma_f32_16x16x32_bf16(fk, fs, mkk, 0, 0, 0);
                mkr = __builtin_amdgcn_mfma_f32_16x16x32_bf16(fr, fs, mkr, 0, 0, 0);
                mar = __builtin_amdgcn_mfma_f32_16x16x32_bf16(fr, fa, mar, 0, 0, 0);
            }
            bf16* yc = WSP(bf16, OFF_YCAT); bf16* side = WSP(bf16, OFF_RSIDE);
            float* ntw = nts + wv * 256;
            auto mat_ptr = [&](int m) -> bf16* { const int sidx = wv * 4 + m;
                return sidx < 28 ? yc + (size_t)(n0 + 1 + (sidx >> 1)) * 1024 + 256 + (sidx & 1) * 256 : side + ((size_t)tile * 4 + (sidx - 28)) * 256; };
            bf16* m0 = mat_ptr(0); bf16* m2 = mat_ptr(2); bf16* m3 = mat_ptr(3);
#pragma unroll
            for (int r = 0; r < 4; ++r) {
                const int t = 4 * q + r; const bool strict = dd ? (x > t) : (x < t), beq = dd ? (x >= t) : (x <= t);
                const int pos = ((x >> 2) * 16 + t) * 4 + (x & 3);
                ntw[t * 16 + x] = strict ? nt[r] : 0.f;
                m0[pos] = f2bf(strict ? mkk[r] : 0.f); m2[pos] = f2bf(beq ? mkr[r] : 0.f); m3[pos] = f2bf(beq ? -mar[r] : 0.f);
            }
            const size_t blk = ((size_t)tile * 4 + (wv >> 1)) * 1024;
            {
                bf16* dk = r7 + (dd ? C_KT1 : C_KT0) * AS + blk; bf16* dr = r7 + (dd ? C_RT1 : C_RT0) * AS + blk;
#pragma unroll
                for (int ks = 0; ks < 2; ++ks) {
                    const uint2 k0 = *reinterpret_cast<const uint2*>(base + x * 72 + 32 * ks + 4 * q), k1 = *reinterpret_cast<const uint2*>(base + x * 72 + 32 * ks + 16 + 4 * q);
                    const uint2 r0 = *reinterpret_cast<const uint2*>(base + 1152 + x * 72 + 32 * ks + 4 * q), r1 = *reinterpret_cast<const uint2*>(base + 1152 + x * 72 + 32 * ks + 16 + 4 * q);
                    *reinterpret_cast<uint4*>(dk + (ks * 64 + lane) * 8) = make_uint4(k0.x, k0.y, k1.x, k1.y);
                    *reinterpret_cast<uint4*>(dr + (ks * 64 + lane) * 8) = make_uint4(r0.x, r0.y, r1.x, r1.y);
                }
            }
            {
                bf16* ds_ = r7 + (dd ? C_KK1 : C_KK0) * AS + blk; bf16* da = r7 + (dd ? C_AT1 : C_AT0) * AS + blk; bf16* dv = r7 + C_VT * AS + blk;
                const bf16* sa = base + 2 * 1152; const bf16* sk = base + 3 * 1152;
                const float* zv = zs + 512 + (wv >> 1) * 64;
#pragma unroll
                for (int u = 0; u < 4; ++u) {
                    const int ch = 16 * u + x;
                    const unsigned a0 = sa[(4 * q) * 72 + ch], a1 = sa[(4 * q + 1) * 72 + ch], a2 = sa[(4 * q + 2) * 72 + ch], a3 = sa[(4 * q + 3) * 72 + ch];
                    const unsigned k0 = sk[(4 * q) * 72 + ch], k1 = sk[(4 * q + 1) * 72 + ch], k2 = sk[(4 * q + 2) * 72 + ch], k3 = sk[(4 * q + 3) * 72 + ch];
                    *reinterpret_cast<uint2*>(ds_ + (u * 64 + lane) * 4) = make_uint2(k0 | (k1 << 16), k2 | (k3 << 16));
                    *reinterpret_cast<uint2*>(da + (u * 64 + lane) * 4) = make_uint2((a0 | (a1 << 16)) ^ 0x80008000u, (a2 | (a3 << 16)) ^ 0x80008000u);
                    if (dd == 0) *reinterpret_cast<uint2*>(dv + (u * 64 + lane) * 4) =
                        make_uint2(pack_bf16(zv[(4 * q) * 960 + ch], zv[(4 * q + 1) * 960 + ch]), pack_bf16(zv[(4 * q + 2) * 960 + ch], zv[(4 * q + 3) * 960 + ch]));
                }
            }
            asm volatile("s_waitcnt lgkmcnt(0)" ::: "memory");
            __builtin_amdgcn_wave_barrier();
            if (lane < 16) {
                float X[16];
                if (dd == 0) {
#pragma unroll
                    for (int t = 0; t < 16; ++t) { float a = (t == lane) ? 1.f : 0.f;
#pragma unroll
                        for (int s2 = 0; s2 < t; ++s2) a -= ntw[t * 16 + s2] * X[s2];
                        X[t] = a; }
                } else {
#pragma unroll
                    for (int t = 15; t >= 0; --t) { float a = (t == lane) ? 1.f : 0.f;
#pragma unroll
                        for (int s2 = t + 1; s2 < 16; ++s2) a -= ntw[t * 16 + s2] * X[s2];
                        X[t] = a; }
                }
                bf16* m1 = mat_ptr(1);
#pragma unroll
                for (int t = 0; t < 16; ++t) m1[((lane >> 2) * 16 + t) * 4 + (lane & 3)] = f2bf(X[t]);
            }
        }
    }
}

DI void scan_rwkv_chunk(const Frame& F, int chain) {
    const int d = chain / (BATCH * 4), b = (chain / 4) % BATCH, h = chain % 4, combo = h * 2 + d;
    const int lane = fresh_tid(F) & 63, q = lane >> 4;
    const size_t AS = (size_t)NTOK * 256;
    bf16* r7 = WSP(bf16, OFF_R7); const bf16* yc = WSP(bf16, OFF_YCAT); const bf16* side = WSP(bf16, OFF_RSIDE); const bf16* reg = WSP(bf16, OFF_REG);
    bf16* akt = r7 + (d ? C_KT1 : C_KT0) * AS; const bf16* art = r7 + (d ? C_RT1 : C_RT0) * AS;
    const bf16* akk = r7 + (d ? C_KK1 : C_KK0) * AS; const bf16* aat = r7 + (d ? C_AT1 : C_AT0) * AS; const bf16* avt = r7 + C_VT * AS;
    f32x4 Z[4][4];
#pragma unroll
    for (int a = 0; a < 4; ++a)
#pragma unroll
        for (int c = 0; c < 4; ++c) Z[a][c] = (f32x4){0.f, 0.f, 0.f, 0.f};
    constexpr int NCH = SEQ / 16;
    const unsigned l8 = (unsigned)lane * 8, l4 = (unsigned)lane * 4, le = (unsigned)(4 * q);
    uint4 nK[2], nR[2]; uint2 nM[4], nV[4];
#define RW_MPTR(tl_, m_) ((combo * 4 + (m_)) < 28 ? yc + (size_t)((tl_) * 16 + 1 + ((combo * 4 + (m_)) >> 1)) * 1024 + 256 + ((combo * 4 + (m_)) & 1) * 256 \
                                                   : side + ((size_t)(tl_) * 4 + (combo * 4 + (m_) - 28)) * 256)
#define RW_LOADKR(cc_) do { const int c_ = d ? NCH - 1 - (cc_) : (cc_); const unsigned tl_ = (unsigned)(b * NCH + c_); const size_t bo_ = ((size_t)tl_ * 4 + h) * 1024; \
        nK[0] = *reinterpret_cast<const uint4*>(akt + bo_ + l8); nK[1] = *reinterpret_cast<const uint4*>(akt + bo_ + 512 + l8); \
        nR[0] = *reinterpret_cast<const uint4*>(art + bo_ + l8); nR[1] = *reinterpret_cast<const uint4*>(art + bo_ + 512 + l8); } while (0)
#define RW_LOAD(cc_) do { const int c_ = d ? NCH - 1 - (cc_) : (cc_); const unsigned tl_ = (unsigned)(b * NCH + c_); const size_t bo_ = ((size_t)tl_ * 4 + h) * 1024; \
        _Pragma("unroll") for (int u_ = 0; u_ < 4; ++u_) { nM[u_] = *reinterpret_cast<const uint2*>(RW_MPTR(tl_, u_) + l4); nV[u_] = *reinterpret_cast<const uint2*>(avt + bo_ + u_ * 256 + l4); \
            nS[u_] = *reinterpret_cast<const uint2*>(akk + bo_ + u_ * 256 + l4); nA[u_] = *reinterpret_cast<const uint2*>(aat + bo_ + u_ * 256 + l4); \
            nE[u_] = *reinterpret_cast<const uint2*>(reg + (size_t)((tl_ * 4 + h) * 2 + d) * 64 + le + 16 * u_); } } while (0)
    uint2 nS[4], nA[4], nE[4];
    RW_LOADKR(0); RW_LOAD(0);
    for (int cc = 0; cc < NCH; ++cc) {
        const int c = d ? NCH - 1 - cc : cc; const unsigned tl = (unsigned)(b * NCH + c); const size_t bo = ((size_t)tl * 4 + h) * 1024;
        uint2 cS[4], cA[4], cE[4];
#pragma unroll
        for (int u = 0; u < 4; ++u) { cS[u] = nS[u]; cA[u] = nA[u]; cE[u] = nE[u]; }
        union Fr { bf16x8 v; unsigned u[4]; uint4 w; };
        Fr aK0, aK1, aR0, aR1, aY;
        aK0.w = nK[0]; aK1.w = nK[1]; aR0.w = nR[0]; aR1.w = nR[1];
        f32x4 P1a[4], P2a[4];
#pragma unroll
        for (int it = 0; it < 4; ++it) {
            Fr bZ0, bZ1;
            bZ0.u[0] = pack_bf16(Z[0][it][0], Z[0][it][1]); bZ0.u[1] = pack_bf16(Z[0][it][2], Z[0][it][3]); bZ0.u[2] = pack_bf16(Z[1][it][0], Z[1][it][1]); bZ0.u[3] = pack_bf16(Z[1][it][2], Z[1][it][3]);
            bZ1.u[0] = pack_bf16(Z[2][it][0], Z[2][it][1]); bZ1.u[1] = pack_bf16(Z[2][it][2], Z[2][it][3]); bZ1.u[2] = pack_bf16(Z[3][it][0], Z[3][it][1]); bZ1.u[3] = pack_bf16(Z[3][it][2], Z[3][it][3]);
            const f32x4 zero = {0.f, 0.f, 0.f, 0.f};
            P1a[it] = __builtin_amdgcn_mfma_f32_16x16x32_bf16(aK0.v, bZ0.v, zero, 0, 0, 0); P1a[it] = __builtin_amdgcn_mfma_f32_16x16x32_bf16(aK1.v, bZ1.v, P1a[it], 0, 0, 0);
            P2a[it] = __builtin_amdgcn_mfma_f32_16x16x32_bf16(aR0.v, bZ0.v, zero, 0, 0, 0); P2a[it] = __builtin_amdgcn_mfma_f32_16x16x32_bf16(aR1.v, bZ1.v, P2a[it], 0, 0, 0);
        }
        asm volatile("" :: "v"(P1a[3][0]) : "memory");
        if (cc + 1 < NCH) RW_LOADKR(cc + 1);
        union F4 { bf16x4 v; unsigned u[2]; };
        F4 aMk4, aTT4;
        aMk4.u[0] = nM[0].x; aMk4.u[1] = nM[0].y;
        aTT4.u[0] = nM[1].x; aTT4.u[1] = nM[1].y;
        aY.u[0] = nM[2].x; aY.u[1] = nM[2].y; aY.u[2] = nM[3].x; aY.u[3] = nM[3].y;
        uint2 cV[4];
#pragma unroll
        for (int u = 0; u < 4; ++u) cV[u] = nV[u];
        if (cc + 1 < NCH) RW_LOAD(cc + 1);
#pragma unroll
        for (int it = 0; it < 4; ++it) {
            Fr bVU;
            const f32x4 zero = {0.f, 0.f, 0.f, 0.f};
            const f32x4 P1 = P1a[it], P2 = P2a[it];
            F4 bV4, bB4;
            bV4.u[0] = cV[it].x; bV4.u[1] = cV[it].y;
            const f32x4 Bt = __builtin_amdgcn_mfma_f32_16x16x16bf16_1k(aMk4.v, bV4.v, P1, 0, 0, 0);
            bB4.u[0] = pack_bf16(Bt[0], Bt[1]); bB4.u[1] = pack_bf16(Bt[2], Bt[3]);
            const f32x4 Ut = __builtin_amdgcn_mfma_f32_16x16x16bf16_1k(aTT4.v, bB4.v, zero, 0, 0, 0);
            bVU.u[0] = cV[it].x; bVU.u[1] = cV[it].y; bVU.u[2] = pack_bf16(Ut[0], Ut[1]); bVU.u[3] = pack_bf16(Ut[2], Ut[3]);
            const f32x4 Y = __builtin_amdgcn_mfma_f32_16x16x32_bf16(aY.v, bVU.v, P2, 0, 0, 0);
            *reinterpret_cast<uint2*>(akt + bo + it * 256 + l4) = make_uint2(pack_bf16(Y[0], Y[1]), pack_bf16(Y[2], Y[3]));
#pragma unroll
            for (int jt = 0; jt < 4; ++jt) {
                Fr aS; aS.u[0] = cS[jt].x; aS.u[1] = cS[jt].y; aS.u[2] = cA[jt].x; aS.u[3] = cA[jt].y;
                f32x4 t = __builtin_amdgcn_mfma_f32_16x16x32_bf16(aS.v, bVU.v, Z[jt][it], 0, 0, 0);
                t[0] *= bflo(cE[jt].x); t[1] *= bfhi(cE[jt].x); t[2] *= bflo(cE[jt].y); t[3] *= bfhi(cE[jt].y);
                Z[jt][it] = t;
            }
        }
    }
#undef RW_LOAD
#undef RW_MPTR
}
#endif

DI void phase_prep(const Frame& F, int l) {
#ifndef CPU_EMU
    prep_attn_gpu(F, l); prep_rwkv_gpu(F, l); prep_hgrn_gpu(F, l);
#else
    {
        bf16* hatt = WSP(bf16, OFF_HATT); bf16* vt = WSP(bf16, OFF_VTATT);
        const float* qn = F.in[5] + l * 64; const float* kn = F.in[6] + l * 64;
        const int nitem = NTOK * 6;
        for (int it = ggrp(F); it < nitem; it += ngrp(F)) {
            const int n = it / 6, hh = it % 6;
            const int s = n % SEQ;
            bf16* p = hatt + (size_t)n * 512 + hh * 64;
            const float* gn = hh < 4 ? qn : kn;
            float v[PER64]; float ss = 0.f;
            for (int i = 0; i < PER64; ++i) { int j = glane(F) + i * GRP; v[i] = bf2f(p[j]); ss += v[i] * v[i]; }
            ss = grp_sum(F, ss); const float rs = 1.0f / sqrtf(ss * (1.0f / 64.0f) + RMS_EPS);
            float o[PER64];
#ifdef CPU_EMU
            float nv[64]; for (int j = 0; j < 64; ++j) nv[j] = v[j] * rs * gn[j];
#endif
            for (int i = 0; i < PER64; ++i) {
                int j = glane(F) + i * GRP;
                const int half = j >> 5, w = j & 31, f = w & 15, second = w >> 4;
                const float pos = half == 0 ? (float)(s / GRIDW) : (float)(s % GRIDW);
                const float ang = pos * rope_inv(2 * f, 32);
                const float cs = cosf(ang), sn = sinf(ang);
                const float mine = v[i] * rs * gn[j];
                const int jp = second ? j - 16 : j + 16;
#ifdef CPU_EMU
                const float partner = nv[jp];
#else
                const float partner = shfl_idx(F, v[0], jp) * rs * gn[jp];
#endif
                o[i] = second ? (partner * sn + mine * cs) : (mine * cs - partner * sn);
            }
            for (int i = 0; i < PER64; ++i) { int j = glane(F) + i * GRP; p[j] = f2bf(o[i]); }
        }
        for (size_t i = gtid_(F); i < (size_t)NTOK * 128; i += gthreads(F)) {
            const int n = (int)(i / 128), c = (int)(i % 128), b = n / SEQ, s = n % SEQ;
            vt[((size_t)b * 128 + c) * SEQ + s] = hatt[(size_t)n * 512 + 384 + c];
        }
    }
    {
        bf16* hm = WSP(bf16, OFF_HMLA); bf16* kr = WSP(bf16, OFF_KROPE);
        const float* qn = F.in[21] + l * 192; const float* kvn = F.in[22] + l * 128;
        for (int it = ggrp(F); it < NTOK * 2; it += ngrp(F)) {
            const int n = it >> 1, which = it & 1;
            bf16* p = hm + (size_t)n * 512 + (which ? 256 : 0);
            const int len = which ? 128 : 192; const float* gn = which ? kvn : qn;
            float ss = 0.f;
            for (int j = glane(F); j < len; j += GRP) { float x = bf2f(p[j]); ss += x * x; }
            ss = grp_sum(F, ss); const float rs = 1.0f / sqrtf(ss / (float)len + RMS_EPS);
            for (int j = glane(F); j < len; j += GRP) p[j] = f2bf(bf2f(p[j]) * rs * gn[j]);
        }
        for (int i = gtid_(F); i < NTOK * 16; i += gthreads(F)) {
            const int n = i >> 4, m = i & 15, s = n % SEQ;
            const bf16* src = hm + (size_t)n * 512 + 192;
            const int i1 = (m < 8 ? m : 16 + (m - 8)), i2 = i1 + 8;
            const float x1 = bf2f(src[i1]), x2 = bf2f(src[i2]);
            const float pos = m < 8 ? (float)(s / GRIDW) : (float)(s % GRIDW);
            const float ang = pos * rope_inv(2 * (m & 7), 16);
            const float cs = cosf(ang), sn = sinf(ang);
            kr[(size_t)n * 32 + 2 * m] = f2bf(x1 * cs - x2 * sn);
            kr[(size_t)n * 32 + 2 * m + 1] = f2bf(x1 * sn + x2 * cs);
        }
    }
#ifdef CPU_EMU
    {
        const bf16* hz = WSP(bf16, OFF_HRWKV); bf16* r7 = WSP(bf16, OFF_R7); bf16* gb = WSP(bf16, OFF_G); float* bonus = WSP(float, OFF_BONUS);
        const float* mup = F.in[7] + l * 960; const float* mun = F.in[8] + l * 960;
        const float* w0 = F.in[9] + l * 512; const float* w2 = F.in[10] + (size_t)l * 2 * 32 * 256;
        const float* a0 = F.in[11] + l * 512; const float* a2 = F.in[12] + (size_t)l * 2 * 32 * 256;
        const float* g2 = F.in[13] + (size_t)l * 64 * 256;
        const float* k_k = F.in[14] + l * 256; const float* k_a = F.in[15] + l * 256; const float* r_k = F.in[16] + l * 256;
        const size_t AS = (size_t)NTOK * 256;
        for (int it = ggrp(F); it < NTOK * 4; it += ngrp(F)) {
            const int n = it >> 2, h = it & 3, s = n % SEQ;
            const bf16* z = hz + (size_t)n * 1024;
            const bool hp = s > 0, hn = s < SEQ - 1;
            auto shifted = [&](int c) -> float {
                const float zc = bf2f(z[c]);
                const float zp = hp ? bf2f(z[c - 1024]) : 0.f, zn = hn ? bf2f(z[c + 1024]) : 0.f;
                return zc + mup[c] * (zp - zc) + mun[c] * (zn - zc);
            };
            float kkv[PER64], rr[PER64], kd0[PER64], kd1[PER64], aa0[PER64], aa1[PER64];
            float ss = 0.f, bs = 0.f;
            for (int i = 0; i < PER64; ++i) {
                const int j = glane(F) + i * GRP, c = h * 64 + j;
                const float r = shifted(c), k = shifted(256 + c), v = shifted(512 + c);
                float wr0 = w0[c], wr1 = w0[256 + c], ar0 = a0[c], ar1 = a0[256 + c], g = 0.f;
                for (int q = 0; q < 32; ++q) {
                    wr0 += tanhf(shifted(768 + q)) * w2[(size_t)q * 256 + c];
                    wr1 += tanhf(shifted(800 + q)) * w2[(size_t)(32 + q) * 256 + c];
                    ar0 += shifted(832 + q) * a2[(size_t)q * 256 + c];
                    ar1 += shifted(864 + q) * a2[(size_t)(32 + q) * 256 + c];
                }
                for (int q = 0; q < 64; ++q) g += sigmoidf_(shifted(896 + q)) * g2[(size_t)q * 256 + c];
                const float dec0 = expf(-DECAY_SCALE * sigmoidf_(wr0)), dec1 = expf(-DECAY_SCALE * sigmoidf_(wr1));
                const float A0 = sigmoidf_(ar0), A1 = sigmoidf_(ar1);
                const float kk = k * k_k[c];
                kkv[i] = kk; ss += kk * kk; rr[i] = r; aa0[i] = A0; aa1[i] = A1;
                kd0[i] = k * (1.0f + (A0 - 1.0f) * k_a[c]); kd1[i] = k * (1.0f + (A1 - 1.0f) * k_a[c]);
                bs += r * (kd0[i] + kd1[i]) * r_k[c];
                const size_t o = (size_t)n * 256 + c;
                r7[R_R * AS + o] = f2bf(r); r7[R_V * AS + o] = f2bf(v);
                r7[R_W0 * AS + o] = f2bf(dec0); r7[R_W1 * AS + o] = f2bf(dec1);
                r7[R_KD0 * AS + o] = f2bf(kd0[i]); r7[R_KD1 * AS + o] = f2bf(kd1[i]);
                gb[o] = f2bf(g);
            }
            ss = grp_sum(F, ss); bs = grp_sum(F, bs);
            const float inv = 1.0f / fmaxf(sqrtf(ss), 1e-12f);
            for (int i = 0; i < PER64; ++i) {
                const int j = glane(F) + i * GRP, c = h * 64 + j; const size_t o = (size_t)n * 256 + c;
                const float kk = kkv[i] * inv;
                r7[R_KK * AS + o] = f2bf(kk); r7[R_AK0 * AS + o] = f2bf(aa0[i] * kk); r7[R_AK1 * AS + o] = f2bf(aa1[i] * kk);
            }
            if (glane(F) == 0) bonus[(size_t)n * 4 + h] = bs;
        }
    }
#else
    prep_rwkv_gpu(F, l);
#endif
    {
        bf16* hh = WSP(bf16, OFF_HHGRN);
        const float* lg = F.in[19];
        for (size_t i = gtid_(F); i < (size_t)NTOK * 768; i += gthreads(F)) {
            const int n = (int)(i / 768), c = (int)(i % 768);
            bf16* p = hh + (size_t)n * 1280 + c;
            const float x = bf2f(*p);
            if (c < 256) { *p = f2bf(siluf_(x)); }
            else {
                const int d = c & 255;
                float lb = 0.f;
                if (l == 1) { const float a = lg[d], b = lg[256 + d]; const float m = fmaxf(a, b); const float ea = expf(a - m), eb = expf(b - m); lb = eb / (ea + eb); }
                *p = f2bf((1.0f - lb) * sigmoidf_(-x));
            }
        }
    }
#endif
}

struct EpiQMla {
    bf16* q; int row0, pn; const float* tab;
    DI void operator()(int r, int c, float a, float b, float cc, float d) const {
        const int row = row0 + r, col = pn * 256 + c;
        if (col >= 384) return;
        const int w = col % 96;
        if (w >= 64) {
            const int s = row % SEQ;
#pragma unroll
            for (int t = 0; t < 2; ++t) {
                const int m = ((w - 64) >> 1) + t;
#ifdef CPU_EMU
                const float pos = m < 8 ? (float)(s / GRIDW) : (float)(s % GRIDW);
                const float ang = pos * rope_inv(2 * (m & 7), 16);
                const float cs = cosf(ang), sn = sinf(ang);
#else
                const int pi = m < 8 ? s / GRIDW : s % GRIDW;
                const float cs = tab[pi * 8 + (m & 7)], sn = tab[512 + pi * 8 + (m & 7)];
#endif
                float& x1 = t ? cc : a; float& x2 = t ? d : b;
                const float y1 = x1 * cs - x2 * sn, y2 = x1 * sn + x2 * cs; x1 = y1; x2 = y2;
            }
        }
#ifndef CPU_EMU
        { const float qsc = 0.10206207261596575f * 1.4426950408889634f; a *= qsc; b *= qsc; cc *= qsc; d *= qsc; }
#endif
        st_bf16x4(q + (size_t)row * 384 + col, a, b, cc, d);
    }
};
struct EpiKVMla {
    bf16* kn; bf16* vt; int row0, pn;
    DI void operator()(int r, int c, float a, float b, float cc, float d) const {
        const int row = row0 + r, col = pn * 256 + c, h = col >> 7, w = col & 127;
        if (w < 64) st_bf16x4(kn + (size_t)row * 256 + h * 64 + w, a, b, cc, d);
        else { const int bb = row / SEQ, s = row % SEQ; bf16* p = vt + ((size_t)bb * 256 + h * 64 + (w - 64)) * SEQ + s;
            p[0] = f2bf(a); p[SEQ] = f2bf(b); p[2 * SEQ] = f2bf(cc); p[3 * SEQ] = f2bf(d); }
    }
};
DI void phase_mlaup(const Frame& F) {
    const bf16* hm = WSP(bf16, OFF_HMLA); const char* wts = (const char*)WSP(bf16, OFF_WTS);
    const int nM = (NTOK + 255) / 256;
    float* rtab = (float*)(F.smem + 139264);
#ifndef CPU_EMU
    __syncthreads();
    { const int i = fresh_tid(F); const int pos = i >> 3, f = i & 7; const float ang = (float)pos * rope_inv(2 * f, 16); rtab[i] = cosf(ang); rtab[512 + i] = sinf(ang); }
    __syncthreads();
#endif
    for (int u0 = blockIdx.x; u0 < nM * 4; u0 += F.nblk) {
#ifdef CPU_EMU
        const int u = u0;
#else
        const int u = xcd_unit(u0, F.nblk, nM * 4);
#endif
        const int pm = u >> 2, j = u & 3;
#ifdef CPU_EMU
        const int mr = min(256, NTOK - pm * 256);
#define MR , mr
#else
#define MR
#endif
        if (j < 2) { EpiQMla E{WSP(bf16, OFF_QMLA), pm * 256, j, rtab};
            gemm_unit(F, hm, 512, nullptr, pm * 256, (const bf16*)(wts + W_UQ_T), 256, j * 256, 256, E MR); }
#ifndef CPU_EMU
        else if (j == 2) { EpiBf E{WSP(bf16, OFF_KNOPE), 256, pm * 256, 0};
            gemm_unit(F, hm + 256, 512, nullptr, pm * 256, (const bf16*)(wts + W_UKV_T), 256, 0, 256, E); }
        else {
            EpiBf E{WSP(bf16, OFF_VTMLA) + (size_t)(pm / (SEQ / 256)) * 256 * SEQ + (size_t)(pm % (SEQ / 256)) * 256, SEQ, 0, 0};
            gemm_unit(F, (const bf16*)(wts + W_UKV_T) + 256 * 256, 256, nullptr, 0, hm + 256, 512, pm * 256, 256, E); }
#else
        else { EpiKVMla E{WSP(bf16, OFF_KNOPE), WSP(bf16, OFF_VTMLA), pm * 256, j - 2};
            gemm_unit(F, hm + 256, 512, nullptr, pm * 256, (const bf16*)(wts + W_UKV_T), 256, (j - 2) * 256, 256, E MR); }
#endif
    }
}

struct AttnDesc {
    const bf16* q; int q_stride;
    int q_hstride;
    const bf16* k; int k_stride; int k_hstride;
    const bf16* k2; int k2_stride;
    int dk_main;
    const bf16* vt;
    bf16* o; int o_stride; int o_hstride;
    int H, HKV, SQ, SK;
    float scale;
};

#ifdef CPU_EMU
template <int DK, int DV>
void attn_phase(const Frame& F, const AttnDesc& A) {
    const int G = A.H / A.HKV;
    float* sc = (float*)malloc(sizeof(float) * A.SK);
    for (int b = 0; b < BATCH; ++b) for (int h = 0; h < A.H; ++h) for (int s = 0; s < A.SQ; ++s) {
        const int kv = h / G;
        const bf16* q = A.q + (size_t)(b * A.SQ + s) * A.q_stride + h * A.q_hstride;
        float mx = -1e30f;
        for (int key = 0; key < A.SK; ++key) {
            const bf16* kp = A.k + (size_t)(b * A.SK + key) * A.k_stride + kv * A.k_hstride;
            double acc = 0;
            for (int d = 0; d < DK; ++d) {
                float kvl = d < A.dk_main ? bf2f(kp[d]) : bf2f(A.k2[(size_t)(b * A.SK + key) * A.k2_stride + d - A.dk_main]);
                acc += (double)bf2f(q[d]) * kvl;
            }
            sc[key] = (float)acc * A.scale; mx = fmaxf(mx, sc[key]);
        }
        double sum = 0; for (int key = 0; key < A.SK; ++key) { sc[key] = expf(sc[key] - mx); sum += sc[key]; }
        for (int dv = 0; dv < DV; ++dv) {
            const bf16* vp = A.vt + ((size_t)(b * A.HKV + kv) * DV + dv) * A.SK;
            double acc = 0; for (int key = 0; key < A.SK; ++key) acc += (double)bf2f(f2bf(sc[key])) * bf2f(vp[key]);
            A.o[(size_t)(b * A.SQ + s) * A.o_stride + h * A.o_hstride + dv] = f2bf((float)(acc / sum));
        }
    }
    free(sc);
}
#else
DI int crow16(int reg, int h) { return (reg & 3) + 8 * (reg >> 2) + 4 * h; }
DI float other_half(float x, int hh) {
    const unsigned u = __builtin_bit_cast(unsigned, x);
    auto r = __builtin_amdgcn_permlane32_swap(u, u, false, false);
    return __builtin_bit_cast(float, hh ? (unsigned)r[0] : (unsigned)r[1]);
}
DI void st_otile(bf16* p, const f32x16& o, float inv, int hh) {
#pragma unroll
    for (int g = 0; g < 4; g += 2) {
        uint2 a = make_uint2(pack_bf16(o[4 * g] * inv, o[4 * g + 1] * inv), pack_bf16(o[4 * g + 2] * inv, o[4 * g + 3] * inv));
        uint2 b = make_uint2(pack_bf16(o[4 * g + 4] * inv, o[4 * g + 5] * inv), pack_bf16(o[4 * g + 6] * inv, o[4 * g + 7] * inv));
        auto rx = __builtin_amdgcn_permlane32_swap(a.x, b.x, false, false); a.x = rx[0]; b.x = rx[1];
        auto ry = __builtin_amdgcn_permlane32_swap(a.y, b.y, false, false); a.y = ry[0]; b.y = ry[1];
        *reinterpret_cast<uint4*>(p + 8 * g + 8 * hh) = make_uint4(a.x, a.y, b.x, b.y);
    }
}
template <int DK, int DV, int DVT, int NQB>
DI void attn_unit(const Frame& F, const AttnDesc& A, int u) {
    constexpr int KP = DK + 8;
    constexpr int VP = 64 + 8;
    constexpr int NPASS = DV / DVT;
    constexpr int UQ = 256 * NQB;
    bf16* Ks = (bf16*)F.smem;
    bf16* Vs = Ks + 64 * KP;
    const int tid = fresh_tid(F), wave = F.wv, lane = tid & 63, r = lane & 31, hh = lane >> 5;
    const int G = A.H / A.HKV;
    const int nqb = A.SQ / UQ;
    {
        int t = u; const int pass = t % NPASS; t /= NPASS; const int qb = t % nqb; t /= nqb; const int h = t % A.H; const int b = t / A.H;
        const int kv = h / G;
        const int q0 = qb * UQ + wave * 32 * NQB;
        bf16x8 qf[NQB][DK / 16];
#pragma unroll
        for (int qi = 0; qi < NQB; ++qi) { const bf16* qp = A.q + (size_t)(b * A.SQ + q0 + 32 * qi + r) * A.q_stride + h * A.q_hstride + 8 * hh;
#pragma unroll
          for (int ks = 0; ks < DK / 16; ++ks) qf[qi][ks] = *reinterpret_cast<const bf16x8*>(qp + 16 * ks); }
        f32x16 oacc[NQB][DVT / 32];
#pragma unroll
        for (int qi = 0; qi < NQB; ++qi)
#pragma unroll
            for (int i = 0; i < DVT / 32; ++i)
#pragma unroll
                for (int j = 0; j < 16; ++j) oacc[qi][i][j] = 0.f;
        float frm[NQB], lrun[NQB];
        union QX { bf16x8 v; unsigned u[4]; };
        QX qx[NQB], kone;
        kone.u[0] = hh ? 0u : 0x3f80u; kone.u[1] = 0u; kone.u[2] = 0u; kone.u[3] = 0u;
#pragma unroll
        for (int qi = 0; qi < NQB; ++qi) { frm[qi] = 0.f; lrun[qi] = 0.f; qx[qi].u[0] = 0u; qx[qi].u[1] = 0u; qx[qi].u[2] = 0u; qx[qi].u[3] = 0u; }
        constexpr int NKC = (64 * (DK / 8) + 511) / 512, NVC = (DVT * 8 + 511) / 512;
        uint4 kr0, kr1, kr2, kr3, vr0, vr1;
        kr0 = kr1 = kr2 = kr3 = vr0 = vr1 = make_uint4(0u, 0u, 0u, 0u);
#define ATT_FK(kt_, i_, reg_) do { if ((i_) < NKC) { int c_ = tid + (i_) * 512; if (c_ >= 64 * (DK / 8)) c_ = 64 * (DK / 8) - 1; \
            const int key_ = c_ / (DK / 8), d8_ = (c_ % (DK / 8)) * 8; const size_t krow_ = (size_t)(b * A.SK + (kt_) * 64 + key_); \
            const bf16* kp_ = (d8_ < A.dk_main) ? (A.k + krow_ * A.k_stride + kv * A.k_hstride + d8_) : (A.k2 + krow_ * A.k2_stride + (d8_ - A.dk_main)); \
            reg_ = *reinterpret_cast<const uint4*>(kp_); } } while (0)
#define ATT_FV(kt_, i_, reg_) do { if ((i_) < NVC) { int c_ = tid + (i_) * 512; if (c_ >= DVT * 8) c_ = DVT * 8 - 1; \
            const int dv_ = c_ >> 3, k8_ = (c_ & 7) * 8; \
            reg_ = *reinterpret_cast<const uint4*>(A.vt + ((size_t)(b * A.HKV + kv) * DV + pass * DVT + dv_) * A.SK + (kt_) * 64 + k8_); } } while (0)
#define ATT_FETCH(kt_) do { ATT_FK(kt_, 0, kr0); ATT_FK(kt_, 1, kr1); ATT_FK(kt_, 2, kr2); ATT_FK(kt_, 3, kr3); ATT_FV(kt_, 0, vr0); ATT_FV(kt_, 1, vr1); } while (0)
#define ATT_SK(kb_, i_, reg_) do { if ((i_) < NKC) { const int c_ = tid + (i_) * 512; if (c_ < 64 * (DK / 8)) { \
            const int key_ = c_ / (DK / 8), d8_ = (c_ % (DK / 8)) * 8; *reinterpret_cast<uint4*>((kb_) + key_ * KP + d8_) = reg_; } } } while (0)
#define ATT_SV(vb_, i_, reg_) do { if ((i_) < NVC) { const int c_ = tid + (i_) * 512; if (c_ < DVT * 8) { \
            const int dv_ = c_ >> 3, k8_ = (c_ & 7) * 8; *reinterpret_cast<uint4*>((vb_) + dv_ * VP + k8_) = reg_; } } } while (0)
#define ATT_STORE(kb_, vb_) do { ATT_SK(kb_, 0, kr0); ATT_SK(kb_, 1, kr1); ATT_SK(kb_, 2, kr2); ATT_SK(kb_, 3, kr3); ATT_SV(vb_, 0, vr0); ATT_SV(vb_, 1, vr1); } while (0)
        constexpr bool PREF = DK <= 96;
        constexpr int BUFE = 64 * KP + DVT * VP;
        const int ntile = A.SK / 64;
        if (PREF) { ATT_FETCH(0); ATT_STORE(Ks, Vs); if (ntile > 1) ATT_FETCH(1); __syncthreads(); }
        for (int kt = 0; kt < ntile; ++kt) {
            if (PREF) {
                if (kt + 1 < ntile) { bf16* kb = Ks + ((kt + 1) & 1) * BUFE; ATT_STORE(kb, kb + 64 * KP); if (kt + 2 < ntile) ATT_FETCH(kt + 2); }
            } else {
            __syncthreads();
            {
                for (int c = tid; c < 64 * (DK / 8); c += 512) {
                    const int key = c / (DK / 8), d8 = (c % (DK / 8)) * 8;
                    const size_t krow = (size_t)(b * A.SK + kt * 64 + key);
                    uint4 v;
                    if (d8 < A.dk_main) v = *reinterpret_cast<const uint4*>(A.k + krow * A.k_stride + kv * A.k_hstride + d8);
                    else v = *reinterpret_cast<const uint4*>(A.k2 + krow * A.k2_stride + (d8 - A.dk_main));
                    *reinterpret_cast<uint4*>(Ks + key * KP + d8) = v;
                }
                for (int c = tid; c < DVT * 8; c += 512) {
                    const int dv = c >> 3, k8 = (c & 7) * 8;
                    const uint4 v = *reinterpret_cast<const uint4*>(A.vt + ((size_t)(b * A.HKV + kv) * DV + pass * DVT + dv) * A.SK + kt * 64 + k8);
                    *reinterpret_cast<uint4*>(Vs + dv * VP + k8) = v;
                }
            }
            __syncthreads();
            }
            const bf16* Kc = PREF ? Ks + (kt & 1) * BUFE : Ks; const bf16* Vc = Kc + 64 * KP;
            f32x16 sacc[NQB][2];
#pragma unroll
            for (int kb = 0; kb < 2; ++kb) {
#pragma unroll
                for (int qi = 0; qi < NQB; ++qi)
#pragma unroll
                    for (int j = 0; j < 16; ++j) sacc[qi][kb][j] = 0.f;
#pragma unroll
                for (int ks = 0; ks < DK / 16; ++ks) {
                    const bf16x8 kf = *reinterpret_cast<const bf16x8*>(Kc + (kb * 32 + r) * KP + 16 * ks + 8 * hh);
#pragma unroll
                    for (int qi = 0; qi < NQB; ++qi) sacc[qi][kb] = __builtin_amdgcn_mfma_f32_32x32x16_bf16(kf, qf[qi][ks], sacc[qi][kb], 0, 0, 0);
                }
#pragma unroll
                for (int qi = 0; qi < NQB; ++qi) sacc[qi][kb] = __builtin_amdgcn_mfma_f32_32x32x16_bf16(kone.v, qx[qi].v, sacc[qi][kb], 0, 0, 0);
            }
#pragma unroll
            for (int qi = 0; qi < NQB; ++qi) {
                float mx = -INFINITY;
#pragma unroll
                for (int kb = 0; kb < 2; ++kb)
#pragma unroll
                    for (int j = 0; j < 16; ++j) mx = fmaxf(mx, sacc[qi][kb][j]);
                mx = fmaxf(mx, other_half(mx, hh));
                if (kt == 0 || __ballot(mx > 60.0f)) {
                    const float mxr = kt == 0 ? mx : fmaxf(mx, 0.f);
                    const float fnew = bflo(pack_bf16(frm[qi] + mxr, 0.f));
                    const float delta = fnew - frm[qi]; frm[qi] = fnew;
                    const float alpha = kt == 0 ? 1.0f : __builtin_amdgcn_exp2f(-delta);
                    lrun[qi] *= alpha;
#pragma unroll
                    for (int i = 0; i < DVT / 32; ++i)
#pragma unroll
                        for (int j = 0; j < 16; ++j) oacc[qi][i][j] *= alpha;
#pragma unroll
                    for (int kb = 0; kb < 2; ++kb)
#pragma unroll
                        for (int j = 0; j < 16; ++j) sacc[qi][kb][j] -= delta;
                    qx[qi].u[0] = hh ? 0u : (pack_bf16(-fnew, 0.f) & 0xffffu);
                }
                float psum = 0.f;
#pragma unroll
                for (int kb = 0; kb < 2; ++kb)
#pragma unroll
                    for (int j = 0; j < 16; ++j) { const float p = __builtin_amdgcn_exp2f(sacc[qi][kb][j]); sacc[qi][kb][j] = p; psum += p; }
                lrun[qi] += psum;
            }
#pragma unroll
            for (int kb = 0; kb < 2; ++kb)
#pragma unroll
                for (int s2 = 0; s2 < 2; ++s2) {
                    union PF { bf16x8 v; unsigned u[4]; };
                    PF pf[NQB];
#pragma unroll
                    for (int qi = 0; qi < NQB; ++qi)
#pragma unroll
                        for (int j = 0; j < 4; ++j) pf[qi].u[j] = pack_bf16(sacc[qi][kb][8 * s2 + 2 * j], sacc[qi][kb][8 * s2 + 2 * j + 1]);
#pragma unroll
                    for (int i = 0; i < DVT / 32; ++i) {
                        const bf16* vp = Vc + (i * 32 + r) * VP + kb * 32 + 16 * s2 + 4 * hh;
                        union { bf16x8 v; bf16x4 h2[2]; } vf;
                        vf.h2[0] = *reinterpret_cast<const bf16x4*>(vp);
                        vf.h2[1] = *reinterpret_cast<const bf16x4*>(vp + 8);
#pragma unroll
                        for (int qi = 0; qi < NQB; ++qi) oacc[qi][i] = __builtin_amdgcn_mfma_f32_32x32x16_bf16(vf.v, pf[qi].v, oacc[qi][i], 0, 0, 0);
                    }
                }
            if (PREF) __syncthreads();
        }
#pragma unroll
        for (int qi = 0; qi < NQB; ++qi) {
            const float lsum = lrun[qi] + other_half(lrun[qi], hh);
            const float inv = 1.0f / lsum;
            bf16* op = A.o + (size_t)(b * A.SQ + q0 + 32 * qi + r) * A.o_stride + h * A.o_hstride + pass * DVT;
#pragma unroll
            for (int i = 0; i < DVT / 32; ++i) st_otile(op + i * 32, oacc[qi][i], inv, hh);
        }
    }
}
#endif

#undef ATT_FETCH
#undef ATT_STORE
#undef ATT_FK
#undef ATT_FV
#undef ATT_SK
#undef ATT_SV
#ifndef CPU_EMU
template <int DK, int DV, int DVT, int NQB>
DI int attn_nunit(const AttnDesc& A) { return BATCH * A.H * (A.SQ / (256 * NQB)) * (DV / DVT); }
template <int DK, int DV, int DVT, int NQB>
DI void attn_phase(const Frame& F, const AttnDesc& A) {
    const int nunit = attn_nunit<DK, DV, DVT, NQB>(A);
    for (int u = blockIdx.x; u < nunit; u += F.nblk) attn_unit<DK, DV, DVT, NQB>(F, A, u);
}
#endif
#ifndef CPU_EMU
DI void memattn_unit(const Frame& F, const AttnDesc& A, int u) {
    constexpr int KP = 256 + 8;
    bf16* Ks = (bf16*)F.smem;
    const int tid = fresh_tid(F), wave = F.wv, lane = tid & 63, r = lane & 31, hh = lane >> 5;
    const float sl2 = A.scale * 1.4426950408889634f;
    const int nqb = A.SQ / 256;
    int t = u; const int qb = t % nqb; t /= nqb; const int h = t & 3; const int b = t >> 2;
    const int q0 = qb * 256 + wave * 32;
    const bf16* kg = A.k + (size_t)(b * A.SK) * A.k_stride + h * A.k_hstride + (size_t)(tid >> 5) * A.k_stride + (tid & 31) * 8;
    const bf16* vg = A.vt + (size_t)(b * A.HKV + h) * 256 * 256 + (size_t)tid * 8;
    bf16* sdst = Ks + (tid >> 5) * KP + (tid & 31) * 8;
#define MA_LK(n_, hf_, i_) const uint4 n_##i_ = *reinterpret_cast<const uint4*>(kg + (size_t)((hf_) * 128 + 16 * i_) * A.k_stride)
#define MA_LV(n_, hf_, i_) const uint4 n_##i_ = *reinterpret_cast<const uint4*>(vg + (size_t)((hf_) * 128 + 16 * i_) * 256)
#define MA_ST(n_, hf_, i_) *reinterpret_cast<uint4*>(sdst + ((hf_) * 128 + 16 * i_) * KP) = n_##i_
#define MA_8(M_, n_, hf_) M_(n_, hf_, 0); M_(n_, hf_, 1); M_(n_, hf_, 2); M_(n_, hf_, 3); M_(n_, hf_, 4); M_(n_, hf_, 5); M_(n_, hf_, 6); M_(n_, hf_, 7)
    bf16x8 qf[16];
    { const bf16* qp = A.q + (size_t)(b * A.SQ + q0 + r) * A.q_stride + h * A.q_hstride + 8 * hh;
#pragma unroll
      for (int ks = 0; ks < 16; ++ks) qf[ks] = *reinterpret_cast<const bf16x8*>(qp + 16 * ks); }
    MA_8(MA_LK, ka, 0);
    MA_8(MA_ST, ka, 0);
    MA_8(MA_LK, kb, 1);
    __syncthreads();
    MA_8(MA_LV, va, 0);
    f32x16 sacc[8];
#define MA_SC(t8_) do { _Pragma("unroll") for (int j = 0; j < 16; ++j) sacc[t8_][j] = 0.f; \
        _Pragma("unroll") for (int ks = 0; ks < 16; ++ks) { \
            const bf16x8 kf = *reinterpret_cast<const bf16x8*>(Ks + ((t8_) * 32 + r) * KP + 16 * ks + 8 * hh); \
            sacc[t8_] = __builtin_amdgcn_mfma_f32_32x32x16_bf16(kf, qf[ks], sacc[t8_], 0, 0, 0); } \
        asm volatile("" ::: "memory"); } while (0)
    MA_SC(0); MA_SC(1); MA_SC(2); MA_SC(3);
    MA_8(MA_ST, kb, 1);
    __syncthreads();
    MA_8(MA_ST, va, 0);
    MA_SC(4); MA_SC(5); MA_SC(6); MA_SC(7);
#undef MA_SC
    float mx = -INFINITY;
#pragma unroll
    for (int t8 = 0; t8 < 8; ++t8)
#pragma unroll
        for (int j = 0; j < 16; ++j) mx = fmaxf(mx, sacc[t8][j]);
    mx = fmaxf(mx, other_half(mx, hh));
    const float mref = mx * sl2;
    float psum = 0.f;
    union PF { bf16x8 v; unsigned u[4]; };
    PF pf[8][2];
#pragma unroll
    for (int t8 = 0; t8 < 8; ++t8) {
#pragma unroll
        for (int j = 0; j < 16; ++j) { const float p = __builtin_amdgcn_exp2f(sacc[t8][j] * sl2 - mref); sacc[t8][j] = p; psum += p; }
#pragma unroll
        for (int s2 = 0; s2 < 2; ++s2)
#pragma unroll
            for (int j = 0; j < 4; ++j) pf[t8][s2].u[j] = pack_bf16(sacc[t8][8 * s2 + 2 * j], sacc[t8][8 * s2 + 2 * j + 1]);
    }
    const float inv = 1.0f / (psum + other_half(psum, hh));
    MA_8(MA_LV, vb, 1);
    __syncthreads();
    bf16* op = A.o + (size_t)(b * A.SQ + q0 + r) * A.o_stride + h * A.o_hstride;
#define MA_OT(i_) do { f32x16 o; _Pragma("unroll") for (int j = 0; j < 16; ++j) o[j] = 0.f; \
        _Pragma("unroll") for (int t8 = 0; t8 < 8; ++t8) _Pragma("unroll") for (int s2 = 0; s2 < 2; ++s2) { \
            const bf16* vp = Ks + ((i_) * 32 + r) * KP + t8 * 32 + 16 * s2 + 4 * hh; \
            union { bf16x8 v; bf16x4 h2[2]; } vf; vf.h2[0] = *reinterpret_cast<const bf16x4*>(vp); vf.h2[1] = *reinterpret_cast<const bf16x4*>(vp + 8); \
            o = __builtin_amdgcn_mfma_f32_32x32x16_bf16(vf.v, pf[t8][s2].v, o, 0, 0, 0); } \
        st_otile(op + (i_) * 32, o, inv, hh); \
        asm volatile("" ::: "memory"); } while (0)
    MA_OT(0); MA_OT(1); MA_OT(2); MA_OT(3);
    MA_8(MA_ST, vb, 1);
    __syncthreads();
    MA_OT(4); MA_OT(5); MA_OT(6); MA_OT(7);
#undef MA_OT
#undef MA_8
#undef MA_ST
#undef MA_LV
#undef MA_LK
}
DI void memattn_phase(const Frame& F, const AttnDesc& A) {
    const int nunit = BATCH * 4 * (A.SQ / 256);
    for (int u = blockIdx.x; u < nunit; u += F.nblk) memattn_unit(F, A, u);
}
#endif
DI AttnDesc desc_gqa(const Frame& F) {
    AttnDesc A; A.q = WSP(bf16, OFF_HATT); A.q_stride = 512; A.q_hstride = 64;
    A.k = WSP(bf16, OFF_HATT) + 256; A.k_stride = 512; A.k_hstride = 64; A.k2 = nullptr; A.k2_stride = 0; A.dk_main = 64;
    A.vt = WSP(bf16, OFF_VTATT); A.o = WSP(bf16, OFF_YCAT); A.o_stride = 1024; A.o_hstride = 64;
    A.H = 4; A.HKV = 2; A.SQ = SEQ; A.SK = SEQ; A.scale = 0.125f; return A;
}
DI AttnDesc desc_mla(const Frame& F) {
    AttnDesc A; A.q = WSP(bf16, OFF_QMLA); A.q_stride = 384; A.q_hstride = 96;
    A.k = WSP(bf16, OFF_KNOPE); A.k_stride = 256; A.k_hstride = 64; A.k2 = WSP(bf16, OFF_KROPE); A.k2_stride = 32; A.dk_main = 64;
    A.vt = WSP(bf16, OFF_VTMLA); A.o = WSP(bf16, OFF_YCAT) + 768; A.o_stride = 1024; A.o_hstride = 64;
    A.H = 4; A.HKV = 4; A.SQ = SEQ; A.SK = SEQ; A.scale = 0.10206207261596575f; return A;
}
DI AttnDesc desc_mem(const Frame& F) {
    AttnDesc A; A.q = WSP(bf16, OFF_QMEM); A.q_stride = 1024; A.q_hstride = 256;
    A.k = WSP(bf16, OFF_KMEM); A.k_stride = 1024; A.k_hstride = 256; A.k2 = nullptr; A.k2_stride = 0; A.dk_main = 256;
    A.vt = WSP(bf16, OFF_VTMEM); A.o = WSP(bf16, OFF_OMEM); A.o_stride = 1024; A.o_hstride = 256;
    A.H = 4; A.HKV = 4; A.SQ = SEQ; A.SK = MEMT; A.scale = 0.0625f; return A;
}

#ifndef CPU_EMU
typedef float f32p __attribute__((ext_vector_type(2)));
DI f32p allsum16p(f32p x) { x.x = allsum16(x.x); x.y = allsum16(x.y); return x; }
template <int KIND>
DI void scan_chain(const Frame& F, int chain) {
    constexpr int T = 32;
    constexpr int NARR = KIND == 0 ? 6 : 3;
    constexpr int STEPB = NARR * 256;
    constexpr int NPIECE = T * NARR * 8;
    constexpr int PPT = (NPIECE + NTH - 1) / NTH;
    const int d = chain / (BATCH * 4), b = (chain / 4) % BATCH, h = chain % 4;
    const int tid = F.tid, wave = tid >> 6, lane = tid & 63, rg = lane >> 4, cg = lane & 15;
    unsigned char* buf0 = F.smem; unsigned char* buf1 = F.smem + T * STEPB;
    unsigned char* ybuf = F.smem + 2 * T * STEPB;
    const size_t AS = (size_t)NTOK * 256;
    bf16* r7 = WSP(bf16, OFF_R7); bf16* hh = WSP(bf16, OFF_HHGRN);
#define PIECE_PTR(t0, p_) ([&]() -> const uint4* { const int pc = (p_) < NPIECE ? (p_) : NPIECE - 1; \
        const int st = pc / (NARR * 8), rem = pc % (NARR * 8), arr = rem >> 3, part = rem & 7; \
        const int tt = (t0) + st, ss = d ? SEQ - 1 - tt : tt; const size_t nn = (size_t)b * SEQ + ss; \
        const bf16* base; \
        if (KIND == 0) { const int aid = arr == 0 ? R_KK : arr == 1 ? (d ? R_W1 : R_W0) : arr == 2 ? (d ? R_AK1 : R_AK0) : arr == 3 ? (d ? R_KD1 : R_KD0) : arr == 4 ? R_R : R_V; \
            base = r7 + aid * AS + nn * 256 + h * 64; } \
        else { const int off = arr == 0 ? 256 + d * 256 : arr == 1 ? 0 : 768; base = hh + nn * 1280 + off + h * 64; } \
        return reinterpret_cast<const uint4*>(base + part * 8); }())
#define PUT_PIECE(dst, p_, v_) do { float4 a_, b_; a_.x = bflo((v_).x); a_.y = bfhi((v_).x); a_.z = bflo((v_).y); a_.w = bfhi((v_).y); \
        b_.x = bflo((v_).z); b_.y = bfhi((v_).z); b_.z = bflo((v_).w); b_.w = bfhi((v_).w); \
        *reinterpret_cast<float4*>((dst) + (p_) * 32) = a_; *reinterpret_cast<float4*>((dst) + (p_) * 32 + 16) = b_; } while (0)
#define STORE_PRE(dst) do { PUT_PIECE(dst, tid, pre0); \
        if (tid + NTH < NPIECE) PUT_PIECE(dst, tid + NTH, pre1); \
        if (PPT > 2 && tid + 2 * NTH < NPIECE) PUT_PIECE(dst, tid + 2 * NTH, pre2); } while (0)
    uint4 pre0, pre1, pre2;
    pre0 = *PIECE_PTR(0, tid); pre1 = *PIECE_PTR(0, tid + NTH); pre2 = pre1;
    if (PPT > 2) pre2 = *PIECE_PTR(0, tid + 2 * NTH);
    __syncthreads();
    STORE_PRE(buf0);
    __syncthreads();
    f32p P[4];
#pragma unroll
    for (int c = 0; c < 4; ++c) P[c] = (f32p){0.f, 0.f};
    const int vofs = (wave * 8 + rg * 2) * 4;
    for (int ch = 0; ch < SEQ / T; ++ch) {
        const unsigned char* cur = (ch & 1) ? buf1 : buf0;
        if (ch + 1 < SEQ / T) {
            pre0 = *PIECE_PTR((ch + 1) * T, tid); pre1 = *PIECE_PTR((ch + 1) * T, tid + NTH);
            if (PPT > 2) pre2 = *PIECE_PTR((ch + 1) * T, tid + 2 * NTH);
        }
        float4 o0, o1, o2, o3, o4; f32p ov;
        { const unsigned char* sb = cur;
          o0 = *reinterpret_cast<const float4*>(sb + 0 * 256 + cg * 16); o1 = *reinterpret_cast<const float4*>(sb + 1 * 256 + cg * 16);
          if (KIND == 0) { o2 = *reinterpret_cast<const float4*>(sb + 2 * 256 + cg * 16); o3 = *reinterpret_cast<const float4*>(sb + 3 * 256 + cg * 16); o4 = *reinterpret_cast<const float4*>(sb + 4 * 256 + cg * 16); }
          ov = *reinterpret_cast<const f32p*>(sb + (NARR - 1) * 256 + vofs); }
        unsigned ykeep = 0u;
#pragma unroll 2
        for (int t = 0; t < T; ++t) {
            const float4 c0 = o0, c1 = o1, c2 = o2, c3 = o3, c4 = o4; const f32p v = ov;
            { const unsigned char* sb = cur + ((t + 1) & (T - 1)) * STEPB;
              o0 = *reinterpret_cast<const float4*>(sb + 0 * 256 + cg * 16); o1 = *reinterpret_cast<const float4*>(sb + 1 * 256 + cg * 16);
              if (KIND == 0) { o2 = *reinterpret_cast<const float4*>(sb + 2 * 256 + cg * 16); o3 = *reinterpret_cast<const float4*>(sb + 3 * 256 + cg * 16); o4 = *reinterpret_cast<const float4*>(sb + 4 * 256 + cg * 16); }
              ov = *reinterpret_cast<const f32p*>(sb + (NARR - 1) * 256 + vofs); }
            f32p y;
            if (KIND == 0) {
                f32p sa = P[0] * c0.x + P[1] * c0.y + P[2] * c0.z + P[3] * c0.w;
                sa = allsum16p(sa);
                P[0] = P[0] * c1.x - sa * c2.x + v * c3.x;
                P[1] = P[1] * c1.y - sa * c2.y + v * c3.y;
                P[2] = P[2] * c1.z - sa * c2.z + v * c3.z;
                P[3] = P[3] * c1.w - sa * c2.w + v * c3.w;
                y = P[0] * c4.x + P[1] * c4.y + P[2] * c4.z + P[3] * c4.w;
            } else {
                P[0] += (v - P[0]) * c0.x; P[1] += (v - P[1]) * c0.y; P[2] += (v - P[2]) * c0.z; P[3] += (v - P[3]) * c0.w;
                y = P[0] * c1.x + P[1] * c1.y + P[2] * c1.z + P[3] * c1.w;
            }
            y = allsum16p(y);
            const unsigned yp = pack_bf16(y.x, y.y);
            ykeep = ((t & 15) == cg) ? yp : ykeep;
            if ((t & 15) == 15) *reinterpret_cast<unsigned*>(ybuf + ((t & ~15) + cg) * 128 + (wave * 8 + rg * 2) * 2) = ykeep;
        }
        asm volatile("s_waitcnt lgkmcnt(0)" ::: "memory");
        __builtin_amdgcn_wave_barrier();
        if (lane < T) {
            const int t = ch * T + lane, s = d ? SEQ - 1 - t : t; const size_t n = (size_t)b * SEQ + s;
            const uint4 yv = *reinterpret_cast<const uint4*>(ybuf + lane * 128 + wave * 16);
            bf16* dst = KIND == 0 ? r7 + (d ? R_W1 : R_W0) * AS + n * 256 + h * 64 + wave * 8 : hh + n * 1280 + 256 + d * 256 + h * 64 + wave * 8;
            *reinterpret_cast<uint4*>(dst) = yv;
        }
        if (ch + 1 < SEQ / T) {
            unsigned char* nxt = (ch & 1) ? buf0 : buf1;
            STORE_PRE(nxt);
        }
        __syncthreads();
    }
#undef PIECE_PTR
#undef STORE_PRE
#undef PUT_PIECE
}
DI void phase_scans(const Frame& F, int l) {
    const int nchain = 2 * BATCH * 4;
    const bool sub = (nchain / 2 <= F.nblk);
    const bool xl = sub && (nchain / 2) % 8 == 0 && (F.nblk & 7) == 0 && BATCH % 8 == 0 && (nchain / 2) / 8 * 2 == (BATCH / 8) * 8;
    for (int g = blockIdx.x; g < nchain / 2; g += F.nblk) {
        int c0 = g * 2 + (F.wv & 1);
        if (xl) { const int cl = (g >> 3) * 2 + (F.wv & 1), bb = (g & 7) * (BATCH / 8) + (cl >> 3); c0 = ((cl >> 2) & 1) * (BATCH * 4) + bb * 4 + (cl & 3); }
        if (F.wv < 2) scan_rwkv_chunk(F, c0); else if (F.wv < 4) scan_hgrn_chunk(F, c0);
        else if (sub) phase_cvt_moe(F, l, (nchain / 2) * 4, g * 4 + F.wv - 4, 2);
    }
    if (!sub) phase_cvt_moe(F, l, 0, 0, 2);
}
#else
DI void phase_scans(const Frame& F) {
    bf16* r7 = WSP(bf16, OFF_R7); const size_t AS = (size_t)NTOK * 256;
    bf16* hh = WSP(bf16, OFF_HHGRN);
    const int nitem = 2 * BATCH * 4 * 64 * 2;
    for (int it = wave_item_index(F); it < nitem; it += gthreads(F)) {
        const int kind = it / (2 * BATCH * 4 * 64);
        int c = (it % (2 * BATCH * 4 * 64)) / 64; const int i = it % 64;
        const int d = c / (BATCH * 4); c %= BATCH * 4; const int b = c / 4, h = c % 4;
        float S[64];
#pragma unroll
        for (int j = 0; j < 64; ++j) S[j] = 0.f;
        if (kind == 0) {
            const bf16* pr = r7 + R_R * AS, *pv = r7 + R_V * AS, *pkk = r7 + R_KK * AS;
            bf16* pw = r7 + (d ? R_W1 : R_W0) * AS; const bf16* pkd = r7 + (d ? R_KD1 : R_KD0) * AS, *pak = r7 + (d ? R_AK1 : R_AK0) * AS;
            for (int t = 0; t < SEQ; ++t) {
                const int s = d ? SEQ - 1 - t : t;
                const size_t o = ((size_t)(b * SEQ + s)) * 256 + h * 64;
                const float v = bf2f(pv[o + i]);
                float sa = 0.f;
#pragma unroll
                for (int j = 0; j < 64; ++j) sa += S[j] * bf2f(pkk[o + j]);
                float y = 0.f;
#pragma unroll
                for (int j = 0; j < 64; ++j) {
                    S[j] = S[j] * bf2f(pw[o + j]) - sa * bf2f(pak[o + j]) + v * bf2f(pkd[o + j]);
                    y += S[j] * bf2f(pr[o + j]);
                }
#ifndef CPU_EMU
                __builtin_amdgcn_wave_barrier();
#endif
#ifdef CPU_EMU
                WSP(bf16, OFF_EMU_SCAN)[(size_t)d * AS + (size_t)(b * SEQ + s) * 256 + h * 64 + i] = f2bf(y);
#else
                pw[o + i] = f2bf(y);
#endif
            }
        } else {
            const bf16* pq = hh; bf16* pk = hh + 256 + d * 256; const bf16* pi = hh + 768;
            for (int t = 0; t < SEQ; ++t) {
                const int s = d ? SEQ - 1 - t : t;
                const size_t o = ((size_t)(b * SEQ + s)) * 1280 + h * 64;
                const float v = bf2f(pi[o + i]);
                float acc = 0.f;
#pragma unroll
                for (int j = 0; j < 64; ++j) {
                    const float k = bf2f(pk[o + j]);
                    S[j] = S[j] + k * (v - S[j]);
                    acc += S[j] * bf2f(pq[o + j]);
                }
#ifndef CPU_EMU
                __builtin_amdgcn_wave_barrier();
#endif
#ifdef CPU_EMU
                WSP(bf16, OFF_EMU_SCAN)[(size_t)(2 + d) * AS + (size_t)(b * SEQ + s) * 256 + h * 64 + i] = f2bf(acc);
#else
                pk[o + i] = f2bf(acc);
#endif
            }
        }
    }
}

#endif

#ifndef CPU_EMU
DI void phase_fin_gpu(const Frame& F, int l) {
    const bf16* r7 = WSP(bf16, OFF_R7); const size_t AS = (size_t)NTOK * 256;
    const bf16* gb = WSP(bf16, OFF_G); const float* bonus = WSP(float, OFF_BONUS);
    const bf16* hh = WSP(bf16, OFF_HHGRN); bf16* ycat = WSP(bf16, OFF_YCAT);
    float* par = (float*)F.smem;
    __syncthreads();
    for (int i = F.tid; i < 768; i += NTH) par[i] = i < 256 ? F.in[17][l * 256 + i] : i < 512 ? F.in[18][l * 256 + i - 256] : F.in[20][l * 256 + i - 512];
    __syncthreads();
    {
        for (int ib = blockIdx.x; ib < (NTOK / 16) * 4 / 8; ib += F.nblk) {
            const int item = xcd_unit(ib, F.nblk, (NTOK / 16) * 4 / 8) * 8 + F.wv;
            const int lane = fresh_tid(F) & 63, x = lane & 15, q = lane >> 4;
            float* wz = (float*)(F.smem + 4096) + F.wv * (16 * 68);
            const int h = item & 3; const size_t n0 = (size_t)(item >> 2) * 16, blk = (size_t)item * 1024;
            const bf16* y0 = r7 + C_KT0 * AS + blk; const bf16* y1 = r7 + C_KT1 * AS + blk; const bf16* vt = r7 + C_VT * AS + blk;
            float y[4][4], v[4][4];
#pragma unroll
            for (int u = 0; u < 4; ++u) {
                const uint2 a = *reinterpret_cast<const uint2*>(y0 + (u * 64 + lane) * 4), b = *reinterpret_cast<const uint2*>(y1 + (u * 64 + lane) * 4), c = *reinterpret_cast<const uint2*>(vt + (u * 64 + lane) * 4);
                y[u][0] = bflo(a.x) + bflo(b.x); y[u][1] = bfhi(a.x) + bfhi(b.x); y[u][2] = bflo(a.y) + bflo(b.y); y[u][3] = bfhi(a.y) + bfhi(b.y);
                v[u][0] = bflo(c.x); v[u][1] = bfhi(c.x); v[u][2] = bflo(c.y); v[u][3] = bfhi(c.y);
            }
#pragma unroll
            for (int r = 0; r < 4; ++r) {
                const size_t n = n0 + 4 * q + r;
                const float mu = allsum16((y[0][r] + y[1][r]) + (y[2][r] + y[3][r])) * (1.0f / 64.0f);
                const float d0 = y[0][r] - mu, d1 = y[1][r] - mu, d2 = y[2][r] - mu, d3 = y[3][r] - mu;
                const float rs = 1.0f / sqrtf(allsum16((d0 * d0 + d1 * d1) + (d2 * d2 + d3 * d3)) * (1.0f / 64.0f) + GN_EPS);
                const float bo = bonus[n * 4 + h];
                const float dv[4] = {d0, d1, d2, d3};
#pragma unroll
                for (int u = 0; u < 4; ++u) {
                    const int c = h * 64 + 16 * u + x;
                    wz[(4 * q + r) * 68 + 16 * u + x] = dv[u] * rs * par[c] + par[256 + c] + bo * v[u][r];
                }
            }
            asm volatile("s_waitcnt lgkmcnt(0)" ::: "memory");
            __builtin_amdgcn_wave_barrier();
            {
                const int t = lane >> 2, part = lane & 3;
                const size_t n = n0 + t;
                const float* zr = wz + t * 68 + part * 16;
                const uint4 ga = *reinterpret_cast<const uint4*>(gb + n * 256 + h * 64 + part * 16), gc = *reinterpret_cast<const uint4*>(gb + n * 256 + h * 64 + part * 16 + 8);
                const float4 z0 = *reinterpret_cast<const float4*>(zr), z1 = *reinterpret_cast<const float4*>(zr + 4), z2 = *reinterpret_cast<const float4*>(zr + 8), z3 = *reinterpret_cast<const float4*>(zr + 12);
                bf16* po = ycat + n * 1024 + 256 + h * 64 + part * 16;
                *reinterpret_cast<uint4*>(po) = make_uint4(pack_bf16(z0.x * bflo(ga.x), z0.y * bfhi(ga.x)), pack_bf16(z0.z * bflo(ga.y), z0.w * bfhi(ga.y)),
                                                           pack_bf16(z1.x * bflo(ga.z), z1.y * bfhi(ga.z)), pack_bf16(z1.z * bflo(ga.w), z1.w * bfhi(ga.w)));
                *reinterpret_cast<uint4*>(po + 8) = make_uint4(pack_bf16(z2.x * bflo(gc.x), z2.y * bfhi(gc.x)), pack_bf16(z2.z * bflo(gc.y), z2.w * bfhi(gc.y)),
                                                               pack_bf16(z3.x * bflo(gc.z), z3.y * bfhi(gc.z)), pack_bf16(z3.z * bflo(gc.w), z3.w * bfhi(gc.w)));
            }
            asm volatile("s_waitcnt lgkmcnt(0)" ::: "memory");
            __builtin_amdgcn_wave_barrier();
        }
    }
    for (int ub = blockIdx.x; ub < NTOK * 32 / NTH; ub += F.nblk) {
        const int it = xcd_unit(ub, F.nblk, NTOK * 32 / NTH) * NTH + fresh_tid(F);
        const int n = it >> 5, hi = it & 31;
        const bf16* row = hh + (size_t)n * 1280 + hi * 8;
        const uint4 a = *reinterpret_cast<const uint4*>(row + 256), b = *reinterpret_cast<const uint4*>(row + 512), g4 = *reinterpret_cast<const uint4*>(row + 1024);
        const float yv[8] = {bflo(a.x) + bflo(b.x), bfhi(a.x) + bfhi(b.x), bflo(a.y) + bflo(b.y), bfhi(a.y) + bfhi(b.y), bflo(a.z) + bflo(b.z), bfhi(a.z) + bfhi(b.z), bflo(a.w) + bflo(b.w), bfhi(a.w) + bfhi(b.w)};
        float s2 = (yv[0] * yv[0] + yv[1] * yv[1]) + (yv[2] * yv[2] + yv[3] * yv[3]) + (yv[4] * yv[4] + yv[5] * yv[5]) + (yv[6] * yv[6] + yv[7] * yv[7]);
        s2 += dppf<0xB1>(s2); s2 += dppf<0x4E>(s2); s2 += dppf<0x141>(s2);
        const float rs = 1.0f / sqrtf(s2 * (1.0f / 64.0f) + RMS_EPS);
        const float* gg = par + 512 + hi * 8;
        const float gf[8] = {bflo(g4.x), bfhi(g4.x), bflo(g4.y), bfhi(g4.y), bflo(g4.z), bfhi(g4.z), bflo(g4.w), bfhi(g4.w)};
        float o[8];
#pragma unroll
        for (int j = 0; j < 8; ++j) o[j] = yv[j] * rs * gg[j] * (gf[j] * fast_sigmoid(gf[j]));
        *reinterpret_cast<uint4*>(ycat + (size_t)n * 1024 + 512 + hi * 8) = make_uint4(pack_bf16(o[0], o[1]), pack_bf16(o[2], o[3]), pack_bf16(o[4], o[5]), pack_bf16(o[6], o[7]));
    }
}
#endif
DI void phase_fin(const Frame& F, int l) {
    const bf16* r7 = WSP(bf16, OFF_R7); const size_t AS = (size_t)NTOK * 256;
    const bf16* gb = WSP(bf16, OFF_G); const float* bonus = WSP(float, OFF_BONUS);
    const bf16* hh = WSP(bf16, OFF_HHGRN); bf16* ycat = WSP(bf16, OFF_YCAT);
    const float* gng = F.in[17] + l * 256; const float* gnb = F.in[18] + l * 256; const float* hng = F.in[20] + l * 256;
    for (int it = ggrp(F); it < NTOK * 8; it += ngrp(F)) {
        const int n = it >> 3, kind = (it >> 2) & 1, h = it & 3;
        float v[PER64];
        if (kind == 0) {
            float s1 = 0.f;
            for (int i = 0; i < PER64; ++i) { const int c = h * 64 + glane(F) + i * GRP; const size_t o = (size_t)n * 256 + c;
#ifdef CPU_EMU
                v[i] = bf2f(WSP(bf16, OFF_EMU_SCAN)[o]) + bf2f(WSP(bf16, OFF_EMU_SCAN)[AS + o]); s1 += v[i]; }
#else
                v[i] = bf2f(r7[R_W0 * AS + o]) + bf2f(r7[R_W1 * AS + o]); s1 += v[i]; }
#endif
            s1 = grp_sum(F, s1); const float mu = s1 * (1.0f / 64.0f);
            float s2 = 0.f; for (int i = 0; i < PER64; ++i) { const float dd = v[i] - mu; s2 += dd * dd; }
            s2 = grp_sum(F, s2); const float rs = 1.0f / sqrtf(s2 * (1.0f / 64.0f) + GN_EPS);
            const float bo = bonus[(size_t)n * 4 + h];
            for (int i = 0; i < PER64; ++i) { const int c = h * 64 + glane(F) + i * GRP; const size_t o = (size_t)n * 256 + c;
                const float y = (v[i] - mu) * rs * gng[c] + gnb[c];
                ycat[(size_t)n * 1024 + 256 + c] = f2bf((y + bo * bf2f(r7[R_V * AS + o])) * bf2f(gb[o])); }
        } else {
            float s2 = 0.f;
            for (int i = 0; i < PER64; ++i) { const int c = h * 64 + glane(F) + i * GRP; const size_t o = (size_t)n * 1280 + c;
#ifdef CPU_EMU
                const size_t oe = (size_t)n * 256 + c;
                v[i] = bf2f(WSP(bf16, OFF_EMU_SCAN)[2 * AS + oe]) + bf2f(WSP(bf16, OFF_EMU_SCAN)[3 * AS + oe]); s2 += v[i] * v[i]; }
#else
                v[i] = bf2f(hh[o + 256]) + bf2f(hh[o + 512]); s2 += v[i] * v[i]; }
#endif
            s2 = grp_sum(F, s2); const float rs = 1.0f / sqrtf(s2 * (1.0f / 64.0f) + RMS_EPS);
            for (int i = 0; i < PER64; ++i) { const int c = h * 64 + glane(F) + i * GRP; const size_t o = (size_t)n * 1280 + c;
                ycat[(size_t)n * 1024 + 512 + c] = f2bf(v[i] * rs * hng[c] * siluf_(bf2f(hh[o + 1024]))); }
        }
    }
}

struct EpiResid {
    float* xf; int row0, pn;
    DI void operator()(int r, int c, float a, float b, float cc, float d) const {
        float* p = xf + (size_t)(row0 + r) * DM + pn * 256 + c;
#ifndef CPU_EMU
        float4 x = *reinterpret_cast<float4*>(p);
        x.x = DN_ALPHA * x.x + a; x.y = DN_ALPHA * x.y + b; x.z = DN_ALPHA * x.z + cc; x.w = DN_ALPHA * x.w + d;
        *reinterpret_cast<float4*>(p) = x;
#else
        p[0] = DN_ALPHA * p[0] + a; p[1] = DN_ALPHA * p[1] + b; p[2] = DN_ALPHA * p[2] + cc; p[3] = DN_ALPHA * p[3] + d;
#endif
    }
};
#ifndef CPU_EMU
struct EpiResidFB {
    const float* xf; bf16* xb; int row0, pn;
    DI void operator()(int r, int c, float a, float b, float cc, float d) const {
        const size_t o = (size_t)(row0 + r) * DM + pn * 256 + c;
        const float4 x = *reinterpret_cast<const float4*>(xf + o);
        *reinterpret_cast<uint2*>(xb + o) = make_uint2(pack_bf16(DN_ALPHA * x.x + a, DN_ALPHA * x.y + b), pack_bf16(DN_ALPHA * x.z + cc, DN_ALPHA * x.w + d));
    }
    DI void wide(int r, int c, const f32x4& u, const f32x4& v) const {
        const size_t o = (size_t)(row0 + r) * DM + pn * 256 + c;
        const float4 x = *reinterpret_cast<const float4*>(xf + o), y = *reinterpret_cast<const float4*>(xf + o + 4);
        *reinterpret_cast<uint4*>(xb + o) = make_uint4(pack_bf16(DN_ALPHA * x.x + u[0], DN_ALPHA * x.y + u[1]), pack_bf16(DN_ALPHA * x.z + u[2], DN_ALPHA * x.w + u[3]),
                                                       pack_bf16(DN_ALPHA * y.x + v[0], DN_ALPHA * y.y + v[1]), pack_bf16(DN_ALPHA * y.z + v[2], DN_ALPHA * y.w + v[3]));
    }
};
struct EpiResidBB {
    bf16* xb; int row0, pn;
    DI void operator()(int r, int c, float a, float b, float cc, float d) const {
        const size_t o = (size_t)(row0 + r) * DM + pn * 256 + c;
        const uint2 x = *reinterpret_cast<const uint2*>(xb + o);
        *reinterpret_cast<uint2*>(xb + o) = make_uint2(pack_bf16(DN_ALPHA * bflo(x.x) + a, DN_ALPHA * bfhi(x.x) + b), pack_bf16(DN_ALPHA * bflo(x.y) + cc, DN_ALPHA * bfhi(x.y) + d));
    }
    DI void wide(int r, int c, const f32x4& u, const f32x4& v) const {
        const size_t o = (size_t)(row0 + r) * DM + pn * 256 + c;
        const uint4 x = *reinterpret_cast<const uint4*>(xb + o);
        *reinterpret_cast<uint4*>(xb + o) = make_uint4(pack_bf16(DN_ALPHA * bflo(x.x) + u[0], DN_ALPHA * bfhi(x.x) + u[1]), pack_bf16(DN_ALPHA * bflo(x.y) + u[2], DN_ALPHA * bfhi(x.y) + u[3]),
                                                       pack_bf16(DN_ALPHA * bflo(x.z) + v[0], DN_ALPHA * bfhi(x.z) + v[1]), pack_bf16(DN_ALPHA * bflo(x.w) + v[2], DN_ALPHA * bfhi(x.w) + v[3]));
    }
};
#endif
template <int MODE>
DI void phase_gemm_sq(const Frame& F, const bf16* A, size_t woff, bf16* outb) {
    const bf16* W = (const bf16*)((const char*)WSP(bf16, OFF_WTS) + woff);
    const int nM = (NTOK + 255) / 256;
    for (int u0 = blockIdx.x; u0 < nM * 4; u0 += F.nblk) {
#ifdef CPU_EMU
        const int u = u0;
#else
        const int u = xcd_unit(u0, F.nblk, nM * 4);
#endif
        const int pm = u >> 2, pn = u & 3;
#ifdef CPU_EMU
        const int mr = min(256, NTOK - pm * 256);
#endif
#ifndef CPU_EMU
        if (MODE == 0 || MODE == 2) { EpiResidBB E{WSP(bf16, OFF_XB), pm * 256, pn}; gemm_unit(F, A, 1024, nullptr, pm * 256, W, 1024, pn * 256, 1024, E MR); }
#else
        if (MODE == 0 || MODE == 2) { EpiResid E{F.xf, pm * 256, pn}; gemm_unit(F, A, 1024, nullptr, pm * 256, W, 1024, pn * 256, 1024, E MR); }
#endif
        else { EpiBf E{outb, 1024, pm * 256, pn}; gemm_unit(F, A, 1024, nullptr, pm * 256, W, 1024, pn * 256, 1024, E MR); }
    }
}

#ifndef CPU_EMU
DI void phase_q_memattn(const Frame& F) {
    const bf16* W = (const bf16*)((const char*)WSP(bf16, OFF_WTS) + W_Q_T);
    const AttnDesc A = desc_mem(F);
    const int nqb = A.SQ / 256;
    for (int u0 = blockIdx.x; u0 < (NTOK / 256) * 4; u0 += F.nblk) {
        const int u = xcd_unit(u0, F.nblk, (NTOK / 256) * 4);
        const int pm = u >> 2, h = u & 3;
        { EpiBf E{WSP(bf16, OFF_QMEM), 1024, pm * 256, h}; gemm_unit(F, WSP(bf16, OFF_XB), 1024, nullptr, pm * 256, W, 1024, h * 256, 1024, E); }
        asm volatile("s_waitcnt vmcnt(0)" ::: "memory");
        __syncthreads();
        memattn_unit(F, A, ((pm / nqb) * 4 + h) * nqb + (pm % nqb));
        __syncthreads();
    }
}
#endif
template <bool BLOCKED = false>
DI void phase_ln(const Frame& F, const float* g, const float* b) {
#ifdef CPU_EMU
    const float* xf = F.xf;
    layer_norm_rows(F, g, b, [&](int row, int c) { return xf[(size_t)row * DM + c]; }, false, nullptr);
#else
    ln_rows_gpu<0, BLOCKED, BLOCKED>(F, g, b, 0);
#endif
}

#ifndef CPU_EMU
DI void phase_route_gpu(const Frame& F, int l) {
    const bf16* xhi = WSP(bf16, OFF_XB); const bf16* xlo = (const bf16*)F.xf;
    const bf16* gt = (const bf16*)((const char*)WSP(bf16, OFF_WTS) + W_GATE_T) + (size_t)l * 2 * 48 * 1024;
    const float* bg = F.in[34] + l * 4; const float* be = F.in[36] + l * 32;
    int* counts = (int*)(F.ws + CTL_CNT) + l * 32;
    int* lists = WSP(int, OFF_LISTS); float* tinfo = WSP(float, OFF_TINFO);
    const int tid = F.tid, wave = tid >> 6, lane = tid & 63, rr = lane & 15, kq = lane >> 4;
    float* lg = (float*)F.smem + wave * (16 * 48);
    const bool blk_ok = (NTOK % (F.nblk * 32) == 0);
    const int rpb = NTOK / F.nblk;
    int* hcnt = (int*)(F.smem + 32768); int* hbase = hcnt + 32;
    __syncthreads();
    const int rt_first = blk_ok ? 0 : blockIdx.x * 8, rt_lim = blk_ok ? rpb / 16 : NTOK / 16, rt_step = blk_ok ? 8 : F.nblk * 8;
    for (int rtb = rt_first; rtb < rt_lim; rtb += rt_step) {
        const int rt = rtb + wave; const bool live = rt < rt_lim;
        { const uint4* src = reinterpret_cast<const uint4*>(gt); uint4* dst = reinterpret_cast<uint4*>(F.smem);
          for (int i = tid; i < 9216; i += NTH) dst[i] = src[i]; }
        __syncthreads();
        int ea = 0, eb = 0, pa = 0, pb = 0, row = 0; float g0 = 0.f, g1 = 0.f;
        const int bx = (F.nblk & 7) ? (int)blockIdx.x : (int)(blockIdx.x & 7) * (F.nblk >> 3) + (int)(blockIdx.x >> 3);
        const int r0 = blk_ok ? bx * rpb + rt * 16 : rt * 16;
        f32x4 acc0 = {0.f, 0.f, 0.f, 0.f}, acc1 = acc0, acc2 = acc0;
        if (live) {
        const bf16* xa = xhi + (size_t)(r0 + rr) * DM + 8 * kq; const bf16* xl = xlo + (size_t)(r0 + rr) * DM + 8 * kq;
        const bf16x8* tb = reinterpret_cast<const bf16x8*>(F.smem) + lane;
        const bf16x8* tt = reinterpret_cast<const bf16x8*>(F.smem) + 8192 + kq * 4 + (rr & 3);
        const bf16x8 zz = {0, 0, 0, 0, 0, 0, 0, 0};
        bf16x8 ah[2], al[2], ch[2], cl[2];
#define RT_LOAD(AH, AL, kb_) do { _Pragma("unroll") for (int u = 0; u < 2; ++u) { const int k0 = (kb_) + 32 * u; \
            AH[u] = *reinterpret_cast<const bf16x8*>(xa + k0); AL[u] = *reinterpret_cast<const bf16x8*>(xl + k0); } } while (0)
#define RT_MMA(AH, AL, kb_) do { _Pragma("unroll") for (int u = 0; u < 2; ++u) { const int k32 = ((kb_) >> 5) + u; \
            const bf16x8 H0 = tb[(k32 * 4 + 0) * 64], H1 = tb[(k32 * 4 + 1) * 64], L0 = tb[(k32 * 4 + 2) * 64], L1 = tb[(k32 * 4 + 3) * 64]; \
            const bf16x8 H2r = tt[(k32 * 2 + 0) * 16], L2r = tt[(k32 * 2 + 1) * 16]; const bf16x8 H2 = rr < 4 ? H2r : zz, L2 = rr < 4 ? L2r : zz; \
            acc0 = __builtin_amdgcn_mfma_f32_16x16x32_bf16(AH[u], H0, acc0, 0, 0, 0); acc1 = __builtin_amdgcn_mfma_f32_16x16x32_bf16(AH[u], H1, acc1, 0, 0, 0); acc2 = __builtin_amdgcn_mfma_f32_16x16x32_bf16(AH[u], H2, acc2, 0, 0, 0); \
            acc0 = __builtin_amdgcn_mfma_f32_16x16x32_bf16(AH[u], L0, acc0, 0, 0, 0); acc1 = __builtin_amdgcn_mfma_f32_16x16x32_bf16(AH[u], L1, acc1, 0, 0, 0); acc2 = __builtin_amdgcn_mfma_f32_16x16x32_bf16(AH[u], L2, acc2, 0, 0, 0); \
            acc0 = __builtin_amdgcn_mfma_f32_16x16x32_bf16(AL[u], H0, acc0, 0, 0, 0); acc1 = __builtin_amdgcn_mfma_f32_16x16x32_bf16(AL[u], H1, acc1, 0, 0, 0); acc2 = __builtin_amdgcn_mfma_f32_16x16x32_bf16(AL[u], H2, acc2, 0, 0, 0); } } while (0)
        RT_LOAD(ah, al, 0);
#pragma unroll 1
        for (int kb = 0; kb < 1024; kb += 128) {
            RT_LOAD(ch, cl, kb + 64);
            RT_MMA(ah, al, kb);
            if (kb + 128 < 1024) RT_LOAD(ah, al, kb + 128);
            RT_MMA(ch, cl, kb + 64);
        }
#undef RT_LOAD
#undef RT_MMA
        }
        __syncthreads();
        if (tid < 32) hcnt[tid] = 0;
        __syncthreads();
        if (live) {
#pragma unroll
        for (int r = 0; r < 4; ++r) { lg[(4 * kq + r) * 48 + rr] = acc0[r]; lg[(4 * kq + r) * 48 + 16 + rr] = acc1[r]; lg[(4 * kq + r) * 48 + 32 + rr] = acc2[r]; }
        asm volatile("s_waitcnt lgkmcnt(0)" ::: "memory");
        __builtin_amdgcn_wave_barrier();
        if (lane < 16) {
            row = r0 + lane; const float* L = lg + lane * 48;
            float gl[4];
#pragma unroll
            for (int q = 0; q < 4; ++q) gl[q] = L[q] + bg[q];
            int gi = 0; float gm = gl[0];
#pragma unroll
            for (int q = 1; q < 4; ++q) if (gl[q] > gm) { gm = gl[q]; gi = q; }
            float den = 0.f;
#pragma unroll
            for (int q = 0; q < 4; ++q) den += expf(gl[q] - gm);
            const float pgroup = 1.0f / den;
            float el[8];
#pragma unroll
            for (int q = 0; q < 8; ++q) el[q] = L[4 + gi * 8 + q] + be[gi * 8 + q];
            int i0 = 0; float v0 = el[0];
#pragma unroll
            for (int q = 1; q < 8; ++q) if (el[q] > v0) { v0 = el[q]; i0 = q; }
            int i1 = -1; float v1 = -INFINITY;
#pragma unroll
            for (int q = 0; q < 8; ++q) if (q != i0 && el[q] > v1) { v1 = el[q]; i1 = q; }
            const float e1 = expf(v1 - v0); g0 = pgroup / (1.0f + e1); g1 = pgroup * e1 / (1.0f + e1);
            ea = gi * 8 + i0; eb = gi * 8 + i1;
            pa = atomicAdd(&hcnt[ea], 1); pb = atomicAdd(&hcnt[eb], 1);
        }
        __builtin_amdgcn_wave_barrier();
        }
        __syncthreads();
        if (tid < 32) { const int c = hcnt[tid]; hbase[tid] = c ? atomicAdd(&counts[tid], c) : 0; }
        __syncthreads();
        if (live && lane < 16) {
            pa += hbase[ea]; pb += hbase[eb];
            lists[(size_t)ea * NTOK + pa] = row; lists[(size_t)eb * NTOK + pb] = row;
            int* ti = (int*)(tinfo + (size_t)row * 8);
            ti[0] = ea; ti[1] = pa; ti[2] = eb; ti[3] = pb; tinfo[(size_t)row * 8 + 4] = g0; tinfo[(size_t)row * 8 + 5] = g1;
        }
        __syncthreads();
    }
}
#endif
DI void phase_route(const Frame& F, int l) {
    const float* xf = F.xf;
    const float* wg = F.in[33] + (size_t)l * 1024 * 4; const float* bg = F.in[34] + l * 4;
    const float* we = F.in[35] + (size_t)l * 1024 * 32; const float* be = F.in[36] + l * 32;
    int* counts = (int*)(F.ws + CTL_CNT) + l * 32;
    int* lists = WSP(int, OFF_LISTS); float* tinfo = WSP(float, OFF_TINFO);
    for (int row = ggrp(F); row < NTOK; row += ngrp(F)) {
        float gl[4] = {0.f, 0.f, 0.f, 0.f};
        for (int i = 0; i < PERLN; ++i) { const int c = glane(F) + i * GRP; const float x = xf[(size_t)row * DM + c];
#pragma unroll
            for (int q = 0; q < 4; ++q) gl[q] += x * wg[c * 4 + q]; }
#pragma unroll
        for (int q = 0; q < 4; ++q) gl[q] = grp_sum(F, gl[q]) + bg[q];
        int gi = 0; float gm = gl[0];
#pragma unroll
        for (int q = 1; q < 4; ++q) if (gl[q] > gm) { gm = gl[q]; gi = q; }
        float den = 0.f;
#pragma unroll
        for (int q = 0; q < 4; ++q) den += expf(gl[q] - gm);
        const float pgroup = 1.0f / den;
        float el[8] = {0.f, 0.f, 0.f, 0.f, 0.f, 0.f, 0.f, 0.f};
        for (int i = 0; i < PERLN; ++i) { const int c = glane(F) + i * GRP; const float x = xf[(size_t)row * DM + c];
#pragma unroll
            for (int q = 0; q < 8; ++q) el[q] += x * we[c * 32 + gi * 8 + q]; }
#pragma unroll
        for (int q = 0; q < 8; ++q) el[q] = grp_sum(F, el[q]) + be[gi * 8 + q];
        int i0 = 0; float v0 = el[0];
#pragma unroll
        for (int q = 1; q < 8; ++q) if (el[q] > v0) { v0 = el[q]; i0 = q; }
        int i1 = -1; float v1 = -INFINITY;
#pragma unroll
        for (int q = 0; q < 8; ++q) if (q != i0 && el[q] > v1) { v1 = el[q]; i1 = q; }
        const float e1 = expf(v1 - v0); const float g0 = pgroup / (1.0f + e1), g1 = pgroup * e1 / (1.0f + e1);
        if (glane(F) == 0) {
            const int ea = gi * 8 + i0, eb = gi * 8 + i1;
            const int pa = atomicAdd(&counts[ea], 1), pb = atomicAdd(&counts[eb], 1);
            lists[(size_t)ea * NTOK + pa] = row; lists[(size_t)eb * NTOK + pb] = row;
            int* ti = (int*)(tinfo + (size_t)row * 8);
            ti[0] = ea; ti[1] = pa; ti[2] = eb; ti[3] = pb; tinfo[(size_t)row * 8 + 4] = g0; tinfo[(size_t)row * 8 + 5] = g1;
        }
    }
}

struct EpiMoeUp {
    bf16* hm; int row0, pn;
    DI void operator()(int r, int c, float a, float b, float cc, float d) const {
        bf16* p = hm + (size_t)(row0 + r) * 256 + ((pn * 256 + c) >> 1);
#ifndef CPU_EMU
        const float s0 = a * __builtin_amdgcn_rcpf(1.0f + __builtin_amdgcn_exp2f(-1.4426950408889634f * a));
        const float s1 = cc * __builtin_amdgcn_rcpf(1.0f + __builtin_amdgcn_exp2f(-1.4426950408889634f * cc));
        __hip_atomic_store((__attribute__((address_space(1))) unsigned*)p, pack_bf16(s0 * b, s1 * d), __ATOMIC_RELAXED, __HIP_MEMORY_SCOPE_AGENT);
#else
        p[0] = f2bf(siluf_(a) * b); p[1] = f2bf(siluf_(cc) * d);
#endif
    }
#ifndef CPU_EMU
    DI void wide(int r, int c, const f32x4& u, const f32x4& v) const {
        bf16* p = hm + (size_t)(row0 + r) * 256 + ((pn * 256 + c) >> 1);
        const float s0 = u[0] * __builtin_amdgcn_rcpf(1.0f + __builtin_amdgcn_exp2f(-1.4426950408889634f * u[0]));
        const float s1 = u[2] * __builtin_amdgcn_rcpf(1.0f + __builtin_amdgcn_exp2f(-1.4426950408889634f * u[2]));
        const float s2 = v[0] * __builtin_amdgcn_rcpf(1.0f + __builtin_amdgcn_exp2f(-1.4426950408889634f * v[0]));
        const float s3 = v[2] * __builtin_amdgcn_rcpf(1.0f + __builtin_amdgcn_exp2f(-1.4426950408889634f * v[2]));
        const unsigned long long w = (unsigned long long)pack_bf16(s0 * u[1], s1 * u[3]) | ((unsigned long long)pack_bf16(s2 * v[1], s3 * v[3]) << 32);
        __hip_atomic_store((__attribute__((address_space(1))) unsigned long long*)p, w, __ATOMIC_RELAXED, __HIP_MEMORY_SCOPE_AGENT);
    }
#endif
};
DI int ld_cnt(const int* p) {
#ifdef CPU_EMU
    return *p;
#else
    return __hip_atomic_load(p, __ATOMIC_RELAXED, __HIP_MEMORY_SCOPE_AGENT);
#endif
}
DI void moe_tiles(const int* counts, int* toff  , int tid) {
    __syncthreads();
    if (tid < NEXP) toff[64 + tid] = (ld_cnt(counts + tid) + 255) >> 8;
    __syncthreads();
    if (tid == 0) { int acc = 0; for (int e = 0; e < NEXP; ++e) { toff[e] = acc; acc += toff[64 + e]; } toff[NEXP] = acc; }
    __syncthreads();
}
DI void phase_moe_up(const Frame& F, int l) {
    const int* counts = (const int*)(F.ws + CTL_CNT) + l * 32;
    int* eoff = (int*)(F.ws + CTL_EOFF) + l * 33;
    int* rowmap = (int*)(F.smem + 131072);
    int* toff = rowmap + 256;
    moe_tiles(counts, toff, fresh_tid(F));
    if (blockIdx.x == 0 && threadIdx.x == 0) for (int e = 0; e <= NEXP; ++e) eoff[e] = toff[e] * 256;
    const int* lists = WSP(int, OFF_LISTS); const bf16* xb = WSP(bf16, OFF_XB);
    const int nunit = toff[NEXP] * 2;
    for (int u = blockIdx.x; u < nunit; u += F.nblk) {
        const int tile = u >> 1, pn = u & 1;
        int e = 0; while (toff[e + 1] <= tile) ++e;
        const int t0 = (tile - toff[e]) * 256, cnt = ld_cnt(counts + e);
        __syncthreads();
        for (int i = fresh_tid(F); i < 256; i += NTH) rowmap[i] = (t0 + i < cnt) ? lists[(size_t)e * NTOK + t0 + i] : 0;
        __syncthreads();
        EpiMoeUp E{WSP(bf16, OFF_HM), tile * 256, pn};
        gemm_unit(F, xb, 1024, rowmap, 0, WSP(bf16, OFF_W13T) + (size_t)e * 512 * 1024, 1024, pn * 256, 1024, E);
    }
}
DI void phase_moe_down(const Frame& F, int l) {
    const int* counts = (const int*)(F.ws + CTL_CNT) + l * 32;
    int* toff = (int*)(F.smem + 131072) + 256;
    moe_tiles(counts, toff, fresh_tid(F));
    const int nunit = toff[NEXP] * 4;
    for (int u = blockIdx.x; u < nunit; u += F.nblk) {
        const int tile = u >> 2, pn = u & 3;
        int e = 0; while (toff[e + 1] <= tile) ++e;
        EpiBf E{WSP(bf16, OFF_YROWS), 1024, tile * 256, pn};
        gemm_unit(F, WSP(bf16, OFF_HM), 256, nullptr, tile * 256, WSP(bf16, OFF_W2T) + (size_t)e * 1024 * 256, 256, pn * 256, 256, E);
    }
}
#ifndef CPU_EMU
DI void phase_moe_fused(const Frame& F, int l) {
    const int* counts = (const int*)(F.ws + CTL_CNT) + l * 32;
    int* eoff = (int*)(F.ws + CTL_EOFF) + l * 33;
    int* rowmap = (int*)(F.smem + 131072);
    int* toff = rowmap + 256;
    moe_tiles(counts, toff, fresh_tid(F));
    if (blockIdx.x == 0 && threadIdx.x == 0) for (int e = 0; e <= NEXP; ++e) eoff[e] = toff[e] * 256;
    const int* lists = WSP(int, OFF_LISTS); const bf16* xb = WSP(bf16, OFF_XB);
    const int ntile = toff[NEXP], nup = ntile * 2, ntot = nup + ntile * 4;
    unsigned* qctr = (unsigned*)(F.ws + CTL_MOEQ) + l * 64;
    unsigned* done = (unsigned*)(F.ws + CTL_MOED) + l * 320;
    volatile int* slot = (volatile int*)(toff + 48);
    for (;;) {
        __syncthreads();
        if (fresh_tid(F) == 0) *slot = (int)atomicAdd(qctr, 1u);
        __syncthreads();
        const int u = *slot;
        if (u >= ntot) break;
        if (u < nup) {
            const int tile = u >> 1, pn = u & 1;
            int e = 0; while (toff[e + 1] <= tile) ++e;
            const int t0 = (tile - toff[e]) * 256, cnt = ld_cnt(counts + e);
            for (int i = fresh_tid(F); i < 256; i += NTH) rowmap[i] = (t0 + i < cnt) ? lists[(size_t)e * NTOK + t0 + i] : 0;
            __syncthreads();
            EpiMoeUp E{WSP(bf16, OFF_HM), tile * 256, pn};
            gemm_unit(F, xb, 1024, rowmap, 0, WSP(bf16, OFF_W13T) + (size_t)e * 512 * 1024, 1024, pn * 256, 1024, E);
            asm volatile("s_waitcnt vmcnt(0)" ::: "memory");
            __syncthreads();
            if (fresh_tid(F) == 0) __hip_atomic_fetch_add((__attribute__((address_space(1))) unsigned*)(done + tile), 1u, __ATOMIC_RELAXED, __HIP_MEMORY_SCOPE_AGENT);
        } else {
            const int d = u - nup, tile = d >> 2, pn = d & 3;
            int e = 0; while (toff[e + 1] <= tile) ++e;
            if (fresh_tid(F) == 0) {
                while (__hip_atomic_load((__attribute__((address_space(1))) unsigned*)(done + tile), __ATOMIC_RELAXED, __HIP_MEMORY_SCOPE_AGENT) < 2u) __builtin_amdgcn_s_sleep(2);
                __builtin_amdgcn_fence(__ATOMIC_ACQUIRE, "agent");
            }
            __syncthreads();
            EpiBf E{WSP(bf16, OFF_YROWS), 1024, tile * 256, pn};
            gemm_unit(F, WSP(bf16, OFF_HM), 256, nullptr, tile * 256, WSP(bf16, OFF_W2T) + (size_t)e * 1024 * 256, 256, pn * 256, 256, E);
        }
    }
}
#endif
DI void phase_ln3(const Frame& F, int l) {
#ifndef CPU_EMU
    ln_rows_gpu<2>(F, F.in[40] + l * 1024, F.in[41] + l * 1024, l);
#else
    const float* xf = F.xf; const bf16* yr = WSP(bf16, OFF_YROWS); const float* tinfo = WSP(float, OFF_TINFO);
    const int* eoff = (const int*)(F.ws + CTL_EOFF) + l * 33;
    layer_norm_rows(F, F.in[40] + l * 1024, F.in[41] + l * 1024, [&](int row, int c) {
        const int* ti = (const int*)(tinfo + (size_t)row * 8);
        const size_t ra = (size_t)eoff[ti[0]] + ti[1], rb = (size_t)eoff[ti[2]] + ti[3];
        return DN_ALPHA * xf[(size_t)row * DM + c] + tinfo[(size_t)row * 8 + 4] * bf2f(yr[ra * 1024 + c]) + tinfo[(size_t)row * 8 + 5] * bf2f(yr[rb * 1024 + c]);
    }, false, nullptr);
#endif
}

#ifndef CPU_EMU
#define XB_TMO      128
#define XB_XCNT(j)  (256  + 64 * (j))
#define XB_XSUB(j)  (1280 + 64 * (j))
#define XB_XGEN(j)  (2304 + 64 * (j))
#define XB_TOP      3328
#define XB_TOPGEN   3392
#define XCD_BAR_WORDS 3456
#define XB_SPIN_CAP (1u << 18)
#define LAS __attribute__((address_space(3)))

__device__ __forceinline__ unsigned xb_ld(unsigned* p)              { return __hip_atomic_load(p, __ATOMIC_RELAXED, __HIP_MEMORY_SCOPE_AGENT); }
__device__ __forceinline__ unsigned xb_add(unsigned* p, unsigned v) { return __hip_atomic_fetch_add(p, v, __ATOMIC_RELAXED, __HIP_MEMORY_SCOPE_AGENT); }
__device__ __forceinline__ unsigned xb_xcc_id() { return (unsigned)__builtin_amdgcn_s_getreg((3 << 11) | 20) & 0xFu; }
#define XB_SPIN(cond, bar) do { unsigned _sp = 0; while (cond) { __builtin_amdgcn_s_sleep(1); \
    if ((++_sp & 255u) == 0u) { if (xb_ld(&(bar)[XB_TMO])) break; if (_sp > XB_SPIN_CAP) { atomicAdd(&(bar)[XB_TMO], 1u); break; } } } } while (0)

struct XcdBarrier {
    unsigned* bar; unsigned x;
    volatile LAS unsigned* st;
};

__device__ __forceinline__ XcdBarrier xcd_barrier_post(unsigned* bar, volatile LAS unsigned* st) {
    XcdBarrier b; b.bar = bar; b.x = xb_xcc_id(); b.st = st;
    if (threadIdx.x == 0) (void)xb_add(&bar[XB_XCNT(b.x)], 1u);
    return b;
}
__device__ __forceinline__ void xcd_barrier_complete(unsigned* bar, unsigned x, unsigned& nloc, unsigned& nx) {
    const unsigned G = gridDim.x * gridDim.y * gridDim.z;
    unsigned sum, cnt, mine, sp = 0u;
    for (;;) {
        sum = 0u; cnt = 0u; mine = 0u;
#pragma unroll
        for (unsigned j = 0; j < 16; ++j) { const unsigned c = xb_ld(&bar[XB_XCNT(j)]); sum += c; cnt += (c > 0u) ? 1u : 0u; mine = (j == x) ? c : mine; }
        if (sum == G) break;
        __builtin_amdgcn_s_sleep(1);
        if ((++sp & 255u) == 0u) { if (xb_ld(&bar[XB_TMO])) break; if (sp > XB_SPIN_CAP) { atomicAdd(&bar[XB_TMO], 1u); break; } }
    }
    nloc = mine > 0u ? mine : 1u; nx = cnt > 0u ? cnt : 1u;
}

__device__ __forceinline__ void xcd_barrier(const XcdBarrier& b) {
    asm volatile("s_waitcnt vmcnt(0)" ::: "memory");
    __syncthreads();
    if (threadIdx.x == 0) {
        unsigned* bar = b.bar;
        __builtin_amdgcn_s_waitcnt(0);
        unsigned nloc = b.st[0], nx = b.st[1];
        if (nloc == 0u) { xcd_barrier_complete(bar, b.x, nloc, nx); b.st[0] = nloc; b.st[1] = nx; }
        const unsigned old = xb_add(&bar[XB_XSUB(b.x)], 1u);
        const unsigned gen = old / nloc;
        if (old + 1u == (gen + 1u) * nloc) {
            __builtin_amdgcn_fence(__ATOMIC_RELEASE, "agent");
            asm volatile("s_waitcnt vmcnt(0)" ::: "memory");
            const unsigned og = xb_add(&bar[XB_TOP], 1u);
            const unsigned tg = og / nx;
            if (og + 1u == (tg + 1u) * nx) xb_add(&bar[XB_TOPGEN], 1u);
            else XB_SPIN(xb_ld(&bar[XB_TOPGEN]) == tg, bar);
            __builtin_amdgcn_fence(__ATOMIC_ACQUIRE, "agent");
            xb_add(&bar[XB_XGEN(b.x)], 1u);
            asm volatile("s_waitcnt vmcnt(0)" ::: "memory");
        } else {
            XB_SPIN(xb_ld(&bar[XB_XGEN(b.x)]) == gen, bar);
            __builtin_amdgcn_fence(__ATOMIC_ACQUIRE, "agent");
            asm volatile("s_waitcnt vmcnt(0)" ::: "memory");
        }
    }
    __syncthreads();
}

#endif

constexpr int NPH_LAYER = 16;
constexpr int NPH_TOTAL = 1 + 2 * NPH_LAYER;
constexpr int SMEM_BYTES = 158976 + 1024;

#ifndef CPU_EMU
DI void phase_attn_queue(const Frame& F, int l) {
    {
            const AttnDesc Ag = desc_gqa(F), Am = desc_mla(F);
            const int ng = attn_nunit<64, 64, 64, 2>(Ag), nm = attn_nunit<96, 64, 64, 1>(Am);
            const bool xq = (F.nblk & 7) == 0 && (ng & 7) == 0 && (nm & 7) == 0;
            const int x = xq ? (int)(blockIdx.x & 7) : 0, ngl = xq ? ng >> 3 : ng, nml = xq ? nm >> 3 : nm;
            unsigned* qctr = xq ? (unsigned*)(F.ws + CTL_AQ) + (l * 8 + x) * 16 : (unsigned*)(F.ws + CTL_QUEUE) + l * 64;
            volatile int* slot = (volatile int*)(F.smem + SMEM_BYTES - 32);
            for (;;) {
                __syncthreads();
                if (fresh_tid(F) == 0) *slot = (int)atomicAdd(qctr, 1u);
                __syncthreads();
                const int u = *slot;
                if (u >= ngl + nml) break;
                if (u < ngl) attn_unit<64, 64, 64, 2>(F, Ag, x * ngl + u); else attn_unit<96, 64, 64, 1>(F, Am, x * nml + (u - ngl));
            }
        }
}
#endif

template <int K>
DI void run_layer_phase(const Frame& F, int l) {
    if constexpr (K == 0) phase_cvt(F, l);
    if constexpr (K == 1) phase_gemm1(F);
    if constexpr (K == 2) phase_prep(F, l);
    if constexpr (K == 3) phase_mlaup(F);
    if constexpr (K == 4) {
#ifdef CPU_EMU
        attn_phase<64, 64>(F, desc_gqa(F)); attn_phase<96, 64>(F, desc_mla(F)); phase_scans(F);
#else
        phase_scans(F, l);
        phase_attn_queue(F, l);
#endif
    }
#ifdef CPU_EMU
    if constexpr (K == 5) phase_fin(F, l);
#else
    if constexpr (K == 5) phase_fin_gpu(F, l);
#endif
    if constexpr (K == 6) phase_gemm_sq<0>(F, WSP(bf16, OFF_YCAT), W_OUT_T, nullptr);
    if constexpr (K == 7) phase_ln(F, F.in[26] + l * 1024, F.in[27] + l * 1024);
#if !defined(CPU_EMU) && N_LAUNCH_MODE == 1
    if constexpr (K == 8) phase_q_memattn(F);
#else
    if constexpr (K == 8) phase_gemm_sq<1>(F, WSP(bf16, OFF_XB), W_Q_T, WSP(bf16, OFF_QMEM));
    if constexpr (K == 9) {
#ifdef CPU_EMU
        attn_phase<256, 256>(F, desc_mem(F));
#else
        memattn_phase(F, desc_mem(F));
#endif
    }
#endif
    if constexpr (K == 10) phase_gemm_sq<2>(F, WSP(bf16, OFF_OMEM), W_O_T, nullptr);
#ifdef CPU_EMU
    if constexpr (K == 11) { phase_ln<true>(F, F.in[31] + l * 1024, F.in[32] + l * 1024); phase_cvt_moe(F, l); }
#else
    if constexpr (K == 11) { phase_ln<true>(F, F.in[31] + l * 1024, F.in[32] + l * 1024); phase_cvt_moe(F, l, 0, 0, 5); }
#endif
#ifdef CPU_EMU
    if constexpr (K == 12) phase_route(F, l);
#else
    if constexpr (K == 12) phase_route_gpu(F, l);
#endif
#if !defined(CPU_EMU) && N_LAUNCH_MODE == 1
    if constexpr (K == 13) phase_moe_fused(F, l);
#else
    if constexpr (K == 13) phase_moe_up(F, l);
    if constexpr (K == 14) phase_moe_down(F, l);
#endif
    if constexpr (K == 15) phase_ln3(F, l);
}

#ifndef CPU_EMU
template <int K>
__global__ void __launch_bounds__(512, 2) k_phase(Args a, int l) {
    extern __shared__ __attribute__((aligned(16))) unsigned char lds[];
    Frame F; F.in = (InPtr)__builtin_amdgcn_kernarg_segment_ptr(); F.xf = a.out; F.ws = a.ws; F.smem = lds; F.tid = threadIdx.x; F.wv = __builtin_amdgcn_readfirstlane((int)(threadIdx.x >> 6)); F.nblk = a.ph_lo;
    if constexpr (K < 0) phase_pro(F); else run_layer_phase<K>(F, l);
}

template <int K>
static void launch_phase(const Args& a, int l, int grid, hipStream_t stream) {
    static bool attr = false;
    if (!attr) { (void)hipFuncSetAttribute((const void*)k_phase<K>, hipFuncAttributeMaxDynamicSharedMemorySize, SMEM_BYTES); attr = true; }
    hipLaunchKernelGGL(k_phase<K>, dim3(grid), dim3(512), SMEM_BYTES, stream, a, l);
}

__global__ void __launch_bounds__(512, 2) fwd_one(Args a) {
    extern __shared__ __attribute__((aligned(16))) unsigned char lds[];
    const int wave_s = __builtin_amdgcn_readfirstlane((int)(threadIdx.x >> 6));
    volatile LAS unsigned* st = (volatile LAS unsigned*)(lds + SMEM_BYTES - 16);
    if (threadIdx.x == 0) { st[0] = 0u; st[1] = 0u; st[2] = 0u; st[3] = 0u; }
    __syncthreads();
    XcdBarrier bar = xcd_barrier_post((unsigned*)(a.ws + OFF_CTL), st);
    Frame F;
#define FRESH do { unsigned z_ = 0u, m_ = ~0u; int ws_ = wave_s; asm volatile("" : "+s"(z_), "+s"(ws_), "+s"(m_)); \
        int t_ = ws_ * 64 + (int)__builtin_amdgcn_mbcnt_hi(m_, __builtin_amdgcn_mbcnt_lo(m_, 0u)); asm volatile("" : "+v"(t_)); \
        const __attribute__((address_space(4))) char* kp_ = (const __attribute__((address_space(4))) char*)__builtin_amdgcn_kernarg_segment_ptr() + z_; \
        F.in = (InPtr)kp_; F.xf = *(float* const __attribute__((address_space(4)))*)(kp_ + 42 * 8); F.ws = *(unsigned char* const __attribute__((address_space(4)))*)(kp_ + 43 * 8); \
        F.smem = lds; F.tid = t_; F.wv = ws_; F.nblk = *(const int __attribute__((address_space(4)))*)(kp_ + 44 * 8); } while (0)
#define GB do { { unsigned zb_ = 0u; unsigned xx_ = __builtin_amdgcn_readfirstlane(bar.x); asm volatile("" : "+s"(zb_), "+s"(xx_)); bar.bar = (unsigned*)(a.ws + OFF_CTL) + zb_; bar.x = xx_; } \
        xcd_barrier(bar); } while (0)
#define DUP(k) ((PROBE_DUP >> (k)) & 1)
    FRESH; phase_pro(F); FRESH; phase_cvt(F, 0); GB;
    if (DUP(0)) { FRESH; phase_cvt(F, 0); GB; }
    for (int l = 0; l < 2; ++l) {
        FRESH; run_layer_phase<1>(F, l); GB;
        if (DUP(1)) { FRESH; run_layer_phase<1>(F, l); GB; }
        FRESH; run_layer_phase<2>(F, l); GB;
        FRESH; run_layer_phase<3>(F, l); GB;
        if (DUP(3)) { FRESH; run_layer_phase<3>(F, l); GB; }
        if (DUP(4)) { FRESH; attn_phase<64, 64, 64, 2>(F, desc_gqa(F)); attn_phase<96, 64, 64, 1>(F, desc_mla(F)); GB; }
        FRESH; run_layer_phase<4>(F, l); GB;
        FRESH; run_layer_phase<5>(F, l); GB;
        if (DUP(5)) { FRESH; run_layer_phase<5>(F, l); GB; }
        FRESH; run_layer_phase<6>(F, l); GB;
        FRESH; run_layer_phase<7>(F, l); GB;
        FRESH; run_layer_phase<8>(F, l); GB;
        if (DUP(8)) { FRESH; run_layer_phase<8>(F, l); GB; }
        FRESH; run_layer_phase<10>(F, l); GB;
        FRESH; run_layer_phase<11>(F, l); if (NTOK % (F.nblk * 32) != 0) GB; FRESH; run_layer_phase<12>(F, l); if (l == 0) { FRESH; phase_cvt(F, 1); } GB;
        if (DUP(11)) { FRESH; phase_cvt_moe(F, l); GB; }
        FRESH; run_layer_phase<13>(F, l); GB;
        if (DUP(13)) { FRESH; run_layer_phase<13>(F, l); GB; }
        FRESH; run_layer_phase<15>(F, l); if (l == 0) GB;
    }
#undef DUP
#undef GB
#undef FRESH
}

extern "C" void kernel_launch(void* const* d_in, const int* in_sizes, int n_in, void* d_out, int out_size, void* d_ws, size_t ws_size, hipStream_t stream) {
    if (n_in != 42 || ws_size < WS_END) return;
    Args a{};
    for (int i = 0; i < 42; ++i) a.in[i] = (const float*)d_in[i];
    a.out = (float*)d_out; a.ws = (unsigned char*)d_ws; a.ph_lo = 0; a.ph_hi = NPH_TOTAL;
    (void)hipMemsetAsync(d_ws, 0, CTL_BYTES, stream);
#if N_LAUNCH_MODE == 1
    static int grid = 0;
    if (!grid) {
        int dev = 0, cus = 0, per_cu = 0;
        (void)hipGetDevice(&dev);
        (void)hipDeviceGetAttribute(&cus, hipDeviceAttributeMultiprocessorCount, dev);
        (void)hipFuncSetAttribute((const void*)fwd_one, hipFuncAttributeMaxDynamicSharedMemorySize, SMEM_BYTES);
        (void)hipOccupancyMaxActiveBlocksPerMultiprocessor(&per_cu, (const void*)fwd_one, 512, SMEM_BYTES);
        (void)hipGetLastError();
        grid = cus > 0 ? cus : 256;
    }
    a.ph_lo = grid;
    hipLaunchKernelGGL(fwd_one, dim3(grid), dim3(512), SMEM_BYTES, stream, a);
#else
    const int grid = 256; a.ph_lo = grid;
    launch_phase<-1>(a, 0, grid, stream);
    for (int l = 0; l < 2; ++l) {
        launch_phase<0>(a, l, grid, stream); launch_phase<1>(a, l, grid, stream); launch_phase<2>(a, l, grid, stream); launch_phase<3>(a, l, grid, stream);
        launch_phase<4>(a, l, grid, stream); launch_phase<5>(a, l, grid, stream); launch_phase<6>(a, l, grid, stream); launch_phase<7>(a, l, grid, stream);
        launch_phase<8>(a, l, grid, stream); launch_phase<9>(a, l, grid, stream); launch_phase<10>(a, l, grid, stream); launch_phase<11>(a, l, grid, stream);
        launch_phase<12>(a, l, grid, stream); launch_phase<13>(a, l, grid, stream); launch_phase<14>(a, l, grid, stream); launch_phase<15>(a, l, grid, stream);
    }
#endif
}
#endif
```
